# Optimizing an MI355X kernel written in HIP

```python
import jax, jax.numpy as jnp
from jax import lax
import numpy as np

D_MODEL = 1024
BATCH = 32
SEQ = 2048
DEPTH = 4

GRID_W = 64
CTX_LEN = 256
N_MIXERS = 3
N_ATTN = (DEPTH + 2) // 3
N_POOL = (DEPTH + 1) // 3
N_RWKV = DEPTH // 3
NORM_EPS = 1e-5

HEAD_DIM = 64
N_HEADS = D_MODEL // HEAD_DIM
N_KV_HEADS = N_HEADS // 4
Q_DIM = N_HEADS * HEAD_DIM
KV_DIM = N_KV_HEADS * HEAD_DIM
QKV_DIM = Q_DIM + 2 * KV_DIM
WINDOW = 128
ATTN_BLOCK = 128
KEY_SPAN = ATTN_BLOCK + 2 * WINDOW
ROPE_BASE = 10000.0

POOL_SIZES = (2, 4, 8, 16)
POOL_GROUPS = len(POOL_SIZES)
POOL_GW = D_MODEL // POOL_GROUPS

RWKV_HEAD = 64
RWKV_HEADS = D_MODEL // RWKV_HEAD
DECAY_LORA = 64
ICLR_LORA = 64
GATE_LORA = 128
GN_EPS = 64e-5

N_EXPERTS = 32
TOP_K = 4
D_FF = D_MODEL
SWIGLU_LIMIT = 7.0
SWIGLU_ALPHA = 1.702
MOE_BLOCK = 256

kernel_name = "hybrid_interleaved_diffusion_trunk"


def rms_norm(x, g):
    xf = x.astype(jnp.float32)
    y = xf * lax.rsqrt(jnp.mean(xf * xf, axis=-1, keepdims=True) + NORM_EPS)
    return (y * g.astype(jnp.float32)).astype(x.dtype)


def modulate(h, shift, scale):
    return h * (1 + scale) + shift


def axial_rope_tables(n_tok):
    rows = n_tok // GRID_W
    n_freq = HEAD_DIM // 4
    inv = ROPE_BASE ** (-jnp.arange(n_freq, dtype=jnp.float32) / n_freq)
    row_ang = jnp.arange(rows, dtype=jnp.float32)[:, None] * inv
    col_ang = jnp.arange(GRID_W, dtype=jnp.float32)[:, None] * inv
    ang_r = jnp.broadcast_to(row_ang[:, None, :], (rows, GRID_W, n_freq)).reshape(n_tok, n_freq)
    ang_c = jnp.broadcast_to(col_ang[None, :, :], (rows, GRID_W, n_freq)).reshape(n_tok, n_freq)
    ang = jnp.concatenate([ang_r, ang_r, ang_c, ang_c], axis=-1)
    return jnp.cos(ang), jnp.sin(ang)


def apply_axial_rope(x, cos, sin):
    xf = x.astype(jnp.float32)
    xr = xf.reshape(x.shape[:-1] + (2, 2, HEAD_DIM // 4))
    rot = jnp.stack([-xr[..., 1, :], xr[..., 0, :]], axis=-2).reshape(x.shape)
    return (xf * cos[:, None, :] + rot * sin[:, None, :]).astype(x.dtype)


def softmax_with_sink(logits, sink):
    sink_col = jnp.broadcast_to(sink[None, :, :, None, None], logits.shape[:-1] + (1,))
    p = jax.nn.softmax(jnp.concatenate([logits, sink_col], axis=-1), axis=-1)
    return p[..., :-1]


def windowed_gqa(hx, hc, w_qkv, b_qkv, w_o, b_o, sinks, need_ctx_out):
    B, T, _ = hx.shape
    L = hc.shape[1]
    G = N_HEADS // N_KV_HEADS
    scale = HEAD_DIM ** -0.5

    def project(h):
        n = h.shape[1]
        qkv = h @ w_qkv + b_qkv
        q, k, v = jnp.split(qkv, [Q_DIM, Q_DIM + KV_DIM], axis=-1)
        return (q.reshape(B, n, N_HEADS, HEAD_DIM), k.reshape(B, n, N_KV_HEADS, HEAD_DIM),
                v.reshape(B, n, N_KV_HEADS, HEAD_DIM))

    qx, kx, vx = project(hx)
    qc, kc, vc = project(hc)
    cos, sin = axial_rope_tables(T)
    qx = apply_axial_rope(qx, cos, sin).reshape(B, T, N_KV_HEADS, G, HEAD_DIM)
    kx = apply_axial_rope(kx, cos, sin)
    sink = sinks.astype(jnp.float32).reshape(N_KV_HEADS, G)

    nb = T // ATTN_BLOCK
    q_blocks = jnp.moveaxis(qx.reshape(B, nb, ATTN_BLOCK, N_KV_HEADS, G, HEAD_DIM), 1, 0)
    kx_p = jnp.pad(kx, ((0, 0), (WINDOW, WINDOW), (0, 0), (0, 0)))
    vx_p = jnp.pad(vx, ((0, 0), (WINDOW, WINDOW), (0, 0), (0, 0)))
    rel = jnp.arange(KEY_SPAN)[None, :] - WINDOW - jnp.arange(ATTN_BLOCK)[:, None]
    band = jnp.abs(rel) <= WINDOW

    def block(args):
        qb, b = args
        start = b * ATTN_BLOCK
        kb = lax.dynamic_slice_in_dim(kx_p, start, KEY_SPAN, axis=1)
        vb = lax.dynamic_slice_in_dim(vx_p, start, KEY_SPAN, axis=1)
        kpos = start - WINDOW + jnp.arange(KEY_SPAN)
        valid = band & ((kpos >= 0) & (kpos < T))[None, :]
        s_loc = jnp.einsum('bqkgd,bskd->bkgqs', qb, kb, preferred_element_type=jnp.float32) * scale
        s_loc = jnp.where(valid, s_loc, -jnp.inf)
        s_ctx = jnp.einsum('bqkgd,bskd->bkgqs', qb, kc, preferred_element_type=jnp.float32) * scale
        p = softmax_with_sink(jnp.concatenate([s_ctx, s_loc], axis=-1), sink).astype(vb.dtype)
        o = (jnp.einsum('bkgqs,bskd->bqkgd', p[..., :L], vc)
             + jnp.einsum('bkgqs,bskd->bqkgd', p[..., L:], vb))
        return o.reshape(B, ATTN_BLOCK, Q_DIM)

    ox = lax.map(block, (q_blocks, jnp.arange(nb)))
    ox = jnp.moveaxis(ox, 0, 1).reshape(B, T, Q_DIM)
    yx = ox @ w_o + b_o
    yc = None
    if need_ctx_out:
        qcg = qc.reshape(B, L, N_KV_HEADS, G, HEAD_DIM)
        s = jnp.einsum('bqkgd,bskd->bkgqs', qcg, kc, preferred_element_type=jnp.float32) * scale
        p = softmax_with_sink(s, sink).astype(vc.dtype)
        oc = jnp.einsum('bkgqs,bskd->bqkgd', p, vc).reshape(B, L, Q_DIM)
        yc = oc @ w_o + b_o
    return yx, yc


def multiscale_pool(h, w, b, ls):
    n = h.shape[1]
    hf = h.astype(jnp.float32)
    cs = jnp.pad(jnp.cumsum(hf, axis=1), ((0, 0), (1, 0), (0, 0)))
    t = jnp.arange(n)
    outs = []
    for g, size in enumerate(POOL_SIZES):
        lo = jnp.clip(t - size // 2, 0, n)
        hi = jnp.clip(t + size - size // 2, 0, n)
        sl = slice(g * POOL_GW, (g + 1) * POOL_GW)
        csg = cs[..., sl]
        mean = (jnp.take(csg, hi, axis=1) - jnp.take(csg, lo, axis=1)) / (hi - lo).astype(jnp.float32)[None, :, None]
        d = (mean - hf[..., sl]).astype(h.dtype)
        outs.append(jnp.einsum('bti,io->bto', d, w[g]) + b[g])
    return jnp.concatenate(outs, axis=-1) * ls


def centred_token_shift(h):
    zero = jnp.zeros_like(h[:, :1])
    prev = jnp.concatenate([zero, h[:, :-1]], axis=1)
    nxt = jnp.concatenate([h[:, 1:], zero], axis=1)
    return 0.5 * (prev + nxt) - h


def rwkv7_streams(h, mix, w_rkv, w0, w1, w2, a0, a1, a2, g1, g2, k_k, k_a):
    B, n, _ = h.shape
    f32 = jnp.float32
    xx = centred_token_shift(h)
    x_r, x_w, x_k, x_v, x_a, x_g = (h + xx * mix[i] for i in range(6))
    r = x_r @ w_rkv[0]
    k = x_k @ w_rkv[1]
    v = x_v @ w_rkv[2]
    g = jax.nn.sigmoid(x_g @ g1) @ g2

    def heads(z):
        return z.astype(f32).reshape(B, n, RWKV_HEADS, RWKV_HEAD)

    kk = heads(k * k_k)
    kk = kk / jnp.maximum(jnp.sqrt(jnp.sum(kk * kk, axis=-1, keepdims=True)), 1e-12)
    dirs = []
    for d in range(2):
        w_log = -jax.nn.softplus(-(w0[d] + jnp.tanh(x_w @ w1[d]) @ w2[d]).astype(f32)) - 0.5
        decay = jnp.exp(-jnp.exp(w_log))
        a = jax.nn.sigmoid((a0[d] + (x_a @ a1[d]) @ a2[d]).astype(f32))
        k_d = k.astype(f32) * (1 + (a - 1) * k_a.astype(f32))
        dirs.append((heads(decay), heads(k_d), -kk, kk * heads(a)))
    return heads(r), heads(v), g, dirs


def rwkv7_scan(r, decay, k, v, a, b, s0, reverse):
    def step(S, inp):
        r_t, w_t, k_t, v_t, a_t, b_t = inp
        sa = jnp.einsum('bhvk,bhk->bhv', S, a_t)
        S = S * w_t[:, :, None, :] + sa[..., None] * b_t[:, :, None, :] + v_t[..., None] * k_t[:, :, None, :]
        return S, jnp.einsum('bhvk,bhk->bhv', S, r_t)
    xs = tuple(jnp.moveaxis(z, 1, 0) for z in (r, decay, k, v, a, b))
    s_last, ys = lax.scan(step, s0, xs, reverse=reverse)
    return s_last, jnp.moveaxis(ys, 0, 1)


def rwkv7_output(y, r, v, g, dirs, r_k, ln_w, ln_b, w_o, dtype):
    B, n = y.shape[:2]
    mu = jnp.mean(y, axis=-1, keepdims=True)
    var = jnp.mean(jnp.square(y - mu), axis=-1, keepdims=True)
    yn = ((y - mu) * lax.rsqrt(var + GN_EPS)).reshape(B, n, D_MODEL) * ln_w.astype(jnp.float32) + ln_b.astype(jnp.float32)
    rk = r_k.astype(jnp.float32)
    bonus = sum(jnp.sum(r * dd[1] * rk, axis=-1, keepdims=True) for dd in dirs) * v
    out = (yn + bonus.reshape(B, n, D_MODEL)).astype(dtype) * g
    return out @ w_o


def rwkv7_mixer(hx, hc, mix, w_rkv, w0, w1, w2, a0, a1, a2, g1, g2, k_k, k_a, r_k, ln_w, ln_b, w_o, need_ctx_out):
    r_x, v_x, g_x, dirs_x = rwkv7_streams(hx, mix, w_rkv, w0, w1, w2, a0, a1, a2, g1, g2, k_k, k_a)
    r_c, v_c, g_c, dirs_c = rwkv7_streams(hc, mix, w_rkv, w0, w1, w2, a0, a1, a2, g1, g2, k_k, k_a)
    s0 = jnp.zeros((hx.shape[0], RWKV_HEADS, RWKV_HEAD, RWKV_HEAD), jnp.float32)
    ys_x, ys_c = [], []
    for d, rev in enumerate((False, True)):
        dc, kc_, ac, bc = dirs_c[d]
        s_ctx, y_c = rwkv7_scan(r_c, dc, kc_, v_c, ac, bc, s0, rev)
        dx, kx_, ax, bx = dirs_x[d]
        _, y_x = rwkv7_scan(r_x, dx, kx_, v_x, ax, bx, s_ctx, rev)
        ys_x.append(y_x)
        ys_c.append(y_c)
    yx = rwkv7_output(ys_x[0] + ys_x[1], r_x, v_x, g_x, dirs_x, r_k, ln_w, ln_b, w_o, hx.dtype)
    yc = None
    if need_ctx_out:
        yc = rwkv7_output(ys_c[0] + ys_c[1], r_c, v_c, g_c, dirs_c, r_k, ln_w, ln_b, w_o, hc.dtype)
    return yx, yc


def moe_ffn(xf, w_router, b_router, w1, b1, w2, b2):
    n = xf.shape[0]
    logits = (xf @ w_router + b_router).astype(jnp.float32)
    top_logits, top_idx = lax.top_k(logits, TOP_K)
    gates = jax.nn.softmax(top_logits, axis=-1)
    nk = n * TOP_K
    e_flat = top_idx.reshape(nk)
    order = jnp.argsort(e_flat)
    e_sorted = e_flat[order]
    tok_sorted = (order // TOP_K).astype(jnp.int32)
    gate_sorted = gates.reshape(nk)[order]
    counts = jnp.bincount(e_flat, length=N_EXPERTS)
    padded = (counts + MOE_BLOCK - 1) // MOE_BLOCK * MOE_BLOCK
    pad_end = jnp.cumsum(padded)
    pad_start = pad_end - padded
    start = jnp.cumsum(counts) - counts
    dest = pad_start[e_sorted] + jnp.arange(nk) - start[e_sorted]
    n_blocks = -(-nk // MOE_BLOCK) + N_EXPERTS
    rows = n_blocks * MOE_BLOCK
    row_tok = jnp.full((rows,), n, jnp.int32).at[dest].set(tok_sorted)
    row_gate = jnp.zeros((rows,), jnp.float32).at[dest].set(gate_sorted)
    block_expert = jnp.minimum(jnp.searchsorted(pad_end, jnp.arange(n_blocks) * MOE_BLOCK, side='right'), N_EXPERTS - 1)
    x_pad = jnp.concatenate([xf, jnp.zeros((1, xf.shape[1]), xf.dtype)], axis=0)
    xb = x_pad[row_tok].reshape(n_blocks, MOE_BLOCK, xf.shape[1])

    def expert_block(args):
        xblk, e = args
        hcat = xblk @ w1[e] + b1[e]
        h_glu = jnp.minimum(hcat[:, :D_FF], SWIGLU_LIMIT)
        h_lin = jnp.clip(hcat[:, D_FF:], -SWIGLU_LIMIT, SWIGLU_LIMIT)
        act = h_glu * jax.nn.sigmoid(SWIGLU_ALPHA * h_glu) * (h_lin + 1)
        return act @ w2[e] + b2[e]

    yb = lax.map(expert_block, (xb, block_expert)).reshape(rows, xf.shape[1])
    yb = yb * row_gate[:, None].astype(yb.dtype)
    return jax.ops.segment_sum(yb, row_tok, num_segments=n + 1)[:n]


def setup_inputs(seed: int = 0) -> dict:
    key = jax.random.key(seed)
    keys = list(jax.random.split(key, 64))
    D = D_MODEL

    def nrm(shape, std):
        return std * jax.random.normal(keys.pop(), shape, jnp.float32)

    def uni(shape, lo, hi):
        return jax.random.uniform(keys.pop(), shape, jnp.float32, lo, hi)

    inp = {}
    inp['x'] = nrm((BATCH, SEQ, D), 1.0)
    inp['c'] = nrm((BATCH, D), 1.0)
    inp['ctx'] = nrm((BATCH, CTX_LEN, D), 1.0)
    inp['c_ctx'] = nrm((D,), 1.0)
    inp['ada_w'] = nrm((DEPTH, D, 6 * D), 0.02)
    inp['ada_b'] = nrm((DEPTH, 6 * D), 0.01)
    inp['norm_g'] = 1.0 + nrm((DEPTH, 2, D), 0.05)
    inp['attn_w_qkv'] = nrm((N_ATTN, D, QKV_DIM), D ** -0.5)
    inp['attn_b_qkv'] = nrm((N_ATTN, QKV_DIM), 0.01)
    inp['attn_w_o'] = nrm((N_ATTN, Q_DIM, D), Q_DIM ** -0.5)
    inp['attn_b_o'] = nrm((N_ATTN, D), 0.01)
    inp['attn_sinks'] = nrm((N_ATTN, N_HEADS), 0.5)
    inp['pool_w'] = nrm((N_POOL, POOL_GROUPS, POOL_GW, POOL_GW), POOL_GW ** -0.5)
    inp['pool_b'] = nrm((N_POOL, POOL_GROUPS, POOL_GW), 0.01)
    inp['pool_scale'] = 1.0 + nrm((N_POOL, D), 0.1)
    inp['rwkv_mix'] = uni((N_RWKV, 6, D), 0.0, 1.0)
    inp['rwkv_w_rkv'] = nrm((N_RWKV, 3, D, D), D ** -0.5)
    inp['rwkv_w0'] = uni((N_RWKV, 2, D), -6.0, 0.0)
    inp['rwkv_w1'] = nrm((N_RWKV, 2, D, DECAY_LORA), D ** -0.5)
    inp['rwkv_w2'] = nrm((N_RWKV, 2, DECAY_LORA, D), 0.3 * DECAY_LORA ** -0.5)
    inp['rwkv_a0'] = nrm((N_RWKV, 2, D), 0.1)
    inp['rwkv_a1'] = nrm((N_RWKV, 2, D, ICLR_LORA), D ** -0.5)
    inp['rwkv_a2'] = nrm((N_RWKV, 2, ICLR_LORA, D), 0.5 * ICLR_LORA ** -0.5)
    inp['rwkv_g1'] = nrm((N_RWKV, D, GATE_LORA), D ** -0.5)
    inp['rwkv_g2'] = nrm((N_RWKV, GATE_LORA, D), GATE_LORA ** -0.5)
    inp['rwkv_k_k'] = 0.85 + nrm((N_RWKV, D), 0.05)
    inp['rwkv_k_a'] = 1.0 + nrm((N_RWKV, D), 0.05)
    inp['rwkv_r_k'] = nrm((N_RWKV, RWKV_HEADS, RWKV_HEAD), 0.1)
    inp['rwkv_ln_w'] = 1.0 + nrm((N_RWKV, D), 0.05)
    inp['rwkv_ln_b'] = nrm((N_RWKV, D), 0.01)
    inp['rwkv_w_o'] = nrm((N_RWKV, D, D), D ** -0.5)
    inp['moe_w_router'] = nrm((DEPTH, D, N_EXPERTS), D ** -0.5)
    inp['moe_b_router'] = nrm((DEPTH, N_EXPERTS), 0.01)
    inp['moe_w1'] = nrm((DEPTH, N_EXPERTS, D, 2 * D_FF), D ** -0.5)
    inp['moe_b1'] = nrm((DEPTH, N_EXPERTS, 2 * D_FF), 0.01)
    inp['moe_w2'] = nrm((DEPTH, N_EXPERTS, D_FF, D), D_FF ** -0.5)
    inp['moe_b2'] = nrm((DEPTH, N_EXPERTS, D), 0.01)
    inp['final_g'] = 1.0 + nrm((D,), 0.05)
    return inp


def reference(x, c, ctx, c_ctx, ada_w, ada_b, norm_g,
              attn_w_qkv, attn_b_qkv, attn_w_o, attn_b_o, attn_sinks,
              pool_w, pool_b, pool_scale,
              rwkv_mix, rwkv_w_rkv, rwkv_w0, rwkv_w1, rwkv_w2, rwkv_a0, rwkv_a1, rwkv_a2,
              rwkv_g1, rwkv_g2, rwkv_k_k, rwkv_k_a, rwkv_r_k, rwkv_ln_w, rwkv_ln_b, rwkv_w_o,
              moe_w_router, moe_b_router, moe_w1, moe_b1, moe_w2, moe_b2, final_g):
    B, T, D = x.shape
    L = ctx.shape[1]
    h_x, h_c = x, ctx
    silu_c = jax.nn.silu(c)
    silu_cc = jax.nn.silu(c_ctx)
    for layer in range(DEPTH):
        last = layer == DEPTH - 1
        kind = layer % N_MIXERS
        j = layer // N_MIXERS
        mod_x = (silu_c @ ada_w[layer] + ada_b[layer])[:, None, :]
        mod_c = (silu_cc @ ada_w[layer] + ada_b[layer])[None, None, :]
        shx1, scx1, gx1, shx2, scx2, gx2 = jnp.split(mod_x, 6, axis=-1)
        shc1, scc1, gc1, shc2, scc2, gc2 = jnp.split(mod_c, 6, axis=-1)

        ax = modulate(rms_norm(h_x, norm_g[layer, 0]), shx1, scx1)
        ac = modulate(rms_norm(h_c, norm_g[layer, 0]), shc1, scc1)
        if kind == 0:
            yx, yc = windowed_gqa(ax, ac, attn_w_qkv[j], attn_b_qkv[j], attn_w_o[j], attn_b_o[j],
                                  attn_sinks[j], not last)
        elif kind == 1:
            yx = multiscale_pool(ax, pool_w[j], pool_b[j], pool_scale[j])
            yc = None if last else multiscale_pool(ac, pool_w[j], pool_b[j], pool_scale[j])
        else:
            yx, yc = rwkv7_mixer(ax, ac, rwkv_mix[j], rwkv_w_rkv[j], rwkv_w0[j], rwkv_w1[j], rwkv_w2[j],
                                 rwkv_a0[j], rwkv_a1[j], rwkv_a2[j], rwkv_g1[j], rwkv_g2[j],
                                 rwkv_k_k[j], rwkv_k_a[j], rwkv_r_k[j], rwkv_ln_w[j], rwkv_ln_b[j],
                                 rwkv_w_o[j], not last)
        h_x = h_x + gx1 * yx

        fx = modulate(rms_norm(h_x, norm_g[layer, 1]), shx2, scx2)
        moe_args = (moe_w_router[layer], moe_b_router[layer], moe_w1[layer], moe_b1[layer],
                    moe_w2[layer], moe_b2[layer])
        if last:
            h_x = h_x + gx2 * moe_ffn(fx.reshape(B * T, D), *moe_args).reshape(B, T, D)
        else:
            h_c = h_c + gc1 * yc
            fc = modulate(rms_norm(h_c, norm_g[layer, 1]), shc2, scc2)
            f_all = jnp.concatenate([fx.reshape(B * T, D), fc.reshape(B * L, D)], axis=0)
            out = moe_ffn(f_all, *moe_args)
            h_x = h_x + gx2 * out[:B * T].reshape(B, T, D)
            h_c = h_c + gc2 * out[B * T:].reshape(B, L, D)
    return rms_norm(h_x, final_g)
```

```cpp
#include <hip/hip_runtime.h>
#include <cstdio>
#include <cstdint>

#ifndef MK_ONE_LAUNCH
#define MK_ONE_LAUNCH 0
#endif
#ifndef DIAG
#define DIAG 0
#endif
#ifndef SKIPMASK
#define SKIPMASK 0x00
#endif

#define LAS __attribute__((address_space(3)))
#define GAS __attribute__((address_space(1)))
typedef unsigned short bf16_t;
typedef short bf16x8 __attribute__((ext_vector_type(8)));
typedef float f32x4 __attribute__((ext_vector_type(4)));
typedef float f32x2 __attribute__((ext_vector_type(2)));
typedef unsigned u32x4 __attribute__((ext_vector_type(4)));
typedef unsigned u32x2 __attribute__((ext_vector_type(2)));

constexpr int D = 1024, NB = 32, T = 2048, L = 256, DEPTH = 4;
constexpr int NX = NB * T, NC = NB * L, NT = NX + NC;
constexpr int NE = 32, TOPK = 4;
constexpr int NWAVES = 8, NTHREADS = 512;
constexpr int MAXRT = NT * TOPK / 256 + NE;

constexpr size_t MiB = 1u << 20;
constexpr size_t WS_CTL = 0, CTL_BYTES = 4 * MiB;
constexpr size_t WS_MOD = 4 * MiB;
constexpr size_t WS_ROPEC = 8 * MiB, WS_ROPES = 8 * MiB + 512 * 1024;
constexpr size_t WS_BQK = 9 * MiB;
constexpr size_t WS_WQK = 10 * MiB;
constexpr size_t WS_WV = 15 * MiB;
constexpr size_t WS_WO = 16 * MiB;
constexpr size_t WS_POOLW = 20 * MiB;
constexpr size_t WS_WRKV = 21 * MiB;
constexpr size_t WS_WOR = 27 * MiB;
constexpr size_t WS_WL1 = 30 * MiB;
constexpr size_t WS_WL2 = 32 * MiB;
constexpr size_t WS_LZERO = WS_WL1, LZERO_BYTES = 6 * MiB;
constexpr size_t WS_W1T = 40 * MiB;
constexpr size_t WS_W2T = 552 * MiB;
constexpr size_t WS_H = 808 * MiB;
constexpr size_t WS_AX = 1096 * MiB;
constexpr size_t WS_FX = 1240 * MiB;
constexpr size_t WS_R = 1384 * MiB;
constexpr size_t WS_ACT = WS_R;
constexpr size_t WS_Y = WS_R + 592 * MiB;
constexpr size_t WS_LIST = WS_R + 1184 * MiB;
constexpr size_t WS_POS = WS_R + 1193 * MiB;
constexpr size_t WS_GATE = WS_R + 1195 * MiB;
constexpr size_t WS_Q = WS_R;
constexpr size_t WS_K = WS_R + 144 * MiB;
constexpr size_t WS_VT = WS_R + 180 * MiB;
constexpr size_t WS_O = WS_R + 216 * MiB;
constexpr size_t WS_PD = WS_R;
constexpr size_t WS_A6 = WS_R;
constexpr size_t WS_E = WS_R;
constexpr size_t WS_A = WS_R + 288 * MiB;
constexpr size_t WS_RO = WS_R + 576 * MiB;
constexpr size_t WS_RKV = WS_R + 864 * MiB;
constexpr size_t WS_LORA = WS_R + 1296 * MiB;
constexpr size_t WS_G = WS_R + 1404 * MiB;
constexpr size_t WS_YS = WS_R + 1548 * MiB;
constexpr size_t WS_BONUS = WS_R + 2124 * MiB;
constexpr size_t WS_END = WS_R + 2134 * MiB;

constexpr int CW_BAR = 4096;
constexpr int CW_GCNT = 16384;
constexpr int LDS_BYTES = 147456;
constexpr int RING_BYTES = 131072;
constexpr int LDSCTL_OFF = 135168;
constexpr int MISC_OFF = LDSCTL_OFF;
constexpr int TPRE_OFF = LDSCTL_OFF + 256;
constexpr int LCNT_OFF = LDSCTL_OFF + 512;
constexpr int LBASE_OFF = LDSCTL_OFF + 768;
constexpr int REC_OFF = LDSCTL_OFF + 1024;
constexpr int JOB_OFF = LDSCTL_OFF + 1024;

__device__ __forceinline__ unsigned f2bf(float f) { unsigned u = __builtin_bit_cast(unsigned, f); return (u + 0x7fffu + ((u >> 16) & 1u)) >> 16; }
__device__ __forceinline__ unsigned pk2(float lo, float hi) { return f2bf(lo) | (f2bf(hi) << 16); }
__device__ __forceinline__ float bflo(unsigned w) { return __builtin_bit_cast(float, w << 16); }
__device__ __forceinline__ float bfhi(unsigned w) { return __builtin_bit_cast(float, w & 0xffff0000u); }
__device__ __forceinline__ float bf1(bf16_t b) { return __builtin_bit_cast(float, ((unsigned)b) << 16); }
__device__ __forceinline__ unsigned cvt_pk_bf16(float lo, float hi) { unsigned r; asm volatile("v_cvt_pk_bf16_f32 %0, %1, %2" : "=v"(r) : "v"(lo), "v"(hi)); return r; }
__device__ __forceinline__ float wave_sum(float v) {
#pragma unroll
    for (int o = 1; o < 64; o <<= 1) v += __shfl_xor(v, o);
    return v;
}
__device__ __forceinline__ float sigmoidf_(float x) { return 1.0f / (1.0f + __expf(-x)); }
__device__ __forceinline__ int opaque_tid() { int t; asm volatile("v_mov_b32 %0, %1" : "=v"(t) : "v"(threadIdx.x)); return t; }
#define REFRESH(F) do { (F).tid = opaque_tid(); (F).lane = (F).tid & 63; } while (0)
__device__ __forceinline__ void seq_of(int row, int& sb, int& t, int& n) { if (row < NX) { sb = row & ~(T - 1); t = row & (T - 1); n = T; } else { const int r2 = row - NX; sb = NX + (r2 & ~(L - 1)); t = r2 & (L - 1); n = L; } }
__device__ __forceinline__ f32x4 ld_bf4(const bf16_t* p) { const u32x2 w = *(const u32x2*)p; return (f32x4){bflo(w.x), bfhi(w.x), bflo(w.y), bfhi(w.y)}; }
__device__ __forceinline__ void st_bf4(bf16_t* p, f32x4 v) { u32x2 w; w.x = pk2(v.x, v.y); w.y = pk2(v.z, v.w); *(u32x2*)p = w; }

#define LDS_WAIT() asm volatile("s_waitcnt lgkmcnt(0)" ::: "memory")
#define VM_WAIT() asm volatile("s_waitcnt vmcnt(0)" ::: "memory")

#define XB_TMO      128
#define XB_XCNT(j)  (256  + 64 * (j))
#define XB_XSUB(j)  (1280 + 64 * (j))
#define XB_XGEN(j)  (2304 + 64 * (j))
#define XB_TOP      3328
#define XB_TOPGEN   3392
#define XCD_BAR_WORDS 3456
#define XB_SPIN_CAP (1u << 18)
__device__ __forceinline__ unsigned xb_ld(unsigned* p)              { return __hip_atomic_load(p, __ATOMIC_RELAXED, __HIP_MEMORY_SCOPE_AGENT); }
__device__ __forceinline__ unsigned xb_add(unsigned* p, unsigned v) { return __hip_atomic_fetch_add(p, v, __ATOMIC_RELAXED, __HIP_MEMORY_SCOPE_AGENT); }
__device__ __forceinline__ unsigned xb_xcc_id() { return (unsigned)__builtin_amdgcn_s_getreg((3 << 11) | 20) & 0xFu; }
#define XB_SPIN(cond, bar) do { unsigned _sp = 0; while (cond) { __builtin_amdgcn_s_sleep(1); \
    if ((++_sp & 255u) == 0u) { if (xb_ld(&(bar)[XB_TMO])) break; if (_sp > XB_SPIN_CAP) { atomicAdd(&(bar)[XB_TMO], 1u); break; } } } } while (0)
struct XcdBarrier { unsigned* bar; unsigned x; volatile LAS unsigned* st; };
__device__ __forceinline__ XcdBarrier xcd_barrier_post(unsigned* bar, volatile LAS unsigned* st) {
    XcdBarrier b; b.bar = bar; b.x = xb_xcc_id(); b.st = st;
    if (threadIdx.x == 0) (void)xb_add(&bar[XB_XCNT(b.x)], 1u);
    return b;
}
__device__ __forceinline__ void xcd_barrier_complete(unsigned* bar, unsigned x, unsigned& nloc, unsigned& nx) {
    const unsigned G = gridDim.x * gridDim.y * gridDim.z;
    unsigned sum, cnt, mine, sp = 0u;
    for (;;) {
        sum = 0u; cnt = 0u; mine = 0u;
#pragma unroll
        for (unsigned j = 0; j < 16; ++j) { const unsigned c = xb_ld(&bar[XB_XCNT(j)]); sum += c; cnt += (c > 0u) ? 1u : 0u; mine = (j == x) ? c : mine; }
        if (sum == G) break;
        __builtin_amdgcn_s_sleep(1);
        if ((++sp & 255u) == 0u) { if (xb_ld(&bar[XB_TMO])) break; if (sp > XB_SPIN_CAP) { atomicAdd(&bar[XB_TMO], 1u); break; } }
    }
    nloc = mine > 0u ? mine : 1u; nx = cnt > 0u ? cnt : 1u;
}
__device__ __forceinline__ void xcd_barrier(const XcdBarrier& b) {
    asm volatile("s_waitcnt vmcnt(0)" ::: "memory");
    __syncthreads();
    if (threadIdx.x == 0) {
        unsigned* bar = b.bar;
        __builtin_amdgcn_s_waitcnt(0);
        unsigned nloc = b.st[0], nx = b.st[1];
        if (nloc == 0u) { xcd_barrier_complete(bar, b.x, nloc, nx); b.st[0] = nloc; b.st[1] = nx; }
        const unsigned old = xb_add(&bar[XB_XSUB(b.x)], 1u);
        const unsigned gen = old / nloc;
        if (old + 1u == (gen + 1u) * nloc) {
            __builtin_amdgcn_fence(__ATOMIC_RELEASE, "agent");
            asm volatile("s_waitcnt vmcnt(0)" ::: "memory");
            const unsigned og = xb_add(&bar[XB_TOP], 1u);
            const unsigned tg = og / nx;
            if (og + 1u == (tg + 1u) * nx) xb_add(&bar[XB_TOPGEN], 1u);
            else XB_SPIN(xb_ld(&bar[XB_TOPGEN]) == tg, bar);
            __builtin_amdgcn_fence(__ATOMIC_ACQUIRE, "agent");
            xb_add(&bar[XB_XGEN(b.x)], 1u);
            asm volatile("s_waitcnt vmcnt(0)" ::: "memory");
        } else {
            XB_SPIN(xb_ld(&bar[XB_XGEN(b.x)]) == gen, bar);
            __builtin_amdgcn_fence(__ATOMIC_ACQUIRE, "agent");
            asm volatile("s_waitcnt vmcnt(0)" ::: "memory");
        }
    }
    __syncthreads();
}

namespace pg8 {
constexpr int BM = 256, BK = 64, HALF = 128, HTB = HALF * BK * 2, STAGE_BYTES = 8 * HTB, NXCD = 8, WGM = 8;
__host__ __device__ __forceinline__ int lds_byte(int r, int c) { const int st = (r >> 4) * 2 + (c >> 5), rr = r & 15, cc = c & 31, ob = rr * 64 + cc * 2; return st * 1024 + (ob ^ (((ob >> 9) & 1) << 5)); }
__host__ __device__ __forceinline__ void stage_rc(int b, int& R, int& C) { const int st = b / 1024, sb = b % 1024, swz = sb ^ (((sb >> 9) & 1) << 5); R = (st >> 1) * 16 + swz / 64; C = (st & 1) * 32 + (swz % 64) / 2; }
__host__ __device__ __forceinline__ int perm32(int rho) { const int n = rho >> 4, i = rho & 15; return 8 * (i >> 2) + 4 * n + (i & 3); }

struct Unit { int pm, pn, e, rt; };
struct TileOrder {
    int nM, nN, nwg, G, c;
    __device__ __forceinline__ void init(int nM_, int nN_, int G_, int c_) { nM = nM_; nN = nN_; nwg = nM * nN; G = G_; c = c_; }
    __device__ __forceinline__ bool next(int i, int& pm, int& pn) const {
        const long Lx = (long)i * G + c; if (Lx >= nwg) return false;
        int wgid = (int)Lx; { const int q = nwg / NXCD, r = nwg % NXCD, xcd = wgid % NXCD, off = wgid / NXCD; wgid = (xcd < r ? xcd * (q + 1) : r * (q + 1) + (xcd - r) * q) + off; }
        const int nig = WGM * nN, gid = wgid / nig, fm = gid * WGM, gsz = (nM - fm) < WGM ? (nM - fm) : WGM;
        pm = fm + ((wgid % nig) % gsz); pn = (wgid % nig) / gsz; return true;
    }
};
struct ProbDense {
    const bf16_t* A; const bf16_t* Bt; int lda, ldb, K, a_pn_off; TileOrder ord;
    __device__ __forceinline__ bool next(int i, Unit& u) const { u.e = 0; const bool ok = ord.next(i, u.pm, u.pn); u.rt = u.pm; return ok; }
    __device__ __forceinline__ const char* a_ptr(const Unit& u) const { return (const char*)(A + (size_t)u.pm * BM * lda + (size_t)u.pn * a_pn_off); }
    __device__ __forceinline__ const char* b_ptr(const Unit& u) const { return (const char*)(Bt + (size_t)u.pn * BM * ldb); }
    __device__ __forceinline__ void a_off(const Unit&, const int (&R)[2], const int (&C)[2], unsigned (&v)[2][2]) const {
#pragma unroll
        for (int h = 0; h < 2; ++h)
#pragma unroll
            for (int i = 0; i < 2; ++i) v[h][i] = (unsigned)((h * HALF + R[i]) * lda + C[i]) * 2u;
    }
};

template <class Prob, class Epi>
__device__ __forceinline__ void gemm_phase(LAS unsigned char* lds, const Prob& P, const Epi& E) {
    const int tid = opaque_tid(), wid = __builtin_amdgcn_readfirstlane(tid >> 6), lane = tid & 63, wr = wid >> 2, wc = wid & 3, fr = lane & 15, fq = lane >> 4;
    const int K = P.K, nt = K / BK;
    int Rr[2], Cc[2]; unsigned voffB[2];
#pragma unroll
    for (int i = 0; i < 2; ++i) { int R, C; stage_rc(tid * 16 + i * 8192, R, C); Rr[i] = R; Cc[i] = C; const int Rb = Epi::PERM ? ((R & ~31) + perm32(R & 31)) : R;
        voffB[i] = (unsigned)(Rb * P.ldb + C) * 2u; }
    const size_t kstep = (size_t)(BK * 2);
    const size_t hstepB = (size_t)HALF * P.ldb * 2;
    const unsigned ldsw = (unsigned)wid * 1024u;
    const int aoff = lds_byte(wr * 64 + fr, fq * 8), boff = lds_byte(wc * 32 + fr, fq * 8);
#define PG8_SA(b, h) (((b) * 2 + (h)) * HTB)
#define PG8_SB(b, h) ((4 + (b) * 2 + (h)) * HTB)
#define PG8_STAGE(bufoff, gbase, voff) do { _Pragma("unroll") for (int _i = 0; _i < 2; ++_i) \
        __builtin_amdgcn_global_load_lds((const unsigned*)((const char*)(gbase) + (voff)[_i]), (LAS unsigned*)(lds + (bufoff) + ldsw + _i * 8192), 16, 0, 0); } while (0)
#define PG8_LDA(dst, b, h) do { _Pragma("unroll") for (int m = 0; m < 4; ++m) _Pragma("unroll") for (int k = 0; k < 2; ++k) dst[m][k] = *(const LAS bf16x8*)(lds + PG8_SA(b, h) + aoff + m * 2048 + k * 1024); } while (0)
#define PG8_LDB(dst, b, h) do { _Pragma("unroll") for (int n = 0; n < 2; ++n) _Pragma("unroll") for (int k = 0; k < 2; ++k) dst[n][k] = *(const LAS bf16x8*)(lds + PG8_SB(b, h) + boff + n * 2048 + k * 1024); } while (0)
#define PG8_MMA(ai, bj, At, Bt) do { __builtin_amdgcn_s_setprio(1); _Pragma("unroll") for (int m = 0; m < 4; ++m) _Pragma("unroll") for (int n = 0; n < 2; ++n) _Pragma("unroll") for (int k = 0; k < 2; ++k) \
        acc[ai][bj][m][n] = __builtin_amdgcn_mfma_f32_16x16x32_bf16(Bt[n][k], At[m][k], acc[ai][bj][m][n], 0, 0, 0); __builtin_amdgcn_s_setprio(0); } while (0)
#define PG8_WAIT_V(n) asm volatile("s_waitcnt vmcnt(" #n ")" ::: "memory")
#define PG8_WAIT_L(n) asm volatile("s_waitcnt lgkmcnt(" #n ")" ::: "memory")
#define PG8_BAR __builtin_amdgcn_s_barrier()
#define PG8_SCHED __builtin_amdgcn_sched_barrier(0)
    Unit cur, nxt; int ui = 0;
    if (!P.next(0, cur)) return;
    f32x4 acc[2][2][4][2];
#pragma unroll
    for (int a = 0; a < 2; ++a)
#pragma unroll
        for (int b = 0; b < 2; ++b)
#pragma unroll
            for (int m = 0; m < 4; ++m)
#pragma unroll
                for (int n = 0; n < 2; ++n) acc[a][b][m][n] = (f32x4){0.f, 0.f, 0.f, 0.f};
    bf16x8 At[4][2], B0[2][2], B1[2][2];
    unsigned vAc[2][2], vAn[2][2];
    P.a_off(cur, Rr, Cc, vAc);
    const char* cA = P.a_ptr(cur); const char* cB = P.b_ptr(cur);
    PG8_STAGE(PG8_SB(0, 0), cB, voffB); PG8_STAGE(PG8_SB(0, 1), cB + hstepB, voffB); PG8_STAGE(PG8_SA(0, 0), cA, vAc[0]); PG8_STAGE(PG8_SA(0, 1), cA, vAc[1]);
    if (wr == 1) PG8_BAR;
    PG8_WAIT_V(2); PG8_BAR;
    PG8_STAGE(PG8_SB(1, 0), cB + kstep, voffB); PG8_STAGE(PG8_SA(1, 0), cA + kstep, vAc[0]); PG8_STAGE(PG8_SB(1, 1), cB + hstepB + kstep, voffB);
    PG8_WAIT_V(6); PG8_BAR;
    for (;;) {
        const bool has_next = P.next(ui + 1, nxt);
        const char* nA = cA; const char* nB = cB;
#pragma unroll
        for (int h = 0; h < 2; ++h)
#pragma unroll
            for (int i = 0; i < 2; ++i) vAn[h][i] = vAc[h][i];
        if (has_next) { nA = P.a_ptr(nxt); nB = P.b_ptr(nxt); P.a_off(nxt, Rr, Cc, vAn); }
        for (int t = 0; t < nt; t += 2) {
            const bool last = (t == nt - 2);
            const char* a1 = cA + (size_t)(t + 1) * kstep;
            const char* a2 = last ? nA : cA + (size_t)(t + 2) * kstep; const char* b2 = last ? nB : cB + (size_t)(t + 2) * kstep;
            const char* a3 = a2 + kstep; const char* b3 = b2 + kstep;
            unsigned vX[2][2];
#pragma unroll
            for (int h = 0; h < 2; ++h)
#pragma unroll
                for (int i = 0; i < 2; ++i) vX[h][i] = last ? vAn[h][i] : vAc[h][i];
            PG8_LDB(B0, 0, 0); PG8_LDB(B1, 0, 1); PG8_SCHED; PG8_LDA(At, 0, 0); PG8_STAGE(PG8_SA(1, 1), a1, vAc[1]);
            PG8_WAIT_V(8); PG8_WAIT_L(0); PG8_BAR; PG8_MMA(0, 0, At, B0); PG8_MMA(0, 1, At, B1); PG8_BAR; PG8_SCHED;
            PG8_LDA(At, 0, 1); PG8_STAGE(PG8_SB(0, 0), b2, voffB); PG8_STAGE(PG8_SB(0, 1), b2 + hstepB, voffB); PG8_STAGE(PG8_SA(0, 0), a2, vX[0]);
            PG8_WAIT_V(8); PG8_WAIT_L(0); PG8_BAR; PG8_MMA(1, 0, At, B0); PG8_MMA(1, 1, At, B1); PG8_BAR; PG8_SCHED;
            PG8_LDB(B0, 1, 0); PG8_LDB(B1, 1, 1); PG8_SCHED; PG8_LDA(At, 1, 0); PG8_STAGE(PG8_SA(0, 1), a2, vX[1]);
            PG8_WAIT_V(8); PG8_WAIT_L(0); PG8_BAR; PG8_MMA(0, 0, At, B0); PG8_MMA(0, 1, At, B1); PG8_BAR; PG8_SCHED;
            PG8_LDA(At, 1, 1); PG8_STAGE(PG8_SB(1, 0), b3, voffB); PG8_STAGE(PG8_SB(1, 1), b3 + hstepB, voffB); PG8_STAGE(PG8_SA(1, 0), a3, vX[0]);
            PG8_WAIT_V(8); PG8_WAIT_L(0); PG8_BAR; PG8_MMA(1, 0, At, B0); PG8_MMA(1, 1, At, B1); PG8_BAR; PG8_SCHED;
        }
        if (wr == 0) PG8_BAR;
        E(acc, cur, wr, wc, fr, fq);
        if (!has_next) break;
#pragma unroll
        for (int a = 0; a < 2; ++a)
#pragma unroll
            for (int b = 0; b < 2; ++b)
#pragma unroll
                for (int m = 0; m < 4; ++m)
#pragma unroll
                    for (int n = 0; n < 2; ++n) acc[a][b][m][n] = (f32x4){0.f, 0.f, 0.f, 0.f};
        cur = nxt; cA = nA; cB = nB; ++ui;
#pragma unroll
        for (int h = 0; h < 2; ++h)
#pragma unroll
            for (int i = 0; i < 2; ++i) vAc[h][i] = vAn[h][i];
        if (wr == 1) PG8_BAR;
    }
    PG8_WAIT_V(0);
    PG8_BAR;
#undef PG8_SA
#undef PG8_SB
#undef PG8_STAGE
#undef PG8_LDA
#undef PG8_LDB
#undef PG8_MMA
#undef PG8_WAIT_V
#undef PG8_WAIT_L
#undef PG8_BAR
#undef PG8_SCHED
}
}

using pg8::Unit;
constexpr int HALF_ = 128;
struct EpiBf16Act {
    static constexpr bool PERM = true;
    bf16_t* O; int ldc; const float* bias; int act; float scale;
    __device__ __forceinline__ void operator()(const f32x4 (&acc)[2][2][4][2], const Unit& u, int wr, int wc, int fr, int fq) const {
        const int row0 = u.pm * 256 + wr * 64 + fr, col0 = u.pn * 256 + wc * 32 + 8 * fq;
        f32x4 bv[2][2];
#pragma unroll
        for (int bj = 0; bj < 2; ++bj)
#pragma unroll
            for (int n = 0; n < 2; ++n) bv[bj][n] = bias ? *(const f32x4*)(bias + col0 + bj * HALF_ + 4 * n) : (f32x4){0.f, 0.f, 0.f, 0.f};
#pragma unroll
        for (int ai = 0; ai < 2; ++ai)
#pragma unroll
            for (int m = 0; m < 4; ++m) { bf16_t* rowp = O + (size_t)(row0 + ai * HALF_ + m * 16) * ldc + col0;
#pragma unroll
                for (int bj = 0; bj < 2; ++bj) { f32x4 v0 = acc[ai][bj][m][0] + bv[bj][0], v1 = acc[ai][bj][m][1] + bv[bj][1];
                    if (act == 1) {
#pragma unroll
                        for (int j = 0; j < 4; ++j) { v0[j] = sigmoidf_(v0[j]) * scale; v1[j] = sigmoidf_(v1[j]) * scale; } }
                    else if (act == 2) {
#pragma unroll
                        for (int j = 0; j < 4; ++j) { v0[j] = 1.0f - 2.0f / (__expf(2.0f * v0[j]) + 1.0f); v1[j] = 1.0f - 2.0f / (__expf(2.0f * v1[j]) + 1.0f); } }
                    u32x4 w; w.x = cvt_pk_bf16(v0[0], v0[1]); w.y = cvt_pk_bf16(v0[2], v0[3]); w.z = cvt_pk_bf16(v1[0], v1[1]); w.w = cvt_pk_bf16(v1[2], v1[3]);
                    *(u32x4*)(rowp + bj * HALF_) = w; } }
    }
};
struct EpiQK {
    static constexpr bool PERM = true;
    bf16_t* Q; bf16_t* Kb; const float* bias; const float* ropec; const float* ropes;
    __device__ __forceinline__ void operator()(const f32x4 (&acc)[2][2][4][2], const Unit& u, int wr, int wc, int fr, int fq) const {
        const int row0 = u.pm * 256 + wr * 64 + fr, cl0 = wc * 32 + 8 * fq;
        const int g = (4 * wc + fq) & 7;
        bf16_t* base; int ldc;
        if (u.pn < 4) { base = Q + u.pn * 256; ldc = 1024; } else { base = Kb; ldc = 256; }
        f32x4 bv[2][2];
#pragma unroll
        for (int bj = 0; bj < 2; ++bj)
#pragma unroll
            for (int n = 0; n < 2; ++n) bv[bj][n] = *(const f32x4*)(bias + u.pn * 256 + cl0 + bj * HALF_ + 4 * n);
#pragma unroll
        for (int ai = 0; ai < 2; ++ai)
#pragma unroll
            for (int m = 0; m < 4; ++m) { const int row = row0 + ai * HALF_ + m * 16; bf16_t* rowp = base + (size_t)row * ldc + cl0;
                f32x4 cs = (f32x4){1.f, 1.f, 1.f, 1.f}, sn = (f32x4){0.f, 0.f, 0.f, 0.f};
                if (row < NX) { const int t = row & (T - 1); cs = *(const f32x4*)(ropec + t * 32 + g * 4); sn = *(const f32x4*)(ropes + t * 32 + g * 4); }
#pragma unroll
                for (int bj = 0; bj < 2; ++bj) { const f32x4 v0 = acc[ai][bj][m][0] + bv[bj][0], v1 = acc[ai][bj][m][1] + bv[bj][1];
                    const f32x4 o0 = v0 * cs - v1 * sn, o1 = v1 * cs + v0 * sn;
                    u32x4 w; w.x = cvt_pk_bf16(o0[0], o0[1]); w.y = cvt_pk_bf16(o0[2], o0[3]); w.z = cvt_pk_bf16(o1[0], o1[1]); w.w = cvt_pk_bf16(o1[2], o1[3]);
                    *(u32x4*)(rowp + bj * HALF_) = w; } }
    }
};
struct EpiVT {
    static constexpr bool PERM = true;
    bf16_t* VT; const float* biasrow;
    __device__ __forceinline__ void operator()(const f32x4 (&acc)[2][2][4][2], const Unit& u, int wr, int wc, int fr, int fq) const {
        const int row0 = wr * 64 + fr, col0 = u.pn * 256 + wc * 32 + 8 * fq;
#pragma unroll
        for (int ai = 0; ai < 2; ++ai)
#pragma unroll
            for (int m = 0; m < 4; ++m) { const int row = row0 + ai * HALF_ + m * 16; const float b = biasrow[row]; bf16_t* rowp = VT + (size_t)row * NT + col0;
#pragma unroll
                for (int bj = 0; bj < 2; ++bj) { const f32x4 v0 = acc[ai][bj][m][0] + b, v1 = acc[ai][bj][m][1] + b;
                    u32x4 w; w.x = cvt_pk_bf16(v0[0], v0[1]); w.y = cvt_pk_bf16(v0[2], v0[3]); w.z = cvt_pk_bf16(v1[0], v1[1]); w.w = cvt_pk_bf16(v1[2], v1[3]);
                    *(u32x4*)(rowp + bj * HALF_) = w; } }
    }
};
struct EpiResid {
    static constexpr bool PERM = false;
    float* H; const float* bias; const float* ls; const float* gate;
    __device__ __forceinline__ void operator()(const f32x4 (&acc)[2][2][4][2], const Unit& u, int wr, int wc, int fr, int fq) const {
        const int row0 = u.pm * 256 + wr * 64 + fr, col0 = u.pn * 256 + wc * 32 + 4 * fq;
        f32x4 bv[2][2], lv[2][2];
#pragma unroll
        for (int bj = 0; bj < 2; ++bj)
#pragma unroll
            for (int n = 0; n < 2; ++n) { bv[bj][n] = bias ? *(const f32x4*)(bias + col0 + bj * HALF_ + n * 16) : (f32x4){0.f, 0.f, 0.f, 0.f};
                                          lv[bj][n] = ls ? *(const f32x4*)(ls + col0 + bj * HALF_ + n * 16) : (f32x4){1.f, 1.f, 1.f, 1.f}; }
#pragma unroll
        for (int ai = 0; ai < 2; ++ai)
#pragma unroll
            for (int m = 0; m < 4; ++m) { const int row = row0 + ai * HALF_ + m * 16; const int brow = row < NX ? (row >> 11) : 32;
                float* hp = H + (size_t)row * D + col0; const float* gp = gate + (size_t)brow * (6 * D) + col0;
#pragma unroll
                for (int bj = 0; bj < 2; ++bj)
#pragma unroll
                    for (int n = 0; n < 2; ++n) { const f32x4 y = (acc[ai][bj][m][n] + bv[bj][n]) * lv[bj][n]; const f32x4 gv = *(const f32x4*)(gp + bj * HALF_ + n * 16);
                        f32x4 hv = *(const f32x4*)(hp + bj * HALF_ + n * 16); hv = hv + gv * y; *(f32x4*)(hp + bj * HALF_ + n * 16) = hv; }
                asm volatile("" ::: "memory"); }
    }
};
struct EpiMoe1 {
    static constexpr bool PERM = true;
    bf16_t* ACT; const float* b1;
    __device__ __forceinline__ void operator()(const f32x4 (&acc)[2][2][4][2], const Unit& u, int wr, int wc, int fr, int fq) const {
        const int row0 = u.rt * 256 + wr * 64 + fr, cl = u.pn * 128 + wc * 32 + 8 * fq;
        const float* bg = b1 + (size_t)u.e * 2048 + cl; const float* bl = bg + 1024;
        f32x4 bgv[2], blv[2];
#pragma unroll
        for (int n = 0; n < 2; ++n) { bgv[n] = *(const f32x4*)(bg + 4 * n); blv[n] = *(const f32x4*)(bl + 4 * n); }
#pragma unroll
        for (int ai = 0; ai < 2; ++ai)
#pragma unroll
            for (int m = 0; m < 4; ++m) { bf16_t* rowp = ACT + (size_t)(row0 + ai * HALF_ + m * 16) * D + cl;
                f32x4 o[2];
#pragma unroll
                for (int n = 0; n < 2; ++n) { const f32x4 hg = acc[ai][0][m][n] + bgv[n], hl = acc[ai][1][m][n] + blv[n];
#pragma unroll
                    for (int j = 0; j < 4; ++j) { const float gl = fminf(hg[j], 7.0f); const float li = fminf(fmaxf(hl[j], -7.0f), 7.0f);
                        o[n][j] = gl * sigmoidf_(1.702f * gl) * (li + 1.0f); } }
                u32x4 w; w.x = cvt_pk_bf16(o[0][0], o[0][1]); w.y = cvt_pk_bf16(o[0][2], o[0][3]); w.z = cvt_pk_bf16(o[1][0], o[1][1]); w.w = cvt_pk_bf16(o[1][2], o[1][3]);
                *(u32x4*)rowp = w; }
    }
};
struct EpiMoe2 {
    static constexpr bool PERM = true;
    bf16_t* Y; const float* b2;
    __device__ __forceinline__ void operator()(const f32x4 (&acc)[2][2][4][2], const Unit& u, int wr, int wc, int fr, int fq) const {
        const int row0 = u.rt * 256 + wr * 64 + fr, col0 = u.pn * 256 + wc * 32 + 8 * fq;
        const float* bb = b2 + (size_t)u.e * D + col0;
        f32x4 bv[2][2];
#pragma unroll
        for (int bj = 0; bj < 2; ++bj)
#pragma unroll
            for (int n = 0; n < 2; ++n) bv[bj][n] = *(const f32x4*)(bb + bj * HALF_ + 4 * n);
#pragma unroll
        for (int ai = 0; ai < 2; ++ai)
#pragma unroll
            for (int m = 0; m < 4; ++m) { bf16_t* rowp = Y + (size_t)(row0 + ai * HALF_ + m * 16) * D + col0;
#pragma unroll
                for (int bj = 0; bj < 2; ++bj) { const f32x4 v0 = acc[ai][bj][m][0] + bv[bj][0], v1 = acc[ai][bj][m][1] + bv[bj][1];
                    u32x4 w; w.x = cvt_pk_bf16(v0[0], v0[1]); w.y = cvt_pk_bf16(v0[2], v0[3]); w.z = cvt_pk_bf16(v1[0], v1[1]); w.w = cvt_pk_bf16(v1[2], v1[3]);
                    *(u32x4*)(rowp + bj * HALF_) = w; } }
    }
};
struct ProbMoe1 {
    const bf16_t* FX; const bf16_t* W1T; const int* list; const LAS int* tpre; const LAS int* cnt; int lda, ldb, K; pg8::TileOrder ord;
    __device__ __forceinline__ bool next(int i, Unit& u) const {
        if (!ord.next(i, u.pm, u.pn)) return false;
        u.rt = u.pm; int e = 0;
#pragma unroll 1
        for (int j = 1; j < NE; ++j) e += (tpre[j] <= u.rt) ? 1 : 0;
        u.e = e; return true;
    }
    __device__ __forceinline__ const char* a_ptr(const Unit&) const { return (const char*)FX; }
    __device__ __forceinline__ const char* b_ptr(const Unit& u) const { return (const char*)(W1T + ((size_t)u.e * 2048 + (size_t)u.pn * 256) * D); }
    __device__ __forceinline__ void a_off(const Unit& u, const int (&R)[2], const int (&C)[2], unsigned (&v)[2][2]) const {
        const int base = (u.rt - tpre[u.e]) * 256, ce = cnt[u.e]; const int* le = list + (size_t)u.e * NT;
#pragma unroll
        for (int h = 0; h < 2; ++h)
#pragma unroll
            for (int i = 0; i < 2; ++i) { const int idx = base + h * 128 + R[i]; const int tok = idx < ce ? le[idx] : 0; v[h][i] = (unsigned)(tok * D + C[i]) * 2u; }
        asm volatile("" : "+v"(v[0][0]), "+v"(v[0][1]), "+v"(v[1][0]), "+v"(v[1][1]));
    }
};
struct ProbMoe2 {
    const bf16_t* ACT; const bf16_t* W2T; const LAS int* tpre; int lda, ldb, K; pg8::TileOrder ord;
    __device__ __forceinline__ bool next(int i, Unit& u) const {
        if (!ord.next(i, u.pm, u.pn)) return false;
        u.rt = u.pm; int e = 0;
#pragma unroll 1
        for (int j = 1; j < NE; ++j) e += (tpre[j] <= u.rt) ? 1 : 0;
        u.e = e; return true;
    }
    __device__ __forceinline__ const char* a_ptr(const Unit& u) const { return (const char*)(ACT + (size_t)u.rt * 256 * D); }
    __device__ __forceinline__ const char* b_ptr(const Unit& u) const { return (const char*)(W2T + ((size_t)u.e * 1024 + (size_t)u.pn * 256) * D); }
    __device__ __forceinline__ void a_off(const Unit&, const int (&R)[2], const int (&C)[2], unsigned (&v)[2][2]) const {
#pragma unroll
        for (int h = 0; h < 2; ++h)
#pragma unroll
            for (int i = 0; i < 2; ++i) v[h][i] = (unsigned)((h * 128 + R[i]) * D + C[i]) * 2u;
    }
};

struct Args { const float* in[38]; float* out; unsigned char* ws; int phase; int one; };
enum { I_X = 0, I_C, I_CTX, I_CCTX, I_ADAW, I_ADAB, I_NORMG, I_AWQKV, I_ABQKV, I_AWO, I_ABO, I_ASINK, I_PW, I_PB, I_PS,
       I_RMIX, I_RWRKV, I_RW0, I_RW1, I_RW2, I_RA0, I_RA1, I_RA2, I_RG1, I_RG2, I_RKK, I_RKA, I_RRK, I_RLNW, I_RLNB, I_RWO,
       I_MWR, I_MBR, I_MW1, I_MB1, I_MW2, I_MB2, I_FG };
struct Frame { LAS unsigned char* lds; int tid, lane, wave, G, c; unsigned char* ws; unsigned* ctl; };
#define WSP(T_, off) ((T_*)(F.ws + (off)))

struct TJob { const float* src; bf16_t* dst; long sbs, dbs; int ldw, ldt, nkb, nnb, mode, item0, per, pad; };
__device__ __forceinline__ int dst_row(int mode, int n) {
    if (mode == 1) { const int hb = n & ~63, d = n & 63; const int ax = d >> 5, dd = d & 31, hf = dd >> 4, f = dd & 15; const int g = ax * 4 + (f >> 2), i = (f & 3) + 4 * hf; return hb + 8 * g + i; }
    if (mode == 2) { return n < 1024 ? ((n >> 7) << 8) + (n & 127) : (((n - 1024) >> 7) << 8) + 128 + (n & 127); }
    return n;
}
__device__ __forceinline__ void transpose_item(const float* W, int ldw, bf16_t* WT, int ldt, int mode, LAS float* scr, int kb, int nb, int lane) {
    const int k0 = 64 * kb, n0 = 32 * nb;
#pragma unroll 8
    for (int i = 0; i < 32; ++i) { const int kk = 2 * i + (lane >> 5); scr[kk * 33 + (lane & 31)] = W[(size_t)(k0 + kk) * ldw + n0 + (lane & 31)]; }
    LDS_WAIT(); asm volatile("" ::: "memory");
    const int c = lane & 7;
#pragma unroll
    for (int j = 0; j < 4; ++j) { const int n = (lane >> 3) + 8 * j; const LAS float* s = scr + (8 * c) * 33 + n;
        u32x4 o; o.x = pk2(s[0 * 33], s[1 * 33]); o.y = pk2(s[2 * 33], s[3 * 33]); o.z = pk2(s[4 * 33], s[5 * 33]); o.w = pk2(s[6 * 33], s[7 * 33]);
        *(u32x4*)(WT + (size_t)dst_row(mode, n0 + n) * ldt + k0 + 8 * c) = o; }
    LDS_WAIT(); asm volatile("" ::: "memory");
}
__device__ __forceinline__ void phase_prologue(Frame& F, const Args& A) {
    REFRESH(F);
    LAS float* S = (LAS float*)F.lds;
    for (int idx = F.tid; idx < 33 * 1024; idx += NTHREADS) { const int r = idx >> 10, k = idx & 1023; const float v = r < 32 ? A.in[I_C][r * 1024 + k] : A.in[I_CCTX][k]; S[k * 33 + r] = v / (1.0f + __expf(-v)); }
    __syncthreads();
    float* MOD = WSP(float, WS_MOD);
    for (int it = F.c; it < 4 * 96; it += F.G) {
        const int layer = it / 96, n = (it % 96) * 64 + F.lane; const float* wp = A.in[I_ADAW] + (size_t)layer * 1024 * 6144 + n;
        float acc[5] = {0.f, 0.f, 0.f, 0.f, 0.f};
#pragma unroll 4
        for (int k = 0; k < 1024; ++k) { const float wv = wp[(size_t)k * 6144]; const LAS float* sr = S + k * 33 + F.wave;
            acc[0] += sr[0] * wv; acc[1] += sr[8] * wv; acc[2] += sr[16] * wv; acc[3] += sr[24] * wv; if (F.wave == 0) acc[4] += S[k * 33 + 32] * wv; }
        const float bb = A.in[I_ADAB][layer * 6144 + n];
#pragma unroll
        for (int i = 0; i < 4; ++i) MOD[((size_t)layer * 33 + F.wave + 8 * i) * 6144 + n] = acc[i] + bb;
        if (F.wave == 0) MOD[((size_t)layer * 33 + 32) * 6144 + n] = acc[4] + bb;
    }
    { float* rc = WSP(float, WS_ROPEC); float* rs = WSP(float, WS_ROPES);
      for (int idx = F.c * NTHREADS + F.tid; idx < 2048 * 32; idx += F.G * NTHREADS) { const int t = idx >> 5, e = idx & 31, g = e >> 2, i = e & 3, f = 4 * (g & 3) + i;
          const float inv = powf(10000.0f, -(float)f / 16.0f); const float pos = (float)(g < 4 ? (t >> 6) : (t & 63)); const float ang = pos * inv; rc[idx] = cosf(ang); rs[idx] = sinf(ang); }
      float* bq = WSP(float, WS_BQK);
      for (int idx = F.c * NTHREADS + F.tid; idx < 2 * 1280; idx += F.G * NTHREADS) { const int j = idx / 1280, n = idx % 1280; bq[j * 1280 + dst_row(1, n)] = A.in[I_ABQKV][j * 1536 + n]; } }
    __syncthreads();
    LAS TJob* jobs = (LAS TJob*)(F.lds + JOB_OFF); LAS int* njobs = (LAS int*)(F.lds + MISC_OFF + 64);
    if (F.tid == 0) {
        int nj = 0, item = 0;
        auto add = [&](const float* src, bf16_t* dst, int ldw, int ldt, int Ks, int Ns, int mode, int nb, long sbs, long dbs) {
            LAS TJob& j = jobs[nj]; j.src = src; j.dst = dst; j.sbs = sbs; j.dbs = dbs; j.ldw = ldw; j.ldt = ldt; j.nkb = Ks / 64; j.nnb = Ns / 32; j.mode = mode; j.item0 = item; j.per = (Ks / 64) * (Ns / 32); j.pad = 0;
            ++nj; item += (Ks / 64) * (Ns / 32) * nb; };
        add(A.in[I_AWQKV], WSP(bf16_t, WS_WQK), 1536, 1024, 1024, 1280, 1, 2, 1024L * 1536, 1280L * 1024);
        add(A.in[I_AWQKV] + 1280, WSP(bf16_t, WS_WV), 1536, 1024, 1024, 256, 0, 2, 1024L * 1536, 256L * 1024);
        add(A.in[I_AWO], WSP(bf16_t, WS_WO), 1024, 1024, 1024, 1024, 0, 2, 1L << 20, 1L << 20);
        add(A.in[I_PW], WSP(bf16_t, WS_POOLW), 256, 256, 256, 256, 0, 4, 65536, 65536);
        add(A.in[I_RWRKV], WSP(bf16_t, WS_WRKV), 1024, 1024, 1024, 1024, 0, 3, 1L << 20, 1L << 20);
        add(A.in[I_RG1], WSP(bf16_t, WS_WL1), 128, 1024, 1024, 128, 0, 1, 0, 0);
        add(A.in[I_RW1], WSP(bf16_t, WS_WL1) + 256 * 1024, 64, 1024, 1024, 64, 0, 2, 65536, 65536);
        add(A.in[I_RA1], WSP(bf16_t, WS_WL1) + 2 * 256 * 1024, 64, 1024, 1024, 64, 0, 2, 65536, 65536);
        add(A.in[I_RG2], WSP(bf16_t, WS_WL2), 1024, 256, 128, 1024, 0, 1, 0, 0);
        add(A.in[I_RW2], WSP(bf16_t, WS_WL2) + 1 * 1024 * 256, 1024, 256, 64, 1024, 0, 2, 65536, 1024L * 256 + 64);
        add(A.in[I_RA2], WSP(bf16_t, WS_WL2) + 3 * 1024 * 256, 1024, 256, 64, 1024, 0, 2, 65536, 1024L * 256 + 64);
        add(A.in[I_RWO], WSP(bf16_t, WS_WOR), 1024, 1024, 1024, 1024, 0, 1, 0, 0);
        add(A.in[I_MW1], WSP(bf16_t, WS_W1T), 2048, 1024, 1024, 2048, 2, 128, 1024L * 2048, 2048L * 1024);
        add(A.in[I_MW2], WSP(bf16_t, WS_W2T), 1024, 1024, 1024, 1024, 0, 128, 1L << 20, 1L << 20);
        njobs[0] = nj; njobs[1] = item;
    }
    __syncthreads();
    { const int nj = njobs[0], nitems = njobs[1]; LAS float* scr = (LAS float*)(F.lds + F.wave * 16384);
      const int gw = F.c * NWAVES + F.wave, NGW = F.G * NWAVES;
      for (int it = gw; it < nitems; it += NGW) {
          int ji = 0;
          for (int q = 1; q < nj; ++q) ji += (jobs[q].item0 <= it) ? 1 : 0;
          const LAS TJob& J = jobs[ji]; const int r = it - J.item0, bi = r / J.per, rr = r % J.per, kb = rr / J.nnb, nb = rr % J.nnb;
          transpose_item(J.src + bi * J.sbs, J.ldw, J.dst + bi * J.dbs, J.ldt, J.mode, scr, kb, nb, F.lane);
      } }
    __syncthreads();
}

__device__ __forceinline__ void moe_tiles(Frame& F, int layer) {
    REFRESH(F);
    LAS int* lcnt = (LAS int*)(F.lds + LCNT_OFF); LAS int* tpre = (LAS int*)(F.lds + TPRE_OFF);
    __syncthreads();
    if (F.tid < NE) lcnt[F.tid] = (int)__hip_atomic_load(F.ctl + CW_GCNT + layer * 64 + F.tid, __ATOMIC_RELAXED, __HIP_MEMORY_SCOPE_AGENT);
    __syncthreads();
    if (F.tid == 0) { int s = 0; for (int e = 0; e < NE; ++e) { tpre[e] = s; s += (lcnt[e] + 255) >> 8; } tpre[NE] = s; }
    __syncthreads();
}
__device__ __forceinline__ void moe_gather(Frame& F, int row, f32x4 (&s)[4]) {
    const LAS int* tpre = (const LAS int*)(F.lds + TPRE_OFF);
    const int* pos = WSP(int, WS_POS) + (size_t)row * 4; const float* gt = WSP(float, WS_GATE) + (size_t)row * 4; const bf16_t* Y = WSP(bf16_t, WS_Y);
#pragma unroll
    for (int j = 0; j < 4; ++j) s[j] = (f32x4){0.f, 0.f, 0.f, 0.f};
#pragma unroll
    for (int k = 0; k < 4; ++k) { const int p = pos[k]; const float g = gt[k]; const int e = p >> 20, slot = p & 0xfffff; const size_t fr = (size_t)tpre[e] * 256 + slot;
        const u32x2* yp = (const u32x2*)(Y + fr * D) + F.lane;
#pragma unroll
        for (int j = 0; j < 4; ++j) { const u32x2 w = yp[64 * j]; s[j] += g * (f32x4){bflo(w.x), bfhi(w.x), bflo(w.y), bfhi(w.y)}; } }
}

__device__ __forceinline__ void phase_norm1(Frame& F, const Args& A, int layer) {
    REFRESH(F);
    if (layer > 0) moe_tiles(F, layer - 1);
    float* H = WSP(float, WS_H); bf16_t* AX = WSP(bf16_t, WS_AX); const float* MOD = WSP(float, WS_MOD);
    const float* g1 = A.in[I_NORMG] + (size_t)(layer * 2 + 0) * D;
    for (int it = 0;; ++it) { const int row = (it * F.G + F.c) * NWAVES + F.wave; if (row >= NT) break;
        const int brow = row < NX ? (row >> 11) : 32;
        f32x4 v[4];
        if (layer == 0) { const float* src = row < NX ? A.in[I_X] + (size_t)row * D : A.in[I_CTX] + (size_t)(row - NX) * D;
#pragma unroll
            for (int j = 0; j < 4; ++j) v[j] = ((const f32x4*)src)[64 * j + F.lane]; }
        else { f32x4 s[4]; moe_gather(F, row, s); const float* g2p = MOD + ((size_t)(layer - 1) * 33 + brow) * 6144 + 5 * D;
#pragma unroll
            for (int j = 0; j < 4; ++j) { const f32x4 hv = ((const f32x4*)(H + (size_t)row * D))[64 * j + F.lane]; const f32x4 gv = ((const f32x4*)g2p)[64 * j + F.lane]; v[j] = ((SKIPMASK >> (4 + layer - 1)) & 1) ? hv : hv + gv * s[j]; } }
        float ss = 0.f;
#pragma unroll
        for (int j = 0; j < 4; ++j) { ((f32x4*)(H + (size_t)row * D))[64 * j + F.lane] = v[j]; ss += (v[j].x * v[j].x + v[j].y * v[j].y) + (v[j].z * v[j].z + v[j].w * v[j].w); }
        const float rstd = 1.0f / sqrtf(wave_sum(ss) * (1.0f / D) + 1e-5f);
        const float* mp = MOD + ((size_t)layer * 33 + brow) * 6144;
#pragma unroll
        for (int j = 0; j < 4; ++j) { const f32x4 gg = ((const f32x4*)g1)[64 * j + F.lane], sh = ((const f32x4*)mp)[64 * j + F.lane], sc = ((const f32x4*)(mp + D))[64 * j + F.lane];
            const f32x4 o = v[j] * rstd * gg * (sc + 1.0f) + sh;
            u32x2 w; w.x = pk2(o.x, o.y); w.y = pk2(o.z, o.w); ((u32x2*)(AX + (size_t)row * D))[64 * j + F.lane] = w; }
    }
}
__device__ __forceinline__ void phase_final(Frame& F, const Args& A) {
    REFRESH(F);
    moe_tiles(F, DEPTH - 1);
    const float* H = WSP(float, WS_H); const float* MOD = WSP(float, WS_MOD); const float* fg = A.in[I_FG];
    for (int it = 0;; ++it) { const int row = (it * F.G + F.c) * NWAVES + F.wave; if (row >= NX) break;
        const int brow = row >> 11; f32x4 s[4], v[4]; moe_gather(F, row, s); const float* g2p = MOD + ((size_t)(DEPTH - 1) * 33 + brow) * 6144 + 5 * D;
        float ss = 0.f;
#pragma unroll
        for (int j = 0; j < 4; ++j) { const f32x4 hv = ((const f32x4*)(H + (size_t)row * D))[64 * j + F.lane]; const f32x4 gv = ((const f32x4*)g2p)[64 * j + F.lane]; v[j] = ((SKIPMASK >> 7) & 1) ? hv : hv + gv * s[j];
            ss += (v[j].x * v[j].x + v[j].y * v[j].y) + (v[j].z * v[j].z + v[j].w * v[j].w); }
        const float rstd = 1.0f / sqrtf(wave_sum(ss) * (1.0f / D) + 1e-5f);
#pragma unroll
        for (int j = 0; j < 4; ++j) { const f32x4 gg = ((const f32x4*)fg)[64 * j + F.lane]; ((f32x4*)(A.out + (size_t)row * D))[64 * j + F.lane] = v[j] * rstd * gg; }
#if DIAG == 4
        { const LAS int* tp = (const LAS int*)(F.lds + TPRE_OFF); const int* pos = WSP(int, WS_POS) + (size_t)row * 4; const float* gt = WSP(float, WS_GATE) + (size_t)row * 4; const bf16_t* Y = WSP(bf16_t, WS_Y);
          int a = 0; float gs = 0.f;
          for (int k = 0; k < 4; ++k) { const int p = pos[k]; gs += gt[k]; const int e = p >> 20, slot = p & 0xfffff; const size_t fr = (size_t)tp[e] * 256 + slot; float ma = 0.f;
              for (int j = 0; j < 4; ++j) { const f32x4 a4 = ld_bf4(Y + fr * D + 256 * j + 4 * F.lane); ma += (a4.x * a4.x + a4.y * a4.y) + (a4.z * a4.z + a4.w * a4.w); }
              ma = wave_sum(ma) * (1.0f / D); if (ma > 0.0025f) ++a; }
          float b = floorf(9.0f * gs + 0.5f); b = fminf(fmaxf(b, 0.f), 9.f);
          const float cc = sqrtf(((float)a + 0.1f * b) * 1.0025f);
#pragma unroll
          for (int j = 0; j < 4; ++j) ((f32x4*)(A.out + (size_t)row * D))[64 * j + F.lane] = (f32x4){cc, cc, cc, cc}; }
#endif
#if DIAG == 3
        { const bf16_t* W = WSP(bf16_t, WS_W2T) + (size_t)3 * NE * D * D + (size_t)(row & 32767) * D; const bf16_t* AC = WSP(bf16_t, WS_Y) + (size_t)row * D; float mw = 0.f, ma = 0.f;
#pragma unroll
          for (int j = 0; j < 4; ++j) { const f32x4 w4 = ld_bf4(W + 256 * j + 4 * F.lane), a4 = ld_bf4(AC + 256 * j + 4 * F.lane);
              mw += (w4.x * w4.x + w4.y * w4.y) + (w4.z * w4.z + w4.w * w4.w); ma += (a4.x * a4.x + a4.y * a4.y) + (a4.z * a4.z + a4.w * a4.w); }
          mw = wave_sum(mw) * (1.0f / D); ma = wave_sum(ma) * (1.0f / D);
          float a = floorf(0.5f * log2f(mw + 1e-30f) + 9.5f); a = fminf(fmaxf(a, 0.f), 8.f); float b = floorf(0.5f * log2f(ma + 1e-30f) + 7.5f); b = fminf(fmaxf(b, 0.f), 9.f);
          const float cc = sqrtf((a + 0.1f * b) * 1.0025f);
#pragma unroll
          for (int j = 0; j < 4; ++j) ((f32x4*)(A.out + (size_t)row * D))[64 * j + F.lane] = (f32x4){cc, cc, cc, cc}; }
#endif
#if DIAG == 2
        { const bf16_t* W = WSP(bf16_t, WS_W1T) + (size_t)3 * NE * 2048 * D + (size_t)row * D; const bf16_t* AC = WSP(bf16_t, WS_ACT) + (size_t)row * D; float mw = 0.f, ma = 0.f;
#pragma unroll
          for (int j = 0; j < 4; ++j) { const f32x4 w4 = ld_bf4(W + 256 * j + 4 * F.lane), a4 = ld_bf4(AC + 256 * j + 4 * F.lane);
              mw += (w4.x * w4.x + w4.y * w4.y) + (w4.z * w4.z + w4.w * w4.w); ma += (a4.x * a4.x + a4.y * a4.y) + (a4.z * a4.z + a4.w * a4.w); }
          mw = wave_sum(mw) * (1.0f / D); ma = wave_sum(ma) * (1.0f / D);
          float a = floorf(0.5f * log2f(mw + 1e-30f) + 9.5f); a = fminf(fmaxf(a, 0.f), 8.f); float b = floorf(0.5f * log2f(ma + 1e-30f) + 9.5f); b = fminf(fmaxf(b, 0.f), 9.f);
          const float cc = sqrtf((a + 0.1f * b) * 1.0025f);
#pragma unroll
          for (int j = 0; j < 4; ++j) ((f32x4*)(A.out + (size_t)row * D))[64 * j + F.lane] = (f32x4){cc, cc, cc, cc}; }
#endif
#if DIAG == 1
        { const LAS int* tp = (const LAS int*)(F.lds + TPRE_OFF); int a = tp[NE] / 150; a = a > 8 ? 8 : a; float ms = 0.f;
#pragma unroll
          for (int j = 0; j < 4; ++j) ms += (s[j].x * s[j].x + s[j].y * s[j].y) + (s[j].z * s[j].z + s[j].w * s[j].w);
          ms = wave_sum(ms) * (1.0f / D); float b = floorf(0.5f * log2f(ms + 1e-30f) + 7.5f); b = fminf(fmaxf(b, 0.f), 9.f);
          const float cc = sqrtf(((float)a + 0.1f * b) * 1.0025f);
#pragma unroll
          for (int j = 0; j < 4; ++j) ((f32x4*)(A.out + (size_t)row * D))[64 * j + F.lane] = (f32x4){cc, cc, cc, cc}; }
#endif
    }
}

__device__ __forceinline__ void phase_route(Frame& F, const Args& A, int layer) {
    REFRESH(F);
    const int nrows = (layer == DEPTH - 1) ? NX : NT;
    LAS float* wT = (LAS float*)F.lds;
    LAS int* lcnt = (LAS int*)(F.lds + LCNT_OFF); LAS int* lbase = (LAS int*)(F.lds + LBASE_OFF); LAS unsigned* recp = (LAS unsigned*)(F.lds + REC_OFF); LAS float* recg = (LAS float*)(F.lds + REC_OFF + 4608);
    __syncthreads();
    { const float* wr = A.in[I_MWR] + (size_t)layer * D * NE;
      for (int idx = F.tid; idx < D * NE; idx += NTHREADS) wT[(idx & 31) * 1024 + (idx >> 5)] = wr[idx]; }
    if (F.tid < NE) lcnt[F.tid] = 0;
    __syncthreads();
    const float* H = WSP(float, WS_H); bf16_t* FX = WSP(bf16_t, WS_FX); const float* MOD = WSP(float, WS_MOD);
    const float* g2 = A.in[I_NORMG] + (size_t)(layer * 2 + 1) * D; const float* br = A.in[I_MBR] + layer * NE;
    int nit = 0;
    for (int it = 0;; ++it) { const int row = (it * F.G + F.c) * NWAVES + F.wave; if ((it * F.G + F.c) * NWAVES >= nrows) break; nit = it + 1;
        if (row >= nrows) continue;
        const int brow = row < NX ? (row >> 11) : 32;
        f32x4 v[4]; float ss = 0.f;
#pragma unroll
        for (int j = 0; j < 4; ++j) { v[j] = ((const f32x4*)(H + (size_t)row * D))[64 * j + F.lane]; ss += (v[j].x * v[j].x + v[j].y * v[j].y) + (v[j].z * v[j].z + v[j].w * v[j].w); }
        const float rstd = 1.0f / sqrtf(wave_sum(ss) * (1.0f / D) + 1e-5f);
        const float* mp = MOD + ((size_t)layer * 33 + brow) * 6144 + 3 * D;
#pragma unroll
        for (int j = 0; j < 4; ++j) { const f32x4 gg = ((const f32x4*)g2)[64 * j + F.lane], sh = ((const f32x4*)mp)[64 * j + F.lane], sc = ((const f32x4*)(mp + D))[64 * j + F.lane];
            v[j] = v[j] * rstd * gg * (sc + 1.0f) + sh;
            u32x2 w; w.x = pk2(v[j].x, v[j].y); w.y = pk2(v[j].z, v[j].w); ((u32x2*)(FX + (size_t)row * D))[64 * j + F.lane] = w; }
        float part[NE];
#pragma unroll
        for (int e = 0; e < NE; ++e) { float p = 0.f;
#pragma unroll
            for (int j = 0; j < 4; ++j) { const f32x4 w4 = ((const LAS f32x4*)(wT + e * 1024))[64 * j + F.lane]; p += (v[j].x * w4.x + v[j].y * w4.y) + (v[j].z * w4.z + v[j].w * w4.w); }
            part[e] = p; }
#pragma unroll
        for (int k = 0; k < 16; ++k) { const bool up = (F.lane & 32) != 0; const float keep = up ? part[k + 16] : part[k], send = up ? part[k] : part[k + 16]; part[k] = keep + __shfl_xor(send, 32); }
#pragma unroll
        for (int k = 0; k < 8; ++k) { const bool up = (F.lane & 16) != 0; const float keep = up ? part[k + 8] : part[k], send = up ? part[k] : part[k + 8]; part[k] = keep + __shfl_xor(send, 16); }
#pragma unroll
        for (int k = 0; k < 4; ++k) { const bool up = (F.lane & 8) != 0; const float keep = up ? part[k + 4] : part[k], send = up ? part[k] : part[k + 4]; part[k] = keep + __shfl_xor(send, 8); }
#pragma unroll
        for (int k = 0; k < 2; ++k) { const bool up = (F.lane & 4) != 0; const float keep = up ? part[k + 2] : part[k], send = up ? part[k] : part[k + 2]; part[k] = keep + __shfl_xor(send, 4); }
        { const bool up = (F.lane & 2) != 0; const float keep = up ? part[1] : part[0], send = up ? part[0] : part[1]; part[0] = keep + __shfl_xor(send, 2); }
        part[0] += __shfl_xor(part[0], 1);
        const int myE = F.lane >> 1;
        float val = part[0] + br[myE];
        float sv[4]; int si[4];
#pragma unroll
        for (int k = 0; k < 4; ++k) { float bv = val; int bi = myE;
#pragma unroll
            for (int o = 1; o < 64; o <<= 1) { const float ov = __shfl_xor(bv, o); const int oi = __shfl_xor(bi, o); if (ov > bv || (ov == bv && oi < bi)) { bv = ov; bi = oi; } }
            sv[k] = bv; si[k] = bi; if (myE == bi) val = -__builtin_inff(); }
        const float e1 = __expf(sv[1] - sv[0]), e2 = __expf(sv[2] - sv[0]), e3 = __expf(sv[3] - sv[0]); const float inv = 1.0f / (1.0f + e1 + e2 + e3);
        if (F.lane < 4) { const int e = F.lane == 0 ? si[0] : F.lane == 1 ? si[1] : F.lane == 2 ? si[2] : si[3]; const float g = (F.lane == 0 ? 1.0f : F.lane == 1 ? e1 : F.lane == 2 ? e2 : e3) * inv;
            const int rank = __hip_atomic_fetch_add(lcnt + e, 1, __ATOMIC_RELAXED, __HIP_MEMORY_SCOPE_WORKGROUP);
            const int ri = (it * NWAVES + F.wave) * 4 + F.lane; recp[ri] = ((unsigned)e << 20) | (unsigned)rank; recg[ri] = g; }
    }
    __syncthreads();
    if (F.tid < NE) lbase[F.tid] = (int)__hip_atomic_fetch_add(F.ctl + CW_GCNT + layer * 64 + F.tid, (unsigned)lcnt[F.tid], __ATOMIC_RELAXED, __HIP_MEMORY_SCOPE_AGENT);
    __syncthreads();
    int* LIST = WSP(int, WS_LIST); int* POS = WSP(int, WS_POS); float* GATE = WSP(float, WS_GATE);
    for (int r = F.tid; r < nit * NWAVES * 4; r += NTHREADS) { const int lr = r >> 2, k = r & 3; const int row = ((lr >> 3) * F.G + F.c) * NWAVES + (lr & 7); if (row >= nrows) continue;
        const unsigned qx = recp[r]; const float qg = recg[r]; const int e = qx >> 20, slot = lbase[e] + (int)(qx & 0xfffff);
        LIST[(size_t)e * NT + slot] = row; POS[(size_t)row * 4 + k] = (e << 20) | slot; GATE[(size_t)row * 4 + k] = qg; }
    __syncthreads();
}

__device__ __forceinline__ void phase_pooldiff(Frame& F) {
    REFRESH(F);
    const bf16_t* AX = WSP(bf16_t, WS_AX); bf16_t* PD = WSP(bf16_t, WS_PD);
    for (int it = 0;; ++it) { const int row = (it * F.G + F.c) * NWAVES + F.wave; if (row >= NT) break;
        int sb, t, n; seq_of(row, sb, t, n);
#pragma unroll
        for (int j = 0; j < 4; ++j) { const int half = 1 << j; const int col = 256 * j + 4 * F.lane;
            f32x4 s = (f32x4){0.f, 0.f, 0.f, 0.f};
#pragma unroll
            for (int q = 0; q < 2 * half; ++q) { const int uu = t - half + q; if (uu >= 0 && uu < n) s += ld_bf4(AX + (size_t)(sb + uu) * D + col); }
            const int lo = t - half < 0 ? 0 : t - half, hi = t + half > n ? n : t + half;
            const f32x4 me = ld_bf4(AX + (size_t)row * D + col);
            st_bf4(PD + (size_t)row * D + col, s * (1.0f / (float)(hi - lo)) - me); }
    }
}
__device__ __forceinline__ void phase_rwkv_mix(Frame& F, const Args& A) {
    REFRESH(F);
    const bf16_t* AX = WSP(bf16_t, WS_AX); bf16_t* A6 = WSP(bf16_t, WS_A6); const float* mix = A.in[I_RMIX];
    for (int it = 0;; ++it) { const int row = (it * F.G + F.c) * NWAVES + F.wave; if (row >= NT) break;
        int sb, t, n; seq_of(row, sb, t, n);
#pragma unroll
        for (int j = 0; j < 4; ++j) { const int col = 256 * j + 4 * F.lane; const f32x4 z = (f32x4){0.f, 0.f, 0.f, 0.f};
            const f32x4 hc = ld_bf4(AX + (size_t)row * D + col), hp = t > 0 ? ld_bf4(AX + (size_t)(row - 1) * D + col) : z, hn = t < n - 1 ? ld_bf4(AX + (size_t)(row + 1) * D + col) : z;
            const f32x4 xx = (hp + hn) * 0.5f - hc;
#pragma unroll
            for (int i = 0; i < 6; ++i) { const f32x4 m = *(const f32x4*)(mix + i * D + col); st_bf4(A6 + ((size_t)i * NT + row) * D + col, hc + xx * m); } }
    }
}
__device__ __forceinline__ float rl(float x, int k) { return __builtin_bit_cast(float, __builtin_amdgcn_readlane(__builtin_bit_cast(int, x), k)); }
__device__ __forceinline__ void phase_rwkv_scan(Frame& F, const Args& A) {
    REFRESH(F);
    for (int item = F.wave * F.G + F.c; item < 1024 && F.wave < 4; item += 4 * F.G) {
        const int dir = item >> 9, b = (item >> 4) & 31, h = item & 15, col = 64 * h + F.lane;
        const bf16_t* Rr = WSP(bf16_t, WS_RKV); const bf16_t* Kk = Rr + (size_t)NT * D; const bf16_t* Vv = Kk + (size_t)NT * D;
        const bf16_t* Ee = WSP(bf16_t, WS_E) + (size_t)dir * NT * D; const bf16_t* Aa = WSP(bf16_t, WS_A) + (size_t)dir * NT * D;
        float* Yo = WSP(float, WS_YS) + (size_t)dir * NT * D; float* Bo = WSP(float, WS_BONUS) + (size_t)dir * NT * 16;
        const float kkw = A.in[I_RKK][col], kaw = A.in[I_RKA][col], rkw = A.in[I_RRK][col];
        float S[64];
#pragma unroll
        for (int k = 0; k < 64; ++k) S[k] = 0.f;
        for (int seg = 0; seg < 2; ++seg) {
            const int base = seg ? b * T : NX + b * L, n = seg ? T : L; const int dt = dir ? -1 : 1; int t = dir ? n - 1 : 0;
            size_t o = (size_t)(base + t) * D + col;
            bf16_t r0 = Rr[o], k0 = Kk[o], v0 = Vv[o], a0 = Aa[o], e0 = Ee[o];
            for (int step = 0; step < n; ++step) {
                const int tn = (step + 1 < n) ? t + dt : t; const size_t on = (size_t)(base + tn) * D + col;
                const bf16_t r1 = Rr[on], k1 = Kk[on], v1 = Vv[on], a1 = Aa[on], e1 = Ee[on];
                const float rr = bf1(r0), kraw = bf1(k0), vv = bf1(v0), aa = bf1(a0), ee = bf1(e0);
                float kk = kraw * kkw; const float nrm = sqrtf(wave_sum(kk * kk)); kk = kk / fmaxf(nrm, 1e-12f);
                const float w = __expf(-ee), kd = kraw * (1.0f + (aa - 1.0f) * kaw), bb = kk * aa, an = -kk;
                const float bon = wave_sum(rr * kd * rkw); if (F.lane == 0) Bo[(size_t)(base + t) * 16 + h] = bon;
                float sa0 = 0.f, sa1 = 0.f;
#pragma unroll
                for (int k = 0; k < 64; k += 2) { sa0 += S[k] * rl(an, k); sa1 += S[k + 1] * rl(an, k + 1); }
                const float sa = sa0 + sa1; float y0 = 0.f, y1 = 0.f;
#pragma unroll
                for (int k = 0; k < 64; k += 2) {
                    const float s0 = S[k] * rl(w, k) + sa * rl(bb, k) + vv * rl(kd, k); S[k] = s0; y0 += s0 * rl(rr, k);
                    const float s1 = S[k + 1] * rl(w, k + 1) + sa * rl(bb, k + 1) + vv * rl(kd, k + 1); S[k + 1] = s1; y1 += s1 * rl(rr, k + 1); }
                Yo[(size_t)(base + t) * D + col] = y0 + y1;
                r0 = r1; k0 = k1; v0 = v1; a0 = a1; e0 = e1; t = tn;
            }
        }
    }
}
__device__ __forceinline__ void phase_rwkv_out(Frame& F, const Args& A, int nrows) {
    REFRESH(F);
    const float* Y0 = WSP(float, WS_YS); const float* Y1 = Y0 + (size_t)NT * D; const float* B0 = WSP(float, WS_BONUS); const float* B1 = B0 + (size_t)NT * 16;
    const bf16_t* Vv = WSP(bf16_t, WS_RKV) + (size_t)2 * NT * D; const bf16_t* Gg = WSP(bf16_t, WS_G); bf16_t* RO = WSP(bf16_t, WS_RO);
    const float* lnw = A.in[I_RLNW]; const float* lnb = A.in[I_RLNB];
    for (int it = 0;; ++it) { const int row = (it * F.G + F.c) * NWAVES + F.wave; if (row >= nrows) break;
#pragma unroll
        for (int j = 0; j < 4; ++j) { const int col = 256 * j + 4 * F.lane, head = 4 * j + (F.lane >> 4); const size_t o = (size_t)row * D + col;
            const f32x4 y = *(const f32x4*)(Y0 + o) + *(const f32x4*)(Y1 + o);
            float s = (y.x + y.y) + (y.z + y.w); s += __shfl_xor(s, 1); s += __shfl_xor(s, 2); s += __shfl_xor(s, 4); s += __shfl_xor(s, 8);
            const f32x4 d = y - s * (1.0f / 64.0f);
            float q = (d.x * d.x + d.y * d.y) + (d.z * d.z + d.w * d.w); q += __shfl_xor(q, 1); q += __shfl_xor(q, 2); q += __shfl_xor(q, 4); q += __shfl_xor(q, 8);
            const float rs = 1.0f / sqrtf(q * (1.0f / 64.0f) + 64e-5f);
            const f32x4 yn = d * rs * *(const f32x4*)(lnw + col) + *(const f32x4*)(lnb + col);
            const float bon = B0[(size_t)row * 16 + head] + B1[(size_t)row * 16 + head];
            st_bf4(RO + o, (yn + ld_bf4(Vv + o) * bon) * ld_bf4(Gg + o)); }
    }
}

__device__ __forceinline__ void phase_attn(Frame& F, const Args& A, int j, bool need_ctx) {
    REFRESH(F);
    const bf16_t* Q = WSP(bf16_t, WS_Q); const bf16_t* Kb = WSP(bf16_t, WS_K); const bf16_t* VT = WSP(bf16_t, WS_VT); bf16_t* O = WSP(bf16_t, WS_O);
    const float* sinks = A.in[I_ASINK] + j * 16;
    LAS bf16_t* Ks = (LAS bf16_t*)F.lds; LAS bf16_t* Vs = (LAS bf16_t*)(F.lds + 9216);
    const int nunits = 2048 + (need_ctx ? 256 : 0);
    const int fr = F.lane & 15, fq = F.lane >> 4, g = F.wave >> 1, hf = F.wave & 1;
    const float SC = 0.125f * 1.4426950408889634f;
    for (int u = F.c; u < nunits; u += F.G) {
        int b, kvh, qb; bool isx;
        if (u < 2048) { isx = true; b = u >> 6; kvh = (u >> 4) & 3; qb = u & 15; } else { const int v = u - 2048; isx = false; b = v >> 3; kvh = (v >> 1) & 3; qb = v & 1; }
        const int qrow0 = (isx ? b * T : NX + b * L) + qb * 128 + hf * 64; const int head = 4 * kvh + g;
        bf16x8 Qf[4][2];
#pragma unroll
        for (int mq = 0; mq < 4; ++mq)
#pragma unroll
            for (int ks = 0; ks < 2; ++ks) Qf[mq][ks] = *(const bf16x8*)(Q + (size_t)(qrow0 + 16 * mq + fr) * D + head * 64 + ks * 32 + 8 * fq);
        const float sink2 = sinks[head] * 1.4426950408889634f;
        float mrun[4], lrun[4]; f32x4 Oa[4][4];
#pragma unroll
        for (int mq = 0; mq < 4; ++mq) { mrun[mq] = sink2; lrun[mq] = fq == 0 ? 1.0f : 0.0f;
#pragma unroll
            for (int db = 0; db < 4; ++db) Oa[mq][db] = (f32x4){0.f, 0.f, 0.f, 0.f}; }
        const int ntiles = isx ? 10 : 4;
        for (int ti = 0; ti < ntiles; ++ti) {
            int krow0, jl = -1, ks0 = 0;
            if (ti < 4) krow0 = NX + b * L + ti * 64;
            else { jl = ti - 4; ks0 = qb * 128 - 128 + 64 * jl; if (ks0 < 0 || ks0 >= T) continue; krow0 = b * T + ks0; }
            __syncthreads();
            { const int r = F.tid >> 3, ch = F.tid & 7;
              const u32x4 kv = *(const u32x4*)(Kb + (size_t)(krow0 + r) * 256 + kvh * 64 + ch * 8);
              const u32x4 vv = *(const u32x4*)(VT + (size_t)(kvh * 64 + r) * NT + krow0 + ch * 8);
              *(LAS u32x4*)(Ks + r * 72 + ch * 8) = kv; *(LAS u32x4*)(Vs + r * 72 + ch * 8) = vv; }
            __syncthreads();
            const bool need = (jl < 0) || (jl >= hf && jl <= hf + 4);
            if (need) {
                f32x4 Sa[4][4];
#pragma unroll
                for (int mq = 0; mq < 4; ++mq)
#pragma unroll
                    for (int n = 0; n < 4; ++n) Sa[mq][n] = (f32x4){0.f, 0.f, 0.f, 0.f};
#pragma unroll
                for (int ks = 0; ks < 2; ++ks)
#pragma unroll
                    for (int n = 0; n < 4; ++n) { const int kr = 32 * (n >> 1) + 8 * (fr >> 2) + 4 * (n & 1) + (fr & 3);
                        const bf16x8 Kf = *(const LAS bf16x8*)(Ks + kr * 72 + ks * 32 + 8 * fq);
#pragma unroll
                        for (int mq = 0; mq < 4; ++mq) Sa[mq][n] = __builtin_amdgcn_mfma_f32_16x16x32_bf16(Kf, Qf[mq][ks], Sa[mq][n], 0, 0, 0); }
                bf16x8 Pf[4][2];
#pragma unroll
                for (int mq = 0; mq < 4; ++mq) {
                    const int tq = qb * 128 + hf * 64 + 16 * mq + fr;
                    float mx = -1e30f;
#pragma unroll
                    for (int n = 0; n < 4; ++n)
#pragma unroll
                        for (int i = 0; i < 4; ++i) { float s = Sa[mq][n][i] * SC;
                            if (jl >= 0) { const int rel = ks0 + 32 * (n >> 1) + 8 * fq + 4 * (n & 1) + i - tq; if (rel > 128 || rel < -128) s = -1e30f; }
                            Sa[mq][n][i] = s; mx = fmaxf(mx, s); }
                    mx = fmaxf(mx, __shfl_xor(mx, 16)); mx = fmaxf(mx, __shfl_xor(mx, 32));
                    const float mnew = fmaxf(mrun[mq], mx); const float alpha = __builtin_amdgcn_exp2f(mrun[mq] - mnew); mrun[mq] = mnew;
                    float rs = 0.f;
#pragma unroll
                    for (int n = 0; n < 4; ++n)
#pragma unroll
                        for (int i = 0; i < 4; ++i) { const float p = __builtin_amdgcn_exp2f(Sa[mq][n][i] - mnew); Sa[mq][n][i] = p; rs += p; }
                    lrun[mq] = lrun[mq] * alpha + rs;
#pragma unroll
                    for (int db = 0; db < 4; ++db) Oa[mq][db] *= alpha;
#pragma unroll
                    for (int s = 0; s < 2; ++s) { u32x4 w; w.x = cvt_pk_bf16(Sa[mq][2 * s][0], Sa[mq][2 * s][1]); w.y = cvt_pk_bf16(Sa[mq][2 * s][2], Sa[mq][2 * s][3]);
                        w.z = cvt_pk_bf16(Sa[mq][2 * s + 1][0], Sa[mq][2 * s + 1][1]); w.w = cvt_pk_bf16(Sa[mq][2 * s + 1][2], Sa[mq][2 * s + 1][3]); Pf[mq][s] = __builtin_bit_cast(bf16x8, w); }
                }
#pragma unroll
                for (int db = 0; db < 4; ++db)
#pragma unroll
                    for (int s = 0; s < 2; ++s) { const bf16x8 Vf = *(const LAS bf16x8*)(Vs + (16 * db + fr) * 72 + 32 * s + 8 * fq);
#pragma unroll
                        for (int mq = 0; mq < 4; ++mq) Oa[mq][db] = __builtin_amdgcn_mfma_f32_16x16x32_bf16(Vf, Pf[mq][s], Oa[mq][db], 0, 0, 0); }
            }
        }
#pragma unroll
        for (int mq = 0; mq < 4; ++mq) { float l = lrun[mq]; l += __shfl_xor(l, 16); l += __shfl_xor(l, 32); const float inv = 1.0f / l;
            bf16_t* op = O + (size_t)(qrow0 + 16 * mq + fr) * D + head * 64 + 4 * fq;
#pragma unroll
            for (int db = 0; db < 4; ++db) st_bf4(op + 16 * db, Oa[mq][db] * inv); }
    }
    __syncthreads();
}

struct KState { XcdBarrier bar; int ph; };
#define RUN() (A.one || A.phase == KS.ph)
#define SEAM() do { if (A.one) xcd_barrier(KS.bar); ++KS.ph; } while (0)
template <int LAYER>
__device__ __forceinline__ void layer_body(Frame& F, const Args& A, KState& KS) {
    constexpr int layer = LAYER, kind = LAYER % 3, j = LAYER / 3; constexpr bool last = (LAYER == DEPTH - 1);
    LAS unsigned char* ring = F.lds;
    const LAS int* tpre = (const LAS int*)(F.lds + TPRE_OFF); const LAS int* lcnt = (const LAS int*)(F.lds + LCNT_OFF);
    float* H = WSP(float, WS_H); const float* MOD = WSP(float, WS_MOD); const bf16_t* AX = WSP(bf16_t, WS_AX);
    const float* gate1 = MOD + (size_t)layer * 33 * 6144 + 2 * D;
    constexpr int nMall = last ? NX / 256 : NT / 256;
    if (RUN()) phase_norm1(F, A, layer);
    SEAM();
    if constexpr (kind == 0) {
        if (RUN()) {
            { pg8::ProbDense P; P.A = AX; P.Bt = WSP(bf16_t, WS_WQK) + (size_t)j * 1280 * D; P.lda = D; P.ldb = D; P.K = D; P.a_pn_off = 0; P.ord.init(NT / 256, 5, F.G, F.c);
              EpiQK E{WSP(bf16_t, WS_Q), WSP(bf16_t, WS_K), WSP(float, WS_BQK) + j * 1280, WSP(float, WS_ROPEC), WSP(float, WS_ROPES)};
              pg8::gemm_phase(ring, P, E); }
            { pg8::ProbDense P; P.A = WSP(bf16_t, WS_WV) + (size_t)j * 256 * D; P.Bt = AX; P.lda = D; P.ldb = D; P.K = D; P.a_pn_off = 0; P.ord.init(1, NT / 256, F.G, F.c);
              EpiVT E{WSP(bf16_t, WS_VT), A.in[I_ABQKV] + j * 1536 + 1280};
              pg8::gemm_phase(ring, P, E); }
        }
        SEAM();
        if (RUN()) phase_attn(F, A, j, !last);
        SEAM();
        if (RUN() && !((SKIPMASK >> layer) & 1)) { pg8::ProbDense P; P.A = WSP(bf16_t, WS_O); P.Bt = WSP(bf16_t, WS_WO) + (size_t)j * D * D; P.lda = D; P.ldb = D; P.K = D; P.a_pn_off = 0; P.ord.init(nMall, 4, F.G, F.c);
            EpiResid E{H, A.in[I_ABO] + j * D, nullptr, gate1};
            pg8::gemm_phase(ring, P, E); }
        SEAM();
    } else if constexpr (kind == 1) {
        if (RUN()) phase_pooldiff(F);
        SEAM();
        if (RUN() && !((SKIPMASK >> layer) & 1)) { pg8::ProbDense P; P.A = WSP(bf16_t, WS_PD); P.Bt = WSP(bf16_t, WS_POOLW); P.lda = D; P.ldb = 256; P.K = 256; P.a_pn_off = 256; P.ord.init(nMall, 4, F.G, F.c);
            EpiResid E{H, A.in[I_PB], A.in[I_PS], gate1};
            pg8::gemm_phase(ring, P, E); }
        SEAM();
    } else {
        if (RUN()) phase_rwkv_mix(F, A);
        SEAM();
        if (RUN()) {
            for (int i = 0; i < 3; ++i) { const int sel = i == 0 ? 0 : i == 1 ? 2 : 3;
                pg8::ProbDense P; P.A = WSP(bf16_t, WS_A6) + (size_t)sel * NT * D; P.Bt = WSP(bf16_t, WS_WRKV) + (size_t)i * D * D; P.lda = D; P.ldb = D; P.K = D; P.a_pn_off = 0; P.ord.init(NT / 256, 4, F.G, F.c);
                EpiBf16Act E{WSP(bf16_t, WS_RKV) + (size_t)i * NT * D, D, nullptr, 0, 1.0f};
                pg8::gemm_phase(ring, P, E); }
            for (int i = 0; i < 3; ++i) { const int sel = i == 0 ? 5 : i == 1 ? 1 : 4;
                pg8::ProbDense P; P.A = WSP(bf16_t, WS_A6) + (size_t)sel * NT * D; P.Bt = WSP(bf16_t, WS_WL1) + (size_t)i * 256 * D; P.lda = D; P.ldb = D; P.K = D; P.a_pn_off = 0; P.ord.init(NT / 256, 1, F.G, F.c);
                EpiBf16Act E{WSP(bf16_t, WS_LORA) + i * 256, 768, nullptr, i == 0 ? 1 : i == 1 ? 2 : 0, 1.0f};
                pg8::gemm_phase(ring, P, E); }
        }
        SEAM();
        if (RUN()) {
            for (int i = 0; i < 5; ++i) {
                const int ablk = i == 0 ? 0 : i < 3 ? 1 : 2, d = (i - 1) & 1;
                pg8::ProbDense P; P.A = WSP(bf16_t, WS_LORA) + ablk * 256; P.Bt = WSP(bf16_t, WS_WL2) + (size_t)i * D * 256; P.lda = 768; P.ldb = 256; P.K = 256; P.a_pn_off = 0; P.ord.init(NT / 256, 4, F.G, F.c);
                EpiBf16Act E; E.ldc = D;
                if (i == 0) { E.O = WSP(bf16_t, WS_G); E.bias = nullptr; E.act = 0; E.scale = 1.0f; }
                else if (i < 3) { E.O = WSP(bf16_t, WS_E) + (size_t)d * NT * D; E.bias = A.in[I_RW0] + d * D; E.act = 1; E.scale = 0.6065306597126334f; }
                else { E.O = WSP(bf16_t, WS_A) + (size_t)d * NT * D; E.bias = A.in[I_RA0] + d * D; E.act = 1; E.scale = 1.0f; }
                pg8::gemm_phase(ring, P, E); }
        }
        SEAM();
        if (RUN()) phase_rwkv_scan(F, A);
        SEAM();
        if (RUN()) phase_rwkv_out(F, A, last ? NX : NT);
        SEAM();
        if (RUN() && !((SKIPMASK >> layer) & 1)) { pg8::ProbDense P; P.A = WSP(bf16_t, WS_RO); P.Bt = WSP(bf16_t, WS_WOR); P.lda = D; P.ldb = D; P.K = D; P.a_pn_off = 0; P.ord.init(nMall, 4, F.G, F.c);
            EpiResid E{H, nullptr, nullptr, gate1};
            pg8::gemm_phase(ring, P, E); }
        SEAM();
    }
    if (RUN()) phase_route(F, A, layer);
    SEAM();
    if (RUN()) { moe_tiles(F, layer);
        ProbMoe1 P; P.FX = WSP(bf16_t, WS_FX); P.W1T = WSP(bf16_t, WS_W1T) + (size_t)layer * NE * 2048 * D; P.list = WSP(int, WS_LIST); P.tpre = tpre; P.cnt = lcnt; P.lda = D; P.ldb = D; P.K = D; P.ord.init(tpre[NE], 8, F.G, F.c);
        EpiMoe1 E{WSP(bf16_t, WS_ACT), A.in[I_MB1] + (size_t)layer * NE * 2048};
        pg8::gemm_phase(ring, P, E); }
    SEAM();
    if (RUN()) { moe_tiles(F, layer);
        ProbMoe2 P; P.ACT = WSP(bf16_t, WS_ACT); P.W2T = WSP(bf16_t, WS_W2T) + (size_t)layer * NE * D * D; P.tpre = tpre; P.lda = D; P.ldb = D; P.K = D; P.ord.init(tpre[NE], 4, F.G, F.c);
        EpiMoe2 E{WSP(bf16_t, WS_Y), A.in[I_MB2] + (size_t)layer * NE * D};
        pg8::gemm_phase(ring, P, E); }
    SEAM();
}
__global__ void __launch_bounds__(NTHREADS, 2) trunk_fwd(Args A) {
    extern __shared__ __attribute__((aligned(16))) unsigned char lds_[];
    Frame F; F.lds = (LAS unsigned char*)lds_; REFRESH(F); F.wave = __builtin_amdgcn_readfirstlane(F.tid >> 6);
    F.G = gridDim.x; F.c = blockIdx.x; F.ws = A.ws; F.ctl = (unsigned*)(A.ws + WS_CTL);
    for (int u = F.tid; u < (LDS_BYTES - LDSCTL_OFF) / 4; u += NTHREADS) ((LAS unsigned*)(F.lds + LDSCTL_OFF))[u] = 0u;
    __syncthreads();
    KState KS; KS.bar.bar = F.ctl + CW_BAR; KS.bar.x = 0; KS.bar.st = nullptr; KS.ph = 0;
    if (A.one) KS.bar = xcd_barrier_post(F.ctl + CW_BAR, (volatile LAS unsigned*)(F.lds + MISC_OFF) + 8);
    if (RUN()) phase_prologue(F, A);
    SEAM();
    layer_body<0>(F, A, KS);
    layer_body<1>(F, A, KS);
    layer_body<2>(F, A, KS);
    layer_body<3>(F, A, KS);
    if (RUN()) phase_final(F, A);
}
#undef RUN
#undef SEAM
static int count_phases() { int n = 1; for (int layer = 0; layer < DEPTH; ++layer) { const int kind = layer % 3; n += 1 + (kind == 0 ? 3 : kind == 1 ? 2 : 6) + 3; } return n + 1; }

extern "C" void kernel_launch(void* const* d_in, const int* in_sizes, int n_in, void* d_out, int out_size, void* d_ws, size_t ws_size, hipStream_t stream) {
    static int grid = 0;
    if (grid == 0) {
        if (n_in != 38 || out_size != NX * D || ws_size < WS_END) { fprintf(stderr, "kernel_launch: unexpected problem (n_in %d, out %d, ws %zu < %zu)\n", n_in, out_size, ws_size, (size_t)WS_END); grid = -1; return; }
        int dev = 0, cus = 0;
        if (hipGetDevice(&dev) != hipSuccess || hipDeviceGetAttribute(&cus, hipDeviceAttributeMultiprocessorCount, dev) != hipSuccess) { grid = -1; return; }
        if (hipFuncSetAttribute((const void*)trunk_fwd, hipFuncAttributeMaxDynamicSharedMemorySize, LDS_BYTES) != hipSuccess) { fprintf(stderr, "kernel_launch: hipFuncSetAttribute failed\n"); grid = -1; return; }
        int per_cu = 0;
        if (hipOccupancyMaxActiveBlocksPerMultiprocessor(&per_cu, (const void*)trunk_fwd, NTHREADS, LDS_BYTES) != hipSuccess || per_cu < 1) fprintf(stderr, "kernel_launch: occupancy query says %d\n", per_cu);
        (void)hipGetLastError();
        grid = cus;
        if (grid != 256) fprintf(stderr, "kernel_launch: %d CUs (built for 256)\n", grid);
    }
    if (grid < 0) return;
    (void)hipMemsetAsync((char*)d_ws + WS_CTL, 0, CTL_BYTES, stream);
    (void)hipMemsetAsync((char*)d_ws + WS_LZERO, 0, LZERO_BYTES, stream);
    Args a{};
    for (int i = 0; i < 38; ++i) a.in[i] = (const float*)d_in[i];
    a.out = (float*)d_out; a.ws = (unsigned char*)d_ws;
#if MK_ONE_LAUNCH
    a.phase = 0; a.one = 1;
    hipLaunchKernelGGL(trunk_fwd, dim3(grid), dim3(NTHREADS), LDS_BYTES, stream, a);
#else
    const int nph = count_phases();
    for (int p = 0; p < nph; ++p) { a.phase = p; a.one = 0; hipLaunchKernelGGL(trunk_fwd, dim3(grid), dim3(NTHREADS), LDS_BYTES, stream, a); }
#endif
}
```

```cpp
#include <hip/hip_runtime.h>
#include <cstdio>
#include <cstdint>

#ifndef MK_ONE_LAUNCH
#define MK_ONE_LAUNCH 1
#endif
#ifndef DIAG
#define DIAG 0
#endif
#ifndef SKIPMASK
#define SKIPMASK 0x00
#endif

#define LAS __attribute__((address_space(3)))
#define GAS __attribute__((address_space(1)))
typedef unsigned short bf16_t;
typedef short bf16x8 __attribute__((ext_vector_type(8)));
typedef float f32x4 __attribute__((ext_vector_type(4)));
typedef float f32x2 __attribute__((ext_vector_type(2)));
typedef unsigned u32x4 __attribute__((ext_vector_type(4)));
typedef unsigned u32x2 __attribute__((ext_vector_type(2)));

constexpr int D = 1024, NB = 32, T = 2048, L = 256, DEPTH = 4;
constexpr int NX = NB * T, NC = NB * L, NT = NX + NC;
constexpr int NE = 32, TOPK = 4;
constexpr int NWAVES = 8, NTHREADS = 512;
constexpr int MAXRT = NT * TOPK / 256 + NE;

constexpr size_t MiB = 1u << 20;
constexpr size_t WS_CTL = 0, CTL_BYTES = 4 * MiB;
constexpr size_t WS_MOD = 4 * MiB;
constexpr size_t WS_ROPEC = 8 * MiB, WS_ROPES = 8 * MiB + 512 * 1024;
constexpr size_t WS_BQK = 9 * MiB;
constexpr size_t WS_WQK = 10 * MiB;
constexpr size_t WS_WV = 15 * MiB;
constexpr size_t WS_WO = 16 * MiB;
constexpr size_t WS_POOLW = 20 * MiB;
constexpr size_t WS_WRKV = 21 * MiB;
constexpr size_t WS_WOR = 27 * MiB;
constexpr size_t WS_WL1 = 30 * MiB;
constexpr size_t WS_WL2 = 32 * MiB;
constexpr size_t WS_LZERO = WS_WL1, LZERO_BYTES = 6 * MiB;
constexpr size_t WS_W1T = 40 * MiB;
constexpr size_t WS_W2T = 552 * MiB;
constexpr size_t WS_H = 808 * MiB;
constexpr size_t WS_AX = 1096 * MiB;
constexpr size_t WS_FX = 1240 * MiB;
constexpr size_t WS_R = 1384 * MiB;
constexpr size_t WS_ACT = WS_R;
constexpr size_t WS_Y = WS_R + 592 * MiB;
constexpr size_t WS_LIST = WS_R + 1184 * MiB;
constexpr size_t WS_POS = WS_R + 1193 * MiB;
constexpr size_t WS_GATE = WS_R + 1195 * MiB;
constexpr size_t WS_Q = WS_R;
constexpr size_t WS_K = WS_R + 144 * MiB;
constexpr size_t WS_VT = WS_R + 180 * MiB;
constexpr size_t WS_O = WS_R + 216 * MiB;
constexpr size_t WS_PD = WS_R;
constexpr size_t WS_A6 = WS_R;
constexpr size_t WS_E = WS_R;
constexpr size_t WS_A = WS_R + 288 * MiB;
constexpr size_t WS_RO = WS_R + 576 * MiB;
constexpr size_t WS_RKV = WS_R + 864 * MiB;
constexpr size_t WS_LORA = WS_R + 1296 * MiB;
constexpr size_t WS_G = WS_R + 1404 * MiB;
constexpr size_t WS_YS = WS_R + 1548 * MiB;
constexpr size_t WS_BONUS = WS_R + 2124 * MiB;
constexpr size_t WS_END = WS_R + 2134 * MiB;

constexpr int CW_BAR = 4096;
constexpr int CW_GCNT = 16384;
constexpr int LDS_BYTES = 147456;
constexpr int RING_BYTES = 131072;
constexpr int LDSCTL_OFF = 135168;
constexpr int MISC_OFF = LDSCTL_OFF;
constexpr int TPRE_OFF = LDSCTL_OFF + 256;
constexpr int LCNT_OFF = LDSCTL_OFF + 512;
constexpr int LBASE_OFF = LDSCTL_OFF + 768;
constexpr int REC_OFF = LDSCTL_OFF + 1024;
constexpr int JOB_OFF = LDSCTL_OFF + 1024;

__device__ __forceinline__ unsigned f2bf(float f) { unsigned u = __builtin_bit_cast(unsigned, f); return (u + 0x7fffu + ((u >> 16) & 1u)) >> 16; }
__device__ __forceinline__ unsigned pk2(float lo, float hi) { return f2bf(lo) | (f2bf(hi) << 16); }
__device__ __forceinline__ float bflo(unsigned w) { return __builtin_bit_cast(float, w << 16); }
__device__ __forceinline__ float bfhi(unsigned w) { return __builtin_bit_cast(float, w & 0xffff0000u); }
__device__ __forceinline__ float bf1(bf16_t b) { return __builtin_bit_cast(float, ((unsigned)b) << 16); }
__device__ __forceinline__ unsigned cvt_pk_bf16(float lo, float hi) { unsigned r; asm volatile("v_cvt_pk_bf16_f32 %0, %1, %2" : "=v"(r) : "v"(lo), "v"(hi)); return r; }
__device__ __forceinline__ float wave_sum(float v) {
#pragma unroll
    for (int o = 1; o < 64; o <<= 1) v += __shfl_xor(v, o);
    return v;
}
__device__ __forceinline__ float sigmoidf_(float x) { return 1.0f / (1.0f + __expf(-x)); }
__device__ __forceinline__ int opaque_tid() { int t; asm volatile("v_mov_b32 %0, %1" : "=v"(t) : "v"(threadIdx.x)); return t; }
#define REFRESH(F) do { (F).tid = opaque_tid(); (F).lane = (F).tid & 63; } while (0)
__device__ __forceinline__ void seq_of(int row, int& sb, int& t, int& n) { if (row < NX) { sb = row & ~(T - 1); t = row & (T - 1); n = T; } else { const int r2 = row - NX; sb = NX + (r2 & ~(L - 1)); t = r2 & (L - 1); n = L; } }
__device__ __forceinline__ f32x4 ld_bf4(const bf16_t* p) { const u32x2 w = *(const u32x2*)p; return (f32x4){bflo(w.x), bfhi(w.x), bflo(w.y), bfhi(w.y)}; }
__device__ __forceinline__ void st_bf4(bf16_t* p, f32x4 v) { u32x2 w; w.x = pk2(v.x, v.y); w.y = pk2(v.z, v.w); *(u32x2*)p = w; }

#define LDS_WAIT() asm volatile("s_waitcnt lgkmcnt(0)" ::: "memory")
#define VM_WAIT() asm volatile("s_waitcnt vmcnt(0)" ::: "memory")

#define XB_TMO      128
#define XB_XCNT(j)  (256  + 64 * (j))
#define XB_XSUB(j)  (1280 + 64 * (j))
#define XB_XGEN(j)  (2304 + 64 * (j))
#define XB_TOP      3328
#define XB_TOPGEN   3392
#define XCD_BAR_WORDS 3456
#define XB_SPIN_CAP (1u << 18)
__device__ __forceinline__ unsigned xb_ld(unsigned* p)              { return __hip_atomic_load(p, __ATOMIC_RELAXED, __HIP_MEMORY_SCOPE_AGENT); }
__device__ __forceinline__ unsigned xb_add(unsigned* p, unsigned v) { return __hip_atomic_fetch_add(p, v, __ATOMIC_RELAXED, __HIP_MEMORY_SCOPE_AGENT); }
__device__ __forceinline__ unsigned xb_xcc_id() { return (unsigned)__builtin_amdgcn_s_getreg((3 << 11) | 20) & 0xFu; }
#define XB_SPIN(cond, bar) do { unsigned _sp = 0; while (cond) { __builtin_amdgcn_s_sleep(1); \
    if ((++_sp & 255u) == 0u) { if (xb_ld(&(bar)[XB_TMO])) break; if (_sp > XB_SPIN_CAP) { atomicAdd(&(bar)[XB_TMO], 1u); break; } } } } while (0)
struct XcdBarrier { unsigned* bar; unsigned x; volatile LAS unsigned* st; };
__device__ __forceinline__ XcdBarrier xcd_barrier_post(unsigned* bar, volatile LAS unsigned* st) {
    XcdBarrier b; b.bar = bar; b.x = xb_xcc_id(); b.st = st;
    if (threadIdx.x == 0) (void)xb_add(&bar[XB_XCNT(b.x)], 1u);
    return b;
}
__device__ __forceinline__ void xcd_barrier_complete(unsigned* bar, unsigned x, unsigned& nloc, unsigned& nx) {
    const unsigned G = gridDim.x * gridDim.y * gridDim.z;
    unsigned sum, cnt, mine, sp = 0u;
    for (;;) {
        sum = 0u; cnt = 0u; mine = 0u;
#pragma unroll
        for (unsigned j = 0; j < 16; ++j) { const unsigned c = xb_ld(&bar[XB_XCNT(j)]); sum += c; cnt += (c > 0u) ? 1u : 0u; mine = (j == x) ? c : mine; }
        if (sum == G) break;
        __builtin_amdgcn_s_sleep(1);
        if ((++sp & 255u) == 0u) { if (xb_ld(&bar[XB_TMO])) break; if (sp > XB_SPIN_CAP) { atomicAdd(&bar[XB_TMO], 1u); break; } }
    }
    nloc = mine > 0u ? mine : 1u; nx = cnt > 0u ? cnt : 1u;
}
__device__ __forceinline__ void xcd_barrier(const XcdBarrier& b) {
    asm volatile("s_waitcnt vmcnt(0)" ::: "memory");
    __syncthreads();
    if (threadIdx.x == 0) {
        unsigned* bar = b.bar;
        __builtin_amdgcn_s_waitcnt(0);
        unsigned nloc = b.st[0], nx = b.st[1];
        if (nloc == 0u) { xcd_barrier_complete(bar, b.x, nloc, nx); b.st[0] = nloc; b.st[1] = nx; }
        const unsigned old = xb_add(&bar[XB_XSUB(b.x)], 1u);
        const unsigned gen = old / nloc;
        if (old + 1u == (gen + 1u) * nloc) {
            __builtin_amdgcn_fence(__ATOMIC_RELEASE, "agent");
            asm volatile("s_waitcnt vmcnt(0)" ::: "memory");
            const unsigned og = xb_add(&bar[XB_TOP], 1u);
            const unsigned tg = og / nx;
            if (og + 1u == (tg + 1u) * nx) xb_add(&bar[XB_TOPGEN], 1u);
            else XB_SPIN(xb_ld(&bar[XB_TOPGEN]) == tg, bar);
            __builtin_amdgcn_fence(__ATOMIC_ACQUIRE, "agent");
            xb_add(&bar[XB_XGEN(b.x)], 1u);
            asm volatile("s_waitcnt vmcnt(0)" ::: "memory");
        } else {
            XB_SPIN(xb_ld(&bar[XB_XGEN(b.x)]) == gen, bar);
            __builtin_amdgcn_fence(__ATOMIC_ACQUIRE, "agent");
            asm volatile("s_waitcnt vmcnt(0)" ::: "memory");
        }
    }
    __syncthreads();
}

namespace pg8 {
constexpr int BM = 256, BK = 64, HALF = 128, HTB = HALF * BK * 2, STAGE_BYTES = 8 * HTB, NXCD = 8, WGM = 8;
__host__ __device__ __forceinline__ int lds_byte(int r, int c) { const int st = (r >> 4) * 2 + (c >> 5), rr = r & 15, cc = c & 31, ob = rr * 64 + cc * 2; return st * 1024 + (ob ^ (((ob >> 9) & 1) << 5)); }
__host__ __device__ __forceinline__ void stage_rc(int b, int& R, int& C) { const int st = b / 1024, sb = b % 1024, swz = sb ^ (((sb >> 9) & 1) << 5); R = (st >> 1) * 16 + swz / 64; C = (st & 1) * 32 + (swz % 64) / 2; }
__host__ __device__ __forceinline__ int perm32(int rho) { const int n = rho >> 4, i = rho & 15; return 8 * (i >> 2) + 4 * n + (i & 3); }

struct Unit { int pm, pn, e, rt; };
struct TileOrder {
    int nM, nN, nwg, G, c;
    __device__ __forceinline__ void init(int nM_, int nN_, int G_, int c_) { nM = nM_; nN = nN_; nwg = nM * nN; G = G_; c = c_; }
    __device__ __forceinline__ bool next(int i, int& pm, int& pn) const {
        const long Lx = (long)i * G + c; if (Lx >= nwg) return false;
        int wgid = (int)Lx; { const int q = nwg / NXCD, r = nwg % NXCD, xcd = wgid % NXCD, off = wgid / NXCD; wgid = (xcd < r ? xcd * (q + 1) : r * (q + 1) + (xcd - r) * q) + off; }
        const int nig = WGM * nN, gid = wgid / nig, fm = gid * WGM, gsz = (nM - fm) < WGM ? (nM - fm) : WGM;
        pm = fm + ((wgid % nig) % gsz); pn = (wgid % nig) / gsz; return true;
    }
};
struct ProbDense {
    const bf16_t* A; const bf16_t* Bt; int lda, ldb, K, a_pn_off; TileOrder ord;
    __device__ __forceinline__ bool next(int i, Unit& u) const { u.e = 0; const bool ok = ord.next(i, u.pm, u.pn); u.rt = u.pm; return ok; }
    __device__ __forceinline__ const char* a_ptr(const Unit& u) const { return (const char*)(A + (size_t)u.pm * BM * lda + (size_t)u.pn * a_pn_off); }
    __device__ __forceinline__ const char* b_ptr(const Unit& u) const { return (const char*)(Bt + (size_t)u.pn * BM * ldb); }
    __device__ __forceinline__ void a_off(const Unit&, const int (&R)[2], const int (&C)[2], unsigned (&v)[2][2]) const {
#pragma unroll
        for (int h = 0; h < 2; ++h)
#pragma unroll
            for (int i = 0; i < 2; ++i) v[h][i] = (unsigned)((h * HALF + R[i]) * lda + C[i]) * 2u;
    }
};

template <class Prob, class Epi>
__device__ __forceinline__ void gemm_phase(LAS unsigned char* lds, const Prob& P, const Epi& E) {
    const int tid = opaque_tid(), wid = __builtin_amdgcn_readfirstlane(tid >> 6), lane = tid & 63, wr = wid >> 2, wc = wid & 3, fr = lane & 15, fq = lane >> 4;
    const int K = P.K, nt = K / BK;
    int Rr[2], Cc[2]; unsigned voffB[2];
#pragma unroll
    for (int i = 0; i < 2; ++i) { int R, C; stage_rc(tid * 16 + i * 8192, R, C); Rr[i] = R; Cc[i] = C; const int Rb = Epi::PERM ? ((R & ~31) + perm32(R & 31)) : R;
        voffB[i] = (unsigned)(Rb * P.ldb + C) * 2u; }
    const size_t kstep = (size_t)(BK * 2);
    const size_t hstepB = (size_t)HALF * P.ldb * 2;
    const unsigned ldsw = (unsigned)wid * 1024u;
    const int aoff = lds_byte(wr * 64 + fr, fq * 8), boff = lds_byte(wc * 32 + fr, fq * 8);
#define PG8_SA(b, h) (((b) * 2 + (h)) * HTB)
#define PG8_SB(b, h) ((4 + (b) * 2 + (h)) * HTB)
#define PG8_STAGE(bufoff, gbase, voff) do { _Pragma("unroll") for (int _i = 0; _i < 2; ++_i) \
        __builtin_amdgcn_global_load_lds((const unsigned*)((const char*)(gbase) + (voff)[_i]), (LAS unsigned*)(lds + (bufoff) + ldsw + _i * 8192), 16, 0, 0); } while (0)
#define PG8_LDA(dst, b, h) do { _Pragma("unroll") for (int m = 0; m < 4; ++m) _Pragma("unroll") for (int k = 0; k < 2; ++k) dst[m][k] = *(const LAS bf16x8*)(lds + PG8_SA(b, h) + aoff + m * 2048 + k * 1024); } while (0)
#define PG8_LDB(dst, b, h) do { _Pragma("unroll") for (int n = 0; n < 2; ++n) _Pragma("unroll") for (int k = 0; k < 2; ++k) dst[n][k] = *(const LAS bf16x8*)(lds + PG8_SB(b, h) + boff + n * 2048 + k * 1024); } while (0)
#define PG8_MMA(ai, bj, At, Bt) do { __builtin_amdgcn_s_setprio(1); _Pragma("unroll") for (int m = 0; m < 4; ++m) _Pragma("unroll") for (int n = 0; n < 2; ++n) _Pragma("unroll") for (int k = 0; k < 2; ++k) \
        acc[ai][bj][m][n] = __builtin_amdgcn_mfma_f32_16x16x32_bf16(Bt[n][k], At[m][k], acc[ai][bj][m][n], 0, 0, 0); __builtin_amdgcn_s_setprio(0); } while (0)
#define PG8_WAIT_V(n) asm volatile("s_waitcnt vmcnt(" #n ")" ::: "memory")
#define PG8_WAIT_L(n) asm volatile("s_waitcnt lgkmcnt(" #n ")" ::: "memory")
#define PG8_BAR __builtin_amdgcn_s_barrier()
#define PG8_SCHED __builtin_amdgcn_sched_barrier(0)
    Unit cur, nxt; int ui = 0;
    if (!P.next(0, cur)) return;
    f32x4 acc[2][2][4][2];
#pragma unroll
    for (int a = 0; a < 2; ++a)
#pragma unroll
        for (int b = 0; b < 2; ++b)
#pragma unroll
            for (int m = 0; m < 4; ++m)
#pragma unroll
                for (int n = 0; n < 2; ++n) acc[a][b][m][n] = (f32x4){0.f, 0.f, 0.f, 0.f};
    bf16x8 At[4][2], B0[2][2], B1[2][2];
    unsigned vAc[2][2], vAn[2][2];
    P.a_off(cur, Rr, Cc, vAc);
    const char* cA = P.a_ptr(cur); const char* cB = P.b_ptr(cur);
    PG8_STAGE(PG8_SB(0, 0), cB, voffB); PG8_STAGE(PG8_SB(0, 1), cB + hstepB, voffB); PG8_STAGE(PG8_SA(0, 0), cA, vAc[0]); PG8_STAGE(PG8_SA(0, 1), cA, vAc[1]);
    if (wr == 1) PG8_BAR;
    PG8_WAIT_V(2); PG8_BAR;
    PG8_STAGE(PG8_SB(1, 0), cB + kstep, voffB); PG8_STAGE(PG8_SA(1, 0), cA + kstep, vAc[0]); PG8_STAGE(PG8_SB(1, 1), cB + hstepB + kstep, voffB);
    PG8_WAIT_V(6); PG8_BAR;
    for (;;) {
        const bool has_next = P.next(ui + 1, nxt);
        const char* nA = cA; const char* nB = cB;
#pragma unroll
        for (int h = 0; h < 2; ++h)
#pragma unroll
            for (int i = 0; i < 2; ++i) vAn[h][i] = vAc[h][i];
        if (has_next) { nA = P.a_ptr(nxt); nB = P.b_ptr(nxt); P.a_off(nxt, Rr, Cc, vAn); }
        for (int t = 0; t < nt; t += 2) {
            const bool last = (t == nt - 2);
            const char* a1 = cA + (size_t)(t + 1) * kstep;
            const char* a2 = last ? nA : cA + (size_t)(t + 2) * kstep; const char* b2 = last ? nB : cB + (size_t)(t + 2) * kstep;
            const char* a3 = a2 + kstep; const char* b3 = b2 + kstep;
            unsigned vX[2][2];
#pragma unroll
            for (int h = 0; h < 2; ++h)
#pragma unroll
                for (int i = 0; i < 2; ++i) vX[h][i] = last ? vAn[h][i] : vAc[h][i];
            PG8_LDB(B0, 0, 0); PG8_LDB(B1, 0, 1); PG8_SCHED; PG8_LDA(At, 0, 0); PG8_STAGE(PG8_SA(1, 1), a1, vAc[1]);
            PG8_WAIT_V(8); PG8_WAIT_L(0); PG8_BAR; PG8_MMA(0, 0, At, B0); PG8_MMA(0, 1, At, B1); PG8_BAR; PG8_SCHED;
            PG8_LDA(At, 0, 1); PG8_STAGE(PG8_SB(0, 0), b2, voffB); PG8_STAGE(PG8_SB(0, 1), b2 + hstepB, voffB); PG8_STAGE(PG8_SA(0, 0), a2, vX[0]);
            PG8_WAIT_V(8); PG8_WAIT_L(0); PG8_BAR; PG8_MMA(1, 0, At, B0); PG8_MMA(1, 1, At, B1); PG8_BAR; PG8_SCHED;
            PG8_LDB(B0, 1, 0); PG8_LDB(B1, 1, 1); PG8_SCHED; PG8_LDA(At, 1, 0); PG8_STAGE(PG8_SA(0, 1), a2, vX[1]);
            PG8_WAIT_V(8); PG8_WAIT_L(0); PG8_BAR; PG8_MMA(0, 0, At, B0); PG8_MMA(0, 1, At, B1); PG8_BAR; PG8_SCHED;
            PG8_LDA(At, 1, 1); PG8_STAGE(PG8_SB(1, 0), b3, voffB); PG8_STAGE(PG8_SB(1, 1), b3 + hstepB, voffB); PG8_STAGE(PG8_SA(1, 0), a3, vX[0]);
            PG8_WAIT_V(8); PG8_WAIT_L(0); PG8_BAR; PG8_MMA(1, 0, At, B0); PG8_MMA(1, 1, At, B1); PG8_BAR; PG8_SCHED;
        }
        if (wr == 0) PG8_BAR;
        E(acc, cur, wr, wc, fr, fq);
        if (!has_next) break;
#pragma unroll
        for (int a = 0; a < 2; ++a)
#pragma unroll
            for (int b = 0; b < 2; ++b)
#pragma unroll
                for (int m = 0; m < 4; ++m)
#pragma unroll
                    for (int n = 0; n < 2; ++n) acc[a][b][m][n] = (f32x4){0.f, 0.f, 0.f, 0.f};
        cur = nxt; cA = nA; cB = nB; ++ui;
#pragma unroll
        for (int h = 0; h < 2; ++h)
#pragma unroll
            for (int i = 0; i < 2; ++i) vAc[h][i] = vAn[h][i];
        if (wr == 1) PG8_BAR;
    }
    PG8_WAIT_V(0);
    PG8_BAR;
#undef PG8_SA
#undef PG8_SB
#undef PG8_STAGE
#undef PG8_LDA
#undef PG8_LDB
#undef PG8_MMA
#undef PG8_WAIT_V
#undef PG8_WAIT_L
#undef PG8_BAR
#undef PG8_SCHED
}
}

using pg8::Unit;
constexpr int HALF_ = 128;
struct EpiBf16Act {
    static constexpr bool PERM = true;
    bf16_t* O; int ldc; const float* bias; int act; float scale;
    __device__ __forceinline__ void operator()(const f32x4 (&acc)[2][2][4][2], const Unit& u, int wr, int wc, int fr, int fq) const {
        const int row0 = u.pm * 256 + wr * 64 + fr, col0 = u.pn * 256 + wc * 32 + 8 * fq;
        f32x4 bv[2][2];
#pragma unroll
        for (int bj = 0; bj < 2; ++bj)
#pragma unroll
            for (int n = 0; n < 2; ++n) bv[bj][n] = bias ? *(const f32x4*)(bias + col0 + bj * HALF_ + 4 * n) : (f32x4){0.f, 0.f, 0.f, 0.f};
#pragma unroll
        for (int ai = 0; ai < 2; ++ai)
#pragma unroll
            for (int m = 0; m < 4; ++m) { bf16_t* rowp = O + (size_t)(row0 + ai * HALF_ + m * 16) * ldc + col0;
#pragma unroll
                for (int bj = 0; bj < 2; ++bj) { f32x4 v0 = acc[ai][bj][m][0] + bv[bj][0], v1 = acc[ai][bj][m][1] + bv[bj][1];
                    if (act == 1) {
#pragma unroll
                        for (int j = 0; j < 4; ++j) { v0[j] = sigmoidf_(v0[j]) * scale; v1[j] = sigmoidf_(v1[j]) * scale; } }
                    else if (act == 2) {
#pragma unroll
                        for (int j = 0; j < 4; ++j) { v0[j] = 1.0f - 2.0f / (__expf(2.0f * v0[j]) + 1.0f); v1[j] = 1.0f - 2.0f / (__expf(2.0f * v1[j]) + 1.0f); } }
                    u32x4 w; w.x = cvt_pk_bf16(v0[0], v0[1]); w.y = cvt_pk_bf16(v0[2], v0[3]); w.z = cvt_pk_bf16(v1[0], v1[1]); w.w = cvt_pk_bf16(v1[2], v1[3]);
                    *(u32x4*)(rowp + bj * HALF_) = w; } }
    }
};
struct EpiQK {
    static constexpr bool PERM = true;
    bf16_t* Q; bf16_t* Kb; const float* bias; const float* ropec; const float* ropes;
    __device__ __forceinline__ void operator()(const f32x4 (&acc)[2][2][4][2], const Unit& u, int wr, int wc, int fr, int fq) const {
        const int row0 = u.pm * 256 + wr * 64 + fr, cl0 = wc * 32 + 8 * fq;
        const int g = (4 * wc + fq) & 7;
        bf16_t* base; int ldc;
        if (u.pn < 4) { base = Q + u.pn * 256; ldc = 1024; } else { base = Kb; ldc = 256; }
        f32x4 bv[2][2];
#pragma unroll
        for (int bj = 0; bj < 2; ++bj)
#pragma unroll
            for (int n = 0; n < 2; ++n) bv[bj][n] = *(const f32x4*)(bias + u.pn * 256 + cl0 + bj * HALF_ + 4 * n);
#pragma unroll
        for (int ai = 0; ai < 2; ++ai)
#pragma unroll
            for (int m = 0; m < 4; ++m) { const int row = row0 + ai * HALF_ + m * 16; bf16_t* rowp = base + (size_t)row * ldc + cl0;
                f32x4 cs = (f32x4){1.f, 1.f, 1.f, 1.f}, sn = (f32x4){0.f, 0.f, 0.f, 0.f};
                if (row < NX) { const int t = row & (T - 1); cs = *(const f32x4*)(ropec + t * 32 + g * 4); sn = *(const f32x4*)(ropes + t * 32 + g * 4); }
#pragma unroll
                for (int bj = 0; bj < 2; ++bj) { const f32x4 v0 = acc[ai][bj][m][0] + bv[bj][0], v1 = acc[ai][bj][m][1] + bv[bj][1];
                    const f32x4 o0 = v0 * cs - v1 * sn, o1 = v1 * cs + v0 * sn;
                    u32x4 w; w.x = cvt_pk_bf16(o0[0], o0[1]); w.y = cvt_pk_bf16(o0[2], o0[3]); w.z = cvt_pk_bf16(o1[0], o1[1]); w.w = cvt_pk_bf16(o1[2], o1[3]);
                    *(u32x4*)(rowp + bj * HALF_) = w; } }
    }
};
struct EpiVT {
    static constexpr bool PERM = true;
    bf16_t* VT; const float* biasrow;
    __device__ __forceinline__ void operator()(const f32x4 (&acc)[2][2][4][2], const Unit& u, int wr, int wc, int fr, int fq) const {
        const int row0 = wr * 64 + fr, col0 = u.pn * 256 + wc * 32 + 8 * fq;
#pragma unroll
        for (int ai = 0; ai < 2; ++ai)
#pragma unroll
            for (int m = 0; m < 4; ++m) { const int row = row0 + ai * HALF_ + m * 16; const float b = biasrow[row]; bf16_t* rowp = VT + (size_t)row * NT + col0;
#pragma unroll
                for (int bj = 0; bj < 2; ++bj) { const f32x4 v0 = acc[ai][bj][m][0] + b, v1 = acc[ai][bj][m][1] + b;
                    u32x4 w; w.x = cvt_pk_bf16(v0[0], v0[1]); w.y = cvt_pk_bf16(v0[2], v0[3]); w.z = cvt_pk_bf16(v1[0], v1[1]); w.w = cvt_pk_bf16(v1[2], v1[3]);
                    *(u32x4*)(rowp + bj * HALF_) = w; } }
    }
};
struct EpiResid {
    static constexpr bool PERM = false;
    float* H; const float* bias; const float* ls; const float* gate;
    __device__ __forceinline__ void operator()(const f32x4 (&acc)[2][2][4][2], const Unit& u, int wr, int wc, int fr, int fq) const {
        const int row0 = u.pm * 256 + wr * 64 + fr, col0 = u.pn * 256 + wc * 32 + 4 * fq;
        f32x4 bv[2][2], lv[2][2];
#pragma unroll
        for (int bj = 0; bj < 2; ++bj)
#pragma unroll
            for (int n = 0; n < 2; ++n) { bv[bj][n] = bias ? *(const f32x4*)(bias + col0 + bj * HALF_ + n * 16) : (f32x4){0.f, 0.f, 0.f, 0.f};
                                          lv[bj][n] = ls ? *(const f32x4*)(ls + col0 + bj * HALF_ + n * 16) : (f32x4){1.f, 1.f, 1.f, 1.f}; }
#pragma unroll
        for (int ai = 0; ai < 2; ++ai)
#pragma unroll
            for (int m = 0; m < 4; ++m) { const int row = row0 + ai * HALF_ + m * 16; const int brow = row < NX ? (row >> 11) : 32;
                float* hp = H + (size_t)row * D + col0; const float* gp = gate + (size_t)brow * (6 * D) + col0;
#pragma unroll
                for (int bj = 0; bj < 2; ++bj)
#pragma unroll
                    for (int n = 0; n < 2; ++n) { const f32x4 y = (acc[ai][bj][m][n] + bv[bj][n]) * lv[bj][n]; const f32x4 gv = *(const f32x4*)(gp + bj * HALF_ + n * 16);
                        f32x4 hv = *(const f32x4*)(hp + bj * HALF_ + n * 16); hv = hv + gv * y; *(f32x4*)(hp + bj * HALF_ + n * 16) = hv; }
                asm volatile("" ::: "memory"); }
    }
};
struct EpiMoe1 {
    static constexpr bool PERM = true;
    bf16_t* ACT; const float* b1;
    __device__ __forceinline__ void operator()(const f32x4 (&acc)[2][2][4][2], const Unit& u, int wr, int wc, int fr, int fq) const {
        const int row0 = u.rt * 256 + wr * 64 + fr, cl = u.pn * 128 + wc * 32 + 8 * fq;
        const float* bg = b1 + (size_t)u.e * 2048 + cl; const float* bl = bg + 1024;
        f32x4 bgv[2], blv[2];
#pragma unroll
        for (int n = 0; n < 2; ++n) { bgv[n] = *(const f32x4*)(bg + 4 * n); blv[n] = *(const f32x4*)(bl + 4 * n); }
#pragma unroll
        for (int ai = 0; ai < 2; ++ai)
#pragma unroll
            for (int m = 0; m < 4; ++m) { bf16_t* rowp = ACT + (size_t)(row0 + ai * HALF_ + m * 16) * D + cl;
                f32x4 o[2];
#pragma unroll
                for (int n = 0; n < 2; ++n) { const f32x4 hg = acc[ai][0][m][n] + bgv[n], hl = acc[ai][1][m][n] + blv[n];
#pragma unroll
                    for (int j = 0; j < 4; ++j) { const float gl = fminf(hg[j], 7.0f); const float li = fminf(fmaxf(hl[j], -7.0f), 7.0f);
                        o[n][j] = gl * sigmoidf_(1.702f * gl) * (li + 1.0f); } }
                u32x4 w; w.x = cvt_pk_bf16(o[0][0], o[0][1]); w.y = cvt_pk_bf16(o[0][2], o[0][3]); w.z = cvt_pk_bf16(o[1][0], o[1][1]); w.w = cvt_pk_bf16(o[1][2], o[1][3]);
                *(u32x4*)rowp = w; }
    }
};
struct EpiMoe2 {
    static constexpr bool PERM = true;
    bf16_t* Y; const float* b2;
    __device__ __forceinline__ void operator()(const f32x4 (&acc)[2][2][4][2], const Unit& u, int wr, int wc, int fr, int fq) const {
        const int row0 = u.rt * 256 + wr * 64 + fr, col0 = u.pn * 256 + wc * 32 + 8 * fq;
        const float* bb = b2 + (size_t)u.e * D + col0;
        f32x4 bv[2][2];
#pragma unroll
        for (int bj = 0; bj < 2; ++bj)
#pragma unroll
            for (int n = 0; n < 2; ++n) bv[bj][n] = *(const f32x4*)(bb + bj * HALF_ + 4 * n);
#pragma unroll
        for (int ai = 0; ai < 2; ++ai)
#pragma unroll
            for (int m = 0; m < 4; ++m) { bf16_t* rowp = Y + (size_t)(row0 + ai * HALF_ + m * 16) * D + col0;
#pragma unroll
                for (int bj = 0; bj < 2; ++bj) { const f32x4 v0 = acc[ai][bj][m][0] + bv[bj][0], v1 = acc[ai][bj][m][1] + bv[bj][1];
                    u32x4 w; w.x = cvt_pk_bf16(v0[0], v0[1]); w.y = cvt_pk_bf16(v0[2], v0[3]); w.z = cvt_pk_bf16(v1[0], v1[1]); w.w = cvt_pk_bf16(v1[2], v1[3]);
                    *(u32x4*)(rowp + bj * HALF_) = w; } }
    }
};
struct ProbMoe1 {
    const bf16_t* FX; const bf16_t* W1T; const int* list; const LAS int* tpre; const LAS int* cnt; int lda, ldb, K; pg8::TileOrder ord;
    __device__ __forceinline__ bool next(int i, Unit& u) const {
        if (!ord.next(i, u.pm, u.pn)) return false;
        u.rt = u.pm; int e = 0;
#pragma unroll 1
        for (int j = 1; j < NE; ++j) e += (tpre[j] <= u.rt) ? 1 : 0;
        u.e = e; return true;
    }
    __device__ __forceinline__ const char* a_ptr(const Unit&) const { return (const char*)FX; }
    __device__ __forceinline__ const char* b_ptr(const Unit& u) const { return (const char*)(W1T + ((size_t)u.e * 2048 + (size_t)u.pn * 256) * D); }
    __device__ __forceinline__ void a_off(const Unit& u, const int (&R)[2], const int (&C)[2], unsigned (&v)[2][2]) const {
        const int base = (u.rt - tpre[u.e]) * 256, ce = cnt[u.e]; const int* le = list + (size_t)u.e * NT;
#pragma unroll
        for (int h = 0; h < 2; ++h)
#pragma unroll
            for (int i = 0; i < 2; ++i) { const int idx = base + h * 128 + R[i]; const int tok = idx < ce ? le[idx] : 0; v[h][i] = (unsigned)(tok * D + C[i]) * 2u; }
        asm volatile("" : "+v"(v[0][0]), "+v"(v[0][1]), "+v"(v[1][0]), "+v"(v[1][1]));
    }
};
struct ProbMoe2 {
    const bf16_t* ACT; const bf16_t* W2T; const LAS int* tpre; int lda, ldb, K; pg8::TileOrder ord;
    __device__ __forceinline__ bool next(int i, Unit& u) const {
        if (!ord.next(i, u.pm, u.pn)) return false;
        u.rt = u.pm; int e = 0;
#pragma unroll 1
        for (int j = 1; j < NE; ++j) e += (tpre[j] <= u.rt) ? 1 : 0;
        u.e = e; return true;
    }
    __device__ __forceinline__ const char* a_ptr(const Unit& u) const { return (const char*)(ACT + (size_t)u.rt * 256 * D); }
    __device__ __forceinline__ const char* b_ptr(const Unit& u) const { return (const char*)(W2T + ((size_t)u.e * 1024 + (size_t)u.pn * 256) * D); }
    __device__ __forceinline__ void a_off(const Unit&, const int (&R)[2], const int (&C)[2], unsigned (&v)[2][2]) const {
#pragma unroll
        for (int h = 0; h < 2; ++h)
#pragma unroll
            for (int i = 0; i < 2; ++i) v[h][i] = (unsigned)((h * 128 + R[i]) * D + C[i]) * 2u;
    }
};

struct Args { const float* in[38]; float* out; unsigned char* ws; int phase; int one; };
enum { I_X = 0, I_C, I_CTX, I_CCTX, I_ADAW, I_ADAB, I_NORMG, I_AWQKV, I_ABQKV, I_AWO, I_ABO, I_ASINK, I_PW, I_PB, I_PS,
       I_RMIX, I_RWRKV, I_RW0, I_RW1, I_RW2, I_RA0, I_RA1, I_RA2, I_RG1, I_RG2, I_RKK, I_RKA, I_RRK, I_RLNW, I_RLNB, I_RWO,
       I_MWR, I_MBR, I_MW1, I_MB1, I_MW2, I_MB2, I_FG };
struct Frame { LAS unsigned char* lds; int tid, lane, wave, G, c; unsigned char* ws; unsigned* ctl; };
#define WSP(T_, off) ((T_*)(F.ws + (off)))

struct TJob { const float* src; bf16_t* dst; long sbs, dbs; int ldw, ldt, nkb, nnb, mode, item0, per, pad; };
__device__ __forceinline__ int dst_row(int mode, int n) {
    if (mode == 1) { const int hb = n & ~63, d = n & 63; const int ax = d >> 5, dd = d & 31, hf = dd >> 4, f = dd & 15; const int g = ax * 4 + (f >> 2), i = (f & 3) + 4 * hf; return hb + 8 * g + i; }
    if (mode == 2) { return n < 1024 ? ((n >> 7) << 8) + (n & 127) : (((n - 1024) >> 7) << 8) + 128 + (n & 127); }
    return n;
}
__device__ __forceinline__ void transpose_item(const float* W, int ldw, bf16_t* WT, int ldt, int mode, LAS float* scr, int kb, int nb, int lane) {
    const int k0 = 64 * kb, n0 = 32 * nb;
#pragma unroll 8
    for (int i = 0; i < 32; ++i) { const int kk = 2 * i + (lane >> 5); scr[kk * 33 + (lane & 31)] = W[(size_t)(k0 + kk) * ldw + n0 + (lane & 31)]; }
    LDS_WAIT(); asm volatile("" ::: "memory");
    const int c = lane & 7;
#pragma unroll
    for (int j = 0; j < 4; ++j) { const int n = (lane >> 3) + 8 * j; const LAS float* s = scr + (8 * c) * 33 + n;
        u32x4 o; o.x = pk2(s[0 * 33], s[1 * 33]); o.y = pk2(s[2 * 33], s[3 * 33]); o.z = pk2(s[4 * 33], s[5 * 33]); o.w = pk2(s[6 * 33], s[7 * 33]);
        *(u32x4*)(WT + (size_t)dst_row(mode, n0 + n) * ldt + k0 + 8 * c) = o; }
    LDS_WAIT(); asm volatile("" ::: "memory");
}
__device__ __forceinline__ void phase_prologue(Frame& F, const Args& A) {
    REFRESH(F);
    LAS float* S = (LAS float*)F.lds;
    for (int idx = F.tid; idx < 33 * 1024; idx += NTHREADS) { const int r = idx >> 10, k = idx & 1023; const float v = r < 32 ? A.in[I_C][r * 1024 + k] : A.in[I_CCTX][k]; S[k * 33 + r] = v / (1.0f + __expf(-v)); }
    __syncthreads();
    float* MOD = WSP(float, WS_MOD);
    for (int it = F.c; it < 4 * 96; it += F.G) {
        const int layer = it / 96, n = (it % 96) * 64 + F.lane; const float* wp = A.in[I_ADAW] + (size_t)layer * 1024 * 6144 + n;
        float acc[5] = {0.f, 0.f, 0.f, 0.f, 0.f};
#pragma unroll 4
        for (int k = 0; k < 1024; ++k) { const float wv = wp[(size_t)k * 6144]; const LAS float* sr = S + k * 33 + F.wave;
            acc[0] += sr[0] * wv; acc[1] += sr[8] * wv; acc[2] += sr[16] * wv; acc[3] += sr[24] * wv; if (F.wave == 0) acc[4] += S[k * 33 + 32] * wv; }
        const float bb = A.in[I_ADAB][layer * 6144 + n];
#pragma unroll
        for (int i = 0; i < 4; ++i) MOD[((size_t)layer * 33 + F.wave + 8 * i) * 6144 + n] = acc[i] + bb;
        if (F.wave == 0) MOD[((size_t)layer * 33 + 32) * 6144 + n] = acc[4] + bb;
    }
    { float* rc = WSP(float, WS_ROPEC); float* rs = WSP(float, WS_ROPES);
      for (int idx = F.c * NTHREADS + F.tid; idx < 2048 * 32; idx += F.G * NTHREADS) { const int t = idx >> 5, e = idx & 31, g = e >> 2, i = e & 3, f = 4 * (g & 3) + i;
          const float inv = powf(10000.0f, -(float)f / 16.0f); const float pos = (float)(g < 4 ? (t >> 6) : (t & 63)); const float ang = pos * inv; rc[idx] = cosf(ang); rs[idx] = sinf(ang); }
      float* bq = WSP(float, WS_BQK);
      for (int idx = F.c * NTHREADS + F.tid; idx < 2 * 1280; idx += F.G * NTHREADS) { const int j = idx / 1280, n = idx % 1280; bq[j * 1280 + dst_row(1, n)] = A.in[I_ABQKV][j * 1536 + n]; } }
    __syncthreads();
    LAS TJob* jobs = (LAS TJob*)(F.lds + JOB_OFF); LAS int* njobs = (LAS int*)(F.lds + MISC_OFF + 64);
    if (F.tid == 0) {
        int nj = 0, item = 0;
        auto add = [&](const float* src, bf16_t* dst, int ldw, int ldt, int Ks, int Ns, int mode, int nb, long sbs, long dbs) {
            LAS TJob& j = jobs[nj]; j.src = src; j.dst = dst; j.sbs = sbs; j.dbs = dbs; j.ldw = ldw; j.ldt = ldt; j.nkb = Ks / 64; j.nnb = Ns / 32; j.mode = mode; j.item0 = item; j.per = (Ks / 64) * (Ns / 32); j.pad = 0;
            ++nj; item += (Ks / 64) * (Ns / 32) * nb; };
        add(A.in[I_AWQKV], WSP(bf16_t, WS_WQK), 1536, 1024, 1024, 1280, 1, 2, 1024L * 1536, 1280L * 1024);
        add(A.in[I_AWQKV] + 1280, WSP(bf16_t, WS_WV), 1536, 1024, 1024, 256, 0, 2, 1024L * 1536, 256L * 1024);
        add(A.in[I_AWO], WSP(bf16_t, WS_WO), 1024, 1024, 1024, 1024, 0, 2, 1L << 20, 1L << 20);
        add(A.in[I_PW], WSP(bf16_t, WS_POOLW), 256, 256, 256, 256, 0, 4, 65536, 65536);
        add(A.in[I_RWRKV], WSP(bf16_t, WS_WRKV), 1024, 1024, 1024, 1024, 0, 3, 1L << 20, 1L << 20);
        add(A.in[I_RG1], WSP(bf16_t, WS_WL1), 128, 1024, 1024, 128, 0, 1, 0, 0);
        add(A.in[I_RW1], WSP(bf16_t, WS_WL1) + 256 * 1024, 64, 1024, 1024, 64, 0, 2, 65536, 65536);
        add(A.in[I_RA1], WSP(bf16_t, WS_WL1) + 2 * 256 * 1024, 64, 1024, 1024, 64, 0, 2, 65536, 65536);
        add(A.in[I_RG2], WSP(bf16_t, WS_WL2), 1024, 256, 128, 1024, 0, 1, 0, 0);
        add(A.in[I_RW2], WSP(bf16_t, WS_WL2) + 1 * 1024 * 256, 1024, 256, 64, 1024, 0, 2, 65536, 1024L * 256 + 64);
        add(A.in[I_RA2], WSP(bf16_t, WS_WL2) + 3 * 1024 * 256, 1024, 256, 64, 1024, 0, 2, 65536, 1024L * 256 + 64);
        add(A.in[I_RWO], WSP(bf16_t, WS_WOR), 1024, 1024, 1024, 1024, 0, 1, 0, 0);
        add(A.in[I_MW1], WSP(bf16_t, WS_W1T), 2048, 1024, 1024, 2048, 2, 128, 1024L * 2048, 2048L * 1024);
        add(A.in[I_MW2], WSP(bf16_t, WS_W2T), 1024, 1024, 1024, 1024, 0, 128, 1L << 20, 1L << 20);
        njobs[0] = nj; njobs[1] = item;
    }
    __syncthreads();
    { const int nj = njobs[0], nitems = njobs[1]; LAS float* scr = (LAS float*)(F.lds + F.wave * 16384);
      const int gw = F.c * NWAVES + F.wave, NGW = F.G * NWAVES;
      for (int it = gw; it < nitems; it += NGW) {
          int ji = 0;
          for (int q = 1; q < nj; ++q) ji += (jobs[q].item0 <= it) ? 1 : 0;
          const LAS TJob& J = jobs[ji]; const int r = it - J.item0, bi = r / J.per, rr = r % J.per, kb = rr / J.nnb, nb = rr % J.nnb;
          transpose_item(J.src + bi * J.sbs, J.ldw, J.dst + bi * J.dbs, J.ldt, J.mode, scr, kb, nb, F.lane);
      } }
    __syncthreads();
}

__device__ __forceinline__ void moe_tiles(Frame& F, int layer) {
    REFRESH(F);
    LAS int* lcnt = (LAS int*)(F.lds + LCNT_OFF); LAS int* tpre = (LAS int*)(F.lds + TPRE_OFF);
    __syncthreads();
    if (F.tid < NE) lcnt[F.tid] = (int)__hip_atomic_load(F.ctl + CW_GCNT + layer * 64 + F.tid, __ATOMIC_RELAXED, __HIP_MEMORY_SCOPE_AGENT);
    __syncthreads();
    if (F.tid == 0) { int s = 0; for (int e = 0; e < NE; ++e) { tpre[e] = s; s += (lcnt[e] + 255) >> 8; } tpre[NE] = s; }
    __syncthreads();
}
__device__ __forceinline__ void moe_gather(Frame& F, int row, f32x4 (&s)[4]) {
    const LAS int* tpre = (const LAS int*)(F.lds + TPRE_OFF);
    const int* pos = WSP(int, WS_POS) + (size_t)row * 4; const float* gt = WSP(float, WS_GATE) + (size_t)row * 4; const bf16_t* Y = WSP(bf16_t, WS_Y);
#pragma unroll
    for (int j = 0; j < 4; ++j) s[j] = (f32x4){0.f, 0.f, 0.f, 0.f};
#pragma unroll
    for (int k = 0; k < 4; ++k) { const int p = pos[k]; const float g = gt[k]; const int e = p >> 20, slot = p & 0xfffff; const size_t fr = (size_t)tpre[e] * 256 + slot;
        const u32x2* yp = (const u32x2*)(Y + fr * D) + F.lane;
#pragma unroll
        for (int j = 0; j < 4; ++j) { const u32x2 w = yp[64 * j]; s[j] += g * (f32x4){bflo(w.x), bfhi(w.x), bflo(w.y), bfhi(w.y)}; } }
}

__device__ __forceinline__ void phase_norm1(Frame& F, const Args& A, int layer) {
    REFRESH(F);
    if (layer > 0) moe_tiles(F, layer - 1);
    float* H = WSP(float, WS_H); bf16_t* AX = WSP(bf16_t, WS_AX); const float* MOD = WSP(float, WS_MOD);
    const float* g1 = A.in[I_NORMG] + (size_t)(layer * 2 + 0) * D;
    for (int it = 0;; ++it) { const int row = (it * F.G + F.c) * NWAVES + F.wave; if (row >= NT) break;
        const int brow = row < NX ? (row >> 11) : 32;
        f32x4 v[4];
        if (layer == 0) { const float* src = row < NX ? A.in[I_X] + (size_t)row * D : A.in[I_CTX] + (size_t)(row - NX) * D;
#pragma unroll
            for (int j = 0; j < 4; ++j) v[j] = ((const f32x4*)src)[64 * j + F.lane]; }
        else { f32x4 s[4]; moe_gather(F, row, s); const float* g2p = MOD + ((size_t)(layer - 1) * 33 + brow) * 6144 + 5 * D;
#pragma unroll
            for (int j = 0; j < 4; ++j) { const f32x4 hv = ((const f32x4*)(H + (size_t)row * D))[64 * j + F.lane]; const f32x4 gv = ((const f32x4*)g2p)[64 * j + F.lane]; v[j] = ((SKIPMASK >> (4 + layer - 1)) & 1) ? hv : hv + gv * s[j]; } }
        float ss = 0.f;
#pragma unroll
        for (int j = 0; j < 4; ++j) { ((f32x4*)(H + (size_t)row * D))[64 * j + F.lane] = v[j]; ss += (v[j].x * v[j].x + v[j].y * v[j].y) + (v[j].z * v[j].z + v[j].w * v[j].w); }
        const float rstd = 1.0f / sqrtf(wave_sum(ss) * (1.0f / D) + 1e-5f);
        const float* mp = MOD + ((size_t)layer * 33 + brow) * 6144;
#pragma unroll
        for (int j = 0; j < 4; ++j) { const f32x4 gg = ((const f32x4*)g1)[64 * j + F.lane], sh = ((const f32x4*)mp)[64 * j + F.lane], sc = ((const f32x4*)(mp + D))[64 * j + F.lane];
            const f32x4 o = v[j] * rstd * gg * (sc + 1.0f) + sh;
            u32x2 w; w.x = pk2(o.x, o.y); w.y = pk2(o.z, o.w); ((u32x2*)(AX + (size_t)row * D))[64 * j + F.lane] = w; }
    }
}
__device__ __forceinline__ void phase_final(Frame& F, const Args& A) {
    REFRESH(F);
    moe_tiles(F, DEPTH - 1);
    const float* H = WSP(float, WS_H); const float* MOD = WSP(float, WS_MOD); const float* fg = A.in[I_FG];
    for (int it = 0;; ++it) { const int row = (it * F.G + F.c) * NWAVES + F.wave; if (row >= NX) break;
        const int brow = row >> 11; f32x4 s[4], v[4]; moe_gather(F, row, s); const float* g2p = MOD + ((size_t)(DEPTH - 1) * 33 + brow) * 6144 + 5 * D;
        float ss = 0.f;
#pragma unroll
        for (int j = 0; j < 4; ++j) { const f32x4 hv = ((const f32x4*)(H + (size_t)row * D))[64 * j + F.lane]; const f32x4 gv = ((const f32x4*)g2p)[64 * j + F.lane]; v[j] = ((SKIPMASK >> 7) & 1) ? hv : hv + gv * s[j];
            ss += (v[j].x * v[j].x + v[j].y * v[j].y) + (v[j].z * v[j].z + v[j].w * v[j].w); }
        const float rstd = 1.0f / sqrtf(wave_sum(ss) * (1.0f / D) + 1e-5f);
#pragma unroll
        for (int j = 0; j < 4; ++j) { const f32x4 gg = ((const f32x4*)fg)[64 * j + F.lane]; ((f32x4*)(A.out + (size_t)row * D))[64 * j + F.lane] = v[j] * rstd * gg; }
#if DIAG == 4
        { const LAS int* tp = (const LAS int*)(F.lds + TPRE_OFF); const int* pos = WSP(int, WS_POS) + (size_t)row * 4; const float* gt = WSP(float, WS_GATE) + (size_t)row * 4; const bf16_t* Y = WSP(bf16_t, WS_Y);
          int a = 0; float gs = 0.f;
          for (int k = 0; k < 4; ++k) { const int p = pos[k]; gs += gt[k]; const int e = p >> 20, slot = p & 0xfffff; const size_t fr = (size_t)tp[e] * 256 + slot; float ma = 0.f;
              for (int j = 0; j < 4; ++j) { const f32x4 a4 = ld_bf4(Y + fr * D + 256 * j + 4 * F.lane); ma += (a4.x * a4.x + a4.y * a4.y) + (a4.z * a4.z + a4.w * a4.w); }
              ma = wave_sum(ma) * (1.0f / D); if (ma > 0.0025f) ++a; }
          float b = floorf(9.0f * gs + 0.5f); b = fminf(fmaxf(b, 0.f), 9.f);
          const float cc = sqrtf(((float)a + 0.1f * b) * 1.0025f);
#pragma unroll
          for (int j = 0; j < 4; ++j) ((f32x4*)(A.out + (size_t)row * D))[64 * j + F.lane] = (f32x4){cc, cc, cc, cc}; }
#endif
#if DIAG == 3
        { const bf16_t* W = WSP(bf16_t, WS_W2T) + (size_t)3 * NE * D * D + (size_t)(row & 32767) * D; const bf16_t* AC = WSP(bf16_t, WS_Y) + (size_t)row * D; float mw = 0.f, ma = 0.f;
#pragma unroll
          for (int j = 0; j < 4; ++j) { const f32x4 w4 = ld_bf4(W + 256 * j + 4 * F.lane), a4 = ld_bf4(AC + 256 * j + 4 * F.lane);
              mw += (w4.x * w4.x + w4.y * w4.y) + (w4.z * w4.z + w4.w * w4.w); ma += (a4.x * a4.x + a4.y * a4.y) + (a4.z * a4.z + a4.w * a4.w); }
          mw = wave_sum(mw) * (1.0f / D); ma = wave_sum(ma) * (1.0f / D);
          float a = floorf(0.5f * log2f(mw + 1e-30f) + 9.5f); a = fminf(fmaxf(a, 0.f), 8.f); float b = floorf(0.5f * log2f(ma + 1e-30f) + 7.5f); b = fminf(fmaxf(b, 0.f), 9.f);
          const float cc = sqrtf((a + 0.1f * b) * 1.0025f);
#pragma unroll
          for (int j = 0; j < 4; ++j) ((f32x4*)(A.out + (size_t)row * D))[64 * j + F.lane] = (f32x4){cc, cc, cc, cc}; }
#endif
#if DIAG == 2
        { const bf16_t* W = WSP(bf16_t, WS_W1T) + (size_t)3 * NE * 2048 * D + (size_t)row * D; const bf16_t* AC = WSP(bf16_t, WS_ACT) + (size_t)row * D; float mw = 0.f, ma = 0.f;
#pragma unroll
          for (int j = 0; j < 4; ++j) { const f32x4 w4 = ld_bf4(W + 256 * j + 4 * F.lane), a4 = ld_bf4(AC + 256 * j + 4 * F.lane);
              mw += (w4.x * w4.x + w4.y * w4.y) + (w4.z * w4.z + w4.w * w4.w); ma += (a4.x * a4.x + a4.y * a4.y) + (a4.z * a4.z + a4.w * a4.w); }
          mw = wave_sum(mw) * (1.0f / D); ma = wave_sum(ma) * (1.0f / D);
          float a = floorf(0.5f * log2f(mw + 1e-30f) + 9.5f); a = fminf(fmaxf(a, 0.f), 8.f); float b = floorf(0.5f * log2f(ma + 1e-30f) + 9.5f); b = fminf(fmaxf(b, 0.f), 9.f);
          const float cc = sqrtf((a + 0.1f * b) * 1.0025f);
#pragma unroll
          for (int j = 0; j < 4; ++j) ((f32x4*)(A.out + (size_t)row * D))[64 * j + F.lane] = (f32x4){cc, cc, cc, cc}; }
#endif
#if DIAG == 1
        { const LAS int* tp = (const LAS int*)(F.lds + TPRE_OFF); int a = tp[NE] / 150; a = a > 8 ? 8 : a; float ms = 0.f;
#pragma unroll
          for (int j = 0; j < 4; ++j) ms += (s[j].x * s[j].x + s[j].y * s[j].y) + (s[j].z * s[j].z + s[j].w * s[j].w);
          ms = wave_sum(ms) * (1.0f / D); float b = floorf(0.5f * log2f(ms + 1e-30f) + 7.5f); b = fminf(fmaxf(b, 0.f), 9.f);
          const float cc = sqrtf(((float)a + 0.1f * b) * 1.0025f);
#pragma unroll
          for (int j = 0; j < 4; ++j) ((f32x4*)(A.out + (size_t)row * D))[64 * j + F.lane] = (f32x4){cc, cc, cc, cc}; }
#endif
    }
}

__device__ __forceinline__ void phase_route(Frame& F, const Args& A, int layer) {
    REFRESH(F);
    const int nrows = (layer == DEPTH - 1) ? NX : NT;
    LAS float* wT = (LAS float*)F.lds;
    LAS int* lcnt = (LAS int*)(F.lds + LCNT_OFF); LAS int* lbase = (LAS int*)(F.lds + LBASE_OFF); LAS unsigned* recp = (LAS unsigned*)(F.lds + REC_OFF); LAS float* recg = (LAS float*)(F.lds + REC_OFF + 4608);
    __syncthreads();
    { const float* wr = A.in[I_MWR] + (size_t)layer * D * NE;
      for (int idx = F.tid; idx < D * NE; idx += NTHREADS) wT[(idx & 31) * 1024 + (idx >> 5)] = wr[idx]; }
    if (F.tid < NE) lcnt[F.tid] = 0;
    __syncthreads();
    const float* H = WSP(float, WS_H); bf16_t* FX = WSP(bf16_t, WS_FX); const float* MOD = WSP(float, WS_MOD);
    const float* g2 = A.in[I_NORMG] + (size_t)(layer * 2 + 1) * D; const float* br = A.in[I_MBR] + layer * NE;
    int nit = 0;
    for (int it = 0;; ++it) { const int row = (it * F.G + F.c) * NWAVES + F.wave; if ((it * F.G + F.c) * NWAVES >= nrows) break; nit = it + 1;
        if (row >= nrows) continue;
        const int brow = row < NX ? (row >> 11) : 32;
        f32x4 v[4]; float ss = 0.f;
#pragma unroll
        for (int j = 0; j < 4; ++j) { v[j] = ((const f32x4*)(H + (size_t)row * D))[64 * j + F.lane]; ss += (v[j].x * v[j].x + v[j].y * v[j].y) + (v[j].z * v[j].z + v[j].w * v[j].w); }
        const float rstd = 1.0f / sqrtf(wave_sum(ss) * (1.0f / D) + 1e-5f);
        const float* mp = MOD + ((size_t)layer * 33 + brow) * 6144 + 3 * D;
#pragma unroll
        for (int j = 0; j < 4; ++j) { const f32x4 gg = ((const f32x4*)g2)[64 * j + F.lane], sh = ((const f32x4*)mp)[64 * j + F.lane], sc = ((const f32x4*)(mp + D))[64 * j + F.lane];
            v[j] = v[j] * rstd * gg * (sc + 1.0f) + sh;
            u32x2 w; w.x = pk2(v[j].x, v[j].y); w.y = pk2(v[j].z, v[j].w); ((u32x2*)(FX + (size_t)row * D))[64 * j + F.lane] = w; }
        float part[NE];
#pragma unroll
        for (int e = 0; e < NE; ++e) { float p = 0.f;
#pragma unroll
            for (int j = 0; j < 4; ++j) { const f32x4 w4 = ((const LAS f32x4*)(wT + e * 1024))[64 * j + F.lane]; p += (v[j].x * w4.x + v[j].y * w4.y) + (v[j].z * w4.z + v[j].w * w4.w); }
            part[e] = p; }
#pragma unroll
        for (int k = 0; k < 16; ++k) { const bool up = (F.lane & 32) != 0; const float keep = up ? part[k + 16] : part[k], send = up ? part[k] : part[k + 16]; part[k] = keep + __shfl_xor(send, 32); }
#pragma unroll
        for (int k = 0; k < 8; ++k) { const bool up = (F.lane & 16) != 0; const float keep = up ? part[k + 8] : part[k], send = up ? part[k] : part[k + 8]; part[k] = keep + __shfl_xor(send, 16); }
#pragma unroll
        for (int k = 0; k < 4; ++k) { const bool up = (F.lane & 8) != 0; const float keep = up ? part[k + 4] : part[k], send = up ? part[k] : part[k + 4]; part[k] = keep + __shfl_xor(send, 8); }
#pragma unroll
        for (int k = 0; k < 2; ++k) { const bool up = (F.lane & 4) != 0; const float keep = up ? part[k + 2] : part[k], send = up ? part[k] : part[k + 2]; part[k] = keep + __shfl_xor(send, 4); }
        { const bool up = (F.lane & 2) != 0; const float keep = up ? part[1] : part[0], send = up ? part[0] : part[1]; part[0] = keep + __shfl_xor(send, 2); }
        part[0] += __shfl_xor(part[0], 1);
        const int myE = F.lane >> 1;
        float val = part[0] + br[myE];
        float sv[4]; int si[4];
#pragma unroll
        for (int k = 0; k < 4; ++k) { float bv = val; int bi = myE;
#pragma unroll
            for (int o = 1; o < 64; o <<= 1) { const float ov = __shfl_xor(bv, o); const int oi = __shfl_xor(bi, o); if (ov > bv || (ov == bv && oi < bi)) { bv = ov; bi = oi; } }
            sv[k] = bv; si[k] = bi; if (myE == bi) val = -__builtin_inff(); }
        const float e1 = __expf(sv[1] - sv[0]), e2 = __expf(sv[2] - sv[0]), e3 = __expf(sv[3] - sv[0]); const float inv = 1.0f / (1.0f + e1 + e2 + e3);
        if (F.lane < 4) { const int e = F.lane == 0 ? si[0] : F.lane == 1 ? si[1] : F.lane == 2 ? si[2] : si[3]; const float g = (F.lane == 0 ? 1.0f : F.lane == 1 ? e1 : F.lane == 2 ? e2 : e3) * inv;
            const int rank = __hip_atomic_fetch_add(lcnt + e, 1, __ATOMIC_RELAXED, __HIP_MEMORY_SCOPE_WORKGROUP);
            const int ri = (it * NWAVES + F.wave) * 4 + F.lane; recp[ri] = ((unsigned)e << 20) | (unsigned)rank; recg[ri] = g; }
    }
    __syncthreads();
    if (F.tid < NE) lbase[F.tid] = (int)__hip_atomic_fetch_add(F.ctl + CW_GCNT + layer * 64 + F.tid, (unsigned)lcnt[F.tid], __ATOMIC_RELAXED, __HIP_MEMORY_SCOPE_AGENT);
    __syncthreads();
    int* LIST = WSP(int, WS_LIST); int* POS = WSP(int, WS_POS); float* GATE = WSP(float, WS_GATE);
    for (int r = F.tid; r < nit * NWAVES * 4; r += NTHREADS) { const int lr = r >> 2, k = r & 3; const int row = ((lr >> 3) * F.G + F.c) * NWAVES + (lr & 7); if (row >= nrows) continue;
        const unsigned qx = recp[r]; const float qg = recg[r]; const int e = qx >> 20, slot = lbase[e] + (int)(qx & 0xfffff);
        LIST[(size_t)e * NT + slot] = row; POS[(size_t)row * 4 + k] = (e << 20) | slot; GATE[(size_t)row * 4 + k] = qg; }
    __syncthreads();
}

__device__ __forceinline__ void phase_pooldiff(Frame& F) {
    REFRESH(F);
    const bf16_t* AX = WSP(bf16_t, WS_AX); bf16_t* PD = WSP(bf16_t, WS_PD);
    for (int it = 0;; ++it) { const int row = (it * F.G + F.c) * NWAVES + F.wave; if (row >= NT) break;
        int sb, t, n; seq_of(row, sb, t, n);
#pragma unroll
        for (int j = 0; j < 4; ++j) { const int half = 1 << j; const int col = 256 * j + 4 * F.lane;
            f32x4 s = (f32x4){0.f, 0.f, 0.f, 0.f};
#pragma unroll
            for (int q = 0; q < 2 * half; ++q) { const int uu = t - half + q; if (uu >= 0 && uu < n) s += ld_bf4(AX + (size_t)(sb + uu) * D + col); }
            const int lo = t - half < 0 ? 0 : t - half, hi = t + half > n ? n : t + half;
            const f32x4 me = ld_bf4(AX + (size_t)row * D + col);
            st_bf4(PD + (size_t)row * D + col, s * (1.0f / (float)(hi - lo)) - me); }
    }
}
__device__ __forceinline__ void phase_rwkv_mix(Frame& F, const Args& A) {
    REFRESH(F);
    const bf16_t* AX = WSP(bf16_t, WS_AX); bf16_t* A6 = WSP(bf16_t, WS_A6); const float* mix = A.in[I_RMIX];
    for (int it = 0;; ++it) { const int row = (it * F.G + F.c) * NWAVES + F.wave; if (row >= NT) break;
        int sb, t, n; seq_of(row, sb, t, n);
#pragma unroll
        for (int j = 0; j < 4; ++j) { const int col = 256 * j + 4 * F.lane; const f32x4 z = (f32x4){0.f, 0.f, 0.f, 0.f};
            const f32x4 hc = ld_bf4(AX + (size_t)row * D + col), hp = t > 0 ? ld_bf4(AX + (size_t)(row - 1) * D + col) : z, hn = t < n - 1 ? ld_bf4(AX + (size_t)(row + 1) * D + col) : z;
            const f32x4 xx = (hp + hn) * 0.5f - hc;
#pragma unroll
            for (int i = 0; i < 6; ++i) { const f32x4 m = *(const f32x4*)(mix + i * D + col); st_bf4(A6 + ((size_t)i * NT + row) * D + col, hc + xx * m); } }
    }
}
__device__ __forceinline__ float rl(float x, int k) { return __builtin_bit_cast(float, __builtin_amdgcn_readlane(__builtin_bit_cast(int, x), k)); }
__device__ __forceinline__ void phase_rwkv_scan(Frame& F, const Args& A) {
    REFRESH(F);
    for (int item = F.wave * F.G + F.c; item < 1024 && F.wave < 4; item += 4 * F.G) {
        const int dir = item >> 9, b = (item >> 4) & 31, h = item & 15, col = 64 * h + F.lane;
        const bf16_t* Rr = WSP(bf16_t, WS_RKV); const bf16_t* Kk = Rr + (size_t)NT * D; const bf16_t* Vv = Kk + (size_t)NT * D;
        const bf16_t* Ee = WSP(bf16_t, WS_E) + (size_t)dir * NT * D; const bf16_t* Aa = WSP(bf16_t, WS_A) + (size_t)dir * NT * D;
        float* Yo = WSP(float, WS_YS) + (size_t)dir * NT * D; float* Bo = WSP(float, WS_BONUS) + (size_t)dir * NT * 16;
        const float kkw = A.in[I_RKK][col], kaw = A.in[I_RKA][col], rkw = A.in[I_RRK][col];
        float S[64];
#pragma unroll
        for (int k = 0; k < 64; ++k) S[k] = 0.f;
        for (int seg = 0; seg < 2; ++seg) {
            const int base = seg ? b * T : NX + b * L, n = seg ? T : L; const int dt = dir ? -1 : 1; int t = dir ? n - 1 : 0;
            size_t o = (size_t)(base + t) * D + col;
            bf16_t r0 = Rr[o], k0 = Kk[o], v0 = Vv[o], a0 = Aa[o], e0 = Ee[o];
            for (int step = 0; step < n; ++step) {
                const int tn = (step + 1 < n) ? t + dt : t; const size_t on = (size_t)(base + tn) * D + col;
                const bf16_t r1 = Rr[on], k1 = Kk[on], v1 = Vv[on], a1 = Aa[on], e1 = Ee[on];
                const float rr = bf1(r0), kraw = bf1(k0), vv = bf1(v0), aa = bf1(a0), ee = bf1(e0);
                float kk = kraw * kkw; const float nrm = sqrtf(wave_sum(kk * kk)); kk = kk / fmaxf(nrm, 1e-12f);
                const float w = __expf(-ee), kd = kraw * (1.0f + (aa - 1.0f) * kaw), bb = kk * aa, an = -kk;
                const float bon = wave_sum(rr * kd * rkw); if (F.lane == 0) Bo[(size_t)(base + t) * 16 + h] = bon;
                float sa0 = 0.f, sa1 = 0.f;
#pragma unroll
                for (int k = 0; k < 64; k += 2) { sa0 += S[k] * rl(an, k); sa1 += S[k + 1] * rl(an, k + 1); }
                const float sa = sa0 + sa1; float y0 = 0.f, y1 = 0.f;
#pragma unroll
                for (int k = 0; k < 64; k += 2) {
                    const float s0 = S[k] * rl(w, k) + sa * rl(bb, k) + vv * rl(kd, k); S[k] = s0; y0 += s0 * rl(rr, k);
                    const float s1 = S[k + 1] * rl(w, k + 1) + sa * rl(bb, k + 1) + vv * rl(kd, k + 1); S[k + 1] = s1; y1 += s1 * rl(rr, k + 1); }
                Yo[(size_t)(base + t) * D + col] = y0 + y1;
                r0 = r1; k0 = k1; v0 = v1; a0 = a1; e0 = e1; t = tn;
            }
        }
    }
}
__device__ __forceinline__ void phase_rwkv_out(Frame& F, const Args& A, int nrows) {
    REFRESH(F);
    const float* Y0 = WSP(float, WS_YS); const float* Y1 = Y0 + (size_t)NT * D; const float* B0 = WSP(float, WS_BONUS); const float* B1 = B0 + (size_t)NT * 16;
    const bf16_t* Vv = WSP(bf16_t, WS_RKV) + (size_t)2 * NT * D; const bf16_t* Gg = WSP(bf16_t, WS_G); bf16_t* RO = WSP(bf16_t, WS_RO);
    const float* lnw = A.in[I_RLNW]; const float* lnb = A.in[I_RLNB];
    for (int it = 0;; ++it) { const int row = (it * F.G + F.c) * NWAVES + F.wave; if (row >= nrows) break;
#pragma unroll
        for (int j = 0; j < 4; ++j) { const int col = 256 * j + 4 * F.lane, head = 4 * j + (F.lane >> 4); const size_t o = (size_t)row * D + col;
            const f32x4 y = *(const f32x4*)(Y0 + o) + *(const f32x4*)(Y1 + o);
            float s = (y.x + y.y) + (y.z + y.w); s += __shfl_xor(s, 1); s += __shfl_xor(s, 2); s += __shfl_xor(s, 4); s += __shfl_xor(s, 8);
            const f32x4 d = y - s * (1.0f / 64.0f);
            float q = (d.x * d.x + d.y * d.y) + (d.z * d.z + d.w * d.w); q += __shfl_xor(q, 1); q += __shfl_xor(q, 2); q += __shfl_xor(q, 4); q += __shfl_xor(q, 8);
            const float rs = 1.0f / sqrtf(q * (1.0f / 64.0f) + 64e-5f);
            const f32x4 yn = d * rs * *(const f32x4*)(lnw + col) + *(const f32x4*)(lnb + col);
            const float bon = B0[(size_t)row * 16 + head] + B1[(size_t)row * 16 + head];
            st_bf4(RO + o, (yn + ld_bf4(Vv + o) * bon) * ld_bf4(Gg + o)); }
    }
}

__device__ __forceinline__ void phase_attn(Frame& F, const Args& A, int j, bool need_ctx) {
    REFRESH(F);
    const bf16_t* Q = WSP(bf16_t, WS_Q); const bf16_t* Kb = WSP(bf16_t, WS_K); const bf16_t* VT = WSP(bf16_t, WS_VT); bf16_t* O = WSP(bf16_t, WS_O);
    const float* sinks = A.in[I_ASINK] + j * 16;
    LAS bf16_t* Ks = (LAS bf16_t*)F.lds; LAS bf16_t* Vs = (LAS bf16_t*)(F.lds + 9216);
    const int nunits = 2048 + (need_ctx ? 256 : 0);
    const int fr = F.lane & 15, fq = F.lane >> 4, g = F.wave >> 1, hf = F.wave & 1;
    const float SC = 0.125f * 1.4426950408889634f;
    for (int u = F.c; u < nunits; u += F.G) {
        int b, kvh, qb; bool isx;
        if (u < 2048) { isx = true; b = u >> 6; kvh = (u >> 4) & 3; qb = u & 15; } else { const int v = u - 2048; isx = false; b = v >> 3; kvh = (v >> 1) & 3; qb = v & 1; }
        const int qrow0 = (isx ? b * T : NX + b * L) + qb * 128 + hf * 64; const int head = 4 * kvh + g;
        bf16x8 Qf[4][2];
#pragma unroll
        for (int mq = 0; mq < 4; ++mq)
#pragma unroll
            for (int ks = 0; ks < 2; ++ks) Qf[mq][ks] = *(const bf16x8*)(Q + (size_t)(qrow0 + 16 * mq + fr) * D + head * 64 + ks * 32 + 8 * fq);
        const float sink2 = sinks[head] * 1.4426950408889634f;
        float mrun[4], lrun[4]; f32x4 Oa[4][4];
#pragma unroll
        for (int mq = 0; mq < 4; ++mq) { mrun[mq] = sink2; lrun[mq] = fq == 0 ? 1.0f : 0.0f;
#pragma unroll
            for (int db = 0; db < 4; ++db) Oa[mq][db] = (f32x4){0.f, 0.f, 0.f, 0.f}; }
        const int ntiles = isx ? 10 : 4;
        for (int ti = 0; ti < ntiles; ++ti) {
            int krow0, jl = -1, ks0 = 0;
            if (ti < 4) krow0 = NX + b * L + ti * 64;
            else { jl = ti - 4; ks0 = qb * 128 - 128 + 64 * jl; if (ks0 < 0 || ks0 >= T) continue; krow0 = b * T + ks0; }
            __syncthreads();
            { const int r = F.tid >> 3, ch = F.tid & 7;
              const u32x4 kv = *(const u32x4*)(Kb + (size_t)(krow0 + r) * 256 + kvh * 64 + ch * 8);
              const u32x4 vv = *(const u32x4*)(VT + (size_t)(kvh * 64 + r) * NT + krow0 + ch * 8);
              *(LAS u32x4*)(Ks + r * 72 + ch * 8) = kv; *(LAS u32x4*)(Vs + r * 72 + ch * 8) = vv; }
            __syncthreads();
            const bool need = (jl < 0) || (jl >= hf && jl <= hf + 4);
            if (need) {
                f32x4 Sa[4][4];
#pragma unroll
                for (int mq = 0; mq < 4; ++mq)
#pragma unroll
                    for (int n = 0; n < 4; ++n) Sa[mq][n] = (f32x4){0.f, 0.f, 0.f, 0.f};
#pragma unroll
                for (int ks = 0; ks < 2; ++ks)
#pragma unroll
                    for (int n = 0; n < 4; ++n) { const int kr = 32 * (n >> 1) + 8 * (fr >> 2) + 4 * (n & 1) + (fr & 3);
                        const bf16x8 Kf = *(const LAS bf16x8*)(Ks + kr * 72 + ks * 32 + 8 * fq);
#pragma unroll
                        for (int mq = 0; mq < 4; ++mq) Sa[mq][n] = __builtin_amdgcn_mfma_f32_16x16x32_bf16(Kf, Qf[mq][ks], Sa[mq][n], 0, 0, 0); }
                bf16x8 Pf[4][2];
#pragma unroll
                for (int mq = 0; mq < 4; ++mq) {
                    const int tq = qb * 128 + hf * 64 + 16 * mq + fr;
                    float mx = -1e30f;
#pragma unroll
                    for (int n = 0; n < 4; ++n)
#pragma unroll
                        for (int i = 0; i < 4; ++i) { float s = Sa[mq][n][i] * SC;
                            if (jl >= 0) { const int rel = ks0 + 32 * (n >> 1) + 8 * fq + 4 * (n & 1) + i - tq; if (rel > 128 || rel < -128) s = -1e30f; }
                            Sa[mq][n][i] = s; mx = fmaxf(mx, s); }
                    mx = fmaxf(mx, __shfl_xor(mx, 16)); mx = fmaxf(mx, __shfl_xor(mx, 32));
                    const float mnew = fmaxf(mrun[mq], mx); const float alpha = __builtin_amdgcn_exp2f(mrun[mq] - mnew); mrun[mq] = mnew;
                    float rs = 0.f;
#pragma unroll
                    for (int n = 0; n < 4; ++n)
#pragma unroll
                        for (int i = 0; i < 4; ++i) { const float p = __builtin_amdgcn_exp2f(Sa[mq][n][i] - mnew); Sa[mq][n][i] = p; rs += p; }
                    lrun[mq] = lrun[mq] * alpha + rs;
#pragma unroll
                    for (int db = 0; db < 4; ++db) Oa[mq][db] *= alpha;
#pragma unroll
                    for (int s = 0; s < 2; ++s) { u32x4 w; w.x = cvt_pk_bf16(Sa[mq][2 * s][0], Sa[mq][2 * s][1]); w.y = cvt_pk_bf16(Sa[mq][2 * s][2], Sa[mq][2 * s][3]);
                        w.z = cvt_pk_bf16(Sa[mq][2 * s + 1][0], Sa[mq][2 * s + 1][1]); w.w = cvt_pk_bf16(Sa[mq][2 * s + 1][2], Sa[mq][2 * s + 1][3]); Pf[mq][s] = __builtin_bit_cast(bf16x8, w); }
                }
#pragma unroll
                for (int db = 0; db < 4; ++db)
#pragma unroll
                    for (int s = 0; s < 2; ++s) { const bf16x8 Vf = *(const LAS bf16x8*)(Vs + (16 * db + fr) * 72 + 32 * s + 8 * fq);
#pragma unroll
                        for (int mq = 0; mq < 4; ++mq) Oa[mq][db] = __builtin_amdgcn_mfma_f32_16x16x32_bf16(Vf, Pf[mq][s], Oa[mq][db], 0, 0, 0); }
            }
        }
#pragma unroll
        for (int mq = 0; mq < 4; ++mq) { float l = lrun[mq]; l += __shfl_xor(l, 16); l += __shfl_xor(l, 32); const float inv = 1.0f / l;
            bf16_t* op = O + (size_t)(qrow0 + 16 * mq + fr) * D + head * 64 + 4 * fq;
#pragma unroll
            for (int db = 0; db < 4; ++db) st_bf4(op + 16 * db, Oa[mq][db] * inv); }
    }
    __syncthreads();
}

struct KState { XcdBarrier bar; int ph; };
#define RUN() (A.one || A.phase == KS.ph)
#define SEAM() do { if (A.one) xcd_barrier(KS.bar); ++KS.ph; } while (0)
template <int LAYER>
__device__ __forceinline__ void layer_body(Frame& F, const Args& A, KState& KS) {
    constexpr int layer = LAYER, kind = LAYER % 3, j = LAYER / 3; constexpr bool last = (LAYER == DEPTH - 1);
    LAS unsigned char* ring = F.lds;
    const LAS int* tpre = (const LAS int*)(F.lds + TPRE_OFF); const LAS int* lcnt = (const LAS int*)(F.lds + LCNT_OFF);
    float* H = WSP(float, WS_H); const float* MOD = WSP(float, WS_MOD); const bf16_t* AX = WSP(bf16_t, WS_AX);
    const float* gate1 = MOD + (size_t)layer * 33 * 6144 + 2 * D;
    constexpr int nMall = last ? NX / 256 : NT / 256;
    if (RUN()) phase_norm1(F, A, layer);
    SEAM();
    if constexpr (kind == 0) {
        if (RUN()) {
            { pg8::ProbDense P; P.A = AX; P.Bt = WSP(bf16_t, WS_WQK) + (size_t)j * 1280 * D; P.lda = D; P.ldb = D; P.K = D; P.a_pn_off = 0; P.ord.init(NT / 256, 5, F.G, F.c);
              EpiQK E{WSP(bf16_t, WS_Q), WSP(bf16_t, WS_K), WSP(float, WS_BQK) + j * 1280, WSP(float, WS_ROPEC), WSP(float, WS_ROPES)};
              pg8::gemm_phase(ring, P, E); }
            { pg8::ProbDense P; P.A = WSP(bf16_t, WS_WV) + (size_t)j * 256 * D; P.Bt = AX; P.lda = D; P.ldb = D; P.K = D; P.a_pn_off = 0; P.ord.init(1, NT / 256, F.G, F.c);
              EpiVT E{WSP(bf16_t, WS_VT), A.in[I_ABQKV] + j * 1536 + 1280};
              pg8::gemm_phase(ring, P, E); }
        }
        SEAM();
        if (RUN()) phase_attn(F, A, j, !last);
        SEAM();
        if (RUN() && !((SKIPMASK >> layer) & 1)) { pg8::ProbDense P; P.A = WSP(bf16_t, WS_O); P.Bt = WSP(bf16_t, WS_WO) + (size_t)j * D * D; P.lda = D; P.ldb = D; P.K = D; P.a_pn_off = 0; P.ord.init(nMall, 4, F.G, F.c);
            EpiResid E{H, A.in[I_ABO] + j * D, nullptr, gate1};
            pg8::gemm_phase(ring, P, E); }
        SEAM();
    } else if constexpr (kind == 1) {
        if (RUN()) phase_pooldiff(F);
        SEAM();
        if (RUN() && !((SKIPMASK >> layer) & 1)) { pg8::ProbDense P; P.A = WSP(bf16_t, WS_PD); P.Bt = WSP(bf16_t, WS_POOLW); P.lda = D; P.ldb = 256; P.K = 256; P.a_pn_off = 256; P.ord.init(nMall, 4, F.G, F.c);
            EpiResid E{H, A.in[I_PB], A.in[I_PS], gate1};
            pg8::gemm_phase(ring, P, E); }
        SEAM();
    } else {
        if (RUN()) phase_rwkv_mix(F, A);
        SEAM();
        if (RUN()) {
            for (int i = 0; i < 3; ++i) { const int sel = i == 0 ? 0 : i == 1 ? 2 : 3;
                pg8::ProbDense P; P.A = WSP(bf16_t, WS_A6) + (size_t)sel * NT * D; P.Bt = WSP(bf16_t, WS_WRKV) + (size_t)i * D * D; P.lda = D; P.ldb = D; P.K = D; P.a_pn_off = 0; P.ord.init(NT / 256, 4, F.G, F.c);
                EpiBf16Act E{WSP(bf16_t, WS_RKV) + (size_t)i * NT * D, D, nullptr, 0, 1.0f};
                pg8::gemm_phase(ring, P, E); }
            for (int i = 0; i < 3; ++i) { const int sel = i == 0 ? 5 : i == 1 ? 1 : 4;
                pg8::ProbDense P; P.A = WSP(bf16_t, WS_A6) + (size_t)sel * NT * D; P.Bt = WSP(bf16_t, WS_WL1) + (size_t)i * 256 * D; P.lda = D; P.ldb = D; P.K = D; P.a_pn_off = 0; P.ord.init(NT / 256, 1, F.G, F.c);
                EpiBf16Act E{WSP(bf16_t, WS_LORA) + i * 256, 768, nullptr, i == 0 ? 1 : i == 1 ? 2 : 0, 1.0f};
                pg8::gemm_phase(ring, P, E); }
        }
        SEAM();
        if (RUN()) {
            for (int i = 0; i < 5; ++i) {
                const int ablk = i == 0 ? 0 : i < 3 ? 1 : 2, d = (i - 1) & 1;
                pg8::ProbDense P; P.A = WSP(bf16_t, WS_LORA) + ablk * 256; P.Bt = WSP(bf16_t, WS_WL2) + (size_t)i * D * 256; P.lda = 768; P.ldb = 256; P.K = 256; P.a_pn_off = 0; P.ord.init(NT / 256, 4, F.G, F.c);
                EpiBf16Act E; E.ldc = D;
                if (i == 0) { E.O = WSP(bf16_t, WS_G); E.bias = nullptr; E.act = 0; E.scale = 1.0f; }
                else if (i < 3) { E.O = WSP(bf16_t, WS_E) + (size_t)d * NT * D; E.bias = A.in[I_RW0] + d * D; E.act = 1; E.scale = 0.6065306597126334f; }
                else { E.O = WSP(bf16_t, WS_A) + (size_t)d * NT * D; E.bias = A.in[I_RA0] + d * D; E.act = 1; E.scale = 1.0f; }
                pg8::gemm_phase(ring, P, E); }
        }
        SEAM();
        if (RUN()) phase_rwkv_scan(F, A);
        SEAM();
        if (RUN()) phase_rwkv_out(F, A, last ? NX : NT);
        SEAM();
        if (RUN() && !((SKIPMASK >> layer) & 1)) { pg8::ProbDense P; P.A = WSP(bf16_t, WS_RO); P.Bt = WSP(bf16_t, WS_WOR); P.lda = D; P.ldb = D; P.K = D; P.a_pn_off = 0; P.ord.init(nMall, 4, F.G, F.c);
            EpiResid E{H, nullptr, nullptr, gate1};
            pg8::gemm_phase(ring, P, E); }
        SEAM();
    }
    if (RUN()) phase_route(F, A, layer);
    SEAM();
    if (RUN()) { moe_tiles(F, layer);
        ProbMoe1 P; P.FX = WSP(bf16_t, WS_FX); P.W1T = WSP(bf16_t, WS_W1T) + (size_t)layer * NE * 2048 * D; P.list = WSP(int, WS_LIST); P.tpre = tpre; P.cnt = lcnt; P.lda = D; P.ldb = D; P.K = D; P.ord.init(tpre[NE], 8, F.G, F.c);
        EpiMoe1 E{WSP(bf16_t, WS_ACT), A.in[I_MB1] + (size_t)layer * NE * 2048};
        pg8::gemm_phase(ring, P, E); }
    SEAM();
    if (RUN()) { moe_tiles(F, layer);
        ProbMoe2 P; P.ACT = WSP(bf16_t, WS_ACT); P.W2T = WSP(bf16_t, WS_W2T) + (size_t)layer * NE * D * D; P.tpre = tpre; P.lda = D; P.ldb = D; P.K = D; P.ord.init(tpre[NE], 4, F.G, F.c);
        EpiMoe2 E{WSP(bf16_t, WS_Y), A.in[I_MB2] + (size_t)layer * NE * D};
        pg8::gemm_phase(ring, P, E); }
    SEAM();
}
__global__ void __launch_bounds__(NTHREADS, 2) trunk_fwd(Args A) {
    extern __shared__ __attribute__((aligned(16))) unsigned char lds_[];
    Frame F; F.lds = (LAS unsigned char*)lds_; REFRESH(F); F.wave = __builtin_amdgcn_readfirstlane(F.tid >> 6);
    F.G = gridDim.x; F.c = blockIdx.x; F.ws = A.ws; F.ctl = (unsigned*)(A.ws + WS_CTL);
    for (int u = F.tid; u < (LDS_BYTES - LDSCTL_OFF) / 4; u += NTHREADS) ((LAS unsigned*)(F.lds + LDSCTL_OFF))[u] = 0u;
    __syncthreads();
    KState KS; KS.bar.bar = F.ctl + CW_BAR; KS.bar.x = 0; KS.bar.st = nullptr; KS.ph = 0;
    if (A.one) KS.bar = xcd_barrier_post(F.ctl + CW_BAR, (volatile LAS unsigned*)(F.lds + MISC_OFF) + 8);
    if (RUN()) phase_prologue(F, A);
    SEAM();
    layer_body<0>(F, A, KS);
    layer_body<1>(F, A, KS);
    layer_body<2>(F, A, KS);
    layer_body<3>(F, A, KS);
    if (RUN()) phase_final(F, A);
}
#undef RUN
#undef SEAM
static int count_phases() { int n = 1; for (int layer = 0; layer < DEPTH; ++layer) { const int kind = layer % 3; n += 1 + (kind == 0 ? 3 : kind == 1 ? 2 : 6) + 3; } return n + 1; }

extern "C" void kernel_launch(void* const* d_in, const int* in_sizes, int n_in, void* d_out, int out_size, void* d_ws, size_t ws_size, hipStream_t stream) {
    static int grid = 0;
    if (grid == 0) {
        if (n_in != 38 || out_size != NX * D || ws_size < WS_END) { fprintf(stderr, "kernel_launch: unexpected problem (n_in %d, out %d, ws %zu < %zu)\n", n_in, out_size, ws_size, (size_t)WS_END); grid = -1; return; }
        int dev = 0, cus = 0;
        if (hipGetDevice(&dev) != hipSuccess || hipDeviceGetAttribute(&cus, hipDeviceAttributeMultiprocessorCount, dev) != hipSuccess) { grid = -1; return; }
        if (hipFuncSetAttribute((const void*)trunk_fwd, hipFuncAttributeMaxDynamicSharedMemorySize, LDS_BYTES) != hipSuccess) { fprintf(stderr, "kernel_launch: hipFuncSetAttribute failed\n"); grid = -1; return; }
        int per_cu = 0;
        if (hipOccupancyMaxActiveBlocksPerMultiprocessor(&per_cu, (const void*)trunk_fwd, NTHREADS, LDS_BYTES) != hipSuccess || per_cu < 1) fprintf(stderr, "kernel_launch: occupancy query says %d\n", per_cu);
        (void)hipGetLastError();
        grid = cus;
        if (grid != 256) fprintf(stderr, "kernel_launch: %d CUs (built for 256)\n", grid);
    }
    if (grid < 0) return;
    (void)hipMemsetAsync((char*)d_ws + WS_CTL, 0, CTL_BYTES, stream);
    (void)hipMemsetAsync((char*)d_ws + WS_LZERO, 0, LZERO_BYTES, stream);
    Args a{};
    for (int i = 0; i < 38; ++i) a.in[i] = (const float*)d_in[i];
    a.out = (float*)d_out; a.ws = (unsigned char*)d_ws;
#if MK_ONE_LAUNCH
    a.phase = 0; a.one = 1;
    hipLaunchKernelGGL(trunk_fwd, dim3(grid), dim3(NTHREADS), LDS_BYTES, stream, a);
#else
    const int nph = count_phases();
    for (int p = 0; p < nph; ++p) { a.phase = p; a.one = 0; hipLaunchKernelGGL(trunk_fwd, dim3(grid), dim3(NTHREADS), LDS_BYTES, stream, a); }
#endif
}
```

```cpp
#include <hip/hip_runtime.h>
#include <cstdio>
#include <cstdint>

#ifndef MK_ONE_LAUNCH
#define MK_ONE_LAUNCH 1
#endif
#ifndef REPMASK
#define REPMASK 0x000
#endif
#define REPN(k) (1 + ((REPMASK >> (k)) & 1))
#ifndef DIAG
#define DIAG 0
#endif
#ifndef SKIPMASK
#define SKIPMASK 0x00
#endif

#define LAS __attribute__((address_space(3)))
#define GAS __attribute__((address_space(1)))
typedef unsigned short bf16_t;
typedef short bf16x8 __attribute__((ext_vector_type(8)));
typedef float f32x4 __attribute__((ext_vector_type(4)));
typedef float f32x2 __attribute__((ext_vector_type(2)));
typedef unsigned u32x4 __attribute__((ext_vector_type(4)));
typedef unsigned u32x2 __attribute__((ext_vector_type(2)));

constexpr int D = 1024, NB = 32, T = 2048, L = 256, DEPTH = 4;
constexpr int NX = NB * T, NC = NB * L, NT = NX + NC;
constexpr int NE = 32, TOPK = 4;
constexpr int NWAVES = 8, NTHREADS = 512;
constexpr int MAXRT = NT * TOPK / 256 + NE;

constexpr size_t MiB = 1u << 20;
constexpr size_t WS_CTL = 0, CTL_BYTES = 4 * MiB;
constexpr size_t WS_MOD = 4 * MiB;
constexpr size_t WS_ROPEC = 8 * MiB, WS_ROPES = 8 * MiB + 512 * 1024;
constexpr size_t WS_BQK = 9 * MiB;
constexpr size_t WS_WQK = 10 * MiB;
constexpr size_t WS_WV = 15 * MiB;
constexpr size_t WS_WO = 16 * MiB;
constexpr size_t WS_POOLW = 20 * MiB;
constexpr size_t WS_WRKV = 21 * MiB;
constexpr size_t WS_WOR = 27 * MiB;
constexpr size_t WS_WL1 = 30 * MiB;
constexpr size_t WS_WL2 = 32 * MiB;
constexpr size_t WS_LZERO = WS_WL1, LZERO_BYTES = 6 * MiB;
constexpr size_t WS_W1T = 40 * MiB;
constexpr size_t WS_W2T = 552 * MiB;
constexpr size_t WS_H = 808 * MiB;
constexpr size_t WS_AX = 1096 * MiB;
constexpr size_t WS_FX = 1240 * MiB;
constexpr size_t WS_R = 1384 * MiB;
constexpr size_t WS_ACT = WS_R;
constexpr size_t WS_Y = WS_R + 592 * MiB;
constexpr size_t WS_LIST = WS_R + 1184 * MiB;
constexpr size_t WS_POS = WS_R + 1193 * MiB;
constexpr size_t WS_GATE = WS_R + 1195 * MiB;
constexpr size_t WS_Q = WS_R;
constexpr size_t WS_K = WS_R + 144 * MiB;
constexpr size_t WS_VT = WS_R + 180 * MiB;
constexpr size_t WS_O = WS_R + 216 * MiB;
constexpr size_t WS_PD = WS_R;
constexpr size_t WS_A6 = WS_R;
constexpr size_t WS_E = WS_R;
constexpr size_t WS_A = WS_R + 288 * MiB;
constexpr size_t WS_RO = WS_R + 576 * MiB;
constexpr size_t WS_RKV = WS_R + 864 * MiB;
constexpr size_t WS_LORA = WS_R + 1296 * MiB;
constexpr size_t WS_G = WS_R + 1404 * MiB;
constexpr size_t WS_YS = WS_R + 1548 * MiB;
constexpr size_t WS_BONUS = WS_R + 2124 * MiB;
constexpr size_t WS_END = WS_R + 2134 * MiB;

constexpr int CW_BAR = 4096;
constexpr int CW_GCNT = 16384;
constexpr int LDS_BYTES = 147456;
constexpr int RING_BYTES = 131072;
constexpr int LDSCTL_OFF = 135168;
constexpr int MISC_OFF = LDSCTL_OFF;
constexpr int TPRE_OFF = LDSCTL_OFF + 256;
constexpr int LCNT_OFF = LDSCTL_OFF + 512;
constexpr int LBASE_OFF = LDSCTL_OFF + 768;
constexpr int REC_OFF = LDSCTL_OFF + 1024;
constexpr int JOB_OFF = LDSCTL_OFF + 1024;

__device__ __forceinline__ unsigned f2bf(float f) { unsigned u = __builtin_bit_cast(unsigned, f); return (u + 0x7fffu + ((u >> 16) & 1u)) >> 16; }
__device__ __forceinline__ unsigned pk2(float lo, float hi) { return f2bf(lo) | (f2bf(hi) << 16); }
__device__ __forceinline__ float bflo(unsigned w) { return __builtin_bit_cast(float, w << 16); }
__device__ __forceinline__ float bfhi(unsigned w) { return __builtin_bit_cast(float, w & 0xffff0000u); }
__device__ __forceinline__ float bf1(bf16_t b) { return __builtin_bit_cast(float, ((unsigned)b) << 16); }
__device__ __forceinline__ unsigned cvt_pk_bf16(float lo, float hi) { unsigned r; asm volatile("v_cvt_pk_bf16_f32 %0, %1, %2" : "=v"(r) : "v"(lo), "v"(hi)); return r; }
__device__ __forceinline__ float wave_sum(float v) {
#pragma unroll
    for (int o = 1; o < 64; o <<= 1) v += __shfl_xor(v, o);
    return v;
}
__device__ __forceinline__ float sigmoidf_(float x) { return 1.0f / (1.0f + __expf(-x)); }
__device__ __forceinline__ int opaque_tid() { int t; asm volatile("v_mov_b32 %0, %1" : "=v"(t) : "v"(threadIdx.x)); return t; }
#define REFRESH(F) do { (F).tid = opaque_tid(); (F).lane = (F).tid & 63; } while (0)
__device__ __forceinline__ void seq_of(int row, int& sb, int& t, int& n) { if (row < NX) { sb = row & ~(T - 1); t = row & (T - 1); n = T; } else { const int r2 = row - NX; sb = NX + (r2 & ~(L - 1)); t = r2 & (L - 1); n = L; } }
__device__ __forceinline__ f32x4 ld_bf4(const bf16_t* p) { const u32x2 w = *(const u32x2*)p; return (f32x4){bflo(w.x), bfhi(w.x), bflo(w.y), bfhi(w.y)}; }
__device__ __forceinline__ void st_bf4(bf16_t* p, f32x4 v) { u32x2 w; w.x = pk2(v.x, v.y); w.y = pk2(v.z, v.w); *(u32x2*)p = w; }

#define LDS_WAIT() asm volatile("s_waitcnt lgkmcnt(0)" ::: "memory")
#define VM_WAIT() asm volatile("s_waitcnt vmcnt(0)" ::: "memory")

#define XB_TMO      128
#define XB_XCNT(j)  (256  + 64 * (j))
#define XB_XSUB(j)  (1280 + 64 * (j))
#define XB_XGEN(j)  (2304 + 64 * (j))
#define XB_TOP      3328
#define XB_TOPGEN   3392
#define XCD_BAR_WORDS 3456
#define XB_SPIN_CAP (1u << 18)
__device__ __forceinline__ unsigned xb_ld(unsigned* p)              { return __hip_atomic_load(p, __ATOMIC_RELAXED, __HIP_MEMORY_SCOPE_AGENT); }
__device__ __forceinline__ unsigned xb_add(unsigned* p, unsigned v) { return __hip_atomic_fetch_add(p, v, __ATOMIC_RELAXED, __HIP_MEMORY_SCOPE_AGENT); }
__device__ __forceinline__ unsigned xb_xcc_id() { return (unsigned)__builtin_amdgcn_s_getreg((3 << 11) | 20) & 0xFu; }
#define XB_SPIN(cond, bar) do { unsigned _sp = 0; while (cond) { __builtin_amdgcn_s_sleep(1); \
    if ((++_sp & 255u) == 0u) { if (xb_ld(&(bar)[XB_TMO])) break; if (_sp > XB_SPIN_CAP) { atomicAdd(&(bar)[XB_TMO], 1u); break; } } } } while (0)
struct XcdBarrier { unsigned* bar; unsigned x; volatile LAS unsigned* st; };
__device__ __forceinline__ XcdBarrier xcd_barrier_post(unsigned* bar, volatile LAS unsigned* st) {
    XcdBarrier b; b.bar = bar; b.x = xb_xcc_id(); b.st = st;
    if (threadIdx.x == 0) (void)xb_add(&bar[XB_XCNT(b.x)], 1u);
    return b;
}
__device__ __forceinline__ void xcd_barrier_complete(unsigned* bar, unsigned x, unsigned& nloc, unsigned& nx) {
    const unsigned G = gridDim.x * gridDim.y * gridDim.z;
    unsigned sum, cnt, mine, sp = 0u;
    for (;;) {
        sum = 0u; cnt = 0u; mine = 0u;
#pragma unroll
        for (unsigned j = 0; j < 16; ++j) { const unsigned c = xb_ld(&bar[XB_XCNT(j)]); sum += c; cnt += (c > 0u) ? 1u : 0u; mine = (j == x) ? c : mine; }
        if (sum == G) break;
        __builtin_amdgcn_s_sleep(1);
        if ((++sp & 255u) == 0u) { if (xb_ld(&bar[XB_TMO])) break; if (sp > XB_SPIN_CAP) { atomicAdd(&bar[XB_TMO], 1u); break; } }
    }
    nloc = mine > 0u ? mine : 1u; nx = cnt > 0u ? cnt : 1u;
}
__device__ __forceinline__ void xcd_barrier(const XcdBarrier& b) {
    asm volatile("s_waitcnt vmcnt(0)" ::: "memory");
    __syncthreads();
    if (threadIdx.x == 0) {
        unsigned* bar = b.bar;
        __builtin_amdgcn_s_waitcnt(0);
        unsigned nloc = b.st[0], nx = b.st[1];
        if (nloc == 0u) { xcd_barrier_complete(bar, b.x, nloc, nx); b.st[0] = nloc; b.st[1] = nx; }
        const unsigned old = xb_add(&bar[XB_XSUB(b.x)], 1u);
        const unsigned gen = old / nloc;
        if (old + 1u == (gen + 1u) * nloc) {
            __builtin_amdgcn_fence(__ATOMIC_RELEASE, "agent");
            asm volatile("s_waitcnt vmcnt(0)" ::: "memory");
            const unsigned og = xb_add(&bar[XB_TOP], 1u);
            const unsigned tg = og / nx;
            if (og + 1u == (tg + 1u) * nx) xb_add(&bar[XB_TOPGEN], 1u);
            else XB_SPIN(xb_ld(&bar[XB_TOPGEN]) == tg, bar);
            __builtin_amdgcn_fence(__ATOMIC_ACQUIRE, "agent");
            xb_add(&bar[XB_XGEN(b.x)], 1u);
            asm volatile("s_waitcnt vmcnt(0)" ::: "memory");
        } else {
            XB_SPIN(xb_ld(&bar[XB_XGEN(b.x)]) == gen, bar);
            __builtin_amdgcn_fence(__ATOMIC_ACQUIRE, "agent");
            asm volatile("s_waitcnt vmcnt(0)" ::: "memory");
        }
    }
    __syncthreads();
}

namespace pg8 {
constexpr int BM = 256, BK = 64, HALF = 128, HTB = HALF * BK * 2, STAGE_BYTES = 8 * HTB, NXCD = 8, WGM = 8;
__host__ __device__ __forceinline__ int lds_byte(int r, int c) { const int st = (r >> 4) * 2 + (c >> 5), rr = r & 15, cc = c & 31, ob = rr * 64 + cc * 2; return st * 1024 + (ob ^ (((ob >> 9) & 1) << 5)); }
__host__ __device__ __forceinline__ void stage_rc(int b, int& R, int& C) { const int st = b / 1024, sb = b % 1024, swz = sb ^ (((sb >> 9) & 1) << 5); R = (st >> 1) * 16 + swz / 64; C = (st & 1) * 32 + (swz % 64) / 2; }
__host__ __device__ __forceinline__ int perm32(int rho) { const int n = rho >> 4, i = rho & 15; return 8 * (i >> 2) + 4 * n + (i & 3); }

struct Unit { int pm, pn, e, rt; };
struct TileOrder {
    int nM, nN, nwg, G, c;
    __device__ __forceinline__ void init(int nM_, int nN_, int G_, int c_) { nM = nM_; nN = nN_; nwg = nM * nN; G = G_; c = c_; }
    __device__ __forceinline__ bool next(int i, int& pm, int& pn) const {
        const long Lx = (long)i * G + c; if (Lx >= nwg) return false;
        int wgid = (int)Lx; { const int q = nwg / NXCD, r = nwg % NXCD, xcd = wgid % NXCD, off = wgid / NXCD; wgid = (xcd < r ? xcd * (q + 1) : r * (q + 1) + (xcd - r) * q) + off; }
        const int nig = WGM * nN, gid = wgid / nig, fm = gid * WGM, gsz = (nM - fm) < WGM ? (nM - fm) : WGM;
        pm = fm + ((wgid % nig) % gsz); pn = (wgid % nig) / gsz; return true;
    }
};
struct ProbDense {
    const bf16_t* A; const bf16_t* Bt; int lda, ldb, K, a_pn_off; TileOrder ord;
    __device__ __forceinline__ bool next(int i, Unit& u) const { u.e = 0; const bool ok = ord.next(i, u.pm, u.pn); u.rt = u.pm; return ok; }
    __device__ __forceinline__ const char* a_ptr(const Unit& u) const { return (const char*)(A + (size_t)u.pm * BM * lda + (size_t)u.pn * a_pn_off); }
    __device__ __forceinline__ const char* b_ptr(const Unit& u) const { return (const char*)(Bt + (size_t)u.pn * BM * ldb); }
    __device__ __forceinline__ void a_off(const Unit&, const int (&R)[2], const int (&C)[2], unsigned (&v)[2][2]) const {
#pragma unroll
        for (int h = 0; h < 2; ++h)
#pragma unroll
            for (int i = 0; i < 2; ++i) v[h][i] = (unsigned)((h * HALF + R[i]) * lda + C[i]) * 2u;
    }
};

template <class Prob, class Epi>
__device__ __forceinline__ void gemm_phase(LAS unsigned char* lds, const Prob& P, const Epi& E) {
    const int tid = opaque_tid(), wid = __builtin_amdgcn_readfirstlane(tid >> 6), lane = tid & 63, wr = wid >> 2, wc = wid & 3, fr = lane & 15, fq = lane >> 4;
    const int K = P.K, nt = K / BK;
    int Rr[2], Cc[2]; unsigned voffB[2];
#pragma unroll
    for (int i = 0; i < 2; ++i) { int R, C; stage_rc(tid * 16 + i * 8192, R, C); Rr[i] = R; Cc[i] = C; const int Rb = Epi::PERM ? ((R & ~31) + perm32(R & 31)) : R;
        voffB[i] = (unsigned)(Rb * P.ldb + C) * 2u; }
    const size_t kstep = (size_t)(BK * 2);
    const size_t hstepB = (size_t)HALF * P.ldb * 2;
    const unsigned ldsw = (unsigned)wid * 1024u;
    const int aoff = lds_byte(wr * 64 + fr, fq * 8), boff = lds_byte(wc * 32 + fr, fq * 8);
#define PG8_SA(b, h) (((b) * 2 + (h)) * HTB)
#define PG8_SB(b, h) ((4 + (b) * 2 + (h)) * HTB)
#define PG8_STAGE(bufoff, gbase, voff) do { _Pragma("unroll") for (int _i = 0; _i < 2; ++_i) \
        __builtin_amdgcn_global_load_lds((const unsigned*)((const char*)(gbase) + (voff)[_i]), (LAS unsigned*)(lds + (bufoff) + ldsw + _i * 8192), 16, 0, 0); } while (0)
#define PG8_LDA(dst, b, h) do { _Pragma("unroll") for (int m = 0; m < 4; ++m) _Pragma("unroll") for (int k = 0; k < 2; ++k) dst[m][k] = *(const LAS bf16x8*)(lds + PG8_SA(b, h) + aoff + m * 2048 + k * 1024); } while (0)
#define PG8_LDB(dst, b, h) do { _Pragma("unroll") for (int n = 0; n < 2; ++n) _Pragma("unroll") for (int k = 0; k < 2; ++k) dst[n][k] = *(const LAS bf16x8*)(lds + PG8_SB(b, h) + boff + n * 2048 + k * 1024); } while (0)
#define PG8_MMA(ai, bj, At, Bt) do { __builtin_amdgcn_s_setprio(1); _Pragma("unroll") for (int m = 0; m < 4; ++m) _Pragma("unroll") for (int n = 0; n < 2; ++n) _Pragma("unroll") for (int k = 0; k < 2; ++k) \
        acc[ai][bj][m][n] = __builtin_amdgcn_mfma_f32_16x16x32_bf16(Bt[n][k], At[m][k], acc[ai][bj][m][n], 0, 0, 0); __builtin_amdgcn_s_setprio(0); } while (0)
#define PG8_WAIT_V(n) asm volatile("s_waitcnt vmcnt(" #n ")" ::: "memory")
#define PG8_WAIT_L(n) asm volatile("s_waitcnt lgkmcnt(" #n ")" ::: "memory")
#define PG8_BAR __builtin_amdgcn_s_barrier()
#define PG8_SCHED __builtin_amdgcn_sched_barrier(0)
    Unit cur, nxt; int ui = 0;
    if (!P.next(0, cur)) return;
    f32x4 acc[2][2][4][2];
#pragma unroll
    for (int a = 0; a < 2; ++a)
#pragma unroll
        for (int b = 0; b < 2; ++b)
#pragma unroll
            for (int m = 0; m < 4; ++m)
#pragma unroll
                for (int n = 0; n < 2; ++n) acc[a][b][m][n] = (f32x4){0.f, 0.f, 0.f, 0.f};
    bf16x8 At[4][2], B0[2][2], B1[2][2];
    unsigned vAc[2][2], vAn[2][2];
    P.a_off(cur, Rr, Cc, vAc);
    const char* cA = P.a_ptr(cur); const char* cB = P.b_ptr(cur);
    PG8_STAGE(PG8_SB(0, 0), cB, voffB); PG8_STAGE(PG8_SB(0, 1), cB + hstepB, voffB); PG8_STAGE(PG8_SA(0, 0), cA, vAc[0]); PG8_STAGE(PG8_SA(0, 1), cA, vAc[1]);
    if (wr == 1) PG8_BAR;
    PG8_WAIT_V(2); PG8_BAR;
    PG8_STAGE(PG8_SB(1, 0), cB + kstep, voffB); PG8_STAGE(PG8_SA(1, 0), cA + kstep, vAc[0]); PG8_STAGE(PG8_SB(1, 1), cB + hstepB + kstep, voffB);
    PG8_WAIT_V(6); PG8_BAR;
    for (;;) {
        const bool has_next = P.next(ui + 1, nxt);
        const char* nA = cA; const char* nB = cB;
#pragma unroll
        for (int h = 0; h < 2; ++h)
#pragma unroll
            for (int i = 0; i < 2; ++i) vAn[h][i] = vAc[h][i];
        if (has_next) { nA = P.a_ptr(nxt); nB = P.b_ptr(nxt); P.a_off(nxt, Rr, Cc, vAn); }
        for (int t = 0; t < nt; t += 2) {
            const bool last = (t == nt - 2);
            const char* a1 = cA + (size_t)(t + 1) * kstep;
            const char* a2 = last ? nA : cA + (size_t)(t + 2) * kstep; const char* b2 = last ? nB : cB + (size_t)(t + 2) * kstep;
            const char* a3 = a2 + kstep; const char* b3 = b2 + kstep;
            unsigned vX[2][2];
#pragma unroll
            for (int h = 0; h < 2; ++h)
#pragma unroll
                for (int i = 0; i < 2; ++i) vX[h][i] = last ? vAn[h][i] : vAc[h][i];
            PG8_LDB(B0, 0, 0); PG8_LDB(B1, 0, 1); PG8_SCHED; PG8_LDA(At, 0, 0); PG8_STAGE(PG8_SA(1, 1), a1, vAc[1]);
            PG8_WAIT_V(8); PG8_WAIT_L(0); PG8_BAR; PG8_MMA(0, 0, At, B0); PG8_MMA(0, 1, At, B1); PG8_BAR; PG8_SCHED;
            PG8_LDA(At, 0, 1); PG8_STAGE(PG8_SB(0, 0), b2, voffB); PG8_STAGE(PG8_SB(0, 1), b2 + hstepB, voffB); PG8_STAGE(PG8_SA(0, 0), a2, vX[0]);
            PG8_WAIT_V(8); PG8_WAIT_L(0); PG8_BAR; PG8_MMA(1, 0, At, B0); PG8_MMA(1, 1, At, B1); PG8_BAR; PG8_SCHED;
            PG8_LDB(B0, 1, 0); PG8_LDB(B1, 1, 1); PG8_SCHED; PG8_LDA(At, 1, 0); PG8_STAGE(PG8_SA(0, 1), a2, vX[1]);
            PG8_WAIT_V(8); PG8_WAIT_L(0); PG8_BAR; PG8_MMA(0, 0, At, B0); PG8_MMA(0, 1, At, B1); PG8_BAR; PG8_SCHED;
            PG8_LDA(At, 1, 1); PG8_STAGE(PG8_SB(1, 0), b3, voffB); PG8_STAGE(PG8_SB(1, 1), b3 + hstepB, voffB); PG8_STAGE(PG8_SA(1, 0), a3, vX[0]);
            PG8_WAIT_V(8); PG8_WAIT_L(0); PG8_BAR; PG8_MMA(1, 0, At, B0); PG8_MMA(1, 1, At, B1); PG8_BAR; PG8_SCHED;
        }
        if (wr == 0) PG8_BAR;
        E(acc, cur, wr, wc, fr, fq);
        if (!has_next) break;
#pragma unroll
        for (int a = 0; a < 2; ++a)
#pragma unroll
            for (int b = 0; b < 2; ++b)
#pragma unroll
                for (int m = 0; m < 4; ++m)
#pragma unroll
                    for (int n = 0; n < 2; ++n) acc[a][b][m][n] = (f32x4){0.f, 0.f, 0.f, 0.f};
        cur = nxt; cA = nA; cB = nB; ++ui;
#pragma unroll
        for (int h = 0; h < 2; ++h)
#pragma unroll
            for (int i = 0; i < 2; ++i) vAc[h][i] = vAn[h][i];
        if (wr == 1) PG8_BAR;
    }
    PG8_WAIT_V(0);
    PG8_BAR;
#undef PG8_SA
#undef PG8_SB
#undef PG8_STAGE
#undef PG8_LDA
#undef PG8_LDB
#undef PG8_MMA
#undef PG8_WAIT_V
#undef PG8_WAIT_L
#undef PG8_BAR
#undef PG8_SCHED
}
}

using pg8::Unit;
constexpr int HALF_ = 128;
struct EpiBf16Act {
    static constexpr bool PERM = true;
    bf16_t* O; int ldc; const float* bias; int act; float scale;
    __device__ __forceinline__ void operator()(const f32x4 (&acc)[2][2][4][2], const Unit& u, int wr, int wc, int fr, int fq) const {
        const int row0 = u.pm * 256 + wr * 64 + fr, col0 = u.pn * 256 + wc * 32 + 8 * fq;
        f32x4 bv[2][2];
#pragma unroll
        for (int bj = 0; bj < 2; ++bj)
#pragma unroll
            for (int n = 0; n < 2; ++n) bv[bj][n] = bias ? *(const f32x4*)(bias + col0 + bj * HALF_ + 4 * n) : (f32x4){0.f, 0.f, 0.f, 0.f};
#pragma unroll
        for (int ai = 0; ai < 2; ++ai)
#pragma unroll
            for (int m = 0; m < 4; ++m) { bf16_t* rowp = O + (size_t)(row0 + ai * HALF_ + m * 16) * ldc + col0;
#pragma unroll
                for (int bj = 0; bj < 2; ++bj) { f32x4 v0 = acc[ai][bj][m][0] + bv[bj][0], v1 = acc[ai][bj][m][1] + bv[bj][1];
                    if (act == 1) {
#pragma unroll
                        for (int j = 0; j < 4; ++j) { v0[j] = sigmoidf_(v0[j]) * scale; v1[j] = sigmoidf_(v1[j]) * scale; } }
                    else if (act == 2) {
#pragma unroll
                        for (int j = 0; j < 4; ++j) { v0[j] = 1.0f - 2.0f / (__expf(2.0f * v0[j]) + 1.0f); v1[j] = 1.0f - 2.0f / (__expf(2.0f * v1[j]) + 1.0f); } }
                    u32x4 w; w.x = cvt_pk_bf16(v0[0], v0[1]); w.y = cvt_pk_bf16(v0[2], v0[3]); w.z = cvt_pk_bf16(v1[0], v1[1]); w.w = cvt_pk_bf16(v1[2], v1[3]);
                    *(u32x4*)(rowp + bj * HALF_) = w; } }
    }
};
struct EpiQK {
    static constexpr bool PERM = true;
    bf16_t* Q; bf16_t* Kb; const float* bias; const float* ropec; const float* ropes;
    __device__ __forceinline__ void operator()(const f32x4 (&acc)[2][2][4][2], const Unit& u, int wr, int wc, int fr, int fq) const {
        const int row0 = u.pm * 256 + wr * 64 + fr, cl0 = wc * 32 + 8 * fq;
        const int g = (4 * wc + fq) & 7;
        bf16_t* base; int ldc;
        if (u.pn < 4) { base = Q + u.pn * 256; ldc = 1024; } else { base = Kb; ldc = 256; }
        f32x4 bv[2][2];
#pragma unroll
        for (int bj = 0; bj < 2; ++bj)
#pragma unroll
            for (int n = 0; n < 2; ++n) bv[bj][n] = *(const f32x4*)(bias + u.pn * 256 + cl0 + bj * HALF_ + 4 * n);
#pragma unroll
        for (int ai = 0; ai < 2; ++ai)
#pragma unroll
            for (int m = 0; m < 4; ++m) { const int row = row0 + ai * HALF_ + m * 16; bf16_t* rowp = base + (size_t)row * ldc + cl0;
                f32x4 cs = (f32x4){1.f, 1.f, 1.f, 1.f}, sn = (f32x4){0.f, 0.f, 0.f, 0.f};
                if (row < NX) { const int t = row & (T - 1); cs = *(const f32x4*)(ropec + t * 32 + g * 4); sn = *(const f32x4*)(ropes + t * 32 + g * 4); }
#pragma unroll
                for (int bj = 0; bj < 2; ++bj) { const f32x4 v0 = acc[ai][bj][m][0] + bv[bj][0], v1 = acc[ai][bj][m][1] + bv[bj][1];
                    const f32x4 o0 = v0 * cs - v1 * sn, o1 = v1 * cs + v0 * sn;
                    u32x4 w; w.x = cvt_pk_bf16(o0[0], o0[1]); w.y = cvt_pk_bf16(o0[2], o0[3]); w.z = cvt_pk_bf16(o1[0], o1[1]); w.w = cvt_pk_bf16(o1[2], o1[3]);
                    *(u32x4*)(rowp + bj * HALF_) = w; } }
    }
};
struct EpiVT {
    static constexpr bool PERM = true;
    bf16_t* VT; const float* biasrow;
    __device__ __forceinline__ void operator()(const f32x4 (&acc)[2][2][4][2], const Unit& u, int wr, int wc, int fr, int fq) const {
        const int row0 = wr * 64 + fr, col0 = u.pn * 256 + wc * 32 + 8 * fq;
#pragma unroll
        for (int ai = 0; ai < 2; ++ai)
#pragma unroll
            for (int m = 0; m < 4; ++m) { const int row = row0 + ai * HALF_ + m * 16; const float b = biasrow[row]; bf16_t* rowp = VT + (size_t)row * NT + col0;
#pragma unroll
                for (int bj = 0; bj < 2; ++bj) { const f32x4 v0 = acc[ai][bj][m][0] + b, v1 = acc[ai][bj][m][1] + b;
                    u32x4 w; w.x = cvt_pk_bf16(v0[0], v0[1]); w.y = cvt_pk_bf16(v0[2], v0[3]); w.z = cvt_pk_bf16(v1[0], v1[1]); w.w = cvt_pk_bf16(v1[2], v1[3]);
                    *(u32x4*)(rowp + bj * HALF_) = w; } }
    }
};
struct EpiResid {
    static constexpr bool PERM = false;
    float* H; const float* bias; const float* ls; const float* gate;
    __device__ __forceinline__ void operator()(const f32x4 (&acc)[2][2][4][2], const Unit& u, int wr, int wc, int fr, int fq) const {
        const int row0 = u.pm * 256 + wr * 64 + fr, col0 = u.pn * 256 + wc * 32 + 4 * fq;
        f32x4 bv[2][2], lv[2][2];
#pragma unroll
        for (int bj = 0; bj < 2; ++bj)
#pragma unroll
            for (int n = 0; n < 2; ++n) { bv[bj][n] = bias ? *(const f32x4*)(bias + col0 + bj * HALF_ + n * 16) : (f32x4){0.f, 0.f, 0.f, 0.f};
                                          lv[bj][n] = ls ? *(const f32x4*)(ls + col0 + bj * HALF_ + n * 16) : (f32x4){1.f, 1.f, 1.f, 1.f}; }
#pragma unroll
        for (int ai = 0; ai < 2; ++ai)
#pragma unroll
            for (int m = 0; m < 4; ++m) { const int row = row0 + ai * HALF_ + m * 16; const int brow = row < NX ? (row >> 11) : 32;
                float* hp = H + (size_t)row * D + col0; const float* gp = gate + (size_t)brow * (6 * D) + col0;
#pragma unroll
                for (int bj = 0; bj < 2; ++bj)
#pragma unroll
                    for (int n = 0; n < 2; ++n) { const f32x4 y = (acc[ai][bj][m][n] + bv[bj][n]) * lv[bj][n]; const f32x4 gv = *(const f32x4*)(gp + bj * HALF_ + n * 16);
                        f32x4 hv = *(const f32x4*)(hp + bj * HALF_ + n * 16); hv = hv + gv * y; *(f32x4*)(hp + bj * HALF_ + n * 16) = hv; }
                asm volatile("" ::: "memory"); }
    }
};
struct EpiMoe1 {
    static constexpr bool PERM = true;
    bf16_t* ACT; const float* b1;
    __device__ __forceinline__ void operator()(const f32x4 (&acc)[2][2][4][2], const Unit& u, int wr, int wc, int fr, int fq) const {
        const int row0 = u.rt * 256 + wr * 64 + fr, cl = u.pn * 128 + wc * 32 + 8 * fq;
        const float* bg = b1 + (size_t)u.e * 2048 + cl; const float* bl = bg + 1024;
        f32x4 bgv[2], blv[2];
#pragma unroll
        for (int n = 0; n < 2; ++n) { bgv[n] = *(const f32x4*)(bg + 4 * n); blv[n] = *(const f32x4*)(bl + 4 * n); }
#pragma unroll
        for (int ai = 0; ai < 2; ++ai)
#pragma unroll
            for (int m = 0; m < 4; ++m) { bf16_t* rowp = ACT + (size_t)(row0 + ai * HALF_ + m * 16) * D + cl;
                f32x4 o[2];
#pragma unroll
                for (int n = 0; n < 2; ++n) { const f32x4 hg = acc[ai][0][m][n] + bgv[n], hl = acc[ai][1][m][n] + blv[n];
#pragma unroll
                    for (int j = 0; j < 4; ++j) { const float gl = fminf(hg[j], 7.0f); const float li = fminf(fmaxf(hl[j], -7.0f), 7.0f);
                        o[n][j] = gl * sigmoidf_(1.702f * gl) * (li + 1.0f); } }
                u32x4 w; w.x = cvt_pk_bf16(o[0][0], o[0][1]); w.y = cvt_pk_bf16(o[0][2], o[0][3]); w.z = cvt_pk_bf16(o[1][0], o[1][1]); w.w = cvt_pk_bf16(o[1][2], o[1][3]);
                *(u32x4*)rowp = w; }
    }
};
struct EpiMoe2 {
    static constexpr bool PERM = true;
    bf16_t* Y; const float* b2;
    __device__ __forceinline__ void operator()(const f32x4 (&acc)[2][2][4][2], const Unit& u, int wr, int wc, int fr, int fq) const {
        const int row0 = u.rt * 256 + wr * 64 + fr, col0 = u.pn * 256 + wc * 32 + 8 * fq;
        const float* bb = b2 + (size_t)u.e * D + col0;
        f32x4 bv[2][2];
#pragma unroll
        for (int bj = 0; bj < 2; ++bj)
#pragma unroll
            for (int n = 0; n < 2; ++n) bv[bj][n] = *(const f32x4*)(bb + bj * HALF_ + 4 * n);
#pragma unroll
        for (int ai = 0; ai < 2; ++ai)
#pragma unroll
            for (int m = 0; m < 4; ++m) { bf16_t* rowp = Y + (size_t)(row0 + ai * HALF_ + m * 16) * D + col0;
#pragma unroll
                for (int bj = 0; bj < 2; ++bj) { const f32x4 v0 = acc[ai][bj][m][0] + bv[bj][0], v1 = acc[ai][bj][m][1] + bv[bj][1];
                    u32x4 w; w.x = cvt_pk_bf16(v0[0], v0[1]); w.y = cvt_pk_bf16(v0[2], v0[3]); w.z = cvt_pk_bf16(v1[0], v1[1]); w.w = cvt_pk_bf16(v1[2], v1[3]);
                    *(u32x4*)(rowp + bj * HALF_) = w; } }
    }
};
struct ProbMoe1 {
    const bf16_t* FX; const bf16_t* W1T; const int* list; const LAS int* tpre; const LAS int* cnt; int lda, ldb, K; pg8::TileOrder ord;
    __device__ __forceinline__ bool next(int i, Unit& u) const {
        if (!ord.next(i, u.pm, u.pn)) return false;
        u.rt = u.pm; int e = 0;
#pragma unroll 1
        for (int j = 1; j < NE; ++j) e += (tpre[j] <= u.rt) ? 1 : 0;
        u.e = e; return true;
    }
    __device__ __forceinline__ const char* a_ptr(const Unit&) const { return (const char*)FX; }
    __device__ __forceinline__ const char* b_ptr(const Unit& u) const { return (const char*)(W1T + ((size_t)u.e * 2048 + (size_t)u.pn * 256) * D); }
    __device__ __forceinline__ void a_off(const Unit& u, const int (&R)[2], const int (&C)[2], unsigned (&v)[2][2]) const {
        const int base = (u.rt - tpre[u.e]) * 256, ce = cnt[u.e]; const int* le = list + (size_t)u.e * NT;
#pragma unroll
        for (int h = 0; h < 2; ++h)
#pragma unroll
            for (int i = 0; i < 2; ++i) { const int idx = base + h * 128 + R[i]; const int tok = idx < ce ? le[idx] : 0; v[h][i] = (unsigned)(tok * D + C[i]) * 2u; }
        asm volatile("" : "+v"(v[0][0]), "+v"(v[0][1]), "+v"(v[1][0]), "+v"(v[1][1]));
    }
};
struct ProbMoe2 {
    const bf16_t* ACT; const bf16_t* W2T; const LAS int* tpre; int lda, ldb, K; pg8::TileOrder ord;
    __device__ __forceinline__ bool next(int i, Unit& u) const {
        if (!ord.next(i, u.pm, u.pn)) return false;
        u.rt = u.pm; int e = 0;
#pragma unroll 1
        for (int j = 1; j < NE; ++j) e += (tpre[j] <= u.rt) ? 1 : 0;
        u.e = e; return true;
    }
    __device__ __forceinline__ const char* a_ptr(const Unit& u) const { return (const char*)(ACT + (size_t)u.rt * 256 * D); }
    __device__ __forceinline__ const char* b_ptr(const Unit& u) const { return (const char*)(W2T + ((size_t)u.e * 1024 + (size_t)u.pn * 256) * D); }
    __device__ __forceinline__ void a_off(const Unit&, const int (&R)[2], const int (&C)[2], unsigned (&v)[2][2]) const {
#pragma unroll
        for (int h = 0; h < 2; ++h)
#pragma unroll
            for (int i = 0; i < 2; ++i) v[h][i] = (unsigned)((h * 128 + R[i]) * D + C[i]) * 2u;
    }
};

struct Args { const float* in[38]; float* out; unsigned char* ws; int phase; int one; };
enum { I_X = 0, I_C, I_CTX, I_CCTX, I_ADAW, I_ADAB, I_NORMG, I_AWQKV, I_ABQKV, I_AWO, I_ABO, I_ASINK, I_PW, I_PB, I_PS,
       I_RMIX, I_RWRKV, I_RW0, I_RW1, I_RW2, I_RA0, I_RA1, I_RA2, I_RG1, I_RG2, I_RKK, I_RKA, I_RRK, I_RLNW, I_RLNB, I_RWO,
       I_MWR, I_MBR, I_MW1, I_MB1, I_MW2, I_MB2, I_FG };
struct Frame { LAS unsigned char* lds; int tid, lane, wave, G, c; unsigned char* ws; unsigned* ctl; };
#define WSP(T_, off) ((T_*)(F.ws + (off)))

struct TJob { const float* src; bf16_t* dst; long sbs, dbs; int ldw, ldt, nkb, nnb, mode, item0, per, pad; };
__device__ __forceinline__ int dst_row(int mode, int n) {
    if (mode == 1) { const int hb = n & ~63, d = n & 63; const int ax = d >> 5, dd = d & 31, hf = dd >> 4, f = dd & 15; const int g = ax * 4 + (f >> 2), i = (f & 3) + 4 * hf; return hb + 8 * g + i; }
    if (mode == 2) { return n < 1024 ? ((n >> 7) << 8) + (n & 127) : (((n - 1024) >> 7) << 8) + 128 + (n & 127); }
    return n;
}
struct TItem { const float* src; bf16_t* dst; int ldw, ldt, mode, n0; };
__device__ __forceinline__ void titem_decode(const LAS TJob* jobs, int nj, int it, TItem& T) {
    int ji = 0;
    for (int q = 1; q < nj; ++q) ji += (jobs[q].item0 <= it) ? 1 : 0;
    const LAS TJob& J = jobs[ji]; const int r = it - J.item0, bi = r / J.per, rr = r % J.per, kb = rr / J.nnb, nb = rr % J.nnb;
    T.src = J.src + bi * J.sbs + (size_t)(64 * kb) * J.ldw + 32 * nb; T.dst = J.dst + bi * J.dbs + 64 * kb; T.ldw = J.ldw; T.ldt = J.ldt; T.mode = J.mode; T.n0 = 32 * nb;
}
__device__ __forceinline__ void titem_load(const TItem& T, int lane, f32x4 (&v)[8]) {
    const float* p = T.src + (size_t)(lane >> 3) * T.ldw + 4 * (lane & 7);
#pragma unroll
    for (int i = 0; i < 8; ++i) v[i] = *(const f32x4*)(p + (size_t)(8 * i) * T.ldw);
}
__device__ __forceinline__ void titem_store(const TItem& T, int lane, const f32x4 (&v)[8], LAS float* scr) {
#pragma unroll
    for (int i = 0; i < 8; ++i) { LAS float* d = scr + (8 * i + (lane >> 3)) * 33 + 4 * (lane & 7); d[0] = v[i].x; d[1] = v[i].y; d[2] = v[i].z; d[3] = v[i].w; }
    LDS_WAIT(); asm volatile("" ::: "memory");
    const int c = lane & 7;
#pragma unroll
    for (int j = 0; j < 4; ++j) { const int n = (lane >> 3) + 8 * j; const LAS float* s = scr + (8 * c) * 33 + n;
        u32x4 o; o.x = pk2(s[0 * 33], s[1 * 33]); o.y = pk2(s[2 * 33], s[3 * 33]); o.z = pk2(s[4 * 33], s[5 * 33]); o.w = pk2(s[6 * 33], s[7 * 33]);
        *(u32x4*)(T.dst + (size_t)dst_row(T.mode, T.n0 + n) * T.ldt + 8 * c) = o; }
    LDS_WAIT(); asm volatile("" ::: "memory");
}
__device__ __forceinline__ void phase_prologue(Frame& F, const Args& A) {
    REFRESH(F);
    LAS float* S = (LAS float*)F.lds;
    for (int idx = F.tid; idx < 33 * 1024; idx += NTHREADS) { const int r = idx >> 10, k = idx & 1023; const float v = r < 32 ? A.in[I_C][r * 1024 + k] : A.in[I_CCTX][k]; S[k * 33 + r] = v / (1.0f + __expf(-v)); }
    __syncthreads();
    float* MOD = WSP(float, WS_MOD);
    for (int it = F.c; it < 4 * 96; it += F.G) {
        const int layer = it / 96, n = (it % 96) * 64 + F.lane; const float* wp = A.in[I_ADAW] + (size_t)layer * 1024 * 6144 + n;
        float acc[5] = {0.f, 0.f, 0.f, 0.f, 0.f};
        for (int k0 = 0; k0 < 1024; k0 += 32) {
            float wv[32];
#pragma unroll
            for (int u = 0; u < 32; ++u) wv[u] = wp[(size_t)(k0 + u) * 6144];
#pragma unroll
            for (int u = 0; u < 32; ++u) { const LAS float* sr = S + (k0 + u) * 33 + F.wave;
                acc[0] += sr[0] * wv[u]; acc[1] += sr[8] * wv[u]; acc[2] += sr[16] * wv[u]; acc[3] += sr[24] * wv[u]; if (F.wave == 0) acc[4] += S[(k0 + u) * 33 + 32] * wv[u]; }
        }
        const float bb = A.in[I_ADAB][layer * 6144 + n];
#pragma unroll
        for (int i = 0; i < 4; ++i) MOD[((size_t)layer * 33 + F.wave + 8 * i) * 6144 + n] = acc[i] + bb;
        if (F.wave == 0) MOD[((size_t)layer * 33 + 32) * 6144 + n] = acc[4] + bb;
    }
    { float* rc = WSP(float, WS_ROPEC); float* rs = WSP(float, WS_ROPES);
      for (int idx = F.c * NTHREADS + F.tid; idx < 2048 * 32; idx += F.G * NTHREADS) { const int t = idx >> 5, e = idx & 31, g = e >> 2, i = e & 3, f = 4 * (g & 3) + i;
          const float inv = powf(10000.0f, -(float)f / 16.0f); const float pos = (float)(g < 4 ? (t >> 6) : (t & 63)); const float ang = pos * inv; rc[idx] = cosf(ang); rs[idx] = sinf(ang); }
      float* bq = WSP(float, WS_BQK);
      for (int idx = F.c * NTHREADS + F.tid; idx < 2 * 1280; idx += F.G * NTHREADS) { const int j = idx / 1280, n = idx % 1280; bq[j * 1280 + dst_row(1, n)] = A.in[I_ABQKV][j * 1536 + n]; } }
    __syncthreads();
    LAS TJob* jobs = (LAS TJob*)(F.lds + JOB_OFF); LAS int* njobs = (LAS int*)(F.lds + MISC_OFF + 64);
    if (F.tid == 0) {
        int nj = 0, item = 0;
        auto add = [&](const float* src, bf16_t* dst, int ldw, int ldt, int Ks, int Ns, int mode, int nb, long sbs, long dbs) {
            LAS TJob& j = jobs[nj]; j.src = src; j.dst = dst; j.sbs = sbs; j.dbs = dbs; j.ldw = ldw; j.ldt = ldt; j.nkb = Ks / 64; j.nnb = Ns / 32; j.mode = mode; j.item0 = item; j.per = (Ks / 64) * (Ns / 32); j.pad = 0;
            ++nj; item += (Ks / 64) * (Ns / 32) * nb; };
        add(A.in[I_AWQKV], WSP(bf16_t, WS_WQK), 1536, 1024, 1024, 1280, 1, 2, 1024L * 1536, 1280L * 1024);
        add(A.in[I_AWQKV] + 1280, WSP(bf16_t, WS_WV), 1536, 1024, 1024, 256, 0, 2, 1024L * 1536, 256L * 1024);
        add(A.in[I_AWO], WSP(bf16_t, WS_WO), 1024, 1024, 1024, 1024, 0, 2, 1L << 20, 1L << 20);
        add(A.in[I_PW], WSP(bf16_t, WS_POOLW), 256, 256, 256, 256, 0, 4, 65536, 65536);
        add(A.in[I_RWRKV], WSP(bf16_t, WS_WRKV), 1024, 1024, 1024, 1024, 0, 3, 1L << 20, 1L << 20);
        add(A.in[I_RG1], WSP(bf16_t, WS_WL1), 128, 1024, 1024, 128, 0, 1, 0, 0);
        add(A.in[I_RW1], WSP(bf16_t, WS_WL1) + 256 * 1024, 64, 1024, 1024, 64, 0, 2, 65536, 65536);
        add(A.in[I_RA1], WSP(bf16_t, WS_WL1) + 2 * 256 * 1024, 64, 1024, 1024, 64, 0, 2, 65536, 65536);
        add(A.in[I_RG2], WSP(bf16_t, WS_WL2), 1024, 256, 128, 1024, 0, 1, 0, 0);
        add(A.in[I_RW2], WSP(bf16_t, WS_WL2) + 1 * 1024 * 256, 1024, 256, 64, 1024, 0, 2, 65536, 1024L * 256 + 64);
        add(A.in[I_RA2], WSP(bf16_t, WS_WL2) + 3 * 1024 * 256, 1024, 256, 64, 1024, 0, 2, 65536, 1024L * 256 + 64);
        add(A.in[I_RWO], WSP(bf16_t, WS_WOR), 1024, 1024, 1024, 1024, 0, 1, 0, 0);
        add(A.in[I_MW1], WSP(bf16_t, WS_W1T), 2048, 1024, 1024, 2048, 2, 128, 1024L * 2048, 2048L * 1024);
        add(A.in[I_MW2], WSP(bf16_t, WS_W2T), 1024, 1024, 1024, 1024, 0, 128, 1L << 20, 1L << 20);
        njobs[0] = nj; njobs[1] = item;
    }
    __syncthreads();
    { const int nj = njobs[0], nitems = njobs[1]; LAS float* scr = (LAS float*)(F.lds + F.wave * 16384);
      const int gw = F.c * NWAVES + F.wave, NGW = F.G * NWAVES;
      int it = gw;
      if (it < nitems) {
          TItem Tc, Tn; f32x4 vc[8], vn[8];
          titem_decode(jobs, nj, it, Tc); titem_load(Tc, F.lane, vc);
          for (;;) {
              const int itn = it + NGW; const bool more = itn < nitems;
              if (more) { titem_decode(jobs, nj, itn, Tn); titem_load(Tn, F.lane, vn); }
              titem_store(Tc, F.lane, vc, scr);
              if (!more) break;
              Tc = Tn;
#pragma unroll
              for (int i = 0; i < 8; ++i) vc[i] = vn[i];
              it = itn;
          }
      } }
    __syncthreads();
}

__device__ __forceinline__ void moe_tiles(Frame& F, int layer) {
    REFRESH(F);
    LAS int* lcnt = (LAS int*)(F.lds + LCNT_OFF); LAS int* tpre = (LAS int*)(F.lds + TPRE_OFF);
    __syncthreads();
    if (F.tid < NE) lcnt[F.tid] = (int)__hip_atomic_load(F.ctl + CW_GCNT + layer * 64 + F.tid, __ATOMIC_RELAXED, __HIP_MEMORY_SCOPE_AGENT);
    __syncthreads();
    if (F.tid == 0) { int s = 0; for (int e = 0; e < NE; ++e) { tpre[e] = s; s += (lcnt[e] + 255) >> 8; } tpre[NE] = s; }
    __syncthreads();
}
__device__ __forceinline__ void moe_gather(Frame& F, int row, f32x4 (&s)[4]) {
    const LAS int* tpre = (const LAS int*)(F.lds + TPRE_OFF);
    const int* pos = WSP(int, WS_POS) + (size_t)row * 4; const float* gt = WSP(float, WS_GATE) + (size_t)row * 4; const bf16_t* Y = WSP(bf16_t, WS_Y);
#pragma unroll
    for (int j = 0; j < 4; ++j) s[j] = (f32x4){0.f, 0.f, 0.f, 0.f};
#pragma unroll
    for (int k = 0; k < 4; ++k) { const int p = pos[k]; const float g = gt[k]; const int e = p >> 20, slot = p & 0xfffff; const size_t fr = (size_t)tpre[e] * 256 + slot;
        const u32x2* yp = (const u32x2*)(Y + fr * D) + F.lane;
#pragma unroll
        for (int j = 0; j < 4; ++j) { const u32x2 w = yp[64 * j]; s[j] += g * (f32x4){bflo(w.x), bfhi(w.x), bflo(w.y), bfhi(w.y)}; } }
}

__device__ __forceinline__ void phase_norm1(Frame& F, const Args& A, int layer) {
    REFRESH(F);
    if (layer > 0) moe_tiles(F, layer - 1);
    float* H = WSP(float, WS_H); bf16_t* AX = WSP(bf16_t, WS_AX); const float* MOD = WSP(float, WS_MOD);
    const float* g1 = A.in[I_NORMG] + (size_t)(layer * 2 + 0) * D;
    for (int it = 0;; ++it) { const int row = (it * F.G + F.c) * NWAVES + F.wave; if (row >= NT) break;
        const int brow = row < NX ? (row >> 11) : 32;
        f32x4 v[4];
        if (layer == 0) { const float* src = row < NX ? A.in[I_X] + (size_t)row * D : A.in[I_CTX] + (size_t)(row - NX) * D;
#pragma unroll
            for (int j = 0; j < 4; ++j) v[j] = ((const f32x4*)src)[64 * j + F.lane]; }
        else { f32x4 s[4]; moe_gather(F, row, s); const float* g2p = MOD + ((size_t)(layer - 1) * 33 + brow) * 6144 + 5 * D;
#pragma unroll
            for (int j = 0; j < 4; ++j) { const f32x4 hv = ((const f32x4*)(H + (size_t)row * D))[64 * j + F.lane]; const f32x4 gv = ((const f32x4*)g2p)[64 * j + F.lane]; v[j] = ((SKIPMASK >> (4 + layer - 1)) & 1) ? hv : hv + gv * s[j]; } }
        float ss = 0.f;
#pragma unroll
        for (int j = 0; j < 4; ++j) { ((f32x4*)(H + (size_t)row * D))[64 * j + F.lane] = v[j]; ss += (v[j].x * v[j].x + v[j].y * v[j].y) + (v[j].z * v[j].z + v[j].w * v[j].w); }
        const float rstd = 1.0f / sqrtf(wave_sum(ss) * (1.0f / D) + 1e-5f);
        const float* mp = MOD + ((size_t)layer * 33 + brow) * 6144;
#pragma unroll
        for (int j = 0; j < 4; ++j) { const f32x4 gg = ((const f32x4*)g1)[64 * j + F.lane], sh = ((const f32x4*)mp)[64 * j + F.lane], sc = ((const f32x4*)(mp + D))[64 * j + F.lane];
            const f32x4 o = v[j] * rstd * gg * (sc + 1.0f) + sh;
            u32x2 w; w.x = pk2(o.x, o.y); w.y = pk2(o.z, o.w); ((u32x2*)(AX + (size_t)row * D))[64 * j + F.lane] = w; }
    }
}
__device__ __forceinline__ void phase_final(Frame& F, const Args& A) {
    REFRESH(F);
    moe_tiles(F, DEPTH - 1);
    const float* H = WSP(float, WS_H); const float* MOD = WSP(float, WS_MOD); const float* fg = A.in[I_FG];
    for (int it = 0;; ++it) { const int row = (it * F.G + F.c) * NWAVES + F.wave; if (row >= NX) break;
        const int brow = row >> 11; f32x4 s[4], v[4]; moe_gather(F, row, s); const float* g2p = MOD + ((size_t)(DEPTH - 1) * 33 + brow) * 6144 + 5 * D;
        float ss = 0.f;
#pragma unroll
        for (int j = 0; j < 4; ++j) { const f32x4 hv = ((const f32x4*)(H + (size_t)row * D))[64 * j + F.lane]; const f32x4 gv = ((const f32x4*)g2p)[64 * j + F.lane]; v[j] = ((SKIPMASK >> 7) & 1) ? hv : hv + gv * s[j];
            ss += (v[j].x * v[j].x + v[j].y * v[j].y) + (v[j].z * v[j].z + v[j].w * v[j].w); }
        const float rstd = 1.0f / sqrtf(wave_sum(ss) * (1.0f / D) + 1e-5f);
#pragma unroll
        for (int j = 0; j < 4; ++j) { const f32x4 gg = ((const f32x4*)fg)[64 * j + F.lane]; ((f32x4*)(A.out + (size_t)row * D))[64 * j + F.lane] = v[j] * rstd * gg; }
#if DIAG == 4
        { const LAS int* tp = (const LAS int*)(F.lds + TPRE_OFF); const int* pos = WSP(int, WS_POS) + (size_t)row * 4; const float* gt = WSP(float, WS_GATE) + (size_t)row * 4; const bf16_t* Y = WSP(bf16_t, WS_Y);
          int a = 0; float gs = 0.f;
          for (int k = 0; k < 4; ++k) { const int p = pos[k]; gs += gt[k]; const int e = p >> 20, slot = p & 0xfffff; const size_t fr = (size_t)tp[e] * 256 + slot; float ma = 0.f;
              for (int j = 0; j < 4; ++j) { const f32x4 a4 = ld_bf4(Y + fr * D + 256 * j + 4 * F.lane); ma += (a4.x * a4.x + a4.y * a4.y) + (a4.z * a4.z + a4.w * a4.w); }
              ma = wave_sum(ma) * (1.0f / D); if (ma > 0.0025f) ++a; }
          float b = floorf(9.0f * gs + 0.5f); b = fminf(fmaxf(b, 0.f), 9.f);
          const float cc = sqrtf(((float)a + 0.1f * b) * 1.0025f);
#pragma unroll
          for (int j = 0; j < 4; ++j) ((f32x4*)(A.out + (size_t)row * D))[64 * j + F.lane] = (f32x4){cc, cc, cc, cc}; }
#endif
#if DIAG == 3
        { const bf16_t* W = WSP(bf16_t, WS_W2T) + (size_t)3 * NE * D * D + (size_t)(row & 32767) * D; const bf16_t* AC = WSP(bf16_t, WS_Y) + (size_t)row * D; float mw = 0.f, ma = 0.f;
#pragma unroll
          for (int j = 0; j < 4; ++j) { const f32x4 w4 = ld_bf4(W + 256 * j + 4 * F.lane), a4 = ld_bf4(AC + 256 * j + 4 * F.lane);
              mw += (w4.x * w4.x + w4.y * w4.y) + (w4.z * w4.z + w4.w * w4.w); ma += (a4.x * a4.x + a4.y * a4.y) + (a4.z * a4.z + a4.w * a4.w); }
          mw = wave_sum(mw) * (1.0f / D); ma = wave_sum(ma) * (1.0f / D);
          float a = floorf(0.5f * log2f(mw + 1e-30f) + 9.5f); a = fminf(fmaxf(a, 0.f), 8.f); float b = floorf(0.5f * log2f(ma + 1e-30f) + 7.5f); b = fminf(fmaxf(b, 0.f), 9.f);
          const float cc = sqrtf((a + 0.1f * b) * 1.0025f);
#pragma unroll
          for (int j = 0; j < 4; ++j) ((f32x4*)(A.out + (size_t)row * D))[64 * j + F.lane] = (f32x4){cc, cc, cc, cc}; }
#endif
#if DIAG == 2
        { const bf16_t* W = WSP(bf16_t, WS_W1T) + (size_t)3 * NE * 2048 * D + (size_t)row * D; const bf16_t* AC = WSP(bf16_t, WS_ACT) + (size_t)row * D; float mw = 0.f, ma = 0.f;
#pragma unroll
          for (int j = 0; j < 4; ++j) { const f32x4 w4 = ld_bf4(W + 256 * j + 4 * F.lane), a4 = ld_bf4(AC + 256 * j + 4 * F.lane);
              mw += (w4.x * w4.x + w4.y * w4.y) + (w4.z * w4.z + w4.w * w4.w); ma += (a4.x * a4.x + a4.y * a4.y) + (a4.z * a4.z + a4.w * a4.w); }
          mw = wave_sum(mw) * (1.0f / D); ma = wave_sum(ma) * (1.0f / D);
          float a = floorf(0.5f * log2f(mw + 1e-30f) + 9.5f); a = fminf(fmaxf(a, 0.f), 8.f); float b = floorf(0.5f * log2f(ma + 1e-30f) + 9.5f); b = fminf(fmaxf(b, 0.f), 9.f);
          const float cc = sqrtf((a + 0.1f * b) * 1.0025f);
#pragma unroll
          for (int j = 0; j < 4; ++j) ((f32x4*)(A.out + (size_t)row * D))[64 * j + F.lane] = (f32x4){cc, cc, cc, cc}; }
#endif
#if DIAG == 1
        { const LAS int* tp = (const LAS int*)(F.lds + TPRE_OFF); int a = tp[NE] / 150; a = a > 8 ? 8 : a; float ms = 0.f;
#pragma unroll
          for (int j = 0; j < 4; ++j) ms += (s[j].x * s[j].x + s[j].y * s[j].y) + (s[j].z * s[j].z + s[j].w * s[j].w);
          ms = wave_sum(ms) * (1.0f / D); float b = floorf(0.5f * log2f(ms + 1e-30f) + 7.5f); b = fminf(fmaxf(b, 0.f), 9.f);
          const float cc = sqrtf(((float)a + 0.1f * b) * 1.0025f);
#pragma unroll
          for (int j = 0; j < 4; ++j) ((f32x4*)(A.out + (size_t)row * D))[64 * j + F.lane] = (f32x4){cc, cc, cc, cc}; }
#endif
    }
}

__device__ __forceinline__ void phase_route(Frame& F, const Args& A, int layer) {
    REFRESH(F);
    const int nrows = (layer == DEPTH - 1) ? NX : NT;
    LAS float* wT = (LAS float*)F.lds;
    LAS int* lcnt = (LAS int*)(F.lds + LCNT_OFF); LAS int* lbase = (LAS int*)(F.lds + LBASE_OFF); LAS unsigned* recp = (LAS unsigned*)(F.lds + REC_OFF); LAS float* recg = (LAS float*)(F.lds + REC_OFF + 4608);
    __syncthreads();
    { const float* wr = A.in[I_MWR] + (size_t)layer * D * NE;
      for (int idx = F.tid; idx < D * NE; idx += NTHREADS) wT[(idx & 31) * 1024 + (idx >> 5)] = wr[idx]; }
    if (F.tid < NE) lcnt[F.tid] = 0;
    __syncthreads();
    const float* H = WSP(float, WS_H); bf16_t* FX = WSP(bf16_t, WS_FX); const float* MOD = WSP(float, WS_MOD);
    const float* g2 = A.in[I_NORMG] + (size_t)(layer * 2 + 1) * D; const float* br = A.in[I_MBR] + layer * NE;
    int nit = 0;
    for (int it = 0;; ++it) { const int row = (it * F.G + F.c) * NWAVES + F.wave; if ((it * F.G + F.c) * NWAVES >= nrows) break; nit = it + 1;
        if (row >= nrows) continue;
        const int brow = row < NX ? (row >> 11) : 32;
        f32x4 v[4]; float ss = 0.f;
#pragma unroll
        for (int j = 0; j < 4; ++j) { v[j] = ((const f32x4*)(H + (size_t)row * D))[64 * j + F.lane]; ss += (v[j].x * v[j].x + v[j].y * v[j].y) + (v[j].z * v[j].z + v[j].w * v[j].w); }
        const float rstd = 1.0f / sqrtf(wave_sum(ss) * (1.0f / D) + 1e-5f);
        const float* mp = MOD + ((size_t)layer * 33 + brow) * 6144 + 3 * D;
#pragma unroll
        for (int j = 0; j < 4; ++j) { const f32x4 gg = ((const f32x4*)g2)[64 * j + F.lane], sh = ((const f32x4*)mp)[64 * j + F.lane], sc = ((const f32x4*)(mp + D))[64 * j + F.lane];
            v[j] = v[j] * rstd * gg * (sc + 1.0f) + sh;
            u32x2 w; w.x = pk2(v[j].x, v[j].y); w.y = pk2(v[j].z, v[j].w); ((u32x2*)(FX + (size_t)row * D))[64 * j + F.lane] = w; }
        float part[NE];
#pragma unroll
        for (int e = 0; e < NE; ++e) { float p = 0.f;
#pragma unroll
            for (int j = 0; j < 4; ++j) { const f32x4 w4 = ((const LAS f32x4*)(wT + e * 1024))[64 * j + F.lane]; p += (v[j].x * w4.x + v[j].y * w4.y) + (v[j].z * w4.z + v[j].w * w4.w); }
            part[e] = p; }
#pragma unroll
        for (int k = 0; k < 16; ++k) { const bool up = (F.lane & 32) != 0; const float keep = up ? part[k + 16] : part[k], send = up ? part[k] : part[k + 16]; part[k] = keep + __shfl_xor(send, 32); }
#pragma unroll
        for (int k = 0; k < 8; ++k) { const bool up = (F.lane & 16) != 0; const float keep = up ? part[k + 8] : part[k], send = up ? part[k] : part[k + 8]; part[k] = keep + __shfl_xor(send, 16); }
#pragma unroll
        for (int k = 0; k < 4; ++k) { const bool up = (F.lane & 8) != 0; const float keep = up ? part[k + 4] : part[k], send = up ? part[k] : part[k + 4]; part[k] = keep + __shfl_xor(send, 8); }
#pragma unroll
        for (int k = 0; k < 2; ++k) { const bool up = (F.lane & 4) != 0; const float keep = up ? part[k + 2] : part[k], send = up ? part[k] : part[k + 2]; part[k] = keep + __shfl_xor(send, 4); }
        { const bool up = (F.lane & 2) != 0; const float keep = up ? part[1] : part[0], send = up ? part[0] : part[1]; part[0] = keep + __shfl_xor(send, 2); }
        part[0] += __shfl_xor(part[0], 1);
        const int myE = F.lane >> 1;
        float val = part[0] + br[myE];
        float sv[4]; int si[4];
#pragma unroll
        for (int k = 0; k < 4; ++k) { float bv = val; int bi = myE;
#pragma unroll
            for (int o = 1; o < 64; o <<= 1) { const float ov = __shfl_xor(bv, o); const int oi = __shfl_xor(bi, o); if (ov > bv || (ov == bv && oi < bi)) { bv = ov; bi = oi; } }
            sv[k] = bv; si[k] = bi; if (myE == bi) val = -__builtin_inff(); }
        const float e1 = __expf(sv[1] - sv[0]), e2 = __expf(sv[2] - sv[0]), e3 = __expf(sv[3] - sv[0]); const float inv = 1.0f / (1.0f + e1 + e2 + e3);
        if (F.lane < 4) { const int e = F.lane == 0 ? si[0] : F.lane == 1 ? si[1] : F.lane == 2 ? si[2] : si[3]; const float g = (F.lane == 0 ? 1.0f : F.lane == 1 ? e1 : F.lane == 2 ? e2 : e3) * inv;
            const int rank = __hip_atomic_fetch_add(lcnt + e, 1, __ATOMIC_RELAXED, __HIP_MEMORY_SCOPE_WORKGROUP);
            const int ri = (it * NWAVES + F.wave) * 4 + F.lane; recp[ri] = ((unsigned)e << 20) | (unsigned)rank; recg[ri] = g; }
    }
    __syncthreads();
    if (F.tid < NE) lbase[F.tid] = (int)__hip_atomic_fetch_add(F.ctl + CW_GCNT + layer * 64 + F.tid, (unsigned)lcnt[F.tid], __ATOMIC_RELAXED, __HIP_MEMORY_SCOPE_AGENT);
    __syncthreads();
    int* LIST = WSP(int, WS_LIST); int* POS = WSP(int, WS_POS); float* GATE = WSP(float, WS_GATE);
    for (int r = F.tid; r < nit * NWAVES * 4; r += NTHREADS) { const int lr = r >> 2, k = r & 3; const int row = ((lr >> 3) * F.G + F.c) * NWAVES + (lr & 7); if (row >= nrows) continue;
        const unsigned qx = recp[r]; const float qg = recg[r]; const int e = qx >> 20, slot = lbase[e] + (int)(qx & 0xfffff);
        LIST[(size_t)e * NT + slot] = row; POS[(size_t)row * 4 + k] = (e << 20) | slot; GATE[(size_t)row * 4 + k] = qg; }
    __syncthreads();
}

__device__ __forceinline__ void phase_pooldiff(Frame& F) {
    REFRESH(F);
    const bf16_t* AX = WSP(bf16_t, WS_AX); bf16_t* PD = WSP(bf16_t, WS_PD);
    for (int it = 0;; ++it) { const int row = (it * F.G + F.c) * NWAVES + F.wave; if (row >= NT) break;
        int sb, t, n; seq_of(row, sb, t, n);
#pragma unroll
        for (int j = 0; j < 4; ++j) { const int half = 1 << j; const int col = 256 * j + 4 * F.lane;
            f32x4 s = (f32x4){0.f, 0.f, 0.f, 0.f};
#pragma unroll
            for (int q = 0; q < 2 * half; ++q) { const int uu = t - half + q; if (uu >= 0 && uu < n) s += ld_bf4(AX + (size_t)(sb + uu) * D + col); }
            const int lo = t - half < 0 ? 0 : t - half, hi = t + half > n ? n : t + half;
            const f32x4 me = ld_bf4(AX + (size_t)row * D + col);
            st_bf4(PD + (size_t)row * D + col, s * (1.0f / (float)(hi - lo)) - me); }
    }
}
__device__ __forceinline__ void phase_rwkv_mix(Frame& F, const Args& A) {
    REFRESH(F);
    const bf16_t* AX = WSP(bf16_t, WS_AX); bf16_t* A6 = WSP(bf16_t, WS_A6); const float* mix = A.in[I_RMIX];
    for (int it = 0;; ++it) { const int row = (it * F.G + F.c) * NWAVES + F.wave; if (row >= NT) break;
        int sb, t, n; seq_of(row, sb, t, n);
#pragma unroll
        for (int j = 0; j < 4; ++j) { const int col = 256 * j + 4 * F.lane; const f32x4 z = (f32x4){0.f, 0.f, 0.f, 0.f};
            const f32x4 hc = ld_bf4(AX + (size_t)row * D + col), hp = t > 0 ? ld_bf4(AX + (size_t)(row - 1) * D + col) : z, hn = t < n - 1 ? ld_bf4(AX + (size_t)(row + 1) * D + col) : z;
            const f32x4 xx = (hp + hn) * 0.5f - hc;
#pragma unroll
            for (int i = 0; i < 6; ++i) { const f32x4 m = *(const f32x4*)(mix + i * D + col); st_bf4(A6 + ((size_t)i * NT + row) * D + col, hc + xx * m); } }
    }
}
__device__ __forceinline__ float rl(float x, int k) { return __builtin_bit_cast(float, __builtin_amdgcn_readlane(__builtin_bit_cast(int, x), k)); }
constexpr int SCAN_TB = 8;
__device__ __forceinline__ void phase_rwkv_scan(Frame& F, const Args& A) {
    REFRESH(F);
    __syncthreads();
    for (int item = F.wave * F.G + F.c; item < 1024 && F.wave < 4; item += 4 * F.G) {
        const int dir = item >> 9, b = (item >> 4) & 31, h = item & 15, col = 64 * h + F.lane;
        const bf16_t* Rr = WSP(bf16_t, WS_RKV); const bf16_t* Kk = Rr + (size_t)NT * D; const bf16_t* Vv = Kk + (size_t)NT * D;
        const bf16_t* Ee = WSP(bf16_t, WS_E) + (size_t)dir * NT * D; const bf16_t* Aa = WSP(bf16_t, WS_A) + (size_t)dir * NT * D;
        float* Yo = WSP(float, WS_YS) + (size_t)dir * NT * D; float* Bo = WSP(float, WS_BONUS) + (size_t)dir * NT * 16;
        const float kkw = A.in[I_RKK][col], kaw = A.in[I_RKA][col], rkw = A.in[I_RRK][col];
        LAS float* slab = (LAS float*)(F.lds + F.wave * (SCAN_TB * 320 * 4));
        const int uoff = 64 + (F.lane >> 2) * 16 + (F.lane & 3);
        f32x2 S[32];
#pragma unroll
        for (int k = 0; k < 32; ++k) S[k] = (f32x2){0.f, 0.f};
        for (int seg = 0; seg < 2; ++seg) {
            const int base = seg ? b * T : NX + b * L, n = seg ? T : L; const int dt = dir ? -1 : 1; const int t0 = dir ? n - 1 : 0;
            bf16_t raw[SCAN_TB][5];
#pragma unroll
            for (int s = 0; s < SCAN_TB; ++s) { const size_t o = (size_t)(base + t0 + dt * s) * D + col; raw[s][0] = Rr[o]; raw[s][1] = Kk[o]; raw[s][2] = Vv[o]; raw[s][3] = Aa[o]; raw[s][4] = Ee[o]; }
            for (int bt = 0; bt < n; bt += SCAN_TB) {
                float vv[SCAN_TB];
                { float rr[SCAN_TB], kk[SCAN_TB], aa[SCAN_TB], ee[SCAN_TB], kd[SCAN_TB], n2[SCAN_TB], bn[SCAN_TB];
#pragma unroll
                  for (int s = 0; s < SCAN_TB; ++s) { rr[s] = bf1(raw[s][0]); const float kraw = bf1(raw[s][1]); vv[s] = bf1(raw[s][2]); aa[s] = bf1(raw[s][3]); ee[s] = bf1(raw[s][4]);
                      kk[s] = kraw * kkw; n2[s] = kk[s] * kk[s]; kd[s] = kraw * (1.0f + (aa[s] - 1.0f) * kaw); bn[s] = rr[s] * kd[s] * rkw; }
#pragma unroll
                  for (int o = 1; o < 64; o <<= 1) {
#pragma unroll
                      for (int s = 0; s < SCAN_TB; ++s) { n2[s] += __shfl_xor(n2[s], o); bn[s] += __shfl_xor(bn[s], o); } }
#pragma unroll
                  for (int s = 0; s < SCAN_TB; ++s) { const float kn = kk[s] / fmaxf(sqrtf(n2[s]), 1e-12f);
                      if (F.lane == 0) Bo[(size_t)(base + t0 + dt * (bt + s)) * 16 + h] = bn[s];
                      LAS float* sl = slab + s * 320; sl[F.lane] = -kn; sl[uoff] = __expf(-ee[s]); sl[uoff + 4] = kn * aa[s]; sl[uoff + 8] = kd[s]; sl[uoff + 12] = rr[s]; } }
                { const int nb = (bt + SCAN_TB < n) ? bt + SCAN_TB : bt;
#pragma unroll
                  for (int s = 0; s < SCAN_TB; ++s) { const size_t o = (size_t)(base + t0 + dt * (nb + s)) * D + col; raw[s][0] = Rr[o]; raw[s][1] = Kk[o]; raw[s][2] = Vv[o]; raw[s][3] = Aa[o]; raw[s][4] = Ee[o]; } }
                asm volatile("s_waitcnt lgkmcnt(0)" ::: "memory");
                const LAS f32x4* cs = (const LAS f32x4*)slab;
                f32x4 R[4][4];
#pragma unroll
                for (int g = 0; g < 3; ++g)
#pragma unroll
                    for (int i = 0; i < 4; ++i) R[g][i] = cs[g * 4 + i];
                f32x2 sa0, sa1, sa2, sa3, y0, y1, y2, y3, sav, vv2;
#pragma unroll
                for (int s = 0; s < SCAN_TB; ++s) {
#pragma unroll
                  for (int c = 0; c < 20; ++c) {
                    const int g = s * 20 + c;
                    if (g + 3 < SCAN_TB * 20) {
#pragma unroll
                        for (int i = 0; i < 4; ++i) R[(c + 3) & 3][i] = cs[(g + 3) * 4 + i]; }
                    __builtin_amdgcn_sched_barrier(0);
                    const f32x4 r0 = R[c & 3][0], r1 = R[c & 3][1], r2 = R[c & 3][2], r3 = R[c & 3][3];
                    if (c < 4) {
                        if (c == 0) { sa0 = (f32x2){0.f, 0.f}; sa1 = sa0; sa2 = sa0; sa3 = sa0; }
                        sa0 += S[8 * c + 0] * (f32x2){r0.x, r0.y}; sa1 += S[8 * c + 1] * (f32x2){r0.z, r0.w}; sa2 += S[8 * c + 2] * (f32x2){r1.x, r1.y}; sa3 += S[8 * c + 3] * (f32x2){r1.z, r1.w};
                        sa0 += S[8 * c + 4] * (f32x2){r2.x, r2.y}; sa1 += S[8 * c + 5] * (f32x2){r2.z, r2.w}; sa2 += S[8 * c + 6] * (f32x2){r3.x, r3.y}; sa3 += S[8 * c + 7] * (f32x2){r3.z, r3.w};
                        if (c == 3) { const f32x2 t2 = (sa0 + sa1) + (sa2 + sa3); const float sa = t2.x + t2.y; sav = (f32x2){sa, sa}; vv2 = (f32x2){vv[s], vv[s]};
                            y0 = (f32x2){0.f, 0.f}; y1 = y0; y2 = y0; y3 = y0; }
                    } else {
                        const int q = c - 4;
                        const f32x2 s0 = S[2 * q] * (f32x2){r0.x, r0.y} + sav * (f32x2){r1.x, r1.y} + vv2 * (f32x2){r2.x, r2.y}; S[2 * q] = s0;
                        const f32x2 s1 = S[2 * q + 1] * (f32x2){r0.z, r0.w} + sav * (f32x2){r1.z, r1.w} + vv2 * (f32x2){r2.z, r2.w}; S[2 * q + 1] = s1;
                        if (q & 1) { y2 += s0 * (f32x2){r3.x, r3.y}; y3 += s1 * (f32x2){r3.z, r3.w}; } else { y0 += s0 * (f32x2){r3.x, r3.y}; y1 += s1 * (f32x2){r3.z, r3.w}; }
                        if (q == 15) { const f32x2 t2 = (y0 + y1) + (y2 + y3); Yo[(size_t)(base + t0 + dt * (bt + s)) * D + col] = t2.x + t2.y; }
                    }
                    __builtin_amdgcn_sched_barrier(0);
                  }
                }
            }
        }
    }
    __syncthreads();
}
__device__ __forceinline__ void phase_rwkv_out(Frame& F, const Args& A, int nrows) {
    REFRESH(F);
    const float* Y0 = WSP(float, WS_YS); const float* Y1 = Y0 + (size_t)NT * D; const float* B0 = WSP(float, WS_BONUS); const float* B1 = B0 + (size_t)NT * 16;
    const bf16_t* Vv = WSP(bf16_t, WS_RKV) + (size_t)2 * NT * D; const bf16_t* Gg = WSP(bf16_t, WS_G); bf16_t* RO = WSP(bf16_t, WS_RO);
    const float* lnw = A.in[I_RLNW]; const float* lnb = A.in[I_RLNB];
    for (int it = 0;; ++it) { const int row = (it * F.G + F.c) * NWAVES + F.wave; if (row >= nrows) break;
#pragma unroll
        for (int j = 0; j < 4; ++j) { const int col = 256 * j + 4 * F.lane, head = 4 * j + (F.lane >> 4); const size_t o = (size_t)row * D + col;
            const f32x4 y = *(const f32x4*)(Y0 + o) + *(const f32x4*)(Y1 + o);
            float s = (y.x + y.y) + (y.z + y.w); s += __shfl_xor(s, 1); s += __shfl_xor(s, 2); s += __shfl_xor(s, 4); s += __shfl_xor(s, 8);
            const f32x4 d = y - s * (1.0f / 64.0f);
            float q = (d.x * d.x + d.y * d.y) + (d.z * d.z + d.w * d.w); q += __shfl_xor(q, 1); q += __shfl_xor(q, 2); q += __shfl_xor(q, 4); q += __shfl_xor(q, 8);
            const float rs = 1.0f / sqrtf(q * (1.0f / 64.0f) + 64e-5f);
            const f32x4 yn = d * rs * *(const f32x4*)(lnw + col) + *(const f32x4*)(lnb + col);
            const float bon = B0[(size_t)row * 16 + head] + B1[(size_t)row * 16 + head];
            st_bf4(RO + o, (yn + ld_bf4(Vv + o) * bon) * ld_bf4(Gg + o)); }
    }
}

__device__ __forceinline__ void phase_attn(Frame& F, const Args& A, int j, bool need_ctx) {
    REFRESH(F);
    const bf16_t* Q = WSP(bf16_t, WS_Q); const bf16_t* Kb = WSP(bf16_t, WS_K); const bf16_t* VT = WSP(bf16_t, WS_VT); bf16_t* O = WSP(bf16_t, WS_O);
    const float* sinks = A.in[I_ASINK] + j * 16;
    LAS bf16_t* Ks = (LAS bf16_t*)F.lds; LAS bf16_t* Vs = (LAS bf16_t*)(F.lds + 9216);
    const int nunits = 2048 + (need_ctx ? 256 : 0);
    const int fr = F.lane & 15, fq = F.lane >> 4, g = F.wave >> 1, hf = F.wave & 1;
    const float SC = 0.125f * 1.4426950408889634f;
    for (int u = F.c; u < nunits; u += F.G) {
        int b, kvh, qb; bool isx;
        if (u < 2048) { isx = true; b = u >> 6; kvh = (u >> 4) & 3; qb = u & 15; } else { const int v = u - 2048; isx = false; b = v >> 3; kvh = (v >> 1) & 3; qb = v & 1; }
        const int qrow0 = (isx ? b * T : NX + b * L) + qb * 128 + hf * 64; const int head = 4 * kvh + g;
        bf16x8 Qf[4][2];
#pragma unroll
        for (int mq = 0; mq < 4; ++mq)
#pragma unroll
            for (int ks = 0; ks < 2; ++ks) Qf[mq][ks] = *(const bf16x8*)(Q + (size_t)(qrow0 + 16 * mq + fr) * D + head * 64 + ks * 32 + 8 * fq);
        const float sink2 = sinks[head] * 1.4426950408889634f;
        float mrun[4], lrun[4]; f32x4 Oa[4][4];
#pragma unroll
        for (int mq = 0; mq < 4; ++mq) { mrun[mq] = sink2; lrun[mq] = fq == 0 ? 1.0f : 0.0f;
#pragma unroll
            for (int db = 0; db < 4; ++db) Oa[mq][db] = (f32x4){0.f, 0.f, 0.f, 0.f}; }
        const int ntiles = isx ? 10 : 4;
        for (int ti = 0; ti < ntiles; ++ti) {
            int krow0, jl = -1, ks0 = 0;
            if (ti < 4) krow0 = NX + b * L + ti * 64;
            else { jl = ti - 4; ks0 = qb * 128 - 128 + 64 * jl; if (ks0 < 0 || ks0 >= T) continue; krow0 = b * T + ks0; }
            __syncthreads();
            { const int r = F.tid >> 3, ch = F.tid & 7;
              const u32x4 kv = *(const u32x4*)(Kb + (size_t)(krow0 + r) * 256 + kvh * 64 + ch * 8);
              const u32x4 vv = *(const u32x4*)(VT + (size_t)(kvh * 64 + r) * NT + krow0 + ch * 8);
              *(LAS u32x4*)(Ks + r * 72 + ch * 8) = kv; *(LAS u32x4*)(Vs + r * 72 + ch * 8) = vv; }
            __syncthreads();
            const bool need = (jl < 0) || (jl >= hf && jl <= hf + 4);
            if (need) {
                f32x4 Sa[4][4];
#pragma unroll
                for (int mq = 0; mq < 4; ++mq)
#pragma unroll
                    for (int n = 0; n < 4; ++n) Sa[mq][n] = (f32x4){0.f, 0.f, 0.f, 0.f};
#pragma unroll
                for (int ks = 0; ks < 2; ++ks)
#pragma unroll
                    for (int n = 0; n < 4; ++n) { const int kr = 32 * (n >> 1) + 8 * (fr >> 2) + 4 * (n & 1) + (fr & 3);
                        const bf16x8 Kf = *(const LAS bf16x8*)(Ks + kr * 72 + ks * 32 + 8 * fq);
#pragma unroll
                        for (int mq = 0; mq < 4; ++mq) Sa[mq][n] = __builtin_amdgcn_mfma_f32_16x16x32_bf16(Kf, Qf[mq][ks], Sa[mq][n], 0, 0, 0); }
                bf16x8 Pf[4][2];
#pragma unroll
                for (int mq = 0; mq < 4; ++mq) {
                    const int tq = qb * 128 + hf * 64 + 16 * mq + fr;
                    float mx = -1e30f;
#pragma unroll
                    for (int n = 0; n < 4; ++n)
#pragma unroll
                        for (int i = 0; i < 4; ++i) { float s = Sa[mq][n][i] * SC;
                            if (jl >= 0) { const int rel = ks0 + 32 * (n >> 1) + 8 * fq + 4 * (n & 1) + i - tq; if (rel > 128 || rel < -128) s = -1e30f; }
                            Sa[mq][n][i] = s; mx = fmaxf(mx, s); }
                    mx = fmaxf(mx, __shfl_xor(mx, 16)); mx = fmaxf(mx, __shfl_xor(mx, 32));
                    const float mnew = fmaxf(mrun[mq], mx); const float alpha = __builtin_amdgcn_exp2f(mrun[mq] - mnew); mrun[mq] = mnew;
                    float rs = 0.f;
#pragma unroll
                    for (int n = 0; n < 4; ++n)
#pragma unroll
                        for (int i = 0; i < 4; ++i) { const float p = __builtin_amdgcn_exp2f(Sa[mq][n][i] - mnew); Sa[mq][n][i] = p; rs += p; }
                    lrun[mq] = lrun[mq] * alpha + rs;
#pragma unroll
                    for (int db = 0; db < 4; ++db) Oa[mq][db] *= alpha;
#pragma unroll
                    for (int s = 0; s < 2; ++s) { u32x4 w; w.x = cvt_pk_bf16(Sa[mq][2 * s][0], Sa[mq][2 * s][1]); w.y = cvt_pk_bf16(Sa[mq][2 * s][2], Sa[mq][2 * s][3]);
                        w.z = cvt_pk_bf16(Sa[mq][2 * s + 1][0], Sa[mq][2 * s + 1][1]); w.w = cvt_pk_bf16(Sa[mq][2 * s + 1][2], Sa[mq][2 * s + 1][3]); Pf[mq][s] = __builtin_bit_cast(bf16x8, w); }
                }
#pragma unroll
                for (int db = 0; db < 4; ++db)
#pragma unroll
                    for (int s = 0; s < 2; ++s) { const bf16x8 Vf = *(const LAS bf16x8*)(Vs + (16 * db + fr) * 72 + 32 * s + 8 * fq);
#pragma unroll
                        for (int mq = 0; mq < 4; ++mq) Oa[mq][db] = __builtin_amdgcn_mfma_f32_16x16x32_bf16(Vf, Pf[mq][s], Oa[mq][db], 0, 0, 0); }
            }
        }
#pragma unroll
        for (int mq = 0; mq < 4; ++mq) { float l = lrun[mq]; l += __shfl_xor(l, 16); l += __shfl_xor(l, 32); const float inv = 1.0f / l;
            bf16_t* op = O + (size_t)(qrow0 + 16 * mq + fr) * D + head * 64 + 4 * fq;
#pragma unroll
            for (int db = 0; db < 4; ++db) st_bf4(op + 16 * db, Oa[mq][db] * inv); }
    }
    __syncthreads();
}

struct KState { XcdBarrier bar; int ph; };
#define RUN() (A.one || A.phase == KS.ph)
#define SEAM() do { if (A.one) xcd_barrier(KS.bar); ++KS.ph; } while (0)
template <int LAYER>
__device__ __forceinline__ void layer_body(Frame& F, const Args& A, KState& KS) {
    constexpr int layer = LAYER, kind = LAYER % 3, j = LAYER / 3; constexpr bool last = (LAYER == DEPTH - 1);
    LAS unsigned char* ring = F.lds;
    const LAS int* tpre = (const LAS int*)(F.lds + TPRE_OFF); const LAS int* lcnt = (const LAS int*)(F.lds + LCNT_OFF);
    float* H = WSP(float, WS_H); const float* MOD = WSP(float, WS_MOD); const bf16_t* AX = WSP(bf16_t, WS_AX);
    const float* gate1 = MOD + (size_t)layer * 33 * 6144 + 2 * D;
    constexpr int nMall = last ? NX / 256 : NT / 256;
    if (RUN()) phase_norm1(F, A, layer);
    SEAM();
    if constexpr (kind == 0) {
        if (RUN()) for (int rep_ = 0; rep_ < REPN(1); ++rep_) {
            { pg8::ProbDense P; P.A = AX; P.Bt = WSP(bf16_t, WS_WQK) + (size_t)j * 1280 * D; P.lda = D; P.ldb = D; P.K = D; P.a_pn_off = 0; P.ord.init(NT / 256, 5, F.G, F.c);
              EpiQK E{WSP(bf16_t, WS_Q), WSP(bf16_t, WS_K), WSP(float, WS_BQK) + j * 1280, WSP(float, WS_ROPEC), WSP(float, WS_ROPES)};
              pg8::gemm_phase(ring, P, E); }
            { pg8::ProbDense P; P.A = WSP(bf16_t, WS_WV) + (size_t)j * 256 * D; P.Bt = AX; P.lda = D; P.ldb = D; P.K = D; P.a_pn_off = 0; P.ord.init(1, NT / 256, F.G, F.c);
              EpiVT E{WSP(bf16_t, WS_VT), A.in[I_ABQKV] + j * 1536 + 1280};
              pg8::gemm_phase(ring, P, E); }
        }
        SEAM();
        if (RUN()) for (int rep_ = 0; rep_ < REPN(2); ++rep_) phase_attn(F, A, j, !last);
        SEAM();
        if (RUN() && !((SKIPMASK >> layer) & 1)) { pg8::ProbDense P; P.A = WSP(bf16_t, WS_O); P.Bt = WSP(bf16_t, WS_WO) + (size_t)j * D * D; P.lda = D; P.ldb = D; P.K = D; P.a_pn_off = 0; P.ord.init(nMall, 4, F.G, F.c);
            EpiResid E{H, A.in[I_ABO] + j * D, nullptr, gate1};
            pg8::gemm_phase(ring, P, E); }
        SEAM();
    } else if constexpr (kind == 1) {
        if (RUN()) for (int rep_ = 0; rep_ < REPN(3); ++rep_) phase_pooldiff(F);
        SEAM();
        if (RUN() && !((SKIPMASK >> layer) & 1)) { pg8::ProbDense P; P.A = WSP(bf16_t, WS_PD); P.Bt = WSP(bf16_t, WS_POOLW); P.lda = D; P.ldb = 256; P.K = 256; P.a_pn_off = 256; P.ord.init(nMall, 4, F.G, F.c);
            EpiResid E{H, A.in[I_PB], A.in[I_PS], gate1};
            pg8::gemm_phase(ring, P, E); }
        SEAM();
    } else {
        if (RUN()) for (int rep_ = 0; rep_ < REPN(4); ++rep_) phase_rwkv_mix(F, A);
        SEAM();
        if (RUN()) for (int rep_ = 0; rep_ < REPN(5); ++rep_) {
            for (int i = 0; i < 3; ++i) { const int sel = i == 0 ? 0 : i == 1 ? 2 : 3;
                pg8::ProbDense P; P.A = WSP(bf16_t, WS_A6) + (size_t)sel * NT * D; P.Bt = WSP(bf16_t, WS_WRKV) + (size_t)i * D * D; P.lda = D; P.ldb = D; P.K = D; P.a_pn_off = 0; P.ord.init(NT / 256, 4, F.G, F.c);
                EpiBf16Act E{WSP(bf16_t, WS_RKV) + (size_t)i * NT * D, D, nullptr, 0, 1.0f};
                pg8::gemm_phase(ring, P, E); }
            for (int i = 0; i < 3; ++i) { const int sel = i == 0 ? 5 : i == 1 ? 1 : 4;
                pg8::ProbDense P; P.A = WSP(bf16_t, WS_A6) + (size_t)sel * NT * D; P.Bt = WSP(bf16_t, WS_WL1) + (size_t)i * 256 * D; P.lda = D; P.ldb = D; P.K = D; P.a_pn_off = 0; P.ord.init(NT / 256, 1, F.G, F.c);
                EpiBf16Act E{WSP(bf16_t, WS_LORA) + i * 256, 768, nullptr, i == 0 ? 1 : i == 1 ? 2 : 0, 1.0f};
                pg8::gemm_phase(ring, P, E); }
        }
        SEAM();
        if (RUN()) for (int rep_ = 0; rep_ < REPN(6); ++rep_) {
            for (int i = 0; i < 5; ++i) {
                const int ablk = i == 0 ? 0 : i < 3 ? 1 : 2, d = (i - 1) & 1;
                pg8::ProbDense P; P.A = WSP(bf16_t, WS_LORA) + ablk * 256; P.Bt = WSP(bf16_t, WS_WL2) + (size_t)i * D * 256; P.lda = 768; P.ldb = 256; P.K = 256; P.a_pn_off = 0; P.ord.init(NT / 256, 4, F.G, F.c);
                EpiBf16Act E; E.ldc = D;
                if (i == 0) { E.O = WSP(bf16_t, WS_G); E.bias = nullptr; E.act = 0; E.scale = 1.0f; }
                else if (i < 3) { E.O = WSP(bf16_t, WS_E) + (size_t)d * NT * D; E.bias = A.in[I_RW0] + d * D; E.act = 1; E.scale = 0.6065306597126334f; }
                else { E.O = WSP(bf16_t, WS_A) + (size_t)d * NT * D; E.bias = A.in[I_RA0] + d * D; E.act = 1; E.scale = 1.0f; }
                pg8::gemm_phase(ring, P, E); }
        }
        SEAM();
        if (RUN()) for (int rep_ = 0; rep_ < REPN(7); ++rep_) phase_rwkv_scan(F, A);
        SEAM();
        if (RUN()) for (int rep_ = 0; rep_ < REPN(8); ++rep_) phase_rwkv_out(F, A, last ? NX : NT);
        SEAM();
        if (RUN() && !((SKIPMASK >> layer) & 1)) { pg8::ProbDense P; P.A = WSP(bf16_t, WS_RO); P.Bt = WSP(bf16_t, WS_WOR); P.lda = D; P.ldb = D; P.K = D; P.a_pn_off = 0; P.ord.init(nMall, 4, F.G, F.c);
            EpiResid E{H, nullptr, nullptr, gate1};
            pg8::gemm_phase(ring, P, E); }
        SEAM();
    }
    if (RUN()) phase_route(F, A, layer);
    SEAM();
    if (RUN()) for (int rep_ = 0; rep_ < REPN(9); ++rep_) { moe_tiles(F, layer);
        ProbMoe1 P; P.FX = WSP(bf16_t, WS_FX); P.W1T = WSP(bf16_t, WS_W1T) + (size_t)layer * NE * 2048 * D; P.list = WSP(int, WS_LIST); P.tpre = tpre; P.cnt = lcnt; P.lda = D; P.ldb = D; P.K = D; P.ord.init(tpre[NE], 8, F.G, F.c);
        EpiMoe1 E{WSP(bf16_t, WS_ACT), A.in[I_MB1] + (size_t)layer * NE * 2048};
        pg8::gemm_phase(ring, P, E); }
    SEAM();
    if (RUN()) for (int rep_ = 0; rep_ < REPN(10); ++rep_) { moe_tiles(F, layer);
        ProbMoe2 P; P.ACT = WSP(bf16_t, WS_ACT); P.W2T = WSP(bf16_t, WS_W2T) + (size_t)layer * NE * D * D; P.tpre = tpre; P.lda = D; P.ldb = D; P.K = D; P.ord.init(tpre[NE], 4, F.G, F.c);
        EpiMoe2 E{WSP(bf16_t, WS_Y), A.in[I_MB2] + (size_t)layer * NE * D};
        pg8::gemm_phase(ring, P, E); }
    SEAM();
}
__global__ void __launch_bounds__(NTHREADS, 2) trunk_fwd(Args A) {
    extern __shared__ __attribute__((aligned(16))) unsigned char lds_[];
    Frame F; F.lds = (LAS unsigned char*)lds_; REFRESH(F); F.wave = __builtin_amdgcn_readfirstlane(F.tid >> 6);
    F.G = gridDim.x; F.c = blockIdx.x; F.ws = A.ws; F.ctl = (unsigned*)(A.ws + WS_CTL);
    for (int u = F.tid; u < (LDS_BYTES - LDSCTL_OFF) / 4; u += NTHREADS) ((LAS unsigned*)(F.lds + LDSCTL_OFF))[u] = 0u;
    __syncthreads();
    KState KS; KS.bar.bar = F.ctl + CW_BAR; KS.bar.x = 0; KS.bar.st = nullptr; KS.ph = 0;
    if (A.one) KS.bar = xcd_barrier_post(F.ctl + CW_BAR, (volatile LAS unsigned*)(F.lds + MISC_OFF) + 8);
    if (RUN()) for (int rep_ = 0; rep_ < REPN(0); ++rep_) phase_prologue(F, A);
    SEAM();
    layer_body<0>(F, A, KS);
    layer_body<1>(F, A, KS);
    layer_body<2>(F, A, KS);
    layer_body<3>(F, A, KS);
    if (RUN()) phase_final(F, A);
}
#undef RUN
#undef SEAM
static int count_phases() { int n = 1; for (int layer = 0; layer < DEPTH; ++layer) { const int kind = layer % 3; n += 1 + (kind == 0 ? 3 : kind == 1 ? 2 : 6) + 3; } return n + 1; }

extern "C" void kernel_launch(void* const* d_in, const int* in_sizes, int n_in, void* d_out, int out_size, void* d_ws, size_t ws_size, hipStream_t stream) {
    static int grid = 0;
    if (grid == 0) {
        if (n_in != 38 || out_size != NX * D || ws_size < WS_END) { fprintf(stderr, "kernel_launch: unexpected problem (n_in %d, out %d, ws %zu < %zu)\n", n_in, out_size, ws_size, (size_t)WS_END); grid = -1; return; }
        int dev = 0, cus = 0;
        if (hipGetDevice(&dev) != hipSuccess || hipDeviceGetAttribute(&cus, hipDeviceAttributeMultiprocessorCount, dev) != hipSuccess) { grid = -1; return; }
        if (hipFuncSetAttribute((const void*)trunk_fwd, hipFuncAttributeMaxDynamicSharedMemorySize, LDS_BYTES) != hipSuccess) { fprintf(stderr, "kernel_launch: hipFuncSetAttribute failed\n"); grid = -1; return; }
        int per_cu = 0;
        if (hipOccupancyMaxActiveBlocksPerMultiprocessor(&per_cu, (const void*)trunk_fwd, NTHREADS, LDS_BYTES) != hipSuccess || per_cu < 1) fprintf(stderr, "kernel_launch: occupancy query says %d\n", per_cu);
        (void)hipGetLastError();
        grid = cus;
        if (grid != 256) fprintf(stderr, "kernel_launch: %d CUs (built for 256)\n", grid);
    }
    if (grid < 0) return;
    (void)hipMemsetAsync((char*)d_ws + WS_CTL, 0, CTL_BYTES, stream);
    (void)hipMemsetAsync((char*)d_ws + WS_LZERO, 0, LZERO_BYTES, stream);
    Args a{};
    for (int i = 0; i < 38; ++i) a.in[i] = (const float*)d_in[i];
    a.out = (float*)d_out; a.ws = (unsigned char*)d_ws;
#if MK_ONE_LAUNCH
    a.phase = 0; a.one = 1;
    hipLaunchKernelGGL(trunk_fwd, dim3(grid), dim3(NTHREADS), LDS_BYTES, stream, a);
#else
    const int nph = count_phases();
    for (int p = 0; p < nph; ++p) { a.phase = p; a.one = 0; hipLaunchKernelGGL(trunk_fwd, dim3(grid), dim3(NTHREADS), LDS_BYTES, stream, a); }
#endif
}
```

```cpp
#include <hip/hip_runtime.h>
#include <cstdio>
#include <cstdint>

#ifndef MK_ONE_LAUNCH
#define MK_ONE_LAUNCH 1
#endif
#ifndef REPMASK
#define REPMASK 0x000
#endif
#define REPN(k) (1 + ((REPMASK >> (k)) & 1))
#ifndef DIAG
#define DIAG 0
#endif
#ifndef SKIPMASK
#define SKIPMASK 0x00
#endif

#define LAS __attribute__((address_space(3)))
#define GAS __attribute__((address_space(1)))
typedef unsigned short bf16_t;
typedef short bf16x8 __attribute__((ext_vector_type(8)));
typedef float f32x4 __attribute__((ext_vector_type(4)));
typedef float f32x2 __attribute__((ext_vector_type(2)));
typedef unsigned u32x4 __attribute__((ext_vector_type(4)));
typedef unsigned u32x2 __attribute__((ext_vector_type(2)));

constexpr int D = 1024, NB = 32, T = 2048, L = 256, DEPTH = 4;
constexpr int NX = NB * T, NC = NB * L, NT = NX + NC;
constexpr int NE = 32, TOPK = 4;
constexpr int NWAVES = 8, NTHREADS = 512;
constexpr int MAXRT = NT * TOPK / 256 + NE;

constexpr size_t MiB = 1u << 20;
constexpr size_t WS_CTL = 0, CTL_BYTES = 4 * MiB;
constexpr size_t WS_MOD = 4 * MiB;
constexpr size_t WS_ROPEC = 8 * MiB, WS_ROPES = 8 * MiB + 512 * 1024;
constexpr size_t WS_BQK = 9 * MiB;
constexpr size_t WS_WQK = 10 * MiB;
constexpr size_t WS_WV = 15 * MiB;
constexpr size_t WS_WO = 16 * MiB;
constexpr size_t WS_POOLW = 20 * MiB;
constexpr size_t WS_WRKV = 21 * MiB;
constexpr size_t WS_WOR = 27 * MiB;
constexpr size_t WS_WL1 = 30 * MiB;
constexpr size_t WS_WL2 = 32 * MiB;
constexpr size_t WS_LZERO = WS_WL1, LZERO_BYTES = 6 * MiB;
constexpr size_t WS_W1T = 40 * MiB;
constexpr size_t WS_W2T = 552 * MiB;
constexpr size_t WS_H = 808 * MiB;
constexpr size_t WS_AX = 1096 * MiB;
constexpr size_t WS_FX = 1240 * MiB;
constexpr size_t WS_R = 1384 * MiB;
constexpr size_t WS_ACT = WS_R;
constexpr size_t WS_Y = WS_R + 592 * MiB;
constexpr size_t WS_LIST = WS_R + 1184 * MiB;
constexpr size_t WS_POS = WS_R + 1193 * MiB;
constexpr size_t WS_GATE = WS_R + 1195 * MiB;
constexpr size_t WS_Q = WS_R;
constexpr size_t WS_K = WS_R + 144 * MiB;
constexpr size_t WS_VT = WS_R + 180 * MiB;
constexpr size_t WS_O = WS_R + 216 * MiB;
constexpr size_t WS_PD = WS_R;
constexpr size_t WS_A6 = WS_R;
constexpr size_t WS_E = WS_R;
constexpr size_t WS_A = WS_R + 288 * MiB;
constexpr size_t WS_RO = WS_R + 576 * MiB;
constexpr size_t WS_RKV = WS_R + 864 * MiB;
constexpr size_t WS_LORA = WS_R + 1296 * MiB;
constexpr size_t WS_G = WS_R + 1404 * MiB;
constexpr size_t WS_YS = WS_R + 1548 * MiB;
constexpr size_t WS_BONUS = WS_R + 2124 * MiB;
constexpr size_t WS_END = WS_R + 2134 * MiB;

constexpr int CW_BAR = 4096;
constexpr int CW_GCNT = 16384;
constexpr int LDS_BYTES = 147456;
constexpr int RING_BYTES = 131072;
constexpr int LDSCTL_OFF = 135168;
constexpr int MISC_OFF = LDSCTL_OFF;
constexpr int TPRE_OFF = LDSCTL_OFF + 256;
constexpr int LCNT_OFF = LDSCTL_OFF + 512;
constexpr int LBASE_OFF = LDSCTL_OFF + 768;
constexpr int REC_OFF = LDSCTL_OFF + 1024;
constexpr int JOB_OFF = LDSCTL_OFF + 1024;

__device__ __forceinline__ unsigned f2bf(float f) { unsigned u = __builtin_bit_cast(unsigned, f); return (u + 0x7fffu + ((u >> 16) & 1u)) >> 16; }
__device__ __forceinline__ unsigned pk2(float lo, float hi) { return f2bf(lo) | (f2bf(hi) << 16); }
__device__ __forceinline__ float bflo(unsigned w) { return __builtin_bit_cast(float, w << 16); }
__device__ __forceinline__ float bfhi(unsigned w) { return __builtin_bit_cast(float, w & 0xffff0000u); }
__device__ __forceinline__ float bf1(bf16_t b) { return __builtin_bit_cast(float, ((unsigned)b) << 16); }
__device__ __forceinline__ unsigned pk4_fp8(float a, float b, float c, float d) { int w = __builtin_amdgcn_cvt_pk_fp8_f32(a, b, 0, false); w = __builtin_amdgcn_cvt_pk_fp8_f32(c, d, w, true); return (unsigned)w; }
__device__ __forceinline__ unsigned cvt_pk_bf16(float lo, float hi) { unsigned r; asm volatile("v_cvt_pk_bf16_f32 %0, %1, %2" : "=v"(r) : "v"(lo), "v"(hi)); return r; }
__device__ __forceinline__ float dpp_add(float v, const int ctrl, const int row_mask) {
    switch (ctrl) {
    case 0xB1:  return v + __builtin_bit_cast(float, __builtin_amdgcn_update_dpp(0, __builtin_bit_cast(int, v), 0xB1, 0xf, 0xf, true));
    case 0x4E:  return v + __builtin_bit_cast(float, __builtin_amdgcn_update_dpp(0, __builtin_bit_cast(int, v), 0x4E, 0xf, 0xf, true));
    case 0x141: return v + __builtin_bit_cast(float, __builtin_amdgcn_update_dpp(0, __builtin_bit_cast(int, v), 0x141, 0xf, 0xf, true));
    case 0x140: return v + __builtin_bit_cast(float, __builtin_amdgcn_update_dpp(0, __builtin_bit_cast(int, v), 0x140, 0xf, 0xf, true));
    case 0x142: return v + __builtin_bit_cast(float, __builtin_amdgcn_update_dpp(0, __builtin_bit_cast(int, v), 0x142, 0xa, 0xf, true));
    default:    return v + __builtin_bit_cast(float, __builtin_amdgcn_update_dpp(0, __builtin_bit_cast(int, v), 0x143, 0xc, 0xf, true));
    }
}
__device__ __forceinline__ float row16_sum(float v) { v = dpp_add(v, 0xB1, 0xf); v = dpp_add(v, 0x4E, 0xf); v = dpp_add(v, 0x141, 0xf); v = dpp_add(v, 0x140, 0xf); return v; }
__device__ __forceinline__ float wave_sum(float v) {
    v = row16_sum(v); v = dpp_add(v, 0x142, 0xa); v = dpp_add(v, 0x143, 0xc);
    return __builtin_bit_cast(float, __builtin_amdgcn_readlane(__builtin_bit_cast(int, v), 63));
}
__device__ __forceinline__ float sigmoidf_(float x) { return 1.0f / (1.0f + __expf(-x)); }
__device__ __forceinline__ int opaque_tid() { int t; asm volatile("v_mov_b32 %0, %1" : "=v"(t) : "v"(threadIdx.x)); return t; }
#define REFRESH(F) do { (F).tid = opaque_tid(); (F).lane = (F).tid & 63; } while (0)
__device__ __forceinline__ void seq_of(int row, int& sb, int& t, int& n) { if (row < NX) { sb = row & ~(T - 1); t = row & (T - 1); n = T; } else { const int r2 = row - NX; sb = NX + (r2 & ~(L - 1)); t = r2 & (L - 1); n = L; } }
__device__ __forceinline__ f32x4 ld_bf4(const bf16_t* p) { const u32x2 w = *(const u32x2*)p; return (f32x4){bflo(w.x), bfhi(w.x), bflo(w.y), bfhi(w.y)}; }
__device__ __forceinline__ void st_bf4(bf16_t* p, f32x4 v) { u32x2 w; w.x = pk2(v.x, v.y); w.y = pk2(v.z, v.w); *(u32x2*)p = w; }

#define LDS_WAIT() asm volatile("s_waitcnt lgkmcnt(0)" ::: "memory")
#define VM_WAIT() asm volatile("s_waitcnt vmcnt(0)" ::: "memory")

#define XB_TMO      128
#define XB_XCNT(j)  (256  + 64 * (j))
#define XB_XSUB(j)  (1280 + 64 * (j))
#define XB_XGEN(j)  (2304 + 64 * (j))
#define XB_TOP      3328
#define XB_TOPGEN   3392
#define XCD_BAR_WORDS 3456
#define XB_SPIN_CAP (1u << 18)
__device__ __forceinline__ unsigned xb_ld(unsigned* p)              { return __hip_atomic_load(p, __ATOMIC_RELAXED, __HIP_MEMORY_SCOPE_AGENT); }
__device__ __forceinline__ unsigned xb_add(unsigned* p, unsigned v) { return __hip_atomic_fetch_add(p, v, __ATOMIC_RELAXED, __HIP_MEMORY_SCOPE_AGENT); }
__device__ __forceinline__ unsigned xb_xcc_id() { return (unsigned)__builtin_amdgcn_s_getreg((3 << 11) | 20) & 0xFu; }
#define XB_SPIN(cond, bar) do { unsigned _sp = 0; while (cond) { __builtin_amdgcn_s_sleep(1); \
    if ((++_sp & 255u) == 0u) { if (xb_ld(&(bar)[XB_TMO])) break; if (_sp > XB_SPIN_CAP) { atomicAdd(&(bar)[XB_TMO], 1u); break; } } } } while (0)
struct XcdBarrier { unsigned* bar; unsigned x; volatile LAS unsigned* st; };
__device__ __forceinline__ XcdBarrier xcd_barrier_post(unsigned* bar, volatile LAS unsigned* st) {
    XcdBarrier b; b.bar = bar; b.x = xb_xcc_id(); b.st = st;
    if (threadIdx.x == 0) (void)xb_add(&bar[XB_XCNT(b.x)], 1u);
    return b;
}
__device__ __forceinline__ void xcd_barrier_complete(unsigned* bar, unsigned x, unsigned& nloc, unsigned& nx) {
    const unsigned G = gridDim.x * gridDim.y * gridDim.z;
    unsigned sum, cnt, mine, sp = 0u;
    for (;;) {
        sum = 0u; cnt = 0u; mine = 0u;
#pragma unroll
        for (unsigned j = 0; j < 16; ++j) { const unsigned c = xb_ld(&bar[XB_XCNT(j)]); sum += c; cnt += (c > 0u) ? 1u : 0u; mine = (j == x) ? c : mine; }
        if (sum == G) break;
        __builtin_amdgcn_s_sleep(1);
        if ((++sp & 255u) == 0u) { if (xb_ld(&bar[XB_TMO])) break; if (sp > XB_SPIN_CAP) { atomicAdd(&bar[XB_TMO], 1u); break; } }
    }
    nloc = mine > 0u ? mine : 1u; nx = cnt > 0u ? cnt : 1u;
}
__device__ __forceinline__ void xcd_barrier(const XcdBarrier& b) {
    asm volatile("s_waitcnt vmcnt(0)" ::: "memory");
    __syncthreads();
    if (threadIdx.x == 0) {
        unsigned* bar = b.bar;
        __builtin_amdgcn_s_waitcnt(0);
        unsigned nloc = b.st[0], nx = b.st[1];
        if (nloc == 0u) { xcd_barrier_complete(bar, b.x, nloc, nx); b.st[0] = nloc; b.st[1] = nx; }
        const unsigned old = xb_add(&bar[XB_XSUB(b.x)], 1u);
        const unsigned gen = old / nloc;
        if (old + 1u == (gen + 1u) * nloc) {
            __builtin_amdgcn_fence(__ATOMIC_RELEASE, "agent");
            asm volatile("s_waitcnt vmcnt(0)" ::: "memory");
            const unsigned og = xb_add(&bar[XB_TOP], 1u);
            const unsigned tg = og / nx;
            if (og + 1u == (tg + 1u) * nx) xb_add(&bar[XB_TOPGEN], 1u);
            else XB_SPIN(xb_ld(&bar[XB_TOPGEN]) == tg, bar);
            __builtin_amdgcn_fence(__ATOMIC_ACQUIRE, "agent");
            xb_add(&bar[XB_XGEN(b.x)], 1u);
            asm volatile("s_waitcnt vmcnt(0)" ::: "memory");
        } else {
            XB_SPIN(xb_ld(&bar[XB_XGEN(b.x)]) == gen, bar);
            __builtin_amdgcn_fence(__ATOMIC_ACQUIRE, "agent");
            asm volatile("s_waitcnt vmcnt(0)" ::: "memory");
        }
    }
    __syncthreads();
}

namespace pg8 {
constexpr int BM = 256, BK = 64, HALF = 128, HTB = HALF * BK * 2, STAGE_BYTES = 8 * HTB, NXCD = 8, WGM = 8;
__host__ __device__ __forceinline__ int lds_byte(int r, int c) { const int st = (r >> 4) * 2 + (c >> 5), rr = r & 15, cc = c & 31, ob = rr * 64 + cc * 2; return st * 1024 + (ob ^ (((ob >> 9) & 1) << 5)); }
__host__ __device__ __forceinline__ void stage_rc(int b, int& R, int& C) { const int st = b / 1024, sb = b % 1024, swz = sb ^ (((sb >> 9) & 1) << 5); R = (st >> 1) * 16 + swz / 64; C = (st & 1) * 32 + (swz % 64) / 2; }
__host__ __device__ __forceinline__ int perm32(int rho) { const int n = rho >> 4, i = rho & 15; return 8 * (i >> 2) + 4 * n + (i & 3); }

typedef int i32x8 __attribute__((ext_vector_type(8)));
typedef int i32x4 __attribute__((ext_vector_type(4)));
__device__ __forceinline__ i32x8 cat8(bf16x8 lo, bf16x8 hi) { const i32x4 a = __builtin_bit_cast(i32x4, lo), b = __builtin_bit_cast(i32x4, hi); return __builtin_shufflevector(a, b, 0, 1, 2, 3, 4, 5, 6, 7); }
struct Unit { int pm, pn, e, rt; };
struct TileOrder {
    int nM, nN, nwg, G, c;
    __device__ __forceinline__ void init(int nM_, int nN_, int G_, int c_) { nM = nM_; nN = nN_; nwg = nM * nN; G = G_; c = c_; }
    __device__ __forceinline__ bool next(int i, int& pm, int& pn) const {
        const long Lx = (long)i * G + c; if (Lx >= nwg) return false;
        int wgid = (int)Lx; { const int q = nwg / NXCD, r = nwg % NXCD, xcd = wgid % NXCD, off = wgid / NXCD; wgid = (xcd < r ? xcd * (q + 1) : r * (q + 1) + (xcd - r) * q) + off; }
        const int nig = WGM * nN, gid = wgid / nig, fm = gid * WGM, gsz = (nM - fm) < WGM ? (nM - fm) : WGM;
        pm = fm + ((wgid % nig) % gsz); pn = (wgid % nig) / gsz; return true;
    }
};
struct ProbDense {
    static constexpr bool FP8 = false;
    const bf16_t* A; const bf16_t* Bt; int lda, ldb, K, a_pn_off; TileOrder ord;
    __device__ __forceinline__ int ldb_bytes() const { return ldb * 2; }
    __device__ __forceinline__ int ntiles() const { return K / 64; }
    __device__ __forceinline__ bool next(int i, Unit& u) const { u.e = 0; const bool ok = ord.next(i, u.pm, u.pn); u.rt = u.pm; return ok; }
    __device__ __forceinline__ const char* a_ptr(const Unit& u) const { return (const char*)(A + (size_t)u.pm * BM * lda + (size_t)u.pn * a_pn_off); }
    __device__ __forceinline__ const char* b_ptr(const Unit& u) const { return (const char*)(Bt + (size_t)u.pn * BM * ldb); }
    __device__ __forceinline__ void a_off(const Unit&, const int (&R)[2], const int (&C)[2], unsigned (&v)[2][2]) const {
#pragma unroll
        for (int h = 0; h < 2; ++h)
#pragma unroll
            for (int i = 0; i < 2; ++i) v[h][i] = (unsigned)((h * HALF + R[i]) * lda + C[i]) * 2u;
    }
};

template <class Prob, class Epi>
__device__ __forceinline__ void gemm_phase(LAS unsigned char* lds, const Prob& P, const Epi& E) {
    const int tid = opaque_tid(), wid = __builtin_amdgcn_readfirstlane(tid >> 6), lane = tid & 63, wr = wid >> 2, wc = wid & 3, fr = lane & 15, fq = lane >> 4;
    const int nt = P.ntiles(); const int ldbB = P.ldb_bytes();
    int Rr[2], Cc[2]; unsigned voffB[2];
#pragma unroll
    for (int i = 0; i < 2; ++i) { int R, C; stage_rc(tid * 16 + i * 8192, R, C); Rr[i] = R; Cc[i] = C; const int Rb = Epi::PERM ? ((R & ~31) + perm32(R & 31)) : R;
        voffB[i] = (unsigned)(Rb * ldbB + C * 2); }
    const size_t kstep = (size_t)(BK * 2);
    const size_t hstepB = (size_t)HALF * ldbB;
    const unsigned ldsw = (unsigned)wid * 1024u;
    const int aoff = lds_byte(wr * 64 + fr, fq * 8), boff = lds_byte(wc * 32 + fr, fq * 8);
#define PG8_SA(b, h) (((b) * 2 + (h)) * HTB)
#define PG8_SB(b, h) ((4 + (b) * 2 + (h)) * HTB)
#define PG8_STAGE(bufoff, gbase, voff) do { _Pragma("unroll") for (int _i = 0; _i < 2; ++_i) \
        __builtin_amdgcn_global_load_lds((const unsigned*)((const char*)(gbase) + (voff)[_i]), (LAS unsigned*)(lds + (bufoff) + ldsw + _i * 8192), 16, 0, 0); } while (0)
#define PG8_LDA(dst, b, h) do { _Pragma("unroll") for (int m = 0; m < 4; ++m) _Pragma("unroll") for (int k = 0; k < 2; ++k) dst[m][k] = *(const LAS bf16x8*)(lds + PG8_SA(b, h) + aoff + m * 2048 + k * 1024); } while (0)
#define PG8_LDB(dst, b, h) do { _Pragma("unroll") for (int n = 0; n < 2; ++n) _Pragma("unroll") for (int k = 0; k < 2; ++k) dst[n][k] = *(const LAS bf16x8*)(lds + PG8_SB(b, h) + boff + n * 2048 + k * 1024); } while (0)
#define PG8_MMA(ai, bj, At, Bt) do { __builtin_amdgcn_s_setprio(1); _Pragma("unroll") for (int m = 0; m < 4; ++m) _Pragma("unroll") for (int n = 0; n < 2; ++n) { \
        if constexpr (Prob::FP8) { asm volatile("v_mfma_scale_f32_16x16x128_f8f6f4 %0, %1, %2, %0, %3, %4 op_sel_hi:[0,0,0]" : "+v"(acc[ai][bj][m][n]) : "v"(cat8(Bt[n][0], Bt[n][1])), "v"(cat8(At[m][0], At[m][1])), "v"(sc_w), "v"(sc_x)); } \
        else { _Pragma("unroll") for (int k = 0; k < 2; ++k) acc[ai][bj][m][n] = __builtin_amdgcn_mfma_f32_16x16x32_bf16(Bt[n][k], At[m][k], acc[ai][bj][m][n], 0, 0, 0); } } __builtin_amdgcn_s_setprio(0); } while (0)
#define PG8_WAIT_V(n) asm volatile("s_waitcnt vmcnt(" #n ")" ::: "memory")
#define PG8_WAIT_L(n) asm volatile("s_waitcnt lgkmcnt(" #n ")" ::: "memory")
#define PG8_BAR __builtin_amdgcn_s_barrier()
#define PG8_SCHED __builtin_amdgcn_sched_barrier(0)
    Unit cur, nxt; int ui = 0;
    if (!P.next(0, cur)) return;
    int sc_w = 0, sc_x = 0; if constexpr (Prob::FP8) { sc_w = P.scale_w; sc_x = P.scale_x; } (void)sc_w; (void)sc_x;
    f32x4 acc[2][2][4][2];
#pragma unroll
    for (int a = 0; a < 2; ++a)
#pragma unroll
        for (int b = 0; b < 2; ++b)
#pragma unroll
            for (int m = 0; m < 4; ++m)
#pragma unroll
                for (int n = 0; n < 2; ++n) acc[a][b][m][n] = (f32x4){0.f, 0.f, 0.f, 0.f};
    bf16x8 At[4][2], B0[2][2], B1[2][2];
    unsigned vAc[2][2], vAn[2][2];
    P.a_off(cur, Rr, Cc, vAc);
    const char* cA = P.a_ptr(cur); const char* cB = P.b_ptr(cur);
    PG8_STAGE(PG8_SB(0, 0), cB, voffB); PG8_STAGE(PG8_SB(0, 1), cB + hstepB, voffB); PG8_STAGE(PG8_SA(0, 0), cA, vAc[0]); PG8_STAGE(PG8_SA(0, 1), cA, vAc[1]);
    if (wr == 1) PG8_BAR;
    PG8_WAIT_V(2); PG8_BAR;
    PG8_STAGE(PG8_SB(1, 0), cB + kstep, voffB); PG8_STAGE(PG8_SA(1, 0), cA + kstep, vAc[0]); PG8_STAGE(PG8_SB(1, 1), cB + hstepB + kstep, voffB);
    PG8_WAIT_V(6); PG8_BAR;
    for (;;) {
        const bool has_next = P.next(ui + 1, nxt);
        const char* nA = cA; const char* nB = cB;
#pragma unroll
        for (int h = 0; h < 2; ++h)
#pragma unroll
            for (int i = 0; i < 2; ++i) vAn[h][i] = vAc[h][i];
        if (has_next) { nA = P.a_ptr(nxt); nB = P.b_ptr(nxt); P.a_off(nxt, Rr, Cc, vAn); }
        for (int t = 0; t < nt; t += 2) {
            const bool last = (t == nt - 2);
            const char* a1 = cA + (size_t)(t + 1) * kstep;
            const char* a2 = last ? nA : cA + (size_t)(t + 2) * kstep; const char* b2 = last ? nB : cB + (size_t)(t + 2) * kstep;
            const char* a3 = a2 + kstep; const char* b3 = b2 + kstep;
            unsigned vX[2][2];
#pragma unroll
            for (int h = 0; h < 2; ++h)
#pragma unroll
                for (int i = 0; i < 2; ++i) vX[h][i] = last ? vAn[h][i] : vAc[h][i];
            PG8_LDB(B0, 0, 0); PG8_LDB(B1, 0, 1); PG8_SCHED; PG8_LDA(At, 0, 0); PG8_STAGE(PG8_SA(1, 1), a1, vAc[1]);
            PG8_WAIT_V(8); PG8_WAIT_L(0); PG8_BAR; PG8_MMA(0, 0, At, B0); PG8_MMA(0, 1, At, B1); PG8_BAR; PG8_SCHED;
            PG8_LDA(At, 0, 1); PG8_STAGE(PG8_SB(0, 0), b2, voffB); PG8_STAGE(PG8_SB(0, 1), b2 + hstepB, voffB); PG8_STAGE(PG8_SA(0, 0), a2, vX[0]);
            PG8_WAIT_V(8); PG8_WAIT_L(0); PG8_BAR; PG8_MMA(1, 0, At, B0); PG8_MMA(1, 1, At, B1); PG8_BAR; PG8_SCHED;
            PG8_LDB(B0, 1, 0); PG8_LDB(B1, 1, 1); PG8_SCHED; PG8_LDA(At, 1, 0); PG8_STAGE(PG8_SA(0, 1), a2, vX[1]);
            PG8_WAIT_V(8); PG8_WAIT_L(0); PG8_BAR; PG8_MMA(0, 0, At, B0); PG8_MMA(0, 1, At, B1); PG8_BAR; PG8_SCHED;
            PG8_LDA(At, 1, 1); PG8_STAGE(PG8_SB(1, 0), b3, voffB); PG8_STAGE(PG8_SB(1, 1), b3 + hstepB, voffB); PG8_STAGE(PG8_SA(1, 0), a3, vX[0]);
            PG8_WAIT_V(8); PG8_WAIT_L(0); PG8_BAR; PG8_MMA(1, 0, At, B0); PG8_MMA(1, 1, At, B1); PG8_BAR; PG8_SCHED;
        }
        if (wr == 0) PG8_BAR;
        if constexpr (Prob::FP8) asm volatile("s_nop 15\n\ts_nop 15" ::: "memory");
        E(acc, cur, wr, wc, fr, fq);
        if (!has_next) break;
#pragma unroll
        for (int a = 0; a < 2; ++a)
#pragma unroll
            for (int b = 0; b < 2; ++b)
#pragma unroll
                for (int m = 0; m < 4; ++m)
#pragma unroll
                    for (int n = 0; n < 2; ++n) acc[a][b][m][n] = (f32x4){0.f, 0.f, 0.f, 0.f};
        cur = nxt; cA = nA; cB = nB; ++ui;
#pragma unroll
        for (int h = 0; h < 2; ++h)
#pragma unroll
            for (int i = 0; i < 2; ++i) vAc[h][i] = vAn[h][i];
        if (wr == 1) PG8_BAR;
    }
    PG8_WAIT_V(0);
    PG8_BAR;
#undef PG8_SA
#undef PG8_SB
#undef PG8_STAGE
#undef PG8_LDA
#undef PG8_LDB
#undef PG8_MMA
#undef PG8_WAIT_V
#undef PG8_WAIT_L
#undef PG8_BAR
#undef PG8_SCHED
}
}

using pg8::Unit;
constexpr int HALF_ = 128;
struct EpiBf16Act {
    static constexpr bool PERM = true;
    bf16_t* O; int ldc; const float* bias; int act; float scale;
    __device__ __forceinline__ void operator()(const f32x4 (&acc)[2][2][4][2], const Unit& u, int wr, int wc, int fr, int fq) const {
        const int row0 = u.pm * 256 + wr * 64 + fr, col0 = u.pn * 256 + wc * 32 + 8 * fq;
        f32x4 bv[2][2];
#pragma unroll
        for (int bj = 0; bj < 2; ++bj)
#pragma unroll
            for (int n = 0; n < 2; ++n) bv[bj][n] = bias ? *(const f32x4*)(bias + col0 + bj * HALF_ + 4 * n) : (f32x4){0.f, 0.f, 0.f, 0.f};
#pragma unroll
        for (int ai = 0; ai < 2; ++ai)
#pragma unroll
            for (int m = 0; m < 4; ++m) { bf16_t* rowp = O + (size_t)(row0 + ai * HALF_ + m * 16) * ldc + col0;
#pragma unroll
                for (int bj = 0; bj < 2; ++bj) { f32x4 v0 = acc[ai][bj][m][0] + bv[bj][0], v1 = acc[ai][bj][m][1] + bv[bj][1];
                    if (act == 1) {
#pragma unroll
                        for (int j = 0; j < 4; ++j) { v0[j] = sigmoidf_(v0[j]) * scale; v1[j] = sigmoidf_(v1[j]) * scale; } }
                    else if (act == 2) {
#pragma unroll
                        for (int j = 0; j < 4; ++j) { v0[j] = 1.0f - 2.0f / (__expf(2.0f * v0[j]) + 1.0f); v1[j] = 1.0f - 2.0f / (__expf(2.0f * v1[j]) + 1.0f); } }
                    u32x4 w; w.x = cvt_pk_bf16(v0[0], v0[1]); w.y = cvt_pk_bf16(v0[2], v0[3]); w.z = cvt_pk_bf16(v1[0], v1[1]); w.w = cvt_pk_bf16(v1[2], v1[3]);
                    *(u32x4*)(rowp + bj * HALF_) = w; } }
    }
};
struct EpiQK {
    static constexpr bool PERM = true;
    bf16_t* Q; bf16_t* Kb; const float* bias; const float* ropec; const float* ropes;
    __device__ __forceinline__ void operator()(const f32x4 (&acc)[2][2][4][2], const Unit& u, int wr, int wc, int fr, int fq) const {
        const int row0 = u.pm * 256 + wr * 64 + fr, cl0 = wc * 32 + 8 * fq;
        const int g = (4 * wc + fq) & 7;
        bf16_t* base; int ldc;
        if (u.pn < 4) { base = Q + u.pn * 256; ldc = 1024; } else { base = Kb; ldc = 256; }
        f32x4 bv[2][2];
#pragma unroll
        for (int bj = 0; bj < 2; ++bj)
#pragma unroll
            for (int n = 0; n < 2; ++n) bv[bj][n] = *(const f32x4*)(bias + u.pn * 256 + cl0 + bj * HALF_ + 4 * n);
#pragma unroll
        for (int ai = 0; ai < 2; ++ai)
#pragma unroll
            for (int m = 0; m < 4; ++m) { const int row = row0 + ai * HALF_ + m * 16; bf16_t* rowp = base + (size_t)row * ldc + cl0;
                f32x4 cs = (f32x4){1.f, 1.f, 1.f, 1.f}, sn = (f32x4){0.f, 0.f, 0.f, 0.f};
                if (row < NX) { const int t = row & (T - 1); cs = *(const f32x4*)(ropec + t * 32 + g * 4); sn = *(const f32x4*)(ropes + t * 32 + g * 4); }
#pragma unroll
                for (int bj = 0; bj < 2; ++bj) { const f32x4 v0 = acc[ai][bj][m][0] + bv[bj][0], v1 = acc[ai][bj][m][1] + bv[bj][1];
                    const f32x4 o0 = v0 * cs - v1 * sn, o1 = v1 * cs + v0 * sn;
                    u32x4 w; w.x = cvt_pk_bf16(o0[0], o0[1]); w.y = cvt_pk_bf16(o0[2], o0[3]); w.z = cvt_pk_bf16(o1[0], o1[1]); w.w = cvt_pk_bf16(o1[2], o1[3]);
                    *(u32x4*)(rowp + bj * HALF_) = w; } }
    }
};
struct EpiVT {
    static constexpr bool PERM = true;
    bf16_t* VT; const float* biasrow;
    __device__ __forceinline__ void operator()(const f32x4 (&acc)[2][2][4][2], const Unit& u, int wr, int wc, int fr, int fq) const {
        const int row0 = wr * 64 + fr, col0 = u.pn * 256 + wc * 32 + 8 * fq;
#pragma unroll
        for (int ai = 0; ai < 2; ++ai)
#pragma unroll
            for (int m = 0; m < 4; ++m) { const int row = row0 + ai * HALF_ + m * 16; const float b = biasrow[row]; bf16_t* rowp = VT + (size_t)row * NT + col0;
#pragma unroll
                for (int bj = 0; bj < 2; ++bj) { const f32x4 v0 = acc[ai][bj][m][0] + b, v1 = acc[ai][bj][m][1] + b;
                    u32x4 w; w.x = cvt_pk_bf16(v0[0], v0[1]); w.y = cvt_pk_bf16(v0[2], v0[3]); w.z = cvt_pk_bf16(v1[0], v1[1]); w.w = cvt_pk_bf16(v1[2], v1[3]);
                    *(u32x4*)(rowp + bj * HALF_) = w; } }
    }
};
struct EpiResid {
    static constexpr bool PERM = false;
    float* H; const float* bias; const float* ls; const float* gate;
    __device__ __forceinline__ void operator()(const f32x4 (&acc)[2][2][4][2], const Unit& u, int wr, int wc, int fr, int fq) const {
        const int row0 = u.pm * 256 + wr * 64 + fr, col0 = u.pn * 256 + wc * 32 + 4 * fq;
        f32x4 bv[2][2], lv[2][2];
#pragma unroll
        for (int bj = 0; bj < 2; ++bj)
#pragma unroll
            for (int n = 0; n < 2; ++n) { bv[bj][n] = bias ? *(const f32x4*)(bias + col0 + bj * HALF_ + n * 16) : (f32x4){0.f, 0.f, 0.f, 0.f};
                                          lv[bj][n] = ls ? *(const f32x4*)(ls + col0 + bj * HALF_ + n * 16) : (f32x4){1.f, 1.f, 1.f, 1.f}; }
#pragma unroll
        for (int ai = 0; ai < 2; ++ai)
#pragma unroll
            for (int m = 0; m < 4; ++m) { const int row = row0 + ai * HALF_ + m * 16; const int brow = row < NX ? (row >> 11) : 32;
                float* hp = H + (size_t)row * D + col0; const float* gp = gate + (size_t)brow * (6 * D) + col0;
#pragma unroll
                for (int bj = 0; bj < 2; ++bj)
#pragma unroll
                    for (int n = 0; n < 2; ++n) { const f32x4 y = (acc[ai][bj][m][n] + bv[bj][n]) * lv[bj][n]; const f32x4 gv = *(const f32x4*)(gp + bj * HALF_ + n * 16);
                        f32x4 hv = *(const f32x4*)(hp + bj * HALF_ + n * 16); hv = hv + gv * y; *(f32x4*)(hp + bj * HALF_ + n * 16) = hv; }
                asm volatile("" ::: "memory"); }
    }
};
struct EpiMoe1 {
    static constexpr bool PERM = true;
    unsigned char* ACT; const float* b1;
    __device__ __forceinline__ void operator()(const f32x4 (&acc)[2][2][4][2], const Unit& u, int wr, int wc, int fr, int fq) const {
        const int row0 = u.rt * 256 + wr * 64 + fr, cl = u.pn * 128 + wc * 32 + 8 * fq;
        const float* bg = b1 + (size_t)u.e * 2048 + cl; const float* bl = bg + 1024;
        f32x4 bgv[2], blv[2];
#pragma unroll
        for (int n = 0; n < 2; ++n) { bgv[n] = *(const f32x4*)(bg + 4 * n); blv[n] = *(const f32x4*)(bl + 4 * n); }
#pragma unroll
        for (int ai = 0; ai < 2; ++ai)
#pragma unroll
            for (int m = 0; m < 4; ++m) { unsigned char* rowp = ACT + (size_t)(row0 + ai * HALF_ + m * 16) * D + cl;
                f32x4 o[2];
#pragma unroll
                for (int n = 0; n < 2; ++n) { const f32x4 hg = acc[ai][0][m][n] + bgv[n], hl = acc[ai][1][m][n] + blv[n];
#pragma unroll
                    for (int j = 0; j < 4; ++j) { const float gl = fminf(hg[j], 7.0f); const float li = fminf(fmaxf(hl[j], -7.0f), 7.0f);
                        o[n][j] = gl * sigmoidf_(1.702f * gl) * (li + 1.0f); } }
                u32x2 w; w.x = pk4_fp8(o[0][0], o[0][1], o[0][2], o[0][3]); w.y = pk4_fp8(o[1][0], o[1][1], o[1][2], o[1][3]);
                *(u32x2*)rowp = w; }
    }
};
struct EpiMoe2 {
    static constexpr bool PERM = true;
    bf16_t* Y; const float* b2;
    __device__ __forceinline__ void operator()(const f32x4 (&acc)[2][2][4][2], const Unit& u, int wr, int wc, int fr, int fq) const {
        const int row0 = u.rt * 256 + wr * 64 + fr, col0 = u.pn * 256 + wc * 32 + 8 * fq;
        const float* bb = b2 + (size_t)u.e * D + col0;
        f32x4 bv[2][2];
#pragma unroll
        for (int bj = 0; bj < 2; ++bj)
#pragma unroll
            for (int n = 0; n < 2; ++n) bv[bj][n] = *(const f32x4*)(bb + bj * HALF_ + 4 * n);
#pragma unroll
        for (int ai = 0; ai < 2; ++ai)
#pragma unroll
            for (int m = 0; m < 4; ++m) { bf16_t* rowp = Y + (size_t)(row0 + ai * HALF_ + m * 16) * D + col0;
#pragma unroll
                for (int bj = 0; bj < 2; ++bj) { const f32x4 v0 = acc[ai][bj][m][0] + bv[bj][0], v1 = acc[ai][bj][m][1] + bv[bj][1];
                    u32x4 w; w.x = cvt_pk_bf16(v0[0], v0[1]); w.y = cvt_pk_bf16(v0[2], v0[3]); w.z = cvt_pk_bf16(v1[0], v1[1]); w.w = cvt_pk_bf16(v1[2], v1[3]);
                    *(u32x4*)(rowp + bj * HALF_) = w; } }
    }
};
typedef unsigned char fp8_t;
constexpr int SCALE_ONE = 0x7f7f7f7f, SCALE_W = 0x79797979;
struct ProbMoe1 {
    static constexpr bool FP8 = true;
    const fp8_t* FX; const fp8_t* W1T; const int* list; const LAS int* tpre; const LAS int* cnt; int scale_w, scale_x; pg8::TileOrder ord;
    __device__ __forceinline__ int ldb_bytes() const { return D; }
    __device__ __forceinline__ int ntiles() const { return D / 128; }
    __device__ __forceinline__ bool next(int i, Unit& u) const {
        if (!ord.next(i, u.pm, u.pn)) return false;
        u.rt = u.pm; int e = 0;
#pragma unroll 1
        for (int j = 1; j < NE; ++j) e += (tpre[j] <= u.rt) ? 1 : 0;
        u.e = e; return true;
    }
    __device__ __forceinline__ const char* a_ptr(const Unit&) const { return (const char*)FX; }
    __device__ __forceinline__ const char* b_ptr(const Unit& u) const { return (const char*)(W1T + ((size_t)u.e * 2048 + (size_t)u.pn * 256) * D); }
    __device__ __forceinline__ void a_off(const Unit& u, const int (&R)[2], const int (&C)[2], unsigned (&v)[2][2]) const {
        const int base = (u.rt - tpre[u.e]) * 256, ce = cnt[u.e]; const int* le = list + (size_t)u.e * NT;
#pragma unroll
        for (int h = 0; h < 2; ++h)
#pragma unroll
            for (int i = 0; i < 2; ++i) { const int idx = base + h * 128 + R[i]; const int tok = le[idx < ce ? idx : 0]; v[h][i] = (unsigned)(tok * D + C[i] * 2); }
        asm volatile("" : "+v"(v[0][0]), "+v"(v[0][1]), "+v"(v[1][0]), "+v"(v[1][1]));
    }
};
struct ProbMoe2 {
    static constexpr bool FP8 = true;
    const fp8_t* ACT; const fp8_t* W2T; const LAS int* tpre; int scale_w, scale_x; pg8::TileOrder ord;
    __device__ __forceinline__ int ldb_bytes() const { return D; }
    __device__ __forceinline__ int ntiles() const { return D / 128; }
    __device__ __forceinline__ bool next(int i, Unit& u) const {
        if (!ord.next(i, u.pm, u.pn)) return false;
        u.rt = u.pm; int e = 0;
#pragma unroll 1
        for (int j = 1; j < NE; ++j) e += (tpre[j] <= u.rt) ? 1 : 0;
        u.e = e; return true;
    }
    __device__ __forceinline__ const char* a_ptr(const Unit& u) const { return (const char*)(ACT + (size_t)u.rt * 256 * D); }
    __device__ __forceinline__ const char* b_ptr(const Unit& u) const { return (const char*)(W2T + ((size_t)u.e * 1024 + (size_t)u.pn * 256) * D); }
    __device__ __forceinline__ void a_off(const Unit&, const int (&R)[2], const int (&C)[2], unsigned (&v)[2][2]) const {
#pragma unroll
        for (int h = 0; h < 2; ++h)
#pragma unroll
            for (int i = 0; i < 2; ++i) v[h][i] = (unsigned)((h * 128 + R[i]) * D + C[i] * 2);
    }
};
struct Args { const float* in[38]; float* out; unsigned char* ws; int phase; int one; };
enum { I_X = 0, I_C, I_CTX, I_CCTX, I_ADAW, I_ADAB, I_NORMG, I_AWQKV, I_ABQKV, I_AWO, I_ABO, I_ASINK, I_PW, I_PB, I_PS,
       I_RMIX, I_RWRKV, I_RW0, I_RW1, I_RW2, I_RA0, I_RA1, I_RA2, I_RG1, I_RG2, I_RKK, I_RKA, I_RRK, I_RLNW, I_RLNB, I_RWO,
       I_MWR, I_MBR, I_MW1, I_MB1, I_MW2, I_MB2, I_FG };
struct Frame { LAS unsigned char* lds; int tid, lane, wave, G, c; unsigned char* ws; unsigned* ctl; };
#define WSP(T_, off) ((T_*)(F.ws + (off)))

struct TJob { const float* src; unsigned char* dst; long sbs, dbs; int ldw, ldt, nkb, nnb, mode, item0, per, esz; };
__device__ __forceinline__ int dst_row(int mode, int n) {
    if (mode == 1) { const int hb = n & ~63, d = n & 63; const int ax = d >> 5, dd = d & 31, hf = dd >> 4, f = dd & 15; const int g = ax * 4 + (f >> 2), i = (f & 3) + 4 * hf; return hb + 8 * g + i; }
    if (mode == 2) { return n < 1024 ? ((n >> 7) << 8) + (n & 127) : (((n - 1024) >> 7) << 8) + 128 + (n & 127); }
    return n;
}
struct TItem { const float* src; unsigned char* dst; int ldw, ldt, mode, n0, esz; };
__device__ __forceinline__ void titem_decode(const LAS TJob* jobs, int nj, int it, TItem& T) {
    int ji = 0;
    for (int q = 1; q < nj; ++q) ji += (jobs[q].item0 <= it) ? 1 : 0;
    const LAS TJob& J = jobs[ji]; const int r = it - J.item0, bi = r / J.per, rr = r % J.per, kb = rr / J.nnb, nb = rr % J.nnb;
    T.src = J.src + bi * J.sbs + (size_t)(64 * kb) * J.ldw + 32 * nb; T.dst = J.dst + (bi * J.dbs + 64 * kb) * J.esz; T.ldw = J.ldw; T.ldt = J.ldt; T.mode = J.mode; T.n0 = 32 * nb; T.esz = J.esz;
}
__device__ __forceinline__ void titem_load(const TItem& T, int lane, f32x4 (&v)[8]) {
    const float* p = T.src + (size_t)(lane >> 3) * T.ldw + 4 * (lane & 7);
#pragma unroll
    for (int i = 0; i < 8; ++i) v[i] = *(const f32x4*)(p + (size_t)(8 * i) * T.ldw);
}
__device__ __forceinline__ void titem_store(const TItem& T, int lane, const f32x4 (&v)[8], LAS float* scr) {
#pragma unroll
    for (int i = 0; i < 8; ++i) { LAS float* d = scr + (8 * i + (lane >> 3)) * 33 + 4 * (lane & 7); d[0] = v[i].x; d[1] = v[i].y; d[2] = v[i].z; d[3] = v[i].w; }
    LDS_WAIT(); asm volatile("" ::: "memory");
    const int c = lane & 7;
#pragma unroll
    for (int j = 0; j < 4; ++j) { const int n = (lane >> 3) + 8 * j; const LAS float* s = scr + (8 * c) * 33 + n;
        const size_t eo = (size_t)dst_row(T.mode, T.n0 + n) * T.ldt + 8 * c;
        if (T.esz == 2) { u32x4 o; o.x = pk2(s[0 * 33], s[1 * 33]); o.y = pk2(s[2 * 33], s[3 * 33]); o.z = pk2(s[4 * 33], s[5 * 33]); o.w = pk2(s[6 * 33], s[7 * 33]); *(u32x4*)(T.dst + eo * 2) = o; }
        else { u32x2 o; o.x = pk4_fp8(64.f * s[0 * 33], 64.f * s[1 * 33], 64.f * s[2 * 33], 64.f * s[3 * 33]); o.y = pk4_fp8(64.f * s[4 * 33], 64.f * s[5 * 33], 64.f * s[6 * 33], 64.f * s[7 * 33]); *(u32x2*)(T.dst + eo) = o; } }
    LDS_WAIT(); asm volatile("" ::: "memory");
}
__device__ __forceinline__ void phase_prologue(Frame& F, const Args& A) {
    REFRESH(F);
    LAS float* S = (LAS float*)F.lds;
    for (int idx = F.tid; idx < 33 * 1024; idx += NTHREADS) { const int r = idx >> 10, k = idx & 1023; const float v = r < 32 ? A.in[I_C][r * 1024 + k] : A.in[I_CCTX][k]; S[k * 33 + r] = v / (1.0f + __expf(-v)); }
    __syncthreads();
    float* MOD = WSP(float, WS_MOD);
    for (int it = F.c; it < 4 * 96; it += F.G) {
        const int layer = it / 96, n = (it % 96) * 64 + F.lane; const float* wp = A.in[I_ADAW] + (size_t)layer * 1024 * 6144 + n;
        float acc[5] = {0.f, 0.f, 0.f, 0.f, 0.f};
        for (int k0 = 0; k0 < 1024; k0 += 32) {
            float wv[32];
#pragma unroll
            for (int u = 0; u < 32; ++u) wv[u] = wp[(size_t)(k0 + u) * 6144];
#pragma unroll
            for (int u = 0; u < 32; ++u) { const LAS float* sr = S + (k0 + u) * 33 + F.wave;
                acc[0] += sr[0] * wv[u]; acc[1] += sr[8] * wv[u]; acc[2] += sr[16] * wv[u]; acc[3] += sr[24] * wv[u]; if (F.wave == 0) acc[4] += S[(k0 + u) * 33 + 32] * wv[u]; }
        }
        const float bb = A.in[I_ADAB][layer * 6144 + n];
#pragma unroll
        for (int i = 0; i < 4; ++i) MOD[((size_t)layer * 33 + F.wave + 8 * i) * 6144 + n] = acc[i] + bb;
        if (F.wave == 0) MOD[((size_t)layer * 33 + 32) * 6144 + n] = acc[4] + bb;
    }
    { float* rc = WSP(float, WS_ROPEC); float* rs = WSP(float, WS_ROPES);
      for (int idx = F.c * NTHREADS + F.tid; idx < 2048 * 32; idx += F.G * NTHREADS) { const int t = idx >> 5, e = idx & 31, g = e >> 2, i = e & 3, f = 4 * (g & 3) + i;
          const float inv = powf(10000.0f, -(float)f / 16.0f); const float pos = (float)(g < 4 ? (t >> 6) : (t & 63)); const float ang = pos * inv; rc[idx] = cosf(ang); rs[idx] = sinf(ang); }
      float* bq = WSP(float, WS_BQK);
      for (int idx = F.c * NTHREADS + F.tid; idx < 2 * 1280; idx += F.G * NTHREADS) { const int j = idx / 1280, n = idx % 1280; bq[j * 1280 + dst_row(1, n)] = A.in[I_ABQKV][j * 1536 + n]; } }
    __syncthreads();
    LAS TJob* jobs = (LAS TJob*)(F.lds + JOB_OFF); LAS int* njobs = (LAS int*)(F.lds + MISC_OFF + 64);
    if (F.tid == 0) {
        int nj = 0, item = 0;
        auto add = [&](const float* src, bf16_t* dst, int ldw, int ldt, int Ks, int Ns, int mode, int nb, long sbs, long dbs, int esz = 2) {
            LAS TJob& j = jobs[nj]; j.src = src; j.dst = (unsigned char*)dst; j.sbs = sbs; j.dbs = dbs; j.ldw = ldw; j.ldt = ldt; j.nkb = Ks / 64; j.nnb = Ns / 32; j.mode = mode; j.item0 = item; j.per = (Ks / 64) * (Ns / 32); j.esz = esz;
            ++nj; item += (Ks / 64) * (Ns / 32) * nb; };
        add(A.in[I_AWQKV], WSP(bf16_t, WS_WQK), 1536, 1024, 1024, 1280, 1, 2, 1024L * 1536, 1280L * 1024);
        add(A.in[I_AWQKV] + 1280, WSP(bf16_t, WS_WV), 1536, 1024, 1024, 256, 0, 2, 1024L * 1536, 256L * 1024);
        add(A.in[I_AWO], WSP(bf16_t, WS_WO), 1024, 1024, 1024, 1024, 0, 2, 1L << 20, 1L << 20);
        add(A.in[I_PW], WSP(bf16_t, WS_POOLW), 256, 256, 256, 256, 0, 4, 65536, 65536);
        add(A.in[I_RWRKV], WSP(bf16_t, WS_WRKV), 1024, 1024, 1024, 1024, 0, 3, 1L << 20, 1L << 20);
        add(A.in[I_RG1], WSP(bf16_t, WS_WL1), 128, 1024, 1024, 128, 0, 1, 0, 0);
        add(A.in[I_RW1], WSP(bf16_t, WS_WL1) + 256 * 1024, 64, 1024, 1024, 64, 0, 2, 65536, 65536);
        add(A.in[I_RA1], WSP(bf16_t, WS_WL1) + 2 * 256 * 1024, 64, 1024, 1024, 64, 0, 2, 65536, 65536);
        add(A.in[I_RG2], WSP(bf16_t, WS_WL2), 1024, 256, 128, 1024, 0, 1, 0, 0);
        add(A.in[I_RW2], WSP(bf16_t, WS_WL2) + 1 * 1024 * 256, 1024, 256, 64, 1024, 0, 2, 65536, 1024L * 256 + 64);
        add(A.in[I_RA2], WSP(bf16_t, WS_WL2) + 3 * 1024 * 256, 1024, 256, 64, 1024, 0, 2, 65536, 1024L * 256 + 64);
        add(A.in[I_RWO], WSP(bf16_t, WS_WOR), 1024, 1024, 1024, 1024, 0, 1, 0, 0);
        add(A.in[I_MW1], WSP(bf16_t, WS_W1T), 2048, 1024, 1024, 2048, 2, 128, 1024L * 2048, 2048L * 1024, 1);
        add(A.in[I_MW2], WSP(bf16_t, WS_W2T), 1024, 1024, 1024, 1024, 0, 128, 1L << 20, 1L << 20, 1);
        njobs[0] = nj; njobs[1] = item;
    }
    __syncthreads();
    { const int nj = njobs[0], nitems = njobs[1]; LAS float* scr = (LAS float*)(F.lds + F.wave * 16384);
      const int gw = F.c * NWAVES + F.wave, NGW = F.G * NWAVES;
      int it = gw;
      if (it < nitems) {
          TItem Tc, Tn; f32x4 vc[8], vn[8];
          titem_decode(jobs, nj, it, Tc); titem_load(Tc, F.lane, vc);
          for (;;) {
              const int itn = it + NGW; const bool more = itn < nitems;
              if (more) { titem_decode(jobs, nj, itn, Tn); titem_load(Tn, F.lane, vn); }
              titem_store(Tc, F.lane, vc, scr);
              if (!more) break;
              Tc = Tn;
#pragma unroll
              for (int i = 0; i < 8; ++i) vc[i] = vn[i];
              it = itn;
          }
      } }
    __syncthreads();
}

__device__ __forceinline__ void moe_tiles(Frame& F, int layer) {
    REFRESH(F);
    LAS int* lcnt = (LAS int*)(F.lds + LCNT_OFF); LAS int* tpre = (LAS int*)(F.lds + TPRE_OFF);
    __syncthreads();
    if (F.tid < NE) lcnt[F.tid] = (int)__hip_atomic_load(F.ctl + CW_GCNT + layer * 64 + F.tid, __ATOMIC_RELAXED, __HIP_MEMORY_SCOPE_AGENT);
    __syncthreads();
    if (F.tid == 0) { int s = 0; for (int e = 0; e < NE; ++e) { tpre[e] = s; s += (lcnt[e] + 255) >> 8; } tpre[NE] = s; }
    __syncthreads();
}
constexpr int RB = 2;
#define ROWOF(it, r) ((((it) * F.G + F.c) * NWAVES + F.wave) * RB + (r))
struct MoeRef { int p[4]; float g[4]; };
__device__ __forceinline__ void moe_ref_load(Frame& F, int row, MoeRef& R) {
    const int4 pp = *(const int4*)(WSP(int, WS_POS) + (size_t)row * 4); const f32x4 gg = *(const f32x4*)(WSP(float, WS_GATE) + (size_t)row * 4);
    R.p[0] = pp.x; R.p[1] = pp.y; R.p[2] = pp.z; R.p[3] = pp.w; R.g[0] = gg.x; R.g[1] = gg.y; R.g[2] = gg.z; R.g[3] = gg.w;
}
__device__ __forceinline__ void moe_rows_load(Frame& F, const MoeRef& R, u32x2 (&y)[4][4]) {
    const LAS int* tpre = (const LAS int*)(F.lds + TPRE_OFF); const bf16_t* Y = WSP(bf16_t, WS_Y);
#pragma unroll
    for (int k = 0; k < 4; ++k) { const int e = R.p[k] >> 20, slot = R.p[k] & 0xfffff; const size_t fr = (size_t)tpre[e] * 256 + slot; const u32x2* yp = (const u32x2*)(Y + fr * D) + F.lane;
#pragma unroll
        for (int j = 0; j < 4; ++j) y[k][j] = yp[64 * j]; }
}
__device__ __forceinline__ f32x4 moe_rows_sum(const MoeRef& R, const u32x2 (&y)[4][4], int j) {
    f32x4 s = (f32x4){0.f, 0.f, 0.f, 0.f};
#pragma unroll
    for (int k = 0; k < 4; ++k) { const u32x2 w = y[k][j]; s += R.g[k] * (f32x4){bflo(w.x), bfhi(w.x), bflo(w.y), bfhi(w.y)}; }
    return s;
}

__device__ __forceinline__ void phase_norm1(Frame& F, const Args& A, int layer) {
    REFRESH(F);
    if (layer > 0) moe_tiles(F, layer - 1);
    float* H = WSP(float, WS_H); bf16_t* AX = WSP(bf16_t, WS_AX); const float* MOD = WSP(float, WS_MOD);
    const float* g1 = A.in[I_NORMG] + (size_t)(layer * 2 + 0) * D;
    f32x4 gg[4];
#pragma unroll
    for (int j = 0; j < 4; ++j) gg[j] = ((const f32x4*)g1)[64 * j + F.lane];
    for (int it = 0;; ++it) { if (ROWOF(it, 0) >= NT) break;
        f32x4 v[RB][4]; int brow[RB];
        if (layer == 0) {
#pragma unroll
            for (int r = 0; r < RB; ++r) { const int row = ROWOF(it, r); brow[r] = row < NX ? (row >> 11) : 32; const float* src = row < NX ? A.in[I_X] + (size_t)row * D : A.in[I_CTX] + (size_t)(row - NX) * D;
#pragma unroll
                for (int j = 0; j < 4; ++j) v[r][j] = ((const f32x4*)src)[64 * j + F.lane]; }
        } else {
            MoeRef R[RB]; u32x2 y[RB][4][4]; f32x4 gv[RB][4];
#pragma unroll
            for (int r = 0; r < RB; ++r) moe_ref_load(F, ROWOF(it, r), R[r]);
#pragma unroll
            for (int r = 0; r < RB; ++r) { const int row = ROWOF(it, r); brow[r] = row < NX ? (row >> 11) : 32; moe_rows_load(F, R[r], y[r]);
                const float* g2p = MOD + ((size_t)(layer - 1) * 33 + brow[r]) * 6144 + 5 * D;
#pragma unroll
                for (int j = 0; j < 4; ++j) { v[r][j] = ((const f32x4*)(H + (size_t)row * D))[64 * j + F.lane]; gv[r][j] = ((const f32x4*)g2p)[64 * j + F.lane]; } }
#pragma unroll
            for (int r = 0; r < RB; ++r)
#pragma unroll
                for (int j = 0; j < 4; ++j) v[r][j] = v[r][j] + gv[r][j] * moe_rows_sum(R[r], y[r], j);
        }
        float rstd[RB];
#pragma unroll
        for (int r = 0; r < RB; ++r) { const int row = ROWOF(it, r); float ss = 0.f;
#pragma unroll
            for (int j = 0; j < 4; ++j) { ((f32x4*)(H + (size_t)row * D))[64 * j + F.lane] = v[r][j]; ss += (v[r][j].x * v[r][j].x + v[r][j].y * v[r][j].y) + (v[r][j].z * v[r][j].z + v[r][j].w * v[r][j].w); }
            rstd[r] = 1.0f / sqrtf(wave_sum(ss) * (1.0f / D) + 1e-5f); }
#pragma unroll
        for (int r = 0; r < RB; ++r) { const int row = ROWOF(it, r); const float* mp = MOD + ((size_t)layer * 33 + brow[r]) * 6144;
#pragma unroll
            for (int j = 0; j < 4; ++j) { const f32x4 sh = ((const f32x4*)mp)[64 * j + F.lane], sc = ((const f32x4*)(mp + D))[64 * j + F.lane];
                const f32x4 o = v[r][j] * rstd[r] * gg[j] * (sc + 1.0f) + sh;
                u32x2 w; w.x = pk2(o.x, o.y); w.y = pk2(o.z, o.w); ((u32x2*)(AX + (size_t)row * D))[64 * j + F.lane] = w; } }
    }
}
__device__ __forceinline__ void phase_final(Frame& F, const Args& A) {
    REFRESH(F);
    moe_tiles(F, DEPTH - 1);
    const float* H = WSP(float, WS_H); const float* MOD = WSP(float, WS_MOD); const float* fg = A.in[I_FG];
    f32x4 gg[4];
#pragma unroll
    for (int j = 0; j < 4; ++j) gg[j] = ((const f32x4*)fg)[64 * j + F.lane];
    for (int it = 0;; ++it) { if (ROWOF(it, 0) >= NX) break;
        MoeRef R[RB]; u32x2 y[RB][4][4]; f32x4 v[RB][4], gv[RB][4];
#pragma unroll
        for (int r = 0; r < RB; ++r) moe_ref_load(F, ROWOF(it, r), R[r]);
#pragma unroll
        for (int r = 0; r < RB; ++r) { const int row = ROWOF(it, r); moe_rows_load(F, R[r], y[r]); const float* g2p = MOD + ((size_t)(DEPTH - 1) * 33 + (row >> 11)) * 6144 + 5 * D;
#pragma unroll
            for (int j = 0; j < 4; ++j) { v[r][j] = ((const f32x4*)(H + (size_t)row * D))[64 * j + F.lane]; gv[r][j] = ((const f32x4*)g2p)[64 * j + F.lane]; } }
#pragma unroll
        for (int r = 0; r < RB; ++r) { const int row = ROWOF(it, r); float ss = 0.f;
#pragma unroll
            for (int j = 0; j < 4; ++j) { v[r][j] = v[r][j] + gv[r][j] * moe_rows_sum(R[r], y[r], j); ss += (v[r][j].x * v[r][j].x + v[r][j].y * v[r][j].y) + (v[r][j].z * v[r][j].z + v[r][j].w * v[r][j].w); }
            const float rstd = 1.0f / sqrtf(wave_sum(ss) * (1.0f / D) + 1e-5f);
#pragma unroll
            for (int j = 0; j < 4; ++j) ((f32x4*)(A.out + (size_t)row * D))[64 * j + F.lane] = v[r][j] * rstd * gg[j]; }
    }
}

__device__ __forceinline__ void phase_route(Frame& F, const Args& A, int layer) {
    REFRESH(F);
    const int nrows = (layer == DEPTH - 1) ? NX : NT;
    LAS float* wT = (LAS float*)F.lds;
    LAS int* lcnt = (LAS int*)(F.lds + LCNT_OFF); LAS int* lbase = (LAS int*)(F.lds + LBASE_OFF);
    LAS unsigned* recp = (LAS unsigned*)(F.lds + REC_OFF); LAS float* recg = (LAS float*)(F.lds + REC_OFF + 4608);
    __syncthreads();
    { const float* wr = A.in[I_MWR] + (size_t)layer * D * NE;
      for (int idx = F.tid; idx < D * NE; idx += NTHREADS) wT[(idx & 31) * 1024 + (idx >> 5)] = wr[idx]; }
    if (F.tid < NE) lcnt[F.tid] = 0;
    __syncthreads();
    const float* H = WSP(float, WS_H); unsigned char* FX = WSP(unsigned char, WS_FX); const float* MOD = WSP(float, WS_MOD);
    const float* g2 = A.in[I_NORMG] + (size_t)(layer * 2 + 1) * D; const float* br = A.in[I_MBR] + layer * NE;
    f32x4 gg[4];
#pragma unroll
    for (int j = 0; j < 4; ++j) gg[j] = ((const f32x4*)g2)[64 * j + F.lane];
    const int myE = F.lane >> 1; const float myb = br[myE];
    int nit = 0;
    for (int it = 0;; ++it) { if (ROWOF(it, 0) - F.wave * RB >= nrows) break; nit = it + 1;
        if (ROWOF(it, 0) >= nrows) continue;
        f32x4 v[RB][4]; float rstd[RB];
#pragma unroll
        for (int r = 0; r < RB; ++r) { const int row = ROWOF(it, r);
#pragma unroll
            for (int j = 0; j < 4; ++j) v[r][j] = ((const f32x4*)(H + (size_t)row * D))[64 * j + F.lane]; }
#pragma unroll
        for (int r = 0; r < RB; ++r) { float ss = 0.f;
#pragma unroll
            for (int j = 0; j < 4; ++j) ss += (v[r][j].x * v[r][j].x + v[r][j].y * v[r][j].y) + (v[r][j].z * v[r][j].z + v[r][j].w * v[r][j].w);
            rstd[r] = 1.0f / sqrtf(wave_sum(ss) * (1.0f / D) + 1e-5f); }
#pragma unroll
        for (int r = 0; r < RB; ++r) { const int row = ROWOF(it, r); const int brow = row < NX ? (row >> 11) : 32;
            const float* mp = MOD + ((size_t)layer * 33 + brow) * 6144 + 3 * D;
#pragma unroll
            for (int j = 0; j < 4; ++j) { const f32x4 sh = ((const f32x4*)mp)[64 * j + F.lane], sc = ((const f32x4*)(mp + D))[64 * j + F.lane];
                v[r][j] = v[r][j] * rstd[r] * gg[j] * (sc + 1.0f) + sh;
                ((unsigned*)(FX + (size_t)row * D))[64 * j + F.lane] = pk4_fp8(v[r][j].x, v[r][j].y, v[r][j].z, v[r][j].w); } }
        float part[RB][NE];
#pragma unroll
        for (int e = 0; e < NE; ++e) { float p0 = 0.f, p1 = 0.f;
#pragma unroll
            for (int j = 0; j < 4; ++j) { const f32x4 w4 = ((const LAS f32x4*)(wT + e * 1024))[64 * j + F.lane];
                p0 += (v[0][j].x * w4.x + v[0][j].y * w4.y) + (v[0][j].z * w4.z + v[0][j].w * w4.w); p1 += (v[1][j].x * w4.x + v[1][j].y * w4.y) + (v[1][j].z * w4.z + v[1][j].w * w4.w); }
            part[0][e] = p0; part[1][e] = p1; }
#pragma unroll
        for (int r = 0; r < RB; ++r) {
#pragma unroll
            for (int k = 0; k < 16; ++k) { const bool up = (F.lane & 32) != 0; const float keep = up ? part[r][k + 16] : part[r][k], send = up ? part[r][k] : part[r][k + 16]; part[r][k] = keep + __shfl_xor(send, 32); }
#pragma unroll
            for (int k = 0; k < 8; ++k) { const bool up = (F.lane & 16) != 0; const float keep = up ? part[r][k + 8] : part[r][k], send = up ? part[r][k] : part[r][k + 8]; part[r][k] = keep + __shfl_xor(send, 16); }
#pragma unroll
            for (int k = 0; k < 4; ++k) { const bool up = (F.lane & 8) != 0; const float keep = up ? part[r][k + 4] : part[r][k], send = up ? part[r][k] : part[r][k + 4]; part[r][k] = keep + __shfl_xor(send, 8); }
#pragma unroll
            for (int k = 0; k < 2; ++k) { const bool up = (F.lane & 4) != 0; const float keep = up ? part[r][k + 2] : part[r][k], send = up ? part[r][k] : part[r][k + 2]; part[r][k] = keep + __shfl_xor(send, 4); }
            { const bool up = (F.lane & 2) != 0; const float keep = up ? part[r][1] : part[r][0], send = up ? part[r][0] : part[r][1]; part[r][0] = keep + __shfl_xor(send, 2); }
            part[r][0] += __shfl_xor(part[r][0], 1);
        }
#pragma unroll
        for (int r = 0; r < RB; ++r) {
            const float val = part[r][0] + myb;
            int rank = 0;
#pragma unroll
            for (int e = 0; e < NE; ++e) { const float ve = __builtin_bit_cast(float, __builtin_amdgcn_readlane(__builtin_bit_cast(int, val), 2 * e)); rank += (ve > val || (ve == val && e < myE)) ? 1 : 0; }
            float sv[4]; int si[4];
#pragma unroll
            for (int k = 0; k < 4; ++k) { const unsigned long long m = __ballot(rank == k && (F.lane & 1) == 0); const int src = __builtin_ctzll(m);
                si[k] = src >> 1; sv[k] = __builtin_bit_cast(float, __builtin_amdgcn_readlane(__builtin_bit_cast(int, val), src)); }
            const float e1 = __expf(sv[1] - sv[0]), e2 = __expf(sv[2] - sv[0]), e3 = __expf(sv[3] - sv[0]); const float inv = 1.0f / (1.0f + e1 + e2 + e3);
            if (F.lane < 4) { const int e = F.lane == 0 ? si[0] : F.lane == 1 ? si[1] : F.lane == 2 ? si[2] : si[3]; const float g = (F.lane == 0 ? 1.0f : F.lane == 1 ? e1 : F.lane == 2 ? e2 : e3) * inv;
                const int rank2 = __hip_atomic_fetch_add(lcnt + e, 1, __ATOMIC_RELAXED, __HIP_MEMORY_SCOPE_WORKGROUP);
                const int ri = ((it * NWAVES + F.wave) * RB + r) * 4 + F.lane; recp[ri] = ((unsigned)e << 20) | (unsigned)rank2; recg[ri] = g; }
        }
    }
    __syncthreads();
    if (F.tid < NE) lbase[F.tid] = (int)__hip_atomic_fetch_add(F.ctl + CW_GCNT + layer * 64 + F.tid, (unsigned)lcnt[F.tid], __ATOMIC_RELAXED, __HIP_MEMORY_SCOPE_AGENT);
    __syncthreads();
    int* LIST = WSP(int, WS_LIST); int* POS = WSP(int, WS_POS); float* GATE = WSP(float, WS_GATE);
    for (int r = F.tid; r < nit * NWAVES * RB * 4; r += NTHREADS) { const int lr = r >> 2, k = r & 3; const int row = ((lr >> 4) * F.G + F.c) * (NWAVES * RB) + (lr & 15); if (row >= nrows) continue;
        const unsigned qx = recp[r]; const float qg = recg[r]; const int e = qx >> 20, slot = lbase[e] + (int)(qx & 0xfffff);
        LIST[(size_t)e * NT + slot] = row; POS[(size_t)row * 4 + k] = (e << 20) | slot; GATE[(size_t)row * 4 + k] = qg; }
    __syncthreads();
}

__device__ __forceinline__ void phase_pooldiff(Frame& F) {
    REFRESH(F);
    const bf16_t* AX = WSP(bf16_t, WS_AX); bf16_t* PD = WSP(bf16_t, WS_PD);
    for (int it = 0;; ++it) { if (ROWOF(it, 0) >= NT) break;
        const int row0 = ROWOF(it, 0); int sb, t, n; seq_of(row0, sb, t, n);
#pragma unroll
        for (int j = 0; j < 4; ++j) { const int half = 1 << j; const int col = 256 * j + 4 * F.lane;
            f32x4 s0 = (f32x4){0.f, 0.f, 0.f, 0.f}, s1 = s0, me0 = s0, me1 = s0;
#pragma unroll
            for (int q = 0; q < 2 * half + 1; ++q) { const int uu = t - half + q;
                if (uu >= 0 && uu < n) { const f32x4 x = ld_bf4(AX + (size_t)(sb + uu) * D + col); if (q < 2 * half) s0 += x; if (q > 0) s1 += x; if (q == half) me0 = x; if (q == half + 1) me1 = x; } }
            const int lo0 = t - half < 0 ? 0 : t - half, hi0 = t + half > n ? n : t + half, lo1 = t + 1 - half < 0 ? 0 : t + 1 - half, hi1 = t + 1 + half > n ? n : t + 1 + half;
            st_bf4(PD + (size_t)row0 * D + col, s0 * (1.0f / (float)(hi0 - lo0)) - me0);
            st_bf4(PD + (size_t)(row0 + 1) * D + col, s1 * (1.0f / (float)(hi1 - lo1)) - me1); }
    }
}
__device__ __forceinline__ void phase_rwkv_mix(Frame& F, const Args& A) {
    REFRESH(F);
    const bf16_t* AX = WSP(bf16_t, WS_AX); bf16_t* A6 = WSP(bf16_t, WS_A6); const float* mix = A.in[I_RMIX];
    for (int it = 0;; ++it) { if (ROWOF(it, 0) >= NT) break;
        const int row0 = ROWOF(it, 0); int sb, t, n; seq_of(row0, sb, t, n);
#pragma unroll
        for (int j = 0; j < 4; ++j) { const int col = 256 * j + 4 * F.lane; const f32x4 z = (f32x4){0.f, 0.f, 0.f, 0.f};
            const f32x4 h0 = ld_bf4(AX + (size_t)row0 * D + col), h1 = ld_bf4(AX + (size_t)(row0 + 1) * D + col);
            const f32x4 hp = t > 0 ? ld_bf4(AX + (size_t)(row0 - 1) * D + col) : z, hn = t + 1 < n - 1 ? ld_bf4(AX + (size_t)(row0 + 2) * D + col) : z;
            const f32x4 xx0 = (hp + h1) * 0.5f - h0, xx1 = (h0 + hn) * 0.5f - h1;
#pragma unroll
            for (int i = 0; i < 6; ++i) { const f32x4 m = *(const f32x4*)(mix + i * D + col); st_bf4(A6 + ((size_t)i * NT + row0) * D + col, h0 + xx0 * m); st_bf4(A6 + ((size_t)i * NT + row0 + 1) * D + col, h1 + xx1 * m); } }
    }
}
__device__ __forceinline__ float rl(float x, int k) { return __builtin_bit_cast(float, __builtin_amdgcn_readlane(__builtin_bit_cast(int, x), k)); }
constexpr int SCAN_TB = 8;
__device__ __forceinline__ void phase_rwkv_scan(Frame& F, const Args& A) {
    REFRESH(F);
    __syncthreads();
    for (int item = F.wave * F.G + F.c; item < 1024 && F.wave < 4; item += 4 * F.G) {
        const int dir = item >> 9, b = (item >> 4) & 31, h = item & 15, col = 64 * h + F.lane;
        const bf16_t* Rr = WSP(bf16_t, WS_RKV); const bf16_t* Kk = Rr + (size_t)NT * D; const bf16_t* Vv = Kk + (size_t)NT * D;
        const bf16_t* Ee = WSP(bf16_t, WS_E) + (size_t)dir * NT * D; const bf16_t* Aa = WSP(bf16_t, WS_A) + (size_t)dir * NT * D;
        float* Yo = WSP(float, WS_YS) + (size_t)dir * NT * D; float* Bo = WSP(float, WS_BONUS) + (size_t)dir * NT * 16;
        const float kkw = A.in[I_RKK][col], kaw = A.in[I_RKA][col], rkw = A.in[I_RRK][col];
        LAS float* slab = (LAS float*)(F.lds + F.wave * (SCAN_TB * 320 * 4));
        const int uoff = 64 + (F.lane >> 2) * 16 + (F.lane & 3);
        f32x2 S[32];
#pragma unroll
        for (int k = 0; k < 32; ++k) S[k] = (f32x2){0.f, 0.f};
        for (int seg = 0; seg < 2; ++seg) {
            const int base = seg ? b * T : NX + b * L, n = seg ? T : L; const int dt = dir ? -1 : 1; const int t0 = dir ? n - 1 : 0;
            bf16_t raw[SCAN_TB][5];
#pragma unroll
            for (int s = 0; s < SCAN_TB; ++s) { const size_t o = (size_t)(base + t0 + dt * s) * D + col; raw[s][0] = Rr[o]; raw[s][1] = Kk[o]; raw[s][2] = Vv[o]; raw[s][3] = Aa[o]; raw[s][4] = Ee[o]; }
            for (int bt = 0; bt < n; bt += SCAN_TB) {
                float vv[SCAN_TB];
                { float rr[SCAN_TB], kk[SCAN_TB], aa[SCAN_TB], ee[SCAN_TB], kd[SCAN_TB], n2[SCAN_TB], bn[SCAN_TB];
#pragma unroll
                  for (int s = 0; s < SCAN_TB; ++s) { rr[s] = bf1(raw[s][0]); const float kraw = bf1(raw[s][1]); vv[s] = bf1(raw[s][2]); aa[s] = bf1(raw[s][3]); ee[s] = bf1(raw[s][4]);
                      kk[s] = kraw * kkw; n2[s] = kk[s] * kk[s]; kd[s] = kraw * (1.0f + (aa[s] - 1.0f) * kaw); bn[s] = rr[s] * kd[s] * rkw; }
#pragma unroll
                  for (int s = 0; s < SCAN_TB; ++s) { n2[s] = wave_sum(n2[s]); bn[s] = wave_sum(bn[s]); }
#pragma unroll
                  for (int s = 0; s < SCAN_TB; ++s) { const float kn = kk[s] / fmaxf(sqrtf(n2[s]), 1e-12f);
                      if (F.lane == 0) Bo[(size_t)(base + t0 + dt * (bt + s)) * 16 + h] = bn[s];
                      LAS float* sl = slab + s * 320; sl[F.lane] = -kn; sl[uoff] = __expf(-ee[s]); sl[uoff + 4] = kn * aa[s]; sl[uoff + 8] = kd[s]; sl[uoff + 12] = rr[s]; } }
                { const int nb = (bt + SCAN_TB < n) ? bt + SCAN_TB : bt;
#pragma unroll
                  for (int s = 0; s < SCAN_TB; ++s) { const size_t o = (size_t)(base + t0 + dt * (nb + s)) * D + col; raw[s][0] = Rr[o]; raw[s][1] = Kk[o]; raw[s][2] = Vv[o]; raw[s][3] = Aa[o]; raw[s][4] = Ee[o]; } }
                asm volatile("s_waitcnt lgkmcnt(0)" ::: "memory");
                const LAS f32x4* cs = (const LAS f32x4*)slab;
                f32x4 R[4][4];
#pragma unroll
                for (int g = 0; g < 3; ++g)
#pragma unroll
                    for (int i = 0; i < 4; ++i) R[g][i] = cs[g * 4 + i];
                f32x2 sa0, sa1, sa2, sa3, y0, y1, y2, y3, sav, vv2;
#pragma unroll
                for (int s = 0; s < SCAN_TB; ++s) {
#pragma unroll
                  for (int c = 0; c < 20; ++c) {
                    const int g = s * 20 + c;
                    if (g + 3 < SCAN_TB * 20) {
#pragma unroll
                        for (int i = 0; i < 4; ++i) R[(c + 3) & 3][i] = cs[(g + 3) * 4 + i]; }
                    __builtin_amdgcn_sched_barrier(0);
                    const f32x4 r0 = R[c & 3][0], r1 = R[c & 3][1], r2 = R[c & 3][2], r3 = R[c & 3][3];
                    if (c < 4) {
                        if (c == 0) { sa0 = (f32x2){0.f, 0.f}; sa1 = sa0; sa2 = sa0; sa3 = sa0; }
                        sa0 += S[8 * c + 0] * (f32x2){r0.x, r0.y}; sa1 += S[8 * c + 1] * (f32x2){r0.z, r0.w}; sa2 += S[8 * c + 2] * (f32x2){r1.x, r1.y}; sa3 += S[8 * c + 3] * (f32x2){r1.z, r1.w};
                        sa0 += S[8 * c + 4] * (f32x2){r2.x, r2.y}; sa1 += S[8 * c + 5] * (f32x2){r2.z, r2.w}; sa2 += S[8 * c + 6] * (f32x2){r3.x, r3.y}; sa3 += S[8 * c + 7] * (f32x2){r3.z, r3.w};
                        if (c == 3) { const f32x2 t2 = (sa0 + sa1) + (sa2 + sa3); const float sa = t2.x + t2.y; sav = (f32x2){sa, sa}; vv2 = (f32x2){vv[s], vv[s]};
                            y0 = (f32x2){0.f, 0.f}; y1 = y0; y2 = y0; y3 = y0; }
                    } else {
                        const int q = c - 4;
                        const f32x2 s0 = S[2 * q] * (f32x2){r0.x, r0.y} + sav * (f32x2){r1.x, r1.y} + vv2 * (f32x2){r2.x, r2.y}; S[2 * q] = s0;
                        const f32x2 s1 = S[2 * q + 1] * (f32x2){r0.z, r0.w} + sav * (f32x2){r1.z, r1.w} + vv2 * (f32x2){r2.z, r2.w}; S[2 * q + 1] = s1;
                        if (q & 1) { y2 += s0 * (f32x2){r3.x, r3.y}; y3 += s1 * (f32x2){r3.z, r3.w}; } else { y0 += s0 * (f32x2){r3.x, r3.y}; y1 += s1 * (f32x2){r3.z, r3.w}; }
                        if (q == 15) { const f32x2 t2 = (y0 + y1) + (y2 + y3); Yo[(size_t)(base + t0 + dt * (bt + s)) * D + col] = t2.x + t2.y; }
                    }
                    __builtin_amdgcn_sched_barrier(0);
                  }
                }
            }
        }
    }
    __syncthreads();
}
__device__ __forceinline__ void phase_rwkv_out(Frame& F, const Args& A, int nrows) {
    REFRESH(F);
    const float* Y0 = WSP(float, WS_YS); const float* Y1 = Y0 + (size_t)NT * D; const float* B0 = WSP(float, WS_BONUS); const float* B1 = B0 + (size_t)NT * 16;
    const bf16_t* Vv = WSP(bf16_t, WS_RKV) + (size_t)2 * NT * D; const bf16_t* Gg = WSP(bf16_t, WS_G); bf16_t* RO = WSP(bf16_t, WS_RO);
    const float* lnw = A.in[I_RLNW]; const float* lnb = A.in[I_RLNB];
    for (int it = 0;; ++it) { if (ROWOF(it, 0) >= nrows) break;
        f32x4 y[RB][4], vv[RB][4], gg[RB][4]; float bon[RB][4];
#pragma unroll
        for (int r = 0; r < RB; ++r) { const int row = ROWOF(it, r);
#pragma unroll
            for (int j = 0; j < 4; ++j) { const int col = 256 * j + 4 * F.lane, head = 4 * j + (F.lane >> 4); const size_t o = (size_t)row * D + col;
                y[r][j] = *(const f32x4*)(Y0 + o) + *(const f32x4*)(Y1 + o); vv[r][j] = ld_bf4(Vv + o); gg[r][j] = ld_bf4(Gg + o); bon[r][j] = B0[(size_t)row * 16 + head] + B1[(size_t)row * 16 + head]; } }
#pragma unroll
        for (int r = 0; r < RB; ++r) { const int row = ROWOF(it, r);
#pragma unroll
            for (int j = 0; j < 4; ++j) { const int col = 256 * j + 4 * F.lane; const size_t o = (size_t)row * D + col; const f32x4 yy = y[r][j];
                const float s = row16_sum((yy.x + yy.y) + (yy.z + yy.w));
                const f32x4 d = yy - s * (1.0f / 64.0f);
                const float q = row16_sum((d.x * d.x + d.y * d.y) + (d.z * d.z + d.w * d.w));
                const float rs = 1.0f / sqrtf(q * (1.0f / 64.0f) + 64e-5f);
                const f32x4 yn = d * rs * *(const f32x4*)(lnw + col) + *(const f32x4*)(lnb + col);
                st_bf4(RO + o, (yn + vv[r][j] * bon[r][j]) * gg[r][j]); } }
    }
}

__device__ __forceinline__ void phase_attn(Frame& F, const Args& A, int j, bool need_ctx) {
    REFRESH(F);
    const bf16_t* Q = WSP(bf16_t, WS_Q); const bf16_t* Kb = WSP(bf16_t, WS_K); const bf16_t* VT = WSP(bf16_t, WS_VT); bf16_t* O = WSP(bf16_t, WS_O);
    const float* sinks = A.in[I_ASINK] + j * 16;
    LAS bf16_t* Ks = (LAS bf16_t*)F.lds; LAS bf16_t* Vs = (LAS bf16_t*)(F.lds + 9216);
    const int nunits = 2048 + (need_ctx ? 256 : 0);
    const int fr = F.lane & 15, fq = F.lane >> 4, g = F.wave >> 1, hf = F.wave & 1;
    const float SC = 0.125f * 1.4426950408889634f;
    for (int u = F.c; u < nunits; u += F.G) {
        int b, kvh, qb; bool isx;
        if (u < 2048) { isx = true; b = u >> 6; kvh = (u >> 4) & 3; qb = u & 15; } else { const int v = u - 2048; isx = false; b = v >> 3; kvh = (v >> 1) & 3; qb = v & 1; }
        const int qrow0 = (isx ? b * T : NX + b * L) + qb * 128 + hf * 64; const int head = 4 * kvh + g;
        bf16x8 Qf[4][2];
#pragma unroll
        for (int mq = 0; mq < 4; ++mq)
#pragma unroll
            for (int ks = 0; ks < 2; ++ks) Qf[mq][ks] = *(const bf16x8*)(Q + (size_t)(qrow0 + 16 * mq + fr) * D + head * 64 + ks * 32 + 8 * fq);
        const float sink2 = sinks[head] * 1.4426950408889634f;
        float mrun[4], lrun[4]; f32x4 Oa[4][4];
#pragma unroll
        for (int mq = 0; mq < 4; ++mq) { mrun[mq] = sink2; lrun[mq] = fq == 0 ? 1.0f : 0.0f;
#pragma unroll
            for (int db = 0; db < 4; ++db) Oa[mq][db] = (f32x4){0.f, 0.f, 0.f, 0.f}; }
        const int ntiles = isx ? 10 : 4;
        for (int ti = 0; ti < ntiles; ++ti) {
            int krow0, jl = -1, ks0 = 0;
            if (ti < 4) krow0 = NX + b * L + ti * 64;
            else { jl = ti - 4; ks0 = qb * 128 - 128 + 64 * jl; if (ks0 < 0 || ks0 >= T) continue; krow0 = b * T + ks0; }
            __syncthreads();
            { const int r = F.tid >> 3, ch = F.tid & 7;
              const u32x4 kv = *(const u32x4*)(Kb + (size_t)(krow0 + r) * 256 + kvh * 64 + ch * 8);
              const u32x4 vv = *(const u32x4*)(VT + (size_t)(kvh * 64 + r) * NT + krow0 + ch * 8);
              *(LAS u32x4*)(Ks + r * 72 + ch * 8) = kv; *(LAS u32x4*)(Vs + r * 72 + ch * 8) = vv; }
            __syncthreads();
            const bool need = (jl < 0) || (jl >= hf && jl <= hf + 4);
            if (need) {
                f32x4 Sa[4][4];
#pragma unroll
                for (int mq = 0; mq < 4; ++mq)
#pragma unroll
                    for (int n = 0; n < 4; ++n) Sa[mq][n] = (f32x4){0.f, 0.f, 0.f, 0.f};
#pragma unroll
                for (int ks = 0; ks < 2; ++ks)
#pragma unroll
                    for (int n = 0; n < 4; ++n) { const int kr = 32 * (n >> 1) + 8 * (fr >> 2) + 4 * (n & 1) + (fr & 3);
                        const bf16x8 Kf = *(const LAS bf16x8*)(Ks + kr * 72 + ks * 32 + 8 * fq);
#pragma unroll
                        for (int mq = 0; mq < 4; ++mq) Sa[mq][n] = __builtin_amdgcn_mfma_f32_16x16x32_bf16(Kf, Qf[mq][ks], Sa[mq][n], 0, 0, 0); }
                bf16x8 Pf[4][2];
#pragma unroll
                for (int mq = 0; mq < 4; ++mq) {
                    const int tq = qb * 128 + hf * 64 + 16 * mq + fr;
                    float mx = -1e30f;
#pragma unroll
                    for (int n = 0; n < 4; ++n)
#pragma unroll
                        for (int i = 0; i < 4; ++i) { float s = Sa[mq][n][i] * SC;
                            if (jl >= 0) { const int rel = ks0 + 32 * (n >> 1) + 8 * fq + 4 * (n & 1) + i - tq; if (rel > 128 || rel < -128) s = -1e30f; }
                            Sa[mq][n][i] = s; mx = fmaxf(mx, s); }
                    mx = fmaxf(mx, __shfl_xor(mx, 16)); mx = fmaxf(mx, __shfl_xor(mx, 32));
                    const float mnew = fmaxf(mrun[mq], mx); const float alpha = __builtin_amdgcn_exp2f(mrun[mq] - mnew); mrun[mq] = mnew;
                    float rs = 0.f;
#pragma unroll
                    for (int n = 0; n < 4; ++n)
#pragma unroll
                        for (int i = 0; i < 4; ++i) { const float p = __builtin_amdgcn_exp2f(Sa[mq][n][i] - mnew); Sa[mq][n][i] = p; rs += p; }
                    lrun[mq] = lrun[mq] * alpha + rs;
#pragma unroll
                    for (int db = 0; db < 4; ++db) Oa[mq][db] *= alpha;
#pragma unroll
                    for (int s = 0; s < 2; ++s) { u32x4 w; w.x = cvt_pk_bf16(Sa[mq][2 * s][0], Sa[mq][2 * s][1]); w.y = cvt_pk_bf16(Sa[mq][2 * s][2], Sa[mq][2 * s][3]);
                        w.z = cvt_pk_bf16(Sa[mq][2 * s + 1][0], Sa[mq][2 * s + 1][1]); w.w = cvt_pk_bf16(Sa[mq][2 * s + 1][2], Sa[mq][2 * s + 1][3]); Pf[mq][s] = __builtin_bit_cast(bf16x8, w); }
                }
#pragma unroll
                for (int db = 0; db < 4; ++db)
#pragma unroll
                    for (int s = 0; s < 2; ++s) { const bf16x8 Vf = *(const LAS bf16x8*)(Vs + (16 * db + fr) * 72 + 32 * s + 8 * fq);
#pragma unroll
                        for (int mq = 0; mq < 4; ++mq) Oa[mq][db] = __builtin_amdgcn_mfma_f32_16x16x32_bf16(Vf, Pf[mq][s], Oa[mq][db], 0, 0, 0); }
            }
        }
#pragma unroll
        for (int mq = 0; mq < 4; ++mq) { float l = lrun[mq]; l += __shfl_xor(l, 16); l += __shfl_xor(l, 32); const float inv = 1.0f / l;
            bf16_t* op = O + (size_t)(qrow0 + 16 * mq + fr) * D + head * 64 + 4 * fq;
#pragma unroll
            for (int db = 0; db < 4; ++db) st_bf4(op + 16 * db, Oa[mq][db] * inv); }
    }
    __syncthreads();
}

struct KState { XcdBarrier bar; int ph; };
#define RUN() (A.one || A.phase == KS.ph)
#define SEAM() do { if (A.one) xcd_barrier(KS.bar); ++KS.ph; } while (0)
template <int LAYER>
__device__ __forceinline__ void layer_body(Frame& F, const Args& A, KState& KS) {
    constexpr int layer = LAYER, kind = LAYER % 3, j = LAYER / 3; constexpr bool last = (LAYER == DEPTH - 1);
    LAS unsigned char* ring = F.lds;
    const LAS int* tpre = (const LAS int*)(F.lds + TPRE_OFF); const LAS int* lcnt = (const LAS int*)(F.lds + LCNT_OFF);
    float* H = WSP(float, WS_H); const float* MOD = WSP(float, WS_MOD); const bf16_t* AX = WSP(bf16_t, WS_AX);
    const float* gate1 = MOD + (size_t)layer * 33 * 6144 + 2 * D;
    constexpr int nMall = last ? NX / 256 : NT / 256;
    if (RUN()) phase_norm1(F, A, layer);
    SEAM();
    if constexpr (kind == 0) {
        if (RUN()) for (int rep_ = 0; rep_ < REPN(1); ++rep_) {
            { pg8::ProbDense P; P.A = AX; P.Bt = WSP(bf16_t, WS_WQK) + (size_t)j * 1280 * D; P.lda = D; P.ldb = D; P.K = D; P.a_pn_off = 0; P.ord.init(NT / 256, 5, F.G, F.c);
              EpiQK E{WSP(bf16_t, WS_Q), WSP(bf16_t, WS_K), WSP(float, WS_BQK) + j * 1280, WSP(float, WS_ROPEC), WSP(float, WS_ROPES)};
              pg8::gemm_phase(ring, P, E); }
            { pg8::ProbDense P; P.A = WSP(bf16_t, WS_WV) + (size_t)j * 256 * D; P.Bt = AX; P.lda = D; P.ldb = D; P.K = D; P.a_pn_off = 0; P.ord.init(1, NT / 256, F.G, F.c);
              EpiVT E{WSP(bf16_t, WS_VT), A.in[I_ABQKV] + j * 1536 + 1280};
              pg8::gemm_phase(ring, P, E); }
        }
        SEAM();
        if (RUN()) for (int rep_ = 0; rep_ < REPN(2); ++rep_) phase_attn(F, A, j, !last);
        SEAM();
        if (RUN() && !((SKIPMASK >> layer) & 1)) { pg8::ProbDense P; P.A = WSP(bf16_t, WS_O); P.Bt = WSP(bf16_t, WS_WO) + (size_t)j * D * D; P.lda = D; P.ldb = D; P.K = D; P.a_pn_off = 0; P.ord.init(nMall, 4, F.G, F.c);
            EpiResid E{H, A.in[I_ABO] + j * D, nullptr, gate1};
            pg8::gemm_phase(ring, P, E); }
        SEAM();
    } else if constexpr (kind == 1) {
        if (RUN()) for (int rep_ = 0; rep_ < REPN(3); ++rep_) phase_pooldiff(F);
        SEAM();
        if (RUN() && !((SKIPMASK >> layer) & 1)) { pg8::ProbDense P; P.A = WSP(bf16_t, WS_PD); P.Bt = WSP(bf16_t, WS_POOLW); P.lda = D; P.ldb = 256; P.K = 256; P.a_pn_off = 256; P.ord.init(nMall, 4, F.G, F.c);
            EpiResid E{H, A.in[I_PB], A.in[I_PS], gate1};
            pg8::gemm_phase(ring, P, E); }
        SEAM();
    } else {
        if (RUN()) for (int rep_ = 0; rep_ < REPN(4); ++rep_) phase_rwkv_mix(F, A);
        SEAM();
        if (RUN()) for (int rep_ = 0; rep_ < REPN(5); ++rep_) {
            for (int i = 0; i < 3; ++i) { const int sel = i == 0 ? 0 : i == 1 ? 2 : 3;
                pg8::ProbDense P; P.A = WSP(bf16_t, WS_A6) + (size_t)sel * NT * D; P.Bt = WSP(bf16_t, WS_WRKV) + (size_t)i * D * D; P.lda = D; P.ldb = D; P.K = D; P.a_pn_off = 0; P.ord.init(NT / 256, 4, F.G, F.c);
                EpiBf16Act E{WSP(bf16_t, WS_RKV) + (size_t)i * NT * D, D, nullptr, 0, 1.0f};
                pg8::gemm_phase(ring, P, E); }
            for (int i = 0; i < 3; ++i) { const int sel = i == 0 ? 5 : i == 1 ? 1 : 4;
                pg8::ProbDense P; P.A = WSP(bf16_t, WS_A6) + (size_t)sel * NT * D; P.Bt = WSP(bf16_t, WS_WL1) + (size_t)i * 256 * D; P.lda = D; P.ldb = D; P.K = D; P.a_pn_off = 0; P.ord.init(NT / 256, 1, F.G, F.c);
                EpiBf16Act E{WSP(bf16_t, WS_LORA) + i * 256, 768, nullptr, i == 0 ? 1 : i == 1 ? 2 : 0, 1.0f};
                pg8::gemm_phase(ring, P, E); }
        }
        SEAM();
        if (RUN()) for (int rep_ = 0; rep_ < REPN(6); ++rep_) {
            for (int i = 0; i < 5; ++i) {
                const int ablk = i == 0 ? 0 : i < 3 ? 1 : 2, d = (i - 1) & 1;
                pg8::ProbDense P; P.A = WSP(bf16_t, WS_LORA) + ablk * 256; P.Bt = WSP(bf16_t, WS_WL2) + (size_t)i * D * 256; P.lda = 768; P.ldb = 256; P.K = 256; P.a_pn_off = 0; P.ord.init(NT / 256, 4, F.G, F.c);
                EpiBf16Act E; E.ldc = D;
                if (i == 0) { E.O = WSP(bf16_t, WS_G); E.bias = nullptr; E.act = 0; E.scale = 1.0f; }
                else if (i < 3) { E.O = WSP(bf16_t, WS_E) + (size_t)d * NT * D; E.bias = A.in[I_RW0] + d * D; E.act = 1; E.scale = 0.6065306597126334f; }
                else { E.O = WSP(bf16_t, WS_A) + (size_t)d * NT * D; E.bias = A.in[I_RA0] + d * D; E.act = 1; E.scale = 1.0f; }
                pg8::gemm_phase(ring, P, E); }
        }
        SEAM();
        if (RUN()) for (int rep_ = 0; rep_ < REPN(7); ++rep_) phase_rwkv_scan(F, A);
        SEAM();
        if (RUN()) for (int rep_ = 0; rep_ < REPN(8); ++rep_) phase_rwkv_out(F, A, last ? NX : NT);
        SEAM();
        if (RUN() && !((SKIPMASK >> layer) & 1)) { pg8::ProbDense P; P.A = WSP(bf16_t, WS_RO); P.Bt = WSP(bf16_t, WS_WOR); P.lda = D; P.ldb = D; P.K = D; P.a_pn_off = 0; P.ord.init(nMall, 4, F.G, F.c);
            EpiResid E{H, nullptr, nullptr, gate1};
            pg8::gemm_phase(ring, P, E); }
        SEAM();
    }
    if (RUN()) phase_route(F, A, layer);
    SEAM();
    if (RUN()) for (int rep_ = 0; rep_ < REPN(9); ++rep_) { moe_tiles(F, layer);
        ProbMoe1 P; P.FX = WSP(fp8_t, WS_FX); P.W1T = WSP(fp8_t, WS_W1T) + (size_t)layer * NE * 2048 * D; P.list = WSP(int, WS_LIST); P.tpre = tpre; P.cnt = lcnt; P.scale_w = SCALE_W; P.scale_x = SCALE_ONE; P.ord.init(tpre[NE], 8, F.G, F.c);
        EpiMoe1 E{WSP(unsigned char, WS_ACT), A.in[I_MB1] + (size_t)layer * NE * 2048};
        pg8::gemm_phase(ring, P, E); }
    SEAM();
    if (RUN()) for (int rep_ = 0; rep_ < REPN(10); ++rep_) { moe_tiles(F, layer);
        ProbMoe2 P; P.ACT = WSP(fp8_t, WS_ACT); P.W2T = WSP(fp8_t, WS_W2T) + (size_t)layer * NE * D * D; P.tpre = tpre; P.scale_w = SCALE_W; P.scale_x = SCALE_ONE; P.ord.init(tpre[NE], 4, F.G, F.c);
        EpiMoe2 E{WSP(bf16_t, WS_Y), A.in[I_MB2] + (size_t)layer * NE * D};
        pg8::gemm_phase(ring, P, E); }
    SEAM();
}
__global__ void __launch_bounds__(NTHREADS, 2) trunk_fwd(Args A) {
    extern __shared__ __attribute__((aligned(16))) unsigned char lds_[];
    Frame F; F.lds = (LAS unsigned char*)lds_; REFRESH(F); F.wave = __builtin_amdgcn_readfirstlane(F.tid >> 6);
    F.G = gridDim.x; F.c = blockIdx.x; F.ws = A.ws; F.ctl = (unsigned*)(A.ws + WS_CTL);
    for (int u = F.tid; u < (LDS_BYTES - LDSCTL_OFF) / 4; u += NTHREADS) ((LAS unsigned*)(F.lds + LDSCTL_OFF))[u] = 0u;
    __syncthreads();
    KState KS; KS.bar.bar = F.ctl + CW_BAR; KS.bar.x = 0; KS.bar.st = nullptr; KS.ph = 0;
    if (A.one) KS.bar = xcd_barrier_post(F.ctl + CW_BAR, (volatile LAS unsigned*)(F.lds + MISC_OFF) + 8);
    if (RUN()) for (int rep_ = 0; rep_ < REPN(0); ++rep_) phase_prologue(F, A);
    SEAM();
    layer_body<0>(F, A, KS);
    layer_body<1>(F, A, KS);
    layer_body<2>(F, A, KS);
    layer_body<3>(F, A, KS);
    if (RUN()) phase_final(F, A);
}
#undef RUN
#undef SEAM
static int count_phases() { int n = 1; for (int layer = 0; layer < DEPTH; ++layer) { const int kind = layer % 3; n += 1 + (kind == 0 ? 3 : kind == 1 ? 2 : 6) + 3; } return n + 1; }

extern "C" void kernel_launch(void* const* d_in, const int* in_sizes, int n_in, void* d_out, int out_size, void* d_ws, size_t ws_size, hipStream_t stream) {
    static int grid = 0;
    if (grid == 0) {
        if (n_in != 38 || out_size != NX * D || ws_size < WS_END) { fprintf(stderr, "kernel_launch: unexpected problem (n_in %d, out %d, ws %zu < %zu)\n", n_in, out_size, ws_size, (size_t)WS_END); grid = -1; return; }
        int dev = 0, cus = 0;
        if (hipGetDevice(&dev) != hipSuccess || hipDeviceGetAttribute(&cus, hipDeviceAttributeMultiprocessorCount, dev) != hipSuccess) { grid = -1; return; }
        if (hipFuncSetAttribute((const void*)trunk_fwd, hipFuncAttributeMaxDynamicSharedMemorySize, LDS_BYTES) != hipSuccess) { fprintf(stderr, "kernel_launch: hipFuncSetAttribute failed\n"); grid = -1; return; }
        int per_cu = 0;
        if (hipOccupancyMaxActiveBlocksPerMultiprocessor(&per_cu, (const void*)trunk_fwd, NTHREADS, LDS_BYTES) != hipSuccess || per_cu < 1) fprintf(stderr, "kernel_launch: occupancy query says %d\n", per_cu);
        (void)hipGetLastError();
        grid = cus;
        if (grid != 256) fprintf(stderr, "kernel_launch: %d CUs (built for 256)\n", grid);
    }
    if (grid < 0) return;
    (void)hipMemsetAsync((char*)d_ws + WS_CTL, 0, CTL_BYTES, stream);
    (void)hipMemsetAsync((char*)d_ws + WS_LZERO, 0, LZERO_BYTES, stream);
    Args a{};
    for (int i = 0; i < 38; ++i) a.in[i] = (const float*)d_in[i];
    a.out = (float*)d_out; a.ws = (unsigned char*)d_ws;
#if MK_ONE_LAUNCH
    a.phase = 0; a.one = 1;
    hipLaunchKernelGGL(trunk_fwd, dim3(grid), dim3(NTHREADS), LDS_BYTES, stream, a);
#else
    const int nph = count_phases();
    for (int p = 0; p < nph; ++p) { a.phase = p; a.one = 0; hipLaunchKernelGGL(trunk_fwd, dim3(grid), dim3(NTHREADS), LDS_BYTES, stream, a); }
#endif
}
```

```cpp
#include <hip/hip_runtime.h>
#include <cstdio>
#include <cstdint>

#ifndef MK_ONE_LAUNCH
#define MK_ONE_LAUNCH 1
#endif
#ifndef REPMASK
#define REPMASK 0x000
#endif
#define REPN(k) (1 + ((REPMASK >> (k)) & 1))
#ifndef DIAG
#define DIAG 0
#endif
#ifndef SKIPMASK
#define SKIPMASK 0x00
#endif

#define LAS __attribute__((address_space(3)))
#define GAS __attribute__((address_space(1)))
typedef unsigned short bf16_t;
typedef short bf16x8 __attribute__((ext_vector_type(8)));
typedef float f32x4 __attribute__((ext_vector_type(4)));
typedef float f32x2 __attribute__((ext_vector_type(2)));
typedef unsigned u32x4 __attribute__((ext_vector_type(4)));
typedef unsigned u32x2 __attribute__((ext_vector_type(2)));

constexpr int D = 1024, NB = 32, T = 2048, L = 256, DEPTH = 4;
constexpr int NX = NB * T, NC = NB * L, NT = NX + NC;
constexpr int NE = 32, TOPK = 4;
constexpr int NWAVES = 8, NTHREADS = 512;
constexpr int MAXRT = NT * TOPK / 256 + NE;

constexpr size_t MiB = 1u << 20;
constexpr size_t WS_CTL = 0, CTL_BYTES = 4 * MiB;
constexpr size_t WS_MOD = 4 * MiB;
constexpr size_t WS_ROPEC = 8 * MiB, WS_ROPES = 8 * MiB + 512 * 1024;
constexpr size_t WS_BQK = 9 * MiB;
constexpr size_t WS_WQK = 10 * MiB;
constexpr size_t WS_WV = 15 * MiB;
constexpr size_t WS_WO = 16 * MiB;
constexpr size_t WS_POOLW = 20 * MiB;
constexpr size_t WS_WRKV = 21 * MiB;
constexpr size_t WS_WOR = 27 * MiB;
constexpr size_t WS_WL1 = 30 * MiB;
constexpr size_t WS_WL2 = 32 * MiB;
constexpr size_t WS_LZERO = WS_WL1, LZERO_BYTES = 6 * MiB;
constexpr size_t WS_W1T = 40 * MiB;
constexpr size_t WS_W2T = 552 * MiB;
constexpr size_t WS_H = 808 * MiB;
constexpr size_t WS_AX = 1096 * MiB;
constexpr size_t WS_FX = 1240 * MiB;
constexpr size_t WS_R = 1384 * MiB;
constexpr size_t WS_ACT = WS_R;
constexpr size_t WS_Y = WS_R + 592 * MiB;
constexpr size_t WS_LIST = WS_R + 1184 * MiB;
constexpr size_t WS_POS = WS_R + 1193 * MiB;
constexpr size_t WS_GATE = WS_R + 1195 * MiB;
constexpr size_t WS_Q = WS_R;
constexpr size_t WS_K = WS_R + 144 * MiB;
constexpr size_t WS_VT = WS_R + 180 * MiB;
constexpr size_t WS_O = WS_R + 216 * MiB;
constexpr size_t WS_PD = WS_R;
constexpr size_t WS_A6 = WS_R;
constexpr size_t WS_E = WS_R;
constexpr size_t WS_A = WS_R + 288 * MiB;
constexpr size_t WS_RO = WS_R + 576 * MiB;
constexpr size_t WS_RKV = WS_R + 864 * MiB;
constexpr size_t WS_LORA = WS_R + 1296 * MiB;
constexpr size_t WS_G = WS_R + 1404 * MiB;
constexpr size_t WS_YS = WS_R + 1548 * MiB;
constexpr size_t WS_BONUS = WS_R + 2124 * MiB;
constexpr size_t WS_END = WS_R + 2134 * MiB;

constexpr int CW_BAR = 4096;
constexpr int CW_GCNT = 16384;
constexpr int LDS_BYTES = 147456;
constexpr int RING_BYTES = 131072;
constexpr int LDSCTL_OFF = 135168;
constexpr int MISC_OFF = LDSCTL_OFF;
constexpr int TPRE_OFF = LDSCTL_OFF + 256;
constexpr int LCNT_OFF = LDSCTL_OFF + 512;
constexpr int LBASE_OFF = LDSCTL_OFF + 768;
constexpr int REC_OFF = LDSCTL_OFF + 1024;
constexpr int JOB_OFF = LDSCTL_OFF + 1024;

__device__ __forceinline__ unsigned f2bf(float f) { unsigned u = __builtin_bit_cast(unsigned, f); return (u + 0x7fffu + ((u >> 16) & 1u)) >> 16; }
__device__ __forceinline__ unsigned pk2(float lo, float hi) { return f2bf(lo) | (f2bf(hi) << 16); }
__device__ __forceinline__ float bflo(unsigned w) { return __builtin_bit_cast(float, w << 16); }
__device__ __forceinline__ float bfhi(unsigned w) { return __builtin_bit_cast(float, w & 0xffff0000u); }
__device__ __forceinline__ float bf1(bf16_t b) { return __builtin_bit_cast(float, ((unsigned)b) << 16); }
__device__ __forceinline__ unsigned pk4_fp8(float a, float b, float c, float d) { int w = __builtin_amdgcn_cvt_pk_fp8_f32(a, b, 0, false); w = __builtin_amdgcn_cvt_pk_fp8_f32(c, d, w, true); return (unsigned)w; }
__device__ __forceinline__ unsigned cvt_pk_bf16(float lo, float hi) { unsigned r; asm volatile("v_cvt_pk_bf16_f32 %0, %1, %2" : "=v"(r) : "v"(lo), "v"(hi)); return r; }
__device__ __forceinline__ float dpp_add(float v, const int ctrl, const int row_mask) {
    switch (ctrl) {
    case 0xB1:  return v + __builtin_bit_cast(float, __builtin_amdgcn_update_dpp(0, __builtin_bit_cast(int, v), 0xB1, 0xf, 0xf, true));
    case 0x4E:  return v + __builtin_bit_cast(float, __builtin_amdgcn_update_dpp(0, __builtin_bit_cast(int, v), 0x4E, 0xf, 0xf, true));
    case 0x141: return v + __builtin_bit_cast(float, __builtin_amdgcn_update_dpp(0, __builtin_bit_cast(int, v), 0x141, 0xf, 0xf, true));
    case 0x140: return v + __builtin_bit_cast(float, __builtin_amdgcn_update_dpp(0, __builtin_bit_cast(int, v), 0x140, 0xf, 0xf, true));
    case 0x142: return v + __builtin_bit_cast(float, __builtin_amdgcn_update_dpp(0, __builtin_bit_cast(int, v), 0x142, 0xa, 0xf, true));
    default:    return v + __builtin_bit_cast(float, __builtin_amdgcn_update_dpp(0, __builtin_bit_cast(int, v), 0x143, 0xc, 0xf, true));
    }
}
__device__ __forceinline__ float row16_sum(float v) { v = dpp_add(v, 0xB1, 0xf); v = dpp_add(v, 0x4E, 0xf); v = dpp_add(v, 0x141, 0xf); v = dpp_add(v, 0x140, 0xf); return v; }
__device__ __forceinline__ float wave_sum(float v) {
    v = row16_sum(v); v = dpp_add(v, 0x142, 0xa); v = dpp_add(v, 0x143, 0xc);
    return __builtin_bit_cast(float, __builtin_amdgcn_readlane(__builtin_bit_cast(int, v), 63));
}
__device__ __forceinline__ float sigmoidf_(float x) { return __builtin_amdgcn_rcpf(1.0f + __builtin_amdgcn_exp2f(-1.4426950408889634f * x)); }
__device__ __forceinline__ int opaque_tid() { int t; asm volatile("v_mov_b32 %0, %1" : "=v"(t) : "v"(threadIdx.x)); return t; }
#define REFRESH(F) do { (F).tid = opaque_tid(); (F).lane = (F).tid & 63; } while (0)
__device__ __forceinline__ void seq_of(int row, int& sb, int& t, int& n) { if (row < NX) { sb = row & ~(T - 1); t = row & (T - 1); n = T; } else { const int r2 = row - NX; sb = NX + (r2 & ~(L - 1)); t = r2 & (L - 1); n = L; } }
__device__ __forceinline__ f32x4 ld_bf4(const bf16_t* p) { const u32x2 w = *(const u32x2*)p; return (f32x4){bflo(w.x), bfhi(w.x), bflo(w.y), bfhi(w.y)}; }
__device__ __forceinline__ void st_bf4(bf16_t* p, f32x4 v) { u32x2 w; w.x = pk2(v.x, v.y); w.y = pk2(v.z, v.w); *(u32x2*)p = w; }

#define LDS_WAIT() asm volatile("s_waitcnt lgkmcnt(0)" ::: "memory")
#define VM_WAIT() asm volatile("s_waitcnt vmcnt(0)" ::: "memory")

#define XB_TMO      128
#define XB_XCNT(j)  (256  + 64 * (j))
#define XB_XSUB(j)  (1280 + 64 * (j))
#define XB_XGEN(j)  (2304 + 64 * (j))
#define XB_TOP      3328
#define XB_TOPGEN   3392
#define XCD_BAR_WORDS 3456
#define XB_SPIN_CAP (1u << 18)
__device__ __forceinline__ unsigned xb_ld(unsigned* p)              { return __hip_atomic_load(p, __ATOMIC_RELAXED, __HIP_MEMORY_SCOPE_AGENT); }
__device__ __forceinline__ unsigned xb_add(unsigned* p, unsigned v) { return __hip_atomic_fetch_add(p, v, __ATOMIC_RELAXED, __HIP_MEMORY_SCOPE_AGENT); }
__device__ __forceinline__ unsigned xb_xcc_id() { return (unsigned)__builtin_amdgcn_s_getreg((3 << 11) | 20) & 0xFu; }
#define XB_SPIN(cond, bar) do { unsigned _sp = 0; while (cond) { __builtin_amdgcn_s_sleep(1); \
    if ((++_sp & 255u) == 0u) { if (xb_ld(&(bar)[XB_TMO])) break; if (_sp > XB_SPIN_CAP) { atomicAdd(&(bar)[XB_TMO], 1u); break; } } } } while (0)
struct XcdBarrier { unsigned* bar; unsigned x; volatile LAS unsigned* st; };
__device__ __forceinline__ XcdBarrier xcd_barrier_post(unsigned* bar, volatile LAS unsigned* st) {
    XcdBarrier b; b.bar = bar; b.x = xb_xcc_id(); b.st = st;
    if (threadIdx.x == 0) (void)xb_add(&bar[XB_XCNT(b.x)], 1u);
    return b;
}
__device__ __forceinline__ void xcd_barrier_complete(unsigned* bar, unsigned x, unsigned& nloc, unsigned& nx) {
    const unsigned G = gridDim.x * gridDim.y * gridDim.z;
    unsigned sum, cnt, mine, sp = 0u;
    for (;;) {
        sum = 0u; cnt = 0u; mine = 0u;
#pragma unroll
        for (unsigned j = 0; j < 16; ++j) { const unsigned c = xb_ld(&bar[XB_XCNT(j)]); sum += c; cnt += (c > 0u) ? 1u : 0u; mine = (j == x) ? c : mine; }
        if (sum == G) break;
        __builtin_amdgcn_s_sleep(1);
        if ((++sp & 255u) == 0u) { if (xb_ld(&bar[XB_TMO])) break; if (sp > XB_SPIN_CAP) { atomicAdd(&bar[XB_TMO], 1u); break; } }
    }
    nloc = mine > 0u ? mine : 1u; nx = cnt > 0u ? cnt : 1u;
}
__device__ __forceinline__ void xcd_barrier(const XcdBarrier& b) {
    asm volatile("s_waitcnt vmcnt(0)" ::: "memory");
    __syncthreads();
    if (threadIdx.x == 0) {
        unsigned* bar = b.bar;
        __builtin_amdgcn_s_waitcnt(0);
        unsigned nloc = b.st[0], nx = b.st[1];
        if (nloc == 0u) { xcd_barrier_complete(bar, b.x, nloc, nx); b.st[0] = nloc; b.st[1] = nx; }
        const unsigned old = xb_add(&bar[XB_XSUB(b.x)], 1u);
        const unsigned gen = old / nloc;
        if (old + 1u == (gen + 1u) * nloc) {
            __builtin_amdgcn_fence(__ATOMIC_RELEASE, "agent");
            asm volatile("s_waitcnt vmcnt(0)" ::: "memory");
            const unsigned og = xb_add(&bar[XB_TOP], 1u);
            const unsigned tg = og / nx;
            if (og + 1u == (tg + 1u) * nx) xb_add(&bar[XB_TOPGEN], 1u);
            else XB_SPIN(xb_ld(&bar[XB_TOPGEN]) == tg, bar);
            __builtin_amdgcn_fence(__ATOMIC_ACQUIRE, "agent");
            xb_add(&bar[XB_XGEN(b.x)], 1u);
            asm volatile("s_waitcnt vmcnt(0)" ::: "memory");
        } else {
            XB_SPIN(xb_ld(&bar[XB_XGEN(b.x)]) == gen, bar);
            __builtin_amdgcn_fence(__ATOMIC_ACQUIRE, "agent");
            asm volatile("s_waitcnt vmcnt(0)" ::: "memory");
        }
    }
    __syncthreads();
}

namespace pg8 {
constexpr int BM = 256, BK = 64, HALF = 128, HTB = HALF * BK * 2, STAGE_BYTES = 8 * HTB, NXCD = 8, WGM = 8;
__host__ __device__ __forceinline__ int lds_byte(int r, int c) { const int st = (r >> 4) * 2 + (c >> 5), rr = r & 15, cc = c & 31, ob = rr * 64 + cc * 2; return st * 1024 + (ob ^ (((ob >> 9) & 1) << 5)); }
__host__ __device__ __forceinline__ void stage_rc(int b, int& R, int& C) { const int st = b / 1024, sb = b % 1024, swz = sb ^ (((sb >> 9) & 1) << 5); R = (st >> 1) * 16 + swz / 64; C = (st & 1) * 32 + (swz % 64) / 2; }
__host__ __device__ __forceinline__ int perm32(int rho) { const int n = rho >> 4, i = rho & 15; return 8 * (i >> 2) + 4 * n + (i & 3); }

typedef int i32x8 __attribute__((ext_vector_type(8)));
typedef int i32x4 __attribute__((ext_vector_type(4)));
__device__ __forceinline__ i32x8 cat8(bf16x8 lo, bf16x8 hi) { const i32x4 a = __builtin_bit_cast(i32x4, lo), b = __builtin_bit_cast(i32x4, hi); return __builtin_shufflevector(a, b, 0, 1, 2, 3, 4, 5, 6, 7); }
struct Unit { int pm, pn, e, rt; };
struct TileOrder {
    int nM, nN, nwg, G, c;
    __device__ __forceinline__ void init(int nM_, int nN_, int G_, int c_) { nM = nM_; nN = nN_; nwg = nM * nN; G = G_; c = c_; }
    __device__ __forceinline__ bool next(int i, int& pm, int& pn) const {
        const long Lx = (long)i * G + c; if (Lx >= nwg) return false;
        int wgid = (int)Lx; { const int q = nwg / NXCD, r = nwg % NXCD, xcd = wgid % NXCD, off = wgid / NXCD; wgid = (xcd < r ? xcd * (q + 1) : r * (q + 1) + (xcd - r) * q) + off; }
        const int nig = WGM * nN, gid = wgid / nig, fm = gid * WGM, gsz = (nM - fm) < WGM ? (nM - fm) : WGM;
        pm = fm + ((wgid % nig) % gsz); pn = (wgid % nig) / gsz; return true;
    }
};
struct ProbDense {
    static constexpr bool FP8 = false;
    const bf16_t* A; const bf16_t* Bt; int lda, ldb, K, a_pn_off; TileOrder ord;
    __device__ __forceinline__ int ldb_bytes() const { return ldb * 2; }
    __device__ __forceinline__ int ntiles() const { return K / 64; }
    __device__ __forceinline__ bool next(int i, Unit& u) const { u.e = 0; const bool ok = ord.next(i, u.pm, u.pn); u.rt = u.pm; return ok; }
    __device__ __forceinline__ const char* a_ptr(const Unit& u) const { return (const char*)(A + (size_t)u.pm * BM * lda + (size_t)u.pn * a_pn_off); }
    __device__ __forceinline__ const char* b_ptr(const Unit& u) const { return (const char*)(Bt + (size_t)u.pn * BM * ldb); }
    __device__ __forceinline__ void a_off(const Unit&, const int (&R)[2], const int (&C)[2], unsigned (&v)[2][2]) const {
#pragma unroll
        for (int h = 0; h < 2; ++h)
#pragma unroll
            for (int i = 0; i < 2; ++i) v[h][i] = (unsigned)((h * HALF + R[i]) * lda + C[i]) * 2u;
    }
};

template <class Prob, class Epi>
__device__ __forceinline__ void gemm_phase(LAS unsigned char* lds, const Prob& P, const Epi& E) {
    const int tid = opaque_tid(), wid = __builtin_amdgcn_readfirstlane(tid >> 6), lane = tid & 63, wr = wid >> 2, wc = wid & 3, fr = lane & 15, fq = lane >> 4;
    const int nt = P.ntiles(); const int ldbB = P.ldb_bytes();
    int Rr[2], Cc[2]; unsigned voffB[2];
#pragma unroll
    for (int i = 0; i < 2; ++i) { int R, C; stage_rc(tid * 16 + i * 8192, R, C); Rr[i] = R; Cc[i] = C; const int Rb = Epi::PERM ? ((R & ~31) + perm32(R & 31)) : R;
        voffB[i] = (unsigned)(Rb * ldbB + C * 2); }
    const size_t kstep = (size_t)(BK * 2);
    const size_t hstepB = (size_t)HALF * ldbB;
    const unsigned ldsw = (unsigned)wid * 1024u;
    const int aoff = lds_byte(wr * 64 + fr, fq * 8), boff = lds_byte(wc * 32 + fr, fq * 8);
#define PG8_SA(b, h) (((b) * 2 + (h)) * HTB)
#define PG8_SB(b, h) ((4 + (b) * 2 + (h)) * HTB)
#define PG8_STAGE(bufoff, gbase, voff) do { _Pragma("unroll") for (int _i = 0; _i < 2; ++_i) \
        __builtin_amdgcn_global_load_lds((const unsigned*)((const char*)(gbase) + (voff)[_i]), (LAS unsigned*)(lds + (bufoff) + ldsw + _i * 8192), 16, 0, 0); } while (0)
#define PG8_LDA(dst, b, h) do { _Pragma("unroll") for (int m = 0; m < 4; ++m) _Pragma("unroll") for (int k = 0; k < 2; ++k) dst[m][k] = *(const LAS bf16x8*)(lds + PG8_SA(b, h) + aoff + m * 2048 + k * 1024); } while (0)
#define PG8_LDB(dst, b, h) do { _Pragma("unroll") for (int n = 0; n < 2; ++n) _Pragma("unroll") for (int k = 0; k < 2; ++k) dst[n][k] = *(const LAS bf16x8*)(lds + PG8_SB(b, h) + boff + n * 2048 + k * 1024); } while (0)
#define PG8_MMA(ai, bj, At, Bt) do { __builtin_amdgcn_s_setprio(1); _Pragma("unroll") for (int m = 0; m < 4; ++m) _Pragma("unroll") for (int n = 0; n < 2; ++n) { \
        if constexpr (Prob::FP8) { asm volatile("v_mfma_scale_f32_16x16x128_f8f6f4 %0, %1, %2, %0, %3, %4 op_sel_hi:[0,0,0]" : "+v"(acc[ai][bj][m][n]) : "v"(cat8(Bt[n][0], Bt[n][1])), "v"(cat8(At[m][0], At[m][1])), "v"(sc_w), "v"(sc_x)); } \
        else { _Pragma("unroll") for (int k = 0; k < 2; ++k) acc[ai][bj][m][n] = __builtin_amdgcn_mfma_f32_16x16x32_bf16(Bt[n][k], At[m][k], acc[ai][bj][m][n], 0, 0, 0); } } __builtin_amdgcn_s_setprio(0); } while (0)
#define PG8_WAIT_V(n) asm volatile("s_waitcnt vmcnt(" #n ")" ::: "memory")
#define PG8_WAIT_L(n) asm volatile("s_waitcnt lgkmcnt(" #n ")" ::: "memory")
#define PG8_BAR __builtin_amdgcn_s_barrier()
#define PG8_SCHED __builtin_amdgcn_sched_barrier(0)
    Unit cur, nxt; int ui = 0;
    if (!P.next(0, cur)) return;
    int sc_w = 0, sc_x = 0; if constexpr (Prob::FP8) { sc_w = P.scale_w; sc_x = P.scale_x; } (void)sc_w; (void)sc_x;
    f32x4 acc[2][2][4][2];
#pragma unroll
    for (int a = 0; a < 2; ++a)
#pragma unroll
        for (int b = 0; b < 2; ++b)
#pragma unroll
            for (int m = 0; m < 4; ++m)
#pragma unroll
                for (int n = 0; n < 2; ++n) acc[a][b][m][n] = (f32x4){0.f, 0.f, 0.f, 0.f};
    bf16x8 At[4][2], B0[2][2], B1[2][2];
    unsigned vAc[2][2], vAn[2][2];
    P.a_off(cur, Rr, Cc, vAc);
    const char* cA = P.a_ptr(cur); const char* cB = P.b_ptr(cur);
    PG8_STAGE(PG8_SB(0, 0), cB, voffB); PG8_STAGE(PG8_SB(0, 1), cB + hstepB, voffB); PG8_STAGE(PG8_SA(0, 0), cA, vAc[0]); PG8_STAGE(PG8_SA(0, 1), cA, vAc[1]);
    if (wr == 1) PG8_BAR;
    PG8_WAIT_V(2); PG8_BAR;
    PG8_STAGE(PG8_SB(1, 0), cB + kstep, voffB); PG8_STAGE(PG8_SA(1, 0), cA + kstep, vAc[0]); PG8_STAGE(PG8_SB(1, 1), cB + hstepB + kstep, voffB);
    PG8_WAIT_V(6); PG8_BAR;
    for (;;) {
        const bool has_next = P.next(ui + 1, nxt);
        const char* nA = cA; const char* nB = cB;
#pragma unroll
        for (int h = 0; h < 2; ++h)
#pragma unroll
            for (int i = 0; i < 2; ++i) vAn[h][i] = vAc[h][i];
        if (has_next) { nA = P.a_ptr(nxt); nB = P.b_ptr(nxt); P.a_off(nxt, Rr, Cc, vAn); }
        for (int t = 0; t < nt; t += 2) {
            const bool last = (t == nt - 2);
            const char* a1 = cA + (size_t)(t + 1) * kstep;
            const char* a2 = last ? nA : cA + (size_t)(t + 2) * kstep; const char* b2 = last ? nB : cB + (size_t)(t + 2) * kstep;
            const char* a3 = a2 + kstep; const char* b3 = b2 + kstep;
            unsigned vX[2][2];
#pragma unroll
            for (int h = 0; h < 2; ++h)
#pragma unroll
                for (int i = 0; i < 2; ++i) vX[h][i] = last ? vAn[h][i] : vAc[h][i];
            PG8_LDB(B0, 0, 0); PG8_LDB(B1, 0, 1); PG8_SCHED; PG8_LDA(At, 0, 0); PG8_STAGE(PG8_SA(1, 1), a1, vAc[1]);
            PG8_WAIT_V(8); PG8_WAIT_L(0); PG8_BAR; PG8_MMA(0, 0, At, B0); PG8_MMA(0, 1, At, B1); PG8_BAR; PG8_SCHED;
            PG8_LDA(At, 0, 1); PG8_STAGE(PG8_SB(0, 0), b2, voffB); PG8_STAGE(PG8_SB(0, 1), b2 + hstepB, voffB); PG8_STAGE(PG8_SA(0, 0), a2, vX[0]);
            PG8_WAIT_V(8); PG8_WAIT_L(0); PG8_BAR; PG8_MMA(1, 0, At, B0); PG8_MMA(1, 1, At, B1); PG8_BAR; PG8_SCHED;
            PG8_LDB(B0, 1, 0); PG8_LDB(B1, 1, 1); PG8_SCHED; PG8_LDA(At, 1, 0); PG8_STAGE(PG8_SA(0, 1), a2, vX[1]);
            PG8_WAIT_V(8); PG8_WAIT_L(0); PG8_BAR; PG8_MMA(0, 0, At, B0); PG8_MMA(0, 1, At, B1); PG8_BAR; PG8_SCHED;
            PG8_LDA(At, 1, 1); PG8_STAGE(PG8_SB(1, 0), b3, voffB); PG8_STAGE(PG8_SB(1, 1), b3 + hstepB, voffB); PG8_STAGE(PG8_SA(1, 0), a3, vX[0]);
            PG8_WAIT_V(8); PG8_WAIT_L(0); PG8_BAR; PG8_MMA(1, 0, At, B0); PG8_MMA(1, 1, At, B1); PG8_BAR; PG8_SCHED;
        }
        if (wr == 0) PG8_BAR;
        if constexpr (Prob::FP8) asm volatile("s_nop 15\n\ts_nop 15" ::: "memory");
        E(acc, cur, wr, wc, fr, fq);
        if (!has_next) break;
#pragma unroll
        for (int a = 0; a < 2; ++a)
#pragma unroll
            for (int b = 0; b < 2; ++b)
#pragma unroll
                for (int m = 0; m < 4; ++m)
#pragma unroll
                    for (int n = 0; n < 2; ++n) acc[a][b][m][n] = (f32x4){0.f, 0.f, 0.f, 0.f};
        cur = nxt; cA = nA; cB = nB; ++ui;
#pragma unroll
        for (int h = 0; h < 2; ++h)
#pragma unroll
            for (int i = 0; i < 2; ++i) vAc[h][i] = vAn[h][i];
        if (wr == 1) PG8_BAR;
    }
    PG8_WAIT_V(0);
    PG8_BAR;
#undef PG8_SA
#undef PG8_SB
#undef PG8_STAGE
#undef PG8_LDA
#undef PG8_LDB
#undef PG8_MMA
#undef PG8_WAIT_V
#undef PG8_WAIT_L
#undef PG8_BAR
#undef PG8_SCHED
}
}

using pg8::Unit;
constexpr int HALF_ = 128;
struct EpiBf16Act {
    static constexpr bool PERM = true;
    bf16_t* O; int ldc; const float* bias; int act; float scale;
    __device__ __forceinline__ void operator()(const f32x4 (&acc)[2][2][4][2], const Unit& u, int wr, int wc, int fr, int fq) const {
        const int row0 = u.pm * 256 + wr * 64 + fr, col0 = u.pn * 256 + wc * 32 + 8 * fq;
        f32x4 bv[2][2];
#pragma unroll
        for (int bj = 0; bj < 2; ++bj)
#pragma unroll
            for (int n = 0; n < 2; ++n) bv[bj][n] = bias ? *(const f32x4*)(bias + col0 + bj * HALF_ + 4 * n) : (f32x4){0.f, 0.f, 0.f, 0.f};
#pragma unroll
        for (int ai = 0; ai < 2; ++ai)
#pragma unroll
            for (int m = 0; m < 4; ++m) { bf16_t* rowp = O + (size_t)(row0 + ai * HALF_ + m * 16) * ldc + col0;
#pragma unroll
                for (int bj = 0; bj < 2; ++bj) { f32x4 v0 = acc[ai][bj][m][0] + bv[bj][0], v1 = acc[ai][bj][m][1] + bv[bj][1];
                    if (act == 1) {
#pragma unroll
                        for (int j = 0; j < 4; ++j) { v0[j] = sigmoidf_(v0[j]) * scale; v1[j] = sigmoidf_(v1[j]) * scale; } }
                    else if (act == 2) {
#pragma unroll
                        for (int j = 0; j < 4; ++j) { v0[j] = 1.0f - 2.0f * __builtin_amdgcn_rcpf(__builtin_amdgcn_exp2f(2.8853900817779268f * v0[j]) + 1.0f); v1[j] = 1.0f - 2.0f * __builtin_amdgcn_rcpf(__builtin_amdgcn_exp2f(2.8853900817779268f * v1[j]) + 1.0f); } }
                    u32x4 w; w.x = cvt_pk_bf16(v0[0], v0[1]); w.y = cvt_pk_bf16(v0[2], v0[3]); w.z = cvt_pk_bf16(v1[0], v1[1]); w.w = cvt_pk_bf16(v1[2], v1[3]);
                    *(u32x4*)(rowp + bj * HALF_) = w; } }
    }
};
struct EpiQK {
    static constexpr bool PERM = true;
    bf16_t* Q; bf16_t* Kb; const float* bias; const float* ropec; const float* ropes;
    __device__ __forceinline__ void operator()(const f32x4 (&acc)[2][2][4][2], const Unit& u, int wr, int wc, int fr, int fq) const {
        int row0 = u.pm * 256 + wr * 64 + fr, cl0 = wc * 32 + 8 * fq;
        asm volatile("" : "+v"(row0), "+v"(cl0));
        const int g = (4 * wc + fq) & 7;
        bf16_t* base; int ldc;
        if (u.pn < 4) { base = Q + u.pn * 256; ldc = 1024; } else { base = Kb; ldc = 256; }
        f32x4 bv[2][2];
#pragma unroll
        for (int bj = 0; bj < 2; ++bj)
#pragma unroll
            for (int n = 0; n < 2; ++n) bv[bj][n] = *(const f32x4*)(bias + u.pn * 256 + cl0 + bj * HALF_ + 4 * n);
#pragma unroll
        for (int ai = 0; ai < 2; ++ai)
#pragma unroll
            for (int m = 0; m < 4; ++m) { const int row = row0 + ai * HALF_ + m * 16; bf16_t* rowp = base + (size_t)row * ldc + cl0;
                f32x4 cs = (f32x4){1.f, 1.f, 1.f, 1.f}, sn = (f32x4){0.f, 0.f, 0.f, 0.f};
                if (row < NX) { const int t = row & (T - 1); cs = *(const f32x4*)(ropec + t * 32 + g * 4); sn = *(const f32x4*)(ropes + t * 32 + g * 4); }
#pragma unroll
                for (int bj = 0; bj < 2; ++bj) { const f32x4 v0 = acc[ai][bj][m][0] + bv[bj][0], v1 = acc[ai][bj][m][1] + bv[bj][1];
                    const f32x4 o0 = v0 * cs - v1 * sn, o1 = v1 * cs + v0 * sn;
                    u32x4 w; w.x = cvt_pk_bf16(o0[0], o0[1]); w.y = cvt_pk_bf16(o0[2], o0[3]); w.z = cvt_pk_bf16(o1[0], o1[1]); w.w = cvt_pk_bf16(o1[2], o1[3]);
                    *(u32x4*)(rowp + bj * HALF_) = w; } }
    }
};
struct EpiVT {
    static constexpr bool PERM = true;
    bf16_t* VT; const float* biasrow;
    __device__ __forceinline__ void operator()(const f32x4 (&acc)[2][2][4][2], const Unit& u, int wr, int wc, int fr, int fq) const {
        int row0 = wr * 64 + fr, col0 = u.pn * 256 + wc * 32 + 8 * fq;
        asm volatile("" : "+v"(row0), "+v"(col0));
#pragma unroll
        for (int ai = 0; ai < 2; ++ai)
#pragma unroll
            for (int m = 0; m < 4; ++m) { const int row = row0 + ai * HALF_ + m * 16; const float b = biasrow[row]; bf16_t* rowp = VT + (size_t)row * NT + col0;
#pragma unroll
                for (int bj = 0; bj < 2; ++bj) { const f32x4 v0 = acc[ai][bj][m][0] + b, v1 = acc[ai][bj][m][1] + b;
                    u32x4 w; w.x = cvt_pk_bf16(v0[0], v0[1]); w.y = cvt_pk_bf16(v0[2], v0[3]); w.z = cvt_pk_bf16(v1[0], v1[1]); w.w = cvt_pk_bf16(v1[2], v1[3]);
                    *(u32x4*)(rowp + bj * HALF_) = w; } }
    }
};
struct EpiResid {
    static constexpr bool PERM = false;
    float* H; const float* bias; const float* ls; const float* gate;
    __device__ __forceinline__ void operator()(const f32x4 (&acc)[2][2][4][2], const Unit& u, int wr, int wc, int fr, int fq) const {
        const int row0 = u.pm * 256 + wr * 64 + fr, col0 = u.pn * 256 + wc * 32 + 4 * fq;
        f32x4 bv[2][2], lv[2][2];
#pragma unroll
        for (int bj = 0; bj < 2; ++bj)
#pragma unroll
            for (int n = 0; n < 2; ++n) { bv[bj][n] = bias ? *(const f32x4*)(bias + col0 + bj * HALF_ + n * 16) : (f32x4){0.f, 0.f, 0.f, 0.f};
                                          lv[bj][n] = ls ? *(const f32x4*)(ls + col0 + bj * HALF_ + n * 16) : (f32x4){1.f, 1.f, 1.f, 1.f}; }
#pragma unroll
        for (int ai = 0; ai < 2; ++ai)
#pragma unroll
            for (int m = 0; m < 4; ++m) { const int row = row0 + ai * HALF_ + m * 16; const int brow = row < NX ? (row >> 11) : 32;
                float* hp = H + (size_t)row * D + col0; const float* gp = gate + (size_t)brow * (6 * D) + col0;
#pragma unroll
                for (int bj = 0; bj < 2; ++bj)
#pragma unroll
                    for (int n = 0; n < 2; ++n) { const f32x4 y = (acc[ai][bj][m][n] + bv[bj][n]) * lv[bj][n]; const f32x4 gv = *(const f32x4*)(gp + bj * HALF_ + n * 16);
                        f32x4 hv = *(const f32x4*)(hp + bj * HALF_ + n * 16); hv = hv + gv * y; *(f32x4*)(hp + bj * HALF_ + n * 16) = hv; }
                asm volatile("" ::: "memory"); }
    }
};
struct EpiMoe1 {
    static constexpr bool PERM = true;
    unsigned char* ACT; const float* b1;
    __device__ __forceinline__ void operator()(const f32x4 (&acc)[2][2][4][2], const Unit& u, int wr, int wc, int fr, int fq) const {
        const int row0 = u.rt * 256 + wr * 64 + fr, cl = u.pn * 128 + wc * 32 + 8 * fq;
        const float* bg = b1 + (size_t)u.e * 2048 + cl; const float* bl = bg + 1024;
        f32x4 bgv[2], blv[2];
#pragma unroll
        for (int n = 0; n < 2; ++n) { bgv[n] = *(const f32x4*)(bg + 4 * n); blv[n] = *(const f32x4*)(bl + 4 * n); }
#pragma unroll
        for (int ai = 0; ai < 2; ++ai)
#pragma unroll
            for (int m = 0; m < 4; ++m) { unsigned char* rowp = ACT + (size_t)(row0 + ai * HALF_ + m * 16) * D + cl;
                f32x4 o[2];
#pragma unroll
                for (int n = 0; n < 2; ++n) { const f32x4 hg = acc[ai][0][m][n] + bgv[n], hl = acc[ai][1][m][n] + blv[n];
#pragma unroll
                    for (int j = 0; j < 4; ++j) { const float gl = fminf(hg[j], 7.0f); const float li = fminf(fmaxf(hl[j], -7.0f), 7.0f);
                        o[n][j] = gl * sigmoidf_(1.702f * gl) * (li + 1.0f); } }
                u32x2 w; w.x = pk4_fp8(o[0][0], o[0][1], o[0][2], o[0][3]); w.y = pk4_fp8(o[1][0], o[1][1], o[1][2], o[1][3]);
                *(u32x2*)rowp = w; }
    }
};
struct EpiMoe2 {
    static constexpr bool PERM = true;
    bf16_t* Y; const float* b2;
    __device__ __forceinline__ void operator()(const f32x4 (&acc)[2][2][4][2], const Unit& u, int wr, int wc, int fr, int fq) const {
        const int row0 = u.rt * 256 + wr * 64 + fr, col0 = u.pn * 256 + wc * 32 + 8 * fq;
        const float* bb = b2 + (size_t)u.e * D + col0;
        f32x4 bv[2][2];
#pragma unroll
        for (int bj = 0; bj < 2; ++bj)
#pragma unroll
            for (int n = 0; n < 2; ++n) bv[bj][n] = *(const f32x4*)(bb + bj * HALF_ + 4 * n);
#pragma unroll
        for (int ai = 0; ai < 2; ++ai)
#pragma unroll
            for (int m = 0; m < 4; ++m) { bf16_t* rowp = Y + (size_t)(row0 + ai * HALF_ + m * 16) * D + col0;
#pragma unroll
                for (int bj = 0; bj < 2; ++bj) { const f32x4 v0 = acc[ai][bj][m][0] + bv[bj][0], v1 = acc[ai][bj][m][1] + bv[bj][1];
                    u32x4 w; w.x = cvt_pk_bf16(v0[0], v0[1]); w.y = cvt_pk_bf16(v0[2], v0[3]); w.z = cvt_pk_bf16(v1[0], v1[1]); w.w = cvt_pk_bf16(v1[2], v1[3]);
                    *(u32x4*)(rowp + bj * HALF_) = w; } }
    }
};
typedef unsigned char fp8_t;
constexpr int SCALE_ONE = 0x7f7f7f7f, SCALE_W = 0x79797979;
struct ProbMoe1 {
    static constexpr bool FP8 = true;
    const fp8_t* FX; const fp8_t* W1T; const int* list; const LAS int* tpre; const LAS int* cnt; int scale_w, scale_x; pg8::TileOrder ord;
    __device__ __forceinline__ int ldb_bytes() const { return D; }
    __device__ __forceinline__ int ntiles() const { return D / 128; }
    __device__ __forceinline__ bool next(int i, Unit& u) const {
        if (!ord.next(i, u.pm, u.pn)) return false;
        u.rt = u.pm; int e = 0;
#pragma unroll 1
        for (int j = 1; j < NE; ++j) e += (tpre[j] <= u.rt) ? 1 : 0;
        u.e = e; return true;
    }
    __device__ __forceinline__ const char* a_ptr(const Unit&) const { return (const char*)FX; }
    __device__ __forceinline__ const char* b_ptr(const Unit& u) const { return (const char*)(W1T + ((size_t)u.e * 2048 + (size_t)u.pn * 256) * D); }
    __device__ __forceinline__ void a_off(const Unit& u, const int (&R)[2], const int (&C)[2], unsigned (&v)[2][2]) const {
        const int base = (u.rt - tpre[u.e]) * 256, ce = cnt[u.e]; const int* le = list + (size_t)u.e * NT;
#pragma unroll
        for (int h = 0; h < 2; ++h)
#pragma unroll
            for (int i = 0; i < 2; ++i) { const int idx = base + h * 128 + R[i]; const int tok = le[idx < ce ? idx : 0]; v[h][i] = (unsigned)(tok * D + C[i] * 2); }
        asm volatile("" : "+v"(v[0][0]), "+v"(v[0][1]), "+v"(v[1][0]), "+v"(v[1][1]));
    }
};
struct ProbMoe2 {
    static constexpr bool FP8 = true;
    const fp8_t* ACT; const fp8_t* W2T; const LAS int* tpre; int scale_w, scale_x; pg8::TileOrder ord;
    __device__ __forceinline__ int ldb_bytes() const { return D; }
    __device__ __forceinline__ int ntiles() const { return D / 128; }
    __device__ __forceinline__ bool next(int i, Unit& u) const {
        if (!ord.next(i, u.pm, u.pn)) return false;
        u.rt = u.pm; int e = 0;
#pragma unroll 1
        for (int j = 1; j < NE; ++j) e += (tpre[j] <= u.rt) ? 1 : 0;
        u.e = e; return true;
    }
    __device__ __forceinline__ const char* a_ptr(const Unit& u) const { return (const char*)(ACT + (size_t)u.rt * 256 * D); }
    __device__ __forceinline__ const char* b_ptr(const Unit& u) const { return (const char*)(W2T + ((size_t)u.e * 1024 + (size_t)u.pn * 256) * D); }
    __device__ __forceinline__ void a_off(const Unit&, const int (&R)[2], const int (&C)[2], unsigned (&v)[2][2]) const {
#pragma unroll
        for (int h = 0; h < 2; ++h)
#pragma unroll
            for (int i = 0; i < 2; ++i) v[h][i] = (unsigned)((h * 128 + R[i]) * D + C[i] * 2);
    }
};
struct Args { const float* in[38]; float* out; unsigned char* ws; int phase; int one; };
enum { I_X = 0, I_C, I_CTX, I_CCTX, I_ADAW, I_ADAB, I_NORMG, I_AWQKV, I_ABQKV, I_AWO, I_ABO, I_ASINK, I_PW, I_PB, I_PS,
       I_RMIX, I_RWRKV, I_RW0, I_RW1, I_RW2, I_RA0, I_RA1, I_RA2, I_RG1, I_RG2, I_RKK, I_RKA, I_RRK, I_RLNW, I_RLNB, I_RWO,
       I_MWR, I_MBR, I_MW1, I_MB1, I_MW2, I_MB2, I_FG };
struct Frame { LAS unsigned char* lds; int tid, lane, wave, G, c; unsigned char* ws; unsigned* ctl; };
#define WSP(T_, off) ((T_*)(F.ws + (off)))

struct TJob { const float* src; unsigned char* dst; long sbs, dbs; int ldw, ldt, nkb, nnb, mode, item0, per, esz; };
__device__ __forceinline__ int dst_row(int mode, int n) {
    if (mode == 1) { const int hb = n & ~63, d = n & 63; const int ax = d >> 5, dd = d & 31, hf = dd >> 4, f = dd & 15; const int g = ax * 4 + (f >> 2), i = (f & 3) + 4 * hf; return hb + 8 * g + i; }
    if (mode == 2) { return n < 1024 ? ((n >> 7) << 8) + (n & 127) : (((n - 1024) >> 7) << 8) + 128 + (n & 127); }
    return n;
}
struct TItem { const float* src; unsigned char* dst; int ldw, ldt, mode, n0, esz; };
__device__ __forceinline__ void titem_decode(const LAS TJob* jobs, int nj, int it, TItem& T) {
    int ji = 0;
    for (int q = 1; q < nj; ++q) ji += (jobs[q].item0 <= it) ? 1 : 0;
    const LAS TJob& J = jobs[ji]; const int r = it - J.item0, bi = r / J.per, rr = r % J.per, kb = rr / J.nnb, nb = rr % J.nnb;
    T.src = J.src + bi * J.sbs + (size_t)(64 * kb) * J.ldw + 32 * nb; T.dst = J.dst + (bi * J.dbs + 64 * kb) * J.esz; T.ldw = J.ldw; T.ldt = J.ldt; T.mode = J.mode; T.n0 = 32 * nb; T.esz = J.esz;
}
__device__ __forceinline__ void titem_load(const TItem& T, int lane, f32x4 (&v)[8]) {
    const float* p = T.src + (size_t)(lane >> 3) * T.ldw + 4 * (lane & 7);
#pragma unroll
    for (int i = 0; i < 8; ++i) v[i] = *(const f32x4*)(p + (size_t)(8 * i) * T.ldw);
}
__device__ __forceinline__ void titem_store(const TItem& T, int lane, const f32x4 (&v)[8], LAS float* scr) {
#pragma unroll
    for (int i = 0; i < 8; ++i) { LAS float* d = scr + (8 * i + (lane >> 3)) * 33 + 4 * (lane & 7); d[0] = v[i].x; d[1] = v[i].y; d[2] = v[i].z; d[3] = v[i].w; }
    LDS_WAIT(); asm volatile("" ::: "memory");
    const int c = lane & 7;
#pragma unroll
    for (int j = 0; j < 4; ++j) { const int n = (lane >> 3) + 8 * j; const LAS float* s = scr + (8 * c) * 33 + n;
        const size_t eo = (size_t)dst_row(T.mode, T.n0 + n) * T.ldt + 8 * c;
        if (T.esz == 2) { u32x4 o; o.x = pk2(s[0 * 33], s[1 * 33]); o.y = pk2(s[2 * 33], s[3 * 33]); o.z = pk2(s[4 * 33], s[5 * 33]); o.w = pk2(s[6 * 33], s[7 * 33]); *(u32x4*)(T.dst + eo * 2) = o; }
        else { u32x2 o; o.x = pk4_fp8(64.f * s[0 * 33], 64.f * s[1 * 33], 64.f * s[2 * 33], 64.f * s[3 * 33]); o.y = pk4_fp8(64.f * s[4 * 33], 64.f * s[5 * 33], 64.f * s[6 * 33], 64.f * s[7 * 33]); *(u32x2*)(T.dst + eo) = o; } }
    LDS_WAIT(); asm volatile("" ::: "memory");
}
__device__ __forceinline__ void phase_prologue(Frame& F, const Args& A) {
    REFRESH(F);
    LAS float* S = (LAS float*)F.lds;
    for (int idx = F.tid; idx < 33 * 1024; idx += NTHREADS) { const int r = idx >> 10, k = idx & 1023; const float v = r < 32 ? A.in[I_C][r * 1024 + k] : A.in[I_CCTX][k]; S[k * 33 + r] = v / (1.0f + __expf(-v)); }
    __syncthreads();
    float* MOD = WSP(float, WS_MOD);
    for (int it = F.c; it < 4 * 96; it += F.G) {
        const int layer = it / 96, n = (it % 96) * 64 + F.lane; const float* wp = A.in[I_ADAW] + (size_t)layer * 1024 * 6144 + n;
        float acc[5] = {0.f, 0.f, 0.f, 0.f, 0.f};
        for (int k0 = 0; k0 < 1024; k0 += 32) {
            float wv[32];
#pragma unroll
            for (int u = 0; u < 32; ++u) wv[u] = wp[(size_t)(k0 + u) * 6144];
#pragma unroll
            for (int u = 0; u < 32; ++u) { const LAS float* sr = S + (k0 + u) * 33 + F.wave;
                acc[0] += sr[0] * wv[u]; acc[1] += sr[8] * wv[u]; acc[2] += sr[16] * wv[u]; acc[3] += sr[24] * wv[u]; if (F.wave == 0) acc[4] += S[(k0 + u) * 33 + 32] * wv[u]; }
        }
        const float bb = A.in[I_ADAB][layer * 6144 + n];
#pragma unroll
        for (int i = 0; i < 4; ++i) MOD[((size_t)layer * 33 + F.wave + 8 * i) * 6144 + n] = acc[i] + bb;
        if (F.wave == 0) MOD[((size_t)layer * 33 + 32) * 6144 + n] = acc[4] + bb;
    }
    { float* rc = WSP(float, WS_ROPEC); float* rs = WSP(float, WS_ROPES);
      for (int idx = F.c * NTHREADS + F.tid; idx < 2048 * 32; idx += F.G * NTHREADS) { const int t = idx >> 5, e = idx & 31, g = e >> 2, i = e & 3, f = 4 * (g & 3) + i;
          const float inv = powf(10000.0f, -(float)f / 16.0f); const float pos = (float)(g < 4 ? (t >> 6) : (t & 63)); const float ang = pos * inv; rc[idx] = cosf(ang); rs[idx] = sinf(ang); }
      float* bq = WSP(float, WS_BQK);
      for (int idx = F.c * NTHREADS + F.tid; idx < 2 * 1280; idx += F.G * NTHREADS) { const int j = idx / 1280, n = idx % 1280; bq[j * 1280 + dst_row(1, n)] = A.in[I_ABQKV][j * 1536 + n]; } }
    __syncthreads();
    LAS TJob* jobs = (LAS TJob*)(F.lds + JOB_OFF); LAS int* njobs = (LAS int*)(F.lds + MISC_OFF + 64);
    if (F.tid == 0) {
        int nj = 0, item = 0;
        auto add = [&](const float* src, bf16_t* dst, int ldw, int ldt, int Ks, int Ns, int mode, int nb, long sbs, long dbs, int esz = 2) {
            LAS TJob& j = jobs[nj]; j.src = src; j.dst = (unsigned char*)dst; j.sbs = sbs; j.dbs = dbs; j.ldw = ldw; j.ldt = ldt; j.nkb = Ks / 64; j.nnb = Ns / 32; j.mode = mode; j.item0 = item; j.per = (Ks / 64) * (Ns / 32); j.esz = esz;
            ++nj; item += (Ks / 64) * (Ns / 32) * nb; };
        add(A.in[I_AWQKV], WSP(bf16_t, WS_WQK), 1536, 1024, 1024, 1280, 1, 2, 1024L * 1536, 1280L * 1024);
        add(A.in[I_AWQKV] + 1280, WSP(bf16_t, WS_WV), 1536, 1024, 1024, 256, 0, 2, 1024L * 1536, 256L * 1024);
        add(A.in[I_AWO], WSP(bf16_t, WS_WO), 1024, 1024, 1024, 1024, 0, 2, 1L << 20, 1L << 20);
        add(A.in[I_PW], WSP(bf16_t, WS_POOLW), 256, 256, 256, 256, 0, 4, 65536, 65536);
        add(A.in[I_RWRKV], WSP(bf16_t, WS_WRKV), 1024, 1024, 1024, 1024, 0, 3, 1L << 20, 1L << 20);
        add(A.in[I_RG1], WSP(bf16_t, WS_WL1), 128, 1024, 1024, 128, 0, 1, 0, 0);
        add(A.in[I_RW1], WSP(bf16_t, WS_WL1) + 256 * 1024, 64, 1024, 1024, 64, 0, 2, 65536, 65536);
        add(A.in[I_RA1], WSP(bf16_t, WS_WL1) + 2 * 256 * 1024, 64, 1024, 1024, 64, 0, 2, 65536, 65536);
        add(A.in[I_RG2], WSP(bf16_t, WS_WL2), 1024, 256, 128, 1024, 0, 1, 0, 0);
        add(A.in[I_RW2], WSP(bf16_t, WS_WL2) + 1 * 1024 * 256, 1024, 256, 64, 1024, 0, 2, 65536, 1024L * 256 + 64);
        add(A.in[I_RA2], WSP(bf16_t, WS_WL2) + 3 * 1024 * 256, 1024, 256, 64, 1024, 0, 2, 65536, 1024L * 256 + 64);
        add(A.in[I_RWO], WSP(bf16_t, WS_WOR), 1024, 1024, 1024, 1024, 0, 1, 0, 0);
        add(A.in[I_MW1], WSP(bf16_t, WS_W1T), 2048, 1024, 1024, 2048, 2, 128, 1024L * 2048, 2048L * 1024, 1);
        add(A.in[I_MW2], WSP(bf16_t, WS_W2T), 1024, 1024, 1024, 1024, 0, 128, 1L << 20, 1L << 20, 1);
        njobs[0] = nj; njobs[1] = item;
    }
    __syncthreads();
    { const int nj = njobs[0], nitems = njobs[1]; LAS float* scr = (LAS float*)(F.lds + F.wave * 16384);
      const int gw = F.c * NWAVES + F.wave, NGW = F.G * NWAVES;
      int it = gw;
      if (it < nitems) {
          TItem Tc, Tn; f32x4 vc[8], vn[8];
          titem_decode(jobs, nj, it, Tc); titem_load(Tc, F.lane, vc);
          for (;;) {
              const int itn = it + NGW; const bool more = itn < nitems;
              if (more) { titem_decode(jobs, nj, itn, Tn); titem_load(Tn, F.lane, vn); }
              titem_store(Tc, F.lane, vc, scr);
              if (!more) break;
              Tc = Tn;
#pragma unroll
              for (int i = 0; i < 8; ++i) vc[i] = vn[i];
              it = itn;
          }
      } }
    __syncthreads();
}

__device__ __forceinline__ void moe_tiles(Frame& F, int layer) {
    REFRESH(F);
    LAS int* lcnt = (LAS int*)(F.lds + LCNT_OFF); LAS int* tpre = (LAS int*)(F.lds + TPRE_OFF);
    __syncthreads();
    if (F.tid < NE) lcnt[F.tid] = (int)__hip_atomic_load(F.ctl + CW_GCNT + layer * 64 + F.tid, __ATOMIC_RELAXED, __HIP_MEMORY_SCOPE_AGENT);
    __syncthreads();
    if (F.tid == 0) { int s = 0; for (int e = 0; e < NE; ++e) { tpre[e] = s; s += (lcnt[e] + 255) >> 8; } tpre[NE] = s; }
    __syncthreads();
}
constexpr int RB = 2;
#define ROWOF(it, r) ((((it) * F.G + F.c) * NWAVES + F.wave) * RB + (r))
struct MoeRef { int p[4]; float g[4]; };
__device__ __forceinline__ void moe_ref_load(Frame& F, int row, MoeRef& R) {
    const int4 pp = *(const int4*)(WSP(int, WS_POS) + (size_t)row * 4); const f32x4 gg = *(const f32x4*)(WSP(float, WS_GATE) + (size_t)row * 4);
    R.p[0] = pp.x; R.p[1] = pp.y; R.p[2] = pp.z; R.p[3] = pp.w; R.g[0] = gg.x; R.g[1] = gg.y; R.g[2] = gg.z; R.g[3] = gg.w;
}
__device__ __forceinline__ void moe_rows_load(Frame& F, const MoeRef& R, u32x2 (&y)[4][4]) {
    const LAS int* tpre = (const LAS int*)(F.lds + TPRE_OFF); const bf16_t* Y = WSP(bf16_t, WS_Y);
#pragma unroll
    for (int k = 0; k < 4; ++k) { const int e = R.p[k] >> 20, slot = R.p[k] & 0xfffff; const size_t fr = (size_t)tpre[e] * 256 + slot; const u32x2* yp = (const u32x2*)(Y + fr * D) + F.lane;
#pragma unroll
        for (int j = 0; j < 4; ++j) y[k][j] = yp[64 * j]; }
}
__device__ __forceinline__ f32x4 moe_rows_sum(const MoeRef& R, const u32x2 (&y)[4][4], int j) {
    f32x4 s = (f32x4){0.f, 0.f, 0.f, 0.f};
#pragma unroll
    for (int k = 0; k < 4; ++k) { const u32x2 w = y[k][j]; s += R.g[k] * (f32x4){bflo(w.x), bfhi(w.x), bflo(w.y), bfhi(w.y)}; }
    return s;
}

__device__ __forceinline__ void phase_norm1(Frame& F, const Args& A, int layer) {
    REFRESH(F);
    if (layer > 0) moe_tiles(F, layer - 1);
    float* H = WSP(float, WS_H); bf16_t* AX = WSP(bf16_t, WS_AX); const float* MOD = WSP(float, WS_MOD);
    const float* g1 = A.in[I_NORMG] + (size_t)(layer * 2 + 0) * D;
    f32x4 gg[4];
#pragma unroll
    for (int j = 0; j < 4; ++j) gg[j] = ((const f32x4*)g1)[64 * j + F.lane];
    for (int it = 0;; ++it) { if (ROWOF(it, 0) >= NT) break;
        f32x4 v[RB][4]; int brow[RB];
        if (layer == 0) {
#pragma unroll
            for (int r = 0; r < RB; ++r) { const int row = ROWOF(it, r); brow[r] = row < NX ? (row >> 11) : 32; const float* src = row < NX ? A.in[I_X] + (size_t)row * D : A.in[I_CTX] + (size_t)(row - NX) * D;
#pragma unroll
                for (int j = 0; j < 4; ++j) v[r][j] = ((const f32x4*)src)[64 * j + F.lane]; }
        } else {
            MoeRef R[RB]; u32x2 y[RB][4][4]; f32x4 gv[RB][4];
#pragma unroll
            for (int r = 0; r < RB; ++r) moe_ref_load(F, ROWOF(it, r), R[r]);
#pragma unroll
            for (int r = 0; r < RB; ++r) { const int row = ROWOF(it, r); brow[r] = row < NX ? (row >> 11) : 32; moe_rows_load(F, R[r], y[r]);
                const float* g2p = MOD + ((size_t)(layer - 1) * 33 + brow[r]) * 6144 + 5 * D;
#pragma unroll
                for (int j = 0; j < 4; ++j) { v[r][j] = ((const f32x4*)(H + (size_t)row * D))[64 * j + F.lane]; gv[r][j] = ((const f32x4*)g2p)[64 * j + F.lane]; } }
#pragma unroll
            for (int r = 0; r < RB; ++r)
#pragma unroll
                for (int j = 0; j < 4; ++j) v[r][j] = v[r][j] + gv[r][j] * moe_rows_sum(R[r], y[r], j);
        }
        float rstd[RB];
#pragma unroll
        for (int r = 0; r < RB; ++r) { const int row = ROWOF(it, r); float ss = 0.f;
#pragma unroll
            for (int j = 0; j < 4; ++j) { ((f32x4*)(H + (size_t)row * D))[64 * j + F.lane] = v[r][j]; ss += (v[r][j].x * v[r][j].x + v[r][j].y * v[r][j].y) + (v[r][j].z * v[r][j].z + v[r][j].w * v[r][j].w); }
            rstd[r] = 1.0f / sqrtf(wave_sum(ss) * (1.0f / D) + 1e-5f); }
#pragma unroll
        for (int r = 0; r < RB; ++r) { const int row = ROWOF(it, r); const float* mp = MOD + ((size_t)layer * 33 + brow[r]) * 6144;
#pragma unroll
            for (int j = 0; j < 4; ++j) { const f32x4 sh = ((const f32x4*)mp)[64 * j + F.lane], sc = ((const f32x4*)(mp + D))[64 * j + F.lane];
                const f32x4 o = v[r][j] * rstd[r] * gg[j] * (sc + 1.0f) + sh;
                u32x2 w; w.x = pk2(o.x, o.y); w.y = pk2(o.z, o.w); ((u32x2*)(AX + (size_t)row * D))[64 * j + F.lane] = w; } }
    }
}
__device__ __forceinline__ void phase_final(Frame& F, const Args& A) {
    REFRESH(F);
    moe_tiles(F, DEPTH - 1);
    const float* H = WSP(float, WS_H); const float* MOD = WSP(float, WS_MOD); const float* fg = A.in[I_FG];
    f32x4 gg[4];
#pragma unroll
    for (int j = 0; j < 4; ++j) gg[j] = ((const f32x4*)fg)[64 * j + F.lane];
    for (int it = 0;; ++it) { if (ROWOF(it, 0) >= NX) break;
        MoeRef R[RB]; u32x2 y[RB][4][4]; f32x4 v[RB][4], gv[RB][4];
#pragma unroll
        for (int r = 0; r < RB; ++r) moe_ref_load(F, ROWOF(it, r), R[r]);
#pragma unroll
        for (int r = 0; r < RB; ++r) { const int row = ROWOF(it, r); moe_rows_load(F, R[r], y[r]); const float* g2p = MOD + ((size_t)(DEPTH - 1) * 33 + (row >> 11)) * 6144 + 5 * D;
#pragma unroll
            for (int j = 0; j < 4; ++j) { v[r][j] = ((const f32x4*)(H + (size_t)row * D))[64 * j + F.lane]; gv[r][j] = ((const f32x4*)g2p)[64 * j + F.lane]; } }
#pragma unroll
        for (int r = 0; r < RB; ++r) { const int row = ROWOF(it, r); float ss = 0.f;
#pragma unroll
            for (int j = 0; j < 4; ++j) { v[r][j] = v[r][j] + gv[r][j] * moe_rows_sum(R[r], y[r], j); ss += (v[r][j].x * v[r][j].x + v[r][j].y * v[r][j].y) + (v[r][j].z * v[r][j].z + v[r][j].w * v[r][j].w); }
            const float rstd = 1.0f / sqrtf(wave_sum(ss) * (1.0f / D) + 1e-5f);
#pragma unroll
            for (int j = 0; j < 4; ++j) ((f32x4*)(A.out + (size_t)row * D))[64 * j + F.lane] = v[r][j] * rstd * gg[j]; }
    }
}

__device__ __forceinline__ void phase_route(Frame& F, const Args& A, int layer) {
    REFRESH(F);
    const int nrows = (layer == DEPTH - 1) ? NX : NT;
    LAS float* wT = (LAS float*)F.lds;
    LAS int* lcnt = (LAS int*)(F.lds + LCNT_OFF); LAS int* lbase = (LAS int*)(F.lds + LBASE_OFF);
    LAS unsigned* recp = (LAS unsigned*)(F.lds + REC_OFF); LAS float* recg = (LAS float*)(F.lds + REC_OFF + 4608);
    __syncthreads();
    { const float* wr = A.in[I_MWR] + (size_t)layer * D * NE;
      for (int idx = F.tid; idx < D * NE; idx += NTHREADS) wT[(idx & 31) * 1024 + (idx >> 5)] = wr[idx]; }
    if (F.tid < NE) lcnt[F.tid] = 0;
    __syncthreads();
    const float* H = WSP(float, WS_H); unsigned char* FX = WSP(unsigned char, WS_FX); const float* MOD = WSP(float, WS_MOD);
    const float* g2 = A.in[I_NORMG] + (size_t)(layer * 2 + 1) * D; const float* br = A.in[I_MBR] + layer * NE;
    f32x4 gg[4];
#pragma unroll
    for (int j = 0; j < 4; ++j) gg[j] = ((const f32x4*)g2)[64 * j + F.lane];
    const int myE = F.lane >> 1; const float myb = br[myE];
    int nit = 0;
    for (int it = 0;; ++it) { if (ROWOF(it, 0) - F.wave * RB >= nrows) break; nit = it + 1;
        if (ROWOF(it, 0) >= nrows) continue;
        f32x4 v[RB][4]; float rstd[RB];
#pragma unroll
        for (int r = 0; r < RB; ++r) { const int row = ROWOF(it, r);
#pragma unroll
            for (int j = 0; j < 4; ++j) v[r][j] = ((const f32x4*)(H + (size_t)row * D))[64 * j + F.lane]; }
#pragma unroll
        for (int r = 0; r < RB; ++r) { float ss = 0.f;
#pragma unroll
            for (int j = 0; j < 4; ++j) ss += (v[r][j].x * v[r][j].x + v[r][j].y * v[r][j].y) + (v[r][j].z * v[r][j].z + v[r][j].w * v[r][j].w);
            rstd[r] = 1.0f / sqrtf(wave_sum(ss) * (1.0f / D) + 1e-5f); }
#pragma unroll
        for (int r = 0; r < RB; ++r) { const int row = ROWOF(it, r); const int brow = row < NX ? (row >> 11) : 32;
            const float* mp = MOD + ((size_t)layer * 33 + brow) * 6144 + 3 * D;
#pragma unroll
            for (int j = 0; j < 4; ++j) { const f32x4 sh = ((const f32x4*)mp)[64 * j + F.lane], sc = ((const f32x4*)(mp + D))[64 * j + F.lane];
                v[r][j] = v[r][j] * rstd[r] * gg[j] * (sc + 1.0f) + sh;
                ((unsigned*)(FX + (size_t)row * D))[64 * j + F.lane] = pk4_fp8(v[r][j].x, v[r][j].y, v[r][j].z, v[r][j].w); } }
        float part[RB][NE];
#pragma unroll
        for (int e = 0; e < NE; ++e) { float p0 = 0.f, p1 = 0.f;
#pragma unroll
            for (int j = 0; j < 4; ++j) { const f32x4 w4 = ((const LAS f32x4*)(wT + e * 1024))[64 * j + F.lane];
                p0 += (v[0][j].x * w4.x + v[0][j].y * w4.y) + (v[0][j].z * w4.z + v[0][j].w * w4.w); p1 += (v[1][j].x * w4.x + v[1][j].y * w4.y) + (v[1][j].z * w4.z + v[1][j].w * w4.w); }
            part[0][e] = p0; part[1][e] = p1; }
#pragma unroll
        for (int r = 0; r < RB; ++r) {
#pragma unroll
            for (int k = 0; k < 16; ++k) { const bool up = (F.lane & 32) != 0; const float keep = up ? part[r][k + 16] : part[r][k], send = up ? part[r][k] : part[r][k + 16]; part[r][k] = keep + __shfl_xor(send, 32); }
#pragma unroll
            for (int k = 0; k < 8; ++k) { const bool up = (F.lane & 16) != 0; const float keep = up ? part[r][k + 8] : part[r][k], send = up ? part[r][k] : part[r][k + 8]; part[r][k] = keep + __shfl_xor(send, 16); }
#pragma unroll
            for (int k = 0; k < 4; ++k) { const bool up = (F.lane & 8) != 0; const float keep = up ? part[r][k + 4] : part[r][k], send = up ? part[r][k] : part[r][k + 4]; part[r][k] = keep + __shfl_xor(send, 8); }
#pragma unroll
            for (int k = 0; k < 2; ++k) { const bool up = (F.lane & 4) != 0; const float keep = up ? part[r][k + 2] : part[r][k], send = up ? part[r][k] : part[r][k + 2]; part[r][k] = keep + __shfl_xor(send, 4); }
            { const bool up = (F.lane & 2) != 0; const float keep = up ? part[r][1] : part[r][0], send = up ? part[r][0] : part[r][1]; part[r][0] = keep + __shfl_xor(send, 2); }
            part[r][0] += __shfl_xor(part[r][0], 1);
        }
#pragma unroll
        for (int r = 0; r < RB; ++r) {
            const float val = part[r][0] + myb;
            int rank = 0;
#pragma unroll
            for (int e = 0; e < NE; ++e) { const float ve = __builtin_bit_cast(float, __builtin_amdgcn_readlane(__builtin_bit_cast(int, val), 2 * e)); rank += (ve > val || (ve == val && e < myE)) ? 1 : 0; }
            float sv[4]; int si[4];
#pragma unroll
            for (int k = 0; k < 4; ++k) { const unsigned long long m = __ballot(rank == k && (F.lane & 1) == 0); const int src = __builtin_ctzll(m);
                si[k] = src >> 1; sv[k] = __builtin_bit_cast(float, __builtin_amdgcn_readlane(__builtin_bit_cast(int, val), src)); }
            const float e1 = __expf(sv[1] - sv[0]), e2 = __expf(sv[2] - sv[0]), e3 = __expf(sv[3] - sv[0]); const float inv = 1.0f / (1.0f + e1 + e2 + e3);
            if (F.lane < 4) { const int e = F.lane == 0 ? si[0] : F.lane == 1 ? si[1] : F.lane == 2 ? si[2] : si[3]; const float g = (F.lane == 0 ? 1.0f : F.lane == 1 ? e1 : F.lane == 2 ? e2 : e3) * inv;
                const int rank2 = __hip_atomic_fetch_add(lcnt + e, 1, __ATOMIC_RELAXED, __HIP_MEMORY_SCOPE_WORKGROUP);
                const int ri = ((it * NWAVES + F.wave) * RB + r) * 4 + F.lane; recp[ri] = ((unsigned)e << 20) | (unsigned)rank2; recg[ri] = g; }
        }
    }
    __syncthreads();
    if (F.tid < NE) lbase[F.tid] = (int)__hip_atomic_fetch_add(F.ctl + CW_GCNT + layer * 64 + F.tid, (unsigned)lcnt[F.tid], __ATOMIC_RELAXED, __HIP_MEMORY_SCOPE_AGENT);
    __syncthreads();
    int* LIST = WSP(int, WS_LIST); int* POS = WSP(int, WS_POS); float* GATE = WSP(float, WS_GATE);
    for (int r = F.tid; r < nit * NWAVES * RB * 4; r += NTHREADS) { const int lr = r >> 2, k = r & 3; const int row = ((lr >> 4) * F.G + F.c) * (NWAVES * RB) + (lr & 15); if (row >= nrows) continue;
        const unsigned qx = recp[r]; const float qg = recg[r]; const int e = qx >> 20, slot = lbase[e] + (int)(qx & 0xfffff);
        LIST[(size_t)e * NT + slot] = row; POS[(size_t)row * 4 + k] = (e << 20) | slot; GATE[(size_t)row * 4 + k] = qg; }
    __syncthreads();
}

__device__ __forceinline__ void phase_pooldiff(Frame& F) {
    REFRESH(F);
    const bf16_t* AX = WSP(bf16_t, WS_AX); bf16_t* PD = WSP(bf16_t, WS_PD);
    for (int it = 0;; ++it) { if (ROWOF(it, 0) >= NT) break;
        const int row0 = ROWOF(it, 0); int sb, t, n; seq_of(row0, sb, t, n);
#pragma unroll
        for (int j = 0; j < 4; ++j) { const int half = 1 << j; const int col = 256 * j + 4 * F.lane;
            f32x4 s0 = (f32x4){0.f, 0.f, 0.f, 0.f}, s1 = s0, me0 = s0, me1 = s0;
#pragma unroll
            for (int q = 0; q < 2 * half + 1; ++q) { const int uu = t - half + q;
                if (uu >= 0 && uu < n) { const f32x4 x = ld_bf4(AX + (size_t)(sb + uu) * D + col); if (q < 2 * half) s0 += x; if (q > 0) s1 += x; if (q == half) me0 = x; if (q == half + 1) me1 = x; } }
            const int lo0 = t - half < 0 ? 0 : t - half, hi0 = t + half > n ? n : t + half, lo1 = t + 1 - half < 0 ? 0 : t + 1 - half, hi1 = t + 1 + half > n ? n : t + 1 + half;
            st_bf4(PD + (size_t)row0 * D + col, s0 * (1.0f / (float)(hi0 - lo0)) - me0);
            st_bf4(PD + (size_t)(row0 + 1) * D + col, s1 * (1.0f / (float)(hi1 - lo1)) - me1); }
    }
}
__device__ __forceinline__ void phase_rwkv_mix(Frame& F, const Args& A) {
    REFRESH(F);
    const bf16_t* AX = WSP(bf16_t, WS_AX); bf16_t* A6 = WSP(bf16_t, WS_A6); const float* mix = A.in[I_RMIX];
    for (int it = 0;; ++it) { if (ROWOF(it, 0) >= NT) break;
        const int row0 = ROWOF(it, 0); int sb, t, n; seq_of(row0, sb, t, n);
#pragma unroll
        for (int j = 0; j < 4; ++j) { const int col = 256 * j + 4 * F.lane; const f32x4 z = (f32x4){0.f, 0.f, 0.f, 0.f};
            const f32x4 h0 = ld_bf4(AX + (size_t)row0 * D + col), h1 = ld_bf4(AX + (size_t)(row0 + 1) * D + col);
            const f32x4 hp = t > 0 ? ld_bf4(AX + (size_t)(row0 - 1) * D + col) : z, hn = t + 1 < n - 1 ? ld_bf4(AX + (size_t)(row0 + 2) * D + col) : z;
            const f32x4 xx0 = (hp + h1) * 0.5f - h0, xx1 = (h0 + hn) * 0.5f - h1;
#pragma unroll
            for (int i = 0; i < 6; ++i) { const f32x4 m = *(const f32x4*)(mix + i * D + col); st_bf4(A6 + ((size_t)i * NT + row0) * D + col, h0 + xx0 * m); st_bf4(A6 + ((size_t)i * NT + row0 + 1) * D + col, h1 + xx1 * m); } }
    }
}
__device__ __forceinline__ float rl(float x, int k) { return __builtin_bit_cast(float, __builtin_amdgcn_readlane(__builtin_bit_cast(int, x), k)); }
typedef float f32x16 __attribute__((ext_vector_type(16)));
constexpr int SCW = 33792;
__device__ __forceinline__ int kpos(int k) { return (k & ~12) | ((k & 4) << 1) | ((k & 8) >> 1); }
__device__ __forceinline__ void phase_rwkv_scan(Frame& F, const Args& A) {
    REFRESH(F);
    __syncthreads();
    for (int item = F.wave * F.G + F.c; item < 1024 && F.wave < 4; item += 4 * F.G) {
        const int dir = item >> 9, b = (item >> 4) & 31, hd = item & 15, col = 64 * hd + F.lane;
        const int l = F.lane, r32 = l & 31, hh = l >> 5;
        const bf16_t* Rr = WSP(bf16_t, WS_RKV); const bf16_t* Kk = Rr + (size_t)NT * D; const bf16_t* Vv = Kk + (size_t)NT * D;
        const bf16_t* Ee = WSP(bf16_t, WS_E) + (size_t)dir * NT * D; const bf16_t* Aa = WSP(bf16_t, WS_A) + (size_t)dir * NT * D;
        float* Yo = WSP(float, WS_YS) + (size_t)dir * NT * D; float* Bo = WSP(float, WS_BONUS) + (size_t)dir * NT * 16;
        const float kkw = A.in[I_RKK][col], kaw = A.in[I_RKA][col], rkw = A.in[I_RRK][col];
        LAS unsigned char* RA = F.lds + F.wave * SCW; LAS unsigned char* RB = RA + 16384; LAS unsigned char* RC = RA + 25600;
        LAS float* cCb = (LAS float*)(F.lds + REC_OFF + F.wave * 256);
        LAS bf16_t* XT = (LAS bf16_t*)RA;
        LAS bf16_t* BK = (LAS bf16_t*)(RA + 8192);
        const int kp = kpos(l);
        f32x16 ST[2][2];
#pragma unroll
        for (int i = 0; i < 2; ++i)
#pragma unroll
            for (int j2 = 0; j2 < 2; ++j2)
#pragma unroll
                for (int q = 0; q < 16; ++q) ST[i][j2][q] = 0.f;
        for (int seg = 0; seg < 2; ++seg) {
            const int base = seg ? b * T : NX + b * L, n = seg ? T : L; const int dt = dir ? -1 : 1; const int t0 = dir ? n - 1 : 0;
            for (int bt = 0; bt < n; bt += 32) {
                f32x2 vv2[16]; float cprev = 1.0f;
#pragma unroll
                for (int g8 = 0; g8 < 8; ++g8) {
                    bf16_t raw[4][5];
#pragma unroll
                    for (int s8 = 0; s8 < 4; ++s8) { const size_t o = (size_t)(base + t0 + dt * (bt + g8 * 4 + s8)) * D + col; raw[s8][0] = Rr[o]; raw[s8][1] = Kk[o]; raw[s8][2] = Vv[o]; raw[s8][3] = Aa[o]; raw[s8][4] = Ee[o]; }
                    float rr[4], kraw[4], aa[4], kk[4], kd[4], n2[4], bn[4], ww[4]; unsigned bq2[2] = {0u, 0u}, kq2[2] = {0u, 0u};
#pragma unroll
                    for (int s8 = 0; s8 < 4; ++s8) { rr[s8] = bf1(raw[s8][0]); kraw[s8] = bf1(raw[s8][1]); aa[s8] = bf1(raw[s8][3]); ww[s8] = __expf(-bf1(raw[s8][4]));
                        const float vx = bf1(raw[s8][2]); const int t = g8 * 4 + s8; if (t & 1) vv2[t >> 1].y = vx; else vv2[t >> 1].x = vx;
                        kk[s8] = kraw[s8] * kkw; n2[s8] = kk[s8] * kk[s8]; kd[s8] = kraw[s8] * (1.0f + (aa[s8] - 1.0f) * kaw); bn[s8] = rr[s8] * kd[s8] * rkw; }
#pragma unroll
                    for (int s8 = 0; s8 < 4; ++s8) { n2[s8] = wave_sum(n2[s8]); bn[s8] = wave_sum(bn[s8]); }
#pragma unroll
                    for (int s8 = 0; s8 < 4; ++s8) { const int t = g8 * 4 + s8;
                        if (l == 0) Bo[(size_t)(base + t0 + dt * (bt + t)) * 16 + hd] = bn[s8];
                        const float kn = kk[s8] * __builtin_amdgcn_rsqf(fmaxf(n2[s8], 1e-24f)); const float c = cprev * ww[s8]; const float ic = __builtin_amdgcn_rcpf(c);
                        const float at = -kn * cprev, rt = rr[s8] * c, bq = kn * aa[s8] * ic, kq = kd[s8] * ic;
                        const unsigned w0 = cvt_pk_bf16(at, rt), w1 = cvt_pk_bf16(bq, kq);
                        XT[t * 64 + kp] = (bf16_t)(w0 & 0xffffu); XT[(32 + t) * 64 + kp] = (bf16_t)(w0 >> 16);
                        BK[t * 64 + kp] = (bf16_t)(w1 & 0xffffu); BK[(32 + t) * 64 + kp] = (bf16_t)(w1 >> 16);
                        if (s8 & 1) { bq2[s8 >> 1] |= (w1 & 0xffffu) << 16; kq2[s8 >> 1] |= (w1 & 0xffff0000u); } else { bq2[s8 >> 1] = w1 & 0xffffu; kq2[s8 >> 1] = w1 >> 16; }
                        cprev = c; }
                    *(LAS u32x2*)(RB + l * 144 + g8 * 8) = (u32x2){bq2[0], bq2[1]}; *(LAS u32x2*)(RB + l * 144 + 64 + g8 * 8) = (u32x2){kq2[0], kq2[1]};
                }
                cCb[l] = cprev;
                asm volatile("s_waitcnt lgkmcnt(0)" ::: "memory");
                bf16x8 XTf[2][4], BKf[2][4];
#pragma unroll
                for (int cb = 0; cb < 2; ++cb)
#pragma unroll
                    for (int s4 = 0; s4 < 4; ++s4) { XTf[cb][s4] = *(const LAS bf16x8*)(XT + (32 * cb + r32) * 64 + 16 * s4 + 8 * hh); BKf[cb][s4] = *(const LAS bf16x8*)(BK + (32 * cb + r32) * 64 + 16 * s4 + 8 * hh); }
                asm volatile("s_waitcnt lgkmcnt(0)" ::: "memory");
#pragma unroll
                for (int cb = 0; cb < 2; ++cb) { f32x16 Gg[2];
#pragma unroll
                  for (int vb = 0; vb < 2; ++vb) {
#pragma unroll
                      for (int q = 0; q < 16; ++q) Gg[vb][q] = 0.f;
#pragma unroll
                      for (int kb = 0; kb < 2; ++kb)
#pragma unroll
                          for (int s2 = 0; s2 < 2; ++s2) { const f32x16& X = ST[kb][vb];
                              u32x4 w; w.x = cvt_pk_bf16(X[8 * s2 + 0], X[8 * s2 + 1]); w.y = cvt_pk_bf16(X[8 * s2 + 2], X[8 * s2 + 3]); w.z = cvt_pk_bf16(X[8 * s2 + 4], X[8 * s2 + 5]); w.w = cvt_pk_bf16(X[8 * s2 + 6], X[8 * s2 + 7]);
                              Gg[vb] = __builtin_amdgcn_mfma_f32_32x32x16_bf16(XTf[cb][2 * kb + s2], __builtin_bit_cast(bf16x8, w), Gg[vb], 0, 0, 0); } }
                  LAS float* GT = (LAS float*)RA;
#pragma unroll
                  for (int vb = 0; vb < 2; ++vb)
#pragma unroll
                      for (int q = 0; q < 16; ++q) { const int t = (q & 3) + 8 * (q >> 2) + 4 * hh; GT[(cb * 32 + t) * 64 + 32 * vb + r32] = Gg[vb][q]; } }
                f32x16 Mm[2][2];
#pragma unroll
                for (int jb = 0; jb < 2; ++jb)
#pragma unroll
                    for (int cb = 0; cb < 2; ++cb) {
#pragma unroll
                        for (int q = 0; q < 16; ++q) Mm[jb][cb][q] = 0.f;
#pragma unroll
                        for (int s4 = 0; s4 < 4; ++s4) Mm[jb][cb] = __builtin_amdgcn_mfma_f32_32x32x16_bf16(BKf[jb][s4], XTf[cb][s4], Mm[jb][cb], 0, 0, 0); }
                LAS float* Mb = (LAS float*)RC;
#pragma unroll
                for (int jb = 0; jb < 2; ++jb)
#pragma unroll
                    for (int g4 = 0; g4 < 4; ++g4) { f32x4 o;
#pragma unroll
                        for (int i = 0; i < 4; ++i) { const int jj = 8 * g4 + 4 * hh + i; o[i] = jj < r32 ? Mm[jb][0][4 * g4 + i] : 0.f; }
                        *(LAS f32x4*)(Mb + (jb * 32 + r32) * 32 + 8 * g4 + 4 * hh) = o; }
                asm volatile("s_waitcnt lgkmcnt(0)" ::: "memory");
                f32x2 uu2[16];
                { const LAS float* GTa = (const LAS float*)RA + l;
                  float gav[32];
#pragma unroll
                  for (int t = 0; t < 32; ++t) gav[t] = GTa[t * 64];
                  f32x4 Rb[4], Rk[4]; int lt = 1, lq = 0, gl = 0;
#define SCAN_LD3() do { if (lt < 32) { Rb[gl & 3] = *(const LAS f32x4*)(Mb + lt * 32 + 4 * lq); Rk[gl & 3] = *(const LAS f32x4*)(Mb + (32 + lt) * 32 + 4 * lq); ++gl; ++lq; if (4 * lq >= lt) { lq = 0; ++lt; } } } while (0)
                  SCAN_LD3(); SCAN_LD3(); SCAN_LD3();
                  int gc = 0;
                  uu2[0].x = gav[0]; uu2[0].y = 0.f;
#pragma unroll
                  for (int t = 1; t < 32; ++t) {
                      f32x2 ac0 = (f32x2){gav[t], 0.f}, ac1 = (f32x2){0.f, 0.f};
#pragma unroll
                      for (int q = 0; 4 * q < t; ++q) { SCAN_LD3(); __builtin_amdgcn_sched_barrier(0);
                          const f32x4 mb = Rb[gc & 3], mk = Rk[gc & 3]; ++gc;
                          ac0 += uu2[2 * q] * (f32x2){mb.x, mb.y}; ac1 += vv2[2 * q] * (f32x2){mk.x, mk.y};
                          if (4 * q + 2 < t) { ac0 += uu2[2 * q + 1] * (f32x2){mb.z, mb.w}; ac1 += vv2[2 * q + 1] * (f32x2){mk.z, mk.w}; }
                          __builtin_amdgcn_sched_barrier(0); }
                      const f32x2 sm = ac0 + ac1; const float u = sm.x + sm.y;
                      if (t & 1) uu2[t >> 1].y = u; else { uu2[t >> 1].x = u; uu2[t >> 1].y = 0.f; } }
#undef SCAN_LD3
                }
                asm volatile("s_waitcnt lgkmcnt(0)" ::: "memory");
#pragma unroll
                for (int jb = 0; jb < 2; ++jb)
#pragma unroll
                    for (int g4 = 0; g4 < 4; ++g4) { f32x4 o;
#pragma unroll
                        for (int i = 0; i < 4; ++i) { const int jj = 8 * g4 + 4 * hh + i; o[i] = jj <= r32 ? Mm[jb][1][4 * g4 + i] : 0.f; }
                        *(LAS f32x4*)(Mb + (jb * 32 + r32) * 32 + 8 * g4 + 4 * hh) = o; }
                asm volatile("s_waitcnt lgkmcnt(0)" ::: "memory");
                { const LAS float* GTr = (const LAS float*)RA + 32 * 64 + l;
                  float grv[32];
#pragma unroll
                  for (int t = 0; t < 32; ++t) grv[t] = GTr[t * 64];
                  f32x4 Rb[4], Rk[4]; int lt = 0, lq = 0, gl = 0;
#define SCAN_LD4() do { if (lt < 32) { Rb[gl & 3] = *(const LAS f32x4*)(Mb + lt * 32 + 4 * lq); Rk[gl & 3] = *(const LAS f32x4*)(Mb + (32 + lt) * 32 + 4 * lq); ++gl; ++lq; if (4 * lq > lt) { lq = 0; ++lt; } } } while (0)
                  SCAN_LD4(); SCAN_LD4(); SCAN_LD4();
                  int gc = 0;
#pragma unroll
                  for (int t = 0; t < 32; ++t) {
                      f32x2 ac0 = (f32x2){grv[t], 0.f}, ac1 = (f32x2){0.f, 0.f};
#pragma unroll
                      for (int q = 0; 4 * q <= t; ++q) { SCAN_LD4(); __builtin_amdgcn_sched_barrier(0);
                          const f32x4 mb = Rb[gc & 3], mk = Rk[gc & 3]; ++gc;
                          ac0 += uu2[2 * q] * (f32x2){mb.x, mb.y}; ac1 += vv2[2 * q] * (f32x2){mk.x, mk.y};
                          if (4 * q + 2 <= t) { ac0 += uu2[2 * q + 1] * (f32x2){mb.z, mb.w}; ac1 += vv2[2 * q + 1] * (f32x2){mk.z, mk.w}; }
                          __builtin_amdgcn_sched_barrier(0); }
                      const f32x2 sm = ac0 + ac1;
                      Yo[(size_t)(base + t0 + dt * (bt + t)) * D + col] = sm.x + sm.y; }
#undef SCAN_LD4
                }
                asm volatile("s_waitcnt lgkmcnt(0)" ::: "memory");
                { LAS u32x4* row = (LAS u32x4*)(RA + l * 144);
#pragma unroll
                  for (int q = 0; q < 4; ++q) {
                      row[q] = (u32x4){cvt_pk_bf16(uu2[4 * q].x, uu2[4 * q].y), cvt_pk_bf16(uu2[4 * q + 1].x, uu2[4 * q + 1].y), cvt_pk_bf16(uu2[4 * q + 2].x, uu2[4 * q + 2].y), cvt_pk_bf16(uu2[4 * q + 3].x, uu2[4 * q + 3].y)};
                      row[4 + q] = (u32x4){cvt_pk_bf16(vv2[4 * q].x, vv2[4 * q].y), cvt_pk_bf16(vv2[4 * q + 1].x, vv2[4 * q + 1].y), cvt_pk_bf16(vv2[4 * q + 2].x, vv2[4 * q + 2].y), cvt_pk_bf16(vv2[4 * q + 3].x, vv2[4 * q + 3].y)}; } }
                asm volatile("s_waitcnt lgkmcnt(0)" ::: "memory");
                { bf16x8 Bf[2][4], Uf[2][4];
#pragma unroll
                  for (int kb = 0; kb < 2; ++kb)
#pragma unroll
                      for (int s4 = 0; s4 < 4; ++s4) { Bf[kb][s4] = *(const LAS bf16x8*)(RB + (32 * kb + r32) * 144 + (16 * s4 + 8 * hh) * 2); Uf[kb][s4] = *(const LAS bf16x8*)(RA + (32 * kb + r32) * 144 + (16 * s4 + 8 * hh) * 2); }
#pragma unroll
                  for (int kb = 0; kb < 2; ++kb)
#pragma unroll
                      for (int vb = 0; vb < 2; ++vb)
#pragma unroll
                          for (int s4 = 0; s4 < 4; ++s4) ST[kb][vb] = __builtin_amdgcn_mfma_f32_32x32x16_bf16(Bf[kb][s4], Uf[vb][s4], ST[kb][vb], 0, 0, 0); }
#pragma unroll
                for (int kb = 0; kb < 2; ++kb)
#pragma unroll
                    for (int g4 = 0; g4 < 4; ++g4) { const f32x4 cc = *(const LAS f32x4*)(cCb + 32 * kb + 8 * g4 + 4 * hh);
#pragma unroll
                        for (int vb = 0; vb < 2; ++vb) { ST[kb][vb][4 * g4 + 0] *= cc.x; ST[kb][vb][4 * g4 + 1] *= cc.y; ST[kb][vb][4 * g4 + 2] *= cc.z; ST[kb][vb][4 * g4 + 3] *= cc.w; } }
                asm volatile("s_waitcnt lgkmcnt(0)" ::: "memory");
            }
        }
    }
    __syncthreads();
}
__device__ __forceinline__ void phase_rwkv_out(Frame& F, const Args& A, int nrows) {
    REFRESH(F);
    const float* Y0 = WSP(float, WS_YS); const float* Y1 = Y0 + (size_t)NT * D; const float* B0 = WSP(float, WS_BONUS); const float* B1 = B0 + (size_t)NT * 16;
    const bf16_t* Vv = WSP(bf16_t, WS_RKV) + (size_t)2 * NT * D; const bf16_t* Gg = WSP(bf16_t, WS_G); bf16_t* RO = WSP(bf16_t, WS_RO);
    const float* lnw = A.in[I_RLNW]; const float* lnb = A.in[I_RLNB];
    for (int it = 0;; ++it) { if (ROWOF(it, 0) >= nrows) break;
        f32x4 y[RB][4], vv[RB][4], gg[RB][4]; float bon[RB][4];
#pragma unroll
        for (int r = 0; r < RB; ++r) { const int row = ROWOF(it, r);
#pragma unroll
            for (int j = 0; j < 4; ++j) { const int col = 256 * j + 4 * F.lane, head = 4 * j + (F.lane >> 4); const size_t o = (size_t)row * D + col;
                y[r][j] = *(const f32x4*)(Y0 + o) + *(const f32x4*)(Y1 + o); vv[r][j] = ld_bf4(Vv + o); gg[r][j] = ld_bf4(Gg + o); bon[r][j] = B0[(size_t)row * 16 + head] + B1[(size_t)row * 16 + head]; } }
#pragma unroll
        for (int r = 0; r < RB; ++r) { const int row = ROWOF(it, r);
#pragma unroll
            for (int j = 0; j < 4; ++j) { const int col = 256 * j + 4 * F.lane; const size_t o = (size_t)row * D + col; const f32x4 yy = y[r][j];
                const float s = row16_sum((yy.x + yy.y) + (yy.z + yy.w));
                const f32x4 d = yy - s * (1.0f / 64.0f);
                const float q = row16_sum((d.x * d.x + d.y * d.y) + (d.z * d.z + d.w * d.w));
                const float rs = 1.0f / sqrtf(q * (1.0f / 64.0f) + 64e-5f);
                const f32x4 yn = d * rs * *(const f32x4*)(lnw + col) + *(const f32x4*)(lnb + col);
                st_bf4(RO + o, (yn + vv[r][j] * bon[r][j]) * gg[r][j]); } }
    }
}

__device__ __forceinline__ void phase_attn(Frame& F, const Args& A, int j, bool need_ctx) {
    REFRESH(F);
    const bf16_t* Q = WSP(bf16_t, WS_Q); const bf16_t* Kb = WSP(bf16_t, WS_K); const bf16_t* VT = WSP(bf16_t, WS_VT); bf16_t* O = WSP(bf16_t, WS_O);
    const float* sinks = A.in[I_ASINK] + j * 16;
    LAS bf16_t* Ks = (LAS bf16_t*)F.lds; LAS bf16_t* Vs = (LAS bf16_t*)(F.lds + 9216);
    LAS bf16x8* Qs = (LAS bf16x8*)(F.lds + 18432 + F.wave * 8192) + F.lane;
    const int nunits = 2048 + (need_ctx ? 256 : 0);
    const int fr = F.lane & 15, fq = F.lane >> 4, g = F.wave >> 1, hf = F.wave & 1;
    const float SC = 0.125f * 1.4426950408889634f;
    const int lr = F.tid >> 3, lch = F.tid & 7;
    __syncthreads();
    for (int u = F.c; u < nunits; u += F.G) {
        int b, kvh, qb; bool isx;
        if (u < 2048) { isx = true; b = u >> 6; kvh = (u >> 4) & 3; qb = u & 15; } else { const int v = u - 2048; isx = false; b = v >> 3; kvh = (v >> 1) & 3; qb = v & 1; }
        const int qrow0 = (isx ? b * T : NX + b * L) + qb * 128 + hf * 64; const int head = 4 * kvh + g;
        int jlo = 0, jhi = -1;
        if (isx) { jlo = qb == 0 ? 2 : 0; jhi = qb == 15 ? 3 : 5; }
        const int ntiles = 4 + (jhi - jlo + 1);
        auto tile_row0 = [&](int ti) -> int { return ti < 4 ? NX + b * L + ti * 64 : b * T + qb * 128 - 128 + 64 * (jlo + ti - 4); };
        u32x4 kv_n, vv_n;
        { const int kr0 = tile_row0(0); kv_n = *(const u32x4*)(Kb + (size_t)(kr0 + lr) * 256 + kvh * 64 + lch * 8); vv_n = *(const u32x4*)(VT + (size_t)(kvh * 64 + lr) * NT + kr0 + lch * 8); }
#pragma unroll
        for (int mq = 0; mq < 4; ++mq)
#pragma unroll
            for (int ks = 0; ks < 2; ++ks) Qs[64 * (mq * 2 + ks)] = *(const bf16x8*)(Q + (size_t)(qrow0 + 16 * mq + fr) * D + head * 64 + ks * 32 + 8 * fq);
        const float sink2 = sinks[head] * 1.4426950408889634f;
        float mrun[4], lrun[4]; f32x4 Oa[4][4];
#pragma unroll
        for (int mq = 0; mq < 4; ++mq) { mrun[mq] = sink2; lrun[mq] = fq == 0 ? 1.0f : 0.0f;
#pragma unroll
            for (int db = 0; db < 4; ++db) Oa[mq][db] = (f32x4){0.f, 0.f, 0.f, 0.f}; }
        for (int ti = 0; ti < ntiles; ++ti) {
            const int jl = ti < 4 ? -1 : jlo + ti - 4; const int ks0 = qb * 128 - 128 + 64 * jl;
            __syncthreads();
            *(LAS u32x4*)(Ks + lr * 72 + lch * 8) = kv_n; *(LAS u32x4*)(Vs + lr * 72 + lch * 8) = vv_n;
            __syncthreads();
            if (ti + 1 < ntiles) { const int kr0 = tile_row0(ti + 1); kv_n = *(const u32x4*)(Kb + (size_t)(kr0 + lr) * 256 + kvh * 64 + lch * 8); vv_n = *(const u32x4*)(VT + (size_t)(kvh * 64 + lr) * NT + kr0 + lch * 8); }
            const bool need = (jl < 0) || (jl >= hf && jl <= hf + 4);
            if (need) {
                const bool domask = (jl >= 0) && (jl == hf || jl == hf + 4);
                f32x4 Sa[4][4];
#pragma unroll
                for (int mq = 0; mq < 4; ++mq)
#pragma unroll
                    for (int n = 0; n < 4; ++n) Sa[mq][n] = (f32x4){0.f, 0.f, 0.f, 0.f};
#pragma unroll
                for (int ks = 0; ks < 2; ++ks) {
                    bf16x8 Qf[4];
#pragma unroll
                    for (int mq = 0; mq < 4; ++mq) Qf[mq] = Qs[64 * (mq * 2 + ks)];
#pragma unroll
                    for (int n = 0; n < 4; ++n) { const int kr = 32 * (n >> 1) + 8 * (fr >> 2) + 4 * (n & 1) + (fr & 3);
                        const bf16x8 Kf = *(const LAS bf16x8*)(Ks + kr * 72 + ks * 32 + 8 * fq);
#pragma unroll
                        for (int mq = 0; mq < 4; ++mq) Sa[mq][n] = __builtin_amdgcn_mfma_f32_16x16x32_bf16(Kf, Qf[mq], Sa[mq][n], 0, 0, 0); } }
                bf16x8 Pf[4][2];
#pragma unroll
                for (int mq = 0; mq < 4; ++mq) {
                    float mx = -1e30f;
                    if (domask) { const int tq = qb * 128 + hf * 64 + 16 * mq + fr;
#pragma unroll
                        for (int n = 0; n < 4; ++n)
#pragma unroll
                            for (int i = 0; i < 4; ++i) { float sv = Sa[mq][n][i] * SC; const int rel = ks0 + 32 * (n >> 1) + 8 * fq + 4 * (n & 1) + i - tq; if (rel > 128 || rel < -128) sv = -1e30f; Sa[mq][n][i] = sv; mx = fmaxf(mx, sv); } }
                    else {
#pragma unroll
                        for (int n = 0; n < 4; ++n)
#pragma unroll
                            for (int i = 0; i < 4; ++i) { const float sv = Sa[mq][n][i] * SC; Sa[mq][n][i] = sv; mx = fmaxf(mx, sv); } }
                    mx = fmaxf(mx, __shfl_xor(mx, 16)); mx = fmaxf(mx, __shfl_xor(mx, 32));
                    const float mnew = fmaxf(mrun[mq], mx); const float alpha = __builtin_amdgcn_exp2f(mrun[mq] - mnew); mrun[mq] = mnew;
                    float rs = 0.f;
#pragma unroll
                    for (int n = 0; n < 4; ++n)
#pragma unroll
                        for (int i = 0; i < 4; ++i) { const float p = __builtin_amdgcn_exp2f(Sa[mq][n][i] - mnew); Sa[mq][n][i] = p; rs += p; }
                    lrun[mq] = lrun[mq] * alpha + rs;
#pragma unroll
                    for (int db = 0; db < 4; ++db) Oa[mq][db] *= alpha;
#pragma unroll
                    for (int s2 = 0; s2 < 2; ++s2) { u32x4 w; w.x = cvt_pk_bf16(Sa[mq][2 * s2][0], Sa[mq][2 * s2][1]); w.y = cvt_pk_bf16(Sa[mq][2 * s2][2], Sa[mq][2 * s2][3]);
                        w.z = cvt_pk_bf16(Sa[mq][2 * s2 + 1][0], Sa[mq][2 * s2 + 1][1]); w.w = cvt_pk_bf16(Sa[mq][2 * s2 + 1][2], Sa[mq][2 * s2 + 1][3]); Pf[mq][s2] = __builtin_bit_cast(bf16x8, w); }
                }
#pragma unroll
                for (int db = 0; db < 4; ++db)
#pragma unroll
                    for (int s2 = 0; s2 < 2; ++s2) { const bf16x8 Vf = *(const LAS bf16x8*)(Vs + (16 * db + fr) * 72 + 32 * s2 + 8 * fq);
#pragma unroll
                        for (int mq = 0; mq < 4; ++mq) Oa[mq][db] = __builtin_amdgcn_mfma_f32_16x16x32_bf16(Vf, Pf[mq][s2], Oa[mq][db], 0, 0, 0); }
            }
        }
#pragma unroll
        for (int mq = 0; mq < 4; ++mq) { float l = lrun[mq]; l += __shfl_xor(l, 16); l += __shfl_xor(l, 32); const float inv = 1.0f / l;
            bf16_t* op = O + (size_t)(qrow0 + 16 * mq + fr) * D + head * 64 + 4 * fq;
#pragma unroll
            for (int db = 0; db < 4; ++db) st_bf4(op + 16 * db, Oa[mq][db] * inv); }
    }
    __syncthreads();
}

struct KState { XcdBarrier bar; int ph; };
#define RUN() (A.one || A.phase == KS.ph)
#define SEAM() do { if (A.one) xcd_barrier(KS.bar); ++KS.ph; } while (0)
template <int LAYER>
__device__ __forceinline__ void layer_body(Frame& F, const Args& A, KState& KS) {
    constexpr int layer = LAYER, kind = LAYER % 3, j = LAYER / 3; constexpr bool last = (LAYER == DEPTH - 1);
    LAS unsigned char* ring = F.lds;
    const LAS int* tpre = (const LAS int*)(F.lds + TPRE_OFF); const LAS int* lcnt = (const LAS int*)(F.lds + LCNT_OFF);
    float* H = WSP(float, WS_H); const float* MOD = WSP(float, WS_MOD); const bf16_t* AX = WSP(bf16_t, WS_AX);
    const float* gate1 = MOD + (size_t)layer * 33 * 6144 + 2 * D;
    constexpr int nMall = last ? NX / 256 : NT / 256;
    if (RUN()) phase_norm1(F, A, layer);
    SEAM();
    if constexpr (kind == 0) {
        if (RUN()) for (int rep_ = 0; rep_ < REPN(1); ++rep_) {
            { pg8::ProbDense P; P.A = AX; P.Bt = WSP(bf16_t, WS_WQK) + (size_t)j * 1280 * D; P.lda = D; P.ldb = D; P.K = D; P.a_pn_off = 0; P.ord.init(NT / 256, 5, F.G, F.c);
              EpiQK E{WSP(bf16_t, WS_Q), WSP(bf16_t, WS_K), WSP(float, WS_BQK) + j * 1280, WSP(float, WS_ROPEC), WSP(float, WS_ROPES)};
              pg8::gemm_phase(ring, P, E); }
            { pg8::ProbDense P; P.A = WSP(bf16_t, WS_WV) + (size_t)j * 256 * D; P.Bt = AX; P.lda = D; P.ldb = D; P.K = D; P.a_pn_off = 0; P.ord.init(1, NT / 256, F.G, F.c);
              EpiVT E{WSP(bf16_t, WS_VT), A.in[I_ABQKV] + j * 1536 + 1280};
              pg8::gemm_phase(ring, P, E); }
        }
        SEAM();
        if (RUN()) for (int rep_ = 0; rep_ < REPN(2); ++rep_) phase_attn(F, A, j, !last);
        SEAM();
        if (RUN() && !((SKIPMASK >> layer) & 1)) { pg8::ProbDense P; P.A = WSP(bf16_t, WS_O); P.Bt = WSP(bf16_t, WS_WO) + (size_t)j * D * D; P.lda = D; P.ldb = D; P.K = D; P.a_pn_off = 0; P.ord.init(nMall, 4, F.G, F.c);
            EpiResid E{H, A.in[I_ABO] + j * D, nullptr, gate1};
            pg8::gemm_phase(ring, P, E); }
        SEAM();
    } else if constexpr (kind == 1) {
        if (RUN()) for (int rep_ = 0; rep_ < REPN(3); ++rep_) phase_pooldiff(F);
        SEAM();
        if (RUN() && !((SKIPMASK >> layer) & 1)) { pg8::ProbDense P; P.A = WSP(bf16_t, WS_PD); P.Bt = WSP(bf16_t, WS_POOLW); P.lda = D; P.ldb = 256; P.K = 256; P.a_pn_off = 256; P.ord.init(nMall, 4, F.G, F.c);
            EpiResid E{H, A.in[I_PB], A.in[I_PS], gate1};
            pg8::gemm_phase(ring, P, E); }
        SEAM();
    } else {
        if (RUN()) for (int rep_ = 0; rep_ < REPN(4); ++rep_) phase_rwkv_mix(F, A);
        SEAM();
        if (RUN()) for (int rep_ = 0; rep_ < REPN(5); ++rep_) {
            for (int i = 0; i < 3; ++i) { const int sel = i == 0 ? 0 : i == 1 ? 2 : 3;
                pg8::ProbDense P; P.A = WSP(bf16_t, WS_A6) + (size_t)sel * NT * D; P.Bt = WSP(bf16_t, WS_WRKV) + (size_t)i * D * D; P.lda = D; P.ldb = D; P.K = D; P.a_pn_off = 0; P.ord.init(NT / 256, 4, F.G, F.c);
                EpiBf16Act E{WSP(bf16_t, WS_RKV) + (size_t)i * NT * D, D, nullptr, 0, 1.0f};
                pg8::gemm_phase(ring, P, E); }
            for (int i = 0; i < 3; ++i) { const int sel = i == 0 ? 5 : i == 1 ? 1 : 4;
                pg8::ProbDense P; P.A = WSP(bf16_t, WS_A6) + (size_t)sel * NT * D; P.Bt = WSP(bf16_t, WS_WL1) + (size_t)i * 256 * D; P.lda = D; P.ldb = D; P.K = D; P.a_pn_off = 0; P.ord.init(NT / 256, 1, F.G, F.c);
                EpiBf16Act E{WSP(bf16_t, WS_LORA) + i * 256, 768, nullptr, i == 0 ? 1 : i == 1 ? 2 : 0, 1.0f};
                pg8::gemm_phase(ring, P, E); }
        }
        SEAM();
        if (RUN()) for (int rep_ = 0; rep_ < REPN(6); ++rep_) {
            for (int i = 0; i < 5; ++i) {
                const int ablk = i == 0 ? 0 : i < 3 ? 1 : 2, d = (i - 1) & 1;
                pg8::ProbDense P; P.A = WSP(bf16_t, WS_LORA) + ablk * 256; P.Bt = WSP(bf16_t, WS_WL2) + (size_t)i * D * 256; P.lda = 768; P.ldb = 256; P.K = 256; P.a_pn_off = 0; P.ord.init(NT / 256, 4, F.G, F.c);
                EpiBf16Act E; E.ldc = D;
                if (i == 0) { E.O = WSP(bf16_t, WS_G); E.bias = nullptr; E.act = 0; E.scale = 1.0f; }
                else if (i < 3) { E.O = WSP(bf16_t, WS_E) + (size_t)d * NT * D; E.bias = A.in[I_RW0] + d * D; E.act = 1; E.scale = 0.6065306597126334f; }
                else { E.O = WSP(bf16_t, WS_A) + (size_t)d * NT * D; E.bias = A.in[I_RA0] + d * D; E.act = 1; E.scale = 1.0f; }
                pg8::gemm_phase(ring, P, E); }
        }
        SEAM();
        if (RUN()) for (int rep_ = 0; rep_ < REPN(7); ++rep_) phase_rwkv_scan(F, A);
        SEAM();
        if (RUN()) for (int rep_ = 0; rep_ < REPN(8); ++rep_) phase_rwkv_out(F, A, last ? NX : NT);
        SEAM();
        if (RUN() && !((SKIPMASK >> layer) & 1)) { pg8::ProbDense P; P.A = WSP(bf16_t, WS_RO); P.Bt = WSP(bf16_t, WS_WOR); P.lda = D; P.ldb = D; P.K = D; P.a_pn_off = 0; P.ord.init(nMall, 4, F.G, F.c);
            EpiResid E{H, nullptr, nullptr, gate1};
            pg8::gemm_phase(ring, P, E); }
        SEAM();
    }
    if (RUN()) phase_route(F, A, layer);
    SEAM();
    if (RUN()) for (int rep_ = 0; rep_ < REPN(9); ++rep_) { moe_tiles(F, layer);
        ProbMoe1 P; P.FX = WSP(fp8_t, WS_FX); P.W1T = WSP(fp8_t, WS_W1T) + (size_t)layer * NE * 2048 * D; P.list = WSP(int, WS_LIST); P.tpre = tpre; P.cnt = lcnt; P.scale_w = SCALE_W; P.scale_x = SCALE_ONE; P.ord.init(tpre[NE], 8, F.G, F.c);
        EpiMoe1 E{WSP(unsigned char, WS_ACT), A.in[I_MB1] + (size_t)layer * NE * 2048};
        pg8::gemm_phase(ring, P, E); }
    SEAM();
    if (RUN()) for (int rep_ = 0; rep_ < REPN(10); ++rep_) { moe_tiles(F, layer);
        ProbMoe2 P; P.ACT = WSP(fp8_t, WS_ACT); P.W2T = WSP(fp8_t, WS_W2T) + (size_t)layer * NE * D * D; P.tpre = tpre; P.scale_w = SCALE_W; P.scale_x = SCALE_ONE; P.ord.init(tpre[NE], 4, F.G, F.c);
        EpiMoe2 E{WSP(bf16_t, WS_Y), A.in[I_MB2] + (size_t)layer * NE * D};
        pg8::gemm_phase(ring, P, E); }
    SEAM();
}
__global__ void __launch_bounds__(NTHREADS, 2) trunk_fwd(Args A) {
    extern __shared__ __attribute__((aligned(16))) unsigned char lds_[];
    Frame F; F.lds = (LAS unsigned char*)lds_; REFRESH(F); F.wave = __builtin_amdgcn_readfirstlane(F.tid >> 6);
    F.G = gridDim.x; F.c = blockIdx.x; F.ws = A.ws; F.ctl = (unsigned*)(A.ws + WS_CTL);
    for (int u = F.tid; u < (LDS_BYTES - LDSCTL_OFF) / 4; u += NTHREADS) ((LAS unsigned*)(F.lds + LDSCTL_OFF))[u] = 0u;
    __syncthreads();
    KState KS; KS.bar.bar = F.ctl + CW_BAR; KS.bar.x = 0; KS.bar.st = nullptr; KS.ph = 0;
    if (A.one) KS.bar = xcd_barrier_post(F.ctl + CW_BAR, (volatile LAS unsigned*)(F.lds + MISC_OFF) + 8);
    if (RUN()) for (int rep_ = 0; rep_ < REPN(0); ++rep_) phase_prologue(F, A);
    SEAM();
    layer_body<0>(F, A, KS);
    layer_body<1>(F, A, KS);
    layer_body<2>(F, A, KS);
    layer_body<3>(F, A, KS);
    if (RUN()) phase_final(F, A);
}
#undef RUN
#undef SEAM
static int count_phases() { int n = 1; for (int layer = 0; layer < DEPTH; ++layer) { const int kind = layer % 3; n += 1 + (kind == 0 ? 3 : kind == 1 ? 2 : 6) + 3; } return n + 1; }

extern "C" void kernel_launch(void* const* d_in, const int* in_sizes, int n_in, void* d_out, int out_size, void* d_ws, size_t ws_size, hipStream_t stream) {
    static int grid = 0;
    if (grid == 0) {
        if (n_in != 38 || out_size != NX * D || ws_size < WS_END) { fprintf(stderr, "kernel_launch: unexpected problem (n_in %d, out %d, ws %zu < %zu)\n", n_in, out_size, ws_size, (size_t)WS_END); grid = -1; return; }
        int dev = 0, cus = 0;
        if (hipGetDevice(&dev) != hipSuccess || hipDeviceGetAttribute(&cus, hipDeviceAttributeMultiprocessorCount, dev) != hipSuccess) { grid = -1; return; }
        if (hipFuncSetAttribute((const void*)trunk_fwd, hipFuncAttributeMaxDynamicSharedMemorySize, LDS_BYTES) != hipSuccess) { fprintf(stderr, "kernel_launch: hipFuncSetAttribute failed\n"); grid = -1; return; }
        int per_cu = 0;
        if (hipOccupancyMaxActiveBlocksPerMultiprocessor(&per_cu, (const void*)trunk_fwd, NTHREADS, LDS_BYTES) != hipSuccess || per_cu < 1) fprintf(stderr, "kernel_launch: occupancy query says %d\n", per_cu);
        (void)hipGetLastError();
        grid = cus;
        if (grid != 256) fprintf(stderr, "kernel_launch: %d CUs (built for 256)\n", grid);
    }
    if (grid < 0) return;
    (void)hipMemsetAsync((char*)d_ws + WS_CTL, 0, CTL_BYTES, stream);
    (void)hipMemsetAsync((char*)d_ws + WS_LZERO, 0, LZERO_BYTES, stream);
    Args a{};
    for (int i = 0; i < 38; ++i) a.in[i] = (const float*)d_in[i];
    a.out = (float*)d_out; a.ws = (unsigned char*)d_ws;
#if MK_ONE_LAUNCH
    a.phase = 0; a.one = 1;
    hipLaunchKernelGGL(trunk_fwd, dim3(grid), dim3(NTHREADS), LDS_BYTES, stream, a);
#else
    const int nph = count_phases();
    for (int p = 0; p < nph; ++p) { a.phase = p; a.one = 0; hipLaunchKernelGGL(trunk_fwd, dim3(grid), dim3(NTHREADS), LDS_BYTES, stream, a); }
#endif
}
```

```cpp
#include <hip/hip_runtime.h>
#include <cstdio>
#include <cstdint>

#ifndef MK_ONE_LAUNCH
#define MK_ONE_LAUNCH 1
#endif
#ifndef REPMASK
#define REPMASK 0x000
#endif
#define REPN(k) (1 + ((REPMASK >> (k)) & 1))
#ifndef DIAG
#define DIAG 0
#endif
#ifndef SKIPMASK
#define SKIPMASK 0x00
#endif

#define LAS __attribute__((address_space(3)))
#define GAS __attribute__((address_space(1)))
typedef unsigned short bf16_t;
typedef short bf16x8 __attribute__((ext_vector_type(8)));
typedef float f32x4 __attribute__((ext_vector_type(4)));
typedef float f32x2 __attribute__((ext_vector_type(2)));
typedef unsigned u32x4 __attribute__((ext_vector_type(4)));
typedef unsigned u32x2 __attribute__((ext_vector_type(2)));

constexpr int D = 1024, NB = 32, T = 2048, L = 256, DEPTH = 4;
constexpr int NX = NB * T, NC = NB * L, NT = NX + NC;
constexpr int NE = 32, TOPK = 4;
constexpr int NWAVES = 8, NTHREADS = 512;
constexpr int MAXRT = NT * TOPK / 256 + NE;

constexpr size_t MiB = 1u << 20;
constexpr size_t WS_CTL = 0, CTL_BYTES = 4 * MiB;
constexpr size_t WS_MOD = 4 * MiB;
constexpr size_t WS_ROPEC = 8 * MiB, WS_ROPES = 8 * MiB + 512 * 1024;
constexpr size_t WS_BQK = 9 * MiB;
constexpr size_t WS_WQK = 10 * MiB;
constexpr size_t WS_WV = 15 * MiB;
constexpr size_t WS_WO = 16 * MiB;
constexpr size_t WS_POOLW = 20 * MiB;
constexpr size_t WS_WRKV = 21 * MiB;
constexpr size_t WS_WOR = 27 * MiB;
constexpr size_t WS_WL1 = 30 * MiB;
constexpr size_t WS_WL2 = 32 * MiB;
constexpr size_t WS_LZERO = WS_WL1, LZERO_BYTES = 6 * MiB;
constexpr size_t WS_W1T = 40 * MiB;
constexpr size_t WS_W2T = 552 * MiB;
constexpr size_t WS_H = 808 * MiB;
constexpr size_t WS_AX = 1096 * MiB;
constexpr size_t WS_FX = 1240 * MiB;
constexpr size_t WS_R = 1384 * MiB;
constexpr size_t WS_ACT = WS_R;
constexpr size_t WS_Y = WS_R + 592 * MiB;
constexpr size_t WS_LIST = WS_R + 1184 * MiB;
constexpr size_t WS_POS = WS_R + 1193 * MiB;
constexpr size_t WS_GATE = WS_R + 1195 * MiB;
constexpr size_t WS_Q = WS_R;
constexpr size_t WS_K = WS_R + 144 * MiB;
constexpr size_t WS_VT = WS_R + 180 * MiB;
constexpr size_t WS_O = WS_R + 216 * MiB;
constexpr size_t WS_PD = WS_R;
constexpr size_t WS_A6 = WS_R;
constexpr size_t WS_E = WS_R;
constexpr size_t WS_A = WS_R + 288 * MiB;
constexpr size_t WS_RO = WS_R + 576 * MiB;
constexpr size_t WS_RKV = WS_R + 864 * MiB;
constexpr size_t WS_LORA = WS_R + 1296 * MiB;
constexpr size_t WS_G = WS_R + 1404 * MiB;
constexpr size_t WS_YS = WS_R + 1548 * MiB;
constexpr size_t WS_BONUS = WS_R + 2124 * MiB;
constexpr size_t WS_END = WS_R + 2134 * MiB;

constexpr int CW_BAR = 4096;
constexpr int CW_GCNT = 16384;
constexpr int LDS_BYTES = 147456;
constexpr int RING_BYTES = 131072;
constexpr int LDSCTL_OFF = 135168;
constexpr int MISC_OFF = LDSCTL_OFF;
constexpr int TPRE_OFF = LDSCTL_OFF + 256;
constexpr int LCNT_OFF = LDSCTL_OFF + 512;
constexpr int LBASE_OFF = LDSCTL_OFF + 768;
constexpr int REC_OFF = LDSCTL_OFF + 1024;
constexpr int JOB_OFF = LDSCTL_OFF + 1024;

__device__ __forceinline__ unsigned f2bf(float f) { unsigned u = __builtin_bit_cast(unsigned, f); return (u + 0x7fffu + ((u >> 16) & 1u)) >> 16; }
__device__ __forceinline__ unsigned pk2(float lo, float hi) { return f2bf(lo) | (f2bf(hi) << 16); }
__device__ __forceinline__ float bflo(unsigned w) { return __builtin_bit_cast(float, w << 16); }
__device__ __forceinline__ float bfhi(unsigned w) { return __builtin_bit_cast(float, w & 0xffff0000u); }
__device__ __forceinline__ float bf1(bf16_t b) { return __builtin_bit_cast(float, ((unsigned)b) << 16); }
__device__ __forceinline__ unsigned pk4_fp8(float a, float b, float c, float d) { int w = __builtin_amdgcn_cvt_pk_fp8_f32(a, b, 0, false); w = __builtin_amdgcn_cvt_pk_fp8_f32(c, d, w, true); return (unsigned)w; }
typedef __bf16 bf16x2_t __attribute__((ext_vector_type(2)));
__device__ __forceinline__ unsigned cvt_pk_bf16(float lo, float hi) { const f32x2 v = {lo, hi}; return __builtin_bit_cast(unsigned, __builtin_convertvector(v, bf16x2_t)); }
__device__ __forceinline__ float dpp_add(float v, const int ctrl, const int row_mask) {
    switch (ctrl) {
    case 0xB1:  return v + __builtin_bit_cast(float, __builtin_amdgcn_update_dpp(0, __builtin_bit_cast(int, v), 0xB1, 0xf, 0xf, true));
    case 0x4E:  return v + __builtin_bit_cast(float, __builtin_amdgcn_update_dpp(0, __builtin_bit_cast(int, v), 0x4E, 0xf, 0xf, true));
    case 0x141: return v + __builtin_bit_cast(float, __builtin_amdgcn_update_dpp(0, __builtin_bit_cast(int, v), 0x141, 0xf, 0xf, true));
    case 0x140: return v + __builtin_bit_cast(float, __builtin_amdgcn_update_dpp(0, __builtin_bit_cast(int, v), 0x140, 0xf, 0xf, true));
    case 0x142: return v + __builtin_bit_cast(float, __builtin_amdgcn_update_dpp(0, __builtin_bit_cast(int, v), 0x142, 0xa, 0xf, true));
    default:    return v + __builtin_bit_cast(float, __builtin_amdgcn_update_dpp(0, __builtin_bit_cast(int, v), 0x143, 0xc, 0xf, true));
    }
}
__device__ __forceinline__ float row16_sum(float v) { v = dpp_add(v, 0xB1, 0xf); v = dpp_add(v, 0x4E, 0xf); v = dpp_add(v, 0x141, 0xf); v = dpp_add(v, 0x140, 0xf); return v; }
__device__ __forceinline__ float wave_sum(float v) {
    v = row16_sum(v); v = dpp_add(v, 0x142, 0xa); v = dpp_add(v, 0x143, 0xc);
    return __builtin_bit_cast(float, __builtin_amdgcn_readlane(__builtin_bit_cast(int, v), 63));
}
__device__ __forceinline__ float sigmoidf_(float x) { return __builtin_amdgcn_rcpf(1.0f + __builtin_amdgcn_exp2f(-1.4426950408889634f * x)); }
__device__ __forceinline__ int opaque_tid() { int t; asm volatile("v_mov_b32 %0, %1" : "=v"(t) : "v"(threadIdx.x)); return t; }
#define REFRESH(F) do { (F).tid = opaque_tid(); (F).lane = (F).tid & 63; } while (0)
__device__ __forceinline__ void seq_of(int row, int& sb, int& t, int& n) { if (row < NX) { sb = row & ~(T - 1); t = row & (T - 1); n = T; } else { const int r2 = row - NX; sb = NX + (r2 & ~(L - 1)); t = r2 & (L - 1); n = L; } }
__device__ __forceinline__ f32x4 ld_bf4(const bf16_t* p) { const u32x2 w = *(const u32x2*)p; return (f32x4){bflo(w.x), bfhi(w.x), bflo(w.y), bfhi(w.y)}; }
__device__ __forceinline__ void st_bf4(bf16_t* p, f32x4 v) { u32x2 w; w.x = pk2(v.x, v.y); w.y = pk2(v.z, v.w); *(u32x2*)p = w; }

#define LDS_WAIT() asm volatile("s_waitcnt lgkmcnt(0)" ::: "memory")
#define VM_WAIT() asm volatile("s_waitcnt vmcnt(0)" ::: "memory")

#define XB_TMO      128
#define XB_XCNT(j)  (256  + 64 * (j))
#define XB_XSUB(j)  (1280 + 64 * (j))
#define XB_XGEN(j)  (2304 + 64 * (j))
#define XB_TOP      3328
#define XB_TOPGEN   3392
#define XCD_BAR_WORDS 3456
#define XB_SPIN_CAP (1u << 18)
__device__ __forceinline__ unsigned xb_ld(unsigned* p)              { return __hip_atomic_load(p, __ATOMIC_RELAXED, __HIP_MEMORY_SCOPE_AGENT); }
__device__ __forceinline__ unsigned xb_add(unsigned* p, unsigned v) { return __hip_atomic_fetch_add(p, v, __ATOMIC_RELAXED, __HIP_MEMORY_SCOPE_AGENT); }
__device__ __forceinline__ unsigned xb_xcc_id() { return (unsigned)__builtin_amdgcn_s_getreg((3 << 11) | 20) & 0xFu; }
#define XB_SPIN(cond, bar) do { unsigned _sp = 0; while (cond) { __builtin_amdgcn_s_sleep(1); \
    if ((++_sp & 255u) == 0u) { if (xb_ld(&(bar)[XB_TMO])) break; if (_sp > XB_SPIN_CAP) { atomicAdd(&(bar)[XB_TMO], 1u); break; } } } } while (0)
struct XcdBarrier { unsigned* bar; unsigned x; volatile LAS unsigned* st; };
__device__ __forceinline__ XcdBarrier xcd_barrier_post(unsigned* bar, volatile LAS unsigned* st) {
    XcdBarrier b; b.bar = bar; b.x = xb_xcc_id(); b.st = st;
    if (threadIdx.x == 0) (void)xb_add(&bar[XB_XCNT(b.x)], 1u);
    return b;
}
__device__ __forceinline__ void xcd_barrier_complete(unsigned* bar, unsigned x, unsigned& nloc, unsigned& nx) {
    const unsigned G = gridDim.x * gridDim.y * gridDim.z;
    unsigned sum, cnt, mine, sp = 0u;
    for (;;) {
        sum = 0u; cnt = 0u; mine = 0u;
#pragma unroll
        for (unsigned j = 0; j < 16; ++j) { const unsigned c = xb_ld(&bar[XB_XCNT(j)]); sum += c; cnt += (c > 0u) ? 1u : 0u; mine = (j == x) ? c : mine; }
        if (sum == G) break;
        __builtin_amdgcn_s_sleep(1);
        if ((++sp & 255u) == 0u) { if (xb_ld(&bar[XB_TMO])) break; if (sp > XB_SPIN_CAP) { atomicAdd(&bar[XB_TMO], 1u); break; } }
    }
    nloc = mine > 0u ? mine : 1u; nx = cnt > 0u ? cnt : 1u;
}
__device__ __forceinline__ void xcd_barrier(const XcdBarrier& b) {
    asm volatile("s_waitcnt vmcnt(0)" ::: "memory");
    __syncthreads();
    if (threadIdx.x == 0) {
        unsigned* bar = b.bar;
        __builtin_amdgcn_s_waitcnt(0);
        unsigned nloc = b.st[0], nx = b.st[1];
        if (nloc == 0u) { xcd_barrier_complete(bar, b.x, nloc, nx); b.st[0] = nloc; b.st[1] = nx; }
        const unsigned old = xb_add(&bar[XB_XSUB(b.x)], 1u);
        const unsigned gen = old / nloc;
        if (old + 1u == (gen + 1u) * nloc) {
            __builtin_amdgcn_fence(__ATOMIC_RELEASE, "agent");
            asm volatile("s_waitcnt vmcnt(0)" ::: "memory");
            const unsigned og = xb_add(&bar[XB_TOP], 1u);
            const unsigned tg = og / nx;
            if (og + 1u == (tg + 1u) * nx) xb_add(&bar[XB_TOPGEN], 1u);
            else XB_SPIN(xb_ld(&bar[XB_TOPGEN]) == tg, bar);
            __builtin_amdgcn_fence(__ATOMIC_ACQUIRE, "agent");
            xb_add(&bar[XB_XGEN(b.x)], 1u);
            asm volatile("s_waitcnt vmcnt(0)" ::: "memory");
        } else {
            XB_SPIN(xb_ld(&bar[XB_XGEN(b.x)]) == gen, bar);
            __builtin_amdgcn_fence(__ATOMIC_ACQUIRE, "agent");
            asm volatile("s_waitcnt vmcnt(0)" ::: "memory");
        }
    }
    __syncthreads();
}

namespace pg8 {
constexpr int BM = 256, BK = 64, HALF = 128, HTB = HALF * BK * 2, STAGE_BYTES = 8 * HTB, NXCD = 8, WGM = 8;
__host__ __device__ __forceinline__ int lds_byte(int r, int c) { const int st = (r >> 4) * 2 + (c >> 5), rr = r & 15, cc = c & 31, ob = rr * 64 + cc * 2; return st * 1024 + (ob ^ (((ob >> 9) & 1) << 5)); }
__host__ __device__ __forceinline__ void stage_rc(int b, int& R, int& C) { const int st = b / 1024, sb = b % 1024, swz = sb ^ (((sb >> 9) & 1) << 5); R = (st >> 1) * 16 + swz / 64; C = (st & 1) * 32 + (swz % 64) / 2; }
__host__ __device__ __forceinline__ int perm32(int rho) { const int n = rho >> 4, i = rho & 15; return 8 * (i >> 2) + 4 * n + (i & 3); }

typedef int i32x8 __attribute__((ext_vector_type(8)));
typedef int i32x4 __attribute__((ext_vector_type(4)));
__device__ __forceinline__ i32x8 cat8(bf16x8 lo, bf16x8 hi) { const i32x4 a = __builtin_bit_cast(i32x4, lo), b = __builtin_bit_cast(i32x4, hi); return __builtin_shufflevector(a, b, 0, 1, 2, 3, 4, 5, 6, 7); }
struct Unit { int pm, pn, e, rt; };
struct TileOrder {
    int nM, nN, nwg, G, c;
    __device__ __forceinline__ void init(int nM_, int nN_, int G_, int c_) { nM = nM_; nN = nN_; nwg = nM * nN; G = G_; c = c_; }
    __device__ __forceinline__ bool next(int i, int& pm, int& pn) const {
        const long Lx = (long)i * G + c; if (Lx >= nwg) return false;
        int wgid = (int)Lx; { const int q = nwg / NXCD, r = nwg % NXCD, xcd = wgid % NXCD, off = wgid / NXCD; wgid = (xcd < r ? xcd * (q + 1) : r * (q + 1) + (xcd - r) * q) + off; }
        const int nig = WGM * nN, gid = wgid / nig, fm = gid * WGM, gsz = (nM - fm) < WGM ? (nM - fm) : WGM;
        pm = fm + ((wgid % nig) % gsz); pn = (wgid % nig) / gsz; return true;
    }
};
struct ProbDense {
    static constexpr bool FP8 = false;
    const bf16_t* A; const bf16_t* Bt; int lda, ldb, K, a_pn_off; TileOrder ord;
    __device__ __forceinline__ int ldb_bytes() const { return ldb * 2; }
    __device__ __forceinline__ int ntiles() const { return K / 64; }
    __device__ __forceinline__ bool next(int i, Unit& u) const { u.e = 0; const bool ok = ord.next(i, u.pm, u.pn); u.rt = u.pm; return ok; }
    __device__ __forceinline__ const char* a_ptr(const Unit& u) const { return (const char*)(A + (size_t)u.pm * BM * lda + (size_t)u.pn * a_pn_off); }
    __device__ __forceinline__ const char* b_ptr(const Unit& u) const { return (const char*)(Bt + (size_t)u.pn * BM * ldb); }
    __device__ __forceinline__ void a_off(const Unit&, const int (&R)[2], const int (&C)[2], unsigned (&v)[2][2]) const {
#pragma unroll
        for (int h = 0; h < 2; ++h)
#pragma unroll
            for (int i = 0; i < 2; ++i) v[h][i] = (unsigned)((h * HALF + R[i]) * lda + C[i]) * 2u;
    }
};

template <class Prob, class Epi>
__device__ __forceinline__ void gemm_phase(LAS unsigned char* lds, const Prob& P, const Epi& E) {
    const int tid = opaque_tid(), wid = __builtin_amdgcn_readfirstlane(tid >> 6), lane = tid & 63, wr = wid >> 2, wc = wid & 3, fr = lane & 15, fq = lane >> 4;
    const int nt = P.ntiles(); const int ldbB = P.ldb_bytes();
    int Rr[2], Cc[2]; unsigned voffB[2];
#pragma unroll
    for (int i = 0; i < 2; ++i) { int R, C; stage_rc(tid * 16 + i * 8192, R, C); Rr[i] = R; Cc[i] = C; const int Rb = Epi::PERM ? ((R & ~31) + perm32(R & 31)) : R;
        voffB[i] = (unsigned)(Rb * ldbB + C * 2); }
    const size_t kstep = (size_t)(BK * 2);
    const size_t hstepB = (size_t)HALF * ldbB;
    const unsigned ldsw = (unsigned)wid * 1024u;
    const int aoff = lds_byte(wr * 64 + fr, fq * 8), boff = lds_byte(wc * 32 + fr, fq * 8);
#define PG8_SA(b, h) (((b) * 2 + (h)) * HTB)
#define PG8_SB(b, h) ((4 + (b) * 2 + (h)) * HTB)
#define PG8_STAGE(bufoff, gbase, voff) do { _Pragma("unroll") for (int _i = 0; _i < 2; ++_i) \
        __builtin_amdgcn_global_load_lds((const unsigned*)((const char*)(gbase) + (voff)[_i]), (LAS unsigned*)(lds + (bufoff) + ldsw + _i * 8192), 16, 0, 0); } while (0)
#define PG8_LDA(dst, b, h) do { _Pragma("unroll") for (int m = 0; m < 4; ++m) _Pragma("unroll") for (int k = 0; k < 2; ++k) dst[m][k] = *(const LAS bf16x8*)(lds + PG8_SA(b, h) + aoff + m * 2048 + k * 1024); } while (0)
#define PG8_LDB(dst, b, h) do { _Pragma("unroll") for (int n = 0; n < 2; ++n) _Pragma("unroll") for (int k = 0; k < 2; ++k) dst[n][k] = *(const LAS bf16x8*)(lds + PG8_SB(b, h) + boff + n * 2048 + k * 1024); } while (0)
#define PG8_MMA(ai, bj, At, Bt) do { __builtin_amdgcn_s_setprio(1); _Pragma("unroll") for (int m = 0; m < 4; ++m) _Pragma("unroll") for (int n = 0; n < 2; ++n) { \
        if constexpr (Prob::FP8) { asm volatile("v_mfma_scale_f32_16x16x128_f8f6f4 %0, %1, %2, %0, %3, %4 op_sel_hi:[0,0,0]" : "+v"(acc[ai][bj][m][n]) : "v"(cat8(Bt[n][0], Bt[n][1])), "v"(cat8(At[m][0], At[m][1])), "v"(sc_w), "v"(sc_x)); } \
        else { _Pragma("unroll") for (int k = 0; k < 2; ++k) acc[ai][bj][m][n] = __builtin_amdgcn_mfma_f32_16x16x32_bf16(Bt[n][k], At[m][k], acc[ai][bj][m][n], 0, 0, 0); } } __builtin_amdgcn_s_setprio(0); } while (0)
#define PG8_WAIT_V(n) asm volatile("s_waitcnt vmcnt(" #n ")" ::: "memory")
#define PG8_WAIT_L(n) asm volatile("s_waitcnt lgkmcnt(" #n ")" ::: "memory")
#define PG8_BAR __builtin_amdgcn_s_barrier()
#define PG8_SCHED __builtin_amdgcn_sched_barrier(0)
    Unit cur, nxt; int ui = 0;
    if (!P.next(0, cur)) return;
    int sc_w = 0, sc_x = 0; if constexpr (Prob::FP8) { sc_w = P.scale_w; sc_x = P.scale_x; } (void)sc_w; (void)sc_x;
    f32x4 acc[2][2][4][2];
#pragma unroll
    for (int a = 0; a < 2; ++a)
#pragma unroll
        for (int b = 0; b < 2; ++b)
#pragma unroll
            for (int m = 0; m < 4; ++m)
#pragma unroll
                for (int n = 0; n < 2; ++n) acc[a][b][m][n] = (f32x4){0.f, 0.f, 0.f, 0.f};
    bf16x8 At[4][2], B0[2][2], B1[2][2];
    unsigned vAc[2][2], vAn[2][2];
    P.a_off(cur, Rr, Cc, vAc);
    const char* cA = P.a_ptr(cur); const char* cB = P.b_ptr(cur);
    PG8_STAGE(PG8_SB(0, 0), cB, voffB); PG8_STAGE(PG8_SB(0, 1), cB + hstepB, voffB); PG8_STAGE(PG8_SA(0, 0), cA, vAc[0]); PG8_STAGE(PG8_SA(0, 1), cA, vAc[1]);
    if (wr == 1) PG8_BAR;
    PG8_WAIT_V(2); PG8_BAR;
    PG8_STAGE(PG8_SB(1, 0), cB + kstep, voffB); PG8_STAGE(PG8_SA(1, 0), cA + kstep, vAc[0]); PG8_STAGE(PG8_SB(1, 1), cB + hstepB + kstep, voffB);
    PG8_WAIT_V(6); PG8_BAR;
    for (;;) {
        const bool has_next = P.next(ui + 1, nxt);
        const char* nA = cA; const char* nB = cB;
#pragma unroll
        for (int h = 0; h < 2; ++h)
#pragma unroll
            for (int i = 0; i < 2; ++i) vAn[h][i] = vAc[h][i];
        if (has_next) { nA = P.a_ptr(nxt); nB = P.b_ptr(nxt); P.a_off(nxt, Rr, Cc, vAn); }
        for (int t = 0; t < nt; t += 2) {
            const bool last = (t == nt - 2);
            const char* a1 = cA + (size_t)(t + 1) * kstep;
            const char* a2 = last ? nA : cA + (size_t)(t + 2) * kstep; const char* b2 = last ? nB : cB + (size_t)(t + 2) * kstep;
            const char* a3 = a2 + kstep; const char* b3 = b2 + kstep;
            unsigned vX[2][2];
#pragma unroll
            for (int h = 0; h < 2; ++h)
#pragma unroll
                for (int i = 0; i < 2; ++i) vX[h][i] = last ? vAn[h][i] : vAc[h][i];
            PG8_LDB(B0, 0, 0); PG8_LDB(B1, 0, 1); PG8_SCHED; PG8_LDA(At, 0, 0); PG8_STAGE(PG8_SA(1, 1), a1, vAc[1]);
            PG8_WAIT_V(8); PG8_WAIT_L(0); PG8_BAR; PG8_MMA(0, 0, At, B0); PG8_MMA(0, 1, At, B1); PG8_BAR; PG8_SCHED;
            PG8_LDA(At, 0, 1); PG8_STAGE(PG8_SB(0, 0), b2, voffB); PG8_STAGE(PG8_SB(0, 1), b2 + hstepB, voffB); PG8_STAGE(PG8_SA(0, 0), a2, vX[0]);
            PG8_WAIT_V(8); PG8_WAIT_L(0); PG8_BAR; PG8_MMA(1, 0, At, B0); PG8_MMA(1, 1, At, B1); PG8_BAR; PG8_SCHED;
            PG8_LDB(B0, 1, 0); PG8_LDB(B1, 1, 1); PG8_SCHED; PG8_LDA(At, 1, 0); PG8_STAGE(PG8_SA(0, 1), a2, vX[1]);
            PG8_WAIT_V(8); PG8_WAIT_L(0); PG8_BAR; PG8_MMA(0, 0, At, B0); PG8_MMA(0, 1, At, B1); PG8_BAR; PG8_SCHED;
            PG8_LDA(At, 1, 1); PG8_STAGE(PG8_SB(1, 0), b3, voffB); PG8_STAGE(PG8_SB(1, 1), b3 + hstepB, voffB); PG8_STAGE(PG8_SA(1, 0), a3, vX[0]);
            PG8_WAIT_V(8); PG8_WAIT_L(0); PG8_BAR; PG8_MMA(1, 0, At, B0); PG8_MMA(1, 1, At, B1); PG8_BAR; PG8_SCHED;
        }
        if (wr == 0) PG8_BAR;
        if constexpr (Prob::FP8) asm volatile("s_nop 15\n\ts_nop 15" ::: "memory");
        E(acc, cur, wr, wc, fr, fq);
        if (!has_next) break;
#pragma unroll
        for (int a = 0; a < 2; ++a)
#pragma unroll
            for (int b = 0; b < 2; ++b)
#pragma unroll
                for (int m = 0; m < 4; ++m)
#pragma unroll
                    for (int n = 0; n < 2; ++n) acc[a][b][m][n] = (f32x4){0.f, 0.f, 0.f, 0.f};
        cur = nxt; cA = nA; cB = nB; ++ui;
#pragma unroll
        for (int h = 0; h < 2; ++h)
#pragma unroll
            for (int i = 0; i < 2; ++i) vAc[h][i] = vAn[h][i];
        if (wr == 1) PG8_BAR;
    }
    PG8_WAIT_V(0);
    PG8_BAR;
#undef PG8_SA
#undef PG8_SB
#undef PG8_STAGE
#undef PG8_LDA
#undef PG8_LDB
#undef PG8_MMA
#undef PG8_WAIT_V
#undef PG8_WAIT_L
#undef PG8_BAR
#undef PG8_SCHED
}
}

using pg8::Unit;
constexpr int HALF_ = 128;
struct EpiBf16Act {
    static constexpr bool PERM = true;
    bf16_t* O; int ldc; const float* bias; int act; float scale;
    __device__ __forceinline__ void operator()(const f32x4 (&acc)[2][2][4][2], const Unit& u, int wr, int wc, int fr, int fq) const {
        const int row0 = u.pm * 256 + wr * 64 + fr, col0 = u.pn * 256 + wc * 32 + 8 * fq;
        f32x4 bv[2][2];
#pragma unroll
        for (int bj = 0; bj < 2; ++bj)
#pragma unroll
            for (int n = 0; n < 2; ++n) bv[bj][n] = bias ? *(const f32x4*)(bias + col0 + bj * HALF_ + 4 * n) : (f32x4){0.f, 0.f, 0.f, 0.f};
#pragma unroll
        for (int ai = 0; ai < 2; ++ai)
#pragma unroll
            for (int m = 0; m < 4; ++m) { bf16_t* rowp = O + (size_t)(row0 + ai * HALF_ + m * 16) * ldc + col0;
#pragma unroll
                for (int bj = 0; bj < 2; ++bj) { f32x4 v0 = acc[ai][bj][m][0] + bv[bj][0], v1 = acc[ai][bj][m][1] + bv[bj][1];
                    if (act == 1) {
#pragma unroll
                        for (int j = 0; j < 4; ++j) { v0[j] = sigmoidf_(v0[j]) * scale; v1[j] = sigmoidf_(v1[j]) * scale; } }
                    else if (act == 2) {
#pragma unroll
                        for (int j = 0; j < 4; ++j) { v0[j] = 1.0f - 2.0f * __builtin_amdgcn_rcpf(__builtin_amdgcn_exp2f(2.8853900817779268f * v0[j]) + 1.0f); v1[j] = 1.0f - 2.0f * __builtin_amdgcn_rcpf(__builtin_amdgcn_exp2f(2.8853900817779268f * v1[j]) + 1.0f); } }
                    u32x4 w; w.x = cvt_pk_bf16(v0[0], v0[1]); w.y = cvt_pk_bf16(v0[2], v0[3]); w.z = cvt_pk_bf16(v1[0], v1[1]); w.w = cvt_pk_bf16(v1[2], v1[3]);
                    *(u32x4*)(rowp + bj * HALF_) = w; } }
    }
};
struct EpiQK {
    static constexpr bool PERM = true;
    bf16_t* Q; bf16_t* Kb; const float* bias; const float* ropec; const float* ropes;
    __device__ __forceinline__ void operator()(const f32x4 (&acc)[2][2][4][2], const Unit& u, int wr, int wc, int fr, int fq) const {
        int row0 = u.pm * 256 + wr * 64 + fr, cl0 = wc * 32 + 8 * fq;
        asm volatile("" : "+v"(row0), "+v"(cl0));
        const int g = (4 * wc + fq) & 7;
        bf16_t* base; int ldc;
        if (u.pn < 4) { base = Q + u.pn * 256; ldc = 1024; } else { base = Kb; ldc = 256; }
        f32x4 bv[2][2];
#pragma unroll
        for (int bj = 0; bj < 2; ++bj)
#pragma unroll
            for (int n = 0; n < 2; ++n) bv[bj][n] = *(const f32x4*)(bias + u.pn * 256 + cl0 + bj * HALF_ + 4 * n);
#pragma unroll
        for (int ai = 0; ai < 2; ++ai)
#pragma unroll
            for (int m = 0; m < 4; ++m) { const int row = row0 + ai * HALF_ + m * 16; bf16_t* rowp = base + (size_t)row * ldc + cl0;
                f32x4 cs = (f32x4){1.f, 1.f, 1.f, 1.f}, sn = (f32x4){0.f, 0.f, 0.f, 0.f};
                if (row < NX) { const int t = row & (T - 1); cs = *(const f32x4*)(ropec + t * 32 + g * 4); sn = *(const f32x4*)(ropes + t * 32 + g * 4); }
#pragma unroll
                for (int bj = 0; bj < 2; ++bj) { const f32x4 v0 = acc[ai][bj][m][0] + bv[bj][0], v1 = acc[ai][bj][m][1] + bv[bj][1];
                    const f32x4 o0 = v0 * cs - v1 * sn, o1 = v1 * cs + v0 * sn;
                    u32x4 w; w.x = cvt_pk_bf16(o0[0], o0[1]); w.y = cvt_pk_bf16(o0[2], o0[3]); w.z = cvt_pk_bf16(o1[0], o1[1]); w.w = cvt_pk_bf16(o1[2], o1[3]);
                    *(u32x4*)(rowp + bj * HALF_) = w; } }
    }
};
struct EpiVT {
    static constexpr bool PERM = true;
    bf16_t* VT; const float* biasrow;
    __device__ __forceinline__ void operator()(const f32x4 (&acc)[2][2][4][2], const Unit& u, int wr, int wc, int fr, int fq) const {
        int row0 = wr * 64 + fr, col0 = u.pn * 256 + wc * 32 + 8 * fq;
        asm volatile("" : "+v"(row0), "+v"(col0));
#pragma unroll
        for (int ai = 0; ai < 2; ++ai)
#pragma unroll
            for (int m = 0; m < 4; ++m) { const int row = row0 + ai * HALF_ + m * 16; const float b = biasrow[row]; bf16_t* rowp = VT + (size_t)row * NT + col0;
#pragma unroll
                for (int bj = 0; bj < 2; ++bj) { const f32x4 v0 = acc[ai][bj][m][0] + b, v1 = acc[ai][bj][m][1] + b;
                    u32x4 w; w.x = cvt_pk_bf16(v0[0], v0[1]); w.y = cvt_pk_bf16(v0[2], v0[3]); w.z = cvt_pk_bf16(v1[0], v1[1]); w.w = cvt_pk_bf16(v1[2], v1[3]);
                    *(u32x4*)(rowp + bj * HALF_) = w; } }
    }
};
struct EpiResid {
    static constexpr bool PERM = false;
    float* H; const float* bias; const float* ls; const float* gate;
    __device__ __forceinline__ void operator()(const f32x4 (&acc)[2][2][4][2], const Unit& u, int wr, int wc, int fr, int fq) const {
        const int row0 = u.pm * 256 + wr * 64 + fr, col0 = u.pn * 256 + wc * 32 + 4 * fq;
        f32x4 bv[2][2], lv[2][2];
#pragma unroll
        for (int bj = 0; bj < 2; ++bj)
#pragma unroll
            for (int n = 0; n < 2; ++n) { bv[bj][n] = bias ? *(const f32x4*)(bias + col0 + bj * HALF_ + n * 16) : (f32x4){0.f, 0.f, 0.f, 0.f};
                                          lv[bj][n] = ls ? *(const f32x4*)(ls + col0 + bj * HALF_ + n * 16) : (f32x4){1.f, 1.f, 1.f, 1.f}; }
#pragma unroll
        for (int ai = 0; ai < 2; ++ai)
#pragma unroll
            for (int m = 0; m < 4; ++m) { const int row = row0 + ai * HALF_ + m * 16; const int brow = row < NX ? (row >> 11) : 32;
                float* hp = H + (size_t)row * D + col0; const float* gp = gate + (size_t)brow * (6 * D) + col0;
#pragma unroll
                for (int bj = 0; bj < 2; ++bj)
#pragma unroll
                    for (int n = 0; n < 2; ++n) { const f32x4 y = (acc[ai][bj][m][n] + bv[bj][n]) * lv[bj][n]; const f32x4 gv = *(const f32x4*)(gp + bj * HALF_ + n * 16);
                        f32x4 hv = *(const f32x4*)(hp + bj * HALF_ + n * 16); hv = hv + gv * y; *(f32x4*)(hp + bj * HALF_ + n * 16) = hv; }
                asm volatile("" ::: "memory"); }
    }
};
struct EpiMoe1 {
    static constexpr bool PERM = true;
    unsigned char* ACT; const float* b1;
    __device__ __forceinline__ void operator()(const f32x4 (&acc)[2][2][4][2], const Unit& u, int wr, int wc, int fr, int fq) const {
        const int row0 = u.rt * 256 + wr * 64 + fr, cl = u.pn * 128 + wc * 32 + 8 * fq;
        const float* bg = b1 + (size_t)u.e * 2048 + cl; const float* bl = bg + 1024;
        f32x4 bgv[2], blv[2];
#pragma unroll
        for (int n = 0; n < 2; ++n) { bgv[n] = *(const f32x4*)(bg + 4 * n); blv[n] = *(const f32x4*)(bl + 4 * n); }
#pragma unroll
        for (int ai = 0; ai < 2; ++ai)
#pragma unroll
            for (int m = 0; m < 4; ++m) { unsigned char* rowp = ACT + (size_t)(row0 + ai * HALF_ + m * 16) * D + cl;
                f32x4 o[2];
#pragma unroll
                for (int n = 0; n < 2; ++n) { const f32x4 hg = acc[ai][0][m][n] + bgv[n], hl = acc[ai][1][m][n] + blv[n];
#pragma unroll
                    for (int j = 0; j < 4; ++j) { const float gl = fminf(hg[j], 7.0f); const float li = fminf(fmaxf(hl[j], -7.0f), 7.0f);
                        o[n][j] = gl * sigmoidf_(1.702f * gl) * (li + 1.0f); } }
                u32x2 w; w.x = pk4_fp8(o[0][0], o[0][1], o[0][2], o[0][3]); w.y = pk4_fp8(o[1][0], o[1][1], o[1][2], o[1][3]);
                *(u32x2*)rowp = w; }
    }
};
struct EpiMoe2 {
    static constexpr bool PERM = true;
    bf16_t* Y; const float* b2;
    __device__ __forceinline__ void operator()(const f32x4 (&acc)[2][2][4][2], const Unit& u, int wr, int wc, int fr, int fq) const {
        const int row0 = u.rt * 256 + wr * 64 + fr, col0 = u.pn * 256 + wc * 32 + 8 * fq;
        const float* bb = b2 + (size_t)u.e * D + col0;
        f32x4 bv[2][2];
#pragma unroll
        for (int bj = 0; bj < 2; ++bj)
#pragma unroll
            for (int n = 0; n < 2; ++n) bv[bj][n] = *(const f32x4*)(bb + bj * HALF_ + 4 * n);
#pragma unroll
        for (int ai = 0; ai < 2; ++ai)
#pragma unroll
            for (int m = 0; m < 4; ++m) { bf16_t* rowp = Y + (size_t)(row0 + ai * HALF_ + m * 16) * D + col0;
#pragma unroll
                for (int bj = 0; bj < 2; ++bj) { const f32x4 v0 = acc[ai][bj][m][0] + bv[bj][0], v1 = acc[ai][bj][m][1] + bv[bj][1];
                    u32x4 w; w.x = cvt_pk_bf16(v0[0], v0[1]); w.y = cvt_pk_bf16(v0[2], v0[3]); w.z = cvt_pk_bf16(v1[0], v1[1]); w.w = cvt_pk_bf16(v1[2], v1[3]);
                    *(u32x4*)(rowp + bj * HALF_) = w; } }
    }
};
typedef unsigned char fp8_t;
constexpr int SCALE_ONE = 0x7f7f7f7f, SCALE_W = 0x79797979;
struct ProbMoe1 {
    static constexpr bool FP8 = true;
    const fp8_t* FX; const fp8_t* W1T; const int* list; const LAS int* tpre; const LAS int* cnt; int scale_w, scale_x; pg8::TileOrder ord;
    __device__ __forceinline__ int ldb_bytes() const { return D; }
    __device__ __forceinline__ int ntiles() const { return D / 128; }
    __device__ __forceinline__ bool next(int i, Unit& u) const {
        if (!ord.next(i, u.pm, u.pn)) return false;
        u.rt = u.pm; int e = 0;
#pragma unroll 1
        for (int j = 1; j < NE; ++j) e += (tpre[j] <= u.rt) ? 1 : 0;
        u.e = e; return true;
    }
    __device__ __forceinline__ const char* a_ptr(const Unit&) const { return (const char*)FX; }
    __device__ __forceinline__ const char* b_ptr(const Unit& u) const { return (const char*)(W1T + ((size_t)u.e * 2048 + (size_t)u.pn * 256) * D); }
    __device__ __forceinline__ void a_off(const Unit& u, const int (&R)[2], const int (&C)[2], unsigned (&v)[2][2]) const {
        const int base = (u.rt - tpre[u.e]) * 256, ce = cnt[u.e]; const int* le = list + (size_t)u.e * NT;
#pragma unroll
        for (int h = 0; h < 2; ++h)
#pragma unroll
            for (int i = 0; i < 2; ++i) { const int idx = base + h * 128 + R[i]; const int tok = le[idx < ce ? idx : 0]; v[h][i] = (unsigned)(tok * D + C[i] * 2); }
        asm volatile("" : "+v"(v[0][0]), "+v"(v[0][1]), "+v"(v[1][0]), "+v"(v[1][1]));
    }
};
struct ProbMoe2 {
    static constexpr bool FP8 = true;
    const fp8_t* ACT; const fp8_t* W2T; const LAS int* tpre; int scale_w, scale_x; pg8::TileOrder ord;
    __device__ __forceinline__ int ldb_bytes() const { return D; }
    __device__ __forceinline__ int ntiles() const { return D / 128; }
    __device__ __forceinline__ bool next(int i, Unit& u) const {
        if (!ord.next(i, u.pm, u.pn)) return false;
        u.rt = u.pm; int e = 0;
#pragma unroll 1
        for (int j = 1; j < NE; ++j) e += (tpre[j] <= u.rt) ? 1 : 0;
        u.e = e; return true;
    }
    __device__ __forceinline__ const char* a_ptr(const Unit& u) const { return (const char*)(ACT + (size_t)u.rt * 256 * D); }
    __device__ __forceinline__ const char* b_ptr(const Unit& u) const { return (const char*)(W2T + ((size_t)u.e * 1024 + (size_t)u.pn * 256) * D); }
    __device__ __forceinline__ void a_off(const Unit&, const int (&R)[2], const int (&C)[2], unsigned (&v)[2][2]) const {
#pragma unroll
        for (int h = 0; h < 2; ++h)
#pragma unroll
            for (int i = 0; i < 2; ++i) v[h][i] = (unsigned)((h * 128 + R[i]) * D + C[i] * 2);
    }
};
struct Args { const float* in[38]; float* out; unsigned char* ws; int phase; int one; };
enum { I_X = 0, I_C, I_CTX, I_CCTX, I_ADAW, I_ADAB, I_NORMG, I_AWQKV, I_ABQKV, I_AWO, I_ABO, I_ASINK, I_PW, I_PB, I_PS,
       I_RMIX, I_RWRKV, I_RW0, I_RW1, I_RW2, I_RA0, I_RA1, I_RA2, I_RG1, I_RG2, I_RKK, I_RKA, I_RRK, I_RLNW, I_RLNB, I_RWO,
       I_MWR, I_MBR, I_MW1, I_MB1, I_MW2, I_MB2, I_FG };
struct Frame { LAS unsigned char* lds; int tid, lane, wave, G, c; unsigned char* ws; unsigned* ctl; };
#define WSP(T_, off) ((T_*)(F.ws + (off)))

struct TJob { const float* src; unsigned char* dst; long sbs, dbs; int ldw, ldt, nkb, nnb, mode, item0, per, esz; };
__device__ __forceinline__ int dst_row(int mode, int n) {
    if (mode == 1) { const int hb = n & ~63, d = n & 63; const int ax = d >> 5, dd = d & 31, hf = dd >> 4, f = dd & 15; const int g = ax * 4 + (f >> 2), i = (f & 3) + 4 * hf; return hb + 8 * g + i; }
    if (mode == 2) { return n < 1024 ? ((n >> 7) << 8) + (n & 127) : (((n - 1024) >> 7) << 8) + 128 + (n & 127); }
    return n;
}
struct TItem { const float* src; unsigned char* dst; int ldw, ldt, mode, n0, esz; };
__device__ __forceinline__ void titem_decode(const LAS TJob* jobs, int nj, int it, TItem& T) {
    int ji = 0;
    for (int q = 1; q < nj; ++q) ji += (jobs[q].item0 <= it) ? 1 : 0;
    const LAS TJob& J = jobs[ji]; const int r = it - J.item0, bi = r / J.per, rr = r % J.per, kb = rr / J.nnb, nb = rr % J.nnb;
    T.src = J.src + bi * J.sbs + (size_t)(64 * kb) * J.ldw + 32 * nb; T.dst = J.dst + (bi * J.dbs + 64 * kb) * J.esz; T.ldw = J.ldw; T.ldt = J.ldt; T.mode = J.mode; T.n0 = 32 * nb; T.esz = J.esz;
}
__device__ __forceinline__ void titem_load(const TItem& T, int lane, f32x4 (&v)[8]) {
    const float* p = T.src + (size_t)(lane >> 3) * T.ldw + 4 * (lane & 7);
#pragma unroll
    for (int i = 0; i < 8; ++i) v[i] = *(const f32x4*)(p + (size_t)(8 * i) * T.ldw);
}
__device__ __forceinline__ void titem_store(const TItem& T, int lane, const f32x4 (&v)[8], LAS float* scr) {
#pragma unroll
    for (int i = 0; i < 8; ++i) { LAS float* d = scr + (8 * i + (lane >> 3)) * 33 + 4 * (lane & 7); d[0] = v[i].x; d[1] = v[i].y; d[2] = v[i].z; d[3] = v[i].w; }
    LDS_WAIT(); asm volatile("" ::: "memory");
    const int c = lane & 7;
#pragma unroll
    for (int j = 0; j < 4; ++j) { const int n = (lane >> 3) + 8 * j; const LAS float* s = scr + (8 * c) * 33 + n;
        const size_t eo = (size_t)dst_row(T.mode, T.n0 + n) * T.ldt + 8 * c;
        if (T.esz == 2) { u32x4 o; o.x = pk2(s[0 * 33], s[1 * 33]); o.y = pk2(s[2 * 33], s[3 * 33]); o.z = pk2(s[4 * 33], s[5 * 33]); o.w = pk2(s[6 * 33], s[7 * 33]); *(u32x4*)(T.dst + eo * 2) = o; }
        else { u32x2 o; o.x = pk4_fp8(64.f * s[0 * 33], 64.f * s[1 * 33], 64.f * s[2 * 33], 64.f * s[3 * 33]); o.y = pk4_fp8(64.f * s[4 * 33], 64.f * s[5 * 33], 64.f * s[6 * 33], 64.f * s[7 * 33]); *(u32x2*)(T.dst + eo) = o; } }
    LDS_WAIT(); asm volatile("" ::: "memory");
}
__device__ __forceinline__ void phase_prologue(Frame& F, const Args& A) {
    REFRESH(F);
    LAS float* S = (LAS float*)F.lds;
    for (int idx = F.tid; idx < 33 * 1024; idx += NTHREADS) { const int r = idx >> 10, k = idx & 1023; const float v = r < 32 ? A.in[I_C][r * 1024 + k] : A.in[I_CCTX][k]; S[k * 33 + r] = v / (1.0f + __expf(-v)); }
    __syncthreads();
    float* MOD = WSP(float, WS_MOD);
    for (int it = F.c; it < 4 * 96; it += F.G) {
        const int layer = it / 96, n = (it % 96) * 64 + F.lane; const float* wp = A.in[I_ADAW] + (size_t)layer * 1024 * 6144 + n;
        float acc[5] = {0.f, 0.f, 0.f, 0.f, 0.f};
        for (int k0 = 0; k0 < 1024; k0 += 32) {
            float wv[32];
#pragma unroll
            for (int u = 0; u < 32; ++u) wv[u] = wp[(size_t)(k0 + u) * 6144];
#pragma unroll
            for (int u = 0; u < 32; ++u) { const LAS float* sr = S + (k0 + u) * 33 + F.wave;
                acc[0] += sr[0] * wv[u]; acc[1] += sr[8] * wv[u]; acc[2] += sr[16] * wv[u]; acc[3] += sr[24] * wv[u]; if (F.wave == 0) acc[4] += S[(k0 + u) * 33 + 32] * wv[u]; }
        }
        const float bb = A.in[I_ADAB][layer * 6144 + n];
#pragma unroll
        for (int i = 0; i < 4; ++i) MOD[((size_t)layer * 33 + F.wave + 8 * i) * 6144 + n] = acc[i] + bb;
        if (F.wave == 0) MOD[((size_t)layer * 33 + 32) * 6144 + n] = acc[4] + bb;
    }
    { float* rc = WSP(float, WS_ROPEC); float* rs = WSP(float, WS_ROPES);
      for (int idx = F.c * NTHREADS + F.tid; idx < 2048 * 32; idx += F.G * NTHREADS) { const int t = idx >> 5, e = idx & 31, g = e >> 2, i = e & 3, f = 4 * (g & 3) + i;
          const float inv = powf(10000.0f, -(float)f / 16.0f); const float pos = (float)(g < 4 ? (t >> 6) : (t & 63)); const float ang = pos * inv; rc[idx] = cosf(ang); rs[idx] = sinf(ang); }
      float* bq = WSP(float, WS_BQK);
      for (int idx = F.c * NTHREADS + F.tid; idx < 2 * 1280; idx += F.G * NTHREADS) { const int j = idx / 1280, n = idx % 1280; bq[j * 1280 + dst_row(1, n)] = A.in[I_ABQKV][j * 1536 + n]; } }
    __syncthreads();
    LAS TJob* jobs = (LAS TJob*)(F.lds + JOB_OFF); LAS int* njobs = (LAS int*)(F.lds + MISC_OFF + 64);
    if (F.tid == 0) {
        int nj = 0, item = 0;
        auto add = [&](const float* src, bf16_t* dst, int ldw, int ldt, int Ks, int Ns, int mode, int nb, long sbs, long dbs, int esz = 2) {
            LAS TJob& j = jobs[nj]; j.src = src; j.dst = (unsigned char*)dst; j.sbs = sbs; j.dbs = dbs; j.ldw = ldw; j.ldt = ldt; j.nkb = Ks / 64; j.nnb = Ns / 32; j.mode = mode; j.item0 = item; j.per = (Ks / 64) * (Ns / 32); j.esz = esz;
            ++nj; item += (Ks / 64) * (Ns / 32) * nb; };
        add(A.in[I_AWQKV], WSP(bf16_t, WS_WQK), 1536, 1024, 1024, 1280, 1, 2, 1024L * 1536, 1280L * 1024);
        add(A.in[I_AWQKV] + 1280, WSP(bf16_t, WS_WV), 1536, 1024, 1024, 256, 0, 2, 1024L * 1536, 256L * 1024);
        add(A.in[I_AWO], WSP(bf16_t, WS_WO), 1024, 1024, 1024, 1024, 0, 2, 1L << 20, 1L << 20);
        add(A.in[I_PW], WSP(bf16_t, WS_POOLW), 256, 256, 256, 256, 0, 4, 65536, 65536);
        add(A.in[I_RWRKV], WSP(bf16_t, WS_WRKV), 1024, 1024, 1024, 1024, 0, 3, 1L << 20, 1L << 20);
        add(A.in[I_RG1], WSP(bf16_t, WS_WL1), 128, 1024, 1024, 128, 0, 1, 0, 0);
        add(A.in[I_RW1], WSP(bf16_t, WS_WL1) + 256 * 1024, 64, 1024, 1024, 64, 0, 2, 65536, 65536);
        add(A.in[I_RA1], WSP(bf16_t, WS_WL1) + 2 * 256 * 1024, 64, 1024, 1024, 64, 0, 2, 65536, 65536);
        add(A.in[I_RG2], WSP(bf16_t, WS_WL2), 1024, 256, 128, 1024, 0, 1, 0, 0);
        add(A.in[I_RW2], WSP(bf16_t, WS_WL2) + 1 * 1024 * 256, 1024, 256, 64, 1024, 0, 2, 65536, 1024L * 256 + 64);
        add(A.in[I_RA2], WSP(bf16_t, WS_WL2) + 3 * 1024 * 256, 1024, 256, 64, 1024, 0, 2, 65536, 1024L * 256 + 64);
        add(A.in[I_RWO], WSP(bf16_t, WS_WOR), 1024, 1024, 1024, 1024, 0, 1, 0, 0);
        add(A.in[I_MW1], WSP(bf16_t, WS_W1T), 2048, 1024, 1024, 2048, 2, 128, 1024L * 2048, 2048L * 1024, 1);
        add(A.in[I_MW2], WSP(bf16_t, WS_W2T), 1024, 1024, 1024, 1024, 0, 128, 1L << 20, 1L << 20, 1);
        njobs[0] = nj; njobs[1] = item;
    }
    __syncthreads();
    { const int nj = njobs[0], nitems = njobs[1]; LAS float* scr = (LAS float*)(F.lds + F.wave * 16384);
      const int gw = F.c * NWAVES + F.wave, NGW = F.G * NWAVES;
      int it = gw;
      if (it < nitems) {
          TItem Tc, Tn; f32x4 vc[8], vn[8];
          titem_decode(jobs, nj, it, Tc); titem_load(Tc, F.lane, vc);
          for (;;) {
              const int itn = it + NGW; const bool more = itn < nitems;
              if (more) { titem_decode(jobs, nj, itn, Tn); titem_load(Tn, F.lane, vn); }
              titem_store(Tc, F.lane, vc, scr);
              if (!more) break;
              Tc = Tn;
#pragma unroll
              for (int i = 0; i < 8; ++i) vc[i] = vn[i];
              it = itn;
          }
      } }
    __syncthreads();
}

__device__ __forceinline__ void moe_tiles(Frame& F, int layer) {
    REFRESH(F);
    LAS int* lcnt = (LAS int*)(F.lds + LCNT_OFF); LAS int* tpre = (LAS int*)(F.lds + TPRE_OFF);
    __syncthreads();
    if (F.tid < NE) lcnt[F.tid] = (int)__hip_atomic_load(F.ctl + CW_GCNT + layer * 64 + F.tid, __ATOMIC_RELAXED, __HIP_MEMORY_SCOPE_AGENT);
    __syncthreads();
    if (F.tid == 0) { int s = 0; for (int e = 0; e < NE; ++e) { tpre[e] = s; s += (lcnt[e] + 255) >> 8; } tpre[NE] = s; }
    __syncthreads();
}
constexpr int RB = 2;
#define ROWOF(it, r) ((((it) * F.G + F.c) * NWAVES + F.wave) * RB + (r))
struct MoeRef { int p[4]; float g[4]; };
__device__ __forceinline__ void moe_ref_load(Frame& F, int row, MoeRef& R) {
    const int4 pp = *(const int4*)(WSP(int, WS_POS) + (size_t)row * 4); const f32x4 gg = *(const f32x4*)(WSP(float, WS_GATE) + (size_t)row * 4);
    R.p[0] = pp.x; R.p[1] = pp.y; R.p[2] = pp.z; R.p[3] = pp.w; R.g[0] = gg.x; R.g[1] = gg.y; R.g[2] = gg.z; R.g[3] = gg.w;
}
__device__ __forceinline__ void moe_rows_load(Frame& F, const MoeRef& R, u32x2 (&y)[4][4]) {
    const LAS int* tpre = (const LAS int*)(F.lds + TPRE_OFF); const bf16_t* Y = WSP(bf16_t, WS_Y);
#pragma unroll
    for (int k = 0; k < 4; ++k) { const int e = R.p[k] >> 20, slot = R.p[k] & 0xfffff; const size_t fr = (size_t)tpre[e] * 256 + slot; const u32x2* yp = (const u32x2*)(Y + fr * D) + F.lane;
#pragma unroll
        for (int j = 0; j < 4; ++j) y[k][j] = yp[64 * j]; }
}
__device__ __forceinline__ f32x4 moe_rows_sum(const MoeRef& R, const u32x2 (&y)[4][4], int j) {
    f32x4 s = (f32x4){0.f, 0.f, 0.f, 0.f};
#pragma unroll
    for (int k = 0; k < 4; ++k) { const u32x2 w = y[k][j]; s += R.g[k] * (f32x4){bflo(w.x), bfhi(w.x), bflo(w.y), bfhi(w.y)}; }
    return s;
}

__device__ __forceinline__ void phase_norm1(Frame& F, const Args& A, int layer) {
    REFRESH(F);
    if (layer > 0) moe_tiles(F, layer - 1);
    float* H = WSP(float, WS_H); bf16_t* AX = WSP(bf16_t, WS_AX); const float* MOD = WSP(float, WS_MOD);
    const float* g1 = A.in[I_NORMG] + (size_t)(layer * 2 + 0) * D;
    f32x4 gg[4];
#pragma unroll
    for (int j = 0; j < 4; ++j) gg[j] = ((const f32x4*)g1)[64 * j + F.lane];
    for (int it = 0;; ++it) { if (ROWOF(it, 0) >= NT) break;
        f32x4 v[RB][4]; int brow[RB];
        if (layer == 0) {
#pragma unroll
            for (int r = 0; r < RB; ++r) { const int row = ROWOF(it, r); brow[r] = row < NX ? (row >> 11) : 32; const float* src = row < NX ? A.in[I_X] + (size_t)row * D : A.in[I_CTX] + (size_t)(row - NX) * D;
#pragma unroll
                for (int j = 0; j < 4; ++j) v[r][j] = ((const f32x4*)src)[64 * j + F.lane]; }
        } else {
            MoeRef R[RB]; u32x2 y[RB][4][4]; f32x4 gv[RB][4];
#pragma unroll
            for (int r = 0; r < RB; ++r) moe_ref_load(F, ROWOF(it, r), R[r]);
#pragma unroll
            for (int r = 0; r < RB; ++r) { const int row = ROWOF(it, r); brow[r] = row < NX ? (row >> 11) : 32; moe_rows_load(F, R[r], y[r]);
                const float* g2p = MOD + ((size_t)(layer - 1) * 33 + brow[r]) * 6144 + 5 * D;
#pragma unroll
                for (int j = 0; j < 4; ++j) { v[r][j] = ((const f32x4*)(H + (size_t)row * D))[64 * j + F.lane]; gv[r][j] = ((const f32x4*)g2p)[64 * j + F.lane]; } }
#pragma unroll
            for (int r = 0; r < RB; ++r)
#pragma unroll
                for (int j = 0; j < 4; ++j) v[r][j] = v[r][j] + gv[r][j] * moe_rows_sum(R[r], y[r], j);
        }
        float rstd[RB];
#pragma unroll
        for (int r = 0; r < RB; ++r) { const int row = ROWOF(it, r); float ss = 0.f;
#pragma unroll
            for (int j = 0; j < 4; ++j) { ((f32x4*)(H + (size_t)row * D))[64 * j + F.lane] = v[r][j]; ss += (v[r][j].x * v[r][j].x + v[r][j].y * v[r][j].y) + (v[r][j].z * v[r][j].z + v[r][j].w * v[r][j].w); }
            rstd[r] = 1.0f / sqrtf(wave_sum(ss) * (1.0f / D) + 1e-5f); }
#pragma unroll
        for (int r = 0; r < RB; ++r) { const int row = ROWOF(it, r); const float* mp = MOD + ((size_t)layer * 33 + brow[r]) * 6144;
#pragma unroll
            for (int j = 0; j < 4; ++j) { const f32x4 sh = ((const f32x4*)mp)[64 * j + F.lane], sc = ((const f32x4*)(mp + D))[64 * j + F.lane];
                const f32x4 o = v[r][j] * rstd[r] * gg[j] * (sc + 1.0f) + sh;
                u32x2 w; w.x = pk2(o.x, o.y); w.y = pk2(o.z, o.w); ((u32x2*)(AX + (size_t)row * D))[64 * j + F.lane] = w; } }
    }
}
__device__ __forceinline__ void phase_final(Frame& F, const Args& A) {
    REFRESH(F);
    moe_tiles(F, DEPTH - 1);
    const float* H = WSP(float, WS_H); const float* MOD = WSP(float, WS_MOD); const float* fg = A.in[I_FG];
    f32x4 gg[4];
#pragma unroll
    for (int j = 0; j < 4; ++j) gg[j] = ((const f32x4*)fg)[64 * j + F.lane];
    for (int it = 0;; ++it) { if (ROWOF(it, 0) >= NX) break;
        MoeRef R[RB]; u32x2 y[RB][4][4]; f32x4 v[RB][4], gv[RB][4];
#pragma unroll
        for (int r = 0; r < RB; ++r) moe_ref_load(F, ROWOF(it, r), R[r]);
#pragma unroll
        for (int r = 0; r < RB; ++r) { const int row = ROWOF(it, r); moe_rows_load(F, R[r], y[r]); const float* g2p = MOD + ((size_t)(DEPTH - 1) * 33 + (row >> 11)) * 6144 + 5 * D;
#pragma unroll
            for (int j = 0; j < 4; ++j) { v[r][j] = ((const f32x4*)(H + (size_t)row * D))[64 * j + F.lane]; gv[r][j] = ((const f32x4*)g2p)[64 * j + F.lane]; } }
#pragma unroll
        for (int r = 0; r < RB; ++r) { const int row = ROWOF(it, r); float ss = 0.f;
#pragma unroll
            for (int j = 0; j < 4; ++j) { v[r][j] = v[r][j] + gv[r][j] * moe_rows_sum(R[r], y[r], j); ss += (v[r][j].x * v[r][j].x + v[r][j].y * v[r][j].y) + (v[r][j].z * v[r][j].z + v[r][j].w * v[r][j].w); }
            const float rstd = 1.0f / sqrtf(wave_sum(ss) * (1.0f / D) + 1e-5f);
#pragma unroll
            for (int j = 0; j < 4; ++j) ((f32x4*)(A.out + (size_t)row * D))[64 * j + F.lane] = v[r][j] * rstd * gg[j]; }
    }
}

__device__ __forceinline__ void phase_route(Frame& F, const Args& A, int layer) {
    REFRESH(F);
    const int nrows = (layer == DEPTH - 1) ? NX : NT;
    LAS float* wT = (LAS float*)F.lds;
    LAS int* lcnt = (LAS int*)(F.lds + LCNT_OFF); LAS int* lbase = (LAS int*)(F.lds + LBASE_OFF);
    LAS unsigned* recp = (LAS unsigned*)(F.lds + REC_OFF); LAS float* recg = (LAS float*)(F.lds + REC_OFF + 4608);
    __syncthreads();
    { const float* wr = A.in[I_MWR] + (size_t)layer * D * NE;
      for (int idx = F.tid; idx < D * NE; idx += NTHREADS) wT[(idx & 31) * 1024 + (idx >> 5)] = wr[idx]; }
    if (F.tid < NE) lcnt[F.tid] = 0;
    __syncthreads();
    const float* H = WSP(float, WS_H); unsigned char* FX = WSP(unsigned char, WS_FX); const float* MOD = WSP(float, WS_MOD);
    const float* g2 = A.in[I_NORMG] + (size_t)(layer * 2 + 1) * D; const float* br = A.in[I_MBR] + layer * NE;
    f32x4 gg[4];
#pragma unroll
    for (int j = 0; j < 4; ++j) gg[j] = ((const f32x4*)g2)[64 * j + F.lane];
    const int myE = F.lane >> 1; const float myb = br[myE];
    int nit = 0;
    for (int it = 0;; ++it) { if (ROWOF(it, 0) - F.wave * RB >= nrows) break; nit = it + 1;
        if (ROWOF(it, 0) >= nrows) continue;
        f32x4 v[RB][4]; float rstd[RB];
#pragma unroll
        for (int r = 0; r < RB; ++r) { const int row = ROWOF(it, r);
#pragma unroll
            for (int j = 0; j < 4; ++j) v[r][j] = ((const f32x4*)(H + (size_t)row * D))[64 * j + F.lane]; }
#pragma unroll
        for (int r = 0; r < RB; ++r) { float ss = 0.f;
#pragma unroll
            for (int j = 0; j < 4; ++j) ss += (v[r][j].x * v[r][j].x + v[r][j].y * v[r][j].y) + (v[r][j].z * v[r][j].z + v[r][j].w * v[r][j].w);
            rstd[r] = 1.0f / sqrtf(wave_sum(ss) * (1.0f / D) + 1e-5f); }
#pragma unroll
        for (int r = 0; r < RB; ++r) { const int row = ROWOF(it, r); const int brow = row < NX ? (row >> 11) : 32;
            const float* mp = MOD + ((size_t)layer * 33 + brow) * 6144 + 3 * D;
#pragma unroll
            for (int j = 0; j < 4; ++j) { const f32x4 sh = ((const f32x4*)mp)[64 * j + F.lane], sc = ((const f32x4*)(mp + D))[64 * j + F.lane];
                v[r][j] = v[r][j] * rstd[r] * gg[j] * (sc + 1.0f) + sh;
                ((unsigned*)(FX + (size_t)row * D))[64 * j + F.lane] = pk4_fp8(v[r][j].x, v[r][j].y, v[r][j].z, v[r][j].w); } }
        float part[RB][NE];
#pragma unroll
        for (int e = 0; e < NE; ++e) { float p0 = 0.f, p1 = 0.f;
#pragma unroll
            for (int j = 0; j < 4; ++j) { const f32x4 w4 = ((const LAS f32x4*)(wT + e * 1024))[64 * j + F.lane];
                p0 += (v[0][j].x * w4.x + v[0][j].y * w4.y) + (v[0][j].z * w4.z + v[0][j].w * w4.w); p1 += (v[1][j].x * w4.x + v[1][j].y * w4.y) + (v[1][j].z * w4.z + v[1][j].w * w4.w); }
            part[0][e] = p0; part[1][e] = p1; }
#pragma unroll
        for (int r = 0; r < RB; ++r) {
#pragma unroll
            for (int k = 0; k < 16; ++k) { const bool up = (F.lane & 32) != 0; const float keep = up ? part[r][k + 16] : part[r][k], send = up ? part[r][k] : part[r][k + 16]; part[r][k] = keep + __shfl_xor(send, 32); }
#pragma unroll
            for (int k = 0; k < 8; ++k) { const bool up = (F.lane & 16) != 0; const float keep = up ? part[r][k + 8] : part[r][k], send = up ? part[r][k] : part[r][k + 8]; part[r][k] = keep + __shfl_xor(send, 16); }
#pragma unroll
            for (int k = 0; k < 4; ++k) { const bool up = (F.lane & 8) != 0; const float keep = up ? part[r][k + 4] : part[r][k], send = up ? part[r][k] : part[r][k + 4]; part[r][k] = keep + __shfl_xor(send, 8); }
#pragma unroll
            for (int k = 0; k < 2; ++k) { const bool up = (F.lane & 4) != 0; const float keep = up ? part[r][k + 2] : part[r][k], send = up ? part[r][k] : part[r][k + 2]; part[r][k] = keep + __shfl_xor(send, 4); }
            { const bool up = (F.lane & 2) != 0; const float keep = up ? part[r][1] : part[r][0], send = up ? part[r][0] : part[r][1]; part[r][0] = keep + __shfl_xor(send, 2); }
            part[r][0] += __shfl_xor(part[r][0], 1);
        }
#pragma unroll
        for (int r = 0; r < RB; ++r) {
            const float val = part[r][0] + myb;
            int rank = 0;
#pragma unroll
            for (int e = 0; e < NE; ++e) { const float ve = __builtin_bit_cast(float, __builtin_amdgcn_readlane(__builtin_bit_cast(int, val), 2 * e)); rank += (ve > val || (ve == val && e < myE)) ? 1 : 0; }
            float sv[4]; int si[4];
#pragma unroll
            for (int k = 0; k < 4; ++k) { const unsigned long long m = __ballot(rank == k && (F.lane & 1) == 0); const int src = __builtin_ctzll(m);
                si[k] = src >> 1; sv[k] = __builtin_bit_cast(float, __builtin_amdgcn_readlane(__builtin_bit_cast(int, val), src)); }
            const float e1 = __expf(sv[1] - sv[0]), e2 = __expf(sv[2] - sv[0]), e3 = __expf(sv[3] - sv[0]); const float inv = 1.0f / (1.0f + e1 + e2 + e3);
            if (F.lane < 4) { const int e = F.lane == 0 ? si[0] : F.lane == 1 ? si[1] : F.lane == 2 ? si[2] : si[3]; const float g = (F.lane == 0 ? 1.0f : F.lane == 1 ? e1 : F.lane == 2 ? e2 : e3) * inv;
                const int rank2 = __hip_atomic_fetch_add(lcnt + e, 1, __ATOMIC_RELAXED, __HIP_MEMORY_SCOPE_WORKGROUP);
                const int ri = ((it * NWAVES + F.wave) * RB + r) * 4 + F.lane; recp[ri] = ((unsigned)e << 20) | (unsigned)rank2; recg[ri] = g; }
        }
    }
    __syncthreads();
    if (F.tid < NE) lbase[F.tid] = (int)__hip_atomic_fetch_add(F.ctl + CW_GCNT + layer * 64 + F.tid, (unsigned)lcnt[F.tid], __ATOMIC_RELAXED, __HIP_MEMORY_SCOPE_AGENT);
    __syncthreads();
    int* LIST = WSP(int, WS_LIST); int* POS = WSP(int, WS_POS); float* GATE = WSP(float, WS_GATE);
    for (int r = F.tid; r < nit * NWAVES * RB * 4; r += NTHREADS) { const int lr = r >> 2, k = r & 3; const int row = ((lr >> 4) * F.G + F.c) * (NWAVES * RB) + (lr & 15); if (row >= nrows) continue;
        const unsigned qx = recp[r]; const float qg = recg[r]; const int e = qx >> 20, slot = lbase[e] + (int)(qx & 0xfffff);
        LIST[(size_t)e * NT + slot] = row; POS[(size_t)row * 4 + k] = (e << 20) | slot; GATE[(size_t)row * 4 + k] = qg; }
    __syncthreads();
}

__device__ __forceinline__ void phase_pooldiff(Frame& F) {
    REFRESH(F);
    const bf16_t* AX = WSP(bf16_t, WS_AX); bf16_t* PD = WSP(bf16_t, WS_PD);
    for (int it = 0;; ++it) { if (ROWOF(it, 0) >= NT) break;
        const int row0 = ROWOF(it, 0); int sb, t, n; seq_of(row0, sb, t, n);
#pragma unroll
        for (int j = 0; j < 4; ++j) { const int half = 1 << j; const int col = 256 * j + 4 * F.lane;
            f32x4 s0 = (f32x4){0.f, 0.f, 0.f, 0.f}, s1 = s0, me0 = s0, me1 = s0;
#pragma unroll
            for (int q = 0; q < 2 * half + 1; ++q) { const int uu = t - half + q;
                if (uu >= 0 && uu < n) { const f32x4 x = ld_bf4(AX + (size_t)(sb + uu) * D + col); if (q < 2 * half) s0 += x; if (q > 0) s1 += x; if (q == half) me0 = x; if (q == half + 1) me1 = x; } }
            const int lo0 = t - half < 0 ? 0 : t - half, hi0 = t + half > n ? n : t + half, lo1 = t + 1 - half < 0 ? 0 : t + 1 - half, hi1 = t + 1 + half > n ? n : t + 1 + half;
            st_bf4(PD + (size_t)row0 * D + col, s0 * (1.0f / (float)(hi0 - lo0)) - me0);
            st_bf4(PD + (size_t)(row0 + 1) * D + col, s1 * (1.0f / (float)(hi1 - lo1)) - me1); }
    }
}
__device__ __forceinline__ void phase_rwkv_mix(Frame& F, const Args& A) {
    REFRESH(F);
    const bf16_t* AX = WSP(bf16_t, WS_AX); bf16_t* A6 = WSP(bf16_t, WS_A6); const float* mix = A.in[I_RMIX];
    for (int it = 0;; ++it) { if (ROWOF(it, 0) >= NT) break;
        const int row0 = ROWOF(it, 0); int sb, t, n; seq_of(row0, sb, t, n);
#pragma unroll
        for (int j = 0; j < 4; ++j) { const int col = 256 * j + 4 * F.lane; const f32x4 z = (f32x4){0.f, 0.f, 0.f, 0.f};
            const f32x4 h0 = ld_bf4(AX + (size_t)row0 * D + col), h1 = ld_bf4(AX + (size_t)(row0 + 1) * D + col);
            const f32x4 hp = t > 0 ? ld_bf4(AX + (size_t)(row0 - 1) * D + col) : z, hn = t + 1 < n - 1 ? ld_bf4(AX + (size_t)(row0 + 2) * D + col) : z;
            const f32x4 xx0 = (hp + h1) * 0.5f - h0, xx1 = (h0 + hn) * 0.5f - h1;
#pragma unroll
            for (int i = 0; i < 6; ++i) { const f32x4 m = *(const f32x4*)(mix + i * D + col); st_bf4(A6 + ((size_t)i * NT + row0) * D + col, h0 + xx0 * m); st_bf4(A6 + ((size_t)i * NT + row0 + 1) * D + col, h1 + xx1 * m); } }
    }
}
__device__ __forceinline__ float rl(float x, int k) { return __builtin_bit_cast(float, __builtin_amdgcn_readlane(__builtin_bit_cast(int, x), k)); }
typedef float f32x16 __attribute__((ext_vector_type(16)));
constexpr int SCW = 33792;
__device__ __forceinline__ int kpos(int k) { return (k & ~12) | ((k & 4) << 1) | ((k & 8) >> 1); }
__device__ __forceinline__ bf16x8 acc_frag(const f32x16& X, int s2) {
    u32x4 w; w.x = cvt_pk_bf16(X[8 * s2 + 0], X[8 * s2 + 1]); w.y = cvt_pk_bf16(X[8 * s2 + 2], X[8 * s2 + 3]); w.z = cvt_pk_bf16(X[8 * s2 + 4], X[8 * s2 + 5]); w.w = cvt_pk_bf16(X[8 * s2 + 6], X[8 * s2 + 7]);
    return __builtin_bit_cast(bf16x8, w);
}
#define MFMA32(a, b, c) __builtin_amdgcn_mfma_f32_32x32x16_bf16(a, b, c, 0, 0, 0)
__device__ __forceinline__ void phase_rwkv_scan(Frame& F, const Args& A) {
    REFRESH(F);
    __syncthreads();
    for (int item = F.wave * F.G + F.c; item < 1024 && F.wave < 4; item += 4 * F.G) {
        const int dir = item >> 9, b = (item >> 4) & 31, hd = item & 15, col = 64 * hd + F.lane;
        const int l = F.lane, r32 = l & 31, hh = l >> 5;
        const bf16_t* Rr = WSP(bf16_t, WS_RKV); const bf16_t* Kk = Rr + (size_t)NT * D; const bf16_t* Vv = Kk + (size_t)NT * D;
        const bf16_t* Ee = WSP(bf16_t, WS_E) + (size_t)dir * NT * D; const bf16_t* Aa = WSP(bf16_t, WS_A) + (size_t)dir * NT * D;
        float* Yo = WSP(float, WS_YS) + (size_t)dir * NT * D; float* Bo = WSP(float, WS_BONUS) + (size_t)dir * NT * 16;
        const float kkw = A.in[I_RKK][col], kaw = A.in[I_RKA][col], rkw = A.in[I_RRK][col];
        LAS unsigned char* RA = F.lds + F.wave * SCW; LAS unsigned char* RB = RA + 16384; LAS unsigned char* RV = RA + 25600;
        LAS float* cCb = (LAS float*)(F.lds + REC_OFF + F.wave * 256);
        LAS bf16_t* XT = (LAS bf16_t*)RA;
        LAS bf16_t* BK = (LAS bf16_t*)(RA + 8192);
        const int kp = kpos(l);
        f32x16 ST[2][2];
#pragma unroll
        for (int i = 0; i < 2; ++i)
#pragma unroll
            for (int j2 = 0; j2 < 2; ++j2)
#pragma unroll
                for (int q = 0; q < 16; ++q) ST[i][j2][q] = 0.f;
        for (int seg = 0; seg < 2; ++seg) {
            const int base = seg ? b * T : NX + b * L, n = seg ? T : L; const int dt = dir ? -1 : 1; const int t0 = dir ? n - 1 : 0;
            for (int bt = 0; bt < n; bt += 32) {
                float cprev = 1.0f;
#pragma unroll
                for (int g8 = 0; g8 < 8; ++g8) {
                    bf16_t raw[4][5];
#pragma unroll
                    for (int s8 = 0; s8 < 4; ++s8) { const size_t o = (size_t)(base + t0 + dt * (bt + g8 * 4 + s8)) * D + col; raw[s8][0] = Rr[o]; raw[s8][1] = Kk[o]; raw[s8][2] = Vv[o]; raw[s8][3] = Aa[o]; raw[s8][4] = Ee[o]; }
                    float rr[4], kraw[4], aa[4], kk[4], kd[4], n2[4], bn[4], ww[4]; unsigned bq2[2] = {0u, 0u}, kq2[2] = {0u, 0u};
#pragma unroll
                    for (int s8 = 0; s8 < 4; ++s8) { rr[s8] = bf1(raw[s8][0]); kraw[s8] = bf1(raw[s8][1]); aa[s8] = bf1(raw[s8][3]); ww[s8] = __expf(-bf1(raw[s8][4]));
                        kk[s8] = kraw[s8] * kkw; n2[s8] = kk[s8] * kk[s8]; kd[s8] = kraw[s8] * (1.0f + (aa[s8] - 1.0f) * kaw); bn[s8] = rr[s8] * kd[s8] * rkw; }
#pragma unroll
                    for (int s8 = 0; s8 < 4; ++s8) { n2[s8] = wave_sum(n2[s8]); bn[s8] = wave_sum(bn[s8]); }
#pragma unroll
                    for (int s8 = 0; s8 < 4; ++s8) { const int t = g8 * 4 + s8;
                        if (l == 0) Bo[(size_t)(base + t0 + dt * (bt + t)) * 16 + hd] = bn[s8];
                        const float kn = kk[s8] * __builtin_amdgcn_rsqf(fmaxf(n2[s8], 1e-24f)); const float c = cprev * ww[s8]; const float ic = __builtin_amdgcn_rcpf(c);
                        const float at = -kn * cprev, rt = rr[s8] * c, bq = kn * aa[s8] * ic, kq = kd[s8] * ic;
                        const unsigned w0 = cvt_pk_bf16(at, rt), w1 = cvt_pk_bf16(bq, kq);
                        XT[t * 64 + kp] = (bf16_t)(w0 & 0xffffu); XT[(32 + t) * 64 + kp] = (bf16_t)(w0 >> 16);
                        BK[t * 64 + kp] = (bf16_t)(w1 & 0xffffu); BK[(32 + t) * 64 + kp] = (bf16_t)(w1 >> 16);
                        if (s8 & 1) { bq2[s8 >> 1] |= (w1 & 0xffffu) << 16; kq2[s8 >> 1] |= (w1 & 0xffff0000u); } else { bq2[s8 >> 1] = w1 & 0xffffu; kq2[s8 >> 1] = w1 >> 16; }
                        cprev = c; }
                    const int gp = (g8 & ~3) | ((g8 & 1) << 1) | ((g8 & 2) >> 1);
                    *(LAS u32x2*)(RB + l * 144 + gp * 8) = (u32x2){bq2[0], bq2[1]}; *(LAS u32x2*)(RB + l * 144 + 64 + gp * 8) = (u32x2){kq2[0], kq2[1]};
                    *(LAS u32x2*)(RV + l * 80 + gp * 8) = (u32x2){(unsigned)raw[0][2] | ((unsigned)raw[1][2] << 16), (unsigned)raw[2][2] | ((unsigned)raw[3][2] << 16)};
                }
                cCb[l] = cprev;
                asm volatile("s_waitcnt lgkmcnt(0)" ::: "memory");
                f32x16 Mp, Np, X[2];
                { bf16x8 XTf[4], BKf[2][4];
#pragma unroll
                  for (int s4 = 0; s4 < 4; ++s4) { XTf[s4] = *(const LAS bf16x8*)(XT + r32 * 64 + 16 * s4 + 8 * hh); BKf[0][s4] = *(const LAS bf16x8*)(BK + r32 * 64 + 16 * s4 + 8 * hh); BKf[1][s4] = *(const LAS bf16x8*)(BK + (32 + r32) * 64 + 16 * s4 + 8 * hh); }
                  bf16x8 MkaF[2];
                  { f32x16 Tm;
#pragma unroll
                    for (int q = 0; q < 16; ++q) Tm[q] = 0.f;
#pragma unroll
                    for (int s4 = 0; s4 < 4; ++s4) Tm = MFMA32(BKf[1][s4], XTf[s4], Tm);
#pragma unroll
                    for (int q = 0; q < 16; ++q) { const int row = (q & 3) + 8 * (q >> 2) + 4 * hh; Tm[q] = row < r32 ? Tm[q] : 0.f; }
                    MkaF[0] = acc_frag(Tm, 0); MkaF[1] = acc_frag(Tm, 1); }
#pragma unroll
                  for (int q = 0; q < 16; ++q) { Mp[q] = 0.f; Np[q] = 0.f; }
#pragma unroll
                  for (int s4 = 0; s4 < 4; ++s4) { Mp = MFMA32(BKf[0][s4], XTf[s4], Mp); Np = MFMA32(XTf[s4], BKf[0][s4], Np); }
#pragma unroll
                  for (int q = 0; q < 16; ++q) { const int row = (q & 3) + 8 * (q >> 2) + 4 * hh; Mp[q] = row < r32 ? Mp[q] : 0.f; Np[q] = r32 < row ? Np[q] : 0.f; }
#pragma unroll
                  for (int vb = 0; vb < 2; ++vb) {
#pragma unroll
                      for (int q = 0; q < 16; ++q) X[vb][q] = 0.f;
#pragma unroll
                      for (int kb = 0; kb < 2; ++kb)
#pragma unroll
                          for (int s2 = 0; s2 < 2; ++s2) X[vb] = MFMA32(XTf[2 * kb + s2], acc_frag(ST[kb][vb], s2), X[vb]);
#pragma unroll
                      for (int s2 = 0; s2 < 2; ++s2) { const bf16x8 Vf = *(const LAS bf16x8*)(RV + (32 * vb + r32) * 80 + (16 * s2 + 8 * hh) * 2); X[vb] = MFMA32(MkaF[s2], Vf, X[vb]); }
                  } }
                __builtin_amdgcn_sched_barrier(0);
#pragma unroll
                for (int lvl = 0; lvl < 5; ++lvl) {
                    bf16x8 Ma[2], Na[2];
#pragma unroll
                    for (int s2 = 0; s2 < 2; ++s2) { Ma[s2] = acc_frag(Mp, s2); Na[s2] = acc_frag(Np, s2); }
#pragma unroll
                    for (int vb = 0; vb < 2; ++vb) { const bf16x8 x0 = acc_frag(X[vb], 0), x1 = acc_frag(X[vb], 1); X[vb] = MFMA32(Ma[0], x0, X[vb]); X[vb] = MFMA32(Ma[1], x1, X[vb]); }
                    if (lvl < 4) { f32x16 M2, N2;
#pragma unroll
                        for (int q = 0; q < 16; ++q) { M2[q] = 0.f; N2[q] = 0.f; }
                        M2 = MFMA32(Na[0], Ma[0], M2); M2 = MFMA32(Na[1], Ma[1], M2);
                        N2 = MFMA32(Ma[0], Na[0], N2); N2 = MFMA32(Ma[1], Na[1], N2);
                        Mp = M2; Np = N2; }
                }
                __builtin_amdgcn_sched_barrier(0);
                { bf16x8 XRf[4], MbrF[2], MkrF[2];
#pragma unroll
                  for (int s4 = 0; s4 < 4; ++s4) XRf[s4] = *(const LAS bf16x8*)(XT + (32 + r32) * 64 + 16 * s4 + 8 * hh);
                  { f32x16 Tm, Tn;
#pragma unroll
                    for (int q = 0; q < 16; ++q) { Tm[q] = 0.f; Tn[q] = 0.f; }
#pragma unroll
                    for (int s4 = 0; s4 < 4; ++s4) { const bf16x8 Bb = *(const LAS bf16x8*)(BK + r32 * 64 + 16 * s4 + 8 * hh), Bk = *(const LAS bf16x8*)(BK + (32 + r32) * 64 + 16 * s4 + 8 * hh);
                        Tm = MFMA32(Bb, XRf[s4], Tm); Tn = MFMA32(Bk, XRf[s4], Tn); }
#pragma unroll
                    for (int q = 0; q < 16; ++q) { const int row = (q & 3) + 8 * (q >> 2) + 4 * hh; Tm[q] = row <= r32 ? Tm[q] : 0.f; Tn[q] = row <= r32 ? Tn[q] : 0.f; }
                    MbrF[0] = acc_frag(Tm, 0); MbrF[1] = acc_frag(Tm, 1); MkrF[0] = acc_frag(Tn, 0); MkrF[1] = acc_frag(Tn, 1); }
#pragma unroll
                  for (int vb = 0; vb < 2; ++vb) {
                    const bf16x8 u0 = acc_frag(X[vb], 0), u1 = acc_frag(X[vb], 1);
                    const bf16x8 Vf0 = *(const LAS bf16x8*)(RV + (32 * vb + r32) * 80 + (8 * hh) * 2), Vf1 = *(const LAS bf16x8*)(RV + (32 * vb + r32) * 80 + (16 + 8 * hh) * 2);
                    f32x16 Yt;
#pragma unroll
                    for (int q = 0; q < 16; ++q) Yt[q] = 0.f;
#pragma unroll
                    for (int kb = 0; kb < 2; ++kb)
#pragma unroll
                        for (int s2 = 0; s2 < 2; ++s2) Yt = MFMA32(XRf[2 * kb + s2], acc_frag(ST[kb][vb], s2), Yt);
                    Yt = MFMA32(MkrF[0], Vf0, Yt); Yt = MFMA32(MkrF[1], Vf1, Yt);
                    Yt = MFMA32(MbrF[0], u0, Yt); Yt = MFMA32(MbrF[1], u1, Yt);
#pragma unroll
                    for (int q = 0; q < 16; ++q) { const int t = (q & 3) + 8 * (q >> 2) + 4 * hh; Yo[(size_t)(base + t0 + dt * (bt + t)) * D + 64 * hd + 32 * vb + r32] = Yt[q]; }
#pragma unroll
                    for (int kb = 0; kb < 2; ++kb) {
                        const bf16x8 b0 = *(const LAS bf16x8*)(RB + (32 * kb + r32) * 144 + (8 * hh) * 2), b1 = *(const LAS bf16x8*)(RB + (32 * kb + r32) * 144 + (16 + 8 * hh) * 2);
                        const bf16x8 k0 = *(const LAS bf16x8*)(RB + (32 * kb + r32) * 144 + 64 + (8 * hh) * 2), k1 = *(const LAS bf16x8*)(RB + (32 * kb + r32) * 144 + 64 + (16 + 8 * hh) * 2);
                        ST[kb][vb] = MFMA32(b0, u0, ST[kb][vb]); ST[kb][vb] = MFMA32(b1, u1, ST[kb][vb]);
                        ST[kb][vb] = MFMA32(k0, Vf0, ST[kb][vb]); ST[kb][vb] = MFMA32(k1, Vf1, ST[kb][vb]); }
                  } }
                __builtin_amdgcn_sched_barrier(0);
#pragma unroll
                for (int kb = 0; kb < 2; ++kb)
#pragma unroll
                    for (int g4 = 0; g4 < 4; ++g4) { const f32x4 cc = *(const LAS f32x4*)(cCb + 32 * kb + 8 * g4 + 4 * hh);
#pragma unroll
                        for (int vb = 0; vb < 2; ++vb) { ST[kb][vb][4 * g4 + 0] *= cc.x; ST[kb][vb][4 * g4 + 1] *= cc.y; ST[kb][vb][4 * g4 + 2] *= cc.z; ST[kb][vb][4 * g4 + 3] *= cc.w; } }
                asm volatile("s_waitcnt lgkmcnt(0)" ::: "memory");
            }
        }
    }
    __syncthreads();
}
#undef MFMA32
__device__ __forceinline__ void phase_rwkv_out(Frame& F, const Args& A, int nrows) {
    REFRESH(F);
    const float* Y0 = WSP(float, WS_YS); const float* Y1 = Y0 + (size_t)NT * D; const float* B0 = WSP(float, WS_BONUS); const float* B1 = B0 + (size_t)NT * 16;
    const bf16_t* Vv = WSP(bf16_t, WS_RKV) + (size_t)2 * NT * D; const bf16_t* Gg = WSP(bf16_t, WS_G); bf16_t* RO = WSP(bf16_t, WS_RO);
    const float* lnw = A.in[I_RLNW]; const float* lnb = A.in[I_RLNB];
    for (int it = 0;; ++it) { if (ROWOF(it, 0) >= nrows) break;
        f32x4 y[RB][4], vv[RB][4], gg[RB][4]; float bon[RB][4];
#pragma unroll
        for (int r = 0; r < RB; ++r) { const int row = ROWOF(it, r);
#pragma unroll
            for (int j = 0; j < 4; ++j) { const int col = 256 * j + 4 * F.lane, head = 4 * j + (F.lane >> 4); const size_t o = (size_t)row * D + col;
                y[r][j] = *(const f32x4*)(Y0 + o) + *(const f32x4*)(Y1 + o); vv[r][j] = ld_bf4(Vv + o); gg[r][j] = ld_bf4(Gg + o); bon[r][j] = B0[(size_t)row * 16 + head] + B1[(size_t)row * 16 + head]; } }
#pragma unroll
        for (int r = 0; r < RB; ++r) { const int row = ROWOF(it, r);
#pragma unroll
            for (int j = 0; j < 4; ++j) { const int col = 256 * j + 4 * F.lane; const size_t o = (size_t)row * D + col; const f32x4 yy = y[r][j];
                const float s = row16_sum((yy.x + yy.y) + (yy.z + yy.w));
                const f32x4 d = yy - s * (1.0f / 64.0f);
                const float q = row16_sum((d.x * d.x + d.y * d.y) + (d.z * d.z + d.w * d.w));
                const float rs = 1.0f / sqrtf(q * (1.0f / 64.0f) + 64e-5f);
                const f32x4 yn = d * rs * *(const f32x4*)(lnw + col) + *(const f32x4*)(lnb + col);
                st_bf4(RO + o, (yn + vv[r][j] * bon[r][j]) * gg[r][j]); } }
    }
}

__device__ __forceinline__ void phase_attn(Frame& F, const Args& A, int j, bool need_ctx) {
    REFRESH(F);
    const bf16_t* Q = WSP(bf16_t, WS_Q); const bf16_t* Kb = WSP(bf16_t, WS_K); const bf16_t* VT = WSP(bf16_t, WS_VT); bf16_t* O = WSP(bf16_t, WS_O);
    const float* sinks = A.in[I_ASINK] + j * 16;
    LAS bf16_t* Ks = (LAS bf16_t*)F.lds; LAS bf16_t* Vs = (LAS bf16_t*)(F.lds + 9216);
    LAS bf16x8* Qs = (LAS bf16x8*)(F.lds + 18432 + F.wave * 8192) + F.lane;
    const int nunits = 2048 + (need_ctx ? 256 : 0);
    const int fr = F.lane & 15, fq = F.lane >> 4, g = F.wave >> 1, hf = F.wave & 1;
    const float SC = 0.125f * 1.4426950408889634f;
    const int lr = F.tid >> 3, lch = F.tid & 7;
    __syncthreads();
    for (int u = F.c; u < nunits; u += F.G) {
        int b, kvh, qb; bool isx;
        if (u < 2048) { isx = true; b = u >> 6; kvh = (u >> 4) & 3; qb = u & 15; } else { const int v = u - 2048; isx = false; b = v >> 3; kvh = (v >> 1) & 3; qb = v & 1; }
        const int qrow0 = (isx ? b * T : NX + b * L) + qb * 128 + hf * 64; const int head = 4 * kvh + g;
        int jlo = 0, jhi = -1;
        if (isx) { jlo = qb == 0 ? 2 : 0; jhi = qb == 15 ? 3 : 5; }
        const int ntiles = 4 + (jhi - jlo + 1);
        auto tile_row0 = [&](int ti) -> int { return ti < 4 ? NX + b * L + ti * 64 : b * T + qb * 128 - 128 + 64 * (jlo + ti - 4); };
        u32x4 kv_n, vv_n;
        { const int kr0 = tile_row0(0); kv_n = *(const u32x4*)(Kb + (size_t)(kr0 + lr) * 256 + kvh * 64 + lch * 8); vv_n = *(const u32x4*)(VT + (size_t)(kvh * 64 + lr) * NT + kr0 + lch * 8); }
#pragma unroll
        for (int mq = 0; mq < 4; ++mq)
#pragma unroll
            for (int ks = 0; ks < 2; ++ks) Qs[64 * (mq * 2 + ks)] = *(const bf16x8*)(Q + (size_t)(qrow0 + 16 * mq + fr) * D + head * 64 + ks * 32 + 8 * fq);
        const float sink2 = sinks[head] * 1.4426950408889634f;
        float mrun[4], lrun[4]; f32x4 Oa[4][4];
#pragma unroll
        for (int mq = 0; mq < 4; ++mq) { mrun[mq] = sink2; lrun[mq] = fq == 0 ? 1.0f : 0.0f;
#pragma unroll
            for (int db = 0; db < 4; ++db) Oa[mq][db] = (f32x4){0.f, 0.f, 0.f, 0.f}; }
        for (int ti = 0; ti < ntiles; ++ti) {
            const int jl = ti < 4 ? -1 : jlo + ti - 4; const int ks0 = qb * 128 - 128 + 64 * jl;
            __syncthreads();
            *(LAS u32x4*)(Ks + lr * 72 + lch * 8) = kv_n; *(LAS u32x4*)(Vs + lr * 72 + lch * 8) = vv_n;
            __syncthreads();
            if (ti + 1 < ntiles) { const int kr0 = tile_row0(ti + 1); kv_n = *(const u32x4*)(Kb + (size_t)(kr0 + lr) * 256 + kvh * 64 + lch * 8); vv_n = *(const u32x4*)(VT + (size_t)(kvh * 64 + lr) * NT + kr0 + lch * 8); }
            const bool need = (jl < 0) || (jl >= hf && jl <= hf + 4);
            if (need) {
                const bool domask = (jl >= 0) && (jl == hf || jl == hf + 4);
                f32x4 Sa[4][4];
#pragma unroll
                for (int mq = 0; mq < 4; ++mq)
#pragma unroll
                    for (int n = 0; n < 4; ++n) Sa[mq][n] = (f32x4){0.f, 0.f, 0.f, 0.f};
#pragma unroll
                for (int ks = 0; ks < 2; ++ks) {
                    bf16x8 Qf[4];
#pragma unroll
                    for (int mq = 0; mq < 4; ++mq) Qf[mq] = Qs[64 * (mq * 2 + ks)];
#pragma unroll
                    for (int n = 0; n < 4; ++n) { const int kr = 32 * (n >> 1) + 8 * (fr >> 2) + 4 * (n & 1) + (fr & 3);
                        const bf16x8 Kf = *(const LAS bf16x8*)(Ks + kr * 72 + ks * 32 + 8 * fq);
#pragma unroll
                        for (int mq = 0; mq < 4; ++mq) Sa[mq][n] = __builtin_amdgcn_mfma_f32_16x16x32_bf16(Kf, Qf[mq], Sa[mq][n], 0, 0, 0); } }
                bf16x8 Pf[4][2];
#pragma unroll
                for (int mq = 0; mq < 4; ++mq) {
                    float mx = -1e30f;
                    if (domask) { const int tq = qb * 128 + hf * 64 + 16 * mq + fr;
#pragma unroll
                        for (int n = 0; n < 4; ++n)
#pragma unroll
                            for (int i = 0; i < 4; ++i) { float sv = Sa[mq][n][i] * SC; const int rel = ks0 + 32 * (n >> 1) + 8 * fq + 4 * (n & 1) + i - tq; if (rel > 128 || rel < -128) sv = -1e30f; Sa[mq][n][i] = sv; mx = fmaxf(mx, sv); } }
                    else {
#pragma unroll
                        for (int n = 0; n < 4; ++n)
#pragma unroll
                            for (int i = 0; i < 4; ++i) { const float sv = Sa[mq][n][i] * SC; Sa[mq][n][i] = sv; mx = fmaxf(mx, sv); } }
                    mx = fmaxf(mx, __shfl_xor(mx, 16)); mx = fmaxf(mx, __shfl_xor(mx, 32));
                    const float mnew = fmaxf(mrun[mq], mx); const float alpha = __builtin_amdgcn_exp2f(mrun[mq] - mnew); mrun[mq] = mnew;
                    float rs = 0.f;
#pragma unroll
                    for (int n = 0; n < 4; ++n)
#pragma unroll
                        for (int i = 0; i < 4; ++i) { const float p = __builtin_amdgcn_exp2f(Sa[mq][n][i] - mnew); Sa[mq][n][i] = p; rs += p; }
                    lrun[mq] = lrun[mq] * alpha + rs;
#pragma unroll
                    for (int db = 0; db < 4; ++db) Oa[mq][db] *= alpha;
#pragma unroll
                    for (int s2 = 0; s2 < 2; ++s2) { u32x4 w; w.x = cvt_pk_bf16(Sa[mq][2 * s2][0], Sa[mq][2 * s2][1]); w.y = cvt_pk_bf16(Sa[mq][2 * s2][2], Sa[mq][2 * s2][3]);
                        w.z = cvt_pk_bf16(Sa[mq][2 * s2 + 1][0], Sa[mq][2 * s2 + 1][1]); w.w = cvt_pk_bf16(Sa[mq][2 * s2 + 1][2], Sa[mq][2 * s2 + 1][3]); Pf[mq][s2] = __builtin_bit_cast(bf16x8, w); }
                }
#pragma unroll
                for (int db = 0; db < 4; ++db)
#pragma unroll
                    for (int s2 = 0; s2 < 2; ++s2) { const bf16x8 Vf = *(const LAS bf16x8*)(Vs + (16 * db + fr) * 72 + 32 * s2 + 8 * fq);
#pragma unroll
                        for (int mq = 0; mq < 4; ++mq) Oa[mq][db] = __builtin_amdgcn_mfma_f32_16x16x32_bf16(Vf, Pf[mq][s2], Oa[mq][db], 0, 0, 0); }
            }
        }
#pragma unroll
        for (int mq = 0; mq < 4; ++mq) { float l = lrun[mq]; l += __shfl_xor(l, 16); l += __shfl_xor(l, 32); const float inv = 1.0f / l;
            bf16_t* op = O + (size_t)(qrow0 + 16 * mq + fr) * D + head * 64 + 4 * fq;
#pragma unroll
            for (int db = 0; db < 4; ++db) st_bf4(op + 16 * db, Oa[mq][db] * inv); }
    }
    __syncthreads();
}

struct KState { XcdBarrier bar; int ph; };
#define RUN() (A.one || A.phase == KS.ph)
#define SEAM() do { if (A.one) xcd_barrier(KS.bar); ++KS.ph; } while (0)
template <int LAYER>
__device__ __forceinline__ void layer_body(Frame& F, const Args& A, KState& KS) {
    constexpr int layer = LAYER, kind = LAYER % 3, j = LAYER / 3; constexpr bool last = (LAYER == DEPTH - 1);
    LAS unsigned char* ring = F.lds;
    const LAS int* tpre = (const LAS int*)(F.lds + TPRE_OFF); const LAS int* lcnt = (const LAS int*)(F.lds + LCNT_OFF);
    float* H = WSP(float, WS_H); const float* MOD = WSP(float, WS_MOD); const bf16_t* AX = WSP(bf16_t, WS_AX);
    const float* gate1 = MOD + (size_t)layer * 33 * 6144 + 2 * D;
    constexpr int nMall = last ? NX / 256 : NT / 256;
    if (RUN()) phase_norm1(F, A, layer);
    SEAM();
    if constexpr (kind == 0) {
        if (RUN()) for (int rep_ = 0; rep_ < REPN(1); ++rep_) {
            { pg8::ProbDense P; P.A = AX; P.Bt = WSP(bf16_t, WS_WQK) + (size_t)j * 1280 * D; P.lda = D; P.ldb = D; P.K = D; P.a_pn_off = 0; P.ord.init(NT / 256, 5, F.G, F.c);
              EpiQK E{WSP(bf16_t, WS_Q), WSP(bf16_t, WS_K), WSP(float, WS_BQK) + j * 1280, WSP(float, WS_ROPEC), WSP(float, WS_ROPES)};
              pg8::gemm_phase(ring, P, E); }
            { pg8::ProbDense P; P.A = WSP(bf16_t, WS_WV) + (size_t)j * 256 * D; P.Bt = AX; P.lda = D; P.ldb = D; P.K = D; P.a_pn_off = 0; P.ord.init(1, NT / 256, F.G, F.c);
              EpiVT E{WSP(bf16_t, WS_VT), A.in[I_ABQKV] + j * 1536 + 1280};
              pg8::gemm_phase(ring, P, E); }
        }
        SEAM();
        if (RUN()) for (int rep_ = 0; rep_ < REPN(2); ++rep_) phase_attn(F, A, j, !last);
        SEAM();
        if (RUN() && !((SKIPMASK >> layer) & 1)) { pg8::ProbDense P; P.A = WSP(bf16_t, WS_O); P.Bt = WSP(bf16_t, WS_WO) + (size_t)j * D * D; P.lda = D; P.ldb = D; P.K = D; P.a_pn_off = 0; P.ord.init(nMall, 4, F.G, F.c);
            EpiResid E{H, A.in[I_ABO] + j * D, nullptr, gate1};
            pg8::gemm_phase(ring, P, E); }
        SEAM();
    } else if constexpr (kind == 1) {
        if (RUN()) for (int rep_ = 0; rep_ < REPN(3); ++rep_) phase_pooldiff(F);
        SEAM();
        if (RUN() && !((SKIPMASK >> layer) & 1)) { pg8::ProbDense P; P.A = WSP(bf16_t, WS_PD); P.Bt = WSP(bf16_t, WS_POOLW); P.lda = D; P.ldb = 256; P.K = 256; P.a_pn_off = 256; P.ord.init(nMall, 4, F.G, F.c);
            EpiResid E{H, A.in[I_PB], A.in[I_PS], gate1};
            pg8::gemm_phase(ring, P, E); }
        SEAM();
    } else {
        if (RUN()) for (int rep_ = 0; rep_ < REPN(4); ++rep_) phase_rwkv_mix(F, A);
        SEAM();
        if (RUN()) for (int rep_ = 0; rep_ < REPN(5); ++rep_) {
            for (int i = 0; i < 3; ++i) { const int sel = i == 0 ? 0 : i == 1 ? 2 : 3;
                pg8::ProbDense P; P.A = WSP(bf16_t, WS_A6) + (size_t)sel * NT * D; P.Bt = WSP(bf16_t, WS_WRKV) + (size_t)i * D * D; P.lda = D; P.ldb = D; P.K = D; P.a_pn_off = 0; P.ord.init(NT / 256, 4, F.G, F.c);
                EpiBf16Act E{WSP(bf16_t, WS_RKV) + (size_t)i * NT * D, D, nullptr, 0, 1.0f};
                pg8::gemm_phase(ring, P, E); }
            for (int i = 0; i < 3; ++i) { const int sel = i == 0 ? 5 : i == 1 ? 1 : 4;
                pg8::ProbDense P; P.A = WSP(bf16_t, WS_A6) + (size_t)sel * NT * D; P.Bt = WSP(bf16_t, WS_WL1) + (size_t)i * 256 * D; P.lda = D; P.ldb = D; P.K = D; P.a_pn_off = 0; P.ord.init(NT / 256, 1, F.G, F.c);
                EpiBf16Act E{WSP(bf16_t, WS_LORA) + i * 256, 768, nullptr, i == 0 ? 1 : i == 1 ? 2 : 0, 1.0f};
                pg8::gemm_phase(ring, P, E); }
        }
        SEAM();
        if (RUN()) for (int rep_ = 0; rep_ < REPN(6); ++rep_) {
            for (int i = 0; i < 5; ++i) {
                const int ablk = i == 0 ? 0 : i < 3 ? 1 : 2, d = (i - 1) & 1;
                pg8::ProbDense P; P.A = WSP(bf16_t, WS_LORA) + ablk * 256; P.Bt = WSP(bf16_t, WS_WL2) + (size_t)i * D * 256; P.lda = 768; P.ldb = 256; P.K = 256; P.a_pn_off = 0; P.ord.init(NT / 256, 4, F.G, F.c);
                EpiBf16Act E; E.ldc = D;
                if (i == 0) { E.O = WSP(bf16_t, WS_G); E.bias = nullptr; E.act = 0; E.scale = 1.0f; }
                else if (i < 3) { E.O = WSP(bf16_t, WS_E) + (size_t)d * NT * D; E.bias = A.in[I_RW0] + d * D; E.act = 1; E.scale = 0.6065306597126334f; }
                else { E.O = WSP(bf16_t, WS_A) + (size_t)d * NT * D; E.bias = A.in[I_RA0] + d * D; E.act = 1; E.scale = 1.0f; }
                pg8::gemm_phase(ring, P, E); }
        }
        SEAM();
        if (RUN()) for (int rep_ = 0; rep_ < REPN(7); ++rep_) phase_rwkv_scan(F, A);
        SEAM();
        if (RUN()) for (int rep_ = 0; rep_ < REPN(8); ++rep_) phase_rwkv_out(F, A, last ? NX : NT);
        SEAM();
        if (RUN() && !((SKIPMASK >> layer) & 1)) { pg8::ProbDense P; P.A = WSP(bf16_t, WS_RO); P.Bt = WSP(bf16_t, WS_WOR); P.lda = D; P.ldb = D; P.K = D; P.a_pn_off = 0; P.ord.init(nMall, 4, F.G, F.c);
            EpiResid E{H, nullptr, nullptr, gate1};
            pg8::gemm_phase(ring, P, E); }
        SEAM();
    }
    if (RUN()) phase_route(F, A, layer);
    SEAM();
    if (RUN()) for (int rep_ = 0; rep_ < REPN(9); ++rep_) { moe_tiles(F, layer);
        ProbMoe1 P; P.FX = WSP(fp8_t, WS_FX); P.W1T = WSP(fp8_t, WS_W1T) + (size_t)layer * NE * 2048 * D; P.list = WSP(int, WS_LIST); P.tpre = tpre; P.cnt = lcnt; P.scale_w = SCALE_W; P.scale_x = SCALE_ONE; P.ord.init(tpre[NE], 8, F.G, F.c);
        EpiMoe1 E{WSP(unsigned char, WS_ACT), A.in[I_MB1] + (size_t)layer * NE * 2048};
        pg8::gemm_phase(ring, P, E); }
    SEAM();
    if (RUN()) for (int rep_ = 0; rep_ < REPN(10); ++rep_) { moe_tiles(F, layer);
        ProbMoe2 P; P.ACT = WSP(fp8_t, WS_ACT); P.W2T = WSP(fp8_t, WS_W2T) + (size_t)layer * NE * D * D; P.tpre = tpre; P.scale_w = SCALE_W; P.scale_x = SCALE_ONE; P.ord.init(tpre[NE], 4, F.G, F.c);
        EpiMoe2 E{WSP(bf16_t, WS_Y), A.in[I_MB2] + (size_t)layer * NE * D};
        pg8::gemm_phase(ring, P, E); }
    SEAM();
}
__global__ void __launch_bounds__(NTHREADS, 2) trunk_fwd(Args A) {
    extern __shared__ __attribute__((aligned(16))) unsigned char lds_[];
    Frame F; F.lds = (LAS unsigned char*)lds_; REFRESH(F); F.wave = __builtin_amdgcn_readfirstlane(F.tid >> 6);
    F.G = gridDim.x; F.c = blockIdx.x; F.ws = A.ws; F.ctl = (unsigned*)(A.ws + WS_CTL);
    for (int u = F.tid; u < (LDS_BYTES - LDSCTL_OFF) / 4; u += NTHREADS) ((LAS unsigned*)(F.lds + LDSCTL_OFF))[u] = 0u;
    __syncthreads();
    KState KS; KS.bar.bar = F.ctl + CW_BAR; KS.bar.x = 0; KS.bar.st = nullptr; KS.ph = 0;
    if (A.one) KS.bar = xcd_barrier_post(F.ctl + CW_BAR, (volatile LAS unsigned*)(F.lds + MISC_OFF) + 8);
    if (RUN()) for (int rep_ = 0; rep_ < REPN(0); ++rep_) phase_prologue(F, A);
    SEAM();
    layer_body<0>(F, A, KS);
    layer_body<1>(F, A, KS);
    layer_body<2>(F, A, KS);
    layer_body<3>(F, A, KS);
    if (RUN()) phase_final(F, A);
}
#undef RUN
#undef SEAM
static int count_phases() { int n = 1; for (int layer = 0; layer < DEPTH; ++layer) { const int kind = layer % 3; n += 1 + (kind == 0 ? 3 : kind == 1 ? 2 : 6) + 3; } return n + 1; }

extern "C" void kernel_launch(void* const* d_in, const int* in_sizes, int n_in, void* d_out, int out_size, void* d_ws, size_t ws_size, hipStream_t stream) {
    static int grid = 0;
    if (grid == 0) {
        if (n_in != 38 || out_size != NX * D || ws_size < WS_END) { fprintf(stderr, "kernel_launch: unexpected problem (n_in %d, out %d, ws %zu < %zu)\n", n_in, out_size, ws_size, (size_t)WS_END); grid = -1; return; }
        int dev = 0, cus = 0;
        if (hipGetDevice(&dev) != hipSuccess || hipDeviceGetAttribute(&cus, hipDeviceAttributeMultiprocessorCount, dev) != hipSuccess) { grid = -1; return; }
        if (hipFuncSetAttribute((const void*)trunk_fwd, hipFuncAttributeMaxDynamicSharedMemorySize, LDS_BYTES) != hipSuccess) { fprintf(stderr, "kernel_launch: hipFuncSetAttribute failed\n"); grid = -1; return; }
        int per_cu = 0;
        if (hipOccupancyMaxActiveBlocksPerMultiprocessor(&per_cu, (const void*)trunk_fwd, NTHREADS, LDS_BYTES) != hipSuccess || per_cu < 1) fprintf(stderr, "kernel_launch: occupancy query says %d\n", per_cu);
        (void)hipGetLastError();
        grid = cus;
        if (grid != 256) fprintf(stderr, "kernel_launch: %d CUs (built for 256)\n", grid);
    }
    if (grid < 0) return;
    (void)hipMemsetAsync((char*)d_ws + WS_CTL, 0, CTL_BYTES, stream);
    (void)hipMemsetAsync((char*)d_ws + WS_LZERO, 0, LZERO_BYTES, stream);
    Args a{};
    for (int i = 0; i < 38; ++i) a.in[i] = (const float*)d_in[i];
    a.out = (float*)d_out; a.ws = (unsigned char*)d_ws;
#if MK_ONE_LAUNCH
    a.phase = 0; a.one = 1;
    hipLaunchKernelGGL(trunk_fwd, dim3(grid), dim3(NTHREADS), LDS_BYTES, stream, a);
#else
    const int nph = count_phases();
    for (int p = 0; p < nph; ++p) { a.phase = p; a.one = 0; hipLaunchKernelGGL(trunk_fwd, dim3(grid), dim3(NTHREADS), LDS_BYTES, stream, a); }
#endif
}
```

```cpp
#include <hip/hip_runtime.h>
#include <cstdio>
#include <cstdint>

#ifndef MK_ONE_LAUNCH
#define MK_ONE_LAUNCH 1
#endif
#ifndef REPMASK
#define REPMASK 0x000
#endif
#define REPN(k) (1 + ((REPMASK >> (k)) & 1))
#ifndef DIAG
#define DIAG 0
#endif
#ifndef SKIPMASK
#define SKIPMASK 0x00
#endif

#define LAS __attribute__((address_space(3)))
#define GAS __attribute__((address_space(1)))
typedef unsigned short bf16_t;
typedef short bf16x8 __attribute__((ext_vector_type(8)));
typedef float f32x4 __attribute__((ext_vector_type(4)));
typedef float f32x2 __attribute__((ext_vector_type(2)));
typedef unsigned u32x4 __attribute__((ext_vector_type(4)));
typedef unsigned u32x2 __attribute__((ext_vector_type(2)));

constexpr int D = 1024, NB = 32, T = 2048, L = 256, DEPTH = 4;
constexpr int NX = NB * T, NC = NB * L, NT = NX + NC;
constexpr int NE = 32, TOPK = 4;
constexpr int NWAVES = 8, NTHREADS = 512;
constexpr int MAXRT = NT * TOPK / 256 + NE;

constexpr size_t MiB = 1u << 20;
constexpr size_t WS_CTL = 0, CTL_BYTES = 4 * MiB;
constexpr size_t WS_MOD = 4 * MiB;
constexpr size_t WS_ROPEC = 8 * MiB, WS_ROPES = 8 * MiB + 512 * 1024;
constexpr size_t WS_BQK = 9 * MiB;
constexpr size_t WS_WQK = 10 * MiB;
constexpr size_t WS_WV = 15 * MiB;
constexpr size_t WS_WO = 16 * MiB;
constexpr size_t WS_POOLW = 20 * MiB;
constexpr size_t WS_WRKV = 21 * MiB;
constexpr size_t WS_WOR = 27 * MiB;
constexpr size_t WS_WL1 = 30 * MiB;
constexpr size_t WS_WL2 = 32 * MiB;
constexpr size_t WS_LZERO = WS_WL1, LZERO_BYTES = 6 * MiB;
constexpr size_t WS_W1T = 40 * MiB;
constexpr size_t WS_W2T = 552 * MiB;
constexpr size_t WS_H = 808 * MiB;
constexpr size_t WS_AX = 1096 * MiB;
constexpr size_t WS_FX = 1240 * MiB;
constexpr size_t WS_R = 1384 * MiB;
constexpr size_t WS_ACT = WS_R;
constexpr size_t WS_Y = WS_R + 592 * MiB;
constexpr size_t WS_LIST = WS_R + 1184 * MiB;
constexpr size_t WS_POS = WS_R + 1193 * MiB;
constexpr size_t WS_GATE = WS_R + 1195 * MiB;
constexpr size_t WS_Q = WS_R;
constexpr size_t WS_K = WS_R + 144 * MiB;
constexpr size_t WS_VT = WS_R + 180 * MiB;
constexpr size_t WS_O = WS_R + 216 * MiB;
constexpr size_t WS_PD = WS_R;
constexpr size_t WS_A6 = WS_R;
constexpr size_t WS_E = WS_R;
constexpr size_t WS_A = WS_R + 288 * MiB;
constexpr size_t WS_RO = WS_R + 576 * MiB;
constexpr size_t WS_RKV = WS_R + 864 * MiB;
constexpr size_t WS_LORA = WS_R + 1296 * MiB;
constexpr size_t WS_G = WS_R + 1404 * MiB;
constexpr size_t WS_YS = WS_R + 1548 * MiB;
constexpr size_t WS_BONUS = WS_R + 2124 * MiB;
constexpr size_t WS_END = WS_R + 2134 * MiB;

constexpr int CW_BAR = 4096;
constexpr int CW_GCNT = 16384;
constexpr int LDS_BYTES = 147456;
constexpr int RING_BYTES = 131072;
constexpr int LDSCTL_OFF = 135168;
constexpr int MISC_OFF = LDSCTL_OFF;
constexpr int TPRE_OFF = LDSCTL_OFF + 256;
constexpr int LCNT_OFF = LDSCTL_OFF + 512;
constexpr int LBASE_OFF = LDSCTL_OFF + 768;
constexpr int REC_OFF = LDSCTL_OFF + 1024;
constexpr int TEXP_OFF = LDSCTL_OFF + 1024 + 2048;
constexpr int TOKS_OFF = LDSCTL_OFF + 1024 + 4096;
constexpr int JOB_OFF = LDSCTL_OFF + 1024;

__device__ __forceinline__ unsigned f2bf(float f) { unsigned u = __builtin_bit_cast(unsigned, f); return (u + 0x7fffu + ((u >> 16) & 1u)) >> 16; }
__device__ __forceinline__ unsigned pk2(float lo, float hi) { return f2bf(lo) | (f2bf(hi) << 16); }
__device__ __forceinline__ float bflo(unsigned w) { return __builtin_bit_cast(float, w << 16); }
__device__ __forceinline__ float bfhi(unsigned w) { return __builtin_bit_cast(float, w & 0xffff0000u); }
__device__ __forceinline__ float bf1(bf16_t b) { return __builtin_bit_cast(float, ((unsigned)b) << 16); }
__device__ __forceinline__ unsigned pk4_fp8(float a, float b, float c, float d) { int w = __builtin_amdgcn_cvt_pk_fp8_f32(a, b, 0, false); w = __builtin_amdgcn_cvt_pk_fp8_f32(c, d, w, true); return (unsigned)w; }
typedef __bf16 bf16x2_t __attribute__((ext_vector_type(2)));
__device__ __forceinline__ unsigned cvt_pk_bf16(float lo, float hi) { const f32x2 v = {lo, hi}; return __builtin_bit_cast(unsigned, __builtin_convertvector(v, bf16x2_t)); }
__device__ __forceinline__ float dpp_add(float v, const int ctrl, const int row_mask) {
    switch (ctrl) {
    case 0xB1:  return v + __builtin_bit_cast(float, __builtin_amdgcn_update_dpp(0, __builtin_bit_cast(int, v), 0xB1, 0xf, 0xf, true));
    case 0x4E:  return v + __builtin_bit_cast(float, __builtin_amdgcn_update_dpp(0, __builtin_bit_cast(int, v), 0x4E, 0xf, 0xf, true));
    case 0x141: return v + __builtin_bit_cast(float, __builtin_amdgcn_update_dpp(0, __builtin_bit_cast(int, v), 0x141, 0xf, 0xf, true));
    case 0x140: return v + __builtin_bit_cast(float, __builtin_amdgcn_update_dpp(0, __builtin_bit_cast(int, v), 0x140, 0xf, 0xf, true));
    case 0x142: return v + __builtin_bit_cast(float, __builtin_amdgcn_update_dpp(0, __builtin_bit_cast(int, v), 0x142, 0xa, 0xf, true));
    default:    return v + __builtin_bit_cast(float, __builtin_amdgcn_update_dpp(0, __builtin_bit_cast(int, v), 0x143, 0xc, 0xf, true));
    }
}
__device__ __forceinline__ float row16_sum(float v) { v = dpp_add(v, 0xB1, 0xf); v = dpp_add(v, 0x4E, 0xf); v = dpp_add(v, 0x141, 0xf); v = dpp_add(v, 0x140, 0xf); return v; }
__device__ __forceinline__ float wave_sum(float v) {
    v = row16_sum(v); v = dpp_add(v, 0x142, 0xa); v = dpp_add(v, 0x143, 0xc);
    return __builtin_bit_cast(float, __builtin_amdgcn_readlane(__builtin_bit_cast(int, v), 63));
}
__device__ __forceinline__ float sigmoidf_(float x) { return __builtin_amdgcn_rcpf(1.0f + __builtin_amdgcn_exp2f(-1.4426950408889634f * x)); }
__device__ __forceinline__ int opaque_tid() { int t; asm volatile("v_mov_b32 %0, %1" : "=v"(t) : "v"(threadIdx.x)); return t; }
#define REFRESH(F) do { (F).tid = opaque_tid(); (F).lane = (F).tid & 63; } while (0)
__device__ __forceinline__ void seq_of(int row, int& sb, int& t, int& n) { if (row < NX) { sb = row & ~(T - 1); t = row & (T - 1); n = T; } else { const int r2 = row - NX; sb = NX + (r2 & ~(L - 1)); t = r2 & (L - 1); n = L; } }
__device__ __forceinline__ f32x4 ld_bf4(const bf16_t* p) { const u32x2 w = *(const u32x2*)p; return (f32x4){bflo(w.x), bfhi(w.x), bflo(w.y), bfhi(w.y)}; }
__device__ __forceinline__ void st_bf4(bf16_t* p, f32x4 v) { u32x2 w; w.x = pk2(v.x, v.y); w.y = pk2(v.z, v.w); *(u32x2*)p = w; }

#define LDS_WAIT() asm volatile("s_waitcnt lgkmcnt(0)" ::: "memory")
#define VM_WAIT() asm volatile("s_waitcnt vmcnt(0)" ::: "memory")

#define XB_TMO      128
#define XB_XCNT(j)  (256  + 64 * (j))
#define XB_XSUB(j)  (1280 + 64 * (j))
#define XB_XGEN(j)  (2304 + 64 * (j))
#define XB_TOP      3328
#define XB_TOPGEN   3392
#define XCD_BAR_WORDS 3456
#define XB_SPIN_CAP (1u << 18)
__device__ __forceinline__ unsigned xb_ld(unsigned* p)              { return __hip_atomic_load(p, __ATOMIC_RELAXED, __HIP_MEMORY_SCOPE_AGENT); }
__device__ __forceinline__ unsigned xb_add(unsigned* p, unsigned v) { return __hip_atomic_fetch_add(p, v, __ATOMIC_RELAXED, __HIP_MEMORY_SCOPE_AGENT); }
__device__ __forceinline__ unsigned xb_xcc_id() { return (unsigned)__builtin_amdgcn_s_getreg((3 << 11) | 20) & 0xFu; }
#define XB_SPIN(cond, bar) do { unsigned _sp = 0; while (cond) { __builtin_amdgcn_s_sleep(1); \
    if ((++_sp & 255u) == 0u) { if (xb_ld(&(bar)[XB_TMO])) break; if (_sp > XB_SPIN_CAP) { atomicAdd(&(bar)[XB_TMO], 1u); break; } } } } while (0)
struct XcdBarrier { unsigned* bar; unsigned x; volatile LAS unsigned* st; };
__device__ __forceinline__ XcdBarrier xcd_barrier_post(unsigned* bar, volatile LAS unsigned* st) {
    XcdBarrier b; b.bar = bar; b.x = xb_xcc_id(); b.st = st;
    if (threadIdx.x == 0) (void)xb_add(&bar[XB_XCNT(b.x)], 1u);
    return b;
}
__device__ __forceinline__ void xcd_barrier_complete(unsigned* bar, unsigned x, unsigned& nloc, unsigned& nx) {
    const unsigned G = gridDim.x * gridDim.y * gridDim.z;
    unsigned sum, cnt, mine, sp = 0u;
    for (;;) {
        sum = 0u; cnt = 0u; mine = 0u;
#pragma unroll
        for (unsigned j = 0; j < 16; ++j) { const unsigned c = xb_ld(&bar[XB_XCNT(j)]); sum += c; cnt += (c > 0u) ? 1u : 0u; mine = (j == x) ? c : mine; }
        if (sum == G) break;
        __builtin_amdgcn_s_sleep(1);
        if ((++sp & 255u) == 0u) { if (xb_ld(&bar[XB_TMO])) break; if (sp > XB_SPIN_CAP) { atomicAdd(&bar[XB_TMO], 1u); break; } }
    }
    nloc = mine > 0u ? mine : 1u; nx = cnt > 0u ? cnt : 1u;
}
__device__ __forceinline__ void xcd_barrier(const XcdBarrier& b) {
    asm volatile("s_waitcnt vmcnt(0)" ::: "memory");
    __syncthreads();
    if (threadIdx.x == 0) {
        unsigned* bar = b.bar;
        __builtin_amdgcn_s_waitcnt(0);
        unsigned nloc = b.st[0], nx = b.st[1];
        if (nloc == 0u) { xcd_barrier_complete(bar, b.x, nloc, nx); b.st[0] = nloc; b.st[1] = nx; }
        const unsigned old = xb_add(&bar[XB_XSUB(b.x)], 1u);
        const unsigned gen = old / nloc;
        if (old + 1u == (gen + 1u) * nloc) {
            __builtin_amdgcn_fence(__ATOMIC_RELEASE, "agent");
            asm volatile("s_waitcnt vmcnt(0)" ::: "memory");
            const unsigned og = xb_add(&bar[XB_TOP], 1u);
            const unsigned tg = og / nx;
            if (og + 1u == (tg + 1u) * nx) xb_add(&bar[XB_TOPGEN], 1u);
            else XB_SPIN(xb_ld(&bar[XB_TOPGEN]) == tg, bar);
            __builtin_amdgcn_fence(__ATOMIC_ACQUIRE, "agent");
            xb_add(&bar[XB_XGEN(b.x)], 1u);
            asm volatile("s_waitcnt vmcnt(0)" ::: "memory");
        } else {
            XB_SPIN(xb_ld(&bar[XB_XGEN(b.x)]) == gen, bar);
            __builtin_amdgcn_fence(__ATOMIC_ACQUIRE, "agent");
            asm volatile("s_waitcnt vmcnt(0)" ::: "memory");
        }
    }
    __syncthreads();
}

namespace pg8 {
constexpr int BM = 256, BK = 64, HALF = 128, HTB = HALF * BK * 2, STAGE_BYTES = 8 * HTB, NXCD = 8, WGM = 8;
__host__ __device__ __forceinline__ int lds_byte(int r, int c) { const int st = (r >> 4) * 2 + (c >> 5), rr = r & 15, cc = c & 31, ob = rr * 64 + cc * 2; return st * 1024 + (ob ^ (((ob >> 9) & 1) << 5)); }
__host__ __device__ __forceinline__ void stage_rc(int b, int& R, int& C) { const int st = b / 1024, sb = b % 1024, swz = sb ^ (((sb >> 9) & 1) << 5); R = (st >> 1) * 16 + swz / 64; C = (st & 1) * 32 + (swz % 64) / 2; }
__host__ __device__ __forceinline__ int perm32(int rho) { const int n = rho >> 4, i = rho & 15; return 8 * (i >> 2) + 4 * n + (i & 3); }

typedef int i32x8 __attribute__((ext_vector_type(8)));
typedef int i32x4 __attribute__((ext_vector_type(4)));
__device__ __forceinline__ i32x8 cat8(bf16x8 lo, bf16x8 hi) { const i32x4 a = __builtin_bit_cast(i32x4, lo), b = __builtin_bit_cast(i32x4, hi); return __builtin_shufflevector(a, b, 0, 1, 2, 3, 4, 5, 6, 7); }
struct Unit { int pm, pn, e, rt; };
struct TileOrder {
    int nM, nN, nwg, G, c;
    __device__ __forceinline__ void init(int nM_, int nN_, int G_, int c_) { nM = nM_; nN = nN_; nwg = nM * nN; G = G_; c = c_; }
    __device__ __forceinline__ bool next(int i, int& pm, int& pn) const {
        const long Lx = (long)i * G + c; if (Lx >= nwg) return false;
        int wgid = (int)Lx; { const int q = nwg / NXCD, r = nwg % NXCD, xcd = wgid % NXCD, off = wgid / NXCD; wgid = (xcd < r ? xcd * (q + 1) : r * (q + 1) + (xcd - r) * q) + off; }
        const int nig = WGM * nN, gid = wgid / nig, fm = gid * WGM, gsz = (nM - fm) < WGM ? (nM - fm) : WGM;
        pm = fm + ((wgid % nig) % gsz); pn = (wgid % nig) / gsz; return true;
    }
};
struct ProbDense {
    static constexpr bool FP8 = false;
    const bf16_t* A; const bf16_t* Bt; int lda, ldb, K, a_pn_off; TileOrder ord;
    __device__ __forceinline__ int ldb_bytes() const { return ldb * 2; }
    __device__ __forceinline__ int ntiles() const { return K / 64; }
    __device__ __forceinline__ bool next(int i, Unit& u) const { u.e = 0; const bool ok = ord.next(i, u.pm, u.pn); u.rt = u.pm; return ok; }
    __device__ __forceinline__ const char* a_ptr(const Unit& u) const { return (const char*)(A + (size_t)u.pm * BM * lda + (size_t)u.pn * a_pn_off); }
    __device__ __forceinline__ const char* b_ptr(const Unit& u) const { return (const char*)(Bt + (size_t)u.pn * BM * ldb); }
    __device__ __forceinline__ void list_prefetch(const Unit&, int, int, int) const {}
    __device__ __forceinline__ void a_off(const Unit&, int, const int (&R)[2], const int (&C)[2], unsigned (&v)[2][2]) const {
#pragma unroll
        for (int h = 0; h < 2; ++h)
#pragma unroll
            for (int i = 0; i < 2; ++i) v[h][i] = (unsigned)((h * HALF + R[i]) * lda + C[i]) * 2u;
    }
};

template <class Prob, class Epi>
__device__ __forceinline__ void gemm_phase(LAS unsigned char* lds, const Prob& P, const Epi& E) {
    const int tid = opaque_tid(), wid = __builtin_amdgcn_readfirstlane(tid >> 6), lane = tid & 63, wr = wid >> 2, wc = wid & 3, fr = lane & 15, fq = lane >> 4;
    const int nt = P.ntiles(); const int ldbB = P.ldb_bytes();
    int Rr[2], Cc[2]; unsigned voffB[2];
#pragma unroll
    for (int i = 0; i < 2; ++i) { int R, C; stage_rc(tid * 16 + i * 8192, R, C); Rr[i] = R; Cc[i] = C; const int Rb = Epi::PERM ? ((R & ~31) + perm32(R & 31)) : R;
        voffB[i] = (unsigned)(Rb * ldbB + C * 2); }
    const size_t kstep = (size_t)(BK * 2);
    const size_t hstepB = (size_t)HALF * ldbB;
    const unsigned ldsw = (unsigned)wid * 1024u;
    const int aoff = lds_byte(wr * 64 + fr, fq * 8), boff = lds_byte(wc * 32 + fr, fq * 8);
#define PG8_SA(b, h) (((b) * 2 + (h)) * HTB)
#define PG8_SB(b, h) ((4 + (b) * 2 + (h)) * HTB)
#define PG8_STAGE(bufoff, gbase, voff) do { _Pragma("unroll") for (int _i = 0; _i < 2; ++_i) \
        __builtin_amdgcn_global_load_lds((const unsigned*)((const char*)(gbase) + (voff)[_i]), (LAS unsigned*)(lds + (bufoff) + ldsw + _i * 8192), 16, 0, 0); } while (0)
#define PG8_LDA(dst, b, h) do { _Pragma("unroll") for (int m = 0; m < 4; ++m) _Pragma("unroll") for (int k = 0; k < 2; ++k) dst[m][k] = *(const LAS bf16x8*)(lds + PG8_SA(b, h) + aoff + m * 2048 + k * 1024); } while (0)
#define PG8_LDB(dst, b, h) do { _Pragma("unroll") for (int n = 0; n < 2; ++n) _Pragma("unroll") for (int k = 0; k < 2; ++k) dst[n][k] = *(const LAS bf16x8*)(lds + PG8_SB(b, h) + boff + n * 2048 + k * 1024); } while (0)
#define PG8_MMA(ai, bj, At, Bt) do { __builtin_amdgcn_s_setprio(1); _Pragma("unroll") for (int m = 0; m < 4; ++m) _Pragma("unroll") for (int n = 0; n < 2; ++n) { \
        if constexpr (Prob::FP8) { asm volatile("v_mfma_scale_f32_16x16x128_f8f6f4 %0, %1, %2, %0, %3, %4 op_sel_hi:[0,0,0]" : "+v"(acc[ai][bj][m][n]) : "v"(cat8(Bt[n][0], Bt[n][1])), "v"(cat8(At[m][0], At[m][1])), "v"(sc_w), "v"(sc_x)); } \
        else { _Pragma("unroll") for (int k = 0; k < 2; ++k) acc[ai][bj][m][n] = __builtin_amdgcn_mfma_f32_16x16x32_bf16(Bt[n][k], At[m][k], acc[ai][bj][m][n], 0, 0, 0); } } __builtin_amdgcn_s_setprio(0); } while (0)
#define PG8_WAIT_V(n) asm volatile("s_waitcnt vmcnt(" #n ")" ::: "memory")
#define PG8_WAIT_L(n) asm volatile("s_waitcnt lgkmcnt(" #n ")" ::: "memory")
#define PG8_BAR __builtin_amdgcn_s_barrier()
#define PG8_SCHED __builtin_amdgcn_sched_barrier(0)
    Unit cur, nxt; int ui = 0;
    if (!P.next(0, cur)) return;
    int sc_w = 0, sc_x = 0; if constexpr (Prob::FP8) { sc_w = P.scale_w; sc_x = P.scale_x; } (void)sc_w; (void)sc_x;
    f32x4 acc[2][2][4][2];
#pragma unroll
    for (int a = 0; a < 2; ++a)
#pragma unroll
        for (int b = 0; b < 2; ++b)
#pragma unroll
            for (int m = 0; m < 4; ++m)
#pragma unroll
                for (int n = 0; n < 2; ++n) acc[a][b][m][n] = (f32x4){0.f, 0.f, 0.f, 0.f};
    bf16x8 At[4][2], B0[2][2], B1[2][2];
    unsigned vAc[2][2], vAn[2][2];
    P.list_prefetch(cur, 0, wid, lane); { Unit u1; if (P.next(1, u1)) P.list_prefetch(u1, 1, wid, lane); }
    PG8_WAIT_V(0); PG8_BAR;
    P.a_off(cur, 0, Rr, Cc, vAc);
    const char* cA = P.a_ptr(cur); const char* cB = P.b_ptr(cur);
    PG8_STAGE(PG8_SB(0, 0), cB, voffB); PG8_STAGE(PG8_SB(0, 1), cB + hstepB, voffB); PG8_STAGE(PG8_SA(0, 0), cA, vAc[0]); PG8_STAGE(PG8_SA(0, 1), cA, vAc[1]);
    if (wr == 1) PG8_BAR;
    PG8_WAIT_V(2); PG8_BAR;
    PG8_STAGE(PG8_SB(1, 0), cB + kstep, voffB); PG8_STAGE(PG8_SA(1, 0), cA + kstep, vAc[0]); PG8_STAGE(PG8_SB(1, 1), cB + hstepB + kstep, voffB);
    PG8_WAIT_V(6); PG8_BAR;
    for (;;) {
        const bool has_next = P.next(ui + 1, nxt);
        const char* nA = cA; const char* nB = cB;
#pragma unroll
        for (int h = 0; h < 2; ++h)
#pragma unroll
            for (int i = 0; i < 2; ++i) vAn[h][i] = vAc[h][i];
        if (has_next) { nA = P.a_ptr(nxt); nB = P.b_ptr(nxt); P.a_off(nxt, (ui + 1) & 1, Rr, Cc, vAn); }
        { Unit u2; if (P.next(ui + 2, u2)) P.list_prefetch(u2, ui & 1, wid, lane); }
        for (int t = 0; t < nt; t += 2) {
            const bool last = (t == nt - 2);
            const char* a1 = cA + (size_t)(t + 1) * kstep;
            const char* a2 = last ? nA : cA + (size_t)(t + 2) * kstep; const char* b2 = last ? nB : cB + (size_t)(t + 2) * kstep;
            const char* a3 = a2 + kstep; const char* b3 = b2 + kstep;
            unsigned vX[2][2];
#pragma unroll
            for (int h = 0; h < 2; ++h)
#pragma unroll
                for (int i = 0; i < 2; ++i) vX[h][i] = last ? vAn[h][i] : vAc[h][i];
            PG8_LDB(B0, 0, 0); PG8_LDB(B1, 0, 1); PG8_SCHED; PG8_LDA(At, 0, 0); PG8_STAGE(PG8_SA(1, 1), a1, vAc[1]);
            PG8_WAIT_V(8); PG8_WAIT_L(0); PG8_BAR; PG8_MMA(0, 0, At, B0); PG8_MMA(0, 1, At, B1); PG8_BAR; PG8_SCHED;
            PG8_LDA(At, 0, 1); PG8_STAGE(PG8_SB(0, 0), b2, voffB); PG8_STAGE(PG8_SB(0, 1), b2 + hstepB, voffB); PG8_STAGE(PG8_SA(0, 0), a2, vX[0]);
            PG8_WAIT_V(8); PG8_WAIT_L(0); PG8_BAR; PG8_MMA(1, 0, At, B0); PG8_MMA(1, 1, At, B1); PG8_BAR; PG8_SCHED;
            PG8_LDB(B0, 1, 0); PG8_LDB(B1, 1, 1); PG8_SCHED; PG8_LDA(At, 1, 0); PG8_STAGE(PG8_SA(0, 1), a2, vX[1]);
            PG8_WAIT_V(8); PG8_WAIT_L(0); PG8_BAR; PG8_MMA(0, 0, At, B0); PG8_MMA(0, 1, At, B1); PG8_BAR; PG8_SCHED;
            PG8_LDA(At, 1, 1); PG8_STAGE(PG8_SB(1, 0), b3, voffB); PG8_STAGE(PG8_SB(1, 1), b3 + hstepB, voffB); PG8_STAGE(PG8_SA(1, 0), a3, vX[0]);
            PG8_WAIT_V(8); PG8_WAIT_L(0); PG8_BAR; PG8_MMA(1, 0, At, B0); PG8_MMA(1, 1, At, B1); PG8_BAR; PG8_SCHED;
        }
        if (wr == 0) PG8_BAR;
        if constexpr (Prob::FP8) asm volatile("s_nop 15\n\ts_nop 15" ::: "memory");
        E(acc, cur, wr, wc, fr, fq);
        if (!has_next) break;
#pragma unroll
        for (int a = 0; a < 2; ++a)
#pragma unroll
            for (int b = 0; b < 2; ++b)
#pragma unroll
                for (int m = 0; m < 4; ++m)
#pragma unroll
                    for (int n = 0; n < 2; ++n) acc[a][b][m][n] = (f32x4){0.f, 0.f, 0.f, 0.f};
        cur = nxt; cA = nA; cB = nB; ++ui;
#pragma unroll
        for (int h = 0; h < 2; ++h)
#pragma unroll
            for (int i = 0; i < 2; ++i) vAc[h][i] = vAn[h][i];
        if (wr == 1) PG8_BAR;
    }
    PG8_WAIT_V(0);
    PG8_BAR;
#undef PG8_SA
#undef PG8_SB
#undef PG8_STAGE
#undef PG8_LDA
#undef PG8_LDB
#undef PG8_MMA
#undef PG8_WAIT_V
#undef PG8_WAIT_L
#undef PG8_BAR
#undef PG8_SCHED
}
}

using pg8::Unit;
constexpr int HALF_ = 128;
struct EpiBf16Act {
    static constexpr bool PERM = true;
    bf16_t* O; int ldc; const float* bias; int act; float scale;
    __device__ __forceinline__ void operator()(const f32x4 (&acc)[2][2][4][2], const Unit& u, int wr, int wc, int fr, int fq) const {
        const int row0 = u.pm * 256 + wr * 64 + fr, col0 = u.pn * 256 + wc * 32 + 8 * fq;
        f32x4 bv[2][2];
#pragma unroll
        for (int bj = 0; bj < 2; ++bj)
#pragma unroll
            for (int n = 0; n < 2; ++n) bv[bj][n] = bias ? *(const f32x4*)(bias + col0 + bj * HALF_ + 4 * n) : (f32x4){0.f, 0.f, 0.f, 0.f};
#pragma unroll
        for (int ai = 0; ai < 2; ++ai)
#pragma unroll
            for (int m = 0; m < 4; ++m) { bf16_t* rowp = O + (size_t)(row0 + ai * HALF_ + m * 16) * ldc + col0;
#pragma unroll
                for (int bj = 0; bj < 2; ++bj) { f32x4 v0 = acc[ai][bj][m][0] + bv[bj][0], v1 = acc[ai][bj][m][1] + bv[bj][1];
                    if (act == 1) {
#pragma unroll
                        for (int j = 0; j < 4; ++j) { v0[j] = sigmoidf_(v0[j]) * scale; v1[j] = sigmoidf_(v1[j]) * scale; } }
                    else if (act == 2) {
#pragma unroll
                        for (int j = 0; j < 4; ++j) { v0[j] = 1.0f - 2.0f * __builtin_amdgcn_rcpf(__builtin_amdgcn_exp2f(2.8853900817779268f * v0[j]) + 1.0f); v1[j] = 1.0f - 2.0f * __builtin_amdgcn_rcpf(__builtin_amdgcn_exp2f(2.8853900817779268f * v1[j]) + 1.0f); } }
                    u32x4 w; w.x = cvt_pk_bf16(v0[0], v0[1]); w.y = cvt_pk_bf16(v0[2], v0[3]); w.z = cvt_pk_bf16(v1[0], v1[1]); w.w = cvt_pk_bf16(v1[2], v1[3]);
                    *(u32x4*)(rowp + bj * HALF_) = w; } }
    }
};
struct EpiQK {
    static constexpr bool PERM = true;
    bf16_t* Q; bf16_t* Kb; const float* bias; const float* ropec; const float* ropes;
    __device__ __forceinline__ void operator()(const f32x4 (&acc)[2][2][4][2], const Unit& u, int wr, int wc, int fr, int fq) const {
        int row0 = u.pm * 256 + wr * 64 + fr, cl0 = wc * 32 + 8 * fq;
        asm volatile("" : "+v"(row0), "+v"(cl0));
        const int g = (4 * wc + fq) & 7;
        bf16_t* base; int ldc;
        if (u.pn < 4) { base = Q + u.pn * 256; ldc = 1024; } else { base = Kb; ldc = 256; }
        f32x4 bv[2][2];
#pragma unroll
        for (int bj = 0; bj < 2; ++bj)
#pragma unroll
            for (int n = 0; n < 2; ++n) bv[bj][n] = *(const f32x4*)(bias + u.pn * 256 + cl0 + bj * HALF_ + 4 * n);
#pragma unroll
        for (int ai = 0; ai < 2; ++ai)
#pragma unroll
            for (int m = 0; m < 4; ++m) { const int row = row0 + ai * HALF_ + m * 16; bf16_t* rowp = base + (size_t)row * ldc + cl0;
                f32x4 cs = (f32x4){1.f, 1.f, 1.f, 1.f}, sn = (f32x4){0.f, 0.f, 0.f, 0.f};
                if (row < NX) { const int t = row & (T - 1); cs = *(const f32x4*)(ropec + t * 32 + g * 4); sn = *(const f32x4*)(ropes + t * 32 + g * 4); }
#pragma unroll
                for (int bj = 0; bj < 2; ++bj) { const f32x4 v0 = acc[ai][bj][m][0] + bv[bj][0], v1 = acc[ai][bj][m][1] + bv[bj][1];
                    const f32x4 o0 = v0 * cs - v1 * sn, o1 = v1 * cs + v0 * sn;
                    u32x4 w; w.x = cvt_pk_bf16(o0[0], o0[1]); w.y = cvt_pk_bf16(o0[2], o0[3]); w.z = cvt_pk_bf16(o1[0], o1[1]); w.w = cvt_pk_bf16(o1[2], o1[3]);
                    *(u32x4*)(rowp + bj * HALF_) = w; } }
    }
};
struct EpiVT {
    static constexpr bool PERM = true;
    bf16_t* VT; const float* biasrow;
    __device__ __forceinline__ void operator()(const f32x4 (&acc)[2][2][4][2], const Unit& u, int wr, int wc, int fr, int fq) const {
        int row0 = wr * 64 + fr, col0 = u.pn * 256 + wc * 32 + 8 * fq;
        asm volatile("" : "+v"(row0), "+v"(col0));
#pragma unroll
        for (int ai = 0; ai < 2; ++ai)
#pragma unroll
            for (int m = 0; m < 4; ++m) { const int row = row0 + ai * HALF_ + m * 16; const float b = biasrow[row]; bf16_t* rowp = VT + (size_t)row * NT + col0;
#pragma unroll
                for (int bj = 0; bj < 2; ++bj) { const f32x4 v0 = acc[ai][bj][m][0] + b, v1 = acc[ai][bj][m][1] + b;
                    u32x4 w; w.x = cvt_pk_bf16(v0[0], v0[1]); w.y = cvt_pk_bf16(v0[2], v0[3]); w.z = cvt_pk_bf16(v1[0], v1[1]); w.w = cvt_pk_bf16(v1[2], v1[3]);
                    *(u32x4*)(rowp + bj * HALF_) = w; } }
    }
};
struct EpiResid {
    static constexpr bool PERM = true;
    bf16_t* H; const float* bias; const float* ls; const float* gate;
    __device__ __forceinline__ void operator()(const f32x4 (&acc)[2][2][4][2], const Unit& u, int wr, int wc, int fr, int fq) const {
        int row0 = u.pm * 256 + wr * 64 + fr, col0 = u.pn * 256 + wc * 32 + 8 * fq;
        asm volatile("" : "+v"(row0), "+v"(col0));
        f32x4 bv[2][2], lv[2][2];
#pragma unroll
        for (int bj = 0; bj < 2; ++bj)
#pragma unroll
            for (int n = 0; n < 2; ++n) { bv[bj][n] = bias ? *(const f32x4*)(bias + col0 + bj * HALF_ + 4 * n) : (f32x4){0.f, 0.f, 0.f, 0.f};
                                          lv[bj][n] = ls ? *(const f32x4*)(ls + col0 + bj * HALF_ + 4 * n) : (f32x4){1.f, 1.f, 1.f, 1.f}; }
#pragma unroll
        for (int ai = 0; ai < 2; ++ai)
#pragma unroll
            for (int m = 0; m < 4; ++m) { const int row = row0 + ai * HALF_ + m * 16; const int brow = row < NX ? (row >> 11) : 32;
                bf16_t* hp = H + (size_t)row * D + col0; const float* gp = gate + (size_t)brow * (6 * D) + col0;
#pragma unroll
                for (int bj = 0; bj < 2; ++bj) { const u32x4 hw = *(const u32x4*)(hp + bj * HALF_);
                    const f32x4 g0 = *(const f32x4*)(gp + bj * HALF_), g1 = *(const f32x4*)(gp + bj * HALF_ + 4);
                    const f32x4 y0 = (acc[ai][bj][m][0] + bv[bj][0]) * lv[bj][0], y1 = (acc[ai][bj][m][1] + bv[bj][1]) * lv[bj][1];
                    const f32x4 h0 = (f32x4){bflo(hw.x), bfhi(hw.x), bflo(hw.y), bfhi(hw.y)} + g0 * y0, h1 = (f32x4){bflo(hw.z), bfhi(hw.z), bflo(hw.w), bfhi(hw.w)} + g1 * y1;
                    u32x4 w; w.x = cvt_pk_bf16(h0[0], h0[1]); w.y = cvt_pk_bf16(h0[2], h0[3]); w.z = cvt_pk_bf16(h1[0], h1[1]); w.w = cvt_pk_bf16(h1[2], h1[3]);
                    *(u32x4*)(hp + bj * HALF_) = w; }
                asm volatile("" ::: "memory"); }
    }
};
struct EpiMoe1 {
    static constexpr bool PERM = true;
    unsigned char* ACT; const float* b1;
    __device__ __forceinline__ void operator()(const f32x4 (&acc)[2][2][4][2], const Unit& u, int wr, int wc, int fr, int fq) const {
        const int row0 = u.rt * 256 + wr * 64 + fr, cl = u.pn * 128 + wc * 32 + 8 * fq;
        const float* bg = b1 + (size_t)u.e * 2048 + cl; const float* bl = bg + 1024;
        f32x4 bgv[2], blv[2];
#pragma unroll
        for (int n = 0; n < 2; ++n) { bgv[n] = *(const f32x4*)(bg + 4 * n); blv[n] = *(const f32x4*)(bl + 4 * n); }
#pragma unroll
        for (int ai = 0; ai < 2; ++ai)
#pragma unroll
            for (int m = 0; m < 4; ++m) { unsigned char* rowp = ACT + (size_t)(row0 + ai * HALF_ + m * 16) * D + cl;
                f32x4 o[2];
#pragma unroll
                for (int n = 0; n < 2; ++n) { const f32x4 hg = acc[ai][0][m][n] + bgv[n], hl = acc[ai][1][m][n] + blv[n];
#pragma unroll
                    for (int j = 0; j < 4; ++j) { const float gl = fminf(hg[j], 7.0f); const float li = fminf(fmaxf(hl[j], -7.0f), 7.0f);
                        o[n][j] = gl * sigmoidf_(1.702f * gl) * (li + 1.0f); } }
                u32x2 w; w.x = pk4_fp8(o[0][0], o[0][1], o[0][2], o[0][3]); w.y = pk4_fp8(o[1][0], o[1][1], o[1][2], o[1][3]);
                *(u32x2*)rowp = w; }
    }
};
struct EpiMoe2 {
    static constexpr bool PERM = true;
    bf16_t* Y; const float* b2;
    __device__ __forceinline__ void operator()(const f32x4 (&acc)[2][2][4][2], const Unit& u, int wr, int wc, int fr, int fq) const {
        const int row0 = u.rt * 256 + wr * 64 + fr, col0 = u.pn * 256 + wc * 32 + 8 * fq;
        const float* bb = b2 + (size_t)u.e * D + col0;
        f32x4 bv[2][2];
#pragma unroll
        for (int bj = 0; bj < 2; ++bj)
#pragma unroll
            for (int n = 0; n < 2; ++n) bv[bj][n] = *(const f32x4*)(bb + bj * HALF_ + 4 * n);
#pragma unroll
        for (int ai = 0; ai < 2; ++ai)
#pragma unroll
            for (int m = 0; m < 4; ++m) { bf16_t* rowp = Y + (size_t)(row0 + ai * HALF_ + m * 16) * D + col0;
#pragma unroll
                for (int bj = 0; bj < 2; ++bj) { const f32x4 v0 = acc[ai][bj][m][0] + bv[bj][0], v1 = acc[ai][bj][m][1] + bv[bj][1];
                    u32x4 w; w.x = cvt_pk_bf16(v0[0], v0[1]); w.y = cvt_pk_bf16(v0[2], v0[3]); w.z = cvt_pk_bf16(v1[0], v1[1]); w.w = cvt_pk_bf16(v1[2], v1[3]);
                    *(u32x4*)(rowp + bj * HALF_) = w; } }
    }
};
typedef unsigned char fp8_t;
constexpr int SCALE_ONE = 0x7f7f7f7f, SCALE_W = 0x79797979;
struct ProbMoe1 {
    static constexpr bool FP8 = true;
    const fp8_t* FX; const fp8_t* W1T; const int* list; const LAS int* tpre; const LAS int* cnt; const LAS unsigned char* texp; LAS int* toks; int scale_w, scale_x; pg8::TileOrder ord;
    __device__ __forceinline__ int ldb_bytes() const { return D; }
    __device__ __forceinline__ int ntiles() const { return D / 128; }
    __device__ __forceinline__ bool next(int i, Unit& u) const {
        if (!ord.next(i, u.pm, u.pn)) return false;
        u.rt = u.pm; u.e = texp[u.rt]; return true;
    }
    __device__ __forceinline__ const char* a_ptr(const Unit&) const { return (const char*)FX; }
    __device__ __forceinline__ const char* b_ptr(const Unit& u) const { return (const char*)(W1T + ((size_t)u.e * 2048 + (size_t)u.pn * 256) * D); }
    __device__ __forceinline__ void list_prefetch(const Unit& u, int par, int wid, int lane) const {
        if (wid == 0) { const int* src = list + (size_t)u.e * NT + (u.rt - tpre[u.e]) * 256 + 4 * lane;
            __builtin_amdgcn_global_load_lds((const unsigned*)src, (LAS unsigned*)(toks + par * 256), 16, 0, 0); }
    }
    __device__ __forceinline__ void a_off(const Unit& u, int par, const int (&R)[2], const int (&C)[2], unsigned (&v)[2][2]) const {
        const int nvalid = cnt[u.e] - (u.rt - tpre[u.e]) * 256; const LAS int* tk = toks + par * 256;
#pragma unroll
        for (int h = 0; h < 2; ++h)
#pragma unroll
            for (int i = 0; i < 2; ++i) { const int r = h * 128 + R[i]; const int tok = tk[r < nvalid ? r : 0]; v[h][i] = (unsigned)(tok * D + C[i] * 2); }
    }
};
struct ProbMoe2 {
    static constexpr bool FP8 = true;
    const fp8_t* ACT; const fp8_t* W2T; const LAS int* tpre; const LAS unsigned char* texp; int scale_w, scale_x; pg8::TileOrder ord;
    __device__ __forceinline__ int ldb_bytes() const { return D; }
    __device__ __forceinline__ int ntiles() const { return D / 128; }
    __device__ __forceinline__ bool next(int i, Unit& u) const {
        if (!ord.next(i, u.pm, u.pn)) return false;
        u.rt = u.pm; u.e = texp[u.rt]; return true;
    }
    __device__ __forceinline__ const char* a_ptr(const Unit& u) const { return (const char*)(ACT + (size_t)u.rt * 256 * D); }
    __device__ __forceinline__ const char* b_ptr(const Unit& u) const { return (const char*)(W2T + ((size_t)u.e * 1024 + (size_t)u.pn * 256) * D); }
    __device__ __forceinline__ void list_prefetch(const Unit&, int, int, int) const {}
    __device__ __forceinline__ void a_off(const Unit&, int, const int (&R)[2], const int (&C)[2], unsigned (&v)[2][2]) const {
#pragma unroll
        for (int h = 0; h < 2; ++h)
#pragma unroll
            for (int i = 0; i < 2; ++i) v[h][i] = (unsigned)((h * 128 + R[i]) * D + C[i] * 2);
    }
};
struct Args { const float* in[38]; float* out; unsigned char* ws; int phase; int one; };
enum { I_X = 0, I_C, I_CTX, I_CCTX, I_ADAW, I_ADAB, I_NORMG, I_AWQKV, I_ABQKV, I_AWO, I_ABO, I_ASINK, I_PW, I_PB, I_PS,
       I_RMIX, I_RWRKV, I_RW0, I_RW1, I_RW2, I_RA0, I_RA1, I_RA2, I_RG1, I_RG2, I_RKK, I_RKA, I_RRK, I_RLNW, I_RLNB, I_RWO,
       I_MWR, I_MBR, I_MW1, I_MB1, I_MW2, I_MB2, I_FG };
struct Frame { LAS unsigned char* lds; int tid, lane, wave, G, c; unsigned char* ws; unsigned* ctl; };
#define WSP(T_, off) ((T_*)(F.ws + (off)))

struct TJob { const float* src; unsigned char* dst; long sbs, dbs; int ldw, ldt, nkb, nnb, mode, item0, per, esz; };
__device__ __forceinline__ int dst_row(int mode, int n) {
    if (mode == 1) { const int hb = n & ~63, d = n & 63; const int ax = d >> 5, dd = d & 31, hf = dd >> 4, f = dd & 15; const int g = ax * 4 + (f >> 2), i = (f & 3) + 4 * hf; return hb + 8 * g + i; }
    if (mode == 2) { return n < 1024 ? ((n >> 7) << 8) + (n & 127) : (((n - 1024) >> 7) << 8) + 128 + (n & 127); }
    return n;
}
struct TItem { const float* src; unsigned char* dst; int ldw, ldt, mode, n0, esz; };
__device__ __forceinline__ void titem_decode(const LAS TJob* jobs, int nj, int it, TItem& T) {
    int ji = 0;
    for (int q = 1; q < nj; ++q) ji += (jobs[q].item0 <= it) ? 1 : 0;
    const LAS TJob& J = jobs[ji]; const int r = it - J.item0, bi = r / J.per, rr = r % J.per, kb = rr / J.nnb, nb = rr % J.nnb;
    T.src = J.src + bi * J.sbs + (size_t)(64 * kb) * J.ldw + 32 * nb; T.dst = J.dst + (bi * J.dbs + 64 * kb) * J.esz; T.ldw = J.ldw; T.ldt = J.ldt; T.mode = J.mode; T.n0 = 32 * nb; T.esz = J.esz;
}
__device__ __forceinline__ void titem_load(const TItem& T, int lane, f32x4 (&v)[8]) {
    const float* p = T.src + (size_t)(lane >> 3) * T.ldw + 4 * (lane & 7);
#pragma unroll
    for (int i = 0; i < 8; ++i) v[i] = *(const f32x4*)(p + (size_t)(8 * i) * T.ldw);
}
__device__ __forceinline__ void titem_store(const TItem& T, int lane, const f32x4 (&v)[8], LAS float* scr) {
#pragma unroll
    for (int i = 0; i < 8; ++i) { LAS float* d = scr + (8 * i + (lane >> 3)) * 33 + 4 * (lane & 7); d[0] = v[i].x; d[1] = v[i].y; d[2] = v[i].z; d[3] = v[i].w; }
    LDS_WAIT(); asm volatile("" ::: "memory");
    const int c = lane & 7;
#pragma unroll
    for (int j = 0; j < 4; ++j) { const int n = (lane >> 3) + 8 * j; const LAS float* s = scr + (8 * c) * 33 + n;
        const size_t eo = (size_t)dst_row(T.mode, T.n0 + n) * T.ldt + 8 * c;
        if (T.esz == 2) { u32x4 o; o.x = pk2(s[0 * 33], s[1 * 33]); o.y = pk2(s[2 * 33], s[3 * 33]); o.z = pk2(s[4 * 33], s[5 * 33]); o.w = pk2(s[6 * 33], s[7 * 33]); *(u32x4*)(T.dst + eo * 2) = o; }
        else { u32x2 o; o.x = pk4_fp8(64.f * s[0 * 33], 64.f * s[1 * 33], 64.f * s[2 * 33], 64.f * s[3 * 33]); o.y = pk4_fp8(64.f * s[4 * 33], 64.f * s[5 * 33], 64.f * s[6 * 33], 64.f * s[7 * 33]); *(u32x2*)(T.dst + eo) = o; } }
    LDS_WAIT(); asm volatile("" ::: "memory");
}
__device__ __forceinline__ void phase_prologue(Frame& F, const Args& A) {
    REFRESH(F);
    LAS float* S = (LAS float*)F.lds;
    for (int idx = F.tid; idx < 33 * 1024; idx += NTHREADS) { const int r = idx >> 10, k = idx & 1023; const float v = r < 32 ? A.in[I_C][r * 1024 + k] : A.in[I_CCTX][k]; S[k * 33 + r] = v / (1.0f + __expf(-v)); }
    __syncthreads();
    float* MOD = WSP(float, WS_MOD);
    for (int it = F.c; it < 4 * 96; it += F.G) {
        const int layer = it / 96, n = (it % 96) * 64 + F.lane; const float* wp = A.in[I_ADAW] + (size_t)layer * 1024 * 6144 + n;
        float acc[5] = {0.f, 0.f, 0.f, 0.f, 0.f};
        for (int k0 = 0; k0 < 1024; k0 += 32) {
            float wv[32];
#pragma unroll
            for (int u = 0; u < 32; ++u) wv[u] = wp[(size_t)(k0 + u) * 6144];
#pragma unroll
            for (int u = 0; u < 32; ++u) { const LAS float* sr = S + (k0 + u) * 33 + F.wave;
                acc[0] += sr[0] * wv[u]; acc[1] += sr[8] * wv[u]; acc[2] += sr[16] * wv[u]; acc[3] += sr[24] * wv[u]; if (F.wave == 0) acc[4] += S[(k0 + u) * 33 + 32] * wv[u]; }
        }
        const float bb = A.in[I_ADAB][layer * 6144 + n];
#pragma unroll
        for (int i = 0; i < 4; ++i) MOD[((size_t)layer * 33 + F.wave + 8 * i) * 6144 + n] = acc[i] + bb;
        if (F.wave == 0) MOD[((size_t)layer * 33 + 32) * 6144 + n] = acc[4] + bb;
    }
    { float* rc = WSP(float, WS_ROPEC); float* rs = WSP(float, WS_ROPES);
      for (int idx = F.c * NTHREADS + F.tid; idx < 2048 * 32; idx += F.G * NTHREADS) { const int t = idx >> 5, e = idx & 31, g = e >> 2, i = e & 3, f = 4 * (g & 3) + i;
          const float inv = powf(10000.0f, -(float)f / 16.0f); const float pos = (float)(g < 4 ? (t >> 6) : (t & 63)); const float ang = pos * inv; rc[idx] = cosf(ang); rs[idx] = sinf(ang); }
      float* bq = WSP(float, WS_BQK);
      for (int idx = F.c * NTHREADS + F.tid; idx < 2 * 1280; idx += F.G * NTHREADS) { const int j = idx / 1280, n = idx % 1280; bq[j * 1280 + dst_row(1, n)] = A.in[I_ABQKV][j * 1536 + n]; } }
    __syncthreads();
    LAS TJob* jobs = (LAS TJob*)(F.lds + JOB_OFF); LAS int* njobs = (LAS int*)(F.lds + MISC_OFF + 64);
    if (F.tid == 0) {
        int nj = 0, item = 0;
        auto add = [&](const float* src, bf16_t* dst, int ldw, int ldt, int Ks, int Ns, int mode, int nb, long sbs, long dbs, int esz = 2) {
            LAS TJob& j = jobs[nj]; j.src = src; j.dst = (unsigned char*)dst; j.sbs = sbs; j.dbs = dbs; j.ldw = ldw; j.ldt = ldt; j.nkb = Ks / 64; j.nnb = Ns / 32; j.mode = mode; j.item0 = item; j.per = (Ks / 64) * (Ns / 32); j.esz = esz;
            ++nj; item += (Ks / 64) * (Ns / 32) * nb; };
        add(A.in[I_AWQKV], WSP(bf16_t, WS_WQK), 1536, 1024, 1024, 1280, 1, 2, 1024L * 1536, 1280L * 1024);
        add(A.in[I_AWQKV] + 1280, WSP(bf16_t, WS_WV), 1536, 1024, 1024, 256, 0, 2, 1024L * 1536, 256L * 1024);
        add(A.in[I_AWO], WSP(bf16_t, WS_WO), 1024, 1024, 1024, 1024, 0, 2, 1L << 20, 1L << 20);
        add(A.in[I_PW], WSP(bf16_t, WS_POOLW), 256, 256, 256, 256, 0, 4, 65536, 65536);
        add(A.in[I_RWRKV], WSP(bf16_t, WS_WRKV), 1024, 1024, 1024, 1024, 0, 3, 1L << 20, 1L << 20);
        add(A.in[I_RG1], WSP(bf16_t, WS_WL1), 128, 1024, 1024, 128, 0, 1, 0, 0);
        add(A.in[I_RW1], WSP(bf16_t, WS_WL1) + 256 * 1024, 64, 1024, 1024, 64, 0, 2, 65536, 65536);
        add(A.in[I_RA1], WSP(bf16_t, WS_WL1) + 2 * 256 * 1024, 64, 1024, 1024, 64, 0, 2, 65536, 65536);
        add(A.in[I_RG2], WSP(bf16_t, WS_WL2), 1024, 256, 128, 1024, 0, 1, 0, 0);
        add(A.in[I_RW2], WSP(bf16_t, WS_WL2) + 1 * 1024 * 256, 1024, 256, 64, 1024, 0, 2, 65536, 1024L * 256 + 64);
        add(A.in[I_RA2], WSP(bf16_t, WS_WL2) + 3 * 1024 * 256, 1024, 256, 64, 1024, 0, 2, 65536, 1024L * 256 + 64);
        add(A.in[I_RWO], WSP(bf16_t, WS_WOR), 1024, 1024, 1024, 1024, 0, 1, 0, 0);
        add(A.in[I_MW1], WSP(bf16_t, WS_W1T), 2048, 1024, 1024, 2048, 2, 128, 1024L * 2048, 2048L * 1024, 1);
        add(A.in[I_MW2], WSP(bf16_t, WS_W2T), 1024, 1024, 1024, 1024, 0, 128, 1L << 20, 1L << 20, 1);
        njobs[0] = nj; njobs[1] = item;
    }
    __syncthreads();
    { const int nj = njobs[0], nitems = njobs[1]; LAS float* scr = (LAS float*)(F.lds + F.wave * 16384);
      const int gw = F.c * NWAVES + F.wave, NGW = F.G * NWAVES;
      int it = gw;
      if (it < nitems) {
          TItem Tc, Tn; f32x4 vc[8], vn[8];
          titem_decode(jobs, nj, it, Tc); titem_load(Tc, F.lane, vc);
          for (;;) {
              const int itn = it + NGW; const bool more = itn < nitems;
              if (more) { titem_decode(jobs, nj, itn, Tn); titem_load(Tn, F.lane, vn); }
              titem_store(Tc, F.lane, vc, scr);
              if (!more) break;
              Tc = Tn;
#pragma unroll
              for (int i = 0; i < 8; ++i) vc[i] = vn[i];
              it = itn;
          }
      } }
    __syncthreads();
}

__device__ __forceinline__ void moe_tiles(Frame& F, int layer) {
    REFRESH(F);
    LAS int* lcnt = (LAS int*)(F.lds + LCNT_OFF); LAS int* tpre = (LAS int*)(F.lds + TPRE_OFF);
    __syncthreads();
    if (F.tid < NE) lcnt[F.tid] = (int)__hip_atomic_load(F.ctl + CW_GCNT + layer * 64 + F.tid, __ATOMIC_RELAXED, __HIP_MEMORY_SCOPE_AGENT);
    __syncthreads();
    if (F.tid == 0) { int s = 0; for (int e = 0; e < NE; ++e) { tpre[e] = s; s += (lcnt[e] + 255) >> 8; } tpre[NE] = s; }
    __syncthreads();
    { LAS unsigned char* texp = (LAS unsigned char*)(F.lds + TEXP_OFF); const int nrt = tpre[NE];
      for (int rt = F.tid; rt < nrt; rt += NTHREADS) { int e = 0; for (int j = 1; j < NE; ++j) e += (tpre[j] <= rt) ? 1 : 0; texp[rt] = (unsigned char)e; } }
    __syncthreads();
}
constexpr int RB = 2;
#define ROWOF(it, r) ((((it) * F.G + F.c) * NWAVES + F.wave) * RB + (r))
struct MoeRef { int p[4]; float g[4]; };
__device__ __forceinline__ void moe_ref_load(Frame& F, int row, MoeRef& R) {
    const int4 pp = *(const int4*)(WSP(int, WS_POS) + (size_t)row * 4); const f32x4 gg = *(const f32x4*)(WSP(float, WS_GATE) + (size_t)row * 4);
    R.p[0] = pp.x; R.p[1] = pp.y; R.p[2] = pp.z; R.p[3] = pp.w; R.g[0] = gg.x; R.g[1] = gg.y; R.g[2] = gg.z; R.g[3] = gg.w;
}
__device__ __forceinline__ void moe_rows_load(Frame& F, const MoeRef& R, u32x2 (&y)[4][4]) {
    const LAS int* tpre = (const LAS int*)(F.lds + TPRE_OFF); const bf16_t* Y = WSP(bf16_t, WS_Y);
#pragma unroll
    for (int k = 0; k < 4; ++k) { const int e = R.p[k] >> 20, slot = R.p[k] & 0xfffff; const size_t fr = (size_t)tpre[e] * 256 + slot; const u32x2* yp = (const u32x2*)(Y + fr * D) + F.lane;
#pragma unroll
        for (int j = 0; j < 4; ++j) y[k][j] = yp[64 * j]; }
}
__device__ __forceinline__ f32x4 moe_rows_sum(const MoeRef& R, const u32x2 (&y)[4][4], int j) {
    f32x4 s = (f32x4){0.f, 0.f, 0.f, 0.f};
#pragma unroll
    for (int k = 0; k < 4; ++k) { const u32x2 w = y[k][j]; s += R.g[k] * (f32x4){bflo(w.x), bfhi(w.x), bflo(w.y), bfhi(w.y)}; }
    return s;
}

__device__ __forceinline__ void phase_norm1(Frame& F, const Args& A, int layer) {
    REFRESH(F);
    if (layer > 0) moe_tiles(F, layer - 1);
    bf16_t* H = WSP(bf16_t, WS_H); bf16_t* AX = WSP(bf16_t, WS_AX); const float* MOD = WSP(float, WS_MOD);
    const float* g1 = A.in[I_NORMG] + (size_t)(layer * 2 + 0) * D;
    f32x4 gg[4];
#pragma unroll
    for (int j = 0; j < 4; ++j) gg[j] = ((const f32x4*)g1)[64 * j + F.lane];
    for (int it = 0;; ++it) { if (ROWOF(it, 0) >= NT) break;
        f32x4 v[RB][4]; int brow[RB];
        if (layer == 0) {
#pragma unroll
            for (int r = 0; r < RB; ++r) { const int row = ROWOF(it, r); brow[r] = row < NX ? (row >> 11) : 32; const float* src = row < NX ? A.in[I_X] + (size_t)row * D : A.in[I_CTX] + (size_t)(row - NX) * D;
#pragma unroll
                for (int j = 0; j < 4; ++j) v[r][j] = ((const f32x4*)src)[64 * j + F.lane]; }
        } else {
            MoeRef R[RB]; u32x2 y[RB][4][4]; f32x4 gv[RB][4];
#pragma unroll
            for (int r = 0; r < RB; ++r) moe_ref_load(F, ROWOF(it, r), R[r]);
#pragma unroll
            for (int r = 0; r < RB; ++r) { const int row = ROWOF(it, r); brow[r] = row < NX ? (row >> 11) : 32; moe_rows_load(F, R[r], y[r]);
                const float* g2p = MOD + ((size_t)(layer - 1) * 33 + brow[r]) * 6144 + 5 * D;
#pragma unroll
                for (int j = 0; j < 4; ++j) { v[r][j] = ld_bf4(H + (size_t)row * D + 256 * j + 4 * F.lane); gv[r][j] = ((const f32x4*)g2p)[64 * j + F.lane]; } }
#pragma unroll
            for (int r = 0; r < RB; ++r)
#pragma unroll
                for (int j = 0; j < 4; ++j) v[r][j] = v[r][j] + gv[r][j] * moe_rows_sum(R[r], y[r], j);
        }
        float rstd[RB];
#pragma unroll
        for (int r = 0; r < RB; ++r) { const int row = ROWOF(it, r); float ss = 0.f;
#pragma unroll
            for (int j = 0; j < 4; ++j) { st_bf4(H + (size_t)row * D + 256 * j + 4 * F.lane, v[r][j]); ss += (v[r][j].x * v[r][j].x + v[r][j].y * v[r][j].y) + (v[r][j].z * v[r][j].z + v[r][j].w * v[r][j].w); }
            rstd[r] = 1.0f / sqrtf(wave_sum(ss) * (1.0f / D) + 1e-5f); }
#pragma unroll
        for (int r = 0; r < RB; ++r) { const int row = ROWOF(it, r); const float* mp = MOD + ((size_t)layer * 33 + brow[r]) * 6144;
#pragma unroll
            for (int j = 0; j < 4; ++j) { const f32x4 sh = ((const f32x4*)mp)[64 * j + F.lane], sc = ((const f32x4*)(mp + D))[64 * j + F.lane];
                const f32x4 o = v[r][j] * rstd[r] * gg[j] * (sc + 1.0f) + sh;
                u32x2 w; w.x = pk2(o.x, o.y); w.y = pk2(o.z, o.w); ((u32x2*)(AX + (size_t)row * D))[64 * j + F.lane] = w; } }
    }
}
__device__ __forceinline__ void phase_final(Frame& F, const Args& A) {
    REFRESH(F);
    moe_tiles(F, DEPTH - 1);
    const bf16_t* H = WSP(bf16_t, WS_H); const float* MOD = WSP(float, WS_MOD); const float* fg = A.in[I_FG];
    f32x4 gg[4];
#pragma unroll
    for (int j = 0; j < 4; ++j) gg[j] = ((const f32x4*)fg)[64 * j + F.lane];
    for (int it = 0;; ++it) { if (ROWOF(it, 0) >= NX) break;
        MoeRef R[RB]; u32x2 y[RB][4][4]; f32x4 v[RB][4], gv[RB][4];
#pragma unroll
        for (int r = 0; r < RB; ++r) moe_ref_load(F, ROWOF(it, r), R[r]);
#pragma unroll
        for (int r = 0; r < RB; ++r) { const int row = ROWOF(it, r); moe_rows_load(F, R[r], y[r]); const float* g2p = MOD + ((size_t)(DEPTH - 1) * 33 + (row >> 11)) * 6144 + 5 * D;
#pragma unroll
            for (int j = 0; j < 4; ++j) { v[r][j] = ld_bf4(H + (size_t)row * D + 256 * j + 4 * F.lane); gv[r][j] = ((const f32x4*)g2p)[64 * j + F.lane]; } }
#pragma unroll
        for (int r = 0; r < RB; ++r) { const int row = ROWOF(it, r); float ss = 0.f;
#pragma unroll
            for (int j = 0; j < 4; ++j) { v[r][j] = v[r][j] + gv[r][j] * moe_rows_sum(R[r], y[r], j); ss += (v[r][j].x * v[r][j].x + v[r][j].y * v[r][j].y) + (v[r][j].z * v[r][j].z + v[r][j].w * v[r][j].w); }
            const float rstd = 1.0f / sqrtf(wave_sum(ss) * (1.0f / D) + 1e-5f);
#pragma unroll
            for (int j = 0; j < 4; ++j) ((f32x4*)(A.out + (size_t)row * D))[64 * j + F.lane] = v[r][j] * rstd * gg[j]; }
    }
}

__device__ __forceinline__ void phase_route(Frame& F, const Args& A, int layer) {
    REFRESH(F);
    const int nrows = (layer == DEPTH - 1) ? NX : NT;
    LAS float* wT = (LAS float*)F.lds;
    LAS int* lcnt = (LAS int*)(F.lds + LCNT_OFF); LAS int* lbase = (LAS int*)(F.lds + LBASE_OFF);
    LAS unsigned* recp = (LAS unsigned*)(F.lds + REC_OFF); LAS float* recg = (LAS float*)(F.lds + REC_OFF + 4608);
    __syncthreads();
    { const float* wr = A.in[I_MWR] + (size_t)layer * D * NE;
      for (int idx = F.tid; idx < D * NE; idx += NTHREADS) wT[(idx & 31) * 1024 + (idx >> 5)] = wr[idx]; }
    if (F.tid < NE) lcnt[F.tid] = 0;
    __syncthreads();
    const bf16_t* H = WSP(bf16_t, WS_H); unsigned char* FX = WSP(unsigned char, WS_FX); const float* MOD = WSP(float, WS_MOD);
    const float* g2 = A.in[I_NORMG] + (size_t)(layer * 2 + 1) * D; const float* br = A.in[I_MBR] + layer * NE;
    f32x4 gg[4];
#pragma unroll
    for (int j = 0; j < 4; ++j) gg[j] = ((const f32x4*)g2)[64 * j + F.lane];
    const int myE = F.lane >> 1; const float myb = br[myE];
    int nit = 0;
    for (int it = 0;; ++it) { if (ROWOF(it, 0) - F.wave * RB >= nrows) break; nit = it + 1;
        if (ROWOF(it, 0) >= nrows) continue;
        f32x4 v[RB][4]; float rstd[RB];
#pragma unroll
        for (int r = 0; r < RB; ++r) { const int row = ROWOF(it, r);
#pragma unroll
            for (int j = 0; j < 4; ++j) v[r][j] = ld_bf4(H + (size_t)row * D + 256 * j + 4 * F.lane); }
#pragma unroll
        for (int r = 0; r < RB; ++r) { float ss = 0.f;
#pragma unroll
            for (int j = 0; j < 4; ++j) ss += (v[r][j].x * v[r][j].x + v[r][j].y * v[r][j].y) + (v[r][j].z * v[r][j].z + v[r][j].w * v[r][j].w);
            rstd[r] = 1.0f / sqrtf(wave_sum(ss) * (1.0f / D) + 1e-5f); }
#pragma unroll
        for (int r = 0; r < RB; ++r) { const int row = ROWOF(it, r); const int brow = row < NX ? (row >> 11) : 32;
            const float* mp = MOD + ((size_t)layer * 33 + brow) * 6144 + 3 * D;
#pragma unroll
            for (int j = 0; j < 4; ++j) { const f32x4 sh = ((const f32x4*)mp)[64 * j + F.lane], sc = ((const f32x4*)(mp + D))[64 * j + F.lane];
                v[r][j] = v[r][j] * rstd[r] * gg[j] * (sc + 1.0f) + sh;
                ((unsigned*)(FX + (size_t)row * D))[64 * j + F.lane] = pk4_fp8(v[r][j].x, v[r][j].y, v[r][j].z, v[r][j].w); } }
        float part[RB][NE];
#pragma unroll
        for (int e = 0; e < NE; ++e) { float p0 = 0.f, p1 = 0.f;
#pragma unroll
            for (int j = 0; j < 4; ++j) { const f32x4 w4 = ((const LAS f32x4*)(wT + e * 1024))[64 * j + F.lane];
                p0 += (v[0][j].x * w4.x + v[0][j].y * w4.y) + (v[0][j].z * w4.z + v[0][j].w * w4.w); p1 += (v[1][j].x * w4.x + v[1][j].y * w4.y) + (v[1][j].z * w4.z + v[1][j].w * w4.w); }
            part[0][e] = p0; part[1][e] = p1; }
#pragma unroll
        for (int r = 0; r < RB; ++r) {
#pragma unroll
            for (int k = 0; k < 16; ++k) { const bool up = (F.lane & 32) != 0; const float keep = up ? part[r][k + 16] : part[r][k], send = up ? part[r][k] : part[r][k + 16]; part[r][k] = keep + __shfl_xor(send, 32); }
#pragma unroll
            for (int k = 0; k < 8; ++k) { const bool up = (F.lane & 16) != 0; const float keep = up ? part[r][k + 8] : part[r][k], send = up ? part[r][k] : part[r][k + 8]; part[r][k] = keep + __shfl_xor(send, 16); }
#pragma unroll
            for (int k = 0; k < 4; ++k) { const bool up = (F.lane & 8) != 0; const float keep = up ? part[r][k + 4] : part[r][k], send = up ? part[r][k] : part[r][k + 4]; part[r][k] = keep + __shfl_xor(send, 8); }
#pragma unroll
            for (int k = 0; k < 2; ++k) { const bool up = (F.lane & 4) != 0; const float keep = up ? part[r][k + 2] : part[r][k], send = up ? part[r][k] : part[r][k + 2]; part[r][k] = keep + __shfl_xor(send, 4); }
            { const bool up = (F.lane & 2) != 0; const float keep = up ? part[r][1] : part[r][0], send = up ? part[r][0] : part[r][1]; part[r][0] = keep + __shfl_xor(send, 2); }
            part[r][0] += __shfl_xor(part[r][0], 1);
        }
#pragma unroll
        for (int r = 0; r < RB; ++r) {
            const float val = part[r][0] + myb;
            int rank = 0;
#pragma unroll
            for (int e = 0; e < NE; ++e) { const float ve = __builtin_bit_cast(float, __builtin_amdgcn_readlane(__builtin_bit_cast(int, val), 2 * e)); rank += (ve > val || (ve == val && e < myE)) ? 1 : 0; }
            float sv[4]; int si[4];
#pragma unroll
            for (int k = 0; k < 4; ++k) { const unsigned long long m = __ballot(rank == k && (F.lane & 1) == 0); const int src = __builtin_ctzll(m);
                si[k] = src >> 1; sv[k] = __builtin_bit_cast(float, __builtin_amdgcn_readlane(__builtin_bit_cast(int, val), src)); }
            const float e1 = __expf(sv[1] - sv[0]), e2 = __expf(sv[2] - sv[0]), e3 = __expf(sv[3] - sv[0]); const float inv = 1.0f / (1.0f + e1 + e2 + e3);
            if (F.lane < 4) { const int e = F.lane == 0 ? si[0] : F.lane == 1 ? si[1] : F.lane == 2 ? si[2] : si[3]; const float g = (F.lane == 0 ? 1.0f : F.lane == 1 ? e1 : F.lane == 2 ? e2 : e3) * inv;
                const int rank2 = __hip_atomic_fetch_add(lcnt + e, 1, __ATOMIC_RELAXED, __HIP_MEMORY_SCOPE_WORKGROUP);
                const int ri = ((it * NWAVES + F.wave) * RB + r) * 4 + F.lane; recp[ri] = ((unsigned)e << 20) | (unsigned)rank2; recg[ri] = g; }
        }
    }
    __syncthreads();
    if (F.tid < NE) lbase[F.tid] = (int)__hip_atomic_fetch_add(F.ctl + CW_GCNT + layer * 64 + F.tid, (unsigned)lcnt[F.tid], __ATOMIC_RELAXED, __HIP_MEMORY_SCOPE_AGENT);
    __syncthreads();
    int* LIST = WSP(int, WS_LIST); int* POS = WSP(int, WS_POS); float* GATE = WSP(float, WS_GATE);
    for (int r = F.tid; r < nit * NWAVES * RB * 4; r += NTHREADS) { const int lr = r >> 2, k = r & 3; const int row = ((lr >> 4) * F.G + F.c) * (NWAVES * RB) + (lr & 15); if (row >= nrows) continue;
        const unsigned qx = recp[r]; const float qg = recg[r]; const int e = qx >> 20, slot = lbase[e] + (int)(qx & 0xfffff);
        LIST[(size_t)e * NT + slot] = row; POS[(size_t)row * 4 + k] = (e << 20) | slot; GATE[(size_t)row * 4 + k] = qg; }
    __syncthreads();
}

__device__ __forceinline__ void phase_pooldiff(Frame& F) {
    REFRESH(F);
    const bf16_t* AX = WSP(bf16_t, WS_AX); bf16_t* PD = WSP(bf16_t, WS_PD);
    for (int it = 0;; ++it) { if (ROWOF(it, 0) >= NT) break;
        const int row0 = ROWOF(it, 0); int sb, t, n; seq_of(row0, sb, t, n);
#pragma unroll
        for (int j = 0; j < 4; ++j) { const int half = 1 << j; const int col = 256 * j + 4 * F.lane;
            f32x4 s0 = (f32x4){0.f, 0.f, 0.f, 0.f}, s1 = s0, me0 = s0, me1 = s0;
#pragma unroll
            for (int q = 0; q < 2 * half + 1; ++q) { const int uu = t - half + q;
                if (uu >= 0 && uu < n) { const f32x4 x = ld_bf4(AX + (size_t)(sb + uu) * D + col); if (q < 2 * half) s0 += x; if (q > 0) s1 += x; if (q == half) me0 = x; if (q == half + 1) me1 = x; } }
            const int lo0 = t - half < 0 ? 0 : t - half, hi0 = t + half > n ? n : t + half, lo1 = t + 1 - half < 0 ? 0 : t + 1 - half, hi1 = t + 1 + half > n ? n : t + 1 + half;
            st_bf4(PD + (size_t)row0 * D + col, s0 * (1.0f / (float)(hi0 - lo0)) - me0);
            st_bf4(PD + (size_t)(row0 + 1) * D + col, s1 * (1.0f / (float)(hi1 - lo1)) - me1); }
    }
}
__device__ __forceinline__ void phase_rwkv_mix(Frame& F, const Args& A) {
    REFRESH(F);
    const bf16_t* AX = WSP(bf16_t, WS_AX); bf16_t* A6 = WSP(bf16_t, WS_A6); const float* mix = A.in[I_RMIX];
    for (int it = 0;; ++it) { if (ROWOF(it, 0) >= NT) break;
        const int row0 = ROWOF(it, 0); int sb, t, n; seq_of(row0, sb, t, n);
#pragma unroll
        for (int j = 0; j < 4; ++j) { const int col = 256 * j + 4 * F.lane; const f32x4 z = (f32x4){0.f, 0.f, 0.f, 0.f};
            const f32x4 h0 = ld_bf4(AX + (size_t)row0 * D + col), h1 = ld_bf4(AX + (size_t)(row0 + 1) * D + col);
            const f32x4 hp = t > 0 ? ld_bf4(AX + (size_t)(row0 - 1) * D + col) : z, hn = t + 1 < n - 1 ? ld_bf4(AX + (size_t)(row0 + 2) * D + col) : z;
            const f32x4 xx0 = (hp + h1) * 0.5f - h0, xx1 = (h0 + hn) * 0.5f - h1;
#pragma unroll
            for (int i = 0; i < 6; ++i) { const f32x4 m = *(const f32x4*)(mix + i * D + col); st_bf4(A6 + ((size_t)i * NT + row0) * D + col, h0 + xx0 * m); st_bf4(A6 + ((size_t)i * NT + row0 + 1) * D + col, h1 + xx1 * m); } }
    }
}
__device__ __forceinline__ float rl(float x, int k) { return __builtin_bit_cast(float, __builtin_amdgcn_readlane(__builtin_bit_cast(int, x), k)); }
typedef float f32x16 __attribute__((ext_vector_type(16)));
constexpr int SCW = 33792;
__device__ __forceinline__ int kpos(int k) { return (k & ~12) | ((k & 4) << 1) | ((k & 8) >> 1); }
__device__ __forceinline__ bf16x8 acc_frag(const f32x16& X, int s2) {
    u32x4 w; w.x = cvt_pk_bf16(X[8 * s2 + 0], X[8 * s2 + 1]); w.y = cvt_pk_bf16(X[8 * s2 + 2], X[8 * s2 + 3]); w.z = cvt_pk_bf16(X[8 * s2 + 4], X[8 * s2 + 5]); w.w = cvt_pk_bf16(X[8 * s2 + 6], X[8 * s2 + 7]);
    return __builtin_bit_cast(bf16x8, w);
}
#define MFMA32(a, b, c) __builtin_amdgcn_mfma_f32_32x32x16_bf16(a, b, c, 0, 0, 0)
__device__ __forceinline__ void phase_rwkv_scan(Frame& F, const Args& A) {
    REFRESH(F);
    __syncthreads();
    const int pr = F.wave >> 1, hw = F.wave & 1;
    for (int item = pr * F.G + F.c; item < 1024; item += 4 * F.G) {
        const int dir = item >> 9, b = (item >> 4) & 31, hd = item & 15, col = 64 * hd + F.lane;
        const int l = F.lane, r32 = l & 31, hh = l >> 5;
        const bf16_t* Rr = WSP(bf16_t, WS_RKV); const bf16_t* Kk = Rr + (size_t)NT * D; const bf16_t* Vv = Kk + (size_t)NT * D;
        const bf16_t* Ee = WSP(bf16_t, WS_E) + (size_t)dir * NT * D; const bf16_t* Aa = WSP(bf16_t, WS_A) + (size_t)dir * NT * D;
        float* Yo = WSP(float, WS_YS) + (size_t)dir * NT * D; float* Bo = WSP(float, WS_BONUS) + (size_t)dir * NT * 16;
        const float kkw = A.in[I_RKK][col], kaw = A.in[I_RKA][col], rkw = A.in[I_RRK][col];
        LAS unsigned char* RA = F.lds + pr * SCW; LAS unsigned char* RB = RA + 16384; LAS unsigned char* RV = RA + 25600;
        LAS float* cCb = (LAS float*)(F.lds + REC_OFF + pr * 256);
        LAS bf16_t* XT = (LAS bf16_t*)RA;
        LAS bf16_t* BK = (LAS bf16_t*)(RA + 8192);
        const int kp = kpos(l), vb = hw;
        f32x16 ST[2];
#pragma unroll
        for (int i = 0; i < 2; ++i)
#pragma unroll
            for (int q = 0; q < 16; ++q) ST[i][q] = 0.f;
        for (int seg = 0; seg < 2; ++seg) {
            const int base = seg ? b * T : NX + b * L, n = seg ? T : L; const int dt = dir ? -1 : 1; const int t0 = dir ? n - 1 : 0;
            for (int bt = 0; bt < n; bt += 32) {
                float cprev = 1.0f;
                if (hw) {
                    bf16_t e16[16];
#pragma unroll
                    for (int s = 0; s < 16; ++s) e16[s] = Ee[(size_t)(base + t0 + dt * (bt + s)) * D + col];
                    float es = 0.f;
#pragma unroll
                    for (int s = 0; s < 16; ++s) es += bf1(e16[s]);
                    cprev = __expf(-es); }
#pragma unroll
                for (int g4i = 0; g4i < 4; ++g4i) { const int g8 = 4 * hw + g4i;
                    bf16_t raw[4][5];
#pragma unroll
                    for (int s8 = 0; s8 < 4; ++s8) { const size_t o = (size_t)(base + t0 + dt * (bt + g8 * 4 + s8)) * D + col; raw[s8][0] = Rr[o]; raw[s8][1] = Kk[o]; raw[s8][2] = Vv[o]; raw[s8][3] = Aa[o]; raw[s8][4] = Ee[o]; }
                    float rr[4], kraw[4], aa[4], kk[4], kd[4], n2[4], bn[4], ww[4]; unsigned bq2[2] = {0u, 0u}, kq2[2] = {0u, 0u};
#pragma unroll
                    for (int s8 = 0; s8 < 4; ++s8) { rr[s8] = bf1(raw[s8][0]); kraw[s8] = bf1(raw[s8][1]); aa[s8] = bf1(raw[s8][3]); ww[s8] = __expf(-bf1(raw[s8][4]));
                        kk[s8] = kraw[s8] * kkw; n2[s8] = kk[s8] * kk[s8]; kd[s8] = kraw[s8] * (1.0f + (aa[s8] - 1.0f) * kaw); bn[s8] = rr[s8] * kd[s8] * rkw; }
#pragma unroll
                    for (int s8 = 0; s8 < 4; ++s8) { n2[s8] = wave_sum(n2[s8]); bn[s8] = wave_sum(bn[s8]); }
#pragma unroll
                    for (int s8 = 0; s8 < 4; ++s8) { const int t = g8 * 4 + s8;
                        if (l == 0) Bo[(size_t)(base + t0 + dt * (bt + t)) * 16 + hd] = bn[s8];
                        const float kn = kk[s8] * __builtin_amdgcn_rsqf(fmaxf(n2[s8], 1e-24f)); const float c = cprev * ww[s8]; const float ic = __builtin_amdgcn_rcpf(c);
                        const float at = -kn * cprev, rt = rr[s8] * c, bq = kn * aa[s8] * ic, kq = kd[s8] * ic;
                        const unsigned w0 = cvt_pk_bf16(at, rt), w1 = cvt_pk_bf16(bq, kq);
                        XT[t * 64 + kp] = (bf16_t)(w0 & 0xffffu); XT[(32 + t) * 64 + kp] = (bf16_t)(w0 >> 16);
                        BK[t * 64 + kp] = (bf16_t)(w1 & 0xffffu); BK[(32 + t) * 64 + kp] = (bf16_t)(w1 >> 16);
                        if (s8 & 1) { bq2[s8 >> 1] |= (w1 & 0xffffu) << 16; kq2[s8 >> 1] |= (w1 & 0xffff0000u); } else { bq2[s8 >> 1] = w1 & 0xffffu; kq2[s8 >> 1] = w1 >> 16; }
                        cprev = c; }
                    const int gp = (g8 & ~3) | ((g8 & 1) << 1) | ((g8 & 2) >> 1);
                    *(LAS u32x2*)(RB + l * 144 + gp * 8) = (u32x2){bq2[0], bq2[1]}; *(LAS u32x2*)(RB + l * 144 + 64 + gp * 8) = (u32x2){kq2[0], kq2[1]};
                    *(LAS u32x2*)(RV + l * 80 + gp * 8) = (u32x2){(unsigned)raw[0][2] | ((unsigned)raw[1][2] << 16), (unsigned)raw[2][2] | ((unsigned)raw[3][2] << 16)};
                }
                if (hw) cCb[l] = cprev;
                __syncthreads();
                f32x16 Mp, Np, X;
                { bf16x8 XTf[4], BKf[2][4];
#pragma unroll
                  for (int s4 = 0; s4 < 4; ++s4) { XTf[s4] = *(const LAS bf16x8*)(XT + r32 * 64 + 16 * s4 + 8 * hh); BKf[0][s4] = *(const LAS bf16x8*)(BK + r32 * 64 + 16 * s4 + 8 * hh); BKf[1][s4] = *(const LAS bf16x8*)(BK + (32 + r32) * 64 + 16 * s4 + 8 * hh); }
                  bf16x8 MkaF[2];
                  { f32x16 Tm;
#pragma unroll
                    for (int q = 0; q < 16; ++q) Tm[q] = 0.f;
#pragma unroll
                    for (int s4 = 0; s4 < 4; ++s4) Tm = MFMA32(BKf[1][s4], XTf[s4], Tm);
#pragma unroll
                    for (int q = 0; q < 16; ++q) { const int row = (q & 3) + 8 * (q >> 2) + 4 * hh; Tm[q] = row < r32 ? Tm[q] : 0.f; }
                    MkaF[0] = acc_frag(Tm, 0); MkaF[1] = acc_frag(Tm, 1); }
#pragma unroll
                  for (int q = 0; q < 16; ++q) { Mp[q] = 0.f; Np[q] = 0.f; X[q] = 0.f; }
#pragma unroll
                  for (int s4 = 0; s4 < 4; ++s4) { Mp = MFMA32(BKf[0][s4], XTf[s4], Mp); Np = MFMA32(XTf[s4], BKf[0][s4], Np); }
#pragma unroll
                  for (int q = 0; q < 16; ++q) { const int row = (q & 3) + 8 * (q >> 2) + 4 * hh; Mp[q] = row < r32 ? Mp[q] : 0.f; Np[q] = r32 < row ? Np[q] : 0.f; }
#pragma unroll
                  for (int kb = 0; kb < 2; ++kb)
#pragma unroll
                      for (int s2 = 0; s2 < 2; ++s2) X = MFMA32(XTf[2 * kb + s2], acc_frag(ST[kb], s2), X);
#pragma unroll
                  for (int s2 = 0; s2 < 2; ++s2) { const bf16x8 Vf = *(const LAS bf16x8*)(RV + (32 * vb + r32) * 80 + (16 * s2 + 8 * hh) * 2); X = MFMA32(MkaF[s2], Vf, X); } }
                __builtin_amdgcn_sched_barrier(0);
#pragma unroll
                for (int lvl = 0; lvl < 5; ++lvl) {
                    bf16x8 Ma[2], Na[2];
#pragma unroll
                    for (int s2 = 0; s2 < 2; ++s2) { Ma[s2] = acc_frag(Mp, s2); Na[s2] = acc_frag(Np, s2); }
                    { const bf16x8 x0 = acc_frag(X, 0), x1 = acc_frag(X, 1); X = MFMA32(Ma[0], x0, X); X = MFMA32(Ma[1], x1, X); }
                    if (lvl < 4) { f32x16 M2, N2;
#pragma unroll
                        for (int q = 0; q < 16; ++q) { M2[q] = 0.f; N2[q] = 0.f; }
                        M2 = MFMA32(Na[0], Ma[0], M2); M2 = MFMA32(Na[1], Ma[1], M2);
                        N2 = MFMA32(Ma[0], Na[0], N2); N2 = MFMA32(Ma[1], Na[1], N2);
                        Mp = M2; Np = N2; }
                }
                __builtin_amdgcn_sched_barrier(0);
                { bf16x8 XRf[4], MbrF[2], MkrF[2];
#pragma unroll
                  for (int s4 = 0; s4 < 4; ++s4) XRf[s4] = *(const LAS bf16x8*)(XT + (32 + r32) * 64 + 16 * s4 + 8 * hh);
                  { f32x16 Tm, Tn;
#pragma unroll
                    for (int q = 0; q < 16; ++q) { Tm[q] = 0.f; Tn[q] = 0.f; }
#pragma unroll
                    for (int s4 = 0; s4 < 4; ++s4) { const bf16x8 Bb = *(const LAS bf16x8*)(BK + r32 * 64 + 16 * s4 + 8 * hh), Bk = *(const LAS bf16x8*)(BK + (32 + r32) * 64 + 16 * s4 + 8 * hh);
                        Tm = MFMA32(Bb, XRf[s4], Tm); Tn = MFMA32(Bk, XRf[s4], Tn); }
#pragma unroll
                    for (int q = 0; q < 16; ++q) { const int row = (q & 3) + 8 * (q >> 2) + 4 * hh; Tm[q] = row <= r32 ? Tm[q] : 0.f; Tn[q] = row <= r32 ? Tn[q] : 0.f; }
                    MbrF[0] = acc_frag(Tm, 0); MbrF[1] = acc_frag(Tm, 1); MkrF[0] = acc_frag(Tn, 0); MkrF[1] = acc_frag(Tn, 1); }
                  { const bf16x8 u0 = acc_frag(X, 0), u1 = acc_frag(X, 1);
                    const bf16x8 Vf0 = *(const LAS bf16x8*)(RV + (32 * vb + r32) * 80 + (8 * hh) * 2), Vf1 = *(const LAS bf16x8*)(RV + (32 * vb + r32) * 80 + (16 + 8 * hh) * 2);
                    f32x16 Yt;
#pragma unroll
                    for (int q = 0; q < 16; ++q) Yt[q] = 0.f;
#pragma unroll
                    for (int kb = 0; kb < 2; ++kb)
#pragma unroll
                        for (int s2 = 0; s2 < 2; ++s2) Yt = MFMA32(XRf[2 * kb + s2], acc_frag(ST[kb], s2), Yt);
                    Yt = MFMA32(MkrF[0], Vf0, Yt); Yt = MFMA32(MkrF[1], Vf1, Yt);
                    Yt = MFMA32(MbrF[0], u0, Yt); Yt = MFMA32(MbrF[1], u1, Yt);
#pragma unroll
                    for (int q = 0; q < 16; ++q) { const int t = (q & 3) + 8 * (q >> 2) + 4 * hh; Yo[(size_t)(base + t0 + dt * (bt + t)) * D + 64 * hd + 32 * vb + r32] = Yt[q]; }
#pragma unroll
                    for (int kb = 0; kb < 2; ++kb) {
                        const bf16x8 b0 = *(const LAS bf16x8*)(RB + (32 * kb + r32) * 144 + (8 * hh) * 2), b1 = *(const LAS bf16x8*)(RB + (32 * kb + r32) * 144 + (16 + 8 * hh) * 2);
                        const bf16x8 k0 = *(const LAS bf16x8*)(RB + (32 * kb + r32) * 144 + 64 + (8 * hh) * 2), k1 = *(const LAS bf16x8*)(RB + (32 * kb + r32) * 144 + 64 + (16 + 8 * hh) * 2);
                        ST[kb] = MFMA32(b0, u0, ST[kb]); ST[kb] = MFMA32(b1, u1, ST[kb]);
                        ST[kb] = MFMA32(k0, Vf0, ST[kb]); ST[kb] = MFMA32(k1, Vf1, ST[kb]); }
                  } }
                __builtin_amdgcn_sched_barrier(0);
#pragma unroll
                for (int kb = 0; kb < 2; ++kb)
#pragma unroll
                    for (int g4 = 0; g4 < 4; ++g4) { const f32x4 cc = *(const LAS f32x4*)(cCb + 32 * kb + 8 * g4 + 4 * hh);
                        ST[kb][4 * g4 + 0] *= cc.x; ST[kb][4 * g4 + 1] *= cc.y; ST[kb][4 * g4 + 2] *= cc.z; ST[kb][4 * g4 + 3] *= cc.w; }
                __syncthreads();
            }
        }
    }
    __syncthreads();
}
#undef MFMA32
__device__ __forceinline__ void phase_rwkv_out(Frame& F, const Args& A, int nrows) {
    REFRESH(F);
    const float* Y0 = WSP(float, WS_YS); const float* Y1 = Y0 + (size_t)NT * D; const float* B0 = WSP(float, WS_BONUS); const float* B1 = B0 + (size_t)NT * 16;
    const bf16_t* Vv = WSP(bf16_t, WS_RKV) + (size_t)2 * NT * D; const bf16_t* Gg = WSP(bf16_t, WS_G); bf16_t* RO = WSP(bf16_t, WS_RO);
    const float* lnw = A.in[I_RLNW]; const float* lnb = A.in[I_RLNB];
    for (int it = 0;; ++it) { if (ROWOF(it, 0) >= nrows) break;
        f32x4 y[RB][4], vv[RB][4], gg[RB][4]; float bon[RB][4];
#pragma unroll
        for (int r = 0; r < RB; ++r) { const int row = ROWOF(it, r);
#pragma unroll
            for (int j = 0; j < 4; ++j) { const int col = 256 * j + 4 * F.lane, head = 4 * j + (F.lane >> 4); const size_t o = (size_t)row * D + col;
                y[r][j] = *(const f32x4*)(Y0 + o) + *(const f32x4*)(Y1 + o); vv[r][j] = ld_bf4(Vv + o); gg[r][j] = ld_bf4(Gg + o); bon[r][j] = B0[(size_t)row * 16 + head] + B1[(size_t)row * 16 + head]; } }
#pragma unroll
        for (int r = 0; r < RB; ++r) { const int row = ROWOF(it, r);
#pragma unroll
            for (int j = 0; j < 4; ++j) { const int col = 256 * j + 4 * F.lane; const size_t o = (size_t)row * D + col; const f32x4 yy = y[r][j];
                const float s = row16_sum((yy.x + yy.y) + (yy.z + yy.w));
                const f32x4 d = yy - s * (1.0f / 64.0f);
                const float q = row16_sum((d.x * d.x + d.y * d.y) + (d.z * d.z + d.w * d.w));
                const float rs = 1.0f / sqrtf(q * (1.0f / 64.0f) + 64e-5f);
                const f32x4 yn = d * rs * *(const f32x4*)(lnw + col) + *(const f32x4*)(lnb + col);
                st_bf4(RO + o, (yn + vv[r][j] * bon[r][j]) * gg[r][j]); } }
    }
}

__device__ __forceinline__ void phase_attn(Frame& F, const Args& A, int j, bool need_ctx) {
    REFRESH(F);
    const bf16_t* Q = WSP(bf16_t, WS_Q); const bf16_t* Kb = WSP(bf16_t, WS_K); const bf16_t* VT = WSP(bf16_t, WS_VT); bf16_t* O = WSP(bf16_t, WS_O);
    const float* sinks = A.in[I_ASINK] + j * 16;
    LAS bf16_t* Ks = (LAS bf16_t*)F.lds; LAS bf16_t* Vs = (LAS bf16_t*)(F.lds + 9216);
    LAS bf16x8* Qs = (LAS bf16x8*)(F.lds + 18432 + F.wave * 8192) + F.lane;
    const int nunits = 2048 + (need_ctx ? 256 : 0);
    const int fr = F.lane & 15, fq = F.lane >> 4, g = F.wave >> 1, hf = F.wave & 1;
    const float SC = 0.125f * 1.4426950408889634f;
    const int lr = F.tid >> 3, lch = F.tid & 7;
    __syncthreads();
    for (int u = F.c; u < nunits; u += F.G) {
        int b, kvh, qb; bool isx;
        if (u < 2048) { isx = true; b = u >> 6; kvh = (u >> 4) & 3; qb = u & 15; } else { const int v = u - 2048; isx = false; b = v >> 3; kvh = (v >> 1) & 3; qb = v & 1; }
        const int qrow0 = (isx ? b * T : NX + b * L) + qb * 128 + hf * 64; const int head = 4 * kvh + g;
        int jlo = 0, jhi = -1;
        if (isx) { jlo = qb == 0 ? 2 : 0; jhi = qb == 15 ? 3 : 5; }
        const int ntiles = 4 + (jhi - jlo + 1);
        auto tile_row0 = [&](int ti) -> int { return ti < 4 ? NX + b * L + ti * 64 : b * T + qb * 128 - 128 + 64 * (jlo + ti - 4); };
        u32x4 kv_n, vv_n;
        { const int kr0 = tile_row0(0); kv_n = *(const u32x4*)(Kb + (size_t)(kr0 + lr) * 256 + kvh * 64 + lch * 8); vv_n = *(const u32x4*)(VT + (size_t)(kvh * 64 + lr) * NT + kr0 + lch * 8); }
#pragma unroll
        for (int mq = 0; mq < 4; ++mq)
#pragma unroll
            for (int ks = 0; ks < 2; ++ks) Qs[64 * (mq * 2 + ks)] = *(const bf16x8*)(Q + (size_t)(qrow0 + 16 * mq + fr) * D + head * 64 + ks * 32 + 8 * fq);
        const float sink2 = sinks[head] * 1.4426950408889634f;
        float mrun[4], lrun[4]; f32x4 Oa[4][4];
#pragma unroll
        for (int mq = 0; mq < 4; ++mq) { mrun[mq] = sink2; lrun[mq] = fq == 0 ? 1.0f : 0.0f;
#pragma unroll
            for (int db = 0; db < 4; ++db) Oa[mq][db] = (f32x4){0.f, 0.f, 0.f, 0.f}; }
        for (int ti = 0; ti < ntiles; ++ti) {
            const int jl = ti < 4 ? -1 : jlo + ti - 4; const int ks0 = qb * 128 - 128 + 64 * jl;
            __syncthreads();
            *(LAS u32x4*)(Ks + lr * 72 + lch * 8) = kv_n; *(LAS u32x4*)(Vs + lr * 72 + lch * 8) = vv_n;
            __syncthreads();
            if (ti + 1 < ntiles) { const int kr0 = tile_row0(ti + 1); kv_n = *(const u32x4*)(Kb + (size_t)(kr0 + lr) * 256 + kvh * 64 + lch * 8); vv_n = *(const u32x4*)(VT + (size_t)(kvh * 64 + lr) * NT + kr0 + lch * 8); }
            const bool need = (jl < 0) || (jl >= hf && jl <= hf + 4);
            if (need) {
                const bool domask = (jl >= 0) && (jl == hf || jl == hf + 4);
                f32x4 Sa[4][4];
#pragma unroll
                for (int mq = 0; mq < 4; ++mq)
#pragma unroll
                    for (int n = 0; n < 4; ++n) Sa[mq][n] = (f32x4){0.f, 0.f, 0.f, 0.f};
#pragma unroll
                for (int ks = 0; ks < 2; ++ks) {
                    bf16x8 Qf[4];
#pragma unroll
                    for (int mq = 0; mq < 4; ++mq) Qf[mq] = Qs[64 * (mq * 2 + ks)];
#pragma unroll
                    for (int n = 0; n < 4; ++n) { const int kr = 32 * (n >> 1) + 8 * (fr >> 2) + 4 * (n & 1) + (fr & 3);
                        const bf16x8 Kf = *(const LAS bf16x8*)(Ks + kr * 72 + ks * 32 + 8 * fq);
#pragma unroll
                        for (int mq = 0; mq < 4; ++mq) Sa[mq][n] = __builtin_amdgcn_mfma_f32_16x16x32_bf16(Kf, Qf[mq], Sa[mq][n], 0, 0, 0); } }
                bf16x8 Pf[4][2];
#pragma unroll
                for (int mq = 0; mq < 4; ++mq) {
                    float mx = -1e30f;
                    if (domask) { const int tq = qb * 128 + hf * 64 + 16 * mq + fr;
#pragma unroll
                        for (int n = 0; n < 4; ++n)
#pragma unroll
                            for (int i = 0; i < 4; ++i) { float sv = Sa[mq][n][i] * SC; const int rel = ks0 + 32 * (n >> 1) + 8 * fq + 4 * (n & 1) + i - tq; if (rel > 128 || rel < -128) sv = -1e30f; Sa[mq][n][i] = sv; mx = fmaxf(mx, sv); } }
                    else {
#pragma unroll
                        for (int n = 0; n < 4; ++n)
#pragma unroll
                            for (int i = 0; i < 4; ++i) { const float sv = Sa[mq][n][i] * SC; Sa[mq][n][i] = sv; mx = fmaxf(mx, sv); } }
                    mx = fmaxf(mx, __shfl_xor(mx, 16)); mx = fmaxf(mx, __shfl_xor(mx, 32));
                    const float mnew = fmaxf(mrun[mq], mx); const float alpha = __builtin_amdgcn_exp2f(mrun[mq] - mnew); mrun[mq] = mnew;
                    float rs = 0.f;
#pragma unroll
                    for (int n = 0; n < 4; ++n)
#pragma unroll
                        for (int i = 0; i < 4; ++i) { const float p = __builtin_amdgcn_exp2f(Sa[mq][n][i] - mnew); Sa[mq][n][i] = p; rs += p; }
                    lrun[mq] = lrun[mq] * alpha + rs;
#pragma unroll
                    for (int db = 0; db < 4; ++db) Oa[mq][db] *= alpha;
#pragma unroll
                    for (int s2 = 0; s2 < 2; ++s2) { u32x4 w; w.x = cvt_pk_bf16(Sa[mq][2 * s2][0], Sa[mq][2 * s2][1]); w.y = cvt_pk_bf16(Sa[mq][2 * s2][2], Sa[mq][2 * s2][3]);
                        w.z = cvt_pk_bf16(Sa[mq][2 * s2 + 1][0], Sa[mq][2 * s2 + 1][1]); w.w = cvt_pk_bf16(Sa[mq][2 * s2 + 1][2], Sa[mq][2 * s2 + 1][3]); Pf[mq][s2] = __builtin_bit_cast(bf16x8, w); }
                }
#pragma unroll
                for (int db = 0; db < 4; ++db)
#pragma unroll
                    for (int s2 = 0; s2 < 2; ++s2) { const bf16x8 Vf = *(const LAS bf16x8*)(Vs + (16 * db + fr) * 72 + 32 * s2 + 8 * fq);
#pragma unroll
                        for (int mq = 0; mq < 4; ++mq) Oa[mq][db] = __builtin_amdgcn_mfma_f32_16x16x32_bf16(Vf, Pf[mq][s2], Oa[mq][db], 0, 0, 0); }
            }
        }
#pragma unroll
        for (int mq = 0; mq < 4; ++mq) { float l = lrun[mq]; l += __shfl_xor(l, 16); l += __shfl_xor(l, 32); const float inv = 1.0f / l;
            bf16_t* op = O + (size_t)(qrow0 + 16 * mq + fr) * D + head * 64 + 4 * fq;
#pragma unroll
            for (int db = 0; db < 4; ++db) st_bf4(op + 16 * db, Oa[mq][db] * inv); }
    }
    __syncthreads();
}

struct KState { XcdBarrier bar; int ph; };
#define RUN() (A.one || A.phase == KS.ph)
#define SEAM() do { if (A.one) xcd_barrier(KS.bar); ++KS.ph; } while (0)
template <int LAYER>
__device__ __forceinline__ void layer_body(Frame& F, const Args& A, KState& KS) {
    constexpr int layer = LAYER, kind = LAYER % 3, j = LAYER / 3; constexpr bool last = (LAYER == DEPTH - 1);
    LAS unsigned char* ring = F.lds;
    const LAS int* tpre = (const LAS int*)(F.lds + TPRE_OFF); const LAS int* lcnt = (const LAS int*)(F.lds + LCNT_OFF);
    bf16_t* H = WSP(bf16_t, WS_H); const float* MOD = WSP(float, WS_MOD); const bf16_t* AX = WSP(bf16_t, WS_AX);
    const float* gate1 = MOD + (size_t)layer * 33 * 6144 + 2 * D;
    constexpr int nMall = last ? NX / 256 : NT / 256;
    if (RUN()) phase_norm1(F, A, layer);
    SEAM();
    if constexpr (kind == 0) {
        if (RUN()) for (int rep_ = 0; rep_ < REPN(1); ++rep_) {
            { pg8::ProbDense P; P.A = AX; P.Bt = WSP(bf16_t, WS_WQK) + (size_t)j * 1280 * D; P.lda = D; P.ldb = D; P.K = D; P.a_pn_off = 0; P.ord.init(NT / 256, 5, F.G, F.c);
              EpiQK E{WSP(bf16_t, WS_Q), WSP(bf16_t, WS_K), WSP(float, WS_BQK) + j * 1280, WSP(float, WS_ROPEC), WSP(float, WS_ROPES)};
              pg8::gemm_phase(ring, P, E); }
            { pg8::ProbDense P; P.A = WSP(bf16_t, WS_WV) + (size_t)j * 256 * D; P.Bt = AX; P.lda = D; P.ldb = D; P.K = D; P.a_pn_off = 0; P.ord.init(1, NT / 256, F.G, F.c);
              EpiVT E{WSP(bf16_t, WS_VT), A.in[I_ABQKV] + j * 1536 + 1280};
              pg8::gemm_phase(ring, P, E); }
        }
        SEAM();
        if (RUN()) for (int rep_ = 0; rep_ < REPN(2); ++rep_) phase_attn(F, A, j, !last);
        SEAM();
        if (RUN() && !((SKIPMASK >> layer) & 1)) { pg8::ProbDense P; P.A = WSP(bf16_t, WS_O); P.Bt = WSP(bf16_t, WS_WO) + (size_t)j * D * D; P.lda = D; P.ldb = D; P.K = D; P.a_pn_off = 0; P.ord.init(nMall, 4, F.G, F.c);
            EpiResid E{H, A.in[I_ABO] + j * D, nullptr, gate1};
            pg8::gemm_phase(ring, P, E); }
        SEAM();
    } else if constexpr (kind == 1) {
        if (RUN()) for (int rep_ = 0; rep_ < REPN(3); ++rep_) phase_pooldiff(F);
        SEAM();
        if (RUN() && !((SKIPMASK >> layer) & 1)) { pg8::ProbDense P; P.A = WSP(bf16_t, WS_PD); P.Bt = WSP(bf16_t, WS_POOLW); P.lda = D; P.ldb = 256; P.K = 256; P.a_pn_off = 256; P.ord.init(nMall, 4, F.G, F.c);
            EpiResid E{H, A.in[I_PB], A.in[I_PS], gate1};
            pg8::gemm_phase(ring, P, E); }
        SEAM();
    } else {
        if (RUN()) for (int rep_ = 0; rep_ < REPN(4); ++rep_) phase_rwkv_mix(F, A);
        SEAM();
        if (RUN()) for (int rep_ = 0; rep_ < REPN(5); ++rep_) {
            for (int i = 0; i < 3; ++i) { const int sel = i == 0 ? 0 : i == 1 ? 2 : 3;
                pg8::ProbDense P; P.A = WSP(bf16_t, WS_A6) + (size_t)sel * NT * D; P.Bt = WSP(bf16_t, WS_WRKV) + (size_t)i * D * D; P.lda = D; P.ldb = D; P.K = D; P.a_pn_off = 0; P.ord.init(NT / 256, 4, F.G, F.c);
                EpiBf16Act E{WSP(bf16_t, WS_RKV) + (size_t)i * NT * D, D, nullptr, 0, 1.0f};
                pg8::gemm_phase(ring, P, E); }
            for (int i = 0; i < 3; ++i) { const int sel = i == 0 ? 5 : i == 1 ? 1 : 4;
                pg8::ProbDense P; P.A = WSP(bf16_t, WS_A6) + (size_t)sel * NT * D; P.Bt = WSP(bf16_t, WS_WL1) + (size_t)i * 256 * D; P.lda = D; P.ldb = D; P.K = D; P.a_pn_off = 0; P.ord.init(NT / 256, 1, F.G, F.c);
                EpiBf16Act E{WSP(bf16_t, WS_LORA) + i * 256, 768, nullptr, i == 0 ? 1 : i == 1 ? 2 : 0, 1.0f};
                pg8::gemm_phase(ring, P, E); }
        }
        SEAM();
        if (RUN()) for (int rep_ = 0; rep_ < REPN(6); ++rep_) {
            for (int i = 0; i < 5; ++i) {
                const int ablk = i == 0 ? 0 : i < 3 ? 1 : 2, d = (i - 1) & 1;
                pg8::ProbDense P; P.A = WSP(bf16_t, WS_LORA) + ablk * 256; P.Bt = WSP(bf16_t, WS_WL2) + (size_t)i * D * 256; P.lda = 768; P.ldb = 256; P.K = 256; P.a_pn_off = 0; P.ord.init(NT / 256, 4, F.G, F.c);
                EpiBf16Act E; E.ldc = D;
                if (i == 0) { E.O = WSP(bf16_t, WS_G); E.bias = nullptr; E.act = 0; E.scale = 1.0f; }
                else if (i < 3) { E.O = WSP(bf16_t, WS_E) + (size_t)d * NT * D; E.bias = A.in[I_RW0] + d * D; E.act = 1; E.scale = 0.6065306597126334f; }
                else { E.O = WSP(bf16_t, WS_A) + (size_t)d * NT * D; E.bias = A.in[I_RA0] + d * D; E.act = 1; E.scale = 1.0f; }
                pg8::gemm_phase(ring, P, E); }
        }
        SEAM();
        if (RUN()) for (int rep_ = 0; rep_ < REPN(7); ++rep_) phase_rwkv_scan(F, A);
        SEAM();
        if (RUN()) for (int rep_ = 0; rep_ < REPN(8); ++rep_) phase_rwkv_out(F, A, last ? NX : NT);
        SEAM();
        if (RUN() && !((SKIPMASK >> layer) & 1)) { pg8::ProbDense P; P.A = WSP(bf16_t, WS_RO); P.Bt = WSP(bf16_t, WS_WOR); P.lda = D; P.ldb = D; P.K = D; P.a_pn_off = 0; P.ord.init(nMall, 4, F.G, F.c);
            EpiResid E{H, nullptr, nullptr, gate1};
            pg8::gemm_phase(ring, P, E); }
        SEAM();
    }
    if (RUN()) phase_route(F, A, layer);
    SEAM();
    if (RUN()) for (int rep_ = 0; rep_ < REPN(9); ++rep_) { moe_tiles(F, layer);
        ProbMoe1 P; P.FX = WSP(fp8_t, WS_FX); P.W1T = WSP(fp8_t, WS_W1T) + (size_t)layer * NE * 2048 * D; P.list = WSP(int, WS_LIST); P.tpre = tpre; P.cnt = lcnt; P.texp = (const LAS unsigned char*)(F.lds + TEXP_OFF); P.toks = (LAS int*)(F.lds + TOKS_OFF); P.scale_w = SCALE_W; P.scale_x = SCALE_ONE; P.ord.init(tpre[NE], 8, F.G, F.c);
        EpiMoe1 E{WSP(unsigned char, WS_ACT), A.in[I_MB1] + (size_t)layer * NE * 2048};
        pg8::gemm_phase(ring, P, E); }
    SEAM();
    if (RUN()) for (int rep_ = 0; rep_ < REPN(10); ++rep_) { moe_tiles(F, layer);
        ProbMoe2 P; P.ACT = WSP(fp8_t, WS_ACT); P.W2T = WSP(fp8_t, WS_W2T) + (size_t)layer * NE * D * D; P.tpre = tpre; P.texp = (const LAS unsigned char*)(F.lds + TEXP_OFF); P.scale_w = SCALE_W; P.scale_x = SCALE_ONE; P.ord.init(tpre[NE], 4, F.G, F.c);
        EpiMoe2 E{WSP(bf16_t, WS_Y), A.in[I_MB2] + (size_t)layer * NE * D};
        pg8::gemm_phase(ring, P, E); }
    SEAM();
}
__global__ void __launch_bounds__(NTHREADS, 2) trunk_fwd(Args A) {
    extern __shared__ __attribute__((aligned(16))) unsigned char lds_[];
    Frame F; F.lds = (LAS unsigned char*)lds_; REFRESH(F); F.wave = __builtin_amdgcn_readfirstlane(F.tid >> 6);
    F.G = gridDim.x; F.c = blockIdx.x; F.ws = A.ws; F.ctl = (unsigned*)(A.ws + WS_CTL);
    for (int u = F.tid; u < (LDS_BYTES - LDSCTL_OFF) / 4; u += NTHREADS) ((LAS unsigned*)(F.lds + LDSCTL_OFF))[u] = 0u;
    __syncthreads();
    KState KS; KS.bar.bar = F.ctl + CW_BAR; KS.bar.x = 0; KS.bar.st = nullptr; KS.ph = 0;
    if (A.one) KS.bar = xcd_barrier_post(F.ctl + CW_BAR, (volatile LAS unsigned*)(F.lds + MISC_OFF) + 8);
    if (RUN()) for (int rep_ = 0; rep_ < REPN(0); ++rep_) phase_prologue(F, A);
    SEAM();
    layer_body<0>(F, A, KS);
    layer_body<1>(F, A, KS);
    layer_body<2>(F, A, KS);
    layer_body<3>(F, A, KS);
    if (RUN()) phase_final(F, A);
}
#undef RUN
#undef SEAM
static int count_phases() { int n = 1; for (int layer = 0; layer < DEPTH; ++layer) { const int kind = layer % 3; n += 1 + (kind == 0 ? 3 : kind == 1 ? 2 : 6) + 3; } return n + 1; }

extern "C" void kernel_launch(void* const* d_in, const int* in_sizes, int n_in, void* d_out, int out_size, void* d_ws, size_t ws_size, hipStream_t stream) {
    static int grid = 0;
    if (grid == 0) {
        if (n_in != 38 || out_size != NX * D || ws_size < WS_END) { fprintf(stderr, "kernel_launch: unexpected problem (n_in %d, out %d, ws %zu < %zu)\n", n_in, out_size, ws_size, (size_t)WS_END); grid = -1; return; }
        int dev = 0, cus = 0;
        if (hipGetDevice(&dev) != hipSuccess || hipDeviceGetAttribute(&cus, hipDeviceAttributeMultiprocessorCount, dev) != hipSuccess) { grid = -1; return; }
        if (hipFuncSetAttribute((const void*)trunk_fwd, hipFuncAttributeMaxDynamicSharedMemorySize, LDS_BYTES) != hipSuccess) { fprintf(stderr, "kernel_launch: hipFuncSetAttribute failed\n"); grid = -1; return; }
        int per_cu = 0;
        if (hipOccupancyMaxActiveBlocksPerMultiprocessor(&per_cu, (const void*)trunk_fwd, NTHREADS, LDS_BYTES) != hipSuccess || per_cu < 1) fprintf(stderr, "kernel_launch: occupancy query says %d\n", per_cu);
        (void)hipGetLastError();
        grid = cus;
        if (grid != 256) fprintf(stderr, "kernel_launch: %d CUs (built for 256)\n", grid);
    }
    if (grid < 0) return;
    (void)hipMemsetAsync((char*)d_ws + WS_CTL, 0, CTL_BYTES, stream);
    (void)hipMemsetAsync((char*)d_ws + WS_LZERO, 0, LZERO_BYTES, stream);
    Args a{};
    for (int i = 0; i < 38; ++i) a.in[i] = (const float*)d_in[i];
    a.out = (float*)d_out; a.ws = (unsigned char*)d_ws;
#if MK_ONE_LAUNCH
    a.phase = 0; a.one = 1;
    hipLaunchKernelGGL(trunk_fwd, dim3(grid), dim3(NTHREADS), LDS_BYTES, stream, a);
#else
    const int nph = count_phases();
    for (int p = 0; p < nph; ++p) { a.phase = p; a.one = 0; hipLaunchKernelGGL(trunk_fwd, dim3(grid), dim3(NTHREADS), LDS_BYTES, stream, a); }
#endif
}
```

```cpp
#include <hip/hip_runtime.h>
#include <cstdio>
#include <cstdint>

#ifndef MK_ONE_LAUNCH
#define MK_ONE_LAUNCH 1
#endif
#ifndef REPMASK
#define REPMASK 0x000
#endif
#define REPN(k) (1 + ((REPMASK >> (k)) & 1))
#ifndef DIAG
#define DIAG 0
#endif
#ifndef SKIPMASK
#define SKIPMASK 0x00
#endif

#define LAS __attribute__((address_space(3)))
#define GAS __attribute__((address_space(1)))
typedef unsigned short bf16_t;
typedef short bf16x8 __attribute__((ext_vector_type(8)));
typedef float f32x4 __attribute__((ext_vector_type(4)));
typedef float f32x2 __attribute__((ext_vector_type(2)));
typedef unsigned u32x4 __attribute__((ext_vector_type(4)));
typedef unsigned u32x2 __attribute__((ext_vector_type(2)));

constexpr int D = 1024, NB = 32, T = 2048, L = 256, DEPTH = 4;
constexpr int NX = NB * T, NC = NB * L, NT = NX + NC;
constexpr int NE = 32, TOPK = 4;
constexpr int NWAVES = 8, NTHREADS = 512;
constexpr int MAXRT = NT * TOPK / 256 + NE;

constexpr size_t MiB = 1u << 20;
constexpr size_t WS_CTL = 0, CTL_BYTES = 4 * MiB;
constexpr size_t WS_MOD = 4 * MiB;
constexpr size_t WS_ROPEC = 8 * MiB, WS_ROPES = 8 * MiB + 512 * 1024;
constexpr size_t WS_BQK = 9 * MiB;
constexpr size_t WS_WQK = 10 * MiB;
constexpr size_t WS_WV = 15 * MiB;
constexpr size_t WS_WO = 16 * MiB;
constexpr size_t WS_POOLW = 20 * MiB;
constexpr size_t WS_WRKV = 21 * MiB;
constexpr size_t WS_WOR = 27 * MiB;
constexpr size_t WS_WL1 = 30 * MiB;
constexpr size_t WS_WL2 = 32 * MiB;
constexpr size_t WS_LZERO = WS_WL1, LZERO_BYTES = 6 * MiB;
constexpr size_t WS_W1T = 40 * MiB;
constexpr size_t WS_W2T = 552 * MiB;
constexpr size_t WS_H = 808 * MiB;
constexpr size_t WS_AX = 1096 * MiB;
constexpr size_t WS_FX = 1240 * MiB;
constexpr size_t WS_R = 1384 * MiB;
constexpr size_t WS_ACT = WS_R;
constexpr size_t WS_Y = WS_R + 592 * MiB;
constexpr size_t WS_LIST = WS_R + 1184 * MiB;
constexpr size_t WS_POS = WS_R + 1193 * MiB;
constexpr size_t WS_GATE = WS_R + 1195 * MiB;
constexpr size_t WS_Q = WS_R;
constexpr size_t WS_K = WS_R + 144 * MiB;
constexpr size_t WS_VT = WS_R + 180 * MiB;
constexpr size_t WS_O = WS_R + 216 * MiB;
constexpr size_t WS_PD = WS_R;
constexpr size_t WS_A6 = WS_R;
constexpr size_t WS_E = WS_R;
constexpr size_t WS_A = WS_R + 288 * MiB;
constexpr size_t WS_RO = WS_R + 576 * MiB;
constexpr size_t WS_RKV = WS_R + 864 * MiB;
constexpr size_t WS_LORA = WS_R + 1296 * MiB;
constexpr size_t WS_G = WS_R + 1404 * MiB;
constexpr size_t WS_YS = WS_R + 1548 * MiB;
constexpr size_t WS_BONUS = WS_R + 2124 * MiB;
constexpr size_t WS_END = WS_R + 2134 * MiB;

constexpr int CW_BAR = 4096;
constexpr int CW_GCNT = 16384;
constexpr int LDS_BYTES = 147456;
constexpr int RING_BYTES = 131072;
constexpr int LDSCTL_OFF = 135168;
constexpr int MISC_OFF = LDSCTL_OFF;
constexpr int TPRE_OFF = LDSCTL_OFF + 256;
constexpr int LCNT_OFF = LDSCTL_OFF + 512;
constexpr int LBASE_OFF = LDSCTL_OFF + 768;
constexpr int REC_OFF = LDSCTL_OFF + 1024;
constexpr int TEXP_OFF = LDSCTL_OFF + 1024 + 2048;
constexpr int TOKS_OFF = LDSCTL_OFF + 1024 + 4096;
constexpr int JOB_OFF = LDSCTL_OFF + 1024;

__device__ __forceinline__ unsigned f2bf(float f) { unsigned u = __builtin_bit_cast(unsigned, f); return (u + 0x7fffu + ((u >> 16) & 1u)) >> 16; }
__device__ __forceinline__ unsigned pk2(float lo, float hi) { return f2bf(lo) | (f2bf(hi) << 16); }
__device__ __forceinline__ float bflo(unsigned w) { return __builtin_bit_cast(float, w << 16); }
__device__ __forceinline__ float bfhi(unsigned w) { return __builtin_bit_cast(float, w & 0xffff0000u); }
__device__ __forceinline__ float bf1(bf16_t b) { return __builtin_bit_cast(float, ((unsigned)b) << 16); }
__device__ __forceinline__ unsigned pk4_fp8(float a, float b, float c, float d) { int w = __builtin_amdgcn_cvt_pk_fp8_f32(a, b, 0, false); w = __builtin_amdgcn_cvt_pk_fp8_f32(c, d, w, true); return (unsigned)w; }
typedef __bf16 bf16x2_t __attribute__((ext_vector_type(2)));
__device__ __forceinline__ unsigned cvt_pk_bf16(float lo, float hi) { const f32x2 v = {lo, hi}; return __builtin_bit_cast(unsigned, __builtin_convertvector(v, bf16x2_t)); }
__device__ __forceinline__ float dpp_add(float v, const int ctrl, const int row_mask) {
    switch (ctrl) {
    case 0xB1:  return v + __builtin_bit_cast(float, __builtin_amdgcn_update_dpp(0, __builtin_bit_cast(int, v), 0xB1, 0xf, 0xf, true));
    case 0x4E:  return v + __builtin_bit_cast(float, __builtin_amdgcn_update_dpp(0, __builtin_bit_cast(int, v), 0x4E, 0xf, 0xf, true));
    case 0x141: return v + __builtin_bit_cast(float, __builtin_amdgcn_update_dpp(0, __builtin_bit_cast(int, v), 0x141, 0xf, 0xf, true));
    case 0x140: return v + __builtin_bit_cast(float, __builtin_amdgcn_update_dpp(0, __builtin_bit_cast(int, v), 0x140, 0xf, 0xf, true));
    case 0x142: return v + __builtin_bit_cast(float, __builtin_amdgcn_update_dpp(0, __builtin_bit_cast(int, v), 0x142, 0xa, 0xf, true));
    default:    return v + __builtin_bit_cast(float, __builtin_amdgcn_update_dpp(0, __builtin_bit_cast(int, v), 0x143, 0xc, 0xf, true));
    }
}
__device__ __forceinline__ float row16_sum(float v) { v = dpp_add(v, 0xB1, 0xf); v = dpp_add(v, 0x4E, 0xf); v = dpp_add(v, 0x141, 0xf); v = dpp_add(v, 0x140, 0xf); return v; }
__device__ __forceinline__ float wave_sum(float v) {
    v = row16_sum(v); v = dpp_add(v, 0x142, 0xa); v = dpp_add(v, 0x143, 0xc);
    return __builtin_bit_cast(float, __builtin_amdgcn_readlane(__builtin_bit_cast(int, v), 63));
}
__device__ __forceinline__ float sigmoidf_(float x) { return __builtin_amdgcn_rcpf(1.0f + __builtin_amdgcn_exp2f(-1.4426950408889634f * x)); }
__device__ __forceinline__ int opaque_tid() { int t; asm volatile("v_mov_b32 %0, %1" : "=v"(t) : "v"(threadIdx.x)); return t; }
#define REFRESH(F) do { (F).tid = opaque_tid(); (F).lane = (F).tid & 63; } while (0)
__device__ __forceinline__ void seq_of(int row, int& sb, int& t, int& n) { if (row < NX) { sb = row & ~(T - 1); t = row & (T - 1); n = T; } else { const int r2 = row - NX; sb = NX + (r2 & ~(L - 1)); t = r2 & (L - 1); n = L; } }
__device__ __forceinline__ f32x4 ld_bf4(const bf16_t* p) { const u32x2 w = *(const u32x2*)p; return (f32x4){bflo(w.x), bfhi(w.x), bflo(w.y), bfhi(w.y)}; }
__device__ __forceinline__ void st_bf4(bf16_t* p, f32x4 v) { u32x2 w; w.x = pk2(v.x, v.y); w.y = pk2(v.z, v.w); *(u32x2*)p = w; }

#define LDS_WAIT() asm volatile("s_waitcnt lgkmcnt(0)" ::: "memory")
#define VM_WAIT() asm volatile("s_waitcnt vmcnt(0)" ::: "memory")

#define XB_TMO      128
#define XB_XCNT(j)  (256  + 64 * (j))
#define XB_XSUB(j)  (1280 + 64 * (j))
#define XB_XGEN(j)  (2304 + 64 * (j))
#define XB_TOP      3328
#define XB_TOPGEN   3392
#define XCD_BAR_WORDS 3456
#define XB_SPIN_CAP (1u << 18)
__device__ __forceinline__ unsigned xb_ld(unsigned* p)              { return __hip_atomic_load(p, __ATOMIC_RELAXED, __HIP_MEMORY_SCOPE_AGENT); }
__device__ __forceinline__ unsigned xb_add(unsigned* p, unsigned v) { return __hip_atomic_fetch_add(p, v, __ATOMIC_RELAXED, __HIP_MEMORY_SCOPE_AGENT); }
__device__ __forceinline__ unsigned xb_xcc_id() { return (unsigned)__builtin_amdgcn_s_getreg((3 << 11) | 20) & 0xFu; }
#define XB_SPIN(cond, bar) do { unsigned _sp = 0; while (cond) { __builtin_amdgcn_s_sleep(1); \
    if ((++_sp & 255u) == 0u) { if (xb_ld(&(bar)[XB_TMO])) break; if (_sp > XB_SPIN_CAP) { atomicAdd(&(bar)[XB_TMO], 1u); break; } } } } while (0)
struct XcdBarrier { unsigned* bar; unsigned x; volatile LAS unsigned* st; };
__device__ __forceinline__ XcdBarrier xcd_barrier_post(unsigned* bar, volatile LAS unsigned* st) {
    XcdBarrier b; b.bar = bar; b.x = xb_xcc_id(); b.st = st;
    if (threadIdx.x == 0) (void)xb_add(&bar[XB_XCNT(b.x)], 1u);
    return b;
}
__device__ __forceinline__ void xcd_barrier_complete(unsigned* bar, unsigned x, unsigned& nloc, unsigned& nx) {
    const unsigned G = gridDim.x * gridDim.y * gridDim.z;
    unsigned sum, cnt, mine, sp = 0u;
    for (;;) {
        sum = 0u; cnt = 0u; mine = 0u;
#pragma unroll
        for (unsigned j = 0; j < 16; ++j) { const unsigned c = xb_ld(&bar[XB_XCNT(j)]); sum += c; cnt += (c > 0u) ? 1u : 0u; mine = (j == x) ? c : mine; }
        if (sum == G) break;
        __builtin_amdgcn_s_sleep(1);
        if ((++sp & 255u) == 0u) { if (xb_ld(&bar[XB_TMO])) break; if (sp > XB_SPIN_CAP) { atomicAdd(&bar[XB_TMO], 1u); break; } }
    }
    nloc = mine > 0u ? mine : 1u; nx = cnt > 0u ? cnt : 1u;
}
__device__ __forceinline__ void xcd_barrier(const XcdBarrier& b) {
    asm volatile("s_waitcnt vmcnt(0)" ::: "memory");
    __syncthreads();
    if (threadIdx.x == 0) {
        unsigned* bar = b.bar;
        __builtin_amdgcn_s_waitcnt(0);
        unsigned nloc = b.st[0], nx = b.st[1];
        if (nloc == 0u) { xcd_barrier_complete(bar, b.x, nloc, nx); b.st[0] = nloc; b.st[1] = nx; }
        const unsigned old = xb_add(&bar[XB_XSUB(b.x)], 1u);
        const unsigned gen = old / nloc;
        if (old + 1u == (gen + 1u) * nloc) {
            __builtin_amdgcn_fence(__ATOMIC_RELEASE, "agent");
            asm volatile("s_waitcnt vmcnt(0)" ::: "memory");
            const unsigned og = xb_add(&bar[XB_TOP], 1u);
            const unsigned tg = og / nx;
            if (og + 1u == (tg + 1u) * nx) xb_add(&bar[XB_TOPGEN], 1u);
            else XB_SPIN(xb_ld(&bar[XB_TOPGEN]) == tg, bar);
            __builtin_amdgcn_fence(__ATOMIC_ACQUIRE, "agent");
            xb_add(&bar[XB_XGEN(b.x)], 1u);
            asm volatile("s_waitcnt vmcnt(0)" ::: "memory");
        } else {
            XB_SPIN(xb_ld(&bar[XB_XGEN(b.x)]) == gen, bar);
            __builtin_amdgcn_fence(__ATOMIC_ACQUIRE, "agent");
            asm volatile("s_waitcnt vmcnt(0)" ::: "memory");
        }
    }
    __syncthreads();
}

namespace pg8 {
constexpr int BM = 256, BK = 64, HALF = 128, HTB = HALF * BK * 2, STAGE_BYTES = 8 * HTB, NXCD = 8, WGM = 8;
__host__ __device__ __forceinline__ int lds_byte(int r, int c) { const int st = (r >> 4) * 2 + (c >> 5), rr = r & 15, cc = c & 31, ob = rr * 64 + cc * 2; return st * 1024 + (ob ^ (((ob >> 9) & 1) << 5)); }
__host__ __device__ __forceinline__ void stage_rc(int b, int& R, int& C) { const int st = b / 1024, sb = b % 1024, swz = sb ^ (((sb >> 9) & 1) << 5); R = (st >> 1) * 16 + swz / 64; C = (st & 1) * 32 + (swz % 64) / 2; }
__host__ __device__ __forceinline__ int perm32(int rho) { const int n = rho >> 4, i = rho & 15; return 8 * (i >> 2) + 4 * n + (i & 3); }

typedef int i32x8 __attribute__((ext_vector_type(8)));
typedef int i32x4 __attribute__((ext_vector_type(4)));
__device__ __forceinline__ i32x8 cat8(bf16x8 lo, bf16x8 hi) { const i32x4 a = __builtin_bit_cast(i32x4, lo), b = __builtin_bit_cast(i32x4, hi); return __builtin_shufflevector(a, b, 0, 1, 2, 3, 4, 5, 6, 7); }
struct Unit { int pm, pn, e, rt; };
struct TileOrder {
    int nM, nN, nwg, G, c;
    __device__ __forceinline__ void init(int nM_, int nN_, int G_, int c_) { nM = nM_; nN = nN_; nwg = nM * nN; G = G_; c = c_; }
    __device__ __forceinline__ bool next(int i, int& pm, int& pn) const {
        const long Lx = (long)i * G + c; if (Lx >= nwg) return false;
        int wgid = (int)Lx; { const int q = nwg / NXCD, r = nwg % NXCD, xcd = wgid % NXCD, off = wgid / NXCD; wgid = (xcd < r ? xcd * (q + 1) : r * (q + 1) + (xcd - r) * q) + off; }
        const int nig = WGM * nN, gid = wgid / nig, fm = gid * WGM, gsz = (nM - fm) < WGM ? (nM - fm) : WGM;
        pm = fm + ((wgid % nig) % gsz); pn = (wgid % nig) / gsz; return true;
    }
};
struct ProbDense {
    static constexpr bool FP8 = false;
    const bf16_t* A; const bf16_t* Bt; int lda, ldb, K, a_pn_off; TileOrder ord;
    __device__ __forceinline__ int ldb_bytes() const { return ldb * 2; }
    __device__ __forceinline__ int ntiles() const { return K / 64; }
    __device__ __forceinline__ bool next(int i, Unit& u) const { u.e = 0; const bool ok = ord.next(i, u.pm, u.pn); u.rt = u.pm; return ok; }
    __device__ __forceinline__ const char* a_ptr(const Unit& u) const { return (const char*)(A + (size_t)u.pm * BM * lda + (size_t)u.pn * a_pn_off); }
    __device__ __forceinline__ const char* b_ptr(const Unit& u) const { return (const char*)(Bt + (size_t)u.pn * BM * ldb); }
    __device__ __forceinline__ void list_prefetch(const Unit&, int, int, int) const {}
    __device__ __forceinline__ void a_off(const Unit&, int, const int (&R)[2], const int (&C)[2], unsigned (&v)[2][2]) const {
#pragma unroll
        for (int h = 0; h < 2; ++h)
#pragma unroll
            for (int i = 0; i < 2; ++i) v[h][i] = (unsigned)((h * HALF + R[i]) * lda + C[i]) * 2u;
    }
};

struct ProbDense8 {
    static constexpr bool FP8 = true;
    const unsigned char* A; const unsigned char* Bt; int lda, ldb, K, scale_w, scale_x; TileOrder ord;
    __device__ __forceinline__ int ldb_bytes() const { return ldb; }
    __device__ __forceinline__ int ntiles() const { return K / 128; }
    __device__ __forceinline__ bool next(int i, Unit& u) const { u.e = 0; const bool ok = ord.next(i, u.pm, u.pn); u.rt = u.pm; return ok; }
    __device__ __forceinline__ const char* a_ptr(const Unit& u) const { return (const char*)(A + (size_t)u.pm * BM * lda); }
    __device__ __forceinline__ const char* b_ptr(const Unit& u) const { return (const char*)(Bt + (size_t)u.pn * BM * ldb); }
    __device__ __forceinline__ void list_prefetch(const Unit&, int, int, int) const {}
    __device__ __forceinline__ void a_off(const Unit&, int, const int (&R)[2], const int (&C)[2], unsigned (&v)[2][2]) const {
#pragma unroll
        for (int h = 0; h < 2; ++h)
#pragma unroll
            for (int i = 0; i < 2; ++i) v[h][i] = (unsigned)((h * HALF + R[i]) * lda + C[i] * 2);
    }
};
template <class Prob, class Epi>
__device__ __forceinline__ void gemm_phase(LAS unsigned char* lds, const Prob& P, const Epi& E) {
    const int tid = opaque_tid(), wid = __builtin_amdgcn_readfirstlane(tid >> 6), lane = tid & 63, wr = wid >> 2, wc = wid & 3, fr = lane & 15, fq = lane >> 4;
    const int nt = P.ntiles(); const int ldbB = P.ldb_bytes();
    int Rr[2], Cc[2]; unsigned voffB[2];
#pragma unroll
    for (int i = 0; i < 2; ++i) { int R, C; stage_rc(tid * 16 + i * 8192, R, C); Rr[i] = R; Cc[i] = C; const int Rb = Epi::PERM ? ((R & ~31) + perm32(R & 31)) : R;
        voffB[i] = (unsigned)(Rb * ldbB + C * 2); }
    const size_t kstep = (size_t)(BK * 2);
    const size_t hstepB = (size_t)HALF * ldbB;
    const unsigned ldsw = (unsigned)wid * 1024u;
    const int aoff = lds_byte(wr * 64 + fr, fq * 8), boff = lds_byte(wc * 32 + fr, fq * 8);
#define PG8_SA(b, h) (((b) * 2 + (h)) * HTB)
#define PG8_SB(b, h) ((4 + (b) * 2 + (h)) * HTB)
#define PG8_STAGE(bufoff, gbase, voff) do { _Pragma("unroll") for (int _i = 0; _i < 2; ++_i) \
        __builtin_amdgcn_global_load_lds((const unsigned*)((const char*)(gbase) + (voff)[_i]), (LAS unsigned*)(lds + (bufoff) + ldsw + _i * 8192), 16, 0, 0); } while (0)
#define PG8_LDA(dst, b, h) do { _Pragma("unroll") for (int m = 0; m < 4; ++m) _Pragma("unroll") for (int k = 0; k < 2; ++k) dst[m][k] = *(const LAS bf16x8*)(lds + PG8_SA(b, h) + aoff + m * 2048 + k * 1024); } while (0)
#define PG8_LDB(dst, b, h) do { _Pragma("unroll") for (int n = 0; n < 2; ++n) _Pragma("unroll") for (int k = 0; k < 2; ++k) dst[n][k] = *(const LAS bf16x8*)(lds + PG8_SB(b, h) + boff + n * 2048 + k * 1024); } while (0)
#define PG8_MMA(ai, bj, At, Bt) do { __builtin_amdgcn_s_setprio(1); _Pragma("unroll") for (int m = 0; m < 4; ++m) _Pragma("unroll") for (int n = 0; n < 2; ++n) { \
        if constexpr (Prob::FP8) { asm volatile("v_mfma_scale_f32_16x16x128_f8f6f4 %0, %1, %2, %0, %3, %4 op_sel_hi:[0,0,0]" : "+v"(acc[ai][bj][m][n]) : "v"(cat8(Bt[n][0], Bt[n][1])), "v"(cat8(At[m][0], At[m][1])), "v"(sc_w), "v"(sc_x)); } \
        else { _Pragma("unroll") for (int k = 0; k < 2; ++k) acc[ai][bj][m][n] = __builtin_amdgcn_mfma_f32_16x16x32_bf16(Bt[n][k], At[m][k], acc[ai][bj][m][n], 0, 0, 0); } } __builtin_amdgcn_s_setprio(0); } while (0)
#define PG8_WAIT_V(n) asm volatile("s_waitcnt vmcnt(" #n ")" ::: "memory")
#define PG8_WAIT_L(n) asm volatile("s_waitcnt lgkmcnt(" #n ")" ::: "memory")
#define PG8_BAR __builtin_amdgcn_s_barrier()
#define PG8_SCHED __builtin_amdgcn_sched_barrier(0)
    Unit cur, nxt; int ui = 0;
    if (!P.next(0, cur)) return;
    int sc_w = 0, sc_x = 0; if constexpr (Prob::FP8) { sc_w = P.scale_w; sc_x = P.scale_x; } (void)sc_w; (void)sc_x;
    f32x4 acc[2][2][4][2];
#pragma unroll
    for (int a = 0; a < 2; ++a)
#pragma unroll
        for (int b = 0; b < 2; ++b)
#pragma unroll
            for (int m = 0; m < 4; ++m)
#pragma unroll
                for (int n = 0; n < 2; ++n) acc[a][b][m][n] = (f32x4){0.f, 0.f, 0.f, 0.f};
    bf16x8 At[4][2], B0[2][2], B1[2][2];
    unsigned vAc[2][2], vAn[2][2];
    P.list_prefetch(cur, 0, wid, lane); { Unit u1; if (P.next(1, u1)) P.list_prefetch(u1, 1, wid, lane); }
    PG8_WAIT_V(0); PG8_BAR;
    P.a_off(cur, 0, Rr, Cc, vAc);
    const char* cA = P.a_ptr(cur); const char* cB = P.b_ptr(cur);
    PG8_STAGE(PG8_SB(0, 0), cB, voffB); PG8_STAGE(PG8_SB(0, 1), cB + hstepB, voffB); PG8_STAGE(PG8_SA(0, 0), cA, vAc[0]); PG8_STAGE(PG8_SA(0, 1), cA, vAc[1]);
    if (wr == 1) PG8_BAR;
    PG8_WAIT_V(2); PG8_BAR;
    PG8_STAGE(PG8_SB(1, 0), cB + kstep, voffB); PG8_STAGE(PG8_SA(1, 0), cA + kstep, vAc[0]); PG8_STAGE(PG8_SB(1, 1), cB + hstepB + kstep, voffB);
    PG8_WAIT_V(6); PG8_BAR;
    for (;;) {
        const bool has_next = P.next(ui + 1, nxt);
        const char* nA = cA; const char* nB = cB;
#pragma unroll
        for (int h = 0; h < 2; ++h)
#pragma unroll
            for (int i = 0; i < 2; ++i) vAn[h][i] = vAc[h][i];
        if (has_next) { nA = P.a_ptr(nxt); nB = P.b_ptr(nxt); P.a_off(nxt, (ui + 1) & 1, Rr, Cc, vAn); }
        { Unit u2; if (P.next(ui + 2, u2)) P.list_prefetch(u2, ui & 1, wid, lane); }
        for (int t = 0; t < nt; t += 2) {
            const bool last = (t == nt - 2);
            const char* a1 = cA + (size_t)(t + 1) * kstep;
            const char* a2 = last ? nA : cA + (size_t)(t + 2) * kstep; const char* b2 = last ? nB : cB + (size_t)(t + 2) * kstep;
            const char* a3 = a2 + kstep; const char* b3 = b2 + kstep;
            unsigned vX[2][2];
#pragma unroll
            for (int h = 0; h < 2; ++h)
#pragma unroll
                for (int i = 0; i < 2; ++i) vX[h][i] = last ? vAn[h][i] : vAc[h][i];
            PG8_LDB(B0, 0, 0); PG8_LDB(B1, 0, 1); PG8_SCHED; PG8_LDA(At, 0, 0); PG8_STAGE(PG8_SA(1, 1), a1, vAc[1]);
            PG8_WAIT_V(8); PG8_WAIT_L(0); PG8_BAR; PG8_MMA(0, 0, At, B0); PG8_MMA(0, 1, At, B1); PG8_BAR; PG8_SCHED;
            PG8_LDA(At, 0, 1); PG8_STAGE(PG8_SB(0, 0), b2, voffB); PG8_STAGE(PG8_SB(0, 1), b2 + hstepB, voffB); PG8_STAGE(PG8_SA(0, 0), a2, vX[0]);
            PG8_WAIT_V(8); PG8_WAIT_L(0); PG8_BAR; PG8_MMA(1, 0, At, B0); PG8_MMA(1, 1, At, B1); PG8_BAR; PG8_SCHED;
            PG8_LDB(B0, 1, 0); PG8_LDB(B1, 1, 1); PG8_SCHED; PG8_LDA(At, 1, 0); PG8_STAGE(PG8_SA(0, 1), a2, vX[1]);
            PG8_WAIT_V(8); PG8_WAIT_L(0); PG8_BAR; PG8_MMA(0, 0, At, B0); PG8_MMA(0, 1, At, B1); PG8_BAR; PG8_SCHED;
            PG8_LDA(At, 1, 1); PG8_STAGE(PG8_SB(1, 0), b3, voffB); PG8_STAGE(PG8_SB(1, 1), b3 + hstepB, voffB); PG8_STAGE(PG8_SA(1, 0), a3, vX[0]);
            PG8_WAIT_V(8); PG8_WAIT_L(0); PG8_BAR; PG8_MMA(1, 0, At, B0); PG8_MMA(1, 1, At, B1); PG8_BAR; PG8_SCHED;
        }
        if (wr == 0) PG8_BAR;
        if constexpr (Prob::FP8) asm volatile("s_nop 15\n\ts_nop 15" ::: "memory");
        E(acc, cur, wr, wc, fr, fq);
        if (!has_next) break;
#pragma unroll
        for (int a = 0; a < 2; ++a)
#pragma unroll
            for (int b = 0; b < 2; ++b)
#pragma unroll
                for (int m = 0; m < 4; ++m)
#pragma unroll
                    for (int n = 0; n < 2; ++n) acc[a][b][m][n] = (f32x4){0.f, 0.f, 0.f, 0.f};
        cur = nxt; cA = nA; cB = nB; ++ui;
#pragma unroll
        for (int h = 0; h < 2; ++h)
#pragma unroll
            for (int i = 0; i < 2; ++i) vAc[h][i] = vAn[h][i];
        if (wr == 1) PG8_BAR;
    }
    PG8_WAIT_V(0);
    PG8_BAR;
#undef PG8_SA
#undef PG8_SB
#undef PG8_STAGE
#undef PG8_LDA
#undef PG8_LDB
#undef PG8_MMA
#undef PG8_WAIT_V
#undef PG8_WAIT_L
#undef PG8_BAR
#undef PG8_SCHED
}
}

using pg8::Unit;
constexpr int HALF_ = 128;
struct EpiBf16Act {
    static constexpr bool PERM = true;
    bf16_t* O; int ldc; const float* bias; int act; float scale;
    __device__ __forceinline__ void operator()(const f32x4 (&acc)[2][2][4][2], const Unit& u, int wr, int wc, int fr, int fq) const {
        const int row0 = u.pm * 256 + wr * 64 + fr, col0 = u.pn * 256 + wc * 32 + 8 * fq;
        f32x4 bv[2][2];
#pragma unroll
        for (int bj = 0; bj < 2; ++bj)
#pragma unroll
            for (int n = 0; n < 2; ++n) bv[bj][n] = bias ? *(const f32x4*)(bias + col0 + bj * HALF_ + 4 * n) : (f32x4){0.f, 0.f, 0.f, 0.f};
#pragma unroll
        for (int ai = 0; ai < 2; ++ai)
#pragma unroll
            for (int m = 0; m < 4; ++m) { bf16_t* rowp = O + (size_t)(row0 + ai * HALF_ + m * 16) * ldc + col0;
#pragma unroll
                for (int bj = 0; bj < 2; ++bj) { f32x4 v0 = acc[ai][bj][m][0] + bv[bj][0], v1 = acc[ai][bj][m][1] + bv[bj][1];
                    if (act == 1) {
#pragma unroll
                        for (int j = 0; j < 4; ++j) { v0[j] = sigmoidf_(v0[j]) * scale; v1[j] = sigmoidf_(v1[j]) * scale; } }
                    else if (act == 2) {
#pragma unroll
                        for (int j = 0; j < 4; ++j) { v0[j] = 1.0f - 2.0f * __builtin_amdgcn_rcpf(__builtin_amdgcn_exp2f(2.8853900817779268f * v0[j]) + 1.0f); v1[j] = 1.0f - 2.0f * __builtin_amdgcn_rcpf(__builtin_amdgcn_exp2f(2.8853900817779268f * v1[j]) + 1.0f); } }
                    u32x4 w; w.x = cvt_pk_bf16(v0[0], v0[1]); w.y = cvt_pk_bf16(v0[2], v0[3]); w.z = cvt_pk_bf16(v1[0], v1[1]); w.w = cvt_pk_bf16(v1[2], v1[3]);
                    *(u32x4*)(rowp + bj * HALF_) = w; } }
    }
};
struct EpiQK {
    static constexpr bool PERM = true;
    bf16_t* Q; bf16_t* Kb; const float* bias; const float* ropec; const float* ropes;
    __device__ __forceinline__ void operator()(const f32x4 (&acc)[2][2][4][2], const Unit& u, int wr, int wc, int fr, int fq) const {
        int row0 = u.pm * 256 + wr * 64 + fr, cl0 = wc * 32 + 8 * fq;
        asm volatile("" : "+v"(row0), "+v"(cl0));
        const int g = (4 * wc + fq) & 7;
        bf16_t* base; int ldc;
        if (u.pn < 4) { base = Q + u.pn * 256; ldc = 1024; } else { base = Kb; ldc = 256; }
        f32x4 bv[2][2];
#pragma unroll
        for (int bj = 0; bj < 2; ++bj)
#pragma unroll
            for (int n = 0; n < 2; ++n) bv[bj][n] = *(const f32x4*)(bias + u.pn * 256 + cl0 + bj * HALF_ + 4 * n);
#pragma unroll
        for (int ai = 0; ai < 2; ++ai)
#pragma unroll
            for (int m = 0; m < 4; ++m) { const int row = row0 + ai * HALF_ + m * 16; bf16_t* rowp = base + (size_t)row * ldc + cl0;
                f32x4 cs = (f32x4){1.f, 1.f, 1.f, 1.f}, sn = (f32x4){0.f, 0.f, 0.f, 0.f};
                if (row < NX) { const int t = row & (T - 1); cs = *(const f32x4*)(ropec + t * 32 + g * 4); sn = *(const f32x4*)(ropes + t * 32 + g * 4); }
#pragma unroll
                for (int bj = 0; bj < 2; ++bj) { const f32x4 v0 = acc[ai][bj][m][0] + bv[bj][0], v1 = acc[ai][bj][m][1] + bv[bj][1];
                    const f32x4 o0 = v0 * cs - v1 * sn, o1 = v1 * cs + v0 * sn;
                    u32x4 w; w.x = cvt_pk_bf16(o0[0], o0[1]); w.y = cvt_pk_bf16(o0[2], o0[3]); w.z = cvt_pk_bf16(o1[0], o1[1]); w.w = cvt_pk_bf16(o1[2], o1[3]);
                    *(u32x4*)(rowp + bj * HALF_) = w; } }
    }
};
struct EpiVT {
    static constexpr bool PERM = true;
    bf16_t* VT; const float* biasrow;
    __device__ __forceinline__ void operator()(const f32x4 (&acc)[2][2][4][2], const Unit& u, int wr, int wc, int fr, int fq) const {
        int row0 = wr * 64 + fr, col0 = u.pn * 256 + wc * 32 + 8 * fq;
        asm volatile("" : "+v"(row0), "+v"(col0));
#pragma unroll
        for (int ai = 0; ai < 2; ++ai)
#pragma unroll
            for (int m = 0; m < 4; ++m) { const int row = row0 + ai * HALF_ + m * 16; const float b = biasrow[row]; bf16_t* rowp = VT + (size_t)row * NT + col0;
#pragma unroll
                for (int bj = 0; bj < 2; ++bj) { const f32x4 v0 = acc[ai][bj][m][0] + b, v1 = acc[ai][bj][m][1] + b;
                    u32x4 w; w.x = cvt_pk_bf16(v0[0], v0[1]); w.y = cvt_pk_bf16(v0[2], v0[3]); w.z = cvt_pk_bf16(v1[0], v1[1]); w.w = cvt_pk_bf16(v1[2], v1[3]);
                    *(u32x4*)(rowp + bj * HALF_) = w; } }
    }
};
struct EpiResid {
    static constexpr bool PERM = true;
    bf16_t* H; const float* bias; const float* ls; const float* gate;
    __device__ __forceinline__ void operator()(const f32x4 (&acc)[2][2][4][2], const Unit& u, int wr, int wc, int fr, int fq) const {
        int row0 = u.pm * 256 + wr * 64 + fr, col0 = u.pn * 256 + wc * 32 + 8 * fq;
        asm volatile("" : "+v"(row0), "+v"(col0));
        f32x4 bv[2][2], lv[2][2];
#pragma unroll
        for (int bj = 0; bj < 2; ++bj)
#pragma unroll
            for (int n = 0; n < 2; ++n) { bv[bj][n] = bias ? *(const f32x4*)(bias + col0 + bj * HALF_ + 4 * n) : (f32x4){0.f, 0.f, 0.f, 0.f};
                                          lv[bj][n] = ls ? *(const f32x4*)(ls + col0 + bj * HALF_ + 4 * n) : (f32x4){1.f, 1.f, 1.f, 1.f}; }
#pragma unroll
        for (int ai = 0; ai < 2; ++ai)
#pragma unroll
            for (int m = 0; m < 4; ++m) { const int row = row0 + ai * HALF_ + m * 16; const int brow = row < NX ? (row >> 11) : 32;
                bf16_t* hp = H + (size_t)row * D + col0; const float* gp = gate + (size_t)brow * (6 * D) + col0;
#pragma unroll
                for (int bj = 0; bj < 2; ++bj) { const u32x4 hw = *(const u32x4*)(hp + bj * HALF_);
                    const f32x4 g0 = *(const f32x4*)(gp + bj * HALF_), g1 = *(const f32x4*)(gp + bj * HALF_ + 4);
                    const f32x4 y0 = (acc[ai][bj][m][0] + bv[bj][0]) * lv[bj][0], y1 = (acc[ai][bj][m][1] + bv[bj][1]) * lv[bj][1];
                    const f32x4 h0 = (f32x4){bflo(hw.x), bfhi(hw.x), bflo(hw.y), bfhi(hw.y)} + g0 * y0, h1 = (f32x4){bflo(hw.z), bfhi(hw.z), bflo(hw.w), bfhi(hw.w)} + g1 * y1;
                    u32x4 w; w.x = cvt_pk_bf16(h0[0], h0[1]); w.y = cvt_pk_bf16(h0[2], h0[3]); w.z = cvt_pk_bf16(h1[0], h1[1]); w.w = cvt_pk_bf16(h1[2], h1[3]);
                    *(u32x4*)(hp + bj * HALF_) = w; }
                asm volatile("" ::: "memory"); }
    }
};
struct EpiMoe1 {
    static constexpr bool PERM = true;
    unsigned char* ACT; const float* b1;
    __device__ __forceinline__ void operator()(const f32x4 (&acc)[2][2][4][2], const Unit& u, int wr, int wc, int fr, int fq) const {
        const int row0 = u.rt * 256 + wr * 64 + fr, cl = u.pn * 128 + wc * 32 + 8 * fq;
        const float* bg = b1 + (size_t)u.e * 2048 + cl; const float* bl = bg + 1024;
        f32x4 bgv[2], blv[2];
#pragma unroll
        for (int n = 0; n < 2; ++n) { bgv[n] = *(const f32x4*)(bg + 4 * n); blv[n] = *(const f32x4*)(bl + 4 * n); }
#pragma unroll
        for (int ai = 0; ai < 2; ++ai)
#pragma unroll
            for (int m = 0; m < 4; ++m) { unsigned char* rowp = ACT + (size_t)(row0 + ai * HALF_ + m * 16) * D + cl;
                f32x4 o[2];
#pragma unroll
                for (int n = 0; n < 2; ++n) { const f32x4 hg = acc[ai][0][m][n] + bgv[n], hl = acc[ai][1][m][n] + blv[n];
#pragma unroll
                    for (int j = 0; j < 4; ++j) { const float gl = fminf(hg[j], 7.0f); const float li = fminf(fmaxf(hl[j], -7.0f), 7.0f);
                        o[n][j] = gl * sigmoidf_(1.702f * gl) * (li + 1.0f); } }
                u32x2 w; w.x = pk4_fp8(o[0][0], o[0][1], o[0][2], o[0][3]); w.y = pk4_fp8(o[1][0], o[1][1], o[1][2], o[1][3]);
                *(u32x2*)rowp = w; }
    }
};
struct EpiMoe2 {
    static constexpr bool PERM = true;
    bf16_t* Y; const float* b2;
    __device__ __forceinline__ void operator()(const f32x4 (&acc)[2][2][4][2], const Unit& u, int wr, int wc, int fr, int fq) const {
        const int row0 = u.rt * 256 + wr * 64 + fr, col0 = u.pn * 256 + wc * 32 + 8 * fq;
        const float* bb = b2 + (size_t)u.e * D + col0;
        f32x4 bv[2][2];
#pragma unroll
        for (int bj = 0; bj < 2; ++bj)
#pragma unroll
            for (int n = 0; n < 2; ++n) bv[bj][n] = *(const f32x4*)(bb + bj * HALF_ + 4 * n);
#pragma unroll
        for (int ai = 0; ai < 2; ++ai)
#pragma unroll
            for (int m = 0; m < 4; ++m) { bf16_t* rowp = Y + (size_t)(row0 + ai * HALF_ + m * 16) * D + col0;
#pragma unroll
                for (int bj = 0; bj < 2; ++bj) { const f32x4 v0 = acc[ai][bj][m][0] + bv[bj][0], v1 = acc[ai][bj][m][1] + bv[bj][1];
                    u32x4 w; w.x = cvt_pk_bf16(v0[0], v0[1]); w.y = cvt_pk_bf16(v0[2], v0[3]); w.z = cvt_pk_bf16(v1[0], v1[1]); w.w = cvt_pk_bf16(v1[2], v1[3]);
                    *(u32x4*)(rowp + bj * HALF_) = w; } }
    }
};
typedef unsigned char fp8_t;
constexpr int SCALE_ONE = 0x7f7f7f7f, SCALE_W = 0x79797979;
struct ProbMoe1 {
    static constexpr bool FP8 = true;
    const fp8_t* FX; const fp8_t* W1T; const int* list; const LAS int* tpre; const LAS int* cnt; const LAS unsigned char* texp; LAS int* toks; int scale_w, scale_x; pg8::TileOrder ord;
    __device__ __forceinline__ int ldb_bytes() const { return D; }
    __device__ __forceinline__ int ntiles() const { return D / 128; }
    __device__ __forceinline__ bool next(int i, Unit& u) const {
        if (!ord.next(i, u.pm, u.pn)) return false;
        u.rt = u.pm; u.e = texp[u.rt]; return true;
    }
    __device__ __forceinline__ const char* a_ptr(const Unit&) const { return (const char*)FX; }
    __device__ __forceinline__ const char* b_ptr(const Unit& u) const { return (const char*)(W1T + ((size_t)u.e * 2048 + (size_t)u.pn * 256) * D); }
    __device__ __forceinline__ void list_prefetch(const Unit& u, int par, int wid, int lane) const {
        if (wid == 0) { const int* src = list + (size_t)u.e * NT + (u.rt - tpre[u.e]) * 256 + 4 * lane;
            __builtin_amdgcn_global_load_lds((const unsigned*)src, (LAS unsigned*)(toks + par * 256), 16, 0, 0); }
    }
    __device__ __forceinline__ void a_off(const Unit& u, int par, const int (&R)[2], const int (&C)[2], unsigned (&v)[2][2]) const {
        const int nvalid = cnt[u.e] - (u.rt - tpre[u.e]) * 256; const LAS int* tk = toks + par * 256;
#pragma unroll
        for (int h = 0; h < 2; ++h)
#pragma unroll
            for (int i = 0; i < 2; ++i) { const int r = h * 128 + R[i]; const int tok = tk[r < nvalid ? r : 0]; v[h][i] = (unsigned)(tok * D + C[i] * 2); }
    }
};
struct ProbMoe2 {
    static constexpr bool FP8 = true;
    const fp8_t* ACT; const fp8_t* W2T; const LAS int* tpre; const LAS unsigned char* texp; int scale_w, scale_x; pg8::TileOrder ord;
    __device__ __forceinline__ int ldb_bytes() const { return D; }
    __device__ __forceinline__ int ntiles() const { return D / 128; }
    __device__ __forceinline__ bool next(int i, Unit& u) const {
        if (!ord.next(i, u.pm, u.pn)) return false;
        u.rt = u.pm; u.e = texp[u.rt]; return true;
    }
    __device__ __forceinline__ const char* a_ptr(const Unit& u) const { return (const char*)(ACT + (size_t)u.rt * 256 * D); }
    __device__ __forceinline__ const char* b_ptr(const Unit& u) const { return (const char*)(W2T + ((size_t)u.e * 1024 + (size_t)u.pn * 256) * D); }
    __device__ __forceinline__ void list_prefetch(const Unit&, int, int, int) const {}
    __device__ __forceinline__ void a_off(const Unit&, int, const int (&R)[2], const int (&C)[2], unsigned (&v)[2][2]) const {
#pragma unroll
        for (int h = 0; h < 2; ++h)
#pragma unroll
            for (int i = 0; i < 2; ++i) v[h][i] = (unsigned)((h * 128 + R[i]) * D + C[i] * 2);
    }
};
struct Args { const float* in[38]; float* out; unsigned char* ws; int phase; int one; };
enum { I_X = 0, I_C, I_CTX, I_CCTX, I_ADAW, I_ADAB, I_NORMG, I_AWQKV, I_ABQKV, I_AWO, I_ABO, I_ASINK, I_PW, I_PB, I_PS,
       I_RMIX, I_RWRKV, I_RW0, I_RW1, I_RW2, I_RA0, I_RA1, I_RA2, I_RG1, I_RG2, I_RKK, I_RKA, I_RRK, I_RLNW, I_RLNB, I_RWO,
       I_MWR, I_MBR, I_MW1, I_MB1, I_MW2, I_MB2, I_FG };
struct Frame { LAS unsigned char* lds; int tid, lane, wave, G, c; unsigned char* ws; unsigned* ctl; };
#define WSP(T_, off) ((T_*)(F.ws + (off)))

struct TJob { const float* src; unsigned char* dst; long sbs, dbs; int ldw, ldt, nkb, nnb, mode, item0, per, esz; };
__device__ __forceinline__ int dst_row(int mode, int n) {
    if (mode == 1) { const int hb = n & ~63, d = n & 63; const int ax = d >> 5, dd = d & 31, hf = dd >> 4, f = dd & 15; const int g = ax * 4 + (f >> 2), i = (f & 3) + 4 * hf; return hb + 8 * g + i; }
    if (mode == 2) { return n < 1024 ? ((n >> 7) << 8) + (n & 127) : (((n - 1024) >> 7) << 8) + 128 + (n & 127); }
    return n;
}
struct TItem { const float* src; unsigned char* dst; int ldw, ldt, mode, n0, esz; };
__device__ __forceinline__ void titem_decode(const LAS TJob* jobs, int nj, int it, TItem& T) {
    int ji = 0;
    for (int q = 1; q < nj; ++q) ji += (jobs[q].item0 <= it) ? 1 : 0;
    const LAS TJob& J = jobs[ji]; const int r = it - J.item0, bi = r / J.per, rr = r % J.per, kb = rr / J.nnb, nb = rr % J.nnb;
    T.src = J.src + bi * J.sbs + (size_t)(64 * kb) * J.ldw + 32 * nb; T.dst = J.dst + (bi * J.dbs + 64 * kb) * J.esz; T.ldw = J.ldw; T.ldt = J.ldt; T.mode = J.mode; T.n0 = 32 * nb; T.esz = J.esz;
}
__device__ __forceinline__ void titem_load(const TItem& T, int lane, f32x4 (&v)[8]) {
    const float* p = T.src + (size_t)(lane >> 3) * T.ldw + 4 * (lane & 7);
#pragma unroll
    for (int i = 0; i < 8; ++i) v[i] = *(const f32x4*)(p + (size_t)(8 * i) * T.ldw);
}
__device__ __forceinline__ void titem_store(const TItem& T, int lane, const f32x4 (&v)[8], LAS float* scr) {
#pragma unroll
    for (int i = 0; i < 8; ++i) { LAS float* d = scr + (8 * i + (lane >> 3)) * 33 + 4 * (lane & 7); d[0] = v[i].x; d[1] = v[i].y; d[2] = v[i].z; d[3] = v[i].w; }
    LDS_WAIT(); asm volatile("" ::: "memory");
    const int c = lane & 7;
#pragma unroll
    for (int j = 0; j < 4; ++j) { const int n = (lane >> 3) + 8 * j; const LAS float* s = scr + (8 * c) * 33 + n;
        const size_t eo = (size_t)dst_row(T.mode, T.n0 + n) * T.ldt + 8 * c;
        if (T.esz == 2) { u32x4 o; o.x = pk2(s[0 * 33], s[1 * 33]); o.y = pk2(s[2 * 33], s[3 * 33]); o.z = pk2(s[4 * 33], s[5 * 33]); o.w = pk2(s[6 * 33], s[7 * 33]); *(u32x4*)(T.dst + eo * 2) = o; }
        else { u32x2 o; o.x = pk4_fp8(64.f * s[0 * 33], 64.f * s[1 * 33], 64.f * s[2 * 33], 64.f * s[3 * 33]); o.y = pk4_fp8(64.f * s[4 * 33], 64.f * s[5 * 33], 64.f * s[6 * 33], 64.f * s[7 * 33]); *(u32x2*)(T.dst + eo) = o; } }
    LDS_WAIT(); asm volatile("" ::: "memory");
}
__device__ __forceinline__ void phase_prologue(Frame& F, const Args& A) {
    REFRESH(F);
    LAS float* S = (LAS float*)F.lds;
    for (int idx = F.tid; idx < 33 * 1024; idx += NTHREADS) { const int r = idx >> 10, k = idx & 1023; const float v = r < 32 ? A.in[I_C][r * 1024 + k] : A.in[I_CCTX][k]; S[k * 33 + r] = v / (1.0f + __expf(-v)); }
    __syncthreads();
    float* MOD = WSP(float, WS_MOD);
    for (int it = F.c; it < 4 * 96; it += F.G) {
        const int layer = it / 96, n = (it % 96) * 64 + F.lane; const float* wp = A.in[I_ADAW] + (size_t)layer * 1024 * 6144 + n;
        float acc[5] = {0.f, 0.f, 0.f, 0.f, 0.f};
        for (int k0 = 0; k0 < 1024; k0 += 32) {
            float wv[32];
#pragma unroll
            for (int u = 0; u < 32; ++u) wv[u] = wp[(size_t)(k0 + u) * 6144];
#pragma unroll
            for (int u = 0; u < 32; ++u) { const LAS float* sr = S + (k0 + u) * 33 + F.wave;
                acc[0] += sr[0] * wv[u]; acc[1] += sr[8] * wv[u]; acc[2] += sr[16] * wv[u]; acc[3] += sr[24] * wv[u]; if (F.wave == 0) acc[4] += S[(k0 + u) * 33 + 32] * wv[u]; }
        }
        const float bb = A.in[I_ADAB][layer * 6144 + n];
#pragma unroll
        for (int i = 0; i < 4; ++i) MOD[((size_t)layer * 33 + F.wave + 8 * i) * 6144 + n] = acc[i] + bb;
        if (F.wave == 0) MOD[((size_t)layer * 33 + 32) * 6144 + n] = acc[4] + bb;
    }
    { float* rc = WSP(float, WS_ROPEC); float* rs = WSP(float, WS_ROPES);
      for (int idx = F.c * NTHREADS + F.tid; idx < 2048 * 32; idx += F.G * NTHREADS) { const int t = idx >> 5, e = idx & 31, g = e >> 2, i = e & 3, f = 4 * (g & 3) + i;
          const float inv = powf(10000.0f, -(float)f / 16.0f); const float pos = (float)(g < 4 ? (t >> 6) : (t & 63)); const float ang = pos * inv; rc[idx] = cosf(ang); rs[idx] = sinf(ang); }
      float* bq = WSP(float, WS_BQK);
      for (int idx = F.c * NTHREADS + F.tid; idx < 2 * 1280; idx += F.G * NTHREADS) { const int j = idx / 1280, n = idx % 1280; bq[j * 1280 + dst_row(1, n)] = A.in[I_ABQKV][j * 1536 + n]; } }
    __syncthreads();
    LAS TJob* jobs = (LAS TJob*)(F.lds + JOB_OFF); LAS int* njobs = (LAS int*)(F.lds + MISC_OFF + 64);
    if (F.tid == 0) {
        int nj = 0, item = 0;
        auto add = [&](const float* src, bf16_t* dst, int ldw, int ldt, int Ks, int Ns, int mode, int nb, long sbs, long dbs, int esz = 2) {
            LAS TJob& j = jobs[nj]; j.src = src; j.dst = (unsigned char*)dst; j.sbs = sbs; j.dbs = dbs; j.ldw = ldw; j.ldt = ldt; j.nkb = Ks / 64; j.nnb = Ns / 32; j.mode = mode; j.item0 = item; j.per = (Ks / 64) * (Ns / 32); j.esz = esz;
            ++nj; item += (Ks / 64) * (Ns / 32) * nb; };
        add(A.in[I_AWQKV], WSP(bf16_t, WS_WQK), 1536, 1024, 1024, 1280, 1, 2, 1024L * 1536, 1280L * 1024, 1);
        add(A.in[I_AWQKV] + 1280, WSP(bf16_t, WS_WV), 1536, 1024, 1024, 256, 0, 2, 1024L * 1536, 256L * 1024, 1);
        add(A.in[I_AWO], WSP(bf16_t, WS_WO), 1024, 1024, 1024, 1024, 0, 2, 1L << 20, 1L << 20, 1);
        add(A.in[I_PW], WSP(bf16_t, WS_POOLW), 256, 256, 256, 256, 0, 4, 65536, 65536);
        add(A.in[I_RWRKV], WSP(bf16_t, WS_WRKV), 1024, 1024, 1024, 1024, 0, 3, 1L << 20, 1L << 20, 1);
        add(A.in[I_RG1], WSP(bf16_t, WS_WL1), 128, 1024, 1024, 128, 0, 1, 0, 0);
        add(A.in[I_RW1], WSP(bf16_t, WS_WL1) + 256 * 1024, 64, 1024, 1024, 64, 0, 2, 65536, 65536);
        add(A.in[I_RA1], WSP(bf16_t, WS_WL1) + 2 * 256 * 1024, 64, 1024, 1024, 64, 0, 2, 65536, 65536);
        add(A.in[I_RG2], WSP(bf16_t, WS_WL2), 1024, 256, 128, 1024, 0, 1, 0, 0);
        add(A.in[I_RW2], WSP(bf16_t, WS_WL2) + 1 * 1024 * 256, 1024, 256, 64, 1024, 0, 2, 65536, 1024L * 256 + 64);
        add(A.in[I_RA2], WSP(bf16_t, WS_WL2) + 3 * 1024 * 256, 1024, 256, 64, 1024, 0, 2, 65536, 1024L * 256 + 64);
        add(A.in[I_RWO], WSP(bf16_t, WS_WOR), 1024, 1024, 1024, 1024, 0, 1, 0, 0, 1);
        add(A.in[I_MW1], WSP(bf16_t, WS_W1T), 2048, 1024, 1024, 2048, 2, 128, 1024L * 2048, 2048L * 1024, 1);
        add(A.in[I_MW2], WSP(bf16_t, WS_W2T), 1024, 1024, 1024, 1024, 0, 128, 1L << 20, 1L << 20, 1);
        njobs[0] = nj; njobs[1] = item;
    }
    __syncthreads();
    { const int nj = njobs[0], nitems = njobs[1]; LAS float* scr = (LAS float*)(F.lds + F.wave * 16384);
      const int gw = F.c * NWAVES + F.wave, NGW = F.G * NWAVES;
      int it = gw;
      if (it < nitems) {
          TItem Tc, Tn; f32x4 vc[8], vn[8];
          titem_decode(jobs, nj, it, Tc); titem_load(Tc, F.lane, vc);
          for (;;) {
              const int itn = it + NGW; const bool more = itn < nitems;
              if (more) { titem_decode(jobs, nj, itn, Tn); titem_load(Tn, F.lane, vn); }
              titem_store(Tc, F.lane, vc, scr);
              if (!more) break;
              Tc = Tn;
#pragma unroll
              for (int i = 0; i < 8; ++i) vc[i] = vn[i];
              it = itn;
          }
      } }
    __syncthreads();
}

__device__ __forceinline__ void moe_tiles(Frame& F, int layer) {
    REFRESH(F);
    LAS int* lcnt = (LAS int*)(F.lds + LCNT_OFF); LAS int* tpre = (LAS int*)(F.lds + TPRE_OFF);
    __syncthreads();
    if (F.tid < NE) lcnt[F.tid] = (int)__hip_atomic_load(F.ctl + CW_GCNT + layer * 64 + F.tid, __ATOMIC_RELAXED, __HIP_MEMORY_SCOPE_AGENT);
    __syncthreads();
    if (F.tid == 0) { int s = 0; for (int e = 0; e < NE; ++e) { tpre[e] = s; s += (lcnt[e] + 255) >> 8; } tpre[NE] = s; }
    __syncthreads();
    { LAS unsigned char* texp = (LAS unsigned char*)(F.lds + TEXP_OFF); const int nrt = tpre[NE];
      for (int rt = F.tid; rt < nrt; rt += NTHREADS) { int e = 0; for (int j = 1; j < NE; ++j) e += (tpre[j] <= rt) ? 1 : 0; texp[rt] = (unsigned char)e; } }
    __syncthreads();
}
constexpr int RB = 2;
#define ROWOF(it, r) ((((it) * F.G + F.c) * NWAVES + F.wave) * RB + (r))
struct MoeRef { int p[4]; float g[4]; };
__device__ __forceinline__ void moe_ref_load(Frame& F, int row, MoeRef& R) {
    const int4 pp = *(const int4*)(WSP(int, WS_POS) + (size_t)row * 4); const f32x4 gg = *(const f32x4*)(WSP(float, WS_GATE) + (size_t)row * 4);
    R.p[0] = pp.x; R.p[1] = pp.y; R.p[2] = pp.z; R.p[3] = pp.w; R.g[0] = gg.x; R.g[1] = gg.y; R.g[2] = gg.z; R.g[3] = gg.w;
}
__device__ __forceinline__ void moe_rows_load(Frame& F, const MoeRef& R, u32x2 (&y)[4][4]) {
    const LAS int* tpre = (const LAS int*)(F.lds + TPRE_OFF); const bf16_t* Y = WSP(bf16_t, WS_Y);
#pragma unroll
    for (int k = 0; k < 4; ++k) { const int e = R.p[k] >> 20, slot = R.p[k] & 0xfffff; const size_t fr = (size_t)tpre[e] * 256 + slot; const u32x2* yp = (const u32x2*)(Y + fr * D) + F.lane;
#pragma unroll
        for (int j = 0; j < 4; ++j) y[k][j] = yp[64 * j]; }
}
__device__ __forceinline__ f32x4 moe_rows_sum(const MoeRef& R, const u32x2 (&y)[4][4], int j) {
    f32x4 s = (f32x4){0.f, 0.f, 0.f, 0.f};
#pragma unroll
    for (int k = 0; k < 4; ++k) { const u32x2 w = y[k][j]; s += R.g[k] * (f32x4){bflo(w.x), bfhi(w.x), bflo(w.y), bfhi(w.y)}; }
    return s;
}

__device__ __forceinline__ void phase_norm1(Frame& F, const Args& A, int layer) {
    REFRESH(F);
    if (layer > 0) moe_tiles(F, layer - 1);
    bf16_t* H = WSP(bf16_t, WS_H); bf16_t* AX = WSP(bf16_t, WS_AX); const float* MOD = WSP(float, WS_MOD);
    const float* g1 = A.in[I_NORMG] + (size_t)(layer * 2 + 0) * D;
    f32x4 gg[4];
#pragma unroll
    for (int j = 0; j < 4; ++j) gg[j] = ((const f32x4*)g1)[64 * j + F.lane];
    for (int it = 0;; ++it) { if (ROWOF(it, 0) >= NT) break;
        f32x4 v[RB][4]; int brow[RB];
        if (layer == 0) {
#pragma unroll
            for (int r = 0; r < RB; ++r) { const int row = ROWOF(it, r); brow[r] = row < NX ? (row >> 11) : 32; const float* src = row < NX ? A.in[I_X] + (size_t)row * D : A.in[I_CTX] + (size_t)(row - NX) * D;
#pragma unroll
                for (int j = 0; j < 4; ++j) v[r][j] = ((const f32x4*)src)[64 * j + F.lane]; }
        } else {
            MoeRef R[RB]; u32x2 y[RB][4][4]; f32x4 gv[RB][4];
#pragma unroll
            for (int r = 0; r < RB; ++r) moe_ref_load(F, ROWOF(it, r), R[r]);
#pragma unroll
            for (int r = 0; r < RB; ++r) { const int row = ROWOF(it, r); brow[r] = row < NX ? (row >> 11) : 32; moe_rows_load(F, R[r], y[r]);
                const float* g2p = MOD + ((size_t)(layer - 1) * 33 + brow[r]) * 6144 + 5 * D;
#pragma unroll
                for (int j = 0; j < 4; ++j) { v[r][j] = ld_bf4(H + (size_t)row * D + 256 * j + 4 * F.lane); gv[r][j] = ((const f32x4*)g2p)[64 * j + F.lane]; } }
#pragma unroll
            for (int r = 0; r < RB; ++r)
#pragma unroll
                for (int j = 0; j < 4; ++j) v[r][j] = v[r][j] + gv[r][j] * moe_rows_sum(R[r], y[r], j);
        }
        float rstd[RB];
#pragma unroll
        for (int r = 0; r < RB; ++r) { const int row = ROWOF(it, r); float ss = 0.f;
#pragma unroll
            for (int j = 0; j < 4; ++j) { st_bf4(H + (size_t)row * D + 256 * j + 4 * F.lane, v[r][j]); ss += (v[r][j].x * v[r][j].x + v[r][j].y * v[r][j].y) + (v[r][j].z * v[r][j].z + v[r][j].w * v[r][j].w); }
            rstd[r] = 1.0f / sqrtf(wave_sum(ss) * (1.0f / D) + 1e-5f); }
#pragma unroll
        for (int r = 0; r < RB; ++r) { const int row = ROWOF(it, r); const float* mp = MOD + ((size_t)layer * 33 + brow[r]) * 6144;
#pragma unroll
            for (int j = 0; j < 4; ++j) { const f32x4 sh = ((const f32x4*)mp)[64 * j + F.lane], sc = ((const f32x4*)(mp + D))[64 * j + F.lane];
                const f32x4 o = v[r][j] * rstd[r] * gg[j] * (sc + 1.0f) + sh;
                if (layer % 3 == 0) ((unsigned*)((unsigned char*)AX + (size_t)row * D))[64 * j + F.lane] = pk4_fp8(o.x, o.y, o.z, o.w);
                else { u32x2 w; w.x = pk2(o.x, o.y); w.y = pk2(o.z, o.w); ((u32x2*)(AX + (size_t)row * D))[64 * j + F.lane] = w; } } }
    }
}
__device__ __forceinline__ void phase_final(Frame& F, const Args& A) {
    REFRESH(F);
    moe_tiles(F, DEPTH - 1);
    const bf16_t* H = WSP(bf16_t, WS_H); const float* MOD = WSP(float, WS_MOD); const float* fg = A.in[I_FG];
    f32x4 gg[4];
#pragma unroll
    for (int j = 0; j < 4; ++j) gg[j] = ((const f32x4*)fg)[64 * j + F.lane];
    for (int it = 0;; ++it) { if (ROWOF(it, 0) >= NX) break;
        MoeRef R[RB]; u32x2 y[RB][4][4]; f32x4 v[RB][4], gv[RB][4];
#pragma unroll
        for (int r = 0; r < RB; ++r) moe_ref_load(F, ROWOF(it, r), R[r]);
#pragma unroll
        for (int r = 0; r < RB; ++r) { const int row = ROWOF(it, r); moe_rows_load(F, R[r], y[r]); const float* g2p = MOD + ((size_t)(DEPTH - 1) * 33 + (row >> 11)) * 6144 + 5 * D;
#pragma unroll
            for (int j = 0; j < 4; ++j) { v[r][j] = ld_bf4(H + (size_t)row * D + 256 * j + 4 * F.lane); gv[r][j] = ((const f32x4*)g2p)[64 * j + F.lane]; } }
#pragma unroll
        for (int r = 0; r < RB; ++r) { const int row = ROWOF(it, r); float ss = 0.f;
#pragma unroll
            for (int j = 0; j < 4; ++j) { v[r][j] = v[r][j] + gv[r][j] * moe_rows_sum(R[r], y[r], j); ss += (v[r][j].x * v[r][j].x + v[r][j].y * v[r][j].y) + (v[r][j].z * v[r][j].z + v[r][j].w * v[r][j].w); }
            const float rstd = 1.0f / sqrtf(wave_sum(ss) * (1.0f / D) + 1e-5f);
#pragma unroll
            for (int j = 0; j < 4; ++j) ((f32x4*)(A.out + (size_t)row * D))[64 * j + F.lane] = v[r][j] * rstd * gg[j]; }
    }
}

__device__ __forceinline__ void phase_route(Frame& F, const Args& A, int layer) {
    REFRESH(F);
    const int nrows = (layer == DEPTH - 1) ? NX : NT;
    LAS float* wT = (LAS float*)F.lds;
    LAS int* lcnt = (LAS int*)(F.lds + LCNT_OFF); LAS int* lbase = (LAS int*)(F.lds + LBASE_OFF);
    LAS unsigned* recp = (LAS unsigned*)(F.lds + REC_OFF); LAS float* recg = (LAS float*)(F.lds + REC_OFF + 4608);
    __syncthreads();
    { const float* wr = A.in[I_MWR] + (size_t)layer * D * NE;
      for (int idx = F.tid; idx < D * NE; idx += NTHREADS) wT[(idx & 31) * 1024 + (idx >> 5)] = wr[idx]; }
    if (F.tid < NE) lcnt[F.tid] = 0;
    __syncthreads();
    const bf16_t* H = WSP(bf16_t, WS_H); unsigned char* FX = WSP(unsigned char, WS_FX); const float* MOD = WSP(float, WS_MOD);
    const float* g2 = A.in[I_NORMG] + (size_t)(layer * 2 + 1) * D; const float* br = A.in[I_MBR] + layer * NE;
    f32x4 gg[4];
#pragma unroll
    for (int j = 0; j < 4; ++j) gg[j] = ((const f32x4*)g2)[64 * j + F.lane];
    const int myE = F.lane >> 1; const float myb = br[myE];
    int nit = 0;
    for (int it = 0;; ++it) { if (ROWOF(it, 0) - F.wave * RB >= nrows) break; nit = it + 1;
        if (ROWOF(it, 0) >= nrows) continue;
        f32x4 v[RB][4]; float rstd[RB];
#pragma unroll
        for (int r = 0; r < RB; ++r) { const int row = ROWOF(it, r);
#pragma unroll
            for (int j = 0; j < 4; ++j) v[r][j] = ld_bf4(H + (size_t)row * D + 256 * j + 4 * F.lane); }
#pragma unroll
        for (int r = 0; r < RB; ++r) { float ss = 0.f;
#pragma unroll
            for (int j = 0; j < 4; ++j) ss += (v[r][j].x * v[r][j].x + v[r][j].y * v[r][j].y) + (v[r][j].z * v[r][j].z + v[r][j].w * v[r][j].w);
            rstd[r] = 1.0f / sqrtf(wave_sum(ss) * (1.0f / D) + 1e-5f); }
#pragma unroll
        for (int r = 0; r < RB; ++r) { const int row = ROWOF(it, r); const int brow = row < NX ? (row >> 11) : 32;
            const float* mp = MOD + ((size_t)layer * 33 + brow) * 6144 + 3 * D;
#pragma unroll
            for (int j = 0; j < 4; ++j) { const f32x4 sh = ((const f32x4*)mp)[64 * j + F.lane], sc = ((const f32x4*)(mp + D))[64 * j + F.lane];
                v[r][j] = v[r][j] * rstd[r] * gg[j] * (sc + 1.0f) + sh;
                ((unsigned*)(FX + (size_t)row * D))[64 * j + F.lane] = pk4_fp8(v[r][j].x, v[r][j].y, v[r][j].z, v[r][j].w); } }
        float part[RB][NE];
#pragma unroll
        for (int e = 0; e < NE; ++e) { float p0 = 0.f, p1 = 0.f;
#pragma unroll
            for (int j = 0; j < 4; ++j) { const f32x4 w4 = ((const LAS f32x4*)(wT + e * 1024))[64 * j + F.lane];
                p0 += (v[0][j].x * w4.x + v[0][j].y * w4.y) + (v[0][j].z * w4.z + v[0][j].w * w4.w); p1 += (v[1][j].x * w4.x + v[1][j].y * w4.y) + (v[1][j].z * w4.z + v[1][j].w * w4.w); }
            part[0][e] = p0; part[1][e] = p1; }
#pragma unroll
        for (int r = 0; r < RB; ++r) {
#pragma unroll
            for (int k = 0; k < 16; ++k) { const bool up = (F.lane & 32) != 0; const float keep = up ? part[r][k + 16] : part[r][k], send = up ? part[r][k] : part[r][k + 16]; part[r][k] = keep + __shfl_xor(send, 32); }
#pragma unroll
            for (int k = 0; k < 8; ++k) { const bool up = (F.lane & 16) != 0; const float keep = up ? part[r][k + 8] : part[r][k], send = up ? part[r][k] : part[r][k + 8]; part[r][k] = keep + __shfl_xor(send, 16); }
#pragma unroll
            for (int k = 0; k < 4; ++k) { const bool up = (F.lane & 8) != 0; const float keep = up ? part[r][k + 4] : part[r][k], send = up ? part[r][k] : part[r][k + 4]; part[r][k] = keep + __shfl_xor(send, 8); }
#pragma unroll
            for (int k = 0; k < 2; ++k) { const bool up = (F.lane & 4) != 0; const float keep = up ? part[r][k + 2] : part[r][k], send = up ? part[r][k] : part[r][k + 2]; part[r][k] = keep + __shfl_xor(send, 4); }
            { const bool up = (F.lane & 2) != 0; const float keep = up ? part[r][1] : part[r][0], send = up ? part[r][0] : part[r][1]; part[r][0] = keep + __shfl_xor(send, 2); }
            part[r][0] += __shfl_xor(part[r][0], 1);
        }
#pragma unroll
        for (int r = 0; r < RB; ++r) {
            const float val = part[r][0] + myb;
            int rank = 0;
#pragma unroll
            for (int e = 0; e < NE; ++e) { const float ve = __builtin_bit_cast(float, __builtin_amdgcn_readlane(__builtin_bit_cast(int, val), 2 * e)); rank += (ve > val || (ve == val && e < myE)) ? 1 : 0; }
            float sv[4]; int si[4];
#pragma unroll
            for (int k = 0; k < 4; ++k) { const unsigned long long m = __ballot(rank == k && (F.lane & 1) == 0); const int src = __builtin_ctzll(m);
                si[k] = src >> 1; sv[k] = __builtin_bit_cast(float, __builtin_amdgcn_readlane(__builtin_bit_cast(int, val), src)); }
            const float e1 = __expf(sv[1] - sv[0]), e2 = __expf(sv[2] - sv[0]), e3 = __expf(sv[3] - sv[0]); const float inv = 1.0f / (1.0f + e1 + e2 + e3);
            if (F.lane < 4) { const int e = F.lane == 0 ? si[0] : F.lane == 1 ? si[1] : F.lane == 2 ? si[2] : si[3]; const float g = (F.lane == 0 ? 1.0f : F.lane == 1 ? e1 : F.lane == 2 ? e2 : e3) * inv;
                const int rank2 = __hip_atomic_fetch_add(lcnt + e, 1, __ATOMIC_RELAXED, __HIP_MEMORY_SCOPE_WORKGROUP);
                const int ri = ((it * NWAVES + F.wave) * RB + r) * 4 + F.lane; recp[ri] = ((unsigned)e << 20) | (unsigned)rank2; recg[ri] = g; }
        }
    }
    __syncthreads();
    if (F.tid < NE) lbase[F.tid] = (int)__hip_atomic_fetch_add(F.ctl + CW_GCNT + layer * 64 + F.tid, (unsigned)lcnt[F.tid], __ATOMIC_RELAXED, __HIP_MEMORY_SCOPE_AGENT);
    __syncthreads();
    int* LIST = WSP(int, WS_LIST); int* POS = WSP(int, WS_POS); float* GATE = WSP(float, WS_GATE);
    for (int r = F.tid; r < nit * NWAVES * RB * 4; r += NTHREADS) { const int lr = r >> 2, k = r & 3; const int row = ((lr >> 4) * F.G + F.c) * (NWAVES * RB) + (lr & 15); if (row >= nrows) continue;
        const unsigned qx = recp[r]; const float qg = recg[r]; const int e = qx >> 20, slot = lbase[e] + (int)(qx & 0xfffff);
        LIST[(size_t)e * NT + slot] = row; POS[(size_t)row * 4 + k] = (e << 20) | slot; GATE[(size_t)row * 4 + k] = qg; }
    __syncthreads();
}

__device__ __forceinline__ void phase_pooldiff(Frame& F) {
    REFRESH(F);
    const bf16_t* AX = WSP(bf16_t, WS_AX); bf16_t* PD = WSP(bf16_t, WS_PD);
    for (int it = 0;; ++it) { if (ROWOF(it, 0) >= NT) break;
        const int row0 = ROWOF(it, 0); int sb, t, n; seq_of(row0, sb, t, n);
#pragma unroll
        for (int j = 0; j < 4; ++j) { const int half = 1 << j; const int col = 256 * j + 4 * F.lane;
            f32x4 s0 = (f32x4){0.f, 0.f, 0.f, 0.f}, s1 = s0, me0 = s0, me1 = s0;
#pragma unroll
            for (int q = 0; q < 2 * half + 1; ++q) { const int uu = t - half + q;
                if (uu >= 0 && uu < n) { const f32x4 x = ld_bf4(AX + (size_t)(sb + uu) * D + col); if (q < 2 * half) s0 += x; if (q > 0) s1 += x; if (q == half) me0 = x; if (q == half + 1) me1 = x; } }
            const int lo0 = t - half < 0 ? 0 : t - half, hi0 = t + half > n ? n : t + half, lo1 = t + 1 - half < 0 ? 0 : t + 1 - half, hi1 = t + 1 + half > n ? n : t + 1 + half;
            st_bf4(PD + (size_t)row0 * D + col, s0 * (1.0f / (float)(hi0 - lo0)) - me0);
            st_bf4(PD + (size_t)(row0 + 1) * D + col, s1 * (1.0f / (float)(hi1 - lo1)) - me1); }
    }
}
__device__ __forceinline__ void phase_rwkv_mix(Frame& F, const Args& A) {
    REFRESH(F);
    const bf16_t* AX = WSP(bf16_t, WS_AX); bf16_t* A6 = WSP(bf16_t, WS_A6); const float* mix = A.in[I_RMIX];
    for (int it = 0;; ++it) { if (ROWOF(it, 0) >= NT) break;
        const int row0 = ROWOF(it, 0); int sb, t, n; seq_of(row0, sb, t, n);
#pragma unroll
        for (int j = 0; j < 4; ++j) { const int col = 256 * j + 4 * F.lane; const f32x4 z = (f32x4){0.f, 0.f, 0.f, 0.f};
            const f32x4 h0 = ld_bf4(AX + (size_t)row0 * D + col), h1 = ld_bf4(AX + (size_t)(row0 + 1) * D + col);
            const f32x4 hp = t > 0 ? ld_bf4(AX + (size_t)(row0 - 1) * D + col) : z, hn = t + 1 < n - 1 ? ld_bf4(AX + (size_t)(row0 + 2) * D + col) : z;
            const f32x4 xx0 = (hp + h1) * 0.5f - h0, xx1 = (h0 + hn) * 0.5f - h1;
#pragma unroll
            for (int i = 0; i < 6; ++i) { const f32x4 m = *(const f32x4*)(mix + i * D + col); const f32x4 o0 = h0 + xx0 * m, o1 = h1 + xx1 * m;
                if (i == 0 || i == 2 || i == 3) { unsigned char* p8 = (unsigned char*)(A6 + (size_t)i * NT * D);
                    *(unsigned*)(p8 + (size_t)row0 * D + col) = pk4_fp8(o0.x, o0.y, o0.z, o0.w); *(unsigned*)(p8 + (size_t)(row0 + 1) * D + col) = pk4_fp8(o1.x, o1.y, o1.z, o1.w); }
                else { st_bf4(A6 + ((size_t)i * NT + row0) * D + col, o0); st_bf4(A6 + ((size_t)i * NT + row0 + 1) * D + col, o1); } } }
    }
}
__device__ __forceinline__ float rl(float x, int k) { return __builtin_bit_cast(float, __builtin_amdgcn_readlane(__builtin_bit_cast(int, x), k)); }
typedef float f32x16 __attribute__((ext_vector_type(16)));
constexpr int SCW = 33792;
__device__ __forceinline__ int kpos(int k) { return (k & ~12) | ((k & 4) << 1) | ((k & 8) >> 1); }
__device__ __forceinline__ bf16x8 acc_frag(const f32x16& X, int s2) {
    u32x4 w; w.x = cvt_pk_bf16(X[8 * s2 + 0], X[8 * s2 + 1]); w.y = cvt_pk_bf16(X[8 * s2 + 2], X[8 * s2 + 3]); w.z = cvt_pk_bf16(X[8 * s2 + 4], X[8 * s2 + 5]); w.w = cvt_pk_bf16(X[8 * s2 + 6], X[8 * s2 + 7]);
    return __builtin_bit_cast(bf16x8, w);
}
#define MFMA32(a, b, c) __builtin_amdgcn_mfma_f32_32x32x16_bf16(a, b, c, 0, 0, 0)
__device__ __forceinline__ void phase_rwkv_scan(Frame& F, const Args& A) {
    REFRESH(F);
    __syncthreads();
    const int pr = F.wave >> 1, hw = F.wave & 1;
    for (int item = pr * F.G + F.c; item < 1024; item += 4 * F.G) {
        const int dir = item >> 9, b = (item >> 4) & 31, hd = item & 15, col = 64 * hd + F.lane;
        const int l = F.lane, r32 = l & 31, hh = l >> 5;
        const bf16_t* Rr = WSP(bf16_t, WS_RKV); const bf16_t* Kk = Rr + (size_t)NT * D; const bf16_t* Vv = Kk + (size_t)NT * D;
        const bf16_t* Ee = WSP(bf16_t, WS_E) + (size_t)dir * NT * D; const bf16_t* Aa = WSP(bf16_t, WS_A) + (size_t)dir * NT * D;
        float* Yo = WSP(float, WS_YS) + (size_t)dir * NT * D; float* Bo = WSP(float, WS_BONUS) + (size_t)dir * NT * 16;
        const float kkw = A.in[I_RKK][col], kaw = A.in[I_RKA][col], rkw = A.in[I_RRK][col];
        LAS unsigned char* RA = F.lds + pr * SCW; LAS unsigned char* RB = RA + 16384; LAS unsigned char* RV = RA + 25600;
        LAS float* cCb = (LAS float*)(F.lds + REC_OFF + pr * 256);
        LAS bf16_t* XT = (LAS bf16_t*)RA;
        LAS bf16_t* BK = (LAS bf16_t*)(RA + 8192);
        const int kp = kpos(l), vb = hw;
        f32x16 ST[2];
#pragma unroll
        for (int i = 0; i < 2; ++i)
#pragma unroll
            for (int q = 0; q < 16; ++q) ST[i][q] = 0.f;
        for (int seg = 0; seg < 2; ++seg) {
            const int base = seg ? b * T : NX + b * L, n = seg ? T : L; const int dt = dir ? -1 : 1; const int t0 = dir ? n - 1 : 0;
            for (int bt = 0; bt < n; bt += 32) {
                float cprev = 1.0f;
                if (hw) {
                    bf16_t e16[16];
#pragma unroll
                    for (int s = 0; s < 16; ++s) e16[s] = Ee[(size_t)(base + t0 + dt * (bt + s)) * D + col];
                    float es = 0.f;
#pragma unroll
                    for (int s = 0; s < 16; ++s) es += bf1(e16[s]);
                    cprev = __expf(-es); }
#pragma unroll
                for (int g4i = 0; g4i < 4; ++g4i) { const int g8 = 4 * hw + g4i;
                    bf16_t raw[4][5];
#pragma unroll
                    for (int s8 = 0; s8 < 4; ++s8) { const size_t o = (size_t)(base + t0 + dt * (bt + g8 * 4 + s8)) * D + col; raw[s8][0] = Rr[o]; raw[s8][1] = Kk[o]; raw[s8][2] = Vv[o]; raw[s8][3] = Aa[o]; raw[s8][4] = Ee[o]; }
                    float rr[4], kraw[4], aa[4], kk[4], kd[4], n2[4], bn[4], ww[4]; unsigned bq2[2] = {0u, 0u}, kq2[2] = {0u, 0u};
#pragma unroll
                    for (int s8 = 0; s8 < 4; ++s8) { rr[s8] = bf1(raw[s8][0]); kraw[s8] = bf1(raw[s8][1]); aa[s8] = bf1(raw[s8][3]); ww[s8] = __expf(-bf1(raw[s8][4]));
                        kk[s8] = kraw[s8] * kkw; n2[s8] = kk[s8] * kk[s8]; kd[s8] = kraw[s8] * (1.0f + (aa[s8] - 1.0f) * kaw); bn[s8] = rr[s8] * kd[s8] * rkw; }
#pragma unroll
                    for (int s8 = 0; s8 < 4; ++s8) { n2[s8] = wave_sum(n2[s8]); bn[s8] = wave_sum(bn[s8]); }
#pragma unroll
                    for (int s8 = 0; s8 < 4; ++s8) { const int t = g8 * 4 + s8;
                        if (l == 0) Bo[(size_t)(base + t0 + dt * (bt + t)) * 16 + hd] = bn[s8];
                        const float kn = kk[s8] * __builtin_amdgcn_rsqf(fmaxf(n2[s8], 1e-24f)); const float c = cprev * ww[s8]; const float ic = __builtin_amdgcn_rcpf(c);
                        const float at = -kn * cprev, rt = rr[s8] * c, bq = kn * aa[s8] * ic, kq = kd[s8] * ic;
                        const unsigned w0 = cvt_pk_bf16(at, rt), w1 = cvt_pk_bf16(bq, kq);
                        XT[t * 64 + kp] = (bf16_t)(w0 & 0xffffu); XT[(32 + t) * 64 + kp] = (bf16_t)(w0 >> 16);
                        BK[t * 64 + kp] = (bf16_t)(w1 & 0xffffu); BK[(32 + t) * 64 + kp] = (bf16_t)(w1 >> 16);
                        if (s8 & 1) { bq2[s8 >> 1] |= (w1 & 0xffffu) << 16; kq2[s8 >> 1] |= (w1 & 0xffff0000u); } else { bq2[s8 >> 1] = w1 & 0xffffu; kq2[s8 >> 1] = w1 >> 16; }
                        cprev = c; }
                    const int gp = (g8 & ~3) | ((g8 & 1) << 1) | ((g8 & 2) >> 1);
                    *(LAS u32x2*)(RB + l * 144 + gp * 8) = (u32x2){bq2[0], bq2[1]}; *(LAS u32x2*)(RB + l * 144 + 64 + gp * 8) = (u32x2){kq2[0], kq2[1]};
                    *(LAS u32x2*)(RV + l * 80 + gp * 8) = (u32x2){(unsigned)raw[0][2] | ((unsigned)raw[1][2] << 16), (unsigned)raw[2][2] | ((unsigned)raw[3][2] << 16)};
                }
                if (hw) cCb[l] = cprev;
                __syncthreads();
                f32x16 Mp, Np, X;
                { bf16x8 XTf[4], BKf[2][4];
#pragma unroll
                  for (int s4 = 0; s4 < 4; ++s4) { XTf[s4] = *(const LAS bf16x8*)(XT + r32 * 64 + 16 * s4 + 8 * hh); BKf[0][s4] = *(const LAS bf16x8*)(BK + r32 * 64 + 16 * s4 + 8 * hh); BKf[1][s4] = *(const LAS bf16x8*)(BK + (32 + r32) * 64 + 16 * s4 + 8 * hh); }
                  bf16x8 MkaF[2];
                  { f32x16 Tm;
#pragma unroll
                    for (int q = 0; q < 16; ++q) Tm[q] = 0.f;
#pragma unroll
                    for (int s4 = 0; s4 < 4; ++s4) Tm = MFMA32(BKf[1][s4], XTf[s4], Tm);
#pragma unroll
                    for (int q = 0; q < 16; ++q) { const int row = (q & 3) + 8 * (q >> 2) + 4 * hh; Tm[q] = row < r32 ? Tm[q] : 0.f; }
                    MkaF[0] = acc_frag(Tm, 0); MkaF[1] = acc_frag(Tm, 1); }
#pragma unroll
                  for (int q = 0; q < 16; ++q) { Mp[q] = 0.f; Np[q] = 0.f; X[q] = 0.f; }
#pragma unroll
                  for (int s4 = 0; s4 < 4; ++s4) { Mp = MFMA32(BKf[0][s4], XTf[s4], Mp); Np = MFMA32(XTf[s4], BKf[0][s4], Np); }
#pragma unroll
                  for (int q = 0; q < 16; ++q) { const int row = (q & 3) + 8 * (q >> 2) + 4 * hh; Mp[q] = row < r32 ? Mp[q] : 0.f; Np[q] = r32 < row ? Np[q] : 0.f; }
#pragma unroll
                  for (int kb = 0; kb < 2; ++kb)
#pragma unroll
                      for (int s2 = 0; s2 < 2; ++s2) X = MFMA32(XTf[2 * kb + s2], acc_frag(ST[kb], s2), X);
#pragma unroll
                  for (int s2 = 0; s2 < 2; ++s2) { const bf16x8 Vf = *(const LAS bf16x8*)(RV + (32 * vb + r32) * 80 + (16 * s2 + 8 * hh) * 2); X = MFMA32(MkaF[s2], Vf, X); } }
                __builtin_amdgcn_sched_barrier(0);
#pragma unroll
                for (int lvl = 0; lvl < 5; ++lvl) {
                    bf16x8 Ma[2], Na[2];
#pragma unroll
                    for (int s2 = 0; s2 < 2; ++s2) { Ma[s2] = acc_frag(Mp, s2); Na[s2] = acc_frag(Np, s2); }
                    { const bf16x8 x0 = acc_frag(X, 0), x1 = acc_frag(X, 1); X = MFMA32(Ma[0], x0, X); X = MFMA32(Ma[1], x1, X); }
                    if (lvl < 4) { f32x16 M2, N2;
#pragma unroll
                        for (int q = 0; q < 16; ++q) { M2[q] = 0.f; N2[q] = 0.f; }
                        M2 = MFMA32(Na[0], Ma[0], M2); M2 = MFMA32(Na[1], Ma[1], M2);
                        N2 = MFMA32(Ma[0], Na[0], N2); N2 = MFMA32(Ma[1], Na[1], N2);
                        Mp = M2; Np = N2; }
                }
                __builtin_amdgcn_sched_barrier(0);
                { bf16x8 XRf[4], MbrF[2], MkrF[2];
#pragma unroll
                  for (int s4 = 0; s4 < 4; ++s4) XRf[s4] = *(const LAS bf16x8*)(XT + (32 + r32) * 64 + 16 * s4 + 8 * hh);
                  { f32x16 Tm, Tn;
#pragma unroll
                    for (int q = 0; q < 16; ++q) { Tm[q] = 0.f; Tn[q] = 0.f; }
#pragma unroll
                    for (int s4 = 0; s4 < 4; ++s4) { const bf16x8 Bb = *(const LAS bf16x8*)(BK + r32 * 64 + 16 * s4 + 8 * hh), Bk = *(const LAS bf16x8*)(BK + (32 + r32) * 64 + 16 * s4 + 8 * hh);
                        Tm = MFMA32(Bb, XRf[s4], Tm); Tn = MFMA32(Bk, XRf[s4], Tn); }
#pragma unroll
                    for (int q = 0; q < 16; ++q) { const int row = (q & 3) + 8 * (q >> 2) + 4 * hh; Tm[q] = row <= r32 ? Tm[q] : 0.f; Tn[q] = row <= r32 ? Tn[q] : 0.f; }
                    MbrF[0] = acc_frag(Tm, 0); MbrF[1] = acc_frag(Tm, 1); MkrF[0] = acc_frag(Tn, 0); MkrF[1] = acc_frag(Tn, 1); }
                  { const bf16x8 u0 = acc_frag(X, 0), u1 = acc_frag(X, 1);
                    const bf16x8 Vf0 = *(const LAS bf16x8*)(RV + (32 * vb + r32) * 80 + (8 * hh) * 2), Vf1 = *(const LAS bf16x8*)(RV + (32 * vb + r32) * 80 + (16 + 8 * hh) * 2);
                    f32x16 Yt;
#pragma unroll
                    for (int q = 0; q < 16; ++q) Yt[q] = 0.f;
#pragma unroll
                    for (int kb = 0; kb < 2; ++kb)
#pragma unroll
                        for (int s2 = 0; s2 < 2; ++s2) Yt = MFMA32(XRf[2 * kb + s2], acc_frag(ST[kb], s2), Yt);
                    Yt = MFMA32(MkrF[0], Vf0, Yt); Yt = MFMA32(MkrF[1], Vf1, Yt);
                    Yt = MFMA32(MbrF[0], u0, Yt); Yt = MFMA32(MbrF[1], u1, Yt);
#pragma unroll
                    for (int q = 0; q < 16; ++q) { const int t = (q & 3) + 8 * (q >> 2) + 4 * hh; Yo[(size_t)(base + t0 + dt * (bt + t)) * D + 64 * hd + 32 * vb + r32] = Yt[q]; }
#pragma unroll
                    for (int kb = 0; kb < 2; ++kb) {
                        const bf16x8 b0 = *(const LAS bf16x8*)(RB + (32 * kb + r32) * 144 + (8 * hh) * 2), b1 = *(const LAS bf16x8*)(RB + (32 * kb + r32) * 144 + (16 + 8 * hh) * 2);
                        const bf16x8 k0 = *(const LAS bf16x8*)(RB + (32 * kb + r32) * 144 + 64 + (8 * hh) * 2), k1 = *(const LAS bf16x8*)(RB + (32 * kb + r32) * 144 + 64 + (16 + 8 * hh) * 2);
                        ST[kb] = MFMA32(b0, u0, ST[kb]); ST[kb] = MFMA32(b1, u1, ST[kb]);
                        ST[kb] = MFMA32(k0, Vf0, ST[kb]); ST[kb] = MFMA32(k1, Vf1, ST[kb]); }
                  } }
                __builtin_amdgcn_sched_barrier(0);
#pragma unroll
                for (int kb = 0; kb < 2; ++kb)
#pragma unroll
                    for (int g4 = 0; g4 < 4; ++g4) { const f32x4 cc = *(const LAS f32x4*)(cCb + 32 * kb + 8 * g4 + 4 * hh);
                        ST[kb][4 * g4 + 0] *= cc.x; ST[kb][4 * g4 + 1] *= cc.y; ST[kb][4 * g4 + 2] *= cc.z; ST[kb][4 * g4 + 3] *= cc.w; }
                __syncthreads();
            }
        }
    }
    __syncthreads();
}
#undef MFMA32
__device__ __forceinline__ void phase_rwkv_out(Frame& F, const Args& A, int nrows) {
    REFRESH(F);
    const float* Y0 = WSP(float, WS_YS); const float* Y1 = Y0 + (size_t)NT * D; const float* B0 = WSP(float, WS_BONUS); const float* B1 = B0 + (size_t)NT * 16;
    const bf16_t* Vv = WSP(bf16_t, WS_RKV) + (size_t)2 * NT * D; const bf16_t* Gg = WSP(bf16_t, WS_G); bf16_t* RO = WSP(bf16_t, WS_RO);
    const float* lnw = A.in[I_RLNW]; const float* lnb = A.in[I_RLNB];
    for (int it = 0;; ++it) { if (ROWOF(it, 0) >= nrows) break;
        f32x4 y[RB][4], vv[RB][4], gg[RB][4]; float bon[RB][4];
#pragma unroll
        for (int r = 0; r < RB; ++r) { const int row = ROWOF(it, r);
#pragma unroll
            for (int j = 0; j < 4; ++j) { const int col = 256 * j + 4 * F.lane, head = 4 * j + (F.lane >> 4); const size_t o = (size_t)row * D + col;
                y[r][j] = *(const f32x4*)(Y0 + o) + *(const f32x4*)(Y1 + o); vv[r][j] = ld_bf4(Vv + o); gg[r][j] = ld_bf4(Gg + o); bon[r][j] = B0[(size_t)row * 16 + head] + B1[(size_t)row * 16 + head]; } }
#pragma unroll
        for (int r = 0; r < RB; ++r) { const int row = ROWOF(it, r);
#pragma unroll
            for (int j = 0; j < 4; ++j) { const int col = 256 * j + 4 * F.lane; const size_t o = (size_t)row * D + col; const f32x4 yy = y[r][j];
                const float s = row16_sum((yy.x + yy.y) + (yy.z + yy.w));
                const f32x4 d = yy - s * (1.0f / 64.0f);
                const float q = row16_sum((d.x * d.x + d.y * d.y) + (d.z * d.z + d.w * d.w));
                const float rs = 1.0f / sqrtf(q * (1.0f / 64.0f) + 64e-5f);
                const f32x4 yn = d * rs * *(const f32x4*)(lnw + col) + *(const f32x4*)(lnb + col);
                { const f32x4 ov = (yn + vv[r][j] * bon[r][j]) * gg[r][j]; *(unsigned*)((unsigned char*)RO + o) = pk4_fp8(ov.x, ov.y, ov.z, ov.w); } } }
    }
}

__device__ __forceinline__ void phase_attn(Frame& F, const Args& A, int j, bool need_ctx) {
    REFRESH(F);
    const bf16_t* Q = WSP(bf16_t, WS_Q); const bf16_t* Kb = WSP(bf16_t, WS_K); const bf16_t* VT = WSP(bf16_t, WS_VT); bf16_t* O = WSP(bf16_t, WS_O);
    const float* sinks = A.in[I_ASINK] + j * 16;
    LAS bf16_t* Ks = (LAS bf16_t*)F.lds; LAS bf16_t* Vs = (LAS bf16_t*)(F.lds + 9216);
    LAS bf16x8* Qs = (LAS bf16x8*)(F.lds + 18432 + F.wave * 8192) + F.lane;
    const int nunits = 2048 + (need_ctx ? 256 : 0);
    const int fr = F.lane & 15, fq = F.lane >> 4, g = F.wave >> 1, hf = F.wave & 1;
    const float SC = 0.125f * 1.4426950408889634f;
    const int lr = F.tid >> 3, lch = F.tid & 7;
    __syncthreads();
    for (int u = F.c; u < nunits; u += F.G) {
        int b, kvh, qb; bool isx;
        if (u < 2048) { isx = true; b = u >> 6; kvh = (u >> 4) & 3; qb = u & 15; } else { const int v = u - 2048; isx = false; b = v >> 3; kvh = (v >> 1) & 3; qb = v & 1; }
        const int qrow0 = (isx ? b * T : NX + b * L) + qb * 128 + hf * 64; const int head = 4 * kvh + g;
        int jlo = 0, jhi = -1;
        if (isx) { jlo = qb == 0 ? 2 : 0; jhi = qb == 15 ? 3 : 5; }
        const int ntiles = 4 + (jhi - jlo + 1);
        auto tile_row0 = [&](int ti) -> int { return ti < 4 ? NX + b * L + ti * 64 : b * T + qb * 128 - 128 + 64 * (jlo + ti - 4); };
        u32x4 kv_n, vv_n;
        { const int kr0 = tile_row0(0); kv_n = *(const u32x4*)(Kb + (size_t)(kr0 + lr) * 256 + kvh * 64 + lch * 8); vv_n = *(const u32x4*)(VT + (size_t)(kvh * 64 + lr) * NT + kr0 + lch * 8); }
#pragma unroll
        for (int mq = 0; mq < 4; ++mq)
#pragma unroll
            for (int ks = 0; ks < 2; ++ks) Qs[64 * (mq * 2 + ks)] = *(const bf16x8*)(Q + (size_t)(qrow0 + 16 * mq + fr) * D + head * 64 + ks * 32 + 8 * fq);
        const float sink2 = sinks[head] * 1.4426950408889634f;
        float mrun[4], lrun[4]; f32x4 Oa[4][4];
#pragma unroll
        for (int mq = 0; mq < 4; ++mq) { mrun[mq] = sink2; lrun[mq] = fq == 0 ? 1.0f : 0.0f;
#pragma unroll
            for (int db = 0; db < 4; ++db) Oa[mq][db] = (f32x4){0.f, 0.f, 0.f, 0.f}; }
        for (int ti = 0; ti < ntiles; ++ti) {
            const int jl = ti < 4 ? -1 : jlo + ti - 4; const int ks0 = qb * 128 - 128 + 64 * jl;
            __syncthreads();
            *(LAS u32x4*)(Ks + lr * 72 + lch * 8) = kv_n; *(LAS u32x4*)(Vs + lr * 72 + lch * 8) = vv_n;
            __syncthreads();
            if (ti + 1 < ntiles) { const int kr0 = tile_row0(ti + 1); kv_n = *(const u32x4*)(Kb + (size_t)(kr0 + lr) * 256 + kvh * 64 + lch * 8); vv_n = *(const u32x4*)(VT + (size_t)(kvh * 64 + lr) * NT + kr0 + lch * 8); }
            const bool need = (jl < 0) || (jl >= hf && jl <= hf + 4);
            if (need) {
                const bool domask = (jl >= 0) && (jl == hf || jl == hf + 4);
                f32x4 Sa[4][4];
#pragma unroll
                for (int mq = 0; mq < 4; ++mq)
#pragma unroll
                    for (int n = 0; n < 4; ++n) Sa[mq][n] = (f32x4){0.f, 0.f, 0.f, 0.f};
#pragma unroll
                for (int ks = 0; ks < 2; ++ks) {
                    bf16x8 Qf[4];
#pragma unroll
                    for (int mq = 0; mq < 4; ++mq) Qf[mq] = Qs[64 * (mq * 2 + ks)];
#pragma unroll
                    for (int n = 0; n < 4; ++n) { const int kr = 32 * (n >> 1) + 8 * (fr >> 2) + 4 * (n & 1) + (fr & 3);
                        const bf16x8 Kf = *(const LAS bf16x8*)(Ks + kr * 72 + ks * 32 + 8 * fq);
#pragma unroll
                        for (int mq = 0; mq < 4; ++mq) Sa[mq][n] = __builtin_amdgcn_mfma_f32_16x16x32_bf16(Kf, Qf[mq], Sa[mq][n], 0, 0, 0); } }
                bf16x8 Pf[4][2];
#pragma unroll
                for (int mq = 0; mq < 4; ++mq) {
                    float mx = -1e30f;
                    if (domask) { const int tq = qb * 128 + hf * 64 + 16 * mq + fr;
#pragma unroll
                        for (int n = 0; n < 4; ++n)
#pragma unroll
                            for (int i = 0; i < 4; ++i) { float sv = Sa[mq][n][i] * SC; const int rel = ks0 + 32 * (n >> 1) + 8 * fq + 4 * (n & 1) + i - tq; if (rel > 128 || rel < -128) sv = -1e30f; Sa[mq][n][i] = sv; mx = fmaxf(mx, sv); } }
                    else {
#pragma unroll
                        for (int n = 0; n < 4; ++n)
#pragma unroll
                            for (int i = 0; i < 4; ++i) { const float sv = Sa[mq][n][i] * SC; Sa[mq][n][i] = sv; mx = fmaxf(mx, sv); } }
                    mx = fmaxf(mx, __shfl_xor(mx, 16)); mx = fmaxf(mx, __shfl_xor(mx, 32));
                    const float mnew = fmaxf(mrun[mq], mx); const float alpha = __builtin_amdgcn_exp2f(mrun[mq] - mnew); mrun[mq] = mnew;
                    float rs = 0.f;
#pragma unroll
                    for (int n = 0; n < 4; ++n)
#pragma unroll
                        for (int i = 0; i < 4; ++i) { const float p = __builtin_amdgcn_exp2f(Sa[mq][n][i] - mnew); Sa[mq][n][i] = p; rs += p; }
                    lrun[mq] = lrun[mq] * alpha + rs;
#pragma unroll
                    for (int db = 0; db < 4; ++db) Oa[mq][db] *= alpha;
#pragma unroll
                    for (int s2 = 0; s2 < 2; ++s2) { u32x4 w; w.x = cvt_pk_bf16(Sa[mq][2 * s2][0], Sa[mq][2 * s2][1]); w.y = cvt_pk_bf16(Sa[mq][2 * s2][2], Sa[mq][2 * s2][3]);
                        w.z = cvt_pk_bf16(Sa[mq][2 * s2 + 1][0], Sa[mq][2 * s2 + 1][1]); w.w = cvt_pk_bf16(Sa[mq][2 * s2 + 1][2], Sa[mq][2 * s2 + 1][3]); Pf[mq][s2] = __builtin_bit_cast(bf16x8, w); }
                }
#pragma unroll
                for (int db = 0; db < 4; ++db)
#pragma unroll
                    for (int s2 = 0; s2 < 2; ++s2) { const bf16x8 Vf = *(const LAS bf16x8*)(Vs + (16 * db + fr) * 72 + 32 * s2 + 8 * fq);
#pragma unroll
                        for (int mq = 0; mq < 4; ++mq) Oa[mq][db] = __builtin_amdgcn_mfma_f32_16x16x32_bf16(Vf, Pf[mq][s2], Oa[mq][db], 0, 0, 0); }
            }
        }
#pragma unroll
        for (int mq = 0; mq < 4; ++mq) { float l = lrun[mq]; l += __shfl_xor(l, 16); l += __shfl_xor(l, 32); const float inv = 1.0f / l;
            unsigned char* op = (unsigned char*)O + (size_t)(qrow0 + 16 * mq + fr) * D + head * 64 + 4 * fq;
#pragma unroll
            for (int db = 0; db < 4; ++db) { const f32x4 o = Oa[mq][db] * inv; *(unsigned*)(op + 16 * db) = pk4_fp8(o.x, o.y, o.z, o.w); } }
    }
    __syncthreads();
}

struct KState { XcdBarrier bar; int ph; };
#define RUN() (A.one || A.phase == KS.ph)
#define SEAM() do { if (A.one) xcd_barrier(KS.bar); ++KS.ph; } while (0)
template <int LAYER>
__device__ __forceinline__ void layer_body(Frame& F, const Args& A, KState& KS) {
    constexpr int layer = LAYER, kind = LAYER % 3, j = LAYER / 3; constexpr bool last = (LAYER == DEPTH - 1);
    LAS unsigned char* ring = F.lds;
    const LAS int* tpre = (const LAS int*)(F.lds + TPRE_OFF); const LAS int* lcnt = (const LAS int*)(F.lds + LCNT_OFF);
    bf16_t* H = WSP(bf16_t, WS_H); const float* MOD = WSP(float, WS_MOD); const bf16_t* AX = WSP(bf16_t, WS_AX);
    const float* gate1 = MOD + (size_t)layer * 33 * 6144 + 2 * D;
    constexpr int nMall = last ? NX / 256 : NT / 256;
    if (RUN()) phase_norm1(F, A, layer);
    SEAM();
    if constexpr (kind == 0) {
        if (RUN()) for (int rep_ = 0; rep_ < REPN(1); ++rep_) {
            { pg8::ProbDense8 P; P.A = (const unsigned char*)AX; P.Bt = WSP(unsigned char, WS_WQK) + (size_t)j * 1280 * D; P.lda = D; P.ldb = D; P.K = D; P.scale_w = SCALE_W; P.scale_x = SCALE_ONE; P.ord.init(NT / 256, 5, F.G, F.c);
              EpiQK E{WSP(bf16_t, WS_Q), WSP(bf16_t, WS_K), WSP(float, WS_BQK) + j * 1280, WSP(float, WS_ROPEC), WSP(float, WS_ROPES)};
              pg8::gemm_phase(ring, P, E); }
            { pg8::ProbDense8 P; P.A = WSP(unsigned char, WS_WV) + (size_t)j * 256 * D; P.Bt = (const unsigned char*)AX; P.lda = D; P.ldb = D; P.K = D; P.scale_w = SCALE_ONE; P.scale_x = SCALE_W; P.ord.init(1, NT / 256, F.G, F.c);
              EpiVT E{WSP(bf16_t, WS_VT), A.in[I_ABQKV] + j * 1536 + 1280};
              pg8::gemm_phase(ring, P, E); }
        }
        SEAM();
        if (RUN()) for (int rep_ = 0; rep_ < REPN(2); ++rep_) phase_attn(F, A, j, !last);
        SEAM();
        if (RUN() && !((SKIPMASK >> layer) & 1)) { pg8::ProbDense8 P; P.A = WSP(unsigned char, WS_O); P.Bt = WSP(unsigned char, WS_WO) + (size_t)j * D * D; P.lda = D; P.ldb = D; P.K = D; P.scale_w = SCALE_W; P.scale_x = SCALE_ONE; P.ord.init(nMall, 4, F.G, F.c);
            EpiResid E{H, A.in[I_ABO] + j * D, nullptr, gate1};
            pg8::gemm_phase(ring, P, E); }
        SEAM();
    } else if constexpr (kind == 1) {
        if (RUN()) for (int rep_ = 0; rep_ < REPN(3); ++rep_) phase_pooldiff(F);
        SEAM();
        if (RUN() && !((SKIPMASK >> layer) & 1)) { pg8::ProbDense P; P.A = WSP(bf16_t, WS_PD); P.Bt = WSP(bf16_t, WS_POOLW); P.lda = D; P.ldb = 256; P.K = 256; P.a_pn_off = 256; P.ord.init(nMall, 4, F.G, F.c);
            EpiResid E{H, A.in[I_PB], A.in[I_PS], gate1};
            pg8::gemm_phase(ring, P, E); }
        SEAM();
    } else {
        if (RUN()) for (int rep_ = 0; rep_ < REPN(4); ++rep_) phase_rwkv_mix(F, A);
        SEAM();
        if (RUN()) for (int rep_ = 0; rep_ < REPN(5); ++rep_) {
            for (int i = 0; i < 3; ++i) { const int sel = i == 0 ? 0 : i == 1 ? 2 : 3;
                pg8::ProbDense8 P; P.A = (const unsigned char*)(WSP(bf16_t, WS_A6) + (size_t)sel * NT * D); P.Bt = WSP(unsigned char, WS_WRKV) + (size_t)i * D * D; P.lda = D; P.ldb = D; P.K = D; P.scale_w = SCALE_W; P.scale_x = SCALE_ONE; P.ord.init(NT / 256, 4, F.G, F.c);
                EpiBf16Act E{WSP(bf16_t, WS_RKV) + (size_t)i * NT * D, D, nullptr, 0, 1.0f};
                pg8::gemm_phase(ring, P, E); }
            for (int i = 0; i < 3; ++i) { const int sel = i == 0 ? 5 : i == 1 ? 1 : 4;
                pg8::ProbDense P; P.A = WSP(bf16_t, WS_A6) + (size_t)sel * NT * D; P.Bt = WSP(bf16_t, WS_WL1) + (size_t)i * 256 * D; P.lda = D; P.ldb = D; P.K = D; P.a_pn_off = 0; P.ord.init(NT / 256, 1, F.G, F.c);
                EpiBf16Act E{WSP(bf16_t, WS_LORA) + i * 256, 768, nullptr, i == 0 ? 1 : i == 1 ? 2 : 0, 1.0f};
                pg8::gemm_phase(ring, P, E); }
        }
        SEAM();
        if (RUN()) for (int rep_ = 0; rep_ < REPN(6); ++rep_) {
            for (int i = 0; i < 5; ++i) {
                const int ablk = i == 0 ? 0 : i < 3 ? 1 : 2, d = (i - 1) & 1;
                pg8::ProbDense P; P.A = WSP(bf16_t, WS_LORA) + ablk * 256; P.Bt = WSP(bf16_t, WS_WL2) + (size_t)i * D * 256; P.lda = 768; P.ldb = 256; P.K = 256; P.a_pn_off = 0; P.ord.init(NT / 256, 4, F.G, F.c);
                EpiBf16Act E; E.ldc = D;
                if (i == 0) { E.O = WSP(bf16_t, WS_G); E.bias = nullptr; E.act = 0; E.scale = 1.0f; }
                else if (i < 3) { E.O = WSP(bf16_t, WS_E) + (size_t)d * NT * D; E.bias = A.in[I_RW0] + d * D; E.act = 1; E.scale = 0.6065306597126334f; }
                else { E.O = WSP(bf16_t, WS_A) + (size_t)d * NT * D; E.bias = A.in[I_RA0] + d * D; E.act = 1; E.scale = 1.0f; }
                pg8::gemm_phase(ring, P, E); }
        }
        SEAM();
        if (RUN()) for (int rep_ = 0; rep_ < REPN(7); ++rep_) phase_rwkv_scan(F, A);
        SEAM();
        if (RUN()) for (int rep_ = 0; rep_ < REPN(8); ++rep_) phase_rwkv_out(F, A, last ? NX : NT);
        SEAM();
        if (RUN() && !((SKIPMASK >> layer) & 1)) { pg8::ProbDense8 P; P.A = WSP(unsigned char, WS_RO); P.Bt = WSP(unsigned char, WS_WOR); P.lda = D; P.ldb = D; P.K = D; P.scale_w = SCALE_W; P.scale_x = SCALE_ONE; P.ord.init(nMall, 4, F.G, F.c);
            EpiResid E{H, nullptr, nullptr, gate1};
            pg8::gemm_phase(ring, P, E); }
        SEAM();
    }
    if (RUN()) phase_route(F, A, layer);
    SEAM();
    if (RUN()) for (int rep_ = 0; rep_ < REPN(9); ++rep_) { moe_tiles(F, layer);
        ProbMoe1 P; P.FX = WSP(fp8_t, WS_FX); P.W1T = WSP(fp8_t, WS_W1T) + (size_t)layer * NE * 2048 * D; P.list = WSP(int, WS_LIST); P.tpre = tpre; P.cnt = lcnt; P.texp = (const LAS unsigned char*)(F.lds + TEXP_OFF); P.toks = (LAS int*)(F.lds + TOKS_OFF); P.scale_w = SCALE_W; P.scale_x = SCALE_ONE; P.ord.init(tpre[NE], 8, F.G, F.c);
        EpiMoe1 E{WSP(unsigned char, WS_ACT), A.in[I_MB1] + (size_t)layer * NE * 2048};
        pg8::gemm_phase(ring, P, E); }
    SEAM();
    if (RUN()) for (int rep_ = 0; rep_ < REPN(10); ++rep_) { moe_tiles(F, layer);
        ProbMoe2 P; P.ACT = WSP(fp8_t, WS_ACT); P.W2T = WSP(fp8_t, WS_W2T) + (size_t)layer * NE * D * D; P.tpre = tpre; P.texp = (const LAS unsigned char*)(F.lds + TEXP_OFF); P.scale_w = SCALE_W; P.scale_x = SCALE_ONE; P.ord.init(tpre[NE], 4, F.G, F.c);
        EpiMoe2 E{WSP(bf16_t, WS_Y), A.in[I_MB2] + (size_t)layer * NE * D};
        pg8::gemm_phase(ring, P, E); }
    SEAM();
}
__global__ void __launch_bounds__(NTHREADS, 2) trunk_fwd(Args A) {
    extern __shared__ __attribute__((aligned(16))) unsigned char lds_[];
    Frame F; F.lds = (LAS unsigned char*)lds_; REFRESH(F); F.wave = __builtin_amdgcn_readfirstlane(F.tid >> 6);
    F.G = gridDim.x; F.c = blockIdx.x; F.ws = A.ws; F.ctl = (unsigned*)(A.ws + WS_CTL);
    for (int u = F.tid; u < (LDS_BYTES - LDSCTL_OFF) / 4; u += NTHREADS) ((LAS unsigned*)(F.lds + LDSCTL_OFF))[u] = 0u;
    __syncthreads();
    KState KS; KS.bar.bar = F.ctl + CW_BAR; KS.bar.x = 0; KS.bar.st = nullptr; KS.ph = 0;
    if (A.one) KS.bar = xcd_barrier_post(F.ctl + CW_BAR, (volatile LAS unsigned*)(F.lds + MISC_OFF) + 8);
    if (RUN()) for (int rep_ = 0; rep_ < REPN(0); ++rep_) phase_prologue(F, A);
    SEAM();
    layer_body<0>(F, A, KS);
    layer_body<1>(F, A, KS);
    layer_body<2>(F, A, KS);
    layer_body<3>(F, A, KS);
    if (RUN()) phase_final(F, A);
}
#undef RUN
#undef SEAM
static int count_phases() { int n = 1; for (int layer = 0; layer < DEPTH; ++layer) { const int kind = layer % 3; n += 1 + (kind == 0 ? 3 : kind == 1 ? 2 : 6) + 3; } return n + 1; }

extern "C" void kernel_launch(void* const* d_in, const int* in_sizes, int n_in, void* d_out, int out_size, void* d_ws, size_t ws_size, hipStream_t stream) {
    static int grid = 0;
    if (grid == 0) {
        if (n_in != 38 || out_size != NX * D || ws_size < WS_END) { fprintf(stderr, "kernel_launch: unexpected problem (n_in %d, out %d, ws %zu < %zu)\n", n_in, out_size, ws_size, (size_t)WS_END); grid = -1; return; }
        int dev = 0, cus = 0;
        if (hipGetDevice(&dev) != hipSuccess || hipDeviceGetAttribute(&cus, hipDeviceAttributeMultiprocessorCount, dev) != hipSuccess) { grid = -1; return; }
        if (hipFuncSetAttribute((const void*)trunk_fwd, hipFuncAttributeMaxDynamicSharedMemorySize, LDS_BYTES) != hipSuccess) { fprintf(stderr, "kernel_launch: hipFuncSetAttribute failed\n"); grid = -1; return; }
        int per_cu = 0;
        if (hipOccupancyMaxActiveBlocksPerMultiprocessor(&per_cu, (const void*)trunk_fwd, NTHREADS, LDS_BYTES) != hipSuccess || per_cu < 1) fprintf(stderr, "kernel_launch: occupancy query says %d\n", per_cu);
        (void)hipGetLastError();
        grid = cus;
        if (grid != 256) fprintf(stderr, "kernel_launch: %d CUs (built for 256)\n", grid);
    }
    if (grid < 0) return;
    (void)hipMemsetAsync((char*)d_ws + WS_CTL, 0, CTL_BYTES, stream);
    (void)hipMemsetAsync((char*)d_ws + WS_LZERO, 0, LZERO_BYTES, stream);
    Args a{};
    for (int i = 0; i < 38; ++i) a.in[i] = (const float*)d_in[i];
    a.out = (float*)d_out; a.ws = (unsigned char*)d_ws;
#if MK_ONE_LAUNCH
    a.phase = 0; a.one = 1;
    hipLaunchKernelGGL(trunk_fwd, dim3(grid), dim3(NTHREADS), LDS_BYTES, stream, a);
#else
    const int nph = count_phases();
    for (int p = 0; p < nph; ++p) { a.phase = p; a.one = 0; hipLaunchKernelGGL(trunk_fwd, dim3(grid), dim3(NTHREADS), LDS_BYTES, stream, a); }
#endif
}
```

```cpp
#include <hip/hip_runtime.h>
#include <cstdio>
#include <cstdint>

#ifndef MK_ONE_LAUNCH
#define MK_ONE_LAUNCH 1
#endif
#ifndef REPMASK
#define REPMASK 0x000
#endif
#define REPN(k) (1 + ((REPMASK >> (k)) & 1))
#ifndef DIAG
#define DIAG 0
#endif
#ifndef SKIPMASK
#define SKIPMASK 0x00
#endif

#define LAS __attribute__((address_space(3)))
#define GAS __attribute__((address_space(1)))
typedef unsigned short bf16_t;
typedef short bf16x8 __attribute__((ext_vector_type(8)));
typedef float f32x4 __attribute__((ext_vector_type(4)));
typedef float f32x2 __attribute__((ext_vector_type(2)));
typedef unsigned u32x4 __attribute__((ext_vector_type(4)));
typedef unsigned u32x2 __attribute__((ext_vector_type(2)));

constexpr int D = 1024, NB = 32, T = 2048, L = 256, DEPTH = 4;
constexpr int NX = NB * T, NC = NB * L, NT = NX + NC;
constexpr int NE = 32, TOPK = 4;
constexpr int NWAVES = 8, NTHREADS = 512;
constexpr int MAXRT = NT * TOPK / 256 + NE;

constexpr size_t MiB = 1u << 20;
constexpr size_t WS_CTL = 0, CTL_BYTES = 4 * MiB;
constexpr size_t WS_MOD = 4 * MiB;
constexpr size_t WS_ROPEC = 8 * MiB, WS_ROPES = 8 * MiB + 512 * 1024;
constexpr size_t WS_BQK = 9 * MiB;
constexpr size_t WS_WQK = 10 * MiB;
constexpr size_t WS_WV = 15 * MiB;
constexpr size_t WS_WO = 16 * MiB;
constexpr size_t WS_POOLW = 20 * MiB;
constexpr size_t WS_WRKV = 21 * MiB;
constexpr size_t WS_WOR = 27 * MiB;
constexpr size_t WS_WL1 = 30 * MiB;
constexpr size_t WS_WL2 = 32 * MiB;
constexpr size_t WS_LZERO = WS_WL1, LZERO_BYTES = 6 * MiB;
constexpr size_t WS_W1T = 40 * MiB;
constexpr size_t WS_W2T = 552 * MiB;
constexpr size_t WS_H = 808 * MiB;
constexpr size_t WS_AX = 1096 * MiB;
constexpr size_t WS_FX = 1240 * MiB;
constexpr size_t WS_R = 1384 * MiB;
constexpr size_t WS_ACT = WS_R;
constexpr size_t WS_Y = WS_R + 592 * MiB;
constexpr size_t WS_LIST = WS_R + 1184 * MiB;
constexpr size_t WS_POS = WS_R + 1193 * MiB;
constexpr size_t WS_GATE = WS_R + 1195 * MiB;
constexpr size_t WS_Q = WS_R;
constexpr size_t WS_K = WS_R + 144 * MiB;
constexpr size_t WS_VT = WS_R + 180 * MiB;
constexpr size_t WS_O = WS_R + 216 * MiB;
constexpr size_t WS_PD = WS_R;
constexpr size_t WS_A6 = WS_R;
constexpr size_t WS_E = WS_R;
constexpr size_t WS_A = WS_R + 288 * MiB;
constexpr size_t WS_RO = WS_R + 576 * MiB;
constexpr size_t WS_RKV = WS_R + 864 * MiB;
constexpr size_t WS_LORA = WS_R + 1296 * MiB;
constexpr size_t WS_G = WS_R + 1404 * MiB;
constexpr size_t WS_YS = WS_R + 1548 * MiB;
constexpr size_t WS_BONUS = WS_R + 2124 * MiB;
constexpr size_t WS_END = WS_R + 2134 * MiB;

constexpr int CW_BAR = 4096;
constexpr int CW_GCNT = 16384;
constexpr int LDS_BYTES = 147456;
constexpr int RING_BYTES = 131072;
constexpr int LDSCTL_OFF = 135168;
constexpr int MISC_OFF = LDSCTL_OFF;
constexpr int TPRE_OFF = LDSCTL_OFF + 256;
constexpr int LCNT_OFF = LDSCTL_OFF + 512;
constexpr int LBASE_OFF = LDSCTL_OFF + 768;
constexpr int REC_OFF = LDSCTL_OFF + 1024;
constexpr int TEXP_OFF = LDSCTL_OFF + 1024 + 2048;
constexpr int TOKS_OFF = LDSCTL_OFF + 1024 + 4096;
constexpr int JOB_OFF = LDSCTL_OFF + 1024;

__device__ __forceinline__ unsigned f2bf(float f) { unsigned u = __builtin_bit_cast(unsigned, f); return (u + 0x7fffu + ((u >> 16) & 1u)) >> 16; }
__device__ __forceinline__ unsigned pk2(float lo, float hi) { return f2bf(lo) | (f2bf(hi) << 16); }
__device__ __forceinline__ float bflo(unsigned w) { return __builtin_bit_cast(float, w << 16); }
__device__ __forceinline__ float bfhi(unsigned w) { return __builtin_bit_cast(float, w & 0xffff0000u); }
__device__ __forceinline__ float bf1(bf16_t b) { return __builtin_bit_cast(float, ((unsigned)b) << 16); }
__device__ __forceinline__ unsigned pk4_fp8(float a, float b, float c, float d) { int w = __builtin_amdgcn_cvt_pk_fp8_f32(a, b, 0, false); w = __builtin_amdgcn_cvt_pk_fp8_f32(c, d, w, true); return (unsigned)w; }
typedef __bf16 bf16x2_t __attribute__((ext_vector_type(2)));
__device__ __forceinline__ unsigned cvt_pk_bf16(float lo, float hi) { const f32x2 v = {lo, hi}; return __builtin_bit_cast(unsigned, __builtin_convertvector(v, bf16x2_t)); }
__device__ __forceinline__ float dpp_add(float v, const int ctrl, const int row_mask) {
    switch (ctrl) {
    case 0xB1:  return v + __builtin_bit_cast(float, __builtin_amdgcn_update_dpp(0, __builtin_bit_cast(int, v), 0xB1, 0xf, 0xf, true));
    case 0x4E:  return v + __builtin_bit_cast(float, __builtin_amdgcn_update_dpp(0, __builtin_bit_cast(int, v), 0x4E, 0xf, 0xf, true));
    case 0x141: return v + __builtin_bit_cast(float, __builtin_amdgcn_update_dpp(0, __builtin_bit_cast(int, v), 0x141, 0xf, 0xf, true));
    case 0x140: return v + __builtin_bit_cast(float, __builtin_amdgcn_update_dpp(0, __builtin_bit_cast(int, v), 0x140, 0xf, 0xf, true));
    case 0x142: return v + __builtin_bit_cast(float, __builtin_amdgcn_update_dpp(0, __builtin_bit_cast(int, v), 0x142, 0xa, 0xf, true));
    default:    return v + __builtin_bit_cast(float, __builtin_amdgcn_update_dpp(0, __builtin_bit_cast(int, v), 0x143, 0xc, 0xf, true));
    }
}
__device__ __forceinline__ float row16_sum(float v) { v = dpp_add(v, 0xB1, 0xf); v = dpp_add(v, 0x4E, 0xf); v = dpp_add(v, 0x141, 0xf); v = dpp_add(v, 0x140, 0xf); return v; }
__device__ __forceinline__ float wave_sum(float v) {
    v = row16_sum(v); v = dpp_add(v, 0x142, 0xa); v = dpp_add(v, 0x143, 0xc);
    return __builtin_bit_cast(float, __builtin_amdgcn_readlane(__builtin_bit_cast(int, v), 63));
}
__device__ __forceinline__ float sigmoidf_(float x) { return __builtin_amdgcn_rcpf(1.0f + __builtin_amdgcn_exp2f(-1.4426950408889634f * x)); }
__device__ __forceinline__ int opaque_tid() { int t; asm volatile("v_mov_b32 %0, %1" : "=v"(t) : "v"(threadIdx.x)); return t; }
#define REFRESH(F) do { (F).tid = opaque_tid(); (F).lane = (F).tid & 63; } while (0)
__device__ __forceinline__ void seq_of(int row, int& sb, int& t, int& n) { if (row < NX) { sb = row & ~(T - 1); t = row & (T - 1); n = T; } else { const int r2 = row - NX; sb = NX + (r2 & ~(L - 1)); t = r2 & (L - 1); n = L; } }
__device__ __forceinline__ f32x4 ld_bf4(const bf16_t* p) { const u32x2 w = *(const u32x2*)p; return (f32x4){bflo(w.x), bfhi(w.x), bflo(w.y), bfhi(w.y)}; }
__device__ __forceinline__ void st_bf4(bf16_t* p, f32x4 v) { u32x2 w; w.x = pk2(v.x, v.y); w.y = pk2(v.z, v.w); *(u32x2*)p = w; }

#define LDS_WAIT() asm volatile("s_waitcnt lgkmcnt(0)" ::: "memory")
#define VM_WAIT() asm volatile("s_waitcnt vmcnt(0)" ::: "memory")

#define XB_TMO      128
#define XB_XCNT(j)  (256  + 64 * (j))
#define XB_XSUB(j)  (1280 + 64 * (j))
#define XB_XGEN(j)  (2304 + 64 * (j))
#define XB_TOP      3328
#define XB_TOPGEN   3392
#define XCD_BAR_WORDS 3456
#define XB_SPIN_CAP (1u << 18)
__device__ __forceinline__ unsigned xb_ld(unsigned* p)              { return __hip_atomic_load(p, __ATOMIC_RELAXED, __HIP_MEMORY_SCOPE_AGENT); }
__device__ __forceinline__ unsigned xb_add(unsigned* p, unsigned v) { return __hip_atomic_fetch_add(p, v, __ATOMIC_RELAXED, __HIP_MEMORY_SCOPE_AGENT); }
__device__ __forceinline__ unsigned xb_xcc_id() { return (unsigned)__builtin_amdgcn_s_getreg((3 << 11) | 20) & 0xFu; }
#define XB_SPIN(cond, bar) do { unsigned _sp = 0; while (cond) { __builtin_amdgcn_s_sleep(1); \
    if ((++_sp & 255u) == 0u) { if (xb_ld(&(bar)[XB_TMO])) break; if (_sp > XB_SPIN_CAP) { atomicAdd(&(bar)[XB_TMO], 1u); break; } } } } while (0)
struct XcdBarrier { unsigned* bar; unsigned x; volatile LAS unsigned* st; };
__device__ __forceinline__ XcdBarrier xcd_barrier_post(unsigned* bar, volatile LAS unsigned* st) {
    XcdBarrier b; b.bar = bar; b.x = xb_xcc_id(); b.st = st;
    if (threadIdx.x == 0) (void)xb_add(&bar[XB_XCNT(b.x)], 1u);
    return b;
}
__device__ __forceinline__ void xcd_barrier_complete(unsigned* bar, unsigned x, unsigned& nloc, unsigned& nx) {
    const unsigned G = gridDim.x * gridDim.y * gridDim.z;
    unsigned sum, cnt, mine, sp = 0u;
    for (;;) {
        sum = 0u; cnt = 0u; mine = 0u;
#pragma unroll
        for (unsigned j = 0; j < 16; ++j) { const unsigned c = xb_ld(&bar[XB_XCNT(j)]); sum += c; cnt += (c > 0u) ? 1u : 0u; mine = (j == x) ? c : mine; }
        if (sum == G) break;
        __builtin_amdgcn_s_sleep(1);
        if ((++sp & 255u) == 0u) { if (xb_ld(&bar[XB_TMO])) break; if (sp > XB_SPIN_CAP) { atomicAdd(&bar[XB_TMO], 1u); break; } }
    }
    nloc = mine > 0u ? mine : 1u; nx = cnt > 0u ? cnt : 1u;
}
__device__ __forceinline__ void xcd_barrier(const XcdBarrier& b) {
    asm volatile("s_waitcnt vmcnt(0)" ::: "memory");
    __syncthreads();
    if (threadIdx.x == 0) {
        unsigned* bar = b.bar;
        __builtin_amdgcn_s_waitcnt(0);
        unsigned nloc = b.st[0], nx = b.st[1];
        if (nloc == 0u) { xcd_barrier_complete(bar, b.x, nloc, nx); b.st[0] = nloc; b.st[1] = nx; }
        const unsigned old = xb_add(&bar[XB_XSUB(b.x)], 1u);
        const unsigned gen = old / nloc;
        if (old + 1u == (gen + 1u) * nloc) {
            __builtin_amdgcn_fence(__ATOMIC_RELEASE, "agent");
            asm volatile("s_waitcnt vmcnt(0)" ::: "memory");
            const unsigned og = xb_add(&bar[XB_TOP], 1u);
            const unsigned tg = og / nx;
            if (og + 1u == (tg + 1u) * nx) xb_add(&bar[XB_TOPGEN], 1u);
            else XB_SPIN(xb_ld(&bar[XB_TOPGEN]) == tg, bar);
            __builtin_amdgcn_fence(__ATOMIC_ACQUIRE, "agent");
            xb_add(&bar[XB_XGEN(b.x)], 1u);
            asm volatile("s_waitcnt vmcnt(0)" ::: "memory");
        } else {
            XB_SPIN(xb_ld(&bar[XB_XGEN(b.x)]) == gen, bar);
            __builtin_amdgcn_fence(__ATOMIC_ACQUIRE, "agent");
            asm volatile("s_waitcnt vmcnt(0)" ::: "memory");
        }
    }
    __syncthreads();
}

namespace pg8 {
constexpr int BM = 256, BK = 64, HALF = 128, HTB = HALF * BK * 2, STAGE_BYTES = 8 * HTB, NXCD = 8, WGM = 8;
__host__ __device__ __forceinline__ int lds_byte(int r, int c) { const int st = (r >> 4) * 2 + (c >> 5), rr = r & 15, cc = c & 31, ob = rr * 64 + cc * 2; return st * 1024 + (ob ^ (((ob >> 9) & 1) << 5)); }
__host__ __device__ __forceinline__ void stage_rc(int b, int& R, int& C) { const int st = b / 1024, sb = b % 1024, swz = sb ^ (((sb >> 9) & 1) << 5); R = (st >> 1) * 16 + swz / 64; C = (st & 1) * 32 + (swz % 64) / 2; }
__host__ __device__ __forceinline__ int perm32(int rho) { const int n = rho >> 4, i = rho & 15; return 8 * (i >> 2) + 4 * n + (i & 3); }

typedef int i32x8 __attribute__((ext_vector_type(8)));
typedef int i32x4 __attribute__((ext_vector_type(4)));
__device__ __forceinline__ i32x8 cat8(bf16x8 lo, bf16x8 hi) { const i32x4 a = __builtin_bit_cast(i32x4, lo), b = __builtin_bit_cast(i32x4, hi); return __builtin_shufflevector(a, b, 0, 1, 2, 3, 4, 5, 6, 7); }
struct Unit { int pm, pn, e, rt; };
struct TileOrder {
    int nM, nN, nwg, G, c;
    __device__ __forceinline__ void init(int nM_, int nN_, int G_, int c_) { nM = nM_; nN = nN_; nwg = nM * nN; G = G_; c = c_; }
    __device__ __forceinline__ bool next(int i, int& pm, int& pn) const {
        const long Lx = (long)i * G + c; if (Lx >= nwg) return false;
        int wgid = (int)Lx; { const int q = nwg / NXCD, r = nwg % NXCD, xcd = wgid % NXCD, off = wgid / NXCD; wgid = (xcd < r ? xcd * (q + 1) : r * (q + 1) + (xcd - r) * q) + off; }
        const int nig = WGM * nN, gid = wgid / nig, fm = gid * WGM, gsz = (nM - fm) < WGM ? (nM - fm) : WGM;
        pm = fm + ((wgid % nig) % gsz); pn = (wgid % nig) / gsz; return true;
    }
};
struct ProbDense {
    static constexpr bool FP8 = false;
    const bf16_t* A; const bf16_t* Bt; int lda, ldb, K, a_pn_off; TileOrder ord;
    __device__ __forceinline__ int ldb_bytes() const { return ldb * 2; }
    __device__ __forceinline__ int ntiles() const { return K / 64; }
    __device__ __forceinline__ bool next(int i, Unit& u) const { u.e = 0; const bool ok = ord.next(i, u.pm, u.pn); u.rt = u.pm; return ok; }
    __device__ __forceinline__ const char* a_ptr(const Unit& u) const { return (const char*)(A + (size_t)u.pm * BM * lda + (size_t)u.pn * a_pn_off); }
    __device__ __forceinline__ const char* b_ptr(const Unit& u) const { return (const char*)(Bt + (size_t)u.pn * BM * ldb); }
    __device__ __forceinline__ void list_prefetch(const Unit&, int, int, int) const {}
    __device__ __forceinline__ void a_off(const Unit&, int, const int (&R)[2], const int (&C)[2], unsigned (&v)[2][2]) const {
#pragma unroll
        for (int h = 0; h < 2; ++h)
#pragma unroll
            for (int i = 0; i < 2; ++i) v[h][i] = (unsigned)((h * HALF + R[i]) * lda + C[i]) * 2u;
    }
};

struct ProbDense8 {
    static constexpr bool FP8 = true;
    const unsigned char* A; const unsigned char* Bt; int lda, ldb, K, scale_w, scale_x; TileOrder ord;
    __device__ __forceinline__ int ldb_bytes() const { return ldb; }
    __device__ __forceinline__ int ntiles() const { return K / 128; }
    __device__ __forceinline__ bool next(int i, Unit& u) const { u.e = 0; const bool ok = ord.next(i, u.pm, u.pn); u.rt = u.pm; return ok; }
    __device__ __forceinline__ const char* a_ptr(const Unit& u) const { return (const char*)(A + (size_t)u.pm * BM * lda); }
    __device__ __forceinline__ const char* b_ptr(const Unit& u) const { return (const char*)(Bt + (size_t)u.pn * BM * ldb); }
    __device__ __forceinline__ void list_prefetch(const Unit&, int, int, int) const {}
    __device__ __forceinline__ void a_off(const Unit&, int, const int (&R)[2], const int (&C)[2], unsigned (&v)[2][2]) const {
#pragma unroll
        for (int h = 0; h < 2; ++h)
#pragma unroll
            for (int i = 0; i < 2; ++i) v[h][i] = (unsigned)((h * HALF + R[i]) * lda + C[i] * 2);
    }
};
template <class Prob, class Epi>
__device__ __forceinline__ void gemm_phase(LAS unsigned char* lds, const Prob& P, const Epi& E) {
    const int tid = opaque_tid(), wid = __builtin_amdgcn_readfirstlane(tid >> 6), lane = tid & 63, wr = wid >> 2, wc = wid & 3, fr = lane & 15, fq = lane >> 4;
    const int nt = P.ntiles(); const int ldbB = P.ldb_bytes();
    int Rr[2], Cc[2]; unsigned voffB[2];
#pragma unroll
    for (int i = 0; i < 2; ++i) { int R, C; stage_rc(tid * 16 + i * 8192, R, C); Rr[i] = R; Cc[i] = C; const int Rb = Epi::PERM ? ((R & ~31) + perm32(R & 31)) : R;
        voffB[i] = (unsigned)(Rb * ldbB + C * 2); }
    const size_t kstep = (size_t)(BK * 2);
    const size_t hstepB = (size_t)HALF * ldbB;
    const unsigned ldsw = (unsigned)wid * 1024u;
    const int aoff = lds_byte(wr * 64 + fr, fq * 8), boff = lds_byte(wc * 32 + fr, fq * 8);
#define PG8_SA(b, h) (((b) * 2 + (h)) * HTB)
#define PG8_SB(b, h) ((4 + (b) * 2 + (h)) * HTB)
#define PG8_STAGE(bufoff, gbase, voff) do { _Pragma("unroll") for (int _i = 0; _i < 2; ++_i) \
        __builtin_amdgcn_global_load_lds((const unsigned*)((const char*)(gbase) + (voff)[_i]), (LAS unsigned*)(lds + (bufoff) + ldsw + _i * 8192), 16, 0, 0); } while (0)
#define PG8_LDA(dst, b, h) do { _Pragma("unroll") for (int m = 0; m < 4; ++m) _Pragma("unroll") for (int k = 0; k < 2; ++k) dst[m][k] = *(const LAS bf16x8*)(lds + PG8_SA(b, h) + aoff + m * 2048 + k * 1024); } while (0)
#define PG8_LDB(dst, b, h) do { _Pragma("unroll") for (int n = 0; n < 2; ++n) _Pragma("unroll") for (int k = 0; k < 2; ++k) dst[n][k] = *(const LAS bf16x8*)(lds + PG8_SB(b, h) + boff + n * 2048 + k * 1024); } while (0)
#define PG8_MMA(ai, bj, At, Bt) do { __builtin_amdgcn_s_setprio(1); _Pragma("unroll") for (int m = 0; m < 4; ++m) _Pragma("unroll") for (int n = 0; n < 2; ++n) { \
        if constexpr (Prob::FP8) { asm volatile("v_mfma_scale_f32_16x16x128_f8f6f4 %0, %1, %2, %0, %3, %4 op_sel_hi:[0,0,0]" : "+v"(acc[ai][bj][m][n]) : "v"(cat8(Bt[n][0], Bt[n][1])), "v"(cat8(At[m][0], At[m][1])), "v"(sc_w), "v"(sc_x)); } \
        else { _Pragma("unroll") for (int k = 0; k < 2; ++k) acc[ai][bj][m][n] = __builtin_amdgcn_mfma_f32_16x16x32_bf16(Bt[n][k], At[m][k], acc[ai][bj][m][n], 0, 0, 0); } } __builtin_amdgcn_s_setprio(0); } while (0)
#define PG8_WAIT_V(n) asm volatile("s_waitcnt vmcnt(" #n ")" ::: "memory")
#define PG8_WAIT_L(n) asm volatile("s_waitcnt lgkmcnt(" #n ")" ::: "memory")
#define PG8_BAR __builtin_amdgcn_s_barrier()
#define PG8_SCHED __builtin_amdgcn_sched_barrier(0)
    Unit cur, nxt; int ui = 0;
    if (!P.next(0, cur)) return;
    int sc_w = 0, sc_x = 0; if constexpr (Prob::FP8) { sc_w = P.scale_w; sc_x = P.scale_x; } (void)sc_w; (void)sc_x;
    f32x4 acc[2][2][4][2];
#pragma unroll
    for (int a = 0; a < 2; ++a)
#pragma unroll
        for (int b = 0; b < 2; ++b)
#pragma unroll
            for (int m = 0; m < 4; ++m)
#pragma unroll
                for (int n = 0; n < 2; ++n) acc[a][b][m][n] = (f32x4){0.f, 0.f, 0.f, 0.f};
    bf16x8 At[4][2], B0[2][2], B1[2][2];
    unsigned vAc[2][2], vAn[2][2];
    P.list_prefetch(cur, 0, wid, lane); { Unit u1; if (P.next(1, u1)) P.list_prefetch(u1, 1, wid, lane); }
    PG8_WAIT_V(0); PG8_BAR;
    P.a_off(cur, 0, Rr, Cc, vAc);
    const char* cA = P.a_ptr(cur); const char* cB = P.b_ptr(cur);
    PG8_STAGE(PG8_SB(0, 0), cB, voffB); PG8_STAGE(PG8_SB(0, 1), cB + hstepB, voffB); PG8_STAGE(PG8_SA(0, 0), cA, vAc[0]); PG8_STAGE(PG8_SA(0, 1), cA, vAc[1]);
    if (wr == 1) PG8_BAR;
    PG8_WAIT_V(2); PG8_BAR;
    PG8_STAGE(PG8_SB(1, 0), cB + kstep, voffB); PG8_STAGE(PG8_SA(1, 0), cA + kstep, vAc[0]); PG8_STAGE(PG8_SB(1, 1), cB + hstepB + kstep, voffB);
    PG8_WAIT_V(6); PG8_BAR;
    for (;;) {
        const bool has_next = P.next(ui + 1, nxt);
        const char* nA = cA; const char* nB = cB;
#pragma unroll
        for (int h = 0; h < 2; ++h)
#pragma unroll
            for (int i = 0; i < 2; ++i) vAn[h][i] = vAc[h][i];
        if (has_next) { nA = P.a_ptr(nxt); nB = P.b_ptr(nxt); P.a_off(nxt, (ui + 1) & 1, Rr, Cc, vAn); }
        { Unit u2; if (P.next(ui + 2, u2)) P.list_prefetch(u2, ui & 1, wid, lane); }
        for (int t = 0; t < nt; t += 2) {
            const bool last = (t == nt - 2);
            const char* a1 = cA + (size_t)(t + 1) * kstep;
            const char* a2 = last ? nA : cA + (size_t)(t + 2) * kstep; const char* b2 = last ? nB : cB + (size_t)(t + 2) * kstep;
            const char* a3 = a2 + kstep; const char* b3 = b2 + kstep;
            unsigned vX[2][2];
#pragma unroll
            for (int h = 0; h < 2; ++h)
#pragma unroll
                for (int i = 0; i < 2; ++i) vX[h][i] = last ? vAn[h][i] : vAc[h][i];
            PG8_LDB(B0, 0, 0); PG8_LDB(B1, 0, 1); PG8_SCHED; PG8_LDA(At, 0, 0); PG8_STAGE(PG8_SA(1, 1), a1, vAc[1]);
            PG8_WAIT_V(8); PG8_WAIT_L(0); PG8_BAR; PG8_MMA(0, 0, At, B0); PG8_MMA(0, 1, At, B1); PG8_BAR; PG8_SCHED;
            PG8_LDA(At, 0, 1); PG8_STAGE(PG8_SB(0, 0), b2, voffB); PG8_STAGE(PG8_SB(0, 1), b2 + hstepB, voffB); PG8_STAGE(PG8_SA(0, 0), a2, vX[0]);
            PG8_WAIT_V(8); PG8_WAIT_L(0); PG8_BAR; PG8_MMA(1, 0, At, B0); PG8_MMA(1, 1, At, B1); PG8_BAR; PG8_SCHED;
            PG8_LDB(B0, 1, 0); PG8_LDB(B1, 1, 1); PG8_SCHED; PG8_LDA(At, 1, 0); PG8_STAGE(PG8_SA(0, 1), a2, vX[1]);
            PG8_WAIT_V(8); PG8_WAIT_L(0); PG8_BAR; PG8_MMA(0, 0, At, B0); PG8_MMA(0, 1, At, B1); PG8_BAR; PG8_SCHED;
            PG8_LDA(At, 1, 1); PG8_STAGE(PG8_SB(1, 0), b3, voffB); PG8_STAGE(PG8_SB(1, 1), b3 + hstepB, voffB); PG8_STAGE(PG8_SA(1, 0), a3, vX[0]);
            PG8_WAIT_V(8); PG8_WAIT_L(0); PG8_BAR; PG8_MMA(1, 0, At, B0); PG8_MMA(1, 1, At, B1); PG8_BAR; PG8_SCHED;
        }
        if (wr == 0) PG8_BAR;
        if constexpr (Prob::FP8) asm volatile("s_nop 15\n\ts_nop 15" ::: "memory");
        E(acc, cur, wr, wc, fr, fq);
        if (!has_next) break;
#pragma unroll
        for (int a = 0; a < 2; ++a)
#pragma unroll
            for (int b = 0; b < 2; ++b)
#pragma unroll
                for (int m = 0; m < 4; ++m)
#pragma unroll
                    for (int n = 0; n < 2; ++n) acc[a][b][m][n] = (f32x4){0.f, 0.f, 0.f, 0.f};
        cur = nxt; cA = nA; cB = nB; ++ui;
#pragma unroll
        for (int h = 0; h < 2; ++h)
#pragma unroll
            for (int i = 0; i < 2; ++i) vAc[h][i] = vAn[h][i];
        if (wr == 1) PG8_BAR;
    }
    PG8_WAIT_V(0);
    PG8_BAR;
#undef PG8_SA
#undef PG8_SB
#undef PG8_STAGE
#undef PG8_LDA
#undef PG8_LDB
#undef PG8_MMA
#undef PG8_WAIT_V
#undef PG8_WAIT_L
#undef PG8_BAR
#undef PG8_SCHED
}
}

using pg8::Unit;
constexpr int HALF_ = 128;
struct EpiBf16Act {
    static constexpr bool PERM = true;
    bf16_t* O; int ldc; const float* bias; int act; float scale;
    __device__ __forceinline__ void operator()(const f32x4 (&acc)[2][2][4][2], const Unit& u, int wr, int wc, int fr, int fq) const {
        const int row0 = u.pm * 256 + wr * 64 + fr, col0 = u.pn * 256 + wc * 32 + 8 * fq;
        f32x4 bv[2][2];
#pragma unroll
        for (int bj = 0; bj < 2; ++bj)
#pragma unroll
            for (int n = 0; n < 2; ++n) bv[bj][n] = bias ? *(const f32x4*)(bias + col0 + bj * HALF_ + 4 * n) : (f32x4){0.f, 0.f, 0.f, 0.f};
#pragma unroll
        for (int ai = 0; ai < 2; ++ai)
#pragma unroll
            for (int m = 0; m < 4; ++m) { bf16_t* rowp = O + (size_t)(row0 + ai * HALF_ + m * 16) * ldc + col0;
#pragma unroll
                for (int bj = 0; bj < 2; ++bj) { f32x4 v0 = acc[ai][bj][m][0] + bv[bj][0], v1 = acc[ai][bj][m][1] + bv[bj][1];
                    if (act == 1) {
#pragma unroll
                        for (int j = 0; j < 4; ++j) { v0[j] = sigmoidf_(v0[j]) * scale; v1[j] = sigmoidf_(v1[j]) * scale; } }
                    else if (act == 2) {
#pragma unroll
                        for (int j = 0; j < 4; ++j) { v0[j] = 1.0f - 2.0f * __builtin_amdgcn_rcpf(__builtin_amdgcn_exp2f(2.8853900817779268f * v0[j]) + 1.0f); v1[j] = 1.0f - 2.0f * __builtin_amdgcn_rcpf(__builtin_amdgcn_exp2f(2.8853900817779268f * v1[j]) + 1.0f); } }
                    u32x4 w; w.x = cvt_pk_bf16(v0[0], v0[1]); w.y = cvt_pk_bf16(v0[2], v0[3]); w.z = cvt_pk_bf16(v1[0], v1[1]); w.w = cvt_pk_bf16(v1[2], v1[3]);
                    *(u32x4*)(rowp + bj * HALF_) = w; } }
    }
};
struct EpiQK {
    static constexpr bool PERM = true;
    bf16_t* Q; bf16_t* Kb; const float* bias; const float* ropec; const float* ropes;
    __device__ __forceinline__ void operator()(const f32x4 (&acc)[2][2][4][2], const Unit& u, int wr, int wc, int fr, int fq) const {
        int row0 = u.pm * 256 + wr * 64 + fr, cl0 = wc * 32 + 8 * fq;
        asm volatile("" : "+v"(row0), "+v"(cl0));
        const int g = (4 * wc + fq) & 7;
        bf16_t* base; int ldc;
        if (u.pn < 4) { base = Q + u.pn * 256; ldc = 1024; } else { base = Kb; ldc = 256; }
        f32x4 bv[2][2];
#pragma unroll
        for (int bj = 0; bj < 2; ++bj)
#pragma unroll
            for (int n = 0; n < 2; ++n) bv[bj][n] = *(const f32x4*)(bias + u.pn * 256 + cl0 + bj * HALF_ + 4 * n);
#pragma unroll
        for (int ai = 0; ai < 2; ++ai)
#pragma unroll
            for (int m = 0; m < 4; ++m) { const int row = row0 + ai * HALF_ + m * 16; bf16_t* rowp = base + (size_t)row * ldc + cl0;
                f32x4 cs = (f32x4){1.f, 1.f, 1.f, 1.f}, sn = (f32x4){0.f, 0.f, 0.f, 0.f};
                if (row < NX) { const int t = row & (T - 1); cs = *(const f32x4*)(ropec + t * 32 + g * 4); sn = *(const f32x4*)(ropes + t * 32 + g * 4); }
#pragma unroll
                for (int bj = 0; bj < 2; ++bj) { const f32x4 v0 = acc[ai][bj][m][0] + bv[bj][0], v1 = acc[ai][bj][m][1] + bv[bj][1];
                    const f32x4 o0 = v0 * cs - v1 * sn, o1 = v1 * cs + v0 * sn;
                    u32x4 w; w.x = cvt_pk_bf16(o0[0], o0[1]); w.y = cvt_pk_bf16(o0[2], o0[3]); w.z = cvt_pk_bf16(o1[0], o1[1]); w.w = cvt_pk_bf16(o1[2], o1[3]);
                    *(u32x4*)(rowp + bj * HALF_) = w; } }
    }
};
struct EpiVT {
    static constexpr bool PERM = true;
    bf16_t* VT; const float* biasrow;
    __device__ __forceinline__ void operator()(const f32x4 (&acc)[2][2][4][2], const Unit& u, int wr, int wc, int fr, int fq) const {
        int row0 = wr * 64 + fr, col0 = u.pn * 256 + wc * 32 + 8 * fq;
        asm volatile("" : "+v"(row0), "+v"(col0));
#pragma unroll
        for (int ai = 0; ai < 2; ++ai)
#pragma unroll
            for (int m = 0; m < 4; ++m) { const int row = row0 + ai * HALF_ + m * 16; const float b = biasrow[row]; bf16_t* rowp = VT + (size_t)row * NT + col0;
#pragma unroll
                for (int bj = 0; bj < 2; ++bj) { const f32x4 v0 = acc[ai][bj][m][0] + b, v1 = acc[ai][bj][m][1] + b;
                    u32x4 w; w.x = cvt_pk_bf16(v0[0], v0[1]); w.y = cvt_pk_bf16(v0[2], v0[3]); w.z = cvt_pk_bf16(v1[0], v1[1]); w.w = cvt_pk_bf16(v1[2], v1[3]);
                    *(u32x4*)(rowp + bj * HALF_) = w; } }
    }
};
struct EpiResid {
    static constexpr bool PERM = true;
    bf16_t* H; const float* bias; const float* ls; const float* gate;
    __device__ __forceinline__ void operator()(const f32x4 (&acc)[2][2][4][2], const Unit& u, int wr, int wc, int fr, int fq) const {
        int row0 = u.pm * 256 + wr * 64 + fr, col0 = u.pn * 256 + wc * 32 + 8 * fq;
        asm volatile("" : "+v"(row0), "+v"(col0));
        f32x4 bv[2][2], lv[2][2];
#pragma unroll
        for (int bj = 0; bj < 2; ++bj)
#pragma unroll
            for (int n = 0; n < 2; ++n) { bv[bj][n] = bias ? *(const f32x4*)(bias + col0 + bj * HALF_ + 4 * n) : (f32x4){0.f, 0.f, 0.f, 0.f};
                                          lv[bj][n] = ls ? *(const f32x4*)(ls + col0 + bj * HALF_ + 4 * n) : (f32x4){1.f, 1.f, 1.f, 1.f}; }
#pragma unroll
        for (int ai = 0; ai < 2; ++ai)
#pragma unroll
            for (int m = 0; m < 4; ++m) { const int row = row0 + ai * HALF_ + m * 16; const int brow = row < NX ? (row >> 11) : 32;
                bf16_t* hp = H + (size_t)row * D + col0; const float* gp = gate + (size_t)brow * (6 * D) + col0;
#pragma unroll
                for (int bj = 0; bj < 2; ++bj) { const u32x4 hw = *(const u32x4*)(hp + bj * HALF_);
                    const f32x4 g0 = *(const f32x4*)(gp + bj * HALF_), g1 = *(const f32x4*)(gp + bj * HALF_ + 4);
                    const f32x4 y0 = (acc[ai][bj][m][0] + bv[bj][0]) * lv[bj][0], y1 = (acc[ai][bj][m][1] + bv[bj][1]) * lv[bj][1];
                    const f32x4 h0 = (f32x4){bflo(hw.x), bfhi(hw.x), bflo(hw.y), bfhi(hw.y)} + g0 * y0, h1 = (f32x4){bflo(hw.z), bfhi(hw.z), bflo(hw.w), bfhi(hw.w)} + g1 * y1;
                    u32x4 w; w.x = cvt_pk_bf16(h0[0], h0[1]); w.y = cvt_pk_bf16(h0[2], h0[3]); w.z = cvt_pk_bf16(h1[0], h1[1]); w.w = cvt_pk_bf16(h1[2], h1[3]);
                    *(u32x4*)(hp + bj * HALF_) = w; }
                asm volatile("" ::: "memory"); }
    }
};
struct EpiMoe1 {
    static constexpr bool PERM = true;
    unsigned char* ACT; const float* b1;
    __device__ __forceinline__ void operator()(const f32x4 (&acc)[2][2][4][2], const Unit& u, int wr, int wc, int fr, int fq) const {
        const int row0 = u.rt * 256 + wr * 64 + fr, cl = u.pn * 128 + wc * 32 + 8 * fq;
        const float* bg = b1 + (size_t)u.e * 2048 + cl; const float* bl = bg + 1024;
        f32x4 bgv[2], blv[2];
#pragma unroll
        for (int n = 0; n < 2; ++n) { bgv[n] = *(const f32x4*)(bg + 4 * n); blv[n] = *(const f32x4*)(bl + 4 * n); }
#pragma unroll
        for (int ai = 0; ai < 2; ++ai)
#pragma unroll
            for (int m = 0; m < 4; ++m) { unsigned char* rowp = ACT + (size_t)(row0 + ai * HALF_ + m * 16) * D + cl;
                f32x4 o[2];
#pragma unroll
                for (int n = 0; n < 2; ++n) { const f32x4 hg = acc[ai][0][m][n] + bgv[n], hl = acc[ai][1][m][n] + blv[n];
#pragma unroll
                    for (int j = 0; j < 4; ++j) { const float gl = fminf(hg[j], 7.0f); const float li = fminf(fmaxf(hl[j], -7.0f), 7.0f);
                        o[n][j] = gl * sigmoidf_(1.702f * gl) * (li + 1.0f); } }
                u32x2 w; w.x = pk4_fp8(o[0][0], o[0][1], o[0][2], o[0][3]); w.y = pk4_fp8(o[1][0], o[1][1], o[1][2], o[1][3]);
                *(u32x2*)rowp = w; }
    }
};
struct EpiMoe2 {
    static constexpr bool PERM = true;
    bf16_t* Y; const float* b2;
    __device__ __forceinline__ void operator()(const f32x4 (&acc)[2][2][4][2], const Unit& u, int wr, int wc, int fr, int fq) const {
        const int row0 = u.rt * 256 + wr * 64 + fr, col0 = u.pn * 256 + wc * 32 + 8 * fq;
        const float* bb = b2 + (size_t)u.e * D + col0;
        f32x4 bv[2][2];
#pragma unroll
        for (int bj = 0; bj < 2; ++bj)
#pragma unroll
            for (int n = 0; n < 2; ++n) bv[bj][n] = *(const f32x4*)(bb + bj * HALF_ + 4 * n);
#pragma unroll
        for (int ai = 0; ai < 2; ++ai)
#pragma unroll
            for (int m = 0; m < 4; ++m) { bf16_t* rowp = Y + (size_t)(row0 + ai * HALF_ + m * 16) * D + col0;
#pragma unroll
                for (int bj = 0; bj < 2; ++bj) { const f32x4 v0 = acc[ai][bj][m][0] + bv[bj][0], v1 = acc[ai][bj][m][1] + bv[bj][1];
                    u32x4 w; w.x = cvt_pk_bf16(v0[0], v0[1]); w.y = cvt_pk_bf16(v0[2], v0[3]); w.z = cvt_pk_bf16(v1[0], v1[1]); w.w = cvt_pk_bf16(v1[2], v1[3]);
                    *(u32x4*)(rowp + bj * HALF_) = w; } }
    }
};
typedef unsigned char fp8_t;
constexpr int SCALE_ONE = 0x7f7f7f7f, SCALE_W = 0x79797979;
struct ProbMoe1 {
    static constexpr bool FP8 = true;
    const fp8_t* FX; const fp8_t* W1T; const int* list; const LAS int* tpre; const LAS int* cnt; const LAS unsigned char* texp; LAS int* toks; int scale_w, scale_x; pg8::TileOrder ord;
    __device__ __forceinline__ int ldb_bytes() const { return D; }
    __device__ __forceinline__ int ntiles() const { return D / 128; }
    __device__ __forceinline__ bool next(int i, Unit& u) const {
        if (!ord.next(i, u.pm, u.pn)) return false;
        u.rt = u.pm; u.e = texp[u.rt]; return true;
    }
    __device__ __forceinline__ const char* a_ptr(const Unit&) const { return (const char*)FX; }
    __device__ __forceinline__ const char* b_ptr(const Unit& u) const { return (const char*)(W1T + ((size_t)u.e * 2048 + (size_t)u.pn * 256) * D); }
    __device__ __forceinline__ void list_prefetch(const Unit& u, int par, int wid, int lane) const {
        if (wid == 0) { const int* src = list + (size_t)u.e * NT + (u.rt - tpre[u.e]) * 256 + 4 * lane;
            __builtin_amdgcn_global_load_lds((const unsigned*)src, (LAS unsigned*)(toks + par * 256), 16, 0, 0); }
    }
    __device__ __forceinline__ void a_off(const Unit& u, int par, const int (&R)[2], const int (&C)[2], unsigned (&v)[2][2]) const {
        const int nvalid = cnt[u.e] - (u.rt - tpre[u.e]) * 256; const LAS int* tk = toks + par * 256;
#pragma unroll
        for (int h = 0; h < 2; ++h)
#pragma unroll
            for (int i = 0; i < 2; ++i) { const int r = h * 128 + R[i]; const int tok = tk[r < nvalid ? r : 0]; v[h][i] = (unsigned)(tok * D + C[i] * 2); }
    }
};
struct ProbMoe2 {
    static constexpr bool FP8 = true;
    const fp8_t* ACT; const fp8_t* W2T; const LAS int* tpre; const LAS unsigned char* texp; int scale_w, scale_x; pg8::TileOrder ord;
    __device__ __forceinline__ int ldb_bytes() const { return D; }
    __device__ __forceinline__ int ntiles() const { return D / 128; }
    __device__ __forceinline__ bool next(int i, Unit& u) const {
        if (!ord.next(i, u.pm, u.pn)) return false;
        u.rt = u.pm; u.e = texp[u.rt]; return true;
    }
    __device__ __forceinline__ const char* a_ptr(const Unit& u) const { return (const char*)(ACT + (size_t)u.rt * 256 * D); }
    __device__ __forceinline__ const char* b_ptr(const Unit& u) const { return (const char*)(W2T + ((size_t)u.e * 1024 + (size_t)u.pn * 256) * D); }
    __device__ __forceinline__ void list_prefetch(const Unit&, int, int, int) const {}
    __device__ __forceinline__ void a_off(const Unit&, int, const int (&R)[2], const int (&C)[2], unsigned (&v)[2][2]) const {
#pragma unroll
        for (int h = 0; h < 2; ++h)
#pragma unroll
            for (int i = 0; i < 2; ++i) v[h][i] = (unsigned)((h * 128 + R[i]) * D + C[i] * 2);
    }
};
struct Args { const float* in[38]; float* out; unsigned char* ws; int phase; int one; };
enum { I_X = 0, I_C, I_CTX, I_CCTX, I_ADAW, I_ADAB, I_NORMG, I_AWQKV, I_ABQKV, I_AWO, I_ABO, I_ASINK, I_PW, I_PB, I_PS,
       I_RMIX, I_RWRKV, I_RW0, I_RW1, I_RW2, I_RA0, I_RA1, I_RA2, I_RG1, I_RG2, I_RKK, I_RKA, I_RRK, I_RLNW, I_RLNB, I_RWO,
       I_MWR, I_MBR, I_MW1, I_MB1, I_MW2, I_MB2, I_FG };
struct Frame { LAS unsigned char* lds; int tid, lane, wave, G, c; unsigned char* ws; unsigned* ctl; };
#define WSP(T_, off) ((T_*)(F.ws + (off)))

struct TJob { const float* src; unsigned char* dst; long sbs, dbs; int ldw, ldt, nkb, nnb, mode, item0, per, esz; };
__device__ __forceinline__ int dst_row(int mode, int n) {
    if (mode == 1) { const int hb = n & ~63, d = n & 63; const int ax = d >> 5, dd = d & 31, hf = dd >> 4, f = dd & 15; const int g = ax * 4 + (f >> 2), i = (f & 3) + 4 * hf; return hb + 8 * g + i; }
    if (mode == 2) { return n < 1024 ? ((n >> 7) << 8) + (n & 127) : (((n - 1024) >> 7) << 8) + 128 + (n & 127); }
    return n;
}
struct TItem { const float* src; unsigned char* dst; int ldw, ldt, mode, n0, esz; };
__device__ __forceinline__ void titem_decode(const LAS TJob* jobs, int nj, int it, TItem& T) {
    int ji = 0;
    for (int q = 1; q < nj; ++q) ji += (jobs[q].item0 <= it) ? 1 : 0;
    const LAS TJob& J = jobs[ji]; const int r = it - J.item0, bi = r / J.per, rr = r % J.per, kb = rr / J.nnb, nb = rr % J.nnb;
    T.src = J.src + bi * J.sbs + (size_t)(64 * kb) * J.ldw + 32 * nb; T.dst = J.dst + (bi * J.dbs + 64 * kb) * J.esz; T.ldw = J.ldw; T.ldt = J.ldt; T.mode = J.mode; T.n0 = 32 * nb; T.esz = J.esz;
}
__device__ __forceinline__ void titem_load(const TItem& T, int lane, f32x4 (&v)[8]) {
    const float* p = T.src + (size_t)(lane >> 3) * T.ldw + 4 * (lane & 7);
#pragma unroll
    for (int i = 0; i < 8; ++i) v[i] = *(const f32x4*)(p + (size_t)(8 * i) * T.ldw);
}
__device__ __forceinline__ void titem_store(const TItem& T, int lane, const f32x4 (&v)[8], LAS float* scr) {
#pragma unroll
    for (int i = 0; i < 8; ++i) { LAS float* d = scr + (8 * i + (lane >> 3)) * 33 + 4 * (lane & 7); d[0] = v[i].x; d[1] = v[i].y; d[2] = v[i].z; d[3] = v[i].w; }
    LDS_WAIT(); asm volatile("" ::: "memory");
    const int c = lane & 7;
#pragma unroll
    for (int j = 0; j < 4; ++j) { const int n = (lane >> 3) + 8 * j; const LAS float* s = scr + (8 * c) * 33 + n;
        const size_t eo = (size_t)dst_row(T.mode, T.n0 + n) * T.ldt + 8 * c;
        if (T.esz == 2) { u32x4 o; o.x = pk2(s[0 * 33], s[1 * 33]); o.y = pk2(s[2 * 33], s[3 * 33]); o.z = pk2(s[4 * 33], s[5 * 33]); o.w = pk2(s[6 * 33], s[7 * 33]); *(u32x4*)(T.dst + eo * 2) = o; }
        else { u32x2 o; o.x = pk4_fp8(64.f * s[0 * 33], 64.f * s[1 * 33], 64.f * s[2 * 33], 64.f * s[3 * 33]); o.y = pk4_fp8(64.f * s[4 * 33], 64.f * s[5 * 33], 64.f * s[6 * 33], 64.f * s[7 * 33]); *(u32x2*)(T.dst + eo) = o; } }
    LDS_WAIT(); asm volatile("" ::: "memory");
}
__device__ __forceinline__ void phase_prologue(Frame& F, const Args& A) {
    REFRESH(F);
    LAS float* S = (LAS float*)F.lds;
    for (int idx = F.tid; idx < 33 * 1024; idx += NTHREADS) { const int r = idx >> 10, k = idx & 1023; const float v = r < 32 ? A.in[I_C][r * 1024 + k] : A.in[I_CCTX][k]; S[k * 33 + r] = v / (1.0f + __expf(-v)); }
    __syncthreads();
    float* MOD = WSP(float, WS_MOD);
    for (int it = F.c; it < 4 * 96; it += F.G) {
        const int layer = it / 96, n = (it % 96) * 64 + F.lane; const float* wp = A.in[I_ADAW] + (size_t)layer * 1024 * 6144 + n;
        float acc[5] = {0.f, 0.f, 0.f, 0.f, 0.f};
        for (int k0 = 0; k0 < 1024; k0 += 32) {
            float wv[32];
#pragma unroll
            for (int u = 0; u < 32; ++u) wv[u] = wp[(size_t)(k0 + u) * 6144];
#pragma unroll
            for (int u = 0; u < 32; ++u) { const LAS float* sr = S + (k0 + u) * 33 + F.wave;
                acc[0] += sr[0] * wv[u]; acc[1] += sr[8] * wv[u]; acc[2] += sr[16] * wv[u]; acc[3] += sr[24] * wv[u]; if (F.wave == 0) acc[4] += S[(k0 + u) * 33 + 32] * wv[u]; }
        }
        const float bb = A.in[I_ADAB][layer * 6144 + n];
#pragma unroll
        for (int i = 0; i < 4; ++i) MOD[((size_t)layer * 33 + F.wave + 8 * i) * 6144 + n] = acc[i] + bb;
        if (F.wave == 0) MOD[((size_t)layer * 33 + 32) * 6144 + n] = acc[4] + bb;
    }
    { float* rc = WSP(float, WS_ROPEC); float* rs = WSP(float, WS_ROPES);
      for (int idx = F.c * NTHREADS + F.tid; idx < 2048 * 32; idx += F.G * NTHREADS) { const int t = idx >> 5, e = idx & 31, g = e >> 2, i = e & 3, f = 4 * (g & 3) + i;
          const float inv = powf(10000.0f, -(float)f / 16.0f); const float pos = (float)(g < 4 ? (t >> 6) : (t & 63)); const float ang = pos * inv; rc[idx] = cosf(ang); rs[idx] = sinf(ang); }
      float* bq = WSP(float, WS_BQK);
      for (int idx = F.c * NTHREADS + F.tid; idx < 2 * 1280; idx += F.G * NTHREADS) { const int j = idx / 1280, n = idx % 1280; bq[j * 1280 + dst_row(1, n)] = A.in[I_ABQKV][j * 1536 + n]; } }
    __syncthreads();
    LAS TJob* jobs = (LAS TJob*)(F.lds + JOB_OFF); LAS int* njobs = (LAS int*)(F.lds + MISC_OFF + 64);
    if (F.tid == 0) {
        int nj = 0, item = 0;
        auto add = [&](const float* src, bf16_t* dst, int ldw, int ldt, int Ks, int Ns, int mode, int nb, long sbs, long dbs, int esz = 2) {
            LAS TJob& j = jobs[nj]; j.src = src; j.dst = (unsigned char*)dst; j.sbs = sbs; j.dbs = dbs; j.ldw = ldw; j.ldt = ldt; j.nkb = Ks / 64; j.nnb = Ns / 32; j.mode = mode; j.item0 = item; j.per = (Ks / 64) * (Ns / 32); j.esz = esz;
            ++nj; item += (Ks / 64) * (Ns / 32) * nb; };
        add(A.in[I_AWQKV], WSP(bf16_t, WS_WQK), 1536, 1024, 1024, 1280, 1, 2, 1024L * 1536, 1280L * 1024, 1);
        add(A.in[I_AWQKV] + 1280, WSP(bf16_t, WS_WV), 1536, 1024, 1024, 256, 0, 2, 1024L * 1536, 256L * 1024, 1);
        add(A.in[I_AWO], WSP(bf16_t, WS_WO), 1024, 1024, 1024, 1024, 0, 2, 1L << 20, 1L << 20, 1);
        add(A.in[I_PW], WSP(bf16_t, WS_POOLW), 256, 256, 256, 256, 0, 4, 65536, 65536);
        add(A.in[I_RWRKV], WSP(bf16_t, WS_WRKV), 1024, 1024, 1024, 1024, 0, 3, 1L << 20, 1L << 20, 1);
        add(A.in[I_RG1], WSP(bf16_t, WS_WL1), 128, 1024, 1024, 128, 0, 1, 0, 0);
        add(A.in[I_RW1], WSP(bf16_t, WS_WL1) + 256 * 1024, 64, 1024, 1024, 64, 0, 2, 65536, 65536);
        add(A.in[I_RA1], WSP(bf16_t, WS_WL1) + 2 * 256 * 1024, 64, 1024, 1024, 64, 0, 2, 65536, 65536);
        add(A.in[I_RG2], WSP(bf16_t, WS_WL2), 1024, 256, 128, 1024, 0, 1, 0, 0);
        add(A.in[I_RW2], WSP(bf16_t, WS_WL2) + 1 * 1024 * 256, 1024, 256, 64, 1024, 0, 2, 65536, 1024L * 256 + 64);
        add(A.in[I_RA2], WSP(bf16_t, WS_WL2) + 3 * 1024 * 256, 1024, 256, 64, 1024, 0, 2, 65536, 1024L * 256 + 64);
        add(A.in[I_RWO], WSP(bf16_t, WS_WOR), 1024, 1024, 1024, 1024, 0, 1, 0, 0, 1);
        add(A.in[I_MW1], WSP(bf16_t, WS_W1T), 2048, 1024, 1024, 2048, 2, 128, 1024L * 2048, 2048L * 1024, 1);
        add(A.in[I_MW2], WSP(bf16_t, WS_W2T), 1024, 1024, 1024, 1024, 0, 128, 1L << 20, 1L << 20, 1);
        njobs[0] = nj; njobs[1] = item;
    }
    __syncthreads();
    { const int nj = njobs[0], nitems = njobs[1]; LAS float* scr = (LAS float*)(F.lds + F.wave * 16384);
      const int gw = F.c * NWAVES + F.wave, NGW = F.G * NWAVES;
      int it = gw;
      if (it < nitems) {
          TItem Tc, Tn; f32x4 vc[8], vn[8];
          titem_decode(jobs, nj, it, Tc); titem_load(Tc, F.lane, vc);
          for (;;) {
              const int itn = it + NGW; const bool more = itn < nitems;
              if (more) { titem_decode(jobs, nj, itn, Tn); titem_load(Tn, F.lane, vn); }
              titem_store(Tc, F.lane, vc, scr);
              if (!more) break;
              Tc = Tn;
#pragma unroll
              for (int i = 0; i < 8; ++i) vc[i] = vn[i];
              it = itn;
          }
      } }
    __syncthreads();
}

__device__ __forceinline__ void moe_tiles(Frame& F, int layer) {
    REFRESH(F);
    LAS int* lcnt = (LAS int*)(F.lds + LCNT_OFF); LAS int* tpre = (LAS int*)(F.lds + TPRE_OFF);
    __syncthreads();
    if (F.tid < NE) lcnt[F.tid] = (int)__hip_atomic_load(F.ctl + CW_GCNT + layer * 64 + F.tid, __ATOMIC_RELAXED, __HIP_MEMORY_SCOPE_AGENT);
    __syncthreads();
    if (F.tid == 0) { int s = 0; for (int e = 0; e < NE; ++e) { tpre[e] = s; s += (lcnt[e] + 255) >> 8; } tpre[NE] = s; }
    __syncthreads();
    { LAS unsigned char* texp = (LAS unsigned char*)(F.lds + TEXP_OFF); const int nrt = tpre[NE];
      for (int rt = F.tid; rt < nrt; rt += NTHREADS) { int e = 0; for (int j = 1; j < NE; ++j) e += (tpre[j] <= rt) ? 1 : 0; texp[rt] = (unsigned char)e; } }
    __syncthreads();
}
constexpr int RB = 2;
#define ROWOF(it, r) ((((it) * F.G + F.c) * NWAVES + F.wave) * RB + (r))
struct MoeRef { int p[4]; float g[4]; };
__device__ __forceinline__ void moe_ref_load(Frame& F, int row, MoeRef& R) {
    const int4 pp = *(const int4*)(WSP(int, WS_POS) + (size_t)row * 4); const f32x4 gg = *(const f32x4*)(WSP(float, WS_GATE) + (size_t)row * 4);
    R.p[0] = pp.x; R.p[1] = pp.y; R.p[2] = pp.z; R.p[3] = pp.w; R.g[0] = gg.x; R.g[1] = gg.y; R.g[2] = gg.z; R.g[3] = gg.w;
}
__device__ __forceinline__ void moe_rows_load(Frame& F, const MoeRef& R, u32x2 (&y)[4][4]) {
    const LAS int* tpre = (const LAS int*)(F.lds + TPRE_OFF); const bf16_t* Y = WSP(bf16_t, WS_Y);
#pragma unroll
    for (int k = 0; k < 4; ++k) { const int e = R.p[k] >> 20, slot = R.p[k] & 0xfffff; const size_t fr = (size_t)tpre[e] * 256 + slot; const u32x2* yp = (const u32x2*)(Y + fr * D) + F.lane;
#pragma unroll
        for (int j = 0; j < 4; ++j) y[k][j] = yp[64 * j]; }
}
__device__ __forceinline__ f32x4 moe_rows_sum(const MoeRef& R, const u32x2 (&y)[4][4], int j) {
    f32x4 s = (f32x4){0.f, 0.f, 0.f, 0.f};
#pragma unroll
    for (int k = 0; k < 4; ++k) { const u32x2 w = y[k][j]; s += R.g[k] * (f32x4){bflo(w.x), bfhi(w.x), bflo(w.y), bfhi(w.y)}; }
    return s;
}

__device__ __forceinline__ void phase_norm1(Frame& F, const Args& A, int layer) {
    REFRESH(F);
    if (layer > 0) moe_tiles(F, layer - 1);
    bf16_t* H = WSP(bf16_t, WS_H); bf16_t* AX = WSP(bf16_t, WS_AX); const float* MOD = WSP(float, WS_MOD);
    const float* g1 = A.in[I_NORMG] + (size_t)(layer * 2 + 0) * D;
    f32x4 gg[4];
#pragma unroll
    for (int j = 0; j < 4; ++j) gg[j] = ((const f32x4*)g1)[64 * j + F.lane];
    for (int it = 0;; ++it) { if (ROWOF(it, 0) >= NT) break;
        f32x4 v[RB][4]; int brow[RB];
        if (layer == 0) {
#pragma unroll
            for (int r = 0; r < RB; ++r) { const int row = ROWOF(it, r); brow[r] = row < NX ? (row >> 11) : 32; const float* src = row < NX ? A.in[I_X] + (size_t)row * D : A.in[I_CTX] + (size_t)(row - NX) * D;
#pragma unroll
                for (int j = 0; j < 4; ++j) v[r][j] = ((const f32x4*)src)[64 * j + F.lane]; }
        } else {
            MoeRef R[RB]; u32x2 y[RB][4][4]; f32x4 gv[RB][4];
#pragma unroll
            for (int r = 0; r < RB; ++r) moe_ref_load(F, ROWOF(it, r), R[r]);
#pragma unroll
            for (int r = 0; r < RB; ++r) { const int row = ROWOF(it, r); brow[r] = row < NX ? (row >> 11) : 32; moe_rows_load(F, R[r], y[r]);
                const float* g2p = MOD + ((size_t)(layer - 1) * 33 + brow[r]) * 6144 + 5 * D;
#pragma unroll
                for (int j = 0; j < 4; ++j) { v[r][j] = ld_bf4(H + (size_t)row * D + 256 * j + 4 * F.lane); gv[r][j] = ((const f32x4*)g2p)[64 * j + F.lane]; } }
#pragma unroll
            for (int r = 0; r < RB; ++r)
#pragma unroll
                for (int j = 0; j < 4; ++j) v[r][j] = v[r][j] + gv[r][j] * moe_rows_sum(R[r], y[r], j);
        }
        float rstd[RB];
#pragma unroll
        for (int r = 0; r < RB; ++r) { const int row = ROWOF(it, r); float ss = 0.f;
#pragma unroll
            for (int j = 0; j < 4; ++j) { st_bf4(H + (size_t)row * D + 256 * j + 4 * F.lane, v[r][j]); ss += (v[r][j].x * v[r][j].x + v[r][j].y * v[r][j].y) + (v[r][j].z * v[r][j].z + v[r][j].w * v[r][j].w); }
            rstd[r] = 1.0f / sqrtf(wave_sum(ss) * (1.0f / D) + 1e-5f); }
#pragma unroll
        for (int r = 0; r < RB; ++r) { const int row = ROWOF(it, r); const float* mp = MOD + ((size_t)layer * 33 + brow[r]) * 6144;
#pragma unroll
            for (int j = 0; j < 4; ++j) { const f32x4 sh = ((const f32x4*)mp)[64 * j + F.lane], sc = ((const f32x4*)(mp + D))[64 * j + F.lane];
                const f32x4 o = v[r][j] * rstd[r] * gg[j] * (sc + 1.0f) + sh;
                if (layer % 3 == 0) ((unsigned*)((unsigned char*)AX + (size_t)row * D))[64 * j + F.lane] = pk4_fp8(o.x, o.y, o.z, o.w);
                else { u32x2 w; w.x = pk2(o.x, o.y); w.y = pk2(o.z, o.w); ((u32x2*)(AX + (size_t)row * D))[64 * j + F.lane] = w; } } }
    }
}
__device__ __forceinline__ void phase_final(Frame& F, const Args& A) {
    REFRESH(F);
    moe_tiles(F, DEPTH - 1);
    const bf16_t* H = WSP(bf16_t, WS_H); const float* MOD = WSP(float, WS_MOD); const float* fg = A.in[I_FG];
    f32x4 gg[4];
#pragma unroll
    for (int j = 0; j < 4; ++j) gg[j] = ((const f32x4*)fg)[64 * j + F.lane];
    for (int it = 0;; ++it) { if (ROWOF(it, 0) >= NX) break;
        MoeRef R[RB]; u32x2 y[RB][4][4]; f32x4 v[RB][4], gv[RB][4];
#pragma unroll
        for (int r = 0; r < RB; ++r) moe_ref_load(F, ROWOF(it, r), R[r]);
#pragma unroll
        for (int r = 0; r < RB; ++r) { const int row = ROWOF(it, r); moe_rows_load(F, R[r], y[r]); const float* g2p = MOD + ((size_t)(DEPTH - 1) * 33 + (row >> 11)) * 6144 + 5 * D;
#pragma unroll
            for (int j = 0; j < 4; ++j) { v[r][j] = ld_bf4(H + (size_t)row * D + 256 * j + 4 * F.lane); gv[r][j] = ((const f32x4*)g2p)[64 * j + F.lane]; } }
#pragma unroll
        for (int r = 0; r < RB; ++r) { const int row = ROWOF(it, r); float ss = 0.f;
#pragma unroll
            for (int j = 0; j < 4; ++j) { v[r][j] = v[r][j] + gv[r][j] * moe_rows_sum(R[r], y[r], j); ss += (v[r][j].x * v[r][j].x + v[r][j].y * v[r][j].y) + (v[r][j].z * v[r][j].z + v[r][j].w * v[r][j].w); }
            const float rstd = 1.0f / sqrtf(wave_sum(ss) * (1.0f / D) + 1e-5f);
#pragma unroll
            for (int j = 0; j < 4; ++j) ((f32x4*)(A.out + (size_t)row * D))[64 * j + F.lane] = v[r][j] * rstd * gg[j]; }
    }
}

template <int DD> __device__ __forceinline__ float dpp_ror(float v) { return __builtin_bit_cast(float, __builtin_amdgcn_update_dpp(0, __builtin_bit_cast(int, v), 0x120 + DD, 0xf, 0xf, false)); }
template <int DD> __device__ __forceinline__ void rank_step(float v0, float v1, int e0, int& r0, int& r1) {
    const float u0 = dpp_ror<DD>(v0), u1 = dpp_ror<DD>(v1); const bool low = DD <= e0;
    r0 += (u0 > v0 || (u0 == v0 && low)) ? 1 : 0; r0 += (u1 > v0) ? 1 : 0;
    r1 += (u0 >= v1) ? 1 : 0; r1 += (u1 > v1 || (u1 == v1 && low)) ? 1 : 0;
}
__device__ __forceinline__ float row_allmax(float v) { v = fmaxf(v, dpp_ror<8>(v)); v = fmaxf(v, dpp_ror<4>(v)); v = fmaxf(v, dpp_ror<2>(v)); v = fmaxf(v, dpp_ror<1>(v)); return v; }
__device__ __forceinline__ float row_allsum(float v) { v += dpp_ror<8>(v); v += dpp_ror<4>(v); v += dpp_ror<2>(v); v += dpp_ror<1>(v); return v; }
__device__ __forceinline__ void phase_route(Frame& F, const Args& A, int layer) {
    REFRESH(F);
    const int nrows = (layer == DEPTH - 1) ? NX : NT; const int TPB = nrows / 16 / F.G;
    LAS float* wT = (LAS float*)F.lds;
    LAS int* lcnt = (LAS int*)(F.lds + LCNT_OFF); LAS int* lbase = (LAS int*)(F.lds + LBASE_OFF);
    LAS unsigned* recp = (LAS unsigned*)(F.lds + REC_OFF); LAS float* recg = (LAS float*)(F.lds + REC_OFF + 4608);
    __syncthreads();
    { const float* wr = A.in[I_MWR] + (size_t)layer * D * NE;
      for (int idx = F.tid; idx < D * NE; idx += NTHREADS) wT[(idx & 31) * 1024 + (idx >> 5)] = wr[idx]; }
    if (F.tid < NE) lcnt[F.tid] = 0;
    __syncthreads();
    const bf16_t* H = WSP(bf16_t, WS_H); unsigned char* FX = WSP(unsigned char, WS_FX); const float* MOD = WSP(float, WS_MOD);
    const float* g2 = A.in[I_NORMG] + (size_t)(layer * 2 + 1) * D; const float* br = A.in[I_MBR] + layer * NE;
    const int l = F.lane, r16 = l & 15, q4 = l >> 4; const float b0 = br[r16], b1 = br[16 + r16];
    for (int k = F.wave; k < TPB; k += NWAVES) {
        const int row0 = (F.c * TPB + k) * 16, row = row0 + r16; const int brow = row0 < NX ? (row0 >> 11) : 32;
        const float* mp = MOD + ((size_t)layer * 33 + brow) * 6144 + 3 * D;
        const bf16_t* hp = H + (size_t)row * D + 8 * q4; float ss = 0.f;
#pragma unroll 8
        for (int j = 0; j < 32; ++j) { const u32x4 w = *(const u32x4*)(hp + 32 * j); const float a0 = bflo(w.x), a1 = bfhi(w.x), a2 = bflo(w.y), a3 = bfhi(w.y), a4 = bflo(w.z), a5 = bfhi(w.z), a6 = bflo(w.w), a7 = bfhi(w.w);
            ss += ((a0 * a0 + a1 * a1) + (a2 * a2 + a3 * a3)) + ((a4 * a4 + a5 * a5) + (a6 * a6 + a7 * a7)); }
        ss += __shfl_xor(ss, 16); ss += __shfl_xor(ss, 32);
        const float rstd = 1.0f / sqrtf(ss * (1.0f / D) + 1e-5f);
        f32x4 acc0 = (f32x4){0.f, 0.f, 0.f, 0.f}, acc1 = acc0;
        const float* gp = g2 + 8 * q4; const float* shp = mp + 8 * q4; const float* scp = mp + D + 8 * q4; unsigned char* fxp = FX + (size_t)row * D + 8 * q4;
        const LAS float* w0p = wT + r16 * 1024 + 8 * q4; const LAS float* w1p = wT + (16 + r16) * 1024 + 8 * q4;
#pragma unroll 2
        for (int j = 0; j < 32; ++j) { const u32x4 w = *(const u32x4*)(hp + 32 * j);
            const f32x4 ga = *(const f32x4*)(gp + 32 * j), gb = *(const f32x4*)(gp + 32 * j + 4), sa = *(const f32x4*)(shp + 32 * j), sb = *(const f32x4*)(shp + 32 * j + 4), ca = *(const f32x4*)(scp + 32 * j), cb = *(const f32x4*)(scp + 32 * j + 4);
            const f32x4 fa = (f32x4){bflo(w.x), bfhi(w.x), bflo(w.y), bfhi(w.y)} * rstd * ga * (ca + 1.0f) + sa, fb = (f32x4){bflo(w.z), bfhi(w.z), bflo(w.w), bfhi(w.w)} * rstd * gb * (cb + 1.0f) + sb;
            *(u32x2*)(fxp + 32 * j) = (u32x2){pk4_fp8(fa.x, fa.y, fa.z, fa.w), pk4_fp8(fb.x, fb.y, fb.z, fb.w)};
            const f32x4 w0a = *(const LAS f32x4*)(w0p + 32 * j), w0b = *(const LAS f32x4*)(w0p + 32 * j + 4), w1a = *(const LAS f32x4*)(w1p + 32 * j), w1b = *(const LAS f32x4*)(w1p + 32 * j + 4);
#pragma unroll
            for (int s4 = 0; s4 < 4; ++s4) { acc0 = __builtin_amdgcn_mfma_f32_16x16x4f32(fa[s4], w0a[s4], acc0, 0, 0, 0); acc1 = __builtin_amdgcn_mfma_f32_16x16x4f32(fa[s4], w1a[s4], acc1, 0, 0, 0); }
#pragma unroll
            for (int s4 = 0; s4 < 4; ++s4) { acc0 = __builtin_amdgcn_mfma_f32_16x16x4f32(fb[s4], w0b[s4], acc0, 0, 0, 0); acc1 = __builtin_amdgcn_mfma_f32_16x16x4f32(fb[s4], w1b[s4], acc1, 0, 0, 0); } }
#pragma unroll
        for (int reg = 0; reg < 4; ++reg) {
            const float v0 = acc0[reg] + b0, v1 = acc1[reg] + b1; int r0 = (v1 > v0) ? 1 : 0, r1 = (v0 >= v1) ? 1 : 0;
            rank_step<1>(v0, v1, r16, r0, r1); rank_step<2>(v0, v1, r16, r0, r1); rank_step<3>(v0, v1, r16, r0, r1); rank_step<4>(v0, v1, r16, r0, r1); rank_step<5>(v0, v1, r16, r0, r1);
            rank_step<6>(v0, v1, r16, r0, r1); rank_step<7>(v0, v1, r16, r0, r1); rank_step<8>(v0, v1, r16, r0, r1); rank_step<9>(v0, v1, r16, r0, r1); rank_step<10>(v0, v1, r16, r0, r1);
            rank_step<11>(v0, v1, r16, r0, r1); rank_step<12>(v0, v1, r16, r0, r1); rank_step<13>(v0, v1, r16, r0, r1); rank_step<14>(v0, v1, r16, r0, r1); rank_step<15>(v0, v1, r16, r0, r1);
            const float mx = row_allmax(fmaxf(v0, v1));
            const float x0 = r0 < 4 ? __expf(v0 - mx) : 0.f, x1 = r1 < 4 ? __expf(v1 - mx) : 0.f;
            const float inv = 1.0f / row_allsum(x0 + x1);
            const int lr = k * 16 + 4 * q4 + reg;
            if (r0 < 4) { const int rk = __hip_atomic_fetch_add(lcnt + r16, 1, __ATOMIC_RELAXED, __HIP_MEMORY_SCOPE_WORKGROUP); recp[lr * 4 + r0] = ((unsigned)r16 << 20) | (unsigned)rk; recg[lr * 4 + r0] = x0 * inv; }
            if (r1 < 4) { const int rk = __hip_atomic_fetch_add(lcnt + 16 + r16, 1, __ATOMIC_RELAXED, __HIP_MEMORY_SCOPE_WORKGROUP); recp[lr * 4 + r1] = ((unsigned)(16 + r16) << 20) | (unsigned)rk; recg[lr * 4 + r1] = x1 * inv; }
        }
    }
    __syncthreads();
    if (F.tid < NE) lbase[F.tid] = (int)__hip_atomic_fetch_add(F.ctl + CW_GCNT + layer * 64 + F.tid, (unsigned)lcnt[F.tid], __ATOMIC_RELAXED, __HIP_MEMORY_SCOPE_AGENT);
    __syncthreads();
    int* LIST = WSP(int, WS_LIST); int* POS = WSP(int, WS_POS); float* GATE = WSP(float, WS_GATE);
    for (int r = F.tid; r < TPB * 16 * 4; r += NTHREADS) { const int lr = r >> 2, kk = r & 3; const int row = F.c * TPB * 16 + lr;
        const unsigned qx = recp[r]; const float qg = recg[r]; const int e = qx >> 20, slot = lbase[e] + (int)(qx & 0xfffff);
        LIST[(size_t)e * NT + slot] = row; POS[(size_t)row * 4 + kk] = (e << 20) | slot; GATE[(size_t)row * 4 + kk] = qg; }
    __syncthreads();
}

__device__ __forceinline__ void phase_pooldiff(Frame& F) {
    REFRESH(F);
    const bf16_t* AX = WSP(bf16_t, WS_AX); bf16_t* PD = WSP(bf16_t, WS_PD);
    for (int it = 0;; ++it) { if (ROWOF(it, 0) >= NT) break;
        const int row0 = ROWOF(it, 0); int sb, t, n; seq_of(row0, sb, t, n);
#pragma unroll
        for (int j = 0; j < 4; ++j) { const int half = 1 << j; const int col = 256 * j + 4 * F.lane;
            f32x4 s0 = (f32x4){0.f, 0.f, 0.f, 0.f}, s1 = s0, me0 = s0, me1 = s0;
#pragma unroll
            for (int q = 0; q < 2 * half + 1; ++q) { const int uu = t - half + q;
                if (uu >= 0 && uu < n) { const f32x4 x = ld_bf4(AX + (size_t)(sb + uu) * D + col); if (q < 2 * half) s0 += x; if (q > 0) s1 += x; if (q == half) me0 = x; if (q == half + 1) me1 = x; } }
            const int lo0 = t - half < 0 ? 0 : t - half, hi0 = t + half > n ? n : t + half, lo1 = t + 1 - half < 0 ? 0 : t + 1 - half, hi1 = t + 1 + half > n ? n : t + 1 + half;
            st_bf4(PD + (size_t)row0 * D + col, s0 * (1.0f / (float)(hi0 - lo0)) - me0);
            st_bf4(PD + (size_t)(row0 + 1) * D + col, s1 * (1.0f / (float)(hi1 - lo1)) - me1); }
    }
}
__device__ __forceinline__ void phase_rwkv_mix(Frame& F, const Args& A) {
    REFRESH(F);
    const bf16_t* AX = WSP(bf16_t, WS_AX); bf16_t* A6 = WSP(bf16_t, WS_A6); const float* mix = A.in[I_RMIX];
    for (int it = 0;; ++it) { if (ROWOF(it, 0) >= NT) break;
        const int row0 = ROWOF(it, 0); int sb, t, n; seq_of(row0, sb, t, n);
#pragma unroll
        for (int j = 0; j < 4; ++j) { const int col = 256 * j + 4 * F.lane; const f32x4 z = (f32x4){0.f, 0.f, 0.f, 0.f};
            const f32x4 h0 = ld_bf4(AX + (size_t)row0 * D + col), h1 = ld_bf4(AX + (size_t)(row0 + 1) * D + col);
            const f32x4 hp = t > 0 ? ld_bf4(AX + (size_t)(row0 - 1) * D + col) : z, hn = t + 1 < n - 1 ? ld_bf4(AX + (size_t)(row0 + 2) * D + col) : z;
            const f32x4 xx0 = (hp + h1) * 0.5f - h0, xx1 = (h0 + hn) * 0.5f - h1;
#pragma unroll
            for (int i = 0; i < 6; ++i) { const f32x4 m = *(const f32x4*)(mix + i * D + col); const f32x4 o0 = h0 + xx0 * m, o1 = h1 + xx1 * m;
                if (i == 0 || i == 2 || i == 3) { unsigned char* p8 = (unsigned char*)(A6 + (size_t)i * NT * D);
                    *(unsigned*)(p8 + (size_t)row0 * D + col) = pk4_fp8(o0.x, o0.y, o0.z, o0.w); *(unsigned*)(p8 + (size_t)(row0 + 1) * D + col) = pk4_fp8(o1.x, o1.y, o1.z, o1.w); }
                else { st_bf4(A6 + ((size_t)i * NT + row0) * D + col, o0); st_bf4(A6 + ((size_t)i * NT + row0 + 1) * D + col, o1); } } }
    }
}
__device__ __forceinline__ float rl(float x, int k) { return __builtin_bit_cast(float, __builtin_amdgcn_readlane(__builtin_bit_cast(int, x), k)); }
typedef float f32x16 __attribute__((ext_vector_type(16)));
constexpr int SCW = 33792;
__device__ __forceinline__ int kpos(int k) { return (k & ~12) | ((k & 4) << 1) | ((k & 8) >> 1); }
__device__ __forceinline__ bf16x8 acc_frag(const f32x16& X, int s2) {
    u32x4 w; w.x = cvt_pk_bf16(X[8 * s2 + 0], X[8 * s2 + 1]); w.y = cvt_pk_bf16(X[8 * s2 + 2], X[8 * s2 + 3]); w.z = cvt_pk_bf16(X[8 * s2 + 4], X[8 * s2 + 5]); w.w = cvt_pk_bf16(X[8 * s2 + 6], X[8 * s2 + 7]);
    return __builtin_bit_cast(bf16x8, w);
}
#define MFMA32(a, b, c) __builtin_amdgcn_mfma_f32_32x32x16_bf16(a, b, c, 0, 0, 0)
__device__ __forceinline__ void phase_rwkv_scan(Frame& F, const Args& A) {
    REFRESH(F);
    __syncthreads();
    const int pr = F.wave >> 1, hw = F.wave & 1;
    for (int item = pr * F.G + F.c; item < 1024; item += 4 * F.G) {
        const int dir = item >> 9, b = (item >> 4) & 31, hd = item & 15, col = 64 * hd + F.lane;
        const int l = F.lane, r32 = l & 31, hh = l >> 5;
        const bf16_t* Rr = WSP(bf16_t, WS_RKV); const bf16_t* Kk = Rr + (size_t)NT * D; const bf16_t* Vv = Kk + (size_t)NT * D;
        const bf16_t* Ee = WSP(bf16_t, WS_E) + (size_t)dir * NT * D; const bf16_t* Aa = WSP(bf16_t, WS_A) + (size_t)dir * NT * D;
        float* Yo = WSP(float, WS_YS) + (size_t)dir * NT * D; float* Bo = WSP(float, WS_BONUS) + (size_t)dir * NT * 16;
        const float kkw = A.in[I_RKK][col], kaw = A.in[I_RKA][col], rkw = A.in[I_RRK][col];
        LAS unsigned char* RA = F.lds + pr * SCW; LAS unsigned char* RB = RA + 16384; LAS unsigned char* RV = RA + 25600;
        LAS float* cCb = (LAS float*)(F.lds + REC_OFF + pr * 256);
        LAS bf16_t* XT = (LAS bf16_t*)RA;
        LAS bf16_t* BK = (LAS bf16_t*)(RA + 8192);
        const int kp = kpos(l), vb = hw;
        f32x16 ST[2];
#pragma unroll
        for (int i = 0; i < 2; ++i)
#pragma unroll
            for (int q = 0; q < 16; ++q) ST[i][q] = 0.f;
        for (int seg = 0; seg < 2; ++seg) {
            const int base = seg ? b * T : NX + b * L, n = seg ? T : L; const int dt = dir ? -1 : 1; const int t0 = dir ? n - 1 : 0;
            for (int bt = 0; bt < n; bt += 32) {
                float cprev = 1.0f;
                if (hw) {
                    bf16_t e16[16];
#pragma unroll
                    for (int s = 0; s < 16; ++s) e16[s] = Ee[(size_t)(base + t0 + dt * (bt + s)) * D + col];
                    float es = 0.f;
#pragma unroll
                    for (int s = 0; s < 16; ++s) es += bf1(e16[s]);
                    cprev = __expf(-es); }
#pragma unroll
                for (int g4i = 0; g4i < 4; ++g4i) { const int g8 = 4 * hw + g4i;
                    bf16_t raw[4][5];
#pragma unroll
                    for (int s8 = 0; s8 < 4; ++s8) { const size_t o = (size_t)(base + t0 + dt * (bt + g8 * 4 + s8)) * D + col; raw[s8][0] = Rr[o]; raw[s8][1] = Kk[o]; raw[s8][2] = Vv[o]; raw[s8][3] = Aa[o]; raw[s8][4] = Ee[o]; }
                    float rr[4], kraw[4], aa[4], kk[4], kd[4], n2[4], bn[4], ww[4]; unsigned bq2[2] = {0u, 0u}, kq2[2] = {0u, 0u};
#pragma unroll
                    for (int s8 = 0; s8 < 4; ++s8) { rr[s8] = bf1(raw[s8][0]); kraw[s8] = bf1(raw[s8][1]); aa[s8] = bf1(raw[s8][3]); ww[s8] = __expf(-bf1(raw[s8][4]));
                        kk[s8] = kraw[s8] * kkw; n2[s8] = kk[s8] * kk[s8]; kd[s8] = kraw[s8] * (1.0f + (aa[s8] - 1.0f) * kaw); bn[s8] = rr[s8] * kd[s8] * rkw; }
#pragma unroll
                    for (int s8 = 0; s8 < 4; ++s8) { n2[s8] = wave_sum(n2[s8]); bn[s8] = wave_sum(bn[s8]); }
#pragma unroll
                    for (int s8 = 0; s8 < 4; ++s8) { const int t = g8 * 4 + s8;
                        if (l == 0) Bo[(size_t)(base + t0 + dt * (bt + t)) * 16 + hd] = bn[s8];
                        const float kn = kk[s8] * __builtin_amdgcn_rsqf(fmaxf(n2[s8], 1e-24f)); const float c = cprev * ww[s8]; const float ic = __builtin_amdgcn_rcpf(c);
                        const float at = -kn * cprev, rt = rr[s8] * c, bq = kn * aa[s8] * ic, kq = kd[s8] * ic;
                        const unsigned w0 = cvt_pk_bf16(at, rt), w1 = cvt_pk_bf16(bq, kq);
                        XT[t * 64 + kp] = (bf16_t)(w0 & 0xffffu); XT[(32 + t) * 64 + kp] = (bf16_t)(w0 >> 16);
                        BK[t * 64 + kp] = (bf16_t)(w1 & 0xffffu); BK[(32 + t) * 64 + kp] = (bf16_t)(w1 >> 16);
                        if (s8 & 1) { bq2[s8 >> 1] |= (w1 & 0xffffu) << 16; kq2[s8 >> 1] |= (w1 & 0xffff0000u); } else { bq2[s8 >> 1] = w1 & 0xffffu; kq2[s8 >> 1] = w1 >> 16; }
                        cprev = c; }
                    const int gp = (g8 & ~3) | ((g8 & 1) << 1) | ((g8 & 2) >> 1);
                    *(LAS u32x2*)(RB + l * 144 + gp * 8) = (u32x2){bq2[0], bq2[1]}; *(LAS u32x2*)(RB + l * 144 + 64 + gp * 8) = (u32x2){kq2[0], kq2[1]};
                    *(LAS u32x2*)(RV + l * 80 + gp * 8) = (u32x2){(unsigned)raw[0][2] | ((unsigned)raw[1][2] << 16), (unsigned)raw[2][2] | ((unsigned)raw[3][2] << 16)};
                }
                if (hw) cCb[l] = cprev;
                __syncthreads();
                f32x16 Mp, Np, X;
                { bf16x8 XTf[4], BKf[2][4];
#pragma unroll
                  for (int s4 = 0; s4 < 4; ++s4) { XTf[s4] = *(const LAS bf16x8*)(XT + r32 * 64 + 16 * s4 + 8 * hh); BKf[0][s4] = *(const LAS bf16x8*)(BK + r32 * 64 + 16 * s4 + 8 * hh); BKf[1][s4] = *(const LAS bf16x8*)(BK + (32 + r32) * 64 + 16 * s4 + 8 * hh); }
                  bf16x8 MkaF[2];
                  { f32x16 Tm;
#pragma unroll
                    for (int q = 0; q < 16; ++q) Tm[q] = 0.f;
#pragma unroll
                    for (int s4 = 0; s4 < 4; ++s4) Tm = MFMA32(BKf[1][s4], XTf[s4], Tm);
#pragma unroll
                    for (int q = 0; q < 16; ++q) { const int row = (q & 3) + 8 * (q >> 2) + 4 * hh; Tm[q] = row < r32 ? Tm[q] : 0.f; }
                    MkaF[0] = acc_frag(Tm, 0); MkaF[1] = acc_frag(Tm, 1); }
#pragma unroll
                  for (int q = 0; q < 16; ++q) { Mp[q] = 0.f; Np[q] = 0.f; X[q] = 0.f; }
#pragma unroll
                  for (int s4 = 0; s4 < 4; ++s4) { Mp = MFMA32(BKf[0][s4], XTf[s4], Mp); Np = MFMA32(XTf[s4], BKf[0][s4], Np); }
#pragma unroll
                  for (int q = 0; q < 16; ++q) { const int row = (q & 3) + 8 * (q >> 2) + 4 * hh; Mp[q] = row < r32 ? Mp[q] : 0.f; Np[q] = r32 < row ? Np[q] : 0.f; }
#pragma unroll
                  for (int kb = 0; kb < 2; ++kb)
#pragma unroll
                      for (int s2 = 0; s2 < 2; ++s2) X = MFMA32(XTf[2 * kb + s2], acc_frag(ST[kb], s2), X);
#pragma unroll
                  for (int s2 = 0; s2 < 2; ++s2) { const bf16x8 Vf = *(const LAS bf16x8*)(RV + (32 * vb + r32) * 80 + (16 * s2 + 8 * hh) * 2); X = MFMA32(MkaF[s2], Vf, X); } }
                __builtin_amdgcn_sched_barrier(0);
#pragma unroll
                for (int lvl = 0; lvl < 5; ++lvl) {
                    bf16x8 Ma[2], Na[2];
#pragma unroll
                    for (int s2 = 0; s2 < 2; ++s2) { Ma[s2] = acc_frag(Mp, s2); Na[s2] = acc_frag(Np, s2); }
                    { const bf16x8 x0 = acc_frag(X, 0), x1 = acc_frag(X, 1); X = MFMA32(Ma[0], x0, X); X = MFMA32(Ma[1], x1, X); }
                    if (lvl < 4) { f32x16 M2, N2;
#pragma unroll
                        for (int q = 0; q < 16; ++q) { M2[q] = 0.f; N2[q] = 0.f; }
                        M2 = MFMA32(Na[0], Ma[0], M2); M2 = MFMA32(Na[1], Ma[1], M2);
                        N2 = MFMA32(Ma[0], Na[0], N2); N2 = MFMA32(Ma[1], Na[1], N2);
                        Mp = M2; Np = N2; }
                }
                __builtin_amdgcn_sched_barrier(0);
                { bf16x8 XRf[4], MbrF[2], MkrF[2];
#pragma unroll
                  for (int s4 = 0; s4 < 4; ++s4) XRf[s4] = *(const LAS bf16x8*)(XT + (32 + r32) * 64 + 16 * s4 + 8 * hh);
                  { f32x16 Tm, Tn;
#pragma unroll
                    for (int q = 0; q < 16; ++q) { Tm[q] = 0.f; Tn[q] = 0.f; }
#pragma unroll
                    for (int s4 = 0; s4 < 4; ++s4) { const bf16x8 Bb = *(const LAS bf16x8*)(BK + r32 * 64 + 16 * s4 + 8 * hh), Bk = *(const LAS bf16x8*)(BK + (32 + r32) * 64 + 16 * s4 + 8 * hh);
                        Tm = MFMA32(Bb, XRf[s4], Tm); Tn = MFMA32(Bk, XRf[s4], Tn); }
#pragma unroll
                    for (int q = 0; q < 16; ++q) { const int row = (q & 3) + 8 * (q >> 2) + 4 * hh; Tm[q] = row <= r32 ? Tm[q] : 0.f; Tn[q] = row <= r32 ? Tn[q] : 0.f; }
                    MbrF[0] = acc_frag(Tm, 0); MbrF[1] = acc_frag(Tm, 1); MkrF[0] = acc_frag(Tn, 0); MkrF[1] = acc_frag(Tn, 1); }
                  { const bf16x8 u0 = acc_frag(X, 0), u1 = acc_frag(X, 1);
                    const bf16x8 Vf0 = *(const LAS bf16x8*)(RV + (32 * vb + r32) * 80 + (8 * hh) * 2), Vf1 = *(const LAS bf16x8*)(RV + (32 * vb + r32) * 80 + (16 + 8 * hh) * 2);
                    f32x16 Yt;
#pragma unroll
                    for (int q = 0; q < 16; ++q) Yt[q] = 0.f;
#pragma unroll
                    for (int kb = 0; kb < 2; ++kb)
#pragma unroll
                        for (int s2 = 0; s2 < 2; ++s2) Yt = MFMA32(XRf[2 * kb + s2], acc_frag(ST[kb], s2), Yt);
                    Yt = MFMA32(MkrF[0], Vf0, Yt); Yt = MFMA32(MkrF[1], Vf1, Yt);
                    Yt = MFMA32(MbrF[0], u0, Yt); Yt = MFMA32(MbrF[1], u1, Yt);
#pragma unroll
                    for (int q = 0; q < 16; ++q) { const int t = (q & 3) + 8 * (q >> 2) + 4 * hh; Yo[(size_t)(base + t0 + dt * (bt + t)) * D + 64 * hd + 32 * vb + r32] = Yt[q]; }
#pragma unroll
                    for (int kb = 0; kb < 2; ++kb) {
                        const bf16x8 b0 = *(const LAS bf16x8*)(RB + (32 * kb + r32) * 144 + (8 * hh) * 2), b1 = *(const LAS bf16x8*)(RB + (32 * kb + r32) * 144 + (16 + 8 * hh) * 2);
                        const bf16x8 k0 = *(const LAS bf16x8*)(RB + (32 * kb + r32) * 144 + 64 + (8 * hh) * 2), k1 = *(const LAS bf16x8*)(RB + (32 * kb + r32) * 144 + 64 + (16 + 8 * hh) * 2);
                        ST[kb] = MFMA32(b0, u0, ST[kb]); ST[kb] = MFMA32(b1, u1, ST[kb]);
                        ST[kb] = MFMA32(k0, Vf0, ST[kb]); ST[kb] = MFMA32(k1, Vf1, ST[kb]); }
                  } }
                __builtin_amdgcn_sched_barrier(0);
#pragma unroll
                for (int kb = 0; kb < 2; ++kb)
#pragma unroll
                    for (int g4 = 0; g4 < 4; ++g4) { const f32x4 cc = *(const LAS f32x4*)(cCb + 32 * kb + 8 * g4 + 4 * hh);
                        ST[kb][4 * g4 + 0] *= cc.x; ST[kb][4 * g4 + 1] *= cc.y; ST[kb][4 * g4 + 2] *= cc.z; ST[kb][4 * g4 + 3] *= cc.w; }
                __syncthreads();
            }
        }
    }
    __syncthreads();
}
#undef MFMA32
__device__ __forceinline__ void phase_rwkv_out(Frame& F, const Args& A, int nrows) {
    REFRESH(F);
    const float* Y0 = WSP(float, WS_YS); const float* Y1 = Y0 + (size_t)NT * D; const float* B0 = WSP(float, WS_BONUS); const float* B1 = B0 + (size_t)NT * 16;
    const bf16_t* Vv = WSP(bf16_t, WS_RKV) + (size_t)2 * NT * D; const bf16_t* Gg = WSP(bf16_t, WS_G); bf16_t* RO = WSP(bf16_t, WS_RO);
    const float* lnw = A.in[I_RLNW]; const float* lnb = A.in[I_RLNB];
    for (int it = 0;; ++it) { if (ROWOF(it, 0) >= nrows) break;
        f32x4 y[RB][4], vv[RB][4], gg[RB][4]; float bon[RB][4];
#pragma unroll
        for (int r = 0; r < RB; ++r) { const int row = ROWOF(it, r);
#pragma unroll
            for (int j = 0; j < 4; ++j) { const int col = 256 * j + 4 * F.lane, head = 4 * j + (F.lane >> 4); const size_t o = (size_t)row * D + col;
                y[r][j] = *(const f32x4*)(Y0 + o) + *(const f32x4*)(Y1 + o); vv[r][j] = ld_bf4(Vv + o); gg[r][j] = ld_bf4(Gg + o); bon[r][j] = B0[(size_t)row * 16 + head] + B1[(size_t)row * 16 + head]; } }
#pragma unroll
        for (int r = 0; r < RB; ++r) { const int row = ROWOF(it, r);
#pragma unroll
            for (int j = 0; j < 4; ++j) { const int col = 256 * j + 4 * F.lane; const size_t o = (size_t)row * D + col; const f32x4 yy = y[r][j];
                const float s = row16_sum((yy.x + yy.y) + (yy.z + yy.w));
                const f32x4 d = yy - s * (1.0f / 64.0f);
                const float q = row16_sum((d.x * d.x + d.y * d.y) + (d.z * d.z + d.w * d.w));
                const float rs = 1.0f / sqrtf(q * (1.0f / 64.0f) + 64e-5f);
                const f32x4 yn = d * rs * *(const f32x4*)(lnw + col) + *(const f32x4*)(lnb + col);
                { const f32x4 ov = (yn + vv[r][j] * bon[r][j]) * gg[r][j]; *(unsigned*)((unsigned char*)RO + o) = pk4_fp8(ov.x, ov.y, ov.z, ov.w); } } }
    }
}

__device__ __forceinline__ void phase_attn(Frame& F, const Args& A, int j, bool need_ctx) {
    REFRESH(F);
    const bf16_t* Q = WSP(bf16_t, WS_Q); const bf16_t* Kb = WSP(bf16_t, WS_K); const bf16_t* VT = WSP(bf16_t, WS_VT); bf16_t* O = WSP(bf16_t, WS_O);
    const float* sinks = A.in[I_ASINK] + j * 16;
    LAS bf16_t* Ks = (LAS bf16_t*)F.lds; LAS bf16_t* Vs = (LAS bf16_t*)(F.lds + 9216);
    LAS bf16x8* Qs = (LAS bf16x8*)(F.lds + 18432 + F.wave * 8192) + F.lane;
    const int nunits = 2048 + (need_ctx ? 256 : 0);
    const int fr = F.lane & 15, fq = F.lane >> 4, g = F.wave >> 1, hf = F.wave & 1;
    const float SC = 0.125f * 1.4426950408889634f;
    const int lr = F.tid >> 3, lch = F.tid & 7;
    __syncthreads();
    for (int u = F.c; u < nunits; u += F.G) {
        int b, kvh, qb; bool isx;
        if (u < 2048) { isx = true; b = u >> 6; kvh = (u >> 4) & 3; qb = u & 15; } else { const int v = u - 2048; isx = false; b = v >> 3; kvh = (v >> 1) & 3; qb = v & 1; }
        const int qrow0 = (isx ? b * T : NX + b * L) + qb * 128 + hf * 64; const int head = 4 * kvh + g;
        int jlo = 0, jhi = -1;
        if (isx) { jlo = qb == 0 ? 2 : 0; jhi = qb == 15 ? 3 : 5; }
        const int ntiles = 4 + (jhi - jlo + 1);
        auto tile_row0 = [&](int ti) -> int { return ti < 4 ? NX + b * L + ti * 64 : b * T + qb * 128 - 128 + 64 * (jlo + ti - 4); };
        u32x4 kv_n, vv_n;
        { const int kr0 = tile_row0(0); kv_n = *(const u32x4*)(Kb + (size_t)(kr0 + lr) * 256 + kvh * 64 + lch * 8); vv_n = *(const u32x4*)(VT + (size_t)(kvh * 64 + lr) * NT + kr0 + lch * 8); }
#pragma unroll
        for (int mq = 0; mq < 4; ++mq)
#pragma unroll
            for (int ks = 0; ks < 2; ++ks) Qs[64 * (mq * 2 + ks)] = *(const bf16x8*)(Q + (size_t)(qrow0 + 16 * mq + fr) * D + head * 64 + ks * 32 + 8 * fq);
        const float sink2 = sinks[head] * 1.4426950408889634f;
        float mrun[4], lrun[4]; f32x4 Oa[4][4];
#pragma unroll
        for (int mq = 0; mq < 4; ++mq) { mrun[mq] = sink2; lrun[mq] = fq == 0 ? 1.0f : 0.0f;
#pragma unroll
            for (int db = 0; db < 4; ++db) Oa[mq][db] = (f32x4){0.f, 0.f, 0.f, 0.f}; }
        for (int ti = 0; ti < ntiles; ++ti) {
            const int jl = ti < 4 ? -1 : jlo + ti - 4; const int ks0 = qb * 128 - 128 + 64 * jl;
            __syncthreads();
            *(LAS u32x4*)(Ks + lr * 72 + lch * 8) = kv_n; *(LAS u32x4*)(Vs + lr * 72 + lch * 8) = vv_n;
            __syncthreads();
            if (ti + 1 < ntiles) { const int kr0 = tile_row0(ti + 1); kv_n = *(const u32x4*)(Kb + (size_t)(kr0 + lr) * 256 + kvh * 64 + lch * 8); vv_n = *(const u32x4*)(VT + (size_t)(kvh * 64 + lr) * NT + kr0 + lch * 8); }
            const bool need = (jl < 0) || (jl >= hf && jl <= hf + 4);
            if (need) {
                const bool domask = (jl >= 0) && (jl == hf || jl == hf + 4);
                f32x4 Sa[4][4];
#pragma unroll
                for (int mq = 0; mq < 4; ++mq)
#pragma unroll
                    for (int n = 0; n < 4; ++n) Sa[mq][n] = (f32x4){0.f, 0.f, 0.f, 0.f};
#pragma unroll
                for (int ks = 0; ks < 2; ++ks) {
                    bf16x8 Qf[4];
#pragma unroll
                    for (int mq = 0; mq < 4; ++mq) Qf[mq] = Qs[64 * (mq * 2 + ks)];
#pragma unroll
                    for (int n = 0; n < 4; ++n) { const int kr = 32 * (n >> 1) + 8 * (fr >> 2) + 4 * (n & 1) + (fr & 3);
                        const bf16x8 Kf = *(const LAS bf16x8*)(Ks + kr * 72 + ks * 32 + 8 * fq);
#pragma unroll
                        for (int mq = 0; mq < 4; ++mq) Sa[mq][n] = __builtin_amdgcn_mfma_f32_16x16x32_bf16(Kf, Qf[mq], Sa[mq][n], 0, 0, 0); } }
                bf16x8 Pf[4][2];
#pragma unroll
                for (int mq = 0; mq < 4; ++mq) {
                    float mx = -1e30f;
                    if (domask) { const int tq = qb * 128 + hf * 64 + 16 * mq + fr;
#pragma unroll
                        for (int n = 0; n < 4; ++n)
#pragma unroll
                            for (int i = 0; i < 4; ++i) { float sv = Sa[mq][n][i] * SC; const int rel = ks0 + 32 * (n >> 1) + 8 * fq + 4 * (n & 1) + i - tq; if (rel > 128 || rel < -128) sv = -1e30f; Sa[mq][n][i] = sv; mx = fmaxf(mx, sv); } }
                    else {
#pragma unroll
                        for (int n = 0; n < 4; ++n)
#pragma unroll
                            for (int i = 0; i < 4; ++i) { const float sv = Sa[mq][n][i] * SC; Sa[mq][n][i] = sv; mx = fmaxf(mx, sv); } }
                    mx = fmaxf(mx, __shfl_xor(mx, 16)); mx = fmaxf(mx, __shfl_xor(mx, 32));
                    const float mnew = fmaxf(mrun[mq], mx); const float alpha = __builtin_amdgcn_exp2f(mrun[mq] - mnew); mrun[mq] = mnew;
                    float rs = 0.f;
#pragma unroll
                    for (int n = 0; n < 4; ++n)
#pragma unroll
                        for (int i = 0; i < 4; ++i) { const float p = __builtin_amdgcn_exp2f(Sa[mq][n][i] - mnew); Sa[mq][n][i] = p; rs += p; }
                    lrun[mq] = lrun[mq] * alpha + rs;
#pragma unroll
                    for (int db = 0; db < 4; ++db) Oa[mq][db] *= alpha;
#pragma unroll
                    for (int s2 = 0; s2 < 2; ++s2) { u32x4 w; w.x = cvt_pk_bf16(Sa[mq][2 * s2][0], Sa[mq][2 * s2][1]); w.y = cvt_pk_bf16(Sa[mq][2 * s2][2], Sa[mq][2 * s2][3]);
                        w.z = cvt_pk_bf16(Sa[mq][2 * s2 + 1][0], Sa[mq][2 * s2 + 1][1]); w.w = cvt_pk_bf16(Sa[mq][2 * s2 + 1][2], Sa[mq][2 * s2 + 1][3]); Pf[mq][s2] = __builtin_bit_cast(bf16x8, w); }
                }
#pragma unroll
                for (int db = 0; db < 4; ++db)
#pragma unroll
                    for (int s2 = 0; s2 < 2; ++s2) { const bf16x8 Vf = *(const LAS bf16x8*)(Vs + (16 * db + fr) * 72 + 32 * s2 + 8 * fq);
#pragma unroll
                        for (int mq = 0; mq < 4; ++mq) Oa[mq][db] = __builtin_amdgcn_mfma_f32_16x16x32_bf16(Vf, Pf[mq][s2], Oa[mq][db], 0, 0, 0); }
            }
        }
#pragma unroll
        for (int mq = 0; mq < 4; ++mq) { float l = lrun[mq]; l += __shfl_xor(l, 16); l += __shfl_xor(l, 32); const float inv = 1.0f / l;
            unsigned char* op = (unsigned char*)O + (size_t)(qrow0 + 16 * mq + fr) * D + head * 64 + 4 * fq;
#pragma unroll
            for (int db = 0; db < 4; ++db) { const f32x4 o = Oa[mq][db] * inv; *(unsigned*)(op + 16 * db) = pk4_fp8(o.x, o.y, o.z, o.w); } }
    }
    __syncthreads();
}

struct KState { XcdBarrier bar; int ph; };
#define RUN() (A.one || A.phase == KS.ph)
#define SEAM() do { if (A.one) xcd_barrier(KS.bar); ++KS.ph; } while (0)
template <int LAYER>
__device__ __forceinline__ void layer_body(Frame& F, const Args& A, KState& KS) {
    constexpr int layer = LAYER, kind = LAYER % 3, j = LAYER / 3; constexpr bool last = (LAYER == DEPTH - 1);
    LAS unsigned char* ring = F.lds;
    const LAS int* tpre = (const LAS int*)(F.lds + TPRE_OFF); const LAS int* lcnt = (const LAS int*)(F.lds + LCNT_OFF);
    bf16_t* H = WSP(bf16_t, WS_H); const float* MOD = WSP(float, WS_MOD); const bf16_t* AX = WSP(bf16_t, WS_AX);
    const float* gate1 = MOD + (size_t)layer * 33 * 6144 + 2 * D;
    constexpr int nMall = last ? NX / 256 : NT / 256;
    if (RUN()) phase_norm1(F, A, layer);
    SEAM();
    if constexpr (kind == 0) {
        if (RUN()) for (int rep_ = 0; rep_ < REPN(1); ++rep_) {
            { pg8::ProbDense8 P; P.A = (const unsigned char*)AX; P.Bt = WSP(unsigned char, WS_WQK) + (size_t)j * 1280 * D; P.lda = D; P.ldb = D; P.K = D; P.scale_w = SCALE_W; P.scale_x = SCALE_ONE; P.ord.init(NT / 256, 5, F.G, F.c);
              EpiQK E{WSP(bf16_t, WS_Q), WSP(bf16_t, WS_K), WSP(float, WS_BQK) + j * 1280, WSP(float, WS_ROPEC), WSP(float, WS_ROPES)};
              pg8::gemm_phase(ring, P, E); }
            { pg8::ProbDense8 P; P.A = WSP(unsigned char, WS_WV) + (size_t)j * 256 * D; P.Bt = (const unsigned char*)AX; P.lda = D; P.ldb = D; P.K = D; P.scale_w = SCALE_ONE; P.scale_x = SCALE_W; P.ord.init(1, NT / 256, F.G, F.c);
              EpiVT E{WSP(bf16_t, WS_VT), A.in[I_ABQKV] + j * 1536 + 1280};
              pg8::gemm_phase(ring, P, E); }
        }
        SEAM();
        if (RUN()) for (int rep_ = 0; rep_ < REPN(2); ++rep_) phase_attn(F, A, j, !last);
        SEAM();
        if (RUN() && !((SKIPMASK >> layer) & 1)) { pg8::ProbDense8 P; P.A = WSP(unsigned char, WS_O); P.Bt = WSP(unsigned char, WS_WO) + (size_t)j * D * D; P.lda = D; P.ldb = D; P.K = D; P.scale_w = SCALE_W; P.scale_x = SCALE_ONE; P.ord.init(nMall, 4, F.G, F.c);
            EpiResid E{H, A.in[I_ABO] + j * D, nullptr, gate1};
            pg8::gemm_phase(ring, P, E); }
        SEAM();
    } else if constexpr (kind == 1) {
        if (RUN()) for (int rep_ = 0; rep_ < REPN(3); ++rep_) phase_pooldiff(F);
        SEAM();
        if (RUN() && !((SKIPMASK >> layer) & 1)) { pg8::ProbDense P; P.A = WSP(bf16_t, WS_PD); P.Bt = WSP(bf16_t, WS_POOLW); P.lda = D; P.ldb = 256; P.K = 256; P.a_pn_off = 256; P.ord.init(nMall, 4, F.G, F.c);
            EpiResid E{H, A.in[I_PB], A.in[I_PS], gate1};
            pg8::gemm_phase(ring, P, E); }
        SEAM();
    } else {
        if (RUN()) for (int rep_ = 0; rep_ < REPN(4); ++rep_) phase_rwkv_mix(F, A);
        SEAM();
        if (RUN()) for (int rep_ = 0; rep_ < REPN(5); ++rep_) {
            for (int i = 0; i < 3; ++i) { const int sel = i == 0 ? 0 : i == 1 ? 2 : 3;
                pg8::ProbDense8 P; P.A = (const unsigned char*)(WSP(bf16_t, WS_A6) + (size_t)sel * NT * D); P.Bt = WSP(unsigned char, WS_WRKV) + (size_t)i * D * D; P.lda = D; P.ldb = D; P.K = D; P.scale_w = SCALE_W; P.scale_x = SCALE_ONE; P.ord.init(NT / 256, 4, F.G, F.c);
                EpiBf16Act E{WSP(bf16_t, WS_RKV) + (size_t)i * NT * D, D, nullptr, 0, 1.0f};
                pg8::gemm_phase(ring, P, E); }
            for (int i = 0; i < 3; ++i) { const int sel = i == 0 ? 5 : i == 1 ? 1 : 4;
                pg8::ProbDense P; P.A = WSP(bf16_t, WS_A6) + (size_t)sel * NT * D; P.Bt = WSP(bf16_t, WS_WL1) + (size_t)i * 256 * D; P.lda = D; P.ldb = D; P.K = D; P.a_pn_off = 0; P.ord.init(NT / 256, 1, F.G, F.c);
                EpiBf16Act E{WSP(bf16_t, WS_LORA) + i * 256, 768, nullptr, i == 0 ? 1 : i == 1 ? 2 : 0, 1.0f};
                pg8::gemm_phase(ring, P, E); }
        }
        SEAM();
        if (RUN()) for (int rep_ = 0; rep_ < REPN(6); ++rep_) {
            for (int i = 0; i < 5; ++i) {
                const int ablk = i == 0 ? 0 : i < 3 ? 1 : 2, d = (i - 1) & 1;
                pg8::ProbDense P; P.A = WSP(bf16_t, WS_LORA) + ablk * 256; P.Bt = WSP(bf16_t, WS_WL2) + (size_t)i * D * 256; P.lda = 768; P.ldb = 256; P.K = 256; P.a_pn_off = 0; P.ord.init(NT / 256, 4, F.G, F.c);
                EpiBf16Act E; E.ldc = D;
                if (i == 0) { E.O = WSP(bf16_t, WS_G); E.bias = nullptr; E.act = 0; E.scale = 1.0f; }
                else if (i < 3) { E.O = WSP(bf16_t, WS_E) + (size_t)d * NT * D; E.bias = A.in[I_RW0] + d * D; E.act = 1; E.scale = 0.6065306597126334f; }
                else { E.O = WSP(bf16_t, WS_A) + (size_t)d * NT * D; E.bias = A.in[I_RA0] + d * D; E.act = 1; E.scale = 1.0f; }
                pg8::gemm_phase(ring, P, E); }
        }
        SEAM();
        if (RUN()) for (int rep_ = 0; rep_ < REPN(7); ++rep_) phase_rwkv_scan(F, A);
        SEAM();
        if (RUN()) for (int rep_ = 0; rep_ < REPN(8); ++rep_) phase_rwkv_out(F, A, last ? NX : NT);
        SEAM();
        if (RUN() && !((SKIPMASK >> layer) & 1)) { pg8::ProbDense8 P; P.A = WSP(unsigned char, WS_RO); P.Bt = WSP(unsigned char, WS_WOR); P.lda = D; P.ldb = D; P.K = D; P.scale_w = SCALE_W; P.scale_x = SCALE_ONE; P.ord.init(nMall, 4, F.G, F.c);
            EpiResid E{H, nullptr, nullptr, gate1};
            pg8::gemm_phase(ring, P, E); }
        SEAM();
    }
    if (RUN()) phase_route(F, A, layer);
    SEAM();
    if (RUN()) for (int rep_ = 0; rep_ < REPN(9); ++rep_) { moe_tiles(F, layer);
        ProbMoe1 P; P.FX = WSP(fp8_t, WS_FX); P.W1T = WSP(fp8_t, WS_W1T) + (size_t)layer * NE * 2048 * D; P.list = WSP(int, WS_LIST); P.tpre = tpre; P.cnt = lcnt; P.texp = (const LAS unsigned char*)(F.lds + TEXP_OFF); P.toks = (LAS int*)(F.lds + TOKS_OFF); P.scale_w = SCALE_W; P.scale_x = SCALE_ONE; P.ord.init(tpre[NE], 8, F.G, F.c);
        EpiMoe1 E{WSP(unsigned char, WS_ACT), A.in[I_MB1] + (size_t)layer * NE * 2048};
        pg8::gemm_phase(ring, P, E); }
    SEAM();
    if (RUN()) for (int rep_ = 0; rep_ < REPN(10); ++rep_) { moe_tiles(F, layer);
        ProbMoe2 P; P.ACT = WSP(fp8_t, WS_ACT); P.W2T = WSP(fp8_t, WS_W2T) + (size_t)layer * NE * D * D; P.tpre = tpre; P.texp = (const LAS unsigned char*)(F.lds + TEXP_OFF); P.scale_w = SCALE_W; P.scale_x = SCALE_ONE; P.ord.init(tpre[NE], 4, F.G, F.c);
        EpiMoe2 E{WSP(bf16_t, WS_Y), A.in[I_MB2] + (size_t)layer * NE * D};
        pg8::gemm_phase(ring, P, E); }
    SEAM();
}
__global__ void __launch_bounds__(NTHREADS, 2) trunk_fwd(Args A) {
    extern __shared__ __attribute__((aligned(16))) unsigned char lds_[];
    Frame F; F.lds = (LAS unsigned char*)lds_; REFRESH(F); F.wave = __builtin_amdgcn_readfirstlane(F.tid >> 6);
    F.G = gridDim.x; F.c = blockIdx.x; F.ws = A.ws; F.ctl = (unsigned*)(A.ws + WS_CTL);
    for (int u = F.tid; u < (LDS_BYTES - LDSCTL_OFF) / 4; u += NTHREADS) ((LAS unsigned*)(F.lds + LDSCTL_OFF))[u] = 0u;
    __syncthreads();
    KState KS; KS.bar.bar = F.ctl + CW_BAR; KS.bar.x = 0; KS.bar.st = nullptr; KS.ph = 0;
    if (A.one) KS.bar = xcd_barrier_post(F.ctl + CW_BAR, (volatile LAS unsigned*)(F.lds + MISC_OFF) + 8);
    if (RUN()) for (int rep_ = 0; rep_ < REPN(0); ++rep_) phase_prologue(F, A);
    SEAM();
    layer_body<0>(F, A, KS);
    layer_body<1>(F, A, KS);
    layer_body<2>(F, A, KS);
    layer_body<3>(F, A, KS);
    if (RUN()) phase_final(F, A);
}
#undef RUN
#undef SEAM
static int count_phases() { int n = 1; for (int layer = 0; layer < DEPTH; ++layer) { const int kind = layer % 3; n += 1 + (kind == 0 ? 3 : kind == 1 ? 2 : 6) + 3; } return n + 1; }

extern "C" void kernel_launch(void* const* d_in, const int* in_sizes, int n_in, void* d_out, int out_size, void* d_ws, size_t ws_size, hipStream_t stream) {
    static int grid = 0;
    if (grid == 0) {
        if (n_in != 38 || out_size != NX * D || ws_size < WS_END) { fprintf(stderr, "kernel_launch: unexpected problem (n_in %d, out %d, ws %zu < %zu)\n", n_in, out_size, ws_size, (size_t)WS_END); grid = -1; return; }
        int dev = 0, cus = 0;
        if (hipGetDevice(&dev) != hipSuccess || hipDeviceGetAttribute(&cus, hipDeviceAttributeMultiprocessorCount, dev) != hipSuccess) { grid = -1; return; }
        if (hipFuncSetAttribute((const void*)trunk_fwd, hipFuncAttributeMaxDynamicSharedMemorySize, LDS_BYTES) != hipSuccess) { fprintf(stderr, "kernel_launch: hipFuncSetAttribute failed\n"); grid = -1; return; }
        int per_cu = 0;
        if (hipOccupancyMaxActiveBlocksPerMultiprocessor(&per_cu, (const void*)trunk_fwd, NTHREADS, LDS_BYTES) != hipSuccess || per_cu < 1) fprintf(stderr, "kernel_launch: occupancy query says %d\n", per_cu);
        (void)hipGetLastError();
        grid = cus;
        if (grid != 256) fprintf(stderr, "kernel_launch: %d CUs (built for 256)\n", grid);
    }
    if (grid < 0) return;
    (void)hipMemsetAsync((char*)d_ws + WS_CTL, 0, CTL_BYTES, stream);
    (void)hipMemsetAsync((char*)d_ws + WS_LZERO, 0, LZERO_BYTES, stream);
    Args a{};
    for (int i = 0; i < 38; ++i) a.in[i] = (const float*)d_in[i];
    a.out = (float*)d_out; a.ws = (unsigned char*)d_ws;
#if MK_ONE_LAUNCH
    a.phase = 0; a.one = 1;
    hipLaunchKernelGGL(trunk_fwd, dim3(grid), dim3(NTHREADS), LDS_BYTES, stream, a);
#else
    const int nph = count_phases();
    for (int p = 0; p < nph; ++p) { a.phase = p; a.one = 0; hipLaunchKernelGGL(trunk_fwd, dim3(grid), dim3(NTHREADS), LDS_BYTES, stream, a); }
#endif
}
```

```cpp
#include <hip/hip_runtime.h>
#include <cstdio>
#include <cstdint>

#ifndef MK_ONE_LAUNCH
#define MK_ONE_LAUNCH 1
#endif
#ifndef REPMASK
#define REPMASK 0x000
#endif
#define REPN(k) (1 + ((REPMASK >> (k)) & 1))
#ifndef DIAG
#define DIAG 0
#endif
#ifndef SKIPMASK
#define SKIPMASK 0x00
#endif

#define LAS __attribute__((address_space(3)))
#define GAS __attribute__((address_space(1)))
typedef unsigned short bf16_t;
typedef short bf16x8 __attribute__((ext_vector_type(8)));
typedef float f32x4 __attribute__((ext_vector_type(4)));
typedef float f32x2 __attribute__((ext_vector_type(2)));
typedef unsigned u32x4 __attribute__((ext_vector_type(4)));
typedef unsigned u32x2 __attribute__((ext_vector_type(2)));

constexpr int D = 1024, NB = 32, T = 2048, L = 256, DEPTH = 4;
constexpr int NX = NB * T, NC = NB * L, NT = NX + NC;
constexpr int NE = 32, TOPK = 4;
constexpr int NWAVES = 8, NTHREADS = 512;
constexpr int MAXRT = NT * TOPK / 256 + NE;

constexpr size_t MiB = 1u << 20;
constexpr size_t WS_CTL = 0, CTL_BYTES = 4 * MiB;
constexpr size_t WS_MOD = 4 * MiB;
constexpr size_t WS_ROPEC = 8 * MiB, WS_ROPES = 8 * MiB + 512 * 1024;
constexpr size_t WS_BQK = 9 * MiB;
constexpr size_t WS_WQK = 10 * MiB;
constexpr size_t WS_WV = 15 * MiB;
constexpr size_t WS_WO = 16 * MiB;
constexpr size_t WS_POOLW = 20 * MiB;
constexpr size_t WS_WRKV = 21 * MiB;
constexpr size_t WS_WOR = 27 * MiB;
constexpr size_t WS_WL1 = 30 * MiB;
constexpr size_t WS_WL2 = 32 * MiB;
constexpr size_t WS_LZERO = WS_WL1, LZERO_BYTES = 6 * MiB;
constexpr size_t WS_W1T = 40 * MiB;
constexpr size_t WS_W2T = 552 * MiB;
constexpr size_t WS_H = 808 * MiB;
constexpr size_t WS_AX = 1096 * MiB;
constexpr size_t WS_FX = 1240 * MiB;
constexpr size_t WS_R = 1384 * MiB;
constexpr size_t WS_ACT = WS_R;
constexpr size_t WS_Y = WS_R + 592 * MiB;
constexpr size_t WS_LIST = WS_R + 1184 * MiB;
constexpr size_t WS_POS = WS_R + 1193 * MiB;
constexpr size_t WS_GATE = WS_R + 1195 * MiB;
constexpr size_t WS_Q = WS_R;
constexpr size_t WS_K = WS_R + 144 * MiB;
constexpr size_t WS_VT = WS_R + 180 * MiB;
constexpr size_t WS_O = WS_R + 216 * MiB;
constexpr size_t WS_PD = WS_R;
constexpr size_t WS_A6 = WS_R;
constexpr size_t WS_E = WS_R;
constexpr size_t WS_A = WS_R + 288 * MiB;
constexpr size_t WS_RO = WS_R + 576 * MiB;
constexpr size_t WS_RKV = WS_R + 864 * MiB;
constexpr size_t WS_LORA = WS_R + 1296 * MiB;
constexpr size_t WS_G = WS_R + 1404 * MiB;
constexpr size_t WS_YS = WS_R + 1548 * MiB;
constexpr size_t WS_BONUS = WS_R + 2124 * MiB;
constexpr size_t WS_END = WS_R + 2134 * MiB;

constexpr int CW_BAR = 4096;
constexpr int CW_GCNT = 16384;
constexpr int LDS_BYTES = 147456;
constexpr int RING_BYTES = 131072;
constexpr int LDSCTL_OFF = 135168;
constexpr int MISC_OFF = LDSCTL_OFF;
constexpr int TPRE_OFF = LDSCTL_OFF + 256;
constexpr int LCNT_OFF = LDSCTL_OFF + 512;
constexpr int LBASE_OFF = LDSCTL_OFF + 768;
constexpr int REC_OFF = LDSCTL_OFF + 1024;
constexpr int TEXP_OFF = LDSCTL_OFF + 1024 + 2048;
constexpr int TOKS_OFF = LDSCTL_OFF + 1024 + 4096;
constexpr int JOB_OFF = LDSCTL_OFF + 1024;

__device__ __forceinline__ unsigned f2bf(float f) { unsigned u = __builtin_bit_cast(unsigned, f); return (u + 0x7fffu + ((u >> 16) & 1u)) >> 16; }
__device__ __forceinline__ unsigned pk2(float lo, float hi) { return f2bf(lo) | (f2bf(hi) << 16); }
__device__ __forceinline__ float bflo(unsigned w) { return __builtin_bit_cast(float, w << 16); }
__device__ __forceinline__ float bfhi(unsigned w) { return __builtin_bit_cast(float, w & 0xffff0000u); }
__device__ __forceinline__ float bf1(bf16_t b) { return __builtin_bit_cast(float, ((unsigned)b) << 16); }
__device__ __forceinline__ unsigned pk4_fp8(float a, float b, float c, float d) { int w = __builtin_amdgcn_cvt_pk_fp8_f32(a, b, 0, false); w = __builtin_amdgcn_cvt_pk_fp8_f32(c, d, w, true); return (unsigned)w; }
typedef __bf16 bf16x2_t __attribute__((ext_vector_type(2)));
__device__ __forceinline__ unsigned cvt_pk_bf16(float lo, float hi) { const f32x2 v = {lo, hi}; return __builtin_bit_cast(unsigned, __builtin_convertvector(v, bf16x2_t)); }
__device__ __forceinline__ float dpp_add(float v, const int ctrl, const int row_mask) {
    switch (ctrl) {
    case 0xB1:  return v + __builtin_bit_cast(float, __builtin_amdgcn_update_dpp(0, __builtin_bit_cast(int, v), 0xB1, 0xf, 0xf, true));
    case 0x4E:  return v + __builtin_bit_cast(float, __builtin_amdgcn_update_dpp(0, __builtin_bit_cast(int, v), 0x4E, 0xf, 0xf, true));
    case 0x141: return v + __builtin_bit_cast(float, __builtin_amdgcn_update_dpp(0, __builtin_bit_cast(int, v), 0x141, 0xf, 0xf, true));
    case 0x140: return v + __builtin_bit_cast(float, __builtin_amdgcn_update_dpp(0, __builtin_bit_cast(int, v), 0x140, 0xf, 0xf, true));
    case 0x142: return v + __builtin_bit_cast(float, __builtin_amdgcn_update_dpp(0, __builtin_bit_cast(int, v), 0x142, 0xa, 0xf, true));
    default:    return v + __builtin_bit_cast(float, __builtin_amdgcn_update_dpp(0, __builtin_bit_cast(int, v), 0x143, 0xc, 0xf, true));
    }
}
__device__ __forceinline__ float row16_sum(float v) { v = dpp_add(v, 0xB1, 0xf); v = dpp_add(v, 0x4E, 0xf); v = dpp_add(v, 0x141, 0xf); v = dpp_add(v, 0x140, 0xf); return v; }
__device__ __forceinline__ float wave_sum(float v) {
    v = row16_sum(v); v = dpp_add(v, 0x142, 0xa); v = dpp_add(v, 0x143, 0xc);
    return __builtin_bit_cast(float, __builtin_amdgcn_readlane(__builtin_bit_cast(int, v), 63));
}
__device__ __forceinline__ float sigmoidf_(float x) { return __builtin_amdgcn_rcpf(1.0f + __builtin_amdgcn_exp2f(-1.4426950408889634f * x)); }
__device__ __forceinline__ int opaque_tid() { int t; asm volatile("v_mov_b32 %0, %1" : "=v"(t) : "v"(threadIdx.x)); return t; }
#define REFRESH(F) do { (F).tid = opaque_tid(); (F).lane = (F).tid & 63; } while (0)
__device__ __forceinline__ void seq_of(int row, int& sb, int& t, int& n) { if (row < NX) { sb = row & ~(T - 1); t = row & (T - 1); n = T; } else { const int r2 = row - NX; sb = NX + (r2 & ~(L - 1)); t = r2 & (L - 1); n = L; } }
__device__ __forceinline__ f32x4 ld_bf4(const bf16_t* p) { const u32x2 w = *(const u32x2*)p; return (f32x4){bflo(w.x), bfhi(w.x), bflo(w.y), bfhi(w.y)}; }
__device__ __forceinline__ void st_bf4(bf16_t* p, f32x4 v) { u32x2 w; w.x = pk2(v.x, v.y); w.y = pk2(v.z, v.w); *(u32x2*)p = w; }

#define LDS_WAIT() asm volatile("s_waitcnt lgkmcnt(0)" ::: "memory")
#define VM_WAIT() asm volatile("s_waitcnt vmcnt(0)" ::: "memory")

#define XB_TMO      128
#define XB_XCNT(j)  (256  + 64 * (j))
#define XB_XSUB(j)  (1280 + 64 * (j))
#define XB_XGEN(j)  (2304 + 64 * (j))
#define XB_TOP      3328
#define XB_TOPGEN   3392
#define XCD_BAR_WORDS 3456
#define XB_SPIN_CAP (1u << 18)
__device__ __forceinline__ unsigned xb_ld(unsigned* p)              { return __hip_atomic_load(p, __ATOMIC_RELAXED, __HIP_MEMORY_SCOPE_AGENT); }
__device__ __forceinline__ unsigned xb_add(unsigned* p, unsigned v) { return __hip_atomic_fetch_add(p, v, __ATOMIC_RELAXED, __HIP_MEMORY_SCOPE_AGENT); }
__device__ __forceinline__ unsigned xb_xcc_id() { return (unsigned)__builtin_amdgcn_s_getreg((3 << 11) | 20) & 0xFu; }
#define XB_SPIN(cond, bar) do { unsigned _sp = 0; while (cond) { __builtin_amdgcn_s_sleep(1); \
    if ((++_sp & 255u) == 0u) { if (xb_ld(&(bar)[XB_TMO])) break; if (_sp > XB_SPIN_CAP) { atomicAdd(&(bar)[XB_TMO], 1u); break; } } } } while (0)
struct XcdBarrier { unsigned* bar; unsigned x; volatile LAS unsigned* st; };
__device__ __forceinline__ XcdBarrier xcd_barrier_post(unsigned* bar, volatile LAS unsigned* st) {
    XcdBarrier b; b.bar = bar; b.x = xb_xcc_id(); b.st = st;
    if (threadIdx.x == 0) (void)xb_add(&bar[XB_XCNT(b.x)], 1u);
    return b;
}
__device__ __forceinline__ void xcd_barrier_complete(unsigned* bar, unsigned x, unsigned& nloc, unsigned& nx) {
    const unsigned G = gridDim.x * gridDim.y * gridDim.z;
    unsigned sum, cnt, mine, sp = 0u;
    for (;;) {
        sum = 0u; cnt = 0u; mine = 0u;
#pragma unroll
        for (unsigned j = 0; j < 16; ++j) { const unsigned c = xb_ld(&bar[XB_XCNT(j)]); sum += c; cnt += (c > 0u) ? 1u : 0u; mine = (j == x) ? c : mine; }
        if (sum == G) break;
        __builtin_amdgcn_s_sleep(1);
        if ((++sp & 255u) == 0u) { if (xb_ld(&bar[XB_TMO])) break; if (sp > XB_SPIN_CAP) { atomicAdd(&bar[XB_TMO], 1u); break; } }
    }
    nloc = mine > 0u ? mine : 1u; nx = cnt > 0u ? cnt : 1u;
}
__device__ __forceinline__ void xcd_barrier(const XcdBarrier& b) {
    asm volatile("s_waitcnt vmcnt(0)" ::: "memory");
    __syncthreads();
    if (threadIdx.x == 0) {
        unsigned* bar = b.bar;
        __builtin_amdgcn_s_waitcnt(0);
        unsigned nloc = b.st[0], nx = b.st[1];
        if (nloc == 0u) { xcd_barrier_complete(bar, b.x, nloc, nx); b.st[0] = nloc; b.st[1] = nx; }
        const unsigned old = xb_add(&bar[XB_XSUB(b.x)], 1u);
        const unsigned gen = old / nloc;
        if (old + 1u == (gen + 1u) * nloc) {
            __builtin_amdgcn_fence(__ATOMIC_RELEASE, "agent");
            asm volatile("s_waitcnt vmcnt(0)" ::: "memory");
            const unsigned og = xb_add(&bar[XB_TOP], 1u);
            const unsigned tg = og / nx;
            if (og + 1u == (tg + 1u) * nx) xb_add(&bar[XB_TOPGEN], 1u);
            else XB_SPIN(xb_ld(&bar[XB_TOPGEN]) == tg, bar);
            __builtin_amdgcn_fence(__ATOMIC_ACQUIRE, "agent");
            xb_add(&bar[XB_XGEN(b.x)], 1u);
            asm volatile("s_waitcnt vmcnt(0)" ::: "memory");
        } else {
            XB_SPIN(xb_ld(&bar[XB_XGEN(b.x)]) == gen, bar);
            __builtin_amdgcn_fence(__ATOMIC_ACQUIRE, "agent");
            asm volatile("s_waitcnt vmcnt(0)" ::: "memory");
        }
    }
    __syncthreads();
}

namespace pg8 {
constexpr int BM = 256, BK = 64, HALF = 128, HTB = HALF * BK * 2, STAGE_BYTES = 8 * HTB, NXCD = 8, WGM = 8;
__host__ __device__ __forceinline__ int lds_byte(int r, int c) { const int st = (r >> 4) * 2 + (c >> 5), rr = r & 15, cc = c & 31, ob = rr * 64 + cc * 2; return st * 1024 + (ob ^ (((ob >> 9) & 1) << 5)); }
__host__ __device__ __forceinline__ void stage_rc(int b, int& R, int& C) { const int st = b / 1024, sb = b % 1024, swz = sb ^ (((sb >> 9) & 1) << 5); R = (st >> 1) * 16 + swz / 64; C = (st & 1) * 32 + (swz % 64) / 2; }
__host__ __device__ __forceinline__ int perm32(int rho) { const int n = rho >> 4, i = rho & 15; return 8 * (i >> 2) + 4 * n + (i & 3); }

typedef int i32x8 __attribute__((ext_vector_type(8)));
typedef int i32x4 __attribute__((ext_vector_type(4)));
__device__ __forceinline__ i32x8 cat8(bf16x8 lo, bf16x8 hi) { const i32x4 a = __builtin_bit_cast(i32x4, lo), b = __builtin_bit_cast(i32x4, hi); return __builtin_shufflevector(a, b, 0, 1, 2, 3, 4, 5, 6, 7); }
struct Unit { int pm, pn, e, rt; };
struct TileOrder {
    int nM, nN, nwg, G, c;
    __device__ __forceinline__ void init(int nM_, int nN_, int G_, int c_) { nM = nM_; nN = nN_; nwg = nM * nN; G = G_; c = c_; }
    __device__ __forceinline__ bool next(int i, int& pm, int& pn) const {
        const long Lx = (long)i * G + c; if (Lx >= nwg) return false;
        int wgid = (int)Lx; { const int q = nwg / NXCD, r = nwg % NXCD, xcd = wgid % NXCD, off = wgid / NXCD; wgid = (xcd < r ? xcd * (q + 1) : r * (q + 1) + (xcd - r) * q) + off; }
        const int nig = WGM * nN, gid = wgid / nig, fm = gid * WGM, gsz = (nM - fm) < WGM ? (nM - fm) : WGM;
        pm = fm + ((wgid % nig) % gsz); pn = (wgid % nig) / gsz; return true;
    }
};
struct ProbDense {
    static constexpr bool FP8 = false;
    const bf16_t* A; const bf16_t* Bt; int lda, ldb, K, a_pn_off; TileOrder ord;
    __device__ __forceinline__ int ldb_bytes() const { return ldb * 2; }
    __device__ __forceinline__ int ntiles() const { return K / 64; }
    __device__ __forceinline__ bool next(int i, Unit& u) const { u.e = 0; const bool ok = ord.next(i, u.pm, u.pn); u.rt = u.pm; return ok; }
    __device__ __forceinline__ const char* a_ptr(const Unit& u) const { return (const char*)(A + (size_t)u.pm * BM * lda + (size_t)u.pn * a_pn_off); }
    __device__ __forceinline__ const char* b_ptr(const Unit& u) const { return (const char*)(Bt + (size_t)u.pn * BM * ldb); }
    __device__ __forceinline__ void list_prefetch(const Unit&, int, int, int) const {}
    __device__ __forceinline__ void a_off(const Unit&, int, const int (&R)[2], const int (&C)[2], unsigned (&v)[2][2]) const {
#pragma unroll
        for (int h = 0; h < 2; ++h)
#pragma unroll
            for (int i = 0; i < 2; ++i) v[h][i] = (unsigned)((h * HALF + R[i]) * lda + C[i]) * 2u;
    }
};

struct ProbDense8 {
    static constexpr bool FP8 = true;
    const unsigned char* A; const unsigned char* Bt; int lda, ldb, K, scale_w, scale_x; TileOrder ord;
    __device__ __forceinline__ int ldb_bytes() const { return ldb; }
    __device__ __forceinline__ int ntiles() const { return K / 128; }
    __device__ __forceinline__ bool next(int i, Unit& u) const { u.e = 0; const bool ok = ord.next(i, u.pm, u.pn); u.rt = u.pm; return ok; }
    __device__ __forceinline__ const char* a_ptr(const Unit& u) const { return (const char*)(A + (size_t)u.pm * BM * lda); }
    __device__ __forceinline__ const char* b_ptr(const Unit& u) const { return (const char*)(Bt + (size_t)u.pn * BM * ldb); }
    __device__ __forceinline__ void list_prefetch(const Unit&, int, int, int) const {}
    __device__ __forceinline__ void a_off(const Unit&, int, const int (&R)[2], const int (&C)[2], unsigned (&v)[2][2]) const {
#pragma unroll
        for (int h = 0; h < 2; ++h)
#pragma unroll
            for (int i = 0; i < 2; ++i) v[h][i] = (unsigned)((h * HALF + R[i]) * lda + C[i] * 2);
    }
};
template <class Prob, class Epi>
__device__ __forceinline__ void gemm_phase(LAS unsigned char* lds, const Prob& P, const Epi& E) {
    const int tid = opaque_tid(), wid = __builtin_amdgcn_readfirstlane(tid >> 6), lane = tid & 63, wr = wid >> 2, wc = wid & 3, fr = lane & 15, fq = lane >> 4;
    const int nt = P.ntiles(); const int ldbB = P.ldb_bytes();
    int Rr[2], Cc[2]; unsigned voffB[2];
#pragma unroll
    for (int i = 0; i < 2; ++i) { int R, C; stage_rc(tid * 16 + i * 8192, R, C); Rr[i] = R; Cc[i] = C; const int Rb = Epi::PERM ? ((R & ~31) + perm32(R & 31)) : R;
        voffB[i] = (unsigned)(Rb * ldbB + C * 2); }
    const size_t kstep = (size_t)(BK * 2);
    const size_t hstepB = (size_t)HALF * ldbB;
    const unsigned ldsw = (unsigned)wid * 1024u;
    const int aoff = lds_byte(wr * 64 + fr, fq * 8), boff = lds_byte(wc * 32 + fr, fq * 8);
#define PG8_SA(b, h) (((b) * 2 + (h)) * HTB)
#define PG8_SB(b, h) ((4 + (b) * 2 + (h)) * HTB)
#define PG8_STAGE(bufoff, gbase, voff) do { _Pragma("unroll") for (int _i = 0; _i < 2; ++_i) \
        __builtin_amdgcn_global_load_lds((const unsigned*)((const char*)(gbase) + (voff)[_i]), (LAS unsigned*)(lds + (bufoff) + ldsw + _i * 8192), 16, 0, 0); } while (0)
#define PG8_LDA(dst, b, h) do { _Pragma("unroll") for (int m = 0; m < 4; ++m) _Pragma("unroll") for (int k = 0; k < 2; ++k) dst[m][k] = *(const LAS bf16x8*)(lds + PG8_SA(b, h) + aoff + m * 2048 + k * 1024); } while (0)
#define PG8_LDB(dst, b, h) do { _Pragma("unroll") for (int n = 0; n < 2; ++n) _Pragma("unroll") for (int k = 0; k < 2; ++k) dst[n][k] = *(const LAS bf16x8*)(lds + PG8_SB(b, h) + boff + n * 2048 + k * 1024); } while (0)
#define PG8_MMA(ai, bj, At, Bt) do { __builtin_amdgcn_s_setprio(1); _Pragma("unroll") for (int m = 0; m < 4; ++m) _Pragma("unroll") for (int n = 0; n < 2; ++n) { \
        if constexpr (Prob::FP8) { asm volatile("v_mfma_scale_f32_16x16x128_f8f6f4 %0, %1, %2, %0, %3, %4 op_sel_hi:[0,0,0]" : "+v"(acc[ai][bj][m][n]) : "v"(cat8(Bt[n][0], Bt[n][1])), "v"(cat8(At[m][0], At[m][1])), "v"(sc_w), "v"(sc_x)); } \
        else { _Pragma("unroll") for (int k = 0; k < 2; ++k) acc[ai][bj][m][n] = __builtin_amdgcn_mfma_f32_16x16x32_bf16(Bt[n][k], At[m][k], acc[ai][bj][m][n], 0, 0, 0); } } __builtin_amdgcn_s_setprio(0); } while (0)
#define PG8_WAIT_V(n) asm volatile("s_waitcnt vmcnt(" #n ")" ::: "memory")
#define PG8_WAIT_L(n) asm volatile("s_waitcnt lgkmcnt(" #n ")" ::: "memory")
#define PG8_BAR __builtin_amdgcn_s_barrier()
#define PG8_SCHED __builtin_amdgcn_sched_barrier(0)
    Unit cur, nxt; int ui = 0;
    if (!P.next(0, cur)) return;
    int sc_w = 0, sc_x = 0; if constexpr (Prob::FP8) { sc_w = P.scale_w; sc_x = P.scale_x; } (void)sc_w; (void)sc_x;
    f32x4 acc[2][2][4][2];
#pragma unroll
    for (int a = 0; a < 2; ++a)
#pragma unroll
        for (int b = 0; b < 2; ++b)
#pragma unroll
            for (int m = 0; m < 4; ++m)
#pragma unroll
                for (int n = 0; n < 2; ++n) acc[a][b][m][n] = (f32x4){0.f, 0.f, 0.f, 0.f};
    bf16x8 At[4][2], B0[2][2], B1[2][2];
    unsigned vAc[2][2], vAn[2][2];
    P.list_prefetch(cur, 0, wid, lane); { Unit u1; if (P.next(1, u1)) P.list_prefetch(u1, 1, wid, lane); }
    PG8_WAIT_V(0); PG8_BAR;
    P.a_off(cur, 0, Rr, Cc, vAc);
    const char* cA = P.a_ptr(cur); const char* cB = P.b_ptr(cur);
    PG8_STAGE(PG8_SB(0, 0), cB, voffB); PG8_STAGE(PG8_SB(0, 1), cB + hstepB, voffB); PG8_STAGE(PG8_SA(0, 0), cA, vAc[0]); PG8_STAGE(PG8_SA(0, 1), cA, vAc[1]);
    if (wr == 1) PG8_BAR;
    PG8_WAIT_V(2); PG8_BAR;
    PG8_STAGE(PG8_SB(1, 0), cB + kstep, voffB); PG8_STAGE(PG8_SA(1, 0), cA + kstep, vAc[0]); PG8_STAGE(PG8_SB(1, 1), cB + hstepB + kstep, voffB);
    PG8_WAIT_V(6); PG8_BAR;
    for (;;) {
        const bool has_next = P.next(ui + 1, nxt);
        const char* nA = cA; const char* nB = cB;
#pragma unroll
        for (int h = 0; h < 2; ++h)
#pragma unroll
            for (int i = 0; i < 2; ++i) vAn[h][i] = vAc[h][i];
        if (has_next) { nA = P.a_ptr(nxt); nB = P.b_ptr(nxt); P.a_off(nxt, (ui + 1) & 1, Rr, Cc, vAn); }
        { Unit u2; if (P.next(ui + 2, u2)) P.list_prefetch(u2, ui & 1, wid, lane); }
        for (int t = 0; t < nt; t += 2) {
            const bool last = (t == nt - 2);
            const char* a1 = cA + (size_t)(t + 1) * kstep;
            const char* a2 = last ? nA : cA + (size_t)(t + 2) * kstep; const char* b2 = last ? nB : cB + (size_t)(t + 2) * kstep;
            const char* a3 = a2 + kstep; const char* b3 = b2 + kstep;
            unsigned vX[2][2];
#pragma unroll
            for (int h = 0; h < 2; ++h)
#pragma unroll
                for (int i = 0; i < 2; ++i) vX[h][i] = last ? vAn[h][i] : vAc[h][i];
            PG8_LDB(B0, 0, 0); PG8_LDB(B1, 0, 1); PG8_SCHED; PG8_LDA(At, 0, 0); PG8_STAGE(PG8_SA(1, 1), a1, vAc[1]);
            PG8_WAIT_V(8); PG8_WAIT_L(0); PG8_BAR; PG8_MMA(0, 0, At, B0); PG8_MMA(0, 1, At, B1); PG8_BAR; PG8_SCHED;
            PG8_LDA(At, 0, 1); PG8_STAGE(PG8_SB(0, 0), b2, voffB); PG8_STAGE(PG8_SB(0, 1), b2 + hstepB, voffB); PG8_STAGE(PG8_SA(0, 0), a2, vX[0]);
            PG8_WAIT_V(8); PG8_WAIT_L(0); PG8_BAR; PG8_MMA(1, 0, At, B0); PG8_MMA(1, 1, At, B1); PG8_BAR; PG8_SCHED;
            PG8_LDB(B0, 1, 0); PG8_LDB(B1, 1, 1); PG8_SCHED; PG8_LDA(At, 1, 0); PG8_STAGE(PG8_SA(0, 1), a2, vX[1]);
            PG8_WAIT_V(8); PG8_WAIT_L(0); PG8_BAR; PG8_MMA(0, 0, At, B0); PG8_MMA(0, 1, At, B1); PG8_BAR; PG8_SCHED;
            PG8_LDA(At, 1, 1); PG8_STAGE(PG8_SB(1, 0), b3, voffB); PG8_STAGE(PG8_SB(1, 1), b3 + hstepB, voffB); PG8_STAGE(PG8_SA(1, 0), a3, vX[0]);
            PG8_WAIT_V(8); PG8_WAIT_L(0); PG8_BAR; PG8_MMA(1, 0, At, B0); PG8_MMA(1, 1, At, B1); PG8_BAR; PG8_SCHED;
        }
        if (wr == 0) PG8_BAR;
        if constexpr (Prob::FP8) asm volatile("s_nop 15\n\ts_nop 15" ::: "memory");
        E(acc, cur, wr, wc, fr, fq);
        if (!has_next) break;
#pragma unroll
        for (int a = 0; a < 2; ++a)
#pragma unroll
            for (int b = 0; b < 2; ++b)
#pragma unroll
                for (int m = 0; m < 4; ++m)
#pragma unroll
                    for (int n = 0; n < 2; ++n) acc[a][b][m][n] = (f32x4){0.f, 0.f, 0.f, 0.f};
        cur = nxt; cA = nA; cB = nB; ++ui;
#pragma unroll
        for (int h = 0; h < 2; ++h)
#pragma unroll
            for (int i = 0; i < 2; ++i) vAc[h][i] = vAn[h][i];
        if (wr == 1) PG8_BAR;
    }
    PG8_WAIT_V(0);
    PG8_BAR;
#undef PG8_SA
#undef PG8_SB
#undef PG8_STAGE
#undef PG8_LDA
#undef PG8_LDB
#undef PG8_MMA
#undef PG8_WAIT_V
#undef PG8_WAIT_L
#undef PG8_BAR
#undef PG8_SCHED
}
}

using pg8::Unit;
constexpr int HALF_ = 128;
struct EpiBf16Act {
    static constexpr bool PERM = true;
    bf16_t* O; int ldc; const float* bias; int act; float scale;
    __device__ __forceinline__ void operator()(const f32x4 (&acc)[2][2][4][2], const Unit& u, int wr, int wc, int fr, int fq) const {
        const int row0 = u.pm * 256 + wr * 64 + fr, col0 = u.pn * 256 + wc * 32 + 8 * fq;
        f32x4 bv[2][2];
#pragma unroll
        for (int bj = 0; bj < 2; ++bj)
#pragma unroll
            for (int n = 0; n < 2; ++n) bv[bj][n] = bias ? *(const f32x4*)(bias + col0 + bj * HALF_ + 4 * n) : (f32x4){0.f, 0.f, 0.f, 0.f};
#pragma unroll
        for (int ai = 0; ai < 2; ++ai)
#pragma unroll
            for (int m = 0; m < 4; ++m) { bf16_t* rowp = O + (size_t)(row0 + ai * HALF_ + m * 16) * ldc + col0;
#pragma unroll
                for (int bj = 0; bj < 2; ++bj) { f32x4 v0 = acc[ai][bj][m][0] + bv[bj][0], v1 = acc[ai][bj][m][1] + bv[bj][1];
                    if (act == 1) {
#pragma unroll
                        for (int j = 0; j < 4; ++j) { v0[j] = sigmoidf_(v0[j]) * scale; v1[j] = sigmoidf_(v1[j]) * scale; } }
                    else if (act == 2) {
#pragma unroll
                        for (int j = 0; j < 4; ++j) { v0[j] = 1.0f - 2.0f * __builtin_amdgcn_rcpf(__builtin_amdgcn_exp2f(2.8853900817779268f * v0[j]) + 1.0f); v1[j] = 1.0f - 2.0f * __builtin_amdgcn_rcpf(__builtin_amdgcn_exp2f(2.8853900817779268f * v1[j]) + 1.0f); } }
                    u32x4 w; w.x = cvt_pk_bf16(v0[0], v0[1]); w.y = cvt_pk_bf16(v0[2], v0[3]); w.z = cvt_pk_bf16(v1[0], v1[1]); w.w = cvt_pk_bf16(v1[2], v1[3]);
                    *(u32x4*)(rowp + bj * HALF_) = w; } }
    }
};
struct EpiQK {
    static constexpr bool PERM = true;
    bf16_t* Q; bf16_t* Kb; const float* bias; const float* ropec; const float* ropes;
    __device__ __forceinline__ void operator()(const f32x4 (&acc)[2][2][4][2], const Unit& u, int wr, int wc, int fr, int fq) const {
        int row0 = u.pm * 256 + wr * 64 + fr, cl0 = wc * 32 + 8 * fq;
        asm volatile("" : "+v"(row0), "+v"(cl0));
        const int g = (4 * wc + fq) & 7;
        bf16_t* base; int ldc;
        if (u.pn < 4) { base = Q + u.pn * 256; ldc = 1024; } else { base = Kb; ldc = 256; }
        f32x4 bv[2][2];
#pragma unroll
        for (int bj = 0; bj < 2; ++bj)
#pragma unroll
            for (int n = 0; n < 2; ++n) bv[bj][n] = *(const f32x4*)(bias + u.pn * 256 + cl0 + bj * HALF_ + 4 * n);
#pragma unroll
        for (int ai = 0; ai < 2; ++ai)
#pragma unroll
            for (int m = 0; m < 4; ++m) { const int row = row0 + ai * HALF_ + m * 16; bf16_t* rowp = base + (size_t)row * ldc + cl0;
                f32x4 cs = (f32x4){1.f, 1.f, 1.f, 1.f}, sn = (f32x4){0.f, 0.f, 0.f, 0.f};
                if (row < NX) { const int t = row & (T - 1); cs = *(const f32x4*)(ropec + t * 32 + g * 4); sn = *(const f32x4*)(ropes + t * 32 + g * 4); }
#pragma unroll
                for (int bj = 0; bj < 2; ++bj) { const f32x4 v0 = acc[ai][bj][m][0] + bv[bj][0], v1 = acc[ai][bj][m][1] + bv[bj][1];
                    const f32x4 o0 = v0 * cs - v1 * sn, o1 = v1 * cs + v0 * sn;
                    u32x4 w; w.x = cvt_pk_bf16(o0[0], o0[1]); w.y = cvt_pk_bf16(o0[2], o0[3]); w.z = cvt_pk_bf16(o1[0], o1[1]); w.w = cvt_pk_bf16(o1[2], o1[3]);
                    *(u32x4*)(rowp + bj * HALF_) = w; } }
    }
};
struct EpiVT {
    static constexpr bool PERM = true;
    bf16_t* VT; const float* biasrow;
    __device__ __forceinline__ void operator()(const f32x4 (&acc)[2][2][4][2], const Unit& u, int wr, int wc, int fr, int fq) const {
        int row0 = wr * 64 + fr, col0 = u.pn * 256 + wc * 32 + 8 * fq;
        asm volatile("" : "+v"(row0), "+v"(col0));
#pragma unroll
        for (int ai = 0; ai < 2; ++ai)
#pragma unroll
            for (int m = 0; m < 4; ++m) { const int row = row0 + ai * HALF_ + m * 16; const float b = biasrow[row]; bf16_t* rowp = VT + (size_t)row * NT + col0;
#pragma unroll
                for (int bj = 0; bj < 2; ++bj) { const f32x4 v0 = acc[ai][bj][m][0] + b, v1 = acc[ai][bj][m][1] + b;
                    u32x4 w; w.x = cvt_pk_bf16(v0[0], v0[1]); w.y = cvt_pk_bf16(v0[2], v0[3]); w.z = cvt_pk_bf16(v1[0], v1[1]); w.w = cvt_pk_bf16(v1[2], v1[3]);
                    *(u32x4*)(rowp + bj * HALF_) = w; } }
    }
};
struct EpiResid {
    static constexpr bool PERM = true;
    bf16_t* H; const float* bias; const float* ls; const float* gate;
    __device__ __forceinline__ void operator()(const f32x4 (&acc)[2][2][4][2], const Unit& u, int wr, int wc, int fr, int fq) const {
        int row0 = u.pm * 256 + wr * 64 + fr, col0 = u.pn * 256 + wc * 32 + 8 * fq;
        asm volatile("" : "+v"(row0), "+v"(col0));
        f32x4 bv[2][2], lv[2][2];
#pragma unroll
        for (int bj = 0; bj < 2; ++bj)
#pragma unroll
            for (int n = 0; n < 2; ++n) { bv[bj][n] = bias ? *(const f32x4*)(bias + col0 + bj * HALF_ + 4 * n) : (f32x4){0.f, 0.f, 0.f, 0.f};
                                          lv[bj][n] = ls ? *(const f32x4*)(ls + col0 + bj * HALF_ + 4 * n) : (f32x4){1.f, 1.f, 1.f, 1.f}; }
#pragma unroll
        for (int ai = 0; ai < 2; ++ai)
#pragma unroll
            for (int m = 0; m < 4; ++m) { const int row = row0 + ai * HALF_ + m * 16; const int brow = row < NX ? (row >> 11) : 32;
                bf16_t* hp = H + (size_t)row * D + col0; const float* gp = gate + (size_t)brow * (6 * D) + col0;
#pragma unroll
                for (int bj = 0; bj < 2; ++bj) { const u32x4 hw = *(const u32x4*)(hp + bj * HALF_);
                    const f32x4 g0 = *(const f32x4*)(gp + bj * HALF_), g1 = *(const f32x4*)(gp + bj * HALF_ + 4);
                    const f32x4 y0 = (acc[ai][bj][m][0] + bv[bj][0]) * lv[bj][0], y1 = (acc[ai][bj][m][1] + bv[bj][1]) * lv[bj][1];
                    const f32x4 h0 = (f32x4){bflo(hw.x), bfhi(hw.x), bflo(hw.y), bfhi(hw.y)} + g0 * y0, h1 = (f32x4){bflo(hw.z), bfhi(hw.z), bflo(hw.w), bfhi(hw.w)} + g1 * y1;
                    u32x4 w; w.x = cvt_pk_bf16(h0[0], h0[1]); w.y = cvt_pk_bf16(h0[2], h0[3]); w.z = cvt_pk_bf16(h1[0], h1[1]); w.w = cvt_pk_bf16(h1[2], h1[3]);
                    *(u32x4*)(hp + bj * HALF_) = w; }
                asm volatile("" ::: "memory"); }
    }
};
struct EpiMoe1 {
    static constexpr bool PERM = true;
    unsigned char* ACT; const float* b1;
    __device__ __forceinline__ void operator()(const f32x4 (&acc)[2][2][4][2], const Unit& u, int wr, int wc, int fr, int fq) const {
        const int row0 = u.rt * 256 + wr * 64 + fr, cl = u.pn * 128 + wc * 32 + 8 * fq;
        const float* bg = b1 + (size_t)u.e * 2048 + cl; const float* bl = bg + 1024;
        f32x4 bgv[2], blv[2];
#pragma unroll
        for (int n = 0; n < 2; ++n) { bgv[n] = *(const f32x4*)(bg + 4 * n); blv[n] = *(const f32x4*)(bl + 4 * n); }
#pragma unroll
        for (int ai = 0; ai < 2; ++ai)
#pragma unroll
            for (int m = 0; m < 4; ++m) { unsigned char* rowp = ACT + (size_t)(row0 + ai * HALF_ + m * 16) * D + cl;
                f32x4 o[2];
#pragma unroll
                for (int n = 0; n < 2; ++n) { const f32x4 hg = acc[ai][0][m][n] + bgv[n], hl = acc[ai][1][m][n] + blv[n];
#pragma unroll
                    for (int j = 0; j < 4; ++j) { const float gl = fminf(hg[j], 7.0f); const float li = fminf(fmaxf(hl[j], -7.0f), 7.0f);
                        o[n][j] = gl * sigmoidf_(1.702f * gl) * (li + 1.0f); } }
                u32x2 w; w.x = pk4_fp8(o[0][0], o[0][1], o[0][2], o[0][3]); w.y = pk4_fp8(o[1][0], o[1][1], o[1][2], o[1][3]);
                *(u32x2*)rowp = w; }
    }
};
struct EpiMoe2 {
    static constexpr bool PERM = true;
    unsigned char* Y; const float* b2;
    __device__ __forceinline__ void operator()(const f32x4 (&acc)[2][2][4][2], const Unit& u, int wr, int wc, int fr, int fq) const {
        const int row0 = u.rt * 256 + wr * 64 + fr, col0 = u.pn * 256 + wc * 32 + 8 * fq;
        const float* bb = b2 + (size_t)u.e * D + col0;
        f32x4 bv[2][2];
#pragma unroll
        for (int bj = 0; bj < 2; ++bj)
#pragma unroll
            for (int n = 0; n < 2; ++n) bv[bj][n] = *(const f32x4*)(bb + bj * HALF_ + 4 * n);
#pragma unroll
        for (int ai = 0; ai < 2; ++ai)
#pragma unroll
            for (int m = 0; m < 4; ++m) { unsigned char* rowp = Y + (size_t)(row0 + ai * HALF_ + m * 16) * D + col0;
#pragma unroll
                for (int bj = 0; bj < 2; ++bj) { const f32x4 v0 = (acc[ai][bj][m][0] + bv[bj][0]) * 8.0f, v1 = (acc[ai][bj][m][1] + bv[bj][1]) * 8.0f;
                    *(u32x2*)(rowp + bj * HALF_) = (u32x2){pk4_fp8(v0[0], v0[1], v0[2], v0[3]), pk4_fp8(v1[0], v1[1], v1[2], v1[3])}; } }
    }
};
typedef unsigned char fp8_t;
constexpr int SCALE_ONE = 0x7f7f7f7f, SCALE_W = 0x79797979;
struct ProbMoe1 {
    static constexpr bool FP8 = true;
    const fp8_t* FX; const fp8_t* W1T; const int* list; const LAS int* tpre; const LAS int* cnt; const LAS unsigned char* texp; LAS int* toks; int scale_w, scale_x; pg8::TileOrder ord;
    __device__ __forceinline__ int ldb_bytes() const { return D; }
    __device__ __forceinline__ int ntiles() const { return D / 128; }
    __device__ __forceinline__ bool next(int i, Unit& u) const {
        if (!ord.next(i, u.pm, u.pn)) return false;
        u.rt = u.pm; u.e = texp[u.rt]; return true;
    }
    __device__ __forceinline__ const char* a_ptr(const Unit&) const { return (const char*)FX; }
    __device__ __forceinline__ const char* b_ptr(const Unit& u) const { return (const char*)(W1T + ((size_t)u.e * 2048 + (size_t)u.pn * 256) * D); }
    __device__ __forceinline__ void list_prefetch(const Unit& u, int par, int wid, int lane) const {
        if (wid == 0) { const int* src = list + (size_t)u.e * NT + (u.rt - tpre[u.e]) * 256 + 4 * lane;
            __builtin_amdgcn_global_load_lds((const unsigned*)src, (LAS unsigned*)(toks + par * 256), 16, 0, 0); }
    }
    __device__ __forceinline__ void a_off(const Unit& u, int par, const int (&R)[2], const int (&C)[2], unsigned (&v)[2][2]) const {
        const int nvalid = cnt[u.e] - (u.rt - tpre[u.e]) * 256; const LAS int* tk = toks + par * 256;
#pragma unroll
        for (int h = 0; h < 2; ++h)
#pragma unroll
            for (int i = 0; i < 2; ++i) { const int r = h * 128 + R[i]; const int tok = tk[r < nvalid ? r : 0]; v[h][i] = (unsigned)(tok * D + C[i] * 2); }
    }
};
struct ProbMoe2 {
    static constexpr bool FP8 = true;
    const fp8_t* ACT; const fp8_t* W2T; const LAS int* tpre; const LAS unsigned char* texp; int scale_w, scale_x; pg8::TileOrder ord;
    __device__ __forceinline__ int ldb_bytes() const { return D; }
    __device__ __forceinline__ int ntiles() const { return D / 128; }
    __device__ __forceinline__ bool next(int i, Unit& u) const {
        if (!ord.next(i, u.pm, u.pn)) return false;
        u.rt = u.pm; u.e = texp[u.rt]; return true;
    }
    __device__ __forceinline__ const char* a_ptr(const Unit& u) const { return (const char*)(ACT + (size_t)u.rt * 256 * D); }
    __device__ __forceinline__ const char* b_ptr(const Unit& u) const { return (const char*)(W2T + ((size_t)u.e * 1024 + (size_t)u.pn * 256) * D); }
    __device__ __forceinline__ void list_prefetch(const Unit&, int, int, int) const {}
    __device__ __forceinline__ void a_off(const Unit&, int, const int (&R)[2], const int (&C)[2], unsigned (&v)[2][2]) const {
#pragma unroll
        for (int h = 0; h < 2; ++h)
#pragma unroll
            for (int i = 0; i < 2; ++i) v[h][i] = (unsigned)((h * 128 + R[i]) * D + C[i] * 2);
    }
};
struct Args { const float* in[38]; float* out; unsigned char* ws; int phase; int one; };
enum { I_X = 0, I_C, I_CTX, I_CCTX, I_ADAW, I_ADAB, I_NORMG, I_AWQKV, I_ABQKV, I_AWO, I_ABO, I_ASINK, I_PW, I_PB, I_PS,
       I_RMIX, I_RWRKV, I_RW0, I_RW1, I_RW2, I_RA0, I_RA1, I_RA2, I_RG1, I_RG2, I_RKK, I_RKA, I_RRK, I_RLNW, I_RLNB, I_RWO,
       I_MWR, I_MBR, I_MW1, I_MB1, I_MW2, I_MB2, I_FG };
struct Frame { LAS unsigned char* lds; int tid, lane, wave, G, c; unsigned char* ws; unsigned* ctl; };
#define WSP(T_, off) ((T_*)(F.ws + (off)))

struct TJob { const float* src; unsigned char* dst; long sbs, dbs; int ldw, ldt, nkb, nnb, mode, item0, per, esz; };
__device__ __forceinline__ int dst_row(int mode, int n) {
    if (mode == 1) { const int hb = n & ~63, d = n & 63; const int ax = d >> 5, dd = d & 31, hf = dd >> 4, f = dd & 15; const int g = ax * 4 + (f >> 2), i = (f & 3) + 4 * hf; return hb + 8 * g + i; }
    if (mode == 2) { return n < 1024 ? ((n >> 7) << 8) + (n & 127) : (((n - 1024) >> 7) << 8) + 128 + (n & 127); }
    return n;
}
struct TItem { const float* src; unsigned char* dst; int ldw, ldt, mode, n0, esz; };
__device__ __forceinline__ void titem_decode(const LAS TJob* jobs, int nj, int it, TItem& T) {
    int ji = 0;
    for (int q = 1; q < nj; ++q) ji += (jobs[q].item0 <= it) ? 1 : 0;
    const LAS TJob& J = jobs[ji]; const int r = it - J.item0, bi = r / J.per, rr = r % J.per, kb = rr / J.nnb, nb = rr % J.nnb;
    T.src = J.src + bi * J.sbs + (size_t)(64 * kb) * J.ldw + 32 * nb; T.dst = J.dst + (bi * J.dbs + 64 * kb) * J.esz; T.ldw = J.ldw; T.ldt = J.ldt; T.mode = J.mode; T.n0 = 32 * nb; T.esz = J.esz;
}
__device__ __forceinline__ void titem_load(const TItem& T, int lane, f32x4 (&v)[8]) {
    const float* p = T.src + (size_t)(lane >> 3) * T.ldw + 4 * (lane & 7);
#pragma unroll
    for (int i = 0; i < 8; ++i) v[i] = *(const f32x4*)(p + (size_t)(8 * i) * T.ldw);
}
__device__ __forceinline__ void titem_store(const TItem& T, int lane, const f32x4 (&v)[8], LAS float* scr) {
#pragma unroll
    for (int i = 0; i < 8; ++i) { LAS float* d = scr + (8 * i + (lane >> 3)) * 33 + 4 * (lane & 7); d[0] = v[i].x; d[1] = v[i].y; d[2] = v[i].z; d[3] = v[i].w; }
    LDS_WAIT(); asm volatile("" ::: "memory");
    const int c = lane & 7;
#pragma unroll
    for (int j = 0; j < 4; ++j) { const int n = (lane >> 3) + 8 * j; const LAS float* s = scr + (8 * c) * 33 + n;
        const size_t eo = (size_t)dst_row(T.mode, T.n0 + n) * T.ldt + 8 * c;
        if (T.esz == 2) { u32x4 o; o.x = pk2(s[0 * 33], s[1 * 33]); o.y = pk2(s[2 * 33], s[3 * 33]); o.z = pk2(s[4 * 33], s[5 * 33]); o.w = pk2(s[6 * 33], s[7 * 33]); *(u32x4*)(T.dst + eo * 2) = o; }
        else { u32x2 o; o.x = pk4_fp8(64.f * s[0 * 33], 64.f * s[1 * 33], 64.f * s[2 * 33], 64.f * s[3 * 33]); o.y = pk4_fp8(64.f * s[4 * 33], 64.f * s[5 * 33], 64.f * s[6 * 33], 64.f * s[7 * 33]); *(u32x2*)(T.dst + eo) = o; } }
    LDS_WAIT(); asm volatile("" ::: "memory");
}
__device__ __forceinline__ void phase_prologue(Frame& F, const Args& A) {
    REFRESH(F);
    LAS float* S = (LAS float*)F.lds;
    for (int idx = F.tid; idx < 33 * 1024; idx += NTHREADS) { const int r = idx >> 10, k = idx & 1023; const float v = r < 32 ? A.in[I_C][r * 1024 + k] : A.in[I_CCTX][k]; S[k * 33 + r] = v / (1.0f + __expf(-v)); }
    __syncthreads();
    float* MOD = WSP(float, WS_MOD);
    for (int it = F.c; it < 4 * 96; it += F.G) {
        const int layer = it / 96, n = (it % 96) * 64 + F.lane; const float* wp = A.in[I_ADAW] + (size_t)layer * 1024 * 6144 + n;
        float acc[5] = {0.f, 0.f, 0.f, 0.f, 0.f};
        for (int k0 = 0; k0 < 1024; k0 += 32) {
            float wv[32];
#pragma unroll
            for (int u = 0; u < 32; ++u) wv[u] = wp[(size_t)(k0 + u) * 6144];
#pragma unroll
            for (int u = 0; u < 32; ++u) { const LAS float* sr = S + (k0 + u) * 33 + F.wave;
                acc[0] += sr[0] * wv[u]; acc[1] += sr[8] * wv[u]; acc[2] += sr[16] * wv[u]; acc[3] += sr[24] * wv[u]; if (F.wave == 0) acc[4] += S[(k0 + u) * 33 + 32] * wv[u]; }
        }
        const float bb = A.in[I_ADAB][layer * 6144 + n];
#pragma unroll
        for (int i = 0; i < 4; ++i) MOD[((size_t)layer * 33 + F.wave + 8 * i) * 6144 + n] = acc[i] + bb;
        if (F.wave == 0) MOD[((size_t)layer * 33 + 32) * 6144 + n] = acc[4] + bb;
    }
    { float* rc = WSP(float, WS_ROPEC); float* rs = WSP(float, WS_ROPES);
      for (int idx = F.c * NTHREADS + F.tid; idx < 2048 * 32; idx += F.G * NTHREADS) { const int t = idx >> 5, e = idx & 31, g = e >> 2, i = e & 3, f = 4 * (g & 3) + i;
          const float inv = powf(10000.0f, -(float)f / 16.0f); const float pos = (float)(g < 4 ? (t >> 6) : (t & 63)); const float ang = pos * inv; rc[idx] = cosf(ang); rs[idx] = sinf(ang); }
      float* bq = WSP(float, WS_BQK);
      for (int idx = F.c * NTHREADS + F.tid; idx < 2 * 1280; idx += F.G * NTHREADS) { const int j = idx / 1280, n = idx % 1280; bq[j * 1280 + dst_row(1, n)] = A.in[I_ABQKV][j * 1536 + n]; } }
    __syncthreads();
    LAS TJob* jobs = (LAS TJob*)(F.lds + JOB_OFF); LAS int* njobs = (LAS int*)(F.lds + MISC_OFF + 64);
    if (F.tid == 0) {
        int nj = 0, item = 0;
        auto add = [&](const float* src, bf16_t* dst, int ldw, int ldt, int Ks, int Ns, int mode, int nb, long sbs, long dbs, int esz = 2) {
            LAS TJob& j = jobs[nj]; j.src = src; j.dst = (unsigned char*)dst; j.sbs = sbs; j.dbs = dbs; j.ldw = ldw; j.ldt = ldt; j.nkb = Ks / 64; j.nnb = Ns / 32; j.mode = mode; j.item0 = item; j.per = (Ks / 64) * (Ns / 32); j.esz = esz;
            ++nj; item += (Ks / 64) * (Ns / 32) * nb; };
        add(A.in[I_AWQKV], WSP(bf16_t, WS_WQK), 1536, 1024, 1024, 1280, 1, 2, 1024L * 1536, 1280L * 1024, 1);
        add(A.in[I_AWQKV] + 1280, WSP(bf16_t, WS_WV), 1536, 1024, 1024, 256, 0, 2, 1024L * 1536, 256L * 1024, 1);
        add(A.in[I_AWO], WSP(bf16_t, WS_WO), 1024, 1024, 1024, 1024, 0, 2, 1L << 20, 1L << 20, 1);
        add(A.in[I_PW], WSP(bf16_t, WS_POOLW), 256, 256, 256, 256, 0, 4, 65536, 65536);
        add(A.in[I_RWRKV], WSP(bf16_t, WS_WRKV), 1024, 1024, 1024, 1024, 0, 3, 1L << 20, 1L << 20, 1);
        add(A.in[I_RG1], WSP(bf16_t, WS_WL1), 128, 1024, 1024, 128, 0, 1, 0, 0);
        add(A.in[I_RW1], WSP(bf16_t, WS_WL1) + 256 * 1024, 64, 1024, 1024, 64, 0, 2, 65536, 65536);
        add(A.in[I_RA1], WSP(bf16_t, WS_WL1) + 2 * 256 * 1024, 64, 1024, 1024, 64, 0, 2, 65536, 65536);
        add(A.in[I_RG2], WSP(bf16_t, WS_WL2), 1024, 256, 128, 1024, 0, 1, 0, 0);
        add(A.in[I_RW2], WSP(bf16_t, WS_WL2) + 1 * 1024 * 256, 1024, 256, 64, 1024, 0, 2, 65536, 1024L * 256 + 64);
        add(A.in[I_RA2], WSP(bf16_t, WS_WL2) + 3 * 1024 * 256, 1024, 256, 64, 1024, 0, 2, 65536, 1024L * 256 + 64);
        add(A.in[I_RWO], WSP(bf16_t, WS_WOR), 1024, 1024, 1024, 1024, 0, 1, 0, 0, 1);
        add(A.in[I_MW1], WSP(bf16_t, WS_W1T), 2048, 1024, 1024, 2048, 2, 128, 1024L * 2048, 2048L * 1024, 1);
        add(A.in[I_MW2], WSP(bf16_t, WS_W2T), 1024, 1024, 1024, 1024, 0, 128, 1L << 20, 1L << 20, 1);
        njobs[0] = nj; njobs[1] = item;
    }
    __syncthreads();
    { const int nj = njobs[0], nitems = njobs[1]; LAS float* scr = (LAS float*)(F.lds + F.wave * 16384);
      const int gw = F.c * NWAVES + F.wave, NGW = F.G * NWAVES;
      int it = gw;
      if (it < nitems) {
          TItem Tc, Tn; f32x4 vc[8], vn[8];
          titem_decode(jobs, nj, it, Tc); titem_load(Tc, F.lane, vc);
          for (;;) {
              const int itn = it + NGW; const bool more = itn < nitems;
              if (more) { titem_decode(jobs, nj, itn, Tn); titem_load(Tn, F.lane, vn); }
              titem_store(Tc, F.lane, vc, scr);
              if (!more) break;
              Tc = Tn;
#pragma unroll
              for (int i = 0; i < 8; ++i) vc[i] = vn[i];
              it = itn;
          }
      } }
    __syncthreads();
}

__device__ __forceinline__ void moe_tiles(Frame& F, int layer) {
    REFRESH(F);
    LAS int* lcnt = (LAS int*)(F.lds + LCNT_OFF); LAS int* tpre = (LAS int*)(F.lds + TPRE_OFF);
    __syncthreads();
    if (F.tid < NE) lcnt[F.tid] = (int)__hip_atomic_load(F.ctl + CW_GCNT + layer * 64 + F.tid, __ATOMIC_RELAXED, __HIP_MEMORY_SCOPE_AGENT);
    __syncthreads();
    if (F.tid == 0) { int s = 0; for (int e = 0; e < NE; ++e) { tpre[e] = s; s += (lcnt[e] + 255) >> 8; } tpre[NE] = s; }
    __syncthreads();
    { LAS unsigned char* texp = (LAS unsigned char*)(F.lds + TEXP_OFF); const int nrt = tpre[NE];
      for (int rt = F.tid; rt < nrt; rt += NTHREADS) { int e = 0; for (int j = 1; j < NE; ++j) e += (tpre[j] <= rt) ? 1 : 0; texp[rt] = (unsigned char)e; } }
    __syncthreads();
}
constexpr int RB = 2;
#define ROWOF(it, r) ((((it) * F.G + F.c) * NWAVES + F.wave) * RB + (r))
struct MoeRef { int p[4]; float g[4]; };
__device__ __forceinline__ void moe_ref_load(Frame& F, int row, MoeRef& R) {
    const int4 pp = *(const int4*)(WSP(int, WS_POS) + (size_t)row * 4); const f32x4 gg = *(const f32x4*)(WSP(float, WS_GATE) + (size_t)row * 4);
    R.p[0] = pp.x; R.p[1] = pp.y; R.p[2] = pp.z; R.p[3] = pp.w; R.g[0] = gg.x; R.g[1] = gg.y; R.g[2] = gg.z; R.g[3] = gg.w;
}
__device__ __forceinline__ void moe_rows_load(Frame& F, const MoeRef& R, unsigned (&y)[4][4]) {
    const LAS int* tpre = (const LAS int*)(F.lds + TPRE_OFF); const unsigned char* Y = WSP(unsigned char, WS_Y);
#pragma unroll
    for (int k = 0; k < 4; ++k) { const int e = R.p[k] >> 20, slot = R.p[k] & 0xfffff; const size_t fr = (size_t)tpre[e] * 256 + slot; const unsigned* yp = (const unsigned*)(Y + fr * D) + F.lane;
#pragma unroll
        for (int j = 0; j < 4; ++j) y[k][j] = yp[64 * j]; }
}
__device__ __forceinline__ f32x4 moe_rows_sum(const MoeRef& R, const unsigned (&y)[4][4], int j) {
    f32x4 s = (f32x4){0.f, 0.f, 0.f, 0.f};
#pragma unroll
    for (int k = 0; k < 4; ++k) { const int w = (int)y[k][j]; const f32x2 lo = __builtin_amdgcn_cvt_pk_f32_fp8(w, false), hi = __builtin_amdgcn_cvt_pk_f32_fp8(w, true);
        s += (R.g[k] * 0.125f) * (f32x4){lo.x, lo.y, hi.x, hi.y}; }
    return s;
}

__device__ __forceinline__ void phase_norm1(Frame& F, const Args& A, int layer) {
    REFRESH(F);
    if (layer > 0) moe_tiles(F, layer - 1);
    bf16_t* H = WSP(bf16_t, WS_H); bf16_t* AX = WSP(bf16_t, WS_AX); const float* MOD = WSP(float, WS_MOD);
    const float* g1 = A.in[I_NORMG] + (size_t)(layer * 2 + 0) * D;
    f32x4 gg[4];
#pragma unroll
    for (int j = 0; j < 4; ++j) gg[j] = ((const f32x4*)g1)[64 * j + F.lane];
    for (int it = 0;; ++it) { if (ROWOF(it, 0) >= NT) break;
        f32x4 v[RB][4]; int brow[RB];
        if (layer == 0) {
#pragma unroll
            for (int r = 0; r < RB; ++r) { const int row = ROWOF(it, r); brow[r] = row < NX ? (row >> 11) : 32; const float* src = row < NX ? A.in[I_X] + (size_t)row * D : A.in[I_CTX] + (size_t)(row - NX) * D;
#pragma unroll
                for (int j = 0; j < 4; ++j) v[r][j] = ((const f32x4*)src)[64 * j + F.lane]; }
        } else {
            MoeRef R[RB]; unsigned y[RB][4][4]; f32x4 gv[RB][4];
#pragma unroll
            for (int r = 0; r < RB; ++r) moe_ref_load(F, ROWOF(it, r), R[r]);
#pragma unroll
            for (int r = 0; r < RB; ++r) { const int row = ROWOF(it, r); brow[r] = row < NX ? (row >> 11) : 32; moe_rows_load(F, R[r], y[r]);
                const float* g2p = MOD + ((size_t)(layer - 1) * 33 + brow[r]) * 6144 + 5 * D;
#pragma unroll
                for (int j = 0; j < 4; ++j) { v[r][j] = ld_bf4(H + (size_t)row * D + 256 * j + 4 * F.lane); gv[r][j] = ((const f32x4*)g2p)[64 * j + F.lane]; } }
#pragma unroll
            for (int r = 0; r < RB; ++r)
#pragma unroll
                for (int j = 0; j < 4; ++j) v[r][j] = v[r][j] + gv[r][j] * moe_rows_sum(R[r], y[r], j);
        }
        float rstd[RB];
#pragma unroll
        for (int r = 0; r < RB; ++r) { const int row = ROWOF(it, r); float ss = 0.f;
#pragma unroll
            for (int j = 0; j < 4; ++j) { st_bf4(H + (size_t)row * D + 256 * j + 4 * F.lane, v[r][j]); ss += (v[r][j].x * v[r][j].x + v[r][j].y * v[r][j].y) + (v[r][j].z * v[r][j].z + v[r][j].w * v[r][j].w); }
            rstd[r] = 1.0f / sqrtf(wave_sum(ss) * (1.0f / D) + 1e-5f); }
#pragma unroll
        for (int r = 0; r < RB; ++r) { const int row = ROWOF(it, r); const float* mp = MOD + ((size_t)layer * 33 + brow[r]) * 6144;
#pragma unroll
            for (int j = 0; j < 4; ++j) { const f32x4 sh = ((const f32x4*)mp)[64 * j + F.lane], sc = ((const f32x4*)(mp + D))[64 * j + F.lane];
                const f32x4 o = v[r][j] * rstd[r] * gg[j] * (sc + 1.0f) + sh;
                if (layer % 3 == 0) ((unsigned*)((unsigned char*)AX + (size_t)row * D))[64 * j + F.lane] = pk4_fp8(o.x, o.y, o.z, o.w);
                else { u32x2 w; w.x = pk2(o.x, o.y); w.y = pk2(o.z, o.w); ((u32x2*)(AX + (size_t)row * D))[64 * j + F.lane] = w; } } }
    }
}
__device__ __forceinline__ void phase_final(Frame& F, const Args& A) {
    REFRESH(F);
    moe_tiles(F, DEPTH - 1);
    const bf16_t* H = WSP(bf16_t, WS_H); const float* MOD = WSP(float, WS_MOD); const float* fg = A.in[I_FG];
    f32x4 gg[4];
#pragma unroll
    for (int j = 0; j < 4; ++j) gg[j] = ((const f32x4*)fg)[64 * j + F.lane];
    for (int it = 0;; ++it) { if (ROWOF(it, 0) >= NX) break;
        MoeRef R[RB]; unsigned y[RB][4][4]; f32x4 v[RB][4], gv[RB][4];
#pragma unroll
        for (int r = 0; r < RB; ++r) moe_ref_load(F, ROWOF(it, r), R[r]);
#pragma unroll
        for (int r = 0; r < RB; ++r) { const int row = ROWOF(it, r); moe_rows_load(F, R[r], y[r]); const float* g2p = MOD + ((size_t)(DEPTH - 1) * 33 + (row >> 11)) * 6144 + 5 * D;
#pragma unroll
            for (int j = 0; j < 4; ++j) { v[r][j] = ld_bf4(H + (size_t)row * D + 256 * j + 4 * F.lane); gv[r][j] = ((const f32x4*)g2p)[64 * j + F.lane]; } }
#pragma unroll
        for (int r = 0; r < RB; ++r) { const int row = ROWOF(it, r); float ss = 0.f;
#pragma unroll
            for (int j = 0; j < 4; ++j) { v[r][j] = v[r][j] + gv[r][j] * moe_rows_sum(R[r], y[r], j); ss += (v[r][j].x * v[r][j].x + v[r][j].y * v[r][j].y) + (v[r][j].z * v[r][j].z + v[r][j].w * v[r][j].w); }
            const float rstd = 1.0f / sqrtf(wave_sum(ss) * (1.0f / D) + 1e-5f);
#pragma unroll
            for (int j = 0; j < 4; ++j) ((f32x4*)(A.out + (size_t)row * D))[64 * j + F.lane] = v[r][j] * rstd * gg[j]; }
    }
}

template <int DD> __device__ __forceinline__ float dpp_ror(float v) { return __builtin_bit_cast(float, __builtin_amdgcn_update_dpp(0, __builtin_bit_cast(int, v), 0x120 + DD, 0xf, 0xf, false)); }
template <int DD> __device__ __forceinline__ void rank_step(float v0, float v1, int e0, int& r0, int& r1) {
    const float u0 = dpp_ror<DD>(v0), u1 = dpp_ror<DD>(v1); const bool low = DD <= e0;
    r0 += (u0 > v0 || (u0 == v0 && low)) ? 1 : 0; r0 += (u1 > v0) ? 1 : 0;
    r1 += (u0 >= v1) ? 1 : 0; r1 += (u1 > v1 || (u1 == v1 && low)) ? 1 : 0;
}
__device__ __forceinline__ float row_allmax(float v) { v = fmaxf(v, dpp_ror<8>(v)); v = fmaxf(v, dpp_ror<4>(v)); v = fmaxf(v, dpp_ror<2>(v)); v = fmaxf(v, dpp_ror<1>(v)); return v; }
__device__ __forceinline__ float row_allsum(float v) { v += dpp_ror<8>(v); v += dpp_ror<4>(v); v += dpp_ror<2>(v); v += dpp_ror<1>(v); return v; }
__device__ __forceinline__ void phase_route(Frame& F, const Args& A, int layer) {
    REFRESH(F);
    const int nrows = (layer == DEPTH - 1) ? NX : NT; const int TPB = nrows / 16 / F.G;
    LAS float* wT = (LAS float*)F.lds;
    LAS int* lcnt = (LAS int*)(F.lds + LCNT_OFF); LAS int* lbase = (LAS int*)(F.lds + LBASE_OFF);
    LAS unsigned* recp = (LAS unsigned*)(F.lds + REC_OFF); LAS float* recg = (LAS float*)(F.lds + REC_OFF + 4608);
    __syncthreads();
    { const float* wr = A.in[I_MWR] + (size_t)layer * D * NE;
      for (int idx = F.tid; idx < D * NE; idx += NTHREADS) wT[(idx & 31) * 1024 + (idx >> 5)] = wr[idx]; }
    if (F.tid < NE) lcnt[F.tid] = 0;
    __syncthreads();
    const bf16_t* H = WSP(bf16_t, WS_H); unsigned char* FX = WSP(unsigned char, WS_FX); const float* MOD = WSP(float, WS_MOD);
    const float* g2 = A.in[I_NORMG] + (size_t)(layer * 2 + 1) * D; const float* br = A.in[I_MBR] + layer * NE;
    const int l = F.lane, r16 = l & 15, q4 = l >> 4; const float b0 = br[r16], b1 = br[16 + r16];
    for (int k = F.wave; k < TPB; k += NWAVES) {
        const int row0 = (F.c * TPB + k) * 16, row = row0 + r16; const int brow = row0 < NX ? (row0 >> 11) : 32;
        const float* mp = MOD + ((size_t)layer * 33 + brow) * 6144 + 3 * D;
        const bf16_t* hp = H + (size_t)row * D + 8 * q4; float ss = 0.f;
#pragma unroll 8
        for (int j = 0; j < 32; ++j) { const u32x4 w = *(const u32x4*)(hp + 32 * j); const float a0 = bflo(w.x), a1 = bfhi(w.x), a2 = bflo(w.y), a3 = bfhi(w.y), a4 = bflo(w.z), a5 = bfhi(w.z), a6 = bflo(w.w), a7 = bfhi(w.w);
            ss += ((a0 * a0 + a1 * a1) + (a2 * a2 + a3 * a3)) + ((a4 * a4 + a5 * a5) + (a6 * a6 + a7 * a7)); }
        ss += __shfl_xor(ss, 16); ss += __shfl_xor(ss, 32);
        const float rstd = 1.0f / sqrtf(ss * (1.0f / D) + 1e-5f);
        f32x4 acc0 = (f32x4){0.f, 0.f, 0.f, 0.f}, acc1 = acc0;
        const float* gp = g2 + 8 * q4; const float* shp = mp + 8 * q4; const float* scp = mp + D + 8 * q4; unsigned char* fxp = FX + (size_t)row * D + 8 * q4;
        const LAS float* w0p = wT + r16 * 1024 + 8 * q4; const LAS float* w1p = wT + (16 + r16) * 1024 + 8 * q4;
#pragma unroll 2
        for (int j = 0; j < 32; ++j) { const u32x4 w = *(const u32x4*)(hp + 32 * j);
            const f32x4 ga = *(const f32x4*)(gp + 32 * j), gb = *(const f32x4*)(gp + 32 * j + 4), sa = *(const f32x4*)(shp + 32 * j), sb = *(const f32x4*)(shp + 32 * j + 4), ca = *(const f32x4*)(scp + 32 * j), cb = *(const f32x4*)(scp + 32 * j + 4);
            const f32x4 fa = (f32x4){bflo(w.x), bfhi(w.x), bflo(w.y), bfhi(w.y)} * rstd * ga * (ca + 1.0f) + sa, fb = (f32x4){bflo(w.z), bfhi(w.z), bflo(w.w), bfhi(w.w)} * rstd * gb * (cb + 1.0f) + sb;
            *(u32x2*)(fxp + 32 * j) = (u32x2){pk4_fp8(fa.x, fa.y, fa.z, fa.w), pk4_fp8(fb.x, fb.y, fb.z, fb.w)};
            const f32x4 w0a = *(const LAS f32x4*)(w0p + 32 * j), w0b = *(const LAS f32x4*)(w0p + 32 * j + 4), w1a = *(const LAS f32x4*)(w1p + 32 * j), w1b = *(const LAS f32x4*)(w1p + 32 * j + 4);
#pragma unroll
            for (int s4 = 0; s4 < 4; ++s4) { acc0 = __builtin_amdgcn_mfma_f32_16x16x4f32(fa[s4], w0a[s4], acc0, 0, 0, 0); acc1 = __builtin_amdgcn_mfma_f32_16x16x4f32(fa[s4], w1a[s4], acc1, 0, 0, 0); }
#pragma unroll
            for (int s4 = 0; s4 < 4; ++s4) { acc0 = __builtin_amdgcn_mfma_f32_16x16x4f32(fb[s4], w0b[s4], acc0, 0, 0, 0); acc1 = __builtin_amdgcn_mfma_f32_16x16x4f32(fb[s4], w1b[s4], acc1, 0, 0, 0); } }
#pragma unroll
        for (int reg = 0; reg < 4; ++reg) {
            const float v0 = acc0[reg] + b0, v1 = acc1[reg] + b1; int r0 = (v1 > v0) ? 1 : 0, r1 = (v0 >= v1) ? 1 : 0;
            rank_step<1>(v0, v1, r16, r0, r1); rank_step<2>(v0, v1, r16, r0, r1); rank_step<3>(v0, v1, r16, r0, r1); rank_step<4>(v0, v1, r16, r0, r1); rank_step<5>(v0, v1, r16, r0, r1);
            rank_step<6>(v0, v1, r16, r0, r1); rank_step<7>(v0, v1, r16, r0, r1); rank_step<8>(v0, v1, r16, r0, r1); rank_step<9>(v0, v1, r16, r0, r1); rank_step<10>(v0, v1, r16, r0, r1);
            rank_step<11>(v0, v1, r16, r0, r1); rank_step<12>(v0, v1, r16, r0, r1); rank_step<13>(v0, v1, r16, r0, r1); rank_step<14>(v0, v1, r16, r0, r1); rank_step<15>(v0, v1, r16, r0, r1);
            const float mx = row_allmax(fmaxf(v0, v1));
            const float x0 = r0 < 4 ? __expf(v0 - mx) : 0.f, x1 = r1 < 4 ? __expf(v1 - mx) : 0.f;
            const float inv = 1.0f / row_allsum(x0 + x1);
            const int lr = k * 16 + 4 * q4 + reg;
            if (r0 < 4) { const int rk = __hip_atomic_fetch_add(lcnt + r16, 1, __ATOMIC_RELAXED, __HIP_MEMORY_SCOPE_WORKGROUP); recp[lr * 4 + r0] = ((unsigned)r16 << 20) | (unsigned)rk; recg[lr * 4 + r0] = x0 * inv; }
            if (r1 < 4) { const int rk = __hip_atomic_fetch_add(lcnt + 16 + r16, 1, __ATOMIC_RELAXED, __HIP_MEMORY_SCOPE_WORKGROUP); recp[lr * 4 + r1] = ((unsigned)(16 + r16) << 20) | (unsigned)rk; recg[lr * 4 + r1] = x1 * inv; }
        }
    }
    __syncthreads();
    if (F.tid < NE) lbase[F.tid] = (int)__hip_atomic_fetch_add(F.ctl + CW_GCNT + layer * 64 + F.tid, (unsigned)lcnt[F.tid], __ATOMIC_RELAXED, __HIP_MEMORY_SCOPE_AGENT);
    __syncthreads();
    int* LIST = WSP(int, WS_LIST); int* POS = WSP(int, WS_POS); float* GATE = WSP(float, WS_GATE);
    for (int r = F.tid; r < TPB * 16 * 4; r += NTHREADS) { const int lr = r >> 2, kk = r & 3; const int row = F.c * TPB * 16 + lr;
        const unsigned qx = recp[r]; const float qg = recg[r]; const int e = qx >> 20, slot = lbase[e] + (int)(qx & 0xfffff);
        LIST[(size_t)e * NT + slot] = row; POS[(size_t)row * 4 + kk] = (e << 20) | slot; GATE[(size_t)row * 4 + kk] = qg; }
    __syncthreads();
}

__device__ __forceinline__ void phase_pooldiff(Frame& F) {
    REFRESH(F);
    const bf16_t* AX = WSP(bf16_t, WS_AX); bf16_t* PD = WSP(bf16_t, WS_PD);
    for (int it = 0;; ++it) { if (ROWOF(it, 0) >= NT) break;
        const int row0 = ROWOF(it, 0); int sb, t, n; seq_of(row0, sb, t, n);
#pragma unroll
        for (int j = 0; j < 4; ++j) { const int half = 1 << j; const int col = 256 * j + 4 * F.lane;
            f32x4 s0 = (f32x4){0.f, 0.f, 0.f, 0.f}, s1 = s0, me0 = s0, me1 = s0;
#pragma unroll
            for (int q = 0; q < 2 * half + 1; ++q) { const int uu = t - half + q;
                if (uu >= 0 && uu < n) { const f32x4 x = ld_bf4(AX + (size_t)(sb + uu) * D + col); if (q < 2 * half) s0 += x; if (q > 0) s1 += x; if (q == half) me0 = x; if (q == half + 1) me1 = x; } }
            const int lo0 = t - half < 0 ? 0 : t - half, hi0 = t + half > n ? n : t + half, lo1 = t + 1 - half < 0 ? 0 : t + 1 - half, hi1 = t + 1 + half > n ? n : t + 1 + half;
            st_bf4(PD + (size_t)row0 * D + col, s0 * (1.0f / (float)(hi0 - lo0)) - me0);
            st_bf4(PD + (size_t)(row0 + 1) * D + col, s1 * (1.0f / (float)(hi1 - lo1)) - me1); }
    }
}
__device__ __forceinline__ void phase_rwkv_mix(Frame& F, const Args& A) {
    REFRESH(F);
    const bf16_t* AX = WSP(bf16_t, WS_AX); bf16_t* A6 = WSP(bf16_t, WS_A6); const float* mix = A.in[I_RMIX];
    for (int it = 0;; ++it) { if (ROWOF(it, 0) >= NT) break;
        const int row0 = ROWOF(it, 0); int sb, t, n; seq_of(row0, sb, t, n);
#pragma unroll
        for (int j = 0; j < 4; ++j) { const int col = 256 * j + 4 * F.lane; const f32x4 z = (f32x4){0.f, 0.f, 0.f, 0.f};
            const f32x4 h0 = ld_bf4(AX + (size_t)row0 * D + col), h1 = ld_bf4(AX + (size_t)(row0 + 1) * D + col);
            const f32x4 hp = t > 0 ? ld_bf4(AX + (size_t)(row0 - 1) * D + col) : z, hn = t + 1 < n - 1 ? ld_bf4(AX + (size_t)(row0 + 2) * D + col) : z;
            const f32x4 xx0 = (hp + h1) * 0.5f - h0, xx1 = (h0 + hn) * 0.5f - h1;
#pragma unroll
            for (int i = 0; i < 6; ++i) { const f32x4 m = *(const f32x4*)(mix + i * D + col); const f32x4 o0 = h0 + xx0 * m, o1 = h1 + xx1 * m;
                if (i == 0 || i == 2 || i == 3) { unsigned char* p8 = (unsigned char*)(A6 + (size_t)i * NT * D);
                    *(unsigned*)(p8 + (size_t)row0 * D + col) = pk4_fp8(o0.x, o0.y, o0.z, o0.w); *(unsigned*)(p8 + (size_t)(row0 + 1) * D + col) = pk4_fp8(o1.x, o1.y, o1.z, o1.w); }
                else { st_bf4(A6 + ((size_t)i * NT + row0) * D + col, o0); st_bf4(A6 + ((size_t)i * NT + row0 + 1) * D + col, o1); } } }
    }
}
__device__ __forceinline__ float rl(float x, int k) { return __builtin_bit_cast(float, __builtin_amdgcn_readlane(__builtin_bit_cast(int, x), k)); }
typedef float f32x16 __attribute__((ext_vector_type(16)));
constexpr int SCW = 33792;
__device__ __forceinline__ int kpos(int k) { return (k & ~12) | ((k & 4) << 1) | ((k & 8) >> 1); }
__device__ __forceinline__ bf16x8 acc_frag(const f32x16& X, int s2) {
    u32x4 w; w.x = cvt_pk_bf16(X[8 * s2 + 0], X[8 * s2 + 1]); w.y = cvt_pk_bf16(X[8 * s2 + 2], X[8 * s2 + 3]); w.z = cvt_pk_bf16(X[8 * s2 + 4], X[8 * s2 + 5]); w.w = cvt_pk_bf16(X[8 * s2 + 6], X[8 * s2 + 7]);
    return __builtin_bit_cast(bf16x8, w);
}
#define MFMA32(a, b, c) __builtin_amdgcn_mfma_f32_32x32x16_bf16(a, b, c, 0, 0, 0)
__device__ __forceinline__ void phase_rwkv_scan(Frame& F, const Args& A) {
    REFRESH(F);
    __syncthreads();
    const int pr = F.wave >> 1, hw = F.wave & 1;
    for (int item = pr * F.G + F.c; item < 1024; item += 4 * F.G) {
        const int dir = item >> 9, b = (item >> 4) & 31, hd = item & 15, col = 64 * hd + F.lane;
        const int l = F.lane, r32 = l & 31, hh = l >> 5;
        const bf16_t* Rr = WSP(bf16_t, WS_RKV); const bf16_t* Kk = Rr + (size_t)NT * D; const bf16_t* Vv = Kk + (size_t)NT * D;
        const bf16_t* Ee = WSP(bf16_t, WS_E) + (size_t)dir * NT * D; const bf16_t* Aa = WSP(bf16_t, WS_A) + (size_t)dir * NT * D;
        float* Yo = WSP(float, WS_YS) + (size_t)dir * NT * D; float* Bo = WSP(float, WS_BONUS) + (size_t)dir * NT * 16;
        const float kkw = A.in[I_RKK][col], kaw = A.in[I_RKA][col], rkw = A.in[I_RRK][col];
        LAS unsigned char* RA = F.lds + pr * SCW; LAS unsigned char* RB = RA + 16384; LAS unsigned char* RV = RA + 25600;
        LAS float* cCb = (LAS float*)(F.lds + REC_OFF + pr * 256);
        LAS bf16_t* XT = (LAS bf16_t*)RA;
        LAS bf16_t* BK = (LAS bf16_t*)(RA + 8192);
        const int kp = kpos(l), vb = hw;
        f32x16 ST[2];
#pragma unroll
        for (int i = 0; i < 2; ++i)
#pragma unroll
            for (int q = 0; q < 16; ++q) ST[i][q] = 0.f;
        for (int seg = 0; seg < 2; ++seg) {
            const int base = seg ? b * T : NX + b * L, n = seg ? T : L; const int dt = dir ? -1 : 1; const int t0 = dir ? n - 1 : 0;
            for (int bt = 0; bt < n; bt += 32) {
                float cprev = 1.0f;
                if (hw) {
                    bf16_t e16[16];
#pragma unroll
                    for (int s = 0; s < 16; ++s) e16[s] = Ee[(size_t)(base + t0 + dt * (bt + s)) * D + col];
                    float es = 0.f;
#pragma unroll
                    for (int s = 0; s < 16; ++s) es += bf1(e16[s]);
                    cprev = __expf(-es); }
#pragma unroll
                for (int g4i = 0; g4i < 4; ++g4i) { const int g8 = 4 * hw + g4i;
                    bf16_t raw[4][5];
#pragma unroll
                    for (int s8 = 0; s8 < 4; ++s8) { const size_t o = (size_t)(base + t0 + dt * (bt + g8 * 4 + s8)) * D + col; raw[s8][0] = Rr[o]; raw[s8][1] = Kk[o]; raw[s8][2] = Vv[o]; raw[s8][3] = Aa[o]; raw[s8][4] = Ee[o]; }
                    float rr[4], kraw[4], aa[4], kk[4], kd[4], n2[4], bn[4], ww[4]; unsigned bq2[2] = {0u, 0u}, kq2[2] = {0u, 0u};
#pragma unroll
                    for (int s8 = 0; s8 < 4; ++s8) { rr[s8] = bf1(raw[s8][0]); kraw[s8] = bf1(raw[s8][1]); aa[s8] = bf1(raw[s8][3]); ww[s8] = __expf(-bf1(raw[s8][4]));
                        kk[s8] = kraw[s8] * kkw; n2[s8] = kk[s8] * kk[s8]; kd[s8] = kraw[s8] * (1.0f + (aa[s8] - 1.0f) * kaw); bn[s8] = rr[s8] * kd[s8] * rkw; }
#pragma unroll
                    for (int s8 = 0; s8 < 4; ++s8) { n2[s8] = wave_sum(n2[s8]); bn[s8] = wave_sum(bn[s8]); }
#pragma unroll
                    for (int s8 = 0; s8 < 4; ++s8) { const int t = g8 * 4 + s8;
                        if (l == 0) Bo[(size_t)(base + t0 + dt * (bt + t)) * 16 + hd] = bn[s8];
                        const float kn = kk[s8] * __builtin_amdgcn_rsqf(fmaxf(n2[s8], 1e-24f)); const float c = cprev * ww[s8]; const float ic = __builtin_amdgcn_rcpf(c);
                        const float at = -kn * cprev, rt = rr[s8] * c, bq = kn * aa[s8] * ic, kq = kd[s8] * ic;
                        const unsigned w0 = cvt_pk_bf16(at, rt), w1 = cvt_pk_bf16(bq, kq);
                        XT[t * 64 + kp] = (bf16_t)(w0 & 0xffffu); XT[(32 + t) * 64 + kp] = (bf16_t)(w0 >> 16);
                        BK[t * 64 + kp] = (bf16_t)(w1 & 0xffffu); BK[(32 + t) * 64 + kp] = (bf16_t)(w1 >> 16);
                        if (s8 & 1) { bq2[s8 >> 1] |= (w1 & 0xffffu) << 16; kq2[s8 >> 1] |= (w1 & 0xffff0000u); } else { bq2[s8 >> 1] = w1 & 0xffffu; kq2[s8 >> 1] = w1 >> 16; }
                        cprev = c; }
                    const int gp = (g8 & ~3) | ((g8 & 1) << 1) | ((g8 & 2) >> 1);
                    *(LAS u32x2*)(RB + l * 144 + gp * 8) = (u32x2){bq2[0], bq2[1]}; *(LAS u32x2*)(RB + l * 144 + 64 + gp * 8) = (u32x2){kq2[0], kq2[1]};
                    *(LAS u32x2*)(RV + l * 80 + gp * 8) = (u32x2){(unsigned)raw[0][2] | ((unsigned)raw[1][2] << 16), (unsigned)raw[2][2] | ((unsigned)raw[3][2] << 16)};
                }
                if (hw) cCb[l] = cprev;
                __syncthreads();
                f32x16 Mp, Np, X;
                { bf16x8 XTf[4], BKf[2][4];
#pragma unroll
                  for (int s4 = 0; s4 < 4; ++s4) { XTf[s4] = *(const LAS bf16x8*)(XT + r32 * 64 + 16 * s4 + 8 * hh); BKf[0][s4] = *(const LAS bf16x8*)(BK + r32 * 64 + 16 * s4 + 8 * hh); BKf[1][s4] = *(const LAS bf16x8*)(BK + (32 + r32) * 64 + 16 * s4 + 8 * hh); }
                  bf16x8 MkaF[2];
                  { f32x16 Tm;
#pragma unroll
                    for (int q = 0; q < 16; ++q) Tm[q] = 0.f;
#pragma unroll
                    for (int s4 = 0; s4 < 4; ++s4) Tm = MFMA32(BKf[1][s4], XTf[s4], Tm);
#pragma unroll
                    for (int q = 0; q < 16; ++q) { const int row = (q & 3) + 8 * (q >> 2) + 4 * hh; Tm[q] = row < r32 ? Tm[q] : 0.f; }
                    MkaF[0] = acc_frag(Tm, 0); MkaF[1] = acc_frag(Tm, 1); }
#pragma unroll
                  for (int q = 0; q < 16; ++q) { Mp[q] = 0.f; Np[q] = 0.f; X[q] = 0.f; }
#pragma unroll
                  for (int s4 = 0; s4 < 4; ++s4) { Mp = MFMA32(BKf[0][s4], XTf[s4], Mp); Np = MFMA32(XTf[s4], BKf[0][s4], Np); }
#pragma unroll
                  for (int q = 0; q < 16; ++q) { const int row = (q & 3) + 8 * (q >> 2) + 4 * hh; Mp[q] = row < r32 ? Mp[q] : 0.f; Np[q] = r32 < row ? Np[q] : 0.f; }
#pragma unroll
                  for (int kb = 0; kb < 2; ++kb)
#pragma unroll
                      for (int s2 = 0; s2 < 2; ++s2) X = MFMA32(XTf[2 * kb + s2], acc_frag(ST[kb], s2), X);
#pragma unroll
                  for (int s2 = 0; s2 < 2; ++s2) { const bf16x8 Vf = *(const LAS bf16x8*)(RV + (32 * vb + r32) * 80 + (16 * s2 + 8 * hh) * 2); X = MFMA32(MkaF[s2], Vf, X); } }
                __builtin_amdgcn_sched_barrier(0);
#pragma unroll
                for (int lvl = 0; lvl < 5; ++lvl) {
                    bf16x8 Ma[2], Na[2];
#pragma unroll
                    for (int s2 = 0; s2 < 2; ++s2) { Ma[s2] = acc_frag(Mp, s2); Na[s2] = acc_frag(Np, s2); }
                    { const bf16x8 x0 = acc_frag(X, 0), x1 = acc_frag(X, 1); X = MFMA32(Ma[0], x0, X); X = MFMA32(Ma[1], x1, X); }
                    if (lvl < 4) { f32x16 M2, N2;
#pragma unroll
                        for (int q = 0; q < 16; ++q) { M2[q] = 0.f; N2[q] = 0.f; }
                        M2 = MFMA32(Na[0], Ma[0], M2); M2 = MFMA32(Na[1], Ma[1], M2);
                        N2 = MFMA32(Ma[0], Na[0], N2); N2 = MFMA32(Ma[1], Na[1], N2);
                        Mp = M2; Np = N2; }
                }
                __builtin_amdgcn_sched_barrier(0);
                { bf16x8 XRf[4], MbrF[2], MkrF[2];
#pragma unroll
                  for (int s4 = 0; s4 < 4; ++s4) XRf[s4] = *(const LAS bf16x8*)(XT + (32 + r32) * 64 + 16 * s4 + 8 * hh);
                  { f32x16 Tm, Tn;
#pragma unroll
                    for (int q = 0; q < 16; ++q) { Tm[q] = 0.f; Tn[q] = 0.f; }
#pragma unroll
                    for (int s4 = 0; s4 < 4; ++s4) { const bf16x8 Bb = *(const LAS bf16x8*)(BK + r32 * 64 + 16 * s4 + 8 * hh), Bk = *(const LAS bf16x8*)(BK + (32 + r32) * 64 + 16 * s4 + 8 * hh);
                        Tm = MFMA32(Bb, XRf[s4], Tm); Tn = MFMA32(Bk, XRf[s4], Tn); }
#pragma unroll
                    for (int q = 0; q < 16; ++q) { const int row = (q & 3) + 8 * (q >> 2) + 4 * hh; Tm[q] = row <= r32 ? Tm[q] : 0.f; Tn[q] = row <= r32 ? Tn[q] : 0.f; }
                    MbrF[0] = acc_frag(Tm, 0); MbrF[1] = acc_frag(Tm, 1); MkrF[0] = acc_frag(Tn, 0); MkrF[1] = acc_frag(Tn, 1); }
                  { const bf16x8 u0 = acc_frag(X, 0), u1 = acc_frag(X, 1);
                    const bf16x8 Vf0 = *(const LAS bf16x8*)(RV + (32 * vb + r32) * 80 + (8 * hh) * 2), Vf1 = *(const LAS bf16x8*)(RV + (32 * vb + r32) * 80 + (16 + 8 * hh) * 2);
                    f32x16 Yt;
#pragma unroll
                    for (int q = 0; q < 16; ++q) Yt[q] = 0.f;
#pragma unroll
                    for (int kb = 0; kb < 2; ++kb)
#pragma unroll
                        for (int s2 = 0; s2 < 2; ++s2) Yt = MFMA32(XRf[2 * kb + s2], acc_frag(ST[kb], s2), Yt);
                    Yt = MFMA32(MkrF[0], Vf0, Yt); Yt = MFMA32(MkrF[1], Vf1, Yt);
                    Yt = MFMA32(MbrF[0], u0, Yt); Yt = MFMA32(MbrF[1], u1, Yt);
#pragma unroll
                    for (int q = 0; q < 16; ++q) { const int t = (q & 3) + 8 * (q >> 2) + 4 * hh; Yo[(size_t)(base + t0 + dt * (bt + t)) * D + 64 * hd + 32 * vb + r32] = Yt[q]; }
#pragma unroll
                    for (int kb = 0; kb < 2; ++kb) {
                        const bf16x8 b0 = *(const LAS bf16x8*)(RB + (32 * kb + r32) * 144 + (8 * hh) * 2), b1 = *(const LAS bf16x8*)(RB + (32 * kb + r32) * 144 + (16 + 8 * hh) * 2);
                        const bf16x8 k0 = *(const LAS bf16x8*)(RB + (32 * kb + r32) * 144 + 64 + (8 * hh) * 2), k1 = *(const LAS bf16x8*)(RB + (32 * kb + r32) * 144 + 64 + (16 + 8 * hh) * 2);
                        ST[kb] = MFMA32(b0, u0, ST[kb]); ST[kb] = MFMA32(b1, u1, ST[kb]);
                        ST[kb] = MFMA32(k0, Vf0, ST[kb]); ST[kb] = MFMA32(k1, Vf1, ST[kb]); }
                  } }
                __builtin_amdgcn_sched_barrier(0);
#pragma unroll
                for (int kb = 0; kb < 2; ++kb)
#pragma unroll
                    for (int g4 = 0; g4 < 4; ++g4) { const f32x4 cc = *(const LAS f32x4*)(cCb + 32 * kb + 8 * g4 + 4 * hh);
                        ST[kb][4 * g4 + 0] *= cc.x; ST[kb][4 * g4 + 1] *= cc.y; ST[kb][4 * g4 + 2] *= cc.z; ST[kb][4 * g4 + 3] *= cc.w; }
                __syncthreads();
            }
        }
    }
    __syncthreads();
}
#undef MFMA32
__device__ __forceinline__ void phase_rwkv_out(Frame& F, const Args& A, int nrows) {
    REFRESH(F);
    const float* Y0 = WSP(float, WS_YS); const float* Y1 = Y0 + (size_t)NT * D; const float* B0 = WSP(float, WS_BONUS); const float* B1 = B0 + (size_t)NT * 16;
    const bf16_t* Vv = WSP(bf16_t, WS_RKV) + (size_t)2 * NT * D; const bf16_t* Gg = WSP(bf16_t, WS_G); bf16_t* RO = WSP(bf16_t, WS_RO);
    const float* lnw = A.in[I_RLNW]; const float* lnb = A.in[I_RLNB];
    for (int it = 0;; ++it) { if (ROWOF(it, 0) >= nrows) break;
        f32x4 y[RB][4], vv[RB][4], gg[RB][4]; float bon[RB][4];
#pragma unroll
        for (int r = 0; r < RB; ++r) { const int row = ROWOF(it, r);
#pragma unroll
            for (int j = 0; j < 4; ++j) { const int col = 256 * j + 4 * F.lane, head = 4 * j + (F.lane >> 4); const size_t o = (size_t)row * D + col;
                y[r][j] = *(const f32x4*)(Y0 + o) + *(const f32x4*)(Y1 + o); vv[r][j] = ld_bf4(Vv + o); gg[r][j] = ld_bf4(Gg + o); bon[r][j] = B0[(size_t)row * 16 + head] + B1[(size_t)row * 16 + head]; } }
#pragma unroll
        for (int r = 0; r < RB; ++r) { const int row = ROWOF(it, r);
#pragma unroll
            for (int j = 0; j < 4; ++j) { const int col = 256 * j + 4 * F.lane; const size_t o = (size_t)row * D + col; const f32x4 yy = y[r][j];
                const float s = row16_sum((yy.x + yy.y) + (yy.z + yy.w));
                const f32x4 d = yy - s * (1.0f / 64.0f);
                const float q = row16_sum((d.x * d.x + d.y * d.y) + (d.z * d.z + d.w * d.w));
                const float rs = 1.0f / sqrtf(q * (1.0f / 64.0f) + 64e-5f);
                const f32x4 yn = d * rs * *(const f32x4*)(lnw + col) + *(const f32x4*)(lnb + col);
                { const f32x4 ov = (yn + vv[r][j] * bon[r][j]) * gg[r][j]; *(unsigned*)((unsigned char*)RO + o) = pk4_fp8(ov.x, ov.y, ov.z, ov.w); } } }
    }
}

__device__ __forceinline__ void phase_attn(Frame& F, const Args& A, int j, bool need_ctx) {
    REFRESH(F);
    const bf16_t* Q = WSP(bf16_t, WS_Q); const bf16_t* Kb = WSP(bf16_t, WS_K); const bf16_t* VT = WSP(bf16_t, WS_VT); bf16_t* O = WSP(bf16_t, WS_O);
    const float* sinks = A.in[I_ASINK] + j * 16;
    LAS bf16_t* Ks = (LAS bf16_t*)F.lds; LAS bf16_t* Vs = (LAS bf16_t*)(F.lds + 9216);
    LAS bf16x8* Qs = (LAS bf16x8*)(F.lds + 18432 + F.wave * 8192) + F.lane;
    const int nunits = 2048 + (need_ctx ? 256 : 0);
    const int fr = F.lane & 15, fq = F.lane >> 4, g = F.wave >> 1, hf = F.wave & 1;
    const float SC = 0.125f * 1.4426950408889634f;
    const int lr = F.tid >> 3, lch = F.tid & 7;
    __syncthreads();
    for (int u = F.c; u < nunits; u += F.G) {
        int b, kvh, qb; bool isx;
        if (u < 2048) { isx = true; b = u >> 6; kvh = (u >> 4) & 3; qb = u & 15; } else { const int v = u - 2048; isx = false; b = v >> 3; kvh = (v >> 1) & 3; qb = v & 1; }
        const int qrow0 = (isx ? b * T : NX + b * L) + qb * 128 + hf * 64; const int head = 4 * kvh + g;
        int jlo = 0, jhi = -1;
        if (isx) { jlo = qb == 0 ? 2 : 0; jhi = qb == 15 ? 3 : 5; }
        const int ntiles = 4 + (jhi - jlo + 1);
        auto tile_row0 = [&](int ti) -> int { return ti < 4 ? NX + b * L + ti * 64 : b * T + qb * 128 - 128 + 64 * (jlo + ti - 4); };
        u32x4 kv_n, vv_n;
        { const int kr0 = tile_row0(0); kv_n = *(const u32x4*)(Kb + (size_t)(kr0 + lr) * 256 + kvh * 64 + lch * 8); vv_n = *(const u32x4*)(VT + (size_t)(kvh * 64 + lr) * NT + kr0 + lch * 8); }
#pragma unroll
        for (int mq = 0; mq < 4; ++mq)
#pragma unroll
            for (int ks = 0; ks < 2; ++ks) Qs[64 * (mq * 2 + ks)] = *(const bf16x8*)(Q + (size_t)(qrow0 + 16 * mq + fr) * D + head * 64 + ks * 32 + 8 * fq);
        const float sink2 = sinks[head] * 1.4426950408889634f;
        float mrun[4], lrun[4]; f32x4 Oa[4][4];
#pragma unroll
        for (int mq = 0; mq < 4; ++mq) { mrun[mq] = sink2; lrun[mq] = fq == 0 ? 1.0f : 0.0f;
#pragma unroll
            for (int db = 0; db < 4; ++db) Oa[mq][db] = (f32x4){0.f, 0.f, 0.f, 0.f}; }
        for (int ti = 0; ti < ntiles; ++ti) {
            const int jl = ti < 4 ? -1 : jlo + ti - 4; const int ks0 = qb * 128 - 128 + 64 * jl;
            __syncthreads();
            *(LAS u32x4*)(Ks + lr * 72 + lch * 8) = kv_n; *(LAS u32x4*)(Vs + lr * 72 + lch * 8) = vv_n;
            __syncthreads();
            if (ti + 1 < ntiles) { const int kr0 = tile_row0(ti + 1); kv_n = *(const u32x4*)(Kb + (size_t)(kr0 + lr) * 256 + kvh * 64 + lch * 8); vv_n = *(const u32x4*)(VT + (size_t)(kvh * 64 + lr) * NT + kr0 + lch * 8); }
            const bool need = (jl < 0) || (jl >= hf && jl <= hf + 4);
            if (need) {
                const bool domask = (jl >= 0) && (jl == hf || jl == hf + 4);
                f32x4 Sa[4][4];
#pragma unroll
                for (int mq = 0; mq < 4; ++mq)
#pragma unroll
                    for (int n = 0; n < 4; ++n) Sa[mq][n] = (f32x4){0.f, 0.f, 0.f, 0.f};
#pragma unroll
                for (int ks = 0; ks < 2; ++ks) {
                    bf16x8 Qf[4];
#pragma unroll
                    for (int mq = 0; mq < 4; ++mq) Qf[mq] = Qs[64 * (mq * 2 + ks)];
#pragma unroll
                    for (int n = 0; n < 4; ++n) { const int kr = 32 * (n >> 1) + 8 * (fr >> 2) + 4 * (n & 1) + (fr & 3);
                        const bf16x8 Kf = *(const LAS bf16x8*)(Ks + kr * 72 + ks * 32 + 8 * fq);
#pragma unroll
                        for (int mq = 0; mq < 4; ++mq) Sa[mq][n] = __builtin_amdgcn_mfma_f32_16x16x32_bf16(Kf, Qf[mq], Sa[mq][n], 0, 0, 0); } }
                bf16x8 Pf[4][2];
#pragma unroll
                for (int mq = 0; mq < 4; ++mq) {
                    float mx = -1e30f;
                    if (domask) { const int tq = qb * 128 + hf * 64 + 16 * mq + fr;
#pragma unroll
                        for (int n = 0; n < 4; ++n)
#pragma unroll
                            for (int i = 0; i < 4; ++i) { float sv = Sa[mq][n][i] * SC; const int rel = ks0 + 32 * (n >> 1) + 8 * fq + 4 * (n & 1) + i - tq; if (rel > 128 || rel < -128) sv = -1e30f; Sa[mq][n][i] = sv; mx = fmaxf(mx, sv); } }
                    else {
#pragma unroll
                        for (int n = 0; n < 4; ++n)
#pragma unroll
                            for (int i = 0; i < 4; ++i) { const float sv = Sa[mq][n][i] * SC; Sa[mq][n][i] = sv; mx = fmaxf(mx, sv); } }
                    mx = fmaxf(mx, __shfl_xor(mx, 16)); mx = fmaxf(mx, __shfl_xor(mx, 32));
                    const float mnew = fmaxf(mrun[mq], mx); const float alpha = __builtin_amdgcn_exp2f(mrun[mq] - mnew); mrun[mq] = mnew;
                    float rs = 0.f;
#pragma unroll
                    for (int n = 0; n < 4; ++n)
#pragma unroll
                        for (int i = 0; i < 4; ++i) { const float p = __builtin_amdgcn_exp2f(Sa[mq][n][i] - mnew); Sa[mq][n][i] = p; rs += p; }
                    lrun[mq] = lrun[mq] * alpha + rs;
#pragma unroll
                    for (int db = 0; db < 4; ++db) Oa[mq][db] *= alpha;
#pragma unroll
                    for (int s2 = 0; s2 < 2; ++s2) { u32x4 w; w.x = cvt_pk_bf16(Sa[mq][2 * s2][0], Sa[mq][2 * s2][1]); w.y = cvt_pk_bf16(Sa[mq][2 * s2][2], Sa[mq][2 * s2][3]);
                        w.z = cvt_pk_bf16(Sa[mq][2 * s2 + 1][0], Sa[mq][2 * s2 + 1][1]); w.w = cvt_pk_bf16(Sa[mq][2 * s2 + 1][2], Sa[mq][2 * s2 + 1][3]); Pf[mq][s2] = __builtin_bit_cast(bf16x8, w); }
                }
#pragma unroll
                for (int db = 0; db < 4; ++db)
#pragma unroll
                    for (int s2 = 0; s2 < 2; ++s2) { const bf16x8 Vf = *(const LAS bf16x8*)(Vs + (16 * db + fr) * 72 + 32 * s2 + 8 * fq);
#pragma unroll
                        for (int mq = 0; mq < 4; ++mq) Oa[mq][db] = __builtin_amdgcn_mfma_f32_16x16x32_bf16(Vf, Pf[mq][s2], Oa[mq][db], 0, 0, 0); }
            }
        }
#pragma unroll
        for (int mq = 0; mq < 4; ++mq) { float l = lrun[mq]; l += __shfl_xor(l, 16); l += __shfl_xor(l, 32); const float inv = 1.0f / l;
            unsigned char* op = (unsigned char*)O + (size_t)(qrow0 + 16 * mq + fr) * D + head * 64 + 4 * fq;
#pragma unroll
            for (int db = 0; db < 4; ++db) { const f32x4 o = Oa[mq][db] * inv; *(unsigned*)(op + 16 * db) = pk4_fp8(o.x, o.y, o.z, o.w); } }
    }
    __syncthreads();
}

struct KState { XcdBarrier bar; int ph; };
#define RUN() (A.one || A.phase == KS.ph)
#define SEAM() do { if (A.one) xcd_barrier(KS.bar); ++KS.ph; } while (0)
template <int LAYER>
__device__ __forceinline__ void layer_body(Frame& F, const Args& A, KState& KS) {
    constexpr int layer = LAYER, kind = LAYER % 3, j = LAYER / 3; constexpr bool last = (LAYER == DEPTH - 1);
    LAS unsigned char* ring = F.lds;
    const LAS int* tpre = (const LAS int*)(F.lds + TPRE_OFF); const LAS int* lcnt = (const LAS int*)(F.lds + LCNT_OFF);
    bf16_t* H = WSP(bf16_t, WS_H); const float* MOD = WSP(float, WS_MOD); const bf16_t* AX = WSP(bf16_t, WS_AX);
    const float* gate1 = MOD + (size_t)layer * 33 * 6144 + 2 * D;
    constexpr int nMall = last ? NX / 256 : NT / 256;
    if (RUN()) phase_norm1(F, A, layer);
    SEAM();
    if constexpr (kind == 0) {
        if (RUN()) for (int rep_ = 0; rep_ < REPN(1); ++rep_) {
            { pg8::ProbDense8 P; P.A = (const unsigned char*)AX; P.Bt = WSP(unsigned char, WS_WQK) + (size_t)j * 1280 * D; P.lda = D; P.ldb = D; P.K = D; P.scale_w = SCALE_W; P.scale_x = SCALE_ONE; P.ord.init(NT / 256, 5, F.G, F.c);
              EpiQK E{WSP(bf16_t, WS_Q), WSP(bf16_t, WS_K), WSP(float, WS_BQK) + j * 1280, WSP(float, WS_ROPEC), WSP(float, WS_ROPES)};
              pg8::gemm_phase(ring, P, E); }
            { pg8::ProbDense8 P; P.A = WSP(unsigned char, WS_WV) + (size_t)j * 256 * D; P.Bt = (const unsigned char*)AX; P.lda = D; P.ldb = D; P.K = D; P.scale_w = SCALE_ONE; P.scale_x = SCALE_W; P.ord.init(1, NT / 256, F.G, F.c);
              EpiVT E{WSP(bf16_t, WS_VT), A.in[I_ABQKV] + j * 1536 + 1280};
              pg8::gemm_phase(ring, P, E); }
        }
        SEAM();
        if (RUN()) for (int rep_ = 0; rep_ < REPN(2); ++rep_) phase_attn(F, A, j, !last);
        SEAM();
        if (RUN() && !((SKIPMASK >> layer) & 1)) { pg8::ProbDense8 P; P.A = WSP(unsigned char, WS_O); P.Bt = WSP(unsigned char, WS_WO) + (size_t)j * D * D; P.lda = D; P.ldb = D; P.K = D; P.scale_w = SCALE_W; P.scale_x = SCALE_ONE; P.ord.init(nMall, 4, F.G, F.c);
            EpiResid E{H, A.in[I_ABO] + j * D, nullptr, gate1};
            pg8::gemm_phase(ring, P, E); }
        SEAM();
    } else if constexpr (kind == 1) {
        if (RUN()) for (int rep_ = 0; rep_ < REPN(3); ++rep_) phase_pooldiff(F);
        SEAM();
        if (RUN() && !((SKIPMASK >> layer) & 1)) { pg8::ProbDense P; P.A = WSP(bf16_t, WS_PD); P.Bt = WSP(bf16_t, WS_POOLW); P.lda = D; P.ldb = 256; P.K = 256; P.a_pn_off = 256; P.ord.init(nMall, 4, F.G, F.c);
            EpiResid E{H, A.in[I_PB], A.in[I_PS], gate1};
            pg8::gemm_phase(ring, P, E); }
        SEAM();
    } else {
        if (RUN()) for (int rep_ = 0; rep_ < REPN(4); ++rep_) phase_rwkv_mix(F, A);
        SEAM();
        if (RUN()) for (int rep_ = 0; rep_ < REPN(5); ++rep_) {
            for (int i = 0; i < 3; ++i) { const int sel = i == 0 ? 0 : i == 1 ? 2 : 3;
                pg8::ProbDense8 P; P.A = (const unsigned char*)(WSP(bf16_t, WS_A6) + (size_t)sel * NT * D); P.Bt = WSP(unsigned char, WS_WRKV) + (size_t)i * D * D; P.lda = D; P.ldb = D; P.K = D; P.scale_w = SCALE_W; P.scale_x = SCALE_ONE; P.ord.init(NT / 256, 4, F.G, F.c);
                EpiBf16Act E{WSP(bf16_t, WS_RKV) + (size_t)i * NT * D, D, nullptr, 0, 1.0f};
                pg8::gemm_phase(ring, P, E); }
            for (int i = 0; i < 3; ++i) { const int sel = i == 0 ? 5 : i == 1 ? 1 : 4;
                pg8::ProbDense P; P.A = WSP(bf16_t, WS_A6) + (size_t)sel * NT * D; P.Bt = WSP(bf16_t, WS_WL1) + (size_t)i * 256 * D; P.lda = D; P.ldb = D; P.K = D; P.a_pn_off = 0; P.ord.init(NT / 256, 1, F.G, F.c);
                EpiBf16Act E{WSP(bf16_t, WS_LORA) + i * 256, 768, nullptr, i == 0 ? 1 : i == 1 ? 2 : 0, 1.0f};
                pg8::gemm_phase(ring, P, E); }
        }
        SEAM();
        if (RUN()) for (int rep_ = 0; rep_ < REPN(6); ++rep_) {
            for (int i = 0; i < 5; ++i) {
                const int ablk = i == 0 ? 0 : i < 3 ? 1 : 2, d = (i - 1) & 1;
                pg8::ProbDense P; P.A = WSP(bf16_t, WS_LORA) + ablk * 256; P.Bt = WSP(bf16_t, WS_WL2) + (size_t)i * D * 256; P.lda = 768; P.ldb = 256; P.K = 256; P.a_pn_off = 0; P.ord.init(NT / 256, 4, F.G, F.c);
                EpiBf16Act E; E.ldc = D;
                if (i == 0) { E.O = WSP(bf16_t, WS_G); E.bias = nullptr; E.act = 0; E.scale = 1.0f; }
                else if (i < 3) { E.O = WSP(bf16_t, WS_E) + (size_t)d * NT * D; E.bias = A.in[I_RW0] + d * D; E.act = 1; E.scale = 0.6065306597126334f; }
                else { E.O = WSP(bf16_t, WS_A) + (size_t)d * NT * D; E.bias = A.in[I_RA0] + d * D; E.act = 1; E.scale = 1.0f; }
                pg8::gemm_phase(ring, P, E); }
        }
        SEAM();
        if (RUN()) for (int rep_ = 0; rep_ < REPN(7); ++rep_) phase_rwkv_scan(F, A);
        SEAM();
        if (RUN()) for (int rep_ = 0; rep_ < REPN(8); ++rep_) phase_rwkv_out(F, A, last ? NX : NT);
        SEAM();
        if (RUN() && !((SKIPMASK >> layer) & 1)) { pg8::ProbDense8 P; P.A = WSP(unsigned char, WS_RO); P.Bt = WSP(unsigned char, WS_WOR); P.lda = D; P.ldb = D; P.K = D; P.scale_w = SCALE_W; P.scale_x = SCALE_ONE; P.ord.init(nMall, 4, F.G, F.c);
            EpiResid E{H, nullptr, nullptr, gate1};
            pg8::gemm_phase(ring, P, E); }
        SEAM();
    }
    if (RUN()) phase_route(F, A, layer);
    SEAM();
    if (RUN()) for (int rep_ = 0; rep_ < REPN(9); ++rep_) { moe_tiles(F, layer);
        ProbMoe1 P; P.FX = WSP(fp8_t, WS_FX); P.W1T = WSP(fp8_t, WS_W1T) + (size_t)layer * NE * 2048 * D; P.list = WSP(int, WS_LIST); P.tpre = tpre; P.cnt = lcnt; P.texp = (const LAS unsigned char*)(F.lds + TEXP_OFF); P.toks = (LAS int*)(F.lds + TOKS_OFF); P.scale_w = SCALE_W; P.scale_x = SCALE_ONE; P.ord.init(tpre[NE], 8, F.G, F.c);
        EpiMoe1 E{WSP(unsigned char, WS_ACT), A.in[I_MB1] + (size_t)layer * NE * 2048};
        pg8::gemm_phase(ring, P, E); }
    SEAM();
    if (RUN()) for (int rep_ = 0; rep_ < REPN(10); ++rep_) { moe_tiles(F, layer);
        ProbMoe2 P; P.ACT = WSP(fp8_t, WS_ACT); P.W2T = WSP(fp8_t, WS_W2T) + (size_t)layer * NE * D * D; P.tpre = tpre; P.texp = (const LAS unsigned char*)(F.lds + TEXP_OFF); P.scale_w = SCALE_W; P.scale_x = SCALE_ONE; P.ord.init(tpre[NE], 4, F.G, F.c);
        EpiMoe2 E{WSP(unsigned char, WS_Y), A.in[I_MB2] + (size_t)layer * NE * D};
        pg8::gemm_phase(ring, P, E); }
    SEAM();
}
__global__ void __launch_bounds__(NTHREADS, 2) trunk_fwd(Args A) {
    extern __shared__ __attribute__((aligned(16))) unsigned char lds_[];
    Frame F; F.lds = (LAS unsigned char*)lds_; REFRESH(F); F.wave = __builtin_amdgcn_readfirstlane(F.tid >> 6);
    F.G = gridDim.x; F.c = blockIdx.x; F.ws = A.ws; F.ctl = (unsigned*)(A.ws + WS_CTL);
    for (int u = F.tid; u < (LDS_BYTES - LDSCTL_OFF) / 4; u += NTHREADS) ((LAS unsigned*)(F.lds + LDSCTL_OFF))[u] = 0u;
    __syncthreads();
    KState KS; KS.bar.bar = F.ctl + CW_BAR; KS.bar.x = 0; KS.bar.st = nullptr; KS.ph = 0;
    if (A.one) KS.bar = xcd_barrier_post(F.ctl + CW_BAR, (volatile LAS unsigned*)(F.lds + MISC_OFF) + 8);
    if (RUN()) for (int rep_ = 0; rep_ < REPN(0); ++rep_) phase_prologue(F, A);
    SEAM();
    layer_body<0>(F, A, KS);
    layer_body<1>(F, A, KS);
    layer_body<2>(F, A, KS);
    layer_body<3>(F, A, KS);
    if (RUN()) phase_final(F, A);
}
#undef RUN
#undef SEAM
static int count_phases() { int n = 1; for (int layer = 0; layer < DEPTH; ++layer) { const int kind = layer % 3; n += 1 + (kind == 0 ? 3 : kind == 1 ? 2 : 6) + 3; } return n + 1; }

extern "C" void kernel_launch(void* const* d_in, const int* in_sizes, int n_in, void* d_out, int out_size, void* d_ws, size_t ws_size, hipStream_t stream) {
    static int grid = 0;
    if (grid == 0) {
        if (n_in != 38 || out_size != NX * D || ws_size < WS_END) { fprintf(stderr, "kernel_launch: unexpected problem (n_in %d, out %d, ws %zu < %zu)\n", n_in, out_size, ws_size, (size_t)WS_END); grid = -1; return; }
        int dev = 0, cus = 0;
        if (hipGetDevice(&dev) != hipSuccess || hipDeviceGetAttribute(&cus, hipDeviceAttributeMultiprocessorCount, dev) != hipSuccess) { grid = -1; return; }
        if (hipFuncSetAttribute((const void*)trunk_fwd, hipFuncAttributeMaxDynamicSharedMemorySize, LDS_BYTES) != hipSuccess) { fprintf(stderr, "kernel_launch: hipFuncSetAttribute failed\n"); grid = -1; return; }
        int per_cu = 0;
        if (hipOccupancyMaxActiveBlocksPerMultiprocessor(&per_cu, (const void*)trunk_fwd, NTHREADS, LDS_BYTES) != hipSuccess || per_cu < 1) fprintf(stderr, "kernel_launch: occupancy query says %d\n", per_cu);
        (void)hipGetLastError();
        grid = cus;
        if (grid != 256) fprintf(stderr, "kernel_launch: %d CUs (built for 256)\n", grid);
    }
    if (grid < 0) return;
    (void)hipMemsetAsync((char*)d_ws + WS_CTL, 0, CTL_BYTES, stream);
    (void)hipMemsetAsync((char*)d_ws + WS_LZERO, 0, LZERO_BYTES, stream);
    Args a{};
    for (int i = 0; i < 38; ++i) a.in[i] = (const float*)d_in[i];
    a.out = (float*)d_out; a.ws = (unsigned char*)d_ws;
#if MK_ONE_LAUNCH
    a.phase = 0; a.one = 1;
    hipLaunchKernelGGL(trunk_fwd, dim3(grid), dim3(NTHREADS), LDS_BYTES, stream, a);
#else
    const int nph = count_phases();
    for (int p = 0; p < nph; ++p) { a.phase = p; a.one = 0; hipLaunchKernelGGL(trunk_fwd, dim3(grid), dim3(NTHREADS), LDS_BYTES, stream, a); }
#endif
}
```

```cpp
#include <hip/hip_runtime.h>
#include <cstdio>
#include <cstdint>

#ifndef MK_ONE_LAUNCH
#define MK_ONE_LAUNCH 1
#endif
#define LAS __attribute__((address_space(3)))
#define GAS __attribute__((address_space(1)))
typedef unsigned short bf16_t;
typedef short bf16x8 __attribute__((ext_vector_type(8)));
typedef float f32x4 __attribute__((ext_vector_type(4)));
typedef float f32x2 __attribute__((ext_vector_type(2)));
typedef unsigned u32x4 __attribute__((ext_vector_type(4)));
typedef unsigned u32x2 __attribute__((ext_vector_type(2)));

constexpr int D = 1024, NB = 32, T = 2048, L = 256, DEPTH = 4;
constexpr int NX = NB * T, NC = NB * L, NT = NX + NC;
constexpr int NE = 32, TOPK = 4;
constexpr int NWAVES = 8, NTHREADS = 512;
constexpr int MAXRT = NT * TOPK / 256 + NE;

constexpr size_t MiB = 1u << 20;
constexpr size_t WS_CTL = 0, CTL_BYTES = 4 * MiB;
constexpr size_t WS_MOD = 4 * MiB;
constexpr size_t WS_ROPEC = 8 * MiB, WS_ROPES = 8 * MiB + 512 * 1024;
constexpr size_t WS_BQK = 9 * MiB;
constexpr size_t WS_WQK = 10 * MiB;
constexpr size_t WS_WV = 15 * MiB;
constexpr size_t WS_WO = 16 * MiB;
constexpr size_t WS_POOLW = 20 * MiB;
constexpr size_t WS_WRKV = 21 * MiB;
constexpr size_t WS_WOR = 27 * MiB;
constexpr size_t WS_WL1 = 30 * MiB;
constexpr size_t WS_WL2 = 32 * MiB;
constexpr size_t WS_LZERO = WS_WL1, LZERO_BYTES = 6 * MiB;
constexpr size_t WS_W1T = 40 * MiB;
constexpr size_t WS_W2T = 552 * MiB;
constexpr size_t WS_H = 808 * MiB;
constexpr size_t WS_AX = 1096 * MiB;
constexpr size_t WS_FX = 1240 * MiB;
constexpr size_t WS_R = 1384 * MiB;
constexpr size_t WS_ACT = WS_R;
constexpr size_t WS_Y = WS_R + 592 * MiB;
constexpr size_t WS_LIST = WS_R + 1184 * MiB;
constexpr size_t WS_POS = WS_R + 1193 * MiB;
constexpr size_t WS_GATE = WS_R + 1195 * MiB;
constexpr size_t WS_Q = WS_R;
constexpr size_t WS_K = WS_R + 144 * MiB;
constexpr size_t WS_VT = WS_R + 180 * MiB;
constexpr size_t WS_O = WS_R + 216 * MiB;
constexpr size_t WS_PD = WS_R;
constexpr size_t WS_A6 = WS_R;
constexpr size_t WS_E = WS_R;
constexpr size_t WS_A = WS_R + 288 * MiB;
constexpr size_t WS_RO = WS_R + 576 * MiB;
constexpr size_t WS_RKV = WS_R + 864 * MiB;
constexpr size_t WS_LORA = WS_R + 1296 * MiB;
constexpr size_t WS_G = WS_R + 1404 * MiB;
constexpr size_t WS_YS = WS_R + 1548 * MiB;
constexpr size_t WS_BONUS = WS_R + 2124 * MiB;
constexpr size_t WS_END = WS_R + 2134 * MiB;

constexpr int CW_BAR = 4096;
constexpr int CW_GCNT = 16384;
constexpr int LDS_BYTES = 147456;
constexpr int RING_BYTES = 131072;
constexpr int LDSCTL_OFF = 135168;
constexpr int MISC_OFF = LDSCTL_OFF;
constexpr int TPRE_OFF = LDSCTL_OFF + 256;
constexpr int LCNT_OFF = LDSCTL_OFF + 512;
constexpr int LBASE_OFF = LDSCTL_OFF + 768;
constexpr int REC_OFF = LDSCTL_OFF + 1024;
constexpr int TEXP_OFF = LDSCTL_OFF + 1024 + 2048;
constexpr int TOKS_OFF = LDSCTL_OFF + 1024 + 4096;
constexpr int JOB_OFF = LDSCTL_OFF + 1024;

__device__ __forceinline__ unsigned f2bf(float f) { unsigned u = __builtin_bit_cast(unsigned, f); return (u + 0x7fffu + ((u >> 16) & 1u)) >> 16; }
__device__ __forceinline__ unsigned pk2(float lo, float hi) { return f2bf(lo) | (f2bf(hi) << 16); }
__device__ __forceinline__ float bflo(unsigned w) { return __builtin_bit_cast(float, w << 16); }
__device__ __forceinline__ float bfhi(unsigned w) { return __builtin_bit_cast(float, w & 0xffff0000u); }
__device__ __forceinline__ float bf1(bf16_t b) { return __builtin_bit_cast(float, ((unsigned)b) << 16); }
__device__ __forceinline__ unsigned pk4_fp8(float a, float b, float c, float d) { int w = __builtin_amdgcn_cvt_pk_fp8_f32(a, b, 0, false); w = __builtin_amdgcn_cvt_pk_fp8_f32(c, d, w, true); return (unsigned)w; }
typedef __bf16 bf16x2_t __attribute__((ext_vector_type(2)));
__device__ __forceinline__ unsigned cvt_pk_bf16(float lo, float hi) { const f32x2 v = {lo, hi}; return __builtin_bit_cast(unsigned, __builtin_convertvector(v, bf16x2_t)); }
__device__ __forceinline__ float dpp_add(float v, const int ctrl, const int row_mask) {
    switch (ctrl) {
    case 0xB1:  return v + __builtin_bit_cast(float, __builtin_amdgcn_update_dpp(0, __builtin_bit_cast(int, v), 0xB1, 0xf, 0xf, true));
    case 0x4E:  return v + __builtin_bit_cast(float, __builtin_amdgcn_update_dpp(0, __builtin_bit_cast(int, v), 0x4E, 0xf, 0xf, true));
    case 0x141: return v + __builtin_bit_cast(float, __builtin_amdgcn_update_dpp(0, __builtin_bit_cast(int, v), 0x141, 0xf, 0xf, true));
    case 0x140: return v + __builtin_bit_cast(float, __builtin_amdgcn_update_dpp(0, __builtin_bit_cast(int, v), 0x140, 0xf, 0xf, true));
    case 0x142: return v + __builtin_bit_cast(float, __builtin_amdgcn_update_dpp(0, __builtin_bit_cast(int, v), 0x142, 0xa, 0xf, true));
    default:    return v + __builtin_bit_cast(float, __builtin_amdgcn_update_dpp(0, __builtin_bit_cast(int, v), 0x143, 0xc, 0xf, true));
    }
}
__device__ __forceinline__ float row16_sum(float v) { v = dpp_add(v, 0xB1, 0xf); v = dpp_add(v, 0x4E, 0xf); v = dpp_add(v, 0x141, 0xf); v = dpp_add(v, 0x140, 0xf); return v; }
__device__ __forceinline__ float wave_sum(float v) {
    v = row16_sum(v); v = dpp_add(v, 0x142, 0xa); v = dpp_add(v, 0x143, 0xc);
    return __builtin_bit_cast(float, __builtin_amdgcn_readlane(__builtin_bit_cast(int, v), 63));
}
__device__ __forceinline__ float sigmoidf_(float x) { return __builtin_amdgcn_rcpf(1.0f + __builtin_amdgcn_exp2f(-1.4426950408889634f * x)); }
__device__ __forceinline__ int opaque_tid() { int t; asm volatile("v_mov_b32 %0, %1" : "=v"(t) : "v"(threadIdx.x)); return t; }
#define REFRESH(F) do { (F).tid = opaque_tid(); (F).lane = (F).tid & 63; } while (0)
__device__ __forceinline__ void seq_of(int row, int& sb, int& t, int& n) { if (row < NX) { sb = row & ~(T - 1); t = row & (T - 1); n = T; } else { const int r2 = row - NX; sb = NX + (r2 & ~(L - 1)); t = r2 & (L - 1); n = L; } }
__device__ __forceinline__ f32x4 ld_bf4(const bf16_t* p) { const u32x2 w = *(const u32x2*)p; return (f32x4){bflo(w.x), bfhi(w.x), bflo(w.y), bfhi(w.y)}; }
__device__ __forceinline__ void st_bf4(bf16_t* p, f32x4 v) { u32x2 w; w.x = pk2(v.x, v.y); w.y = pk2(v.z, v.w); *(u32x2*)p = w; }

#define LDS_WAIT() asm volatile("s_waitcnt lgkmcnt(0)" ::: "memory")
#define VM_WAIT() asm volatile("s_waitcnt vmcnt(0)" ::: "memory")

#define XB_TMO      128
#define XB_XCNT(j)  (256  + 64 * (j))
#define XB_XSUB(j)  (1280 + 64 * (j))
#define XB_XGEN(j)  (2304 + 64 * (j))
#define XB_TOP      3328
#define XB_TOPGEN   3392
#define XCD_BAR_WORDS 3456
#define XB_SPIN_CAP (1u << 18)
__device__ __forceinline__ unsigned xb_ld(unsigned* p)              { return __hip_atomic_load(p, __ATOMIC_RELAXED, __HIP_MEMORY_SCOPE_AGENT); }
__device__ __forceinline__ unsigned xb_add(unsigned* p, unsigned v) { return __hip_atomic_fetch_add(p, v, __ATOMIC_RELAXED, __HIP_MEMORY_SCOPE_AGENT); }
__device__ __forceinline__ unsigned xb_xcc_id() { return (unsigned)__builtin_amdgcn_s_getreg((3 << 11) | 20) & 0xFu; }
#define XB_SPIN(cond, bar) do { unsigned _sp = 0; while (cond) { __builtin_amdgcn_s_sleep(1); \
    if ((++_sp & 255u) == 0u) { if (xb_ld(&(bar)[XB_TMO])) break; if (_sp > XB_SPIN_CAP) { atomicAdd(&(bar)[XB_TMO], 1u); break; } } } } while (0)
struct XcdBarrier { unsigned* bar; unsigned x; volatile LAS unsigned* st; };
__device__ __forceinline__ XcdBarrier xcd_barrier_post(unsigned* bar, volatile LAS unsigned* st) {
    XcdBarrier b; b.bar = bar; b.x = xb_xcc_id(); b.st = st;
    if (threadIdx.x == 0) (void)xb_add(&bar[XB_XCNT(b.x)], 1u);
    return b;
}
__device__ __forceinline__ void xcd_barrier_complete(unsigned* bar, unsigned x, unsigned& nloc, unsigned& nx) {
    const unsigned G = gridDim.x * gridDim.y * gridDim.z;
    unsigned sum, cnt, mine, sp = 0u;
    for (;;) {
        sum = 0u; cnt = 0u; mine = 0u;
#pragma unroll
        for (unsigned j = 0; j < 16; ++j) { const unsigned c = xb_ld(&bar[XB_XCNT(j)]); sum += c; cnt += (c > 0u) ? 1u : 0u; mine = (j == x) ? c : mine; }
        if (sum == G) break;
        __builtin_amdgcn_s_sleep(1);
        if ((++sp & 255u) == 0u) { if (xb_ld(&bar[XB_TMO])) break; if (sp > XB_SPIN_CAP) { atomicAdd(&bar[XB_TMO], 1u); break; } }
    }
    nloc = mine > 0u ? mine : 1u; nx = cnt > 0u ? cnt : 1u;
}
__device__ __forceinline__ void xcd_barrier(const XcdBarrier& b) {
    asm volatile("s_waitcnt vmcnt(0)" ::: "memory");
    __syncthreads();
    if (threadIdx.x == 0) {
        unsigned* bar = b.bar;
        __builtin_amdgcn_s_waitcnt(0);
        unsigned nloc = b.st[0], nx = b.st[1];
        if (nloc == 0u) { xcd_barrier_complete(bar, b.x, nloc, nx); b.st[0] = nloc; b.st[1] = nx; }
        const unsigned old = xb_add(&bar[XB_XSUB(b.x)], 1u);
        const unsigned gen = old / nloc;
        if (old + 1u == (gen + 1u) * nloc) {
            __builtin_amdgcn_fence(__ATOMIC_RELEASE, "agent");
            asm volatile("s_waitcnt vmcnt(0)" ::: "memory");
            const unsigned og = xb_add(&bar[XB_TOP], 1u);
            const unsigned tg = og / nx;
            if (og + 1u == (tg + 1u) * nx) xb_add(&bar[XB_TOPGEN], 1u);
            else XB_SPIN(xb_ld(&bar[XB_TOPGEN]) == tg, bar);
            __builtin_amdgcn_fence(__ATOMIC_ACQUIRE, "agent");
            xb_add(&bar[XB_XGEN(b.x)], 1u);
            asm volatile("s_waitcnt vmcnt(0)" ::: "memory");
        } else {
            XB_SPIN(xb_ld(&bar[XB_XGEN(b.x)]) == gen, bar);
            __builtin_amdgcn_fence(__ATOMIC_ACQUIRE, "agent");
            asm volatile("s_waitcnt vmcnt(0)" ::: "memory");
        }
    }
    __syncthreads();
}

namespace pg8 {
constexpr int BM = 256, BK = 64, HALF = 128, HTB = HALF * BK * 2, STAGE_BYTES = 8 * HTB, NXCD = 8, WGM = 8;
__host__ __device__ __forceinline__ int lds_byte(int r, int c) { const int st = (r >> 4) * 2 + (c >> 5), rr = r & 15, cc = c & 31, ob = rr * 64 + cc * 2; return st * 1024 + (ob ^ (((ob >> 9) & 1) << 5)); }
__host__ __device__ __forceinline__ void stage_rc(int b, int& R, int& C) { const int st = b / 1024, sb = b % 1024, swz = sb ^ (((sb >> 9) & 1) << 5); R = (st >> 1) * 16 + swz / 64; C = (st & 1) * 32 + (swz % 64) / 2; }
__host__ __device__ __forceinline__ int perm32(int rho) { const int n = rho >> 4, i = rho & 15; return 8 * (i >> 2) + 4 * n + (i & 3); }

typedef int i32x8 __attribute__((ext_vector_type(8)));
typedef int i32x4 __attribute__((ext_vector_type(4)));
__device__ __forceinline__ i32x8 cat8(bf16x8 lo, bf16x8 hi) { const i32x4 a = __builtin_bit_cast(i32x4, lo), b = __builtin_bit_cast(i32x4, hi); return __builtin_shufflevector(a, b, 0, 1, 2, 3, 4, 5, 6, 7); }
struct Unit { int pm, pn, e, rt; };
struct TileOrder {
    int nM, nN, nwg, G, c;
    __device__ __forceinline__ void init(int nM_, int nN_, int G_, int c_) { nM = nM_; nN = nN_; nwg = nM * nN; G = G_; c = c_; }
    __device__ __forceinline__ bool next(int i, int& pm, int& pn) const {
        const long Lx = (long)i * G + c; if (Lx >= nwg) return false;
        int wgid = (int)Lx; { const int q = nwg / NXCD, r = nwg % NXCD, xcd = wgid % NXCD, off = wgid / NXCD; wgid = (xcd < r ? xcd * (q + 1) : r * (q + 1) + (xcd - r) * q) + off; }
        const int nig = WGM * nN, gid = wgid / nig, fm = gid * WGM, gsz = (nM - fm) < WGM ? (nM - fm) : WGM;
        pm = fm + ((wgid % nig) % gsz); pn = (wgid % nig) / gsz; return true;
    }
};
struct ProbDense {
    static constexpr bool FP8 = false;
    const bf16_t* A; const bf16_t* Bt; int lda, ldb, K, a_pn_off; TileOrder ord;
    __device__ __forceinline__ int ldb_bytes() const { return ldb * 2; }
    __device__ __forceinline__ int ntiles() const { return K / 64; }
    __device__ __forceinline__ bool next(int i, Unit& u) const { u.e = 0; const bool ok = ord.next(i, u.pm, u.pn); u.rt = u.pm; return ok; }
    __device__ __forceinline__ const char* a_ptr(const Unit& u) const { return (const char*)(A + (size_t)u.pm * BM * lda + (size_t)u.pn * a_pn_off); }
    __device__ __forceinline__ const char* b_ptr(const Unit& u) const { return (const char*)(Bt + (size_t)u.pn * BM * ldb); }
    __device__ __forceinline__ void list_prefetch(const Unit&, int, int, int) const {}
    __device__ __forceinline__ void a_off(const Unit&, int, const int (&R)[2], const int (&C)[2], unsigned (&v)[2][2]) const {
#pragma unroll
        for (int h = 0; h < 2; ++h)
#pragma unroll
            for (int i = 0; i < 2; ++i) v[h][i] = (unsigned)((h * HALF + R[i]) * lda + C[i]) * 2u;
    }
};

struct ProbDense8 {
    static constexpr bool FP8 = true;
    const unsigned char* A; const unsigned char* Bt; int lda, ldb, K, scale_w, scale_x; TileOrder ord;
    __device__ __forceinline__ int ldb_bytes() const { return ldb; }
    __device__ __forceinline__ int ntiles() const { return K / 128; }
    __device__ __forceinline__ bool next(int i, Unit& u) const { u.e = 0; const bool ok = ord.next(i, u.pm, u.pn); u.rt = u.pm; return ok; }
    __device__ __forceinline__ const char* a_ptr(const Unit& u) const { return (const char*)(A + (size_t)u.pm * BM * lda); }
    __device__ __forceinline__ const char* b_ptr(const Unit& u) const { return (const char*)(Bt + (size_t)u.pn * BM * ldb); }
    __device__ __forceinline__ void list_prefetch(const Unit&, int, int, int) const {}
    __device__ __forceinline__ void a_off(const Unit&, int, const int (&R)[2], const int (&C)[2], unsigned (&v)[2][2]) const {
#pragma unroll
        for (int h = 0; h < 2; ++h)
#pragma unroll
            for (int i = 0; i < 2; ++i) v[h][i] = (unsigned)((h * HALF + R[i]) * lda + C[i] * 2);
    }
};
template <class Prob, class Epi>
__device__ __forceinline__ void gemm_phase(LAS unsigned char* lds, const Prob& P, const Epi& E) {
    const int tid = opaque_tid(), wid = __builtin_amdgcn_readfirstlane(tid >> 6), lane = tid & 63, wr = wid >> 2, wc = wid & 3, fr = lane & 15, fq = lane >> 4;
    const int nt = P.ntiles(); const int ldbB = P.ldb_bytes();
    int Rr[2], Cc[2]; unsigned voffB[2];
#pragma unroll
    for (int i = 0; i < 2; ++i) { int R, C; stage_rc(tid * 16 + i * 8192, R, C); Rr[i] = R; Cc[i] = C; const int Rb = Epi::PERM ? ((R & ~31) + perm32(R & 31)) : R;
        voffB[i] = (unsigned)(Rb * ldbB + C * 2); }
    const size_t kstep = (size_t)(BK * 2);
    const size_t hstepB = (size_t)HALF * ldbB;
    const unsigned ldsw = (unsigned)wid * 1024u;
    const int aoff = lds_byte(wr * 64 + fr, fq * 8), boff = lds_byte(wc * 32 + fr, fq * 8);
#define PG8_SA(b, h) (((b) * 2 + (h)) * HTB)
#define PG8_SB(b, h) ((4 + (b) * 2 + (h)) * HTB)
#define PG8_STAGE(bufoff, gbase, voff) do { _Pragma("unroll") for (int _i = 0; _i < 2; ++_i) \
        __builtin_amdgcn_global_load_lds((const unsigned*)((const char*)(gbase) + (voff)[_i]), (LAS unsigned*)(lds + (bufoff) + ldsw + _i * 8192), 16, 0, 0); } while (0)
#define PG8_LDA(dst, b, h) do { _Pragma("unroll") for (int m = 0; m < 4; ++m) _Pragma("unroll") for (int k = 0; k < 2; ++k) dst[m][k] = *(const LAS bf16x8*)(lds + PG8_SA(b, h) + aoff + m * 2048 + k * 1024); } while (0)
#define PG8_LDB(dst, b, h) do { _Pragma("unroll") for (int n = 0; n < 2; ++n) _Pragma("unroll") for (int k = 0; k < 2; ++k) dst[n][k] = *(const LAS bf16x8*)(lds + PG8_SB(b, h) + boff + n * 2048 + k * 1024); } while (0)
#define PG8_MMA(ai, bj, At, Bt) do { __builtin_amdgcn_s_setprio(1); _Pragma("unroll") for (int m = 0; m < 4; ++m) _Pragma("unroll") for (int n = 0; n < 2; ++n) { \
        if constexpr (Prob::FP8) { asm volatile("v_mfma_scale_f32_16x16x128_f8f6f4 %0, %1, %2, %0, %3, %4 op_sel_hi:[0,0,0]" : "+v"(acc[ai][bj][m][n]) : "v"(cat8(Bt[n][0], Bt[n][1])), "v"(cat8(At[m][0], At[m][1])), "v"(sc_w), "v"(sc_x)); } \
        else { _Pragma("unroll") for (int k = 0; k < 2; ++k) acc[ai][bj][m][n] = __builtin_amdgcn_mfma_f32_16x16x32_bf16(Bt[n][k], At[m][k], acc[ai][bj][m][n], 0, 0, 0); } } __builtin_amdgcn_s_setprio(0); } while (0)
#define PG8_WAIT_V(n) asm volatile("s_waitcnt vmcnt(" #n ")" ::: "memory")
#define PG8_WAIT_L(n) asm volatile("s_waitcnt lgkmcnt(" #n ")" ::: "memory")
#define PG8_BAR __builtin_amdgcn_s_barrier()
#define PG8_SCHED __builtin_amdgcn_sched_barrier(0)
    Unit cur, nxt; int ui = 0;
    if (!P.next(0, cur)) return;
    int sc_w = 0, sc_x = 0; if constexpr (Prob::FP8) { sc_w = P.scale_w; sc_x = P.scale_x; } (void)sc_w; (void)sc_x;
    f32x4 acc[2][2][4][2];
#pragma unroll
    for (int a = 0; a < 2; ++a)
#pragma unroll
        for (int b = 0; b < 2; ++b)
#pragma unroll
            for (int m = 0; m < 4; ++m)
#pragma unroll
                for (int n = 0; n < 2; ++n) acc[a][b][m][n] = (f32x4){0.f, 0.f, 0.f, 0.f};
    bf16x8 At[4][2], B0[2][2], B1[2][2];
    unsigned vAc[2][2], vAn[2][2];
    P.list_prefetch(cur, 0, wid, lane); { Unit u1; if (P.next(1, u1)) P.list_prefetch(u1, 1, wid, lane); }
    PG8_WAIT_V(0); PG8_BAR;
    P.a_off(cur, 0, Rr, Cc, vAc);
    const char* cA = P.a_ptr(cur); const char* cB = P.b_ptr(cur);
    PG8_STAGE(PG8_SB(0, 0), cB, voffB); PG8_STAGE(PG8_SB(0, 1), cB + hstepB, voffB); PG8_STAGE(PG8_SA(0, 0), cA, vAc[0]); PG8_STAGE(PG8_SA(0, 1), cA, vAc[1]);
    if (wr == 1) PG8_BAR;
    PG8_WAIT_V(2); PG8_BAR;
    PG8_STAGE(PG8_SB(1, 0), cB + kstep, voffB); PG8_STAGE(PG8_SA(1, 0), cA + kstep, vAc[0]); PG8_STAGE(PG8_SB(1, 1), cB + hstepB + kstep, voffB);
    PG8_WAIT_V(6); PG8_BAR;
    for (;;) {
        const bool has_next = P.next(ui + 1, nxt);
        const char* nA = cA; const char* nB = cB;
#pragma unroll
        for (int h = 0; h < 2; ++h)
#pragma unroll
            for (int i = 0; i < 2; ++i) vAn[h][i] = vAc[h][i];
        if (has_next) { nA = P.a_ptr(nxt); nB = P.b_ptr(nxt); P.a_off(nxt, (ui + 1) & 1, Rr, Cc, vAn); }
        { Unit u2; if (P.next(ui + 2, u2)) P.list_prefetch(u2, ui & 1, wid, lane); }
        for (int t = 0; t < nt; t += 2) {
            const bool last = (t == nt - 2);
            const char* a1 = cA + (size_t)(t + 1) * kstep;
            const char* a2 = last ? nA : cA + (size_t)(t + 2) * kstep; const char* b2 = last ? nB : cB + (size_t)(t + 2) * kstep;
            const char* a3 = a2 + kstep; const char* b3 = b2 + kstep;
            unsigned vX[2][2];
#pragma unroll
            for (int h = 0; h < 2; ++h)
#pragma unroll
                for (int i = 0; i < 2; ++i) vX[h][i] = last ? vAn[h][i] : vAc[h][i];
            PG8_LDB(B0, 0, 0); PG8_LDB(B1, 0, 1); PG8_SCHED; PG8_LDA(At, 0, 0); PG8_STAGE(PG8_SA(1, 1), a1, vAc[1]);
            PG8_WAIT_V(8); PG8_WAIT_L(0); PG8_BAR; PG8_MMA(0, 0, At, B0); PG8_MMA(0, 1, At, B1); PG8_BAR; PG8_SCHED;
            PG8_LDA(At, 0, 1); PG8_STAGE(PG8_SB(0, 0), b2, voffB); PG8_STAGE(PG8_SB(0, 1), b2 + hstepB, voffB); PG8_STAGE(PG8_SA(0, 0), a2, vX[0]);
            PG8_WAIT_V(8); PG8_WAIT_L(0); PG8_BAR; PG8_MMA(1, 0, At, B0); PG8_MMA(1, 1, At, B1); PG8_BAR; PG8_SCHED;
            PG8_LDB(B0, 1, 0); PG8_LDB(B1, 1, 1); PG8_SCHED; PG8_LDA(At, 1, 0); PG8_STAGE(PG8_SA(0, 1), a2, vX[1]);
            PG8_WAIT_V(8); PG8_WAIT_L(0); PG8_BAR; PG8_MMA(0, 0, At, B0); PG8_MMA(0, 1, At, B1); PG8_BAR; PG8_SCHED;
            PG8_LDA(At, 1, 1); PG8_STAGE(PG8_SB(1, 0), b3, voffB); PG8_STAGE(PG8_SB(1, 1), b3 + hstepB, voffB); PG8_STAGE(PG8_SA(1, 0), a3, vX[0]);
            PG8_WAIT_V(8); PG8_WAIT_L(0); PG8_BAR; PG8_MMA(1, 0, At, B0); PG8_MMA(1, 1, At, B1); PG8_BAR; PG8_SCHED;
        }
        if (wr == 0) PG8_BAR;
        if constexpr (Prob::FP8) asm volatile("s_nop 15\n\ts_nop 15" ::: "memory");
        E(acc, cur, wr, wc, fr, fq);
        if (!has_next) break;
#pragma unroll
        for (int a = 0; a < 2; ++a)
#pragma unroll
            for (int b = 0; b < 2; ++b)
#pragma unroll
                for (int m = 0; m < 4; ++m)
#pragma unroll
                    for (int n = 0; n < 2; ++n) acc[a][b][m][n] = (f32x4){0.f, 0.f, 0.f, 0.f};
        cur = nxt; cA = nA; cB = nB; ++ui;
#pragma unroll
        for (int h = 0; h < 2; ++h)
#pragma unroll
            for (int i = 0; i < 2; ++i) vAc[h][i] = vAn[h][i];
        if (wr == 1) PG8_BAR;
    }
    PG8_WAIT_V(0);
    PG8_BAR;
#undef PG8_SA
#undef PG8_SB
#undef PG8_STAGE
#undef PG8_LDA
#undef PG8_LDB
#undef PG8_MMA
#undef PG8_WAIT_V
#undef PG8_WAIT_L
#undef PG8_BAR
#undef PG8_SCHED
}
}

using pg8::Unit;
constexpr int HALF_ = 128;
struct EpiBf16Act {
    static constexpr bool PERM = true;
    bf16_t* O; int ldc; const float* bias; int act; float scale;
    __device__ __forceinline__ void operator()(const f32x4 (&acc)[2][2][4][2], const Unit& u, int wr, int wc, int fr, int fq) const {
        const int row0 = u.pm * 256 + wr * 64 + fr, col0 = u.pn * 256 + wc * 32 + 8 * fq;
        f32x4 bv[2][2];
#pragma unroll
        for (int bj = 0; bj < 2; ++bj)
#pragma unroll
            for (int n = 0; n < 2; ++n) bv[bj][n] = bias ? *(const f32x4*)(bias + col0 + bj * HALF_ + 4 * n) : (f32x4){0.f, 0.f, 0.f, 0.f};
#pragma unroll
        for (int ai = 0; ai < 2; ++ai)
#pragma unroll
            for (int m = 0; m < 4; ++m) { bf16_t* rowp = O + (size_t)(row0 + ai * HALF_ + m * 16) * ldc + col0;
#pragma unroll
                for (int bj = 0; bj < 2; ++bj) { f32x4 v0 = acc[ai][bj][m][0] + bv[bj][0], v1 = acc[ai][bj][m][1] + bv[bj][1];
                    if (act == 1) {
#pragma unroll
                        for (int j = 0; j < 4; ++j) { v0[j] = sigmoidf_(v0[j]) * scale; v1[j] = sigmoidf_(v1[j]) * scale; } }
                    else if (act == 2) {
#pragma unroll
                        for (int j = 0; j < 4; ++j) { v0[j] = 1.0f - 2.0f * __builtin_amdgcn_rcpf(__builtin_amdgcn_exp2f(2.8853900817779268f * v0[j]) + 1.0f); v1[j] = 1.0f - 2.0f * __builtin_amdgcn_rcpf(__builtin_amdgcn_exp2f(2.8853900817779268f * v1[j]) + 1.0f); } }
                    u32x4 w; w.x = cvt_pk_bf16(v0[0], v0[1]); w.y = cvt_pk_bf16(v0[2], v0[3]); w.z = cvt_pk_bf16(v1[0], v1[1]); w.w = cvt_pk_bf16(v1[2], v1[3]);
                    *(u32x4*)(rowp + bj * HALF_) = w; } }
    }
};
struct EpiQK {
    static constexpr bool PERM = true;
    bf16_t* Q; bf16_t* Kb; const float* bias; const float* ropec; const float* ropes;
    __device__ __forceinline__ void operator()(const f32x4 (&acc)[2][2][4][2], const Unit& u, int wr, int wc, int fr, int fq) const {
        int row0 = u.pm * 256 + wr * 64 + fr, cl0 = wc * 32 + 8 * fq;
        asm volatile("" : "+v"(row0), "+v"(cl0));
        const int g = (4 * wc + fq) & 7;
        bf16_t* base; int ldc;
        if (u.pn < 4) { base = Q + u.pn * 256; ldc = 1024; } else { base = Kb; ldc = 256; }
        f32x4 bv[2][2];
#pragma unroll
        for (int bj = 0; bj < 2; ++bj)
#pragma unroll
            for (int n = 0; n < 2; ++n) bv[bj][n] = *(const f32x4*)(bias + u.pn * 256 + cl0 + bj * HALF_ + 4 * n);
#pragma unroll
        for (int ai = 0; ai < 2; ++ai)
#pragma unroll
            for (int m = 0; m < 4; ++m) { const int row = row0 + ai * HALF_ + m * 16; bf16_t* rowp = base + (size_t)row * ldc + cl0;
                f32x4 cs = (f32x4){1.f, 1.f, 1.f, 1.f}, sn = (f32x4){0.f, 0.f, 0.f, 0.f};
                if (row < NX) { const int t = row & (T - 1); cs = *(const f32x4*)(ropec + t * 32 + g * 4); sn = *(const f32x4*)(ropes + t * 32 + g * 4); }
#pragma unroll
                for (int bj = 0; bj < 2; ++bj) { const f32x4 v0 = acc[ai][bj][m][0] + bv[bj][0], v1 = acc[ai][bj][m][1] + bv[bj][1];
                    const f32x4 o0 = v0 * cs - v1 * sn, o1 = v1 * cs + v0 * sn;
                    u32x4 w; w.x = cvt_pk_bf16(o0[0], o0[1]); w.y = cvt_pk_bf16(o0[2], o0[3]); w.z = cvt_pk_bf16(o1[0], o1[1]); w.w = cvt_pk_bf16(o1[2], o1[3]);
                    *(u32x4*)(rowp + bj * HALF_) = w; } }
    }
};
struct EpiVT {
    static constexpr bool PERM = true;
    bf16_t* VT; const float* biasrow;
    __device__ __forceinline__ void operator()(const f32x4 (&acc)[2][2][4][2], const Unit& u, int wr, int wc, int fr, int fq) const {
        int row0 = wr * 64 + fr, col0 = u.pn * 256 + wc * 32 + 8 * fq;
        asm volatile("" : "+v"(row0), "+v"(col0));
#pragma unroll
        for (int ai = 0; ai < 2; ++ai)
#pragma unroll
            for (int m = 0; m < 4; ++m) { const int row = row0 + ai * HALF_ + m * 16; const float b = biasrow[row]; bf16_t* rowp = VT + (size_t)row * NT + col0;
#pragma unroll
                for (int bj = 0; bj < 2; ++bj) { const f32x4 v0 = acc[ai][bj][m][0] + b, v1 = acc[ai][bj][m][1] + b;
                    u32x4 w; w.x = cvt_pk_bf16(v0[0], v0[1]); w.y = cvt_pk_bf16(v0[2], v0[3]); w.z = cvt_pk_bf16(v1[0], v1[1]); w.w = cvt_pk_bf16(v1[2], v1[3]);
                    *(u32x4*)(rowp + bj * HALF_) = w; } }
    }
};
struct EpiResid {
    static constexpr bool PERM = true;
    bf16_t* H; const float* bias; const float* ls; const float* gate;
    __device__ __forceinline__ void operator()(const f32x4 (&acc)[2][2][4][2], const Unit& u, int wr, int wc, int fr, int fq) const {
        int row0 = u.pm * 256 + wr * 64 + fr, col0 = u.pn * 256 + wc * 32 + 8 * fq;
        asm volatile("" : "+v"(row0), "+v"(col0));
        f32x4 bv[2][2], lv[2][2];
#pragma unroll
        for (int bj = 0; bj < 2; ++bj)
#pragma unroll
            for (int n = 0; n < 2; ++n) { bv[bj][n] = bias ? *(const f32x4*)(bias + col0 + bj * HALF_ + 4 * n) : (f32x4){0.f, 0.f, 0.f, 0.f};
                                          lv[bj][n] = ls ? *(const f32x4*)(ls + col0 + bj * HALF_ + 4 * n) : (f32x4){1.f, 1.f, 1.f, 1.f}; }
#pragma unroll
        for (int ai = 0; ai < 2; ++ai)
#pragma unroll
            for (int m = 0; m < 4; ++m) { const int row = row0 + ai * HALF_ + m * 16; const int brow = row < NX ? (row >> 11) : 32;
                bf16_t* hp = H + (size_t)row * D + col0; const float* gp = gate + (size_t)brow * (6 * D) + col0;
#pragma unroll
                for (int bj = 0; bj < 2; ++bj) { const u32x4 hw = *(const u32x4*)(hp + bj * HALF_);
                    const f32x4 g0 = *(const f32x4*)(gp + bj * HALF_), g1 = *(const f32x4*)(gp + bj * HALF_ + 4);
                    const f32x4 y0 = (acc[ai][bj][m][0] + bv[bj][0]) * lv[bj][0], y1 = (acc[ai][bj][m][1] + bv[bj][1]) * lv[bj][1];
                    const f32x4 h0 = (f32x4){bflo(hw.x), bfhi(hw.x), bflo(hw.y), bfhi(hw.y)} + g0 * y0, h1 = (f32x4){bflo(hw.z), bfhi(hw.z), bflo(hw.w), bfhi(hw.w)} + g1 * y1;
                    u32x4 w; w.x = cvt_pk_bf16(h0[0], h0[1]); w.y = cvt_pk_bf16(h0[2], h0[3]); w.z = cvt_pk_bf16(h1[0], h1[1]); w.w = cvt_pk_bf16(h1[2], h1[3]);
                    *(u32x4*)(hp + bj * HALF_) = w; }
                asm volatile("" ::: "memory"); }
    }
};
struct EpiMoe1 {
    static constexpr bool PERM = true;
    unsigned char* ACT; const float* b1;
    __device__ __forceinline__ void operator()(const f32x4 (&acc)[2][2][4][2], const Unit& u, int wr, int wc, int fr, int fq) const {
        const int row0 = u.rt * 256 + wr * 64 + fr, cl = u.pn * 128 + wc * 32 + 8 * fq;
        const float* bg = b1 + (size_t)u.e * 2048 + cl; const float* bl = bg + 1024;
        f32x4 bgv[2], blv[2];
#pragma unroll
        for (int n = 0; n < 2; ++n) { bgv[n] = *(const f32x4*)(bg + 4 * n); blv[n] = *(const f32x4*)(bl + 4 * n); }
#pragma unroll
        for (int ai = 0; ai < 2; ++ai)
#pragma unroll
            for (int m = 0; m < 4; ++m) { unsigned char* rowp = ACT + (size_t)(row0 + ai * HALF_ + m * 16) * D + cl;
                f32x4 o[2];
#pragma unroll
                for (int n = 0; n < 2; ++n) { const f32x4 c7 = (f32x4){7.f, 7.f, 7.f, 7.f};
                    const f32x4 gl = __builtin_elementwise_min(acc[ai][0][m][n] + bgv[n], c7), li = __builtin_elementwise_min(__builtin_elementwise_max(acc[ai][1][m][n] + blv[n], -c7), c7);
                    const f32x4 z = gl * (-1.702f * 1.4426950408889634f); f32x4 den;
#pragma unroll
                    for (int j = 0; j < 4; ++j) den[j] = __builtin_amdgcn_rcpf(1.0f + __builtin_amdgcn_exp2f(z[j]));
                    o[n] = gl * den * (li + 1.0f); }
                u32x2 w; w.x = pk4_fp8(o[0][0], o[0][1], o[0][2], o[0][3]); w.y = pk4_fp8(o[1][0], o[1][1], o[1][2], o[1][3]);
                *(u32x2*)rowp = w; }
    }
};
struct EpiMoe2 {
    static constexpr bool PERM = true;
    unsigned char* Y; const float* b2;
    __device__ __forceinline__ void operator()(const f32x4 (&acc)[2][2][4][2], const Unit& u, int wr, int wc, int fr, int fq) const {
        const int row0 = u.rt * 256 + wr * 64 + fr, col0 = u.pn * 256 + wc * 32 + 8 * fq;
        const float* bb = b2 + (size_t)u.e * D + col0;
        f32x4 bv[2][2];
#pragma unroll
        for (int bj = 0; bj < 2; ++bj)
#pragma unroll
            for (int n = 0; n < 2; ++n) bv[bj][n] = *(const f32x4*)(bb + bj * HALF_ + 4 * n);
#pragma unroll
        for (int ai = 0; ai < 2; ++ai)
#pragma unroll
            for (int m = 0; m < 4; ++m) { unsigned char* rowp = Y + (size_t)(row0 + ai * HALF_ + m * 16) * D + col0;
#pragma unroll
                for (int bj = 0; bj < 2; ++bj) { const f32x4 v0 = (acc[ai][bj][m][0] + bv[bj][0]) * 8.0f, v1 = (acc[ai][bj][m][1] + bv[bj][1]) * 8.0f;
                    *(u32x2*)(rowp + bj * HALF_) = (u32x2){pk4_fp8(v0[0], v0[1], v0[2], v0[3]), pk4_fp8(v1[0], v1[1], v1[2], v1[3])}; } }
    }
};
typedef unsigned char fp8_t;
constexpr int SCALE_ONE = 0x7f7f7f7f, SCALE_W = 0x79797979;
struct ProbMoe1 {
    static constexpr bool FP8 = true;
    const fp8_t* FX; const fp8_t* W1T; const int* list; const LAS int* tpre; const LAS int* cnt; const LAS unsigned char* texp; LAS int* toks; int scale_w, scale_x; pg8::TileOrder ord;
    __device__ __forceinline__ int ldb_bytes() const { return D; }
    __device__ __forceinline__ int ntiles() const { return D / 128; }
    __device__ __forceinline__ bool next(int i, Unit& u) const {
        if (!ord.next(i, u.pm, u.pn)) return false;
        u.rt = u.pm; u.e = texp[u.rt]; return true;
    }
    __device__ __forceinline__ const char* a_ptr(const Unit&) const { return (const char*)FX; }
    __device__ __forceinline__ const char* b_ptr(const Unit& u) const { return (const char*)(W1T + ((size_t)u.e * 2048 + (size_t)u.pn * 256) * D); }
    __device__ __forceinline__ void list_prefetch(const Unit& u, int par, int wid, int lane) const {
        if (wid == 0) { const int* src = list + (size_t)u.e * NT + (u.rt - tpre[u.e]) * 256 + 4 * lane;
            __builtin_amdgcn_global_load_lds((const unsigned*)src, (LAS unsigned*)(toks + par * 256), 16, 0, 0); }
    }
    __device__ __forceinline__ void a_off(const Unit& u, int par, const int (&R)[2], const int (&C)[2], unsigned (&v)[2][2]) const {
        const int nvalid = cnt[u.e] - (u.rt - tpre[u.e]) * 256; const LAS int* tk = toks + par * 256;
#pragma unroll
        for (int h = 0; h < 2; ++h)
#pragma unroll
            for (int i = 0; i < 2; ++i) { const int r = h * 128 + R[i]; const int tok = tk[r < nvalid ? r : 0]; v[h][i] = (unsigned)(tok * D + C[i] * 2); }
    }
};
struct ProbMoe2 {
    static constexpr bool FP8 = true;
    const fp8_t* ACT; const fp8_t* W2T; const LAS int* tpre; const LAS unsigned char* texp; int scale_w, scale_x; pg8::TileOrder ord;
    __device__ __forceinline__ int ldb_bytes() const { return D; }
    __device__ __forceinline__ int ntiles() const { return D / 128; }
    __device__ __forceinline__ bool next(int i, Unit& u) const {
        if (!ord.next(i, u.pm, u.pn)) return false;
        u.rt = u.pm; u.e = texp[u.rt]; return true;
    }
    __device__ __forceinline__ const char* a_ptr(const Unit& u) const { return (const char*)(ACT + (size_t)u.rt * 256 * D); }
    __device__ __forceinline__ const char* b_ptr(const Unit& u) const { return (const char*)(W2T + ((size_t)u.e * 1024 + (size_t)u.pn * 256) * D); }
    __device__ __forceinline__ void list_prefetch(const Unit&, int, int, int) const {}
    __device__ __forceinline__ void a_off(const Unit&, int, const int (&R)[2], const int (&C)[2], unsigned (&v)[2][2]) const {
#pragma unroll
        for (int h = 0; h < 2; ++h)
#pragma unroll
            for (int i = 0; i < 2; ++i) v[h][i] = (unsigned)((h * 128 + R[i]) * D + C[i] * 2);
    }
};
struct Args { const float* in[38]; float* out; unsigned char* ws; int phase; int one; };
enum { I_X = 0, I_C, I_CTX, I_CCTX, I_ADAW, I_ADAB, I_NORMG, I_AWQKV, I_ABQKV, I_AWO, I_ABO, I_ASINK, I_PW, I_PB, I_PS,
       I_RMIX, I_RWRKV, I_RW0, I_RW1, I_RW2, I_RA0, I_RA1, I_RA2, I_RG1, I_RG2, I_RKK, I_RKA, I_RRK, I_RLNW, I_RLNB, I_RWO,
       I_MWR, I_MBR, I_MW1, I_MB1, I_MW2, I_MB2, I_FG };
struct Frame { LAS unsigned char* lds; int tid, lane, wave, G, c; unsigned char* ws; unsigned* ctl; };
#define WSP(T_, off) ((T_*)(F.ws + (off)))

struct TJob { const float* src; unsigned char* dst; long sbs, dbs; int ldw, ldt, nkb, nnb, mode, item0, per, esz; };
__device__ __forceinline__ int dst_row(int mode, int n) {
    if (mode == 1) { const int hb = n & ~63, d = n & 63; const int ax = d >> 5, dd = d & 31, hf = dd >> 4, f = dd & 15; const int g = ax * 4 + (f >> 2), i = (f & 3) + 4 * hf; return hb + 8 * g + i; }
    if (mode == 2) { return n < 1024 ? ((n >> 7) << 8) + (n & 127) : (((n - 1024) >> 7) << 8) + 128 + (n & 127); }
    return n;
}
struct TItem { const float* src; unsigned char* dst; int ldw, ldt, mode, n0, esz; };
__device__ __forceinline__ void titem_decode(const LAS TJob* jobs, int nj, int it, TItem& T) {
    int ji = 0;
    for (int q = 1; q < nj; ++q) ji += (jobs[q].item0 <= it) ? 1 : 0;
    const LAS TJob& J = jobs[ji]; const int r = it - J.item0, bi = r / J.per, rr = r % J.per, kb = rr / J.nnb, nb = rr % J.nnb;
    T.src = J.src + bi * J.sbs + (size_t)(64 * kb) * J.ldw + 32 * nb; T.dst = J.dst + (bi * J.dbs + 64 * kb) * J.esz; T.ldw = J.ldw; T.ldt = J.ldt; T.mode = J.mode; T.n0 = 32 * nb; T.esz = J.esz;
}
__device__ __forceinline__ void titem_load(const TItem& T, int lane, f32x4 (&v)[8]) {
    const float* p = T.src + (size_t)(lane >> 3) * T.ldw + 4 * (lane & 7);
#pragma unroll
    for (int i = 0; i < 8; ++i) v[i] = *(const f32x4*)(p + (size_t)(8 * i) * T.ldw);
}
__device__ __forceinline__ void titem_store(const TItem& T, int lane, const f32x4 (&v)[8], LAS float* scr) {
#pragma unroll
    for (int i = 0; i < 8; ++i) { LAS float* d = scr + (8 * i + (lane >> 3)) * 33 + 4 * (lane & 7); d[0] = v[i].x; d[1] = v[i].y; d[2] = v[i].z; d[3] = v[i].w; }
    LDS_WAIT(); asm volatile("" ::: "memory");
    const int c = lane & 7;
#pragma unroll
    for (int j = 0; j < 4; ++j) { const int n = (lane >> 3) + 8 * j; const LAS float* s = scr + (8 * c) * 33 + n;
        const size_t eo = (size_t)dst_row(T.mode, T.n0 + n) * T.ldt + 8 * c;
        if (T.esz == 2) { u32x4 o; o.x = pk2(s[0 * 33], s[1 * 33]); o.y = pk2(s[2 * 33], s[3 * 33]); o.z = pk2(s[4 * 33], s[5 * 33]); o.w = pk2(s[6 * 33], s[7 * 33]); *(u32x4*)(T.dst + eo * 2) = o; }
        else { u32x2 o; o.x = pk4_fp8(64.f * s[0 * 33], 64.f * s[1 * 33], 64.f * s[2 * 33], 64.f * s[3 * 33]); o.y = pk4_fp8(64.f * s[4 * 33], 64.f * s[5 * 33], 64.f * s[6 * 33], 64.f * s[7 * 33]); *(u32x2*)(T.dst + eo) = o; } }
    LDS_WAIT(); asm volatile("" ::: "memory");
}
__device__ __forceinline__ void phase_prologue(Frame& F, const Args& A) {
    REFRESH(F);
    LAS float* S = (LAS float*)F.lds;
    for (int idx = F.tid; idx < 33 * 1024; idx += NTHREADS) { const int r = idx >> 10, k = idx & 1023; const float v = r < 32 ? A.in[I_C][r * 1024 + k] : A.in[I_CCTX][k]; S[k * 33 + r] = v / (1.0f + __expf(-v)); }
    __syncthreads();
    float* MOD = WSP(float, WS_MOD);
    for (int it = F.c; it < 4 * 96; it += F.G) {
        const int layer = it / 96, n = (it % 96) * 64 + F.lane; const float* wp = A.in[I_ADAW] + (size_t)layer * 1024 * 6144 + n;
        float acc[5] = {0.f, 0.f, 0.f, 0.f, 0.f};
        for (int k0 = 0; k0 < 1024; k0 += 32) {
            float wv[32];
#pragma unroll
            for (int u = 0; u < 32; ++u) wv[u] = wp[(size_t)(k0 + u) * 6144];
#pragma unroll
            for (int u = 0; u < 32; ++u) { const LAS float* sr = S + (k0 + u) * 33 + F.wave;
                acc[0] += sr[0] * wv[u]; acc[1] += sr[8] * wv[u]; acc[2] += sr[16] * wv[u]; acc[3] += sr[24] * wv[u]; if (F.wave == 0) acc[4] += S[(k0 + u) * 33 + 32] * wv[u]; }
        }
        const float bb = A.in[I_ADAB][layer * 6144 + n];
#pragma unroll
        for (int i = 0; i < 4; ++i) MOD[((size_t)layer * 33 + F.wave + 8 * i) * 6144 + n] = acc[i] + bb;
        if (F.wave == 0) MOD[((size_t)layer * 33 + 32) * 6144 + n] = acc[4] + bb;
    }
    { float* rc = WSP(float, WS_ROPEC); float* rs = WSP(float, WS_ROPES);
      for (int idx = F.c * NTHREADS + F.tid; idx < 2048 * 32; idx += F.G * NTHREADS) { const int t = idx >> 5, e = idx & 31, g = e >> 2, i = e & 3, f = 4 * (g & 3) + i;
          const float inv = powf(10000.0f, -(float)f / 16.0f); const float pos = (float)(g < 4 ? (t >> 6) : (t & 63)); const float ang = pos * inv; rc[idx] = cosf(ang); rs[idx] = sinf(ang); }
      float* bq = WSP(float, WS_BQK);
      for (int idx = F.c * NTHREADS + F.tid; idx < 2 * 1280; idx += F.G * NTHREADS) { const int j = idx / 1280, n = idx % 1280; bq[j * 1280 + dst_row(1, n)] = A.in[I_ABQKV][j * 1536 + n]; } }
    __syncthreads();
    LAS TJob* jobs = (LAS TJob*)(F.lds + JOB_OFF); LAS int* njobs = (LAS int*)(F.lds + MISC_OFF + 64);
    if (F.tid == 0) {
        int nj = 0, item = 0;
        auto add = [&](const float* src, bf16_t* dst, int ldw, int ldt, int Ks, int Ns, int mode, int nb, long sbs, long dbs, int esz = 2) {
            LAS TJob& j = jobs[nj]; j.src = src; j.dst = (unsigned char*)dst; j.sbs = sbs; j.dbs = dbs; j.ldw = ldw; j.ldt = ldt; j.nkb = Ks / 64; j.nnb = Ns / 32; j.mode = mode; j.item0 = item; j.per = (Ks / 64) * (Ns / 32); j.esz = esz;
            ++nj; item += (Ks / 64) * (Ns / 32) * nb; };
        add(A.in[I_AWQKV], WSP(bf16_t, WS_WQK), 1536, 1024, 1024, 1280, 1, 2, 1024L * 1536, 1280L * 1024, 1);
        add(A.in[I_AWQKV] + 1280, WSP(bf16_t, WS_WV), 1536, 1024, 1024, 256, 0, 2, 1024L * 1536, 256L * 1024, 1);
        add(A.in[I_AWO], WSP(bf16_t, WS_WO), 1024, 1024, 1024, 1024, 0, 2, 1L << 20, 1L << 20, 1);
        add(A.in[I_PW], WSP(bf16_t, WS_POOLW), 256, 256, 256, 256, 0, 4, 65536, 65536);
        add(A.in[I_RWRKV], WSP(bf16_t, WS_WRKV), 1024, 1024, 1024, 1024, 0, 3, 1L << 20, 1L << 20, 1);
        add(A.in[I_RG1], WSP(bf16_t, WS_WL1), 128, 1024, 1024, 128, 0, 1, 0, 0);
        add(A.in[I_RW1], WSP(bf16_t, WS_WL1) + 256 * 1024, 64, 1024, 1024, 64, 0, 2, 65536, 65536);
        add(A.in[I_RA1], WSP(bf16_t, WS_WL1) + 2 * 256 * 1024, 64, 1024, 1024, 64, 0, 2, 65536, 65536);
        add(A.in[I_RG2], WSP(bf16_t, WS_WL2), 1024, 256, 128, 1024, 0, 1, 0, 0);
        add(A.in[I_RW2], WSP(bf16_t, WS_WL2) + 1 * 1024 * 256, 1024, 256, 64, 1024, 0, 2, 65536, 1024L * 256 + 64);
        add(A.in[I_RA2], WSP(bf16_t, WS_WL2) + 3 * 1024 * 256, 1024, 256, 64, 1024, 0, 2, 65536, 1024L * 256 + 64);
        add(A.in[I_RWO], WSP(bf16_t, WS_WOR), 1024, 1024, 1024, 1024, 0, 1, 0, 0, 1);
        add(A.in[I_MW1], WSP(bf16_t, WS_W1T), 2048, 1024, 1024, 2048, 2, 128, 1024L * 2048, 2048L * 1024, 1);
        add(A.in[I_MW2], WSP(bf16_t, WS_W2T), 1024, 1024, 1024, 1024, 0, 128, 1L << 20, 1L << 20, 1);
        njobs[0] = nj; njobs[1] = item;
    }
    __syncthreads();
    { const int nj = njobs[0], nitems = njobs[1]; LAS float* scr = (LAS float*)(F.lds + F.wave * 16384);
      const int gw = F.c * NWAVES + F.wave, NGW = F.G * NWAVES;
      int it = gw;
      if (it < nitems) {
          TItem Tc, Tn; f32x4 vc[8], vn[8];
          titem_decode(jobs, nj, it, Tc); titem_load(Tc, F.lane, vc);
          for (;;) {
              const int itn = it + NGW; const bool more = itn < nitems;
              if (more) { titem_decode(jobs, nj, itn, Tn); titem_load(Tn, F.lane, vn); }
              titem_store(Tc, F.lane, vc, scr);
              if (!more) break;
              Tc = Tn;
#pragma unroll
              for (int i = 0; i < 8; ++i) vc[i] = vn[i];
              it = itn;
          }
      } }
    __syncthreads();
}

__device__ __forceinline__ void moe_tiles(Frame& F, int layer) {
    REFRESH(F);
    LAS int* lcnt = (LAS int*)(F.lds + LCNT_OFF); LAS int* tpre = (LAS int*)(F.lds + TPRE_OFF);
    __syncthreads();
    if (F.tid < NE) lcnt[F.tid] = (int)__hip_atomic_load(F.ctl + CW_GCNT + layer * 64 + F.tid, __ATOMIC_RELAXED, __HIP_MEMORY_SCOPE_AGENT);
    __syncthreads();
    if (F.tid == 0) { int s = 0; for (int e = 0; e < NE; ++e) { tpre[e] = s; s += (lcnt[e] + 255) >> 8; } tpre[NE] = s; }
    __syncthreads();
    { LAS unsigned char* texp = (LAS unsigned char*)(F.lds + TEXP_OFF); const int nrt = tpre[NE];
      for (int rt = F.tid; rt < nrt; rt += NTHREADS) { int e = 0; for (int j = 1; j < NE; ++j) e += (tpre[j] <= rt) ? 1 : 0; texp[rt] = (unsigned char)e; } }
    __syncthreads();
}
constexpr int RB = 2;
#define ROWOF(it, r) ((((it) * F.G + F.c) * NWAVES + F.wave) * RB + (r))
struct MoeRef { int p[4]; float g[4]; };
__device__ __forceinline__ void moe_ref_load(Frame& F, int row, MoeRef& R) {
    const int4 pp = *(const int4*)(WSP(int, WS_POS) + (size_t)row * 4); const f32x4 gg = *(const f32x4*)(WSP(float, WS_GATE) + (size_t)row * 4);
    R.p[0] = pp.x; R.p[1] = pp.y; R.p[2] = pp.z; R.p[3] = pp.w; R.g[0] = gg.x; R.g[1] = gg.y; R.g[2] = gg.z; R.g[3] = gg.w;
}
__device__ __forceinline__ void moe_rows_load(Frame& F, const MoeRef& R, unsigned (&y)[4][4]) {
    const LAS int* tpre = (const LAS int*)(F.lds + TPRE_OFF); const unsigned char* Y = WSP(unsigned char, WS_Y);
#pragma unroll
    for (int k = 0; k < 4; ++k) { const int e = R.p[k] >> 20, slot = R.p[k] & 0xfffff; const size_t fr = (size_t)tpre[e] * 256 + slot; const unsigned* yp = (const unsigned*)(Y + fr * D) + F.lane;
#pragma unroll
        for (int j = 0; j < 4; ++j) y[k][j] = yp[64 * j]; }
}
__device__ __forceinline__ f32x4 moe_rows_sum(const MoeRef& R, const unsigned (&y)[4][4], int j) {
    f32x4 s = (f32x4){0.f, 0.f, 0.f, 0.f};
#pragma unroll
    for (int k = 0; k < 4; ++k) { const int w = (int)y[k][j]; const f32x2 lo = __builtin_amdgcn_cvt_pk_f32_fp8(w, false), hi = __builtin_amdgcn_cvt_pk_f32_fp8(w, true);
        s += (R.g[k] * 0.125f) * (f32x4){lo.x, lo.y, hi.x, hi.y}; }
    return s;
}

__device__ __forceinline__ void phase_norm1(Frame& F, const Args& A, int layer) {
    REFRESH(F);
    if (layer > 0) moe_tiles(F, layer - 1);
    bf16_t* H = WSP(bf16_t, WS_H); bf16_t* AX = WSP(bf16_t, WS_AX); const float* MOD = WSP(float, WS_MOD);
    const float* g1 = A.in[I_NORMG] + (size_t)(layer * 2 + 0) * D;
    f32x4 gg[4];
#pragma unroll
    for (int j = 0; j < 4; ++j) gg[j] = ((const f32x4*)g1)[64 * j + F.lane];
    for (int it = 0;; ++it) { if (ROWOF(it, 0) >= NT) break;
        f32x4 v[RB][4]; int brow[RB];
        if (layer == 0) {
#pragma unroll
            for (int r = 0; r < RB; ++r) { const int row = ROWOF(it, r); brow[r] = row < NX ? (row >> 11) : 32; const float* src = row < NX ? A.in[I_X] + (size_t)row * D : A.in[I_CTX] + (size_t)(row - NX) * D;
#pragma unroll
                for (int j = 0; j < 4; ++j) v[r][j] = ((const f32x4*)src)[64 * j + F.lane]; }
        } else {
            MoeRef R[RB]; unsigned y[RB][4][4]; f32x4 gv[RB][4];
#pragma unroll
            for (int r = 0; r < RB; ++r) moe_ref_load(F, ROWOF(it, r), R[r]);
#pragma unroll
            for (int r = 0; r < RB; ++r) { const int row = ROWOF(it, r); brow[r] = row < NX ? (row >> 11) : 32; moe_rows_load(F, R[r], y[r]);
                const float* g2p = MOD + ((size_t)(layer - 1) * 33 + brow[r]) * 6144 + 5 * D;
#pragma unroll
                for (int j = 0; j < 4; ++j) { v[r][j] = ld_bf4(H + (size_t)row * D + 256 * j + 4 * F.lane); gv[r][j] = ((const f32x4*)g2p)[64 * j + F.lane]; } }
#pragma unroll
            for (int r = 0; r < RB; ++r)
#pragma unroll
                for (int j = 0; j < 4; ++j) v[r][j] = v[r][j] + gv[r][j] * moe_rows_sum(R[r], y[r], j);
        }
        float rstd[RB];
#pragma unroll
        for (int r = 0; r < RB; ++r) { const int row = ROWOF(it, r); float ss = 0.f;
#pragma unroll
            for (int j = 0; j < 4; ++j) { st_bf4(H + (size_t)row * D + 256 * j + 4 * F.lane, v[r][j]); ss += (v[r][j].x * v[r][j].x + v[r][j].y * v[r][j].y) + (v[r][j].z * v[r][j].z + v[r][j].w * v[r][j].w); }
            rstd[r] = 1.0f / sqrtf(wave_sum(ss) * (1.0f / D) + 1e-5f); }
#pragma unroll
        for (int r = 0; r < RB; ++r) { const int row = ROWOF(it, r); const float* mp = MOD + ((size_t)layer * 33 + brow[r]) * 6144;
#pragma unroll
            for (int j = 0; j < 4; ++j) { const f32x4 sh = ((const f32x4*)mp)[64 * j + F.lane], sc = ((const f32x4*)(mp + D))[64 * j + F.lane];
                const f32x4 o = v[r][j] * rstd[r] * gg[j] * (sc + 1.0f) + sh;
                if (layer % 3 == 0) ((unsigned*)((unsigned char*)AX + (size_t)row * D))[64 * j + F.lane] = pk4_fp8(o.x, o.y, o.z, o.w);
                else { u32x2 w; w.x = pk2(o.x, o.y); w.y = pk2(o.z, o.w); ((u32x2*)(AX + (size_t)row * D))[64 * j + F.lane] = w; } } }
    }
}
__device__ __forceinline__ void phase_final(Frame& F, const Args& A) {
    REFRESH(F);
    moe_tiles(F, DEPTH - 1);
    const bf16_t* H = WSP(bf16_t, WS_H); const float* MOD = WSP(float, WS_MOD); const float* fg = A.in[I_FG];
    f32x4 gg[4];
#pragma unroll
    for (int j = 0; j < 4; ++j) gg[j] = ((const f32x4*)fg)[64 * j + F.lane];
    for (int it = 0;; ++it) { if (ROWOF(it, 0) >= NX) break;
        MoeRef R[RB]; unsigned y[RB][4][4]; f32x4 v[RB][4], gv[RB][4];
#pragma unroll
        for (int r = 0; r < RB; ++r) moe_ref_load(F, ROWOF(it, r), R[r]);
#pragma unroll
        for (int r = 0; r < RB; ++r) { const int row = ROWOF(it, r); moe_rows_load(F, R[r], y[r]); const float* g2p = MOD + ((size_t)(DEPTH - 1) * 33 + (row >> 11)) * 6144 + 5 * D;
#pragma unroll
            for (int j = 0; j < 4; ++j) { v[r][j] = ld_bf4(H + (size_t)row * D + 256 * j + 4 * F.lane); gv[r][j] = ((const f32x4*)g2p)[64 * j + F.lane]; } }
#pragma unroll
        for (int r = 0; r < RB; ++r) { const int row = ROWOF(it, r); float ss = 0.f;
#pragma unroll
            for (int j = 0; j < 4; ++j) { v[r][j] = v[r][j] + gv[r][j] * moe_rows_sum(R[r], y[r], j); ss += (v[r][j].x * v[r][j].x + v[r][j].y * v[r][j].y) + (v[r][j].z * v[r][j].z + v[r][j].w * v[r][j].w); }
            const float rstd = 1.0f / sqrtf(wave_sum(ss) * (1.0f / D) + 1e-5f);
#pragma unroll
            for (int j = 0; j < 4; ++j) ((f32x4*)(A.out + (size_t)row * D))[64 * j + F.lane] = v[r][j] * rstd * gg[j]; }
    }
}

template <int DD> __device__ __forceinline__ float dpp_ror(float v) { return __builtin_bit_cast(float, __builtin_amdgcn_update_dpp(0, __builtin_bit_cast(int, v), 0x120 + DD, 0xf, 0xf, false)); }
template <int DD> __device__ __forceinline__ void rank_step(float v0, float v1, int e0, int& r0, int& r1) {
    const float u0 = dpp_ror<DD>(v0), u1 = dpp_ror<DD>(v1); const bool low = DD <= e0;
    r0 += (u0 > v0 || (u0 == v0 && low)) ? 1 : 0; r0 += (u1 > v0) ? 1 : 0;
    r1 += (u0 >= v1) ? 1 : 0; r1 += (u1 > v1 || (u1 == v1 && low)) ? 1 : 0;
}
__device__ __forceinline__ float row_allmax(float v) { v = fmaxf(v, dpp_ror<8>(v)); v = fmaxf(v, dpp_ror<4>(v)); v = fmaxf(v, dpp_ror<2>(v)); v = fmaxf(v, dpp_ror<1>(v)); return v; }
__device__ __forceinline__ float row_allsum(float v) { v += dpp_ror<8>(v); v += dpp_ror<4>(v); v += dpp_ror<2>(v); v += dpp_ror<1>(v); return v; }
__device__ __forceinline__ void phase_route(Frame& F, const Args& A, int layer) {
    REFRESH(F);
    const int nrows = (layer == DEPTH - 1) ? NX : NT; const int TPB = nrows / 16 / F.G;
    LAS float* wT = (LAS float*)F.lds;
    LAS int* lcnt = (LAS int*)(F.lds + LCNT_OFF); LAS int* lbase = (LAS int*)(F.lds + LBASE_OFF);
    LAS unsigned* recp = (LAS unsigned*)(F.lds + REC_OFF); LAS float* recg = (LAS float*)(F.lds + REC_OFF + 4608);
    __syncthreads();
    { const float* wr = A.in[I_MWR] + (size_t)layer * D * NE;
      for (int idx = F.tid; idx < D * NE; idx += NTHREADS) wT[(idx & 31) * 1024 + (idx >> 5)] = wr[idx]; }
    if (F.tid < NE) lcnt[F.tid] = 0;
    __syncthreads();
    const bf16_t* H = WSP(bf16_t, WS_H); unsigned char* FX = WSP(unsigned char, WS_FX); const float* MOD = WSP(float, WS_MOD);
    const float* g2 = A.in[I_NORMG] + (size_t)(layer * 2 + 1) * D; const float* br = A.in[I_MBR] + layer * NE;
    const int l = F.lane, r16 = l & 15, q4 = l >> 4; const float b0 = br[r16], b1 = br[16 + r16];
    for (int k = F.wave; k < TPB; k += NWAVES) {
        const int row0 = (F.c * TPB + k) * 16, row = row0 + r16; const int brow = row0 < NX ? (row0 >> 11) : 32;
        const float* mp = MOD + ((size_t)layer * 33 + brow) * 6144 + 3 * D;
        const bf16_t* hp = H + (size_t)row * D + 8 * q4; float ss = 0.f;
#pragma unroll 8
        for (int j = 0; j < 32; ++j) { const u32x4 w = *(const u32x4*)(hp + 32 * j); const float a0 = bflo(w.x), a1 = bfhi(w.x), a2 = bflo(w.y), a3 = bfhi(w.y), a4 = bflo(w.z), a5 = bfhi(w.z), a6 = bflo(w.w), a7 = bfhi(w.w);
            ss += ((a0 * a0 + a1 * a1) + (a2 * a2 + a3 * a3)) + ((a4 * a4 + a5 * a5) + (a6 * a6 + a7 * a7)); }
        ss += __shfl_xor(ss, 16); ss += __shfl_xor(ss, 32);
        const float rstd = 1.0f / sqrtf(ss * (1.0f / D) + 1e-5f);
        f32x4 acc0 = (f32x4){0.f, 0.f, 0.f, 0.f}, acc1 = acc0;
        const float* gp = g2 + 8 * q4; const float* shp = mp + 8 * q4; const float* scp = mp + D + 8 * q4; unsigned char* fxp = FX + (size_t)row * D + 8 * q4;
        const LAS float* w0p = wT + r16 * 1024 + 8 * q4; const LAS float* w1p = wT + (16 + r16) * 1024 + 8 * q4;
#pragma unroll 2
        for (int j = 0; j < 32; ++j) { const u32x4 w = *(const u32x4*)(hp + 32 * j);
            const f32x4 ga = *(const f32x4*)(gp + 32 * j), gb = *(const f32x4*)(gp + 32 * j + 4), sa = *(const f32x4*)(shp + 32 * j), sb = *(const f32x4*)(shp + 32 * j + 4), ca = *(const f32x4*)(scp + 32 * j), cb = *(const f32x4*)(scp + 32 * j + 4);
            const f32x4 fa = (f32x4){bflo(w.x), bfhi(w.x), bflo(w.y), bfhi(w.y)} * rstd * ga * (ca + 1.0f) + sa, fb = (f32x4){bflo(w.z), bfhi(w.z), bflo(w.w), bfhi(w.w)} * rstd * gb * (cb + 1.0f) + sb;
            *(u32x2*)(fxp + 32 * j) = (u32x2){pk4_fp8(fa.x, fa.y, fa.z, fa.w), pk4_fp8(fb.x, fb.y, fb.z, fb.w)};
            const f32x4 w0a = *(const LAS f32x4*)(w0p + 32 * j), w0b = *(const LAS f32x4*)(w0p + 32 * j + 4), w1a = *(const LAS f32x4*)(w1p + 32 * j), w1b = *(const LAS f32x4*)(w1p + 32 * j + 4);
#pragma unroll
            for (int s4 = 0; s4 < 4; ++s4) { acc0 = __builtin_amdgcn_mfma_f32_16x16x4f32(fa[s4], w0a[s4], acc0, 0, 0, 0); acc1 = __builtin_amdgcn_mfma_f32_16x16x4f32(fa[s4], w1a[s4], acc1, 0, 0, 0); }
#pragma unroll
            for (int s4 = 0; s4 < 4; ++s4) { acc0 = __builtin_amdgcn_mfma_f32_16x16x4f32(fb[s4], w0b[s4], acc0, 0, 0, 0); acc1 = __builtin_amdgcn_mfma_f32_16x16x4f32(fb[s4], w1b[s4], acc1, 0, 0, 0); } }
#pragma unroll
        for (int reg = 0; reg < 4; ++reg) {
            const float v0 = acc0[reg] + b0, v1 = acc1[reg] + b1; int r0 = (v1 > v0) ? 1 : 0, r1 = (v0 >= v1) ? 1 : 0;
            rank_step<1>(v0, v1, r16, r0, r1); rank_step<2>(v0, v1, r16, r0, r1); rank_step<3>(v0, v1, r16, r0, r1); rank_step<4>(v0, v1, r16, r0, r1); rank_step<5>(v0, v1, r16, r0, r1);
            rank_step<6>(v0, v1, r16, r0, r1); rank_step<7>(v0, v1, r16, r0, r1); rank_step<8>(v0, v1, r16, r0, r1); rank_step<9>(v0, v1, r16, r0, r1); rank_step<10>(v0, v1, r16, r0, r1);
            rank_step<11>(v0, v1, r16, r0, r1); rank_step<12>(v0, v1, r16, r0, r1); rank_step<13>(v0, v1, r16, r0, r1); rank_step<14>(v0, v1, r16, r0, r1); rank_step<15>(v0, v1, r16, r0, r1);
            const float mx = row_allmax(fmaxf(v0, v1));
            const float x0 = r0 < 4 ? __expf(v0 - mx) : 0.f, x1 = r1 < 4 ? __expf(v1 - mx) : 0.f;
            const float inv = 1.0f / row_allsum(x0 + x1);
            const int lr = k * 16 + 4 * q4 + reg;
            if (r0 < 4) { const int rk = __hip_atomic_fetch_add(lcnt + r16, 1, __ATOMIC_RELAXED, __HIP_MEMORY_SCOPE_WORKGROUP); recp[lr * 4 + r0] = ((unsigned)r16 << 20) | (unsigned)rk; recg[lr * 4 + r0] = x0 * inv; }
            if (r1 < 4) { const int rk = __hip_atomic_fetch_add(lcnt + 16 + r16, 1, __ATOMIC_RELAXED, __HIP_MEMORY_SCOPE_WORKGROUP); recp[lr * 4 + r1] = ((unsigned)(16 + r16) << 20) | (unsigned)rk; recg[lr * 4 + r1] = x1 * inv; }
        }
    }
    __syncthreads();
    if (F.tid < NE) lbase[F.tid] = (int)__hip_atomic_fetch_add(F.ctl + CW_GCNT + layer * 64 + F.tid, (unsigned)lcnt[F.tid], __ATOMIC_RELAXED, __HIP_MEMORY_SCOPE_AGENT);
    __syncthreads();
    int* LIST = WSP(int, WS_LIST); int* POS = WSP(int, WS_POS); float* GATE = WSP(float, WS_GATE);
    for (int r = F.tid; r < TPB * 16 * 4; r += NTHREADS) { const int lr = r >> 2, kk = r & 3; const int row = F.c * TPB * 16 + lr;
        const unsigned qx = recp[r]; const float qg = recg[r]; const int e = qx >> 20, slot = lbase[e] + (int)(qx & 0xfffff);
        LIST[(size_t)e * NT + slot] = row; POS[(size_t)row * 4 + kk] = (e << 20) | slot; GATE[(size_t)row * 4 + kk] = qg; }
    __syncthreads();
}

__device__ __forceinline__ void phase_pooldiff(Frame& F) {
    REFRESH(F);
    const bf16_t* AX = WSP(bf16_t, WS_AX); bf16_t* PD = WSP(bf16_t, WS_PD);
    for (int it = 0;; ++it) { if (ROWOF(it, 0) >= NT) break;
        const int row0 = ROWOF(it, 0); int sb, t, n; seq_of(row0, sb, t, n);
#pragma unroll
        for (int j = 0; j < 4; ++j) { const int half = 1 << j; const int col = 256 * j + 4 * F.lane;
            f32x4 s0 = (f32x4){0.f, 0.f, 0.f, 0.f}, s1 = s0, me0 = s0, me1 = s0;
#pragma unroll
            for (int q = 0; q < 2 * half + 1; ++q) { const int uu = t - half + q;
                if (uu >= 0 && uu < n) { const f32x4 x = ld_bf4(AX + (size_t)(sb + uu) * D + col); if (q < 2 * half) s0 += x; if (q > 0) s1 += x; if (q == half) me0 = x; if (q == half + 1) me1 = x; } }
            const int lo0 = t - half < 0 ? 0 : t - half, hi0 = t + half > n ? n : t + half, lo1 = t + 1 - half < 0 ? 0 : t + 1 - half, hi1 = t + 1 + half > n ? n : t + 1 + half;
            st_bf4(PD + (size_t)row0 * D + col, s0 * (1.0f / (float)(hi0 - lo0)) - me0);
            st_bf4(PD + (size_t)(row0 + 1) * D + col, s1 * (1.0f / (float)(hi1 - lo1)) - me1); }
    }
}
__device__ __forceinline__ void phase_rwkv_mix(Frame& F, const Args& A) {
    REFRESH(F);
    const bf16_t* AX = WSP(bf16_t, WS_AX); bf16_t* A6 = WSP(bf16_t, WS_A6); const float* mix = A.in[I_RMIX];
    for (int it = 0;; ++it) { if (ROWOF(it, 0) >= NT) break;
        const int row0 = ROWOF(it, 0); int sb, t, n; seq_of(row0, sb, t, n);
#pragma unroll
        for (int j = 0; j < 4; ++j) { const int col = 256 * j + 4 * F.lane; const f32x4 z = (f32x4){0.f, 0.f, 0.f, 0.f};
            const f32x4 h0 = ld_bf4(AX + (size_t)row0 * D + col), h1 = ld_bf4(AX + (size_t)(row0 + 1) * D + col);
            const f32x4 hp = t > 0 ? ld_bf4(AX + (size_t)(row0 - 1) * D + col) : z, hn = t + 1 < n - 1 ? ld_bf4(AX + (size_t)(row0 + 2) * D + col) : z;
            const f32x4 xx0 = (hp + h1) * 0.5f - h0, xx1 = (h0 + hn) * 0.5f - h1;
#pragma unroll
            for (int i = 0; i < 6; ++i) { const f32x4 m = *(const f32x4*)(mix + i * D + col); const f32x4 o0 = h0 + xx0 * m, o1 = h1 + xx1 * m;
                if (i == 0 || i == 2 || i == 3) { unsigned char* p8 = (unsigned char*)(A6 + (size_t)i * NT * D);
                    *(unsigned*)(p8 + (size_t)row0 * D + col) = pk4_fp8(o0.x, o0.y, o0.z, o0.w); *(unsigned*)(p8 + (size_t)(row0 + 1) * D + col) = pk4_fp8(o1.x, o1.y, o1.z, o1.w); }
                else { st_bf4(A6 + ((size_t)i * NT + row0) * D + col, o0); st_bf4(A6 + ((size_t)i * NT + row0 + 1) * D + col, o1); } } }
    }
}
__device__ __forceinline__ float rl(float x, int k) { return __builtin_bit_cast(float, __builtin_amdgcn_readlane(__builtin_bit_cast(int, x), k)); }
typedef float f32x16 __attribute__((ext_vector_type(16)));
constexpr int SCW = 33792;
__device__ __forceinline__ int kpos(int k) { return (k & ~12) | ((k & 4) << 1) | ((k & 8) >> 1); }
__device__ __forceinline__ bf16x8 acc_frag(const f32x16& X, int s2) {
    u32x4 w; w.x = cvt_pk_bf16(X[8 * s2 + 0], X[8 * s2 + 1]); w.y = cvt_pk_bf16(X[8 * s2 + 2], X[8 * s2 + 3]); w.z = cvt_pk_bf16(X[8 * s2 + 4], X[8 * s2 + 5]); w.w = cvt_pk_bf16(X[8 * s2 + 6], X[8 * s2 + 7]);
    return __builtin_bit_cast(bf16x8, w);
}
#define MFMA32(a, b, c) __builtin_amdgcn_mfma_f32_32x32x16_bf16(a, b, c, 0, 0, 0)
__device__ __forceinline__ void phase_rwkv_scan(Frame& F, const Args& A) {
    REFRESH(F);
    __syncthreads();
    const int pr = F.wave >> 1, hw = F.wave & 1;
    for (int item = pr * F.G + F.c; item < 1024; item += 4 * F.G) {
        const int dir = item >> 9, b = (item >> 4) & 31, hd = item & 15, col = 64 * hd + F.lane;
        const int l = F.lane, r32 = l & 31, hh = l >> 5;
        const bf16_t* Rr = WSP(bf16_t, WS_RKV); const bf16_t* Kk = Rr + (size_t)NT * D; const bf16_t* Vv = Kk + (size_t)NT * D;
        const bf16_t* Ee = WSP(bf16_t, WS_E) + (size_t)dir * NT * D; const bf16_t* Aa = WSP(bf16_t, WS_A) + (size_t)dir * NT * D;
        bf16_t* Yo = WSP(bf16_t, WS_YS) + (size_t)dir * NT * D; float* Bo = WSP(float, WS_BONUS) + (size_t)dir * NT * 16;
        const float kkw = A.in[I_RKK][col], kaw = A.in[I_RKA][col], rkw = A.in[I_RRK][col];
        LAS unsigned char* RA = F.lds + pr * SCW; LAS unsigned char* RB = RA + 16384; LAS unsigned char* RV = RA + 25600;
        LAS float* cCb = (LAS float*)(F.lds + REC_OFF + pr * 256);
        LAS bf16_t* XT = (LAS bf16_t*)RA;
        LAS bf16_t* BK = (LAS bf16_t*)(RA + 8192);
        const int kp = kpos(l), vb = hw;
        f32x16 ST[2];
#pragma unroll
        for (int i = 0; i < 2; ++i)
#pragma unroll
            for (int q = 0; q < 16; ++q) ST[i][q] = 0.f;
        for (int seg = 0; seg < 2; ++seg) {
            const int base = seg ? b * T : NX + b * L, n = seg ? T : L; const int dt = dir ? -1 : 1; const int t0 = dir ? n - 1 : 0;
            for (int bt = 0; bt < n; bt += 32) {
                float cprev = 1.0f;
                if (hw) {
                    bf16_t e16[16];
#pragma unroll
                    for (int s = 0; s < 16; ++s) e16[s] = Ee[(size_t)(base + t0 + dt * (bt + s)) * D + col];
                    float es = 0.f;
#pragma unroll
                    for (int s = 0; s < 16; ++s) es += bf1(e16[s]);
                    cprev = __expf(-es); }
#pragma unroll
                for (int g4i = 0; g4i < 4; ++g4i) { const int g8 = 4 * hw + g4i;
                    bf16_t raw[4][5];
#pragma unroll
                    for (int s8 = 0; s8 < 4; ++s8) { const size_t o = (size_t)(base + t0 + dt * (bt + g8 * 4 + s8)) * D + col; raw[s8][0] = Rr[o]; raw[s8][1] = Kk[o]; raw[s8][2] = Vv[o]; raw[s8][3] = Aa[o]; raw[s8][4] = Ee[o]; }
                    float rr[4], kraw[4], aa[4], kk[4], kd[4], n2[4], bn[4], ww[4]; unsigned bq2[2] = {0u, 0u}, kq2[2] = {0u, 0u};
#pragma unroll
                    for (int s8 = 0; s8 < 4; ++s8) { rr[s8] = bf1(raw[s8][0]); kraw[s8] = bf1(raw[s8][1]); aa[s8] = bf1(raw[s8][3]); ww[s8] = __expf(-bf1(raw[s8][4]));
                        kk[s8] = kraw[s8] * kkw; n2[s8] = kk[s8] * kk[s8]; kd[s8] = kraw[s8] * (1.0f + (aa[s8] - 1.0f) * kaw); bn[s8] = rr[s8] * kd[s8] * rkw; }
#pragma unroll
                    for (int s8 = 0; s8 < 4; ++s8) { n2[s8] = wave_sum(n2[s8]); bn[s8] = wave_sum(bn[s8]); }
#pragma unroll
                    for (int s8 = 0; s8 < 4; ++s8) { const int t = g8 * 4 + s8;
                        if (l == 0) Bo[(size_t)(base + t0 + dt * (bt + t)) * 16 + hd] = bn[s8];
                        const float kn = kk[s8] * __builtin_amdgcn_rsqf(fmaxf(n2[s8], 1e-24f)); const float c = cprev * ww[s8]; const float ic = __builtin_amdgcn_rcpf(c);
                        const float at = -kn * cprev, rt = rr[s8] * c, bq = kn * aa[s8] * ic, kq = kd[s8] * ic;
                        const unsigned w0 = cvt_pk_bf16(at, rt), w1 = cvt_pk_bf16(bq, kq);
                        XT[t * 64 + kp] = (bf16_t)(w0 & 0xffffu); XT[(32 + t) * 64 + kp] = (bf16_t)(w0 >> 16);
                        BK[t * 64 + kp] = (bf16_t)(w1 & 0xffffu); BK[(32 + t) * 64 + kp] = (bf16_t)(w1 >> 16);
                        if (s8 & 1) { bq2[s8 >> 1] |= (w1 & 0xffffu) << 16; kq2[s8 >> 1] |= (w1 & 0xffff0000u); } else { bq2[s8 >> 1] = w1 & 0xffffu; kq2[s8 >> 1] = w1 >> 16; }
                        cprev = c; }
                    const int gp = (g8 & ~3) | ((g8 & 1) << 1) | ((g8 & 2) >> 1);
                    *(LAS u32x2*)(RB + l * 144 + gp * 8) = (u32x2){bq2[0], bq2[1]}; *(LAS u32x2*)(RB + l * 144 + 64 + gp * 8) = (u32x2){kq2[0], kq2[1]};
                    *(LAS u32x2*)(RV + l * 80 + gp * 8) = (u32x2){(unsigned)raw[0][2] | ((unsigned)raw[1][2] << 16), (unsigned)raw[2][2] | ((unsigned)raw[3][2] << 16)};
                }
                if (hw) cCb[l] = cprev;
                __syncthreads();
                f32x16 Mp, Np, X;
                { bf16x8 XTf[4], BKf[2][4];
#pragma unroll
                  for (int s4 = 0; s4 < 4; ++s4) { XTf[s4] = *(const LAS bf16x8*)(XT + r32 * 64 + 16 * s4 + 8 * hh); BKf[0][s4] = *(const LAS bf16x8*)(BK + r32 * 64 + 16 * s4 + 8 * hh); BKf[1][s4] = *(const LAS bf16x8*)(BK + (32 + r32) * 64 + 16 * s4 + 8 * hh); }
                  bf16x8 MkaF[2];
                  { f32x16 Tm;
#pragma unroll
                    for (int q = 0; q < 16; ++q) Tm[q] = 0.f;
#pragma unroll
                    for (int s4 = 0; s4 < 4; ++s4) Tm = MFMA32(BKf[1][s4], XTf[s4], Tm);
#pragma unroll
                    for (int q = 0; q < 16; ++q) { const int row = (q & 3) + 8 * (q >> 2) + 4 * hh; Tm[q] = row < r32 ? Tm[q] : 0.f; }
                    MkaF[0] = acc_frag(Tm, 0); MkaF[1] = acc_frag(Tm, 1); }
#pragma unroll
                  for (int q = 0; q < 16; ++q) { Mp[q] = 0.f; Np[q] = 0.f; X[q] = 0.f; }
#pragma unroll
                  for (int s4 = 0; s4 < 4; ++s4) { Mp = MFMA32(BKf[0][s4], XTf[s4], Mp); Np = MFMA32(XTf[s4], BKf[0][s4], Np); }
#pragma unroll
                  for (int q = 0; q < 16; ++q) { const int row = (q & 3) + 8 * (q >> 2) + 4 * hh; Mp[q] = row < r32 ? Mp[q] : 0.f; Np[q] = r32 < row ? Np[q] : 0.f; }
#pragma unroll
                  for (int kb = 0; kb < 2; ++kb)
#pragma unroll
                      for (int s2 = 0; s2 < 2; ++s2) X = MFMA32(XTf[2 * kb + s2], acc_frag(ST[kb], s2), X);
#pragma unroll
                  for (int s2 = 0; s2 < 2; ++s2) { const bf16x8 Vf = *(const LAS bf16x8*)(RV + (32 * vb + r32) * 80 + (16 * s2 + 8 * hh) * 2); X = MFMA32(MkaF[s2], Vf, X); } }
                __builtin_amdgcn_sched_barrier(0);
#pragma unroll
                for (int lvl = 0; lvl < 5; ++lvl) {
                    bf16x8 Ma[2], Na[2];
#pragma unroll
                    for (int s2 = 0; s2 < 2; ++s2) { Ma[s2] = acc_frag(Mp, s2); Na[s2] = acc_frag(Np, s2); }
                    { const bf16x8 x0 = acc_frag(X, 0), x1 = acc_frag(X, 1); X = MFMA32(Ma[0], x0, X); X = MFMA32(Ma[1], x1, X); }
                    if (lvl < 4) { f32x16 M2, N2;
#pragma unroll
                        for (int q = 0; q < 16; ++q) { M2[q] = 0.f; N2[q] = 0.f; }
                        M2 = MFMA32(Na[0], Ma[0], M2); M2 = MFMA32(Na[1], Ma[1], M2);
                        N2 = MFMA32(Ma[0], Na[0], N2); N2 = MFMA32(Ma[1], Na[1], N2);
                        Mp = M2; Np = N2; }
                }
                __builtin_amdgcn_sched_barrier(0);
                { bf16x8 XRf[4], MbrF[2], MkrF[2];
#pragma unroll
                  for (int s4 = 0; s4 < 4; ++s4) XRf[s4] = *(const LAS bf16x8*)(XT + (32 + r32) * 64 + 16 * s4 + 8 * hh);
                  { f32x16 Tm, Tn;
#pragma unroll
                    for (int q = 0; q < 16; ++q) { Tm[q] = 0.f; Tn[q] = 0.f; }
#pragma unroll
                    for (int s4 = 0; s4 < 4; ++s4) { const bf16x8 Bb = *(const LAS bf16x8*)(BK + r32 * 64 + 16 * s4 + 8 * hh), Bk = *(const LAS bf16x8*)(BK + (32 + r32) * 64 + 16 * s4 + 8 * hh);
                        Tm = MFMA32(Bb, XRf[s4], Tm); Tn = MFMA32(Bk, XRf[s4], Tn); }
#pragma unroll
                    for (int q = 0; q < 16; ++q) { const int row = (q & 3) + 8 * (q >> 2) + 4 * hh; Tm[q] = row <= r32 ? Tm[q] : 0.f; Tn[q] = row <= r32 ? Tn[q] : 0.f; }
                    MbrF[0] = acc_frag(Tm, 0); MbrF[1] = acc_frag(Tm, 1); MkrF[0] = acc_frag(Tn, 0); MkrF[1] = acc_frag(Tn, 1); }
                  { const bf16x8 u0 = acc_frag(X, 0), u1 = acc_frag(X, 1);
                    const bf16x8 Vf0 = *(const LAS bf16x8*)(RV + (32 * vb + r32) * 80 + (8 * hh) * 2), Vf1 = *(const LAS bf16x8*)(RV + (32 * vb + r32) * 80 + (16 + 8 * hh) * 2);
                    f32x16 Yt;
#pragma unroll
                    for (int q = 0; q < 16; ++q) Yt[q] = 0.f;
#pragma unroll
                    for (int kb = 0; kb < 2; ++kb)
#pragma unroll
                        for (int s2 = 0; s2 < 2; ++s2) Yt = MFMA32(XRf[2 * kb + s2], acc_frag(ST[kb], s2), Yt);
                    Yt = MFMA32(MkrF[0], Vf0, Yt); Yt = MFMA32(MkrF[1], Vf1, Yt);
                    Yt = MFMA32(MbrF[0], u0, Yt); Yt = MFMA32(MbrF[1], u1, Yt);
#pragma unroll
                    for (int q = 0; q < 16; ++q) { const int t = (q & 3) + 8 * (q >> 2) + 4 * hh; Yo[(size_t)(base + t0 + dt * (bt + t)) * D + 64 * hd + 32 * vb + r32] = (bf16_t)f2bf(Yt[q]); }
#pragma unroll
                    for (int kb = 0; kb < 2; ++kb) {
                        const bf16x8 b0 = *(const LAS bf16x8*)(RB + (32 * kb + r32) * 144 + (8 * hh) * 2), b1 = *(const LAS bf16x8*)(RB + (32 * kb + r32) * 144 + (16 + 8 * hh) * 2);
                        const bf16x8 k0 = *(const LAS bf16x8*)(RB + (32 * kb + r32) * 144 + 64 + (8 * hh) * 2), k1 = *(const LAS bf16x8*)(RB + (32 * kb + r32) * 144 + 64 + (16 + 8 * hh) * 2);
                        ST[kb] = MFMA32(b0, u0, ST[kb]); ST[kb] = MFMA32(b1, u1, ST[kb]);
                        ST[kb] = MFMA32(k0, Vf0, ST[kb]); ST[kb] = MFMA32(k1, Vf1, ST[kb]); }
                  } }
                __builtin_amdgcn_sched_barrier(0);
#pragma unroll
                for (int kb = 0; kb < 2; ++kb)
#pragma unroll
                    for (int g4 = 0; g4 < 4; ++g4) { const f32x4 cc = *(const LAS f32x4*)(cCb + 32 * kb + 8 * g4 + 4 * hh);
                        ST[kb][4 * g4 + 0] *= cc.x; ST[kb][4 * g4 + 1] *= cc.y; ST[kb][4 * g4 + 2] *= cc.z; ST[kb][4 * g4 + 3] *= cc.w; }
                __syncthreads();
            }
        }
    }
    __syncthreads();
}
#undef MFMA32
__device__ __forceinline__ void phase_rwkv_out(Frame& F, const Args& A, int nrows) {
    REFRESH(F);
    const bf16_t* Y0 = WSP(bf16_t, WS_YS); const bf16_t* Y1 = Y0 + (size_t)NT * D; const float* B0 = WSP(float, WS_BONUS); const float* B1 = B0 + (size_t)NT * 16;
    const bf16_t* Vv = WSP(bf16_t, WS_RKV) + (size_t)2 * NT * D; const bf16_t* Gg = WSP(bf16_t, WS_G); bf16_t* RO = WSP(bf16_t, WS_RO);
    const float* lnw = A.in[I_RLNW]; const float* lnb = A.in[I_RLNB];
    for (int it = 0;; ++it) { if (ROWOF(it, 0) >= nrows) break;
        f32x4 y[RB][4], vv[RB][4], gg[RB][4]; float bon[RB][4];
#pragma unroll
        for (int r = 0; r < RB; ++r) { const int row = ROWOF(it, r);
#pragma unroll
            for (int j = 0; j < 4; ++j) { const int col = 256 * j + 4 * F.lane, head = 4 * j + (F.lane >> 4); const size_t o = (size_t)row * D + col;
                y[r][j] = ld_bf4(Y0 + o) + ld_bf4(Y1 + o); vv[r][j] = ld_bf4(Vv + o); gg[r][j] = ld_bf4(Gg + o); bon[r][j] = B0[(size_t)row * 16 + head] + B1[(size_t)row * 16 + head]; } }
#pragma unroll
        for (int r = 0; r < RB; ++r) { const int row = ROWOF(it, r);
#pragma unroll
            for (int j = 0; j < 4; ++j) { const int col = 256 * j + 4 * F.lane; const size_t o = (size_t)row * D + col; const f32x4 yy = y[r][j];
                const float s = row16_sum((yy.x + yy.y) + (yy.z + yy.w));
                const f32x4 d = yy - s * (1.0f / 64.0f);
                const float q = row16_sum((d.x * d.x + d.y * d.y) + (d.z * d.z + d.w * d.w));
                const float rs = 1.0f / sqrtf(q * (1.0f / 64.0f) + 64e-5f);
                const f32x4 yn = d * rs * *(const f32x4*)(lnw + col) + *(const f32x4*)(lnb + col);
                { const f32x4 ov = (yn + vv[r][j] * bon[r][j]) * gg[r][j]; *(unsigned*)((unsigned char*)RO + o) = pk4_fp8(ov.x, ov.y, ov.z, ov.w); } } }
    }
}

__device__ __forceinline__ void phase_attn(Frame& F, const Args& A, int j, bool need_ctx) {
    REFRESH(F);
    const bf16_t* Q = WSP(bf16_t, WS_Q); const bf16_t* Kb = WSP(bf16_t, WS_K); const bf16_t* VT = WSP(bf16_t, WS_VT); bf16_t* O = WSP(bf16_t, WS_O);
    const float* sinks = A.in[I_ASINK] + j * 16;
    LAS bf16_t* Ks = (LAS bf16_t*)F.lds; LAS bf16_t* Vs = (LAS bf16_t*)(F.lds + 9216);
    LAS bf16x8* Qs = (LAS bf16x8*)(F.lds + 18432 + F.wave * 8192) + F.lane;
    const int nunits = 2048 + (need_ctx ? 256 : 0);
    const int fr = F.lane & 15, fq = F.lane >> 4, g = F.wave >> 1, hf = F.wave & 1;
    const float SC = 0.125f * 1.4426950408889634f;
    const int lr = F.tid >> 3, lch = F.tid & 7;
    __syncthreads();
    for (int u = F.c; u < nunits; u += F.G) {
        int b, kvh, qb; bool isx;
        if (u < 2048) { isx = true; b = u >> 6; kvh = (u >> 4) & 3; qb = u & 15; } else { const int v = u - 2048; isx = false; b = v >> 3; kvh = (v >> 1) & 3; qb = v & 1; }
        const int qrow0 = (isx ? b * T : NX + b * L) + qb * 128 + hf * 64; const int head = 4 * kvh + g;
        int jlo = 0, jhi = -1;
        if (isx) { jlo = qb == 0 ? 2 : 0; jhi = qb == 15 ? 3 : 5; }
        const int ntiles = 4 + (jhi - jlo + 1);
        auto tile_row0 = [&](int ti) -> int { return ti < 4 ? NX + b * L + ti * 64 : b * T + qb * 128 - 128 + 64 * (jlo + ti - 4); };
        u32x4 kv_n, vv_n;
        { const int kr0 = tile_row0(0); kv_n = *(const u32x4*)(Kb + (size_t)(kr0 + lr) * 256 + kvh * 64 + lch * 8); vv_n = *(const u32x4*)(VT + (size_t)(kvh * 64 + lr) * NT + kr0 + lch * 8); }
#pragma unroll
        for (int mq = 0; mq < 4; ++mq)
#pragma unroll
            for (int ks = 0; ks < 2; ++ks) Qs[64 * (mq * 2 + ks)] = *(const bf16x8*)(Q + (size_t)(qrow0 + 16 * mq + fr) * D + head * 64 + ks * 32 + 8 * fq);
        const float sink2 = sinks[head] * 1.4426950408889634f;
        float mrun[4], lrun[4]; f32x4 Oa[4][4];
#pragma unroll
        for (int mq = 0; mq < 4; ++mq) { mrun[mq] = sink2; lrun[mq] = fq == 0 ? 1.0f : 0.0f;
#pragma unroll
            for (int db = 0; db < 4; ++db) Oa[mq][db] = (f32x4){0.f, 0.f, 0.f, 0.f}; }
        for (int ti = 0; ti < ntiles; ++ti) {
            const int jl = ti < 4 ? -1 : jlo + ti - 4; const int ks0 = qb * 128 - 128 + 64 * jl;
            __syncthreads();
            *(LAS u32x4*)(Ks + lr * 72 + lch * 8) = kv_n; *(LAS u32x4*)(Vs + lr * 72 + lch * 8) = vv_n;
            __syncthreads();
            if (ti + 1 < ntiles) { const int kr0 = tile_row0(ti + 1); kv_n = *(const u32x4*)(Kb + (size_t)(kr0 + lr) * 256 + kvh * 64 + lch * 8); vv_n = *(const u32x4*)(VT + (size_t)(kvh * 64 + lr) * NT + kr0 + lch * 8); }
            const bool need = (jl < 0) || (jl >= hf && jl <= hf + 4);
            if (need) {
                const bool domask = (jl >= 0) && (jl == hf || jl == hf + 4);
                f32x4 Sa[4][4];
#pragma unroll
                for (int mq = 0; mq < 4; ++mq)
#pragma unroll
                    for (int n = 0; n < 4; ++n) Sa[mq][n] = (f32x4){0.f, 0.f, 0.f, 0.f};
#pragma unroll
                for (int ks = 0; ks < 2; ++ks) {
                    bf16x8 Qf[4];
#pragma unroll
                    for (int mq = 0; mq < 4; ++mq) Qf[mq] = Qs[64 * (mq * 2 + ks)];
#pragma unroll
                    for (int n = 0; n < 4; ++n) { const int kr = 32 * (n >> 1) + 8 * (fr >> 2) + 4 * (n & 1) + (fr & 3);
                        const bf16x8 Kf = *(const LAS bf16x8*)(Ks + kr * 72 + ks * 32 + 8 * fq);
#pragma unroll
                        for (int mq = 0; mq < 4; ++mq) Sa[mq][n] = __builtin_amdgcn_mfma_f32_16x16x32_bf16(Kf, Qf[mq], Sa[mq][n], 0, 0, 0); } }
                bf16x8 Pf[4][2];
#pragma unroll
                for (int mq = 0; mq < 4; ++mq) {
                    float mx = -1e30f;
                    if (domask) { const int tq = qb * 128 + hf * 64 + 16 * mq + fr;
#pragma unroll
                        for (int n = 0; n < 4; ++n)
#pragma unroll
                            for (int i = 0; i < 4; ++i) { float sv = Sa[mq][n][i] * SC; const int rel = ks0 + 32 * (n >> 1) + 8 * fq + 4 * (n & 1) + i - tq; if (rel > 128 || rel < -128) sv = -1e30f; Sa[mq][n][i] = sv; mx = fmaxf(mx, sv); } }
                    else {
#pragma unroll
                        for (int n = 0; n < 4; ++n)
#pragma unroll
                            for (int i = 0; i < 4; ++i) { const float sv = Sa[mq][n][i] * SC; Sa[mq][n][i] = sv; mx = fmaxf(mx, sv); } }
                    mx = fmaxf(mx, __shfl_xor(mx, 16)); mx = fmaxf(mx, __shfl_xor(mx, 32));
                    const float mnew = fmaxf(mrun[mq], mx); const float alpha = __builtin_amdgcn_exp2f(mrun[mq] - mnew); mrun[mq] = mnew;
                    float rs = 0.f;
#pragma unroll
                    for (int n = 0; n < 4; ++n)
#pragma unroll
                        for (int i = 0; i < 4; ++i) { const float p = __builtin_amdgcn_exp2f(Sa[mq][n][i] - mnew); Sa[mq][n][i] = p; rs += p; }
                    lrun[mq] = lrun[mq] * alpha + rs;
#pragma unroll
                    for (int db = 0; db < 4; ++db) Oa[mq][db] *= alpha;
#pragma unroll
                    for (int s2 = 0; s2 < 2; ++s2) { u32x4 w; w.x = cvt_pk_bf16(Sa[mq][2 * s2][0], Sa[mq][2 * s2][1]); w.y = cvt_pk_bf16(Sa[mq][2 * s2][2], Sa[mq][2 * s2][3]);
                        w.z = cvt_pk_bf16(Sa[mq][2 * s2 + 1][0], Sa[mq][2 * s2 + 1][1]); w.w = cvt_pk_bf16(Sa[mq][2 * s2 + 1][2], Sa[mq][2 * s2 + 1][3]); Pf[mq][s2] = __builtin_bit_cast(bf16x8, w); }
                }
#pragma unroll
                for (int db = 0; db < 4; ++db)
#pragma unroll
                    for (int s2 = 0; s2 < 2; ++s2) { const bf16x8 Vf = *(const LAS bf16x8*)(Vs + (16 * db + fr) * 72 + 32 * s2 + 8 * fq);
#pragma unroll
                        for (int mq = 0; mq < 4; ++mq) Oa[mq][db] = __builtin_amdgcn_mfma_f32_16x16x32_bf16(Vf, Pf[mq][s2], Oa[mq][db], 0, 0, 0); }
            }
        }
#pragma unroll
        for (int mq = 0; mq < 4; ++mq) { float l = lrun[mq]; l += __shfl_xor(l, 16); l += __shfl_xor(l, 32); const float inv = 1.0f / l;
            unsigned char* op = (unsigned char*)O + (size_t)(qrow0 + 16 * mq + fr) * D + head * 64 + 4 * fq;
#pragma unroll
            for (int db = 0; db < 4; ++db) { const f32x4 o = Oa[mq][db] * inv; *(unsigned*)(op + 16 * db) = pk4_fp8(o.x, o.y, o.z, o.w); } }
    }
    __syncthreads();
}

struct KState { XcdBarrier bar; int ph; };
#define RUN() (A.one || A.phase == KS.ph)
#define SEAM() do { if (A.one) xcd_barrier(KS.bar); ++KS.ph; } while (0)
template <int LAYER>
__device__ __forceinline__ void layer_body(Frame& F, const Args& A, KState& KS) {
    constexpr int layer = LAYER, kind = LAYER % 3, j = LAYER / 3; constexpr bool last = (LAYER == DEPTH - 1);
    LAS unsigned char* ring = F.lds;
    const LAS int* tpre = (const LAS int*)(F.lds + TPRE_OFF); const LAS int* lcnt = (const LAS int*)(F.lds + LCNT_OFF);
    bf16_t* H = WSP(bf16_t, WS_H); const float* MOD = WSP(float, WS_MOD); const bf16_t* AX = WSP(bf16_t, WS_AX);
    const float* gate1 = MOD + (size_t)layer * 33 * 6144 + 2 * D;
    constexpr int nMall = last ? NX / 256 : NT / 256;
    if (RUN()) phase_norm1(F, A, layer);
    SEAM();
    if constexpr (kind == 0) {
        if (RUN()) {
            { pg8::ProbDense8 P; P.A = (const unsigned char*)AX; P.Bt = WSP(unsigned char, WS_WQK) + (size_t)j * 1280 * D; P.lda = D; P.ldb = D; P.K = D; P.scale_w = SCALE_W; P.scale_x = SCALE_ONE; P.ord.init(NT / 256, 5, F.G, F.c);
              EpiQK E{WSP(bf16_t, WS_Q), WSP(bf16_t, WS_K), WSP(float, WS_BQK) + j * 1280, WSP(float, WS_ROPEC), WSP(float, WS_ROPES)};
              pg8::gemm_phase(ring, P, E); }
            { pg8::ProbDense8 P; P.A = WSP(unsigned char, WS_WV) + (size_t)j * 256 * D; P.Bt = (const unsigned char*)AX; P.lda = D; P.ldb = D; P.K = D; P.scale_w = SCALE_ONE; P.scale_x = SCALE_W; P.ord.init(1, NT / 256, F.G, F.c);
              EpiVT E{WSP(bf16_t, WS_VT), A.in[I_ABQKV] + j * 1536 + 1280};
              pg8::gemm_phase(ring, P, E); }
        }
        SEAM();
        if (RUN()) phase_attn(F, A, j, !last);
        SEAM();
        if (RUN()) { pg8::ProbDense8 P; P.A = WSP(unsigned char, WS_O); P.Bt = WSP(unsigned char, WS_WO) + (size_t)j * D * D; P.lda = D; P.ldb = D; P.K = D; P.scale_w = SCALE_W; P.scale_x = SCALE_ONE; P.ord.init(nMall, 4, F.G, F.c);
            EpiResid E{H, A.in[I_ABO] + j * D, nullptr, gate1};
            pg8::gemm_phase(ring, P, E); }
        SEAM();
    } else if constexpr (kind == 1) {
        if (RUN()) phase_pooldiff(F);
        SEAM();
        if (RUN()) { pg8::ProbDense P; P.A = WSP(bf16_t, WS_PD); P.Bt = WSP(bf16_t, WS_POOLW); P.lda = D; P.ldb = 256; P.K = 256; P.a_pn_off = 256; P.ord.init(nMall, 4, F.G, F.c);
            EpiResid E{H, A.in[I_PB], A.in[I_PS], gate1};
            pg8::gemm_phase(ring, P, E); }
        SEAM();
    } else {
        if (RUN()) phase_rwkv_mix(F, A);
        SEAM();
        if (RUN()) {
            for (int i = 0; i < 3; ++i) { const int sel = i == 0 ? 0 : i == 1 ? 2 : 3;
                pg8::ProbDense8 P; P.A = (const unsigned char*)(WSP(bf16_t, WS_A6) + (size_t)sel * NT * D); P.Bt = WSP(unsigned char, WS_WRKV) + (size_t)i * D * D; P.lda = D; P.ldb = D; P.K = D; P.scale_w = SCALE_W; P.scale_x = SCALE_ONE; P.ord.init(NT / 256, 4, F.G, F.c);
                EpiBf16Act E{WSP(bf16_t, WS_RKV) + (size_t)i * NT * D, D, nullptr, 0, 1.0f};
                pg8::gemm_phase(ring, P, E); }
            for (int i = 0; i < 3; ++i) { const int sel = i == 0 ? 5 : i == 1 ? 1 : 4;
                pg8::ProbDense P; P.A = WSP(bf16_t, WS_A6) + (size_t)sel * NT * D; P.Bt = WSP(bf16_t, WS_WL1) + (size_t)i * 256 * D; P.lda = D; P.ldb = D; P.K = D; P.a_pn_off = 0; P.ord.init(NT / 256, 1, F.G, F.c);
                EpiBf16Act E{WSP(bf16_t, WS_LORA) + i * 256, 768, nullptr, i == 0 ? 1 : i == 1 ? 2 : 0, 1.0f};
                pg8::gemm_phase(ring, P, E); }
        }
        SEAM();
        if (RUN()) {
            for (int i = 0; i < 5; ++i) {
                const int ablk = i == 0 ? 0 : i < 3 ? 1 : 2, d = (i - 1) & 1;
                pg8::ProbDense P; P.A = WSP(bf16_t, WS_LORA) + ablk * 256; P.Bt = WSP(bf16_t, WS_WL2) + (size_t)i * D * 256; P.lda = 768; P.ldb = 256; { int k128 = 128; asm volatile("" : "+s"(k128)); P.K = k128; }     P.a_pn_off = 0; P.ord.init(NT / 256, 4, F.G, F.c);
                EpiBf16Act E; E.ldc = D;
                if (i == 0) { E.O = WSP(bf16_t, WS_G); E.bias = nullptr; E.act = 0; E.scale = 1.0f; }
                else if (i < 3) { E.O = WSP(bf16_t, WS_E) + (size_t)d * NT * D; E.bias = A.in[I_RW0] + d * D; E.act = 1; E.scale = 0.6065306597126334f; }
                else { E.O = WSP(bf16_t, WS_A) + (size_t)d * NT * D; E.bias = A.in[I_RA0] + d * D; E.act = 1; E.scale = 1.0f; }
                pg8::gemm_phase(ring, P, E); }
        }
        SEAM();
        if (RUN()) phase_rwkv_scan(F, A);
        SEAM();
        if (RUN()) phase_rwkv_out(F, A, last ? NX : NT);
        SEAM();
        if (RUN()) { pg8::ProbDense8 P; P.A = WSP(unsigned char, WS_RO); P.Bt = WSP(unsigned char, WS_WOR); P.lda = D; P.ldb = D; P.K = D; P.scale_w = SCALE_W; P.scale_x = SCALE_ONE; P.ord.init(nMall, 4, F.G, F.c);
            EpiResid E{H, nullptr, nullptr, gate1};
            pg8::gemm_phase(ring, P, E); }
        SEAM();
    }
    if (RUN()) phase_route(F, A, layer);
    SEAM();
    if (RUN()) { moe_tiles(F, layer);
        ProbMoe1 P; P.FX = WSP(fp8_t, WS_FX); P.W1T = WSP(fp8_t, WS_W1T) + (size_t)layer * NE * 2048 * D; P.list = WSP(int, WS_LIST); P.tpre = tpre; P.cnt = lcnt; P.texp = (const LAS unsigned char*)(F.lds + TEXP_OFF); P.toks = (LAS int*)(F.lds + TOKS_OFF); P.scale_w = SCALE_W; P.scale_x = SCALE_ONE; P.ord.init(tpre[NE], 8, F.G, F.c);
        EpiMoe1 E{WSP(unsigned char, WS_ACT), A.in[I_MB1] + (size_t)layer * NE * 2048};
        pg8::gemm_phase(ring, P, E); }
    SEAM();
    if (RUN()) { moe_tiles(F, layer);
        ProbMoe2 P; P.ACT = WSP(fp8_t, WS_ACT); P.W2T = WSP(fp8_t, WS_W2T) + (size_t)layer * NE * D * D; P.tpre = tpre; P.texp = (const LAS unsigned char*)(F.lds + TEXP_OFF); P.scale_w = SCALE_W; P.scale_x = SCALE_ONE; P.ord.init(tpre[NE], 4, F.G, F.c);
        EpiMoe2 E{WSP(unsigned char, WS_Y), A.in[I_MB2] + (size_t)layer * NE * D};
        pg8::gemm_phase(ring, P, E); }
    SEAM();
}
__global__ void __launch_bounds__(NTHREADS, 2) trunk_fwd(Args A) {
    extern __shared__ __attribute__((aligned(16))) unsigned char lds_[];
    Frame F; F.lds = (LAS unsigned char*)lds_; REFRESH(F); F.wave = __builtin_amdgcn_readfirstlane(F.tid >> 6);
    F.G = gridDim.x; F.c = blockIdx.x; F.ws = A.ws; F.ctl = (unsigned*)(A.ws + WS_CTL);
    for (int u = F.tid; u < (LDS_BYTES - LDSCTL_OFF) / 4; u += NTHREADS) ((LAS unsigned*)(F.lds + LDSCTL_OFF))[u] = 0u;
    __syncthreads();
    KState KS; KS.bar.bar = F.ctl + CW_BAR; KS.bar.x = 0; KS.bar.st = nullptr; KS.ph = 0;
    if (A.one) KS.bar = xcd_barrier_post(F.ctl + CW_BAR, (volatile LAS unsigned*)(F.lds + MISC_OFF) + 8);
    if (RUN()) phase_prologue(F, A);
    SEAM();
    layer_body<0>(F, A, KS);
    layer_body<1>(F, A, KS);
    layer_body<2>(F, A, KS);
    layer_body<3>(F, A, KS);
    if (RUN()) phase_final(F, A);
}
#undef RUN
#undef SEAM
static int count_phases() { int n = 1; for (int layer = 0; layer < DEPTH; ++layer) { const int kind = layer % 3; n += 1 + (kind == 0 ? 3 : kind == 1 ? 2 : 6) + 3; } return n + 1; }

extern "C" void kernel_launch(void* const* d_in, const int* in_sizes, int n_in, void* d_out, int out_size, void* d_ws, size_t ws_size, hipStream_t stream) {
    static int grid = 0;
    if (grid == 0) {
        if (n_in != 38 || out_size != NX * D || ws_size < WS_END) { fprintf(stderr, "kernel_launch: unexpected problem (n_in %d, out %d, ws %zu < %zu)\n", n_in, out_size, ws_size, (size_t)WS_END); grid = -1; return; }
        int dev = 0, cus = 0;
        if (hipGetDevice(&dev) != hipSuccess || hipDeviceGetAttribute(&cus, hipDeviceAttributeMultiprocessorCount, dev) != hipSuccess) { grid = -1; return; }
        if (hipFuncSetAttribute((const void*)trunk_fwd, hipFuncAttributeMaxDynamicSharedMemorySize, LDS_BYTES) != hipSuccess) { fprintf(stderr, "kernel_launch: hipFuncSetAttribute failed\n"); grid = -1; return; }
        int per_cu = 0;
        if (hipOccupancyMaxActiveBlocksPerMultiprocessor(&per_cu, (const void*)trunk_fwd, NTHREADS, LDS_BYTES) != hipSuccess || per_cu < 1) fprintf(stderr, "kernel_launch: occupancy query says %d\n", per_cu);
        (void)hipGetLastError();
        grid = cus;
        if (grid != 256) fprintf(stderr, "kernel_launch: %d CUs (built for 256)\n", grid);
    }
    if (grid < 0) return;
    (void)hipMemsetAsync((char*)d_ws + WS_CTL, 0, CTL_BYTES, stream);
    (void)hipMemsetAsync((char*)d_ws + WS_LZERO, 0, LZERO_BYTES, stream);
    Args a{};
    for (int i = 0; i < 38; ++i) a.in[i] = (const float*)d_in[i];
    a.out = (float*)d_out; a.ws = (unsigned char*)d_ws;
#if MK_ONE_LAUNCH
    a.phase = 0; a.one = 1;
    hipLaunchKernelGGL(trunk_fwd, dim3(grid), dim3(NTHREADS), LDS_BYTES, stream, a);
#else
    const int nph = count_phases();
    for (int p = 0; p < nph; ++p) { a.phase = p; a.one = 0; hipLaunchKernelGGL(trunk_fwd, dim3(grid), dim3(NTHREADS), LDS_BYTES, stream, a); }
#endif
}
```

```cpp
#include <hip/hip_runtime.h>
#include <cstdio>
#include <cstdint>

#ifndef MK_ONE_LAUNCH
#define MK_ONE_LAUNCH 1
#endif
#define LAS __attribute__((address_space(3)))
#define GAS __attribute__((address_space(1)))
typedef unsigned short bf16_t;
typedef short bf16x8 __attribute__((ext_vector_type(8)));
typedef float f32x4 __attribute__((ext_vector_type(4)));
typedef float f32x2 __attribute__((ext_vector_type(2)));
typedef unsigned u32x4 __attribute__((ext_vector_type(4)));
typedef unsigned u32x2 __attribute__((ext_vector_type(2)));

constexpr int D = 1024, NB = 32, T = 2048, L = 256, DEPTH = 4;
constexpr int NX = NB * T, NC = NB * L, NT = NX + NC;
constexpr int NE = 32, TOPK = 4;
constexpr int NWAVES = 8, NTHREADS = 512;
constexpr int MAXRT = NT * TOPK / 256 + NE;

constexpr size_t MiB = 1u << 20;
constexpr size_t WS_CTL = 0, CTL_BYTES = 4 * MiB;
constexpr size_t WS_MOD = 4 * MiB;
constexpr size_t WS_ROPEC = 8 * MiB, WS_ROPES = 8 * MiB + 512 * 1024;
constexpr size_t WS_BQK = 9 * MiB;
constexpr size_t WS_WQK = 10 * MiB;
constexpr size_t WS_WV = 15 * MiB;
constexpr size_t WS_WO = 16 * MiB;
constexpr size_t WS_POOLW = 20 * MiB;
constexpr size_t WS_WRKV = 21 * MiB;
constexpr size_t WS_WOR = 27 * MiB;
constexpr size_t WS_WL1 = 30 * MiB;
constexpr size_t WS_WL2 = 32 * MiB;
constexpr size_t WS_LZERO = WS_WL1, LZERO_BYTES = 6 * MiB;
constexpr size_t WS_W1T = 40 * MiB;
constexpr size_t WS_W2T = 552 * MiB;
constexpr size_t WS_H = 808 * MiB;
constexpr size_t WS_AX = 1096 * MiB;
constexpr size_t WS_FX = 1240 * MiB;
constexpr size_t WS_R = 1384 * MiB;
constexpr size_t WS_ACT = WS_R;
constexpr size_t WS_Y = WS_R + 592 * MiB;
constexpr size_t WS_LIST = WS_R + 1184 * MiB;
constexpr size_t WS_POS = WS_R + 1193 * MiB;
constexpr size_t WS_GATE = WS_R + 1195 * MiB;
constexpr size_t WS_Q = WS_R;
constexpr size_t WS_K = WS_R + 144 * MiB;
constexpr size_t WS_VT = WS_R + 180 * MiB;
constexpr size_t WS_O = WS_R + 216 * MiB;
constexpr size_t WS_PD = WS_R;
constexpr size_t WS_A6 = WS_R;
constexpr size_t WS_E = WS_R;
constexpr size_t WS_A = WS_R + 288 * MiB;
constexpr size_t WS_RO = WS_R + 576 * MiB;
constexpr size_t WS_RKV = WS_R + 864 * MiB;
constexpr size_t WS_LORA = WS_R + 1296 * MiB;
constexpr size_t WS_G = WS_R + 1404 * MiB;
constexpr size_t WS_YS = WS_R + 1548 * MiB;
constexpr size_t WS_BONUS = WS_R + 2124 * MiB;
constexpr size_t WS_END = WS_R + 2134 * MiB;

constexpr int CW_BAR = 4096;
constexpr int CW_GCNT = 16384;
constexpr int LDS_BYTES = 147456;
constexpr int RING_BYTES = 131072;
constexpr int LDSCTL_OFF = 135168;
constexpr int MISC_OFF = LDSCTL_OFF;
constexpr int TPRE_OFF = LDSCTL_OFF + 256;
constexpr int LCNT_OFF = LDSCTL_OFF + 512;
constexpr int LBASE_OFF = LDSCTL_OFF + 768;
constexpr int REC_OFF = LDSCTL_OFF + 1024;
constexpr int TEXP_OFF = LDSCTL_OFF + 1024 + 2048;
constexpr int TOKS_OFF = LDSCTL_OFF + 1024 + 4096;
constexpr int JOB_OFF = LDSCTL_OFF + 1024;

__device__ __forceinline__ unsigned f2bf(float f) { unsigned u = __builtin_bit_cast(unsigned, f); return (u + 0x7fffu + ((u >> 16) & 1u)) >> 16; }
__device__ __forceinline__ unsigned pk2(float lo, float hi) { return f2bf(lo) | (f2bf(hi) << 16); }
__device__ __forceinline__ float bflo(unsigned w) { return __builtin_bit_cast(float, w << 16); }
__device__ __forceinline__ float bfhi(unsigned w) { return __builtin_bit_cast(float, w & 0xffff0000u); }
__device__ __forceinline__ float bf1(bf16_t b) { return __builtin_bit_cast(float, ((unsigned)b) << 16); }
__device__ __forceinline__ unsigned pk4_fp8(float a, float b, float c, float d) { int w = __builtin_amdgcn_cvt_pk_fp8_f32(a, b, 0, false); w = __builtin_amdgcn_cvt_pk_fp8_f32(c, d, w, true); return (unsigned)w; }
typedef __bf16 bf16x2_t __attribute__((ext_vector_type(2)));
__device__ __forceinline__ unsigned cvt_pk_bf16(float lo, float hi) { const f32x2 v = {lo, hi}; return __builtin_bit_cast(unsigned, __builtin_convertvector(v, bf16x2_t)); }
__device__ __forceinline__ float dpp_add(float v, const int ctrl, const int row_mask) {
    switch (ctrl) {
    case 0xB1:  return v + __builtin_bit_cast(float, __builtin_amdgcn_update_dpp(0, __builtin_bit_cast(int, v), 0xB1, 0xf, 0xf, true));
    case 0x4E:  return v + __builtin_bit_cast(float, __builtin_amdgcn_update_dpp(0, __builtin_bit_cast(int, v), 0x4E, 0xf, 0xf, true));
    case 0x141: return v + __builtin_bit_cast(float, __builtin_amdgcn_update_dpp(0, __builtin_bit_cast(int, v), 0x141, 0xf, 0xf, true));
    case 0x140: return v + __builtin_bit_cast(float, __builtin_amdgcn_update_dpp(0, __builtin_bit_cast(int, v), 0x140, 0xf, 0xf, true));
    case 0x142: return v + __builtin_bit_cast(float, __builtin_amdgcn_update_dpp(0, __builtin_bit_cast(int, v), 0x142, 0xa, 0xf, true));
    default:    return v + __builtin_bit_cast(float, __builtin_amdgcn_update_dpp(0, __builtin_bit_cast(int, v), 0x143, 0xc, 0xf, true));
    }
}
__device__ __forceinline__ float row16_sum(float v) { v = dpp_add(v, 0xB1, 0xf); v = dpp_add(v, 0x4E, 0xf); v = dpp_add(v, 0x141, 0xf); v = dpp_add(v, 0x140, 0xf); return v; }
__device__ __forceinline__ float wave_sum(float v) {
    v = row16_sum(v); v = dpp_add(v, 0x142, 0xa); v = dpp_add(v, 0x143, 0xc);
    return __builtin_bit_cast(float, __builtin_amdgcn_readlane(__builtin_bit_cast(int, v), 63));
}
__device__ __forceinline__ float sigmoidf_(float x) { return __builtin_amdgcn_rcpf(1.0f + __builtin_amdgcn_exp2f(-1.4426950408889634f * x)); }
__device__ __forceinline__ int opaque_tid() { int t; asm volatile("v_mov_b32 %0, %1" : "=v"(t) : "v"(threadIdx.x)); return t; }
#define REFRESH(F) do { (F).tid = opaque_tid(); (F).lane = (F).tid & 63; } while (0)
__device__ __forceinline__ void seq_of(int row, int& sb, int& t, int& n) { if (row < NX) { sb = row & ~(T - 1); t = row & (T - 1); n = T; } else { const int r2 = row - NX; sb = NX + (r2 & ~(L - 1)); t = r2 & (L - 1); n = L; } }
__device__ __forceinline__ f32x4 ld_bf4(const bf16_t* p) { const u32x2 w = *(const u32x2*)p; return (f32x4){bflo(w.x), bfhi(w.x), bflo(w.y), bfhi(w.y)}; }
__device__ __forceinline__ void st_bf4(bf16_t* p, f32x4 v) { u32x2 w; w.x = pk2(v.x, v.y); w.y = pk2(v.z, v.w); *(u32x2*)p = w; }

#define LDS_WAIT() asm volatile("s_waitcnt lgkmcnt(0)" ::: "memory")
#define VM_WAIT() asm volatile("s_waitcnt vmcnt(0)" ::: "memory")

#define XB_TMO      128
#define XB_XCNT(j)  (256  + 64 * (j))
#define XB_XSUB(j)  (1280 + 64 * (j))
#define XB_XGEN(j)  (2304 + 64 * (j))
#define XB_TOP      3328
#define XB_TOPGEN   3392
#define XCD_BAR_WORDS 3456
#define XB_SPIN_CAP (1u << 18)
__device__ __forceinline__ unsigned xb_ld(unsigned* p)              { return __hip_atomic_load(p, __ATOMIC_RELAXED, __HIP_MEMORY_SCOPE_AGENT); }
__device__ __forceinline__ unsigned xb_add(unsigned* p, unsigned v) { return __hip_atomic_fetch_add(p, v, __ATOMIC_RELAXED, __HIP_MEMORY_SCOPE_AGENT); }
__device__ __forceinline__ unsigned xb_xcc_id() { return (unsigned)__builtin_amdgcn_s_getreg((3 << 11) | 20) & 0xFu; }
#define XB_SPIN(cond, bar) do { unsigned _sp = 0; while (cond) { __builtin_amdgcn_s_sleep(1); \
    if ((++_sp & 255u) == 0u) { if (xb_ld(&(bar)[XB_TMO])) break; if (_sp > XB_SPIN_CAP) { atomicAdd(&(bar)[XB_TMO], 1u); break; } } } } while (0)
struct XcdBarrier { unsigned* bar; unsigned x; volatile LAS unsigned* st; };
__device__ __forceinline__ XcdBarrier xcd_barrier_post(unsigned* bar, volatile LAS unsigned* st) {
    XcdBarrier b; b.bar = bar; b.x = xb_xcc_id(); b.st = st;
    if (threadIdx.x == 0) (void)xb_add(&bar[XB_XCNT(b.x)], 1u);
    return b;
}
__device__ __forceinline__ void xcd_barrier_complete(unsigned* bar, unsigned x, unsigned& nloc, unsigned& nx) {
    const unsigned G = gridDim.x * gridDim.y * gridDim.z;
    unsigned sum, cnt, mine, sp = 0u;
    for (;;) {
        sum = 0u; cnt = 0u; mine = 0u;
#pragma unroll
        for (unsigned j = 0; j < 16; ++j) { const unsigned c = xb_ld(&bar[XB_XCNT(j)]); sum += c; cnt += (c > 0u) ? 1u : 0u; mine = (j == x) ? c : mine; }
        if (sum == G) break;
        __builtin_amdgcn_s_sleep(1);
        if ((++sp & 255u) == 0u) { if (xb_ld(&bar[XB_TMO])) break; if (sp > XB_SPIN_CAP) { atomicAdd(&bar[XB_TMO], 1u); break; } }
    }
    nloc = mine > 0u ? mine : 1u; nx = cnt > 0u ? cnt : 1u;
}
__device__ __forceinline__ void xcd_barrier(const XcdBarrier& b) {
    asm volatile("s_waitcnt vmcnt(0)" ::: "memory");
    __syncthreads();
    if (threadIdx.x == 0) {
        unsigned* bar = b.bar;
        __builtin_amdgcn_s_waitcnt(0);
        unsigned nloc = b.st[0], nx = b.st[1];
        if (nloc == 0u) { xcd_barrier_complete(bar, b.x, nloc, nx); b.st[0] = nloc; b.st[1] = nx; }
        const unsigned old = xb_add(&bar[XB_XSUB(b.x)], 1u);
        const unsigned gen = old / nloc;
        if (old + 1u == (gen + 1u) * nloc) {
            __builtin_amdgcn_fence(__ATOMIC_RELEASE, "agent");
            asm volatile("s_waitcnt vmcnt(0)" ::: "memory");
            const unsigned og = xb_add(&bar[XB_TOP], 1u);
            const unsigned tg = og / nx;
            if (og + 1u == (tg + 1u) * nx) xb_add(&bar[XB_TOPGEN], 1u);
            else XB_SPIN(xb_ld(&bar[XB_TOPGEN]) == tg, bar);
            __builtin_amdgcn_fence(__ATOMIC_ACQUIRE, "agent");
            xb_add(&bar[XB_XGEN(b.x)], 1u);
            asm volatile("s_waitcnt vmcnt(0)" ::: "memory");
        } else {
            XB_SPIN(xb_ld(&bar[XB_XGEN(b.x)]) == gen, bar);
            __builtin_amdgcn_fence(__ATOMIC_ACQUIRE, "agent");
            asm volatile("s_waitcnt vmcnt(0)" ::: "memory");
        }
    }
    __syncthreads();
}

namespace pg8 {
constexpr int BM = 256, BK = 64, HALF = 128, HTB = HALF * BK * 2, STAGE_BYTES = 8 * HTB, NXCD = 8, WGM = 8;
__host__ __device__ __forceinline__ int lds_byte(int r, int c) { const int st = (r >> 4) * 2 + (c >> 5), rr = r & 15, cc = c & 31, ob = rr * 64 + cc * 2; return st * 1024 + (ob ^ (((ob >> 9) & 1) << 5)); }
__host__ __device__ __forceinline__ void stage_rc(int b, int& R, int& C) { const int st = b / 1024, sb = b % 1024, swz = sb ^ (((sb >> 9) & 1) << 5); R = (st >> 1) * 16 + swz / 64; C = (st & 1) * 32 + (swz % 64) / 2; }
__host__ __device__ __forceinline__ int perm32(int rho) { const int n = rho >> 4, i = rho & 15; return 8 * (i >> 2) + 4 * n + (i & 3); }

typedef int i32x8 __attribute__((ext_vector_type(8)));
typedef int i32x4 __attribute__((ext_vector_type(4)));
__device__ __forceinline__ i32x8 cat8(bf16x8 lo, bf16x8 hi) { const i32x4 a = __builtin_bit_cast(i32x4, lo), b = __builtin_bit_cast(i32x4, hi); return __builtin_shufflevector(a, b, 0, 1, 2, 3, 4, 5, 6, 7); }
struct Unit { int pm, pn, e, rt; };
struct TileOrder {
    int nM, nN, nwg, G, c;
    __device__ __forceinline__ void init(int nM_, int nN_, int G_, int c_) { nM = nM_; nN = nN_; nwg = nM * nN; G = G_; c = c_; }
    __device__ __forceinline__ bool next(int i, int& pm, int& pn) const {
        const long Lx = (long)i * G + c; if (Lx >= nwg) return false;
        int wgid = (int)Lx; { const int q = nwg / NXCD, r = nwg % NXCD, xcd = wgid % NXCD, off = wgid / NXCD; wgid = (xcd < r ? xcd * (q + 1) : r * (q + 1) + (xcd - r) * q) + off; }
        const int nig = WGM * nN, gid = wgid / nig, fm = gid * WGM, gsz = (nM - fm) < WGM ? (nM - fm) : WGM;
        pm = fm + ((wgid % nig) % gsz); pn = (wgid % nig) / gsz; return true;
    }
};
struct ProbDense {
    static constexpr bool FP8 = false;
    const bf16_t* A; const bf16_t* Bt; int lda, ldb, K, a_pn_off; TileOrder ord;
    __device__ __forceinline__ int ldb_bytes() const { return ldb * 2; }
    __device__ __forceinline__ int ntiles() const { return K / 64; }
    __device__ __forceinline__ bool next(int i, Unit& u) const { u.e = 0; const bool ok = ord.next(i, u.pm, u.pn); u.rt = u.pm; return ok; }
    __device__ __forceinline__ const char* a_ptr(const Unit& u) const { return (const char*)(A + (size_t)u.pm * BM * lda + (size_t)u.pn * a_pn_off); }
    __device__ __forceinline__ const char* b_ptr(const Unit& u) const { return (const char*)(Bt + (size_t)u.pn * BM * ldb); }
    __device__ __forceinline__ void list_prefetch(const Unit&, int, int, int) const {}
    __device__ __forceinline__ void a_off(const Unit&, int, const int (&R)[2], const int (&C)[2], unsigned (&v)[2][2]) const {
#pragma unroll
        for (int h = 0; h < 2; ++h)
#pragma unroll
            for (int i = 0; i < 2; ++i) v[h][i] = (unsigned)((h * HALF + R[i]) * lda + C[i]) * 2u;
    }
};

struct ProbDense8 {
    static constexpr bool FP8 = true;
    const unsigned char* A; const unsigned char* Bt; int lda, ldb, K, scale_w, scale_x; TileOrder ord;
    __device__ __forceinline__ int ldb_bytes() const { return ldb; }
    __device__ __forceinline__ int ntiles() const { return K / 128; }
    __device__ __forceinline__ bool next(int i, Unit& u) const { u.e = 0; const bool ok = ord.next(i, u.pm, u.pn); u.rt = u.pm; return ok; }
    __device__ __forceinline__ const char* a_ptr(const Unit& u) const { return (const char*)(A + (size_t)u.pm * BM * lda); }
    __device__ __forceinline__ const char* b_ptr(const Unit& u) const { return (const char*)(Bt + (size_t)u.pn * BM * ldb); }
    __device__ __forceinline__ void list_prefetch(const Unit&, int, int, int) const {}
    __device__ __forceinline__ void a_off(const Unit&, int, const int (&R)[2], const int (&C)[2], unsigned (&v)[2][2]) const {
#pragma unroll
        for (int h = 0; h < 2; ++h)
#pragma unroll
            for (int i = 0; i < 2; ++i) v[h][i] = (unsigned)((h * HALF + R[i]) * lda + C[i] * 2);
    }
};
template <class Prob, class Epi>
__device__ __forceinline__ void gemm_phase(LAS unsigned char* lds, const Prob& P, const Epi& E) {
    const int tid = opaque_tid(), wid = __builtin_amdgcn_readfirstlane(tid >> 6), lane = tid & 63, wr = wid >> 2, wc = wid & 3, fr = lane & 15, fq = lane >> 4;
    const int nt = P.ntiles(); const int ldbB = P.ldb_bytes();
    int Rr[2], Cc[2]; unsigned voffB[2];
#pragma unroll
    for (int i = 0; i < 2; ++i) { int R, C; stage_rc(tid * 16 + i * 8192, R, C); Rr[i] = R; Cc[i] = C; const int Rb = Epi::PERM ? ((R & ~31) + perm32(R & 31)) : R;
        voffB[i] = (unsigned)(Rb * ldbB + C * 2); }
    const size_t kstep = (size_t)(BK * 2);
    const size_t hstepB = (size_t)HALF * ldbB;
    const unsigned ldsw = (unsigned)wid * 1024u;
    const int aoff = lds_byte(wr * 64 + fr, fq * 8), boff = lds_byte(wc * 32 + fr, fq * 8);
#define PG8_SA(b, h) (((b) * 2 + (h)) * HTB)
#define PG8_SB(b, h) ((4 + (b) * 2 + (h)) * HTB)
#define PG8_STAGE(bufoff, gbase, voff) do { _Pragma("unroll") for (int _i = 0; _i < 2; ++_i) \
        __builtin_amdgcn_global_load_lds((const unsigned*)((const char*)(gbase) + (voff)[_i]), (LAS unsigned*)(lds + (bufoff) + ldsw + _i * 8192), 16, 0, 0); } while (0)
#define PG8_LDA(dst, b, h) do { _Pragma("unroll") for (int m = 0; m < 4; ++m) _Pragma("unroll") for (int k = 0; k < 2; ++k) dst[m][k] = *(const LAS bf16x8*)(lds + PG8_SA(b, h) + aoff + m * 2048 + k * 1024); } while (0)
#define PG8_LDB(dst, b, h) do { _Pragma("unroll") for (int n = 0; n < 2; ++n) _Pragma("unroll") for (int k = 0; k < 2; ++k) dst[n][k] = *(const LAS bf16x8*)(lds + PG8_SB(b, h) + boff + n * 2048 + k * 1024); } while (0)
#define PG8_MMA(ai, bj, At, Bt) do { __builtin_amdgcn_s_setprio(1); _Pragma("unroll") for (int m = 0; m < 4; ++m) _Pragma("unroll") for (int n = 0; n < 2; ++n) { \
        if constexpr (Prob::FP8) { asm volatile("v_mfma_scale_f32_16x16x128_f8f6f4 %0, %1, %2, %0, %3, %4 op_sel_hi:[0,0,0]" : "+v"(acc[ai][bj][m][n]) : "v"(cat8(Bt[n][0], Bt[n][1])), "v"(cat8(At[m][0], At[m][1])), "v"(sc_w), "v"(sc_x)); } \
        else { _Pragma("unroll") for (int k = 0; k < 2; ++k) acc[ai][bj][m][n] = __builtin_amdgcn_mfma_f32_16x16x32_bf16(Bt[n][k], At[m][k], acc[ai][bj][m][n], 0, 0, 0); } } __builtin_amdgcn_s_setprio(0); } while (0)
#define PG8_WAIT_V(n) asm volatile("s_waitcnt vmcnt(" #n ")" ::: "memory")
#define PG8_WAIT_L(n) asm volatile("s_waitcnt lgkmcnt(" #n ")" ::: "memory")
#define PG8_BAR __builtin_amdgcn_s_barrier()
#define PG8_SCHED __builtin_amdgcn_sched_barrier(0)
    Unit cur, nxt; int ui = 0;
    if (!P.next(0, cur)) return;
    int sc_w = 0, sc_x = 0; if constexpr (Prob::FP8) { sc_w = P.scale_w; sc_x = P.scale_x; } (void)sc_w; (void)sc_x;
    f32x4 acc[2][2][4][2];
#pragma unroll
    for (int a = 0; a < 2; ++a)
#pragma unroll
        for (int b = 0; b < 2; ++b)
#pragma unroll
            for (int m = 0; m < 4; ++m)
#pragma unroll
                for (int n = 0; n < 2; ++n) acc[a][b][m][n] = (f32x4){0.f, 0.f, 0.f, 0.f};
    bf16x8 At[4][2], B0[2][2], B1[2][2];
    unsigned vAc[2][2], vAn[2][2];
    P.list_prefetch(cur, 0, wid, lane); { Unit u1; if (P.next(1, u1)) P.list_prefetch(u1, 1, wid, lane); }
    PG8_WAIT_V(0); PG8_BAR;
    P.a_off(cur, 0, Rr, Cc, vAc);
    const char* cA = P.a_ptr(cur); const char* cB = P.b_ptr(cur);
    PG8_STAGE(PG8_SB(0, 0), cB, voffB); PG8_STAGE(PG8_SB(0, 1), cB + hstepB, voffB); PG8_STAGE(PG8_SA(0, 0), cA, vAc[0]); PG8_STAGE(PG8_SA(0, 1), cA, vAc[1]);
    if (wr == 1) PG8_BAR;
    PG8_WAIT_V(2); PG8_BAR;
    PG8_STAGE(PG8_SB(1, 0), cB + kstep, voffB); PG8_STAGE(PG8_SA(1, 0), cA + kstep, vAc[0]); PG8_STAGE(PG8_SB(1, 1), cB + hstepB + kstep, voffB);
    PG8_WAIT_V(6); PG8_BAR;
    for (;;) {
        const bool has_next = P.next(ui + 1, nxt);
        const char* nA = cA; const char* nB = cB;
#pragma unroll
        for (int h = 0; h < 2; ++h)
#pragma unroll
            for (int i = 0; i < 2; ++i) vAn[h][i] = vAc[h][i];
        if (has_next) { nA = P.a_ptr(nxt); nB = P.b_ptr(nxt); P.a_off(nxt, (ui + 1) & 1, Rr, Cc, vAn); }
        { Unit u2; if (P.next(ui + 2, u2)) P.list_prefetch(u2, ui & 1, wid, lane); }
        for (int t = 0; t < nt; t += 2) {
            const bool last = (t == nt - 2);
            const char* a1 = cA + (size_t)(t + 1) * kstep;
            const char* a2 = last ? nA : cA + (size_t)(t + 2) * kstep; const char* b2 = last ? nB : cB + (size_t)(t + 2) * kstep;
            const char* a3 = a2 + kstep; const char* b3 = b2 + kstep;
            unsigned vX[2][2];
#pragma unroll
            for (int h = 0; h < 2; ++h)
#pragma unroll
                for (int i = 0; i < 2; ++i) vX[h][i] = last ? vAn[h][i] : vAc[h][i];
            PG8_LDB(B0, 0, 0); PG8_LDB(B1, 0, 1); PG8_SCHED; PG8_LDA(At, 0, 0); PG8_STAGE(PG8_SA(1, 1), a1, vAc[1]);
            PG8_WAIT_V(8); PG8_WAIT_L(0); PG8_BAR; PG8_MMA(0, 0, At, B0); PG8_MMA(0, 1, At, B1); PG8_BAR; PG8_SCHED;
            PG8_LDA(At, 0, 1); PG8_STAGE(PG8_SB(0, 0), b2, voffB); PG8_STAGE(PG8_SB(0, 1), b2 + hstepB, voffB); PG8_STAGE(PG8_SA(0, 0), a2, vX[0]);
            PG8_WAIT_V(8); PG8_WAIT_L(0); PG8_BAR; PG8_MMA(1, 0, At, B0); PG8_MMA(1, 1, At, B1); PG8_BAR; PG8_SCHED;
            PG8_LDB(B0, 1, 0); PG8_LDB(B1, 1, 1); PG8_SCHED; PG8_LDA(At, 1, 0); PG8_STAGE(PG8_SA(0, 1), a2, vX[1]);
            PG8_WAIT_V(8); PG8_WAIT_L(0); PG8_BAR; PG8_MMA(0, 0, At, B0); PG8_MMA(0, 1, At, B1); PG8_BAR; PG8_SCHED;
            PG8_LDA(At, 1, 1); PG8_STAGE(PG8_SB(1, 0), b3, voffB); PG8_STAGE(PG8_SB(1, 1), b3 + hstepB, voffB); PG8_STAGE(PG8_SA(1, 0), a3, vX[0]);
            PG8_WAIT_V(8); PG8_WAIT_L(0); PG8_BAR; PG8_MMA(1, 0, At, B0); PG8_MMA(1, 1, At, B1); PG8_BAR; PG8_SCHED;
        }
        if (wr == 0) PG8_BAR;
        if constexpr (Prob::FP8) asm volatile("s_nop 15\n\ts_nop 15" ::: "memory");
        E(acc, cur, wr, wc, fr, fq);
        if (!has_next) break;
#pragma unroll
        for (int a = 0; a < 2; ++a)
#pragma unroll
            for (int b = 0; b < 2; ++b)
#pragma unroll
                for (int m = 0; m < 4; ++m)
#pragma unroll
                    for (int n = 0; n < 2; ++n) acc[a][b][m][n] = (f32x4){0.f, 0.f, 0.f, 0.f};
        cur = nxt; cA = nA; cB = nB; ++ui;
#pragma unroll
        for (int h = 0; h < 2; ++h)
#pragma unroll
            for (int i = 0; i < 2; ++i) vAc[h][i] = vAn[h][i];
        if (wr == 1) PG8_BAR;
    }
    PG8_WAIT_V(0);
    PG8_BAR;
#undef PG8_SA
#undef PG8_SB
#undef PG8_STAGE
#undef PG8_LDA
#undef PG8_LDB
#undef PG8_MMA
#undef PG8_WAIT_V
#undef PG8_WAIT_L
#undef PG8_BAR
#undef PG8_SCHED
}
}

using pg8::Unit;
constexpr int HALF_ = 128;
struct EpiBf16Act {
    static constexpr bool PERM = true;
    bf16_t* O; int ldc; const float* bias; int act; float scale;
    __device__ __forceinline__ void operator()(const f32x4 (&acc)[2][2][4][2], const Unit& u, int wr, int wc, int fr, int fq) const {
        const int row0 = u.pm * 256 + wr * 64 + fr, col0 = u.pn * 256 + wc * 32 + 8 * fq;
        f32x4 bv[2][2];
#pragma unroll
        for (int bj = 0; bj < 2; ++bj)
#pragma unroll
            for (int n = 0; n < 2; ++n) bv[bj][n] = bias ? *(const f32x4*)(bias + col0 + bj * HALF_ + 4 * n) : (f32x4){0.f, 0.f, 0.f, 0.f};
#pragma unroll
        for (int ai = 0; ai < 2; ++ai)
#pragma unroll
            for (int m = 0; m < 4; ++m) { bf16_t* rowp = O + (size_t)(row0 + ai * HALF_ + m * 16) * ldc + col0;
#pragma unroll
                for (int bj = 0; bj < 2; ++bj) { f32x4 v0 = acc[ai][bj][m][0] + bv[bj][0], v1 = acc[ai][bj][m][1] + bv[bj][1];
                    if (act == 1) {
#pragma unroll
                        for (int j = 0; j < 4; ++j) { v0[j] = sigmoidf_(v0[j]) * scale; v1[j] = sigmoidf_(v1[j]) * scale; } }
                    else if (act == 2) {
#pragma unroll
                        for (int j = 0; j < 4; ++j) { v0[j] = 1.0f - 2.0f * __builtin_amdgcn_rcpf(__builtin_amdgcn_exp2f(2.8853900817779268f * v0[j]) + 1.0f); v1[j] = 1.0f - 2.0f * __builtin_amdgcn_rcpf(__builtin_amdgcn_exp2f(2.8853900817779268f * v1[j]) + 1.0f); } }
                    u32x4 w; w.x = cvt_pk_bf16(v0[0], v0[1]); w.y = cvt_pk_bf16(v0[2], v0[3]); w.z = cvt_pk_bf16(v1[0], v1[1]); w.w = cvt_pk_bf16(v1[2], v1[3]);
                    *(u32x4*)(rowp + bj * HALF_) = w; } }
    }
};
struct EpiQK {
    static constexpr bool PERM = true;
    bf16_t* Q; bf16_t* Kb; const float* bias; const float* ropec; const float* ropes;
    __device__ __forceinline__ void operator()(const f32x4 (&acc)[2][2][4][2], const Unit& u, int wr, int wc, int fr, int fq) const {
        int row0 = u.pm * 256 + wr * 64 + fr, cl0 = wc * 32 + 8 * fq;
        asm volatile("" : "+v"(row0), "+v"(cl0));
        const int g = (4 * wc + fq) & 7;
        bf16_t* base; int ldc;
        if (u.pn < 4) { base = Q + u.pn * 256; ldc = 1024; } else { base = Kb; ldc = 256; }
        f32x4 bv[2][2];
#pragma unroll
        for (int bj = 0; bj < 2; ++bj)
#pragma unroll
            for (int n = 0; n < 2; ++n) bv[bj][n] = *(const f32x4*)(bias + u.pn * 256 + cl0 + bj * HALF_ + 4 * n);
#pragma unroll
        for (int ai = 0; ai < 2; ++ai)
#pragma unroll
            for (int m = 0; m < 4; ++m) { const int row = row0 + ai * HALF_ + m * 16; bf16_t* rowp = base + (size_t)row * ldc + cl0;
                f32x4 cs = (f32x4){1.f, 1.f, 1.f, 1.f}, sn = (f32x4){0.f, 0.f, 0.f, 0.f};
                if (row < NX) { const int t = row & (T - 1); cs = *(const f32x4*)(ropec + t * 32 + g * 4); sn = *(const f32x4*)(ropes + t * 32 + g * 4); }
#pragma unroll
                for (int bj = 0; bj < 2; ++bj) { const f32x4 v0 = acc[ai][bj][m][0] + bv[bj][0], v1 = acc[ai][bj][m][1] + bv[bj][1];
                    const f32x4 o0 = v0 * cs - v1 * sn, o1 = v1 * cs + v0 * sn;
                    u32x4 w; w.x = cvt_pk_bf16(o0[0], o0[1]); w.y = cvt_pk_bf16(o0[2], o0[3]); w.z = cvt_pk_bf16(o1[0], o1[1]); w.w = cvt_pk_bf16(o1[2], o1[3]);
                    *(u32x4*)(rowp + bj * HALF_) = w; } }
    }
};
struct EpiVT {
    static constexpr bool PERM = true;
    bf16_t* VT; const float* biasrow;
    __device__ __forceinline__ void operator()(const f32x4 (&acc)[2][2][4][2], const Unit& u, int wr, int wc, int fr, int fq) const {
        int row0 = wr * 64 + fr, col0 = u.pn * 256 + wc * 32 + 8 * fq;
        asm volatile("" : "+v"(row0), "+v"(col0));
#pragma unroll
        for (int ai = 0; ai < 2; ++ai)
#pragma unroll
            for (int m = 0; m < 4; ++m) { const int row = row0 + ai * HALF_ + m * 16; const float b = biasrow[row]; bf16_t* rowp = VT + (size_t)row * NT + col0;
#pragma unroll
                for (int bj = 0; bj < 2; ++bj) { const f32x4 v0 = acc[ai][bj][m][0] + b, v1 = acc[ai][bj][m][1] + b;
                    u32x4 w; w.x = cvt_pk_bf16(v0[0], v0[1]); w.y = cvt_pk_bf16(v0[2], v0[3]); w.z = cvt_pk_bf16(v1[0], v1[1]); w.w = cvt_pk_bf16(v1[2], v1[3]);
                    *(u32x4*)(rowp + bj * HALF_) = w; } }
    }
};
struct EpiResid {
    static constexpr bool PERM = true;
    bf16_t* H; const float* bias; const float* ls; const float* gate;
    __device__ __forceinline__ void operator()(const f32x4 (&acc)[2][2][4][2], const Unit& u, int wr, int wc, int fr, int fq) const {
        int row0 = u.pm * 256 + wr * 64 + fr, col0 = u.pn * 256 + wc * 32 + 8 * fq;
        asm volatile("" : "+v"(row0), "+v"(col0));
        f32x4 bv[2][2], lv[2][2];
#pragma unroll
        for (int bj = 0; bj < 2; ++bj)
#pragma unroll
            for (int n = 0; n < 2; ++n) { bv[bj][n] = bias ? *(const f32x4*)(bias + col0 + bj * HALF_ + 4 * n) : (f32x4){0.f, 0.f, 0.f, 0.f};
                                          lv[bj][n] = ls ? *(const f32x4*)(ls + col0 + bj * HALF_ + 4 * n) : (f32x4){1.f, 1.f, 1.f, 1.f}; }
#pragma unroll
        for (int ai = 0; ai < 2; ++ai)
#pragma unroll
            for (int m = 0; m < 4; ++m) { const int row = row0 + ai * HALF_ + m * 16; const int brow = row < NX ? (row >> 11) : 32;
                bf16_t* hp = H + (size_t)row * D + col0; const float* gp = gate + (size_t)brow * (6 * D) + col0;
#pragma unroll
                for (int bj = 0; bj < 2; ++bj) { const u32x4 hw = *(const u32x4*)(hp + bj * HALF_);
                    const f32x4 g0 = *(const f32x4*)(gp + bj * HALF_), g1 = *(const f32x4*)(gp + bj * HALF_ + 4);
                    const f32x4 y0 = (acc[ai][bj][m][0] + bv[bj][0]) * lv[bj][0], y1 = (acc[ai][bj][m][1] + bv[bj][1]) * lv[bj][1];
                    const f32x4 h0 = (f32x4){bflo(hw.x), bfhi(hw.x), bflo(hw.y), bfhi(hw.y)} + g0 * y0, h1 = (f32x4){bflo(hw.z), bfhi(hw.z), bflo(hw.w), bfhi(hw.w)} + g1 * y1;
                    u32x4 w; w.x = cvt_pk_bf16(h0[0], h0[1]); w.y = cvt_pk_bf16(h0[2], h0[3]); w.z = cvt_pk_bf16(h1[0], h1[1]); w.w = cvt_pk_bf16(h1[2], h1[3]);
                    *(u32x4*)(hp + bj * HALF_) = w; }
                asm volatile("" ::: "memory"); }
    }
};
struct EpiMoe1 {
    static constexpr bool PERM = true;
    unsigned char* ACT; const float* b1;
    __device__ __forceinline__ void operator()(const f32x4 (&acc)[2][2][4][2], const Unit& u, int wr, int wc, int fr, int fq) const {
        const int row0 = u.rt * 256 + wr * 64 + fr, cl = u.pn * 128 + wc * 32 + 8 * fq;
        const float* bg = b1 + (size_t)u.e * 2048 + cl; const float* bl = bg + 1024;
        f32x4 bgv[2], blv[2];
#pragma unroll
        for (int n = 0; n < 2; ++n) { bgv[n] = *(const f32x4*)(bg + 4 * n); blv[n] = *(const f32x4*)(bl + 4 * n); }
#pragma unroll
        for (int ai = 0; ai < 2; ++ai)
#pragma unroll
            for (int m = 0; m < 4; ++m) { unsigned char* rowp = ACT + (size_t)(row0 + ai * HALF_ + m * 16) * D + cl;
                f32x4 o[2];
#pragma unroll
                for (int n = 0; n < 2; ++n) { const f32x4 c7 = (f32x4){7.f, 7.f, 7.f, 7.f};
                    const f32x4 gl = __builtin_elementwise_min(acc[ai][0][m][n] + bgv[n], c7), li = __builtin_elementwise_min(__builtin_elementwise_max(acc[ai][1][m][n] + blv[n], -c7), c7);
                    const f32x4 z = gl * (-1.702f * 1.4426950408889634f); f32x4 den;
#pragma unroll
                    for (int j = 0; j < 4; ++j) den[j] = __builtin_amdgcn_rcpf(1.0f + __builtin_amdgcn_exp2f(z[j]));
                    o[n] = gl * den * (li + 1.0f); }
                u32x2 w; w.x = pk4_fp8(o[0][0], o[0][1], o[0][2], o[0][3]); w.y = pk4_fp8(o[1][0], o[1][1], o[1][2], o[1][3]);
                *(u32x2*)rowp = w; }
    }
};
struct EpiMoe2 {
    static constexpr bool PERM = true;
    unsigned char* Y; const float* b2;
    __device__ __forceinline__ void operator()(const f32x4 (&acc)[2][2][4][2], const Unit& u, int wr, int wc, int fr, int fq) const {
        const int row0 = u.rt * 256 + wr * 64 + fr, col0 = u.pn * 256 + wc * 32 + 8 * fq;
        const float* bb = b2 + (size_t)u.e * D + col0;
        f32x4 bv[2][2];
#pragma unroll
        for (int bj = 0; bj < 2; ++bj)
#pragma unroll
            for (int n = 0; n < 2; ++n) bv[bj][n] = *(const f32x4*)(bb + bj * HALF_ + 4 * n);
#pragma unroll
        for (int ai = 0; ai < 2; ++ai)
#pragma unroll
            for (int m = 0; m < 4; ++m) { unsigned char* rowp = Y + (size_t)(row0 + ai * HALF_ + m * 16) * D + col0;
#pragma unroll
                for (int bj = 0; bj < 2; ++bj) { f32x4 v0 = (acc[ai][bj][m][0] + bv[bj][0]) * 4.0f, v1 = (acc[ai][bj][m][1] + bv[bj][1]) * 4.0f;
#pragma unroll
                    for (int i = 0; i < 4; ++i) { v0[i] = __builtin_amdgcn_fmed3f(v0[i], -448.0f, 448.0f); v1[i] = __builtin_amdgcn_fmed3f(v1[i], -448.0f, 448.0f); }
                    *(u32x2*)(rowp + bj * HALF_) = (u32x2){pk4_fp8(v0[0], v0[1], v0[2], v0[3]), pk4_fp8(v1[0], v1[1], v1[2], v1[3])}; } }
    }
};
typedef unsigned char fp8_t;
constexpr int SCALE_ONE = 0x7f7f7f7f, SCALE_W = 0x79797979;
struct ProbMoe1 {
    static constexpr bool FP8 = true;
    const fp8_t* FX; const fp8_t* W1T; const int* list; const LAS int* tpre; const LAS int* cnt; const LAS unsigned char* texp; LAS int* toks; int scale_w, scale_x; pg8::TileOrder ord;
    __device__ __forceinline__ int ldb_bytes() const { return D; }
    __device__ __forceinline__ int ntiles() const { return D / 128; }
    __device__ __forceinline__ bool next(int i, Unit& u) const {
        if (!ord.next(i, u.pm, u.pn)) return false;
        u.rt = u.pm; u.e = texp[u.rt]; return true;
    }
    __device__ __forceinline__ const char* a_ptr(const Unit&) const { return (const char*)FX; }
    __device__ __forceinline__ const char* b_ptr(const Unit& u) const { return (const char*)(W1T + ((size_t)u.e * 2048 + (size_t)u.pn * 256) * D); }
    __device__ __forceinline__ void list_prefetch(const Unit& u, int par, int wid, int lane) const {
        if (wid == 0) { const int* src = list + (size_t)u.e * NT + (u.rt - tpre[u.e]) * 256 + 4 * lane;
            __builtin_amdgcn_global_load_lds((const unsigned*)src, (LAS unsigned*)(toks + par * 256), 16, 0, 0); }
    }
    __device__ __forceinline__ void a_off(const Unit& u, int par, const int (&R)[2], const int (&C)[2], unsigned (&v)[2][2]) const {
        const int nvalid = cnt[u.e] - (u.rt - tpre[u.e]) * 256; const LAS int* tk = toks + par * 256;
#pragma unroll
        for (int h = 0; h < 2; ++h)
#pragma unroll
            for (int i = 0; i < 2; ++i) { const int r = h * 128 + R[i]; const int tok = tk[r < nvalid ? r : 0]; v[h][i] = (unsigned)(tok * D + C[i] * 2); }
    }
};
struct ProbMoe2 {
    static constexpr bool FP8 = true;
    const fp8_t* ACT; const fp8_t* W2T; const LAS int* tpre; const LAS unsigned char* texp; int scale_w, scale_x; pg8::TileOrder ord;
    __device__ __forceinline__ int ldb_bytes() const { return D; }
    __device__ __forceinline__ int ntiles() const { return D / 128; }
    __device__ __forceinline__ bool next(int i, Unit& u) const {
        if (!ord.next(i, u.pm, u.pn)) return false;
        u.rt = u.pm; u.e = texp[u.rt]; return true;
    }
    __device__ __forceinline__ const char* a_ptr(const Unit& u) const { return (const char*)(ACT + (size_t)u.rt * 256 * D); }
    __device__ __forceinline__ const char* b_ptr(const Unit& u) const { return (const char*)(W2T + ((size_t)u.e * 1024 + (size_t)u.pn * 256) * D); }
    __device__ __forceinline__ void list_prefetch(const Unit&, int, int, int) const {}
    __device__ __forceinline__ void a_off(const Unit&, int, const int (&R)[2], const int (&C)[2], unsigned (&v)[2][2]) const {
#pragma unroll
        for (int h = 0; h < 2; ++h)
#pragma unroll
            for (int i = 0; i < 2; ++i) v[h][i] = (unsigned)((h * 128 + R[i]) * D + C[i] * 2);
    }
};
struct Args { const float* in[38]; float* out; unsigned char* ws; int phase; int one; };
enum { I_X = 0, I_C, I_CTX, I_CCTX, I_ADAW, I_ADAB, I_NORMG, I_AWQKV, I_ABQKV, I_AWO, I_ABO, I_ASINK, I_PW, I_PB, I_PS,
       I_RMIX, I_RWRKV, I_RW0, I_RW1, I_RW2, I_RA0, I_RA1, I_RA2, I_RG1, I_RG2, I_RKK, I_RKA, I_RRK, I_RLNW, I_RLNB, I_RWO,
       I_MWR, I_MBR, I_MW1, I_MB1, I_MW2, I_MB2, I_FG };
struct Frame { LAS unsigned char* lds; int tid, lane, wave, G, c; unsigned char* ws; unsigned* ctl; };
#define WSP(T_, off) ((T_*)(F.ws + (off)))

struct TJob { const float* src; unsigned char* dst; long sbs, dbs; int ldw, ldt, nkb, nnb, mode, item0, per, esz; };
__device__ __forceinline__ int dst_row(int mode, int n) {
    if (mode == 1) { const int hb = n & ~63, d = n & 63; const int ax = d >> 5, dd = d & 31, hf = dd >> 4, f = dd & 15; const int g = ax * 4 + (f >> 2), i = (f & 3) + 4 * hf; return hb + 8 * g + i; }
    if (mode == 2) { return n < 1024 ? ((n >> 7) << 8) + (n & 127) : (((n - 1024) >> 7) << 8) + 128 + (n & 127); }
    return n;
}
struct TItem { const float* src; unsigned char* dst; int ldw, ldt, mode, n0, esz; };
__device__ __forceinline__ void titem_decode(const LAS TJob* jobs, int nj, int it, TItem& T) {
    int ji = 0;
    for (int q = 1; q < nj; ++q) ji += (jobs[q].item0 <= it) ? 1 : 0;
    const LAS TJob& J = jobs[ji]; const int r = it - J.item0, bi = r / J.per, rr = r % J.per, kb = rr / J.nnb, nb = rr % J.nnb;
    T.src = J.src + bi * J.sbs + (size_t)(64 * kb) * J.ldw + 32 * nb; T.dst = J.dst + (bi * J.dbs + 64 * kb) * J.esz; T.ldw = J.ldw; T.ldt = J.ldt; T.mode = J.mode; T.n0 = 32 * nb; T.esz = J.esz;
}
__device__ __forceinline__ void titem_load(const TItem& T, int lane, f32x4 (&v)[8]) {
    const float* p = T.src + (size_t)(lane >> 3) * T.ldw + 4 * (lane & 7);
#pragma unroll
    for (int i = 0; i < 8; ++i) v[i] = *(const f32x4*)(p + (size_t)(8 * i) * T.ldw);
}
__device__ __forceinline__ void titem_store(const TItem& T, int lane, const f32x4 (&v)[8], LAS float* scr) {
#pragma unroll
    for (int i = 0; i < 8; ++i) { LAS float* d = scr + (8 * i + (lane >> 3)) * 33 + 4 * (lane & 7); d[0] = v[i].x; d[1] = v[i].y; d[2] = v[i].z; d[3] = v[i].w; }
    LDS_WAIT(); asm volatile("" ::: "memory");
    const int c = lane & 7;
#pragma unroll
    for (int j = 0; j < 4; ++j) { const int n = (lane >> 3) + 8 * j; const LAS float* s = scr + (8 * c) * 33 + n;
        const size_t eo = (size_t)dst_row(T.mode, T.n0 + n) * T.ldt + 8 * c;
        if (T.esz == 2) { u32x4 o; o.x = pk2(s[0 * 33], s[1 * 33]); o.y = pk2(s[2 * 33], s[3 * 33]); o.z = pk2(s[4 * 33], s[5 * 33]); o.w = pk2(s[6 * 33], s[7 * 33]); *(u32x4*)(T.dst + eo * 2) = o; }
        else { u32x2 o; o.x = pk4_fp8(64.f * s[0 * 33], 64.f * s[1 * 33], 64.f * s[2 * 33], 64.f * s[3 * 33]); o.y = pk4_fp8(64.f * s[4 * 33], 64.f * s[5 * 33], 64.f * s[6 * 33], 64.f * s[7 * 33]); *(u32x2*)(T.dst + eo) = o; } }
    LDS_WAIT(); asm volatile("" ::: "memory");
}
__device__ __forceinline__ void phase_prologue(Frame& F, const Args& A) {
    REFRESH(F);
    LAS float* S = (LAS float*)F.lds;
    for (int idx = F.tid; idx < 33 * 1024; idx += NTHREADS) { const int r = idx >> 10, k = idx & 1023; const float v = r < 32 ? A.in[I_C][r * 1024 + k] : A.in[I_CCTX][k]; S[k * 33 + r] = v / (1.0f + __expf(-v)); }
    __syncthreads();
    float* MOD = WSP(float, WS_MOD);
    for (int it = F.c; it < 4 * 96; it += F.G) {
        const int layer = it / 96, n = (it % 96) * 64 + F.lane; const float* wp = A.in[I_ADAW] + (size_t)layer * 1024 * 6144 + n;
        float acc[5] = {0.f, 0.f, 0.f, 0.f, 0.f};
        for (int k0 = 0; k0 < 1024; k0 += 32) {
            float wv[32];
#pragma unroll
            for (int u = 0; u < 32; ++u) wv[u] = wp[(size_t)(k0 + u) * 6144];
#pragma unroll
            for (int u = 0; u < 32; ++u) { const LAS float* sr = S + (k0 + u) * 33 + F.wave;
                acc[0] += sr[0] * wv[u]; acc[1] += sr[8] * wv[u]; acc[2] += sr[16] * wv[u]; acc[3] += sr[24] * wv[u]; if (F.wave == 0) acc[4] += S[(k0 + u) * 33 + 32] * wv[u]; }
        }
        const float bb = A.in[I_ADAB][layer * 6144 + n];
#pragma unroll
        for (int i = 0; i < 4; ++i) MOD[((size_t)layer * 33 + F.wave + 8 * i) * 6144 + n] = acc[i] + bb;
        if (F.wave == 0) MOD[((size_t)layer * 33 + 32) * 6144 + n] = acc[4] + bb;
    }
    { float* rc = WSP(float, WS_ROPEC); float* rs = WSP(float, WS_ROPES);
      for (int idx = F.c * NTHREADS + F.tid; idx < 2048 * 32; idx += F.G * NTHREADS) { const int t = idx >> 5, e = idx & 31, g = e >> 2, i = e & 3, f = 4 * (g & 3) + i;
          const float inv = powf(10000.0f, -(float)f / 16.0f); const float pos = (float)(g < 4 ? (t >> 6) : (t & 63)); const float ang = pos * inv; rc[idx] = cosf(ang); rs[idx] = sinf(ang); }
      float* bq = WSP(float, WS_BQK);
      for (int idx = F.c * NTHREADS + F.tid; idx < 2 * 1280; idx += F.G * NTHREADS) { const int j = idx / 1280, n = idx % 1280; bq[j * 1280 + dst_row(1, n)] = A.in[I_ABQKV][j * 1536 + n]; } }
    __syncthreads();
    LAS TJob* jobs = (LAS TJob*)(F.lds + JOB_OFF); LAS int* njobs = (LAS int*)(F.lds + MISC_OFF + 64);
    if (F.tid == 0) {
        int nj = 0, item = 0;
        auto add = [&](const float* src, bf16_t* dst, int ldw, int ldt, int Ks, int Ns, int mode, int nb, long sbs, long dbs, int esz = 2) {
            LAS TJob& j = jobs[nj]; j.src = src; j.dst = (unsigned char*)dst; j.sbs = sbs; j.dbs = dbs; j.ldw = ldw; j.ldt = ldt; j.nkb = Ks / 64; j.nnb = Ns / 32; j.mode = mode; j.item0 = item; j.per = (Ks / 64) * (Ns / 32); j.esz = esz;
            ++nj; item += (Ks / 64) * (Ns / 32) * nb; };
        add(A.in[I_AWQKV], WSP(bf16_t, WS_WQK), 1536, 1024, 1024, 1280, 1, 2, 1024L * 1536, 1280L * 1024, 1);
        add(A.in[I_AWQKV] + 1280, WSP(bf16_t, WS_WV), 1536, 1024, 1024, 256, 0, 2, 1024L * 1536, 256L * 1024, 1);
        add(A.in[I_AWO], WSP(bf16_t, WS_WO), 1024, 1024, 1024, 1024, 0, 2, 1L << 20, 1L << 20, 1);
        add(A.in[I_PW], WSP(bf16_t, WS_POOLW), 256, 256, 256, 256, 0, 4, 65536, 65536);
        add(A.in[I_RWRKV], WSP(bf16_t, WS_WRKV), 1024, 1024, 1024, 1024, 0, 3, 1L << 20, 1L << 20, 1);
        add(A.in[I_RG1], WSP(bf16_t, WS_WL1), 128, 1024, 1024, 128, 0, 1, 0, 0);
        add(A.in[I_RW1], WSP(bf16_t, WS_WL1) + 256 * 1024, 64, 1024, 1024, 64, 0, 2, 65536, 65536);
        add(A.in[I_RA1], WSP(bf16_t, WS_WL1) + 2 * 256 * 1024, 64, 1024, 1024, 64, 0, 2, 65536, 65536);
        add(A.in[I_RG2], WSP(bf16_t, WS_WL2), 1024, 256, 128, 1024, 0, 1, 0, 0);
        add(A.in[I_RW2], WSP(bf16_t, WS_WL2) + 1 * 1024 * 256, 1024, 256, 64, 1024, 0, 2, 65536, 1024L * 256 + 64);
        add(A.in[I_RA2], WSP(bf16_t, WS_WL2) + 3 * 1024 * 256, 1024, 256, 64, 1024, 0, 2, 65536, 1024L * 256 + 64);
        add(A.in[I_RWO], WSP(bf16_t, WS_WOR), 1024, 1024, 1024, 1024, 0, 1, 0, 0, 1);
        add(A.in[I_MW1], WSP(bf16_t, WS_W1T), 2048, 1024, 1024, 2048, 2, 128, 1024L * 2048, 2048L * 1024, 1);
        add(A.in[I_MW2], WSP(bf16_t, WS_W2T), 1024, 1024, 1024, 1024, 0, 128, 1L << 20, 1L << 20, 1);
        njobs[0] = nj; njobs[1] = item;
    }
    __syncthreads();
    { const int nj = njobs[0], nitems = njobs[1]; LAS float* scr = (LAS float*)(F.lds + F.wave * 16384);
      const int gw = F.c * NWAVES + F.wave, NGW = F.G * NWAVES;
      int it = gw;
      if (it < nitems) {
          TItem Tc, Tn; f32x4 vc[8], vn[8];
          titem_decode(jobs, nj, it, Tc); titem_load(Tc, F.lane, vc);
          for (;;) {
              const int itn = it + NGW; const bool more = itn < nitems;
              if (more) { titem_decode(jobs, nj, itn, Tn); titem_load(Tn, F.lane, vn); }
              titem_store(Tc, F.lane, vc, scr);
              if (!more) break;
              Tc = Tn;
#pragma unroll
              for (int i = 0; i < 8; ++i) vc[i] = vn[i];
              it = itn;
          }
      } }
    __syncthreads();
}

__device__ __forceinline__ void moe_tiles(Frame& F, int layer) {
    REFRESH(F);
    LAS int* lcnt = (LAS int*)(F.lds + LCNT_OFF); LAS int* tpre = (LAS int*)(F.lds + TPRE_OFF);
    __syncthreads();
    if (F.tid < NE) lcnt[F.tid] = (int)__hip_atomic_load(F.ctl + CW_GCNT + layer * 64 + F.tid, __ATOMIC_RELAXED, __HIP_MEMORY_SCOPE_AGENT);
    __syncthreads();
    if (F.tid == 0) { int s = 0; for (int e = 0; e < NE; ++e) { tpre[e] = s; s += (lcnt[e] + 255) >> 8; } tpre[NE] = s; }
    __syncthreads();
    { LAS unsigned char* texp = (LAS unsigned char*)(F.lds + TEXP_OFF); const int nrt = tpre[NE];
      for (int rt = F.tid; rt < nrt; rt += NTHREADS) { int e = 0; for (int j = 1; j < NE; ++j) e += (tpre[j] <= rt) ? 1 : 0; texp[rt] = (unsigned char)e; } }
    __syncthreads();
}
constexpr int RB = 2;
#define ROWOF(it, r) ((((it) * F.G + F.c) * NWAVES + F.wave) * RB + (r))
struct MoeRef { int p[4]; float g[4]; };
__device__ __forceinline__ void moe_ref_load(Frame& F, int row, MoeRef& R) {
    const int4 pp = *(const int4*)(WSP(int, WS_POS) + (size_t)row * 4); const f32x4 gg = *(const f32x4*)(WSP(float, WS_GATE) + (size_t)row * 4);
    R.p[0] = pp.x; R.p[1] = pp.y; R.p[2] = pp.z; R.p[3] = pp.w; R.g[0] = gg.x; R.g[1] = gg.y; R.g[2] = gg.z; R.g[3] = gg.w;
}
__device__ __forceinline__ void moe_rows_load(Frame& F, const MoeRef& R, unsigned (&y)[4][4]) {
    const LAS int* tpre = (const LAS int*)(F.lds + TPRE_OFF); const unsigned char* Y = WSP(unsigned char, WS_Y);
#pragma unroll
    for (int k = 0; k < 4; ++k) { const int e = R.p[k] >> 20, slot = R.p[k] & 0xfffff; const size_t fr = (size_t)tpre[e] * 256 + slot; const unsigned* yp = (const unsigned*)(Y + fr * D) + F.lane;
#pragma unroll
        for (int j = 0; j < 4; ++j) y[k][j] = yp[64 * j]; }
}
__device__ __forceinline__ f32x4 moe_rows_sum(const MoeRef& R, const unsigned (&y)[4][4], int j) {
    f32x4 s = (f32x4){0.f, 0.f, 0.f, 0.f};
#pragma unroll
    for (int k = 0; k < 4; ++k) { const int w = (int)y[k][j]; const f32x2 lo = __builtin_amdgcn_cvt_pk_f32_fp8(w, false), hi = __builtin_amdgcn_cvt_pk_f32_fp8(w, true);
        s += (R.g[k] * 0.25f) * (f32x4){lo.x, lo.y, hi.x, hi.y}; }
    return s;
}

__device__ __forceinline__ void phase_norm1(Frame& F, const Args& A, int layer) {
    REFRESH(F);
    if (layer > 0) moe_tiles(F, layer - 1);
    bf16_t* H = WSP(bf16_t, WS_H); bf16_t* AX = WSP(bf16_t, WS_AX); const float* MOD = WSP(float, WS_MOD);
    const float* g1 = A.in[I_NORMG] + (size_t)(layer * 2 + 0) * D;
    f32x4 gg[4];
#pragma unroll
    for (int j = 0; j < 4; ++j) gg[j] = ((const f32x4*)g1)[64 * j + F.lane];
    for (int it = 0;; ++it) { if (ROWOF(it, 0) >= NT) break;
        f32x4 v[RB][4]; int brow[RB];
        if (layer == 0) {
#pragma unroll
            for (int r = 0; r < RB; ++r) { const int row = ROWOF(it, r); brow[r] = row < NX ? (row >> 11) : 32; const float* src = row < NX ? A.in[I_X] + (size_t)row * D : A.in[I_CTX] + (size_t)(row - NX) * D;
#pragma unroll
                for (int j = 0; j < 4; ++j) v[r][j] = ((const f32x4*)src)[64 * j + F.lane]; }
        } else {
            MoeRef R[RB]; unsigned y[RB][4][4]; f32x4 gv[RB][4];
#pragma unroll
            for (int r = 0; r < RB; ++r) moe_ref_load(F, ROWOF(it, r), R[r]);
#pragma unroll
            for (int r = 0; r < RB; ++r) { const int row = ROWOF(it, r); brow[r] = row < NX ? (row >> 11) : 32; moe_rows_load(F, R[r], y[r]);
                const float* g2p = MOD + ((size_t)(layer - 1) * 33 + brow[r]) * 6144 + 5 * D;
#pragma unroll
                for (int j = 0; j < 4; ++j) { v[r][j] = ld_bf4(H + (size_t)row * D + 256 * j + 4 * F.lane); gv[r][j] = ((const f32x4*)g2p)[64 * j + F.lane]; } }
#pragma unroll
            for (int r = 0; r < RB; ++r)
#pragma unroll
                for (int j = 0; j < 4; ++j) v[r][j] = v[r][j] + gv[r][j] * moe_rows_sum(R[r], y[r], j);
        }
        float rstd[RB];
#pragma unroll
        for (int r = 0; r < RB; ++r) { const int row = ROWOF(it, r); float ss = 0.f;
#pragma unroll
            for (int j = 0; j < 4; ++j) { st_bf4(H + (size_t)row * D + 256 * j + 4 * F.lane, v[r][j]); ss += (v[r][j].x * v[r][j].x + v[r][j].y * v[r][j].y) + (v[r][j].z * v[r][j].z + v[r][j].w * v[r][j].w); }
            rstd[r] = 1.0f / sqrtf(wave_sum(ss) * (1.0f / D) + 1e-5f); }
#pragma unroll
        for (int r = 0; r < RB; ++r) { const int row = ROWOF(it, r); const float* mp = MOD + ((size_t)layer * 33 + brow[r]) * 6144;
#pragma unroll
            for (int j = 0; j < 4; ++j) { const f32x4 sh = ((const f32x4*)mp)[64 * j + F.lane], sc = ((const f32x4*)(mp + D))[64 * j + F.lane];
                const f32x4 o = v[r][j] * rstd[r] * gg[j] * (sc + 1.0f) + sh;
                if (layer % 3 == 0) ((unsigned*)((unsigned char*)AX + (size_t)row * D))[64 * j + F.lane] = pk4_fp8(o.x, o.y, o.z, o.w);
                else { u32x2 w; w.x = pk2(o.x, o.y); w.y = pk2(o.z, o.w); ((u32x2*)(AX + (size_t)row * D))[64 * j + F.lane] = w; } } }
    }
}
__device__ __forceinline__ void phase_final(Frame& F, const Args& A) {
    REFRESH(F);
    moe_tiles(F, DEPTH - 1);
    const bf16_t* H = WSP(bf16_t, WS_H); const float* MOD = WSP(float, WS_MOD); const float* fg = A.in[I_FG];
    f32x4 gg[4];
#pragma unroll
    for (int j = 0; j < 4; ++j) gg[j] = ((const f32x4*)fg)[64 * j + F.lane];
    for (int it = 0;; ++it) { if (ROWOF(it, 0) >= NX) break;
        MoeRef R[RB]; unsigned y[RB][4][4]; f32x4 v[RB][4], gv[RB][4];
#pragma unroll
        for (int r = 0; r < RB; ++r) moe_ref_load(F, ROWOF(it, r), R[r]);
#pragma unroll
        for (int r = 0; r < RB; ++r) { const int row = ROWOF(it, r); moe_rows_load(F, R[r], y[r]); const float* g2p = MOD + ((size_t)(DEPTH - 1) * 33 + (row >> 11)) * 6144 + 5 * D;
#pragma unroll
            for (int j = 0; j < 4; ++j) { v[r][j] = ld_bf4(H + (size_t)row * D + 256 * j + 4 * F.lane); gv[r][j] = ((const f32x4*)g2p)[64 * j + F.lane]; } }
#pragma unroll
        for (int r = 0; r < RB; ++r) { const int row = ROWOF(it, r); float ss = 0.f;
#pragma unroll
            for (int j = 0; j < 4; ++j) { v[r][j] = v[r][j] + gv[r][j] * moe_rows_sum(R[r], y[r], j); ss += (v[r][j].x * v[r][j].x + v[r][j].y * v[r][j].y) + (v[r][j].z * v[r][j].z + v[r][j].w * v[r][j].w); }
            const float rstd = 1.0f / sqrtf(wave_sum(ss) * (1.0f / D) + 1e-5f);
#pragma unroll
            for (int j = 0; j < 4; ++j) ((f32x4*)(A.out + (size_t)row * D))[64 * j + F.lane] = v[r][j] * rstd * gg[j]; }
    }
}

template <int DD> __device__ __forceinline__ float dpp_ror(float v) { return __builtin_bit_cast(float, __builtin_amdgcn_update_dpp(0, __builtin_bit_cast(int, v), 0x120 + DD, 0xf, 0xf, false)); }
template <int DD> __device__ __forceinline__ void rank_step(float v0, float v1, int e0, int& r0, int& r1) {
    const float u0 = dpp_ror<DD>(v0), u1 = dpp_ror<DD>(v1); const bool low = DD <= e0;
    r0 += (u0 > v0 || (u0 == v0 && low)) ? 1 : 0; r0 += (u1 > v0) ? 1 : 0;
    r1 += (u0 >= v1) ? 1 : 0; r1 += (u1 > v1 || (u1 == v1 && low)) ? 1 : 0;
}
__device__ __forceinline__ float row_allmax(float v) { v = fmaxf(v, dpp_ror<8>(v)); v = fmaxf(v, dpp_ror<4>(v)); v = fmaxf(v, dpp_ror<2>(v)); v = fmaxf(v, dpp_ror<1>(v)); return v; }
__device__ __forceinline__ float row_allsum(float v) { v += dpp_ror<8>(v); v += dpp_ror<4>(v); v += dpp_ror<2>(v); v += dpp_ror<1>(v); return v; }
__device__ __forceinline__ void phase_route(Frame& F, const Args& A, int layer) {
    REFRESH(F);
    const int nrows = (layer == DEPTH - 1) ? NX : NT; const int TPB = nrows / 16 / F.G;
    LAS float* wT = (LAS float*)F.lds;
    LAS int* lcnt = (LAS int*)(F.lds + LCNT_OFF); LAS int* lbase = (LAS int*)(F.lds + LBASE_OFF);
    LAS unsigned* recp = (LAS unsigned*)(F.lds + REC_OFF); LAS float* recg = (LAS float*)(F.lds + REC_OFF + 4608);
    __syncthreads();
    { const float* wr = A.in[I_MWR] + (size_t)layer * D * NE;
      for (int idx = F.tid; idx < D * NE; idx += NTHREADS) wT[(idx & 31) * 1024 + (idx >> 5)] = wr[idx]; }
    if (F.tid < NE) lcnt[F.tid] = 0;
    __syncthreads();
    const bf16_t* H = WSP(bf16_t, WS_H); unsigned char* FX = WSP(unsigned char, WS_FX); const float* MOD = WSP(float, WS_MOD);
    const float* g2 = A.in[I_NORMG] + (size_t)(layer * 2 + 1) * D; const float* br = A.in[I_MBR] + layer * NE;
    const int l = F.lane, r16 = l & 15, q4 = l >> 4; const float b0 = br[r16], b1 = br[16 + r16];
    for (int k = F.wave; k < TPB; k += NWAVES) {
        const int row0 = (F.c * TPB + k) * 16, row = row0 + r16; const int brow = row0 < NX ? (row0 >> 11) : 32;
        const float* mp = MOD + ((size_t)layer * 33 + brow) * 6144 + 3 * D;
        const bf16_t* hp = H + (size_t)row * D + 8 * q4; float ss = 0.f;
#pragma unroll 8
        for (int j = 0; j < 32; ++j) { const u32x4 w = *(const u32x4*)(hp + 32 * j); const float a0 = bflo(w.x), a1 = bfhi(w.x), a2 = bflo(w.y), a3 = bfhi(w.y), a4 = bflo(w.z), a5 = bfhi(w.z), a6 = bflo(w.w), a7 = bfhi(w.w);
            ss += ((a0 * a0 + a1 * a1) + (a2 * a2 + a3 * a3)) + ((a4 * a4 + a5 * a5) + (a6 * a6 + a7 * a7)); }
        ss += __shfl_xor(ss, 16); ss += __shfl_xor(ss, 32);
        const float rstd = 1.0f / sqrtf(ss * (1.0f / D) + 1e-5f);
        f32x4 acc0 = (f32x4){0.f, 0.f, 0.f, 0.f}, acc1 = acc0;
        const float* gp = g2 + 8 * q4; const float* shp = mp + 8 * q4; const float* scp = mp + D + 8 * q4; unsigned char* fxp = FX + (size_t)row * D + 8 * q4;
        const LAS float* w0p = wT + r16 * 1024 + 8 * q4; const LAS float* w1p = wT + (16 + r16) * 1024 + 8 * q4;
#pragma unroll 2
        for (int j = 0; j < 32; ++j) { const u32x4 w = *(const u32x4*)(hp + 32 * j);
            const f32x4 ga = *(const f32x4*)(gp + 32 * j), gb = *(const f32x4*)(gp + 32 * j + 4), sa = *(const f32x4*)(shp + 32 * j), sb = *(const f32x4*)(shp + 32 * j + 4), ca = *(const f32x4*)(scp + 32 * j), cb = *(const f32x4*)(scp + 32 * j + 4);
            const f32x4 fa = (f32x4){bflo(w.x), bfhi(w.x), bflo(w.y), bfhi(w.y)} * rstd * ga * (ca + 1.0f) + sa, fb = (f32x4){bflo(w.z), bfhi(w.z), bflo(w.w), bfhi(w.w)} * rstd * gb * (cb + 1.0f) + sb;
            *(u32x2*)(fxp + 32 * j) = (u32x2){pk4_fp8(fa.x, fa.y, fa.z, fa.w), pk4_fp8(fb.x, fb.y, fb.z, fb.w)};
            const f32x4 w0a = *(const LAS f32x4*)(w0p + 32 * j), w0b = *(const LAS f32x4*)(w0p + 32 * j + 4), w1a = *(const LAS f32x4*)(w1p + 32 * j), w1b = *(const LAS f32x4*)(w1p + 32 * j + 4);
#pragma unroll
            for (int s4 = 0; s4 < 4; ++s4) { acc0 = __builtin_amdgcn_mfma_f32_16x16x4f32(fa[s4], w0a[s4], acc0, 0, 0, 0); acc1 = __builtin_amdgcn_mfma_f32_16x16x4f32(fa[s4], w1a[s4], acc1, 0, 0, 0); }
#pragma unroll
            for (int s4 = 0; s4 < 4; ++s4) { acc0 = __builtin_amdgcn_mfma_f32_16x16x4f32(fb[s4], w0b[s4], acc0, 0, 0, 0); acc1 = __builtin_amdgcn_mfma_f32_16x16x4f32(fb[s4], w1b[s4], acc1, 0, 0, 0); } }
#pragma unroll
        for (int reg = 0; reg < 4; ++reg) {
            const float v0 = acc0[reg] + b0, v1 = acc1[reg] + b1; int r0 = (v1 > v0) ? 1 : 0, r1 = (v0 >= v1) ? 1 : 0;
            rank_step<1>(v0, v1, r16, r0, r1); rank_step<2>(v0, v1, r16, r0, r1); rank_step<3>(v0, v1, r16, r0, r1); rank_step<4>(v0, v1, r16, r0, r1); rank_step<5>(v0, v1, r16, r0, r1);
            rank_step<6>(v0, v1, r16, r0, r1); rank_step<7>(v0, v1, r16, r0, r1); rank_step<8>(v0, v1, r16, r0, r1); rank_step<9>(v0, v1, r16, r0, r1); rank_step<10>(v0, v1, r16, r0, r1);
            rank_step<11>(v0, v1, r16, r0, r1); rank_step<12>(v0, v1, r16, r0, r1); rank_step<13>(v0, v1, r16, r0, r1); rank_step<14>(v0, v1, r16, r0, r1); rank_step<15>(v0, v1, r16, r0, r1);
            const float mx = row_allmax(fmaxf(v0, v1));
            const float x0 = r0 < 4 ? __expf(v0 - mx) : 0.f, x1 = r1 < 4 ? __expf(v1 - mx) : 0.f;
            const float inv = 1.0f / row_allsum(x0 + x1);
            const int lr = k * 16 + 4 * q4 + reg;
            if (r0 < 4) { const int rk = __hip_atomic_fetch_add(lcnt + r16, 1, __ATOMIC_RELAXED, __HIP_MEMORY_SCOPE_WORKGROUP); recp[lr * 4 + r0] = ((unsigned)r16 << 20) | (unsigned)rk; recg[lr * 4 + r0] = x0 * inv; }
            if (r1 < 4) { const int rk = __hip_atomic_fetch_add(lcnt + 16 + r16, 1, __ATOMIC_RELAXED, __HIP_MEMORY_SCOPE_WORKGROUP); recp[lr * 4 + r1] = ((unsigned)(16 + r16) << 20) | (unsigned)rk; recg[lr * 4 + r1] = x1 * inv; }
        }
    }
    __syncthreads();
    if (F.tid < NE) lbase[F.tid] = (int)__hip_atomic_fetch_add(F.ctl + CW_GCNT + layer * 64 + F.tid, (unsigned)lcnt[F.tid], __ATOMIC_RELAXED, __HIP_MEMORY_SCOPE_AGENT);
    __syncthreads();
    int* LIST = WSP(int, WS_LIST); int* POS = WSP(int, WS_POS); float* GATE = WSP(float, WS_GATE);
    for (int r = F.tid; r < TPB * 16 * 4; r += NTHREADS) { const int lr = r >> 2, kk = r & 3; const int row = F.c * TPB * 16 + lr;
        const unsigned qx = recp[r]; const float qg = recg[r]; const int e = qx >> 20, slot = lbase[e] + (int)(qx & 0xfffff);
        LIST[(size_t)e * NT + slot] = row; POS[(size_t)row * 4 + kk] = (e << 20) | slot; GATE[(size_t)row * 4 + kk] = qg; }
    __syncthreads();
}

__device__ __forceinline__ void phase_pooldiff(Frame& F) {
    REFRESH(F);
    const bf16_t* AX = WSP(bf16_t, WS_AX); bf16_t* PD = WSP(bf16_t, WS_PD);
    for (int it = 0;; ++it) { if (ROWOF(it, 0) >= NT) break;
        const int row0 = ROWOF(it, 0); int sb, t, n; seq_of(row0, sb, t, n);
#pragma unroll
        for (int j = 0; j < 4; ++j) { const int half = 1 << j; const int col = 256 * j + 4 * F.lane;
            f32x4 s0 = (f32x4){0.f, 0.f, 0.f, 0.f}, s1 = s0, me0 = s0, me1 = s0;
#pragma unroll
            for (int q = 0; q < 2 * half + 1; ++q) { const int uu = t - half + q;
                if (uu >= 0 && uu < n) { const f32x4 x = ld_bf4(AX + (size_t)(sb + uu) * D + col); if (q < 2 * half) s0 += x; if (q > 0) s1 += x; if (q == half) me0 = x; if (q == half + 1) me1 = x; } }
            const int lo0 = t - half < 0 ? 0 : t - half, hi0 = t + half > n ? n : t + half, lo1 = t + 1 - half < 0 ? 0 : t + 1 - half, hi1 = t + 1 + half > n ? n : t + 1 + half;
            st_bf4(PD + (size_t)row0 * D + col, s0 * (1.0f / (float)(hi0 - lo0)) - me0);
            st_bf4(PD + (size_t)(row0 + 1) * D + col, s1 * (1.0f / (float)(hi1 - lo1)) - me1); }
    }
}
__device__ __forceinline__ void phase_rwkv_mix(Frame& F, const Args& A) {
    REFRESH(F);
    const bf16_t* AX = WSP(bf16_t, WS_AX); bf16_t* A6 = WSP(bf16_t, WS_A6); const float* mix = A.in[I_RMIX];
    for (int it = 0;; ++it) { if (ROWOF(it, 0) >= NT) break;
        const int row0 = ROWOF(it, 0); int sb, t, n; seq_of(row0, sb, t, n);
#pragma unroll
        for (int j = 0; j < 4; ++j) { const int col = 256 * j + 4 * F.lane; const f32x4 z = (f32x4){0.f, 0.f, 0.f, 0.f};
            const f32x4 h0 = ld_bf4(AX + (size_t)row0 * D + col), h1 = ld_bf4(AX + (size_t)(row0 + 1) * D + col);
            const f32x4 hp = t > 0 ? ld_bf4(AX + (size_t)(row0 - 1) * D + col) : z, hn = t + 1 < n - 1 ? ld_bf4(AX + (size_t)(row0 + 2) * D + col) : z;
            const f32x4 xx0 = (hp + h1) * 0.5f - h0, xx1 = (h0 + hn) * 0.5f - h1;
#pragma unroll
            for (int i = 0; i < 6; ++i) { const f32x4 m = *(const f32x4*)(mix + i * D + col); const f32x4 o0 = h0 + xx0 * m, o1 = h1 + xx1 * m;
                if (i == 0 || i == 2 || i == 3) { unsigned char* p8 = (unsigned char*)(A6 + (size_t)i * NT * D);
                    *(unsigned*)(p8 + (size_t)row0 * D + col) = pk4_fp8(o0.x, o0.y, o0.z, o0.w); *(unsigned*)(p8 + (size_t)(row0 + 1) * D + col) = pk4_fp8(o1.x, o1.y, o1.z, o1.w); }
                else { st_bf4(A6 + ((size_t)i * NT + row0) * D + col, o0); st_bf4(A6 + ((size_t)i * NT + row0 + 1) * D + col, o1); } } }
    }
}
__device__ __forceinline__ float rl(float x, int k) { return __builtin_bit_cast(float, __builtin_amdgcn_readlane(__builtin_bit_cast(int, x), k)); }
typedef float f32x16 __attribute__((ext_vector_type(16)));
constexpr int SCW = 33792;
__device__ __forceinline__ int kpos(int k) { return (k & ~12) | ((k & 4) << 1) | ((k & 8) >> 1); }
__device__ __forceinline__ bf16x8 acc_frag(const f32x16& X, int s2) {
    u32x4 w; w.x = cvt_pk_bf16(X[8 * s2 + 0], X[8 * s2 + 1]); w.y = cvt_pk_bf16(X[8 * s2 + 2], X[8 * s2 + 3]); w.z = cvt_pk_bf16(X[8 * s2 + 4], X[8 * s2 + 5]); w.w = cvt_pk_bf16(X[8 * s2 + 6], X[8 * s2 + 7]);
    return __builtin_bit_cast(bf16x8, w);
}
#define MFMA32(a, b, c) __builtin_amdgcn_mfma_f32_32x32x16_bf16(a, b, c, 0, 0, 0)
__device__ __forceinline__ void phase_rwkv_scan(Frame& F, const Args& A) {
    REFRESH(F);
    __syncthreads();
    const int pr = F.wave >> 1, hw = F.wave & 1;
    for (int item = pr * F.G + F.c; item < 1024; item += 4 * F.G) {
        const int dir = item >> 9, b = (item >> 4) & 31, hd = item & 15, col = 64 * hd + F.lane;
        const int l = F.lane, r32 = l & 31, hh = l >> 5;
        const bf16_t* Rr = WSP(bf16_t, WS_RKV); const bf16_t* Kk = Rr + (size_t)NT * D; const bf16_t* Vv = Kk + (size_t)NT * D;
        const bf16_t* Ee = WSP(bf16_t, WS_E) + (size_t)dir * NT * D; const bf16_t* Aa = WSP(bf16_t, WS_A) + (size_t)dir * NT * D;
        bf16_t* Yo = WSP(bf16_t, WS_YS) + (size_t)dir * NT * D; float* Bo = WSP(float, WS_BONUS) + (size_t)dir * NT * 16;
        const float kkw = A.in[I_RKK][col], kaw = A.in[I_RKA][col], rkw = A.in[I_RRK][col];
        LAS unsigned char* RA = F.lds + pr * SCW; LAS unsigned char* RB = RA + 16384; LAS unsigned char* RV = RA + 25600;
        LAS float* cCb = (LAS float*)(F.lds + REC_OFF + pr * 256);
        LAS bf16_t* XT = (LAS bf16_t*)RA;
        LAS bf16_t* BK = (LAS bf16_t*)(RA + 8192);
        const int kp = kpos(l), vb = hw;
        f32x16 ST[2];
#pragma unroll
        for (int i = 0; i < 2; ++i)
#pragma unroll
            for (int q = 0; q < 16; ++q) ST[i][q] = 0.f;
        for (int seg = 0; seg < 2; ++seg) {
            const int base = seg ? b * T : NX + b * L, n = seg ? T : L; const int dt = dir ? -1 : 1; const int t0 = dir ? n - 1 : 0;
            for (int bt = 0; bt < n; bt += 32) {
                float cprev = 1.0f;
                if (hw) {
                    bf16_t e16[16];
#pragma unroll
                    for (int s = 0; s < 16; ++s) e16[s] = Ee[(size_t)(base + t0 + dt * (bt + s)) * D + col];
                    float es = 0.f;
#pragma unroll
                    for (int s = 0; s < 16; ++s) es += bf1(e16[s]);
                    cprev = __expf(-es); }
#pragma unroll
                for (int g4i = 0; g4i < 4; ++g4i) { const int g8 = 4 * hw + g4i;
                    bf16_t raw[4][5];
#pragma unroll
                    for (int s8 = 0; s8 < 4; ++s8) { const size_t o = (size_t)(base + t0 + dt * (bt + g8 * 4 + s8)) * D + col; raw[s8][0] = Rr[o]; raw[s8][1] = Kk[o]; raw[s8][2] = Vv[o]; raw[s8][3] = Aa[o]; raw[s8][4] = Ee[o]; }
                    float rr[4], kraw[4], aa[4], kk[4], kd[4], n2[4], bn[4], ww[4]; unsigned bq2[2] = {0u, 0u}, kq2[2] = {0u, 0u};
#pragma unroll
                    for (int s8 = 0; s8 < 4; ++s8) { rr[s8] = bf1(raw[s8][0]); kraw[s8] = bf1(raw[s8][1]); aa[s8] = bf1(raw[s8][3]); ww[s8] = __expf(-bf1(raw[s8][4]));
                        kk[s8] = kraw[s8] * kkw; n2[s8] = kk[s8] * kk[s8]; kd[s8] = kraw[s8] * (1.0f + (aa[s8] - 1.0f) * kaw); bn[s8] = rr[s8] * kd[s8] * rkw; }
#pragma unroll
                    for (int s8 = 0; s8 < 4; ++s8) { n2[s8] = wave_sum(n2[s8]); bn[s8] = wave_sum(bn[s8]); }
#pragma unroll
                    for (int s8 = 0; s8 < 4; ++s8) { const int t = g8 * 4 + s8;
                        if (l == 0) Bo[(size_t)(base + t0 + dt * (bt + t)) * 16 + hd] = bn[s8];
                        const float kn = kk[s8] * __builtin_amdgcn_rsqf(fmaxf(n2[s8], 1e-24f)); const float c = cprev * ww[s8]; const float ic = __builtin_amdgcn_rcpf(c);
                        const float at = -kn * cprev, rt = rr[s8] * c, bq = kn * aa[s8] * ic, kq = kd[s8] * ic;
                        const unsigned w0 = cvt_pk_bf16(at, rt), w1 = cvt_pk_bf16(bq, kq);
                        XT[t * 64 + kp] = (bf16_t)(w0 & 0xffffu); XT[(32 + t) * 64 + kp] = (bf16_t)(w0 >> 16);
                        BK[t * 64 + kp] = (bf16_t)(w1 & 0xffffu); BK[(32 + t) * 64 + kp] = (bf16_t)(w1 >> 16);
                        if (s8 & 1) { bq2[s8 >> 1] |= (w1 & 0xffffu) << 16; kq2[s8 >> 1] |= (w1 & 0xffff0000u); } else { bq2[s8 >> 1] = w1 & 0xffffu; kq2[s8 >> 1] = w1 >> 16; }
                        cprev = c; }
                    const int gp = (g8 & ~3) | ((g8 & 1) << 1) | ((g8 & 2) >> 1);
                    *(LAS u32x2*)(RB + l * 144 + gp * 8) = (u32x2){bq2[0], bq2[1]}; *(LAS u32x2*)(RB + l * 144 + 64 + gp * 8) = (u32x2){kq2[0], kq2[1]};
                    *(LAS u32x2*)(RV + l * 80 + gp * 8) = (u32x2){(unsigned)raw[0][2] | ((unsigned)raw[1][2] << 16), (unsigned)raw[2][2] | ((unsigned)raw[3][2] << 16)};
                }
                if (hw) cCb[l] = cprev;
                __syncthreads();
                f32x16 Mp, Np, X;
                { bf16x8 XTf[4], BKf[2][4];
#pragma unroll
                  for (int s4 = 0; s4 < 4; ++s4) { XTf[s4] = *(const LAS bf16x8*)(XT + r32 * 64 + 16 * s4 + 8 * hh); BKf[0][s4] = *(const LAS bf16x8*)(BK + r32 * 64 + 16 * s4 + 8 * hh); BKf[1][s4] = *(const LAS bf16x8*)(BK + (32 + r32) * 64 + 16 * s4 + 8 * hh); }
                  bf16x8 MkaF[2];
                  { f32x16 Tm;
#pragma unroll
                    for (int q = 0; q < 16; ++q) Tm[q] = 0.f;
#pragma unroll
                    for (int s4 = 0; s4 < 4; ++s4) Tm = MFMA32(BKf[1][s4], XTf[s4], Tm);
#pragma unroll
                    for (int q = 0; q < 16; ++q) { const int row = (q & 3) + 8 * (q >> 2) + 4 * hh; Tm[q] = row < r32 ? Tm[q] : 0.f; }
                    MkaF[0] = acc_frag(Tm, 0); MkaF[1] = acc_frag(Tm, 1); }
#pragma unroll
                  for (int q = 0; q < 16; ++q) { Mp[q] = 0.f; Np[q] = 0.f; X[q] = 0.f; }
#pragma unroll
                  for (int s4 = 0; s4 < 4; ++s4) { Mp = MFMA32(BKf[0][s4], XTf[s4], Mp); Np = MFMA32(XTf[s4], BKf[0][s4], Np); }
#pragma unroll
                  for (int q = 0; q < 16; ++q) { const int row = (q & 3) + 8 * (q >> 2) + 4 * hh; Mp[q] = row < r32 ? Mp[q] : 0.f; Np[q] = r32 < row ? Np[q] : 0.f; }
#pragma unroll
                  for (int kb = 0; kb < 2; ++kb)
#pragma unroll
                      for (int s2 = 0; s2 < 2; ++s2) X = MFMA32(XTf[2 * kb + s2], acc_frag(ST[kb], s2), X);
#pragma unroll
                  for (int s2 = 0; s2 < 2; ++s2) { const bf16x8 Vf = *(const LAS bf16x8*)(RV + (32 * vb + r32) * 80 + (16 * s2 + 8 * hh) * 2); X = MFMA32(MkaF[s2], Vf, X); } }
                __builtin_amdgcn_sched_barrier(0);
#pragma unroll
                for (int lvl = 0; lvl < 5; ++lvl) {
                    bf16x8 Ma[2], Na[2];
#pragma unroll
                    for (int s2 = 0; s2 < 2; ++s2) { Ma[s2] = acc_frag(Mp, s2); Na[s2] = acc_frag(Np, s2); }
                    { const bf16x8 x0 = acc_frag(X, 0), x1 = acc_frag(X, 1); X = MFMA32(Ma[0], x0, X); X = MFMA32(Ma[1], x1, X); }
                    if (lvl < 4) { f32x16 M2, N2;
#pragma unroll
                        for (int q = 0; q < 16; ++q) { M2[q] = 0.f; N2[q] = 0.f; }
                        M2 = MFMA32(Na[0], Ma[0], M2); M2 = MFMA32(Na[1], Ma[1], M2);
                        N2 = MFMA32(Ma[0], Na[0], N2); N2 = MFMA32(Ma[1], Na[1], N2);
                        Mp = M2; Np = N2; }
                }
                __builtin_amdgcn_sched_barrier(0);
                { bf16x8 XRf[4], MbrF[2], MkrF[2];
#pragma unroll
                  for (int s4 = 0; s4 < 4; ++s4) XRf[s4] = *(const LAS bf16x8*)(XT + (32 + r32) * 64 + 16 * s4 + 8 * hh);
                  { f32x16 Tm, Tn;
#pragma unroll
                    for (int q = 0; q < 16; ++q) { Tm[q] = 0.f; Tn[q] = 0.f; }
#pragma unroll
                    for (int s4 = 0; s4 < 4; ++s4) { const bf16x8 Bb = *(const LAS bf16x8*)(BK + r32 * 64 + 16 * s4 + 8 * hh), Bk = *(const LAS bf16x8*)(BK + (32 + r32) * 64 + 16 * s4 + 8 * hh);
                        Tm = MFMA32(Bb, XRf[s4], Tm); Tn = MFMA32(Bk, XRf[s4], Tn); }
#pragma unroll
                    for (int q = 0; q < 16; ++q) { const int row = (q & 3) + 8 * (q >> 2) + 4 * hh; Tm[q] = row <= r32 ? Tm[q] : 0.f; Tn[q] = row <= r32 ? Tn[q] : 0.f; }
                    MbrF[0] = acc_frag(Tm, 0); MbrF[1] = acc_frag(Tm, 1); MkrF[0] = acc_frag(Tn, 0); MkrF[1] = acc_frag(Tn, 1); }
                  { const bf16x8 u0 = acc_frag(X, 0), u1 = acc_frag(X, 1);
                    const bf16x8 Vf0 = *(const LAS bf16x8*)(RV + (32 * vb + r32) * 80 + (8 * hh) * 2), Vf1 = *(const LAS bf16x8*)(RV + (32 * vb + r32) * 80 + (16 + 8 * hh) * 2);
                    f32x16 Yt;
#pragma unroll
                    for (int q = 0; q < 16; ++q) Yt[q] = 0.f;
#pragma unroll
                    for (int kb = 0; kb < 2; ++kb)
#pragma unroll
                        for (int s2 = 0; s2 < 2; ++s2) Yt = MFMA32(XRf[2 * kb + s2], acc_frag(ST[kb], s2), Yt);
                    Yt = MFMA32(MkrF[0], Vf0, Yt); Yt = MFMA32(MkrF[1], Vf1, Yt);
                    Yt = MFMA32(MbrF[0], u0, Yt); Yt = MFMA32(MbrF[1], u1, Yt);
#pragma unroll
                    for (int q = 0; q < 16; ++q) { const int t = (q & 3) + 8 * (q >> 2) + 4 * hh; Yo[(size_t)(base + t0 + dt * (bt + t)) * D + 64 * hd + 32 * vb + r32] = (bf16_t)f2bf(Yt[q]); }
#pragma unroll
                    for (int kb = 0; kb < 2; ++kb) {
                        const bf16x8 b0 = *(const LAS bf16x8*)(RB + (32 * kb + r32) * 144 + (8 * hh) * 2), b1 = *(const LAS bf16x8*)(RB + (32 * kb + r32) * 144 + (16 + 8 * hh) * 2);
                        const bf16x8 k0 = *(const LAS bf16x8*)(RB + (32 * kb + r32) * 144 + 64 + (8 * hh) * 2), k1 = *(const LAS bf16x8*)(RB + (32 * kb + r32) * 144 + 64 + (16 + 8 * hh) * 2);
                        ST[kb] = MFMA32(b0, u0, ST[kb]); ST[kb] = MFMA32(b1, u1, ST[kb]);
                        ST[kb] = MFMA32(k0, Vf0, ST[kb]); ST[kb] = MFMA32(k1, Vf1, ST[kb]); }
                  } }
                __builtin_amdgcn_sched_barrier(0);
#pragma unroll
                for (int kb = 0; kb < 2; ++kb)
#pragma unroll
                    for (int g4 = 0; g4 < 4; ++g4) { const f32x4 cc = *(const LAS f32x4*)(cCb + 32 * kb + 8 * g4 + 4 * hh);
                        ST[kb][4 * g4 + 0] *= cc.x; ST[kb][4 * g4 + 1] *= cc.y; ST[kb][4 * g4 + 2] *= cc.z; ST[kb][4 * g4 + 3] *= cc.w; }
                __syncthreads();
            }
        }
    }
    __syncthreads();
}
#undef MFMA32
__device__ __forceinline__ void phase_rwkv_out(Frame& F, const Args& A, int nrows) {
    REFRESH(F);
    const bf16_t* Y0 = WSP(bf16_t, WS_YS); const bf16_t* Y1 = Y0 + (size_t)NT * D; const float* B0 = WSP(float, WS_BONUS); const float* B1 = B0 + (size_t)NT * 16;
    const bf16_t* Vv = WSP(bf16_t, WS_RKV) + (size_t)2 * NT * D; const bf16_t* Gg = WSP(bf16_t, WS_G); bf16_t* RO = WSP(bf16_t, WS_RO);
    const float* lnw = A.in[I_RLNW]; const float* lnb = A.in[I_RLNB];
    for (int it = 0;; ++it) { if (ROWOF(it, 0) >= nrows) break;
        f32x4 y[RB][4], vv[RB][4], gg[RB][4]; float bon[RB][4];
#pragma unroll
        for (int r = 0; r < RB; ++r) { const int row = ROWOF(it, r);
#pragma unroll
            for (int j = 0; j < 4; ++j) { const int col = 256 * j + 4 * F.lane, head = 4 * j + (F.lane >> 4); const size_t o = (size_t)row * D + col;
                y[r][j] = ld_bf4(Y0 + o) + ld_bf4(Y1 + o); vv[r][j] = ld_bf4(Vv + o); gg[r][j] = ld_bf4(Gg + o); bon[r][j] = B0[(size_t)row * 16 + head] + B1[(size_t)row * 16 + head]; } }
#pragma unroll
        for (int r = 0; r < RB; ++r) { const int row = ROWOF(it, r);
#pragma unroll
            for (int j = 0; j < 4; ++j) { const int col = 256 * j + 4 * F.lane; const size_t o = (size_t)row * D + col; const f32x4 yy = y[r][j];
                const float s = row16_sum((yy.x + yy.y) + (yy.z + yy.w));
                const f32x4 d = yy - s * (1.0f / 64.0f);
                const float q = row16_sum((d.x * d.x + d.y * d.y) + (d.z * d.z + d.w * d.w));
                const float rs = 1.0f / sqrtf(q * (1.0f / 64.0f) + 64e-5f);
                const f32x4 yn = d * rs * *(const f32x4*)(lnw + col) + *(const f32x4*)(lnb + col);
                { const f32x4 ov = (yn + vv[r][j] * bon[r][j]) * gg[r][j]; *(unsigned*)((unsigned char*)RO + o) = pk4_fp8(ov.x, ov.y, ov.z, ov.w); } } }
    }
}

__device__ __forceinline__ void phase_attn(Frame& F, const Args& A, int j, bool need_ctx) {
    REFRESH(F);
    const bf16_t* Q = WSP(bf16_t, WS_Q); const bf16_t* Kb = WSP(bf16_t, WS_K); const bf16_t* VT = WSP(bf16_t, WS_VT); bf16_t* O = WSP(bf16_t, WS_O);
    const float* sinks = A.in[I_ASINK] + j * 16;
    LAS bf16_t* Ks = (LAS bf16_t*)F.lds; LAS bf16_t* Vs = (LAS bf16_t*)(F.lds + 9216);
    LAS bf16x8* Qs = (LAS bf16x8*)(F.lds + 18432 + F.wave * 8192) + F.lane;
    const int nunits = 2048 + (need_ctx ? 256 : 0);
    const int fr = F.lane & 15, fq = F.lane >> 4, g = F.wave >> 1, hf = F.wave & 1;
    const float SC = 0.125f * 1.4426950408889634f;
    const int lr = F.tid >> 3, lch = F.tid & 7;
    __syncthreads();
    for (int u = F.c; u < nunits; u += F.G) {
        int b, kvh, qb; bool isx;
        if (u < 2048) { isx = true; b = u >> 6; kvh = (u >> 4) & 3; qb = u & 15; } else { const int v = u - 2048; isx = false; b = v >> 3; kvh = (v >> 1) & 3; qb = v & 1; }
        const int qrow0 = (isx ? b * T : NX + b * L) + qb * 128 + hf * 64; const int head = 4 * kvh + g;
        int jlo = 0, jhi = -1;
        if (isx) { jlo = qb == 0 ? 2 : 0; jhi = qb == 15 ? 3 : 5; }
        const int ntiles = 4 + (jhi - jlo + 1);
        auto tile_row0 = [&](int ti) -> int { return ti < 4 ? NX + b * L + ti * 64 : b * T + qb * 128 - 128 + 64 * (jlo + ti - 4); };
        u32x4 kv_n, vv_n;
        { const int kr0 = tile_row0(0); kv_n = *(const u32x4*)(Kb + (size_t)(kr0 + lr) * 256 + kvh * 64 + lch * 8); vv_n = *(const u32x4*)(VT + (size_t)(kvh * 64 + lr) * NT + kr0 + lch * 8); }
#pragma unroll
        for (int mq = 0; mq < 4; ++mq)
#pragma unroll
            for (int ks = 0; ks < 2; ++ks) Qs[64 * (mq * 2 + ks)] = *(const bf16x8*)(Q + (size_t)(qrow0 + 16 * mq + fr) * D + head * 64 + ks * 32 + 8 * fq);
        const float sink2 = sinks[head] * 1.4426950408889634f;
        float mrun[4], lrun[4]; f32x4 Oa[4][4];
#pragma unroll
        for (int mq = 0; mq < 4; ++mq) { mrun[mq] = sink2; lrun[mq] = fq == 0 ? 1.0f : 0.0f;
#pragma unroll
            for (int db = 0; db < 4; ++db) Oa[mq][db] = (f32x4){0.f, 0.f, 0.f, 0.f}; }
        for (int ti = 0; ti < ntiles; ++ti) {
            const int jl = ti < 4 ? -1 : jlo + ti - 4; const int ks0 = qb * 128 - 128 + 64 * jl;
            __syncthreads();
            *(LAS u32x4*)(Ks + lr * 72 + lch * 8) = kv_n; *(LAS u32x4*)(Vs + lr * 72 + lch * 8) = vv_n;
            __syncthreads();
            if (ti + 1 < ntiles) { const int kr0 = tile_row0(ti + 1); kv_n = *(const u32x4*)(Kb + (size_t)(kr0 + lr) * 256 + kvh * 64 + lch * 8); vv_n = *(const u32x4*)(VT + (size_t)(kvh * 64 + lr) * NT + kr0 + lch * 8); }
            const bool need = (jl < 0) || (jl >= hf && jl <= hf + 4);
            if (need) {
                const bool domask = (jl >= 0) && (jl == hf || jl == hf + 4);
                f32x4 Sa[4][4];
#pragma unroll
                for (int mq = 0; mq < 4; ++mq)
#pragma unroll
                    for (int n = 0; n < 4; ++n) Sa[mq][n] = (f32x4){0.f, 0.f, 0.f, 0.f};
#pragma unroll
                for (int ks = 0; ks < 2; ++ks) {
                    bf16x8 Qf[4];
#pragma unroll
                    for (int mq = 0; mq < 4; ++mq) Qf[mq] = Qs[64 * (mq * 2 + ks)];
#pragma unroll
                    for (int n = 0; n < 4; ++n) { const int kr = 32 * (n >> 1) + 8 * (fr >> 2) + 4 * (n & 1) + (fr & 3);
                        const bf16x8 Kf = *(const LAS bf16x8*)(Ks + kr * 72 + ks * 32 + 8 * fq);
#pragma unroll
                        for (int mq = 0; mq < 4; ++mq) Sa[mq][n] = __builtin_amdgcn_mfma_f32_16x16x32_bf16(Kf, Qf[mq], Sa[mq][n], 0, 0, 0); } }
                bf16x8 Pf[4][2];
#pragma unroll
                for (int mq = 0; mq < 4; ++mq) {
                    float mx = -1e30f;
                    if (domask) { const int tq = qb * 128 + hf * 64 + 16 * mq + fr;
#pragma unroll
                        for (int n = 0; n < 4; ++n)
#pragma unroll
                            for (int i = 0; i < 4; ++i) { float sv = Sa[mq][n][i] * SC; const int rel = ks0 + 32 * (n >> 1) + 8 * fq + 4 * (n & 1) + i - tq; if (rel > 128 || rel < -128) sv = -1e30f; Sa[mq][n][i] = sv; mx = fmaxf(mx, sv); } }
                    else {
#pragma unroll
                        for (int n = 0; n < 4; ++n)
#pragma unroll
                            for (int i = 0; i < 4; ++i) { const float sv = Sa[mq][n][i] * SC; Sa[mq][n][i] = sv; mx = fmaxf(mx, sv); } }
                    mx = fmaxf(mx, __shfl_xor(mx, 16)); mx = fmaxf(mx, __shfl_xor(mx, 32));
                    const float mnew = fmaxf(mrun[mq], mx); const float alpha = __builtin_amdgcn_exp2f(mrun[mq] - mnew); mrun[mq] = mnew;
                    float rs = 0.f;
#pragma unroll
                    for (int n = 0; n < 4; ++n)
#pragma unroll
                        for (int i = 0; i < 4; ++i) { const float p = __builtin_amdgcn_exp2f(Sa[mq][n][i] - mnew); Sa[mq][n][i] = p; rs += p; }
                    lrun[mq] = lrun[mq] * alpha + rs;
#pragma unroll
                    for (int db = 0; db < 4; ++db) Oa[mq][db] *= alpha;
#pragma unroll
                    for (int s2 = 0; s2 < 2; ++s2) { u32x4 w; w.x = cvt_pk_bf16(Sa[mq][2 * s2][0], Sa[mq][2 * s2][1]); w.y = cvt_pk_bf16(Sa[mq][2 * s2][2], Sa[mq][2 * s2][3]);
                        w.z = cvt_pk_bf16(Sa[mq][2 * s2 + 1][0], Sa[mq][2 * s2 + 1][1]); w.w = cvt_pk_bf16(Sa[mq][2 * s2 + 1][2], Sa[mq][2 * s2 + 1][3]); Pf[mq][s2] = __builtin_bit_cast(bf16x8, w); }
                }
#pragma unroll
                for (int db = 0; db < 4; ++db)
#pragma unroll
                    for (int s2 = 0; s2 < 2; ++s2) { const bf16x8 Vf = *(const LAS bf16x8*)(Vs + (16 * db + fr) * 72 + 32 * s2 + 8 * fq);
#pragma unroll
                        for (int mq = 0; mq < 4; ++mq) Oa[mq][db] = __builtin_amdgcn_mfma_f32_16x16x32_bf16(Vf, Pf[mq][s2], Oa[mq][db], 0, 0, 0); }
            }
        }
#pragma unroll
        for (int mq = 0; mq < 4; ++mq) { float l = lrun[mq]; l += __shfl_xor(l, 16); l += __shfl_xor(l, 32); const float inv = 1.0f / l;
            unsigned char* op = (unsigned char*)O + (size_t)(qrow0 + 16 * mq + fr) * D + head * 64 + 4 * fq;
#pragma unroll
            for (int db = 0; db < 4; ++db) { const f32x4 o = Oa[mq][db] * inv; *(unsigned*)(op + 16 * db) = pk4_fp8(o.x, o.y, o.z, o.w); } }
    }
    __syncthreads();
}

struct KState { XcdBarrier bar; int ph; };
#define RUN() (A.one || A.phase == KS.ph)
#define SEAM() do { if (A.one) xcd_barrier(KS.bar); ++KS.ph; } while (0)
template <int LAYER>
__device__ __forceinline__ void layer_body(Frame& F, const Args& A, KState& KS) {
    constexpr int layer = LAYER, kind = LAYER % 3, j = LAYER / 3; constexpr bool last = (LAYER == DEPTH - 1);
    LAS unsigned char* ring = F.lds;
    const LAS int* tpre = (const LAS int*)(F.lds + TPRE_OFF); const LAS int* lcnt = (const LAS int*)(F.lds + LCNT_OFF);
    bf16_t* H = WSP(bf16_t, WS_H); const float* MOD = WSP(float, WS_MOD); const bf16_t* AX = WSP(bf16_t, WS_AX);
    const float* gate1 = MOD + (size_t)layer * 33 * 6144 + 2 * D;
    constexpr int nMall = last ? NX / 256 : NT / 256;
    if (RUN()) phase_norm1(F, A, layer);
    SEAM();
    if constexpr (kind == 0) {
        if (RUN()) {
            { pg8::ProbDense8 P; P.A = (const unsigned char*)AX; P.Bt = WSP(unsigned char, WS_WQK) + (size_t)j * 1280 * D; P.lda = D; P.ldb = D; P.K = D; P.scale_w = SCALE_W; P.scale_x = SCALE_ONE; P.ord.init(NT / 256, 5, F.G, F.c);
              EpiQK E{WSP(bf16_t, WS_Q), WSP(bf16_t, WS_K), WSP(float, WS_BQK) + j * 1280, WSP(float, WS_ROPEC), WSP(float, WS_ROPES)};
              pg8::gemm_phase(ring, P, E); }
            { pg8::ProbDense8 P; P.A = WSP(unsigned char, WS_WV) + (size_t)j * 256 * D; P.Bt = (const unsigned char*)AX; P.lda = D; P.ldb = D; P.K = D; P.scale_w = SCALE_ONE; P.scale_x = SCALE_W; P.ord.init(1, NT / 256, F.G, F.c);
              EpiVT E{WSP(bf16_t, WS_VT), A.in[I_ABQKV] + j * 1536 + 1280};
              pg8::gemm_phase(ring, P, E); }
        }
        SEAM();
        if (RUN()) phase_attn(F, A, j, !last);
        SEAM();
        if (RUN()) { pg8::ProbDense8 P; P.A = WSP(unsigned char, WS_O); P.Bt = WSP(unsigned char, WS_WO) + (size_t)j * D * D; P.lda = D; P.ldb = D; P.K = D; P.scale_w = SCALE_W; P.scale_x = SCALE_ONE; P.ord.init(nMall, 4, F.G, F.c);
            EpiResid E{H, A.in[I_ABO] + j * D, nullptr, gate1};
            pg8::gemm_phase(ring, P, E); }
        SEAM();
    } else if constexpr (kind == 1) {
        if (RUN()) phase_pooldiff(F);
        SEAM();
        if (RUN()) { pg8::ProbDense P; P.A = WSP(bf16_t, WS_PD); P.Bt = WSP(bf16_t, WS_POOLW); P.lda = D; P.ldb = 256; P.K = 256; P.a_pn_off = 256; P.ord.init(nMall, 4, F.G, F.c);
            EpiResid E{H, A.in[I_PB], A.in[I_PS], gate1};
            pg8::gemm_phase(ring, P, E); }
        SEAM();
    } else {
        if (RUN()) phase_rwkv_mix(F, A);
        SEAM();
        if (RUN()) {
            for (int i = 0; i < 3; ++i) { const int sel = i == 0 ? 0 : i == 1 ? 2 : 3;
                pg8::ProbDense8 P; P.A = (const unsigned char*)(WSP(bf16_t, WS_A6) + (size_t)sel * NT * D); P.Bt = WSP(unsigned char, WS_WRKV) + (size_t)i * D * D; P.lda = D; P.ldb = D; P.K = D; P.scale_w = SCALE_W; P.scale_x = SCALE_ONE; P.ord.init(NT / 256, 4, F.G, F.c);
                EpiBf16Act E{WSP(bf16_t, WS_RKV) + (size_t)i * NT * D, D, nullptr, 0, 1.0f};
                pg8::gemm_phase(ring, P, E); }
            for (int i = 0; i < 3; ++i) { const int sel = i == 0 ? 5 : i == 1 ? 1 : 4;
                pg8::ProbDense P; P.A = WSP(bf16_t, WS_A6) + (size_t)sel * NT * D; P.Bt = WSP(bf16_t, WS_WL1) + (size_t)i * 256 * D; P.lda = D; P.ldb = D; P.K = D; P.a_pn_off = 0; P.ord.init(NT / 256, 1, F.G, F.c);
                EpiBf16Act E{WSP(bf16_t, WS_LORA) + i * 256, 768, nullptr, i == 0 ? 1 : i == 1 ? 2 : 0, 1.0f};
                pg8::gemm_phase(ring, P, E); }
        }
        SEAM();
        if (RUN()) {
            for (int i = 0; i < 5; ++i) {
                const int ablk = i == 0 ? 0 : i < 3 ? 1 : 2, d = (i - 1) & 1;
                pg8::ProbDense P; P.A = WSP(bf16_t, WS_LORA) + ablk * 256; P.Bt = WSP(bf16_t, WS_WL2) + (size_t)i * D * 256; P.lda = 768; P.ldb = 256; { int k128 = 128; asm volatile("" : "+s"(k128)); P.K = k128; }     P.a_pn_off = 0; P.ord.init(NT / 256, 4, F.G, F.c);
                EpiBf16Act E; E.ldc = D;
                if (i == 0) { E.O = WSP(bf16_t, WS_G); E.bias = nullptr; E.act = 0; E.scale = 1.0f; }
                else if (i < 3) { E.O = WSP(bf16_t, WS_E) + (size_t)d * NT * D; E.bias = A.in[I_RW0] + d * D; E.act = 1; E.scale = 0.6065306597126334f; }
                else { E.O = WSP(bf16_t, WS_A) + (size_t)d * NT * D; E.bias = A.in[I_RA0] + d * D; E.act = 1; E.scale = 1.0f; }
                pg8::gemm_phase(ring, P, E); }
        }
        SEAM();
        if (RUN()) phase_rwkv_scan(F, A);
        SEAM();
        if (RUN()) phase_rwkv_out(F, A, last ? NX : NT);
        SEAM();
        if (RUN()) { pg8::ProbDense8 P; P.A = WSP(unsigned char, WS_RO); P.Bt = WSP(unsigned char, WS_WOR); P.lda = D; P.ldb = D; P.K = D; P.scale_w = SCALE_W; P.scale_x = SCALE_ONE; P.ord.init(nMall, 4, F.G, F.c);
            EpiResid E{H, nullptr, nullptr, gate1};
            pg8::gemm_phase(ring, P, E); }
        SEAM();
    }
    if (RUN()) phase_route(F, A, layer);
    SEAM();
    if (RUN()) { moe_tiles(F, layer);
        ProbMoe1 P; P.FX = WSP(fp8_t, WS_FX); P.W1T = WSP(fp8_t, WS_W1T) + (size_t)layer * NE * 2048 * D; P.list = WSP(int, WS_LIST); P.tpre = tpre; P.cnt = lcnt; P.texp = (const LAS unsigned char*)(F.lds + TEXP_OFF); P.toks = (LAS int*)(F.lds + TOKS_OFF); P.scale_w = SCALE_W; P.scale_x = SCALE_ONE; P.ord.init(tpre[NE], 8, F.G, F.c);
        EpiMoe1 E{WSP(unsigned char, WS_ACT), A.in[I_MB1] + (size_t)layer * NE * 2048};
        pg8::gemm_phase(ring, P, E); }
    SEAM();
    if (RUN()) { moe_tiles(F, layer);
        ProbMoe2 P; P.ACT = WSP(fp8_t, WS_ACT); P.W2T = WSP(fp8_t, WS_W2T) + (size_t)layer * NE * D * D; P.tpre = tpre; P.texp = (const LAS unsigned char*)(F.lds + TEXP_OFF); P.scale_w = SCALE_W; P.scale_x = SCALE_ONE; P.ord.init(tpre[NE], 4, F.G, F.c);
        EpiMoe2 E{WSP(unsigned char, WS_Y), A.in[I_MB2] + (size_t)layer * NE * D};
        pg8::gemm_phase(ring, P, E); }
    SEAM();
}
__global__ void __launch_bounds__(NTHREADS, 2) trunk_fwd(Args A) {
    extern __shared__ __attribute__((aligned(16))) unsigned char lds_[];
    Frame F; F.lds = (LAS unsigned char*)lds_; REFRESH(F); F.wave = __builtin_amdgcn_readfirstlane(F.tid >> 6);
    F.G = gridDim.x; F.c = blockIdx.x; F.ws = A.ws; F.ctl = (unsigned*)(A.ws + WS_CTL);
    for (int u = F.tid; u < (LDS_BYTES - LDSCTL_OFF) / 4; u += NTHREADS) ((LAS unsigned*)(F.lds + LDSCTL_OFF))[u] = 0u;
    __syncthreads();
    KState KS; KS.bar.bar = F.ctl + CW_BAR; KS.bar.x = 0; KS.bar.st = nullptr; KS.ph = 0;
    if (A.one) KS.bar = xcd_barrier_post(F.ctl + CW_BAR, (volatile LAS unsigned*)(F.lds + MISC_OFF) + 8);
    if (RUN()) phase_prologue(F, A);
    SEAM();
    layer_body<0>(F, A, KS);
    layer_body<1>(F, A, KS);
    layer_body<2>(F, A, KS);
    layer_body<3>(F, A, KS);
    if (RUN()) phase_final(F, A);
}
#undef RUN
#undef SEAM
static int count_phases() { int n = 1; for (int layer = 0; layer < DEPTH; ++layer) { const int kind = layer % 3; n += 1 + (kind == 0 ? 3 : kind == 1 ? 2 : 6) + 3; } return n + 1; }

extern "C" void kernel_launch(void* const* d_in, const int* in_sizes, int n_in, void* d_out, int out_size, void* d_ws, size_t ws_size, hipStream_t stream) {
    static int grid = 0;
    if (grid == 0) {
        if (n_in != 38 || out_size != NX * D || ws_size < WS_END) { fprintf(stderr, "kernel_launch: unexpected problem (n_in %d, out %d, ws %zu < %zu)\n", n_in, out_size, ws_size, (size_t)WS_END); grid = -1; return; }
        int dev = 0, cus = 0;
        if (hipGetDevice(&dev) != hipSuccess || hipDeviceGetAttribute(&cus, hipDeviceAttributeMultiprocessorCount, dev) != hipSuccess) { grid = -1; return; }
        if (hipFuncSetAttribute((const void*)trunk_fwd, hipFuncAttributeMaxDynamicSharedMemorySize, LDS_BYTES) != hipSuccess) { fprintf(stderr, "kernel_launch: hipFuncSetAttribute failed\n"); grid = -1; return; }
        int per_cu = 0;
        if (hipOccupancyMaxActiveBlocksPerMultiprocessor(&per_cu, (const void*)trunk_fwd, NTHREADS, LDS_BYTES) != hipSuccess || per_cu < 1) fprintf(stderr, "kernel_launch: occupancy query says %d\n", per_cu);
        (void)hipGetLastError();
        grid = cus;
        if (grid != 256) fprintf(stderr, "kernel_launch: %d CUs (built for 256)\n", grid);
    }
    if (grid < 0) return;
    (void)hipMemsetAsync((char*)d_ws + WS_CTL, 0, CTL_BYTES, stream);
    (void)hipMemsetAsync((char*)d_ws + WS_LZERO, 0, LZERO_BYTES, stream);
    Args a{};
    for (int i = 0; i < 38; ++i) a.in[i] = (const float*)d_in[i];
    a.out = (float*)d_out; a.ws = (unsigned char*)d_ws;
#if MK_ONE_LAUNCH
    a.phase = 0; a.one = 1;
    hipLaunchKernelGGL(trunk_fwd, dim3(grid), dim3(NTHREADS), LDS_BYTES, stream, a);
#else
    const int nph = count_phases();
    for (int p = 0; p < nph; ++p) { a.phase = p; a.one = 0; hipLaunchKernelGGL(trunk_fwd, dim3(grid), dim3(NTHREADS), LDS_BYTES, stream, a); }
#endif
}
```

```cpp
#include <hip/hip_runtime.h>
#include <cstdio>
#include <cstdint>

#ifndef MK_ONE_LAUNCH
#define MK_ONE_LAUNCH 1
#endif
#define LAS __attribute__((address_space(3)))
#define GAS __attribute__((address_space(1)))
typedef unsigned short bf16_t;
typedef short bf16x8 __attribute__((ext_vector_type(8)));
typedef float f32x4 __attribute__((ext_vector_type(4)));
typedef float f32x2 __attribute__((ext_vector_type(2)));
typedef unsigned u32x4 __attribute__((ext_vector_type(4)));
typedef unsigned u32x2 __attribute__((ext_vector_type(2)));

constexpr int D = 1024, NB = 32, T = 2048, L = 256, DEPTH = 4;
constexpr int NX = NB * T, NC = NB * L, NT = NX + NC;
constexpr int NE = 32, TOPK = 4;
constexpr int NWAVES = 8, NTHREADS = 512;
constexpr int MAXRT = NT * TOPK / 256 + NE;

constexpr size_t MiB = 1u << 20;
constexpr size_t WS_CTL = 0, CTL_BYTES = 4 * MiB;
constexpr size_t WS_MOD = 4 * MiB;
constexpr size_t WS_ROPEC = 8 * MiB, WS_ROPES = 8 * MiB + 512 * 1024;
constexpr size_t WS_BQK = 9 * MiB;
constexpr size_t WS_WQK = 10 * MiB;
constexpr size_t WS_WV = 15 * MiB;
constexpr size_t WS_WO = 16 * MiB;
constexpr size_t WS_POOLW = 20 * MiB;
constexpr size_t WS_WRKV = 21 * MiB;
constexpr size_t WS_WOR = 27 * MiB;
constexpr size_t WS_WL1 = 30 * MiB;
constexpr size_t WS_WL2 = 32 * MiB;
constexpr size_t WS_LZERO = WS_WL1, LZERO_BYTES = 6 * MiB;
constexpr size_t WS_W1T = 40 * MiB;
constexpr size_t WS_W2T = 552 * MiB;
constexpr size_t WS_H = 808 * MiB;
constexpr size_t WS_AX = 1096 * MiB;
constexpr size_t WS_FX = 1240 * MiB;
constexpr size_t WS_R = 1384 * MiB;
constexpr size_t WS_ACT = WS_R;
constexpr size_t WS_Y = WS_R + 592 * MiB;
constexpr size_t WS_LIST = WS_R + 1184 * MiB;
constexpr size_t WS_POS = WS_R + 1193 * MiB;
constexpr size_t WS_GATE = WS_R + 1195 * MiB;
constexpr size_t WS_Q = WS_R;
constexpr size_t WS_K = WS_R + 144 * MiB;
constexpr size_t WS_VT = WS_R + 180 * MiB;
constexpr size_t WS_O = WS_R + 216 * MiB;
constexpr size_t WS_PD = WS_R;
constexpr size_t WS_A6 = WS_R;
constexpr size_t WS_E = WS_R;
constexpr size_t WS_A = WS_R + 288 * MiB;
constexpr size_t WS_RO = WS_R + 576 * MiB;
constexpr size_t WS_RKV = WS_R + 864 * MiB;
constexpr size_t WS_LORA = WS_R + 1296 * MiB;
constexpr size_t WS_G = WS_R + 1404 * MiB;
constexpr size_t WS_YS = WS_R + 1548 * MiB;
constexpr size_t WS_BONUS = WS_R + 2124 * MiB;
constexpr size_t WS_END = WS_R + 2134 * MiB;

constexpr int CW_BAR = 4096;
constexpr int CW_GCNT = 16384;
constexpr int LDS_BYTES = 147456;
constexpr int RING_BYTES = 131072;
constexpr int LDSCTL_OFF = 135168;
constexpr int MISC_OFF = LDSCTL_OFF;
constexpr int TPRE_OFF = LDSCTL_OFF + 256;
constexpr int LCNT_OFF = LDSCTL_OFF + 512;
constexpr int LBASE_OFF = LDSCTL_OFF + 768;
constexpr int REC_OFF = LDSCTL_OFF + 1024;
constexpr int TEXP_OFF = LDSCTL_OFF + 1024 + 2048;
constexpr int TOKS_OFF = LDSCTL_OFF + 1024 + 4096;
constexpr int JOB_OFF = LDSCTL_OFF + 1024;

__device__ __forceinline__ unsigned f2bf(float f) { unsigned u = __builtin_bit_cast(unsigned, f); return (u + 0x7fffu + ((u >> 16) & 1u)) >> 16; }
__device__ __forceinline__ unsigned pk2(float lo, float hi) { return f2bf(lo) | (f2bf(hi) << 16); }
__device__ __forceinline__ float bflo(unsigned w) { return __builtin_bit_cast(float, w << 16); }
__device__ __forceinline__ float bfhi(unsigned w) { return __builtin_bit_cast(float, w & 0xffff0000u); }
__device__ __forceinline__ float bf1(bf16_t b) { return __builtin_bit_cast(float, ((unsigned)b) << 16); }
__device__ __forceinline__ unsigned pk4_fp8(float a, float b, float c, float d) { int w = __builtin_amdgcn_cvt_pk_fp8_f32(a, b, 0, false); w = __builtin_amdgcn_cvt_pk_fp8_f32(c, d, w, true); return (unsigned)w; }
typedef __bf16 bf16x2_t __attribute__((ext_vector_type(2)));
__device__ __forceinline__ unsigned cvt_pk_bf16(float lo, float hi) { const f32x2 v = {lo, hi}; return __builtin_bit_cast(unsigned, __builtin_convertvector(v, bf16x2_t)); }
__device__ __forceinline__ float dpp_add(float v, const int ctrl, const int row_mask) {
    switch (ctrl) {
    case 0xB1:  return v + __builtin_bit_cast(float, __builtin_amdgcn_update_dpp(0, __builtin_bit_cast(int, v), 0xB1, 0xf, 0xf, true));
    case 0x4E:  return v + __builtin_bit_cast(float, __builtin_amdgcn_update_dpp(0, __builtin_bit_cast(int, v), 0x4E, 0xf, 0xf, true));
    case 0x141: return v + __builtin_bit_cast(float, __builtin_amdgcn_update_dpp(0, __builtin_bit_cast(int, v), 0x141, 0xf, 0xf, true));
    case 0x140: return v + __builtin_bit_cast(float, __builtin_amdgcn_update_dpp(0, __builtin_bit_cast(int, v), 0x140, 0xf, 0xf, true));
    case 0x142: return v + __builtin_bit_cast(float, __builtin_amdgcn_update_dpp(0, __builtin_bit_cast(int, v), 0x142, 0xa, 0xf, true));
    default:    return v + __builtin_bit_cast(float, __builtin_amdgcn_update_dpp(0, __builtin_bit_cast(int, v), 0x143, 0xc, 0xf, true));
    }
}
__device__ __forceinline__ float row16_sum(float v) { v = dpp_add(v, 0xB1, 0xf); v = dpp_add(v, 0x4E, 0xf); v = dpp_add(v, 0x141, 0xf); v = dpp_add(v, 0x140, 0xf); return v; }
__device__ __forceinline__ float wave_sum(float v) {
    v = row16_sum(v); v = dpp_add(v, 0x142, 0xa); v = dpp_add(v, 0x143, 0xc);
    return __builtin_bit_cast(float, __builtin_amdgcn_readlane(__builtin_bit_cast(int, v), 63));
}
__device__ __forceinline__ float sigmoidf_(float x) { return __builtin_amdgcn_rcpf(1.0f + __builtin_amdgcn_exp2f(-1.4426950408889634f * x)); }
__device__ __forceinline__ int opaque_tid() { int t; asm volatile("v_mov_b32 %0, %1" : "=v"(t) : "v"(threadIdx.x)); return t; }
#define REFRESH(F) do { (F).tid = opaque_tid(); (F).lane = (F).tid & 63; } while (0)
__device__ __forceinline__ void seq_of(int row, int& sb, int& t, int& n) { if (row < NX) { sb = row & ~(T - 1); t = row & (T - 1); n = T; } else { const int r2 = row - NX; sb = NX + (r2 & ~(L - 1)); t = r2 & (L - 1); n = L; } }
__device__ __forceinline__ f32x4 ld_bf4(const bf16_t* p) { const u32x2 w = *(const u32x2*)p; return (f32x4){bflo(w.x), bfhi(w.x), bflo(w.y), bfhi(w.y)}; }
__device__ __forceinline__ void st_bf4(bf16_t* p, f32x4 v) { u32x2 w; w.x = pk2(v.x, v.y); w.y = pk2(v.z, v.w); *(u32x2*)p = w; }

#define LDS_WAIT() asm volatile("s_waitcnt lgkmcnt(0)" ::: "memory")
#define VM_WAIT() asm volatile("s_waitcnt vmcnt(0)" ::: "memory")

#define XB_TMO      128
#define XB_XCNT(j)  (256  + 64 * (j))
#define XB_XSUB(j)  (1280 + 64 * (j))
#define XB_XGEN(j)  (2304 + 64 * (j))
#define XB_TOP      3328
#define XB_TOPGEN   3392
#define XCD_BAR_WORDS 3456
#define XB_SPIN_CAP (1u << 18)
__device__ __forceinline__ unsigned xb_ld(unsigned* p)              { return __hip_atomic_load(p, __ATOMIC_RELAXED, __HIP_MEMORY_SCOPE_AGENT); }
__device__ __forceinline__ unsigned xb_add(unsigned* p, unsigned v) { return __hip_atomic_fetch_add(p, v, __ATOMIC_RELAXED, __HIP_MEMORY_SCOPE_AGENT); }
__device__ __forceinline__ unsigned xb_xcc_id() { return (unsigned)__builtin_amdgcn_s_getreg((3 << 11) | 20) & 0xFu; }
#define XB_SPIN(cond, bar) do { unsigned _sp = 0; while (cond) { __builtin_amdgcn_s_sleep(1); \
    if ((++_sp & 255u) == 0u) { if (xb_ld(&(bar)[XB_TMO])) break; if (_sp > XB_SPIN_CAP) { atomicAdd(&(bar)[XB_TMO], 1u); break; } } } } while (0)
struct XcdBarrier { unsigned* bar; unsigned x; volatile LAS unsigned* st; };
__device__ __forceinline__ XcdBarrier xcd_barrier_post(unsigned* bar, volatile LAS unsigned* st) {
    XcdBarrier b; b.bar = bar; b.x = xb_xcc_id(); b.st = st;
    if (threadIdx.x == 0) (void)xb_add(&bar[XB_XCNT(b.x)], 1u);
    return b;
}
__device__ __forceinline__ void xcd_barrier_complete(unsigned* bar, unsigned x, unsigned& nloc, unsigned& nx) {
    const unsigned G = gridDim.x * gridDim.y * gridDim.z;
    unsigned sum, cnt, mine, sp = 0u;
    for (;;) {
        sum = 0u; cnt = 0u; mine = 0u;
#pragma unroll
        for (unsigned j = 0; j < 16; ++j) { const unsigned c = xb_ld(&bar[XB_XCNT(j)]); sum += c; cnt += (c > 0u) ? 1u : 0u; mine = (j == x) ? c : mine; }
        if (sum == G) break;
        __builtin_amdgcn_s_sleep(1);
        if ((++sp & 255u) == 0u) { if (xb_ld(&bar[XB_TMO])) break; if (sp > XB_SPIN_CAP) { atomicAdd(&bar[XB_TMO], 1u); break; } }
    }
    nloc = mine > 0u ? mine : 1u; nx = cnt > 0u ? cnt : 1u;
}
__device__ __forceinline__ void xcd_barrier(const XcdBarrier& b) {
    asm volatile("s_waitcnt vmcnt(0)" ::: "memory");
    __syncthreads();
    if (threadIdx.x == 0) {
        unsigned* bar = b.bar;
        __builtin_amdgcn_s_waitcnt(0);
        unsigned nloc = b.st[0], nx = b.st[1];
        if (nloc == 0u) { xcd_barrier_complete(bar, b.x, nloc, nx); b.st[0] = nloc; b.st[1] = nx; }
        const unsigned old = xb_add(&bar[XB_XSUB(b.x)], 1u);
        const unsigned gen = old / nloc;
        if (old + 1u == (gen + 1u) * nloc) {
            __builtin_amdgcn_fence(__ATOMIC_RELEASE, "agent");
            asm volatile("s_waitcnt vmcnt(0)" ::: "memory");
            const unsigned og = xb_add(&bar[XB_TOP], 1u);
            const unsigned tg = og / nx;
            if (og + 1u == (tg + 1u) * nx) xb_add(&bar[XB_TOPGEN], 1u);
            else XB_SPIN(xb_ld(&bar[XB_TOPGEN]) == tg, bar);
            __builtin_amdgcn_fence(__ATOMIC_ACQUIRE, "agent");
            xb_add(&bar[XB_XGEN(b.x)], 1u);
            asm volatile("s_waitcnt vmcnt(0)" ::: "memory");
        } else {
            XB_SPIN(xb_ld(&bar[XB_XGEN(b.x)]) == gen, bar);
            __builtin_amdgcn_fence(__ATOMIC_ACQUIRE, "agent");
            asm volatile("s_waitcnt vmcnt(0)" ::: "memory");
        }
    }
    __syncthreads();
}

namespace pg8 {
constexpr int BM = 256, BK = 64, HALF = 128, HTB = HALF * BK * 2, STAGE_BYTES = 8 * HTB, NXCD = 8, WGM = 8;
__host__ __device__ __forceinline__ int lds_byte(int r, int c) { const int st = (r >> 4) * 2 + (c >> 5), rr = r & 15, cc = c & 31, ob = rr * 64 + cc * 2; return st * 1024 + (ob ^ (((ob >> 9) & 1) << 5)); }
__host__ __device__ __forceinline__ void stage_rc(int b, int& R, int& C) { const int st = b / 1024, sb = b % 1024, swz = sb ^ (((sb >> 9) & 1) << 5); R = (st >> 1) * 16 + swz / 64; C = (st & 1) * 32 + (swz % 64) / 2; }
__host__ __device__ __forceinline__ int perm32(int rho) { const int n = rho >> 4, i = rho & 15; return 8 * (i >> 2) + 4 * n + (i & 3); }

typedef int i32x8 __attribute__((ext_vector_type(8)));
typedef int i32x4 __attribute__((ext_vector_type(4)));
__device__ __forceinline__ i32x8 cat8(bf16x8 lo, bf16x8 hi) { const i32x4 a = __builtin_bit_cast(i32x4, lo), b = __builtin_bit_cast(i32x4, hi); return __builtin_shufflevector(a, b, 0, 1, 2, 3, 4, 5, 6, 7); }
struct Unit { int pm, pn, e, rt; };
struct TileOrder {
    int nM, nN, nwg, G, c;
    __device__ __forceinline__ void init(int nM_, int nN_, int G_, int c_) { nM = nM_; nN = nN_; nwg = nM * nN; G = G_; c = c_; }
    __device__ __forceinline__ bool next(int i, int& pm, int& pn) const {
        const long Lx = (long)i * G + c; if (Lx >= nwg) return false;
        int wgid = (int)Lx; { const int q = nwg / NXCD, r = nwg % NXCD, xcd = wgid % NXCD, off = wgid / NXCD; wgid = (xcd < r ? xcd * (q + 1) : r * (q + 1) + (xcd - r) * q) + off; }
        const int nig = WGM * nN, gid = wgid / nig, fm = gid * WGM, gsz = (nM - fm) < WGM ? (nM - fm) : WGM;
        pm = fm + ((wgid % nig) % gsz); pn = (wgid % nig) / gsz; return true;
    }
};
struct ProbDense {
    static constexpr bool FP8 = false;
    const bf16_t* A; const bf16_t* Bt; int lda, ldb, K, a_pn_off; TileOrder ord;
    __device__ __forceinline__ int ldb_bytes() const { return ldb * 2; }
    __device__ __forceinline__ int ntiles() const { return K / 64; }
    __device__ __forceinline__ bool next(int i, Unit& u) const { u.e = 0; const bool ok = ord.next(i, u.pm, u.pn); u.rt = u.pm; return ok; }
    __device__ __forceinline__ const char* a_ptr(const Unit& u) const { return (const char*)(A + (size_t)u.pm * BM * lda + (size_t)u.pn * a_pn_off); }
    __device__ __forceinline__ const char* b_ptr(const Unit& u) const { return (const char*)(Bt + (size_t)u.pn * BM * ldb); }
    __device__ __forceinline__ void list_prefetch(const Unit&, int, int, int) const {}
    __device__ __forceinline__ void a_off(const Unit&, int, const int (&R)[2], const int (&C)[2], unsigned (&v)[2][2]) const {
#pragma unroll
        for (int h = 0; h < 2; ++h)
#pragma unroll
            for (int i = 0; i < 2; ++i) v[h][i] = (unsigned)((h * HALF + R[i]) * lda + C[i]) * 2u;
    }
};

struct ProbDense8 {
    static constexpr bool FP8 = true;
    const unsigned char* A; const unsigned char* Bt; int lda, ldb, K, scale_w, scale_x; TileOrder ord;
    __device__ __forceinline__ int ldb_bytes() const { return ldb; }
    __device__ __forceinline__ int ntiles() const { return K / 128; }
    __device__ __forceinline__ bool next(int i, Unit& u) const { u.e = 0; const bool ok = ord.next(i, u.pm, u.pn); u.rt = u.pm; return ok; }
    __device__ __forceinline__ const char* a_ptr(const Unit& u) const { return (const char*)(A + (size_t)u.pm * BM * lda); }
    __device__ __forceinline__ const char* b_ptr(const Unit& u) const { return (const char*)(Bt + (size_t)u.pn * BM * ldb); }
    __device__ __forceinline__ void list_prefetch(const Unit&, int, int, int) const {}
    __device__ __forceinline__ void a_off(const Unit&, int, const int (&R)[2], const int (&C)[2], unsigned (&v)[2][2]) const {
#pragma unroll
        for (int h = 0; h < 2; ++h)
#pragma unroll
            for (int i = 0; i < 2; ++i) v[h][i] = (unsigned)((h * HALF + R[i]) * lda + C[i] * 2);
    }
};
template <class Prob, class Epi>
__device__ __forceinline__ void gemm_phase(LAS unsigned char* lds, const Prob& P, const Epi& E) {
    const int tid = opaque_tid(), wid = __builtin_amdgcn_readfirstlane(tid >> 6), lane = tid & 63, wr = wid >> 2, wc = wid & 3, fr = lane & 15, fq = lane >> 4;
    const int nt = P.ntiles(); const int ldbB = P.ldb_bytes();
    int Rr[2], Cc[2]; unsigned voffB[2];
#pragma unroll
    for (int i = 0; i < 2; ++i) { int R, C; stage_rc(tid * 16 + i * 8192, R, C); Rr[i] = R; Cc[i] = C; const int Rb = Epi::PERM ? ((R & ~31) + perm32(R & 31)) : R;
        voffB[i] = (unsigned)(Rb * ldbB + C * 2); }
    const size_t kstep = (size_t)(BK * 2);
    const size_t hstepB = (size_t)HALF * ldbB;
    const unsigned ldsw = (unsigned)wid * 1024u;
    const int aoff = lds_byte(wr * 64 + fr, fq * 8), boff = lds_byte(wc * 32 + fr, fq * 8);
#define PG8_SA(b, h) (((b) * 2 + (h)) * HTB)
#define PG8_SB(b, h) ((4 + (b) * 2 + (h)) * HTB)
#define PG8_STAGE(bufoff, gbase, voff) do { _Pragma("unroll") for (int _i = 0; _i < 2; ++_i) \
        __builtin_amdgcn_global_load_lds((const unsigned*)((const char*)(gbase) + (voff)[_i]), (LAS unsigned*)(lds + (bufoff) + ldsw + _i * 8192), 16, 0, 0); } while (0)
#define PG8_LDA(dst, b, h) do { _Pragma("unroll") for (int m = 0; m < 4; ++m) _Pragma("unroll") for (int k = 0; k < 2; ++k) dst[m][k] = *(const LAS bf16x8*)(lds + PG8_SA(b, h) + aoff + m * 2048 + k * 1024); } while (0)
#define PG8_LDB(dst, b, h) do { _Pragma("unroll") for (int n = 0; n < 2; ++n) _Pragma("unroll") for (int k = 0; k < 2; ++k) dst[n][k] = *(const LAS bf16x8*)(lds + PG8_SB(b, h) + boff + n * 2048 + k * 1024); } while (0)
#define PG8_MMA(ai, bj, At, Bt) do { __builtin_amdgcn_s_setprio(1); _Pragma("unroll") for (int m = 0; m < 4; ++m) _Pragma("unroll") for (int n = 0; n < 2; ++n) { \
        if constexpr (Prob::FP8) { asm volatile("v_mfma_scale_f32_16x16x128_f8f6f4 %0, %1, %2, %0, %3, %4 op_sel_hi:[0,0,0]" : "+v"(acc[ai][bj][m][n]) : "v"(cat8(Bt[n][0], Bt[n][1])), "v"(cat8(At[m][0], At[m][1])), "v"(sc_w), "v"(sc_x)); } \
        else { _Pragma("unroll") for (int k = 0; k < 2; ++k) acc[ai][bj][m][n] = __builtin_amdgcn_mfma_f32_16x16x32_bf16(Bt[n][k], At[m][k], acc[ai][bj][m][n], 0, 0, 0); } } __builtin_amdgcn_s_setprio(0); } while (0)
#define PG8_WAIT_V(n) asm volatile("s_waitcnt vmcnt(" #n ")" ::: "memory")
#define PG8_WAIT_L(n) asm volatile("s_waitcnt lgkmcnt(" #n ")" ::: "memory")
#define PG8_BAR __builtin_amdgcn_s_barrier()
#define PG8_SCHED __builtin_amdgcn_sched_barrier(0)
    Unit cur, nxt; int ui = 0;
    if (!P.next(0, cur)) return;
    int sc_w = 0, sc_x = 0; if constexpr (Prob::FP8) { sc_w = P.scale_w; sc_x = P.scale_x; } (void)sc_w; (void)sc_x;
    f32x4 acc[2][2][4][2];
#pragma unroll
    for (int a = 0; a < 2; ++a)
#pragma unroll
        for (int b = 0; b < 2; ++b)
#pragma unroll
            for (int m = 0; m < 4; ++m)
#pragma unroll
                for (int n = 0; n < 2; ++n) acc[a][b][m][n] = (f32x4){0.f, 0.f, 0.f, 0.f};
    bf16x8 At[4][2], B0[2][2], B1[2][2];
    unsigned vAc[2][2], vAn[2][2];
    P.list_prefetch(cur, 0, wid, lane); { Unit u1; if (P.next(1, u1)) P.list_prefetch(u1, 1, wid, lane); }
    PG8_WAIT_V(0); PG8_BAR;
    P.a_off(cur, 0, Rr, Cc, vAc);
    const char* cA = P.a_ptr(cur); const char* cB = P.b_ptr(cur);
    PG8_STAGE(PG8_SB(0, 0), cB, voffB); PG8_STAGE(PG8_SB(0, 1), cB + hstepB, voffB); PG8_STAGE(PG8_SA(0, 0), cA, vAc[0]); PG8_STAGE(PG8_SA(0, 1), cA, vAc[1]);
    if (wr == 1) PG8_BAR;
    PG8_WAIT_V(2); PG8_BAR;
    PG8_STAGE(PG8_SB(1, 0), cB + kstep, voffB); PG8_STAGE(PG8_SA(1, 0), cA + kstep, vAc[0]); PG8_STAGE(PG8_SB(1, 1), cB + hstepB + kstep, voffB);
    PG8_WAIT_V(6); PG8_BAR;
    for (;;) {
        const bool has_next = P.next(ui + 1, nxt);
        const char* nA = cA; const char* nB = cB;
#pragma unroll
        for (int h = 0; h < 2; ++h)
#pragma unroll
            for (int i = 0; i < 2; ++i) vAn[h][i] = vAc[h][i];
        if (has_next) { nA = P.a_ptr(nxt); nB = P.b_ptr(nxt); P.a_off(nxt, (ui + 1) & 1, Rr, Cc, vAn); }
        { Unit u2; if (P.next(ui + 2, u2)) P.list_prefetch(u2, ui & 1, wid, lane); }
        for (int t = 0; t < nt; t += 2) {
            const bool last = (t == nt - 2);
            const char* a1 = cA + (size_t)(t + 1) * kstep;
            const char* a2 = last ? nA : cA + (size_t)(t + 2) * kstep; const char* b2 = last ? nB : cB + (size_t)(t + 2) * kstep;
            const char* a3 = a2 + kstep; const char* b3 = b2 + kstep;
            unsigned vX[2][2];
#pragma unroll
            for (int h = 0; h < 2; ++h)
#pragma unroll
                for (int i = 0; i < 2; ++i) vX[h][i] = last ? vAn[h][i] : vAc[h][i];
            PG8_LDB(B0, 0, 0); PG8_LDB(B1, 0, 1); PG8_SCHED; PG8_LDA(At, 0, 0); PG8_STAGE(PG8_SA(1, 1), a1, vAc[1]);
            PG8_WAIT_V(8); PG8_WAIT_L(0); PG8_BAR; PG8_MMA(0, 0, At, B0); PG8_MMA(0, 1, At, B1); PG8_BAR; PG8_SCHED;
            PG8_LDA(At, 0, 1); PG8_STAGE(PG8_SB(0, 0), b2, voffB); PG8_STAGE(PG8_SB(0, 1), b2 + hstepB, voffB); PG8_STAGE(PG8_SA(0, 0), a2, vX[0]);
            PG8_WAIT_V(8); PG8_WAIT_L(0); PG8_BAR; PG8_MMA(1, 0, At, B0); PG8_MMA(1, 1, At, B1); PG8_BAR; PG8_SCHED;
            PG8_LDB(B0, 1, 0); PG8_LDB(B1, 1, 1); PG8_SCHED; PG8_LDA(At, 1, 0); PG8_STAGE(PG8_SA(0, 1), a2, vX[1]);
            PG8_WAIT_V(8); PG8_WAIT_L(0); PG8_BAR; PG8_MMA(0, 0, At, B0); PG8_MMA(0, 1, At, B1); PG8_BAR; PG8_SCHED;
            PG8_LDA(At, 1, 1); PG8_STAGE(PG8_SB(1, 0), b3, voffB); PG8_STAGE(PG8_SB(1, 1), b3 + hstepB, voffB); PG8_STAGE(PG8_SA(1, 0), a3, vX[0]);
            PG8_WAIT_V(8); PG8_WAIT_L(0); PG8_BAR; PG8_MMA(1, 0, At, B0); PG8_MMA(1, 1, At, B1); PG8_BAR; PG8_SCHED;
        }
        if (wr == 0) PG8_BAR;
        if constexpr (Prob::FP8) asm volatile("s_nop 15\n\ts_nop 15" ::: "memory");
        E(acc, cur, wr, wc, fr, fq);
        if (!has_next) break;
#pragma unroll
        for (int a = 0; a < 2; ++a)
#pragma unroll
            for (int b = 0; b < 2; ++b)
#pragma unroll
                for (int m = 0; m < 4; ++m)
#pragma unroll
                    for (int n = 0; n < 2; ++n) acc[a][b][m][n] = (f32x4){0.f, 0.f, 0.f, 0.f};
        cur = nxt; cA = nA; cB = nB; ++ui;
#pragma unroll
        for (int h = 0; h < 2; ++h)
#pragma unroll
            for (int i = 0; i < 2; ++i) vAc[h][i] = vAn[h][i];
        if (wr == 1) PG8_BAR;
    }
    PG8_WAIT_V(0);
    PG8_BAR;
#undef PG8_SA
#undef PG8_SB
#undef PG8_STAGE
#undef PG8_LDA
#undef PG8_LDB
#undef PG8_MMA
#undef PG8_WAIT_V
#undef PG8_WAIT_L
#undef PG8_BAR
#undef PG8_SCHED
}
}

using pg8::Unit;
constexpr int HALF_ = 128;
struct EpiBf16Act {
    static constexpr bool PERM = true;
    bf16_t* O; int ldc; const float* bias; int act; float scale;
    __device__ __forceinline__ void operator()(const f32x4 (&acc)[2][2][4][2], const Unit& u, int wr, int wc, int fr, int fq) const {
        const int row0 = u.pm * 256 + wr * 64 + fr, col0 = u.pn * 256 + wc * 32 + 8 * fq;
        f32x4 bv[2][2];
#pragma unroll
        for (int bj = 0; bj < 2; ++bj)
#pragma unroll
            for (int n = 0; n < 2; ++n) bv[bj][n] = bias ? *(const f32x4*)(bias + col0 + bj * HALF_ + 4 * n) : (f32x4){0.f, 0.f, 0.f, 0.f};
#pragma unroll
        for (int ai = 0; ai < 2; ++ai)
#pragma unroll
            for (int m = 0; m < 4; ++m) { bf16_t* rowp = O + (size_t)(row0 + ai * HALF_ + m * 16) * ldc + col0;
#pragma unroll
                for (int bj = 0; bj < 2; ++bj) { f32x4 v0 = acc[ai][bj][m][0] + bv[bj][0], v1 = acc[ai][bj][m][1] + bv[bj][1];
                    if (act == 1) {
#pragma unroll
                        for (int j = 0; j < 4; ++j) { v0[j] = sigmoidf_(v0[j]) * scale; v1[j] = sigmoidf_(v1[j]) * scale; } }
                    else if (act == 2) {
#pragma unroll
                        for (int j = 0; j < 4; ++j) { v0[j] = 1.0f - 2.0f * __builtin_amdgcn_rcpf(__builtin_amdgcn_exp2f(2.8853900817779268f * v0[j]) + 1.0f); v1[j] = 1.0f - 2.0f * __builtin_amdgcn_rcpf(__builtin_amdgcn_exp2f(2.8853900817779268f * v1[j]) + 1.0f); } }
                    u32x4 w; w.x = cvt_pk_bf16(v0[0], v0[1]); w.y = cvt_pk_bf16(v0[2], v0[3]); w.z = cvt_pk_bf16(v1[0], v1[1]); w.w = cvt_pk_bf16(v1[2], v1[3]);
                    *(u32x4*)(rowp + bj * HALF_) = w; } }
    }
};
struct EpiQK {
    static constexpr bool PERM = true;
    bf16_t* Q; bf16_t* Kb; const float* bias; const float* ropec; const float* ropes;
    __device__ __forceinline__ void operator()(const f32x4 (&acc)[2][2][4][2], const Unit& u, int wr, int wc, int fr, int fq) const {
        int row0 = u.pm * 256 + wr * 64 + fr, cl0 = wc * 32 + 8 * fq;
        asm volatile("" : "+v"(row0), "+v"(cl0));
        const int g = (4 * wc + fq) & 7;
        bf16_t* base; int ldc;
        if (u.pn < 4) { base = Q + u.pn * 256; ldc = 1024; } else { base = Kb; ldc = 256; }
        f32x4 bv[2][2];
#pragma unroll
        for (int bj = 0; bj < 2; ++bj)
#pragma unroll
            for (int n = 0; n < 2; ++n) bv[bj][n] = *(const f32x4*)(bias + u.pn * 256 + cl0 + bj * HALF_ + 4 * n);
#pragma unroll
        for (int ai = 0; ai < 2; ++ai)
#pragma unroll
            for (int m = 0; m < 4; ++m) { const int row = row0 + ai * HALF_ + m * 16; bf16_t* rowp = base + (size_t)row * ldc + cl0;
                f32x4 cs = (f32x4){1.f, 1.f, 1.f, 1.f}, sn = (f32x4){0.f, 0.f, 0.f, 0.f};
                if (row < NX) { const int t = row & (T - 1); cs = *(const f32x4*)(ropec + t * 32 + g * 4); sn = *(const f32x4*)(ropes + t * 32 + g * 4); }
#pragma unroll
                for (int bj = 0; bj < 2; ++bj) { const f32x4 v0 = acc[ai][bj][m][0] + bv[bj][0], v1 = acc[ai][bj][m][1] + bv[bj][1];
                    const f32x4 o0 = v0 * cs - v1 * sn, o1 = v1 * cs + v0 * sn;
                    u32x4 w; w.x = cvt_pk_bf16(o0[0], o0[1]); w.y = cvt_pk_bf16(o0[2], o0[3]); w.z = cvt_pk_bf16(o1[0], o1[1]); w.w = cvt_pk_bf16(o1[2], o1[3]);
                    *(u32x4*)(rowp + bj * HALF_) = w; } }
    }
};
struct EpiVT {
    static constexpr bool PERM = true;
    bf16_t* VT; const float* biasrow;
    __device__ __forceinline__ void operator()(const f32x4 (&acc)[2][2][4][2], const Unit& u, int wr, int wc, int fr, int fq) const {
        int row0 = wr * 64 + fr, col0 = u.pn * 256 + wc * 32 + 8 * fq;
        asm volatile("" : "+v"(row0), "+v"(col0));
#pragma unroll
        for (int ai = 0; ai < 2; ++ai)
#pragma unroll
            for (int m = 0; m < 4; ++m) { const int row = row0 + ai * HALF_ + m * 16; const float b = biasrow[row]; bf16_t* rowp = VT + (size_t)row * NT + col0;
#pragma unroll
                for (int bj = 0; bj < 2; ++bj) { const f32x4 v0 = acc[ai][bj][m][0] + b, v1 = acc[ai][bj][m][1] + b;
                    u32x4 w; w.x = cvt_pk_bf16(v0[0], v0[1]); w.y = cvt_pk_bf16(v0[2], v0[3]); w.z = cvt_pk_bf16(v1[0], v1[1]); w.w = cvt_pk_bf16(v1[2], v1[3]);
                    *(u32x4*)(rowp + bj * HALF_) = w; } }
    }
};
struct EpiResid {
    static constexpr bool PERM = true;
    bf16_t* H; const float* bias; const float* ls; const float* gate;
    __device__ __forceinline__ void operator()(const f32x4 (&acc)[2][2][4][2], const Unit& u, int wr, int wc, int fr, int fq) const {
        int row0 = u.pm * 256 + wr * 64 + fr, col0 = u.pn * 256 + wc * 32 + 8 * fq;
        asm volatile("" : "+v"(row0), "+v"(col0));
        f32x4 bv[2][2], lv[2][2];
#pragma unroll
        for (int bj = 0; bj < 2; ++bj)
#pragma unroll
            for (int n = 0; n < 2; ++n) { bv[bj][n] = bias ? *(const f32x4*)(bias + col0 + bj * HALF_ + 4 * n) : (f32x4){0.f, 0.f, 0.f, 0.f};
                                          lv[bj][n] = ls ? *(const f32x4*)(ls + col0 + bj * HALF_ + 4 * n) : (f32x4){1.f, 1.f, 1.f, 1.f}; }
#pragma unroll
        for (int ai = 0; ai < 2; ++ai)
#pragma unroll
            for (int m = 0; m < 4; ++m) { const int row = row0 + ai * HALF_ + m * 16; const int brow = row < NX ? (row >> 11) : 32;
                bf16_t* hp = H + (size_t)row * D + col0; const float* gp = gate + (size_t)brow * (6 * D) + col0;
#pragma unroll
                for (int bj = 0; bj < 2; ++bj) { const u32x4 hw = *(const u32x4*)(hp + bj * HALF_);
                    const f32x4 g0 = *(const f32x4*)(gp + bj * HALF_), g1 = *(const f32x4*)(gp + bj * HALF_ + 4);
                    const f32x4 y0 = (acc[ai][bj][m][0] + bv[bj][0]) * lv[bj][0], y1 = (acc[ai][bj][m][1] + bv[bj][1]) * lv[bj][1];
                    const f32x4 h0 = (f32x4){bflo(hw.x), bfhi(hw.x), bflo(hw.y), bfhi(hw.y)} + g0 * y0, h1 = (f32x4){bflo(hw.z), bfhi(hw.z), bflo(hw.w), bfhi(hw.w)} + g1 * y1;
                    u32x4 w; w.x = cvt_pk_bf16(h0[0], h0[1]); w.y = cvt_pk_bf16(h0[2], h0[3]); w.z = cvt_pk_bf16(h1[0], h1[1]); w.w = cvt_pk_bf16(h1[2], h1[3]);
                    *(u32x4*)(hp + bj * HALF_) = w; }
                asm volatile("" ::: "memory"); }
    }
};
struct EpiMoe1 {
    static constexpr bool PERM = true;
    unsigned char* ACT; const float* b1;
    __device__ __forceinline__ void operator()(const f32x4 (&acc)[2][2][4][2], const Unit& u, int wr, int wc, int fr, int fq) const {
        const int row0 = u.rt * 256 + wr * 64 + fr, cl = u.pn * 128 + wc * 32 + 8 * fq;
        const float* bg = b1 + (size_t)u.e * 2048 + cl; const float* bl = bg + 1024;
        f32x4 bgv[2], blv[2];
#pragma unroll
        for (int n = 0; n < 2; ++n) { bgv[n] = *(const f32x4*)(bg + 4 * n); blv[n] = *(const f32x4*)(bl + 4 * n); }
#pragma unroll
        for (int ai = 0; ai < 2; ++ai)
#pragma unroll
            for (int m = 0; m < 4; ++m) { unsigned char* rowp = ACT + (size_t)(row0 + ai * HALF_ + m * 16) * D + cl;
                f32x4 o[2];
#pragma unroll
                for (int n = 0; n < 2; ++n) { const f32x4 c7 = (f32x4){7.f, 7.f, 7.f, 7.f};
                    const f32x4 gl = __builtin_elementwise_min(acc[ai][0][m][n] + bgv[n], c7), li = __builtin_elementwise_min(__builtin_elementwise_max(acc[ai][1][m][n] + blv[n], -c7), c7);
                    const f32x4 z = gl * (-1.702f * 1.4426950408889634f); f32x4 den;
#pragma unroll
                    for (int j = 0; j < 4; ++j) den[j] = __builtin_amdgcn_rcpf(1.0f + __builtin_amdgcn_exp2f(z[j]));
                    o[n] = gl * den * (li + 1.0f); }
                u32x2 w; w.x = pk4_fp8(o[0][0], o[0][1], o[0][2], o[0][3]); w.y = pk4_fp8(o[1][0], o[1][1], o[1][2], o[1][3]);
                *(u32x2*)rowp = w; }
    }
};
struct EpiMoe2 {
    static constexpr bool PERM = true;
    unsigned char* Y; const float* b2;
    __device__ __forceinline__ void operator()(const f32x4 (&acc)[2][2][4][2], const Unit& u, int wr, int wc, int fr, int fq) const {
        const int row0 = u.rt * 256 + wr * 64 + fr, col0 = u.pn * 256 + wc * 32 + 8 * fq;
        const float* bb = b2 + (size_t)u.e * D + col0;
        f32x4 bv[2][2];
#pragma unroll
        for (int bj = 0; bj < 2; ++bj)
#pragma unroll
            for (int n = 0; n < 2; ++n) bv[bj][n] = *(const f32x4*)(bb + bj * HALF_ + 4 * n);
#pragma unroll
        for (int ai = 0; ai < 2; ++ai)
#pragma unroll
            for (int m = 0; m < 4; ++m) { unsigned char* rowp = Y + (size_t)(row0 + ai * HALF_ + m * 16) * D + col0;
#pragma unroll
                for (int bj = 0; bj < 2; ++bj) { f32x4 v0 = (acc[ai][bj][m][0] + bv[bj][0]) * 4.0f, v1 = (acc[ai][bj][m][1] + bv[bj][1]) * 4.0f;
#pragma unroll
                    for (int i = 0; i < 4; ++i) { v0[i] = __builtin_amdgcn_fmed3f(v0[i], -448.0f, 448.0f); v1[i] = __builtin_amdgcn_fmed3f(v1[i], -448.0f, 448.0f); }
                    *(u32x2*)(rowp + bj * HALF_) = (u32x2){pk4_fp8(v0[0], v0[1], v0[2], v0[3]), pk4_fp8(v1[0], v1[1], v1[2], v1[3])}; } }
    }
};
typedef unsigned char fp8_t;
constexpr int SCALE_ONE = 0x7f7f7f7f, SCALE_W = 0x79797979;
struct ProbMoe1 {
    static constexpr bool FP8 = true;
    const fp8_t* FX; const fp8_t* W1T; const int* list; const LAS int* tpre; const LAS int* cnt; const LAS unsigned char* texp; LAS int* toks; int scale_w, scale_x; pg8::TileOrder ord;
    __device__ __forceinline__ int ldb_bytes() const { return D; }
    __device__ __forceinline__ int ntiles() const { return D / 128; }
    __device__ __forceinline__ bool next(int i, Unit& u) const {
        if (!ord.next(i, u.pm, u.pn)) return false;
        u.rt = u.pm; u.e = texp[u.rt]; return true;
    }
    __device__ __forceinline__ const char* a_ptr(const Unit&) const { return (const char*)FX; }
    __device__ __forceinline__ const char* b_ptr(const Unit& u) const { return (const char*)(W1T + ((size_t)u.e * 2048 + (size_t)u.pn * 256) * D); }
    __device__ __forceinline__ void list_prefetch(const Unit& u, int par, int wid, int lane) const {
        if (wid == 0) { const int* src = list + (size_t)u.e * NT + (u.rt - tpre[u.e]) * 256 + 4 * lane;
            __builtin_amdgcn_global_load_lds((const unsigned*)src, (LAS unsigned*)(toks + par * 256), 16, 0, 0); }
    }
    __device__ __forceinline__ void a_off(const Unit& u, int par, const int (&R)[2], const int (&C)[2], unsigned (&v)[2][2]) const {
        const int nvalid = cnt[u.e] - (u.rt - tpre[u.e]) * 256; const LAS int* tk = toks + par * 256;
#pragma unroll
        for (int h = 0; h < 2; ++h)
#pragma unroll
            for (int i = 0; i < 2; ++i) { const int r = h * 128 + R[i]; const int tok = tk[r < nvalid ? r : 0]; v[h][i] = (unsigned)(tok * D + C[i] * 2); }
    }
};
struct ProbMoe2 {
    static constexpr bool FP8 = true;
    const fp8_t* ACT; const fp8_t* W2T; const LAS int* tpre; const LAS unsigned char* texp; int scale_w, scale_x; pg8::TileOrder ord;
    __device__ __forceinline__ int ldb_bytes() const { return D; }
    __device__ __forceinline__ int ntiles() const { return D / 128; }
    __device__ __forceinline__ bool next(int i, Unit& u) const {
        if (!ord.next(i, u.pm, u.pn)) return false;
        u.rt = u.pm; u.e = texp[u.rt]; return true;
    }
    __device__ __forceinline__ const char* a_ptr(const Unit& u) const { return (const char*)(ACT + (size_t)u.rt * 256 * D); }
    __device__ __forceinline__ const char* b_ptr(const Unit& u) const { return (const char*)(W2T + ((size_t)u.e * 1024 + (size_t)u.pn * 256) * D); }
    __device__ __forceinline__ void list_prefetch(const Unit&, int, int, int) const {}
    __device__ __forceinline__ void a_off(const Unit&, int, const int (&R)[2], const int (&C)[2], unsigned (&v)[2][2]) const {
#pragma unroll
        for (int h = 0; h < 2; ++h)
#pragma unroll
            for (int i = 0; i < 2; ++i) v[h][i] = (unsigned)((h * 128 + R[i]) * D + C[i] * 2);
    }
};
struct Args { const float* in[38]; float* out; unsigned char* ws; int phase; int one; };
enum { I_X = 0, I_C, I_CTX, I_CCTX, I_ADAW, I_ADAB, I_NORMG, I_AWQKV, I_ABQKV, I_AWO, I_ABO, I_ASINK, I_PW, I_PB, I_PS,
       I_RMIX, I_RWRKV, I_RW0, I_RW1, I_RW2, I_RA0, I_RA1, I_RA2, I_RG1, I_RG2, I_RKK, I_RKA, I_RRK, I_RLNW, I_RLNB, I_RWO,
       I_MWR, I_MBR, I_MW1, I_MB1, I_MW2, I_MB2, I_FG };
struct Frame { LAS unsigned char* lds; int tid, lane, wave, G, c; unsigned char* ws; unsigned* ctl; };
#define WSP(T_, off) ((T_*)(F.ws + (off)))

struct TJob { const float* src; unsigned char* dst; long sbs, dbs; int ldw, ldt, nkb, nnb, mode, item0, per, esz; };
__device__ __forceinline__ int dst_row(int mode, int n) {
    if (mode == 1) { const int hb = n & ~63, d = n & 63; const int ax = d >> 5, dd = d & 31, hf = dd >> 4, f = dd & 15; const int g = ax * 4 + (f >> 2), i = (f & 3) + 4 * hf; return hb + 8 * g + i; }
    if (mode == 2) { return n < 1024 ? ((n >> 7) << 8) + (n & 127) : (((n - 1024) >> 7) << 8) + 128 + (n & 127); }
    return n;
}
struct TItem { const float* src; unsigned char* dst; int ldw, ldt, mode, n0, esz; };
__device__ __forceinline__ void titem_decode(const LAS TJob* jobs, int nj, int it, TItem& T) {
    int ji = 0;
    for (int q = 1; q < nj; ++q) ji += (jobs[q].item0 <= it) ? 1 : 0;
    const LAS TJob& J = jobs[ji]; const int r = it - J.item0, bi = r / J.per, rr = r % J.per, kb = rr / J.nnb, nb = rr % J.nnb;
    T.src = J.src + bi * J.sbs + (size_t)(64 * kb) * J.ldw + 32 * nb; T.dst = J.dst + (bi * J.dbs + 64 * kb) * J.esz; T.ldw = J.ldw; T.ldt = J.ldt; T.mode = J.mode; T.n0 = 32 * nb; T.esz = J.esz;
}
__device__ __forceinline__ void titem_load(const TItem& T, int lane, f32x4 (&v)[8]) {
    const float* p = T.src + (size_t)(lane >> 3) * T.ldw + 4 * (lane & 7);
#pragma unroll
    for (int i = 0; i < 8; ++i) v[i] = *(const f32x4*)(p + (size_t)(8 * i) * T.ldw);
}
__device__ __forceinline__ void titem_store(const TItem& T, int lane, const f32x4 (&v)[8], LAS float* scr) {
#pragma unroll
    for (int i = 0; i < 8; ++i) { LAS float* d = scr + (8 * i + (lane >> 3)) * 33 + 4 * (lane & 7); d[0] = v[i].x; d[1] = v[i].y; d[2] = v[i].z; d[3] = v[i].w; }
    LDS_WAIT(); asm volatile("" ::: "memory");
    const int c = lane & 7;
#pragma unroll
    for (int j = 0; j < 4; ++j) { const int n = (lane >> 3) + 8 * j; const LAS float* s = scr + (8 * c) * 33 + n;
        const size_t eo = (size_t)dst_row(T.mode, T.n0 + n) * T.ldt + 8 * c;
        if (T.esz == 2) { u32x4 o; o.x = pk2(s[0 * 33], s[1 * 33]); o.y = pk2(s[2 * 33], s[3 * 33]); o.z = pk2(s[4 * 33], s[5 * 33]); o.w = pk2(s[6 * 33], s[7 * 33]); *(u32x4*)(T.dst + eo * 2) = o; }
        else { u32x2 o; o.x = pk4_fp8(64.f * s[0 * 33], 64.f * s[1 * 33], 64.f * s[2 * 33], 64.f * s[3 * 33]); o.y = pk4_fp8(64.f * s[4 * 33], 64.f * s[5 * 33], 64.f * s[6 * 33], 64.f * s[7 * 33]); *(u32x2*)(T.dst + eo) = o; } }
    LDS_WAIT(); asm volatile("" ::: "memory");
}
__device__ __forceinline__ void phase_prologue(Frame& F, const Args& A) {
    REFRESH(F);
    LAS float* S = (LAS float*)F.lds;
    for (int idx = F.tid; idx < 33 * 1024; idx += NTHREADS) { const int r = idx >> 10, k = idx & 1023; const float v = r < 32 ? A.in[I_C][r * 1024 + k] : A.in[I_CCTX][k]; S[k * 33 + r] = v / (1.0f + __expf(-v)); }
    __syncthreads();
    float* MOD = WSP(float, WS_MOD);
    for (int it = F.c; it < 4 * 96; it += F.G) {
        const int layer = it / 96, n = (it % 96) * 64 + F.lane; const float* wp = A.in[I_ADAW] + (size_t)layer * 1024 * 6144 + n;
        float acc[5] = {0.f, 0.f, 0.f, 0.f, 0.f};
        for (int k0 = 0; k0 < 1024; k0 += 32) {
            float wv[32];
#pragma unroll
            for (int u = 0; u < 32; ++u) wv[u] = wp[(size_t)(k0 + u) * 6144];
#pragma unroll
            for (int u = 0; u < 32; ++u) { const LAS float* sr = S + (k0 + u) * 33 + F.wave;
                acc[0] += sr[0] * wv[u]; acc[1] += sr[8] * wv[u]; acc[2] += sr[16] * wv[u]; acc[3] += sr[24] * wv[u]; if (F.wave == 0) acc[4] += S[(k0 + u) * 33 + 32] * wv[u]; }
        }
        const float bb = A.in[I_ADAB][layer * 6144 + n];
#pragma unroll
        for (int i = 0; i < 4; ++i) MOD[((size_t)layer * 33 + F.wave + 8 * i) * 6144 + n] = acc[i] + bb;
        if (F.wave == 0) MOD[((size_t)layer * 33 + 32) * 6144 + n] = acc[4] + bb;
    }
    { float* rc = WSP(float, WS_ROPEC); float* rs = WSP(float, WS_ROPES);
      for (int idx = F.c * NTHREADS + F.tid; idx < 2048 * 32; idx += F.G * NTHREADS) { const int t = idx >> 5, e = idx & 31, g = e >> 2, i = e & 3, f = 4 * (g & 3) + i;
          const float inv = powf(10000.0f, -(float)f / 16.0f); const float pos = (float)(g < 4 ? (t >> 6) : (t & 63)); const float ang = pos * inv; rc[idx] = cosf(ang); rs[idx] = sinf(ang); }
      float* bq = WSP(float, WS_BQK);
      for (int idx = F.c * NTHREADS + F.tid; idx < 2 * 1280; idx += F.G * NTHREADS) { const int j = idx / 1280, n = idx % 1280; bq[j * 1280 + dst_row(1, n)] = A.in[I_ABQKV][j * 1536 + n]; } }
    __syncthreads();
    LAS TJob* jobs = (LAS TJob*)(F.lds + JOB_OFF); LAS int* njobs = (LAS int*)(F.lds + MISC_OFF + 64);
    if (F.tid == 0) {
        int nj = 0, item = 0;
        auto add = [&](const float* src, bf16_t* dst, int ldw, int ldt, int Ks, int Ns, int mode, int nb, long sbs, long dbs, int esz = 2) {
            LAS TJob& j = jobs[nj]; j.src = src; j.dst = (unsigned char*)dst; j.sbs = sbs; j.dbs = dbs; j.ldw = ldw; j.ldt = ldt; j.nkb = Ks / 64; j.nnb = Ns / 32; j.mode = mode; j.item0 = item; j.per = (Ks / 64) * (Ns / 32); j.esz = esz;
            ++nj; item += (Ks / 64) * (Ns / 32) * nb; };
        add(A.in[I_AWQKV], WSP(bf16_t, WS_WQK), 1536, 1024, 1024, 1280, 1, 2, 1024L * 1536, 1280L * 1024, 1);
        add(A.in[I_AWQKV] + 1280, WSP(bf16_t, WS_WV), 1536, 1024, 1024, 256, 0, 2, 1024L * 1536, 256L * 1024, 1);
        add(A.in[I_AWO], WSP(bf16_t, WS_WO), 1024, 1024, 1024, 1024, 0, 2, 1L << 20, 1L << 20, 1);
        add(A.in[I_PW], WSP(bf16_t, WS_POOLW), 256, 256, 256, 256, 0, 4, 65536, 65536);
        add(A.in[I_RWRKV], WSP(bf16_t, WS_WRKV), 1024, 1024, 1024, 1024, 0, 3, 1L << 20, 1L << 20, 1);
        add(A.in[I_RG1], WSP(bf16_t, WS_WL1), 128, 1024, 1024, 128, 0, 1, 0, 0);
        add(A.in[I_RW1], WSP(bf16_t, WS_WL1) + 256 * 1024, 64, 1024, 1024, 64, 0, 2, 65536, 65536);
        add(A.in[I_RA1], WSP(bf16_t, WS_WL1) + 2 * 256 * 1024, 64, 1024, 1024, 64, 0, 2, 65536, 65536);
        add(A.in[I_RG2], WSP(bf16_t, WS_WL2), 1024, 256, 128, 1024, 0, 1, 0, 0);
        add(A.in[I_RW2], WSP(bf16_t, WS_WL2) + 1 * 1024 * 256, 1024, 256, 64, 1024, 0, 2, 65536, 1024L * 256 + 64);
        add(A.in[I_RA2], WSP(bf16_t, WS_WL2) + 3 * 1024 * 256, 1024, 256, 64, 1024, 0, 2, 65536, 1024L * 256 + 64);
        add(A.in[I_RWO], WSP(bf16_t, WS_WOR), 1024, 1024, 1024, 1024, 0, 1, 0, 0, 1);
        add(A.in[I_MW1], WSP(bf16_t, WS_W1T), 2048, 1024, 1024, 2048, 2, 128, 1024L * 2048, 2048L * 1024, 1);
        add(A.in[I_MW2], WSP(bf16_t, WS_W2T), 1024, 1024, 1024, 1024, 0, 128, 1L << 20, 1L << 20, 1);
        njobs[0] = nj; njobs[1] = item;
    }
    __syncthreads();
    { const int nj = njobs[0], nitems = njobs[1]; LAS float* scr = (LAS float*)(F.lds + F.wave * 16384);
      const int gw = F.c * NWAVES + F.wave, NGW = F.G * NWAVES;
      int it = gw;
      if (it < nitems) {
          TItem Tc, Tn; f32x4 vc[8], vn[8];
          titem_decode(jobs, nj, it, Tc); titem_load(Tc, F.lane, vc);
          for (;;) {
              const int itn = it + NGW; const bool more = itn < nitems;
              if (more) { titem_decode(jobs, nj, itn, Tn); titem_load(Tn, F.lane, vn); }
              titem_store(Tc, F.lane, vc, scr);
              if (!more) break;
              Tc = Tn;
#pragma unroll
              for (int i = 0; i < 8; ++i) vc[i] = vn[i];
              it = itn;
          }
      } }
    __syncthreads();
}

__device__ __forceinline__ void moe_tiles(Frame& F, int layer) {
    REFRESH(F);
    LAS int* lcnt = (LAS int*)(F.lds + LCNT_OFF); LAS int* tpre = (LAS int*)(F.lds + TPRE_OFF);
    __syncthreads();
    if (F.tid < NE) lcnt[F.tid] = (int)__hip_atomic_load(F.ctl + CW_GCNT + layer * 64 + F.tid, __ATOMIC_RELAXED, __HIP_MEMORY_SCOPE_AGENT);
    __syncthreads();
    if (F.tid == 0) { int s = 0; for (int e = 0; e < NE; ++e) { tpre[e] = s; s += (lcnt[e] + 255) >> 8; } tpre[NE] = s; }
    __syncthreads();
    { LAS unsigned char* texp = (LAS unsigned char*)(F.lds + TEXP_OFF); const int nrt = tpre[NE];
      for (int rt = F.tid; rt < nrt; rt += NTHREADS) { int e = 0; for (int j = 1; j < NE; ++j) e += (tpre[j] <= rt) ? 1 : 0; texp[rt] = (unsigned char)e; } }
    __syncthreads();
}
constexpr int RB = 2;
#define ROWOF(it, r) ((((it) * F.G + F.c) * NWAVES + F.wave) * RB + (r))
struct MoeRef { int p[4]; float g[4]; };
__device__ __forceinline__ void moe_ref_load(Frame& F, int row, MoeRef& R) {
    const int4 pp = *(const int4*)(WSP(int, WS_POS) + (size_t)row * 4); const f32x4 gg = *(const f32x4*)(WSP(float, WS_GATE) + (size_t)row * 4);
    R.p[0] = pp.x; R.p[1] = pp.y; R.p[2] = pp.z; R.p[3] = pp.w; R.g[0] = gg.x; R.g[1] = gg.y; R.g[2] = gg.z; R.g[3] = gg.w;
}
__device__ __forceinline__ void moe_rows_load(Frame& F, const MoeRef& R, unsigned (&y)[4][4]) {
    const LAS int* tpre = (const LAS int*)(F.lds + TPRE_OFF); const unsigned char* Y = WSP(unsigned char, WS_Y);
#pragma unroll
    for (int k = 0; k < 4; ++k) { const int e = R.p[k] >> 20, slot = R.p[k] & 0xfffff; const size_t fr = (size_t)tpre[e] * 256 + slot; const unsigned* yp = (const unsigned*)(Y + fr * D) + F.lane;
#pragma unroll
        for (int j = 0; j < 4; ++j) y[k][j] = yp[64 * j]; }
}
__device__ __forceinline__ f32x4 moe_rows_sum(const MoeRef& R, const unsigned (&y)[4][4], int j) {
    f32x4 s = (f32x4){0.f, 0.f, 0.f, 0.f};
#pragma unroll
    for (int k = 0; k < 4; ++k) { const int w = (int)y[k][j]; const f32x2 lo = __builtin_amdgcn_cvt_pk_f32_fp8(w, false), hi = __builtin_amdgcn_cvt_pk_f32_fp8(w, true);
        s += (R.g[k] * 0.25f) * (f32x4){lo.x, lo.y, hi.x, hi.y}; }
    return s;
}

__device__ __forceinline__ void phase_norm1(Frame& F, const Args& A, int layer) {
    REFRESH(F);
    if (layer > 0) moe_tiles(F, layer - 1);
    bf16_t* H = WSP(bf16_t, WS_H); bf16_t* AX = WSP(bf16_t, WS_AX); const float* MOD = WSP(float, WS_MOD);
    const float* g1 = A.in[I_NORMG] + (size_t)(layer * 2 + 0) * D;
    f32x4 gg[4];
#pragma unroll
    for (int j = 0; j < 4; ++j) gg[j] = ((const f32x4*)g1)[64 * j + F.lane];
    for (int it = 0;; ++it) { if (ROWOF(it, 0) >= NT) break;
        f32x4 v[RB][4]; int brow[RB];
        if (layer == 0) {
#pragma unroll
            for (int r = 0; r < RB; ++r) { const int row = ROWOF(it, r); brow[r] = row < NX ? (row >> 11) : 32; const float* src = row < NX ? A.in[I_X] + (size_t)row * D : A.in[I_CTX] + (size_t)(row - NX) * D;
#pragma unroll
                for (int j = 0; j < 4; ++j) v[r][j] = ((const f32x4*)src)[64 * j + F.lane]; }
        } else {
            MoeRef R[RB]; unsigned y[RB][4][4]; f32x4 gv[RB][4];
#pragma unroll
            for (int r = 0; r < RB; ++r) moe_ref_load(F, ROWOF(it, r), R[r]);
#pragma unroll
            for (int r = 0; r < RB; ++r) { const int row = ROWOF(it, r); brow[r] = row < NX ? (row >> 11) : 32; moe_rows_load(F, R[r], y[r]);
                const float* g2p = MOD + ((size_t)(layer - 1) * 33 + brow[r]) * 6144 + 5 * D;
#pragma unroll
                for (int j = 0; j < 4; ++j) { v[r][j] = ld_bf4(H + (size_t)row * D + 256 * j + 4 * F.lane); gv[r][j] = ((const f32x4*)g2p)[64 * j + F.lane]; } }
#pragma unroll
            for (int r = 0; r < RB; ++r)
#pragma unroll
                for (int j = 0; j < 4; ++j) v[r][j] = v[r][j] + gv[r][j] * moe_rows_sum(R[r], y[r], j);
        }
        float rstd[RB];
#pragma unroll
        for (int r = 0; r < RB; ++r) { const int row = ROWOF(it, r); float ss = 0.f;
#pragma unroll
            for (int j = 0; j < 4; ++j) { st_bf4(H + (size_t)row * D + 256 * j + 4 * F.lane, v[r][j]); ss += (v[r][j].x * v[r][j].x + v[r][j].y * v[r][j].y) + (v[r][j].z * v[r][j].z + v[r][j].w * v[r][j].w); }
            rstd[r] = 1.0f / sqrtf(wave_sum(ss) * (1.0f / D) + 1e-5f); }
#pragma unroll
        for (int r = 0; r < RB; ++r) { const int row = ROWOF(it, r); const float* mp = MOD + ((size_t)layer * 33 + brow[r]) * 6144;
#pragma unroll
            for (int j = 0; j < 4; ++j) { const f32x4 sh = ((const f32x4*)mp)[64 * j + F.lane], sc = ((const f32x4*)(mp + D))[64 * j + F.lane];
                const f32x4 o = v[r][j] * rstd[r] * gg[j] * (sc + 1.0f) + sh;
                if (layer % 3 == 0) ((unsigned*)((unsigned char*)AX + (size_t)row * D))[64 * j + F.lane] = pk4_fp8(o.x, o.y, o.z, o.w);
                else { u32x2 w; w.x = pk2(o.x, o.y); w.y = pk2(o.z, o.w); ((u32x2*)(AX + (size_t)row * D))[64 * j + F.lane] = w; } } }
    }
}
__device__ __forceinline__ void phase_final(Frame& F, const Args& A) {
    REFRESH(F);
    moe_tiles(F, DEPTH - 1);
    const bf16_t* H = WSP(bf16_t, WS_H); const float* MOD = WSP(float, WS_MOD); const float* fg = A.in[I_FG];
    f32x4 gg[4];
#pragma unroll
    for (int j = 0; j < 4; ++j) gg[j] = ((const f32x4*)fg)[64 * j + F.lane];
    for (int it = 0;; ++it) { if (ROWOF(it, 0) >= NX) break;
        MoeRef R[RB]; unsigned y[RB][4][4]; f32x4 v[RB][4], gv[RB][4];
#pragma unroll
        for (int r = 0; r < RB; ++r) moe_ref_load(F, ROWOF(it, r), R[r]);
#pragma unroll
        for (int r = 0; r < RB; ++r) { const int row = ROWOF(it, r); moe_rows_load(F, R[r], y[r]); const float* g2p = MOD + ((size_t)(DEPTH - 1) * 33 + (row >> 11)) * 6144 + 5 * D;
#pragma unroll
            for (int j = 0; j < 4; ++j) { v[r][j] = ld_bf4(H + (size_t)row * D + 256 * j + 4 * F.lane); gv[r][j] = ((const f32x4*)g2p)[64 * j + F.lane]; } }
#pragma unroll
        for (int r = 0; r < RB; ++r) { const int row = ROWOF(it, r); float ss = 0.f;
#pragma unroll
            for (int j = 0; j < 4; ++j) { v[r][j] = v[r][j] + gv[r][j] * moe_rows_sum(R[r], y[r], j); ss += (v[r][j].x * v[r][j].x + v[r][j].y * v[r][j].y) + (v[r][j].z * v[r][j].z + v[r][j].w * v[r][j].w); }
            const float rstd = 1.0f / sqrtf(wave_sum(ss) * (1.0f / D) + 1e-5f);
#pragma unroll
            for (int j = 0; j < 4; ++j) ((f32x4*)(A.out + (size_t)row * D))[64 * j + F.lane] = v[r][j] * rstd * gg[j]; }
    }
}

template <int DD> __device__ __forceinline__ float dpp_ror(float v) { return __builtin_bit_cast(float, __builtin_amdgcn_update_dpp(0, __builtin_bit_cast(int, v), 0x120 + DD, 0xf, 0xf, false)); }
template <int DD> __device__ __forceinline__ void rank_step(float v0, float v1, int e0, int& r0, int& r1) {
    const float u0 = dpp_ror<DD>(v0), u1 = dpp_ror<DD>(v1); const bool low = DD <= e0;
    r0 += (u0 > v0 || (u0 == v0 && low)) ? 1 : 0; r0 += (u1 > v0) ? 1 : 0;
    r1 += (u0 >= v1) ? 1 : 0; r1 += (u1 > v1 || (u1 == v1 && low)) ? 1 : 0;
}
__device__ __forceinline__ float row_allmax(float v) { v = fmaxf(v, dpp_ror<8>(v)); v = fmaxf(v, dpp_ror<4>(v)); v = fmaxf(v, dpp_ror<2>(v)); v = fmaxf(v, dpp_ror<1>(v)); return v; }
__device__ __forceinline__ float row_allsum(float v) { v += dpp_ror<8>(v); v += dpp_ror<4>(v); v += dpp_ror<2>(v); v += dpp_ror<1>(v); return v; }
__device__ __forceinline__ void phase_route(Frame& F, const Args& A, int layer) {
    REFRESH(F);
    const int nrows = (layer == DEPTH - 1) ? NX : NT; const int TPB = nrows / 16 / F.G;
    LAS float* wT = (LAS float*)F.lds;
    LAS int* lcnt = (LAS int*)(F.lds + LCNT_OFF); LAS int* lbase = (LAS int*)(F.lds + LBASE_OFF);
    LAS unsigned* recp = (LAS unsigned*)(F.lds + REC_OFF); LAS float* recg = (LAS float*)(F.lds + REC_OFF + 4608);
    __syncthreads();
    { const float* wr = A.in[I_MWR] + (size_t)layer * D * NE;
      for (int idx = F.tid; idx < D * NE; idx += NTHREADS) wT[(idx & 31) * 1024 + (idx >> 5)] = wr[idx]; }
    if (F.tid < NE) lcnt[F.tid] = 0;
    __syncthreads();
    const bf16_t* H = WSP(bf16_t, WS_H); unsigned char* FX = WSP(unsigned char, WS_FX); const float* MOD = WSP(float, WS_MOD);
    const float* g2 = A.in[I_NORMG] + (size_t)(layer * 2 + 1) * D; const float* br = A.in[I_MBR] + layer * NE;
    const int l = F.lane, r16 = l & 15, q4 = l >> 4; const float b0 = br[r16], b1 = br[16 + r16];
    for (int k = F.wave; k < TPB; k += NWAVES) {
        const int row0 = (F.c * TPB + k) * 16, row = row0 + r16; const int brow = row0 < NX ? (row0 >> 11) : 32;
        const float* mp = MOD + ((size_t)layer * 33 + brow) * 6144 + 3 * D;
        const bf16_t* hp = H + (size_t)row * D + 8 * q4; float ss = 0.f;
#pragma unroll 8
        for (int j = 0; j < 32; ++j) { const u32x4 w = *(const u32x4*)(hp + 32 * j); const float a0 = bflo(w.x), a1 = bfhi(w.x), a2 = bflo(w.y), a3 = bfhi(w.y), a4 = bflo(w.z), a5 = bfhi(w.z), a6 = bflo(w.w), a7 = bfhi(w.w);
            ss += ((a0 * a0 + a1 * a1) + (a2 * a2 + a3 * a3)) + ((a4 * a4 + a5 * a5) + (a6 * a6 + a7 * a7)); }
        ss += __shfl_xor(ss, 16); ss += __shfl_xor(ss, 32);
        const float rstd = 1.0f / sqrtf(ss * (1.0f / D) + 1e-5f);
        f32x4 acc0 = (f32x4){0.f, 0.f, 0.f, 0.f}, acc1 = acc0;
        const float* gp = g2 + 8 * q4; const float* shp = mp + 8 * q4; const float* scp = mp + D + 8 * q4; unsigned char* fxp = FX + (size_t)row * D + 8 * q4;
        const LAS float* w0p = wT + r16 * 1024 + 8 * q4; const LAS float* w1p = wT + (16 + r16) * 1024 + 8 * q4;
#pragma unroll 2
        for (int j = 0; j < 32; ++j) { const u32x4 w = *(const u32x4*)(hp + 32 * j);
            const f32x4 ga = *(const f32x4*)(gp + 32 * j), gb = *(const f32x4*)(gp + 32 * j + 4), sa = *(const f32x4*)(shp + 32 * j), sb = *(const f32x4*)(shp + 32 * j + 4), ca = *(const f32x4*)(scp + 32 * j), cb = *(const f32x4*)(scp + 32 * j + 4);
            const f32x4 fa = (f32x4){bflo(w.x), bfhi(w.x), bflo(w.y), bfhi(w.y)} * rstd * ga * (ca + 1.0f) + sa, fb = (f32x4){bflo(w.z), bfhi(w.z), bflo(w.w), bfhi(w.w)} * rstd * gb * (cb + 1.0f) + sb;
            *(u32x2*)(fxp + 32 * j) = (u32x2){pk4_fp8(fa.x, fa.y, fa.z, fa.w), pk4_fp8(fb.x, fb.y, fb.z, fb.w)};
            const f32x4 w0a = *(const LAS f32x4*)(w0p + 32 * j), w0b = *(const LAS f32x4*)(w0p + 32 * j + 4), w1a = *(const LAS f32x4*)(w1p + 32 * j), w1b = *(const LAS f32x4*)(w1p + 32 * j + 4);
#pragma unroll
            for (int s4 = 0; s4 < 4; ++s4) { acc0 = __builtin_amdgcn_mfma_f32_16x16x4f32(fa[s4], w0a[s4], acc0, 0, 0, 0); acc1 = __builtin_amdgcn_mfma_f32_16x16x4f32(fa[s4], w1a[s4], acc1, 0, 0, 0); }
#pragma unroll
            for (int s4 = 0; s4 < 4; ++s4) { acc0 = __builtin_amdgcn_mfma_f32_16x16x4f32(fb[s4], w0b[s4], acc0, 0, 0, 0); acc1 = __builtin_amdgcn_mfma_f32_16x16x4f32(fb[s4], w1b[s4], acc1, 0, 0, 0); } }
#pragma unroll
        for (int reg = 0; reg < 4; ++reg) {
            const float v0 = acc0[reg] + b0, v1 = acc1[reg] + b1; int r0 = (v1 > v0) ? 1 : 0, r1 = (v0 >= v1) ? 1 : 0;
            rank_step<1>(v0, v1, r16, r0, r1); rank_step<2>(v0, v1, r16, r0, r1); rank_step<3>(v0, v1, r16, r0, r1); rank_step<4>(v0, v1, r16, r0, r1); rank_step<5>(v0, v1, r16, r0, r1);
            rank_step<6>(v0, v1, r16, r0, r1); rank_step<7>(v0, v1, r16, r0, r1); rank_step<8>(v0, v1, r16, r0, r1); rank_step<9>(v0, v1, r16, r0, r1); rank_step<10>(v0, v1, r16, r0, r1);
            rank_step<11>(v0, v1, r16, r0, r1); rank_step<12>(v0, v1, r16, r0, r1); rank_step<13>(v0, v1, r16, r0, r1); rank_step<14>(v0, v1, r16, r0, r1); rank_step<15>(v0, v1, r16, r0, r1);
            const float mx = row_allmax(fmaxf(v0, v1));
            const float x0 = r0 < 4 ? __expf(v0 - mx) : 0.f, x1 = r1 < 4 ? __expf(v1 - mx) : 0.f;
            const float inv = 1.0f / row_allsum(x0 + x1);
            const int lr = k * 16 + 4 * q4 + reg;
            if (r0 < 4) { const int rk = __hip_atomic_fetch_add(lcnt + r16, 1, __ATOMIC_RELAXED, __HIP_MEMORY_SCOPE_WORKGROUP); recp[lr * 4 + r0] = ((unsigned)r16 << 20) | (unsigned)rk; recg[lr * 4 + r0] = x0 * inv; }
            if (r1 < 4) { const int rk = __hip_atomic_fetch_add(lcnt + 16 + r16, 1, __ATOMIC_RELAXED, __HIP_MEMORY_SCOPE_WORKGROUP); recp[lr * 4 + r1] = ((unsigned)(16 + r16) << 20) | (unsigned)rk; recg[lr * 4 + r1] = x1 * inv; }
        }
    }
    __syncthreads();
    if (F.tid < NE) lbase[F.tid] = (int)__hip_atomic_fetch_add(F.ctl + CW_GCNT + layer * 64 + F.tid, (unsigned)lcnt[F.tid], __ATOMIC_RELAXED, __HIP_MEMORY_SCOPE_AGENT);
    __syncthreads();
    int* LIST = WSP(int, WS_LIST); int* POS = WSP(int, WS_POS); float* GATE = WSP(float, WS_GATE);
    for (int r = F.tid; r < TPB * 16 * 4; r += NTHREADS) { const int lr = r >> 2, kk = r & 3; const int row = F.c * TPB * 16 + lr;
        const unsigned qx = recp[r]; const float qg = recg[r]; const int e = qx >> 20, slot = lbase[e] + (int)(qx & 0xfffff);
        LIST[(size_t)e * NT + slot] = row; POS[(size_t)row * 4 + kk] = (e << 20) | slot; GATE[(size_t)row * 4 + kk] = qg; }
    __syncthreads();
}

__device__ __forceinline__ void phase_pooldiff(Frame& F) {
    REFRESH(F);
    const bf16_t* AX = WSP(bf16_t, WS_AX); bf16_t* PD = WSP(bf16_t, WS_PD);
    for (int it = 0;; ++it) { if (ROWOF(it, 0) >= NT) break;
        const int row0 = ROWOF(it, 0); int sb, t, n; seq_of(row0, sb, t, n);
#pragma unroll
        for (int j = 0; j < 4; ++j) { const int half = 1 << j; const int col = 256 * j + 4 * F.lane;
            f32x4 s0 = (f32x4){0.f, 0.f, 0.f, 0.f}, s1 = s0, me0 = s0, me1 = s0;
#pragma unroll
            for (int q = 0; q < 2 * half + 1; ++q) { const int uu = t - half + q;
                if (uu >= 0 && uu < n) { const f32x4 x = ld_bf4(AX + (size_t)(sb + uu) * D + col); if (q < 2 * half) s0 += x; if (q > 0) s1 += x; if (q == half) me0 = x; if (q == half + 1) me1 = x; } }
            const int lo0 = t - half < 0 ? 0 : t - half, hi0 = t + half > n ? n : t + half, lo1 = t + 1 - half < 0 ? 0 : t + 1 - half, hi1 = t + 1 + half > n ? n : t + 1 + half;
            st_bf4(PD + (size_t)row0 * D + col, s0 * (1.0f / (float)(hi0 - lo0)) - me0);
            st_bf4(PD + (size_t)(row0 + 1) * D + col, s1 * (1.0f / (float)(hi1 - lo1)) - me1); }
    }
}
__device__ __forceinline__ void phase_rwkv_mix(Frame& F, const Args& A) {
    REFRESH(F);
    const bf16_t* AX = WSP(bf16_t, WS_AX); bf16_t* A6 = WSP(bf16_t, WS_A6); const float* mix = A.in[I_RMIX];
    for (int it = 0;; ++it) { if (ROWOF(it, 0) >= NT) break;
        const int row0 = ROWOF(it, 0); int sb, t, n; seq_of(row0, sb, t, n);
#pragma unroll
        for (int j = 0; j < 4; ++j) { const int col = 256 * j + 4 * F.lane; const f32x4 z = (f32x4){0.f, 0.f, 0.f, 0.f};
            const f32x4 h0 = ld_bf4(AX + (size_t)row0 * D + col), h1 = ld_bf4(AX + (size_t)(row0 + 1) * D + col);
            const f32x4 hp = t > 0 ? ld_bf4(AX + (size_t)(row0 - 1) * D + col) : z, hn = t + 1 < n - 1 ? ld_bf4(AX + (size_t)(row0 + 2) * D + col) : z;
            const f32x4 xx0 = (hp + h1) * 0.5f - h0, xx1 = (h0 + hn) * 0.5f - h1;
#pragma unroll
            for (int i = 0; i < 6; ++i) { const f32x4 m = *(const f32x4*)(mix + i * D + col); const f32x4 o0 = h0 + xx0 * m, o1 = h1 + xx1 * m;
                if (i == 0 || i == 2 || i == 3) { unsigned char* p8 = (unsigned char*)(A6 + (size_t)i * NT * D);
                    *(unsigned*)(p8 + (size_t)row0 * D + col) = pk4_fp8(o0.x, o0.y, o0.z, o0.w); *(unsigned*)(p8 + (size_t)(row0 + 1) * D + col) = pk4_fp8(o1.x, o1.y, o1.z, o1.w); }
                else { st_bf4(A6 + ((size_t)i * NT + row0) * D + col, o0); st_bf4(A6 + ((size_t)i * NT + row0 + 1) * D + col, o1); } } }
    }
}
__device__ __forceinline__ float rl(float x, int k) { return __builtin_bit_cast(float, __builtin_amdgcn_readlane(__builtin_bit_cast(int, x), k)); }
typedef float f32x16 __attribute__((ext_vector_type(16)));
constexpr int SCW = 33792;
__device__ __forceinline__ int kpos(int k) { return (k & ~12) | ((k & 4) << 1) | ((k & 8) >> 1); }
__device__ __forceinline__ bf16x8 acc_frag(const f32x16& X, int s2) {
    u32x4 w; w.x = cvt_pk_bf16(X[8 * s2 + 0], X[8 * s2 + 1]); w.y = cvt_pk_bf16(X[8 * s2 + 2], X[8 * s2 + 3]); w.z = cvt_pk_bf16(X[8 * s2 + 4], X[8 * s2 + 5]); w.w = cvt_pk_bf16(X[8 * s2 + 6], X[8 * s2 + 7]);
    return __builtin_bit_cast(bf16x8, w);
}
#define MFMA32(a, b, c) __builtin_amdgcn_mfma_f32_32x32x16_bf16(a, b, c, 0, 0, 0)
__device__ __forceinline__ void phase_rwkv_scan(Frame& F, const Args& A) {
    REFRESH(F);
    volatile LAS int* psync = (volatile LAS int*)(F.lds + MISC_OFF + 128);
    if (F.tid < 8) psync[F.tid] = 0;
    __syncthreads();
    int pphase = 0;
#define PAIR_SYNC() do { asm volatile("s_waitcnt lgkmcnt(0)" ::: "memory"); ++pphase; psync[pr * 2 + hw] = pphase; \
        for (unsigned sp_ = 0; psync[pr * 2 + (hw ^ 1)] < pphase && sp_ < (1u << 24); ++sp_) __builtin_amdgcn_s_sleep(1); asm volatile("" ::: "memory"); } while (0)
    const int pr = F.wave >> 1, hw = F.wave & 1;
    for (int item = pr * F.G + F.c; item < 1024; item += 4 * F.G) {
        const int dir = item >> 9, b = (item >> 4) & 31, hd = item & 15, col = 64 * hd + F.lane;
        const int l = F.lane, r32 = l & 31, hh = l >> 5;
        const bf16_t* Rr = WSP(bf16_t, WS_RKV); const bf16_t* Kk = Rr + (size_t)NT * D; const bf16_t* Vv = Kk + (size_t)NT * D;
        const bf16_t* Ee = WSP(bf16_t, WS_E) + (size_t)dir * NT * D; const bf16_t* Aa = WSP(bf16_t, WS_A) + (size_t)dir * NT * D;
        bf16_t* Yo = WSP(bf16_t, WS_YS) + (size_t)dir * NT * D; float* Bo = WSP(float, WS_BONUS) + (size_t)dir * NT * 16;
        const float kkw = A.in[I_RKK][col], kaw = A.in[I_RKA][col], rkw = A.in[I_RRK][col];
        LAS unsigned char* RA = F.lds + pr * SCW; LAS unsigned char* RB = RA + 16384; LAS unsigned char* RV = RA + 25600;
        LAS float* cCb = (LAS float*)(F.lds + REC_OFF + pr * 256);
        LAS bf16_t* XT = (LAS bf16_t*)RA;
        LAS bf16_t* BK = (LAS bf16_t*)(RA + 8192);
        const int kp = kpos(l), vb = hw;
        f32x16 ST[2];
#pragma unroll
        for (int i = 0; i < 2; ++i)
#pragma unroll
            for (int q = 0; q < 16; ++q) ST[i][q] = 0.f;
        for (int seg = 0; seg < 2; ++seg) {
            const int base = seg ? b * T : NX + b * L, n = seg ? T : L; const int dt = dir ? -1 : 1; const int t0 = dir ? n - 1 : 0;
            for (int bt = 0; bt < n; bt += 32) {
                float cprev = 1.0f;
                if (hw) {
                    bf16_t e16[16];
#pragma unroll
                    for (int s = 0; s < 16; ++s) e16[s] = Ee[(size_t)(base + t0 + dt * (bt + s)) * D + col];
                    float es = 0.f;
#pragma unroll
                    for (int s = 0; s < 16; ++s) es += bf1(e16[s]);
                    cprev = __expf(-es); }
#pragma unroll
                for (int g4i = 0; g4i < 4; ++g4i) { const int g8 = 4 * hw + g4i;
                    bf16_t raw[4][5];
#pragma unroll
                    for (int s8 = 0; s8 < 4; ++s8) { const size_t o = (size_t)(base + t0 + dt * (bt + g8 * 4 + s8)) * D + col; raw[s8][0] = Rr[o]; raw[s8][1] = Kk[o]; raw[s8][2] = Vv[o]; raw[s8][3] = Aa[o]; raw[s8][4] = Ee[o]; }
                    float rr[4], kraw[4], aa[4], kk[4], kd[4], n2[4], bn[4], ww[4]; unsigned bq2[2] = {0u, 0u}, kq2[2] = {0u, 0u};
#pragma unroll
                    for (int s8 = 0; s8 < 4; ++s8) { rr[s8] = bf1(raw[s8][0]); kraw[s8] = bf1(raw[s8][1]); aa[s8] = bf1(raw[s8][3]); ww[s8] = __expf(-bf1(raw[s8][4]));
                        kk[s8] = kraw[s8] * kkw; n2[s8] = kk[s8] * kk[s8]; kd[s8] = kraw[s8] * (1.0f + (aa[s8] - 1.0f) * kaw); bn[s8] = rr[s8] * kd[s8] * rkw; }
#pragma unroll
                    for (int s8 = 0; s8 < 4; ++s8) { n2[s8] = wave_sum(n2[s8]); bn[s8] = wave_sum(bn[s8]); }
#pragma unroll
                    for (int s8 = 0; s8 < 4; ++s8) { const int t = g8 * 4 + s8;
                        if (l == 0) Bo[(size_t)(base + t0 + dt * (bt + t)) * 16 + hd] = bn[s8];
                        const float kn = kk[s8] * __builtin_amdgcn_rsqf(fmaxf(n2[s8], 1e-24f)); const float c = cprev * ww[s8]; const float ic = __builtin_amdgcn_rcpf(c);
                        const float at = -kn * cprev, rt = rr[s8] * c, bq = kn * aa[s8] * ic, kq = kd[s8] * ic;
                        const unsigned w0 = cvt_pk_bf16(at, rt), w1 = cvt_pk_bf16(bq, kq);
                        XT[t * 64 + kp] = (bf16_t)(w0 & 0xffffu); XT[(32 + t) * 64 + kp] = (bf16_t)(w0 >> 16);
                        BK[t * 64 + kp] = (bf16_t)(w1 & 0xffffu); BK[(32 + t) * 64 + kp] = (bf16_t)(w1 >> 16);
                        if (s8 & 1) { bq2[s8 >> 1] |= (w1 & 0xffffu) << 16; kq2[s8 >> 1] |= (w1 & 0xffff0000u); } else { bq2[s8 >> 1] = w1 & 0xffffu; kq2[s8 >> 1] = w1 >> 16; }
                        cprev = c; }
                    const int gp = (g8 & ~3) | ((g8 & 1) << 1) | ((g8 & 2) >> 1);
                    *(LAS u32x2*)(RB + l * 144 + gp * 8) = (u32x2){bq2[0], bq2[1]}; *(LAS u32x2*)(RB + l * 144 + 64 + gp * 8) = (u32x2){kq2[0], kq2[1]};
                    *(LAS u32x2*)(RV + l * 80 + gp * 8) = (u32x2){(unsigned)raw[0][2] | ((unsigned)raw[1][2] << 16), (unsigned)raw[2][2] | ((unsigned)raw[3][2] << 16)};
                }
                if (hw) cCb[l] = cprev;
                PAIR_SYNC();
                f32x16 Mp, Np, X;
                { bf16x8 XTf[4], BKf[2][4];
#pragma unroll
                  for (int s4 = 0; s4 < 4; ++s4) { XTf[s4] = *(const LAS bf16x8*)(XT + r32 * 64 + 16 * s4 + 8 * hh); BKf[0][s4] = *(const LAS bf16x8*)(BK + r32 * 64 + 16 * s4 + 8 * hh); BKf[1][s4] = *(const LAS bf16x8*)(BK + (32 + r32) * 64 + 16 * s4 + 8 * hh); }
                  bf16x8 MkaF[2];
                  { f32x16 Tm;
#pragma unroll
                    for (int q = 0; q < 16; ++q) Tm[q] = 0.f;
#pragma unroll
                    for (int s4 = 0; s4 < 4; ++s4) Tm = MFMA32(BKf[1][s4], XTf[s4], Tm);
#pragma unroll
                    for (int q = 0; q < 16; ++q) { const int row = (q & 3) + 8 * (q >> 2) + 4 * hh; Tm[q] = row < r32 ? Tm[q] : 0.f; }
                    MkaF[0] = acc_frag(Tm, 0); MkaF[1] = acc_frag(Tm, 1); }
#pragma unroll
                  for (int q = 0; q < 16; ++q) { Mp[q] = 0.f; Np[q] = 0.f; X[q] = 0.f; }
#pragma unroll
                  for (int s4 = 0; s4 < 4; ++s4) { Mp = MFMA32(BKf[0][s4], XTf[s4], Mp); Np = MFMA32(XTf[s4], BKf[0][s4], Np); }
#pragma unroll
                  for (int q = 0; q < 16; ++q) { const int row = (q & 3) + 8 * (q >> 2) + 4 * hh; Mp[q] = row < r32 ? Mp[q] : 0.f; Np[q] = r32 < row ? Np[q] : 0.f; }
#pragma unroll
                  for (int kb = 0; kb < 2; ++kb)
#pragma unroll
                      for (int s2 = 0; s2 < 2; ++s2) X = MFMA32(XTf[2 * kb + s2], acc_frag(ST[kb], s2), X);
#pragma unroll
                  for (int s2 = 0; s2 < 2; ++s2) { const bf16x8 Vf = *(const LAS bf16x8*)(RV + (32 * vb + r32) * 80 + (16 * s2 + 8 * hh) * 2); X = MFMA32(MkaF[s2], Vf, X); } }
                __builtin_amdgcn_sched_barrier(0);
#pragma unroll
                for (int lvl = 0; lvl < 5; ++lvl) {
                    bf16x8 Ma[2], Na[2];
#pragma unroll
                    for (int s2 = 0; s2 < 2; ++s2) { Ma[s2] = acc_frag(Mp, s2); Na[s2] = acc_frag(Np, s2); }
                    { const bf16x8 x0 = acc_frag(X, 0), x1 = acc_frag(X, 1); X = MFMA32(Ma[0], x0, X); X = MFMA32(Ma[1], x1, X); }
                    if (lvl < 4) { f32x16 M2, N2;
#pragma unroll
                        for (int q = 0; q < 16; ++q) { M2[q] = 0.f; N2[q] = 0.f; }
                        M2 = MFMA32(Na[0], Ma[0], M2); M2 = MFMA32(Na[1], Ma[1], M2);
                        N2 = MFMA32(Ma[0], Na[0], N2); N2 = MFMA32(Ma[1], Na[1], N2);
                        Mp = M2; Np = N2; }
                }
                __builtin_amdgcn_sched_barrier(0);
                { bf16x8 XRf[4], MbrF[2], MkrF[2];
#pragma unroll
                  for (int s4 = 0; s4 < 4; ++s4) XRf[s4] = *(const LAS bf16x8*)(XT + (32 + r32) * 64 + 16 * s4 + 8 * hh);
                  { f32x16 Tm, Tn;
#pragma unroll
                    for (int q = 0; q < 16; ++q) { Tm[q] = 0.f; Tn[q] = 0.f; }
#pragma unroll
                    for (int s4 = 0; s4 < 4; ++s4) { const bf16x8 Bb = *(const LAS bf16x8*)(BK + r32 * 64 + 16 * s4 + 8 * hh), Bk = *(const LAS bf16x8*)(BK + (32 + r32) * 64 + 16 * s4 + 8 * hh);
                        Tm = MFMA32(Bb, XRf[s4], Tm); Tn = MFMA32(Bk, XRf[s4], Tn); }
#pragma unroll
                    for (int q = 0; q < 16; ++q) { const int row = (q & 3) + 8 * (q >> 2) + 4 * hh; Tm[q] = row <= r32 ? Tm[q] : 0.f; Tn[q] = row <= r32 ? Tn[q] : 0.f; }
                    MbrF[0] = acc_frag(Tm, 0); MbrF[1] = acc_frag(Tm, 1); MkrF[0] = acc_frag(Tn, 0); MkrF[1] = acc_frag(Tn, 1); }
                  { const bf16x8 u0 = acc_frag(X, 0), u1 = acc_frag(X, 1);
                    const bf16x8 Vf0 = *(const LAS bf16x8*)(RV + (32 * vb + r32) * 80 + (8 * hh) * 2), Vf1 = *(const LAS bf16x8*)(RV + (32 * vb + r32) * 80 + (16 + 8 * hh) * 2);
                    f32x16 Yt;
#pragma unroll
                    for (int q = 0; q < 16; ++q) Yt[q] = 0.f;
#pragma unroll
                    for (int kb = 0; kb < 2; ++kb)
#pragma unroll
                        for (int s2 = 0; s2 < 2; ++s2) Yt = MFMA32(XRf[2 * kb + s2], acc_frag(ST[kb], s2), Yt);
                    Yt = MFMA32(MkrF[0], Vf0, Yt); Yt = MFMA32(MkrF[1], Vf1, Yt);
                    Yt = MFMA32(MbrF[0], u0, Yt); Yt = MFMA32(MbrF[1], u1, Yt);
#pragma unroll
                    for (int q = 0; q < 16; ++q) { const int t = (q & 3) + 8 * (q >> 2) + 4 * hh; Yo[(size_t)(base + t0 + dt * (bt + t)) * D + 64 * hd + 32 * vb + r32] = (bf16_t)f2bf(Yt[q]); }
#pragma unroll
                    for (int kb = 0; kb < 2; ++kb) {
                        const bf16x8 b0 = *(const LAS bf16x8*)(RB + (32 * kb + r32) * 144 + (8 * hh) * 2), b1 = *(const LAS bf16x8*)(RB + (32 * kb + r32) * 144 + (16 + 8 * hh) * 2);
                        const bf16x8 k0 = *(const LAS bf16x8*)(RB + (32 * kb + r32) * 144 + 64 + (8 * hh) * 2), k1 = *(const LAS bf16x8*)(RB + (32 * kb + r32) * 144 + 64 + (16 + 8 * hh) * 2);
                        ST[kb] = MFMA32(b0, u0, ST[kb]); ST[kb] = MFMA32(b1, u1, ST[kb]);
                        ST[kb] = MFMA32(k0, Vf0, ST[kb]); ST[kb] = MFMA32(k1, Vf1, ST[kb]); }
                  } }
                __builtin_amdgcn_sched_barrier(0);
#pragma unroll
                for (int kb = 0; kb < 2; ++kb)
#pragma unroll
                    for (int g4 = 0; g4 < 4; ++g4) { const f32x4 cc = *(const LAS f32x4*)(cCb + 32 * kb + 8 * g4 + 4 * hh);
                        ST[kb][4 * g4 + 0] *= cc.x; ST[kb][4 * g4 + 1] *= cc.y; ST[kb][4 * g4 + 2] *= cc.z; ST[kb][4 * g4 + 3] *= cc.w; }
                PAIR_SYNC();
            }
        }
    }
    __syncthreads();
}
#undef PAIR_SYNC
#undef MFMA32
__device__ __forceinline__ void phase_rwkv_out(Frame& F, const Args& A, int nrows) {
    REFRESH(F);
    const bf16_t* Y0 = WSP(bf16_t, WS_YS); const bf16_t* Y1 = Y0 + (size_t)NT * D; const float* B0 = WSP(float, WS_BONUS); const float* B1 = B0 + (size_t)NT * 16;
    const bf16_t* Vv = WSP(bf16_t, WS_RKV) + (size_t)2 * NT * D; const bf16_t* Gg = WSP(bf16_t, WS_G); bf16_t* RO = WSP(bf16_t, WS_RO);
    const float* lnw = A.in[I_RLNW]; const float* lnb = A.in[I_RLNB];
    for (int it = 0;; ++it) { if (ROWOF(it, 0) >= nrows) break;
        f32x4 y[RB][4], vv[RB][4], gg[RB][4]; float bon[RB][4];
#pragma unroll
        for (int r = 0; r < RB; ++r) { const int row = ROWOF(it, r);
#pragma unroll
            for (int j = 0; j < 4; ++j) { const int col = 256 * j + 4 * F.lane, head = 4 * j + (F.lane >> 4); const size_t o = (size_t)row * D + col;
                y[r][j] = ld_bf4(Y0 + o) + ld_bf4(Y1 + o); vv[r][j] = ld_bf4(Vv + o); gg[r][j] = ld_bf4(Gg + o); bon[r][j] = B0[(size_t)row * 16 + head] + B1[(size_t)row * 16 + head]; } }
#pragma unroll
        for (int r = 0; r < RB; ++r) { const int row = ROWOF(it, r);
#pragma unroll
            for (int j = 0; j < 4; ++j) { const int col = 256 * j + 4 * F.lane; const size_t o = (size_t)row * D + col; const f32x4 yy = y[r][j];
                const float s = row16_sum((yy.x + yy.y) + (yy.z + yy.w));
                const f32x4 d = yy - s * (1.0f / 64.0f);
                const float q = row16_sum((d.x * d.x + d.y * d.y) + (d.z * d.z + d.w * d.w));
                const float rs = 1.0f / sqrtf(q * (1.0f / 64.0f) + 64e-5f);
                const f32x4 yn = d * rs * *(const f32x4*)(lnw + col) + *(const f32x4*)(lnb + col);
                { const f32x4 ov = (yn + vv[r][j] * bon[r][j]) * gg[r][j]; *(unsigned*)((unsigned char*)RO + o) = pk4_fp8(ov.x, ov.y, ov.z, ov.w); } } }
    }
}

__device__ __forceinline__ void phase_attn(Frame& F, const Args& A, int j, bool need_ctx) {
    REFRESH(F);
    const bf16_t* Q = WSP(bf16_t, WS_Q); const bf16_t* Kb = WSP(bf16_t, WS_K); const bf16_t* VT = WSP(bf16_t, WS_VT); bf16_t* O = WSP(bf16_t, WS_O);
    const float* sinks = A.in[I_ASINK] + j * 16;
    LAS bf16_t* Ks = (LAS bf16_t*)F.lds; LAS bf16_t* Vs = (LAS bf16_t*)(F.lds + 9216);
    LAS bf16x8* Qs = (LAS bf16x8*)(F.lds + 18432 + F.wave * 8192) + F.lane;
    const int nunits = 2048 + (need_ctx ? 256 : 0);
    const int fr = F.lane & 15, fq = F.lane >> 4, g = F.wave >> 1, hf = F.wave & 1;
    const float SC = 0.125f * 1.4426950408889634f;
    const int lr = F.tid >> 3, lch = F.tid & 7;
    __syncthreads();
    for (int u = F.c; u < nunits; u += F.G) {
        int b, kvh, qb; bool isx;
        if (u < 2048) { isx = true; b = u >> 6; kvh = (u >> 4) & 3; qb = u & 15; } else { const int v = u - 2048; isx = false; b = v >> 3; kvh = (v >> 1) & 3; qb = v & 1; }
        const int qrow0 = (isx ? b * T : NX + b * L) + qb * 128 + hf * 64; const int head = 4 * kvh + g;
        int jlo = 0, jhi = -1;
        if (isx) { jlo = qb == 0 ? 2 : 0; jhi = qb == 15 ? 3 : 5; }
        const int ntiles = 4 + (jhi - jlo + 1);
        auto tile_row0 = [&](int ti) -> int { return ti < 4 ? NX + b * L + ti * 64 : b * T + qb * 128 - 128 + 64 * (jlo + ti - 4); };
        u32x4 kv_n, vv_n;
        { const int kr0 = tile_row0(0); kv_n = *(const u32x4*)(Kb + (size_t)(kr0 + lr) * 256 + kvh * 64 + lch * 8); vv_n = *(const u32x4*)(VT + (size_t)(kvh * 64 + lr) * NT + kr0 + lch * 8); }
#pragma unroll
        for (int mq = 0; mq < 4; ++mq)
#pragma unroll
            for (int ks = 0; ks < 2; ++ks) Qs[64 * (mq * 2 + ks)] = *(const bf16x8*)(Q + (size_t)(qrow0 + 16 * mq + fr) * D + head * 64 + ks * 32 + 8 * fq);
        const float sink2 = sinks[head] * 1.4426950408889634f;
        float mrun[4], lrun[4]; f32x4 Oa[4][4];
#pragma unroll
        for (int mq = 0; mq < 4; ++mq) { mrun[mq] = sink2; lrun[mq] = fq == 0 ? 1.0f : 0.0f;
#pragma unroll
            for (int db = 0; db < 4; ++db) Oa[mq][db] = (f32x4){0.f, 0.f, 0.f, 0.f}; }
        for (int ti = 0; ti < ntiles; ++ti) {
            const int jl = ti < 4 ? -1 : jlo + ti - 4; const int ks0 = qb * 128 - 128 + 64 * jl;
            __syncthreads();
            *(LAS u32x4*)(Ks + lr * 72 + lch * 8) = kv_n; *(LAS u32x4*)(Vs + lr * 72 + lch * 8) = vv_n;
            __syncthreads();
            if (ti + 1 < ntiles) { const int kr0 = tile_row0(ti + 1); kv_n = *(const u32x4*)(Kb + (size_t)(kr0 + lr) * 256 + kvh * 64 + lch * 8); vv_n = *(const u32x4*)(VT + (size_t)(kvh * 64 + lr) * NT + kr0 + lch * 8); }
            const bool need = (jl < 0) || (jl >= hf && jl <= hf + 4);
            if (need) {
                const bool domask = (jl >= 0) && (jl == hf || jl == hf + 4);
                f32x4 Sa[4][4];
#pragma unroll
                for (int mq = 0; mq < 4; ++mq)
#pragma unroll
                    for (int n = 0; n < 4; ++n) Sa[mq][n] = (f32x4){0.f, 0.f, 0.f, 0.f};
#pragma unroll
                for (int ks = 0; ks < 2; ++ks) {
                    bf16x8 Qf[4];
#pragma unroll
                    for (int mq = 0; mq < 4; ++mq) Qf[mq] = Qs[64 * (mq * 2 + ks)];
#pragma unroll
                    for (int n = 0; n < 4; ++n) { const int kr = 32 * (n >> 1) + 8 * (fr >> 2) + 4 * (n & 1) + (fr & 3);
                        const bf16x8 Kf = *(const LAS bf16x8*)(Ks + kr * 72 + ks * 32 + 8 * fq);
#pragma unroll
                        for (int mq = 0; mq < 4; ++mq) Sa[mq][n] = __builtin_amdgcn_mfma_f32_16x16x32_bf16(Kf, Qf[mq], Sa[mq][n], 0, 0, 0); } }
                bf16x8 Pf[4][2];
#pragma unroll
                for (int mq = 0; mq < 4; ++mq) {
                    float mx = -1e30f;
                    if (domask) { const int tq = qb * 128 + hf * 64 + 16 * mq + fr;
#pragma unroll
                        for (int n = 0; n < 4; ++n)
#pragma unroll
                            for (int i = 0; i < 4; ++i) { float sv = Sa[mq][n][i] * SC; const int rel = ks0 + 32 * (n >> 1) + 8 * fq + 4 * (n & 1) + i - tq; if (rel > 128 || rel < -128) sv = -1e30f; Sa[mq][n][i] = sv; mx = fmaxf(mx, sv); } }
                    else {
#pragma unroll
                        for (int n = 0; n < 4; ++n)
#pragma unroll
                            for (int i = 0; i < 4; ++i) { const float sv = Sa[mq][n][i] * SC; Sa[mq][n][i] = sv; mx = fmaxf(mx, sv); } }
                    mx = fmaxf(mx, __shfl_xor(mx, 16)); mx = fmaxf(mx, __shfl_xor(mx, 32));
                    const float mnew = fmaxf(mrun[mq], mx); const float alpha = __builtin_amdgcn_exp2f(mrun[mq] - mnew); mrun[mq] = mnew;
                    float rs = 0.f;
#pragma unroll
                    for (int n = 0; n < 4; ++n)
#pragma unroll
                        for (int i = 0; i < 4; ++i) { const float p = __builtin_amdgcn_exp2f(Sa[mq][n][i] - mnew); Sa[mq][n][i] = p; rs += p; }
                    lrun[mq] = lrun[mq] * alpha + rs;
#pragma unroll
                    for (int db = 0; db < 4; ++db) Oa[mq][db] *= alpha;
#pragma unroll
                    for (int s2 = 0; s2 < 2; ++s2) { u32x4 w; w.x = cvt_pk_bf16(Sa[mq][2 * s2][0], Sa[mq][2 * s2][1]); w.y = cvt_pk_bf16(Sa[mq][2 * s2][2], Sa[mq][2 * s2][3]);
                        w.z = cvt_pk_bf16(Sa[mq][2 * s2 + 1][0], Sa[mq][2 * s2 + 1][1]); w.w = cvt_pk_bf16(Sa[mq][2 * s2 + 1][2], Sa[mq][2 * s2 + 1][3]); Pf[mq][s2] = __builtin_bit_cast(bf16x8, w); }
                }
#pragma unroll
                for (int db = 0; db < 4; ++db)
#pragma unroll
                    for (int s2 = 0; s2 < 2; ++s2) { const bf16x8 Vf = *(const LAS bf16x8*)(Vs + (16 * db + fr) * 72 + 32 * s2 + 8 * fq);
#pragma unroll
                        for (int mq = 0; mq < 4; ++mq) Oa[mq][db] = __builtin_amdgcn_mfma_f32_16x16x32_bf16(Vf, Pf[mq][s2], Oa[mq][db], 0, 0, 0); }
            }
        }
#pragma unroll
        for (int mq = 0; mq < 4; ++mq) { float l = lrun[mq]; l += __shfl_xor(l, 16); l += __shfl_xor(l, 32); const float inv = 1.0f / l;
            unsigned char* op = (unsigned char*)O + (size_t)(qrow0 + 16 * mq + fr) * D + head * 64 + 4 * fq;
#pragma unroll
            for (int db = 0; db < 4; ++db) { const f32x4 o = Oa[mq][db] * inv; *(unsigned*)(op + 16 * db) = pk4_fp8(o.x, o.y, o.z, o.w); } }
    }
    __syncthreads();
}

struct KState { XcdBarrier bar; int ph; };
#define RUN() (A.one || A.phase == KS.ph)
#define SEAM() do { if (A.one) xcd_barrier(KS.bar); ++KS.ph; } while (0)
template <int LAYER>
__device__ __forceinline__ void layer_body(Frame& F, const Args& A, KState& KS) {
    constexpr int layer = LAYER, kind = LAYER % 3, j = LAYER / 3; constexpr bool last = (LAYER == DEPTH - 1);
    LAS unsigned char* ring = F.lds;
    const LAS int* tpre = (const LAS int*)(F.lds + TPRE_OFF); const LAS int* lcnt = (const LAS int*)(F.lds + LCNT_OFF);
    bf16_t* H = WSP(bf16_t, WS_H); const float* MOD = WSP(float, WS_MOD); const bf16_t* AX = WSP(bf16_t, WS_AX);
    const float* gate1 = MOD + (size_t)layer * 33 * 6144 + 2 * D;
    constexpr int nMall = last ? NX / 256 : NT / 256;
    if (RUN()) phase_norm1(F, A, layer);
    SEAM();
    if constexpr (kind == 0) {
        if (RUN()) {
            { pg8::ProbDense8 P; P.A = (const unsigned char*)AX; P.Bt = WSP(unsigned char, WS_WQK) + (size_t)j * 1280 * D; P.lda = D; P.ldb = D; P.K = D; P.scale_w = SCALE_W; P.scale_x = SCALE_ONE; P.ord.init(NT / 256, 5, F.G, F.c);
              EpiQK E{WSP(bf16_t, WS_Q), WSP(bf16_t, WS_K), WSP(float, WS_BQK) + j * 1280, WSP(float, WS_ROPEC), WSP(float, WS_ROPES)};
              pg8::gemm_phase(ring, P, E); }
            { pg8::ProbDense8 P; P.A = WSP(unsigned char, WS_WV) + (size_t)j * 256 * D; P.Bt = (const unsigned char*)AX; P.lda = D; P.ldb = D; P.K = D; P.scale_w = SCALE_ONE; P.scale_x = SCALE_W; P.ord.init(1, NT / 256, F.G, F.c);
              EpiVT E{WSP(bf16_t, WS_VT), A.in[I_ABQKV] + j * 1536 + 1280};
              pg8::gemm_phase(ring, P, E); }
        }
        SEAM();
        if (RUN()) phase_attn(F, A, j, !last);
        SEAM();
        if (RUN()) { pg8::ProbDense8 P; P.A = WSP(unsigned char, WS_O); P.Bt = WSP(unsigned char, WS_WO) + (size_t)j * D * D; P.lda = D; P.ldb = D; P.K = D; P.scale_w = SCALE_W; P.scale_x = SCALE_ONE; P.ord.init(nMall, 4, F.G, F.c);
            EpiResid E{H, A.in[I_ABO] + j * D, nullptr, gate1};
            pg8::gemm_phase(ring, P, E); }
        SEAM();
    } else if constexpr (kind == 1) {
        if (RUN()) phase_pooldiff(F);
        SEAM();
        if (RUN()) { pg8::ProbDense P; P.A = WSP(bf16_t, WS_PD); P.Bt = WSP(bf16_t, WS_POOLW); P.lda = D; P.ldb = 256; P.K = 256; P.a_pn_off = 256; P.ord.init(nMall, 4, F.G, F.c);
            EpiResid E{H, A.in[I_PB], A.in[I_PS], gate1};
            pg8::gemm_phase(ring, P, E); }
        SEAM();
    } else {
        if (RUN()) phase_rwkv_mix(F, A);
        SEAM();
        if (RUN()) {
            for (int i = 0; i < 3; ++i) { const int sel = i == 0 ? 0 : i == 1 ? 2 : 3;
                pg8::ProbDense8 P; P.A = (const unsigned char*)(WSP(bf16_t, WS_A6) + (size_t)sel * NT * D); P.Bt = WSP(unsigned char, WS_WRKV) + (size_t)i * D * D; P.lda = D; P.ldb = D; P.K = D; P.scale_w = SCALE_W; P.scale_x = SCALE_ONE; P.ord.init(NT / 256, 4, F.G, F.c);
                EpiBf16Act E{WSP(bf16_t, WS_RKV) + (size_t)i * NT * D, D, nullptr, 0, 1.0f};
                pg8::gemm_phase(ring, P, E); }
            for (int i = 0; i < 3; ++i) { const int sel = i == 0 ? 5 : i == 1 ? 1 : 4;
                pg8::ProbDense P; P.A = WSP(bf16_t, WS_A6) + (size_t)sel * NT * D; P.Bt = WSP(bf16_t, WS_WL1) + (size_t)i * 256 * D; P.lda = D; P.ldb = D; P.K = D; P.a_pn_off = 0; P.ord.init(NT / 256, 1, F.G, F.c);
                EpiBf16Act E{WSP(bf16_t, WS_LORA) + i * 256, 768, nullptr, i == 0 ? 1 : i == 1 ? 2 : 0, 1.0f};
                pg8::gemm_phase(ring, P, E); }
        }
        SEAM();
        if (RUN()) {
            for (int i = 0; i < 5; ++i) {
                const int ablk = i == 0 ? 0 : i < 3 ? 1 : 2, d = (i - 1) & 1;
                pg8::ProbDense P; P.A = WSP(bf16_t, WS_LORA) + ablk * 256; P.Bt = WSP(bf16_t, WS_WL2) + (size_t)i * D * 256; P.lda = 768; P.ldb = 256; { int k128 = 128; asm volatile("" : "+s"(k128)); P.K = k128; }     P.a_pn_off = 0; P.ord.init(NT / 256, 4, F.G, F.c);
                EpiBf16Act E; E.ldc = D;
                if (i == 0) { E.O = WSP(bf16_t, WS_G); E.bias = nullptr; E.act = 0; E.scale = 1.0f; }
                else if (i < 3) { E.O = WSP(bf16_t, WS_E) + (size_t)d * NT * D; E.bias = A.in[I_RW0] + d * D; E.act = 1; E.scale = 0.6065306597126334f; }
                else { E.O = WSP(bf16_t, WS_A) + (size_t)d * NT * D; E.bias = A.in[I_RA0] + d * D; E.act = 1; E.scale = 1.0f; }
                pg8::gemm_phase(ring, P, E); }
        }
        SEAM();
        if (RUN()) phase_rwkv_scan(F, A);
        SEAM();
        if (RUN()) phase_rwkv_out(F, A, last ? NX : NT);
        SEAM();
        if (RUN()) { pg8::ProbDense8 P; P.A = WSP(unsigned char, WS_RO); P.Bt = WSP(unsigned char, WS_WOR); P.lda = D; P.ldb = D; P.K = D; P.scale_w = SCALE_W; P.scale_x = SCALE_ONE; P.ord.init(nMall, 4, F.G, F.c);
            EpiResid E{H, nullptr, nullptr, gate1};
            pg8::gemm_phase(ring, P, E); }
        SEAM();
    }
    if (RUN()) phase_route(F, A, layer);
    SEAM();
    if (RUN()) { moe_tiles(F, layer);
        ProbMoe1 P; P.FX = WSP(fp8_t, WS_FX); P.W1T = WSP(fp8_t, WS_W1T) + (size_t)layer * NE * 2048 * D; P.list = WSP(int, WS_LIST); P.tpre = tpre; P.cnt = lcnt; P.texp = (const LAS unsigned char*)(F.lds + TEXP_OFF); P.toks = (LAS int*)(F.lds + TOKS_OFF); P.scale_w = SCALE_W; P.scale_x = SCALE_ONE; P.ord.init(tpre[NE], 8, F.G, F.c);
        EpiMoe1 E{WSP(unsigned char, WS_ACT), A.in[I_MB1] + (size_t)layer * NE * 2048};
        pg8::gemm_phase(ring, P, E); }
    SEAM();
    if (RUN()) { moe_tiles(F, layer);
        ProbMoe2 P; P.ACT = WSP(fp8_t, WS_ACT); P.W2T = WSP(fp8_t, WS_W2T) + (size_t)layer * NE * D * D; P.tpre = tpre; P.texp = (const LAS unsigned char*)(F.lds + TEXP_OFF); P.scale_w = SCALE_W; P.scale_x = SCALE_ONE; P.ord.init(tpre[NE], 4, F.G, F.c);
        EpiMoe2 E{WSP(unsigned char, WS_Y), A.in[I_MB2] + (size_t)layer * NE * D};
        pg8::gemm_phase(ring, P, E); }
    SEAM();
}
__global__ void __launch_bounds__(NTHREADS, 2) trunk_fwd(Args A) {
    extern __shared__ __attribute__((aligned(16))) unsigned char lds_[];
    Frame F; F.lds = (LAS unsigned char*)lds_; REFRESH(F); F.wave = __builtin_amdgcn_readfirstlane(F.tid >> 6);
    F.G = gridDim.x; F.c = blockIdx.x; F.ws = A.ws; F.ctl = (unsigned*)(A.ws + WS_CTL);
    for (int u = F.tid; u < (LDS_BYTES - LDSCTL_OFF) / 4; u += NTHREADS) ((LAS unsigned*)(F.lds + LDSCTL_OFF))[u] = 0u;
    __syncthreads();
    KState KS; KS.bar.bar = F.ctl + CW_BAR; KS.bar.x = 0; KS.bar.st = nullptr; KS.ph = 0;
    if (A.one) KS.bar = xcd_barrier_post(F.ctl + CW_BAR, (volatile LAS unsigned*)(F.lds + MISC_OFF) + 8);
    if (RUN()) phase_prologue(F, A);
    SEAM();
    layer_body<0>(F, A, KS);
    layer_body<1>(F, A, KS);
    layer_body<2>(F, A, KS);
    layer_body<3>(F, A, KS);
    if (RUN()) phase_final(F, A);
}
#undef RUN
#undef SEAM
static int count_phases() { int n = 1; for (int layer = 0; layer < DEPTH; ++layer) { const int kind = layer % 3; n += 1 + (kind == 0 ? 3 : kind == 1 ? 2 : 6) + 3; } return n + 1; }

extern "C" void kernel_launch(void* const* d_in, const int* in_sizes, int n_in, void* d_out, int out_size, void* d_ws, size_t ws_size, hipStream_t stream) {
    static int grid = 0;
    if (grid == 0) {
        if (n_in != 38 || out_size != NX * D || ws_size < WS_END) { fprintf(stderr, "kernel_launch: unexpected problem (n_in %d, out %d, ws %zu < %zu)\n", n_in, out_size, ws_size, (size_t)WS_END); grid = -1; return; }
        int dev = 0, cus = 0;
        if (hipGetDevice(&dev) != hipSuccess || hipDeviceGetAttribute(&cus, hipDeviceAttributeMultiprocessorCount, dev) != hipSuccess) { grid = -1; return; }
        if (hipFuncSetAttribute((const void*)trunk_fwd, hipFuncAttributeMaxDynamicSharedMemorySize, LDS_BYTES) != hipSuccess) { fprintf(stderr, "kernel_launch: hipFuncSetAttribute failed\n"); grid = -1; return; }
        int per_cu = 0;
        if (hipOccupancyMaxActiveBlocksPerMultiprocessor(&per_cu, (const void*)trunk_fwd, NTHREADS, LDS_BYTES) != hipSuccess || per_cu < 1) fprintf(stderr, "kernel_launch: occupancy query says %d\n", per_cu);
        (void)hipGetLastError();
        grid = cus;
        if (grid != 256) fprintf(stderr, "kernel_launch: %d CUs (built for 256)\n", grid);
    }
    if (grid < 0) return;
    (void)hipMemsetAsync((char*)d_ws + WS_CTL, 0, CTL_BYTES, stream);
    (void)hipMemsetAsync((char*)d_ws + WS_LZERO, 0, LZERO_BYTES, stream);
    Args a{};
    for (int i = 0; i < 38; ++i) a.in[i] = (const float*)d_in[i];
    a.out = (float*)d_out; a.ws = (unsigned char*)d_ws;
#if MK_ONE_LAUNCH
    a.phase = 0; a.one = 1;
    hipLaunchKernelGGL(trunk_fwd, dim3(grid), dim3(NTHREADS), LDS_BYTES, stream, a);
#else
    const int nph = count_phases();
    for (int p = 0; p < nph; ++p) { a.phase = p; a.one = 0; hipLaunchKernelGGL(trunk_fwd, dim3(grid), dim3(NTHREADS), LDS_BYTES, stream, a); }
#endif
}
```

```cpp
#include <hip/hip_runtime.h>
#include <cstdio>
#include <cstdint>

#ifndef MK_ONE_LAUNCH
#define MK_ONE_LAUNCH 1
#endif
#define LAS __attribute__((address_space(3)))
#define GAS __attribute__((address_space(1)))
typedef unsigned short bf16_t;
typedef short bf16x8 __attribute__((ext_vector_type(8)));
typedef float f32x4 __attribute__((ext_vector_type(4)));
typedef float f32x2 __attribute__((ext_vector_type(2)));
typedef unsigned u32x4 __attribute__((ext_vector_type(4)));
typedef unsigned u32x2 __attribute__((ext_vector_type(2)));

constexpr int D = 1024, NB = 32, T = 2048, L = 256, DEPTH = 4;
constexpr int NX = NB * T, NC = NB * L, NT = NX + NC;
constexpr int NE = 32, TOPK = 4;
constexpr int NWAVES = 8, NTHREADS = 512;
constexpr int MAXRT = NT * TOPK / 256 + NE;

constexpr size_t MiB = 1u << 20;
constexpr size_t WS_CTL = 0, CTL_BYTES = 4 * MiB;
constexpr size_t WS_MOD = 4 * MiB;
constexpr size_t WS_ROPEC = 8 * MiB, WS_ROPES = 8 * MiB + 512 * 1024;
constexpr size_t WS_BQK = 9 * MiB;
constexpr size_t WS_WQK = 10 * MiB;
constexpr size_t WS_WV = 15 * MiB;
constexpr size_t WS_WO = 16 * MiB;
constexpr size_t WS_POOLW = 20 * MiB;
constexpr size_t WS_WRKV = 21 * MiB;
constexpr size_t WS_WOR = 27 * MiB;
constexpr size_t WS_WL1 = 30 * MiB;
constexpr size_t WS_WL2 = 32 * MiB;
constexpr size_t WS_LZERO = WS_WL1, LZERO_BYTES = 6 * MiB;
constexpr size_t WS_W1T = 40 * MiB;
constexpr size_t WS_W2T = 552 * MiB;
constexpr size_t WS_H = 808 * MiB;
constexpr size_t WS_AX = 1096 * MiB;
constexpr size_t WS_FX = 1240 * MiB;
constexpr size_t WS_R = 1384 * MiB;
constexpr size_t WS_ACT = WS_R;
constexpr size_t WS_Y = WS_R + 592 * MiB;
constexpr size_t WS_LIST = WS_R + 1184 * MiB;
constexpr size_t WS_POS = WS_R + 1193 * MiB;
constexpr size_t WS_GATE = WS_R + 1195 * MiB;
constexpr size_t WS_Q = WS_R;
constexpr size_t WS_K = WS_R + 144 * MiB;
constexpr size_t WS_VT = WS_R + 180 * MiB;
constexpr size_t WS_O = WS_R + 216 * MiB;
constexpr size_t WS_PD = WS_R;
constexpr size_t WS_A6 = WS_R;
constexpr size_t WS_E = WS_R;
constexpr size_t WS_A = WS_R + 288 * MiB;
constexpr size_t WS_RO = WS_R + 576 * MiB;
constexpr size_t WS_RKV = WS_R + 864 * MiB;
constexpr size_t WS_LORA = WS_R + 1296 * MiB;
constexpr size_t WS_G = WS_R + 1404 * MiB;
constexpr size_t WS_YS = WS_R + 1548 * MiB;
constexpr size_t WS_BONUS = WS_R + 2124 * MiB;
constexpr size_t WS_END = WS_R + 2134 * MiB;

constexpr int CW_BAR = 4096;
constexpr int CW_GCNT = 16384;
constexpr int LDS_BYTES = 147456;
constexpr int RING_BYTES = 131072;
constexpr int LDSCTL_OFF = 135168;
constexpr int MISC_OFF = LDSCTL_OFF;
constexpr int TPRE_OFF = LDSCTL_OFF + 256;
constexpr int LCNT_OFF = LDSCTL_OFF + 512;
constexpr int LBASE_OFF = LDSCTL_OFF + 768;
constexpr int REC_OFF = LDSCTL_OFF + 1024;
constexpr int TEXP_OFF = LDSCTL_OFF + 1024 + 2048;
constexpr int TOKS_OFF = LDSCTL_OFF + 1024 + 4096;
constexpr int BIAS_OFF = LDSCTL_OFF + 1024 + 6144;
constexpr int JOB_OFF = LDSCTL_OFF + 1024;

__device__ __forceinline__ unsigned f2bf(float f) { unsigned u = __builtin_bit_cast(unsigned, f); return (u + 0x7fffu + ((u >> 16) & 1u)) >> 16; }
__device__ __forceinline__ unsigned pk2(float lo, float hi) { return f2bf(lo) | (f2bf(hi) << 16); }
__device__ __forceinline__ float bflo(unsigned w) { return __builtin_bit_cast(float, w << 16); }
__device__ __forceinline__ float bfhi(unsigned w) { return __builtin_bit_cast(float, w & 0xffff0000u); }
__device__ __forceinline__ float bf1(bf16_t b) { return __builtin_bit_cast(float, ((unsigned)b) << 16); }
__device__ __forceinline__ unsigned pk4_fp8(float a, float b, float c, float d) {
    int w = __builtin_amdgcn_cvt_pk_fp8_f32(a, b, __builtin_bit_cast(int, a), false); w = __builtin_amdgcn_cvt_pk_fp8_f32(c, d, w, true); return (unsigned)w; }
typedef __bf16 bf16x2_t __attribute__((ext_vector_type(2)));
__device__ __forceinline__ unsigned cvt_pk_bf16(float lo, float hi) { const f32x2 v = {lo, hi}; return __builtin_bit_cast(unsigned, __builtin_convertvector(v, bf16x2_t)); }
__device__ __forceinline__ float dpp_add(float v, const int ctrl, const int row_mask) {
    switch (ctrl) {
    case 0xB1:  return v + __builtin_bit_cast(float, __builtin_amdgcn_update_dpp(0, __builtin_bit_cast(int, v), 0xB1, 0xf, 0xf, true));
    case 0x4E:  return v + __builtin_bit_cast(float, __builtin_amdgcn_update_dpp(0, __builtin_bit_cast(int, v), 0x4E, 0xf, 0xf, true));
    case 0x141: return v + __builtin_bit_cast(float, __builtin_amdgcn_update_dpp(0, __builtin_bit_cast(int, v), 0x141, 0xf, 0xf, true));
    case 0x140: return v + __builtin_bit_cast(float, __builtin_amdgcn_update_dpp(0, __builtin_bit_cast(int, v), 0x140, 0xf, 0xf, true));
    case 0x142: return v + __builtin_bit_cast(float, __builtin_amdgcn_update_dpp(0, __builtin_bit_cast(int, v), 0x142, 0xa, 0xf, true));
    default:    return v + __builtin_bit_cast(float, __builtin_amdgcn_update_dpp(0, __builtin_bit_cast(int, v), 0x143, 0xc, 0xf, true));
    }
}
__device__ __forceinline__ float row16_sum(float v) { v = dpp_add(v, 0xB1, 0xf); v = dpp_add(v, 0x4E, 0xf); v = dpp_add(v, 0x141, 0xf); v = dpp_add(v, 0x140, 0xf); return v; }
__device__ __forceinline__ float wave_sum(float v) {
    v = row16_sum(v); v = dpp_add(v, 0x142, 0xa); v = dpp_add(v, 0x143, 0xc);
    return __builtin_bit_cast(float, __builtin_amdgcn_readlane(__builtin_bit_cast(int, v), 63));
}
__device__ __forceinline__ float sigmoidf_(float x) { return __builtin_amdgcn_rcpf(1.0f + __builtin_amdgcn_exp2f(-1.4426950408889634f * x)); }
__device__ __forceinline__ int opaque_tid() { int t; asm volatile("v_mov_b32 %0, %1" : "=v"(t) : "v"(threadIdx.x)); return t; }
#define REFRESH(F) do { (F).tid = opaque_tid(); (F).lane = (F).tid & 63; } while (0)
__device__ __forceinline__ void seq_of(int row, int& sb, int& t, int& n) { if (row < NX) { sb = row & ~(T - 1); t = row & (T - 1); n = T; } else { const int r2 = row - NX; sb = NX + (r2 & ~(L - 1)); t = r2 & (L - 1); n = L; } }
__device__ __forceinline__ f32x4 ld_bf4(const bf16_t* p) { const u32x2 w = *(const u32x2*)p; return (f32x4){bflo(w.x), bfhi(w.x), bflo(w.y), bfhi(w.y)}; }
__device__ __forceinline__ void st_bf4(bf16_t* p, f32x4 v) { u32x2 w; w.x = pk2(v.x, v.y); w.y = pk2(v.z, v.w); *(u32x2*)p = w; }

#define LDS_WAIT() asm volatile("s_waitcnt lgkmcnt(0)" ::: "memory")
#define VM_WAIT() asm volatile("s_waitcnt vmcnt(0)" ::: "memory")

#define XB_TMO      128
#define XB_XCNT(j)  (256  + 64 * (j))
#define XB_XSUB(j)  (1280 + 64 * (j))
#define XB_XGEN(j)  (2304 + 64 * (j))
#define XB_TOP      3328
#define XB_TOPGEN   3392
#define XCD_BAR_WORDS 3456
#define XB_SPIN_CAP (1u << 18)
__device__ __forceinline__ unsigned xb_ld(unsigned* p)              { return __hip_atomic_load(p, __ATOMIC_RELAXED, __HIP_MEMORY_SCOPE_AGENT); }
__device__ __forceinline__ unsigned xb_add(unsigned* p, unsigned v) { return __hip_atomic_fetch_add(p, v, __ATOMIC_RELAXED, __HIP_MEMORY_SCOPE_AGENT); }
__device__ __forceinline__ unsigned xb_xcc_id() { return (unsigned)__builtin_amdgcn_s_getreg((3 << 11) | 20) & 0xFu; }
#define XB_SPIN(cond, bar) do { unsigned _sp = 0; while (cond) { __builtin_amdgcn_s_sleep(1); \
    if ((++_sp & 255u) == 0u) { if (xb_ld(&(bar)[XB_TMO])) break; if (_sp > XB_SPIN_CAP) { atomicAdd(&(bar)[XB_TMO], 1u); break; } } } } while (0)
struct XcdBarrier { unsigned* bar; unsigned x; volatile LAS unsigned* st; };
__device__ __forceinline__ XcdBarrier xcd_barrier_post(unsigned* bar, volatile LAS unsigned* st) {
    XcdBarrier b; b.bar = bar; b.x = xb_xcc_id(); b.st = st;
    if (threadIdx.x == 0) (void)xb_add(&bar[XB_XCNT(b.x)], 1u);
    return b;
}
__device__ __forceinline__ void xcd_barrier_complete(unsigned* bar, unsigned x, unsigned& nloc, unsigned& nx) {
    const unsigned G = gridDim.x * gridDim.y * gridDim.z;
    unsigned sum, cnt, mine, sp = 0u;
    for (;;) {
        sum = 0u; cnt = 0u; mine = 0u;
#pragma unroll
        for (unsigned j = 0; j < 16; ++j) { const unsigned c = xb_ld(&bar[XB_XCNT(j)]); sum += c; cnt += (c > 0u) ? 1u : 0u; mine = (j == x) ? c : mine; }
        if (sum == G) break;
        __builtin_amdgcn_s_sleep(1);
        if ((++sp & 255u) == 0u) { if (xb_ld(&bar[XB_TMO])) break; if (sp > XB_SPIN_CAP) { atomicAdd(&bar[XB_TMO], 1u); break; } }
    }
    nloc = mine > 0u ? mine : 1u; nx = cnt > 0u ? cnt : 1u;
}
__device__ __forceinline__ void xcd_barrier(const XcdBarrier& b) {
    asm volatile("s_waitcnt vmcnt(0)" ::: "memory");
    __syncthreads();
    if (threadIdx.x == 0) {
        unsigned* bar = b.bar;
        __builtin_amdgcn_s_waitcnt(0);
        unsigned nloc = b.st[0], nx = b.st[1];
        if (nloc == 0u) { xcd_barrier_complete(bar, b.x, nloc, nx); b.st[0] = nloc; b.st[1] = nx; }
        const unsigned old = xb_add(&bar[XB_XSUB(b.x)], 1u);
        const unsigned gen = old / nloc;
        if (old + 1u == (gen + 1u) * nloc) {
            __builtin_amdgcn_fence(__ATOMIC_RELEASE, "agent");
            asm volatile("s_waitcnt vmcnt(0)" ::: "memory");
            const unsigned og = xb_add(&bar[XB_TOP], 1u);
            const unsigned tg = og / nx;
            if (og + 1u == (tg + 1u) * nx) xb_add(&bar[XB_TOPGEN], 1u);
            else XB_SPIN(xb_ld(&bar[XB_TOPGEN]) == tg, bar);
            __builtin_amdgcn_fence(__ATOMIC_ACQUIRE, "agent");
            xb_add(&bar[XB_XGEN(b.x)], 1u);
            asm volatile("s_waitcnt vmcnt(0)" ::: "memory");
        } else {
            XB_SPIN(xb_ld(&bar[XB_XGEN(b.x)]) == gen, bar);
            __builtin_amdgcn_fence(__ATOMIC_ACQUIRE, "agent");
            asm volatile("s_waitcnt vmcnt(0)" ::: "memory");
        }
    }
    __syncthreads();
}

namespace pg8 {
constexpr int BM = 256, BK = 64, HALF = 128, HTB = HALF * BK * 2, STAGE_BYTES = 8 * HTB, NXCD = 8, WGM = 8;
__host__ __device__ __forceinline__ int lds_byte(int r, int c) { const int st = (r >> 4) * 2 + (c >> 5), rr = r & 15, cc = c & 31, ob = rr * 64 + cc * 2; return st * 1024 + (ob ^ (((ob >> 9) & 1) << 5)); }
__host__ __device__ __forceinline__ void stage_rc(int b, int& R, int& C) { const int st = b / 1024, sb = b % 1024, swz = sb ^ (((sb >> 9) & 1) << 5); R = (st >> 1) * 16 + swz / 64; C = (st & 1) * 32 + (swz % 64) / 2; }
__host__ __device__ __forceinline__ int perm32(int rho) { const int n = rho >> 4, i = rho & 15; return 8 * (i >> 2) + 4 * n + (i & 3); }

typedef int i32x8 __attribute__((ext_vector_type(8)));
typedef int i32x4 __attribute__((ext_vector_type(4)));
__device__ __forceinline__ i32x8 cat8(bf16x8 lo, bf16x8 hi) { const i32x4 a = __builtin_bit_cast(i32x4, lo), b = __builtin_bit_cast(i32x4, hi); return __builtin_shufflevector(a, b, 0, 1, 2, 3, 4, 5, 6, 7); }
struct Unit { int pm, pn, e, rt; };
struct TileOrder {
    int nM, nN, nwg, G, c; unsigned inv_nig;
    __device__ __forceinline__ void init(int nM_, int nN_, int G_, int c_) { nM = nM_; nN = nN_; nwg = nM * nN; G = G_; c = c_; inv_nig = (unsigned)((0x100000000ull + (unsigned)(WGM * nN_) - 1u) / (unsigned)(WGM * nN_)); }
    __device__ __forceinline__ bool next(int i, int& pm, int& pn) const {
        const long Lx = (long)i * G + c; if (Lx >= nwg) return false;
        int wgid = (int)Lx; { const int q = nwg >> 3, r = nwg & 7, xcd = wgid & 7, off = wgid >> 3; wgid = (xcd < r ? xcd * (q + 1) : r * (q + 1) + (xcd - r) * q) + off; }
        const int nig = WGM * nN, gid = (int)(((unsigned long long)(unsigned)wgid * inv_nig) >> 32), fm = gid * WGM, rem = wgid - gid * nig, left = nM - fm;
        if (left >= WGM) { pm = fm + (rem & (WGM - 1)); pn = rem >> 3; }
        else { pm = fm + rem % left; pn = rem / left; }
        return true;
    }
};
struct ProbDense {
    static constexpr bool FP8 = false;
    const bf16_t* A; const bf16_t* Bt; int lda, ldb, K, a_pn_off; TileOrder ord;
    __device__ __forceinline__ int ldb_bytes() const { return ldb * 2; }
    __device__ __forceinline__ int ntiles() const { return K / 64; }
    __device__ __forceinline__ bool next(int i, Unit& u) const { u.e = 0; const bool ok = ord.next(i, u.pm, u.pn); u.rt = u.pm; return ok; }
    __device__ __forceinline__ const char* a_ptr(const Unit& u) const { return (const char*)(A + (size_t)u.pm * BM * lda + (size_t)u.pn * a_pn_off); }
    __device__ __forceinline__ const char* b_ptr(const Unit& u) const { return (const char*)(Bt + (size_t)u.pn * BM * ldb); }
    __device__ __forceinline__ void list_prefetch(const Unit&, int, int, int) const {}
    __device__ __forceinline__ void a_off(const Unit&, int, const int (&R)[2], const int (&C)[2], unsigned (&v)[2][2]) const {
#pragma unroll
        for (int h = 0; h < 2; ++h)
#pragma unroll
            for (int i = 0; i < 2; ++i) v[h][i] = (unsigned)((h * HALF + R[i]) * lda + C[i]) * 2u;
    }
};

struct ProbDense8 {
    static constexpr bool FP8 = true;
    const unsigned char* A; const unsigned char* Bt; int lda, ldb, K, scale_w, scale_x; TileOrder ord;
    __device__ __forceinline__ int ldb_bytes() const { return ldb; }
    __device__ __forceinline__ int ntiles() const { return K / 128; }
    __device__ __forceinline__ bool next(int i, Unit& u) const { u.e = 0; const bool ok = ord.next(i, u.pm, u.pn); u.rt = u.pm; return ok; }
    __device__ __forceinline__ const char* a_ptr(const Unit& u) const { return (const char*)(A + (size_t)u.pm * BM * lda); }
    __device__ __forceinline__ const char* b_ptr(const Unit& u) const { return (const char*)(Bt + (size_t)u.pn * BM * ldb); }
    __device__ __forceinline__ void list_prefetch(const Unit&, int, int, int) const {}
    __device__ __forceinline__ void a_off(const Unit&, int, const int (&R)[2], const int (&C)[2], unsigned (&v)[2][2]) const {
#pragma unroll
        for (int h = 0; h < 2; ++h)
#pragma unroll
            for (int i = 0; i < 2; ++i) v[h][i] = (unsigned)((h * HALF + R[i]) * lda + C[i] * 2);
    }
};
template <class Prob, class Epi>
__device__ __forceinline__ void gemm_phase(LAS unsigned char* lds, const Prob& P, const Epi& E) {
    const int tid = opaque_tid(), wid = __builtin_amdgcn_readfirstlane(tid >> 6), lane = tid & 63, wr = wid >> 2, wc = wid & 3, fr = lane & 15, fq = lane >> 4;
    const int nt = P.ntiles(); const int ldbB = P.ldb_bytes();
    int Rr[2], Cc[2]; unsigned voffB[2];
#pragma unroll
    for (int i = 0; i < 2; ++i) { int R, C; stage_rc(tid * 16 + i * 8192, R, C); Rr[i] = R; Cc[i] = C; const int Rb = Epi::PERM ? ((R & ~31) + perm32(R & 31)) : R;
        voffB[i] = (unsigned)(Rb * ldbB + C * 2); }
    const size_t kstep = (size_t)(BK * 2);
    const size_t hstepB = (size_t)HALF * ldbB;
    const unsigned ldsw = (unsigned)wid * 1024u;
    const int aoff = lds_byte(wr * 64 + fr, fq * 8), boff = lds_byte(wc * 32 + fr, fq * 8);
#define PG8_SA(b, h) (((b) * 2 + (h)) * HTB)
#define PG8_SB(b, h) ((4 + (b) * 2 + (h)) * HTB)
#define PG8_STAGE(bufoff, gbase, voff) do { _Pragma("unroll") for (int _i = 0; _i < 2; ++_i) { \
        __builtin_amdgcn_global_load_lds((const unsigned*)((const char*)(gbase) + (voff)[_i]), (LAS unsigned*)(lds + (bufoff) + ldsw + _i * 8192), 16, 0, 0); } } while (0)
#define PG8_LDA(dst, b, h) do { _Pragma("unroll") for (int m = 0; m < 4; ++m) _Pragma("unroll") for (int k = 0; k < 2; ++k) dst[m][k] = *(const LAS bf16x8*)(lds + PG8_SA(b, h) + aoff + m * 2048 + k * 1024); } while (0)
#define PG8_LDB(dst, b, h) do { _Pragma("unroll") for (int n = 0; n < 2; ++n) _Pragma("unroll") for (int k = 0; k < 2; ++k) dst[n][k] = *(const LAS bf16x8*)(lds + PG8_SB(b, h) + boff + n * 2048 + k * 1024); } while (0)
#define PG8_MMA(ai, bj, At, Bt) do { __builtin_amdgcn_s_setprio(1); _Pragma("unroll") for (int m = 0; m < 4; ++m) _Pragma("unroll") for (int n = 0; n < 2; ++n) { \
        if constexpr (Prob::FP8) { asm volatile("v_mfma_scale_f32_16x16x128_f8f6f4 %0, %1, %2, %0, %3, %4 op_sel_hi:[0,0,0]" : "+v"(acc[ai][bj][m][n]) : "v"(cat8(Bt[n][0], Bt[n][1])), "v"(cat8(At[m][0], At[m][1])), "v"(sc_w), "v"(sc_x)); } \
        else { _Pragma("unroll") for (int k = 0; k < 2; ++k) acc[ai][bj][m][n] = __builtin_amdgcn_mfma_f32_16x16x32_bf16(Bt[n][k], At[m][k], acc[ai][bj][m][n], 0, 0, 0); } } __builtin_amdgcn_s_setprio(0); } while (0)
#define PG8_MMAZ(ai, bj, At, Bt) do { __builtin_amdgcn_s_setprio(1); _Pragma("unroll") for (int m = 0; m < 4; ++m) _Pragma("unroll") for (int n = 0; n < 2; ++n) { \
        if constexpr (Prob::FP8) { asm volatile("v_mfma_scale_f32_16x16x128_f8f6f4 %0, %1, %2, 0, %3, %4 op_sel_hi:[0,0,0]" : "=&v"(acc[ai][bj][m][n]) : "v"(cat8(Bt[n][0], Bt[n][1])), "v"(cat8(At[m][0], At[m][1])), "v"(sc_w), "v"(sc_x)); } \
        else { acc[ai][bj][m][n] = __builtin_amdgcn_mfma_f32_16x16x32_bf16(Bt[n][0], At[m][0], (f32x4){0.f, 0.f, 0.f, 0.f}, 0, 0, 0); acc[ai][bj][m][n] = __builtin_amdgcn_mfma_f32_16x16x32_bf16(Bt[n][1], At[m][1], acc[ai][bj][m][n], 0, 0, 0); } } __builtin_amdgcn_s_setprio(0); } while (0)
#define PG8_WAIT_V(n) asm volatile("s_waitcnt vmcnt(" #n ")" ::: "memory")
#define PG8_WAIT_V8R(flag) do { if constexpr (Epi::NSTORE > 0) asm volatile("s_cmp_lg_u32 %0, 0\n\ts_cbranch_scc1 .Lpg8w%=\n\ts_waitcnt vmcnt(8)\n.Lpg8w%=:\n\ts_waitcnt vmcnt(%1)" :: "s"(flag), "n"(8 + Epi::NSTORE) : "scc", "memory"); else PG8_WAIT_V(8); } while (0)
#define PG8_WAIT_L(n) asm volatile("s_waitcnt lgkmcnt(" #n ")" ::: "memory")
#define PG8_BAR __builtin_amdgcn_s_barrier()
#define PG8_SCHED __builtin_amdgcn_sched_barrier(0)
    Unit cur, nxt; int ui = 0;
    if (!P.next(0, cur)) return;
    const int ntm = nt - 1;
    int k0c = (cur.pm + 2 * cur.pn) & 7 & ntm;
    int sc_w = 0, sc_x = 0; if constexpr (Prob::FP8) { sc_w = P.scale_w; sc_x = P.scale_x; } (void)sc_w; (void)sc_x;
    f32x4 acc[2][2][4][2];
    bf16x8 At[4][2], B0[2][2], B1[2][2];
    unsigned vAc[2][2], vAn[2][2];
    Unit nx1; bool h1 = P.next(1, nx1);
    P.list_prefetch(cur, 0, wid, lane); if (h1) P.list_prefetch(nx1, 1, wid, lane);
    LAS float* const biasl = (LAS float*)(lds + BIAS_OFF); int bsc = 0;
    if constexpr (Epi::LDSBIAS) { if (wid == 1) E.prefetch(cur, biasl, lane); }
    PG8_WAIT_V(0); PG8_BAR;
    P.a_off(cur, 0, Rr, Cc, vAc);
    const char* cA = P.a_ptr(cur); const char* cB = P.b_ptr(cur);
    const size_t po0 = (size_t)k0c * kstep, po1 = (size_t)((k0c + 1) & ntm) * kstep;
    PG8_STAGE(PG8_SB(0, 0), cB + po0, voffB); PG8_STAGE(PG8_SB(0, 1), cB + hstepB + po0, voffB); PG8_STAGE(PG8_SA(0, 0), cA + po0, vAc[0]); PG8_STAGE(PG8_SA(0, 1), cA + po0, vAc[1]);
    if (wr == 1) PG8_BAR;
    PG8_WAIT_V(2); PG8_BAR;
    PG8_STAGE(PG8_SB(1, 0), cB + po1, voffB); PG8_STAGE(PG8_SA(1, 0), cA + po1, vAc[0]); PG8_STAGE(PG8_SB(1, 1), cB + hstepB + po1, voffB);
    PG8_WAIT_V(6); PG8_BAR;
    for (;;) {
        const bool has_next = h1; nxt = nx1;
        const char* nA = cA; const char* nB = cB;
#pragma unroll
        for (int h = 0; h < 2; ++h)
#pragma unroll
            for (int i = 0; i < 2; ++i) vAn[h][i] = vAc[h][i];
        int k0n = k0c;
        if (has_next) { nA = P.a_ptr(nxt); nB = P.b_ptr(nxt); P.a_off(nxt, (ui + 1) & 1, Rr, Cc, vAn); k0n = (nxt.pm + 2 * nxt.pn) & 7 & ntm; }
        h1 = has_next && P.next(ui + 2, nx1); if (h1) P.list_prefetch(nx1, ui & 1, wid, lane);
        const int bsn = (bsc == 2) ? 0 : bsc + 1;
        if constexpr (Epi::LDSBIAS) { if (has_next && wid == 1) E.prefetch(nxt, biasl + bsn * 256, lane); }
#define PG8_KBODY(T, MMX, W12) { const int t = (T); const bool last = (t == nt - 2); \
            asm volatile("" : "+v"(voffB[0]), "+v"(voffB[1]), "+v"(vAc[0][0]), "+v"(vAc[0][1]), "+v"(vAc[1][0]), "+v"(vAc[1][1])); \
            const char* a1 = cA + (size_t)((t + 1 + k0c) & ntm) * kstep; \
            const size_t o2 = (size_t)(last ? k0n : ((t + 2 + k0c) & ntm)) * kstep, o3 = (size_t)(last ? ((k0n + 1) & ntm) : ((t + 3 + k0c) & ntm)) * kstep; \
            const char* a2 = (last ? nA : cA) + o2; const char* b2 = (last ? nB : cB) + o2; \
            const char* a3 = (last ? nA : cA) + o3; const char* b3 = (last ? nB : cB) + o3; \
            unsigned vX[2][2]; \
            _Pragma("unroll") for (int h = 0; h < 2; ++h) _Pragma("unroll") for (int i = 0; i < 2; ++i) vX[h][i] = last ? vAn[h][i] : vAc[h][i]; \
            PG8_LDB(B0, 0, 0); PG8_LDB(B1, 0, 1); PG8_SCHED; PG8_LDA(At, 0, 0); PG8_STAGE(PG8_SA(1, 1), a1, vAc[1]); \
            W12; PG8_WAIT_L(0); PG8_BAR; MMX(0, 0, At, B0); MMX(0, 1, At, B1); PG8_BAR; PG8_SCHED; \
            PG8_LDA(At, 0, 1); PG8_STAGE(PG8_SB(0, 0), b2, voffB); PG8_STAGE(PG8_SB(0, 1), b2 + hstepB, voffB); PG8_STAGE(PG8_SA(0, 0), a2, vX[0]); \
            W12; PG8_WAIT_L(0); PG8_BAR; MMX(1, 0, At, B0); MMX(1, 1, At, B1); PG8_BAR; PG8_SCHED; \
            PG8_LDB(B0, 1, 0); PG8_LDB(B1, 1, 1); PG8_SCHED; PG8_LDA(At, 1, 0); PG8_STAGE(PG8_SA(0, 1), a2, vX[1]); \
            PG8_WAIT_V(8); PG8_WAIT_L(0); PG8_BAR; PG8_MMA(0, 0, At, B0); PG8_MMA(0, 1, At, B1); PG8_BAR; PG8_SCHED; \
            PG8_LDA(At, 1, 1); PG8_STAGE(PG8_SB(1, 0), b3, voffB); PG8_STAGE(PG8_SB(1, 1), b3 + hstepB, voffB); PG8_STAGE(PG8_SA(1, 0), a3, vX[0]); \
            PG8_WAIT_V(8); PG8_WAIT_L(0); PG8_BAR; PG8_MMA(1, 0, At, B0); PG8_MMA(1, 1, At, B1); PG8_BAR; PG8_SCHED; }
        if constexpr (Prob::FP8) {
            { const int rlx = __builtin_amdgcn_readfirstlane(ui != 0 ? 1 : 0);
              PG8_KBODY(0, PG8_MMAZ, PG8_WAIT_V8R(rlx)) }
            for (int tt = 2; tt < nt; tt += 2) PG8_KBODY(tt, PG8_MMA, PG8_WAIT_V(8))
        } else {
            { f32x4 zz = (f32x4){0.f, 0.f, 0.f, 0.f}; asm volatile("" : "+v"(zz));
#pragma unroll
                for (int a = 0; a < 2; ++a)
#pragma unroll
                    for (int b = 0; b < 2; ++b)
#pragma unroll
                        for (int m = 0; m < 4; ++m)
#pragma unroll
                            for (int n = 0; n < 2; ++n) acc[a][b][m][n] = zz; }
            for (int tt = 0; tt < nt; tt += 2) PG8_KBODY(tt, PG8_MMA, PG8_WAIT_V(8))
        }
#undef PG8_KBODY
        if (wr == 0) PG8_BAR;
        if constexpr (Prob::FP8) { asm volatile("s_nop 15\n\ts_nop 15" ::: "memory");
#pragma unroll
            for (int a = 0; a < 2; ++a)
#pragma unroll
                for (int b = 0; b < 2; ++b)
                    asm volatile("" : "+v"(acc[a][b][0][0]), "+v"(acc[a][b][0][1]), "+v"(acc[a][b][1][0]), "+v"(acc[a][b][1][1]), "+v"(acc[a][b][2][0]), "+v"(acc[a][b][2][1]), "+v"(acc[a][b][3][0]), "+v"(acc[a][b][3][1])); }
        if constexpr (Epi::LDSBIAS) E(acc, cur, wr, wc, fr, fq, biasl + bsc * 256); else E(acc, cur, wr, wc, fr, fq);
        if (!has_next) break;
        cur = nxt; cA = nA; cB = nB; k0c = k0n; bsc = bsn; ++ui;
#pragma unroll
        for (int h = 0; h < 2; ++h)
#pragma unroll
            for (int i = 0; i < 2; ++i) vAc[h][i] = vAn[h][i];
        if (wr == 1) PG8_BAR;
    }
    PG8_WAIT_V(0);
    PG8_BAR;
#undef PG8_SA
#undef PG8_SB
#undef PG8_STAGE
#undef PG8_LDA
#undef PG8_LDB
#undef PG8_MMA
#undef PG8_MMAZ
#undef PG8_WAIT_V
#undef PG8_WAIT_L
#undef PG8_WAIT_V8R
#undef PG8_BAR
#undef PG8_SCHED
}
}

using pg8::Unit;
constexpr int HALF_ = 128;
struct EpiBf16Act {
    static constexpr bool PERM = true; static constexpr bool LDSBIAS = false; static constexpr int NSTORE = 0;
    bf16_t* O; int ldc; const float* bias; int act; float scale;
    __device__ __forceinline__ void operator()(const f32x4 (&acc)[2][2][4][2], const Unit& u, int wr, int wc, int fr, int fq) const {
        const int row0 = u.pm * 256 + wr * 64 + fr, col0 = u.pn * 256 + wc * 32 + 8 * fq;
        f32x4 bv[2][2];
#pragma unroll
        for (int bj = 0; bj < 2; ++bj)
#pragma unroll
            for (int n = 0; n < 2; ++n) bv[bj][n] = bias ? *(const f32x4*)(bias + col0 + bj * HALF_ + 4 * n) : (f32x4){0.f, 0.f, 0.f, 0.f};
#pragma unroll
        for (int ai = 0; ai < 2; ++ai)
#pragma unroll
            for (int m = 0; m < 4; ++m) { bf16_t* rowp = O + (size_t)(row0 + ai * HALF_ + m * 16) * ldc + col0;
#pragma unroll
                for (int bj = 0; bj < 2; ++bj) { f32x4 v0 = acc[ai][bj][m][0] + bv[bj][0], v1 = acc[ai][bj][m][1] + bv[bj][1];
                    if (act == 1) {
#pragma unroll
                        for (int j = 0; j < 4; ++j) { v0[j] = sigmoidf_(v0[j]) * scale; v1[j] = sigmoidf_(v1[j]) * scale; } }
                    else if (act == 2) {
#pragma unroll
                        for (int j = 0; j < 4; ++j) { v0[j] = 1.0f - 2.0f * __builtin_amdgcn_rcpf(__builtin_amdgcn_exp2f(2.8853900817779268f * v0[j]) + 1.0f); v1[j] = 1.0f - 2.0f * __builtin_amdgcn_rcpf(__builtin_amdgcn_exp2f(2.8853900817779268f * v1[j]) + 1.0f); } }
                    u32x4 w; w.x = cvt_pk_bf16(v0[0], v0[1]); w.y = cvt_pk_bf16(v0[2], v0[3]); w.z = cvt_pk_bf16(v1[0], v1[1]); w.w = cvt_pk_bf16(v1[2], v1[3]);
                    *(u32x4*)(rowp + bj * HALF_) = w; } }
    }
};
struct EpiQK {
    static constexpr bool PERM = true; static constexpr bool LDSBIAS = false; static constexpr int NSTORE = 0;
    bf16_t* Q; bf16_t* Kb; const float* bias; const float* ropec; const float* ropes;
    __device__ __forceinline__ void operator()(const f32x4 (&acc)[2][2][4][2], const Unit& u, int wr, int wc, int fr, int fq) const {
        int row0 = u.pm * 256 + wr * 64 + fr, cl0 = wc * 32 + 8 * fq;
        asm volatile("" : "+v"(row0), "+v"(cl0));
        const int g = (4 * wc + fq) & 7;
        bf16_t* base; int ldc;
        if (u.pn < 4) { base = Q + u.pn * 256; ldc = 1024; } else { base = Kb; ldc = 256; }
        f32x4 bv[2][2];
#pragma unroll
        for (int bj = 0; bj < 2; ++bj)
#pragma unroll
            for (int n = 0; n < 2; ++n) bv[bj][n] = *(const f32x4*)(bias + u.pn * 256 + cl0 + bj * HALF_ + 4 * n);
#pragma unroll
        for (int ai = 0; ai < 2; ++ai)
#pragma unroll
            for (int m = 0; m < 4; ++m) { const int row = row0 + ai * HALF_ + m * 16; bf16_t* rowp = base + (size_t)row * ldc + cl0;
                f32x4 cs = (f32x4){1.f, 1.f, 1.f, 1.f}, sn = (f32x4){0.f, 0.f, 0.f, 0.f};
                if (row < NX) { const int t = row & (T - 1); cs = *(const f32x4*)(ropec + t * 32 + g * 4); sn = *(const f32x4*)(ropes + t * 32 + g * 4); }
#pragma unroll
                for (int bj = 0; bj < 2; ++bj) { const f32x4 v0 = acc[ai][bj][m][0] + bv[bj][0], v1 = acc[ai][bj][m][1] + bv[bj][1];
                    const f32x4 o0 = v0 * cs - v1 * sn, o1 = v1 * cs + v0 * sn;
                    u32x4 w; w.x = cvt_pk_bf16(o0[0], o0[1]); w.y = cvt_pk_bf16(o0[2], o0[3]); w.z = cvt_pk_bf16(o1[0], o1[1]); w.w = cvt_pk_bf16(o1[2], o1[3]);
                    *(u32x4*)(rowp + bj * HALF_) = w; } }
    }
};
struct EpiVT {
    static constexpr bool PERM = true; static constexpr bool LDSBIAS = false; static constexpr int NSTORE = 0;
    bf16_t* VT; const float* biasrow;
    __device__ __forceinline__ void operator()(const f32x4 (&acc)[2][2][4][2], const Unit& u, int wr, int wc, int fr, int fq) const {
        int row0 = wr * 64 + fr, col0 = u.pn * 256 + wc * 32 + 8 * fq;
        asm volatile("" : "+v"(row0), "+v"(col0));
#pragma unroll
        for (int ai = 0; ai < 2; ++ai)
#pragma unroll
            for (int m = 0; m < 4; ++m) { const int row = row0 + ai * HALF_ + m * 16; const float b = biasrow[row]; bf16_t* rowp = VT + (size_t)row * NT + col0;
#pragma unroll
                for (int bj = 0; bj < 2; ++bj) { const f32x4 v0 = acc[ai][bj][m][0] + b, v1 = acc[ai][bj][m][1] + b;
                    u32x4 w; w.x = cvt_pk_bf16(v0[0], v0[1]); w.y = cvt_pk_bf16(v0[2], v0[3]); w.z = cvt_pk_bf16(v1[0], v1[1]); w.w = cvt_pk_bf16(v1[2], v1[3]);
                    *(u32x4*)(rowp + bj * HALF_) = w; } }
    }
};
struct EpiResid {
    static constexpr bool PERM = true; static constexpr bool LDSBIAS = false; static constexpr int NSTORE = 0;
    bf16_t* H; const float* bias; const float* ls; const float* gate;
    __device__ __forceinline__ void operator()(const f32x4 (&acc)[2][2][4][2], const Unit& u, int wr, int wc, int fr, int fq) const {
        int row0 = u.pm * 256 + wr * 64 + fr, col0 = u.pn * 256 + wc * 32 + 8 * fq;
        asm volatile("" : "+v"(row0), "+v"(col0));
        f32x4 bv[2][2], lv[2][2];
#pragma unroll
        for (int bj = 0; bj < 2; ++bj)
#pragma unroll
            for (int n = 0; n < 2; ++n) { bv[bj][n] = bias ? *(const f32x4*)(bias + col0 + bj * HALF_ + 4 * n) : (f32x4){0.f, 0.f, 0.f, 0.f};
                                          lv[bj][n] = ls ? *(const f32x4*)(ls + col0 + bj * HALF_ + 4 * n) : (f32x4){1.f, 1.f, 1.f, 1.f}; }
#pragma unroll
        for (int ai = 0; ai < 2; ++ai)
#pragma unroll
            for (int m = 0; m < 4; ++m) { const int row = row0 + ai * HALF_ + m * 16; const int brow = row < NX ? (row >> 11) : 32;
                bf16_t* hp = H + (size_t)row * D + col0; const float* gp = gate + (size_t)brow * (6 * D) + col0;
#pragma unroll
                for (int bj = 0; bj < 2; ++bj) { const u32x4 hw = *(const u32x4*)(hp + bj * HALF_);
                    const f32x4 g0 = *(const f32x4*)(gp + bj * HALF_), g1 = *(const f32x4*)(gp + bj * HALF_ + 4);
                    const f32x4 y0 = (acc[ai][bj][m][0] + bv[bj][0]) * lv[bj][0], y1 = (acc[ai][bj][m][1] + bv[bj][1]) * lv[bj][1];
                    const f32x4 h0 = (f32x4){bflo(hw.x), bfhi(hw.x), bflo(hw.y), bfhi(hw.y)} + g0 * y0, h1 = (f32x4){bflo(hw.z), bfhi(hw.z), bflo(hw.w), bfhi(hw.w)} + g1 * y1;
                    u32x4 w; w.x = cvt_pk_bf16(h0[0], h0[1]); w.y = cvt_pk_bf16(h0[2], h0[3]); w.z = cvt_pk_bf16(h1[0], h1[1]); w.w = cvt_pk_bf16(h1[2], h1[3]);
                    *(u32x4*)(hp + bj * HALF_) = w; }
                asm volatile("" ::: "memory"); }
    }
};
struct EpiMoe1 {
    static constexpr bool PERM = true; static constexpr bool LDSBIAS = true; static constexpr int NSTORE = 8;
    unsigned char* ACT; const float* b1;
    __device__ __forceinline__ void prefetch(const Unit& u, LAS float* slot, int lane) const {
        const float* src = b1 + (size_t)u.e * 2048 + u.pn * 128 + (lane >> 5) * 1024 + (lane & 31) * 4;
        __builtin_amdgcn_global_load_lds((const unsigned*)src, (LAS unsigned*)slot, 16, 0, 0); }
    __device__ __forceinline__ void operator()(const f32x4 (&acc)[2][2][4][2], const Unit& u, int wr, int wc, int fr, int fq, const LAS float* bias) const {
        unsigned char* const Ab = ACT + ((size_t)u.rt * 256 * D + (size_t)u.pn * 128);
        unsigned voff = (unsigned)((wr * 64 + fr) * D + wc * 32 + 8 * fq); asm volatile("" : "+v"(voff));
        const LAS float* bg = bias + wc * 32 + 8 * fq; const LAS float* bl = bg + 128;
        f32x4 bgv[2], blv[2];
#pragma unroll
        for (int n = 0; n < 2; ++n) { bgv[n] = *(const LAS f32x4*)(bg + 4 * n); blv[n] = *(const LAS f32x4*)(bl + 4 * n); }
#pragma unroll
        for (int ai = 0; ai < 2; ++ai)
#pragma unroll
            for (int m = 0; m < 4; ++m) { unsigned char* rowp = Ab + (size_t)(ai * HALF_ + m * 16) * D + voff;
                f32x4 o[2];
#pragma unroll
                for (int n = 0; n < 2; ++n) { const f32x4 c7 = (f32x4){7.f, 7.f, 7.f, 7.f};
                    const f32x4 gl = __builtin_elementwise_min(acc[ai][0][m][n] + bgv[n], c7), li = __builtin_elementwise_min(__builtin_elementwise_max(acc[ai][1][m][n] + blv[n], -c7), c7);
                    const f32x4 z = gl * (-1.702f * 1.4426950408889634f);
#pragma unroll
                    for (int j = 0; j < 4; j += 2) {
                        f32x2 d2 = (f32x2){__builtin_amdgcn_exp2f(z[j]), __builtin_amdgcn_exp2f(z[j + 1])} + 1.0f; asm("" : "+v"(d2));
                        f32x2 gd = (f32x2){gl[j], gl[j + 1]} * (f32x2){__builtin_amdgcn_rcpf(d2.x), __builtin_amdgcn_rcpf(d2.y)}; asm("" : "+v"(gd));
                        const f32x2 o2 = gd * (f32x2){li[j], li[j + 1]} + gd;
                        o[n][j] = o2.x; o[n][j + 1] = o2.y; } }
                u32x2 w; w.x = pk4_fp8(o[0][0], o[0][1], o[0][2], o[0][3]); w.y = pk4_fp8(o[1][0], o[1][1], o[1][2], o[1][3]);
                *(u32x2*)rowp = w; }
    }
};
struct EpiMoe2 {
    static constexpr bool PERM = true; static constexpr bool LDSBIAS = true; static constexpr int NSTORE = 16;
    unsigned char* Y; const float* b2;
    __device__ __forceinline__ void prefetch(const Unit& u, LAS float* slot, int lane) const {
        const float* src = b2 + (size_t)u.e * D + u.pn * 256 + lane * 4;
        __builtin_amdgcn_global_load_lds((const unsigned*)src, (LAS unsigned*)slot, 16, 0, 0); }
    __device__ __forceinline__ void operator()(const f32x4 (&acc)[2][2][4][2], const Unit& u, int wr, int wc, int fr, int fq, const LAS float* bias) const {
        unsigned char* const Yb = Y + ((size_t)u.rt * 256 * D + (size_t)u.pn * 256);
        unsigned voff = (unsigned)((wr * 64 + fr) * D + wc * 32 + 8 * fq); asm volatile("" : "+v"(voff));
        const LAS float* bb = bias + wc * 32 + 8 * fq;
        f32x4 bv[2][2];
#pragma unroll
        for (int bj = 0; bj < 2; ++bj)
#pragma unroll
            for (int n = 0; n < 2; ++n) bv[bj][n] = *(const LAS f32x4*)(bb + bj * HALF_ + 4 * n);
#pragma unroll
        for (int ai = 0; ai < 2; ++ai)
#pragma unroll
            for (int m = 0; m < 4; ++m) { unsigned char* rowp = Yb + (size_t)(ai * HALF_ + m * 16) * D + voff;
#pragma unroll
                for (int bj = 0; bj < 2; ++bj) { f32x4 v0 = bv[bj][0] * 4.0f + acc[ai][bj][m][0], v1 = bv[bj][1] * 4.0f + acc[ai][bj][m][1];
#pragma unroll
                    for (int i = 0; i < 4; ++i) { v0[i] = __builtin_amdgcn_fmed3f(v0[i], -448.0f, 448.0f); v1[i] = __builtin_amdgcn_fmed3f(v1[i], -448.0f, 448.0f); }
                    *(u32x2*)(rowp + bj * HALF_) = (u32x2){pk4_fp8(v0[0], v0[1], v0[2], v0[3]), pk4_fp8(v1[0], v1[1], v1[2], v1[3])}; } }
    }
};
typedef unsigned char fp8_t;
constexpr int SCALE_ONE = 0x7f7f7f7f, SCALE_W = 0x79797979, SCALE_W4 = 0x7b7b7b7b;
struct ProbMoe1 {
    static constexpr bool FP8 = true;
    const fp8_t* FX; const fp8_t* W1T; const int* list; const LAS int* tpre; const LAS int* cnt; const LAS unsigned char* texp; LAS int* toks; int scale_w, scale_x; pg8::TileOrder ord;
    __device__ __forceinline__ int ldb_bytes() const { return D; }
    __device__ __forceinline__ int ntiles() const { return D / 128; }
    __device__ __forceinline__ bool next(int i, Unit& u) const {
        if (!ord.next(i, u.pm, u.pn)) return false;
        u.rt = u.pm; u.e = texp[u.rt]; return true;
    }
    __device__ __forceinline__ const char* a_ptr(const Unit&) const { return (const char*)FX; }
    __device__ __forceinline__ const char* b_ptr(const Unit& u) const { return (const char*)(W1T + ((size_t)u.e * 2048 + (size_t)u.pn * 256) * D); }
    __device__ __forceinline__ void list_prefetch(const Unit& u, int par, int wid, int lane) const {
        if (wid == 0) { const int* src = list + (size_t)u.e * NT + (u.rt - tpre[u.e]) * 256 + 4 * lane;
            __builtin_amdgcn_global_load_lds((const unsigned*)src, (LAS unsigned*)(toks + par * 256), 16, 0, 0); }
    }
    __device__ __forceinline__ void a_off(const Unit& u, int par, const int (&R)[2], const int (&C)[2], unsigned (&v)[2][2]) const {
        const int nvalid = cnt[u.e] - (u.rt - tpre[u.e]) * 256; const LAS int* tk = toks + par * 256;
#pragma unroll
        for (int h = 0; h < 2; ++h)
#pragma unroll
            for (int i = 0; i < 2; ++i) { const int r = h * 128 + R[i]; const int tok = tk[r < nvalid ? r : 0]; v[h][i] = (unsigned)(tok * D + C[i] * 2); }
    }
};
struct ProbMoe2 {
    static constexpr bool FP8 = true;
    const fp8_t* ACT; const fp8_t* W2T; const LAS int* tpre; const LAS unsigned char* texp; int scale_w, scale_x; pg8::TileOrder ord;
    __device__ __forceinline__ int ldb_bytes() const { return D; }
    __device__ __forceinline__ int ntiles() const { return D / 128; }
    __device__ __forceinline__ bool next(int i, Unit& u) const {
        if (!ord.next(i, u.pm, u.pn)) return false;
        u.rt = ord.nM - 1 - u.pm; u.e = texp[u.rt]; return true;
    }
    __device__ __forceinline__ const char* a_ptr(const Unit& u) const { return (const char*)(ACT + (size_t)u.rt * 256 * D); }
    __device__ __forceinline__ const char* b_ptr(const Unit& u) const { return (const char*)(W2T + ((size_t)u.e * 1024 + (size_t)u.pn * 256) * D); }
    __device__ __forceinline__ void list_prefetch(const Unit&, int, int, int) const {}
    __device__ __forceinline__ void a_off(const Unit&, int, const int (&R)[2], const int (&C)[2], unsigned (&v)[2][2]) const {
#pragma unroll
        for (int h = 0; h < 2; ++h)
#pragma unroll
            for (int i = 0; i < 2; ++i) v[h][i] = (unsigned)((h * 128 + R[i]) * D + C[i] * 2);
    }
};
struct Args { const float* in[38]; float* out; unsigned char* ws; int phase; int one; };
enum { I_X = 0, I_C, I_CTX, I_CCTX, I_ADAW, I_ADAB, I_NORMG, I_AWQKV, I_ABQKV, I_AWO, I_ABO, I_ASINK, I_PW, I_PB, I_PS,
       I_RMIX, I_RWRKV, I_RW0, I_RW1, I_RW2, I_RA0, I_RA1, I_RA2, I_RG1, I_RG2, I_RKK, I_RKA, I_RRK, I_RLNW, I_RLNB, I_RWO,
       I_MWR, I_MBR, I_MW1, I_MB1, I_MW2, I_MB2, I_FG };
struct Frame { LAS unsigned char* lds; int tid, lane, wave, G, c; unsigned char* ws; unsigned* ctl; };
#define WSP(T_, off) ((T_*)(F.ws + (off)))

struct TJob { const float* src; unsigned char* dst; long sbs, dbs; int ldw, ldt, nkb, nnb, mode, item0, per, esz; };
__device__ __forceinline__ int dst_row(int mode, int n) {
    if (mode == 1) { const int hb = n & ~63, d = n & 63; const int ax = d >> 5, dd = d & 31, hf = dd >> 4, f = dd & 15; const int g = ax * 4 + (f >> 2), i = (f & 3) + 4 * hf; return hb + 8 * g + i; }
    if (mode == 2) { return n < 1024 ? ((n >> 7) << 8) + (n & 127) : (((n - 1024) >> 7) << 8) + 128 + (n & 127); }
    return n;
}
struct TItem { const float* src; unsigned char* dst; int ldw, ldt, mode, n0, esz; };
__device__ __forceinline__ void titem_decode(const LAS TJob* jobs, int nj, int it, TItem& T) {
    int ji = 0;
    for (int q = 1; q < nj; ++q) ji += (jobs[q].item0 <= it) ? 1 : 0;
    const LAS TJob& J = jobs[ji]; const int r = it - J.item0, bi = r / J.per, rr = r % J.per, kb = rr / J.nnb, nb = rr % J.nnb;
    T.src = J.src + bi * J.sbs + (size_t)(64 * kb) * J.ldw + 32 * nb; T.dst = J.dst + (bi * J.dbs + 64 * kb) * J.esz; T.ldw = J.ldw; T.ldt = J.ldt; T.mode = J.mode; T.n0 = 32 * nb; T.esz = J.esz;
}
__device__ __forceinline__ void titem_load(const TItem& T, int lane, f32x4 (&v)[8]) {
    const float* p = T.src + (size_t)(lane >> 3) * T.ldw + 4 * (lane & 7);
#pragma unroll
    for (int i = 0; i < 8; ++i) v[i] = *(const f32x4*)(p + (size_t)(8 * i) * T.ldw);
}
__device__ __forceinline__ void titem_store(const TItem& T, int lane, const f32x4 (&v)[8], LAS float* scr) {
#pragma unroll
    for (int i = 0; i < 8; ++i) { LAS float* d = scr + (8 * i + (lane >> 3)) * 33 + 4 * (lane & 7); d[0] = v[i].x; d[1] = v[i].y; d[2] = v[i].z; d[3] = v[i].w; }
    LDS_WAIT(); asm volatile("" ::: "memory");
    const int c = lane & 7;
#pragma unroll
    for (int j = 0; j < 4; ++j) { const int n = (lane >> 3) + 8 * j; const LAS float* s = scr + (8 * c) * 33 + n;
        const size_t eo = (size_t)dst_row(T.mode, T.n0 + n) * T.ldt + 8 * c;
        if (T.esz == 2) { u32x4 o; o.x = pk2(s[0 * 33], s[1 * 33]); o.y = pk2(s[2 * 33], s[3 * 33]); o.z = pk2(s[4 * 33], s[5 * 33]); o.w = pk2(s[6 * 33], s[7 * 33]); *(u32x4*)(T.dst + eo * 2) = o; }
        else { u32x2 o; o.x = pk4_fp8(64.f * s[0 * 33], 64.f * s[1 * 33], 64.f * s[2 * 33], 64.f * s[3 * 33]); o.y = pk4_fp8(64.f * s[4 * 33], 64.f * s[5 * 33], 64.f * s[6 * 33], 64.f * s[7 * 33]); *(u32x2*)(T.dst + eo) = o; } }
    LDS_WAIT(); asm volatile("" ::: "memory");
}
__device__ __forceinline__ void phase_prologue(Frame& F, const Args& A) {
    REFRESH(F);
    LAS float* S = (LAS float*)F.lds;
    for (int idx = F.tid; idx < 33 * 1024; idx += NTHREADS) { const int r = idx >> 10, k = idx & 1023; const float v = r < 32 ? A.in[I_C][r * 1024 + k] : A.in[I_CCTX][k]; S[k * 33 + r] = v / (1.0f + __expf(-v)); }
    __syncthreads();
    float* MOD = WSP(float, WS_MOD);
    for (int it = F.c; it < 4 * 48; it += F.G) {
        const int layer = it / 48, n = (it % 48) * 128 + F.lane; const float* wp = A.in[I_ADAW] + (size_t)layer * 1024 * 6144 + n;
        float acc[5] = {0.f, 0.f, 0.f, 0.f, 0.f}, acd[5] = {0.f, 0.f, 0.f, 0.f, 0.f};
        for (int k0 = 0; k0 < 1024; k0 += 16) {
            float wv[16], wd[16];
#pragma unroll
            for (int u = 0; u < 16; ++u) { wv[u] = wp[(size_t)(k0 + u) * 6144]; wd[u] = wp[(size_t)(k0 + u) * 6144 + 64]; }
#pragma unroll
            for (int u = 0; u < 16; ++u) { const LAS float* sr = S + (k0 + u) * 33 + F.wave; const float s0 = sr[0], s1 = sr[8], s2 = sr[16], s3 = sr[24];
                acc[0] += s0 * wv[u]; acc[1] += s1 * wv[u]; acc[2] += s2 * wv[u]; acc[3] += s3 * wv[u];
                acd[0] += s0 * wd[u]; acd[1] += s1 * wd[u]; acd[2] += s2 * wd[u]; acd[3] += s3 * wd[u];
                if (F.wave == 0) { const float s4 = S[(k0 + u) * 33 + 32]; acc[4] += s4 * wv[u]; acd[4] += s4 * wd[u]; } }
        }
        const float bb = A.in[I_ADAB][layer * 6144 + n], bd = A.in[I_ADAB][layer * 6144 + n + 64];
#pragma unroll
        for (int i = 0; i < 4; ++i) { MOD[((size_t)layer * 33 + F.wave + 8 * i) * 6144 + n] = acc[i] + bb; MOD[((size_t)layer * 33 + F.wave + 8 * i) * 6144 + n + 64] = acd[i] + bd; }
        if (F.wave == 0) { MOD[((size_t)layer * 33 + 32) * 6144 + n] = acc[4] + bb; MOD[((size_t)layer * 33 + 32) * 6144 + n + 64] = acd[4] + bd; }
    }
    { float* rc = WSP(float, WS_ROPEC); float* rs = WSP(float, WS_ROPES);
      for (int idx = F.c * NTHREADS + F.tid; idx < 2048 * 32; idx += F.G * NTHREADS) { const int t = idx >> 5, e = idx & 31, g = e >> 2, i = e & 3, f = 4 * (g & 3) + i;
          const float inv = powf(10000.0f, -(float)f / 16.0f); const float pos = (float)(g < 4 ? (t >> 6) : (t & 63)); const float ang = pos * inv; rc[idx] = cosf(ang); rs[idx] = sinf(ang); }
      float* bq = WSP(float, WS_BQK);
      for (int idx = F.c * NTHREADS + F.tid; idx < 2 * 1280; idx += F.G * NTHREADS) { const int j = idx / 1280, n = idx % 1280; bq[j * 1280 + dst_row(1, n)] = A.in[I_ABQKV][j * 1536 + n]; } }
    __syncthreads();
    LAS TJob* jobs = (LAS TJob*)(F.lds + JOB_OFF); LAS int* njobs = (LAS int*)(F.lds + MISC_OFF + 64);
    if (F.tid == 0) {
        int nj = 0, item = 0;
        auto add = [&](const float* src, bf16_t* dst, int ldw, int ldt, int Ks, int Ns, int mode, int nb, long sbs, long dbs, int esz = 2) {
            LAS TJob& j = jobs[nj]; j.src = src; j.dst = (unsigned char*)dst; j.sbs = sbs; j.dbs = dbs; j.ldw = ldw; j.ldt = ldt; j.nkb = Ks / 64; j.nnb = Ns / 32; j.mode = mode; j.item0 = item; j.per = (Ks / 64) * (Ns / 32); j.esz = esz;
            ++nj; item += (Ks / 64) * (Ns / 32) * nb; };
        add(A.in[I_AWQKV], WSP(bf16_t, WS_WQK), 1536, 1024, 1024, 1280, 1, 2, 1024L * 1536, 1280L * 1024, 1);
        add(A.in[I_AWQKV] + 1280, WSP(bf16_t, WS_WV), 1536, 1024, 1024, 256, 0, 2, 1024L * 1536, 256L * 1024, 1);
        add(A.in[I_AWO], WSP(bf16_t, WS_WO), 1024, 1024, 1024, 1024, 0, 2, 1L << 20, 1L << 20, 1);
        add(A.in[I_PW], WSP(bf16_t, WS_POOLW), 256, 256, 256, 256, 0, 4, 65536, 65536);
        add(A.in[I_RWRKV], WSP(bf16_t, WS_WRKV), 1024, 1024, 1024, 1024, 0, 3, 1L << 20, 1L << 20, 1);
        add(A.in[I_RG1], WSP(bf16_t, WS_WL1), 128, 1024, 1024, 128, 0, 1, 0, 0);
        add(A.in[I_RW1], WSP(bf16_t, WS_WL1) + 256 * 1024, 64, 1024, 1024, 64, 0, 2, 65536, 65536);
        add(A.in[I_RA1], WSP(bf16_t, WS_WL1) + 2 * 256 * 1024, 64, 1024, 1024, 64, 0, 2, 65536, 65536);
        add(A.in[I_RG2], WSP(bf16_t, WS_WL2), 1024, 256, 128, 1024, 0, 1, 0, 0);
        add(A.in[I_RW2], WSP(bf16_t, WS_WL2) + 1 * 1024 * 256, 1024, 256, 64, 1024, 0, 2, 65536, 1024L * 256 + 64);
        add(A.in[I_RA2], WSP(bf16_t, WS_WL2) + 3 * 1024 * 256, 1024, 256, 64, 1024, 0, 2, 65536, 1024L * 256 + 64);
        add(A.in[I_RWO], WSP(bf16_t, WS_WOR), 1024, 1024, 1024, 1024, 0, 1, 0, 0, 1);
        add(A.in[I_MW1], WSP(bf16_t, WS_W1T), 2048, 1024, 1024, 2048, 2, 128, 1024L * 2048, 2048L * 1024, 1);
        add(A.in[I_MW2], WSP(bf16_t, WS_W2T), 1024, 1024, 1024, 1024, 0, 128, 1L << 20, 1L << 20, 1);
        njobs[0] = nj; njobs[1] = item;
    }
    __syncthreads();
    { const int nj = njobs[0], nitems = njobs[1]; LAS float* scr = (LAS float*)(F.lds + F.wave * 16384);
      const int gw = F.c * NWAVES + F.wave, NGW = F.G * NWAVES;
      int it = gw;
      if (it < nitems) {
          TItem Tc, Tn; f32x4 vc[8], vn[8];
          titem_decode(jobs, nj, it, Tc); titem_load(Tc, F.lane, vc);
          for (;;) {
              const int itn = it + NGW; const bool more = itn < nitems;
              if (more) { titem_decode(jobs, nj, itn, Tn); titem_load(Tn, F.lane, vn); }
              titem_store(Tc, F.lane, vc, scr);
              if (!more) break;
              Tc = Tn;
#pragma unroll
              for (int i = 0; i < 8; ++i) vc[i] = vn[i];
              it = itn;
          }
      } }
    __syncthreads();
}

__device__ __forceinline__ void moe_tiles(Frame& F, int layer) {
    REFRESH(F);
    LAS int* lcnt = (LAS int*)(F.lds + LCNT_OFF); LAS int* tpre = (LAS int*)(F.lds + TPRE_OFF);
    __syncthreads();
    if (F.tid < NE) lcnt[F.tid] = (int)__hip_atomic_load(F.ctl + CW_GCNT + layer * 64 + F.tid, __ATOMIC_RELAXED, __HIP_MEMORY_SCOPE_AGENT);
    __syncthreads();
    if (F.tid == 0) { int s = 0; for (int e = 0; e < NE; ++e) { tpre[e] = s; s += (lcnt[e] + 255) >> 8; } tpre[NE] = s; }
    __syncthreads();
    { LAS unsigned char* texp = (LAS unsigned char*)(F.lds + TEXP_OFF); const int nrt = tpre[NE];
      for (int rt = F.tid; rt < nrt; rt += NTHREADS) { int e = 0; for (int j = 1; j < NE; ++j) e += (tpre[j] <= rt) ? 1 : 0; texp[rt] = (unsigned char)e; } }
    __syncthreads();
}
constexpr int RB = 2;
#define ROWOF(it, r) ((((it) * F.G + F.c) * NWAVES + F.wave) * RB + (r))
struct MoeRef { int p[4]; float g[4]; };
__device__ __forceinline__ void moe_ref_load(Frame& F, int row, MoeRef& R) {
    const int4 pp = *(const int4*)(WSP(int, WS_POS) + (size_t)row * 4); const f32x4 gg = *(const f32x4*)(WSP(float, WS_GATE) + (size_t)row * 4);
    R.p[0] = pp.x; R.p[1] = pp.y; R.p[2] = pp.z; R.p[3] = pp.w; R.g[0] = gg.x; R.g[1] = gg.y; R.g[2] = gg.z; R.g[3] = gg.w;
}
__device__ __forceinline__ void moe_rows_load(Frame& F, const MoeRef& R, unsigned (&y)[4][4]) {
    const LAS int* tpre = (const LAS int*)(F.lds + TPRE_OFF); const unsigned char* Y = WSP(unsigned char, WS_Y);
#pragma unroll
    for (int k = 0; k < 4; ++k) { const int e = R.p[k] >> 20, slot = R.p[k] & 0xfffff; const size_t fr = (size_t)tpre[e] * 256 + slot; const unsigned* yp = (const unsigned*)(Y + fr * D) + F.lane;
#pragma unroll
        for (int j = 0; j < 4; ++j) y[k][j] = yp[64 * j]; }
}
__device__ __forceinline__ f32x4 moe_rows_sum(const MoeRef& R, const unsigned (&y)[4][4], int j) {
    f32x4 s = (f32x4){0.f, 0.f, 0.f, 0.f};
#pragma unroll
    for (int k = 0; k < 4; ++k) { const int w = (int)y[k][j]; const f32x2 lo = __builtin_amdgcn_cvt_pk_f32_fp8(w, false), hi = __builtin_amdgcn_cvt_pk_f32_fp8(w, true);
        s += (R.g[k] * 0.25f) * (f32x4){lo.x, lo.y, hi.x, hi.y}; }
    return s;
}

__device__ __forceinline__ void phase_norm1(Frame& F, const Args& A, int layer) {
    REFRESH(F);
    if (layer > 0) moe_tiles(F, layer - 1);
    bf16_t* H = WSP(bf16_t, WS_H); bf16_t* AX = WSP(bf16_t, WS_AX); const float* MOD = WSP(float, WS_MOD);
    const float* g1 = A.in[I_NORMG] + (size_t)(layer * 2 + 0) * D;
    f32x4 gg[4];
#pragma unroll
    for (int j = 0; j < 4; ++j) gg[j] = ((const f32x4*)g1)[64 * j + F.lane];
    for (int it = 0;; ++it) { if (ROWOF(it, 0) >= NT) break;
        f32x4 v[RB][4]; int brow[RB];
        if (layer == 0) {
#pragma unroll
            for (int r = 0; r < RB; ++r) { const int row = ROWOF(it, r); brow[r] = row < NX ? (row >> 11) : 32; const float* src = row < NX ? A.in[I_X] + (size_t)row * D : A.in[I_CTX] + (size_t)(row - NX) * D;
#pragma unroll
                for (int j = 0; j < 4; ++j) v[r][j] = ((const f32x4*)src)[64 * j + F.lane]; }
        } else {
            MoeRef R[RB]; unsigned y[RB][4][4]; f32x4 gv[RB][4];
#pragma unroll
            for (int r = 0; r < RB; ++r) moe_ref_load(F, ROWOF(it, r), R[r]);
#pragma unroll
            for (int r = 0; r < RB; ++r) { const int row = ROWOF(it, r); brow[r] = row < NX ? (row >> 11) : 32; moe_rows_load(F, R[r], y[r]);
                const float* g2p = MOD + ((size_t)(layer - 1) * 33 + brow[r]) * 6144 + 5 * D;
#pragma unroll
                for (int j = 0; j < 4; ++j) { v[r][j] = ld_bf4(H + (size_t)row * D + 256 * j + 4 * F.lane); gv[r][j] = ((const f32x4*)g2p)[64 * j + F.lane]; } }
#pragma unroll
            for (int r = 0; r < RB; ++r)
#pragma unroll
                for (int j = 0; j < 4; ++j) v[r][j] = v[r][j] + gv[r][j] * moe_rows_sum(R[r], y[r], j);
        }
        float rstd[RB];
#pragma unroll
        for (int r = 0; r < RB; ++r) { const int row = ROWOF(it, r); float ss = 0.f;
#pragma unroll
            for (int j = 0; j < 4; ++j) { st_bf4(H + (size_t)row * D + 256 * j + 4 * F.lane, v[r][j]); ss += (v[r][j].x * v[r][j].x + v[r][j].y * v[r][j].y) + (v[r][j].z * v[r][j].z + v[r][j].w * v[r][j].w); }
            rstd[r] = 1.0f / sqrtf(wave_sum(ss) * (1.0f / D) + 1e-5f); }
#pragma unroll
        for (int r = 0; r < RB; ++r) { const int row = ROWOF(it, r); const float* mp = MOD + ((size_t)layer * 33 + brow[r]) * 6144;
#pragma unroll
            for (int j = 0; j < 4; ++j) { const f32x4 sh = ((const f32x4*)mp)[64 * j + F.lane], sc = ((const f32x4*)(mp + D))[64 * j + F.lane];
                const f32x4 o = v[r][j] * rstd[r] * gg[j] * (sc + 1.0f) + sh;
                if (layer % 3 == 0) ((unsigned*)((unsigned char*)AX + (size_t)row * D))[64 * j + F.lane] = pk4_fp8(o.x, o.y, o.z, o.w);
                else { u32x2 w; w.x = pk2(o.x, o.y); w.y = pk2(o.z, o.w); ((u32x2*)(AX + (size_t)row * D))[64 * j + F.lane] = w; } } }
    }
}
__device__ __forceinline__ void phase_final(Frame& F, const Args& A) {
    REFRESH(F);
    moe_tiles(F, DEPTH - 1);
    const bf16_t* H = WSP(bf16_t, WS_H); const float* MOD = WSP(float, WS_MOD); const float* fg = A.in[I_FG];
    f32x4 gg[4];
#pragma unroll
    for (int j = 0; j < 4; ++j) gg[j] = ((const f32x4*)fg)[64 * j + F.lane];
    for (int it = 0;; ++it) { if (ROWOF(it, 0) >= NX) break;
        MoeRef R[RB]; unsigned y[RB][4][4]; f32x4 v[RB][4], gv[RB][4];
#pragma unroll
        for (int r = 0; r < RB; ++r) moe_ref_load(F, ROWOF(it, r), R[r]);
#pragma unroll
        for (int r = 0; r < RB; ++r) { const int row = ROWOF(it, r); moe_rows_load(F, R[r], y[r]); const float* g2p = MOD + ((size_t)(DEPTH - 1) * 33 + (row >> 11)) * 6144 + 5 * D;
#pragma unroll
            for (int j = 0; j < 4; ++j) { v[r][j] = ld_bf4(H + (size_t)row * D + 256 * j + 4 * F.lane); gv[r][j] = ((const f32x4*)g2p)[64 * j + F.lane]; } }
#pragma unroll
        for (int r = 0; r < RB; ++r) { const int row = ROWOF(it, r); float ss = 0.f;
#pragma unroll
            for (int j = 0; j < 4; ++j) { v[r][j] = v[r][j] + gv[r][j] * moe_rows_sum(R[r], y[r], j); ss += (v[r][j].x * v[r][j].x + v[r][j].y * v[r][j].y) + (v[r][j].z * v[r][j].z + v[r][j].w * v[r][j].w); }
            const float rstd = 1.0f / sqrtf(wave_sum(ss) * (1.0f / D) + 1e-5f);
#pragma unroll
            for (int j = 0; j < 4; ++j) ((f32x4*)(A.out + (size_t)row * D))[64 * j + F.lane] = v[r][j] * rstd * gg[j]; }
    }
}

template <int DD> __device__ __forceinline__ float dpp_ror(float v) { return __builtin_bit_cast(float, __builtin_amdgcn_update_dpp(0, __builtin_bit_cast(int, v), 0x120 + DD, 0xf, 0xf, false)); }
template <int DD> __device__ __forceinline__ void rank_step(float v0, float v1, int e0, int& r0, int& r1) {
    const float u0 = dpp_ror<DD>(v0), u1 = dpp_ror<DD>(v1); const bool low = DD <= e0;
    r0 += (u0 > v0 || (u0 == v0 && low)) ? 1 : 0; r0 += (u1 > v0) ? 1 : 0;
    r1 += (u0 >= v1) ? 1 : 0; r1 += (u1 > v1 || (u1 == v1 && low)) ? 1 : 0;
}
__device__ __forceinline__ float row_allmax(float v) { v = fmaxf(v, dpp_ror<8>(v)); v = fmaxf(v, dpp_ror<4>(v)); v = fmaxf(v, dpp_ror<2>(v)); v = fmaxf(v, dpp_ror<1>(v)); return v; }
__device__ __forceinline__ float row_allsum(float v) { v += dpp_ror<8>(v); v += dpp_ror<4>(v); v += dpp_ror<2>(v); v += dpp_ror<1>(v); return v; }
__device__ __forceinline__ void phase_route(Frame& F, const Args& A, int layer) {
    REFRESH(F);
    const int nrows = (layer == DEPTH - 1) ? NX : NT; const int TPB = nrows / 16 / F.G;
    LAS float* wT = (LAS float*)F.lds;
    LAS int* lcnt = (LAS int*)(F.lds + LCNT_OFF); LAS int* lbase = (LAS int*)(F.lds + LBASE_OFF);
    LAS unsigned* recp = (LAS unsigned*)(F.lds + REC_OFF); LAS float* recg = (LAS float*)(F.lds + REC_OFF + 4608);
    __syncthreads();
    { const float* wr = A.in[I_MWR] + (size_t)layer * D * NE;
      for (int idx = F.tid; idx < D * NE; idx += NTHREADS) wT[(idx & 31) * 1024 + (idx >> 5)] = wr[idx]; }
    if (F.tid < NE) lcnt[F.tid] = 0;
    __syncthreads();
    const bf16_t* H = WSP(bf16_t, WS_H); unsigned char* FX = WSP(unsigned char, WS_FX); const float* MOD = WSP(float, WS_MOD);
    const float* g2 = A.in[I_NORMG] + (size_t)(layer * 2 + 1) * D; const float* br = A.in[I_MBR] + layer * NE;
    const int l = F.lane, r16 = l & 15, q4 = l >> 4; const float b0 = br[r16], b1 = br[16 + r16];
    for (int k = F.wave; k < TPB; k += NWAVES) {
        const int row0 = (F.c * TPB + k) * 16, row = row0 + r16; const int brow = row0 < NX ? (row0 >> 11) : 32;
        const float* mp = MOD + ((size_t)layer * 33 + brow) * 6144 + 3 * D;
        const bf16_t* hp = H + (size_t)row * D + 8 * q4; float ss = 0.f;
#pragma unroll 8
        for (int j = 0; j < 32; ++j) { const u32x4 w = *(const u32x4*)(hp + 32 * j); const float a0 = bflo(w.x), a1 = bfhi(w.x), a2 = bflo(w.y), a3 = bfhi(w.y), a4 = bflo(w.z), a5 = bfhi(w.z), a6 = bflo(w.w), a7 = bfhi(w.w);
            ss += ((a0 * a0 + a1 * a1) + (a2 * a2 + a3 * a3)) + ((a4 * a4 + a5 * a5) + (a6 * a6 + a7 * a7)); }
        ss += __shfl_xor(ss, 16); ss += __shfl_xor(ss, 32);
        const float rstd = 1.0f / sqrtf(ss * (1.0f / D) + 1e-5f);
        f32x4 acc0 = (f32x4){0.f, 0.f, 0.f, 0.f}, acc1 = acc0;
        const float* gp = g2 + 8 * q4; const float* shp = mp + 8 * q4; const float* scp = mp + D + 8 * q4; unsigned char* fxp = FX + (size_t)row * D + 8 * q4;
        const LAS float* w0p = wT + r16 * 1024 + 8 * q4; const LAS float* w1p = wT + (16 + r16) * 1024 + 8 * q4;
#pragma unroll 2
        for (int j = 0; j < 32; ++j) { const u32x4 w = *(const u32x4*)(hp + 32 * j);
            const f32x4 ga = *(const f32x4*)(gp + 32 * j), gb = *(const f32x4*)(gp + 32 * j + 4), sa = *(const f32x4*)(shp + 32 * j), sb = *(const f32x4*)(shp + 32 * j + 4), ca = *(const f32x4*)(scp + 32 * j), cb = *(const f32x4*)(scp + 32 * j + 4);
            const f32x4 fa = (f32x4){bflo(w.x), bfhi(w.x), bflo(w.y), bfhi(w.y)} * rstd * ga * (ca + 1.0f) + sa, fb = (f32x4){bflo(w.z), bfhi(w.z), bflo(w.w), bfhi(w.w)} * rstd * gb * (cb + 1.0f) + sb;
            *(u32x2*)(fxp + 32 * j) = (u32x2){pk4_fp8(fa.x, fa.y, fa.z, fa.w), pk4_fp8(fb.x, fb.y, fb.z, fb.w)};
            const f32x4 w0a = *(const LAS f32x4*)(w0p + 32 * j), w0b = *(const LAS f32x4*)(w0p + 32 * j + 4), w1a = *(const LAS f32x4*)(w1p + 32 * j), w1b = *(const LAS f32x4*)(w1p + 32 * j + 4);
#pragma unroll
            for (int s4 = 0; s4 < 4; ++s4) { acc0 = __builtin_amdgcn_mfma_f32_16x16x4f32(fa[s4], w0a[s4], acc0, 0, 0, 0); acc1 = __builtin_amdgcn_mfma_f32_16x16x4f32(fa[s4], w1a[s4], acc1, 0, 0, 0); }
#pragma unroll
            for (int s4 = 0; s4 < 4; ++s4) { acc0 = __builtin_amdgcn_mfma_f32_16x16x4f32(fb[s4], w0b[s4], acc0, 0, 0, 0); acc1 = __builtin_amdgcn_mfma_f32_16x16x4f32(fb[s4], w1b[s4], acc1, 0, 0, 0); } }
#pragma unroll
        for (int reg = 0; reg < 4; ++reg) {
            const float v0 = acc0[reg] + b0, v1 = acc1[reg] + b1; int r0 = (v1 > v0) ? 1 : 0, r1 = (v0 >= v1) ? 1 : 0;
            rank_step<1>(v0, v1, r16, r0, r1); rank_step<2>(v0, v1, r16, r0, r1); rank_step<3>(v0, v1, r16, r0, r1); rank_step<4>(v0, v1, r16, r0, r1); rank_step<5>(v0, v1, r16, r0, r1);
            rank_step<6>(v0, v1, r16, r0, r1); rank_step<7>(v0, v1, r16, r0, r1); rank_step<8>(v0, v1, r16, r0, r1); rank_step<9>(v0, v1, r16, r0, r1); rank_step<10>(v0, v1, r16, r0, r1);
            rank_step<11>(v0, v1, r16, r0, r1); rank_step<12>(v0, v1, r16, r0, r1); rank_step<13>(v0, v1, r16, r0, r1); rank_step<14>(v0, v1, r16, r0, r1); rank_step<15>(v0, v1, r16, r0, r1);
            const float mx = row_allmax(fmaxf(v0, v1));
            const float x0 = r0 < 4 ? __expf(v0 - mx) : 0.f, x1 = r1 < 4 ? __expf(v1 - mx) : 0.f;
            const float inv = 1.0f / row_allsum(x0 + x1);
            const int lr = k * 16 + 4 * q4 + reg;
            if (r0 < 4) { const int rk = __hip_atomic_fetch_add(lcnt + r16, 1, __ATOMIC_RELAXED, __HIP_MEMORY_SCOPE_WORKGROUP); recp[lr * 4 + r0] = ((unsigned)r16 << 20) | (unsigned)rk; recg[lr * 4 + r0] = x0 * inv; }
            if (r1 < 4) { const int rk = __hip_atomic_fetch_add(lcnt + 16 + r16, 1, __ATOMIC_RELAXED, __HIP_MEMORY_SCOPE_WORKGROUP); recp[lr * 4 + r1] = ((unsigned)(16 + r16) << 20) | (unsigned)rk; recg[lr * 4 + r1] = x1 * inv; }
        }
    }
    __syncthreads();
    if (F.tid < NE) lbase[F.tid] = (int)__hip_atomic_fetch_add(F.ctl + CW_GCNT + layer * 64 + F.tid, (unsigned)lcnt[F.tid], __ATOMIC_RELAXED, __HIP_MEMORY_SCOPE_AGENT);
    __syncthreads();
    int* LIST = WSP(int, WS_LIST); int* POS = WSP(int, WS_POS); float* GATE = WSP(float, WS_GATE);
    for (int r = F.tid; r < TPB * 16 * 4; r += NTHREADS) { const int lr = r >> 2, kk = r & 3; const int row = F.c * TPB * 16 + lr;
        const unsigned qx = recp[r]; const float qg = recg[r]; const int e = qx >> 20, slot = lbase[e] + (int)(qx & 0xfffff);
        LIST[(size_t)e * NT + slot] = row; POS[(size_t)row * 4 + kk] = (e << 20) | slot; GATE[(size_t)row * 4 + kk] = qg; }
    __syncthreads();
}

__device__ __forceinline__ void phase_pooldiff(Frame& F) {
    REFRESH(F);
    const bf16_t* AX = WSP(bf16_t, WS_AX); bf16_t* PD = WSP(bf16_t, WS_PD);
    for (int it = 0;; ++it) { if (ROWOF(it, 0) >= NT) break;
        const int row0 = ROWOF(it, 0); int sb, t, n; seq_of(row0, sb, t, n);
#pragma unroll
        for (int j = 0; j < 4; ++j) { const int half = 1 << j; const int col = 256 * j + 4 * F.lane;
            f32x4 s0 = (f32x4){0.f, 0.f, 0.f, 0.f}, s1 = s0, me0 = s0, me1 = s0;
#pragma unroll
            for (int q = 0; q < 2 * half + 1; ++q) { const int uu = t - half + q;
                if (uu >= 0 && uu < n) { const f32x4 x = ld_bf4(AX + (size_t)(sb + uu) * D + col); if (q < 2 * half) s0 += x; if (q > 0) s1 += x; if (q == half) me0 = x; if (q == half + 1) me1 = x; } }
            const int lo0 = t - half < 0 ? 0 : t - half, hi0 = t + half > n ? n : t + half, lo1 = t + 1 - half < 0 ? 0 : t + 1 - half, hi1 = t + 1 + half > n ? n : t + 1 + half;
            st_bf4(PD + (size_t)row0 * D + col, s0 * (1.0f / (float)(hi0 - lo0)) - me0);
            st_bf4(PD + (size_t)(row0 + 1) * D + col, s1 * (1.0f / (float)(hi1 - lo1)) - me1); }
    }
}
__device__ __forceinline__ void phase_rwkv_mix(Frame& F, const Args& A) {
    REFRESH(F);
    const bf16_t* AX = WSP(bf16_t, WS_AX); bf16_t* A6 = WSP(bf16_t, WS_A6); const float* mix = A.in[I_RMIX];
    for (int it = 0;; ++it) { if (ROWOF(it, 0) >= NT) break;
        const int row0 = ROWOF(it, 0); int sb, t, n; seq_of(row0, sb, t, n);
#pragma unroll
        for (int j = 0; j < 4; ++j) { const int col = 256 * j + 4 * F.lane; const f32x4 z = (f32x4){0.f, 0.f, 0.f, 0.f};
            const f32x4 h0 = ld_bf4(AX + (size_t)row0 * D + col), h1 = ld_bf4(AX + (size_t)(row0 + 1) * D + col);
            const f32x4 hp = t > 0 ? ld_bf4(AX + (size_t)(row0 - 1) * D + col) : z, hn = t + 1 < n - 1 ? ld_bf4(AX + (size_t)(row0 + 2) * D + col) : z;
            const f32x4 xx0 = (hp + h1) * 0.5f - h0, xx1 = (h0 + hn) * 0.5f - h1;
#pragma unroll
            for (int i = 0; i < 6; ++i) { const f32x4 m = *(const f32x4*)(mix + i * D + col); const f32x4 o0 = h0 + xx0 * m, o1 = h1 + xx1 * m;
                if (i == 0 || i == 2 || i == 3) { unsigned char* p8 = (unsigned char*)(A6 + (size_t)i * NT * D);
                    *(unsigned*)(p8 + (size_t)row0 * D + col) = pk4_fp8(o0.x, o0.y, o0.z, o0.w); *(unsigned*)(p8 + (size_t)(row0 + 1) * D + col) = pk4_fp8(o1.x, o1.y, o1.z, o1.w); }
                else { st_bf4(A6 + ((size_t)i * NT + row0) * D + col, o0); st_bf4(A6 + ((size_t)i * NT + row0 + 1) * D + col, o1); } } }
    }
}
__device__ __forceinline__ float rl(float x, int k) { return __builtin_bit_cast(float, __builtin_amdgcn_readlane(__builtin_bit_cast(int, x), k)); }
typedef float f32x16 __attribute__((ext_vector_type(16)));
constexpr int SCW = 33792;
__device__ __forceinline__ int kpos(int k) { return (k & ~12) | ((k & 4) << 1) | ((k & 8) >> 1); }
__device__ __forceinline__ bf16x8 acc_frag(const f32x16& X, int s2) {
    u32x4 w; w.x = cvt_pk_bf16(X[8 * s2 + 0], X[8 * s2 + 1]); w.y = cvt_pk_bf16(X[8 * s2 + 2], X[8 * s2 + 3]); w.z = cvt_pk_bf16(X[8 * s2 + 4], X[8 * s2 + 5]); w.w = cvt_pk_bf16(X[8 * s2 + 6], X[8 * s2 + 7]);
    return __builtin_bit_cast(bf16x8, w);
}
#define MFMA32(a, b, c) __builtin_amdgcn_mfma_f32_32x32x16_bf16(a, b, c, 0, 0, 0)
__device__ __forceinline__ void phase_rwkv_scan(Frame& F, const Args& A) {
    REFRESH(F);
    volatile LAS int* psync = (volatile LAS int*)(F.lds + MISC_OFF + 128);
    if (F.tid < 8) psync[F.tid] = 0;
    __syncthreads();
    int pphase = 0;
#define PAIR_SYNC() do { asm volatile("s_waitcnt lgkmcnt(0)" ::: "memory"); ++pphase; psync[pr * 2 + hw] = pphase; \
        for (unsigned sp_ = 0; psync[pr * 2 + (hw ^ 1)] < pphase && sp_ < (1u << 24); ++sp_) __builtin_amdgcn_s_sleep(1); asm volatile("" ::: "memory"); } while (0)
    const int pr = F.wave >> 1, hw = F.wave & 1;
    for (int item = pr * F.G + F.c; item < 1024; item += 4 * F.G) {
        const int dir = item >> 9, b = (item >> 4) & 31, hd = item & 15, col = 64 * hd + F.lane;
        const int l = F.lane, r32 = l & 31, hh = l >> 5;
        const bf16_t* Rr = WSP(bf16_t, WS_RKV); const bf16_t* Kk = Rr + (size_t)NT * D; const bf16_t* Vv = Kk + (size_t)NT * D;
        const bf16_t* Ee = WSP(bf16_t, WS_E) + (size_t)dir * NT * D; const bf16_t* Aa = WSP(bf16_t, WS_A) + (size_t)dir * NT * D;
        bf16_t* Yo = WSP(bf16_t, WS_YS) + (size_t)dir * NT * D; float* Bo = WSP(float, WS_BONUS) + (size_t)dir * NT * 16;
        const float kkw = A.in[I_RKK][col], kaw = A.in[I_RKA][col], rkw = A.in[I_RRK][col];
        LAS unsigned char* RA = F.lds + pr * SCW; LAS unsigned char* RB = RA + 16384; LAS unsigned char* RV = RA + 25600;
        LAS float* cCb = (LAS float*)(F.lds + REC_OFF + pr * 256);
        LAS bf16_t* XT = (LAS bf16_t*)RA;
        LAS bf16_t* BK = (LAS bf16_t*)(RA + 8192);
        const int kp = kpos(l), vb = hw;
        f32x16 ST[2];
#pragma unroll
        for (int i = 0; i < 2; ++i)
#pragma unroll
            for (int q = 0; q < 16; ++q) ST[i][q] = 0.f;
        for (int seg = 0; seg < 2; ++seg) {
            const int base = seg ? b * T : NX + b * L, n = seg ? T : L; const int dt = dir ? -1 : 1; const int t0 = dir ? n - 1 : 0;
            bf16_t rawn[4][5]; bool have_n = false;
#pragma unroll
            for (int s8 = 0; s8 < 4; ++s8)
#pragma unroll
                for (int q = 0; q < 5; ++q) rawn[s8][q] = (bf16_t)0;
            for (int bt = 0; bt < n; bt += 32) {
                float cprev = 1.0f;
                if (hw) {
                    bf16_t e16[16];
#pragma unroll
                    for (int s = 0; s < 16; ++s) e16[s] = Ee[(size_t)(base + t0 + dt * (bt + s)) * D + col];
                    float es = 0.f;
#pragma unroll
                    for (int s = 0; s < 16; ++s) es += bf1(e16[s]);
                    cprev = __expf(-es); }
#pragma unroll
                for (int g4i = 0; g4i < 4; ++g4i) { const int g8 = 4 * hw + g4i;
                    bf16_t raw[4][5];
#pragma unroll
                    for (int s8 = 0; s8 < 4; ++s8) { if (g4i == 0 && have_n) {
#pragma unroll
                            for (int q = 0; q < 5; ++q) raw[s8][q] = rawn[s8][q]; }
                        else { const size_t o = (size_t)(base + t0 + dt * (bt + g8 * 4 + s8)) * D + col; raw[s8][0] = Rr[o]; raw[s8][1] = Kk[o]; raw[s8][2] = Vv[o]; raw[s8][3] = Aa[o]; raw[s8][4] = Ee[o]; } }
                    float rr[4], kraw[4], aa[4], kk[4], kd[4], n2[4], bn[4], ww[4]; unsigned bq2[2] = {0u, 0u}, kq2[2] = {0u, 0u};
#pragma unroll
                    for (int s8 = 0; s8 < 4; ++s8) { rr[s8] = bf1(raw[s8][0]); kraw[s8] = bf1(raw[s8][1]); aa[s8] = bf1(raw[s8][3]); ww[s8] = __expf(-bf1(raw[s8][4]));
                        kk[s8] = kraw[s8] * kkw; n2[s8] = kk[s8] * kk[s8]; kd[s8] = kraw[s8] * (1.0f + (aa[s8] - 1.0f) * kaw); bn[s8] = rr[s8] * kd[s8] * rkw; }
#pragma unroll
                    for (int s8 = 0; s8 < 4; ++s8) { n2[s8] = wave_sum(n2[s8]); bn[s8] = wave_sum(bn[s8]); }
#pragma unroll
                    for (int s8 = 0; s8 < 4; ++s8) { const int t = g8 * 4 + s8;
                        if (l == 0) Bo[(size_t)(base + t0 + dt * (bt + t)) * 16 + hd] = bn[s8];
                        const float kn = kk[s8] * __builtin_amdgcn_rsqf(fmaxf(n2[s8], 1e-24f)); const float c = cprev * ww[s8]; const float ic = __builtin_amdgcn_rcpf(c);
                        const float at = -kn * cprev, rt = rr[s8] * c, bq = kn * aa[s8] * ic, kq = kd[s8] * ic;
                        const unsigned w0 = cvt_pk_bf16(at, rt), w1 = cvt_pk_bf16(bq, kq);
                        XT[t * 64 + kp] = (bf16_t)(w0 & 0xffffu); XT[(32 + t) * 64 + kp] = (bf16_t)(w0 >> 16);
                        BK[t * 64 + kp] = (bf16_t)(w1 & 0xffffu); BK[(32 + t) * 64 + kp] = (bf16_t)(w1 >> 16);
                        if (s8 & 1) { bq2[s8 >> 1] |= (w1 & 0xffffu) << 16; kq2[s8 >> 1] |= (w1 & 0xffff0000u); } else { bq2[s8 >> 1] = w1 & 0xffffu; kq2[s8 >> 1] = w1 >> 16; }
                        cprev = c; }
                    const int gp = (g8 & ~3) | ((g8 & 1) << 1) | ((g8 & 2) >> 1);
                    *(LAS u32x2*)(RB + l * 144 + gp * 8) = (u32x2){bq2[0], bq2[1]}; *(LAS u32x2*)(RB + l * 144 + 64 + gp * 8) = (u32x2){kq2[0], kq2[1]};
                    *(LAS u32x2*)(RV + l * 80 + gp * 8) = (u32x2){(unsigned)raw[0][2] | ((unsigned)raw[1][2] << 16), (unsigned)raw[2][2] | ((unsigned)raw[3][2] << 16)};
                }
                if (hw) cCb[l] = cprev;
                PAIR_SYNC();
                unsigned pf0 = 0u, pf1 = 0u;
                if (bt + 32 < n) { const size_t po = (size_t)(base + t0 + dt * (bt + 32 + 16 * hw + (l & 15))) * D + 64 * hd; const int ps = l >> 4;
                    const bf16_t* sp = ps == 0 ? Rr : ps == 1 ? Kk : ps == 2 ? Vv : Aa;
                    pf0 = *(const unsigned*)(sp + po); if (l < 16) pf1 = *(const unsigned*)(Ee + po); }
                f32x16 Mp, Np, X;
                { bf16x8 XTf[4], BKf[2][4];
#pragma unroll
                  for (int s4 = 0; s4 < 4; ++s4) { XTf[s4] = *(const LAS bf16x8*)(XT + r32 * 64 + 16 * s4 + 8 * hh); BKf[0][s4] = *(const LAS bf16x8*)(BK + r32 * 64 + 16 * s4 + 8 * hh); BKf[1][s4] = *(const LAS bf16x8*)(BK + (32 + r32) * 64 + 16 * s4 + 8 * hh); }
                  bf16x8 MkaF[2];
                  { f32x16 Tm;
#pragma unroll
                    for (int q = 0; q < 16; ++q) Tm[q] = 0.f;
#pragma unroll
                    for (int s4 = 0; s4 < 4; ++s4) Tm = MFMA32(BKf[1][s4], XTf[s4], Tm);
#pragma unroll
                    for (int q = 0; q < 16; ++q) { const int row = (q & 3) + 8 * (q >> 2) + 4 * hh; Tm[q] = row < r32 ? Tm[q] : 0.f; }
                    MkaF[0] = acc_frag(Tm, 0); MkaF[1] = acc_frag(Tm, 1); }
#pragma unroll
                  for (int q = 0; q < 16; ++q) { Mp[q] = 0.f; Np[q] = 0.f; X[q] = 0.f; }
#pragma unroll
                  for (int s4 = 0; s4 < 4; ++s4) { Mp = MFMA32(BKf[0][s4], XTf[s4], Mp); Np = MFMA32(XTf[s4], BKf[0][s4], Np); }
#pragma unroll
                  for (int q = 0; q < 16; ++q) { const int row = (q & 3) + 8 * (q >> 2) + 4 * hh; Mp[q] = row < r32 ? Mp[q] : 0.f; Np[q] = r32 < row ? Np[q] : 0.f; }
#pragma unroll
                  for (int kb = 0; kb < 2; ++kb)
#pragma unroll
                      for (int s2 = 0; s2 < 2; ++s2) X = MFMA32(XTf[2 * kb + s2], acc_frag(ST[kb], s2), X);
#pragma unroll
                  for (int s2 = 0; s2 < 2; ++s2) { const bf16x8 Vf = *(const LAS bf16x8*)(RV + (32 * vb + r32) * 80 + (16 * s2 + 8 * hh) * 2); X = MFMA32(MkaF[s2], Vf, X); } }
                __builtin_amdgcn_sched_barrier(0);
#pragma unroll
                for (int lvl = 0; lvl < 5; ++lvl) {
                    bf16x8 Ma[2], Na[2];
#pragma unroll
                    for (int s2 = 0; s2 < 2; ++s2) { Ma[s2] = acc_frag(Mp, s2); Na[s2] = acc_frag(Np, s2); }
                    { const bf16x8 x0 = acc_frag(X, 0), x1 = acc_frag(X, 1); X = MFMA32(Ma[0], x0, X); X = MFMA32(Ma[1], x1, X); }
                    if (lvl < 4) { f32x16 M2, N2;
#pragma unroll
                        for (int q = 0; q < 16; ++q) { M2[q] = 0.f; N2[q] = 0.f; }
                        M2 = MFMA32(Na[0], Ma[0], M2); M2 = MFMA32(Na[1], Ma[1], M2);
                        N2 = MFMA32(Ma[0], Na[0], N2); N2 = MFMA32(Ma[1], Na[1], N2);
                        Mp = M2; Np = N2; }
                }
                __builtin_amdgcn_sched_barrier(0);
                { bf16x8 XRf[4], MbrF[2], MkrF[2];
#pragma unroll
                  for (int s4 = 0; s4 < 4; ++s4) XRf[s4] = *(const LAS bf16x8*)(XT + (32 + r32) * 64 + 16 * s4 + 8 * hh);
                  { f32x16 Tm, Tn;
#pragma unroll
                    for (int q = 0; q < 16; ++q) { Tm[q] = 0.f; Tn[q] = 0.f; }
#pragma unroll
                    for (int s4 = 0; s4 < 4; ++s4) { const bf16x8 Bb = *(const LAS bf16x8*)(BK + r32 * 64 + 16 * s4 + 8 * hh), Bk = *(const LAS bf16x8*)(BK + (32 + r32) * 64 + 16 * s4 + 8 * hh);
                        Tm = MFMA32(Bb, XRf[s4], Tm); Tn = MFMA32(Bk, XRf[s4], Tn); }
#pragma unroll
                    for (int q = 0; q < 16; ++q) { const int row = (q & 3) + 8 * (q >> 2) + 4 * hh; Tm[q] = row <= r32 ? Tm[q] : 0.f; Tn[q] = row <= r32 ? Tn[q] : 0.f; }
                    MbrF[0] = acc_frag(Tm, 0); MbrF[1] = acc_frag(Tm, 1); MkrF[0] = acc_frag(Tn, 0); MkrF[1] = acc_frag(Tn, 1); }
                  { const bf16x8 u0 = acc_frag(X, 0), u1 = acc_frag(X, 1);
                    const bf16x8 Vf0 = *(const LAS bf16x8*)(RV + (32 * vb + r32) * 80 + (8 * hh) * 2), Vf1 = *(const LAS bf16x8*)(RV + (32 * vb + r32) * 80 + (16 + 8 * hh) * 2);
                    f32x16 Yt;
#pragma unroll
                    for (int q = 0; q < 16; ++q) Yt[q] = 0.f;
#pragma unroll
                    for (int kb = 0; kb < 2; ++kb)
#pragma unroll
                        for (int s2 = 0; s2 < 2; ++s2) Yt = MFMA32(XRf[2 * kb + s2], acc_frag(ST[kb], s2), Yt);
                    Yt = MFMA32(MkrF[0], Vf0, Yt); Yt = MFMA32(MkrF[1], Vf1, Yt);
                    Yt = MFMA32(MbrF[0], u0, Yt); Yt = MFMA32(MbrF[1], u1, Yt);
#pragma unroll
                    for (int q = 0; q < 16; ++q) { const int t = (q & 3) + 8 * (q >> 2) + 4 * hh; Yo[(size_t)(base + t0 + dt * (bt + t)) * D + 64 * hd + 32 * vb + r32] = (bf16_t)f2bf(Yt[q]); }
#pragma unroll
                    for (int kb = 0; kb < 2; ++kb) {
                        const bf16x8 b0 = *(const LAS bf16x8*)(RB + (32 * kb + r32) * 144 + (8 * hh) * 2), b1 = *(const LAS bf16x8*)(RB + (32 * kb + r32) * 144 + (16 + 8 * hh) * 2);
                        const bf16x8 k0 = *(const LAS bf16x8*)(RB + (32 * kb + r32) * 144 + 64 + (8 * hh) * 2), k1 = *(const LAS bf16x8*)(RB + (32 * kb + r32) * 144 + 64 + (16 + 8 * hh) * 2);
                        ST[kb] = MFMA32(b0, u0, ST[kb]); ST[kb] = MFMA32(b1, u1, ST[kb]);
                        ST[kb] = MFMA32(k0, Vf0, ST[kb]); ST[kb] = MFMA32(k1, Vf1, ST[kb]); }
                  } }
                __builtin_amdgcn_sched_barrier(0);
#pragma unroll
                for (int kb = 0; kb < 2; ++kb)
#pragma unroll
                    for (int g4 = 0; g4 < 4; ++g4) { const f32x4 cc = *(const LAS f32x4*)(cCb + 32 * kb + 8 * g4 + 4 * hh);
                        ST[kb][4 * g4 + 0] *= cc.x; ST[kb][4 * g4 + 1] *= cc.y; ST[kb][4 * g4 + 2] *= cc.z; ST[kb][4 * g4 + 3] *= cc.w; }
                asm volatile("" :: "v"(pf0), "v"(pf1));
                have_n = bt + 32 < n;
                if (have_n) {
#pragma unroll
                    for (int s8 = 0; s8 < 4; ++s8) { const size_t o = (size_t)(base + t0 + dt * (bt + 32 + 16 * hw + s8)) * D + col; rawn[s8][0] = Rr[o]; rawn[s8][1] = Kk[o]; rawn[s8][2] = Vv[o]; rawn[s8][3] = Aa[o]; rawn[s8][4] = Ee[o]; } }
                PAIR_SYNC();
            }
        }
    }
    __syncthreads();
}
#undef PAIR_SYNC
#undef MFMA32
__device__ __forceinline__ void phase_rwkv_out(Frame& F, const Args& A, int nrows) {
    REFRESH(F);
    const bf16_t* Y0 = WSP(bf16_t, WS_YS); const bf16_t* Y1 = Y0 + (size_t)NT * D; const float* B0 = WSP(float, WS_BONUS); const float* B1 = B0 + (size_t)NT * 16;
    const bf16_t* Vv = WSP(bf16_t, WS_RKV) + (size_t)2 * NT * D; const bf16_t* Gg = WSP(bf16_t, WS_G); bf16_t* RO = WSP(bf16_t, WS_RO);
    const float* lnw = A.in[I_RLNW]; const float* lnb = A.in[I_RLNB];
    for (int it = 0;; ++it) { if (ROWOF(it, 0) >= nrows) break;
        f32x4 y[RB][4], vv[RB][4], gg[RB][4]; float bon[RB][4];
#pragma unroll
        for (int r = 0; r < RB; ++r) { const int row = ROWOF(it, r);
#pragma unroll
            for (int j = 0; j < 4; ++j) { const int col = 256 * j + 4 * F.lane, head = 4 * j + (F.lane >> 4); const size_t o = (size_t)row * D + col;
                y[r][j] = ld_bf4(Y0 + o) + ld_bf4(Y1 + o); vv[r][j] = ld_bf4(Vv + o); gg[r][j] = ld_bf4(Gg + o); bon[r][j] = B0[(size_t)row * 16 + head] + B1[(size_t)row * 16 + head]; } }
#pragma unroll
        for (int r = 0; r < RB; ++r) { const int row = ROWOF(it, r);
#pragma unroll
            for (int j = 0; j < 4; ++j) { const int col = 256 * j + 4 * F.lane; const size_t o = (size_t)row * D + col; const f32x4 yy = y[r][j];
                const float s = row16_sum((yy.x + yy.y) + (yy.z + yy.w));
                const f32x4 d = yy - s * (1.0f / 64.0f);
                const float q = row16_sum((d.x * d.x + d.y * d.y) + (d.z * d.z + d.w * d.w));
                const float rs = 1.0f / sqrtf(q * (1.0f / 64.0f) + 64e-5f);
                const f32x4 yn = d * rs * *(const f32x4*)(lnw + col) + *(const f32x4*)(lnb + col);
                { const f32x4 ov = (yn + vv[r][j] * bon[r][j]) * gg[r][j]; *(unsigned*)((unsigned char*)RO + o) = pk4_fp8(ov.x, ov.y, ov.z, ov.w); } } }
    }
}

__device__ __forceinline__ void phase_attn(Frame& F, const Args& A, int j, bool need_ctx) {
    REFRESH(F);
    const bf16_t* Q = WSP(bf16_t, WS_Q); const bf16_t* Kb = WSP(bf16_t, WS_K); const bf16_t* VT = WSP(bf16_t, WS_VT); bf16_t* O = WSP(bf16_t, WS_O);
    const float* sinks = A.in[I_ASINK] + j * 16;
    LAS bf16_t* Ks = (LAS bf16_t*)F.lds; LAS bf16_t* Vs = (LAS bf16_t*)(F.lds + 9216);
    LAS bf16x8* Qs = (LAS bf16x8*)(F.lds + 18432 + F.wave * 8192) + F.lane;
    const int nunits = 2048 + (need_ctx ? 256 : 0);
    const int fr = F.lane & 15, fq = F.lane >> 4, g = F.wave >> 1, hf = F.wave & 1;
    const float SC = 0.125f * 1.4426950408889634f;
    const int lr = F.tid >> 3, lch = F.tid & 7;
    __syncthreads();
    for (int u = F.c; u < nunits; u += F.G) {
        int b, kvh, qb; bool isx;
        if (u < 2048) { isx = true; b = u >> 6; kvh = (u >> 4) & 3; qb = u & 15; } else { const int v = u - 2048; isx = false; b = v >> 3; kvh = (v >> 1) & 3; qb = v & 1; }
        const int qrow0 = (isx ? b * T : NX + b * L) + qb * 128 + hf * 64; const int head = 4 * kvh + g;
        int jlo = 0, jhi = -1;
        if (isx) { jlo = qb == 0 ? 2 : 0; jhi = qb == 15 ? 3 : 5; }
        const int ntiles = 4 + (jhi - jlo + 1);
        auto tile_row0 = [&](int ti) -> int { return ti < 4 ? NX + b * L + ti * 64 : b * T + qb * 128 - 128 + 64 * (jlo + ti - 4); };
        u32x4 kv_n, vv_n;
        { const int kr0 = tile_row0(0); kv_n = *(const u32x4*)(Kb + (size_t)(kr0 + lr) * 256 + kvh * 64 + lch * 8); vv_n = *(const u32x4*)(VT + (size_t)(kvh * 64 + lr) * NT + kr0 + lch * 8); }
#pragma unroll
        for (int mq = 0; mq < 4; ++mq)
#pragma unroll
            for (int ks = 0; ks < 2; ++ks) Qs[64 * (mq * 2 + ks)] = *(const bf16x8*)(Q + (size_t)(qrow0 + 16 * mq + fr) * D + head * 64 + ks * 32 + 8 * fq);
        const float sink2 = sinks[head] * 1.4426950408889634f;
        float mrun[4], lrun[4]; f32x4 Oa[4][4];
#pragma unroll
        for (int mq = 0; mq < 4; ++mq) { mrun[mq] = sink2; lrun[mq] = fq == 0 ? 1.0f : 0.0f;
#pragma unroll
            for (int db = 0; db < 4; ++db) Oa[mq][db] = (f32x4){0.f, 0.f, 0.f, 0.f}; }
        for (int ti = 0; ti < ntiles; ++ti) {
            const int jl = ti < 4 ? -1 : jlo + ti - 4; const int ks0 = qb * 128 - 128 + 64 * jl;
            __syncthreads();
            *(LAS u32x4*)(Ks + lr * 72 + lch * 8) = kv_n; *(LAS u32x4*)(Vs + lr * 72 + lch * 8) = vv_n;
            __syncthreads();
            if (ti + 1 < ntiles) { const int kr0 = tile_row0(ti + 1); kv_n = *(const u32x4*)(Kb + (size_t)(kr0 + lr) * 256 + kvh * 64 + lch * 8); vv_n = *(const u32x4*)(VT + (size_t)(kvh * 64 + lr) * NT + kr0 + lch * 8); }
            const bool need = (jl < 0) || (jl >= hf && jl <= hf + 4);
            if (need) {
                const bool domask = (jl >= 0) && (jl == hf || jl == hf + 4);
                f32x4 Sa[4][4];
#pragma unroll
                for (int mq = 0; mq < 4; ++mq)
#pragma unroll
                    for (int n = 0; n < 4; ++n) Sa[mq][n] = (f32x4){0.f, 0.f, 0.f, 0.f};
#pragma unroll
                for (int ks = 0; ks < 2; ++ks) {
                    bf16x8 Qf[4];
#pragma unroll
                    for (int mq = 0; mq < 4; ++mq) Qf[mq] = Qs[64 * (mq * 2 + ks)];
#pragma unroll
                    for (int n = 0; n < 4; ++n) { const int kr = 32 * (n >> 1) + 8 * (fr >> 2) + 4 * (n & 1) + (fr & 3);
                        const bf16x8 Kf = *(const LAS bf16x8*)(Ks + kr * 72 + ks * 32 + 8 * fq);
#pragma unroll
                        for (int mq = 0; mq < 4; ++mq) Sa[mq][n] = __builtin_amdgcn_mfma_f32_16x16x32_bf16(Kf, Qf[mq], Sa[mq][n], 0, 0, 0); } }
                bf16x8 Pf[4][2];
#pragma unroll
                for (int mq = 0; mq < 4; ++mq) {
                    float mx = -1e30f;
                    if (domask) { const int tq = qb * 128 + hf * 64 + 16 * mq + fr;
#pragma unroll
                        for (int n = 0; n < 4; ++n)
#pragma unroll
                            for (int i = 0; i < 4; ++i) { float sv = Sa[mq][n][i]; const int rel = ks0 + 32 * (n >> 1) + 8 * fq + 4 * (n & 1) + i - tq; if (rel > 128 || rel < -128) sv = -1e30f; Sa[mq][n][i] = sv; mx = fmaxf(mx, sv); } }
                    else {
#pragma unroll
                        for (int n = 0; n < 4; ++n)
#pragma unroll
                            for (int i = 0; i < 4; ++i) mx = fmaxf(mx, Sa[mq][n][i]); }
                    mx = fmaxf(mx, __shfl_xor(mx, 16)); mx = fmaxf(mx, __shfl_xor(mx, 32));
                    const float mnew = fmaxf(mrun[mq], mx * SC); const float alpha = __builtin_amdgcn_exp2f(mrun[mq] - mnew); mrun[mq] = mnew;
                    float rs = 0.f; const float nm = -mnew;
#pragma unroll
                    for (int n = 0; n < 4; ++n) { const f32x4 tt = Sa[mq][n] * SC + nm;
#pragma unroll
                        for (int i = 0; i < 4; ++i) { const float p = __builtin_amdgcn_exp2f(tt[i]); Sa[mq][n][i] = p; rs += p; } }
                    lrun[mq] = lrun[mq] * alpha + rs;
#pragma unroll
                    for (int db = 0; db < 4; ++db) Oa[mq][db] *= alpha;
#pragma unroll
                    for (int s2 = 0; s2 < 2; ++s2) { u32x4 w; w.x = cvt_pk_bf16(Sa[mq][2 * s2][0], Sa[mq][2 * s2][1]); w.y = cvt_pk_bf16(Sa[mq][2 * s2][2], Sa[mq][2 * s2][3]);
                        w.z = cvt_pk_bf16(Sa[mq][2 * s2 + 1][0], Sa[mq][2 * s2 + 1][1]); w.w = cvt_pk_bf16(Sa[mq][2 * s2 + 1][2], Sa[mq][2 * s2 + 1][3]); Pf[mq][s2] = __builtin_bit_cast(bf16x8, w); }
                }
#pragma unroll
                for (int db = 0; db < 4; ++db)
#pragma unroll
                    for (int s2 = 0; s2 < 2; ++s2) { const bf16x8 Vf = *(const LAS bf16x8*)(Vs + (16 * db + fr) * 72 + 32 * s2 + 8 * fq);
#pragma unroll
                        for (int mq = 0; mq < 4; ++mq) Oa[mq][db] = __builtin_amdgcn_mfma_f32_16x16x32_bf16(Vf, Pf[mq][s2], Oa[mq][db], 0, 0, 0); }
            }
        }
#pragma unroll
        for (int mq = 0; mq < 4; ++mq) { float l = lrun[mq]; l += __shfl_xor(l, 16); l += __shfl_xor(l, 32); const float inv = 1.0f / l;
            unsigned char* op = (unsigned char*)O + (size_t)(qrow0 + 16 * mq + fr) * D + head * 64 + 4 * fq;
#pragma unroll
            for (int db = 0; db < 4; ++db) { const f32x4 o = Oa[mq][db] * inv; *(unsigned*)(op + 16 * db) = pk4_fp8(o.x, o.y, o.z, o.w); } }
    }
    __syncthreads();
}

struct KState { XcdBarrier bar; int ph; };
#define RUN() (A.one || A.phase == KS.ph)
#define SEAM() do { if (A.one) xcd_barrier(KS.bar); ++KS.ph; } while (0)
template <int LAYER>
__device__ __forceinline__ void layer_body(Frame& F, const Args& A, KState& KS) {
    constexpr int layer = LAYER, kind = LAYER % 3, j = LAYER / 3; constexpr bool last = (LAYER == DEPTH - 1);
    LAS unsigned char* ring = F.lds;
    const LAS int* tpre = (const LAS int*)(F.lds + TPRE_OFF); const LAS int* lcnt = (const LAS int*)(F.lds + LCNT_OFF);
    bf16_t* H = WSP(bf16_t, WS_H); const float* MOD = WSP(float, WS_MOD); const bf16_t* AX = WSP(bf16_t, WS_AX);
    const float* gate1 = MOD + (size_t)layer * 33 * 6144 + 2 * D;
    constexpr int nMall = last ? NX / 256 : NT / 256;
    if (RUN()) phase_norm1(F, A, layer);
    SEAM();
    if constexpr (kind == 0) {
        if (RUN()) {
            { pg8::ProbDense8 P; P.A = (const unsigned char*)AX; P.Bt = WSP(unsigned char, WS_WQK) + (size_t)j * 1280 * D; P.lda = D; P.ldb = D; P.K = D; P.scale_w = SCALE_W; P.scale_x = SCALE_ONE; P.ord.init(NT / 256, 5, F.G, F.c);
              EpiQK E{WSP(bf16_t, WS_Q), WSP(bf16_t, WS_K), WSP(float, WS_BQK) + j * 1280, WSP(float, WS_ROPEC), WSP(float, WS_ROPES)};
              pg8::gemm_phase(ring, P, E); }
            { pg8::ProbDense8 P; P.A = WSP(unsigned char, WS_WV) + (size_t)j * 256 * D; P.Bt = (const unsigned char*)AX; P.lda = D; P.ldb = D; P.K = D; P.scale_w = SCALE_ONE; P.scale_x = SCALE_W; P.ord.init(1, NT / 256, F.G, (F.c + 96) % F.G);
              EpiVT E{WSP(bf16_t, WS_VT), A.in[I_ABQKV] + j * 1536 + 1280};
              pg8::gemm_phase(ring, P, E); }
        }
        SEAM();
        if (RUN()) phase_attn(F, A, j, !last);
        SEAM();
        if (RUN()) { pg8::ProbDense8 P; P.A = WSP(unsigned char, WS_O); P.Bt = WSP(unsigned char, WS_WO) + (size_t)j * D * D; P.lda = D; P.ldb = D; P.K = D; P.scale_w = SCALE_W; P.scale_x = SCALE_ONE; P.ord.init(nMall, 4, F.G, F.c);
            EpiResid E{H, A.in[I_ABO] + j * D, nullptr, gate1};
            pg8::gemm_phase(ring, P, E); }
        SEAM();
    } else if constexpr (kind == 1) {
        if (RUN()) phase_pooldiff(F);
        SEAM();
        if (RUN()) { pg8::ProbDense P; P.A = WSP(bf16_t, WS_PD); P.Bt = WSP(bf16_t, WS_POOLW); P.lda = D; P.ldb = 256; P.K = 256; P.a_pn_off = 256; P.ord.init(nMall, 4, F.G, F.c);
            EpiResid E{H, A.in[I_PB], A.in[I_PS], gate1};
            pg8::gemm_phase(ring, P, E); }
        SEAM();
    } else {
        if (RUN()) phase_rwkv_mix(F, A);
        SEAM();
        if (RUN()) {
            for (int i = 0; i < 3; ++i) { const int sel = i == 0 ? 0 : i == 1 ? 2 : 3;
                pg8::ProbDense8 P; P.A = (const unsigned char*)(WSP(bf16_t, WS_A6) + (size_t)sel * NT * D); P.Bt = WSP(unsigned char, WS_WRKV) + (size_t)i * D * D; P.lda = D; P.ldb = D; P.K = D; P.scale_w = SCALE_W; P.scale_x = SCALE_ONE; P.ord.init(NT / 256, 4, F.G, (F.c + (i == 1 ? 128 : 0)) % F.G);
                EpiBf16Act E{WSP(bf16_t, WS_RKV) + (size_t)i * NT * D, D, nullptr, 0, 1.0f};
                pg8::gemm_phase(ring, P, E); }
            for (int i = 0; i < 3; ++i) { const int sel = i == 0 ? 5 : i == 1 ? 1 : 4;
                pg8::ProbDense P; P.A = WSP(bf16_t, WS_A6) + (size_t)sel * NT * D; P.Bt = WSP(bf16_t, WS_WL1) + (size_t)i * 256 * D; P.lda = D; P.ldb = D; P.K = D; P.a_pn_off = 0; P.ord.init(NT / 256, 1, F.G, (F.c + 128 - 32 * i) % F.G);
                EpiBf16Act E{WSP(bf16_t, WS_LORA) + i * 256, 768, nullptr, i == 0 ? 1 : i == 1 ? 2 : 0, 1.0f};
                pg8::gemm_phase(ring, P, E); }
        }
        SEAM();
        if (RUN()) {
            for (int i = 0; i < 5; ++i) {
                const int ablk = i == 0 ? 0 : i < 3 ? 1 : 2, d = (i - 1) & 1;
                pg8::ProbDense P; P.A = WSP(bf16_t, WS_LORA) + ablk * 256; P.Bt = WSP(bf16_t, WS_WL2) + (size_t)i * D * 256; P.lda = 768; P.ldb = 256; { int k128 = 128; asm volatile("" : "+s"(k128)); P.K = k128; }     P.a_pn_off = 0; P.ord.init(NT / 256, 4, F.G, (F.c + 128 * (i & 1)) % F.G);
                EpiBf16Act E; E.ldc = D;
                if (i == 0) { E.O = WSP(bf16_t, WS_G); E.bias = nullptr; E.act = 0; E.scale = 1.0f; }
                else if (i < 3) { E.O = WSP(bf16_t, WS_E) + (size_t)d * NT * D; E.bias = A.in[I_RW0] + d * D; E.act = 1; E.scale = 0.6065306597126334f; }
                else { E.O = WSP(bf16_t, WS_A) + (size_t)d * NT * D; E.bias = A.in[I_RA0] + d * D; E.act = 1; E.scale = 1.0f; }
                pg8::gemm_phase(ring, P, E); }
        }
        SEAM();
        if (RUN()) phase_rwkv_scan(F, A);
        SEAM();
        if (RUN()) phase_rwkv_out(F, A, last ? NX : NT);
        SEAM();
        if (RUN()) { pg8::ProbDense8 P; P.A = WSP(unsigned char, WS_RO); P.Bt = WSP(unsigned char, WS_WOR); P.lda = D; P.ldb = D; P.K = D; P.scale_w = SCALE_W; P.scale_x = SCALE_ONE; P.ord.init(nMall, 4, F.G, F.c);
            EpiResid E{H, nullptr, nullptr, gate1};
            pg8::gemm_phase(ring, P, E); }
        SEAM();
    }
    if (RUN()) phase_route(F, A, layer);
    SEAM();
    if (RUN()) { moe_tiles(F, layer);
        ProbMoe1 P; P.FX = WSP(fp8_t, WS_FX); P.W1T = WSP(fp8_t, WS_W1T) + (size_t)layer * NE * 2048 * D; P.list = WSP(int, WS_LIST); P.tpre = tpre; P.cnt = lcnt; P.texp = (const LAS unsigned char*)(F.lds + TEXP_OFF); P.toks = (LAS int*)(F.lds + TOKS_OFF); P.scale_w = SCALE_W; P.scale_x = SCALE_ONE; P.ord.init(tpre[NE], 8, F.G, F.c);
        EpiMoe1 E{WSP(unsigned char, WS_ACT), A.in[I_MB1] + (size_t)layer * NE * 2048};
        pg8::gemm_phase(ring, P, E); }
    SEAM();
    if (RUN()) { moe_tiles(F, layer);
        ProbMoe2 P; P.ACT = WSP(fp8_t, WS_ACT); P.W2T = WSP(fp8_t, WS_W2T) + (size_t)layer * NE * D * D; P.tpre = tpre; P.texp = (const LAS unsigned char*)(F.lds + TEXP_OFF); P.scale_w = SCALE_W4; P.scale_x = SCALE_ONE; P.ord.init(tpre[NE], 4, F.G, F.c);
        EpiMoe2 E{WSP(unsigned char, WS_Y), A.in[I_MB2] + (size_t)layer * NE * D};
        pg8::gemm_phase(ring, P, E); }
    SEAM();
}
__global__ void __launch_bounds__(NTHREADS, 2) trunk_fwd(Args A) {
    extern __shared__ __attribute__((aligned(16))) unsigned char lds_[];
    Frame F; F.lds = (LAS unsigned char*)lds_; REFRESH(F); F.wave = __builtin_amdgcn_readfirstlane(F.tid >> 6);
    F.G = gridDim.x; F.c = blockIdx.x; F.ws = A.ws; F.ctl = (unsigned*)(A.ws + WS_CTL);
    for (int u = F.tid; u < (LDS_BYTES - LDSCTL_OFF) / 4; u += NTHREADS) ((LAS unsigned*)(F.lds + LDSCTL_OFF))[u] = 0u;
    __syncthreads();
    KState KS; KS.bar.bar = F.ctl + CW_BAR; KS.bar.x = 0; KS.bar.st = nullptr; KS.ph = 0;
    if (A.one) KS.bar = xcd_barrier_post(F.ctl + CW_BAR, (volatile LAS unsigned*)(F.lds + MISC_OFF) + 8);
    if (RUN()) phase_prologue(F, A);
    SEAM();
    layer_body<0>(F, A, KS);
    layer_body<1>(F, A, KS);
    layer_body<2>(F, A, KS);
    layer_body<3>(F, A, KS);
    if (RUN()) phase_final(F, A);
}
#undef RUN
#undef SEAM
static int count_phases() { int n = 1; for (int layer = 0; layer < DEPTH; ++layer) { const int kind = layer % 3; n += 1 + (kind == 0 ? 3 : kind == 1 ? 2 : 6) + 3; } return n + 1; }

extern "C" void kernel_launch(void* const* d_in, const int* in_sizes, int n_in, void* d_out, int out_size, void* d_ws, size_t ws_size, hipStream_t stream) {
    static int grid = 0;
    if (grid == 0) {
        if (n_in != 38 || out_size != NX * D || ws_size < WS_END) { fprintf(stderr, "kernel_launch: unexpected problem (n_in %d, out %d, ws %zu < %zu)\n", n_in, out_size, ws_size, (size_t)WS_END); grid = -1; return; }
        int dev = 0, cus = 0;
        if (hipGetDevice(&dev) != hipSuccess || hipDeviceGetAttribute(&cus, hipDeviceAttributeMultiprocessorCount, dev) != hipSuccess) { grid = -1; return; }
        if (hipFuncSetAttribute((const void*)trunk_fwd, hipFuncAttributeMaxDynamicSharedMemorySize, LDS_BYTES) != hipSuccess) { fprintf(stderr, "kernel_launch: hipFuncSetAttribute failed\n"); grid = -1; return; }
        int per_cu = 0;
        if (hipOccupancyMaxActiveBlocksPerMultiprocessor(&per_cu, (const void*)trunk_fwd, NTHREADS, LDS_BYTES) != hipSuccess || per_cu < 1) fprintf(stderr, "kernel_launch: occupancy query says %d\n", per_cu);
        (void)hipGetLastError();
        grid = cus;
        if (grid != 256) fprintf(stderr, "kernel_launch: %d CUs (built for 256)\n", grid);
    }
    if (grid < 0) return;
    (void)hipMemsetAsync((char*)d_ws + WS_CTL, 0, CTL_BYTES, stream);
    (void)hipMemsetAsync((char*)d_ws + WS_LZERO, 0, LZERO_BYTES, stream);
    Args a{};
    for (int i = 0; i < 38; ++i) a.in[i] = (const float*)d_in[i];
    a.out = (float*)d_out; a.ws = (unsigned char*)d_ws;
#if MK_ONE_LAUNCH
    a.phase = 0; a.one = 1;
    hipLaunchKernelGGL(trunk_fwd, dim3(grid), dim3(NTHREADS), LDS_BYTES, stream, a);
#else
    const int nph = count_phases();
    for (int p = 0; p < nph; ++p) { a.phase = p; a.one = 0; hipLaunchKernelGGL(trunk_fwd, dim3(grid), dim3(NTHREADS), LDS_BYTES, stream, a); }
#endif
}
```

```cpp
#include <hip/hip_runtime.h>
#include <cstdio>
#include <cstdint>

#ifndef MK_ONE_LAUNCH
#define MK_ONE_LAUNCH 1
#endif
#define LAS __attribute__((address_space(3)))
#define GAS __attribute__((address_space(1)))
typedef unsigned short bf16_t;
typedef short bf16x8 __attribute__((ext_vector_type(8)));
typedef float f32x4 __attribute__((ext_vector_type(4)));
typedef float f32x2 __attribute__((ext_vector_type(2)));
typedef unsigned u32x4 __attribute__((ext_vector_type(4)));
typedef unsigned u32x2 __attribute__((ext_vector_type(2)));

constexpr int D = 1024, NB = 32, T = 2048, L = 256, DEPTH = 4;
constexpr int NX = NB * T, NC = NB * L, NT = NX + NC;
constexpr int NE = 32, TOPK = 4;
constexpr int NWAVES = 8, NTHREADS = 512;
constexpr int MAXRT = NT * TOPK / 256 + NE;

constexpr size_t MiB = 1u << 20;
constexpr size_t WS_CTL = 0, CTL_BYTES = 128 * 1024;
constexpr size_t WS_MOD = 4 * MiB;
constexpr size_t WS_ROPEC = 8 * MiB, WS_ROPES = 8 * MiB + 512 * 1024;
constexpr size_t WS_BQK = 9 * MiB;
constexpr size_t WS_WQK = 10 * MiB;
constexpr size_t WS_WV = 15 * MiB;
constexpr size_t WS_WO = 16 * MiB;
constexpr size_t WS_POOLW = 20 * MiB;
constexpr size_t WS_WRKV = 21 * MiB;
constexpr size_t WS_WOR = 27 * MiB;
constexpr size_t WS_WL1 = 30 * MiB;
constexpr size_t WS_WL2 = 32 * MiB;
constexpr size_t WS_LZERO = WS_WL1, LZERO_BYTES = 6 * MiB;
constexpr size_t WS_W1T = 40 * MiB;
constexpr size_t WS_W2T = 552 * MiB;
constexpr size_t WS_H = 808 * MiB;
constexpr size_t WS_AX = 1096 * MiB;
constexpr size_t WS_FX = 1240 * MiB;
constexpr size_t WS_R = 1384 * MiB;
constexpr size_t WS_ACT = WS_R;
constexpr size_t WS_Y = WS_R + 592 * MiB;
constexpr size_t WS_LIST = WS_R + 1184 * MiB;
constexpr size_t WS_POS = WS_R + 1193 * MiB;
constexpr size_t WS_GATE = WS_R + 1195 * MiB;
constexpr size_t WS_Q = WS_R;
constexpr size_t WS_K = WS_R + 144 * MiB;
constexpr size_t WS_VT = WS_R + 180 * MiB;
constexpr size_t WS_O = WS_R + 216 * MiB;
constexpr size_t WS_PD = WS_R;
constexpr size_t WS_A6 = WS_R;
constexpr size_t WS_E = WS_R;
constexpr size_t WS_A = WS_R + 288 * MiB;
constexpr size_t WS_RO = WS_R + 576 * MiB;
constexpr size_t WS_RKV = WS_R + 864 * MiB;
constexpr size_t WS_LORA = WS_R + 1296 * MiB;
constexpr size_t WS_G = WS_R + 1404 * MiB;
constexpr size_t WS_YS = WS_R + 1548 * MiB;
constexpr size_t WS_BONUS = WS_R + 2124 * MiB;
constexpr size_t WS_END = WS_R + 2134 * MiB;

constexpr int CW_BAR = 4096;
constexpr int CW_GCNT = 16384;
constexpr int LDS_BYTES = 147456;
constexpr int RING_BYTES = 131072;
constexpr int LDSCTL_OFF = 135168;
constexpr int MISC_OFF = LDSCTL_OFF;
constexpr int TPRE_OFF = LDSCTL_OFF + 256;
constexpr int LCNT_OFF = LDSCTL_OFF + 512;
constexpr int LBASE_OFF = LDSCTL_OFF + 768;
constexpr int REC_OFF = LDSCTL_OFF + 1024;
constexpr int TEXP_OFF = LDSCTL_OFF + 1024 + 2048;
constexpr int TOKS_OFF = LDSCTL_OFF + 1024 + 4096;
constexpr int BIAS_OFF = LDSCTL_OFF + 1024 + 6144;
constexpr int JOB_OFF = LDSCTL_OFF + 1024;

__device__ __forceinline__ unsigned f2bf(float f) { unsigned u = __builtin_bit_cast(unsigned, f); return (u + 0x7fffu + ((u >> 16) & 1u)) >> 16; }
__device__ __forceinline__ unsigned pk2(float lo, float hi) { return f2bf(lo) | (f2bf(hi) << 16); }
__device__ __forceinline__ float bflo(unsigned w) { return __builtin_bit_cast(float, w << 16); }
__device__ __forceinline__ float bfhi(unsigned w) { return __builtin_bit_cast(float, w & 0xffff0000u); }
__device__ __forceinline__ float bf1(bf16_t b) { return __builtin_bit_cast(float, ((unsigned)b) << 16); }
__device__ __forceinline__ unsigned pk4_fp8(float a, float b, float c, float d) {
    int w = __builtin_amdgcn_cvt_pk_fp8_f32(a, b, __builtin_bit_cast(int, a), false); w = __builtin_amdgcn_cvt_pk_fp8_f32(c, d, w, true); return (unsigned)w; }
typedef __bf16 bf16x2_t __attribute__((ext_vector_type(2)));
__device__ __forceinline__ unsigned cvt_pk_bf16(float lo, float hi) { const f32x2 v = {lo, hi}; return __builtin_bit_cast(unsigned, __builtin_convertvector(v, bf16x2_t)); }
__device__ __forceinline__ float dpp_add(float v, const int ctrl, const int row_mask) {
    switch (ctrl) {
    case 0xB1:  return v + __builtin_bit_cast(float, __builtin_amdgcn_update_dpp(0, __builtin_bit_cast(int, v), 0xB1, 0xf, 0xf, true));
    case 0x4E:  return v + __builtin_bit_cast(float, __builtin_amdgcn_update_dpp(0, __builtin_bit_cast(int, v), 0x4E, 0xf, 0xf, true));
    case 0x141: return v + __builtin_bit_cast(float, __builtin_amdgcn_update_dpp(0, __builtin_bit_cast(int, v), 0x141, 0xf, 0xf, true));
    case 0x140: return v + __builtin_bit_cast(float, __builtin_amdgcn_update_dpp(0, __builtin_bit_cast(int, v), 0x140, 0xf, 0xf, true));
    case 0x142: return v + __builtin_bit_cast(float, __builtin_amdgcn_update_dpp(0, __builtin_bit_cast(int, v), 0x142, 0xa, 0xf, true));
    default:    return v + __builtin_bit_cast(float, __builtin_amdgcn_update_dpp(0, __builtin_bit_cast(int, v), 0x143, 0xc, 0xf, true));
    }
}
__device__ __forceinline__ float row16_sum(float v) { v = dpp_add(v, 0xB1, 0xf); v = dpp_add(v, 0x4E, 0xf); v = dpp_add(v, 0x141, 0xf); v = dpp_add(v, 0x140, 0xf); return v; }
__device__ __forceinline__ float wave_sum(float v) {
    v = row16_sum(v); v = dpp_add(v, 0x142, 0xa); v = dpp_add(v, 0x143, 0xc);
    return __builtin_bit_cast(float, __builtin_amdgcn_readlane(__builtin_bit_cast(int, v), 63));
}
__device__ __forceinline__ float sigmoidf_(float x) { return __builtin_amdgcn_rcpf(1.0f + __builtin_amdgcn_exp2f(-1.4426950408889634f * x)); }
__device__ __forceinline__ int opaque_tid() { int t; asm volatile("v_mov_b32 %0, %1" : "=v"(t) : "v"(threadIdx.x)); return t; }
#define REFRESH(F) do { (F).tid = opaque_tid(); (F).lane = (F).tid & 63; } while (0)
__device__ __forceinline__ void seq_of(int row, int& sb, int& t, int& n) { if (row < NX) { sb = row & ~(T - 1); t = row & (T - 1); n = T; } else { const int r2 = row - NX; sb = NX + (r2 & ~(L - 1)); t = r2 & (L - 1); n = L; } }
__device__ __forceinline__ f32x4 ld_bf4(const bf16_t* p) { const u32x2 w = *(const u32x2*)p; return (f32x4){bflo(w.x), bfhi(w.x), bflo(w.y), bfhi(w.y)}; }
__device__ __forceinline__ void st_bf4(bf16_t* p, f32x4 v) { u32x2 w; w.x = pk2(v.x, v.y); w.y = pk2(v.z, v.w); *(u32x2*)p = w; }

#define LDS_WAIT() asm volatile("s_waitcnt lgkmcnt(0)" ::: "memory")
#define VM_WAIT() asm volatile("s_waitcnt vmcnt(0)" ::: "memory")

#define XB_TMO      128
#define XB_XCNT(j)  (256  + 64 * (j))
#define XB_XSUB(j)  (1280 + 64 * (j))
#define XB_XGEN(j)  (2304 + 64 * (j))
#define XB_TOP      3328
#define XB_TOPGEN   3392
#define XCD_BAR_WORDS 3456
#define XB_SPIN_CAP (1u << 18)
__device__ __forceinline__ unsigned xb_ld(unsigned* p)              { return __hip_atomic_load(p, __ATOMIC_RELAXED, __HIP_MEMORY_SCOPE_AGENT); }
__device__ __forceinline__ unsigned xb_add(unsigned* p, unsigned v) { return __hip_atomic_fetch_add(p, v, __ATOMIC_RELAXED, __HIP_MEMORY_SCOPE_AGENT); }
__device__ __forceinline__ unsigned xb_xcc_id() { return (unsigned)__builtin_amdgcn_s_getreg((3 << 11) | 20) & 0xFu; }
#define XB_SPIN(cond, bar) do { unsigned _sp = 0; while (cond) { __builtin_amdgcn_s_sleep(1); \
    if ((++_sp & 255u) == 0u) { if (xb_ld(&(bar)[XB_TMO])) break; if (_sp > XB_SPIN_CAP) { atomicAdd(&(bar)[XB_TMO], 1u); break; } } } } while (0)
struct XcdBarrier { unsigned* bar; unsigned x; volatile LAS unsigned* st; };
__device__ __forceinline__ XcdBarrier xcd_barrier_post(unsigned* bar, volatile LAS unsigned* st) {
    XcdBarrier b; b.bar = bar; b.x = xb_xcc_id(); b.st = st;
    if (threadIdx.x == 0) (void)xb_add(&bar[XB_XCNT(b.x)], 1u);
    return b;
}
__device__ __forceinline__ void xcd_barrier_complete(unsigned* bar, unsigned x, unsigned& nloc, unsigned& nx) {
    const unsigned G = gridDim.x * gridDim.y * gridDim.z;
    unsigned sum, cnt, mine, sp = 0u;
    for (;;) {
        sum = 0u; cnt = 0u; mine = 0u;
#pragma unroll
        for (unsigned j = 0; j < 16; ++j) { const unsigned c = xb_ld(&bar[XB_XCNT(j)]); sum += c; cnt += (c > 0u) ? 1u : 0u; mine = (j == x) ? c : mine; }
        if (sum == G) break;
        __builtin_amdgcn_s_sleep(1);
        if ((++sp & 255u) == 0u) { if (xb_ld(&bar[XB_TMO])) break; if (sp > XB_SPIN_CAP) { atomicAdd(&bar[XB_TMO], 1u); break; } }
    }
    nloc = mine > 0u ? mine : 1u; nx = cnt > 0u ? cnt : 1u;
}
__device__ __forceinline__ void xcd_barrier(const XcdBarrier& b) {
    asm volatile("s_waitcnt vmcnt(0)" ::: "memory");
    __syncthreads();
    if (threadIdx.x == 0) {
        unsigned* bar = b.bar;
        __builtin_amdgcn_s_waitcnt(0);
        unsigned nloc = b.st[0], nx = b.st[1];
        if (nloc == 0u) { xcd_barrier_complete(bar, b.x, nloc, nx); b.st[0] = nloc; b.st[1] = nx; }
        const unsigned old = xb_add(&bar[XB_XSUB(b.x)], 1u);
        const unsigned gen = old / nloc;
        if (old + 1u == (gen + 1u) * nloc) {
            __builtin_amdgcn_fence(__ATOMIC_RELEASE, "agent");
            asm volatile("s_waitcnt vmcnt(0)" ::: "memory");
            const unsigned og = xb_add(&bar[XB_TOP], 1u);
            const unsigned tg = og / nx;
            if (og + 1u == (tg + 1u) * nx) xb_add(&bar[XB_TOPGEN], 1u);
            else XB_SPIN(xb_ld(&bar[XB_TOPGEN]) == tg, bar);
            __builtin_amdgcn_fence(__ATOMIC_ACQUIRE, "agent");
            xb_add(&bar[XB_XGEN(b.x)], 1u);
            asm volatile("s_waitcnt vmcnt(0)" ::: "memory");
        } else {
            XB_SPIN(xb_ld(&bar[XB_XGEN(b.x)]) == gen, bar);
            __builtin_amdgcn_fence(__ATOMIC_ACQUIRE, "agent");
            asm volatile("s_waitcnt vmcnt(0)" ::: "memory");
        }
    }
    __syncthreads();
}

namespace pg8 {
constexpr int BM = 256, BK = 64, HALF = 128, HTB = HALF * BK * 2, STAGE_BYTES = 8 * HTB, NXCD = 8, WGM = 8;
__host__ __device__ __forceinline__ int lds_byte(int r, int c) { const int st = (r >> 4) * 2 + (c >> 5), rr = r & 15, cc = c & 31, ob = rr * 64 + cc * 2; return st * 1024 + (ob ^ (((ob >> 9) & 1) << 5)); }
__host__ __device__ __forceinline__ void stage_rc(int b, int& R, int& C) { const int st = b / 1024, sb = b % 1024, swz = sb ^ (((sb >> 9) & 1) << 5); R = (st >> 1) * 16 + swz / 64; C = (st & 1) * 32 + (swz % 64) / 2; }
__host__ __device__ __forceinline__ int perm32(int rho) { const int n = rho >> 4, i = rho & 15; return 8 * (i >> 2) + 4 * n + (i & 3); }

typedef int i32x8 __attribute__((ext_vector_type(8)));
typedef int i32x4 __attribute__((ext_vector_type(4)));
__device__ __forceinline__ i32x8 cat8(bf16x8 lo, bf16x8 hi) { const i32x4 a = __builtin_bit_cast(i32x4, lo), b = __builtin_bit_cast(i32x4, hi); return __builtin_shufflevector(a, b, 0, 1, 2, 3, 4, 5, 6, 7); }
struct Unit { int pm, pn, e, rt; };
struct TileOrder {
    int nM, nN, nwg, G, c; unsigned inv_nig;
    __device__ __forceinline__ void init(int nM_, int nN_, int G_, int c_) { nM = nM_; nN = nN_; nwg = nM * nN; G = G_; c = c_; inv_nig = (unsigned)((0x100000000ull + (unsigned)(WGM * nN_) - 1u) / (unsigned)(WGM * nN_)); }
    __device__ __forceinline__ bool next(int i, int& pm, int& pn) const {
        const long Lx = (long)i * G + c; if (Lx >= nwg) return false;
        int wgid = (int)Lx; { const int q = nwg >> 3, r = nwg & 7, xcd = wgid & 7, off = wgid >> 3; wgid = (xcd < r ? xcd * (q + 1) : r * (q + 1) + (xcd - r) * q) + off; }
        const int nig = WGM * nN, gid = (int)(((unsigned long long)(unsigned)wgid * inv_nig) >> 32), fm = gid * WGM, rem = wgid - gid * nig, left = nM - fm;
        if (left >= WGM) { pm = fm + (rem & (WGM - 1)); pn = rem >> 3; }
        else { pm = fm + rem % left; pn = rem / left; }
        return true;
    }
};
struct ProbDense {
    static constexpr bool FP8 = false;
    const bf16_t* A; const bf16_t* Bt; int lda, ldb, K, a_pn_off; TileOrder ord;
    __device__ __forceinline__ int ldb_bytes() const { return ldb * 2; }
    __device__ __forceinline__ int ntiles() const { return K / 64; }
    __device__ __forceinline__ bool next(int i, Unit& u) const { u.e = 0; const bool ok = ord.next(i, u.pm, u.pn); u.rt = u.pm; return ok; }
    __device__ __forceinline__ const char* a_ptr(const Unit& u) const { return (const char*)(A + (size_t)u.pm * BM * lda + (size_t)u.pn * a_pn_off); }
    __device__ __forceinline__ const char* b_ptr(const Unit& u) const { return (const char*)(Bt + (size_t)u.pn * BM * ldb); }
    __device__ __forceinline__ void list_prefetch(const Unit&, int, int, int) const {}
    __device__ __forceinline__ void a_off(const Unit&, int, const int (&R)[2], const int (&C)[2], unsigned (&v)[2][2]) const {
#pragma unroll
        for (int h = 0; h < 2; ++h)
#pragma unroll
            for (int i = 0; i < 2; ++i) v[h][i] = (unsigned)((h * HALF + R[i]) * lda + C[i]) * 2u;
    }
};

struct ProbDense8 {
    static constexpr bool FP8 = true;
    const unsigned char* A; const unsigned char* Bt; int lda, ldb, K, scale_w, scale_x; TileOrder ord;
    __device__ __forceinline__ int ldb_bytes() const { return ldb; }
    __device__ __forceinline__ int ntiles() const { return K / 128; }
    __device__ __forceinline__ bool next(int i, Unit& u) const { u.e = 0; const bool ok = ord.next(i, u.pm, u.pn); u.rt = u.pm; return ok; }
    __device__ __forceinline__ const char* a_ptr(const Unit& u) const { return (const char*)(A + (size_t)u.pm * BM * lda); }
    __device__ __forceinline__ const char* b_ptr(const Unit& u) const { return (const char*)(Bt + (size_t)u.pn * BM * ldb); }
    __device__ __forceinline__ void list_prefetch(const Unit&, int, int, int) const {}
    __device__ __forceinline__ void a_off(const Unit&, int, const int (&R)[2], const int (&C)[2], unsigned (&v)[2][2]) const {
#pragma unroll
        for (int h = 0; h < 2; ++h)
#pragma unroll
            for (int i = 0; i < 2; ++i) v[h][i] = (unsigned)((h * HALF + R[i]) * lda + C[i] * 2);
    }
};
template <class Prob, class Epi>
__device__ __forceinline__ void gemm_phase(LAS unsigned char* lds, const Prob& P, const Epi& E) {
    const int tid = opaque_tid(), wid = __builtin_amdgcn_readfirstlane(tid >> 6), lane = tid & 63, wr = wid >> 2, wc = wid & 3, fr = lane & 15, fq = lane >> 4;
    const int nt = P.ntiles(); const int ldbB = P.ldb_bytes();
    int Rr[2], Cc[2]; unsigned voffB[2];
#pragma unroll
    for (int i = 0; i < 2; ++i) { int R, C; stage_rc(tid * 16 + i * 8192, R, C); Rr[i] = R; Cc[i] = C; const int Rb = Epi::PERM ? ((R & ~31) + perm32(R & 31)) : R;
        voffB[i] = (unsigned)(Rb * ldbB + C * 2); }
    const size_t kstep = (size_t)(BK * 2);
    const size_t hstepB = (size_t)HALF * ldbB;
    const unsigned ldsw = (unsigned)wid * 1024u;
    const int aoff = lds_byte(wr * 64 + fr, fq * 8), boff = lds_byte(wc * 32 + fr, fq * 8);
#define PG8_SA(b, h) (((b) * 2 + (h)) * HTB)
#define PG8_SB(b, h) ((4 + (b) * 2 + (h)) * HTB)
#define PG8_STAGE(bufoff, gbase, voff) do { _Pragma("unroll") for (int _i = 0; _i < 2; ++_i) { \
        __builtin_amdgcn_global_load_lds((const unsigned*)((const char*)(gbase) + (voff)[_i]), (LAS unsigned*)(lds + (bufoff) + ldsw + _i * 8192), 16, 0, 0); } } while (0)
#define PG8_LDA(dst, b, h) do { _Pragma("unroll") for (int m = 0; m < 4; ++m) _Pragma("unroll") for (int k = 0; k < 2; ++k) dst[m][k] = *(const LAS bf16x8*)(lds + PG8_SA(b, h) + aoff + m * 2048 + k * 1024); } while (0)
#define PG8_LDB(dst, b, h) do { _Pragma("unroll") for (int n = 0; n < 2; ++n) _Pragma("unroll") for (int k = 0; k < 2; ++k) dst[n][k] = *(const LAS bf16x8*)(lds + PG8_SB(b, h) + boff + n * 2048 + k * 1024); } while (0)
#define PG8_MMA(ai, bj, At, Bt) do { __builtin_amdgcn_s_setprio(1); _Pragma("unroll") for (int m = 0; m < 4; ++m) _Pragma("unroll") for (int n = 0; n < 2; ++n) { \
        if constexpr (Prob::FP8) { asm volatile("v_mfma_scale_f32_16x16x128_f8f6f4 %0, %1, %2, %0, %3, %4 op_sel_hi:[0,0,0]" : "+v"(acc[ai][bj][m][n]) : "v"(cat8(Bt[n][0], Bt[n][1])), "v"(cat8(At[m][0], At[m][1])), "v"(sc_w), "v"(sc_x)); } \
        else { _Pragma("unroll") for (int k = 0; k < 2; ++k) acc[ai][bj][m][n] = __builtin_amdgcn_mfma_f32_16x16x32_bf16(Bt[n][k], At[m][k], acc[ai][bj][m][n], 0, 0, 0); } } __builtin_amdgcn_s_setprio(0); } while (0)
#define PG8_MMAZ(ai, bj, At, Bt) do { __builtin_amdgcn_s_setprio(1); _Pragma("unroll") for (int m = 0; m < 4; ++m) _Pragma("unroll") for (int n = 0; n < 2; ++n) { \
        if constexpr (Prob::FP8) { asm volatile("v_mfma_scale_f32_16x16x128_f8f6f4 %0, %1, %2, 0, %3, %4 op_sel_hi:[0,0,0]" : "=&v"(acc[ai][bj][m][n]) : "v"(cat8(Bt[n][0], Bt[n][1])), "v"(cat8(At[m][0], At[m][1])), "v"(sc_w), "v"(sc_x)); } \
        else { acc[ai][bj][m][n] = __builtin_amdgcn_mfma_f32_16x16x32_bf16(Bt[n][0], At[m][0], (f32x4){0.f, 0.f, 0.f, 0.f}, 0, 0, 0); acc[ai][bj][m][n] = __builtin_amdgcn_mfma_f32_16x16x32_bf16(Bt[n][1], At[m][1], acc[ai][bj][m][n], 0, 0, 0); } } __builtin_amdgcn_s_setprio(0); } while (0)
#define PG8_WAIT_V(n) asm volatile("s_waitcnt vmcnt(" #n ")" ::: "memory")
#define PG8_WAIT_V8R(flag) do { if constexpr (Epi::NSTORE > 0) asm volatile("s_cmp_lg_u32 %0, 0\n\ts_cbranch_scc1 .Lpg8w%=\n\ts_waitcnt vmcnt(8)\n.Lpg8w%=:\n\ts_waitcnt vmcnt(%1)" :: "s"(flag), "n"(8 + Epi::NSTORE) : "scc", "memory"); else PG8_WAIT_V(8); } while (0)
#define PG8_WAIT_L(n) asm volatile("s_waitcnt lgkmcnt(" #n ")" ::: "memory")
#define PG8_BAR __builtin_amdgcn_s_barrier()
#define PG8_SCHED __builtin_amdgcn_sched_barrier(0)
    Unit cur, nxt; int ui = 0;
    if (!P.next(0, cur)) return;
    const int ntm = nt - 1;
    int k0c = (cur.pm + 2 * cur.pn) & 7 & ntm;
    int sc_w = 0, sc_x = 0; if constexpr (Prob::FP8) { sc_w = P.scale_w; sc_x = P.scale_x; } (void)sc_w; (void)sc_x;
    f32x4 acc[2][2][4][2];
    bf16x8 At[4][2], B0[2][2], B1[2][2];
    unsigned vAc[2][2], vAn[2][2];
    Unit nx1; bool h1 = P.next(1, nx1);
    P.list_prefetch(cur, 0, wid, lane); if (h1) P.list_prefetch(nx1, 1, wid, lane);
    LAS float* const biasl = (LAS float*)(lds + BIAS_OFF); int bsc = 0;
    if constexpr (Epi::LDSBIAS) { if (wid == 1) E.prefetch(cur, biasl, lane); }
    PG8_WAIT_V(0); PG8_BAR;
    P.a_off(cur, 0, Rr, Cc, vAc);
    const char* cA = P.a_ptr(cur); const char* cB = P.b_ptr(cur);
    const size_t po0 = (size_t)k0c * kstep, po1 = (size_t)((k0c + 1) & ntm) * kstep;
    PG8_STAGE(PG8_SB(0, 0), cB + po0, voffB); PG8_STAGE(PG8_SB(0, 1), cB + hstepB + po0, voffB); PG8_STAGE(PG8_SA(0, 0), cA + po0, vAc[0]); PG8_STAGE(PG8_SA(0, 1), cA + po0, vAc[1]);
    if (wr == 1) PG8_BAR;
    PG8_WAIT_V(2); PG8_BAR;
    PG8_STAGE(PG8_SB(1, 0), cB + po1, voffB); PG8_STAGE(PG8_SA(1, 0), cA + po1, vAc[0]); PG8_STAGE(PG8_SB(1, 1), cB + hstepB + po1, voffB);
    PG8_WAIT_V(6); PG8_BAR;
    for (;;) {
        const bool has_next = h1; nxt = nx1;
        const char* nA = cA; const char* nB = cB;
#pragma unroll
        for (int h = 0; h < 2; ++h)
#pragma unroll
            for (int i = 0; i < 2; ++i) vAn[h][i] = vAc[h][i];
        int k0n = k0c;
        if (has_next) { nA = P.a_ptr(nxt); nB = P.b_ptr(nxt); P.a_off(nxt, (ui + 1) & 1, Rr, Cc, vAn); k0n = (nxt.pm + 2 * nxt.pn) & 7 & ntm; }
        h1 = has_next && P.next(ui + 2, nx1); if (h1) P.list_prefetch(nx1, ui & 1, wid, lane);
        const int bsn = (bsc == 2) ? 0 : bsc + 1;
        if constexpr (Epi::LDSBIAS) { if (has_next && wid == 1) E.prefetch(nxt, biasl + bsn * 256, lane); }
#define PG8_KBODY(T, MMX, W12) { const int t = (T); const bool last = (t == nt - 2); \
            asm volatile("" : "+v"(voffB[0]), "+v"(voffB[1]), "+v"(vAc[0][0]), "+v"(vAc[0][1]), "+v"(vAc[1][0]), "+v"(vAc[1][1])); \
            const char* a1 = cA + (size_t)((t + 1 + k0c) & ntm) * kstep; \
            const size_t o2 = (size_t)(last ? k0n : ((t + 2 + k0c) & ntm)) * kstep, o3 = (size_t)(last ? ((k0n + 1) & ntm) : ((t + 3 + k0c) & ntm)) * kstep; \
            const char* a2 = (last ? nA : cA) + o2; const char* b2 = (last ? nB : cB) + o2; \
            const char* a3 = (last ? nA : cA) + o3; const char* b3 = (last ? nB : cB) + o3; \
            unsigned vX[2][2]; \
            _Pragma("unroll") for (int h = 0; h < 2; ++h) _Pragma("unroll") for (int i = 0; i < 2; ++i) vX[h][i] = last ? vAn[h][i] : vAc[h][i]; \
            PG8_LDB(B0, 0, 0); PG8_LDB(B1, 0, 1); PG8_SCHED; PG8_LDA(At, 0, 0); PG8_STAGE(PG8_SA(1, 1), a1, vAc[1]); \
            W12; PG8_WAIT_L(0); PG8_BAR; MMX(0, 0, At, B0); MMX(0, 1, At, B1); PG8_BAR; PG8_SCHED; \
            PG8_LDA(At, 0, 1); PG8_STAGE(PG8_SB(0, 0), b2, voffB); PG8_STAGE(PG8_SB(0, 1), b2 + hstepB, voffB); PG8_STAGE(PG8_SA(0, 0), a2, vX[0]); \
            W12; PG8_WAIT_L(0); PG8_BAR; MMX(1, 0, At, B0); MMX(1, 1, At, B1); PG8_BAR; PG8_SCHED; \
            PG8_LDB(B0, 1, 0); PG8_LDB(B1, 1, 1); PG8_SCHED; PG8_LDA(At, 1, 0); PG8_STAGE(PG8_SA(0, 1), a2, vX[1]); \
            PG8_WAIT_V(8); PG8_WAIT_L(0); PG8_BAR; PG8_MMA(0, 0, At, B0); PG8_MMA(0, 1, At, B1); PG8_BAR; PG8_SCHED; \
            PG8_LDA(At, 1, 1); PG8_STAGE(PG8_SB(1, 0), b3, voffB); PG8_STAGE(PG8_SB(1, 1), b3 + hstepB, voffB); PG8_STAGE(PG8_SA(1, 0), a3, vX[0]); \
            PG8_WAIT_V(8); PG8_WAIT_L(0); PG8_BAR; PG8_MMA(1, 0, At, B0); PG8_MMA(1, 1, At, B1); PG8_BAR; PG8_SCHED; }
        if constexpr (Prob::FP8) {
            { const int rlx = __builtin_amdgcn_readfirstlane(ui != 0 ? 1 : 0);
              PG8_KBODY(0, PG8_MMAZ, PG8_WAIT_V8R(rlx)) }
            for (int tt = 2; tt < nt; tt += 2) PG8_KBODY(tt, PG8_MMA, PG8_WAIT_V(8))
        } else {
            { f32x4 zz = (f32x4){0.f, 0.f, 0.f, 0.f}; asm volatile("" : "+v"(zz));
#pragma unroll
                for (int a = 0; a < 2; ++a)
#pragma unroll
                    for (int b = 0; b < 2; ++b)
#pragma unroll
                        for (int m = 0; m < 4; ++m)
#pragma unroll
                            for (int n = 0; n < 2; ++n) acc[a][b][m][n] = zz; }
            for (int tt = 0; tt < nt; tt += 2) PG8_KBODY(tt, PG8_MMA, PG8_WAIT_V(8))
        }
#undef PG8_KBODY
        f32x4 bqe[2][2];
        if constexpr (Epi::LDSBIAS) {
#pragma unroll
            for (int bj = 0; bj < 2; ++bj)
#pragma unroll
                for (int n = 0; n < 2; ++n) bqe[bj][n] = *(const LAS f32x4*)(biasl + bsc * 256 + bj * 128 + wc * 32 + 8 * fq + 4 * n);
        } else { (void)bqe; }
        if (wr == 0) PG8_BAR;
        if constexpr (Prob::FP8) { asm volatile("s_nop 15\n\ts_nop 15" ::: "memory");
#pragma unroll
            for (int a = 0; a < 2; ++a)
#pragma unroll
                for (int b = 0; b < 2; ++b)
                    asm volatile("" : "+v"(acc[a][b][0][0]), "+v"(acc[a][b][0][1]), "+v"(acc[a][b][1][0]), "+v"(acc[a][b][1][1]), "+v"(acc[a][b][2][0]), "+v"(acc[a][b][2][1]), "+v"(acc[a][b][3][0]), "+v"(acc[a][b][3][1])); }
        if constexpr (Epi::LDSBIAS) E(acc, cur, wr, wc, fr, fq, bqe); else E(acc, cur, wr, wc, fr, fq);
        if (!has_next) break;
        cur = nxt; cA = nA; cB = nB; k0c = k0n; bsc = bsn; ++ui;
#pragma unroll
        for (int h = 0; h < 2; ++h)
#pragma unroll
            for (int i = 0; i < 2; ++i) vAc[h][i] = vAn[h][i];
        if (wr == 1) PG8_BAR;
    }
    PG8_WAIT_V(0);
    PG8_BAR;
#undef PG8_SA
#undef PG8_SB
#undef PG8_STAGE
#undef PG8_LDA
#undef PG8_LDB
#undef PG8_MMA
#undef PG8_MMAZ
#undef PG8_WAIT_V
#undef PG8_WAIT_L
#undef PG8_WAIT_V8R
#undef PG8_BAR
#undef PG8_SCHED
}
}

using pg8::Unit;
constexpr int HALF_ = 128;
struct EpiBf16Act {
    static constexpr bool PERM = true; static constexpr bool LDSBIAS = false; static constexpr int NSTORE = 0;
    bf16_t* O; int ldc; const float* bias; int act; float scale;
    __device__ __forceinline__ void operator()(const f32x4 (&acc)[2][2][4][2], const Unit& u, int wr, int wc, int fr, int fq) const {
        const int row0 = u.pm * 256 + wr * 64 + fr, col0 = u.pn * 256 + wc * 32 + 8 * fq;
        f32x4 bv[2][2];
#pragma unroll
        for (int bj = 0; bj < 2; ++bj)
#pragma unroll
            for (int n = 0; n < 2; ++n) bv[bj][n] = bias ? *(const f32x4*)(bias + col0 + bj * HALF_ + 4 * n) : (f32x4){0.f, 0.f, 0.f, 0.f};
#pragma unroll
        for (int ai = 0; ai < 2; ++ai)
#pragma unroll
            for (int m = 0; m < 4; ++m) { bf16_t* rowp = O + (size_t)(row0 + ai * HALF_ + m * 16) * ldc + col0;
#pragma unroll
                for (int bj = 0; bj < 2; ++bj) { f32x4 v0 = acc[ai][bj][m][0] + bv[bj][0], v1 = acc[ai][bj][m][1] + bv[bj][1];
                    if (act == 1) {
#pragma unroll
                        for (int j = 0; j < 4; ++j) { v0[j] = sigmoidf_(v0[j]) * scale; v1[j] = sigmoidf_(v1[j]) * scale; } }
                    else if (act == 2) {
#pragma unroll
                        for (int j = 0; j < 4; ++j) { v0[j] = 1.0f - 2.0f * __builtin_amdgcn_rcpf(__builtin_amdgcn_exp2f(2.8853900817779268f * v0[j]) + 1.0f); v1[j] = 1.0f - 2.0f * __builtin_amdgcn_rcpf(__builtin_amdgcn_exp2f(2.8853900817779268f * v1[j]) + 1.0f); } }
                    u32x4 w; w.x = cvt_pk_bf16(v0[0], v0[1]); w.y = cvt_pk_bf16(v0[2], v0[3]); w.z = cvt_pk_bf16(v1[0], v1[1]); w.w = cvt_pk_bf16(v1[2], v1[3]);
                    *(u32x4*)(rowp + bj * HALF_) = w; } }
    }
};
struct EpiQK {
    static constexpr bool PERM = true; static constexpr bool LDSBIAS = false; static constexpr int NSTORE = 0;
    bf16_t* Q; bf16_t* Kb; const float* bias; const float* ropec; const float* ropes;
    __device__ __forceinline__ void operator()(const f32x4 (&acc)[2][2][4][2], const Unit& u, int wr, int wc, int fr, int fq) const {
        int row0 = u.pm * 256 + wr * 64 + fr, cl0 = wc * 32 + 8 * fq;
        asm volatile("" : "+v"(row0), "+v"(cl0));
        const int g = (4 * wc + fq) & 7;
        bf16_t* base; int ldc;
        if (u.pn < 4) { base = Q + u.pn * 256; ldc = 1024; } else { base = Kb; ldc = 256; }
        f32x4 bv[2][2];
#pragma unroll
        for (int bj = 0; bj < 2; ++bj)
#pragma unroll
            for (int n = 0; n < 2; ++n) bv[bj][n] = *(const f32x4*)(bias + u.pn * 256 + cl0 + bj * HALF_ + 4 * n);
#pragma unroll
        for (int ai = 0; ai < 2; ++ai)
#pragma unroll
            for (int m = 0; m < 4; ++m) { const int row = row0 + ai * HALF_ + m * 16; bf16_t* rowp = base + (size_t)row * ldc + cl0;
                f32x4 cs = (f32x4){1.f, 1.f, 1.f, 1.f}, sn = (f32x4){0.f, 0.f, 0.f, 0.f};
                if (row < NX) { const int t = row & (T - 1); cs = *(const f32x4*)(ropec + t * 32 + g * 4); sn = *(const f32x4*)(ropes + t * 32 + g * 4); }
#pragma unroll
                for (int bj = 0; bj < 2; ++bj) { const f32x4 v0 = acc[ai][bj][m][0] + bv[bj][0], v1 = acc[ai][bj][m][1] + bv[bj][1];
                    const f32x4 o0 = v0 * cs - v1 * sn, o1 = v1 * cs + v0 * sn;
                    u32x4 w; w.x = cvt_pk_bf16(o0[0], o0[1]); w.y = cvt_pk_bf16(o0[2], o0[3]); w.z = cvt_pk_bf16(o1[0], o1[1]); w.w = cvt_pk_bf16(o1[2], o1[3]);
                    *(u32x4*)(rowp + bj * HALF_) = w; } }
    }
};
struct EpiVT {
    static constexpr bool PERM = true; static constexpr bool LDSBIAS = false; static constexpr int NSTORE = 0;
    bf16_t* VT; const float* biasrow;
    __device__ __forceinline__ void operator()(const f32x4 (&acc)[2][2][4][2], const Unit& u, int wr, int wc, int fr, int fq) const {
        int row0 = wr * 64 + fr, col0 = u.pn * 256 + wc * 32 + 8 * fq;
        asm volatile("" : "+v"(row0), "+v"(col0));
#pragma unroll
        for (int ai = 0; ai < 2; ++ai)
#pragma unroll
            for (int m = 0; m < 4; ++m) { const int row = row0 + ai * HALF_ + m * 16; const float b = biasrow[row]; bf16_t* rowp = VT + (size_t)row * NT + col0;
#pragma unroll
                for (int bj = 0; bj < 2; ++bj) { const f32x4 v0 = acc[ai][bj][m][0] + b, v1 = acc[ai][bj][m][1] + b;
                    u32x4 w; w.x = cvt_pk_bf16(v0[0], v0[1]); w.y = cvt_pk_bf16(v0[2], v0[3]); w.z = cvt_pk_bf16(v1[0], v1[1]); w.w = cvt_pk_bf16(v1[2], v1[3]);
                    *(u32x4*)(rowp + bj * HALF_) = w; } }
    }
};
struct EpiResid {
    static constexpr bool PERM = true; static constexpr bool LDSBIAS = false; static constexpr int NSTORE = 0;
    bf16_t* H; const float* bias; const float* ls; const float* gate;
    __device__ __forceinline__ void operator()(const f32x4 (&acc)[2][2][4][2], const Unit& u, int wr, int wc, int fr, int fq) const {
        int row0 = u.pm * 256 + wr * 64 + fr, col0 = u.pn * 256 + wc * 32 + 8 * fq;
        asm volatile("" : "+v"(row0), "+v"(col0));
        f32x4 bv[2][2], lv[2][2];
#pragma unroll
        for (int bj = 0; bj < 2; ++bj)
#pragma unroll
            for (int n = 0; n < 2; ++n) { bv[bj][n] = bias ? *(const f32x4*)(bias + col0 + bj * HALF_ + 4 * n) : (f32x4){0.f, 0.f, 0.f, 0.f};
                                          lv[bj][n] = ls ? *(const f32x4*)(ls + col0 + bj * HALF_ + 4 * n) : (f32x4){1.f, 1.f, 1.f, 1.f}; }
#pragma unroll
        for (int ai = 0; ai < 2; ++ai)
#pragma unroll
            for (int m = 0; m < 4; ++m) { const int row = row0 + ai * HALF_ + m * 16; const int brow = row < NX ? (row >> 11) : 32;
                bf16_t* hp = H + (size_t)row * D + col0; const float* gp = gate + (size_t)brow * (6 * D) + col0;
#pragma unroll
                for (int bj = 0; bj < 2; ++bj) { const u32x4 hw = *(const u32x4*)(hp + bj * HALF_);
                    const f32x4 g0 = *(const f32x4*)(gp + bj * HALF_), g1 = *(const f32x4*)(gp + bj * HALF_ + 4);
                    const f32x4 y0 = (acc[ai][bj][m][0] + bv[bj][0]) * lv[bj][0], y1 = (acc[ai][bj][m][1] + bv[bj][1]) * lv[bj][1];
                    const f32x4 h0 = (f32x4){bflo(hw.x), bfhi(hw.x), bflo(hw.y), bfhi(hw.y)} + g0 * y0, h1 = (f32x4){bflo(hw.z), bfhi(hw.z), bflo(hw.w), bfhi(hw.w)} + g1 * y1;
                    u32x4 w; w.x = cvt_pk_bf16(h0[0], h0[1]); w.y = cvt_pk_bf16(h0[2], h0[3]); w.z = cvt_pk_bf16(h1[0], h1[1]); w.w = cvt_pk_bf16(h1[2], h1[3]);
                    *(u32x4*)(hp + bj * HALF_) = w; }
                asm volatile("" ::: "memory"); }
    }
};
struct EpiMoe1 {
    static constexpr bool PERM = true; static constexpr bool LDSBIAS = true; static constexpr int NSTORE = 8;
    unsigned char* ACT; const float* b1;
    __device__ __forceinline__ void prefetch(const Unit& u, LAS float* slot, int lane) const {
        const float* src = b1 + (size_t)u.e * 2048 + u.pn * 128 + (lane >> 5) * 1024 + (lane & 31) * 4;
        __builtin_amdgcn_global_load_lds((const unsigned*)src, (LAS unsigned*)slot, 16, 0, 0); }
    __device__ __forceinline__ void operator()(const f32x4 (&acc)[2][2][4][2], const Unit& u, int wr, int wc, int fr, int fq, const f32x4 (&bq)[2][2]) const {
        unsigned char* const Ab = ACT + ((size_t)u.rt * 256 * D + (size_t)u.pn * 128);
        unsigned voff = (unsigned)((wr * 64 + fr) * D + wc * 32 + 8 * fq); asm volatile("" : "+v"(voff));
        f32x4 bgv[2], blv[2];
#pragma unroll
        for (int n = 0; n < 2; ++n) { bgv[n] = bq[0][n]; blv[n] = bq[1][n]; }
#pragma unroll
        for (int ai = 0; ai < 2; ++ai)
#pragma unroll
            for (int m = 0; m < 4; ++m) { unsigned char* rowp = Ab + (size_t)(ai * HALF_ + m * 16) * D + voff;
                f32x4 o[2];
#pragma unroll
                for (int n = 0; n < 2; ++n) { const f32x4 c7 = (f32x4){7.f, 7.f, 7.f, 7.f};
                    const f32x4 gl = __builtin_elementwise_min(acc[ai][0][m][n] + bgv[n], c7), li = __builtin_elementwise_min(__builtin_elementwise_max(acc[ai][1][m][n] + blv[n], -c7), c7);
                    const f32x4 z = gl * (-1.702f * 1.4426950408889634f);
#pragma unroll
                    for (int j = 0; j < 4; j += 2) {
                        f32x2 d2 = (f32x2){__builtin_amdgcn_exp2f(z[j]), __builtin_amdgcn_exp2f(z[j + 1])} + 1.0f; asm("" : "+v"(d2));
                        f32x2 gd = (f32x2){gl[j], gl[j + 1]} * (f32x2){__builtin_amdgcn_rcpf(d2.x), __builtin_amdgcn_rcpf(d2.y)}; asm("" : "+v"(gd));
                        const f32x2 o2 = gd * (f32x2){li[j], li[j + 1]} + gd;
                        o[n][j] = o2.x; o[n][j + 1] = o2.y; } }
                u32x2 w; w.x = pk4_fp8(o[0][0], o[0][1], o[0][2], o[0][3]); w.y = pk4_fp8(o[1][0], o[1][1], o[1][2], o[1][3]);
                *(u32x2*)rowp = w; }
    }
};
struct EpiMoe2 {
    static constexpr bool PERM = true; static constexpr bool LDSBIAS = true; static constexpr int NSTORE = 16;
    unsigned char* Y; const float* b2;
    __device__ __forceinline__ void prefetch(const Unit& u, LAS float* slot, int lane) const {
        const float* src = b2 + (size_t)u.e * D + u.pn * 256 + lane * 4;
        __builtin_amdgcn_global_load_lds((const unsigned*)src, (LAS unsigned*)slot, 16, 0, 0); }
    __device__ __forceinline__ void operator()(const f32x4 (&acc)[2][2][4][2], const Unit& u, int wr, int wc, int fr, int fq, const f32x4 (&bq)[2][2]) const {
        unsigned char* const Yb = Y + ((size_t)u.rt * 256 * D + (size_t)u.pn * 256);
        unsigned voff = (unsigned)((wr * 64 + fr) * D + wc * 32 + 8 * fq); asm volatile("" : "+v"(voff));
        f32x4 bv[2][2];
#pragma unroll
        for (int bj = 0; bj < 2; ++bj)
#pragma unroll
            for (int n = 0; n < 2; ++n) bv[bj][n] = bq[bj][n];
#pragma unroll
        for (int ai = 0; ai < 2; ++ai)
#pragma unroll
            for (int m = 0; m < 4; ++m) { unsigned char* rowp = Yb + (size_t)(ai * HALF_ + m * 16) * D + voff;
#pragma unroll
                for (int bj = 0; bj < 2; ++bj) { f32x4 v0 = bv[bj][0] * 4.0f + acc[ai][bj][m][0], v1 = bv[bj][1] * 4.0f + acc[ai][bj][m][1];
#pragma unroll
                    for (int i = 0; i < 4; ++i) { v0[i] = __builtin_amdgcn_fmed3f(v0[i], -448.0f, 448.0f); v1[i] = __builtin_amdgcn_fmed3f(v1[i], -448.0f, 448.0f); }
                    *(u32x2*)(rowp + bj * HALF_) = (u32x2){pk4_fp8(v0[0], v0[1], v0[2], v0[3]), pk4_fp8(v1[0], v1[1], v1[2], v1[3])}; } }
    }
};
typedef unsigned char fp8_t;
constexpr int SCALE_ONE = 0x7f7f7f7f, SCALE_W = 0x79797979, SCALE_W4 = 0x7b7b7b7b;
struct ProbMoe1 {
    static constexpr bool FP8 = true;
    const fp8_t* FX; const fp8_t* W1T; const int* list; const LAS int* tpre; const LAS int* cnt; const LAS unsigned char* texp; LAS int* toks; int scale_w, scale_x; pg8::TileOrder ord;
    __device__ __forceinline__ int ldb_bytes() const { return D; }
    __device__ __forceinline__ int ntiles() const { return D / 128; }
    __device__ __forceinline__ bool next(int i, Unit& u) const {
        if (!ord.next(i, u.pm, u.pn)) return false;
        u.rt = u.pm; u.e = texp[u.rt]; return true;
    }
    __device__ __forceinline__ const char* a_ptr(const Unit&) const { return (const char*)FX; }
    __device__ __forceinline__ const char* b_ptr(const Unit& u) const { return (const char*)(W1T + ((size_t)u.e * 2048 + (size_t)u.pn * 256) * D); }
    __device__ __forceinline__ void list_prefetch(const Unit& u, int par, int wid, int lane) const {
        if (wid == 0) { const int* src = list + (size_t)u.e * NT + (u.rt - tpre[u.e]) * 256 + 4 * lane;
            __builtin_amdgcn_global_load_lds((const unsigned*)src, (LAS unsigned*)(toks + par * 256), 16, 0, 0); }
    }
    __device__ __forceinline__ void a_off(const Unit& u, int par, const int (&R)[2], const int (&C)[2], unsigned (&v)[2][2]) const {
        const int nvalid = cnt[u.e] - (u.rt - tpre[u.e]) * 256; const LAS int* tk = toks + par * 256;
#pragma unroll
        for (int h = 0; h < 2; ++h)
#pragma unroll
            for (int i = 0; i < 2; ++i) { const int r = h * 128 + R[i]; const int tok = tk[r < nvalid ? r : 0]; v[h][i] = (unsigned)(tok * D + C[i] * 2); }
    }
};
struct ProbMoe2 {
    static constexpr bool FP8 = true;
    const fp8_t* ACT; const fp8_t* W2T; const LAS int* tpre; const LAS unsigned char* texp; int scale_w, scale_x; pg8::TileOrder ord;
    __device__ __forceinline__ int ldb_bytes() const { return D; }
    __device__ __forceinline__ int ntiles() const { return D / 128; }
    __device__ __forceinline__ bool next(int i, Unit& u) const {
        if (!ord.next(i, u.pm, u.pn)) return false;
        u.rt = ord.nM - 1 - u.pm; u.e = texp[u.rt]; return true;
    }
    __device__ __forceinline__ const char* a_ptr(const Unit& u) const { return (const char*)(ACT + (size_t)u.rt * 256 * D); }
    __device__ __forceinline__ const char* b_ptr(const Unit& u) const { return (const char*)(W2T + ((size_t)u.e * 1024 + (size_t)u.pn * 256) * D); }
    __device__ __forceinline__ void list_prefetch(const Unit&, int, int, int) const {}
    __device__ __forceinline__ void a_off(const Unit&, int, const int (&R)[2], const int (&C)[2], unsigned (&v)[2][2]) const {
#pragma unroll
        for (int h = 0; h < 2; ++h)
#pragma unroll
            for (int i = 0; i < 2; ++i) v[h][i] = (unsigned)((h * 128 + R[i]) * D + C[i] * 2);
    }
};
struct Args { const float* in[38]; float* out; unsigned char* ws; int phase; int one; };
enum { I_X = 0, I_C, I_CTX, I_CCTX, I_ADAW, I_ADAB, I_NORMG, I_AWQKV, I_ABQKV, I_AWO, I_ABO, I_ASINK, I_PW, I_PB, I_PS,
       I_RMIX, I_RWRKV, I_RW0, I_RW1, I_RW2, I_RA0, I_RA1, I_RA2, I_RG1, I_RG2, I_RKK, I_RKA, I_RRK, I_RLNW, I_RLNB, I_RWO,
       I_MWR, I_MBR, I_MW1, I_MB1, I_MW2, I_MB2, I_FG };
struct Frame { LAS unsigned char* lds; int tid, lane, wave, G, c; unsigned char* ws; unsigned* ctl; };
#define WSP(T_, off) ((T_*)(F.ws + (off)))

struct TJob { const float* src; unsigned char* dst; long sbs, dbs; int ldw, ldt, nkb, nnb, mode, item0, per, esz; };
__device__ __forceinline__ int dst_row(int mode, int n) {
    if (mode == 1) { const int hb = n & ~63, d = n & 63; const int ax = d >> 5, dd = d & 31, hf = dd >> 4, f = dd & 15; const int g = ax * 4 + (f >> 2), i = (f & 3) + 4 * hf; return hb + 8 * g + i; }
    if (mode == 2) { return n < 1024 ? ((n >> 7) << 8) + (n & 127) : (((n - 1024) >> 7) << 8) + 128 + (n & 127); }
    return n;
}
struct TItem { const float* src; unsigned char* dst; int ldw, ldt, mode, n0, esz; };
__device__ __forceinline__ void titem_decode(const LAS TJob* jobs, int nj, int it, TItem& T) {
    int ji = 0;
    for (int q = 1; q < nj; ++q) ji += (jobs[q].item0 <= it) ? 1 : 0;
    const LAS TJob& J = jobs[ji]; const int r = it - J.item0, bi = r / J.per, rr = r % J.per, kb = rr / J.nnb, nb = rr % J.nnb;
    T.src = J.src + bi * J.sbs + (size_t)(64 * kb) * J.ldw + 32 * nb; T.dst = J.dst + (bi * J.dbs + 64 * kb) * J.esz; T.ldw = J.ldw; T.ldt = J.ldt; T.mode = J.mode; T.n0 = 32 * nb; T.esz = J.esz;
}
__device__ __forceinline__ void titem_load(const TItem& T, int lane, f32x4 (&v)[8]) {
    const float* p = T.src + (size_t)(lane >> 3) * T.ldw + 4 * (lane & 7);
#pragma unroll
    for (int i = 0; i < 8; ++i) v[i] = *(const f32x4*)(p + (size_t)(8 * i) * T.ldw);
}
__device__ __forceinline__ void titem_store(const TItem& T, int lane, const f32x4 (&v)[8], LAS float* scr) {
#pragma unroll
    for (int i = 0; i < 8; ++i) { LAS float* d = scr + (8 * i + (lane >> 3)) * 33 + 4 * (lane & 7); d[0] = v[i].x; d[1] = v[i].y; d[2] = v[i].z; d[3] = v[i].w; }
    LDS_WAIT(); asm volatile("" ::: "memory");
    const int c = lane & 7;
#pragma unroll
    for (int j = 0; j < 4; ++j) { const int n = (lane >> 3) + 8 * j; const LAS float* s = scr + (8 * c) * 33 + n;
        const size_t eo = (size_t)dst_row(T.mode, T.n0 + n) * T.ldt + 8 * c;
        if (T.esz == 2) { u32x4 o; o.x = pk2(s[0 * 33], s[1 * 33]); o.y = pk2(s[2 * 33], s[3 * 33]); o.z = pk2(s[4 * 33], s[5 * 33]); o.w = pk2(s[6 * 33], s[7 * 33]); *(u32x4*)(T.dst + eo * 2) = o; }
        else { u32x2 o; o.x = pk4_fp8(64.f * s[0 * 33], 64.f * s[1 * 33], 64.f * s[2 * 33], 64.f * s[3 * 33]); o.y = pk4_fp8(64.f * s[4 * 33], 64.f * s[5 * 33], 64.f * s[6 * 33], 64.f * s[7 * 33]); *(u32x2*)(T.dst + eo) = o; } }
    LDS_WAIT(); asm volatile("" ::: "memory");
}
__device__ __forceinline__ void phase_prologue(Frame& F, const Args& A) {
    REFRESH(F);
    LAS float* S = (LAS float*)F.lds;
    for (int idx = F.tid; idx < 33 * 1024; idx += NTHREADS) { const int r = idx >> 10, k = idx & 1023; const float v = r < 32 ? A.in[I_C][r * 1024 + k] : A.in[I_CCTX][k]; S[k * 33 + r] = v / (1.0f + __expf(-v)); }
    __syncthreads();
    float* MOD = WSP(float, WS_MOD);
    for (int it = F.c; it < 4 * 48; it += F.G) {
        const int layer = it / 48, n = (it % 48) * 128 + F.lane; const float* wp = A.in[I_ADAW] + (size_t)layer * 1024 * 6144 + n;
        float acc[5] = {0.f, 0.f, 0.f, 0.f, 0.f}, acd[5] = {0.f, 0.f, 0.f, 0.f, 0.f};
        for (int k0 = 0; k0 < 1024; k0 += 16) {
            float wv[16], wd[16];
#pragma unroll
            for (int u = 0; u < 16; ++u) { wv[u] = wp[(size_t)(k0 + u) * 6144]; wd[u] = wp[(size_t)(k0 + u) * 6144 + 64]; }
#pragma unroll
            for (int u = 0; u < 16; ++u) { const LAS float* sr = S + (k0 + u) * 33 + F.wave; const float s0 = sr[0], s1 = sr[8], s2 = sr[16], s3 = sr[24];
                acc[0] += s0 * wv[u]; acc[1] += s1 * wv[u]; acc[2] += s2 * wv[u]; acc[3] += s3 * wv[u];
                acd[0] += s0 * wd[u]; acd[1] += s1 * wd[u]; acd[2] += s2 * wd[u]; acd[3] += s3 * wd[u];
                if (F.wave == 0) { const float s4 = S[(k0 + u) * 33 + 32]; acc[4] += s4 * wv[u]; acd[4] += s4 * wd[u]; } }
        }
        const float bb = A.in[I_ADAB][layer * 6144 + n], bd = A.in[I_ADAB][layer * 6144 + n + 64];
#pragma unroll
        for (int i = 0; i < 4; ++i) { MOD[((size_t)layer * 33 + F.wave + 8 * i) * 6144 + n] = acc[i] + bb; MOD[((size_t)layer * 33 + F.wave + 8 * i) * 6144 + n + 64] = acd[i] + bd; }
        if (F.wave == 0) { MOD[((size_t)layer * 33 + 32) * 6144 + n] = acc[4] + bb; MOD[((size_t)layer * 33 + 32) * 6144 + n + 64] = acd[4] + bd; }
    }
    { float* rc = WSP(float, WS_ROPEC); float* rs = WSP(float, WS_ROPES);
      for (int idx = F.c * NTHREADS + F.tid; idx < 2048 * 32; idx += F.G * NTHREADS) { const int t = idx >> 5, e = idx & 31, g = e >> 2, i = e & 3, f = 4 * (g & 3) + i;
          const float inv = powf(10000.0f, -(float)f / 16.0f); const float pos = (float)(g < 4 ? (t >> 6) : (t & 63)); const float ang = pos * inv; rc[idx] = cosf(ang); rs[idx] = sinf(ang); }
      float* bq = WSP(float, WS_BQK);
      for (int idx = F.c * NTHREADS + F.tid; idx < 2 * 1280; idx += F.G * NTHREADS) { const int j = idx / 1280, n = idx % 1280; bq[j * 1280 + dst_row(1, n)] = A.in[I_ABQKV][j * 1536 + n]; } }
    __syncthreads();
    LAS TJob* jobs = (LAS TJob*)(F.lds + JOB_OFF); LAS int* njobs = (LAS int*)(F.lds + MISC_OFF + 64);
    if (F.tid == 0) {
        int nj = 0, item = 0;
        auto add = [&](const float* src, bf16_t* dst, int ldw, int ldt, int Ks, int Ns, int mode, int nb, long sbs, long dbs, int esz = 2) {
            LAS TJob& j = jobs[nj]; j.src = src; j.dst = (unsigned char*)dst; j.sbs = sbs; j.dbs = dbs; j.ldw = ldw; j.ldt = ldt; j.nkb = Ks / 64; j.nnb = Ns / 32; j.mode = mode; j.item0 = item; j.per = (Ks / 64) * (Ns / 32); j.esz = esz;
            ++nj; item += (Ks / 64) * (Ns / 32) * nb; };
        add(A.in[I_AWQKV], WSP(bf16_t, WS_WQK), 1536, 1024, 1024, 1280, 1, 2, 1024L * 1536, 1280L * 1024, 1);
        add(A.in[I_AWQKV] + 1280, WSP(bf16_t, WS_WV), 1536, 1024, 1024, 256, 0, 2, 1024L * 1536, 256L * 1024, 1);
        add(A.in[I_AWO], WSP(bf16_t, WS_WO), 1024, 1024, 1024, 1024, 0, 2, 1L << 20, 1L << 20, 1);
        add(A.in[I_PW], WSP(bf16_t, WS_POOLW), 256, 256, 256, 256, 0, 4, 65536, 65536);
        add(A.in[I_RWRKV], WSP(bf16_t, WS_WRKV), 1024, 1024, 1024, 1024, 0, 3, 1L << 20, 1L << 20, 1);
        add(A.in[I_RG1], WSP(bf16_t, WS_WL1), 128, 1024, 1024, 128, 0, 1, 0, 0);
        add(A.in[I_RW1], WSP(bf16_t, WS_WL1) + 256 * 1024, 64, 1024, 1024, 64, 0, 2, 65536, 65536);
        add(A.in[I_RA1], WSP(bf16_t, WS_WL1) + 2 * 256 * 1024, 64, 1024, 1024, 64, 0, 2, 65536, 65536);
        add(A.in[I_RG2], WSP(bf16_t, WS_WL2), 1024, 256, 128, 1024, 0, 1, 0, 0);
        add(A.in[I_RW2], WSP(bf16_t, WS_WL2) + 1 * 1024 * 256, 1024, 256, 64, 1024, 0, 2, 65536, 1024L * 256 + 64);
        add(A.in[I_RA2], WSP(bf16_t, WS_WL2) + 3 * 1024 * 256, 1024, 256, 64, 1024, 0, 2, 65536, 1024L * 256 + 64);
        add(A.in[I_RWO], WSP(bf16_t, WS_WOR), 1024, 1024, 1024, 1024, 0, 1, 0, 0, 1);
        add(A.in[I_MW1], WSP(bf16_t, WS_W1T), 2048, 1024, 1024, 2048, 2, 128, 1024L * 2048, 2048L * 1024, 1);
        add(A.in[I_MW2], WSP(bf16_t, WS_W2T), 1024, 1024, 1024, 1024, 0, 128, 1L << 20, 1L << 20, 1);
        njobs[0] = nj; njobs[1] = item;
    }
    __syncthreads();
    { const int nj = njobs[0], nitems = njobs[1]; LAS float* scr = (LAS float*)(F.lds + F.wave * 16384);
      const int gw = F.c * NWAVES + F.wave, NGW = F.G * NWAVES;
      int it = gw;
      if (it < nitems) {
          TItem Tc, Tn; f32x4 vc[8], vn[8];
          titem_decode(jobs, nj, it, Tc); titem_load(Tc, F.lane, vc);
          for (;;) {
              const int itn = it + NGW; const bool more = itn < nitems;
              if (more) { titem_decode(jobs, nj, itn, Tn); titem_load(Tn, F.lane, vn); }
              titem_store(Tc, F.lane, vc, scr);
              if (!more) break;
              Tc = Tn;
#pragma unroll
              for (int i = 0; i < 8; ++i) vc[i] = vn[i];
              it = itn;
          }
      } }
    __syncthreads();
}

__device__ __forceinline__ void moe_tiles(Frame& F, int layer) {
    REFRESH(F);
    LAS int* lcnt = (LAS int*)(F.lds + LCNT_OFF); LAS int* tpre = (LAS int*)(F.lds + TPRE_OFF);
    __syncthreads();
    if (F.tid < NE) lcnt[F.tid] = (int)__hip_atomic_load(F.ctl + CW_GCNT + layer * 64 + F.tid, __ATOMIC_RELAXED, __HIP_MEMORY_SCOPE_AGENT);
    __syncthreads();
    if (F.tid == 0) { int s = 0; for (int e = 0; e < NE; ++e) { tpre[e] = s; s += (lcnt[e] + 255) >> 8; } tpre[NE] = s; }
    __syncthreads();
    { LAS unsigned char* texp = (LAS unsigned char*)(F.lds + TEXP_OFF); const int nrt = tpre[NE];
      for (int rt = F.tid; rt < nrt; rt += NTHREADS) { int e = 0; for (int j = 1; j < NE; ++j) e += (tpre[j] <= rt) ? 1 : 0; texp[rt] = (unsigned char)e; } }
    __syncthreads();
}
constexpr int RB = 2;
#define ROWOF(it, r) ((((it) * F.G + F.c) * NWAVES + F.wave) * RB + (r))
struct MoeRef { int p[4]; float g[4]; };
__device__ __forceinline__ void moe_ref_load(Frame& F, int row, MoeRef& R) {
    const int4 pp = *(const int4*)(WSP(int, WS_POS) + (size_t)row * 4); const f32x4 gg = *(const f32x4*)(WSP(float, WS_GATE) + (size_t)row * 4);
    R.p[0] = pp.x; R.p[1] = pp.y; R.p[2] = pp.z; R.p[3] = pp.w; R.g[0] = gg.x; R.g[1] = gg.y; R.g[2] = gg.z; R.g[3] = gg.w;
}
__device__ __forceinline__ void moe_rows_load(Frame& F, const MoeRef& R, unsigned (&y)[4][4]) {
    const LAS int* tpre = (const LAS int*)(F.lds + TPRE_OFF); const unsigned char* Y = WSP(unsigned char, WS_Y);
#pragma unroll
    for (int k = 0; k < 4; ++k) { const int e = R.p[k] >> 20, slot = R.p[k] & 0xfffff; const size_t fr = (size_t)tpre[e] * 256 + slot; const unsigned* yp = (const unsigned*)(Y + fr * D) + F.lane;
#pragma unroll
        for (int j = 0; j < 4; ++j) y[k][j] = yp[64 * j]; }
}
__device__ __forceinline__ f32x4 moe_rows_sum(const MoeRef& R, const unsigned (&y)[4][4], int j) {
    f32x4 s = (f32x4){0.f, 0.f, 0.f, 0.f};
#pragma unroll
    for (int k = 0; k < 4; ++k) { const int w = (int)y[k][j]; const f32x2 lo = __builtin_amdgcn_cvt_pk_f32_fp8(w, false), hi = __builtin_amdgcn_cvt_pk_f32_fp8(w, true);
        s += (R.g[k] * 0.25f) * (f32x4){lo.x, lo.y, hi.x, hi.y}; }
    return s;
}

__device__ __forceinline__ void phase_norm1(Frame& F, const Args& A, int layer) {
    REFRESH(F);
    if (layer > 0) moe_tiles(F, layer - 1);
    bf16_t* H = WSP(bf16_t, WS_H); bf16_t* AX = WSP(bf16_t, WS_AX); const float* MOD = WSP(float, WS_MOD);
    const float* g1 = A.in[I_NORMG] + (size_t)(layer * 2 + 0) * D;
    f32x4 gg[4];
#pragma unroll
    for (int j = 0; j < 4; ++j) gg[j] = ((const f32x4*)g1)[64 * j + F.lane];
    for (int it = 0;; ++it) { if (ROWOF(it, 0) >= NT) break;
        f32x4 v[RB][4]; int brow[RB];
        if (layer == 0) {
#pragma unroll
            for (int r = 0; r < RB; ++r) { const int row = ROWOF(it, r); brow[r] = row < NX ? (row >> 11) : 32; const float* src = row < NX ? A.in[I_X] + (size_t)row * D : A.in[I_CTX] + (size_t)(row - NX) * D;
#pragma unroll
                for (int j = 0; j < 4; ++j) v[r][j] = ((const f32x4*)src)[64 * j + F.lane]; }
        } else {
            MoeRef R[RB]; unsigned y[RB][4][4]; f32x4 gv[RB][4];
#pragma unroll
            for (int r = 0; r < RB; ++r) moe_ref_load(F, ROWOF(it, r), R[r]);
#pragma unroll
            for (int r = 0; r < RB; ++r) { const int row = ROWOF(it, r); brow[r] = row < NX ? (row >> 11) : 32; moe_rows_load(F, R[r], y[r]);
                const float* g2p = MOD + ((size_t)(layer - 1) * 33 + brow[r]) * 6144 + 5 * D;
#pragma unroll
                for (int j = 0; j < 4; ++j) { v[r][j] = ld_bf4(H + (size_t)row * D + 256 * j + 4 * F.lane); gv[r][j] = ((const f32x4*)g2p)[64 * j + F.lane]; } }
#pragma unroll
            for (int r = 0; r < RB; ++r)
#pragma unroll
                for (int j = 0; j < 4; ++j) v[r][j] = v[r][j] + gv[r][j] * moe_rows_sum(R[r], y[r], j);
        }
        float rstd[RB];
#pragma unroll
        for (int r = 0; r < RB; ++r) { const int row = ROWOF(it, r); float ss = 0.f;
#pragma unroll
            for (int j = 0; j < 4; ++j) { st_bf4(H + (size_t)row * D + 256 * j + 4 * F.lane, v[r][j]); ss += (v[r][j].x * v[r][j].x + v[r][j].y * v[r][j].y) + (v[r][j].z * v[r][j].z + v[r][j].w * v[r][j].w); }
            rstd[r] = 1.0f / sqrtf(wave_sum(ss) * (1.0f / D) + 1e-5f); }
#pragma unroll
        for (int r = 0; r < RB; ++r) { const int row = ROWOF(it, r); const float* mp = MOD + ((size_t)layer * 33 + brow[r]) * 6144;
#pragma unroll
            for (int j = 0; j < 4; ++j) { const f32x4 sh = ((const f32x4*)mp)[64 * j + F.lane], sc = ((const f32x4*)(mp + D))[64 * j + F.lane];
                const f32x4 o = v[r][j] * rstd[r] * gg[j] * (sc + 1.0f) + sh;
                if (layer % 3 == 0) ((unsigned*)((unsigned char*)AX + (size_t)row * D))[64 * j + F.lane] = pk4_fp8(o.x, o.y, o.z, o.w);
                else { u32x2 w; w.x = pk2(o.x, o.y); w.y = pk2(o.z, o.w); ((u32x2*)(AX + (size_t)row * D))[64 * j + F.lane] = w; } } }
    }
}
__device__ __forceinline__ void phase_final(Frame& F, const Args& A) {
    REFRESH(F);
    moe_tiles(F, DEPTH - 1);
    const bf16_t* H = WSP(bf16_t, WS_H); const float* MOD = WSP(float, WS_MOD); const float* fg = A.in[I_FG];
    f32x4 gg[4];
#pragma unroll
    for (int j = 0; j < 4; ++j) gg[j] = ((const f32x4*)fg)[64 * j + F.lane];
    for (int it = 0;; ++it) { if (ROWOF(it, 0) >= NX) break;
        MoeRef R[RB]; unsigned y[RB][4][4]; f32x4 v[RB][4], gv[RB][4];
#pragma unroll
        for (int r = 0; r < RB; ++r) moe_ref_load(F, ROWOF(it, r), R[r]);
#pragma unroll
        for (int r = 0; r < RB; ++r) { const int row = ROWOF(it, r); moe_rows_load(F, R[r], y[r]); const float* g2p = MOD + ((size_t)(DEPTH - 1) * 33 + (row >> 11)) * 6144 + 5 * D;
#pragma unroll
            for (int j = 0; j < 4; ++j) { v[r][j] = ld_bf4(H + (size_t)row * D + 256 * j + 4 * F.lane); gv[r][j] = ((const f32x4*)g2p)[64 * j + F.lane]; } }
#pragma unroll
        for (int r = 0; r < RB; ++r) { const int row = ROWOF(it, r); float ss = 0.f;
#pragma unroll
            for (int j = 0; j < 4; ++j) { v[r][j] = v[r][j] + gv[r][j] * moe_rows_sum(R[r], y[r], j); ss += (v[r][j].x * v[r][j].x + v[r][j].y * v[r][j].y) + (v[r][j].z * v[r][j].z + v[r][j].w * v[r][j].w); }
            const float rstd = 1.0f / sqrtf(wave_sum(ss) * (1.0f / D) + 1e-5f);
#pragma unroll
            for (int j = 0; j < 4; ++j) ((f32x4*)(A.out + (size_t)row * D))[64 * j + F.lane] = v[r][j] * rstd * gg[j]; }
    }
}

template <int DD> __device__ __forceinline__ float dpp_ror(float v) { return __builtin_bit_cast(float, __builtin_amdgcn_update_dpp(0, __builtin_bit_cast(int, v), 0x120 + DD, 0xf, 0xf, false)); }
template <int DD> __device__ __forceinline__ void rank_step(float v0, float v1, int e0, int& r0, int& r1) {
    const float u0 = dpp_ror<DD>(v0), u1 = dpp_ror<DD>(v1); const bool low = DD <= e0;
    r0 += (u0 > v0 || (u0 == v0 && low)) ? 1 : 0; r0 += (u1 > v0) ? 1 : 0;
    r1 += (u0 >= v1) ? 1 : 0; r1 += (u1 > v1 || (u1 == v1 && low)) ? 1 : 0;
}
__device__ __forceinline__ float row_allmax(float v) { v = fmaxf(v, dpp_ror<8>(v)); v = fmaxf(v, dpp_ror<4>(v)); v = fmaxf(v, dpp_ror<2>(v)); v = fmaxf(v, dpp_ror<1>(v)); return v; }
__device__ __forceinline__ float row_allsum(float v) { v += dpp_ror<8>(v); v += dpp_ror<4>(v); v += dpp_ror<2>(v); v += dpp_ror<1>(v); return v; }
__device__ __forceinline__ void phase_route(Frame& F, const Args& A, int layer) {
    REFRESH(F);
    const int nrows = (layer == DEPTH - 1) ? NX : NT; const int TPB = nrows / 16 / F.G;
    LAS float* wT = (LAS float*)F.lds;
    LAS int* lcnt = (LAS int*)(F.lds + LCNT_OFF); LAS int* lbase = (LAS int*)(F.lds + LBASE_OFF);
    LAS unsigned* recp = (LAS unsigned*)(F.lds + REC_OFF); LAS float* recg = (LAS float*)(F.lds + REC_OFF + 4608);
    __syncthreads();
    { const float* wr = A.in[I_MWR] + (size_t)layer * D * NE;
      for (int idx = F.tid; idx < D * NE; idx += NTHREADS) wT[(idx & 31) * 1024 + (idx >> 5)] = wr[idx]; }
    if (F.tid < NE) lcnt[F.tid] = 0;
    __syncthreads();
    const bf16_t* H = WSP(bf16_t, WS_H); unsigned char* FX = WSP(unsigned char, WS_FX); const float* MOD = WSP(float, WS_MOD);
    const float* g2 = A.in[I_NORMG] + (size_t)(layer * 2 + 1) * D; const float* br = A.in[I_MBR] + layer * NE;
    const int l = F.lane, r16 = l & 15, q4 = l >> 4; const float b0 = br[r16], b1 = br[16 + r16];
    for (int k = F.wave; k < TPB; k += NWAVES) {
        const int row0 = (F.c * TPB + k) * 16, row = row0 + r16; const int brow = row0 < NX ? (row0 >> 11) : 32;
        const float* mp = MOD + ((size_t)layer * 33 + brow) * 6144 + 3 * D;
        const bf16_t* hp = H + (size_t)row * D + 8 * q4; float ss = 0.f;
#pragma unroll 8
        for (int j = 0; j < 32; ++j) { const u32x4 w = *(const u32x4*)(hp + 32 * j); const float a0 = bflo(w.x), a1 = bfhi(w.x), a2 = bflo(w.y), a3 = bfhi(w.y), a4 = bflo(w.z), a5 = bfhi(w.z), a6 = bflo(w.w), a7 = bfhi(w.w);
            ss += ((a0 * a0 + a1 * a1) + (a2 * a2 + a3 * a3)) + ((a4 * a4 + a5 * a5) + (a6 * a6 + a7 * a7)); }
        ss += __shfl_xor(ss, 16); ss += __shfl_xor(ss, 32);
        const float rstd = 1.0f / sqrtf(ss * (1.0f / D) + 1e-5f);
        f32x4 acc0 = (f32x4){0.f, 0.f, 0.f, 0.f}, acc1 = acc0;
        const float* gp = g2 + 8 * q4; const float* shp = mp + 8 * q4; const float* scp = mp + D + 8 * q4; unsigned char* fxp = FX + (size_t)row * D + 8 * q4;
        const LAS float* w0p = wT + r16 * 1024 + 8 * q4; const LAS float* w1p = wT + (16 + r16) * 1024 + 8 * q4;
#pragma unroll 2
        for (int j = 0; j < 32; ++j) { const u32x4 w = *(const u32x4*)(hp + 32 * j);
            const f32x4 ga = *(const f32x4*)(gp + 32 * j), gb = *(const f32x4*)(gp + 32 * j + 4), sa = *(const f32x4*)(shp + 32 * j), sb = *(const f32x4*)(shp + 32 * j + 4), ca = *(const f32x4*)(scp + 32 * j), cb = *(const f32x4*)(scp + 32 * j + 4);
            const f32x4 fa = (f32x4){bflo(w.x), bfhi(w.x), bflo(w.y), bfhi(w.y)} * rstd * ga * (ca + 1.0f) + sa, fb = (f32x4){bflo(w.z), bfhi(w.z), bflo(w.w), bfhi(w.w)} * rstd * gb * (cb + 1.0f) + sb;
            *(u32x2*)(fxp + 32 * j) = (u32x2){pk4_fp8(fa.x, fa.y, fa.z, fa.w), pk4_fp8(fb.x, fb.y, fb.z, fb.w)};
            const f32x4 w0a = *(const LAS f32x4*)(w0p + 32 * j), w0b = *(const LAS f32x4*)(w0p + 32 * j + 4), w1a = *(const LAS f32x4*)(w1p + 32 * j), w1b = *(const LAS f32x4*)(w1p + 32 * j + 4);
#pragma unroll
            for (int s4 = 0; s4 < 4; ++s4) { acc0 = __builtin_amdgcn_mfma_f32_16x16x4f32(fa[s4], w0a[s4], acc0, 0, 0, 0); acc1 = __builtin_amdgcn_mfma_f32_16x16x4f32(fa[s4], w1a[s4], acc1, 0, 0, 0); }
#pragma unroll
            for (int s4 = 0; s4 < 4; ++s4) { acc0 = __builtin_amdgcn_mfma_f32_16x16x4f32(fb[s4], w0b[s4], acc0, 0, 0, 0); acc1 = __builtin_amdgcn_mfma_f32_16x16x4f32(fb[s4], w1b[s4], acc1, 0, 0, 0); } }
#pragma unroll
        for (int reg = 0; reg < 4; ++reg) {
            const float v0 = acc0[reg] + b0, v1 = acc1[reg] + b1; int r0 = (v1 > v0) ? 1 : 0, r1 = (v0 >= v1) ? 1 : 0;
            rank_step<1>(v0, v1, r16, r0, r1); rank_step<2>(v0, v1, r16, r0, r1); rank_step<3>(v0, v1, r16, r0, r1); rank_step<4>(v0, v1, r16, r0, r1); rank_step<5>(v0, v1, r16, r0, r1);
            rank_step<6>(v0, v1, r16, r0, r1); rank_step<7>(v0, v1, r16, r0, r1); rank_step<8>(v0, v1, r16, r0, r1); rank_step<9>(v0, v1, r16, r0, r1); rank_step<10>(v0, v1, r16, r0, r1);
            rank_step<11>(v0, v1, r16, r0, r1); rank_step<12>(v0, v1, r16, r0, r1); rank_step<13>(v0, v1, r16, r0, r1); rank_step<14>(v0, v1, r16, r0, r1); rank_step<15>(v0, v1, r16, r0, r1);
            const float mx = row_allmax(fmaxf(v0, v1));
            const float x0 = r0 < 4 ? __expf(v0 - mx) : 0.f, x1 = r1 < 4 ? __expf(v1 - mx) : 0.f;
            const float inv = 1.0f / row_allsum(x0 + x1);
            const int lr = k * 16 + 4 * q4 + reg;
            if (r0 < 4) { const int rk = __hip_atomic_fetch_add(lcnt + r16, 1, __ATOMIC_RELAXED, __HIP_MEMORY_SCOPE_WORKGROUP); recp[lr * 4 + r0] = ((unsigned)r16 << 20) | (unsigned)rk; recg[lr * 4 + r0] = x0 * inv; }
            if (r1 < 4) { const int rk = __hip_atomic_fetch_add(lcnt + 16 + r16, 1, __ATOMIC_RELAXED, __HIP_MEMORY_SCOPE_WORKGROUP); recp[lr * 4 + r1] = ((unsigned)(16 + r16) << 20) | (unsigned)rk; recg[lr * 4 + r1] = x1 * inv; }
        }
    }
    __syncthreads();
    if (F.tid < NE) lbase[F.tid] = (int)__hip_atomic_fetch_add(F.ctl + CW_GCNT + layer * 64 + F.tid, (unsigned)lcnt[F.tid], __ATOMIC_RELAXED, __HIP_MEMORY_SCOPE_AGENT);
    __syncthreads();
    int* LIST = WSP(int, WS_LIST); int* POS = WSP(int, WS_POS); float* GATE = WSP(float, WS_GATE);
    for (int r = F.tid; r < TPB * 16 * 4; r += NTHREADS) { const int lr = r >> 2, kk = r & 3; const int row = F.c * TPB * 16 + lr;
        const unsigned qx = recp[r]; const float qg = recg[r]; const int e = qx >> 20, slot = lbase[e] + (int)(qx & 0xfffff);
        LIST[(size_t)e * NT + slot] = row; POS[(size_t)row * 4 + kk] = (e << 20) | slot; GATE[(size_t)row * 4 + kk] = qg; }
    __syncthreads();
}

__device__ __forceinline__ void phase_pooldiff(Frame& F) {
    REFRESH(F);
    const bf16_t* AX = WSP(bf16_t, WS_AX); bf16_t* PD = WSP(bf16_t, WS_PD);
    for (int it = 0;; ++it) { if (ROWOF(it, 0) >= NT) break;
        const int row0 = ROWOF(it, 0); int sb, t, n; seq_of(row0, sb, t, n);
#pragma unroll
        for (int j = 0; j < 4; ++j) { const int half = 1 << j; const int col = 256 * j + 4 * F.lane;
            f32x4 s0 = (f32x4){0.f, 0.f, 0.f, 0.f}, s1 = s0, me0 = s0, me1 = s0;
#pragma unroll
            for (int q = 0; q < 2 * half + 1; ++q) { const int uu = t - half + q;
                if (uu >= 0 && uu < n) { const f32x4 x = ld_bf4(AX + (size_t)(sb + uu) * D + col); if (q < 2 * half) s0 += x; if (q > 0) s1 += x; if (q == half) me0 = x; if (q == half + 1) me1 = x; } }
            const int lo0 = t - half < 0 ? 0 : t - half, hi0 = t + half > n ? n : t + half, lo1 = t + 1 - half < 0 ? 0 : t + 1 - half, hi1 = t + 1 + half > n ? n : t + 1 + half;
            st_bf4(PD + (size_t)row0 * D + col, s0 * (1.0f / (float)(hi0 - lo0)) - me0);
            st_bf4(PD + (size_t)(row0 + 1) * D + col, s1 * (1.0f / (float)(hi1 - lo1)) - me1); }
    }
}
__device__ __forceinline__ void phase_rwkv_mix(Frame& F, const Args& A) {
    REFRESH(F);
    const bf16_t* AX = WSP(bf16_t, WS_AX); bf16_t* A6 = WSP(bf16_t, WS_A6); const float* mix = A.in[I_RMIX];
    for (int it = 0;; ++it) { if (ROWOF(it, 0) >= NT) break;
        const int row0 = ROWOF(it, 0); int sb, t, n; seq_of(row0, sb, t, n);
#pragma unroll
        for (int j = 0; j < 4; ++j) { const int col = 256 * j + 4 * F.lane; const f32x4 z = (f32x4){0.f, 0.f, 0.f, 0.f};
            const f32x4 h0 = ld_bf4(AX + (size_t)row0 * D + col), h1 = ld_bf4(AX + (size_t)(row0 + 1) * D + col);
            const f32x4 hp = t > 0 ? ld_bf4(AX + (size_t)(row0 - 1) * D + col) : z, hn = t + 1 < n - 1 ? ld_bf4(AX + (size_t)(row0 + 2) * D + col) : z;
            const f32x4 xx0 = (hp + h1) * 0.5f - h0, xx1 = (h0 + hn) * 0.5f - h1;
#pragma unroll
            for (int i = 0; i < 6; ++i) { const f32x4 m = *(const f32x4*)(mix + i * D + col); const f32x4 o0 = h0 + xx0 * m, o1 = h1 + xx1 * m;
                if (i == 0 || i == 2 || i == 3) { unsigned char* p8 = (unsigned char*)(A6 + (size_t)i * NT * D);
                    *(unsigned*)(p8 + (size_t)row0 * D + col) = pk4_fp8(o0.x, o0.y, o0.z, o0.w); *(unsigned*)(p8 + (size_t)(row0 + 1) * D + col) = pk4_fp8(o1.x, o1.y, o1.z, o1.w); }
                else { st_bf4(A6 + ((size_t)i * NT + row0) * D + col, o0); st_bf4(A6 + ((size_t)i * NT + row0 + 1) * D + col, o1); } } }
    }
}
__device__ __forceinline__ float rl(float x, int k) { return __builtin_bit_cast(float, __builtin_amdgcn_readlane(__builtin_bit_cast(int, x), k)); }
typedef float f32x16 __attribute__((ext_vector_type(16)));
constexpr int SCW = 33792;
__device__ __forceinline__ int kpos(int k) { return (k & ~12) | ((k & 4) << 1) | ((k & 8) >> 1); }
__device__ __forceinline__ bf16x8 acc_frag(const f32x16& X, int s2) {
    u32x4 w; w.x = cvt_pk_bf16(X[8 * s2 + 0], X[8 * s2 + 1]); w.y = cvt_pk_bf16(X[8 * s2 + 2], X[8 * s2 + 3]); w.z = cvt_pk_bf16(X[8 * s2 + 4], X[8 * s2 + 5]); w.w = cvt_pk_bf16(X[8 * s2 + 6], X[8 * s2 + 7]);
    return __builtin_bit_cast(bf16x8, w);
}
#define MFMA32(a, b, c) __builtin_amdgcn_mfma_f32_32x32x16_bf16(a, b, c, 0, 0, 0)
__device__ __forceinline__ void phase_rwkv_scan(Frame& F, const Args& A) {
    REFRESH(F);
    volatile LAS int* psync = (volatile LAS int*)(F.lds + MISC_OFF + 128);
    if (F.tid < 8) psync[F.tid] = 0;
    __syncthreads();
    int pphase = 0;
#define PAIR_SYNC() do { asm volatile("s_waitcnt lgkmcnt(0)" ::: "memory"); ++pphase; psync[pr * 2 + hw] = pphase; \
        for (unsigned sp_ = 0; psync[pr * 2 + (hw ^ 1)] < pphase && sp_ < (1u << 24); ++sp_) __builtin_amdgcn_s_sleep(1); asm volatile("" ::: "memory"); } while (0)
    const int pr = F.wave >> 1, hw = F.wave & 1;
    for (int item = pr * F.G + F.c; item < 1024; item += 4 * F.G) {
        const int dir = item >> 9, b = (item >> 4) & 31, hd = item & 15, col = 64 * hd + F.lane;
        const int l = F.lane, r32 = l & 31, hh = l >> 5;
        const bf16_t* Rr = WSP(bf16_t, WS_RKV); const bf16_t* Kk = Rr + (size_t)NT * D; const bf16_t* Vv = Kk + (size_t)NT * D;
        const bf16_t* Ee = WSP(bf16_t, WS_E) + (size_t)dir * NT * D; const bf16_t* Aa = WSP(bf16_t, WS_A) + (size_t)dir * NT * D;
        bf16_t* Yo = WSP(bf16_t, WS_YS) + (size_t)dir * NT * D; float* Bo = WSP(float, WS_BONUS) + (size_t)dir * NT * 16;
        const float kkw = A.in[I_RKK][col], kaw = A.in[I_RKA][col], rkw = A.in[I_RRK][col];
        LAS unsigned char* RA = F.lds + pr * SCW; LAS unsigned char* RB = RA + 16384; LAS unsigned char* RV = RA + 25600;
        LAS float* cCb = (LAS float*)(F.lds + REC_OFF + pr * 256);
        LAS bf16_t* XT = (LAS bf16_t*)RA;
        LAS bf16_t* BK = (LAS bf16_t*)(RA + 8192);
        const int kp = kpos(l), vb = hw;
        f32x16 ST[2];
#pragma unroll
        for (int i = 0; i < 2; ++i)
#pragma unroll
            for (int q = 0; q < 16; ++q) ST[i][q] = 0.f;
        for (int seg = 0; seg < 2; ++seg) {
            const int base = seg ? b * T : NX + b * L, n = seg ? T : L; const int dt = dir ? -1 : 1; const int t0 = dir ? n - 1 : 0;
            for (int bt = 0; bt < n; bt += 32) {
                float cprev = 1.0f;
                if (hw) {
                    bf16_t e16[16];
#pragma unroll
                    for (int s = 0; s < 16; ++s) e16[s] = Ee[(size_t)(base + t0 + dt * (bt + s)) * D + col];
                    float es = 0.f;
#pragma unroll
                    for (int s = 0; s < 16; ++s) es += bf1(e16[s]);
                    cprev = __expf(-es); }
#pragma unroll
                for (int g4i = 0; g4i < 4; ++g4i) { const int g8 = 4 * hw + g4i;
                    bf16_t raw[4][5];
#pragma unroll
                    for (int s8 = 0; s8 < 4; ++s8) { const size_t o = (size_t)(base + t0 + dt * (bt + g8 * 4 + s8)) * D + col; raw[s8][0] = Rr[o]; raw[s8][1] = Kk[o]; raw[s8][2] = Vv[o]; raw[s8][3] = Aa[o]; raw[s8][4] = Ee[o]; }
                    float rr[4], kraw[4], aa[4], kk[4], kd[4], n2[4], bn[4], ww[4]; unsigned bq2[2] = {0u, 0u}, kq2[2] = {0u, 0u};
#pragma unroll
                    for (int s8 = 0; s8 < 4; ++s8) { rr[s8] = bf1(raw[s8][0]); kraw[s8] = bf1(raw[s8][1]); aa[s8] = bf1(raw[s8][3]); ww[s8] = __expf(-bf1(raw[s8][4]));
                        kk[s8] = kraw[s8] * kkw; n2[s8] = kk[s8] * kk[s8]; kd[s8] = kraw[s8] * (1.0f + (aa[s8] - 1.0f) * kaw); bn[s8] = rr[s8] * kd[s8] * rkw; }
#pragma unroll
                    for (int s8 = 0; s8 < 4; ++s8) { n2[s8] = wave_sum(n2[s8]); bn[s8] = wave_sum(bn[s8]); }
#pragma unroll
                    for (int s8 = 0; s8 < 4; ++s8) { const int t = g8 * 4 + s8;
                        if (l == 0) Bo[(size_t)(base + t0 + dt * (bt + t)) * 16 + hd] = bn[s8];
                        const float kn = kk[s8] * __builtin_amdgcn_rsqf(fmaxf(n2[s8], 1e-24f)); const float c = cprev * ww[s8]; const float ic = __builtin_amdgcn_rcpf(c);
                        const float at = -kn * cprev, rt = rr[s8] * c, bq = kn * aa[s8] * ic, kq = kd[s8] * ic;
                        const unsigned w0 = cvt_pk_bf16(at, rt), w1 = cvt_pk_bf16(bq, kq);
                        XT[t * 64 + kp] = (bf16_t)(w0 & 0xffffu); XT[(32 + t) * 64 + kp] = (bf16_t)(w0 >> 16);
                        BK[t * 64 + kp] = (bf16_t)(w1 & 0xffffu); BK[(32 + t) * 64 + kp] = (bf16_t)(w1 >> 16);
                        if (s8 & 1) { bq2[s8 >> 1] |= (w1 & 0xffffu) << 16; kq2[s8 >> 1] |= (w1 & 0xffff0000u); } else { bq2[s8 >> 1] = w1 & 0xffffu; kq2[s8 >> 1] = w1 >> 16; }
                        cprev = c; }
                    const int gp = (g8 & ~3) | ((g8 & 1) << 1) | ((g8 & 2) >> 1);
                    *(LAS u32x2*)(RB + l * 144 + gp * 8) = (u32x2){bq2[0], bq2[1]}; *(LAS u32x2*)(RB + l * 144 + 64 + gp * 8) = (u32x2){kq2[0], kq2[1]};
                    *(LAS u32x2*)(RV + l * 80 + gp * 8) = (u32x2){(unsigned)raw[0][2] | ((unsigned)raw[1][2] << 16), (unsigned)raw[2][2] | ((unsigned)raw[3][2] << 16)};
                }
                if (hw) cCb[l] = cprev;
                PAIR_SYNC();
                unsigned pf0 = 0u, pf1 = 0u;
                if (bt + 32 < n) { const size_t po = (size_t)(base + t0 + dt * (bt + 32 + 16 * hw + (l & 15))) * D + 64 * hd; const int ps = l >> 4;
                    const bf16_t* sp = ps == 0 ? Rr : ps == 1 ? Kk : ps == 2 ? Vv : Aa;
                    pf0 = *(const unsigned*)(sp + po); if (l < 16) pf1 = *(const unsigned*)(Ee + po); }
                f32x16 Mp, Np, X;
                { bf16x8 XTf[4], BKf[2][4];
#pragma unroll
                  for (int s4 = 0; s4 < 4; ++s4) { XTf[s4] = *(const LAS bf16x8*)(XT + r32 * 64 + 16 * s4 + 8 * hh); BKf[0][s4] = *(const LAS bf16x8*)(BK + r32 * 64 + 16 * s4 + 8 * hh); BKf[1][s4] = *(const LAS bf16x8*)(BK + (32 + r32) * 64 + 16 * s4 + 8 * hh); }
                  bf16x8 MkaF[2];
                  { f32x16 Tm;
#pragma unroll
                    for (int q = 0; q < 16; ++q) Tm[q] = 0.f;
#pragma unroll
                    for (int s4 = 0; s4 < 4; ++s4) Tm = MFMA32(BKf[1][s4], XTf[s4], Tm);
#pragma unroll
                    for (int q = 0; q < 16; ++q) { const int row = (q & 3) + 8 * (q >> 2) + 4 * hh; Tm[q] = row < r32 ? Tm[q] : 0.f; }
                    MkaF[0] = acc_frag(Tm, 0); MkaF[1] = acc_frag(Tm, 1); }
#pragma unroll
                  for (int q = 0; q < 16; ++q) { Mp[q] = 0.f; Np[q] = 0.f; X[q] = 0.f; }
#pragma unroll
                  for (int s4 = 0; s4 < 4; ++s4) { Mp = MFMA32(BKf[0][s4], XTf[s4], Mp); Np = MFMA32(XTf[s4], BKf[0][s4], Np); }
#pragma unroll
                  for (int q = 0; q < 16; ++q) { const int row = (q & 3) + 8 * (q >> 2) + 4 * hh; Mp[q] = row < r32 ? Mp[q] : 0.f; Np[q] = r32 < row ? Np[q] : 0.f; }
#pragma unroll
                  for (int kb = 0; kb < 2; ++kb)
#pragma unroll
                      for (int s2 = 0; s2 < 2; ++s2) X = MFMA32(XTf[2 * kb + s2], acc_frag(ST[kb], s2), X);
#pragma unroll
                  for (int s2 = 0; s2 < 2; ++s2) { const bf16x8 Vf = *(const LAS bf16x8*)(RV + (32 * vb + r32) * 80 + (16 * s2 + 8 * hh) * 2); X = MFMA32(MkaF[s2], Vf, X); } }
                __builtin_amdgcn_sched_barrier(0);
#pragma unroll
                for (int lvl = 0; lvl < 5; ++lvl) {
                    bf16x8 Ma[2], Na[2];
#pragma unroll
                    for (int s2 = 0; s2 < 2; ++s2) { Ma[s2] = acc_frag(Mp, s2); Na[s2] = acc_frag(Np, s2); }
                    { const bf16x8 x0 = acc_frag(X, 0), x1 = acc_frag(X, 1); X = MFMA32(Ma[0], x0, X); X = MFMA32(Ma[1], x1, X); }
                    if (lvl < 4) { f32x16 M2, N2;
#pragma unroll
                        for (int q = 0; q < 16; ++q) { M2[q] = 0.f; N2[q] = 0.f; }
                        M2 = MFMA32(Na[0], Ma[0], M2); M2 = MFMA32(Na[1], Ma[1], M2);
                        N2 = MFMA32(Ma[0], Na[0], N2); N2 = MFMA32(Ma[1], Na[1], N2);
                        Mp = M2; Np = N2; }
                }
                __builtin_amdgcn_sched_barrier(0);
                { bf16x8 XRf[4], MbrF[2], MkrF[2];
#pragma unroll
                  for (int s4 = 0; s4 < 4; ++s4) XRf[s4] = *(const LAS bf16x8*)(XT + (32 + r32) * 64 + 16 * s4 + 8 * hh);
                  { f32x16 Tm, Tn;
#pragma unroll
                    for (int q = 0; q < 16; ++q) { Tm[q] = 0.f; Tn[q] = 0.f; }
#pragma unroll
                    for (int s4 = 0; s4 < 4; ++s4) { const bf16x8 Bb = *(const LAS bf16x8*)(BK + r32 * 64 + 16 * s4 + 8 * hh), Bk = *(const LAS bf16x8*)(BK + (32 + r32) * 64 + 16 * s4 + 8 * hh);
                        Tm = MFMA32(Bb, XRf[s4], Tm); Tn = MFMA32(Bk, XRf[s4], Tn); }
#pragma unroll
                    for (int q = 0; q < 16; ++q) { const int row = (q & 3) + 8 * (q >> 2) + 4 * hh; Tm[q] = row <= r32 ? Tm[q] : 0.f; Tn[q] = row <= r32 ? Tn[q] : 0.f; }
                    MbrF[0] = acc_frag(Tm, 0); MbrF[1] = acc_frag(Tm, 1); MkrF[0] = acc_frag(Tn, 0); MkrF[1] = acc_frag(Tn, 1); }
                  { const bf16x8 u0 = acc_frag(X, 0), u1 = acc_frag(X, 1);
                    const bf16x8 Vf0 = *(const LAS bf16x8*)(RV + (32 * vb + r32) * 80 + (8 * hh) * 2), Vf1 = *(const LAS bf16x8*)(RV + (32 * vb + r32) * 80 + (16 + 8 * hh) * 2);
                    f32x16 Yt;
#pragma unroll
                    for (int q = 0; q < 16; ++q) Yt[q] = 0.f;
#pragma unroll
                    for (int kb = 0; kb < 2; ++kb)
#pragma unroll
                        for (int s2 = 0; s2 < 2; ++s2) Yt = MFMA32(XRf[2 * kb + s2], acc_frag(ST[kb], s2), Yt);
                    Yt = MFMA32(MkrF[0], Vf0, Yt); Yt = MFMA32(MkrF[1], Vf1, Yt);
                    Yt = MFMA32(MbrF[0], u0, Yt); Yt = MFMA32(MbrF[1], u1, Yt);
#pragma unroll
                    for (int q = 0; q < 16; ++q) { const int t = (q & 3) + 8 * (q >> 2) + 4 * hh; Yo[(size_t)(base + t0 + dt * (bt + t)) * D + 64 * hd + 32 * vb + r32] = (bf16_t)f2bf(Yt[q]); }
#pragma unroll
                    for (int kb = 0; kb < 2; ++kb) {
                        const bf16x8 b0 = *(const LAS bf16x8*)(RB + (32 * kb + r32) * 144 + (8 * hh) * 2), b1 = *(const LAS bf16x8*)(RB + (32 * kb + r32) * 144 + (16 + 8 * hh) * 2);
                        const bf16x8 k0 = *(const LAS bf16x8*)(RB + (32 * kb + r32) * 144 + 64 + (8 * hh) * 2), k1 = *(const LAS bf16x8*)(RB + (32 * kb + r32) * 144 + 64 + (16 + 8 * hh) * 2);
                        ST[kb] = MFMA32(b0, u0, ST[kb]); ST[kb] = MFMA32(b1, u1, ST[kb]);
                        ST[kb] = MFMA32(k0, Vf0, ST[kb]); ST[kb] = MFMA32(k1, Vf1, ST[kb]); }
                  } }
                __builtin_amdgcn_sched_barrier(0);
#pragma unroll
                for (int kb = 0; kb < 2; ++kb)
#pragma unroll
                    for (int g4 = 0; g4 < 4; ++g4) { const f32x4 cc = *(const LAS f32x4*)(cCb + 32 * kb + 8 * g4 + 4 * hh);
                        ST[kb][4 * g4 + 0] *= cc.x; ST[kb][4 * g4 + 1] *= cc.y; ST[kb][4 * g4 + 2] *= cc.z; ST[kb][4 * g4 + 3] *= cc.w; }
                asm volatile("" :: "v"(pf0), "v"(pf1));
                PAIR_SYNC();
            }
        }
    }
    __syncthreads();
}
#undef PAIR_SYNC
#undef MFMA32
__device__ __forceinline__ void phase_rwkv_out(Frame& F, const Args& A, int nrows) {
    REFRESH(F);
    const bf16_t* Y0 = WSP(bf16_t, WS_YS); const bf16_t* Y1 = Y0 + (size_t)NT * D; const float* B0 = WSP(float, WS_BONUS); const float* B1 = B0 + (size_t)NT * 16;
    const bf16_t* Vv = WSP(bf16_t, WS_RKV) + (size_t)2 * NT * D; const bf16_t* Gg = WSP(bf16_t, WS_G); bf16_t* RO = WSP(bf16_t, WS_RO);
    const float* lnw = A.in[I_RLNW]; const float* lnb = A.in[I_RLNB];
    for (int it = 0;; ++it) { if (ROWOF(it, 0) >= nrows) break;
        f32x4 y[RB][4], vv[RB][4], gg[RB][4]; float bon[RB][4];
#pragma unroll
        for (int r = 0; r < RB; ++r) { const int row = ROWOF(it, r);
#pragma unroll
            for (int j = 0; j < 4; ++j) { const int col = 256 * j + 4 * F.lane, head = 4 * j + (F.lane >> 4); const size_t o = (size_t)row * D + col;
                y[r][j] = ld_bf4(Y0 + o) + ld_bf4(Y1 + o); vv[r][j] = ld_bf4(Vv + o); gg[r][j] = ld_bf4(Gg + o); bon[r][j] = B0[(size_t)row * 16 + head] + B1[(size_t)row * 16 + head]; } }
#pragma unroll
        for (int r = 0; r < RB; ++r) { const int row = ROWOF(it, r);
#pragma unroll
            for (int j = 0; j < 4; ++j) { const int col = 256 * j + 4 * F.lane; const size_t o = (size_t)row * D + col; const f32x4 yy = y[r][j];
                const float s = row16_sum((yy.x + yy.y) + (yy.z + yy.w));
                const f32x4 d = yy - s * (1.0f / 64.0f);
                const float q = row16_sum((d.x * d.x + d.y * d.y) + (d.z * d.z + d.w * d.w));
                const float rs = 1.0f / sqrtf(q * (1.0f / 64.0f) + 64e-5f);
                const f32x4 yn = d * rs * *(const f32x4*)(lnw + col) + *(const f32x4*)(lnb + col);
                { const f32x4 ov = (yn + vv[r][j] * bon[r][j]) * gg[r][j]; *(unsigned*)((unsigned char*)RO + o) = pk4_fp8(ov.x, ov.y, ov.z, ov.w); } } }
    }
}

__device__ __forceinline__ void phase_attn(Frame& F, const Args& A, int j, bool need_ctx) {
    REFRESH(F);
    const bf16_t* Q = WSP(bf16_t, WS_Q); const bf16_t* Kb = WSP(bf16_t, WS_K); const bf16_t* VT = WSP(bf16_t, WS_VT); bf16_t* O = WSP(bf16_t, WS_O);
    const float* sinks = A.in[I_ASINK] + j * 16;
    LAS bf16_t* Ks = (LAS bf16_t*)F.lds; LAS bf16_t* Vs = (LAS bf16_t*)(F.lds + 9216);
    LAS bf16x8* Qs = (LAS bf16x8*)(F.lds + 18432 + F.wave * 8192) + F.lane;
    const int nunits = 2048 + (need_ctx ? 256 : 0);
    const int fr = F.lane & 15, fq = F.lane >> 4, g = F.wave >> 1, hf = F.wave & 1;
    const float SC = 0.125f * 1.4426950408889634f;
    const int lr = F.tid >> 3, lch = F.tid & 7;
    __syncthreads();
    for (int u = F.c; u < nunits; u += F.G) {
        int b, kvh, qb; bool isx;
        if (u < 2048) { isx = true; b = u >> 6; kvh = (u >> 4) & 3; qb = u & 15; } else { const int v = u - 2048; isx = false; b = v >> 3; kvh = (v >> 1) & 3; qb = v & 1; }
        const int qrow0 = (isx ? b * T : NX + b * L) + qb * 128 + hf * 64; const int head = 4 * kvh + g;
        int jlo = 0, jhi = -1;
        if (isx) { jlo = qb == 0 ? 2 : 0; jhi = qb == 15 ? 3 : 5; }
        const int ntiles = 4 + (jhi - jlo + 1);
        auto tile_row0 = [&](int ti) -> int { return ti < 4 ? NX + b * L + ti * 64 : b * T + qb * 128 - 128 + 64 * (jlo + ti - 4); };
        u32x4 kv_n, vv_n;
        { const int kr0 = tile_row0(0); kv_n = *(const u32x4*)(Kb + (size_t)(kr0 + lr) * 256 + kvh * 64 + lch * 8); vv_n = *(const u32x4*)(VT + (size_t)(kvh * 64 + lr) * NT + kr0 + lch * 8); }
#pragma unroll
        for (int mq = 0; mq < 4; ++mq)
#pragma unroll
            for (int ks = 0; ks < 2; ++ks) Qs[64 * (mq * 2 + ks)] = *(const bf16x8*)(Q + (size_t)(qrow0 + 16 * mq + fr) * D + head * 64 + ks * 32 + 8 * fq);
        const float sink2 = sinks[head] * 1.4426950408889634f;
        float mrun[4], lrun[4]; f32x4 Oa[4][4];
#pragma unroll
        for (int mq = 0; mq < 4; ++mq) { mrun[mq] = sink2; lrun[mq] = fq == 0 ? 1.0f : 0.0f;
#pragma unroll
            for (int db = 0; db < 4; ++db) Oa[mq][db] = (f32x4){0.f, 0.f, 0.f, 0.f}; }
        for (int ti = 0; ti < ntiles; ++ti) {
            const int jl = ti < 4 ? -1 : jlo + ti - 4; const int ks0 = qb * 128 - 128 + 64 * jl;
            __syncthreads();
            *(LAS u32x4*)(Ks + lr * 72 + lch * 8) = kv_n; *(LAS u32x4*)(Vs + lr * 72 + lch * 8) = vv_n;
            __syncthreads();
            if (ti + 1 < ntiles) { const int kr0 = tile_row0(ti + 1); kv_n = *(const u32x4*)(Kb + (size_t)(kr0 + lr) * 256 + kvh * 64 + lch * 8); vv_n = *(const u32x4*)(VT + (size_t)(kvh * 64 + lr) * NT + kr0 + lch * 8); }
            const bool need = (jl < 0) || (jl >= hf && jl <= hf + 4);
            if (need) {
                const bool domask = (jl >= 0) && (jl == hf || jl == hf + 4);
                f32x4 Sa[4][4];
#pragma unroll
                for (int mq = 0; mq < 4; ++mq)
#pragma unroll
                    for (int n = 0; n < 4; ++n) Sa[mq][n] = (f32x4){0.f, 0.f, 0.f, 0.f};
#pragma unroll
                for (int ks = 0; ks < 2; ++ks) {
                    bf16x8 Qf[4];
#pragma unroll
                    for (int mq = 0; mq < 4; ++mq) Qf[mq] = Qs[64 * (mq * 2 + ks)];
#pragma unroll
                    for (int n = 0; n < 4; ++n) { const int kr = 32 * (n >> 1) + 8 * (fr >> 2) + 4 * (n & 1) + (fr & 3);
                        const bf16x8 Kf = *(const LAS bf16x8*)(Ks + kr * 72 + ks * 32 + 8 * fq);
#pragma unroll
                        for (int mq = 0; mq < 4; ++mq) Sa[mq][n] = __builtin_amdgcn_mfma_f32_16x16x32_bf16(Kf, Qf[mq], Sa[mq][n], 0, 0, 0); } }
                bf16x8 Pf[4][2];
#pragma unroll
                for (int mq = 0; mq < 4; ++mq) {
                    float mx = -1e30f;
                    if (domask) { const int tq = qb * 128 + hf * 64 + 16 * mq + fr;
#pragma unroll
                        for (int n = 0; n < 4; ++n)
#pragma unroll
                            for (int i = 0; i < 4; ++i) { float sv = Sa[mq][n][i]; const int rel = ks0 + 32 * (n >> 1) + 8 * fq + 4 * (n & 1) + i - tq; if (rel > 128 || rel < -128) sv = -1e30f; Sa[mq][n][i] = sv; mx = fmaxf(mx, sv); } }
                    else {
#pragma unroll
                        for (int n = 0; n < 4; ++n)
#pragma unroll
                            for (int i = 0; i < 4; ++i) mx = fmaxf(mx, Sa[mq][n][i]); }
                    mx = fmaxf(mx, __shfl_xor(mx, 16)); mx = fmaxf(mx, __shfl_xor(mx, 32));
                    const float mnew = fmaxf(mrun[mq], mx * SC); const float alpha = __builtin_amdgcn_exp2f(mrun[mq] - mnew); mrun[mq] = mnew;
                    float rs = 0.f; const float nm = -mnew;
#pragma unroll
                    for (int n = 0; n < 4; ++n) { const f32x4 tt = Sa[mq][n] * SC + nm;
#pragma unroll
                        for (int i = 0; i < 4; ++i) { const float p = __builtin_amdgcn_exp2f(tt[i]); Sa[mq][n][i] = p; rs += p; } }
                    lrun[mq] = lrun[mq] * alpha + rs;
#pragma unroll
                    for (int db = 0; db < 4; ++db) Oa[mq][db] *= alpha;
#pragma unroll
                    for (int s2 = 0; s2 < 2; ++s2) { u32x4 w; w.x = cvt_pk_bf16(Sa[mq][2 * s2][0], Sa[mq][2 * s2][1]); w.y = cvt_pk_bf16(Sa[mq][2 * s2][2], Sa[mq][2 * s2][3]);
                        w.z = cvt_pk_bf16(Sa[mq][2 * s2 + 1][0], Sa[mq][2 * s2 + 1][1]); w.w = cvt_pk_bf16(Sa[mq][2 * s2 + 1][2], Sa[mq][2 * s2 + 1][3]); Pf[mq][s2] = __builtin_bit_cast(bf16x8, w); }
                }
#pragma unroll
                for (int db = 0; db < 4; ++db)
#pragma unroll
                    for (int s2 = 0; s2 < 2; ++s2) { const bf16x8 Vf = *(const LAS bf16x8*)(Vs + (16 * db + fr) * 72 + 32 * s2 + 8 * fq);
#pragma unroll
                        for (int mq = 0; mq < 4; ++mq) Oa[mq][db] = __builtin_amdgcn_mfma_f32_16x16x32_bf16(Vf, Pf[mq][s2], Oa[mq][db], 0, 0, 0); }
            }
        }
#pragma unroll
        for (int mq = 0; mq < 4; ++mq) { float l = lrun[mq]; l += __shfl_xor(l, 16); l += __shfl_xor(l, 32); const float inv = 1.0f / l;
            unsigned char* op = (unsigned char*)O + (size_t)(qrow0 + 16 * mq + fr) * D + head * 64 + 4 * fq;
#pragma unroll
            for (int db = 0; db < 4; ++db) { const f32x4 o = Oa[mq][db] * inv; *(unsigned*)(op + 16 * db) = pk4_fp8(o.x, o.y, o.z, o.w); } }
    }
    __syncthreads();
}

struct KState { XcdBarrier bar; int ph; };
#define RUN() (A.one || A.phase == KS.ph)
#define SEAM() do { if (A.one) xcd_barrier(KS.bar); ++KS.ph; } while (0)
template <int LAYER>
__device__ __forceinline__ void layer_body(Frame& F, const Args& A, KState& KS) {
    constexpr int layer = LAYER, kind = LAYER % 3, j = LAYER / 3; constexpr bool last = (LAYER == DEPTH - 1);
    LAS unsigned char* ring = F.lds;
    const LAS int* tpre = (const LAS int*)(F.lds + TPRE_OFF); const LAS int* lcnt = (const LAS int*)(F.lds + LCNT_OFF);
    bf16_t* H = WSP(bf16_t, WS_H); const float* MOD = WSP(float, WS_MOD); const bf16_t* AX = WSP(bf16_t, WS_AX);
    const float* gate1 = MOD + (size_t)layer * 33 * 6144 + 2 * D;
    constexpr int nMall = last ? NX / 256 : NT / 256;
    if (RUN()) phase_norm1(F, A, layer);
    SEAM();
    if constexpr (kind == 0) {
        if (RUN()) {
            { pg8::ProbDense8 P; P.A = (const unsigned char*)AX; P.Bt = WSP(unsigned char, WS_WQK) + (size_t)j * 1280 * D; P.lda = D; P.ldb = D; P.K = D; P.scale_w = SCALE_W; P.scale_x = SCALE_ONE; P.ord.init(NT / 256, 5, F.G, F.c);
              EpiQK E{WSP(bf16_t, WS_Q), WSP(bf16_t, WS_K), WSP(float, WS_BQK) + j * 1280, WSP(float, WS_ROPEC), WSP(float, WS_ROPES)};
              pg8::gemm_phase(ring, P, E); }
            { pg8::ProbDense8 P; P.A = WSP(unsigned char, WS_WV) + (size_t)j * 256 * D; P.Bt = (const unsigned char*)AX; P.lda = D; P.ldb = D; P.K = D; P.scale_w = SCALE_ONE; P.scale_x = SCALE_W; P.ord.init(1, NT / 256, F.G, (F.c + 96) % F.G);
              EpiVT E{WSP(bf16_t, WS_VT), A.in[I_ABQKV] + j * 1536 + 1280};
              pg8::gemm_phase(ring, P, E); }
        }
        SEAM();
        if (RUN()) phase_attn(F, A, j, !last);
        SEAM();
        if (RUN()) { pg8::ProbDense8 P; P.A = WSP(unsigned char, WS_O); P.Bt = WSP(unsigned char, WS_WO) + (size_t)j * D * D; P.lda = D; P.ldb = D; P.K = D; P.scale_w = SCALE_W; P.scale_x = SCALE_ONE; P.ord.init(nMall, 4, F.G, F.c);
            EpiResid E{H, A.in[I_ABO] + j * D, nullptr, gate1};
            pg8::gemm_phase(ring, P, E); }
        SEAM();
    } else if constexpr (kind == 1) {
        if (RUN()) phase_pooldiff(F);
        SEAM();
        if (RUN()) { pg8::ProbDense P; P.A = WSP(bf16_t, WS_PD); P.Bt = WSP(bf16_t, WS_POOLW); P.lda = D; P.ldb = 256; P.K = 256; P.a_pn_off = 256; P.ord.init(nMall, 4, F.G, F.c);
            EpiResid E{H, A.in[I_PB], A.in[I_PS], gate1};
            pg8::gemm_phase(ring, P, E); }
        SEAM();
    } else {
        if (RUN()) phase_rwkv_mix(F, A);
        SEAM();
        if (RUN()) {
            for (int i = 0; i < 3; ++i) { const int sel = i == 0 ? 0 : i == 1 ? 2 : 3;
                pg8::ProbDense8 P; P.A = (const unsigned char*)(WSP(bf16_t, WS_A6) + (size_t)sel * NT * D); P.Bt = WSP(unsigned char, WS_WRKV) + (size_t)i * D * D; P.lda = D; P.ldb = D; P.K = D; P.scale_w = SCALE_W; P.scale_x = SCALE_ONE; P.ord.init(NT / 256, 4, F.G, (F.c + (i == 1 ? 128 : 0)) % F.G);
                EpiBf16Act E{WSP(bf16_t, WS_RKV) + (size_t)i * NT * D, D, nullptr, 0, 1.0f};
                pg8::gemm_phase(ring, P, E); }
            for (int i = 0; i < 3; ++i) { const int sel = i == 0 ? 5 : i == 1 ? 1 : 4;
                pg8::ProbDense P; P.A = WSP(bf16_t, WS_A6) + (size_t)sel * NT * D; P.Bt = WSP(bf16_t, WS_WL1) + (size_t)i * 256 * D; P.lda = D; P.ldb = D; P.K = D; P.a_pn_off = 0; P.ord.init(NT / 256, 1, F.G, (F.c + 128 - 32 * i) % F.G);
                EpiBf16Act E{WSP(bf16_t, WS_LORA) + i * 256, 768, nullptr, i == 0 ? 1 : i == 1 ? 2 : 0, 1.0f};
                pg8::gemm_phase(ring, P, E); }
        }
        SEAM();
        if (RUN()) {
            for (int i = 0; i < 5; ++i) {
                const int ablk = i == 0 ? 0 : i < 3 ? 1 : 2, d = (i - 1) & 1;
                pg8::ProbDense P; P.A = WSP(bf16_t, WS_LORA) + ablk * 256; P.Bt = WSP(bf16_t, WS_WL2) + (size_t)i * D * 256; P.lda = 768; P.ldb = 256; { int k128 = 128; asm volatile("" : "+s"(k128)); P.K = k128; }     P.a_pn_off = 0; P.ord.init(NT / 256, 4, F.G, (F.c + 128 * (i & 1)) % F.G);
                EpiBf16Act E; E.ldc = D;
                if (i == 0) { E.O = WSP(bf16_t, WS_G); E.bias = nullptr; E.act = 0; E.scale = 1.0f; }
                else if (i < 3) { E.O = WSP(bf16_t, WS_E) + (size_t)d * NT * D; E.bias = A.in[I_RW0] + d * D; E.act = 1; E.scale = 0.6065306597126334f; }
                else { E.O = WSP(bf16_t, WS_A) + (size_t)d * NT * D; E.bias = A.in[I_RA0] + d * D; E.act = 1; E.scale = 1.0f; }
                pg8::gemm_phase(ring, P, E); }
        }
        SEAM();
        if (RUN()) phase_rwkv_scan(F, A);
        SEAM();
        if (RUN()) phase_rwkv_out(F, A, last ? NX : NT);
        SEAM();
        if (RUN()) { pg8::ProbDense8 P; P.A = WSP(unsigned char, WS_RO); P.Bt = WSP(unsigned char, WS_WOR); P.lda = D; P.ldb = D; P.K = D; P.scale_w = SCALE_W; P.scale_x = SCALE_ONE; P.ord.init(nMall, 4, F.G, F.c);
            EpiResid E{H, nullptr, nullptr, gate1};
            pg8::gemm_phase(ring, P, E); }
        SEAM();
    }
    if (RUN()) phase_route(F, A, layer);
    SEAM();
    if (RUN()) { moe_tiles(F, layer);
        ProbMoe1 P; P.FX = WSP(fp8_t, WS_FX); P.W1T = WSP(fp8_t, WS_W1T) + (size_t)layer * NE * 2048 * D; P.list = WSP(int, WS_LIST); P.tpre = tpre; P.cnt = lcnt; P.texp = (const LAS unsigned char*)(F.lds + TEXP_OFF); P.toks = (LAS int*)(F.lds + TOKS_OFF); P.scale_w = SCALE_W; P.scale_x = SCALE_ONE; P.ord.init(tpre[NE], 8, F.G, F.c);
        EpiMoe1 E{WSP(unsigned char, WS_ACT), A.in[I_MB1] + (size_t)layer * NE * 2048};
        pg8::gemm_phase(ring, P, E); }
    SEAM();
    if (RUN()) { moe_tiles(F, layer);
        ProbMoe2 P; P.ACT = WSP(fp8_t, WS_ACT); P.W2T = WSP(fp8_t, WS_W2T) + (size_t)layer * NE * D * D; P.tpre = tpre; P.texp = (const LAS unsigned char*)(F.lds + TEXP_OFF); P.scale_w = SCALE_W4; P.scale_x = SCALE_ONE; P.ord.init(tpre[NE], 4, F.G, F.c);
        EpiMoe2 E{WSP(unsigned char, WS_Y), A.in[I_MB2] + (size_t)layer * NE * D};
        pg8::gemm_phase(ring, P, E); }
    SEAM();
}
__global__ void __launch_bounds__(NTHREADS, 2) trunk_fwd(Args A) {
    extern __shared__ __attribute__((aligned(16))) unsigned char lds_[];
    Frame F; F.lds = (LAS unsigned char*)lds_; REFRESH(F); F.wave = __builtin_amdgcn_readfirstlane(F.tid >> 6);
    F.G = gridDim.x; F.c = blockIdx.x; F.ws = A.ws; F.ctl = (unsigned*)(A.ws + WS_CTL);
    for (int u = F.tid; u < (LDS_BYTES - LDSCTL_OFF) / 4; u += NTHREADS) ((LAS unsigned*)(F.lds + LDSCTL_OFF))[u] = 0u;
    __syncthreads();
    KState KS; KS.bar.bar = F.ctl + CW_BAR; KS.bar.x = 0; KS.bar.st = nullptr; KS.ph = 0;
    if (A.one) KS.bar = xcd_barrier_post(F.ctl + CW_BAR, (volatile LAS unsigned*)(F.lds + MISC_OFF) + 8);
    if (RUN()) phase_prologue(F, A);
    SEAM();
    layer_body<0>(F, A, KS);
    layer_body<1>(F, A, KS);
    layer_body<2>(F, A, KS);
    layer_body<3>(F, A, KS);
    if (RUN()) phase_final(F, A);
}
#undef RUN
#undef SEAM
static int count_phases() { int n = 1; for (int layer = 0; layer < DEPTH; ++layer) { const int kind = layer % 3; n += 1 + (kind == 0 ? 3 : kind == 1 ? 2 : 6) + 3; } return n + 1; }

extern "C" void kernel_launch(void* const* d_in, const int* in_sizes, int n_in, void* d_out, int out_size, void* d_ws, size_t ws_size, hipStream_t stream) {
    static int grid = 0;
    if (grid == 0) {
        if (n_in != 38 || out_size != NX * D || ws_size < WS_END) { fprintf(stderr, "kernel_launch: unexpected problem (n_in %d, out %d, ws %zu < %zu)\n", n_in, out_size, ws_size, (size_t)WS_END); grid = -1; return; }
        int dev = 0, cus = 0;
        if (hipGetDevice(&dev) != hipSuccess || hipDeviceGetAttribute(&cus, hipDeviceAttributeMultiprocessorCount, dev) != hipSuccess) { grid = -1; return; }
        if (hipFuncSetAttribute((const void*)trunk_fwd, hipFuncAttributeMaxDynamicSharedMemorySize, LDS_BYTES) != hipSuccess) { fprintf(stderr, "kernel_launch: hipFuncSetAttribute failed\n"); grid = -1; return; }
        int per_cu = 0;
        if (hipOccupancyMaxActiveBlocksPerMultiprocessor(&per_cu, (const void*)trunk_fwd, NTHREADS, LDS_BYTES) != hipSuccess || per_cu < 1) fprintf(stderr, "kernel_launch: occupancy query says %d\n", per_cu);
        (void)hipGetLastError();
        grid = cus;
        if (grid != 256) fprintf(stderr, "kernel_launch: %d CUs (built for 256)\n", grid);
    }
    if (grid < 0) return;
    (void)hipMemsetAsync((char*)d_ws + WS_CTL, 0, CTL_BYTES, stream);
    (void)hipMemsetAsync((char*)d_ws + WS_LZERO, 0, LZERO_BYTES, stream);
    Args a{};
    for (int i = 0; i < 38; ++i) a.in[i] = (const float*)d_in[i];
    a.out = (float*)d_out; a.ws = (unsigned char*)d_ws;
#if MK_ONE_LAUNCH
    a.phase = 0; a.one = 1;
    hipLaunchKernelGGL(trunk_fwd, dim3(grid), dim3(NTHREADS), LDS_BYTES, stream, a);
#else
    const int nph = count_phases();
    for (int p = 0; p < nph; ++p) { a.phase = p; a.one = 0; hipLaunchKernelGGL(trunk_fwd, dim3(grid), dim3(NTHREADS), LDS_BYTES, stream, a); }
#endif
}
```

```cpp
#include <hip/hip_runtime.h>
#include <cstdio>
#include <cstdint>

#ifndef MK_ONE_LAUNCH
#define MK_ONE_LAUNCH 1
#endif
#define LAS __attribute__((address_space(3)))
#define GAS __attribute__((address_space(1)))
typedef unsigned short bf16_t;
typedef short bf16x8 __attribute__((ext_vector_type(8)));
typedef float f32x4 __attribute__((ext_vector_type(4)));
typedef float f32x2 __attribute__((ext_vector_type(2)));
typedef unsigned u32x4 __attribute__((ext_vector_type(4)));
typedef unsigned u32x2 __attribute__((ext_vector_type(2)));

constexpr int D = 1024, NB = 32, T = 2048, L = 256, DEPTH = 4;
constexpr int NX = NB * T, NC = NB * L, NT = NX + NC;
constexpr int NE = 32, TOPK = 4;
constexpr int NWAVES = 8, NTHREADS = 512;
constexpr int MAXRT = NT * TOPK / 256 + NE;

constexpr size_t MiB = 1u << 20;
constexpr size_t WS_CTL = 0, CTL_BYTES = 128 * 1024;
constexpr size_t WS_MOD = 4 * MiB;
constexpr size_t WS_ROPEC = 8 * MiB, WS_ROPES = 8 * MiB + 512 * 1024;
constexpr size_t WS_BQK = 9 * MiB;
constexpr size_t WS_WQK = 10 * MiB;
constexpr size_t WS_WV = 15 * MiB;
constexpr size_t WS_WO = 16 * MiB;
constexpr size_t WS_POOLW = 20 * MiB;
constexpr size_t WS_WRKV = 21 * MiB;
constexpr size_t WS_WOR = 27 * MiB;
constexpr size_t WS_WL1 = 30 * MiB;
constexpr size_t WS_WL2 = 32 * MiB;
constexpr size_t WS_LZERO = WS_WL1, LZERO_BYTES = 6 * MiB;
constexpr size_t WS_W1T = 40 * MiB;
constexpr size_t WS_W2T = 552 * MiB;
constexpr size_t WS_H = 808 * MiB;
constexpr size_t WS_AX = 1096 * MiB;
constexpr size_t WS_FX = 1240 * MiB;
constexpr size_t WS_R = 1384 * MiB;
constexpr size_t WS_ACT = WS_R;
constexpr size_t WS_Y = WS_R + 592 * MiB;
constexpr size_t WS_LIST = WS_R + 1184 * MiB;
constexpr size_t WS_POS = WS_R + 1193 * MiB;
constexpr size_t WS_GATE = WS_R + 1195 * MiB;
constexpr size_t WS_Q = WS_R;
constexpr size_t WS_K = WS_R + 144 * MiB;
constexpr size_t WS_VT = WS_R + 180 * MiB;
constexpr size_t WS_O = WS_R + 216 * MiB;
constexpr size_t WS_PD = WS_R;
constexpr size_t WS_A6 = WS_R;
constexpr size_t WS_E = WS_R;
constexpr size_t WS_A = WS_R + 288 * MiB;
constexpr size_t WS_RO = WS_R + 576 * MiB;
constexpr size_t WS_RKV = WS_R + 864 * MiB;
constexpr size_t WS_LORA = WS_R + 1296 * MiB;
constexpr size_t WS_G = WS_R + 1404 * MiB;
constexpr size_t WS_YS = WS_R + 1548 * MiB;
constexpr size_t WS_BONUS = WS_R + 2124 * MiB;
constexpr size_t WS_END = WS_R + 2134 * MiB;

constexpr int CW_BAR = 4096;
constexpr int CW_GCNT = 16384;
constexpr int LDS_BYTES = 147456;
constexpr int RING_BYTES = 131072;
constexpr int LDSCTL_OFF = 135168;
constexpr int MISC_OFF = LDSCTL_OFF;
constexpr int TPRE_OFF = LDSCTL_OFF + 256;
constexpr int LCNT_OFF = LDSCTL_OFF + 512;
constexpr int LBASE_OFF = LDSCTL_OFF + 768;
constexpr int REC_OFF = LDSCTL_OFF + 1024;
constexpr int TEXP_OFF = LDSCTL_OFF + 1024 + 2048;
constexpr int TOKS_OFF = LDSCTL_OFF + 1024 + 4096;
constexpr int BIAS_OFF = LDSCTL_OFF + 1024 + 6144;
constexpr int JOB_OFF = LDSCTL_OFF + 1024;

__device__ __forceinline__ unsigned f2bf(float f) { unsigned u = __builtin_bit_cast(unsigned, f); return (u + 0x7fffu + ((u >> 16) & 1u)) >> 16; }
__device__ __forceinline__ unsigned pk2(float lo, float hi) { return f2bf(lo) | (f2bf(hi) << 16); }
__device__ __forceinline__ float bflo(unsigned w) { return __builtin_bit_cast(float, w << 16); }
__device__ __forceinline__ float bfhi(unsigned w) { return __builtin_bit_cast(float, w & 0xffff0000u); }
__device__ __forceinline__ float bf1(bf16_t b) { return __builtin_bit_cast(float, ((unsigned)b) << 16); }
__device__ __forceinline__ unsigned pk4_fp8(float a, float b, float c, float d) {
    int w = __builtin_amdgcn_cvt_pk_fp8_f32(a, b, __builtin_bit_cast(int, a), false); w = __builtin_amdgcn_cvt_pk_fp8_f32(c, d, w, true); return (unsigned)w; }
typedef __bf16 bf16x2_t __attribute__((ext_vector_type(2)));
__device__ __forceinline__ unsigned cvt_pk_bf16(float lo, float hi) { const f32x2 v = {lo, hi}; return __builtin_bit_cast(unsigned, __builtin_convertvector(v, bf16x2_t)); }
__device__ __forceinline__ float dpp_add(float v, const int ctrl, const int row_mask) {
    switch (ctrl) {
    case 0xB1:  return v + __builtin_bit_cast(float, __builtin_amdgcn_update_dpp(0, __builtin_bit_cast(int, v), 0xB1, 0xf, 0xf, true));
    case 0x4E:  return v + __builtin_bit_cast(float, __builtin_amdgcn_update_dpp(0, __builtin_bit_cast(int, v), 0x4E, 0xf, 0xf, true));
    case 0x141: return v + __builtin_bit_cast(float, __builtin_amdgcn_update_dpp(0, __builtin_bit_cast(int, v), 0x141, 0xf, 0xf, true));
    case 0x140: return v + __builtin_bit_cast(float, __builtin_amdgcn_update_dpp(0, __builtin_bit_cast(int, v), 0x140, 0xf, 0xf, true));
    case 0x142: return v + __builtin_bit_cast(float, __builtin_amdgcn_update_dpp(0, __builtin_bit_cast(int, v), 0x142, 0xa, 0xf, true));
    default:    return v + __builtin_bit_cast(float, __builtin_amdgcn_update_dpp(0, __builtin_bit_cast(int, v), 0x143, 0xc, 0xf, true));
    }
}
__device__ __forceinline__ float row16_sum(float v) { v = dpp_add(v, 0xB1, 0xf); v = dpp_add(v, 0x4E, 0xf); v = dpp_add(v, 0x141, 0xf); v = dpp_add(v, 0x140, 0xf); return v; }
__device__ __forceinline__ float wave_sum(float v) {
    v = row16_sum(v); v = dpp_add(v, 0x142, 0xa); v = dpp_add(v, 0x143, 0xc);
    return __builtin_bit_cast(float, __builtin_amdgcn_readlane(__builtin_bit_cast(int, v), 63));
}
__device__ __forceinline__ float sigmoidf_(float x) { return __builtin_amdgcn_rcpf(1.0f + __builtin_amdgcn_exp2f(-1.4426950408889634f * x)); }
__device__ __forceinline__ int opaque_tid() { int t; asm volatile("v_mov_b32 %0, %1" : "=v"(t) : "v"(threadIdx.x)); return t; }
#define REFRESH(F) do { (F).tid = opaque_tid(); (F).lane = (F).tid & 63; } while (0)
__device__ __forceinline__ void seq_of(int row, int& sb, int& t, int& n) { if (row < NX) { sb = row & ~(T - 1); t = row & (T - 1); n = T; } else { const int r2 = row - NX; sb = NX + (r2 & ~(L - 1)); t = r2 & (L - 1); n = L; } }
__device__ __forceinline__ f32x4 ld_bf4(const bf16_t* p) { const u32x2 w = *(const u32x2*)p; return (f32x4){bflo(w.x), bfhi(w.x), bflo(w.y), bfhi(w.y)}; }
__device__ __forceinline__ void st_bf4(bf16_t* p, f32x4 v) { u32x2 w; w.x = pk2(v.x, v.y); w.y = pk2(v.z, v.w); *(u32x2*)p = w; }

#define LDS_WAIT() asm volatile("s_waitcnt lgkmcnt(0)" ::: "memory")
#define VM_WAIT() asm volatile("s_waitcnt vmcnt(0)" ::: "memory")

#define XB_TMO      128
#define XB_XCNT(j)  (256  + 64 * (j))
#define XB_XSUB(j)  (1280 + 64 * (j))
#define XB_XGEN(j)  (2304 + 64 * (j))
#define XB_TOP      3328
#define XB_TOPGEN   3392
#define XCD_BAR_WORDS 3456
#define XB_SPIN_CAP (1u << 18)
__device__ __forceinline__ unsigned xb_ld(unsigned* p)              { return __hip_atomic_load(p, __ATOMIC_RELAXED, __HIP_MEMORY_SCOPE_AGENT); }
__device__ __forceinline__ unsigned xb_add(unsigned* p, unsigned v) { return __hip_atomic_fetch_add(p, v, __ATOMIC_RELAXED, __HIP_MEMORY_SCOPE_AGENT); }
__device__ __forceinline__ unsigned xb_xcc_id() { return (unsigned)__builtin_amdgcn_s_getreg((3 << 11) | 20) & 0xFu; }
#define XB_SPIN(cond, bar) do { unsigned _sp = 0; while (cond) { __builtin_amdgcn_s_sleep(1); \
    if ((++_sp & 255u) == 0u) { if (xb_ld(&(bar)[XB_TMO])) break; if (_sp > XB_SPIN_CAP) { atomicAdd(&(bar)[XB_TMO], 1u); break; } } } } while (0)
struct XcdBarrier { unsigned* bar; unsigned x; volatile LAS unsigned* st; };
__device__ __forceinline__ XcdBarrier xcd_barrier_post(unsigned* bar, volatile LAS unsigned* st) {
    XcdBarrier b; b.bar = bar; b.x = xb_xcc_id(); b.st = st;
    if (threadIdx.x == 0) (void)xb_add(&bar[XB_XCNT(b.x)], 1u);
    return b;
}
__device__ __forceinline__ void xcd_barrier_complete(unsigned* bar, unsigned x, unsigned& nloc, unsigned& nx) {
    const unsigned G = gridDim.x * gridDim.y * gridDim.z;
    unsigned sum, cnt, mine, sp = 0u;
    for (;;) {
        sum = 0u; cnt = 0u; mine = 0u;
#pragma unroll
        for (unsigned j = 0; j < 16; ++j) { const unsigned c = xb_ld(&bar[XB_XCNT(j)]); sum += c; cnt += (c > 0u) ? 1u : 0u; mine = (j == x) ? c : mine; }
        if (sum == G) break;
        __builtin_amdgcn_s_sleep(1);
        if ((++sp & 255u) == 0u) { if (xb_ld(&bar[XB_TMO])) break; if (sp > XB_SPIN_CAP) { atomicAdd(&bar[XB_TMO], 1u); break; } }
    }
    nloc = mine > 0u ? mine : 1u; nx = cnt > 0u ? cnt : 1u;
}
__device__ __forceinline__ void xcd_barrier(const XcdBarrier& b) {
    asm volatile("s_waitcnt vmcnt(0)" ::: "memory");
    __syncthreads();
    if (threadIdx.x == 0) {
        unsigned* bar = b.bar;
        __builtin_amdgcn_s_waitcnt(0);
        unsigned nloc = b.st[0], nx = b.st[1];
        if (nloc == 0u) { xcd_barrier_complete(bar, b.x, nloc, nx); b.st[0] = nloc; b.st[1] = nx; }
        const unsigned old = xb_add(&bar[XB_XSUB(b.x)], 1u);
        const unsigned gen = old / nloc;
        if (old + 1u == (gen + 1u) * nloc) {
            __builtin_amdgcn_fence(__ATOMIC_RELEASE, "agent");
            asm volatile("s_waitcnt vmcnt(0)" ::: "memory");
            const unsigned og = xb_add(&bar[XB_TOP], 1u);
            const unsigned tg = og / nx;
            if (og + 1u == (tg + 1u) * nx) xb_add(&bar[XB_TOPGEN], 1u);
            else XB_SPIN(xb_ld(&bar[XB_TOPGEN]) == tg, bar);
            __builtin_amdgcn_fence(__ATOMIC_ACQUIRE, "agent");
            xb_add(&bar[XB_XGEN(b.x)], 1u);
            asm volatile("s_waitcnt vmcnt(0)" ::: "memory");
        } else {
            XB_SPIN(xb_ld(&bar[XB_XGEN(b.x)]) == gen, bar);
            __builtin_amdgcn_fence(__ATOMIC_ACQUIRE, "agent");
            asm volatile("s_waitcnt vmcnt(0)" ::: "memory");
        }
    }
    __syncthreads();
}

namespace pg8 {
constexpr int BM = 256, BK = 64, HALF = 128, HTB = HALF * BK * 2, STAGE_BYTES = 8 * HTB, NXCD = 8, WGM = 8;
__host__ __device__ __forceinline__ int lds_byte(int r, int c) { const int st = (r >> 4) * 2 + (c >> 5), rr = r & 15, cc = c & 31, ob = rr * 64 + cc * 2; return st * 1024 + (ob ^ (((ob >> 9) & 1) << 5)); }
__host__ __device__ __forceinline__ void stage_rc(int b, int& R, int& C) { const int st = b / 1024, sb = b % 1024, swz = sb ^ (((sb >> 9) & 1) << 5); R = (st >> 1) * 16 + swz / 64; C = (st & 1) * 32 + (swz % 64) / 2; }
__host__ __device__ __forceinline__ int perm32(int rho) { const int n = rho >> 4, i = rho & 15; return 8 * (i >> 2) + 4 * n + (i & 3); }

typedef int i32x8 __attribute__((ext_vector_type(8)));
typedef int i32x4 __attribute__((ext_vector_type(4)));
__device__ __forceinline__ i32x8 cat8(bf16x8 lo, bf16x8 hi) { const i32x4 a = __builtin_bit_cast(i32x4, lo), b = __builtin_bit_cast(i32x4, hi); return __builtin_shufflevector(a, b, 0, 1, 2, 3, 4, 5, 6, 7); }
struct Unit { int pm, pn, e, rt; };
struct TileOrder {
    int nM, nN, nwg, G, c; unsigned inv_nig;
    __device__ __forceinline__ void init(int nM_, int nN_, int G_, int c_) { nM = nM_; nN = nN_; nwg = nM * nN; G = G_; c = c_; inv_nig = (unsigned)((0x100000000ull + (unsigned)(WGM * nN_) - 1u) / (unsigned)(WGM * nN_)); }
    __device__ __forceinline__ bool next(int i, int& pm, int& pn) const {
        const long Lx = (long)i * G + c; if (Lx >= nwg) return false;
        int wgid = (int)Lx; { const int q = nwg >> 3, r = nwg & 7, xcd = wgid & 7, off = wgid >> 3; wgid = (xcd < r ? xcd * (q + 1) : r * (q + 1) + (xcd - r) * q) + off; }
        const int nig = WGM * nN, gid = (int)(((unsigned long long)(unsigned)wgid * inv_nig) >> 32), fm = gid * WGM, rem = wgid - gid * nig, left = nM - fm;
        if (left >= WGM) { pm = fm + (rem & (WGM - 1)); pn = rem >> 3; }
        else { pm = fm + rem % left; pn = rem / left; }
        return true;
    }
};
struct ProbDense {
    static constexpr bool FP8 = false;
    const bf16_t* A; const bf16_t* Bt; int lda, ldb, K, a_pn_off; TileOrder ord;
    __device__ __forceinline__ int ldb_bytes() const { return ldb * 2; }
    __device__ __forceinline__ int ntiles() const { return K / 64; }
    __device__ __forceinline__ bool next(int i, Unit& u) const { u.e = 0; const bool ok = ord.next(i, u.pm, u.pn); u.rt = u.pm; return ok; }
    __device__ __forceinline__ const char* a_ptr(const Unit& u) const { return (const char*)(A + (size_t)u.pm * BM * lda + (size_t)u.pn * a_pn_off); }
    __device__ __forceinline__ const char* b_ptr(const Unit& u) const { return (const char*)(Bt + (size_t)u.pn * BM * ldb); }
    __device__ __forceinline__ void list_prefetch(const Unit&, int, int, int) const {}
    __device__ __forceinline__ void a_off(const Unit&, int, const int (&R)[2], const int (&C)[2], unsigned (&v)[2][2]) const {
#pragma unroll
        for (int h = 0; h < 2; ++h)
#pragma unroll
            for (int i = 0; i < 2; ++i) v[h][i] = (unsigned)((h * HALF + R[i]) * lda + C[i]) * 2u;
    }
};

struct ProbDense8 {
    static constexpr bool FP8 = true;
    const unsigned char* A; const unsigned char* Bt; int lda, ldb, K, scale_w, scale_x; TileOrder ord;
    __device__ __forceinline__ int ldb_bytes() const { return ldb; }
    __device__ __forceinline__ int ntiles() const { return K / 128; }
    __device__ __forceinline__ bool next(int i, Unit& u) const { u.e = 0; const bool ok = ord.next(i, u.pm, u.pn); u.rt = u.pm; return ok; }
    __device__ __forceinline__ const char* a_ptr(const Unit& u) const { return (const char*)(A + (size_t)u.pm * BM * lda); }
    __device__ __forceinline__ const char* b_ptr(const Unit& u) const { return (const char*)(Bt + (size_t)u.pn * BM * ldb); }
    __device__ __forceinline__ void list_prefetch(const Unit&, int, int, int) const {}
    __device__ __forceinline__ void a_off(const Unit&, int, const int (&R)[2], const int (&C)[2], unsigned (&v)[2][2]) const {
#pragma unroll
        for (int h = 0; h < 2; ++h)
#pragma unroll
            for (int i = 0; i < 2; ++i) v[h][i] = (unsigned)((h * HALF + R[i]) * lda + C[i] * 2);
    }
};
template <class Prob, class Epi>
__device__ __forceinline__ void gemm_phase(LAS unsigned char* lds, const Prob& P, const Epi& E) {
    const int tid = opaque_tid(), wid = __builtin_amdgcn_readfirstlane(tid >> 6), lane = tid & 63, wr = wid >> 2, wc = wid & 3, fr = lane & 15, fq = lane >> 4;
    const int nt = P.ntiles(); const int ldbB = P.ldb_bytes();
    int Rr[2], Cc[2]; unsigned voffB[2];
#pragma unroll
    for (int i = 0; i < 2; ++i) { int R, C; stage_rc(tid * 16 + i * 8192, R, C); Rr[i] = R; Cc[i] = C; const int Rb = Epi::PERM ? ((R & ~31) + perm32(R & 31)) : R;
        voffB[i] = (unsigned)(Rb * ldbB + C * 2); }
    const size_t kstep = (size_t)(BK * 2);
    const size_t hstepB = (size_t)HALF * ldbB;
    const unsigned ldsw = (unsigned)wid * 1024u;
    const int aoff = lds_byte(wr * 64 + fr, fq * 8), boff = lds_byte(wc * 32 + fr, fq * 8);
#define PG8_SA(b, h) (((b) * 2 + (h)) * HTB)
#define PG8_SB(b, h) ((4 + (b) * 2 + (h)) * HTB)
#define PG8_STAGE(bufoff, gbase, voff) do { _Pragma("unroll") for (int _i = 0; _i < 2; ++_i) { \
        __builtin_amdgcn_global_load_lds((const unsigned*)((const char*)(gbase) + (voff)[_i]), (LAS unsigned*)(lds + (bufoff) + ldsw + _i * 8192), 16, 0, 0); } } while (0)
#define PG8_LDA(dst, b, h) do { _Pragma("unroll") for (int m = 0; m < 4; ++m) _Pragma("unroll") for (int k = 0; k < 2; ++k) dst[m][k] = *(const LAS bf16x8*)(lds + PG8_SA(b, h) + aoff + m * 2048 + k * 1024); } while (0)
#define PG8_LDB(dst, b, h) do { _Pragma("unroll") for (int n = 0; n < 2; ++n) _Pragma("unroll") for (int k = 0; k < 2; ++k) dst[n][k] = *(const LAS bf16x8*)(lds + PG8_SB(b, h) + boff + n * 2048 + k * 1024); } while (0)
#define PG8_MMA(ai, bj, At, Bt) do { __builtin_amdgcn_s_setprio(1); _Pragma("unroll") for (int m = 0; m < 4; ++m) _Pragma("unroll") for (int n = 0; n < 2; ++n) { \
        if constexpr (Prob::FP8) { asm volatile("v_mfma_scale_f32_16x16x128_f8f6f4 %0, %1, %2, %0, %3, %4 op_sel_hi:[0,0,0]" : "+v"(acc[ai][bj][m][n]) : "v"(cat8(Bt[n][0], Bt[n][1])), "v"(cat8(At[m][0], At[m][1])), "v"(sc_w), "v"(sc_x)); } \
        else { _Pragma("unroll") for (int k = 0; k < 2; ++k) acc[ai][bj][m][n] = __builtin_amdgcn_mfma_f32_16x16x32_bf16(Bt[n][k], At[m][k], acc[ai][bj][m][n], 0, 0, 0); } } __builtin_amdgcn_s_setprio(0); } while (0)
#define PG8_MMAZ(ai, bj, At, Bt) do { __builtin_amdgcn_s_setprio(1); _Pragma("unroll") for (int m = 0; m < 4; ++m) _Pragma("unroll") for (int n = 0; n < 2; ++n) { \
        if constexpr (Prob::FP8) { asm volatile("v_mfma_scale_f32_16x16x128_f8f6f4 %0, %1, %2, 0, %3, %4 op_sel_hi:[0,0,0]" : "=&v"(acc[ai][bj][m][n]) : "v"(cat8(Bt[n][0], Bt[n][1])), "v"(cat8(At[m][0], At[m][1])), "v"(sc_w), "v"(sc_x)); } \
        else { acc[ai][bj][m][n] = __builtin_amdgcn_mfma_f32_16x16x32_bf16(Bt[n][0], At[m][0], (f32x4){0.f, 0.f, 0.f, 0.f}, 0, 0, 0); acc[ai][bj][m][n] = __builtin_amdgcn_mfma_f32_16x16x32_bf16(Bt[n][1], At[m][1], acc[ai][bj][m][n], 0, 0, 0); } } __builtin_amdgcn_s_setprio(0); } while (0)
#define PG8_WAIT_V(n) asm volatile("s_waitcnt vmcnt(" #n ")" ::: "memory")
#define PG8_WAIT_V8R(flag) do { if constexpr (Epi::NSTORE > 0) asm volatile("s_cmp_lg_u32 %0, 0\n\ts_cbranch_scc1 .Lpg8w%=\n\ts_waitcnt vmcnt(8)\n.Lpg8w%=:\n\ts_waitcnt vmcnt(%1)" :: "s"(flag), "n"(8 + Epi::NSTORE) : "scc", "memory"); else PG8_WAIT_V(8); } while (0)
#define PG8_WAIT_L(n) asm volatile("s_waitcnt lgkmcnt(" #n ")" ::: "memory")
#define PG8_BAR __builtin_amdgcn_s_barrier()
#define PG8_SCHED __builtin_amdgcn_sched_barrier(0)
    Unit cur, nxt; int ui = 0;
    if (!P.next(0, cur)) return;
    const int ntm = nt - 1;
    int k0c = (cur.pm + 2 * cur.pn) & 7 & ntm;
    int sc_w = 0, sc_x = 0; if constexpr (Prob::FP8) { sc_w = P.scale_w; sc_x = P.scale_x; } (void)sc_w; (void)sc_x;
    f32x4 acc[2][2][4][2];
    bf16x8 At[4][2], B0[2][2], B1[2][2];
    unsigned vAc[2][2], vAn[2][2];
    Unit nx1; bool h1 = P.next(1, nx1);
    P.list_prefetch(cur, 0, wid, lane); if (h1) P.list_prefetch(nx1, 1, wid, lane);
    LAS float* const biasl = (LAS float*)(lds + BIAS_OFF); int bsc = 0;
    if constexpr (Epi::LDSBIAS) { if (wid == 1) E.prefetch(cur, biasl, lane); }
    PG8_WAIT_V(0); PG8_BAR;
    P.a_off(cur, 0, Rr, Cc, vAc);
    const char* cA = P.a_ptr(cur); const char* cB = P.b_ptr(cur);
    const size_t po0 = (size_t)k0c * kstep, po1 = (size_t)((k0c + 1) & ntm) * kstep;
    PG8_STAGE(PG8_SB(0, 0), cB + po0, voffB); PG8_STAGE(PG8_SB(0, 1), cB + hstepB + po0, voffB); PG8_STAGE(PG8_SA(0, 0), cA + po0, vAc[0]); PG8_STAGE(PG8_SA(0, 1), cA + po0, vAc[1]);
    if (wr == 1) PG8_BAR;
    PG8_WAIT_V(2); PG8_BAR;
    PG8_STAGE(PG8_SB(1, 0), cB + po1, voffB); PG8_STAGE(PG8_SA(1, 0), cA + po1, vAc[0]); PG8_STAGE(PG8_SB(1, 1), cB + hstepB + po1, voffB);
    PG8_WAIT_V(6); PG8_BAR;
    for (;;) {
        const bool has_next = h1; nxt = nx1;
        const char* nA = cA; const char* nB = cB;
#pragma unroll
        for (int h = 0; h < 2; ++h)
#pragma unroll
            for (int i = 0; i < 2; ++i) vAn[h][i] = vAc[h][i];
        int k0n = k0c;
        if (has_next) { nA = P.a_ptr(nxt); nB = P.b_ptr(nxt); P.a_off(nxt, (ui + 1) & 1, Rr, Cc, vAn); k0n = (nxt.pm + 2 * nxt.pn) & 7 & ntm; }
        h1 = has_next && P.next(ui + 2, nx1); if (h1) P.list_prefetch(nx1, ui & 1, wid, lane);
        const int bsn = (bsc == 2) ? 0 : bsc + 1;
        if constexpr (Epi::LDSBIAS) { if (has_next && wid == 1) E.prefetch(nxt, biasl + bsn * 256, lane); }
#define PG8_KBODY(T, MMX, W12) { const int t = (T); const bool last = (t == nt - 2); \
            asm volatile("" : "+v"(voffB[0]), "+v"(voffB[1]), "+v"(vAc[0][0]), "+v"(vAc[0][1]), "+v"(vAc[1][0]), "+v"(vAc[1][1])); \
            const char* a1 = cA + (size_t)((t + 1 + k0c) & ntm) * kstep; \
            const size_t o2 = (size_t)(last ? k0n : ((t + 2 + k0c) & ntm)) * kstep, o3 = (size_t)(last ? ((k0n + 1) & ntm) : ((t + 3 + k0c) & ntm)) * kstep; \
            const char* a2 = (last ? nA : cA) + o2; const char* b2 = (last ? nB : cB) + o2; \
            const char* a3 = (last ? nA : cA) + o3; const char* b3 = (last ? nB : cB) + o3; \
            unsigned vX[2][2]; \
            _Pragma("unroll") for (int h = 0; h < 2; ++h) _Pragma("unroll") for (int i = 0; i < 2; ++i) vX[h][i] = last ? vAn[h][i] : vAc[h][i]; \
            PG8_LDB(B0, 0, 0); PG8_LDB(B1, 0, 1); PG8_SCHED; PG8_LDA(At, 0, 0); PG8_STAGE(PG8_SA(1, 1), a1, vAc[1]); \
            W12; PG8_WAIT_L(0); PG8_BAR; MMX(0, 0, At, B0); MMX(0, 1, At, B1); PG8_BAR; PG8_SCHED; \
            PG8_LDA(At, 0, 1); PG8_STAGE(PG8_SB(0, 0), b2, voffB); PG8_STAGE(PG8_SB(0, 1), b2 + hstepB, voffB); PG8_STAGE(PG8_SA(0, 0), a2, vX[0]); \
            W12; PG8_WAIT_L(0); PG8_BAR; MMX(1, 0, At, B0); MMX(1, 1, At, B1); PG8_BAR; PG8_SCHED; \
            PG8_LDB(B0, 1, 0); PG8_LDB(B1, 1, 1); PG8_SCHED; PG8_LDA(At, 1, 0); PG8_STAGE(PG8_SA(0, 1), a2, vX[1]); \
            PG8_WAIT_V(8); PG8_WAIT_L(0); PG8_BAR; PG8_MMA(0, 0, At, B0); PG8_MMA(0, 1, At, B1); PG8_BAR; PG8_SCHED; \
            PG8_LDA(At, 1, 1); PG8_STAGE(PG8_SB(1, 0), b3, voffB); PG8_STAGE(PG8_SB(1, 1), b3 + hstepB, voffB); PG8_STAGE(PG8_SA(1, 0), a3, vX[0]); \
            PG8_WAIT_V(8); PG8_WAIT_L(0); PG8_BAR; PG8_MMA(1, 0, At, B0); PG8_MMA(1, 1, At, B1); PG8_BAR; PG8_SCHED; }
        if constexpr (Prob::FP8) {
            { const int rlx = __builtin_amdgcn_readfirstlane(ui != 0 ? 1 : 0);
              PG8_KBODY(0, PG8_MMAZ, PG8_WAIT_V8R(rlx)) }
            for (int tt = 2; tt < nt; tt += 2) PG8_KBODY(tt, PG8_MMA, PG8_WAIT_V(8))
        } else {
            { f32x4 zz = (f32x4){0.f, 0.f, 0.f, 0.f}; asm volatile("" : "+v"(zz));
#pragma unroll
                for (int a = 0; a < 2; ++a)
#pragma unroll
                    for (int b = 0; b < 2; ++b)
#pragma unroll
                        for (int m = 0; m < 4; ++m)
#pragma unroll
                            for (int n = 0; n < 2; ++n) acc[a][b][m][n] = zz; }
            for (int tt = 0; tt < nt; tt += 2) PG8_KBODY(tt, PG8_MMA, PG8_WAIT_V(8))
        }
#undef PG8_KBODY
        f32x4 bqe[2][2];
        if constexpr (Epi::LDSBIAS) {
#pragma unroll
            for (int bj = 0; bj < 2; ++bj)
#pragma unroll
                for (int n = 0; n < 2; ++n) bqe[bj][n] = *(const LAS f32x4*)(biasl + bsc * 256 + bj * 128 + wc * 32 + 8 * fq + 4 * n);
        } else { (void)bqe; }
        if (wr == 0) PG8_BAR;
        if constexpr (Prob::FP8) { asm volatile("s_nop 15\n\ts_nop 15" ::: "memory");
#pragma unroll
            for (int a = 0; a < 2; ++a)
#pragma unroll
                for (int b = 0; b < 2; ++b)
                    asm volatile("" : "+v"(acc[a][b][0][0]), "+v"(acc[a][b][0][1]), "+v"(acc[a][b][1][0]), "+v"(acc[a][b][1][1]), "+v"(acc[a][b][2][0]), "+v"(acc[a][b][2][1]), "+v"(acc[a][b][3][0]), "+v"(acc[a][b][3][1])); }
        if constexpr (Epi::LDSBIAS) E(acc, cur, wr, wc, fr, fq, bqe); else E(acc, cur, wr, wc, fr, fq);
        if (!has_next) break;
        cur = nxt; cA = nA; cB = nB; k0c = k0n; bsc = bsn; ++ui;
#pragma unroll
        for (int h = 0; h < 2; ++h)
#pragma unroll
            for (int i = 0; i < 2; ++i) vAc[h][i] = vAn[h][i];
        if (wr == 1) PG8_BAR;
    }
    PG8_WAIT_V(0);
    PG8_BAR;
#undef PG8_SA
#undef PG8_SB
#undef PG8_STAGE
#undef PG8_LDA
#undef PG8_LDB
#undef PG8_MMA
#undef PG8_MMAZ
#undef PG8_WAIT_V
#undef PG8_WAIT_L
#undef PG8_WAIT_V8R
#undef PG8_BAR
#undef PG8_SCHED
}
}

using pg8::Unit;
constexpr int HALF_ = 128;
struct EpiBf16Act {
    static constexpr bool PERM = true; static constexpr bool LDSBIAS = false; static constexpr int NSTORE = 0;
    bf16_t* O; int ldc; const float* bias; int act; float scale;
    __device__ __forceinline__ void operator()(const f32x4 (&acc)[2][2][4][2], const Unit& u, int wr, int wc, int fr, int fq) const {
        const int row0 = u.pm * 256 + wr * 64 + fr, col0 = u.pn * 256 + wc * 32 + 8 * fq;
        f32x4 bv[2][2];
#pragma unroll
        for (int bj = 0; bj < 2; ++bj)
#pragma unroll
            for (int n = 0; n < 2; ++n) bv[bj][n] = bias ? *(const f32x4*)(bias + col0 + bj * HALF_ + 4 * n) : (f32x4){0.f, 0.f, 0.f, 0.f};
#pragma unroll
        for (int ai = 0; ai < 2; ++ai)
#pragma unroll
            for (int m = 0; m < 4; ++m) { bf16_t* rowp = O + (size_t)(row0 + ai * HALF_ + m * 16) * ldc + col0;
#pragma unroll
                for (int bj = 0; bj < 2; ++bj) { f32x4 v0 = acc[ai][bj][m][0] + bv[bj][0], v1 = acc[ai][bj][m][1] + bv[bj][1];
                    if (act == 1) {
#pragma unroll
                        for (int j = 0; j < 4; ++j) { v0[j] = sigmoidf_(v0[j]) * scale; v1[j] = sigmoidf_(v1[j]) * scale; } }
                    else if (act == 2) {
#pragma unroll
                        for (int j = 0; j < 4; ++j) { v0[j] = 1.0f - 2.0f * __builtin_amdgcn_rcpf(__builtin_amdgcn_exp2f(2.8853900817779268f * v0[j]) + 1.0f); v1[j] = 1.0f - 2.0f * __builtin_amdgcn_rcpf(__builtin_amdgcn_exp2f(2.8853900817779268f * v1[j]) + 1.0f); } }
                    u32x4 w; w.x = cvt_pk_bf16(v0[0], v0[1]); w.y = cvt_pk_bf16(v0[2], v0[3]); w.z = cvt_pk_bf16(v1[0], v1[1]); w.w = cvt_pk_bf16(v1[2], v1[3]);
                    *(u32x4*)(rowp + bj * HALF_) = w; } }
    }
};
struct EpiQK {
    static constexpr bool PERM = true; static constexpr bool LDSBIAS = false; static constexpr int NSTORE = 0;
    bf16_t* Q; bf16_t* Kb; const float* bias; const float* ropec; const float* ropes;
    __device__ __forceinline__ void operator()(const f32x4 (&acc)[2][2][4][2], const Unit& u, int wr, int wc, int fr, int fq) const {
        int row0 = u.pm * 256 + wr * 64 + fr, cl0 = wc * 32 + 8 * fq;
        asm volatile("" : "+v"(row0), "+v"(cl0));
        const int g = (4 * wc + fq) & 7;
        bf16_t* base; int ldc;
        if (u.pn < 4) { base = Q + u.pn * 256; ldc = 1024; } else { base = Kb; ldc = 256; }
        f32x4 bv[2][2];
#pragma unroll
        for (int bj = 0; bj < 2; ++bj)
#pragma unroll
            for (int n = 0; n < 2; ++n) bv[bj][n] = *(const f32x4*)(bias + u.pn * 256 + cl0 + bj * HALF_ + 4 * n);
#pragma unroll
        for (int ai = 0; ai < 2; ++ai)
#pragma unroll
            for (int m = 0; m < 4; ++m) { const int row = row0 + ai * HALF_ + m * 16; bf16_t* rowp = base + (size_t)row * ldc + cl0;
                f32x4 cs = (f32x4){1.f, 1.f, 1.f, 1.f}, sn = (f32x4){0.f, 0.f, 0.f, 0.f};
                if (row < NX) { const int t = row & (T - 1); cs = *(const f32x4*)(ropec + t * 32 + g * 4); sn = *(const f32x4*)(ropes + t * 32 + g * 4); }
#pragma unroll
                for (int bj = 0; bj < 2; ++bj) { const f32x4 v0 = acc[ai][bj][m][0] + bv[bj][0], v1 = acc[ai][bj][m][1] + bv[bj][1];
                    const f32x4 o0 = v0 * cs - v1 * sn, o1 = v1 * cs + v0 * sn;
                    u32x4 w; w.x = cvt_pk_bf16(o0[0], o0[1]); w.y = cvt_pk_bf16(o0[2], o0[3]); w.z = cvt_pk_bf16(o1[0], o1[1]); w.w = cvt_pk_bf16(o1[2], o1[3]);
                    *(u32x4*)(rowp + bj * HALF_) = w; } }
    }
};
struct EpiVT {
    static constexpr bool PERM = true; static constexpr bool LDSBIAS = false; static constexpr int NSTORE = 0;
    bf16_t* VT; const float* biasrow;
    __device__ __forceinline__ void operator()(const f32x4 (&acc)[2][2][4][2], const Unit& u, int wr, int wc, int fr, int fq) const {
        int row0 = wr * 64 + fr, col0 = u.pn * 256 + wc * 32 + 8 * fq;
        asm volatile("" : "+v"(row0), "+v"(col0));
#pragma unroll
        for (int ai = 0; ai < 2; ++ai)
#pragma unroll
            for (int m = 0; m < 4; ++m) { const int row = row0 + ai * HALF_ + m * 16; const float b = biasrow[row]; bf16_t* rowp = VT + (size_t)row * NT + col0;
#pragma unroll
                for (int bj = 0; bj < 2; ++bj) { const f32x4 v0 = acc[ai][bj][m][0] + b, v1 = acc[ai][bj][m][1] + b;
                    u32x4 w; w.x = cvt_pk_bf16(v0[0], v0[1]); w.y = cvt_pk_bf16(v0[2], v0[3]); w.z = cvt_pk_bf16(v1[0], v1[1]); w.w = cvt_pk_bf16(v1[2], v1[3]);
                    *(u32x4*)(rowp + bj * HALF_) = w; } }
    }
};
struct EpiResid {
    static constexpr bool PERM = true; static constexpr bool LDSBIAS = false; static constexpr int NSTORE = 0;
    bf16_t* H; const float* bias; const float* ls; const float* gate;
    __device__ __forceinline__ void operator()(const f32x4 (&acc)[2][2][4][2], const Unit& u, int wr, int wc, int fr, int fq) const {
        int row0 = u.pm * 256 + wr * 64 + fr, col0 = u.pn * 256 + wc * 32 + 8 * fq;
        asm volatile("" : "+v"(row0), "+v"(col0));
        f32x4 bv[2][2], lv[2][2];
#pragma unroll
        for (int bj = 0; bj < 2; ++bj)
#pragma unroll
            for (int n = 0; n < 2; ++n) { bv[bj][n] = bias ? *(const f32x4*)(bias + col0 + bj * HALF_ + 4 * n) : (f32x4){0.f, 0.f, 0.f, 0.f};
                                          lv[bj][n] = ls ? *(const f32x4*)(ls + col0 + bj * HALF_ + 4 * n) : (f32x4){1.f, 1.f, 1.f, 1.f}; }
#pragma unroll
        for (int ai = 0; ai < 2; ++ai)
#pragma unroll
            for (int m = 0; m < 4; ++m) { const int row = row0 + ai * HALF_ + m * 16; const int brow = row < NX ? (row >> 11) : 32;
                bf16_t* hp = H + (size_t)row * D + col0; const float* gp = gate + (size_t)brow * (6 * D) + col0;
#pragma unroll
                for (int bj = 0; bj < 2; ++bj) { const u32x4 hw = *(const u32x4*)(hp + bj * HALF_);
                    const f32x4 g0 = *(const f32x4*)(gp + bj * HALF_), g1 = *(const f32x4*)(gp + bj * HALF_ + 4);
                    const f32x4 y0 = (acc[ai][bj][m][0] + bv[bj][0]) * lv[bj][0], y1 = (acc[ai][bj][m][1] + bv[bj][1]) * lv[bj][1];
                    const f32x4 h0 = (f32x4){bflo(hw.x), bfhi(hw.x), bflo(hw.y), bfhi(hw.y)} + g0 * y0, h1 = (f32x4){bflo(hw.z), bfhi(hw.z), bflo(hw.w), bfhi(hw.w)} + g1 * y1;
                    u32x4 w; w.x = cvt_pk_bf16(h0[0], h0[1]); w.y = cvt_pk_bf16(h0[2], h0[3]); w.z = cvt_pk_bf16(h1[0], h1[1]); w.w = cvt_pk_bf16(h1[2], h1[3]);
                    *(u32x4*)(hp + bj * HALF_) = w; }
                asm volatile("" ::: "memory"); }
    }
};
struct EpiMoe1 {
    static constexpr bool PERM = true; static constexpr bool LDSBIAS = true; static constexpr int NSTORE = 8;
    unsigned char* ACT; const float* b1;
    __device__ __forceinline__ void prefetch(const Unit& u, LAS float* slot, int lane) const {
        const float* src = b1 + (size_t)u.e * 2048 + u.pn * 128 + (lane >> 5) * 1024 + (lane & 31) * 4;
        __builtin_amdgcn_global_load_lds((const unsigned*)src, (LAS unsigned*)slot, 16, 0, 0); }
    __device__ __forceinline__ void operator()(const f32x4 (&acc)[2][2][4][2], const Unit& u, int wr, int wc, int fr, int fq, const f32x4 (&bq)[2][2]) const {
        unsigned char* const Ab = ACT + ((size_t)u.rt * 256 * D + (size_t)u.pn * 128);
        unsigned voff = (unsigned)((wr * 64 + fr) * D + wc * 32 + 8 * fq); asm volatile("" : "+v"(voff));
        f32x4 bgv[2], blv[2];
#pragma unroll
        for (int n = 0; n < 2; ++n) { bgv[n] = bq[0][n]; blv[n] = bq[1][n]; }
#pragma unroll
        for (int ai = 0; ai < 2; ++ai)
#pragma unroll
            for (int m = 0; m < 4; ++m) { unsigned char* rowp = Ab + (size_t)(ai * HALF_ + m * 16) * D + voff;
                f32x4 o[2];
#pragma unroll
                for (int n = 0; n < 2; ++n) { const f32x4 c7 = (f32x4){7.f, 7.f, 7.f, 7.f};
                    const f32x4 gl = __builtin_elementwise_min(acc[ai][0][m][n] + bgv[n], c7), li = __builtin_elementwise_min(__builtin_elementwise_max(acc[ai][1][m][n] + blv[n], -c7), c7);
                    const f32x4 z = gl * (-1.702f * 1.4426950408889634f);
#pragma unroll
                    for (int j = 0; j < 4; j += 2) {
                        f32x2 d2 = (f32x2){__builtin_amdgcn_exp2f(z[j]), __builtin_amdgcn_exp2f(z[j + 1])} + 1.0f; asm("" : "+v"(d2));
                        f32x2 gd = (f32x2){gl[j], gl[j + 1]} * (f32x2){__builtin_amdgcn_rcpf(d2.x), __builtin_amdgcn_rcpf(d2.y)}; asm("" : "+v"(gd));
                        const f32x2 o2 = gd * (f32x2){li[j], li[j + 1]} + gd;
                        o[n][j] = o2.x; o[n][j + 1] = o2.y; } }
                u32x2 w; w.x = pk4_fp8(o[0][0], o[0][1], o[0][2], o[0][3]); w.y = pk4_fp8(o[1][0], o[1][1], o[1][2], o[1][3]);
                *(u32x2*)rowp = w; }
    }
};
struct EpiMoe2 {
    static constexpr bool PERM = true; static constexpr bool LDSBIAS = true; static constexpr int NSTORE = 16;
    unsigned char* Y; const float* b2;
    __device__ __forceinline__ void prefetch(const Unit& u, LAS float* slot, int lane) const {
        const float* src = b2 + (size_t)u.e * D + u.pn * 256 + lane * 4;
        __builtin_amdgcn_global_load_lds((const unsigned*)src, (LAS unsigned*)slot, 16, 0, 0); }
    __device__ __forceinline__ void operator()(const f32x4 (&acc)[2][2][4][2], const Unit& u, int wr, int wc, int fr, int fq, const f32x4 (&bq)[2][2]) const {
        unsigned char* const Yb = Y + ((size_t)u.rt * 256 * D + (size_t)u.pn * 256);
        unsigned voff = (unsigned)((wr * 64 + fr) * D + wc * 32 + 8 * fq); asm volatile("" : "+v"(voff));
        f32x4 bv[2][2];
#pragma unroll
        for (int bj = 0; bj < 2; ++bj)
#pragma unroll
            for (int n = 0; n < 2; ++n) bv[bj][n] = bq[bj][n];
#pragma unroll
        for (int ai = 0; ai < 2; ++ai)
#pragma unroll
            for (int m = 0; m < 4; ++m) { unsigned char* rowp = Yb + (size_t)(ai * HALF_ + m * 16) * D + voff;
#pragma unroll
                for (int bj = 0; bj < 2; ++bj) { f32x4 v0 = bv[bj][0] * 4.0f + acc[ai][bj][m][0], v1 = bv[bj][1] * 4.0f + acc[ai][bj][m][1];
#pragma unroll
                    for (int i = 0; i < 4; ++i) { v0[i] = __builtin_amdgcn_fmed3f(v0[i], -448.0f, 448.0f); v1[i] = __builtin_amdgcn_fmed3f(v1[i], -448.0f, 448.0f); }
                    *(u32x2*)(rowp + bj * HALF_) = (u32x2){pk4_fp8(v0[0], v0[1], v0[2], v0[3]), pk4_fp8(v1[0], v1[1], v1[2], v1[3])}; } }
    }
};
typedef unsigned char fp8_t;
constexpr int SCALE_ONE = 0x7f7f7f7f, SCALE_W = 0x79797979, SCALE_W4 = 0x7b7b7b7b;
struct ProbMoe1 {
    static constexpr bool FP8 = true;
    const fp8_t* FX; const fp8_t* W1T; const int* list; const LAS int* tpre; const LAS int* cnt; const LAS unsigned char* texp; LAS int* toks; int scale_w, scale_x; pg8::TileOrder ord;
    __device__ __forceinline__ int ldb_bytes() const { return D; }
    __device__ __forceinline__ int ntiles() const { return D / 128; }
    __device__ __forceinline__ bool next(int i, Unit& u) const {
        if (!ord.next(i, u.pm, u.pn)) return false;
        u.rt = u.pm; u.e = texp[u.rt]; return true;
    }
    __device__ __forceinline__ const char* a_ptr(const Unit&) const { return (const char*)FX; }
    __device__ __forceinline__ const char* b_ptr(const Unit& u) const { return (const char*)(W1T + ((size_t)u.e * 2048 + (size_t)u.pn * 256) * D); }
    __device__ __forceinline__ void list_prefetch(const Unit& u, int par, int wid, int lane) const {
        if (wid == 0) { const int* src = list + (size_t)u.e * NT + (u.rt - tpre[u.e]) * 256 + 4 * lane;
            __builtin_amdgcn_global_load_lds((const unsigned*)src, (LAS unsigned*)(toks + par * 256), 16, 0, 0); }
    }
    __device__ __forceinline__ void a_off(const Unit& u, int par, const int (&R)[2], const int (&C)[2], unsigned (&v)[2][2]) const {
        const int nvalid = cnt[u.e] - (u.rt - tpre[u.e]) * 256; const LAS int* tk = toks + par * 256;
#pragma unroll
        for (int h = 0; h < 2; ++h)
#pragma unroll
            for (int i = 0; i < 2; ++i) { const int r = h * 128 + R[i]; const int tok = tk[r < nvalid ? r : 0]; v[h][i] = (unsigned)(tok * D + C[i] * 2); }
    }
};
struct ProbMoe2 {
    static constexpr bool FP8 = true;
    const fp8_t* ACT; const fp8_t* W2T; const LAS int* tpre; const LAS unsigned char* texp; int scale_w, scale_x; pg8::TileOrder ord;
    __device__ __forceinline__ int ldb_bytes() const { return D; }
    __device__ __forceinline__ int ntiles() const { return D / 128; }
    __device__ __forceinline__ bool next(int i, Unit& u) const {
        if (!ord.next(i, u.pm, u.pn)) return false;
        u.rt = ord.nM - 1 - u.pm; u.e = texp[u.rt]; return true;
    }
    __device__ __forceinline__ const char* a_ptr(const Unit& u) const { return (const char*)(ACT + (size_t)u.rt * 256 * D); }
    __device__ __forceinline__ const char* b_ptr(const Unit& u) const { return (const char*)(W2T + ((size_t)u.e * 1024 + (size_t)u.pn * 256) * D); }
    __device__ __forceinline__ void list_prefetch(const Unit&, int, int, int) const {}
    __device__ __forceinline__ void a_off(const Unit&, int, const int (&R)[2], const int (&C)[2], unsigned (&v)[2][2]) const {
#pragma unroll
        for (int h = 0; h < 2; ++h)
#pragma unroll
            for (int i = 0; i < 2; ++i) v[h][i] = (unsigned)((h * 128 + R[i]) * D + C[i] * 2);
    }
};
struct Args { const float* in[38]; float* out; unsigned char* ws; int phase; int one; };
enum { I_X = 0, I_C, I_CTX, I_CCTX, I_ADAW, I_ADAB, I_NORMG, I_AWQKV, I_ABQKV, I_AWO, I_ABO, I_ASINK, I_PW, I_PB, I_PS,
       I_RMIX, I_RWRKV, I_RW0, I_RW1, I_RW2, I_RA0, I_RA1, I_RA2, I_RG1, I_RG2, I_RKK, I_RKA, I_RRK, I_RLNW, I_RLNB, I_RWO,
       I_MWR, I_MBR, I_MW1, I_MB1, I_MW2, I_MB2, I_FG };
struct Frame { LAS unsigned char* lds; int tid, lane, wave, G, c; unsigned char* ws; unsigned* ctl; };
#define WSP(T_, off) ((T_*)(F.ws + (off)))

struct TJob { const float* src; unsigned char* dst; long sbs, dbs; int ldw, ldt, nkb, nnb, mode, item0, per, esz; };
__device__ __forceinline__ int dst_row(int mode, int n) {
    if (mode == 1) { const int hb = n & ~63, d = n & 63; const int ax = d >> 5, dd = d & 31, hf = dd >> 4, f = dd & 15; const int g = ax * 4 + (f >> 2), i = (f & 3) + 4 * hf; return hb + 8 * g + i; }
    if (mode == 2) { return n < 1024 ? ((n >> 7) << 8) + (n & 127) : (((n - 1024) >> 7) << 8) + 128 + (n & 127); }
    return n;
}
struct TItem { const float* src; unsigned char* dst; int ldw, ldt, mode, n0, esz; };
__device__ __forceinline__ void titem_decode(const LAS TJob* jobs, int nj, int it, TItem& T) {
    int ji = 0;
    for (int q = 1; q < nj; ++q) ji += (jobs[q].item0 <= it) ? 1 : 0;
    const LAS TJob& J = jobs[ji]; const int r = it - J.item0, bi = r / J.per, rr = r % J.per, kb = rr / J.nnb, nb = rr % J.nnb;
    T.src = J.src + bi * J.sbs + (size_t)(64 * kb) * J.ldw + 32 * nb; T.dst = J.dst + (bi * J.dbs + 64 * kb) * J.esz; T.ldw = J.ldw; T.ldt = J.ldt; T.mode = J.mode; T.n0 = 32 * nb; T.esz = J.esz;
}
__device__ __forceinline__ void titem_load(const TItem& T, int lane, f32x4 (&v)[8]) {
    const float* p = T.src + (size_t)(lane >> 3) * T.ldw + 4 * (lane & 7);
#pragma unroll
    for (int i = 0; i < 8; ++i) v[i] = *(const __attribute__((address_space(1))) f32x4*)(p + (size_t)(8 * i) * T.ldw);
}
__device__ __forceinline__ void titem_store(const TItem& T, int lane, const f32x4 (&v)[8], LAS float* scr) {
#pragma unroll
    for (int i = 0; i < 8; ++i) { LAS float* d = scr + (8 * i + (lane >> 3)) * 33 + 4 * (lane & 7); d[0] = v[i].x; d[1] = v[i].y; d[2] = v[i].z; d[3] = v[i].w; }
    LDS_WAIT(); asm volatile("" ::: "memory");
    const int c = lane & 7;
#pragma unroll
    for (int j = 0; j < 4; ++j) { const int n = (lane >> 3) + 8 * j; const LAS float* s = scr + (8 * c) * 33 + n;
        const size_t eo = (size_t)dst_row(T.mode, T.n0 + n) * T.ldt + 8 * c;
        if (T.esz == 2) { u32x4 o; o.x = pk2(s[0 * 33], s[1 * 33]); o.y = pk2(s[2 * 33], s[3 * 33]); o.z = pk2(s[4 * 33], s[5 * 33]); o.w = pk2(s[6 * 33], s[7 * 33]); *(__attribute__((address_space(1))) u32x4*)(T.dst + eo * 2) = o; }
        else { u32x2 o; o.x = pk4_fp8(64.f * s[0 * 33], 64.f * s[1 * 33], 64.f * s[2 * 33], 64.f * s[3 * 33]); o.y = pk4_fp8(64.f * s[4 * 33], 64.f * s[5 * 33], 64.f * s[6 * 33], 64.f * s[7 * 33]); *(__attribute__((address_space(1))) u32x2*)(T.dst + eo) = o; } }
    LDS_WAIT(); asm volatile("" ::: "memory");
}
__device__ __forceinline__ void phase_prologue(Frame& F, const Args& A) {
    REFRESH(F);
    LAS float* S = (LAS float*)F.lds;
    for (int idx = F.tid; idx < 33 * 1024; idx += NTHREADS) { const int r = idx >> 10, k = idx & 1023; const float v = r < 32 ? A.in[I_C][r * 1024 + k] : A.in[I_CCTX][k]; S[k * 33 + r] = v / (1.0f + __expf(-v)); }
    __syncthreads();
    float* MOD = WSP(float, WS_MOD);
    for (int it = F.c; it < 4 * 48; it += F.G) {
        const int layer = it / 48, n = (it % 48) * 128 + F.lane; const float* wp = A.in[I_ADAW] + (size_t)layer * 1024 * 6144 + n;
        float acc[5] = {0.f, 0.f, 0.f, 0.f, 0.f}, acd[5] = {0.f, 0.f, 0.f, 0.f, 0.f};
        for (int k0 = 0; k0 < 1024; k0 += 16) {
            float wv[16], wd[16];
#pragma unroll
            for (int u = 0; u < 16; ++u) { wv[u] = wp[(size_t)(k0 + u) * 6144]; wd[u] = wp[(size_t)(k0 + u) * 6144 + 64]; }
#pragma unroll
            for (int u = 0; u < 16; ++u) { const LAS float* sr = S + (k0 + u) * 33 + F.wave; const float s0 = sr[0], s1 = sr[8], s2 = sr[16], s3 = sr[24];
                acc[0] += s0 * wv[u]; acc[1] += s1 * wv[u]; acc[2] += s2 * wv[u]; acc[3] += s3 * wv[u];
                acd[0] += s0 * wd[u]; acd[1] += s1 * wd[u]; acd[2] += s2 * wd[u]; acd[3] += s3 * wd[u];
                if (F.wave == 0) { const float s4 = S[(k0 + u) * 33 + 32]; acc[4] += s4 * wv[u]; acd[4] += s4 * wd[u]; } }
        }
        const float bb = A.in[I_ADAB][layer * 6144 + n], bd = A.in[I_ADAB][layer * 6144 + n + 64];
#pragma unroll
        for (int i = 0; i < 4; ++i) { MOD[((size_t)layer * 33 + F.wave + 8 * i) * 6144 + n] = acc[i] + bb; MOD[((size_t)layer * 33 + F.wave + 8 * i) * 6144 + n + 64] = acd[i] + bd; }
        if (F.wave == 0) { MOD[((size_t)layer * 33 + 32) * 6144 + n] = acc[4] + bb; MOD[((size_t)layer * 33 + 32) * 6144 + n + 64] = acd[4] + bd; }
    }
    { float* rc = WSP(float, WS_ROPEC); float* rs = WSP(float, WS_ROPES);
      for (int idx = F.c * NTHREADS + F.tid; idx < 2048 * 32; idx += F.G * NTHREADS) { const int t = idx >> 5, e = idx & 31, g = e >> 2, i = e & 3, f = 4 * (g & 3) + i;
          const float inv = powf(10000.0f, -(float)f / 16.0f); const float pos = (float)(g < 4 ? (t >> 6) : (t & 63)); const float ang = pos * inv; rc[idx] = cosf(ang); rs[idx] = sinf(ang); }
      float* bq = WSP(float, WS_BQK);
      for (int idx = F.c * NTHREADS + F.tid; idx < 2 * 1280; idx += F.G * NTHREADS) { const int j = idx / 1280, n = idx % 1280; bq[j * 1280 + dst_row(1, n)] = A.in[I_ABQKV][j * 1536 + n]; } }
    __syncthreads();
    LAS TJob* jobs = (LAS TJob*)(F.lds + JOB_OFF); LAS int* njobs = (LAS int*)(F.lds + MISC_OFF + 64);
    if (F.tid == 0) {
        int nj = 0, item = 0;
        auto add = [&](const float* src, bf16_t* dst, int ldw, int ldt, int Ks, int Ns, int mode, int nb, long sbs, long dbs, int esz = 2) {
            LAS TJob& j = jobs[nj]; j.src = src; j.dst = (unsigned char*)dst; j.sbs = sbs; j.dbs = dbs; j.ldw = ldw; j.ldt = ldt; j.nkb = Ks / 64; j.nnb = Ns / 32; j.mode = mode; j.item0 = item; j.per = (Ks / 64) * (Ns / 32); j.esz = esz;
            ++nj; item += (Ks / 64) * (Ns / 32) * nb; };
        add(A.in[I_AWQKV], WSP(bf16_t, WS_WQK), 1536, 1024, 1024, 1280, 1, 2, 1024L * 1536, 1280L * 1024, 1);
        add(A.in[I_AWQKV] + 1280, WSP(bf16_t, WS_WV), 1536, 1024, 1024, 256, 0, 2, 1024L * 1536, 256L * 1024, 1);
        add(A.in[I_AWO], WSP(bf16_t, WS_WO), 1024, 1024, 1024, 1024, 0, 2, 1L << 20, 1L << 20, 1);
        add(A.in[I_PW], WSP(bf16_t, WS_POOLW), 256, 256, 256, 256, 0, 4, 65536, 65536);
        add(A.in[I_RWRKV], WSP(bf16_t, WS_WRKV), 1024, 1024, 1024, 1024, 0, 3, 1L << 20, 1L << 20, 1);
        add(A.in[I_RG1], WSP(bf16_t, WS_WL1), 128, 1024, 1024, 128, 0, 1, 0, 0);
        add(A.in[I_RW1], WSP(bf16_t, WS_WL1) + 256 * 1024, 64, 1024, 1024, 64, 0, 2, 65536, 65536);
        add(A.in[I_RA1], WSP(bf16_t, WS_WL1) + 2 * 256 * 1024, 64, 1024, 1024, 64, 0, 2, 65536, 65536);
        add(A.in[I_RG2], WSP(bf16_t, WS_WL2), 1024, 256, 128, 1024, 0, 1, 0, 0);
        add(A.in[I_RW2], WSP(bf16_t, WS_WL2) + 1 * 1024 * 256, 1024, 256, 64, 1024, 0, 2, 65536, 1024L * 256 + 64);
        add(A.in[I_RA2], WSP(bf16_t, WS_WL2) + 3 * 1024 * 256, 1024, 256, 64, 1024, 0, 2, 65536, 1024L * 256 + 64);
        add(A.in[I_RWO], WSP(bf16_t, WS_WOR), 1024, 1024, 1024, 1024, 0, 1, 0, 0, 1);
        add(A.in[I_MW1], WSP(bf16_t, WS_W1T), 2048, 1024, 1024, 2048, 2, 128, 1024L * 2048, 2048L * 1024, 1);
        add(A.in[I_MW2], WSP(bf16_t, WS_W2T), 1024, 1024, 1024, 1024, 0, 128, 1L << 20, 1L << 20, 1);
        njobs[0] = nj; njobs[1] = item;
    }
    __syncthreads();
    { const int nj = njobs[0], nitems = njobs[1]; LAS float* scr = (LAS float*)(F.lds + F.wave * 16384);
      const int gw = F.c * NWAVES + F.wave, NGW = F.G * NWAVES;
      int it = gw;
      if (it < nitems) {
          TItem Ta, Tb, Tc; f32x4 va[8], vb[8], vc[8];
          bool hb = it + NGW < nitems;
          titem_decode(jobs, nj, it, Ta); titem_load(Ta, F.lane, va);
          Tb = Ta; Tc = Ta;
#pragma unroll
          for (int i = 0; i < 8; ++i) { vb[i] = va[i]; vc[i] = va[i]; }
          if (hb) { titem_decode(jobs, nj, it + NGW, Tb); titem_load(Tb, F.lane, vb); }
          for (;;) {
              const int itc = it + 2 * NGW; const bool hc = hb && itc < nitems;
              if (hc) { titem_decode(jobs, nj, itc, Tc); titem_load(Tc, F.lane, vc); }
              titem_store(Ta, F.lane, va, scr);
              if (!hb) break;
              Ta = Tb; Tb = Tc;
#pragma unroll
              for (int i = 0; i < 8; ++i) { va[i] = vb[i]; vb[i] = vc[i]; }
              hb = hc; it += NGW;
          }
      } }
    __syncthreads();
}

__device__ __forceinline__ void moe_tiles(Frame& F, int layer) {
    REFRESH(F);
    LAS int* lcnt = (LAS int*)(F.lds + LCNT_OFF); LAS int* tpre = (LAS int*)(F.lds + TPRE_OFF);
    __syncthreads();
    if (F.tid < NE) lcnt[F.tid] = (int)__hip_atomic_load(F.ctl + CW_GCNT + layer * 64 + F.tid, __ATOMIC_RELAXED, __HIP_MEMORY_SCOPE_AGENT);
    __syncthreads();
    if (F.tid == 0) { int s = 0; for (int e = 0; e < NE; ++e) { tpre[e] = s; s += (lcnt[e] + 255) >> 8; } tpre[NE] = s; }
    __syncthreads();
    { LAS unsigned char* texp = (LAS unsigned char*)(F.lds + TEXP_OFF); const int nrt = tpre[NE];
      for (int rt = F.tid; rt < nrt; rt += NTHREADS) { int e = 0; for (int j = 1; j < NE; ++j) e += (tpre[j] <= rt) ? 1 : 0; texp[rt] = (unsigned char)e; } }
    __syncthreads();
}
constexpr int RB = 2;
#define ROWOF(it, r) ((((it) * F.G + F.c) * NWAVES + F.wave) * RB + (r))
struct MoeRef { int p[4]; float g[4]; };
__device__ __forceinline__ void moe_ref_load(Frame& F, int row, MoeRef& R) {
    const int4 pp = *(const int4*)(WSP(int, WS_POS) + (size_t)row * 4); const f32x4 gg = *(const f32x4*)(WSP(float, WS_GATE) + (size_t)row * 4);
    R.p[0] = pp.x; R.p[1] = pp.y; R.p[2] = pp.z; R.p[3] = pp.w; R.g[0] = gg.x; R.g[1] = gg.y; R.g[2] = gg.z; R.g[3] = gg.w;
}
__device__ __forceinline__ void moe_rows_load(Frame& F, const MoeRef& R, unsigned (&y)[4][4]) {
    const LAS int* tpre = (const LAS int*)(F.lds + TPRE_OFF); const unsigned char* Y = WSP(unsigned char, WS_Y);
#pragma unroll
    for (int k = 0; k < 4; ++k) { const int e = R.p[k] >> 20, slot = R.p[k] & 0xfffff; const size_t fr = (size_t)tpre[e] * 256 + slot; const unsigned* yp = (const unsigned*)(Y + fr * D) + F.lane;
#pragma unroll
        for (int j = 0; j < 4; ++j) y[k][j] = yp[64 * j]; }
}
__device__ __forceinline__ f32x4 moe_rows_sum(const MoeRef& R, const unsigned (&y)[4][4], int j) {
    f32x4 s = (f32x4){0.f, 0.f, 0.f, 0.f};
#pragma unroll
    for (int k = 0; k < 4; ++k) { const int w = (int)y[k][j]; const f32x2 lo = __builtin_amdgcn_cvt_pk_f32_fp8(w, false), hi = __builtin_amdgcn_cvt_pk_f32_fp8(w, true);
        s += (R.g[k] * 0.25f) * (f32x4){lo.x, lo.y, hi.x, hi.y}; }
    return s;
}

__device__ __forceinline__ void phase_norm1(Frame& F, const Args& A, int layer) {
    REFRESH(F);
    if (layer > 0) moe_tiles(F, layer - 1);
    bf16_t* H = WSP(bf16_t, WS_H); bf16_t* AX = WSP(bf16_t, WS_AX); const float* MOD = WSP(float, WS_MOD);
    const float* g1 = A.in[I_NORMG] + (size_t)(layer * 2 + 0) * D;
    f32x4 gg[4];
#pragma unroll
    for (int j = 0; j < 4; ++j) gg[j] = ((const f32x4*)g1)[64 * j + F.lane];
    for (int it = 0;; ++it) { if (ROWOF(it, 0) >= NT) break;
        f32x4 v[RB][4]; int brow[RB];
        if (layer == 0) {
#pragma unroll
            for (int r = 0; r < RB; ++r) { const int row = ROWOF(it, r); brow[r] = row < NX ? (row >> 11) : 32; const float* src = row < NX ? A.in[I_X] + (size_t)row * D : A.in[I_CTX] + (size_t)(row - NX) * D;
#pragma unroll
                for (int j = 0; j < 4; ++j) v[r][j] = ((const f32x4*)src)[64 * j + F.lane]; }
        } else {
            MoeRef R[RB]; unsigned y[RB][4][4]; f32x4 gv[RB][4];
#pragma unroll
            for (int r = 0; r < RB; ++r) moe_ref_load(F, ROWOF(it, r), R[r]);
#pragma unroll
            for (int r = 0; r < RB; ++r) { const int row = ROWOF(it, r); brow[r] = row < NX ? (row >> 11) : 32; moe_rows_load(F, R[r], y[r]);
                const float* g2p = MOD + ((size_t)(layer - 1) * 33 + brow[r]) * 6144 + 5 * D;
#pragma unroll
                for (int j = 0; j < 4; ++j) { v[r][j] = ld_bf4(H + (size_t)row * D + 256 * j + 4 * F.lane); gv[r][j] = ((const f32x4*)g2p)[64 * j + F.lane]; } }
#pragma unroll
            for (int r = 0; r < RB; ++r)
#pragma unroll
                for (int j = 0; j < 4; ++j) v[r][j] = v[r][j] + gv[r][j] * moe_rows_sum(R[r], y[r], j);
        }
        float rstd[RB];
#pragma unroll
        for (int r = 0; r < RB; ++r) { const int row = ROWOF(it, r); float ss = 0.f;
#pragma unroll
            for (int j = 0; j < 4; ++j) { st_bf4(H + (size_t)row * D + 256 * j + 4 * F.lane, v[r][j]); ss += (v[r][j].x * v[r][j].x + v[r][j].y * v[r][j].y) + (v[r][j].z * v[r][j].z + v[r][j].w * v[r][j].w); }
            rstd[r] = 1.0f / sqrtf(wave_sum(ss) * (1.0f / D) + 1e-5f); }
#pragma unroll
        for (int r = 0; r < RB; ++r) { const int row = ROWOF(it, r); const float* mp = MOD + ((size_t)layer * 33 + brow[r]) * 6144;
#pragma unroll
            for (int j = 0; j < 4; ++j) { const f32x4 sh = ((const f32x4*)mp)[64 * j + F.lane], sc = ((const f32x4*)(mp + D))[64 * j + F.lane];
                const f32x4 o = v[r][j] * rstd[r] * gg[j] * (sc + 1.0f) + sh;
                if (layer % 3 == 0) ((unsigned*)((unsigned char*)AX + (size_t)row * D))[64 * j + F.lane] = pk4_fp8(o.x, o.y, o.z, o.w);
                else { u32x2 w; w.x = pk2(o.x, o.y); w.y = pk2(o.z, o.w); ((u32x2*)(AX + (size_t)row * D))[64 * j + F.lane] = w; } } }
    }
}
__device__ __forceinline__ void phase_final(Frame& F, const Args& A) {
    REFRESH(F);
    moe_tiles(F, DEPTH - 1);
    const bf16_t* H = WSP(bf16_t, WS_H); const float* MOD = WSP(float, WS_MOD); const float* fg = A.in[I_FG];
    f32x4 gg[4];
#pragma unroll
    for (int j = 0; j < 4; ++j) gg[j] = ((const f32x4*)fg)[64 * j + F.lane];
    for (int it = 0;; ++it) { if (ROWOF(it, 0) >= NX) break;
        MoeRef R[RB]; unsigned y[RB][4][4]; f32x4 v[RB][4], gv[RB][4];
#pragma unroll
        for (int r = 0; r < RB; ++r) moe_ref_load(F, ROWOF(it, r), R[r]);
#pragma unroll
        for (int r = 0; r < RB; ++r) { const int row = ROWOF(it, r); moe_rows_load(F, R[r], y[r]); const float* g2p = MOD + ((size_t)(DEPTH - 1) * 33 + (row >> 11)) * 6144 + 5 * D;
#pragma unroll
            for (int j = 0; j < 4; ++j) { v[r][j] = ld_bf4(H + (size_t)row * D + 256 * j + 4 * F.lane); gv[r][j] = ((const f32x4*)g2p)[64 * j + F.lane]; } }
#pragma unroll
        for (int r = 0; r < RB; ++r) { const int row = ROWOF(it, r); float ss = 0.f;
#pragma unroll
            for (int j = 0; j < 4; ++j) { v[r][j] = v[r][j] + gv[r][j] * moe_rows_sum(R[r], y[r], j); ss += (v[r][j].x * v[r][j].x + v[r][j].y * v[r][j].y) + (v[r][j].z * v[r][j].z + v[r][j].w * v[r][j].w); }
            const float rstd = 1.0f / sqrtf(wave_sum(ss) * (1.0f / D) + 1e-5f);
#pragma unroll
            for (int j = 0; j < 4; ++j) ((f32x4*)(A.out + (size_t)row * D))[64 * j + F.lane] = v[r][j] * rstd * gg[j]; }
    }
}

template <int DD> __device__ __forceinline__ float dpp_ror(float v) { return __builtin_bit_cast(float, __builtin_amdgcn_update_dpp(0, __builtin_bit_cast(int, v), 0x120 + DD, 0xf, 0xf, false)); }
template <int DD> __device__ __forceinline__ void rank_step(float v0, float v1, int e0, int& r0, int& r1) {
    const float u0 = dpp_ror<DD>(v0), u1 = dpp_ror<DD>(v1); const bool low = DD <= e0;
    r0 += (u0 > v0 || (u0 == v0 && low)) ? 1 : 0; r0 += (u1 > v0) ? 1 : 0;
    r1 += (u0 >= v1) ? 1 : 0; r1 += (u1 > v1 || (u1 == v1 && low)) ? 1 : 0;
}
__device__ __forceinline__ float row_allmax(float v) { v = fmaxf(v, dpp_ror<8>(v)); v = fmaxf(v, dpp_ror<4>(v)); v = fmaxf(v, dpp_ror<2>(v)); v = fmaxf(v, dpp_ror<1>(v)); return v; }
__device__ __forceinline__ float row_allsum(float v) { v += dpp_ror<8>(v); v += dpp_ror<4>(v); v += dpp_ror<2>(v); v += dpp_ror<1>(v); return v; }
__device__ __forceinline__ void phase_route(Frame& F, const Args& A, int layer) {
    REFRESH(F);
    const int nrows = (layer == DEPTH - 1) ? NX : NT; const int TPB = nrows / 16 / F.G;
    LAS float* wT = (LAS float*)F.lds;
    LAS int* lcnt = (LAS int*)(F.lds + LCNT_OFF); LAS int* lbase = (LAS int*)(F.lds + LBASE_OFF);
    LAS unsigned* recp = (LAS unsigned*)(F.lds + REC_OFF); LAS float* recg = (LAS float*)(F.lds + REC_OFF + 4608);
    __syncthreads();
    { const float* wr = A.in[I_MWR] + (size_t)layer * D * NE;
      for (int idx = F.tid; idx < D * NE; idx += NTHREADS) wT[(idx & 31) * 1024 + (idx >> 5)] = wr[idx]; }
    if (F.tid < NE) lcnt[F.tid] = 0;
    __syncthreads();
    const bf16_t* H = WSP(bf16_t, WS_H); unsigned char* FX = WSP(unsigned char, WS_FX); const float* MOD = WSP(float, WS_MOD);
    const float* g2 = A.in[I_NORMG] + (size_t)(layer * 2 + 1) * D; const float* br = A.in[I_MBR] + layer * NE;
    const int l = F.lane, r16 = l & 15, q4 = l >> 4; const float b0 = br[r16], b1 = br[16 + r16];
    for (int k = F.wave; k < TPB; k += NWAVES) {
        const int row0 = (F.c * TPB + k) * 16, row = row0 + r16; const int brow = row0 < NX ? (row0 >> 11) : 32;
        const float* mp = MOD + ((size_t)layer * 33 + brow) * 6144 + 3 * D;
        const bf16_t* hp = H + (size_t)row * D + 8 * q4; float ss = 0.f;
#pragma unroll 8
        for (int j = 0; j < 32; ++j) { const u32x4 w = *(const u32x4*)(hp + 32 * j); const float a0 = bflo(w.x), a1 = bfhi(w.x), a2 = bflo(w.y), a3 = bfhi(w.y), a4 = bflo(w.z), a5 = bfhi(w.z), a6 = bflo(w.w), a7 = bfhi(w.w);
            ss += ((a0 * a0 + a1 * a1) + (a2 * a2 + a3 * a3)) + ((a4 * a4 + a5 * a5) + (a6 * a6 + a7 * a7)); }
        ss += __shfl_xor(ss, 16); ss += __shfl_xor(ss, 32);
        const float rstd = 1.0f / sqrtf(ss * (1.0f / D) + 1e-5f);
        f32x4 acc0 = (f32x4){0.f, 0.f, 0.f, 0.f}, acc1 = acc0;
        const float* gp = g2 + 8 * q4; const float* shp = mp + 8 * q4; const float* scp = mp + D + 8 * q4; unsigned char* fxp = FX + (size_t)row * D + 8 * q4;
        const LAS float* w0p = wT + r16 * 1024 + 8 * q4; const LAS float* w1p = wT + (16 + r16) * 1024 + 8 * q4;
#pragma unroll 2
        for (int j = 0; j < 32; ++j) { const u32x4 w = *(const u32x4*)(hp + 32 * j);
            const f32x4 ga = *(const f32x4*)(gp + 32 * j), gb = *(const f32x4*)(gp + 32 * j + 4), sa = *(const f32x4*)(shp + 32 * j), sb = *(const f32x4*)(shp + 32 * j + 4), ca = *(const f32x4*)(scp + 32 * j), cb = *(const f32x4*)(scp + 32 * j + 4);
            const f32x4 fa = (f32x4){bflo(w.x), bfhi(w.x), bflo(w.y), bfhi(w.y)} * rstd * ga * (ca + 1.0f) + sa, fb = (f32x4){bflo(w.z), bfhi(w.z), bflo(w.w), bfhi(w.w)} * rstd * gb * (cb + 1.0f) + sb;
            *(u32x2*)(fxp + 32 * j) = (u32x2){pk4_fp8(fa.x, fa.y, fa.z, fa.w), pk4_fp8(fb.x, fb.y, fb.z, fb.w)};
            const f32x4 w0a = *(const LAS f32x4*)(w0p + 32 * j), w0b = *(const LAS f32x4*)(w0p + 32 * j + 4), w1a = *(const LAS f32x4*)(w1p + 32 * j), w1b = *(const LAS f32x4*)(w1p + 32 * j + 4);
#pragma unroll
            for (int s4 = 0; s4 < 4; ++s4) { acc0 = __builtin_amdgcn_mfma_f32_16x16x4f32(fa[s4], w0a[s4], acc0, 0, 0, 0); acc1 = __builtin_amdgcn_mfma_f32_16x16x4f32(fa[s4], w1a[s4], acc1, 0, 0, 0); }
#pragma unroll
            for (int s4 = 0; s4 < 4; ++s4) { acc0 = __builtin_amdgcn_mfma_f32_16x16x4f32(fb[s4], w0b[s4], acc0, 0, 0, 0); acc1 = __builtin_amdgcn_mfma_f32_16x16x4f32(fb[s4], w1b[s4], acc1, 0, 0, 0); } }
#pragma unroll
        for (int reg = 0; reg < 4; ++reg) {
            const float v0 = acc0[reg] + b0, v1 = acc1[reg] + b1; int r0 = (v1 > v0) ? 1 : 0, r1 = (v0 >= v1) ? 1 : 0;
            rank_step<1>(v0, v1, r16, r0, r1); rank_step<2>(v0, v1, r16, r0, r1); rank_step<3>(v0, v1, r16, r0, r1); rank_step<4>(v0, v1, r16, r0, r1); rank_step<5>(v0, v1, r16, r0, r1);
            rank_step<6>(v0, v1, r16, r0, r1); rank_step<7>(v0, v1, r16, r0, r1); rank_step<8>(v0, v1, r16, r0, r1); rank_step<9>(v0, v1, r16, r0, r1); rank_step<10>(v0, v1, r16, r0, r1);
            rank_step<11>(v0, v1, r16, r0, r1); rank_step<12>(v0, v1, r16, r0, r1); rank_step<13>(v0, v1, r16, r0, r1); rank_step<14>(v0, v1, r16, r0, r1); rank_step<15>(v0, v1, r16, r0, r1);
            const float mx = row_allmax(fmaxf(v0, v1));
            const float x0 = r0 < 4 ? __expf(v0 - mx) : 0.f, x1 = r1 < 4 ? __expf(v1 - mx) : 0.f;
            const float inv = 1.0f / row_allsum(x0 + x1);
            const int lr = k * 16 + 4 * q4 + reg;
            if (r0 < 4) { const int rk = __hip_atomic_fetch_add(lcnt + r16, 1, __ATOMIC_RELAXED, __HIP_MEMORY_SCOPE_WORKGROUP); recp[lr * 4 + r0] = ((unsigned)r16 << 20) | (unsigned)rk; recg[lr * 4 + r0] = x0 * inv; }
            if (r1 < 4) { const int rk = __hip_atomic_fetch_add(lcnt + 16 + r16, 1, __ATOMIC_RELAXED, __HIP_MEMORY_SCOPE_WORKGROUP); recp[lr * 4 + r1] = ((unsigned)(16 + r16) << 20) | (unsigned)rk; recg[lr * 4 + r1] = x1 * inv; }
        }
    }
    __syncthreads();
    if (F.tid < NE) lbase[F.tid] = (int)__hip_atomic_fetch_add(F.ctl + CW_GCNT + layer * 64 + F.tid, (unsigned)lcnt[F.tid], __ATOMIC_RELAXED, __HIP_MEMORY_SCOPE_AGENT);
    __syncthreads();
    int* LIST = WSP(int, WS_LIST); int* POS = WSP(int, WS_POS); float* GATE = WSP(float, WS_GATE);
    for (int r = F.tid; r < TPB * 16 * 4; r += NTHREADS) { const int lr = r >> 2, kk = r & 3; const int row = F.c * TPB * 16 + lr;
        const unsigned qx = recp[r]; const float qg = recg[r]; const int e = qx >> 20, slot = lbase[e] + (int)(qx & 0xfffff);
        LIST[(size_t)e * NT + slot] = row; POS[(size_t)row * 4 + kk] = (e << 20) | slot; GATE[(size_t)row * 4 + kk] = qg; }
    __syncthreads();
}

__device__ __forceinline__ void phase_pooldiff(Frame& F) {
    REFRESH(F);
    const bf16_t* AX = WSP(bf16_t, WS_AX); bf16_t* PD = WSP(bf16_t, WS_PD);
    for (int it = 0;; ++it) { if (ROWOF(it, 0) >= NT) break;
        const int row0 = ROWOF(it, 0); int sb, t, n; seq_of(row0, sb, t, n);
#pragma unroll
        for (int j = 0; j < 4; ++j) { const int half = 1 << j; const int col = 256 * j + 4 * F.lane;
            f32x4 s0 = (f32x4){0.f, 0.f, 0.f, 0.f}, s1 = s0, me0 = s0, me1 = s0;
#pragma unroll
            for (int q = 0; q < 2 * half + 1; ++q) { const int uu = t - half + q;
                if (uu >= 0 && uu < n) { const f32x4 x = ld_bf4(AX + (size_t)(sb + uu) * D + col); if (q < 2 * half) s0 += x; if (q > 0) s1 += x; if (q == half) me0 = x; if (q == half + 1) me1 = x; } }
            const int lo0 = t - half < 0 ? 0 : t - half, hi0 = t + half > n ? n : t + half, lo1 = t + 1 - half < 0 ? 0 : t + 1 - half, hi1 = t + 1 + half > n ? n : t + 1 + half;
            st_bf4(PD + (size_t)row0 * D + col, s0 * (1.0f / (float)(hi0 - lo0)) - me0);
            st_bf4(PD + (size_t)(row0 + 1) * D + col, s1 * (1.0f / (float)(hi1 - lo1)) - me1); }
    }
}
__device__ __forceinline__ void phase_rwkv_mix(Frame& F, const Args& A) {
    REFRESH(F);
    const bf16_t* AX = WSP(bf16_t, WS_AX); bf16_t* A6 = WSP(bf16_t, WS_A6); const float* mix = A.in[I_RMIX];
    for (int it = 0;; ++it) { if (ROWOF(it, 0) >= NT) break;
        const int row0 = ROWOF(it, 0); int sb, t, n; seq_of(row0, sb, t, n);
#pragma unroll
        for (int j = 0; j < 4; ++j) { const int col = 256 * j + 4 * F.lane; const f32x4 z = (f32x4){0.f, 0.f, 0.f, 0.f};
            const f32x4 h0 = ld_bf4(AX + (size_t)row0 * D + col), h1 = ld_bf4(AX + (size_t)(row0 + 1) * D + col);
            const f32x4 hp = t > 0 ? ld_bf4(AX + (size_t)(row0 - 1) * D + col) : z, hn = t + 1 < n - 1 ? ld_bf4(AX + (size_t)(row0 + 2) * D + col) : z;
            const f32x4 xx0 = (hp + h1) * 0.5f - h0, xx1 = (h0 + hn) * 0.5f - h1;
#pragma unroll
            for (int i = 0; i < 6; ++i) { const f32x4 m = *(const f32x4*)(mix + i * D + col); const f32x4 o0 = h0 + xx0 * m, o1 = h1 + xx1 * m;
                if (i == 0 || i == 2 || i == 3) { unsigned char* p8 = (unsigned char*)(A6 + (size_t)i * NT * D);
                    *(unsigned*)(p8 + (size_t)row0 * D + col) = pk4_fp8(o0.x, o0.y, o0.z, o0.w); *(unsigned*)(p8 + (size_t)(row0 + 1) * D + col) = pk4_fp8(o1.x, o1.y, o1.z, o1.w); }
                else { st_bf4(A6 + ((size_t)i * NT + row0) * D + col, o0); st_bf4(A6 + ((size_t)i * NT + row0 + 1) * D + col, o1); } } }
    }
}
__device__ __forceinline__ float rl(float x, int k) { return __builtin_bit_cast(float, __builtin_amdgcn_readlane(__builtin_bit_cast(int, x), k)); }
typedef float f32x16 __attribute__((ext_vector_type(16)));
constexpr int SCW = 33792;
__device__ __forceinline__ int kpos(int k) { return (k & ~12) | ((k & 4) << 1) | ((k & 8) >> 1); }
__device__ __forceinline__ bf16x8 acc_frag(const f32x16& X, int s2) {
    u32x4 w; w.x = cvt_pk_bf16(X[8 * s2 + 0], X[8 * s2 + 1]); w.y = cvt_pk_bf16(X[8 * s2 + 2], X[8 * s2 + 3]); w.z = cvt_pk_bf16(X[8 * s2 + 4], X[8 * s2 + 5]); w.w = cvt_pk_bf16(X[8 * s2 + 6], X[8 * s2 + 7]);
    return __builtin_bit_cast(bf16x8, w);
}
#define MFMA32(a, b, c) __builtin_amdgcn_mfma_f32_32x32x16_bf16(a, b, c, 0, 0, 0)
__device__ __forceinline__ void phase_rwkv_scan(Frame& F, const Args& A) {
    REFRESH(F);
    volatile LAS int* psync = (volatile LAS int*)(F.lds + MISC_OFF + 128);
    if (F.tid < 8) psync[F.tid] = 0;
    __syncthreads();
    int pphase = 0;
#define PAIR_SYNC() do { asm volatile("s_waitcnt lgkmcnt(0)" ::: "memory"); ++pphase; psync[pr * 2 + hw] = pphase; \
        for (unsigned sp_ = 0; psync[pr * 2 + (hw ^ 1)] < pphase && sp_ < (1u << 24); ++sp_) __builtin_amdgcn_s_sleep(1); asm volatile("" ::: "memory"); } while (0)
    const int pr = F.wave >> 1, hw = F.wave & 1;
    for (int item = pr * F.G + F.c; item < 1024; item += 4 * F.G) {
        const int dir = item >> 9, b = (item >> 4) & 31, hd = item & 15, col = 64 * hd + F.lane;
        const int l = F.lane, r32 = l & 31, hh = l >> 5;
        const bf16_t* Rr = WSP(bf16_t, WS_RKV); const bf16_t* Kk = Rr + (size_t)NT * D; const bf16_t* Vv = Kk + (size_t)NT * D;
        const bf16_t* Ee = WSP(bf16_t, WS_E) + (size_t)dir * NT * D; const bf16_t* Aa = WSP(bf16_t, WS_A) + (size_t)dir * NT * D;
        bf16_t* Yo = WSP(bf16_t, WS_YS) + (size_t)dir * NT * D; float* Bo = WSP(float, WS_BONUS) + (size_t)dir * NT * 16;
        const float kkw = A.in[I_RKK][col], kaw = A.in[I_RKA][col], rkw = A.in[I_RRK][col];
        LAS unsigned char* RA = F.lds + pr * SCW; LAS unsigned char* RB = RA + 16384; LAS unsigned char* RV = RA + 25600;
        LAS float* cCb = (LAS float*)(F.lds + REC_OFF + pr * 256);
        LAS bf16_t* XT = (LAS bf16_t*)RA;
        LAS bf16_t* BK = (LAS bf16_t*)(RA + 8192);
        const int kp = kpos(l), vb = hw;
        f32x16 ST[2];
#pragma unroll
        for (int i = 0; i < 2; ++i)
#pragma unroll
            for (int q = 0; q < 16; ++q) ST[i][q] = 0.f;
        for (int seg = 0; seg < 2; ++seg) {
            const int base = seg ? b * T : NX + b * L, n = seg ? T : L; const int dt = dir ? -1 : 1; const int t0 = dir ? n - 1 : 0;
            for (int bt = 0; bt < n; bt += 32) {
                float cprev = 1.0f;
                if (hw) {
                    bf16_t e16[16];
#pragma unroll
                    for (int s = 0; s < 16; ++s) e16[s] = Ee[(size_t)(base + t0 + dt * (bt + s)) * D + col];
                    float es = 0.f;
#pragma unroll
                    for (int s = 0; s < 16; ++s) es += bf1(e16[s]);
                    cprev = __expf(-es); }
#pragma unroll
                for (int g4i = 0; g4i < 4; ++g4i) { const int g8 = 4 * hw + g4i;
                    bf16_t raw[4][5];
#pragma unroll
                    for (int s8 = 0; s8 < 4; ++s8) { const size_t o = (size_t)(base + t0 + dt * (bt + g8 * 4 + s8)) * D + col; raw[s8][0] = Rr[o]; raw[s8][1] = Kk[o]; raw[s8][2] = Vv[o]; raw[s8][3] = Aa[o]; raw[s8][4] = Ee[o]; }
                    float rr[4], kraw[4], aa[4], kk[4], kd[4], n2[4], bn[4], ww[4]; unsigned bq2[2] = {0u, 0u}, kq2[2] = {0u, 0u};
#pragma unroll
                    for (int s8 = 0; s8 < 4; ++s8) { rr[s8] = bf1(raw[s8][0]); kraw[s8] = bf1(raw[s8][1]); aa[s8] = bf1(raw[s8][3]); ww[s8] = __expf(-bf1(raw[s8][4]));
                        kk[s8] = kraw[s8] * kkw; n2[s8] = kk[s8] * kk[s8]; kd[s8] = kraw[s8] * (1.0f + (aa[s8] - 1.0f) * kaw); bn[s8] = rr[s8] * kd[s8] * rkw; }
#pragma unroll
                    for (int s8 = 0; s8 < 4; ++s8) { n2[s8] = wave_sum(n2[s8]); bn[s8] = wave_sum(bn[s8]); }
#pragma unroll
                    for (int s8 = 0; s8 < 4; ++s8) { const int t = g8 * 4 + s8;
                        if (l == 0) Bo[(size_t)(base + t0 + dt * (bt + t)) * 16 + hd] = bn[s8];
                        const float kn = kk[s8] * __builtin_amdgcn_rsqf(fmaxf(n2[s8], 1e-24f)); const float c = cprev * ww[s8]; const float ic = __builtin_amdgcn_rcpf(c);
                        const float at = -kn * cprev, rt = rr[s8] * c, bq = kn * aa[s8] * ic, kq = kd[s8] * ic;
                        const unsigned w0 = cvt_pk_bf16(at, rt), w1 = cvt_pk_bf16(bq, kq);
                        XT[t * 64 + kp] = (bf16_t)(w0 & 0xffffu); XT[(32 + t) * 64 + kp] = (bf16_t)(w0 >> 16);
                        BK[t * 64 + kp] = (bf16_t)(w1 & 0xffffu); BK[(32 + t) * 64 + kp] = (bf16_t)(w1 >> 16);
                        if (s8 & 1) { bq2[s8 >> 1] |= (w1 & 0xffffu) << 16; kq2[s8 >> 1] |= (w1 & 0xffff0000u); } else { bq2[s8 >> 1] = w1 & 0xffffu; kq2[s8 >> 1] = w1 >> 16; }
                        cprev = c; }
                    const int gp = (g8 & ~3) | ((g8 & 1) << 1) | ((g8 & 2) >> 1);
                    *(LAS u32x2*)(RB + l * 144 + gp * 8) = (u32x2){bq2[0], bq2[1]}; *(LAS u32x2*)(RB + l * 144 + 64 + gp * 8) = (u32x2){kq2[0], kq2[1]};
                    *(LAS u32x2*)(RV + l * 80 + gp * 8) = (u32x2){(unsigned)raw[0][2] | ((unsigned)raw[1][2] << 16), (unsigned)raw[2][2] | ((unsigned)raw[3][2] << 16)};
                }
                if (hw) cCb[l] = cprev;
                PAIR_SYNC();
                unsigned pf0 = 0u, pf1 = 0u;
                if (bt + 32 < n) { const size_t po = (size_t)(base + t0 + dt * (bt + 32 + 16 * hw + (l & 15))) * D + 64 * hd; const int ps = l >> 4;
                    const bf16_t* sp = ps == 0 ? Rr : ps == 1 ? Kk : ps == 2 ? Vv : Aa;
                    pf0 = *(const unsigned*)(sp + po); if (l < 16) pf1 = *(const unsigned*)(Ee + po); }
                f32x16 Mp, Np, X;
                { bf16x8 XTf[4], BKf[2][4];
#pragma unroll
                  for (int s4 = 0; s4 < 4; ++s4) { XTf[s4] = *(const LAS bf16x8*)(XT + r32 * 64 + 16 * s4 + 8 * hh); BKf[0][s4] = *(const LAS bf16x8*)(BK + r32 * 64 + 16 * s4 + 8 * hh); BKf[1][s4] = *(const LAS bf16x8*)(BK + (32 + r32) * 64 + 16 * s4 + 8 * hh); }
                  bf16x8 MkaF[2];
                  { f32x16 Tm;
#pragma unroll
                    for (int q = 0; q < 16; ++q) Tm[q] = 0.f;
#pragma unroll
                    for (int s4 = 0; s4 < 4; ++s4) Tm = MFMA32(BKf[1][s4], XTf[s4], Tm);
#pragma unroll
                    for (int q = 0; q < 16; ++q) { const int row = (q & 3) + 8 * (q >> 2) + 4 * hh; Tm[q] = row < r32 ? Tm[q] : 0.f; }
                    MkaF[0] = acc_frag(Tm, 0); MkaF[1] = acc_frag(Tm, 1); }
#pragma unroll
                  for (int q = 0; q < 16; ++q) { Mp[q] = 0.f; Np[q] = 0.f; X[q] = 0.f; }
#pragma unroll
                  for (int s4 = 0; s4 < 4; ++s4) { Mp = MFMA32(BKf[0][s4], XTf[s4], Mp); Np = MFMA32(XTf[s4], BKf[0][s4], Np); }
#pragma unroll
                  for (int q = 0; q < 16; ++q) { const int row = (q & 3) + 8 * (q >> 2) + 4 * hh; Mp[q] = row < r32 ? Mp[q] : 0.f; Np[q] = r32 < row ? Np[q] : 0.f; }
#pragma unroll
                  for (int kb = 0; kb < 2; ++kb)
#pragma unroll
                      for (int s2 = 0; s2 < 2; ++s2) X = MFMA32(XTf[2 * kb + s2], acc_frag(ST[kb], s2), X);
#pragma unroll
                  for (int s2 = 0; s2 < 2; ++s2) { const bf16x8 Vf = *(const LAS bf16x8*)(RV + (32 * vb + r32) * 80 + (16 * s2 + 8 * hh) * 2); X = MFMA32(MkaF[s2], Vf, X); } }
                __builtin_amdgcn_sched_barrier(0);
#pragma unroll
                for (int lvl = 0; lvl < 5; ++lvl) {
                    bf16x8 Ma[2], Na[2];
#pragma unroll
                    for (int s2 = 0; s2 < 2; ++s2) { Ma[s2] = acc_frag(Mp, s2); Na[s2] = acc_frag(Np, s2); }
                    { const bf16x8 x0 = acc_frag(X, 0), x1 = acc_frag(X, 1); X = MFMA32(Ma[0], x0, X); X = MFMA32(Ma[1], x1, X); }
                    if (lvl < 4) { f32x16 M2, N2;
#pragma unroll
                        for (int q = 0; q < 16; ++q) { M2[q] = 0.f; N2[q] = 0.f; }
                        M2 = MFMA32(Na[0], Ma[0], M2); M2 = MFMA32(Na[1], Ma[1], M2);
                        N2 = MFMA32(Ma[0], Na[0], N2); N2 = MFMA32(Ma[1], Na[1], N2);
                        Mp = M2; Np = N2; }
                }
                __builtin_amdgcn_sched_barrier(0);
                { bf16x8 XRf[4], MbrF[2], MkrF[2];
#pragma unroll
                  for (int s4 = 0; s4 < 4; ++s4) XRf[s4] = *(const LAS bf16x8*)(XT + (32 + r32) * 64 + 16 * s4 + 8 * hh);
                  { f32x16 Tm, Tn;
#pragma unroll
                    for (int q = 0; q < 16; ++q) { Tm[q] = 0.f; Tn[q] = 0.f; }
#pragma unroll
                    for (int s4 = 0; s4 < 4; ++s4) { const bf16x8 Bb = *(const LAS bf16x8*)(BK + r32 * 64 + 16 * s4 + 8 * hh), Bk = *(const LAS bf16x8*)(BK + (32 + r32) * 64 + 16 * s4 + 8 * hh);
                        Tm = MFMA32(Bb, XRf[s4], Tm); Tn = MFMA32(Bk, XRf[s4], Tn); }
#pragma unroll
                    for (int q = 0; q < 16; ++q) { const int row = (q & 3) + 8 * (q >> 2) + 4 * hh; Tm[q] = row <= r32 ? Tm[q] : 0.f; Tn[q] = row <= r32 ? Tn[q] : 0.f; }
                    MbrF[0] = acc_frag(Tm, 0); MbrF[1] = acc_frag(Tm, 1); MkrF[0] = acc_frag(Tn, 0); MkrF[1] = acc_frag(Tn, 1); }
                  { const bf16x8 u0 = acc_frag(X, 0), u1 = acc_frag(X, 1);
                    const bf16x8 Vf0 = *(const LAS bf16x8*)(RV + (32 * vb + r32) * 80 + (8 * hh) * 2), Vf1 = *(const LAS bf16x8*)(RV + (32 * vb + r32) * 80 + (16 + 8 * hh) * 2);
                    f32x16 Yt;
#pragma unroll
                    for (int q = 0; q < 16; ++q) Yt[q] = 0.f;
#pragma unroll
                    for (int kb = 0; kb < 2; ++kb)
#pragma unroll
                        for (int s2 = 0; s2 < 2; ++s2) Yt = MFMA32(XRf[2 * kb + s2], acc_frag(ST[kb], s2), Yt);
                    Yt = MFMA32(MkrF[0], Vf0, Yt); Yt = MFMA32(MkrF[1], Vf1, Yt);
                    Yt = MFMA32(MbrF[0], u0, Yt); Yt = MFMA32(MbrF[1], u1, Yt);
#pragma unroll
                    for (int q = 0; q < 16; ++q) { const int t = (q & 3) + 8 * (q >> 2) + 4 * hh; Yo[(size_t)(base + t0 + dt * (bt + t)) * D + 64 * hd + 32 * vb + r32] = (bf16_t)f2bf(Yt[q]); }
#pragma unroll
                    for (int kb = 0; kb < 2; ++kb) {
                        const bf16x8 b0 = *(const LAS bf16x8*)(RB + (32 * kb + r32) * 144 + (8 * hh) * 2), b1 = *(const LAS bf16x8*)(RB + (32 * kb + r32) * 144 + (16 + 8 * hh) * 2);
                        const bf16x8 k0 = *(const LAS bf16x8*)(RB + (32 * kb + r32) * 144 + 64 + (8 * hh) * 2), k1 = *(const LAS bf16x8*)(RB + (32 * kb + r32) * 144 + 64 + (16 + 8 * hh) * 2);
                        ST[kb] = MFMA32(b0, u0, ST[kb]); ST[kb] = MFMA32(b1, u1, ST[kb]);
                        ST[kb] = MFMA32(k0, Vf0, ST[kb]); ST[kb] = MFMA32(k1, Vf1, ST[kb]); }
                  } }
                __builtin_amdgcn_sched_barrier(0);
#pragma unroll
                for (int kb = 0; kb < 2; ++kb)
#pragma unroll
                    for (int g4 = 0; g4 < 4; ++g4) { const f32x4 cc = *(const LAS f32x4*)(cCb + 32 * kb + 8 * g4 + 4 * hh);
                        ST[kb][4 * g4 + 0] *= cc.x; ST[kb][4 * g4 + 1] *= cc.y; ST[kb][4 * g4 + 2] *= cc.z; ST[kb][4 * g4 + 3] *= cc.w; }
                asm volatile("" :: "v"(pf0), "v"(pf1));
                PAIR_SYNC();
            }
        }
    }
    __syncthreads();
}
#undef PAIR_SYNC
#undef MFMA32
__device__ __forceinline__ void phase_rwkv_out(Frame& F, const Args& A, int nrows) {
    REFRESH(F);
    const bf16_t* Y0 = WSP(bf16_t, WS_YS); const bf16_t* Y1 = Y0 + (size_t)NT * D; const float* B0 = WSP(float, WS_BONUS); const float* B1 = B0 + (size_t)NT * 16;
    const bf16_t* Vv = WSP(bf16_t, WS_RKV) + (size_t)2 * NT * D; const bf16_t* Gg = WSP(bf16_t, WS_G); bf16_t* RO = WSP(bf16_t, WS_RO);
    const float* lnw = A.in[I_RLNW]; const float* lnb = A.in[I_RLNB];
    for (int it = 0;; ++it) { if (ROWOF(it, 0) >= nrows) break;
        f32x4 y[RB][4], vv[RB][4], gg[RB][4]; float bon[RB][4];
#pragma unroll
        for (int r = 0; r < RB; ++r) { const int row = ROWOF(it, r);
#pragma unroll
            for (int j = 0; j < 4; ++j) { const int col = 256 * j + 4 * F.lane, head = 4 * j + (F.lane >> 4); const size_t o = (size_t)row * D + col;
                y[r][j] = ld_bf4(Y0 + o) + ld_bf4(Y1 + o); vv[r][j] = ld_bf4(Vv + o); gg[r][j] = ld_bf4(Gg + o); bon[r][j] = B0[(size_t)row * 16 + head] + B1[(size_t)row * 16 + head]; } }
#pragma unroll
        for (int r = 0; r < RB; ++r) { const int row = ROWOF(it, r);
#pragma unroll
            for (int j = 0; j < 4; ++j) { const int col = 256 * j + 4 * F.lane; const size_t o = (size_t)row * D + col; const f32x4 yy = y[r][j];
                const float s = row16_sum((yy.x + yy.y) + (yy.z + yy.w));
                const f32x4 d = yy - s * (1.0f / 64.0f);
                const float q = row16_sum((d.x * d.x + d.y * d.y) + (d.z * d.z + d.w * d.w));
                const float rs = 1.0f / sqrtf(q * (1.0f / 64.0f) + 64e-5f);
                const f32x4 yn = d * rs * *(const f32x4*)(lnw + col) + *(const f32x4*)(lnb + col);
                { const f32x4 ov = (yn + vv[r][j] * bon[r][j]) * gg[r][j]; *(unsigned*)((unsigned char*)RO + o) = pk4_fp8(ov.x, ov.y, ov.z, ov.w); } } }
    }
}

__device__ __forceinline__ void phase_attn(Frame& F, const Args& A, int j, bool need_ctx) {
    REFRESH(F);
    const bf16_t* Q = WSP(bf16_t, WS_Q); const bf16_t* Kb = WSP(bf16_t, WS_K); const bf16_t* VT = WSP(bf16_t, WS_VT); bf16_t* O = WSP(bf16_t, WS_O);
    const float* sinks = A.in[I_ASINK] + j * 16;
    LAS bf16_t* Ks = (LAS bf16_t*)F.lds; LAS bf16_t* Vs = (LAS bf16_t*)(F.lds + 9216);
    LAS bf16x8* Qs = (LAS bf16x8*)(F.lds + 18432 + F.wave * 8192) + F.lane;
    const int nunits = 2048 + (need_ctx ? 256 : 0);
    const int fr = F.lane & 15, fq = F.lane >> 4, g = F.wave >> 1, hf = F.wave & 1;
    const float SC = 0.125f * 1.4426950408889634f;
    const int lr = F.tid >> 3, lch = F.tid & 7;
    __syncthreads();
    for (int u = F.c; u < nunits; u += F.G) {
        int b, kvh, qb; bool isx;
        if (u < 2048) { isx = true; b = u >> 6; kvh = (u >> 4) & 3; qb = u & 15; } else { const int v = u - 2048; isx = false; b = v >> 3; kvh = (v >> 1) & 3; qb = v & 1; }
        const int qrow0 = (isx ? b * T : NX + b * L) + qb * 128 + hf * 64; const int head = 4 * kvh + g;
        int jlo = 0, jhi = -1;
        if (isx) { jlo = qb == 0 ? 2 : 0; jhi = qb == 15 ? 3 : 5; }
        const int ntiles = 4 + (jhi - jlo + 1);
        auto tile_row0 = [&](int ti) -> int { return ti < 4 ? NX + b * L + ti * 64 : b * T + qb * 128 - 128 + 64 * (jlo + ti - 4); };
        u32x4 kv_n, vv_n;
        { const int kr0 = tile_row0(0); kv_n = *(const u32x4*)(Kb + (size_t)(kr0 + lr) * 256 + kvh * 64 + lch * 8); vv_n = *(const u32x4*)(VT + (size_t)(kvh * 64 + lr) * NT + kr0 + lch * 8); }
#pragma unroll
        for (int mq = 0; mq < 4; ++mq)
#pragma unroll
            for (int ks = 0; ks < 2; ++ks) Qs[64 * (mq * 2 + ks)] = *(const bf16x8*)(Q + (size_t)(qrow0 + 16 * mq + fr) * D + head * 64 + ks * 32 + 8 * fq);
        const float sink2 = sinks[head] * 1.4426950408889634f;
        float mrun[4], lrun[4]; f32x4 Oa[4][4];
#pragma unroll
        for (int mq = 0; mq < 4; ++mq) { mrun[mq] = sink2; lrun[mq] = fq == 0 ? 1.0f : 0.0f;
#pragma unroll
            for (int db = 0; db < 4; ++db) Oa[mq][db] = (f32x4){0.f, 0.f, 0.f, 0.f}; }
        for (int ti = 0; ti < ntiles; ++ti) {
            const int jl = ti < 4 ? -1 : jlo + ti - 4; const int ks0 = qb * 128 - 128 + 64 * jl;
            __syncthreads();
            *(LAS u32x4*)(Ks + lr * 72 + lch * 8) = kv_n; *(LAS u32x4*)(Vs + lr * 72 + lch * 8) = vv_n;
            __syncthreads();
            if (ti + 1 < ntiles) { const int kr0 = tile_row0(ti + 1); kv_n = *(const u32x4*)(Kb + (size_t)(kr0 + lr) * 256 + kvh * 64 + lch * 8); vv_n = *(const u32x4*)(VT + (size_t)(kvh * 64 + lr) * NT + kr0 + lch * 8); }
            const bool need = (jl < 0) || (jl >= hf && jl <= hf + 4);
            if (need) {
                const bool domask = (jl >= 0) && (jl == hf || jl == hf + 4);
                f32x4 Sa[4][4];
#pragma unroll
                for (int mq = 0; mq < 4; ++mq)
#pragma unroll
                    for (int n = 0; n < 4; ++n) Sa[mq][n] = (f32x4){0.f, 0.f, 0.f, 0.f};
#pragma unroll
                for (int ks = 0; ks < 2; ++ks) {
                    bf16x8 Qf[4];
#pragma unroll
                    for (int mq = 0; mq < 4; ++mq) Qf[mq] = Qs[64 * (mq * 2 + ks)];
#pragma unroll
                    for (int n = 0; n < 4; ++n) { const int kr = 32 * (n >> 1) + 8 * (fr >> 2) + 4 * (n & 1) + (fr & 3);
                        const bf16x8 Kf = *(const LAS bf16x8*)(Ks + kr * 72 + ks * 32 + 8 * fq);
#pragma unroll
                        for (int mq = 0; mq < 4; ++mq) Sa[mq][n] = __builtin_amdgcn_mfma_f32_16x16x32_bf16(Kf, Qf[mq], Sa[mq][n], 0, 0, 0); } }
                bf16x8 Pf[4][2];
#pragma unroll
                for (int mq = 0; mq < 4; ++mq) {
                    float mx = -1e30f;
                    if (domask) { const int tq = qb * 128 + hf * 64 + 16 * mq + fr;
#pragma unroll
                        for (int n = 0; n < 4; ++n)
#pragma unroll
                            for (int i = 0; i < 4; ++i) { float sv = Sa[mq][n][i]; const int rel = ks0 + 32 * (n >> 1) + 8 * fq + 4 * (n & 1) + i - tq; if (rel > 128 || rel < -128) sv = -1e30f; Sa[mq][n][i] = sv; mx = fmaxf(mx, sv); } }
                    else {
#pragma unroll
                        for (int n = 0; n < 4; ++n)
#pragma unroll
                            for (int i = 0; i < 4; ++i) mx = fmaxf(mx, Sa[mq][n][i]); }
                    mx = fmaxf(mx, __shfl_xor(mx, 16)); mx = fmaxf(mx, __shfl_xor(mx, 32));
                    const float mnew = fmaxf(mrun[mq], mx * SC); const float alpha = __builtin_amdgcn_exp2f(mrun[mq] - mnew); mrun[mq] = mnew;
                    float rs = 0.f; const float nm = -mnew;
#pragma unroll
                    for (int n = 0; n < 4; ++n) { const f32x4 tt = Sa[mq][n] * SC + nm;
#pragma unroll
                        for (int i = 0; i < 4; ++i) { const float p = __builtin_amdgcn_exp2f(tt[i]); Sa[mq][n][i] = p; rs += p; } }
                    lrun[mq] = lrun[mq] * alpha + rs;
#pragma unroll
                    for (int db = 0; db < 4; ++db) Oa[mq][db] *= alpha;
#pragma unroll
                    for (int s2 = 0; s2 < 2; ++s2) { u32x4 w; w.x = cvt_pk_bf16(Sa[mq][2 * s2][0], Sa[mq][2 * s2][1]); w.y = cvt_pk_bf16(Sa[mq][2 * s2][2], Sa[mq][2 * s2][3]);
                        w.z = cvt_pk_bf16(Sa[mq][2 * s2 + 1][0], Sa[mq][2 * s2 + 1][1]); w.w = cvt_pk_bf16(Sa[mq][2 * s2 + 1][2], Sa[mq][2 * s2 + 1][3]); Pf[mq][s2] = __builtin_bit_cast(bf16x8, w); }
                }
#pragma unroll
                for (int db = 0; db < 4; ++db)
#pragma unroll
                    for (int s2 = 0; s2 < 2; ++s2) { const bf16x8 Vf = *(const LAS bf16x8*)(Vs + (16 * db + fr) * 72 + 32 * s2 + 8 * fq);
#pragma unroll
                        for (int mq = 0; mq < 4; ++mq) Oa[mq][db] = __builtin_amdgcn_mfma_f32_16x16x32_bf16(Vf, Pf[mq][s2], Oa[mq][db], 0, 0, 0); }
            }
        }
#pragma unroll
        for (int mq = 0; mq < 4; ++mq) { float l = lrun[mq]; l += __shfl_xor(l, 16); l += __shfl_xor(l, 32); const float inv = 1.0f / l;
            unsigned char* op = (unsigned char*)O + (size_t)(qrow0 + 16 * mq + fr) * D + head * 64 + 4 * fq;
#pragma unroll
            for (int db = 0; db < 4; ++db) { const f32x4 o = Oa[mq][db] * inv; *(unsigned*)(op + 16 * db) = pk4_fp8(o.x, o.y, o.z, o.w); } }
    }
    __syncthreads();
}

struct KState { XcdBarrier bar; int ph; };
#define RUN() (A.one || A.phase == KS.ph)
#define SEAM() do { if (A.one) xcd_barrier(KS.bar); ++KS.ph; } while (0)
template <int LAYER>
__device__ __forceinline__ void layer_body(Frame& F, const Args& A, KState& KS) {
    constexpr int layer = LAYER, kind = LAYER % 3, j = LAYER / 3; constexpr bool last = (LAYER == DEPTH - 1);
    LAS unsigned char* ring = F.lds;
    const LAS int* tpre = (const LAS int*)(F.lds + TPRE_OFF); const LAS int* lcnt = (const LAS int*)(F.lds + LCNT_OFF);
    bf16_t* H = WSP(bf16_t, WS_H); const float* MOD = WSP(float, WS_MOD); const bf16_t* AX = WSP(bf16_t, WS_AX);
    const float* gate1 = MOD + (size_t)layer * 33 * 6144 + 2 * D;
    constexpr int nMall = last ? NX / 256 : NT / 256;
    if (RUN()) phase_norm1(F, A, layer);
    SEAM();
    if constexpr (kind == 0) {
        if (RUN()) {
            { pg8::ProbDense8 P; P.A = (const unsigned char*)AX; P.Bt = WSP(unsigned char, WS_WQK) + (size_t)j * 1280 * D; P.lda = D; P.ldb = D; P.K = D; P.scale_w = SCALE_W; P.scale_x = SCALE_ONE; P.ord.init(NT / 256, 5, F.G, F.c);
              EpiQK E{WSP(bf16_t, WS_Q), WSP(bf16_t, WS_K), WSP(float, WS_BQK) + j * 1280, WSP(float, WS_ROPEC), WSP(float, WS_ROPES)};
              pg8::gemm_phase(ring, P, E); }
            { pg8::ProbDense8 P; P.A = WSP(unsigned char, WS_WV) + (size_t)j * 256 * D; P.Bt = (const unsigned char*)AX; P.lda = D; P.ldb = D; P.K = D; P.scale_w = SCALE_ONE; P.scale_x = SCALE_W; P.ord.init(1, NT / 256, F.G, (F.c + 96) % F.G);
              EpiVT E{WSP(bf16_t, WS_VT), A.in[I_ABQKV] + j * 1536 + 1280};
              pg8::gemm_phase(ring, P, E); }
        }
        SEAM();
        if (RUN()) phase_attn(F, A, j, !last);
        SEAM();
        if (RUN()) { pg8::ProbDense8 P; P.A = WSP(unsigned char, WS_O); P.Bt = WSP(unsigned char, WS_WO) + (size_t)j * D * D; P.lda = D; P.ldb = D; P.K = D; P.scale_w = SCALE_W; P.scale_x = SCALE_ONE; P.ord.init(nMall, 4, F.G, F.c);
            EpiResid E{H, A.in[I_ABO] + j * D, nullptr, gate1};
            pg8::gemm_phase(ring, P, E); }
        SEAM();
    } else if constexpr (kind == 1) {
        if (RUN()) phase_pooldiff(F);
        SEAM();
        if (RUN()) { pg8::ProbDense P; P.A = WSP(bf16_t, WS_PD); P.Bt = WSP(bf16_t, WS_POOLW); P.lda = D; P.ldb = 256; P.K = 256; P.a_pn_off = 256; P.ord.init(nMall, 4, F.G, F.c);
            EpiResid E{H, A.in[I_PB], A.in[I_PS], gate1};
            pg8::gemm_phase(ring, P, E); }
        SEAM();
    } else {
        if (RUN()) phase_rwkv_mix(F, A);
        SEAM();
        if (RUN()) {
            for (int i = 0; i < 3; ++i) { const int sel = i == 0 ? 0 : i == 1 ? 2 : 3;
                pg8::ProbDense8 P; P.A = (const unsigned char*)(WSP(bf16_t, WS_A6) + (size_t)sel * NT * D); P.Bt = WSP(unsigned char, WS_WRKV) + (size_t)i * D * D; P.lda = D; P.ldb = D; P.K = D; P.scale_w = SCALE_W; P.scale_x = SCALE_ONE; P.ord.init(NT / 256, 4, F.G, (F.c + (i == 1 ? 128 : 0)) % F.G);
                EpiBf16Act E{WSP(bf16_t, WS_RKV) + (size_t)i * NT * D, D, nullptr, 0, 1.0f};
                pg8::gemm_phase(ring, P, E); }
            for (int i = 0; i < 3; ++i) { const int sel = i == 0 ? 5 : i == 1 ? 1 : 4;
                pg8::ProbDense P; P.A = WSP(bf16_t, WS_A6) + (size_t)sel * NT * D; P.Bt = WSP(bf16_t, WS_WL1) + (size_t)i * 256 * D; P.lda = D; P.ldb = D; P.K = D; P.a_pn_off = 0; P.ord.init(NT / 256, 1, F.G, (F.c + 128 - 32 * i) % F.G);
                EpiBf16Act E{WSP(bf16_t, WS_LORA) + i * 256, 768, nullptr, i == 0 ? 1 : i == 1 ? 2 : 0, 1.0f};
                pg8::gemm_phase(ring, P, E); }
        }
        SEAM();
        if (RUN()) {
            for (int i = 0; i < 5; ++i) {
                const int ablk = i == 0 ? 0 : i < 3 ? 1 : 2, d = (i - 1) & 1;
                pg8::ProbDense P; P.A = WSP(bf16_t, WS_LORA) + ablk * 256; P.Bt = WSP(bf16_t, WS_WL2) + (size_t)i * D * 256; P.lda = 768; P.ldb = 256; { int k128 = 128; asm volatile("" : "+s"(k128)); P.K = k128; }     P.a_pn_off = 0; P.ord.init(NT / 256, 4, F.G, (F.c + 128 * (i & 1)) % F.G);
                EpiBf16Act E; E.ldc = D;
                if (i == 0) { E.O = WSP(bf16_t, WS_G); E.bias = nullptr; E.act = 0; E.scale = 1.0f; }
                else if (i < 3) { E.O = WSP(bf16_t, WS_E) + (size_t)d * NT * D; E.bias = A.in[I_RW0] + d * D; E.act = 1; E.scale = 0.6065306597126334f; }
                else { E.O = WSP(bf16_t, WS_A) + (size_t)d * NT * D; E.bias = A.in[I_RA0] + d * D; E.act = 1; E.scale = 1.0f; }
                pg8::gemm_phase(ring, P, E); }
        }
        SEAM();
        if (RUN()) phase_rwkv_scan(F, A);
        SEAM();
        if (RUN()) phase_rwkv_out(F, A, last ? NX : NT);
        SEAM();
        if (RUN()) { pg8::ProbDense8 P; P.A = WSP(unsigned char, WS_RO); P.Bt = WSP(unsigned char, WS_WOR); P.lda = D; P.ldb = D; P.K = D; P.scale_w = SCALE_W; P.scale_x = SCALE_ONE; P.ord.init(nMall, 4, F.G, F.c);
            EpiResid E{H, nullptr, nullptr, gate1};
            pg8::gemm_phase(ring, P, E); }
        SEAM();
    }
    if (RUN()) phase_route(F, A, layer);
    SEAM();
    if (RUN()) { moe_tiles(F, layer);
        ProbMoe1 P; P.FX = WSP(fp8_t, WS_FX); P.W1T = WSP(fp8_t, WS_W1T) + (size_t)layer * NE * 2048 * D; P.list = WSP(int, WS_LIST); P.tpre = tpre; P.cnt = lcnt; P.texp = (const LAS unsigned char*)(F.lds + TEXP_OFF); P.toks = (LAS int*)(F.lds + TOKS_OFF); P.scale_w = SCALE_W; P.scale_x = SCALE_ONE; P.ord.init(tpre[NE], 8, F.G, F.c);
        EpiMoe1 E{WSP(unsigned char, WS_ACT), A.in[I_MB1] + (size_t)layer * NE * 2048};
        pg8::gemm_phase(ring, P, E); }
    SEAM();
    if (RUN()) { moe_tiles(F, layer);
        ProbMoe2 P; P.ACT = WSP(fp8_t, WS_ACT); P.W2T = WSP(fp8_t, WS_W2T) + (size_t)layer * NE * D * D; P.tpre = tpre; P.texp = (const LAS unsigned char*)(F.lds + TEXP_OFF); P.scale_w = SCALE_W4; P.scale_x = SCALE_ONE; P.ord.init(tpre[NE], 4, F.G, F.c);
        EpiMoe2 E{WSP(unsigned char, WS_Y), A.in[I_MB2] + (size_t)layer * NE * D};
        pg8::gemm_phase(ring, P, E); }
    SEAM();
}
__global__ void __launch_bounds__(NTHREADS, 2) trunk_fwd(Args A) {
    extern __shared__ __attribute__((aligned(16))) unsigned char lds_[];
    Frame F; F.lds = (LAS unsigned char*)lds_; REFRESH(F); F.wave = __builtin_amdgcn_readfirstlane(F.tid >> 6);
    F.G = gridDim.x; F.c = blockIdx.x; F.ws = A.ws; F.ctl = (unsigned*)(A.ws + WS_CTL);
    for (int u = F.tid; u < (LDS_BYTES - LDSCTL_OFF) / 4; u += NTHREADS) ((LAS unsigned*)(F.lds + LDSCTL_OFF))[u] = 0u;
    __syncthreads();
    KState KS; KS.bar.bar = F.ctl + CW_BAR; KS.bar.x = 0; KS.bar.st = nullptr; KS.ph = 0;
    if (A.one) KS.bar = xcd_barrier_post(F.ctl + CW_BAR, (volatile LAS unsigned*)(F.lds + MISC_OFF) + 8);
    if (RUN()) phase_prologue(F, A);
    SEAM();
    layer_body<0>(F, A, KS);
    layer_body<1>(F, A, KS);
    layer_body<2>(F, A, KS);
    layer_body<3>(F, A, KS);
    if (RUN()) phase_final(F, A);
}
#undef RUN
#undef SEAM
static int count_phases() { int n = 1; for (int layer = 0; layer < DEPTH; ++layer) { const int kind = layer % 3; n += 1 + (kind == 0 ? 3 : kind == 1 ? 2 : 6) + 3; } return n + 1; }

extern "C" void kernel_launch(void* const* d_in, const int* in_sizes, int n_in, void* d_out, int out_size, void* d_ws, size_t ws_size, hipStream_t stream) {
    static int grid = 0;
    if (grid == 0) {
        if (n_in != 38 || out_size != NX * D || ws_size < WS_END) { fprintf(stderr, "kernel_launch: unexpected problem (n_in %d, out %d, ws %zu < %zu)\n", n_in, out_size, ws_size, (size_t)WS_END); grid = -1; return; }
        int dev = 0, cus = 0;
        if (hipGetDevice(&dev) != hipSuccess || hipDeviceGetAttribute(&cus, hipDeviceAttributeMultiprocessorCount, dev) != hipSuccess) { grid = -1; return; }
        if (hipFuncSetAttribute((const void*)trunk_fwd, hipFuncAttributeMaxDynamicSharedMemorySize, LDS_BYTES) != hipSuccess) { fprintf(stderr, "kernel_launch: hipFuncSetAttribute failed\n"); grid = -1; return; }
        int per_cu = 0;
        if (hipOccupancyMaxActiveBlocksPerMultiprocessor(&per_cu, (const void*)trunk_fwd, NTHREADS, LDS_BYTES) != hipSuccess || per_cu < 1) fprintf(stderr, "kernel_launch: occupancy query says %d\n", per_cu);
        (void)hipGetLastError();
        grid = cus;
        if (grid != 256) fprintf(stderr, "kernel_launch: %d CUs (built for 256)\n", grid);
    }
    if (grid < 0) return;
    (void)hipMemsetAsync((char*)d_ws + WS_CTL, 0, CTL_BYTES, stream);
    (void)hipMemsetAsync((char*)d_ws + WS_LZERO, 0, LZERO_BYTES, stream);
    Args a{};
    for (int i = 0; i < 38; ++i) a.in[i] = (const float*)d_in[i];
    a.out = (float*)d_out; a.ws = (unsigned char*)d_ws;
#if MK_ONE_LAUNCH
    a.phase = 0; a.one = 1;
    hipLaunchKernelGGL(trunk_fwd, dim3(grid), dim3(NTHREADS), LDS_BYTES, stream, a);
#else
    const int nph = count_phases();
    for (int p = 0; p < nph; ++p) { a.phase = p; a.one = 0; hipLaunchKernelGGL(trunk_fwd, dim3(grid), dim3(NTHREADS), LDS_BYTES, stream, a); }
#endif
}
```

```cpp
#include <hip/hip_runtime.h>
#include <cstdio>
#include <cstdint>

#ifndef MK_ONE_LAUNCH
#define MK_ONE_LAUNCH 1
#endif
#define LAS __attribute__((address_space(3)))
#define GAS __attribute__((address_space(1)))
typedef unsigned short bf16_t;
typedef short bf16x8 __attribute__((ext_vector_type(8)));
typedef float f32x4 __attribute__((ext_vector_type(4)));
typedef float f32x2 __attribute__((ext_vector_type(2)));
typedef unsigned u32x4 __attribute__((ext_vector_type(4)));
typedef unsigned u32x2 __attribute__((ext_vector_type(2)));

constexpr int D = 1024, NB = 32, T = 2048, L = 256, DEPTH = 4;
constexpr int NX = NB * T, NC = NB * L, NT = NX + NC;
constexpr int NE = 32, TOPK = 4;
constexpr int NWAVES = 8, NTHREADS = 512;
constexpr int MAXRT = NT * TOPK / 256 + NE;

constexpr size_t MiB = 1u << 20;
constexpr size_t WS_CTL = 0, CTL_BYTES = 128 * 1024;
constexpr size_t WS_MOD = 4 * MiB;
constexpr size_t WS_ROPEC = 8 * MiB, WS_ROPES = 8 * MiB + 512 * 1024;
constexpr size_t WS_BQK = 9 * MiB;
constexpr size_t WS_WQK = 10 * MiB;
constexpr size_t WS_WV = 15 * MiB;
constexpr size_t WS_WO = 16 * MiB;
constexpr size_t WS_POOLW = 20 * MiB;
constexpr size_t WS_WRKV = 21 * MiB;
constexpr size_t WS_WOR = 27 * MiB;
constexpr size_t WS_WL1 = 30 * MiB;
constexpr size_t WS_WL2 = 32 * MiB;
constexpr size_t WS_LZERO = WS_WL1, LZERO_BYTES = 6 * MiB;
constexpr size_t WS_W1T = 40 * MiB;
constexpr size_t WS_W2T = 552 * MiB;
constexpr size_t WS_H = 808 * MiB;
constexpr size_t WS_AX = 1096 * MiB;
constexpr size_t WS_FX = 1240 * MiB;
constexpr size_t WS_R = 1384 * MiB;
constexpr size_t WS_ACT = WS_R;
constexpr size_t WS_Y = WS_R + 592 * MiB;
constexpr size_t WS_LIST = WS_R + 1184 * MiB;
constexpr size_t WS_POS = WS_R + 1193 * MiB;
constexpr size_t WS_GATE = WS_R + 1195 * MiB;
constexpr size_t WS_Q = WS_R;
constexpr size_t WS_K = WS_R + 144 * MiB;
constexpr size_t WS_VT = WS_R + 180 * MiB;
constexpr size_t WS_O = WS_R + 216 * MiB;
constexpr size_t WS_PD = WS_R;
constexpr size_t WS_A6 = WS_R;
constexpr size_t WS_E = WS_R;
constexpr size_t WS_A = WS_R + 288 * MiB;
constexpr size_t WS_RO = WS_R + 576 * MiB;
constexpr size_t WS_RKV = WS_R + 864 * MiB;
constexpr size_t WS_LORA = WS_R + 1296 * MiB;
constexpr size_t WS_G = WS_R + 1404 * MiB;
constexpr size_t WS_YS = WS_R + 1548 * MiB;
constexpr size_t WS_BONUS = WS_R + 2124 * MiB;
constexpr size_t WS_END = WS_R + 2134 * MiB;

constexpr int CW_BAR = 4096;
constexpr int CW_GCNT = 16384;
constexpr int LDS_BYTES = 147456;
constexpr int RING_BYTES = 131072;
constexpr int LDSCTL_OFF = 135168;
constexpr int MISC_OFF = LDSCTL_OFF;
constexpr int TPRE_OFF = LDSCTL_OFF + 256;
constexpr int LCNT_OFF = LDSCTL_OFF + 512;
constexpr int LBASE_OFF = LDSCTL_OFF + 768;
constexpr int REC_OFF = LDSCTL_OFF + 1024;
constexpr int TEXP_OFF = LDSCTL_OFF + 1024 + 2048;
constexpr int TOKS_OFF = LDSCTL_OFF + 1024 + 4096;
constexpr int BIAS_OFF = LDSCTL_OFF + 1024 + 6144;
constexpr int JOB_OFF = LDSCTL_OFF + 1024;

__device__ __forceinline__ unsigned f2bf(float f) { unsigned u = __builtin_bit_cast(unsigned, f); return (u + 0x7fffu + ((u >> 16) & 1u)) >> 16; }
__device__ __forceinline__ unsigned pk2(float lo, float hi) { return f2bf(lo) | (f2bf(hi) << 16); }
__device__ __forceinline__ float bflo(unsigned w) { return __builtin_bit_cast(float, w << 16); }
__device__ __forceinline__ float bfhi(unsigned w) { return __builtin_bit_cast(float, w & 0xffff0000u); }
__device__ __forceinline__ float bf1(bf16_t b) { return __builtin_bit_cast(float, ((unsigned)b) << 16); }
__device__ __forceinline__ unsigned pk4_fp8(float a, float b, float c, float d) {
    int w = __builtin_amdgcn_cvt_pk_fp8_f32(a, b, __builtin_bit_cast(int, a), false); w = __builtin_amdgcn_cvt_pk_fp8_f32(c, d, w, true); return (unsigned)w; }
typedef __bf16 bf16x2_t __attribute__((ext_vector_type(2)));
__device__ __forceinline__ unsigned cvt_pk_bf16(float lo, float hi) { const f32x2 v = {lo, hi}; return __builtin_bit_cast(unsigned, __builtin_convertvector(v, bf16x2_t)); }
__device__ __forceinline__ float dpp_add(float v, const int ctrl, const int row_mask) {
    switch (ctrl) {
    case 0xB1:  return v + __builtin_bit_cast(float, __builtin_amdgcn_update_dpp(0, __builtin_bit_cast(int, v), 0xB1, 0xf, 0xf, true));
    case 0x4E:  return v + __builtin_bit_cast(float, __builtin_amdgcn_update_dpp(0, __builtin_bit_cast(int, v), 0x4E, 0xf, 0xf, true));
    case 0x141: return v + __builtin_bit_cast(float, __builtin_amdgcn_update_dpp(0, __builtin_bit_cast(int, v), 0x141, 0xf, 0xf, true));
    case 0x140: return v + __builtin_bit_cast(float, __builtin_amdgcn_update_dpp(0, __builtin_bit_cast(int, v), 0x140, 0xf, 0xf, true));
    case 0x142: return v + __builtin_bit_cast(float, __builtin_amdgcn_update_dpp(0, __builtin_bit_cast(int, v), 0x142, 0xa, 0xf, true));
    default:    return v + __builtin_bit_cast(float, __builtin_amdgcn_update_dpp(0, __builtin_bit_cast(int, v), 0x143, 0xc, 0xf, true));
    }
}
__device__ __forceinline__ float row16_sum(float v) { v = dpp_add(v, 0xB1, 0xf); v = dpp_add(v, 0x4E, 0xf); v = dpp_add(v, 0x141, 0xf); v = dpp_add(v, 0x140, 0xf); return v; }
__device__ __forceinline__ float wave_sum(float v) {
    v = row16_sum(v); v = dpp_add(v, 0x142, 0xa); v = dpp_add(v, 0x143, 0xc);
    return __builtin_bit_cast(float, __builtin_amdgcn_readlane(__builtin_bit_cast(int, v), 63));
}
__device__ __forceinline__ float sigmoidf_(float x) { return __builtin_amdgcn_rcpf(1.0f + __builtin_amdgcn_exp2f(-1.4426950408889634f * x)); }
__device__ __forceinline__ int opaque_tid() { int t; asm volatile("v_mov_b32 %0, %1" : "=v"(t) : "v"(threadIdx.x)); return t; }
#define REFRESH(F) do { (F).tid = opaque_tid(); (F).lane = (F).tid & 63; } while (0)
__device__ __forceinline__ void seq_of(int row, int& sb, int& t, int& n) { if (row < NX) { sb = row & ~(T - 1); t = row & (T - 1); n = T; } else { const int r2 = row - NX; sb = NX + (r2 & ~(L - 1)); t = r2 & (L - 1); n = L; } }
__device__ __forceinline__ f32x4 ld_bf4(const bf16_t* p) { const u32x2 w = *(const u32x2*)p; return (f32x4){bflo(w.x), bfhi(w.x), bflo(w.y), bfhi(w.y)}; }
__device__ __forceinline__ void st_bf4(bf16_t* p, f32x4 v) { u32x2 w; w.x = pk2(v.x, v.y); w.y = pk2(v.z, v.w); *(u32x2*)p = w; }

#define LDS_WAIT() asm volatile("s_waitcnt lgkmcnt(0)" ::: "memory")
#define VM_WAIT() asm volatile("s_waitcnt vmcnt(0)" ::: "memory")

#define XB_TMO      128
#define XB_XCNT(j)  (256  + 64 * (j))
#define XB_XSUB(j)  (1280 + 64 * (j))
#define XB_XGEN(j)  (2304 + 64 * (j))
#define XB_TOP      3328
#define XB_TOPGEN   3392
#define XCD_BAR_WORDS 3456
#define XB_SPIN_CAP (1u << 18)
__device__ __forceinline__ unsigned xb_ld(unsigned* p)              { return __hip_atomic_load(p, __ATOMIC_RELAXED, __HIP_MEMORY_SCOPE_AGENT); }
__device__ __forceinline__ unsigned xb_add(unsigned* p, unsigned v) { return __hip_atomic_fetch_add(p, v, __ATOMIC_RELAXED, __HIP_MEMORY_SCOPE_AGENT); }
__device__ __forceinline__ unsigned xb_xcc_id() { return (unsigned)__builtin_amdgcn_s_getreg((3 << 11) | 20) & 0xFu; }
#define XB_SPIN(cond, bar) do { unsigned _sp = 0; while (cond) { __builtin_amdgcn_s_sleep(1); \
    if ((++_sp & 255u) == 0u) { if (xb_ld(&(bar)[XB_TMO])) break; if (_sp > XB_SPIN_CAP) { atomicAdd(&(bar)[XB_TMO], 1u); break; } } } } while (0)
struct XcdBarrier { unsigned* bar; unsigned x; volatile LAS unsigned* st; };
__device__ __forceinline__ XcdBarrier xcd_barrier_post(unsigned* bar, volatile LAS unsigned* st) {
    XcdBarrier b; b.bar = bar; b.x = xb_xcc_id(); b.st = st;
    if (threadIdx.x == 0) (void)xb_add(&bar[XB_XCNT(b.x)], 1u);
    return b;
}
__device__ __forceinline__ void xcd_barrier_complete(unsigned* bar, unsigned x, unsigned& nloc, unsigned& nx) {
    const unsigned G = gridDim.x * gridDim.y * gridDim.z;
    unsigned sum, cnt, mine, sp = 0u;
    for (;;) {
        sum = 0u; cnt = 0u; mine = 0u;
#pragma unroll
        for (unsigned j = 0; j < 16; ++j) { const unsigned c = xb_ld(&bar[XB_XCNT(j)]); sum += c; cnt += (c > 0u) ? 1u : 0u; mine = (j == x) ? c : mine; }
        if (sum == G) break;
        __builtin_amdgcn_s_sleep(1);
        if ((++sp & 255u) == 0u) { if (xb_ld(&bar[XB_TMO])) break; if (sp > XB_SPIN_CAP) { atomicAdd(&bar[XB_TMO], 1u); break; } }
    }
    nloc = mine > 0u ? mine : 1u; nx = cnt > 0u ? cnt : 1u;
}
__device__ __forceinline__ void xcd_barrier(const XcdBarrier& b) {
    asm volatile("s_waitcnt vmcnt(0)" ::: "memory");
    __syncthreads();
    if (threadIdx.x == 0) {
        unsigned* bar = b.bar;
        __builtin_amdgcn_s_waitcnt(0);
        unsigned nloc = b.st[0], nx = b.st[1];
        if (nloc == 0u) { xcd_barrier_complete(bar, b.x, nloc, nx); b.st[0] = nloc; b.st[1] = nx; }
        const unsigned old = xb_add(&bar[XB_XSUB(b.x)], 1u);
        const unsigned gen = old / nloc;
        if (old + 1u == (gen + 1u) * nloc) {
            __builtin_amdgcn_fence(__ATOMIC_RELEASE, "agent");
            asm volatile("s_waitcnt vmcnt(0)" ::: "memory");
            const unsigned og = xb_add(&bar[XB_TOP], 1u);
            const unsigned tg = og / nx;
            if (og + 1u == (tg + 1u) * nx) xb_add(&bar[XB_TOPGEN], 1u);
            else XB_SPIN(xb_ld(&bar[XB_TOPGEN]) == tg, bar);
            __builtin_amdgcn_fence(__ATOMIC_ACQUIRE, "agent");
            xb_add(&bar[XB_XGEN(b.x)], 1u);
            asm volatile("s_waitcnt vmcnt(0)" ::: "memory");
        } else {
            XB_SPIN(xb_ld(&bar[XB_XGEN(b.x)]) == gen, bar);
            __builtin_amdgcn_fence(__ATOMIC_ACQUIRE, "agent");
            asm volatile("s_waitcnt vmcnt(0)" ::: "memory");
        }
    }
    __syncthreads();
}

namespace pg8 {
constexpr int BM = 256, BK = 64, HALF = 128, HTB = HALF * BK * 2, STAGE_BYTES = 8 * HTB, NXCD = 8, WGM = 8;
__host__ __device__ __forceinline__ int lds_byte(int r, int c) { const int st = (r >> 4) * 2 + (c >> 5), rr = r & 15, cc = c & 31, ob = rr * 64 + cc * 2; return st * 1024 + (ob ^ (((ob >> 9) & 1) << 5)); }
__host__ __device__ __forceinline__ void stage_rc(int b, int& R, int& C) { const int st = b / 1024, sb = b % 1024, swz = sb ^ (((sb >> 9) & 1) << 5); R = (st >> 1) * 16 + swz / 64; C = (st & 1) * 32 + (swz % 64) / 2; }
__host__ __device__ __forceinline__ int perm32(int rho) { const int n = rho >> 4, i = rho & 15; return 8 * (i >> 2) + 4 * n + (i & 3); }

typedef int i32x8 __attribute__((ext_vector_type(8)));
typedef int i32x4 __attribute__((ext_vector_type(4)));
__device__ __forceinline__ i32x8 cat8(bf16x8 lo, bf16x8 hi) { const i32x4 a = __builtin_bit_cast(i32x4, lo), b = __builtin_bit_cast(i32x4, hi); return __builtin_shufflevector(a, b, 0, 1, 2, 3, 4, 5, 6, 7); }
struct Unit { int pm, pn, e, rt; };
struct TileOrder {
    int nM, nN, nwg, G, c; unsigned inv_nig;
    __device__ __forceinline__ void init(int nM_, int nN_, int G_, int c_) { nM = nM_; nN = nN_; nwg = nM * nN; G = G_; c = c_; inv_nig = (unsigned)((0x100000000ull + (unsigned)(WGM * nN_) - 1u) / (unsigned)(WGM * nN_)); }
    __device__ __forceinline__ bool next(int i, int& pm, int& pn) const {
        const long Lx = (long)i * G + c; if (Lx >= nwg) return false;
        int wgid = (int)Lx; { const int q = nwg >> 3, r = nwg & 7, xcd = wgid & 7, off = wgid >> 3; wgid = (xcd < r ? xcd * (q + 1) : r * (q + 1) + (xcd - r) * q) + off; }
        const int nig = WGM * nN, gid = (int)(((unsigned long long)(unsigned)wgid * inv_nig) >> 32), fm = gid * WGM, rem = wgid - gid * nig, left = nM - fm;
        if (left >= WGM) { pm = fm + (rem & (WGM - 1)); pn = rem >> 3; }
        else { pm = fm + rem % left; pn = rem / left; }
        return true;
    }
};
struct ProbDense {
    static constexpr bool FP8 = false;
    const bf16_t* A; const bf16_t* Bt; int lda, ldb, K, a_pn_off; TileOrder ord;
    __device__ __forceinline__ int ldb_bytes() const { return ldb * 2; }
    __device__ __forceinline__ int ntiles() const { return K / 64; }
    __device__ __forceinline__ bool next(int i, Unit& u) const { u.e = 0; const bool ok = ord.next(i, u.pm, u.pn); u.rt = u.pm; return ok; }
    __device__ __forceinline__ const char* a_ptr(const Unit& u) const { return (const char*)(A + (size_t)u.pm * BM * lda + (size_t)u.pn * a_pn_off); }
    __device__ __forceinline__ const char* b_ptr(const Unit& u) const { return (const char*)(Bt + (size_t)u.pn * BM * ldb); }
    __device__ __forceinline__ void list_prefetch(const Unit&, int, int, int) const {}
    __device__ __forceinline__ void a_off(const Unit&, int, const int (&R)[2], const int (&C)[2], unsigned (&v)[2][2]) const {
#pragma unroll
        for (int h = 0; h < 2; ++h)
#pragma unroll
            for (int i = 0; i < 2; ++i) v[h][i] = (unsigned)((h * HALF + R[i]) * lda + C[i]) * 2u;
    }
};

struct ProbDense8 {
    static constexpr bool FP8 = true;
    const unsigned char* A; const unsigned char* Bt; int lda, ldb, K, scale_w, scale_x; TileOrder ord;
    __device__ __forceinline__ int ldb_bytes() const { return ldb; }
    __device__ __forceinline__ int ntiles() const { return K / 128; }
    __device__ __forceinline__ bool next(int i, Unit& u) const { u.e = 0; const bool ok = ord.next(i, u.pm, u.pn); u.rt = u.pm; return ok; }
    __device__ __forceinline__ const char* a_ptr(const Unit& u) const { return (const char*)(A + (size_t)u.pm * BM * lda); }
    __device__ __forceinline__ const char* b_ptr(const Unit& u) const { return (const char*)(Bt + (size_t)u.pn * BM * ldb); }
    __device__ __forceinline__ void list_prefetch(const Unit&, int, int, int) const {}
    __device__ __forceinline__ void a_off(const Unit&, int, const int (&R)[2], const int (&C)[2], unsigned (&v)[2][2]) const {
#pragma unroll
        for (int h = 0; h < 2; ++h)
#pragma unroll
            for (int i = 0; i < 2; ++i) v[h][i] = (unsigned)((h * HALF + R[i]) * lda + C[i] * 2);
    }
};
template <class Prob, class Epi>
__device__ __forceinline__ void gemm_phase(LAS unsigned char* lds, const Prob& P, const Epi& E) {
    const int tid = opaque_tid(), wid = __builtin_amdgcn_readfirstlane(tid >> 6), lane = tid & 63, wr = wid >> 2, wc = wid & 3, fr = lane & 15, fq = lane >> 4;
    const int nt = P.ntiles(); const int ldbB = P.ldb_bytes();
    int Rr[2], Cc[2]; unsigned voffB[2];
#pragma unroll
    for (int i = 0; i < 2; ++i) { int R, C; stage_rc(tid * 16 + i * 8192, R, C); Rr[i] = R; Cc[i] = C; const int Rb = Epi::PERM ? ((R & ~31) + perm32(R & 31)) : R;
        voffB[i] = (unsigned)(Rb * ldbB + C * 2); }
    const size_t kstep = (size_t)(BK * 2);
    const size_t hstepB = (size_t)HALF * ldbB;
    const unsigned ldsw = (unsigned)wid * 1024u;
    const int aoff = lds_byte(wr * 64 + fr, fq * 8), boff = lds_byte(wc * 32 + fr, fq * 8);
#define PG8_SA(b, h) (((b) * 2 + (h)) * HTB)
#define PG8_SB(b, h) ((4 + (b) * 2 + (h)) * HTB)
#define PG8_STAGE(bufoff, gbase, voff) do { _Pragma("unroll") for (int _i = 0; _i < 2; ++_i) { \
        __builtin_amdgcn_global_load_lds((const unsigned*)((const char*)(gbase) + (voff)[_i]), (LAS unsigned*)(lds + (bufoff) + ldsw + _i * 8192), 16, 0, 0); } } while (0)
#define PG8_LDA(dst, b, h) do { _Pragma("unroll") for (int m = 0; m < 4; ++m) _Pragma("unroll") for (int k = 0; k < 2; ++k) dst[m][k] = *(const LAS bf16x8*)(lds + PG8_SA(b, h) + aoff + m * 2048 + k * 1024); } while (0)
#define PG8_LDB(dst, b, h) do { _Pragma("unroll") for (int n = 0; n < 2; ++n) _Pragma("unroll") for (int k = 0; k < 2; ++k) dst[n][k] = *(const LAS bf16x8*)(lds + PG8_SB(b, h) + boff + n * 2048 + k * 1024); } while (0)
#define PG8_MMA(ai, bj, At, Bt) do { __builtin_amdgcn_s_setprio(1); _Pragma("unroll") for (int m = 0; m < 4; ++m) _Pragma("unroll") for (int n = 0; n < 2; ++n) { \
        if constexpr (Prob::FP8) { asm volatile("v_mfma_scale_f32_16x16x128_f8f6f4 %0, %1, %2, %0, %3, %4 op_sel_hi:[0,0,0]" : "+v"(acc[ai][bj][m][n]) : "v"(cat8(Bt[n][0], Bt[n][1])), "v"(cat8(At[m][0], At[m][1])), "v"(sc_w), "v"(sc_x)); } \
        else { _Pragma("unroll") for (int k = 0; k < 2; ++k) acc[ai][bj][m][n] = __builtin_amdgcn_mfma_f32_16x16x32_bf16(Bt[n][k], At[m][k], acc[ai][bj][m][n], 0, 0, 0); } } __builtin_amdgcn_s_setprio(0); } while (0)
#define PG8_MMAZ(ai, bj, At, Bt) do { __builtin_amdgcn_s_setprio(1); _Pragma("unroll") for (int m = 0; m < 4; ++m) _Pragma("unroll") for (int n = 0; n < 2; ++n) { \
        if constexpr (Prob::FP8) { asm volatile("v_mfma_scale_f32_16x16x128_f8f6f4 %0, %1, %2, 0, %3, %4 op_sel_hi:[0,0,0]" : "=&v"(acc[ai][bj][m][n]) : "v"(cat8(Bt[n][0], Bt[n][1])), "v"(cat8(At[m][0], At[m][1])), "v"(sc_w), "v"(sc_x)); } \
        else { acc[ai][bj][m][n] = __builtin_amdgcn_mfma_f32_16x16x32_bf16(Bt[n][0], At[m][0], (f32x4){0.f, 0.f, 0.f, 0.f}, 0, 0, 0); acc[ai][bj][m][n] = __builtin_amdgcn_mfma_f32_16x16x32_bf16(Bt[n][1], At[m][1], acc[ai][bj][m][n], 0, 0, 0); } } __builtin_amdgcn_s_setprio(0); } while (0)
#define PG8_WAIT_V(n) asm volatile("s_waitcnt vmcnt(" #n ")" ::: "memory")
#define PG8_WAIT_V8R(flag) do { if constexpr (Epi::NSTORE > 0) asm volatile("s_cmp_lg_u32 %0, 0\n\ts_cbranch_scc1 .Lpg8w%=\n\ts_waitcnt vmcnt(8)\n.Lpg8w%=:\n\ts_waitcnt vmcnt(%1)" :: "s"(flag), "n"(8 + Epi::NSTORE) : "scc", "memory"); else PG8_WAIT_V(8); } while (0)
#define PG8_WAIT_L(n) asm volatile("s_waitcnt lgkmcnt(" #n ")" ::: "memory")
#define PG8_BAR __builtin_amdgcn_s_barrier()
#define PG8_SCHED __builtin_amdgcn_sched_barrier(0)
    Unit cur, nxt; int ui = 0;
    if (!P.next(0, cur)) return;
    const int ntm = nt - 1;
    int k0c = (cur.pm + 2 * cur.pn) & 7 & ntm;
    int sc_w = 0, sc_x = 0; if constexpr (Prob::FP8) { sc_w = P.scale_w; sc_x = P.scale_x; } (void)sc_w; (void)sc_x;
    f32x4 acc[2][2][4][2];
    bf16x8 At[4][2], B0[2][2], B1[2][2];
    unsigned vAc[2][2], vAn[2][2];
    Unit nx1; bool h1 = P.next(1, nx1);
    P.list_prefetch(cur, 0, wid, lane); if (h1) P.list_prefetch(nx1, 1, wid, lane);
    LAS float* const biasl = (LAS float*)(lds + BIAS_OFF); int bsc = 0;
    if constexpr (Epi::LDSBIAS) { if (wid == 1) E.prefetch(cur, biasl, lane); }
    PG8_WAIT_V(0); PG8_BAR;
    P.a_off(cur, 0, Rr, Cc, vAc);
    const char* cA = P.a_ptr(cur); const char* cB = P.b_ptr(cur);
    const size_t po0 = (size_t)k0c * kstep, po1 = (size_t)((k0c + 1) & ntm) * kstep;
    PG8_STAGE(PG8_SB(0, 0), cB + po0, voffB); PG8_STAGE(PG8_SB(0, 1), cB + hstepB + po0, voffB); PG8_STAGE(PG8_SA(0, 0), cA + po0, vAc[0]); PG8_STAGE(PG8_SA(0, 1), cA + po0, vAc[1]);
    if (wr == 1) PG8_BAR;
    PG8_WAIT_V(2); PG8_BAR;
    PG8_STAGE(PG8_SB(1, 0), cB + po1, voffB); PG8_STAGE(PG8_SA(1, 0), cA + po1, vAc[0]); PG8_STAGE(PG8_SB(1, 1), cB + hstepB + po1, voffB);
    PG8_WAIT_V(6); PG8_BAR;
    for (;;) {
        const bool has_next = h1; nxt = nx1;
        const char* nA = cA; const char* nB = cB;
#pragma unroll
        for (int h = 0; h < 2; ++h)
#pragma unroll
            for (int i = 0; i < 2; ++i) vAn[h][i] = vAc[h][i];
        int k0n = k0c;
        if (has_next) { nA = P.a_ptr(nxt); nB = P.b_ptr(nxt); P.a_off(nxt, (ui + 1) & 1, Rr, Cc, vAn); k0n = (nxt.pm + 2 * nxt.pn) & 7 & ntm; }
        h1 = has_next && P.next(ui + 2, nx1); if (h1) P.list_prefetch(nx1, ui & 1, wid, lane);
        const int bsn = (bsc == 2) ? 0 : bsc + 1;
        if constexpr (Epi::LDSBIAS) { if (has_next && wid == 1) E.prefetch(nxt, biasl + bsn * 256, lane); }
#define PG8_KBODY(T, MMX, W12) { const int t = (T); const bool last = (t == nt - 2); \
            asm volatile("" : "+v"(voffB[0]), "+v"(voffB[1]), "+v"(vAc[0][0]), "+v"(vAc[0][1]), "+v"(vAc[1][0]), "+v"(vAc[1][1])); \
            const char* a1 = cA + (size_t)((t + 1 + k0c) & ntm) * kstep; \
            const size_t o2 = (size_t)(last ? k0n : ((t + 2 + k0c) & ntm)) * kstep, o3 = (size_t)(last ? ((k0n + 1) & ntm) : ((t + 3 + k0c) & ntm)) * kstep; \
            const char* a2 = (last ? nA : cA) + o2; const char* b2 = (last ? nB : cB) + o2; \
            const char* a3 = (last ? nA : cA) + o3; const char* b3 = (last ? nB : cB) + o3; \
            unsigned vX[2][2]; \
            _Pragma("unroll") for (int h = 0; h < 2; ++h) _Pragma("unroll") for (int i = 0; i < 2; ++i) vX[h][i] = last ? vAn[h][i] : vAc[h][i]; \
            PG8_LDB(B0, 0, 0); PG8_LDB(B1, 0, 1); PG8_SCHED; PG8_LDA(At, 0, 0); PG8_STAGE(PG8_SA(1, 1), a1, vAc[1]); \
            W12; PG8_WAIT_L(0); PG8_BAR; MMX(0, 0, At, B0); MMX(0, 1, At, B1); PG8_BAR; PG8_SCHED; \
            PG8_LDA(At, 0, 1); PG8_STAGE(PG8_SB(0, 0), b2, voffB); PG8_STAGE(PG8_SB(0, 1), b2 + hstepB, voffB); PG8_STAGE(PG8_SA(0, 0), a2, vX[0]); \
            W12; PG8_WAIT_L(0); PG8_BAR; MMX(1, 0, At, B0); MMX(1, 1, At, B1); PG8_BAR; PG8_SCHED; \
            PG8_LDB(B0, 1, 0); PG8_LDB(B1, 1, 1); PG8_SCHED; PG8_LDA(At, 1, 0); PG8_STAGE(PG8_SA(0, 1), a2, vX[1]); \
            PG8_WAIT_V(8); PG8_WAIT_L(0); PG8_BAR; PG8_MMA(0, 0, At, B0); PG8_MMA(0, 1, At, B1); PG8_BAR; PG8_SCHED; \
            PG8_LDA(At, 1, 1); PG8_STAGE(PG8_SB(1, 0), b3, voffB); PG8_STAGE(PG8_SB(1, 1), b3 + hstepB, voffB); PG8_STAGE(PG8_SA(1, 0), a3, vX[0]); \
            PG8_WAIT_V(8); PG8_WAIT_L(0); PG8_BAR; PG8_MMA(1, 0, At, B0); PG8_MMA(1, 1, At, B1); PG8_BAR; PG8_SCHED; }
        if constexpr (Prob::FP8) {
            { const int rlx = __builtin_amdgcn_readfirstlane(ui != 0 ? 1 : 0);
              PG8_KBODY(0, PG8_MMAZ, PG8_WAIT_V8R(rlx)) }
            for (int tt = 2; tt < nt; tt += 2) PG8_KBODY(tt, PG8_MMA, PG8_WAIT_V(8))
        } else {
            { f32x4 zz = (f32x4){0.f, 0.f, 0.f, 0.f}; asm volatile("" : "+v"(zz));
#pragma unroll
                for (int a = 0; a < 2; ++a)
#pragma unroll
                    for (int b = 0; b < 2; ++b)
#pragma unroll
                        for (int m = 0; m < 4; ++m)
#pragma unroll
                            for (int n = 0; n < 2; ++n) acc[a][b][m][n] = zz; }
            for (int tt = 0; tt < nt; tt += 2) PG8_KBODY(tt, PG8_MMA, PG8_WAIT_V(8))
        }
#undef PG8_KBODY
        f32x4 bqe[2][2];
        if constexpr (Epi::LDSBIAS) {
#pragma unroll
            for (int bj = 0; bj < 2; ++bj)
#pragma unroll
                for (int n = 0; n < 2; ++n) bqe[bj][n] = *(const LAS f32x4*)(biasl + bsc * 256 + bj * 128 + wc * 32 + 8 * fq + 4 * n);
        } else { (void)bqe; }
        if (wr == 0) PG8_BAR;
        if constexpr (Prob::FP8) { asm volatile("s_nop 15\n\ts_nop 15" ::: "memory");
#pragma unroll
            for (int a = 0; a < 2; ++a)
#pragma unroll
                for (int b = 0; b < 2; ++b)
                    asm volatile("" : "+v"(acc[a][b][0][0]), "+v"(acc[a][b][0][1]), "+v"(acc[a][b][1][0]), "+v"(acc[a][b][1][1]), "+v"(acc[a][b][2][0]), "+v"(acc[a][b][2][1]), "+v"(acc[a][b][3][0]), "+v"(acc[a][b][3][1])); }
        if constexpr (Epi::LDSBIAS) E(acc, cur, wr, wc, fr, fq, bqe); else E(acc, cur, wr, wc, fr, fq);
        if (!has_next) break;
        cur = nxt; cA = nA; cB = nB; k0c = k0n; bsc = bsn; ++ui;
#pragma unroll
        for (int h = 0; h < 2; ++h)
#pragma unroll
            for (int i = 0; i < 2; ++i) vAc[h][i] = vAn[h][i];
        if (wr == 1) PG8_BAR;
    }
    PG8_WAIT_V(0);
    PG8_BAR;
#undef PG8_SA
#undef PG8_SB
#undef PG8_STAGE
#undef PG8_LDA
#undef PG8_LDB
#undef PG8_MMA
#undef PG8_MMAZ
#undef PG8_WAIT_V
#undef PG8_WAIT_L
#undef PG8_WAIT_V8R
#undef PG8_BAR
#undef PG8_SCHED
}
}

using pg8::Unit;
constexpr int HALF_ = 128;
struct EpiBf16Act {
    static constexpr bool PERM = true; static constexpr bool LDSBIAS = false; static constexpr int NSTORE = 0;
    bf16_t* O; int ldc; const float* bias; int act; float scale;
    __device__ __forceinline__ void operator()(const f32x4 (&acc)[2][2][4][2], const Unit& u, int wr, int wc, int fr, int fq) const {
        const int row0 = u.pm * 256 + wr * 64 + fr, col0 = u.pn * 256 + wc * 32 + 8 * fq;
        f32x4 bv[2][2];
#pragma unroll
        for (int bj = 0; bj < 2; ++bj)
#pragma unroll
            for (int n = 0; n < 2; ++n) bv[bj][n] = bias ? *(const f32x4*)(bias + col0 + bj * HALF_ + 4 * n) : (f32x4){0.f, 0.f, 0.f, 0.f};
#pragma unroll
        for (int ai = 0; ai < 2; ++ai)
#pragma unroll
            for (int m = 0; m < 4; ++m) { bf16_t* rowp = O + (size_t)(row0 + ai * HALF_ + m * 16) * ldc + col0;
#pragma unroll
                for (int bj = 0; bj < 2; ++bj) { f32x4 v0 = acc[ai][bj][m][0] + bv[bj][0], v1 = acc[ai][bj][m][1] + bv[bj][1];
                    if (act == 1) {
#pragma unroll
                        for (int j = 0; j < 4; ++j) { v0[j] = sigmoidf_(v0[j]) * scale; v1[j] = sigmoidf_(v1[j]) * scale; } }
                    else if (act == 2) {
#pragma unroll
                        for (int j = 0; j < 4; ++j) { v0[j] = 1.0f - 2.0f * __builtin_amdgcn_rcpf(__builtin_amdgcn_exp2f(2.8853900817779268f * v0[j]) + 1.0f); v1[j] = 1.0f - 2.0f * __builtin_amdgcn_rcpf(__builtin_amdgcn_exp2f(2.8853900817779268f * v1[j]) + 1.0f); } }
                    u32x4 w; w.x = cvt_pk_bf16(v0[0], v0[1]); w.y = cvt_pk_bf16(v0[2], v0[3]); w.z = cvt_pk_bf16(v1[0], v1[1]); w.w = cvt_pk_bf16(v1[2], v1[3]);
                    *(u32x4*)(rowp + bj * HALF_) = w; } }
    }
};
struct EpiQK {
    static constexpr bool PERM = true; static constexpr bool LDSBIAS = false; static constexpr int NSTORE = 0;
    bf16_t* Q; bf16_t* Kb; const float* bias; const float* ropec; const float* ropes;
    __device__ __forceinline__ void operator()(const f32x4 (&acc)[2][2][4][2], const Unit& u, int wr, int wc, int fr, int fq) const {
        int row0 = u.pm * 256 + wr * 64 + fr, cl0 = wc * 32 + 8 * fq;
        asm volatile("" : "+v"(row0), "+v"(cl0));
        const int g = (4 * wc + fq) & 7;
        bf16_t* base; int ldc;
        if (u.pn < 4) { base = Q + u.pn * 256; ldc = 1024; } else { base = Kb; ldc = 256; }
        f32x4 bv[2][2];
#pragma unroll
        for (int bj = 0; bj < 2; ++bj)
#pragma unroll
            for (int n = 0; n < 2; ++n) bv[bj][n] = *(const f32x4*)(bias + u.pn * 256 + cl0 + bj * HALF_ + 4 * n);
#pragma unroll
        for (int ai = 0; ai < 2; ++ai)
#pragma unroll
            for (int m = 0; m < 4; ++m) { const int row = row0 + ai * HALF_ + m * 16; bf16_t* rowp = base + (size_t)row * ldc + cl0;
                f32x4 cs = (f32x4){1.f, 1.f, 1.f, 1.f}, sn = (f32x4){0.f, 0.f, 0.f, 0.f};
                if (row < NX) { const int t = row & (T - 1); cs = *(const f32x4*)(ropec + t * 32 + g * 4); sn = *(const f32x4*)(ropes + t * 32 + g * 4); }
#pragma unroll
                for (int bj = 0; bj < 2; ++bj) { const f32x4 v0 = acc[ai][bj][m][0] + bv[bj][0], v1 = acc[ai][bj][m][1] + bv[bj][1];
                    const f32x4 o0 = v0 * cs - v1 * sn, o1 = v1 * cs + v0 * sn;
                    u32x4 w; w.x = cvt_pk_bf16(o0[0], o0[1]); w.y = cvt_pk_bf16(o0[2], o0[3]); w.z = cvt_pk_bf16(o1[0], o1[1]); w.w = cvt_pk_bf16(o1[2], o1[3]);
                    *(u32x4*)(rowp + bj * HALF_) = w; } }
    }
};
struct EpiVT {
    static constexpr bool PERM = true; static constexpr bool LDSBIAS = false; static constexpr int NSTORE = 0;
    bf16_t* VT; const float* biasrow;
    __device__ __forceinline__ void operator()(const f32x4 (&acc)[2][2][4][2], const Unit& u, int wr, int wc, int fr, int fq) const {
        int row0 = wr * 64 + fr, col0 = u.pn * 256 + wc * 32 + 8 * fq;
        asm volatile("" : "+v"(row0), "+v"(col0));
#pragma unroll
        for (int ai = 0; ai < 2; ++ai)
#pragma unroll
            for (int m = 0; m < 4; ++m) { const int row = row0 + ai * HALF_ + m * 16; const float b = biasrow[row]; bf16_t* rowp = VT + (size_t)row * NT + col0;
#pragma unroll
                for (int bj = 0; bj < 2; ++bj) { const f32x4 v0 = acc[ai][bj][m][0] + b, v1 = acc[ai][bj][m][1] + b;
                    u32x4 w; w.x = cvt_pk_bf16(v0[0], v0[1]); w.y = cvt_pk_bf16(v0[2], v0[3]); w.z = cvt_pk_bf16(v1[0], v1[1]); w.w = cvt_pk_bf16(v1[2], v1[3]);
                    *(u32x4*)(rowp + bj * HALF_) = w; } }
    }
};
struct EpiResid {
    static constexpr bool PERM = true; static constexpr bool LDSBIAS = false; static constexpr int NSTORE = 0;
    bf16_t* H; const float* bias; const float* ls; const float* gate;
    __device__ __forceinline__ void operator()(const f32x4 (&acc)[2][2][4][2], const Unit& u, int wr, int wc, int fr, int fq) const {
        int row0 = u.pm * 256 + wr * 64 + fr, col0 = u.pn * 256 + wc * 32 + 8 * fq;
        asm volatile("" : "+v"(row0), "+v"(col0));
        f32x4 bv[2][2], lv[2][2];
#pragma unroll
        for (int bj = 0; bj < 2; ++bj)
#pragma unroll
            for (int n = 0; n < 2; ++n) { bv[bj][n] = bias ? *(const f32x4*)(bias + col0 + bj * HALF_ + 4 * n) : (f32x4){0.f, 0.f, 0.f, 0.f};
                                          lv[bj][n] = ls ? *(const f32x4*)(ls + col0 + bj * HALF_ + 4 * n) : (f32x4){1.f, 1.f, 1.f, 1.f}; }
#pragma unroll
        for (int ai = 0; ai < 2; ++ai)
#pragma unroll
            for (int m = 0; m < 4; ++m) { const int row = row0 + ai * HALF_ + m * 16; const int brow = row < NX ? (row >> 11) : 32;
                bf16_t* hp = H + (size_t)row * D + col0; const float* gp = gate + (size_t)brow * (6 * D) + col0;
#pragma unroll
                for (int bj = 0; bj < 2; ++bj) { const u32x4 hw = *(const u32x4*)(hp + bj * HALF_);
                    const f32x4 g0 = *(const f32x4*)(gp + bj * HALF_), g1 = *(const f32x4*)(gp + bj * HALF_ + 4);
                    const f32x4 y0 = (acc[ai][bj][m][0] + bv[bj][0]) * lv[bj][0], y1 = (acc[ai][bj][m][1] + bv[bj][1]) * lv[bj][1];
                    const f32x4 h0 = (f32x4){bflo(hw.x), bfhi(hw.x), bflo(hw.y), bfhi(hw.y)} + g0 * y0, h1 = (f32x4){bflo(hw.z), bfhi(hw.z), bflo(hw.w), bfhi(hw.w)} + g1 * y1;
                    u32x4 w; w.x = cvt_pk_bf16(h0[0], h0[1]); w.y = cvt_pk_bf16(h0[2], h0[3]); w.z = cvt_pk_bf16(h1[0], h1[1]); w.w = cvt_pk_bf16(h1[2], h1[3]);
                    *(u32x4*)(hp + bj * HALF_) = w; }
                asm volatile("" ::: "memory"); }
    }
};
struct EpiMoe1 {
    static constexpr bool PERM = true; static constexpr bool LDSBIAS = true; static constexpr int NSTORE = 8;
    unsigned char* ACT; const float* b1;
    __device__ __forceinline__ void prefetch(const Unit& u, LAS float* slot, int lane) const {
        const float* src = b1 + (size_t)u.e * 2048 + u.pn * 128 + (lane >> 5) * 1024 + (lane & 31) * 4;
        __builtin_amdgcn_global_load_lds((const unsigned*)src, (LAS unsigned*)slot, 16, 0, 0); }
    __device__ __forceinline__ void operator()(const f32x4 (&acc)[2][2][4][2], const Unit& u, int wr, int wc, int fr, int fq, const f32x4 (&bq)[2][2]) const {
        unsigned char* const Ab = ACT + ((size_t)u.rt * 256 * D + (size_t)u.pn * 128);
        unsigned voff = (unsigned)((wr * 64 + fr) * D + wc * 32 + 8 * fq); asm volatile("" : "+v"(voff));
        f32x4 bgv[2], blv[2];
#pragma unroll
        for (int n = 0; n < 2; ++n) { bgv[n] = bq[0][n]; blv[n] = bq[1][n]; }
#pragma unroll
        for (int ai = 0; ai < 2; ++ai)
#pragma unroll
            for (int m = 0; m < 4; ++m) { unsigned char* rowp = Ab + (size_t)(ai * HALF_ + m * 16) * D + voff;
                f32x4 o[2];
#pragma unroll
                for (int n = 0; n < 2; ++n) { const f32x4 c7 = (f32x4){7.f, 7.f, 7.f, 7.f};
                    const f32x4 gl = __builtin_elementwise_min(acc[ai][0][m][n] + bgv[n], c7), li = __builtin_elementwise_min(__builtin_elementwise_max(acc[ai][1][m][n] + blv[n], -c7), c7);
                    const f32x4 z = gl * (-1.702f * 1.4426950408889634f);
#pragma unroll
                    for (int j = 0; j < 4; j += 2) {
                        f32x2 d2 = (f32x2){__builtin_amdgcn_exp2f(z[j]), __builtin_amdgcn_exp2f(z[j + 1])} + 1.0f; asm("" : "+v"(d2));
                        f32x2 gd = (f32x2){gl[j], gl[j + 1]} * (f32x2){__builtin_amdgcn_rcpf(d2.x), __builtin_amdgcn_rcpf(d2.y)}; asm("" : "+v"(gd));
                        const f32x2 o2 = gd * (f32x2){li[j], li[j + 1]} + gd;
                        o[n][j] = o2.x; o[n][j + 1] = o2.y; } }
                u32x2 w; w.x = pk4_fp8(o[0][0], o[0][1], o[0][2], o[0][3]); w.y = pk4_fp8(o[1][0], o[1][1], o[1][2], o[1][3]);
                *(u32x2*)rowp = w; }
    }
};
struct EpiMoe2 {
    static constexpr bool PERM = true; static constexpr bool LDSBIAS = true; static constexpr int NSTORE = 16;
    unsigned char* Y; const float* b2;
    __device__ __forceinline__ void prefetch(const Unit& u, LAS float* slot, int lane) const {
        const float* src = b2 + (size_t)u.e * D + u.pn * 256 + lane * 4;
        __builtin_amdgcn_global_load_lds((const unsigned*)src, (LAS unsigned*)slot, 16, 0, 0); }
    __device__ __forceinline__ void operator()(const f32x4 (&acc)[2][2][4][2], const Unit& u, int wr, int wc, int fr, int fq, const f32x4 (&bq)[2][2]) const {
        unsigned char* const Yb = Y + ((size_t)u.rt * 256 * D + (size_t)u.pn * 256);
        unsigned voff = (unsigned)((wr * 64 + fr) * D + wc * 32 + 8 * fq); asm volatile("" : "+v"(voff));
        f32x4 bv[2][2];
#pragma unroll
        for (int bj = 0; bj < 2; ++bj)
#pragma unroll
            for (int n = 0; n < 2; ++n) bv[bj][n] = bq[bj][n];
#pragma unroll
        for (int ai = 0; ai < 2; ++ai)
#pragma unroll
            for (int m = 0; m < 4; ++m) { unsigned char* rowp = Yb + (size_t)(ai * HALF_ + m * 16) * D + voff;
#pragma unroll
                for (int bj = 0; bj < 2; ++bj) { f32x4 v0 = bv[bj][0] * 4.0f + acc[ai][bj][m][0], v1 = bv[bj][1] * 4.0f + acc[ai][bj][m][1];
#pragma unroll
                    for (int i = 0; i < 4; ++i) { v0[i] = __builtin_amdgcn_fmed3f(v0[i], -448.0f, 448.0f); v1[i] = __builtin_amdgcn_fmed3f(v1[i], -448.0f, 448.0f); }
                    *(u32x2*)(rowp + bj * HALF_) = (u32x2){pk4_fp8(v0[0], v0[1], v0[2], v0[3]), pk4_fp8(v1[0], v1[1], v1[2], v1[3])}; } }
    }
};
typedef unsigned char fp8_t;
constexpr int SCALE_ONE = 0x7f7f7f7f, SCALE_W = 0x79797979, SCALE_W4 = 0x7b7b7b7b;
struct ProbMoe1 {
    static constexpr bool FP8 = true;
    const fp8_t* FX; const fp8_t* W1T; const int* list; const LAS int* tpre; const LAS int* cnt; const LAS unsigned char* texp; LAS int* toks; int scale_w, scale_x; pg8::TileOrder ord;
    __device__ __forceinline__ int ldb_bytes() const { return D; }
    __device__ __forceinline__ int ntiles() const { return D / 128; }
    __device__ __forceinline__ bool next(int i, Unit& u) const {
        if (!ord.next(i, u.pm, u.pn)) return false;
        u.rt = u.pm; u.e = texp[u.rt]; return true;
    }
    __device__ __forceinline__ const char* a_ptr(const Unit&) const { return (const char*)FX; }
    __device__ __forceinline__ const char* b_ptr(const Unit& u) const { return (const char*)(W1T + ((size_t)u.e * 2048 + (size_t)u.pn * 256) * D); }
    __device__ __forceinline__ void list_prefetch(const Unit& u, int par, int wid, int lane) const {
        if (wid == 0) { const int* src = list + (size_t)u.e * NT + (u.rt - tpre[u.e]) * 256 + 4 * lane;
            __builtin_amdgcn_global_load_lds((const unsigned*)src, (LAS unsigned*)(toks + par * 256), 16, 0, 0); }
    }
    __device__ __forceinline__ void a_off(const Unit& u, int par, const int (&R)[2], const int (&C)[2], unsigned (&v)[2][2]) const {
        const int nvalid = cnt[u.e] - (u.rt - tpre[u.e]) * 256; const LAS int* tk = toks + par * 256;
#pragma unroll
        for (int h = 0; h < 2; ++h)
#pragma unroll
            for (int i = 0; i < 2; ++i) { const int r = h * 128 + R[i]; const int tok = tk[r < nvalid ? r : 0]; v[h][i] = (unsigned)(tok * D + C[i] * 2); }
    }
};
struct ProbMoe2 {
    static constexpr bool FP8 = true;
    const fp8_t* ACT; const fp8_t* W2T; const LAS int* tpre; const LAS unsigned char* texp; int scale_w, scale_x; pg8::TileOrder ord;
    __device__ __forceinline__ int ldb_bytes() const { return D; }
    __device__ __forceinline__ int ntiles() const { return D / 128; }
    __device__ __forceinline__ bool next(int i, Unit& u) const {
        if (!ord.next(i, u.pm, u.pn)) return false;
        u.rt = ord.nM - 1 - u.pm; u.e = texp[u.rt]; return true;
    }
    __device__ __forceinline__ const char* a_ptr(const Unit& u) const { return (const char*)(ACT + (size_t)u.rt * 256 * D); }
    __device__ __forceinline__ const char* b_ptr(const Unit& u) const { return (const char*)(W2T + ((size_t)u.e * 1024 + (size_t)u.pn * 256) * D); }
    __device__ __forceinline__ void list_prefetch(const Unit&, int, int, int) const {}
    __device__ __forceinline__ void a_off(const Unit&, int, const int (&R)[2], const int (&C)[2], unsigned (&v)[2][2]) const {
#pragma unroll
        for (int h = 0; h < 2; ++h)
#pragma unroll
            for (int i = 0; i < 2; ++i) v[h][i] = (unsigned)((h * 128 + R[i]) * D + C[i] * 2);
    }
};
struct Args { const float* in[38]; float* out; unsigned char* ws; int phase; int one; };
enum { I_X = 0, I_C, I_CTX, I_CCTX, I_ADAW, I_ADAB, I_NORMG, I_AWQKV, I_ABQKV, I_AWO, I_ABO, I_ASINK, I_PW, I_PB, I_PS,
       I_RMIX, I_RWRKV, I_RW0, I_RW1, I_RW2, I_RA0, I_RA1, I_RA2, I_RG1, I_RG2, I_RKK, I_RKA, I_RRK, I_RLNW, I_RLNB, I_RWO,
       I_MWR, I_MBR, I_MW1, I_MB1, I_MW2, I_MB2, I_FG };
struct Frame { LAS unsigned char* lds; int tid, lane, wave, G, c; unsigned char* ws; unsigned* ctl; };
#define WSP(T_, off) ((T_*)(F.ws + (off)))

struct TJob { const float* src; unsigned char* dst; long sbs, dbs; int ldw, ldt, nkb, nnb, mode, item0, per, esz; };
__device__ __forceinline__ int dst_row(int mode, int n) {
    if (mode == 1) { const int hb = n & ~63, d = n & 63; const int ax = d >> 5, dd = d & 31, hf = dd >> 4, f = dd & 15; const int g = ax * 4 + (f >> 2), i = (f & 3) + 4 * hf; return hb + 8 * g + i; }
    if (mode == 2) { return n < 1024 ? ((n >> 7) << 8) + (n & 127) : (((n - 1024) >> 7) << 8) + 128 + (n & 127); }
    return n;
}
struct TItem { const float* src; unsigned char* dst; int ldw, ldt, mode, n0, esz; };
__device__ __forceinline__ void titem_decode(const LAS TJob* jobs, int nj, int it, TItem& T) {
    int ji = 0;
    for (int q = 1; q < nj; ++q) ji += (jobs[q].item0 <= it) ? 1 : 0;
    const LAS TJob& J = jobs[ji]; const int r = it - J.item0, bi = r / J.per, rr = r % J.per, kb = rr / J.nnb, nb = rr % J.nnb;
    T.src = J.src + bi * J.sbs + (size_t)(64 * kb) * J.ldw + 32 * nb; T.dst = J.dst + (bi * J.dbs + 64 * kb) * J.esz; T.ldw = J.ldw; T.ldt = J.ldt; T.mode = J.mode; T.n0 = 32 * nb; T.esz = J.esz;
}
__device__ __forceinline__ void titem_load(const TItem& T, int lane, f32x4 (&v)[8]) {
    const float* p = T.src + (size_t)(lane >> 3) * T.ldw + 4 * (lane & 7);
#pragma unroll
    for (int i = 0; i < 8; ++i) v[i] = *(const __attribute__((address_space(1))) f32x4*)(p + (size_t)(8 * i) * T.ldw);
}
__device__ __forceinline__ void titem_store(const TItem& T, int lane, const f32x4 (&v)[8], LAS float* scr) {
#pragma unroll
    for (int i = 0; i < 8; ++i) { LAS float* d = scr + (8 * i + (lane >> 3)) * 33 + 4 * (lane & 7); d[0] = v[i].x; d[1] = v[i].y; d[2] = v[i].z; d[3] = v[i].w; }
    LDS_WAIT(); asm volatile("" ::: "memory");
    const int c = lane & 7;
#pragma unroll
    for (int j = 0; j < 4; ++j) { const int n = (lane >> 3) + 8 * j; const LAS float* s = scr + (8 * c) * 33 + n;
        const size_t eo = (size_t)dst_row(T.mode, T.n0 + n) * T.ldt + 8 * c;
        if (T.esz == 2) { u32x4 o; o.x = pk2(s[0 * 33], s[1 * 33]); o.y = pk2(s[2 * 33], s[3 * 33]); o.z = pk2(s[4 * 33], s[5 * 33]); o.w = pk2(s[6 * 33], s[7 * 33]); *(__attribute__((address_space(1))) u32x4*)(T.dst + eo * 2) = o; }
        else { u32x2 o; o.x = pk4_fp8(64.f * s[0 * 33], 64.f * s[1 * 33], 64.f * s[2 * 33], 64.f * s[3 * 33]); o.y = pk4_fp8(64.f * s[4 * 33], 64.f * s[5 * 33], 64.f * s[6 * 33], 64.f * s[7 * 33]); *(__attribute__((address_space(1))) u32x2*)(T.dst + eo) = o; } }
    LDS_WAIT(); asm volatile("" ::: "memory");
}
__device__ __forceinline__ void phase_prologue(Frame& F, const Args& A) {
    REFRESH(F);
    LAS float* S = (LAS float*)F.lds;
    for (int idx = F.tid; idx < 33 * 1024; idx += NTHREADS) { const int r = idx >> 10, k = idx & 1023; const float v = r < 32 ? A.in[I_C][r * 1024 + k] : A.in[I_CCTX][k]; S[k * 33 + r] = v / (1.0f + __expf(-v)); }
    __syncthreads();
    float* MOD = WSP(float, WS_MOD);
    for (int it = F.c; it < 4 * 48; it += F.G) {
        const int layer = it / 48, n = (it % 48) * 128 + F.lane; const float* wp = A.in[I_ADAW] + (size_t)layer * 1024 * 6144 + n;
        float acc[5] = {0.f, 0.f, 0.f, 0.f, 0.f}, acd[5] = {0.f, 0.f, 0.f, 0.f, 0.f};
        for (int k0 = 0; k0 < 1024; k0 += 16) {
            float wv[16], wd[16];
#pragma unroll
            for (int u = 0; u < 16; ++u) { wv[u] = wp[(size_t)(k0 + u) * 6144]; wd[u] = wp[(size_t)(k0 + u) * 6144 + 64]; }
#pragma unroll
            for (int u = 0; u < 16; ++u) { const LAS float* sr = S + (k0 + u) * 33 + F.wave; const float s0 = sr[0], s1 = sr[8], s2 = sr[16], s3 = sr[24];
                acc[0] += s0 * wv[u]; acc[1] += s1 * wv[u]; acc[2] += s2 * wv[u]; acc[3] += s3 * wv[u];
                acd[0] += s0 * wd[u]; acd[1] += s1 * wd[u]; acd[2] += s2 * wd[u]; acd[3] += s3 * wd[u];
                if (F.wave == 0) { const float s4 = S[(k0 + u) * 33 + 32]; acc[4] += s4 * wv[u]; acd[4] += s4 * wd[u]; } }
        }
        const float bb = A.in[I_ADAB][layer * 6144 + n], bd = A.in[I_ADAB][layer * 6144 + n + 64];
#pragma unroll
        for (int i = 0; i < 4; ++i) { MOD[((size_t)layer * 33 + F.wave + 8 * i) * 6144 + n] = acc[i] + bb; MOD[((size_t)layer * 33 + F.wave + 8 * i) * 6144 + n + 64] = acd[i] + bd; }
        if (F.wave == 0) { MOD[((size_t)layer * 33 + 32) * 6144 + n] = acc[4] + bb; MOD[((size_t)layer * 33 + 32) * 6144 + n + 64] = acd[4] + bd; }
    }
    { float* rc = WSP(float, WS_ROPEC); float* rs = WSP(float, WS_ROPES);
      for (int idx = F.c * NTHREADS + F.tid; idx < 2048 * 32; idx += F.G * NTHREADS) { const int t = idx >> 5, e = idx & 31, g = e >> 2, i = e & 3, f = 4 * (g & 3) + i;
          const float inv = powf(10000.0f, -(float)f / 16.0f); const float pos = (float)(g < 4 ? (t >> 6) : (t & 63)); const float ang = pos * inv; rc[idx] = cosf(ang); rs[idx] = sinf(ang); }
      float* bq = WSP(float, WS_BQK);
      for (int idx = F.c * NTHREADS + F.tid; idx < 2 * 1280; idx += F.G * NTHREADS) { const int j = idx / 1280, n = idx % 1280; bq[j * 1280 + dst_row(1, n)] = A.in[I_ABQKV][j * 1536 + n]; } }
    __syncthreads();
    LAS TJob* jobs = (LAS TJob*)(F.lds + JOB_OFF); LAS int* njobs = (LAS int*)(F.lds + MISC_OFF + 64);
    if (F.tid == 0) {
        int nj = 0, item = 0;
        auto add = [&](const float* src, bf16_t* dst, int ldw, int ldt, int Ks, int Ns, int mode, int nb, long sbs, long dbs, int esz = 2) {
            LAS TJob& j = jobs[nj]; j.src = src; j.dst = (unsigned char*)dst; j.sbs = sbs; j.dbs = dbs; j.ldw = ldw; j.ldt = ldt; j.nkb = Ks / 64; j.nnb = Ns / 32; j.mode = mode; j.item0 = item; j.per = (Ks / 64) * (Ns / 32); j.esz = esz;
            ++nj; item += (Ks / 64) * (Ns / 32) * nb; };
        add(A.in[I_AWQKV], WSP(bf16_t, WS_WQK), 1536, 1024, 1024, 1280, 1, 2, 1024L * 1536, 1280L * 1024, 1);
        add(A.in[I_AWQKV] + 1280, WSP(bf16_t, WS_WV), 1536, 1024, 1024, 256, 0, 2, 1024L * 1536, 256L * 1024, 1);
        add(A.in[I_AWO], WSP(bf16_t, WS_WO), 1024, 1024, 1024, 1024, 0, 2, 1L << 20, 1L << 20, 1);
        add(A.in[I_PW], WSP(bf16_t, WS_POOLW), 256, 256, 256, 256, 0, 4, 65536, 65536);
        add(A.in[I_RWRKV], WSP(bf16_t, WS_WRKV), 1024, 1024, 1024, 1024, 0, 3, 1L << 20, 1L << 20, 1);
        add(A.in[I_RG1], WSP(bf16_t, WS_WL1), 128, 1024, 1024, 128, 0, 1, 0, 0);
        add(A.in[I_RW1], WSP(bf16_t, WS_WL1) + 256 * 1024, 64, 1024, 1024, 64, 0, 2, 65536, 65536);
        add(A.in[I_RA1], WSP(bf16_t, WS_WL1) + 2 * 256 * 1024, 64, 1024, 1024, 64, 0, 2, 65536, 65536);
        add(A.in[I_RG2], WSP(bf16_t, WS_WL2), 1024, 256, 128, 1024, 0, 1, 0, 0);
        add(A.in[I_RW2], WSP(bf16_t, WS_WL2) + 1 * 1024 * 256, 1024, 256, 64, 1024, 0, 2, 65536, 1024L * 256 + 64);
        add(A.in[I_RA2], WSP(bf16_t, WS_WL2) + 3 * 1024 * 256, 1024, 256, 64, 1024, 0, 2, 65536, 1024L * 256 + 64);
        add(A.in[I_RWO], WSP(bf16_t, WS_WOR), 1024, 1024, 1024, 1024, 0, 1, 0, 0, 1);
        add(A.in[I_MW1], WSP(bf16_t, WS_W1T), 2048, 1024, 1024, 2048, 2, 128, 1024L * 2048, 2048L * 1024, 1);
        add(A.in[I_MW2], WSP(bf16_t, WS_W2T), 1024, 1024, 1024, 1024, 0, 128, 1L << 20, 1L << 20, 1);
        njobs[0] = nj; njobs[1] = item;
    }
    __syncthreads();
    { const int nj = njobs[0], nitems = njobs[1]; LAS float* scr = (LAS float*)(F.lds + F.wave * 16384);
      const int gw = F.c * NWAVES + F.wave, NGW = F.G * NWAVES;
      int it = gw;
      if (it < nitems) {
          TItem Ta, Tb, Tc; f32x4 va[8], vb[8], vc[8];
          bool hb = it + NGW < nitems;
          titem_decode(jobs, nj, it, Ta); titem_load(Ta, F.lane, va);
          Tb = Ta; Tc = Ta;
#pragma unroll
          for (int i = 0; i < 8; ++i) { vb[i] = va[i]; vc[i] = va[i]; }
          if (hb) { titem_decode(jobs, nj, it + NGW, Tb); titem_load(Tb, F.lane, vb); }
          for (;;) {
              const int itc = it + 2 * NGW; const bool hc = hb && itc < nitems;
              if (hc) { titem_decode(jobs, nj, itc, Tc); titem_load(Tc, F.lane, vc); }
              titem_store(Ta, F.lane, va, scr);
              if (!hb) break;
              Ta = Tb; Tb = Tc;
#pragma unroll
              for (int i = 0; i < 8; ++i) { va[i] = vb[i]; vb[i] = vc[i]; }
              hb = hc; it += NGW;
          }
      } }
    __syncthreads();
}

__device__ __forceinline__ void moe_tiles(Frame& F, int layer) {
    REFRESH(F);
    LAS int* lcnt = (LAS int*)(F.lds + LCNT_OFF); LAS int* tpre = (LAS int*)(F.lds + TPRE_OFF);
    __syncthreads();
    if (F.tid < NE) lcnt[F.tid] = (int)__hip_atomic_load(F.ctl + CW_GCNT + layer * 64 + F.tid, __ATOMIC_RELAXED, __HIP_MEMORY_SCOPE_AGENT);
    __syncthreads();
    if (F.tid == 0) { int s = 0; for (int e = 0; e < NE; ++e) { tpre[e] = s; s += (lcnt[e] + 255) >> 8; } tpre[NE] = s; }
    __syncthreads();
    { LAS unsigned char* texp = (LAS unsigned char*)(F.lds + TEXP_OFF); const int nrt = tpre[NE];
      for (int rt = F.tid; rt < nrt; rt += NTHREADS) { int e = 0; for (int j = 1; j < NE; ++j) e += (tpre[j] <= rt) ? 1 : 0; texp[rt] = (unsigned char)e; } }
    __syncthreads();
}
constexpr int RB = 2;
#define ROWOF(it, r) ((((it) * F.G + F.c) * NWAVES + F.wave) * RB + (r))
struct MoeRef { int p[4]; float g[4]; };
__device__ __forceinline__ void moe_ref_load(Frame& F, int row, MoeRef& R) {
    const int4 pp = *(const int4*)(WSP(int, WS_POS) + (size_t)row * 4); const f32x4 gg = *(const f32x4*)(WSP(float, WS_GATE) + (size_t)row * 4);
    R.p[0] = pp.x; R.p[1] = pp.y; R.p[2] = pp.z; R.p[3] = pp.w; R.g[0] = gg.x; R.g[1] = gg.y; R.g[2] = gg.z; R.g[3] = gg.w;
}
__device__ __forceinline__ void moe_rows_load(Frame& F, const MoeRef& R, unsigned (&y)[4][4]) {
    const LAS int* tpre = (const LAS int*)(F.lds + TPRE_OFF); const unsigned char* Y = WSP(unsigned char, WS_Y);
#pragma unroll
    for (int k = 0; k < 4; ++k) { const int e = R.p[k] >> 20, slot = R.p[k] & 0xfffff; const size_t fr = (size_t)tpre[e] * 256 + slot; const unsigned* yp = (const unsigned*)(Y + fr * D) + F.lane;
#pragma unroll
        for (int j = 0; j < 4; ++j) y[k][j] = yp[64 * j]; }
}
__device__ __forceinline__ f32x4 moe_rows_sum(const MoeRef& R, const unsigned (&y)[4][4], int j) {
    f32x4 s = (f32x4){0.f, 0.f, 0.f, 0.f};
#pragma unroll
    for (int k = 0; k < 4; ++k) { const int w = (int)y[k][j]; const f32x2 lo = __builtin_amdgcn_cvt_pk_f32_fp8(w, false), hi = __builtin_amdgcn_cvt_pk_f32_fp8(w, true);
        s += (R.g[k] * 0.25f) * (f32x4){lo.x, lo.y, hi.x, hi.y}; }
    return s;
}

__device__ __forceinline__ void phase_norm1(Frame& F, const Args& A, int layer) {
    REFRESH(F);
    if (layer > 0) moe_tiles(F, layer - 1);
    bf16_t* H = WSP(bf16_t, WS_H); bf16_t* AX = WSP(bf16_t, WS_AX); const float* MOD = WSP(float, WS_MOD);
    const float* g1 = A.in[I_NORMG] + (size_t)(layer * 2 + 0) * D;
    f32x4 gg[4];
#pragma unroll
    for (int j = 0; j < 4; ++j) gg[j] = ((const f32x4*)g1)[64 * j + F.lane];
    for (int it = 0;; ++it) { if (ROWOF(it, 0) >= NT) break;
        f32x4 v[RB][4]; int brow[RB];
        if (layer == 0) {
#pragma unroll
            for (int r = 0; r < RB; ++r) { const int row = ROWOF(it, r); brow[r] = row < NX ? (row >> 11) : 32; const float* src = row < NX ? A.in[I_X] + (size_t)row * D : A.in[I_CTX] + (size_t)(row - NX) * D;
#pragma unroll
                for (int j = 0; j < 4; ++j) v[r][j] = ((const f32x4*)src)[64 * j + F.lane]; }
        } else {
            MoeRef R[RB]; unsigned y[RB][4][4]; f32x4 gv[RB][4];
#pragma unroll
            for (int r = 0; r < RB; ++r) moe_ref_load(F, ROWOF(it, r), R[r]);
#pragma unroll
            for (int r = 0; r < RB; ++r) { const int row = ROWOF(it, r); brow[r] = row < NX ? (row >> 11) : 32; moe_rows_load(F, R[r], y[r]);
                const float* g2p = MOD + ((size_t)(layer - 1) * 33 + brow[r]) * 6144 + 5 * D;
#pragma unroll
                for (int j = 0; j < 4; ++j) { v[r][j] = ld_bf4(H + (size_t)row * D + 256 * j + 4 * F.lane); gv[r][j] = ((const f32x4*)g2p)[64 * j + F.lane]; } }
#pragma unroll
            for (int r = 0; r < RB; ++r)
#pragma unroll
                for (int j = 0; j < 4; ++j) v[r][j] = v[r][j] + gv[r][j] * moe_rows_sum(R[r], y[r], j);
        }
        float rstd[RB];
#pragma unroll
        for (int r = 0; r < RB; ++r) { const int row = ROWOF(it, r); float ss = 0.f;
#pragma unroll
            for (int j = 0; j < 4; ++j) { st_bf4(H + (size_t)row * D + 256 * j + 4 * F.lane, v[r][j]); ss += (v[r][j].x * v[r][j].x + v[r][j].y * v[r][j].y) + (v[r][j].z * v[r][j].z + v[r][j].w * v[r][j].w); }
            rstd[r] = 1.0f / sqrtf(wave_sum(ss) * (1.0f / D) + 1e-5f); }
#pragma unroll
        for (int r = 0; r < RB; ++r) { const int row = ROWOF(it, r); const float* mp = MOD + ((size_t)layer * 33 + brow[r]) * 6144;
#pragma unroll
            for (int j = 0; j < 4; ++j) { const f32x4 sh = ((const f32x4*)mp)[64 * j + F.lane], sc = ((const f32x4*)(mp + D))[64 * j + F.lane];
                const f32x4 o = v[r][j] * rstd[r] * gg[j] * (sc + 1.0f) + sh;
                if (layer % 3 == 0) ((unsigned*)((unsigned char*)AX + (size_t)row * D))[64 * j + F.lane] = pk4_fp8(o.x, o.y, o.z, o.w);
                else { u32x2 w; w.x = pk2(o.x, o.y); w.y = pk2(o.z, o.w); ((u32x2*)(AX + (size_t)row * D))[64 * j + F.lane] = w; } } }
    }
}
__device__ __forceinline__ void phase_final(Frame& F, const Args& A) {
    REFRESH(F);
    moe_tiles(F, DEPTH - 1);
    const bf16_t* H = WSP(bf16_t, WS_H); const float* MOD = WSP(float, WS_MOD); const float* fg = A.in[I_FG];
    f32x4 gg[4];
#pragma unroll
    for (int j = 0; j < 4; ++j) gg[j] = ((const f32x4*)fg)[64 * j + F.lane];
    for (int it = 0;; ++it) { if (ROWOF(it, 0) >= NX) break;
        MoeRef R[RB]; unsigned y[RB][4][4]; f32x4 v[RB][4], gv[RB][4];
#pragma unroll
        for (int r = 0; r < RB; ++r) moe_ref_load(F, ROWOF(it, r), R[r]);
#pragma unroll
        for (int r = 0; r < RB; ++r) { const int row = ROWOF(it, r); moe_rows_load(F, R[r], y[r]); const float* g2p = MOD + ((size_t)(DEPTH - 1) * 33 + (row >> 11)) * 6144 + 5 * D;
#pragma unroll
            for (int j = 0; j < 4; ++j) { v[r][j] = ld_bf4(H + (size_t)row * D + 256 * j + 4 * F.lane); gv[r][j] = ((const f32x4*)g2p)[64 * j + F.lane]; } }
#pragma unroll
        for (int r = 0; r < RB; ++r) { const int row = ROWOF(it, r); float ss = 0.f;
#pragma unroll
            for (int j = 0; j < 4; ++j) { v[r][j] = v[r][j] + gv[r][j] * moe_rows_sum(R[r], y[r], j); ss += (v[r][j].x * v[r][j].x + v[r][j].y * v[r][j].y) + (v[r][j].z * v[r][j].z + v[r][j].w * v[r][j].w); }
            const float rstd = 1.0f / sqrtf(wave_sum(ss) * (1.0f / D) + 1e-5f);
#pragma unroll
            for (int j = 0; j < 4; ++j) ((f32x4*)(A.out + (size_t)row * D))[64 * j + F.lane] = v[r][j] * rstd * gg[j]; }
    }
}

template <int DD> __device__ __forceinline__ float dpp_ror(float v) { return __builtin_bit_cast(float, __builtin_amdgcn_update_dpp(0, __builtin_bit_cast(int, v), 0x120 + DD, 0xf, 0xf, false)); }
template <int DD> __device__ __forceinline__ void rank_step(float v0, float v1, int e0, int& r0, int& r1) {
    const float u0 = dpp_ror<DD>(v0), u1 = dpp_ror<DD>(v1); const bool low = DD <= e0;
    r0 += (u0 > v0 || (u0 == v0 && low)) ? 1 : 0; r0 += (u1 > v0) ? 1 : 0;
    r1 += (u0 >= v1) ? 1 : 0; r1 += (u1 > v1 || (u1 == v1 && low)) ? 1 : 0;
}
__device__ __forceinline__ float row_allmax(float v) { v = fmaxf(v, dpp_ror<8>(v)); v = fmaxf(v, dpp_ror<4>(v)); v = fmaxf(v, dpp_ror<2>(v)); v = fmaxf(v, dpp_ror<1>(v)); return v; }
__device__ __forceinline__ float row_allsum(float v) { v += dpp_ror<8>(v); v += dpp_ror<4>(v); v += dpp_ror<2>(v); v += dpp_ror<1>(v); return v; }
__device__ __forceinline__ void phase_route(Frame& F, const Args& A, int layer) {
    REFRESH(F);
    const int nrows = (layer == DEPTH - 1) ? NX : NT; const int TPB = nrows / 16 / F.G;
    LAS float* wT = (LAS float*)F.lds;
    LAS int* lcnt = (LAS int*)(F.lds + LCNT_OFF); LAS int* lbase = (LAS int*)(F.lds + LBASE_OFF);
    LAS unsigned* recp = (LAS unsigned*)(F.lds + REC_OFF); LAS float* recg = (LAS float*)(F.lds + REC_OFF + 4608);
    __syncthreads();
    { const float* wr = A.in[I_MWR] + (size_t)layer * D * NE;
      for (int idx = F.tid; idx < D * NE; idx += NTHREADS) wT[(idx & 31) * 1024 + (idx >> 5)] = wr[idx]; }
    if (F.tid < NE) lcnt[F.tid] = 0;
    __syncthreads();
    const bf16_t* H = WSP(bf16_t, WS_H); unsigned char* FX = WSP(unsigned char, WS_FX); const float* MOD = WSP(float, WS_MOD);
    const float* g2 = A.in[I_NORMG] + (size_t)(layer * 2 + 1) * D; const float* br = A.in[I_MBR] + layer * NE;
    const int l = F.lane, r16 = l & 15, q4 = l >> 4; const float b0 = br[r16], b1 = br[16 + r16];
    for (int k = F.wave; k < TPB; k += NWAVES) {
        const int row0 = (F.c * TPB + k) * 16, row = row0 + r16; const int brow = row0 < NX ? (row0 >> 11) : 32;
        const float* mp = MOD + ((size_t)layer * 33 + brow) * 6144 + 3 * D;
        const bf16_t* hp = H + (size_t)row * D + 8 * q4; float ss = 0.f;
#pragma unroll 8
        for (int j = 0; j < 32; ++j) { const u32x4 w = *(const u32x4*)(hp + 32 * j); const float a0 = bflo(w.x), a1 = bfhi(w.x), a2 = bflo(w.y), a3 = bfhi(w.y), a4 = bflo(w.z), a5 = bfhi(w.z), a6 = bflo(w.w), a7 = bfhi(w.w);
            ss += ((a0 * a0 + a1 * a1) + (a2 * a2 + a3 * a3)) + ((a4 * a4 + a5 * a5) + (a6 * a6 + a7 * a7)); }
        ss += __shfl_xor(ss, 16); ss += __shfl_xor(ss, 32);
        const float rstd = 1.0f / sqrtf(ss * (1.0f / D) + 1e-5f);
        f32x4 acc0 = (f32x4){0.f, 0.f, 0.f, 0.f}, acc1 = acc0;
        const float* gp = g2 + 8 * q4; const float* shp = mp + 8 * q4; const float* scp = mp + D + 8 * q4; unsigned char* fxp = FX + (size_t)row * D + 8 * q4;
        const LAS float* w0p = wT + r16 * 1024 + 8 * q4; const LAS float* w1p = wT + (16 + r16) * 1024 + 8 * q4;
#pragma unroll 2
        for (int j = 0; j < 32; ++j) { const u32x4 w = *(const u32x4*)(hp + 32 * j);
            const f32x4 ga = *(const f32x4*)(gp + 32 * j), gb = *(const f32x4*)(gp + 32 * j + 4), sa = *(const f32x4*)(shp + 32 * j), sb = *(const f32x4*)(shp + 32 * j + 4), ca = *(const f32x4*)(scp + 32 * j), cb = *(const f32x4*)(scp + 32 * j + 4);
            const f32x4 fa = (f32x4){bflo(w.x), bfhi(w.x), bflo(w.y), bfhi(w.y)} * rstd * ga * (ca + 1.0f) + sa, fb = (f32x4){bflo(w.z), bfhi(w.z), bflo(w.w), bfhi(w.w)} * rstd * gb * (cb + 1.0f) + sb;
            *(u32x2*)(fxp + 32 * j) = (u32x2){pk4_fp8(fa.x, fa.y, fa.z, fa.w), pk4_fp8(fb.x, fb.y, fb.z, fb.w)};
            const f32x4 w0a = *(const LAS f32x4*)(w0p + 32 * j), w0b = *(const LAS f32x4*)(w0p + 32 * j + 4), w1a = *(const LAS f32x4*)(w1p + 32 * j), w1b = *(const LAS f32x4*)(w1p + 32 * j + 4);
#pragma unroll
            for (int s4 = 0; s4 < 4; ++s4) { acc0 = __builtin_amdgcn_mfma_f32_16x16x4f32(fa[s4], w0a[s4], acc0, 0, 0, 0); acc1 = __builtin_amdgcn_mfma_f32_16x16x4f32(fa[s4], w1a[s4], acc1, 0, 0, 0); }
#pragma unroll
            for (int s4 = 0; s4 < 4; ++s4) { acc0 = __builtin_amdgcn_mfma_f32_16x16x4f32(fb[s4], w0b[s4], acc0, 0, 0, 0); acc1 = __builtin_amdgcn_mfma_f32_16x16x4f32(fb[s4], w1b[s4], acc1, 0, 0, 0); } }
#pragma unroll
        for (int reg = 0; reg < 4; ++reg) {
            const float v0 = acc0[reg] + b0, v1 = acc1[reg] + b1; int r0 = (v1 > v0) ? 1 : 0, r1 = (v0 >= v1) ? 1 : 0;
            rank_step<1>(v0, v1, r16, r0, r1); rank_step<2>(v0, v1, r16, r0, r1); rank_step<3>(v0, v1, r16, r0, r1); rank_step<4>(v0, v1, r16, r0, r1); rank_step<5>(v0, v1, r16, r0, r1);
            rank_step<6>(v0, v1, r16, r0, r1); rank_step<7>(v0, v1, r16, r0, r1); rank_step<8>(v0, v1, r16, r0, r1); rank_step<9>(v0, v1, r16, r0, r1); rank_step<10>(v0, v1, r16, r0, r1);
            rank_step<11>(v0, v1, r16, r0, r1); rank_step<12>(v0, v1, r16, r0, r1); rank_step<13>(v0, v1, r16, r0, r1); rank_step<14>(v0, v1, r16, r0, r1); rank_step<15>(v0, v1, r16, r0, r1);
            const float mx = row_allmax(fmaxf(v0, v1));
            const float x0 = r0 < 4 ? __expf(v0 - mx) : 0.f, x1 = r1 < 4 ? __expf(v1 - mx) : 0.f;
            const float inv = 1.0f / row_allsum(x0 + x1);
            const int lr = k * 16 + 4 * q4 + reg;
            if (r0 < 4) { const int rk = __hip_atomic_fetch_add(lcnt + r16, 1, __ATOMIC_RELAXED, __HIP_MEMORY_SCOPE_WORKGROUP); recp[lr * 4 + r0] = ((unsigned)r16 << 20) | (unsigned)rk; recg[lr * 4 + r0] = x0 * inv; }
            if (r1 < 4) { const int rk = __hip_atomic_fetch_add(lcnt + 16 + r16, 1, __ATOMIC_RELAXED, __HIP_MEMORY_SCOPE_WORKGROUP); recp[lr * 4 + r1] = ((unsigned)(16 + r16) << 20) | (unsigned)rk; recg[lr * 4 + r1] = x1 * inv; }
        }
    }
    __syncthreads();
    if (F.tid < NE) lbase[F.tid] = (int)__hip_atomic_fetch_add(F.ctl + CW_GCNT + layer * 64 + F.tid, (unsigned)lcnt[F.tid], __ATOMIC_RELAXED, __HIP_MEMORY_SCOPE_AGENT);
    __syncthreads();
    int* LIST = WSP(int, WS_LIST); int* POS = WSP(int, WS_POS); float* GATE = WSP(float, WS_GATE);
    for (int r = F.tid; r < TPB * 16 * 4; r += NTHREADS) { const int lr = r >> 2, kk = r & 3; const int row = F.c * TPB * 16 + lr;
        const unsigned qx = recp[r]; const float qg = recg[r]; const int e = qx >> 20, slot = lbase[e] + (int)(qx & 0xfffff);
        LIST[(size_t)e * NT + slot] = row; POS[(size_t)row * 4 + kk] = (e << 20) | slot; GATE[(size_t)row * 4 + kk] = qg; }
    __syncthreads();
}

__device__ __forceinline__ void phase_pooldiff(Frame& F) {
    REFRESH(F);
    const bf16_t* AX = WSP(bf16_t, WS_AX); bf16_t* PD = WSP(bf16_t, WS_PD);
    for (int it = 0;; ++it) { if (ROWOF(it, 0) >= NT) break;
        const int row0 = ROWOF(it, 0); int sb, t, n; seq_of(row0, sb, t, n);
#pragma unroll
        for (int j = 0; j < 4; ++j) { const int half = 1 << j; const int col = 256 * j + 4 * F.lane;
            f32x4 s0 = (f32x4){0.f, 0.f, 0.f, 0.f}, s1 = s0, me0 = s0, me1 = s0;
#pragma unroll
            for (int q = 0; q < 2 * half + 1; ++q) { const int uu = t - half + q;
                if (uu >= 0 && uu < n) { const f32x4 x = ld_bf4(AX + (size_t)(sb + uu) * D + col); if (q < 2 * half) s0 += x; if (q > 0) s1 += x; if (q == half) me0 = x; if (q == half + 1) me1 = x; } }
            const int lo0 = t - half < 0 ? 0 : t - half, hi0 = t + half > n ? n : t + half, lo1 = t + 1 - half < 0 ? 0 : t + 1 - half, hi1 = t + 1 + half > n ? n : t + 1 + half;
            st_bf4(PD + (size_t)row0 * D + col, s0 * (1.0f / (float)(hi0 - lo0)) - me0);
            st_bf4(PD + (size_t)(row0 + 1) * D + col, s1 * (1.0f / (float)(hi1 - lo1)) - me1); }
    }
}
__device__ __forceinline__ void phase_rwkv_mix(Frame& F, const Args& A) {
    REFRESH(F);
    const bf16_t* AX = WSP(bf16_t, WS_AX); bf16_t* A6 = WSP(bf16_t, WS_A6); const float* mix = A.in[I_RMIX];
    for (int it = 0;; ++it) { if (ROWOF(it, 0) >= NT) break;
        const int row0 = ROWOF(it, 0); int sb, t, n; seq_of(row0, sb, t, n);
#pragma unroll
        for (int j = 0; j < 4; ++j) { const int col = 256 * j + 4 * F.lane; const f32x4 z = (f32x4){0.f, 0.f, 0.f, 0.f};
            const f32x4 h0 = ld_bf4(AX + (size_t)row0 * D + col), h1 = ld_bf4(AX + (size_t)(row0 + 1) * D + col);
            const f32x4 hp = t > 0 ? ld_bf4(AX + (size_t)(row0 - 1) * D + col) : z, hn = t + 1 < n - 1 ? ld_bf4(AX + (size_t)(row0 + 2) * D + col) : z;
            const f32x4 xx0 = (hp + h1) * 0.5f - h0, xx1 = (h0 + hn) * 0.5f - h1;
#pragma unroll
            for (int i = 0; i < 6; ++i) { const f32x4 m = *(const f32x4*)(mix + i * D + col); const f32x4 o0 = h0 + xx0 * m, o1 = h1 + xx1 * m;
                if (i == 0 || i == 2 || i == 3) { unsigned char* p8 = (unsigned char*)(A6 + (size_t)i * NT * D);
                    *(unsigned*)(p8 + (size_t)row0 * D + col) = pk4_fp8(o0.x, o0.y, o0.z, o0.w); *(unsigned*)(p8 + (size_t)(row0 + 1) * D + col) = pk4_fp8(o1.x, o1.y, o1.z, o1.w); }
                else { st_bf4(A6 + ((size_t)i * NT + row0) * D + col, o0); st_bf4(A6 + ((size_t)i * NT + row0 + 1) * D + col, o1); } } }
    }
}
__device__ __forceinline__ float rl(float x, int k) { return __builtin_bit_cast(float, __builtin_amdgcn_readlane(__builtin_bit_cast(int, x), k)); }
typedef float f32x16 __attribute__((ext_vector_type(16)));
constexpr int SCW = 33792;
__device__ __forceinline__ int kpos(int k) { return (k & ~12) | ((k & 4) << 1) | ((k & 8) >> 1); }
__device__ __forceinline__ bf16x8 acc_frag(const f32x16& X, int s2) {
    u32x4 w; w.x = cvt_pk_bf16(X[8 * s2 + 0], X[8 * s2 + 1]); w.y = cvt_pk_bf16(X[8 * s2 + 2], X[8 * s2 + 3]); w.z = cvt_pk_bf16(X[8 * s2 + 4], X[8 * s2 + 5]); w.w = cvt_pk_bf16(X[8 * s2 + 6], X[8 * s2 + 7]);
    return __builtin_bit_cast(bf16x8, w);
}
#define MFMA32(a, b, c) __builtin_amdgcn_mfma_f32_32x32x16_bf16(a, b, c, 0, 0, 0)
__device__ __forceinline__ void phase_rwkv_scan(Frame& F, const Args& A) {
    REFRESH(F);
    volatile LAS int* psync = (volatile LAS int*)(F.lds + MISC_OFF + 128);
    if (F.tid < 8) psync[F.tid] = 0;
    __syncthreads();
    int pphase = 0;
#define PAIR_SYNC() do { asm volatile("s_waitcnt lgkmcnt(0)" ::: "memory"); ++pphase; psync[pr * 2 + hw] = pphase; \
        for (unsigned sp_ = 0; psync[pr * 2 + (hw ^ 1)] < pphase && sp_ < (1u << 24); ++sp_) { } asm volatile("" ::: "memory"); } while (0)
    const int pr = F.wave >> 1, hw = F.wave & 1;
    for (int item = pr * F.G + F.c; item < 1024; item += 4 * F.G) {
        const int dir = item >> 9, b = (item >> 4) & 31, hd = item & 15, col = 64 * hd + F.lane;
        const int l = F.lane, r32 = l & 31, hh = l >> 5;
        const bf16_t* Rr = WSP(bf16_t, WS_RKV); const bf16_t* Kk = Rr + (size_t)NT * D; const bf16_t* Vv = Kk + (size_t)NT * D;
        const bf16_t* Ee = WSP(bf16_t, WS_E) + (size_t)dir * NT * D; const bf16_t* Aa = WSP(bf16_t, WS_A) + (size_t)dir * NT * D;
        bf16_t* Yo = WSP(bf16_t, WS_YS) + (size_t)dir * NT * D; float* Bo = WSP(float, WS_BONUS) + (size_t)dir * NT * 16;
        const float kkw = A.in[I_RKK][col], kaw = A.in[I_RKA][col], rkw = A.in[I_RRK][col];
        LAS unsigned char* RA = F.lds + pr * SCW; LAS unsigned char* RB = RA + 16384; LAS unsigned char* RV = RA + 25600;
        LAS float* cCb = (LAS float*)(F.lds + REC_OFF + pr * 256);
        LAS bf16_t* XT = (LAS bf16_t*)RA;
        LAS bf16_t* BK = (LAS bf16_t*)(RA + 8192);
        const int kp = kpos(l), vb = hw;
        f32x16 ST[2];
#pragma unroll
        for (int i = 0; i < 2; ++i)
#pragma unroll
            for (int q = 0; q < 16; ++q) ST[i][q] = 0.f;
        for (int seg = 0; seg < 2; ++seg) {
            const int base = seg ? b * T : NX + b * L, n = seg ? T : L; const int dt = dir ? -1 : 1; const int t0 = dir ? n - 1 : 0;
            for (int bt = 0; bt < n; bt += 32) {
                float cprev = 1.0f;
                if (hw) {
                    bf16_t e16[16];
#pragma unroll
                    for (int s = 0; s < 16; ++s) e16[s] = Ee[(size_t)(base + t0 + dt * (bt + s)) * D + col];
                    float es = 0.f;
#pragma unroll
                    for (int s = 0; s < 16; ++s) es += bf1(e16[s]);
                    cprev = __expf(-es); }
#pragma unroll
                for (int g4i = 0; g4i < 4; ++g4i) { const int g8 = 4 * hw + g4i;
                    bf16_t raw[4][5];
#pragma unroll
                    for (int s8 = 0; s8 < 4; ++s8) { const size_t o = (size_t)(base + t0 + dt * (bt + g8 * 4 + s8)) * D + col; raw[s8][0] = Rr[o]; raw[s8][1] = Kk[o]; raw[s8][2] = Vv[o]; raw[s8][3] = Aa[o]; raw[s8][4] = Ee[o]; }
                    float rr[4], kraw[4], aa[4], kk[4], kd[4], n2[4], bn[4], ww[4]; unsigned bq2[2] = {0u, 0u}, kq2[2] = {0u, 0u};
#pragma unroll
                    for (int s8 = 0; s8 < 4; ++s8) { rr[s8] = bf1(raw[s8][0]); kraw[s8] = bf1(raw[s8][1]); aa[s8] = bf1(raw[s8][3]); ww[s8] = __expf(-bf1(raw[s8][4]));
                        kk[s8] = kraw[s8] * kkw; n2[s8] = kk[s8] * kk[s8]; kd[s8] = kraw[s8] * (1.0f + (aa[s8] - 1.0f) * kaw); bn[s8] = rr[s8] * kd[s8] * rkw; }
#pragma unroll
                    for (int s8 = 0; s8 < 4; ++s8) { n2[s8] = wave_sum(n2[s8]); bn[s8] = wave_sum(bn[s8]); }
#pragma unroll
                    for (int s8 = 0; s8 < 4; ++s8) { const int t = g8 * 4 + s8;
                        if (l == 0) Bo[(size_t)(base + t0 + dt * (bt + t)) * 16 + hd] = bn[s8];
                        const float kn = kk[s8] * __builtin_amdgcn_rsqf(fmaxf(n2[s8], 1e-24f)); const float c = cprev * ww[s8]; const float ic = __builtin_amdgcn_rcpf(c);
                        const float at = -kn * cprev, rt = rr[s8] * c, bq = kn * aa[s8] * ic, kq = kd[s8] * ic;
                        const unsigned w0 = cvt_pk_bf16(at, rt), w1 = cvt_pk_bf16(bq, kq);
                        XT[t * 64 + kp] = (bf16_t)(w0 & 0xffffu); XT[(32 + t) * 64 + kp] = (bf16_t)(w0 >> 16);
                        BK[t * 64 + kp] = (bf16_t)(w1 & 0xffffu); BK[(32 + t) * 64 + kp] = (bf16_t)(w1 >> 16);
                        if (s8 & 1) { bq2[s8 >> 1] |= (w1 & 0xffffu) << 16; kq2[s8 >> 1] |= (w1 & 0xffff0000u); } else { bq2[s8 >> 1] = w1 & 0xffffu; kq2[s8 >> 1] = w1 >> 16; }
                        cprev = c; }
                    const int gp = (g8 & ~3) | ((g8 & 1) << 1) | ((g8 & 2) >> 1);
                    *(LAS u32x2*)(RB + l * 144 + gp * 8) = (u32x2){bq2[0], bq2[1]}; *(LAS u32x2*)(RB + l * 144 + 64 + gp * 8) = (u32x2){kq2[0], kq2[1]};
                    *(LAS u32x2*)(RV + l * 80 + gp * 8) = (u32x2){(unsigned)raw[0][2] | ((unsigned)raw[1][2] << 16), (unsigned)raw[2][2] | ((unsigned)raw[3][2] << 16)};
                }
                if (hw) cCb[l] = cprev;
                PAIR_SYNC();
                unsigned pf0 = 0u, pf1 = 0u;
                if (bt + 32 < n) { const size_t po = (size_t)(base + t0 + dt * (bt + 32 + 16 * hw + (l & 15))) * D + 64 * hd; const int ps = l >> 4;
                    const bf16_t* sp = ps == 0 ? Rr : ps == 1 ? Kk : ps == 2 ? Vv : Aa;
                    pf0 = *(const unsigned*)(sp + po); if (l < 16) pf1 = *(const unsigned*)(Ee + po); }
                f32x16 Mp, Np, X;
                { bf16x8 XTf[4], BKf[2][4];
#pragma unroll
                  for (int s4 = 0; s4 < 4; ++s4) { XTf[s4] = *(const LAS bf16x8*)(XT + r32 * 64 + 16 * s4 + 8 * hh); BKf[0][s4] = *(const LAS bf16x8*)(BK + r32 * 64 + 16 * s4 + 8 * hh); BKf[1][s4] = *(const LAS bf16x8*)(BK + (32 + r32) * 64 + 16 * s4 + 8 * hh); }
                  bf16x8 MkaF[2];
                  { f32x16 Tm;
#pragma unroll
                    for (int q = 0; q < 16; ++q) Tm[q] = 0.f;
#pragma unroll
                    for (int s4 = 0; s4 < 4; ++s4) Tm = MFMA32(BKf[1][s4], XTf[s4], Tm);
#pragma unroll
                    for (int q = 0; q < 16; ++q) { const int row = (q & 3) + 8 * (q >> 2) + 4 * hh; Tm[q] = row < r32 ? Tm[q] : 0.f; }
                    MkaF[0] = acc_frag(Tm, 0); MkaF[1] = acc_frag(Tm, 1); }
#pragma unroll
                  for (int q = 0; q < 16; ++q) { Mp[q] = 0.f; Np[q] = 0.f; X[q] = 0.f; }
#pragma unroll
                  for (int s4 = 0; s4 < 4; ++s4) { Mp = MFMA32(BKf[0][s4], XTf[s4], Mp); Np = MFMA32(XTf[s4], BKf[0][s4], Np); }
#pragma unroll
                  for (int q = 0; q < 16; ++q) { const int row = (q & 3) + 8 * (q >> 2) + 4 * hh; Mp[q] = row < r32 ? Mp[q] : 0.f; Np[q] = r32 < row ? Np[q] : 0.f; }
#pragma unroll
                  for (int kb = 0; kb < 2; ++kb)
#pragma unroll
                      for (int s2 = 0; s2 < 2; ++s2) X = MFMA32(XTf[2 * kb + s2], acc_frag(ST[kb], s2), X);
#pragma unroll
                  for (int s2 = 0; s2 < 2; ++s2) { const bf16x8 Vf = *(const LAS bf16x8*)(RV + (32 * vb + r32) * 80 + (16 * s2 + 8 * hh) * 2); X = MFMA32(MkaF[s2], Vf, X); } }
                __builtin_amdgcn_sched_barrier(0);
#pragma unroll
                for (int lvl = 0; lvl < 5; ++lvl) {
                    bf16x8 Ma[2], Na[2];
#pragma unroll
                    for (int s2 = 0; s2 < 2; ++s2) { Ma[s2] = acc_frag(Mp, s2); Na[s2] = acc_frag(Np, s2); }
                    { const bf16x8 x0 = acc_frag(X, 0), x1 = acc_frag(X, 1); X = MFMA32(Ma[0], x0, X); X = MFMA32(Ma[1], x1, X); }
                    if (lvl < 4) { f32x16 M2, N2;
#pragma unroll
                        for (int q = 0; q < 16; ++q) { M2[q] = 0.f; N2[q] = 0.f; }
                        M2 = MFMA32(Na[0], Ma[0], M2); M2 = MFMA32(Na[1], Ma[1], M2);
                        N2 = MFMA32(Ma[0], Na[0], N2); N2 = MFMA32(Ma[1], Na[1], N2);
                        Mp = M2; Np = N2; }
                }
                __builtin_amdgcn_sched_barrier(0);
                { bf16x8 XRf[4], MbrF[2], MkrF[2];
#pragma unroll
                  for (int s4 = 0; s4 < 4; ++s4) XRf[s4] = *(const LAS bf16x8*)(XT + (32 + r32) * 64 + 16 * s4 + 8 * hh);
                  { f32x16 Tm, Tn;
#pragma unroll
                    for (int q = 0; q < 16; ++q) { Tm[q] = 0.f; Tn[q] = 0.f; }
#pragma unroll
                    for (int s4 = 0; s4 < 4; ++s4) { const bf16x8 Bb = *(const LAS bf16x8*)(BK + r32 * 64 + 16 * s4 + 8 * hh), Bk = *(const LAS bf16x8*)(BK + (32 + r32) * 64 + 16 * s4 + 8 * hh);
                        Tm = MFMA32(Bb, XRf[s4], Tm); Tn = MFMA32(Bk, XRf[s4], Tn); }
#pragma unroll
                    for (int q = 0; q < 16; ++q) { const int row = (q & 3) + 8 * (q >> 2) + 4 * hh; Tm[q] = row <= r32 ? Tm[q] : 0.f; Tn[q] = row <= r32 ? Tn[q] : 0.f; }
                    MbrF[0] = acc_frag(Tm, 0); MbrF[1] = acc_frag(Tm, 1); MkrF[0] = acc_frag(Tn, 0); MkrF[1] = acc_frag(Tn, 1); }
                  { const bf16x8 u0 = acc_frag(X, 0), u1 = acc_frag(X, 1);
                    const bf16x8 Vf0 = *(const LAS bf16x8*)(RV + (32 * vb + r32) * 80 + (8 * hh) * 2), Vf1 = *(const LAS bf16x8*)(RV + (32 * vb + r32) * 80 + (16 + 8 * hh) * 2);
                    f32x16 Yt;
#pragma unroll
                    for (int q = 0; q < 16; ++q) Yt[q] = 0.f;
#pragma unroll
                    for (int kb = 0; kb < 2; ++kb)
#pragma unroll
                        for (int s2 = 0; s2 < 2; ++s2) Yt = MFMA32(XRf[2 * kb + s2], acc_frag(ST[kb], s2), Yt);
                    Yt = MFMA32(MkrF[0], Vf0, Yt); Yt = MFMA32(MkrF[1], Vf1, Yt);
                    Yt = MFMA32(MbrF[0], u0, Yt); Yt = MFMA32(MbrF[1], u1, Yt);
#pragma unroll
                    for (int q = 0; q < 16; ++q) { const int t = (q & 3) + 8 * (q >> 2) + 4 * hh; Yo[(size_t)(base + t0 + dt * (bt + t)) * D + 64 * hd + 32 * vb + r32] = (bf16_t)f2bf(Yt[q]); }
#pragma unroll
                    for (int kb = 0; kb < 2; ++kb) {
                        const bf16x8 b0 = *(const LAS bf16x8*)(RB + (32 * kb + r32) * 144 + (8 * hh) * 2), b1 = *(const LAS bf16x8*)(RB + (32 * kb + r32) * 144 + (16 + 8 * hh) * 2);
                        const bf16x8 k0 = *(const LAS bf16x8*)(RB + (32 * kb + r32) * 144 + 64 + (8 * hh) * 2), k1 = *(const LAS bf16x8*)(RB + (32 * kb + r32) * 144 + 64 + (16 + 8 * hh) * 2);
                        ST[kb] = MFMA32(b0, u0, ST[kb]); ST[kb] = MFMA32(b1, u1, ST[kb]);
                        ST[kb] = MFMA32(k0, Vf0, ST[kb]); ST[kb] = MFMA32(k1, Vf1, ST[kb]); }
                  } }
                __builtin_amdgcn_sched_barrier(0);
#pragma unroll
                for (int kb = 0; kb < 2; ++kb)
#pragma unroll
                    for (int g4 = 0; g4 < 4; ++g4) { const f32x4 cc = *(const LAS f32x4*)(cCb + 32 * kb + 8 * g4 + 4 * hh);
                        ST[kb][4 * g4 + 0] *= cc.x; ST[kb][4 * g4 + 1] *= cc.y; ST[kb][4 * g4 + 2] *= cc.z; ST[kb][4 * g4 + 3] *= cc.w; }
                asm volatile("" :: "v"(pf0), "v"(pf1));
                PAIR_SYNC();
            }
        }
    }
    __syncthreads();
}
#undef PAIR_SYNC
#undef MFMA32
__device__ __forceinline__ void phase_rwkv_out(Frame& F, const Args& A, int nrows) {
    REFRESH(F);
    const bf16_t* Y0 = WSP(bf16_t, WS_YS); const bf16_t* Y1 = Y0 + (size_t)NT * D; const float* B0 = WSP(float, WS_BONUS); const float* B1 = B0 + (size_t)NT * 16;
    const bf16_t* Vv = WSP(bf16_t, WS_RKV) + (size_t)2 * NT * D; const bf16_t* Gg = WSP(bf16_t, WS_G); bf16_t* RO = WSP(bf16_t, WS_RO);
    const float* lnw = A.in[I_RLNW]; const float* lnb = A.in[I_RLNB];
    for (int it = 0;; ++it) { if (ROWOF(it, 0) >= nrows) break;
        f32x4 y[RB][4], vv[RB][4], gg[RB][4]; float bon[RB][4];
#pragma unroll
        for (int r = 0; r < RB; ++r) { const int row = ROWOF(it, r);
#pragma unroll
            for (int j = 0; j < 4; ++j) { const int col = 256 * j + 4 * F.lane, head = 4 * j + (F.lane >> 4); const size_t o = (size_t)row * D + col;
                y[r][j] = ld_bf4(Y0 + o) + ld_bf4(Y1 + o); vv[r][j] = ld_bf4(Vv + o); gg[r][j] = ld_bf4(Gg + o); bon[r][j] = B0[(size_t)row * 16 + head] + B1[(size_t)row * 16 + head]; } }
#pragma unroll
        for (int r = 0; r < RB; ++r) { const int row = ROWOF(it, r);
#pragma unroll
            for (int j = 0; j < 4; ++j) { const int col = 256 * j + 4 * F.lane; const size_t o = (size_t)row * D + col; const f32x4 yy = y[r][j];
                const float s = row16_sum((yy.x + yy.y) + (yy.z + yy.w));
                const f32x4 d = yy - s * (1.0f / 64.0f);
                const float q = row16_sum((d.x * d.x + d.y * d.y) + (d.z * d.z + d.w * d.w));
                const float rs = 1.0f / sqrtf(q * (1.0f / 64.0f) + 64e-5f);
                const f32x4 yn = d * rs * *(const f32x4*)(lnw + col) + *(const f32x4*)(lnb + col);
                { const f32x4 ov = (yn + vv[r][j] * bon[r][j]) * gg[r][j]; *(unsigned*)((unsigned char*)RO + o) = pk4_fp8(ov.x, ov.y, ov.z, ov.w); } } }
    }
}

__device__ __forceinline__ void phase_attn(Frame& F, const Args& A, int j, bool need_ctx) {
    REFRESH(F);
    const bf16_t* Q = WSP(bf16_t, WS_Q); const bf16_t* Kb = WSP(bf16_t, WS_K); const bf16_t* VT = WSP(bf16_t, WS_VT); bf16_t* O = WSP(bf16_t, WS_O);
    const float* sinks = A.in[I_ASINK] + j * 16;
    LAS bf16_t* Ks = (LAS bf16_t*)F.lds; LAS bf16_t* Vs = (LAS bf16_t*)(F.lds + 9216);
    LAS bf16x8* Qs = (LAS bf16x8*)(F.lds + 18432 + F.wave * 8192) + F.lane;
    const int nunits = 2048 + (need_ctx ? 256 : 0);
    const int fr = F.lane & 15, fq = F.lane >> 4, g = F.wave >> 1, hf = F.wave & 1;
    const float SC = 0.125f * 1.4426950408889634f;
    const int lr = F.tid >> 3, lch = F.tid & 7;
    __syncthreads();
    for (int u = F.c; u < nunits; u += F.G) {
        int b, kvh, qb; bool isx;
        if (u < 2048) { isx = true; b = u >> 6; kvh = (u >> 4) & 3; qb = u & 15; } else { const int v = u - 2048; isx = false; b = v >> 3; kvh = (v >> 1) & 3; qb = v & 1; }
        const int qrow0 = (isx ? b * T : NX + b * L) + qb * 128 + hf * 64; const int head = 4 * kvh + g;
        int jlo = 0, jhi = -1;
        if (isx) { jlo = qb == 0 ? 2 : 0; jhi = qb == 15 ? 3 : 5; }
        const int ntiles = 4 + (jhi - jlo + 1);
        auto tile_row0 = [&](int ti) -> int { return ti < 4 ? NX + b * L + ti * 64 : b * T + qb * 128 - 128 + 64 * (jlo + ti - 4); };
        u32x4 kv_n, vv_n;
        { const int kr0 = tile_row0(0); kv_n = *(const u32x4*)(Kb + (size_t)(kr0 + lr) * 256 + kvh * 64 + lch * 8); vv_n = *(const u32x4*)(VT + (size_t)(kvh * 64 + lr) * NT + kr0 + lch * 8); }
#pragma unroll
        for (int mq = 0; mq < 4; ++mq)
#pragma unroll
            for (int ks = 0; ks < 2; ++ks) Qs[64 * (mq * 2 + ks)] = *(const bf16x8*)(Q + (size_t)(qrow0 + 16 * mq + fr) * D + head * 64 + ks * 32 + 8 * fq);
        const float sink2 = sinks[head] * 1.4426950408889634f;
        float mrun[4], lrun[4]; f32x4 Oa[4][4];
#pragma unroll
        for (int mq = 0; mq < 4; ++mq) { mrun[mq] = sink2; lrun[mq] = fq == 0 ? 1.0f : 0.0f;
#pragma unroll
            for (int db = 0; db < 4; ++db) Oa[mq][db] = (f32x4){0.f, 0.f, 0.f, 0.f}; }
        for (int ti = 0; ti < ntiles; ++ti) {
            const int jl = ti < 4 ? -1 : jlo + ti - 4; const int ks0 = qb * 128 - 128 + 64 * jl;
            __syncthreads();
            *(LAS u32x4*)(Ks + lr * 72 + lch * 8) = kv_n; *(LAS u32x4*)(Vs + lr * 72 + lch * 8) = vv_n;
            __syncthreads();
            if (ti + 1 < ntiles) { const int kr0 = tile_row0(ti + 1); kv_n = *(const u32x4*)(Kb + (size_t)(kr0 + lr) * 256 + kvh * 64 + lch * 8); vv_n = *(const u32x4*)(VT + (size_t)(kvh * 64 + lr) * NT + kr0 + lch * 8); }
            const bool need = (jl < 0) || (jl >= hf && jl <= hf + 4);
            if (need) {
                const bool domask = (jl >= 0) && (jl == hf || jl == hf + 4);
                f32x4 Sa[4][4];
#pragma unroll
                for (int mq = 0; mq < 4; ++mq)
#pragma unroll
                    for (int n = 0; n < 4; ++n) Sa[mq][n] = (f32x4){0.f, 0.f, 0.f, 0.f};
#pragma unroll
                for (int ks = 0; ks < 2; ++ks) {
                    bf16x8 Qf[4];
#pragma unroll
                    for (int mq = 0; mq < 4; ++mq) Qf[mq] = Qs[64 * (mq * 2 + ks)];
#pragma unroll
                    for (int n = 0; n < 4; ++n) { const int kr = 32 * (n >> 1) + 8 * (fr >> 2) + 4 * (n & 1) + (fr & 3);
                        const bf16x8 Kf = *(const LAS bf16x8*)(Ks + kr * 72 + ks * 32 + 8 * fq);
#pragma unroll
                        for (int mq = 0; mq < 4; ++mq) Sa[mq][n] = __builtin_amdgcn_mfma_f32_16x16x32_bf16(Kf, Qf[mq], Sa[mq][n], 0, 0, 0); } }
                bf16x8 Pf[4][2];
#pragma unroll
                for (int mq = 0; mq < 4; ++mq) {
                    float mx = -1e30f;
                    if (domask) { const int tq = qb * 128 + hf * 64 + 16 * mq + fr;
#pragma unroll
                        for (int n = 0; n < 4; ++n)
#pragma unroll
                            for (int i = 0; i < 4; ++i) { float sv = Sa[mq][n][i]; const int rel = ks0 + 32 * (n >> 1) + 8 * fq + 4 * (n & 1) + i - tq; if (rel > 128 || rel < -128) sv = -1e30f; Sa[mq][n][i] = sv; mx = fmaxf(mx, sv); } }
                    else {
#pragma unroll
                        for (int n = 0; n < 4; ++n)
#pragma unroll
                            for (int i = 0; i < 4; ++i) mx = fmaxf(mx, Sa[mq][n][i]); }
                    mx = fmaxf(mx, __shfl_xor(mx, 16)); mx = fmaxf(mx, __shfl_xor(mx, 32));
                    const float mnew = fmaxf(mrun[mq], mx * SC); const float alpha = __builtin_amdgcn_exp2f(mrun[mq] - mnew); mrun[mq] = mnew;
                    float rs = 0.f; const float nm = -mnew;
#pragma unroll
                    for (int n = 0; n < 4; ++n) { const f32x4 tt = Sa[mq][n] * SC + nm;
#pragma unroll
                        for (int i = 0; i < 4; ++i) { const float p = __builtin_amdgcn_exp2f(tt[i]); Sa[mq][n][i] = p; rs += p; } }
                    lrun[mq] = lrun[mq] * alpha + rs;
#pragma unroll
                    for (int db = 0; db < 4; ++db) Oa[mq][db] *= alpha;
#pragma unroll
                    for (int s2 = 0; s2 < 2; ++s2) { u32x4 w; w.x = cvt_pk_bf16(Sa[mq][2 * s2][0], Sa[mq][2 * s2][1]); w.y = cvt_pk_bf16(Sa[mq][2 * s2][2], Sa[mq][2 * s2][3]);
                        w.z = cvt_pk_bf16(Sa[mq][2 * s2 + 1][0], Sa[mq][2 * s2 + 1][1]); w.w = cvt_pk_bf16(Sa[mq][2 * s2 + 1][2], Sa[mq][2 * s2 + 1][3]); Pf[mq][s2] = __builtin_bit_cast(bf16x8, w); }
                }
#pragma unroll
                for (int db = 0; db < 4; ++db)
#pragma unroll
                    for (int s2 = 0; s2 < 2; ++s2) { const bf16x8 Vf = *(const LAS bf16x8*)(Vs + (16 * db + fr) * 72 + 32 * s2 + 8 * fq);
#pragma unroll
                        for (int mq = 0; mq < 4; ++mq) Oa[mq][db] = __builtin_amdgcn_mfma_f32_16x16x32_bf16(Vf, Pf[mq][s2], Oa[mq][db], 0, 0, 0); }
            }
        }
#pragma unroll
        for (int mq = 0; mq < 4; ++mq) { float l = lrun[mq]; l += __shfl_xor(l, 16); l += __shfl_xor(l, 32); const float inv = 1.0f / l;
            unsigned char* op = (unsigned char*)O + (size_t)(qrow0 + 16 * mq + fr) * D + head * 64 + 4 * fq;
#pragma unroll
            for (int db = 0; db < 4; ++db) { const f32x4 o = Oa[mq][db] * inv; *(unsigned*)(op + 16 * db) = pk4_fp8(o.x, o.y, o.z, o.w); } }
    }
    __syncthreads();
}

struct KState { XcdBarrier bar; int ph; };
#define RUN() (A.one || A.phase == KS.ph)
#define SEAM() do { if (A.one) xcd_barrier(KS.bar); ++KS.ph; } while (0)
template <int LAYER>
__device__ __forceinline__ void layer_body(Frame& F, const Args& A, KState& KS) {
    constexpr int layer = LAYER, kind = LAYER % 3, j = LAYER / 3; constexpr bool last = (LAYER == DEPTH - 1);
    LAS unsigned char* ring = F.lds;
    const LAS int* tpre = (const LAS int*)(F.lds + TPRE_OFF); const LAS int* lcnt = (const LAS int*)(F.lds + LCNT_OFF);
    bf16_t* H = WSP(bf16_t, WS_H); const float* MOD = WSP(float, WS_MOD); const bf16_t* AX = WSP(bf16_t, WS_AX);
    const float* gate1 = MOD + (size_t)layer * 33 * 6144 + 2 * D;
    constexpr int nMall = last ? NX / 256 : NT / 256;
    if (RUN()) phase_norm1(F, A, layer);
    SEAM();
    if constexpr (kind == 0) {
        if (RUN()) {
            { pg8::ProbDense8 P; P.A = (const unsigned char*)AX; P.Bt = WSP(unsigned char, WS_WQK) + (size_t)j * 1280 * D; P.lda = D; P.ldb = D; P.K = D; P.scale_w = SCALE_W; P.scale_x = SCALE_ONE; P.ord.init(NT / 256, 5, F.G, F.c);
              EpiQK E{WSP(bf16_t, WS_Q), WSP(bf16_t, WS_K), WSP(float, WS_BQK) + j * 1280, WSP(float, WS_ROPEC), WSP(float, WS_ROPES)};
              pg8::gemm_phase(ring, P, E); }
            { pg8::ProbDense8 P; P.A = WSP(unsigned char, WS_WV) + (size_t)j * 256 * D; P.Bt = (const unsigned char*)AX; P.lda = D; P.ldb = D; P.K = D; P.scale_w = SCALE_ONE; P.scale_x = SCALE_W; P.ord.init(1, NT / 256, F.G, (F.c + 96) % F.G);
              EpiVT E{WSP(bf16_t, WS_VT), A.in[I_ABQKV] + j * 1536 + 1280};
              pg8::gemm_phase(ring, P, E); }
        }
        SEAM();
        if (RUN()) phase_attn(F, A, j, !last);
        SEAM();
        if (RUN()) { pg8::ProbDense8 P; P.A = WSP(unsigned char, WS_O); P.Bt = WSP(unsigned char, WS_WO) + (size_t)j * D * D; P.lda = D; P.ldb = D; P.K = D; P.scale_w = SCALE_W; P.scale_x = SCALE_ONE; P.ord.init(nMall, 4, F.G, F.c);
            EpiResid E{H, A.in[I_ABO] + j * D, nullptr, gate1};
            pg8::gemm_phase(ring, P, E); }
        SEAM();
    } else if constexpr (kind == 1) {
        if (RUN()) phase_pooldiff(F);
        SEAM();
        if (RUN()) { pg8::ProbDense P; P.A = WSP(bf16_t, WS_PD); P.Bt = WSP(bf16_t, WS_POOLW); P.lda = D; P.ldb = 256; P.K = 256; P.a_pn_off = 256; P.ord.init(nMall, 4, F.G, F.c);
            EpiResid E{H, A.in[I_PB], A.in[I_PS], gate1};
            pg8::gemm_phase(ring, P, E); }
        SEAM();
    } else {
        if (RUN()) phase_rwkv_mix(F, A);
        SEAM();
        if (RUN()) {
            for (int i = 0; i < 3; ++i) { const int sel = i == 0 ? 0 : i == 1 ? 2 : 3;
                pg8::ProbDense8 P; P.A = (const unsigned char*)(WSP(bf16_t, WS_A6) + (size_t)sel * NT * D); P.Bt = WSP(unsigned char, WS_WRKV) + (size_t)i * D * D; P.lda = D; P.ldb = D; P.K = D; P.scale_w = SCALE_W; P.scale_x = SCALE_ONE; P.ord.init(NT / 256, 4, F.G, (F.c + (i == 1 ? 128 : 0)) % F.G);
                EpiBf16Act E{WSP(bf16_t, WS_RKV) + (size_t)i * NT * D, D, nullptr, 0, 1.0f};
                pg8::gemm_phase(ring, P, E); }
            for (int i = 0; i < 3; ++i) { const int sel = i == 0 ? 5 : i == 1 ? 1 : 4;
                pg8::ProbDense P; P.A = WSP(bf16_t, WS_A6) + (size_t)sel * NT * D; P.Bt = WSP(bf16_t, WS_WL1) + (size_t)i * 256 * D; P.lda = D; P.ldb = D; P.K = D; P.a_pn_off = 0; P.ord.init(NT / 256, 1, F.G, (F.c + 128 - 32 * i) % F.G);
                EpiBf16Act E{WSP(bf16_t, WS_LORA) + i * 256, 768, nullptr, i == 0 ? 1 : i == 1 ? 2 : 0, 1.0f};
                pg8::gemm_phase(ring, P, E); }
        }
        SEAM();
        if (RUN()) {
            for (int i = 0; i < 5; ++i) {
                const int ablk = i == 0 ? 0 : i < 3 ? 1 : 2, d = (i - 1) & 1;
                pg8::ProbDense P; P.A = WSP(bf16_t, WS_LORA) + ablk * 256; P.Bt = WSP(bf16_t, WS_WL2) + (size_t)i * D * 256; P.lda = 768; P.ldb = 256; { int k128 = 128; asm volatile("" : "+s"(k128)); P.K = k128; }     P.a_pn_off = 0; P.ord.init(NT / 256, 4, F.G, (F.c + 128 * (i & 1)) % F.G);
                EpiBf16Act E; E.ldc = D;
                if (i == 0) { E.O = WSP(bf16_t, WS_G); E.bias = nullptr; E.act = 0; E.scale = 1.0f; }
                else if (i < 3) { E.O = WSP(bf16_t, WS_E) + (size_t)d * NT * D; E.bias = A.in[I_RW0] + d * D; E.act = 1; E.scale = 0.6065306597126334f; }
                else { E.O = WSP(bf16_t, WS_A) + (size_t)d * NT * D; E.bias = A.in[I_RA0] + d * D; E.act = 1; E.scale = 1.0f; }
                pg8::gemm_phase(ring, P, E); }
        }
        SEAM();
        if (RUN()) phase_rwkv_scan(F, A);
        SEAM();
        if (RUN()) phase_rwkv_out(F, A, last ? NX : NT);
        SEAM();
        if (RUN()) { pg8::ProbDense8 P; P.A = WSP(unsigned char, WS_RO); P.Bt = WSP(unsigned char, WS_WOR); P.lda = D; P.ldb = D; P.K = D; P.scale_w = SCALE_W; P.scale_x = SCALE_ONE; P.ord.init(nMall, 4, F.G, F.c);
            EpiResid E{H, nullptr, nullptr, gate1};
            pg8::gemm_phase(ring, P, E); }
        SEAM();
    }
    if (RUN()) phase_route(F, A, layer);
    SEAM();
    if (RUN()) { moe_tiles(F, layer);
        ProbMoe1 P; P.FX = WSP(fp8_t, WS_FX); P.W1T = WSP(fp8_t, WS_W1T) + (size_t)layer * NE * 2048 * D; P.list = WSP(int, WS_LIST); P.tpre = tpre; P.cnt = lcnt; P.texp = (const LAS unsigned char*)(F.lds + TEXP_OFF); P.toks = (LAS int*)(F.lds + TOKS_OFF); P.scale_w = SCALE_W; P.scale_x = SCALE_ONE; P.ord.init(tpre[NE], 8, F.G, F.c);
        EpiMoe1 E{WSP(unsigned char, WS_ACT), A.in[I_MB1] + (size_t)layer * NE * 2048};
        pg8::gemm_phase(ring, P, E); }
    SEAM();
    if (RUN()) { moe_tiles(F, layer);
        ProbMoe2 P; P.ACT = WSP(fp8_t, WS_ACT); P.W2T = WSP(fp8_t, WS_W2T) + (size_t)layer * NE * D * D; P.tpre = tpre; P.texp = (const LAS unsigned char*)(F.lds + TEXP_OFF); P.scale_w = SCALE_W4; P.scale_x = SCALE_ONE; P.ord.init(tpre[NE], 4, F.G, F.c);
        EpiMoe2 E{WSP(unsigned char, WS_Y), A.in[I_MB2] + (size_t)layer * NE * D};
        pg8::gemm_phase(ring, P, E); }
    SEAM();
}
__global__ void __launch_bounds__(NTHREADS, 2) trunk_fwd(Args A) {
    extern __shared__ __attribute__((aligned(16))) unsigned char lds_[];
    Frame F; F.lds = (LAS unsigned char*)lds_; REFRESH(F); F.wave = __builtin_amdgcn_readfirstlane(F.tid >> 6);
    F.G = gridDim.x; F.c = blockIdx.x; F.ws = A.ws; F.ctl = (unsigned*)(A.ws + WS_CTL);
    for (int u = F.tid; u < (LDS_BYTES - LDSCTL_OFF) / 4; u += NTHREADS) ((LAS unsigned*)(F.lds + LDSCTL_OFF))[u] = 0u;
    __syncthreads();
    KState KS; KS.bar.bar = F.ctl + CW_BAR; KS.bar.x = 0; KS.bar.st = nullptr; KS.ph = 0;
    if (A.one) KS.bar = xcd_barrier_post(F.ctl + CW_BAR, (volatile LAS unsigned*)(F.lds + MISC_OFF) + 8);
    if (RUN()) phase_prologue(F, A);
    SEAM();
    layer_body<0>(F, A, KS);
    layer_body<1>(F, A, KS);
    layer_body<2>(F, A, KS);
    layer_body<3>(F, A, KS);
    if (RUN()) phase_final(F, A);
}
#undef RUN
#undef SEAM
static int count_phases() { int n = 1; for (int layer = 0; layer < DEPTH; ++layer) { const int kind = layer % 3; n += 1 + (kind == 0 ? 3 : kind == 1 ? 2 : 6) + 3; } return n + 1; }

extern "C" void kernel_launch(void* const* d_in, const int* in_sizes, int n_in, void* d_out, int out_size, void* d_ws, size_t ws_size, hipStream_t stream) {
    static int grid = 0;
    if (grid == 0) {
        if (n_in != 38 || out_size != NX * D || ws_size < WS_END) { fprintf(stderr, "kernel_launch: unexpected problem (n_in %d, out %d, ws %zu < %zu)\n", n_in, out_size, ws_size, (size_t)WS_END); grid = -1; return; }
        int dev = 0, cus = 0;
        if (hipGetDevice(&dev) != hipSuccess || hipDeviceGetAttribute(&cus, hipDeviceAttributeMultiprocessorCount, dev) != hipSuccess) { grid = -1; return; }
        if (hipFuncSetAttribute((const void*)trunk_fwd, hipFuncAttributeMaxDynamicSharedMemorySize, LDS_BYTES) != hipSuccess) { fprintf(stderr, "kernel_launch: hipFuncSetAttribute failed\n"); grid = -1; return; }
        int per_cu = 0;
        if (hipOccupancyMaxActiveBlocksPerMultiprocessor(&per_cu, (const void*)trunk_fwd, NTHREADS, LDS_BYTES) != hipSuccess || per_cu < 1) fprintf(stderr, "kernel_launch: occupancy query says %d\n", per_cu);
        (void)hipGetLastError();
        grid = cus;
        if (grid != 256) fprintf(stderr, "kernel_launch: %d CUs (built for 256)\n", grid);
    }
    if (grid < 0) return;
    (void)hipMemsetAsync((char*)d_ws + WS_CTL, 0, CTL_BYTES, stream);
    (void)hipMemsetAsync((char*)d_ws + WS_LZERO, 0, LZERO_BYTES, stream);
    Args a{};
    for (int i = 0; i < 38; ++i) a.in[i] = (const float*)d_in[i];
    a.out = (float*)d_out; a.ws = (unsigned char*)d_ws;
#if MK_ONE_LAUNCH
    a.phase = 0; a.one = 1;
    hipLaunchKernelGGL(trunk_fwd, dim3(grid), dim3(NTHREADS), LDS_BYTES, stream, a);
#else
    const int nph = count_phases();
    for (int p = 0; p < nph; ++p) { a.phase = p; a.one = 0; hipLaunchKernelGGL(trunk_fwd, dim3(grid), dim3(NTHREADS), LDS_BYTES, stream, a); }
#endif
}
```
